# Optimizing an MI355X kernel written in HIP

```python
import math
import jax
import jax.numpy as jnp
from jax import lax
import numpy as np

D_MODEL = 1024
BATCH = 8
SEQ = 4096
DEPTH = 2

HEAD_DIM = 64
N_EVEN = (DEPTH + 1) // 2
N_ODD = DEPTH // 2
NUM_BUCKETS = 32
MAX_DISTANCE = 128
N_BIAS_HEADS = 16
ALPHA = (2 * DEPTH) ** 0.25
BETA = (8 * DEPTH) ** -0.25
A_HEADS = 8
A_Q_RANK = 256
A_KV_RANK = 128
IDX_HEADS = 16
IDX_DIM = 64
DSA_TOPK = 256
B_HEADS = 8
B_GROUPS = 2
B_HPG = B_HEADS // B_GROUPS
CMP_LEN = 32
CMP_STRIDE = 16
SLC_BLOCK = 64
SLC_TOPN = 16
WINDOW = 512
C_HEADS = 16
MOBA_BLOCK = 256
MOBA_TOPK = 3
D_FF = 2816
N_EXPERTS = 8
TOP_K = 2
D_FF_EXPERT = 3584
EXPERT_ROWS = 256
Q_BLOCK = 64
MOBA_Q_BLOCK = 16
EVEN_SPLITS = (A_Q_RANK, A_KV_RANK, IDX_DIM, IDX_HEADS, B_HEADS * HEAD_DIM) + (B_GROUPS * HEAD_DIM,) * 6 + (B_HEADS * 3,)
EVEN_IN = sum(EVEN_SPLITS)
ODD_IN = 3 * C_HEADS * HEAD_DIM
MIX_WIDTH_EVEN = (A_HEADS + B_HEADS) * HEAD_DIM
MIX_WIDTH_ODD = C_HEADS * HEAD_DIM

kernel_name = 'hybrid_dsa_nsa_moba_moe_deepnorm'


def split_cols(y, sizes):
    cuts = [int(c) for c in np.cumsum(sizes)[:-1]]
    return jnp.split(y, cuts, axis=-1)


def layer_norm(x, g, b, eps=1e-5):
    xf = x.astype(jnp.float32)
    mu = jnp.mean(xf, axis=-1, keepdims=True)
    var = jnp.mean(jnp.square(xf - mu), axis=-1, keepdims=True)
    return ((xf - mu) * lax.rsqrt(var + eps) * g + b).astype(x.dtype)


def rms_norm(x, g, eps=1e-6):
    xf = x.astype(jnp.float32)
    return (xf * lax.rsqrt(jnp.mean(jnp.square(xf), axis=-1, keepdims=True) + eps) * g).astype(x.dtype)


def swiglu(h, w1, w3, w2):
    return (jax.nn.silu(h @ w1) * (h @ w3)) @ w2


def masked_softmax(logits, mask):
    z = jnp.where(mask, logits.astype(jnp.float32), -jnp.inf)
    m = jnp.max(z, axis=-1, keepdims=True)
    m = jnp.where(jnp.isfinite(m), m, 0.0)
    e = jnp.exp(z - m)
    s = jnp.sum(e, axis=-1, keepdims=True)
    return e / jnp.where(s > 0, s, 1.0)


def t5_bucket(dist):
    n = jnp.maximum(dist, 0)
    max_exact = NUM_BUCKETS // 2
    large = max_exact + (jnp.log(jnp.maximum(n, 1).astype(jnp.float32) / max_exact)
                         / math.log(MAX_DISTANCE / max_exact) * (NUM_BUCKETS - max_exact)).astype(jnp.int32)
    large = jnp.minimum(large, NUM_BUCKETS - 1)
    return jnp.where(n < max_exact, n, large)


def dsa_attention(c_q, c_kv, k_idx, w_idx, q_norm, kv_norm, w_uq, w_uk, w_uv, w_qidx, bias_table):
    bsz, seq = c_q.shape[:2]
    scale = HEAD_DIM ** -0.5
    c_q = rms_norm(c_q, q_norm)
    c_kv = rms_norm(c_kv, kv_norm)
    q = jnp.einsum('bsr,rhd->bshd', c_q, w_uq)
    q_lat = jnp.einsum('bshd,chd->bshc', q, w_uk)
    q_idx = jnp.einsum('bsr,rhd->bshd', c_q, w_qidx)
    w_idx = w_idx * IDX_HEADS ** -0.5
    n_keep = min(DSA_TOPK, seq // 4)
    b_idx = jnp.arange(bsz)[:, None, None]
    s_pos = jnp.arange(seq)

    def chunk(c):
        start = c * Q_BLOCK
        t = start + jnp.arange(Q_BLOCK)
        ql = lax.dynamic_slice_in_dim(q_lat, start, Q_BLOCK, axis=1)
        qi = lax.dynamic_slice_in_dim(q_idx, start, Q_BLOCK, axis=1)
        wi = lax.dynamic_slice_in_dim(w_idx, start, Q_BLOCK, axis=1)
        dots = jax.nn.relu(jnp.einsum('bqhd,bsd->bqhs', qi, k_idx))
        score = jnp.einsum('bqhs,bqh->bqs', dots, wi).astype(jnp.float32)
        score = jnp.where(s_pos[None, None, :] <= t[None, :, None], score, -jnp.inf)
        _, idx = lax.top_k(score, n_keep)
        c_sel = c_kv[b_idx, idx]
        dist = t[None, :, None] - idx
        logits = jnp.einsum('bqhr,bqkr->bhqk', ql, c_sel).astype(jnp.float32) * scale
        logits = logits + jnp.moveaxis(bias_table[t5_bucket(dist)], -1, 1)
        p = masked_softmax(logits, (dist >= 0)[:, None])
        o_lat = jnp.einsum('bhqk,bqkr->bqhr', p.astype(c_sel.dtype), c_sel)
        o = jnp.einsum('bqhr,rhd->bqhd', o_lat, w_uv)
        return o.astype(c_q.dtype).reshape(bsz, Q_BLOCK, A_HEADS * HEAD_DIM)

    out = lax.map(chunk, jnp.arange(seq // Q_BLOCK))
    return out.transpose(1, 0, 2, 3).reshape(bsz, seq, A_HEADS * HEAD_DIM)


def nsa_attention(q, k_cmp, v_cmp, k_slc, v_slc, k_win, v_win, gate_logits,
                  pos_k, pos_v, ck1, ck2, cv1, cv2, bias_table):
    bsz, seq = q.shape[:2]
    scale = HEAD_DIM ** -0.5
    q = q.reshape(bsz, seq, B_GROUPS, B_HPG, HEAD_DIM)
    kv_shape = (bsz, seq, B_GROUPS, HEAD_DIM)
    k_cmp, v_cmp, k_slc, v_slc, k_win, v_win = [a.reshape(kv_shape) for a in (k_cmp, v_cmp, k_slc, v_slc, k_win, v_win)]
    n_cmp = (seq - CMP_LEN) // CMP_STRIDE + 1
    cmp_start = np.arange(n_cmp) * CMP_STRIDE
    cmp_tok = cmp_start[:, None] + np.arange(CMP_LEN)[None, :]

    def compress(a, pos, w1, w2):
        blocks = a[:, cmp_tok] + pos[None, None, :, None, :]
        hid = jax.nn.gelu(jnp.einsum('bnlgd,lde->bnge', blocks, w1))
        return jnp.einsum('bnge,ef->bngf', hid, w2)

    kc = compress(k_cmp, pos_k, ck1, ck2)
    vc = compress(v_cmp, pos_v, cv1, cv2)
    cmp_end = jnp.asarray(cmp_start + CMP_LEN - 1, jnp.int32)
    n_slc = seq // SLC_BLOCK
    n_sel = min(SLC_TOPN, n_slc)
    slc_start = np.arange(n_slc) * SLC_BLOCK
    overlap = jnp.asarray(((cmp_start[:, None] + CMP_LEN - 1 >= slc_start[None, :])
                           & (cmp_start[:, None] <= slc_start[None, :] + SLC_BLOCK - 1)).astype(np.float32))
    ks_blocks = k_slc.reshape(bsz, n_slc, SLC_BLOCK, B_GROUPS, HEAD_DIM).transpose(0, 3, 1, 2, 4)
    vs_blocks = v_slc.reshape(bsz, n_slc, SLC_BLOCK, B_GROUPS, HEAD_DIM).transpose(0, 3, 1, 2, 4)
    kw_pad = jnp.pad(k_win, ((0, 0), (WINDOW, 0), (0, 0), (0, 0)))
    vw_pad = jnp.pad(v_win, ((0, 0), (WINDOW, 0), (0, 0), (0, 0)))
    gates = jax.nn.sigmoid(gate_logits.astype(jnp.float32)).reshape(bsz, seq, B_GROUPS, B_HPG, 3)
    table = bias_table.reshape(NUM_BUCKETS, B_GROUPS, B_HPG).transpose(1, 0, 2)
    b_idx = jnp.arange(bsz)[:, None, None, None]
    g_idx = jnp.arange(B_GROUPS)[None, :, None, None]
    blk = jnp.arange(n_slc)

    def chunk(c):
        start = c * Q_BLOCK
        t = start + jnp.arange(Q_BLOCK)
        qc = lax.dynamic_slice_in_dim(q, start, Q_BLOCK, axis=1)
        dist_c = t[:, None] - cmp_end[None, :]
        lg = jnp.einsum('bqgnd,bigd->bgnqi', qc, kc).astype(jnp.float32) * scale
        lg = lg + table[:, t5_bucket(dist_c)].transpose(0, 3, 1, 2)
        p_c = masked_softmax(lg, dist_c >= 0)
        o_c = jnp.einsum('bgnqi,bigd->bqgnd', p_c.astype(vc.dtype), vc)
        cur = t // SLC_BLOCK
        sc = jnp.einsum('bgnqi,ij->bgqj', p_c, overlap)
        admissible = blk[None, :] <= cur[:, None]
        forced = (blk[None, :] == 0) | (blk[None, :] == cur[:, None]) | (blk[None, :] == cur[:, None] - 1)
        sc = jnp.where(admissible, jnp.where(forced, jnp.inf, sc), -jnp.inf)
        _, sel = lax.top_k(sc, n_sel)
        n_key = n_sel * SLC_BLOCK
        k_s = ks_blocks[b_idx, g_idx, sel].reshape(bsz, B_GROUPS, Q_BLOCK, n_key, HEAD_DIM)
        v_s = vs_blocks[b_idx, g_idx, sel].reshape(bsz, B_GROUPS, Q_BLOCK, n_key, HEAD_DIM)
        pos_s = (sel[..., None] * SLC_BLOCK + jnp.arange(SLC_BLOCK)).reshape(bsz, B_GROUPS, Q_BLOCK, n_key)
        dist_s = t[None, None, :, None] - pos_s
        lg = jnp.einsum('bqgnd,bgqkd->bgnqk', qc, k_s).astype(jnp.float32) * scale
        lg = lg + jnp.moveaxis(table[g_idx, t5_bucket(dist_s)], -1, 2)
        p_s = masked_softmax(lg, (dist_s >= 0)[:, :, None])
        o_s = jnp.einsum('bgnqk,bgqkd->bqgnd', p_s.astype(v_s.dtype), v_s)
        pos_w = start - WINDOW + jnp.arange(Q_BLOCK + WINDOW)
        dist_w = t[:, None] - pos_w[None, :]
        valid_w = (dist_w >= 0) & (dist_w < WINDOW) & (pos_w[None, :] >= 0)
        k_w = lax.dynamic_slice_in_dim(kw_pad, start, Q_BLOCK + WINDOW, axis=1)
        v_w = lax.dynamic_slice_in_dim(vw_pad, start, Q_BLOCK + WINDOW, axis=1)
        lg = jnp.einsum('bqgnd,bkgd->bgnqk', qc, k_w).astype(jnp.float32) * scale
        lg = lg + table[:, t5_bucket(dist_w)].transpose(0, 3, 1, 2)
        p_w = masked_softmax(lg, valid_w)
        o_w = jnp.einsum('bgnqk,bkgd->bqgnd', p_w.astype(v_w.dtype), v_w)
        g = lax.dynamic_slice_in_dim(gates, start, Q_BLOCK, axis=1)
        o = g[..., 0:1] * o_c + g[..., 1:2] * o_s + g[..., 2:3] * o_w
        return o.astype(q.dtype).reshape(bsz, Q_BLOCK, B_HEADS * HEAD_DIM)

    out = lax.map(chunk, jnp.arange(seq // Q_BLOCK))
    return out.transpose(1, 0, 2, 3).reshape(bsz, seq, B_HEADS * HEAD_DIM)


def moba_attention(q, k, v, bias_table):
    bsz, seq = q.shape[:2]
    scale = HEAD_DIM ** -0.5
    n_blk = -(-seq // MOBA_BLOCK)
    pad = n_blk * MOBA_BLOCK - seq
    k_pad = jnp.pad(k, ((0, 0), (0, pad), (0, 0), (0, 0)))
    v_pad = jnp.pad(v, ((0, 0), (0, pad), (0, 0), (0, 0)))
    k_blocks = k_pad.reshape(bsz, n_blk, MOBA_BLOCK, C_HEADS, HEAD_DIM)
    k_mean = jnp.mean(k_blocks, axis=2)
    kb = k_blocks.transpose(0, 3, 1, 2, 4)
    vb = v_pad.reshape(bsz, n_blk, MOBA_BLOCK, C_HEADS, HEAD_DIM).transpose(0, 3, 1, 2, 4)
    n_sel = min(MOBA_TOPK, n_blk - 1)
    table = bias_table.T
    b_idx = jnp.arange(bsz)[:, None, None, None]
    h_idx = jnp.arange(C_HEADS)[None, :, None, None]
    blk = jnp.arange(n_blk)

    def chunk(c):
        start = c * MOBA_Q_BLOCK
        t = start + jnp.arange(MOBA_Q_BLOCK)
        own = start // MOBA_BLOCK
        qc = lax.dynamic_slice_in_dim(q, start, MOBA_Q_BLOCK, axis=1)
        k_o = lax.dynamic_slice_in_dim(k_pad, own * MOBA_BLOCK, MOBA_BLOCK, axis=1)
        v_o = lax.dynamic_slice_in_dim(v_pad, own * MOBA_BLOCK, MOBA_BLOCK, axis=1)
        dist_o = t[:, None] - (own * MOBA_BLOCK + jnp.arange(MOBA_BLOCK))[None, :]
        lg_o = jnp.einsum('bqhd,bkhd->bhqk', qc, k_o).astype(jnp.float32) * scale
        lg_o = lg_o + table[:, t5_bucket(dist_o)]
        mask_o = jnp.broadcast_to(dist_o >= 0, lg_o.shape)
        if n_sel == 0:
            p = masked_softmax(lg_o, mask_o)
            o = jnp.einsum('bhqk,bkhd->bqhd', p.astype(v_o.dtype), v_o)
        else:
            gate = jnp.einsum('bqhd,bjhd->bhqj', qc, k_mean).astype(jnp.float32)
            gate = jnp.where(blk < own, gate, -jnp.inf)
            _, sel = lax.top_k(gate, n_sel)
            n_key = n_sel * MOBA_BLOCK
            k_s = kb[b_idx, h_idx, sel].reshape(bsz, C_HEADS, MOBA_Q_BLOCK, n_key, HEAD_DIM)
            v_s = vb[b_idx, h_idx, sel].reshape(bsz, C_HEADS, MOBA_Q_BLOCK, n_key, HEAD_DIM)
            pos_s = (sel[..., None] * MOBA_BLOCK + jnp.arange(MOBA_BLOCK)).reshape(bsz, C_HEADS, MOBA_Q_BLOCK, n_key)
            lg_s = jnp.einsum('bqhd,bhqkd->bhqk', qc, k_s).astype(jnp.float32) * scale
            lg_s = lg_s + table[h_idx, t5_bucket(t[None, None, :, None] - pos_s)]
            mask_s = jnp.broadcast_to((sel < own)[..., None], sel.shape + (MOBA_BLOCK,)).reshape(lg_s.shape)
            p = masked_softmax(jnp.concatenate([lg_s, lg_o], axis=-1), jnp.concatenate([mask_s, mask_o], axis=-1))
            o = (jnp.einsum('bhqk,bhqkd->bqhd', p[..., :n_key].astype(v_s.dtype), v_s)
                 + jnp.einsum('bhqk,bkhd->bqhd', p[..., n_key:].astype(v_o.dtype), v_o))
        return o.astype(q.dtype).reshape(bsz, MOBA_Q_BLOCK, C_HEADS * HEAD_DIM)

    out = lax.map(chunk, jnp.arange(seq // MOBA_Q_BLOCK))
    return out.transpose(1, 0, 2, 3).reshape(bsz, seq, C_HEADS * HEAD_DIM)


def moe_swiglu(h, router, w1, w3, w2):
    bsz, seq, dm = h.shape
    n_tok = bsz * seq
    xf = h.reshape(n_tok, dm)
    logits = (xf @ router).astype(jnp.float32)
    top_val, top_e = lax.top_k(logits, TOP_K)
    gate = jax.nn.softmax(top_val, axis=-1)
    e_flat = top_e.reshape(-1)
    tok_flat = jnp.repeat(jnp.arange(n_tok), TOP_K)
    g_flat = gate.reshape(-1)
    order = jnp.argsort(e_flat)
    e_s, tok_s, g_s = e_flat[order], tok_flat[order], g_flat[order]
    counts = jnp.bincount(e_flat, length=N_EXPERTS)
    padded = (counts + EXPERT_ROWS - 1) // EXPERT_ROWS * EXPERT_ROWS
    start = jnp.cumsum(counts) - counts
    pend = jnp.cumsum(padded)
    pstart = pend - padded
    n_assign = n_tok * TOP_K
    dest = pstart[e_s] + jnp.arange(n_assign) - start[e_s]
    n_rows = -(-n_assign // EXPERT_ROWS) * EXPERT_ROWS + N_EXPERTS * EXPERT_ROWS
    n_groups = n_rows // EXPERT_ROWS
    row_tok = jnp.full((n_rows,), n_tok, jnp.int32).at[dest].set(tok_s)
    x_pad = jnp.concatenate([xf, jnp.zeros((1, dm), xf.dtype)], axis=0)
    x_rows = x_pad[row_tok].reshape(n_groups, EXPERT_ROWS, dm)
    grp_e = jnp.minimum(jnp.searchsorted(pend, jnp.arange(n_groups) * EXPERT_ROWS, side='right'), N_EXPERTS - 1)

    def expert_group(args):
        xg, e = args
        return swiglu(xg, w1[e], w3[e], w2[e])

    y_rows = lax.map(expert_group, (x_rows, grp_e)).reshape(n_rows, dm)
    y = jax.ops.segment_sum(y_rows[dest] * g_s[:, None], tok_s, num_segments=n_tok)
    return y.astype(h.dtype).reshape(bsz, seq, dm)


def setup_inputs(seed: int = 0) -> dict:
    key = jax.random.key(seed)
    keys = iter(jax.random.split(key, 40))

    def nrm(shape, scale):
        return jax.random.normal(next(keys), shape, jnp.float32) * scale

    def gain(shape):
        return 1.0 + nrm(shape, 0.02)

    d = D_MODEL
    return {
        'x': nrm((BATCH, SEQ, d), 1.0),
        'rel_bias': nrm((NUM_BUCKETS, N_BIAS_HEADS), 0.5),
        'e_w_in': nrm((N_EVEN, d, EVEN_IN), d ** -0.5),
        'e_q_norm': gain((N_EVEN, A_Q_RANK)),
        'e_kv_norm': gain((N_EVEN, A_KV_RANK)),
        'e_w_uq': nrm((N_EVEN, A_Q_RANK, A_HEADS, HEAD_DIM), A_Q_RANK ** -0.5),
        'e_w_uk': nrm((N_EVEN, A_KV_RANK, A_HEADS, HEAD_DIM), A_KV_RANK ** -0.5),
        'e_w_uv': nrm((N_EVEN, A_KV_RANK, A_HEADS, HEAD_DIM), A_KV_RANK ** -0.5),
        'e_w_qidx': nrm((N_EVEN, A_Q_RANK, IDX_HEADS, IDX_DIM), A_Q_RANK ** -0.5),
        'e_pos_k': nrm((N_EVEN, CMP_LEN, HEAD_DIM), 0.1),
        'e_pos_v': nrm((N_EVEN, CMP_LEN, HEAD_DIM), 0.1),
        'e_ck1': nrm((N_EVEN, CMP_LEN, HEAD_DIM, HEAD_DIM), (CMP_LEN * HEAD_DIM) ** -0.5),
        'e_ck2': nrm((N_EVEN, HEAD_DIM, HEAD_DIM), HEAD_DIM ** -0.5),
        'e_cv1': nrm((N_EVEN, CMP_LEN, HEAD_DIM, HEAD_DIM), (CMP_LEN * HEAD_DIM) ** -0.5),
        'e_cv2': nrm((N_EVEN, HEAD_DIM, HEAD_DIM), HEAD_DIM ** -0.5),
        'e_w_out': nrm((N_EVEN, MIX_WIDTH_EVEN, d), MIX_WIDTH_EVEN ** -0.5 * BETA),
        'e_ln1_g': gain((N_EVEN, d)),
        'e_ln1_b': nrm((N_EVEN, d), 0.02),
        'e_ffn_w1': nrm((N_EVEN, d, D_FF), d ** -0.5),
        'e_ffn_w3': nrm((N_EVEN, d, D_FF), d ** -0.5),
        'e_ffn_w2': nrm((N_EVEN, D_FF, d), D_FF ** -0.5 * BETA),
        'e_ln2_g': gain((N_EVEN, d)),
        'e_ln2_b': nrm((N_EVEN, d), 0.02),
        'o_w_in': nrm((N_ODD, d, ODD_IN), d ** -0.5),
        'o_w_out': nrm((N_ODD, MIX_WIDTH_ODD, d), MIX_WIDTH_ODD ** -0.5 * BETA),
        'o_ln1_g': gain((N_ODD, d)),
        'o_ln1_b': nrm((N_ODD, d), 0.02),
        'o_router': nrm((N_ODD, d, N_EXPERTS), d ** -0.5),
        'o_moe_w1': nrm((N_ODD, N_EXPERTS, d, D_FF_EXPERT), d ** -0.5),
        'o_moe_w3': nrm((N_ODD, N_EXPERTS, d, D_FF_EXPERT), d ** -0.5),
        'o_moe_w2': nrm((N_ODD, N_EXPERTS, D_FF_EXPERT, d), D_FF_EXPERT ** -0.5 * BETA),
        'o_ln2_g': gain((N_ODD, d)),
        'o_ln2_b': nrm((N_ODD, d), 0.02),
    }


def reference(x, rel_bias,
              e_w_in, e_q_norm, e_kv_norm, e_w_uq, e_w_uk, e_w_uv, e_w_qidx,
              e_pos_k, e_pos_v, e_ck1, e_ck2, e_cv1, e_cv2, e_w_out,
              e_ln1_g, e_ln1_b, e_ffn_w1, e_ffn_w3, e_ffn_w2, e_ln2_g, e_ln2_b,
              o_w_in, o_w_out, o_ln1_g, o_ln1_b, o_router, o_moe_w1, o_moe_w3, o_moe_w2,
              o_ln2_g, o_ln2_b):
    bsz, seq = x.shape[:2]
    for layer in range(DEPTH):
        i = layer // 2
        if layer % 2 == 0:
            parts = split_cols(x @ e_w_in[i], EVEN_SPLITS)
            c_q, c_kv, k_idx, w_idx, q_b = parts[0], parts[1], parts[2], parts[3], parts[4]
            k_c, v_c, k_sl, v_sl, k_w, v_w = parts[5], parts[6], parts[7], parts[8], parts[9], parts[10]
            gate_logits = parts[11]
            o_a = dsa_attention(c_q, c_kv, k_idx, w_idx, e_q_norm[i], e_kv_norm[i],
                                e_w_uq[i], e_w_uk[i], e_w_uv[i], e_w_qidx[i], rel_bias[:, :A_HEADS])
            o_b = nsa_attention(q_b, k_c, v_c, k_sl, v_sl, k_w, v_w, gate_logits,
                                e_pos_k[i], e_pos_v[i], e_ck1[i], e_ck2[i], e_cv1[i], e_cv2[i],
                                rel_bias[:, A_HEADS:A_HEADS + B_HEADS])
            mix = jnp.concatenate([o_a, o_b], axis=-1) @ e_w_out[i]
            h = layer_norm(ALPHA * x + mix, e_ln1_g[i], e_ln1_b[i])
            ffn = swiglu(h, e_ffn_w1[i], e_ffn_w3[i], e_ffn_w2[i])
            x = layer_norm(ALPHA * h + ffn, e_ln2_g[i], e_ln2_b[i])
        else:
            q, k, v = [a.reshape(bsz, seq, C_HEADS, HEAD_DIM) for a in jnp.split(x @ o_w_in[i], 3, axis=-1)]
            mix = moba_attention(q, k, v, rel_bias[:, :C_HEADS]) @ o_w_out[i]
            h = layer_norm(ALPHA * x + mix, o_ln1_g[i], o_ln1_b[i])
            ffn = moe_swiglu(h, o_router[i], o_moe_w1[i], o_moe_w3[i], o_moe_w2[i])
            x = layer_norm(ALPHA * h + ffn, o_ln2_g[i], o_ln2_b[i])
    return x
```

```cpp
#include <hip/hip_runtime.h>
#include <cstdio>
#include <cstdint>

#define LAS __attribute__((address_space(3)))
#define GAS __attribute__((address_space(1)))
typedef unsigned short bf16_t;
typedef short bf16x8 __attribute__((ext_vector_type(8)));
typedef short s16x4 __attribute__((ext_vector_type(4)));
typedef float f32x2 __attribute__((ext_vector_type(2)));
typedef float f32x4 __attribute__((ext_vector_type(4)));
typedef float f32x16 __attribute__((ext_vector_type(16)));
typedef unsigned u32x2 __attribute__((ext_vector_type(2)));
typedef unsigned u32x4 __attribute__((ext_vector_type(4)));
typedef __bf16 bf16x2_t __attribute__((ext_vector_type(2)));
typedef _Float16 f16x2_t __attribute__((ext_vector_type(2)));

constexpr int DM = 1024, NB = 8, SEQ = 4096, MTOK = NB * SEQ;
constexpr int EVEN_IN = 1768, EVEN_INP = 1792, DFF = 2816, DFFE = 3584, NEXP = 8;
constexpr float ALPHA = 1.4142135623730951f;
constexpr float LOG2E = 1.4426950408889634f;
constexpr float QSCALE = 0.125f * LOG2E;
constexpr int NWAVES = 8, NTHR = 512;

__device__ __forceinline__ unsigned f2bf(float f) { unsigned u = __builtin_bit_cast(unsigned, f); return (u + 0x7fffu + ((u >> 16) & 1u)) >> 16; }
__device__ __forceinline__ unsigned pk2(float lo, float hi) { f32x2 v = {lo, hi}; bf16x2_t b = __builtin_convertvector(v, bf16x2_t); return __builtin_bit_cast(unsigned, b); }
__device__ __forceinline__ float bf2f(unsigned short h) { return __builtin_bit_cast(float, (unsigned)h << 16); }
__device__ __forceinline__ float bflo(unsigned w) { return __builtin_bit_cast(float, w << 16); }
__device__ __forceinline__ float bfhi(unsigned w) { return __builtin_bit_cast(float, w & 0xffff0000u); }
__device__ __forceinline__ float wave_sum(float v) {
#pragma unroll
    for (int o = 1; o < 64; o <<= 1) v += __shfl_xor(v, o);
    return v;
}
#define LDS_WAIT() asm volatile("s_waitcnt lgkmcnt(0)" ::: "memory")
#define VM_WAIT() asm volatile("s_waitcnt vmcnt(0)" ::: "memory")
#define MK_N_LAUNCHES 18
namespace pg8 {
#define PG8_LAS __attribute__((address_space(3)))
typedef unsigned short bf16_t;
typedef short bf16x8 __attribute__((ext_vector_type(8)));
typedef float f32x4 __attribute__((ext_vector_type(4)));
typedef unsigned u32x4 __attribute__((ext_vector_type(4)));
constexpr int BM = 256, BK = 64, HALF = 128, HTB = HALF * BK * 2  , STAGE_BYTES = 8 * HTB, NXCD = 8, WGM = 8;

__host__ __device__ __forceinline__ int lds_byte(int r, int c) { const int st = (r >> 4) * 2 + (c >> 5), rr = r & 15, cc = c & 31, ob = rr * 64 + cc * 2; return st * 1024 + (ob ^ (((ob >> 9) & 1) << 5)); }
__host__ __device__ __forceinline__ void stage_rc(int b, int& R, int& C) { const int st = b / 1024, sb = b % 1024, swz = sb ^ (((sb >> 9) & 1) << 5); R = (st >> 1) * 16 + swz / 64; C = (st & 1) * 32 + (swz % 64) / 2; }
__host__ __device__ __forceinline__ int perm32(int rho) { const int n = rho >> 4, i = rho & 15; return 8 * (i >> 2) + 4 * n + (i & 3); }

struct Unit { int pm, pn, e; };
struct Gemm { const bf16_t* A; const bf16_t* Bt; int M, N, K; int lda; size_t bstride; };

struct StaticOrder {
    int nM, nN, nwg, G, c;
    __host__ __device__ void init(int M, int N, int G_, int c_) { nM = M / BM; nN = N / BM; nwg = nM * nN; G = G_; c = c_; }
    __host__ __device__ bool next(int i, Unit& u) const {
        const long L = (long)i * G + c; if (L >= nwg) return false;
        int wgid = (int)L; { const int q = nwg / NXCD, r = nwg % NXCD, xcd = wgid % NXCD, off = wgid / NXCD; wgid = (xcd < r ? xcd * (q + 1) : r * (q + 1) + (xcd - r) * q) + off; }
        const int nig = WGM * nN, gid = wgid / nig, fm = gid * WGM, gsz = (nM - fm) < WGM ? (nM - fm) : WGM;
        u.pm = fm + ((wgid % nig) % gsz); u.pn = (wgid % nig) / gsz; u.e = 0; return true;
    }
    __device__ __forceinline__ void a_ready(const Unit&) const {}
    __device__ __forceinline__ void done(const Unit&) const {}
};


template <class Epi, class Sched, bool ALIGN_EPI = false, bool SP2 = false>
__device__ __forceinline__ void gemm_phase(PG8_LAS unsigned char* lds, const Gemm g, const Sched& S, const Epi& E) {
    const int tid = threadIdx.x, wid = __builtin_amdgcn_readfirstlane(tid >> 6), lane = tid & 63, wr = wid >> 2, wc = wid & 3, fr = lane & 15, fq = lane >> 4;
    const int K = g.K, nt = K / BK;
    unsigned voffA[2], voffB[2];
#pragma unroll
    for (int i = 0; i < 2; ++i) { int R, C; stage_rc(tid * 16 + i * 8192, R, C); const int Rb = Epi::PERM ? ((R & ~31) + perm32(R & 31)) : R;
        voffA[i] = (unsigned)(R * g.lda + C) * 2u; voffB[i] = (unsigned)(Rb * K + C) * 2u; }
    const size_t kstep = (size_t)(BK * 2);
    const size_t hstep = (size_t)HALF * K * 2;
    const size_t tstep = 2 * hstep;
    const size_t hstepA = (size_t)HALF * g.lda * 2, tstepA = 2 * hstepA;
    const size_t estep = g.bstride * 2;
    const unsigned ldsw = (unsigned)wid * 1024u;
    const int aoff = lds_byte(wr * 64 + fr, fq * 8), boff = lds_byte(wc * 32 + fr, fq * 8);
#define PG8_SA(b, h) (((b) * 2 + (h)) * HTB)
#define PG8_SB(b, h) ((4 + (b) * 2 + (h)) * HTB)
#define PG8_STAGE(bufoff, gbase, voff) do { _Pragma("unroll") for (int _i = 0; _i < 2; ++_i) \
        __builtin_amdgcn_global_load_lds((const unsigned*)((const char*)(gbase) + (voff)[_i]), (PG8_LAS unsigned*)(lds + (bufoff) + ldsw + _i * 8192), 16, 0, 0); } while (0)
#define PG8_LDA(dst, b, h) do { _Pragma("unroll") for (int m = 0; m < 4; ++m) _Pragma("unroll") for (int k = 0; k < 2; ++k) dst[m][k] = *(const PG8_LAS bf16x8*)(lds + PG8_SA(b, h) + aoff + m * 2048 + k * 1024); } while (0)
#define PG8_LDB(dst, b, h) do { _Pragma("unroll") for (int n = 0; n < 2; ++n) _Pragma("unroll") for (int k = 0; k < 2; ++k) dst[n][k] = *(const PG8_LAS bf16x8*)(lds + PG8_SB(b, h) + boff + n * 2048 + k * 1024); } while (0)
#define PG8_MMA(ai, bj, At, Bt) do { __builtin_amdgcn_s_setprio(1); _Pragma("unroll") for (int m = 0; m < 4; ++m) _Pragma("unroll") for (int n = 0; n < 2; ++n) _Pragma("unroll") for (int k = 0; k < 2; ++k) \
        acc[ai][bj][m][n] = __builtin_amdgcn_mfma_f32_16x16x32_bf16(Bt[n][k], At[m][k], acc[ai][bj][m][n], 0, 0, 0); __builtin_amdgcn_s_setprio(0); } while (0)
#define PG8_WAIT_V(n) asm volatile("s_waitcnt vmcnt(" #n ")" ::: "memory")
#define PG8_WAIT_L(n) asm volatile("s_waitcnt lgkmcnt(" #n ")" ::: "memory")
#define PG8_BAR __builtin_amdgcn_s_barrier()
#define PG8_SCHED __builtin_amdgcn_sched_barrier(0)
    Unit cur, nxt; int ui = 0;
    if (!S.next(0, cur)) return;
    f32x4 acc[2][2][4][2];
#pragma unroll
    for (int a = 0; a < 2; ++a)
#pragma unroll
        for (int b = 0; b < 2; ++b)
#pragma unroll
            for (int m = 0; m < 4; ++m)
#pragma unroll
                for (int n = 0; n < 2; ++n) acc[a][b][m][n] = (f32x4){0.f, 0.f, 0.f, 0.f};
    bf16x8 At[4][2], B0[2][2], B1[2][2];
    const char* cA = (const char*)g.A + (size_t)cur.pm * tstepA; const char* cB = (const char*)g.Bt + (size_t)cur.pn * tstep + (size_t)cur.e * estep;
    S.a_ready(cur);
    if constexpr (SP2) {
        PG8_STAGE(PG8_SB(0, 0), cB, voffB); PG8_STAGE(PG8_SB(0, 1), cB + hstep, voffB); PG8_STAGE(PG8_SA(0, 0), cA, voffA); PG8_STAGE(PG8_SA(0, 1), cA + hstepA, voffA);
        if (wr == 1) PG8_BAR;
        PG8_WAIT_V(2); PG8_BAR;
        PG8_STAGE(PG8_SB(1, 0), cB + kstep, voffB); PG8_STAGE(PG8_SA(1, 0), cA + kstep, voffA); PG8_STAGE(PG8_SB(1, 1), cB + hstep + kstep, voffB);
        PG8_WAIT_V(6); PG8_BAR;
    } else {
        PG8_STAGE(PG8_SB(0, 0), cB, voffB); PG8_STAGE(PG8_SA(0, 0), cA, voffA); PG8_STAGE(PG8_SB(0, 1), cB + hstep, voffB); PG8_STAGE(PG8_SA(0, 1), cA + hstepA, voffA);
        if (wr == 1) PG8_BAR;
        PG8_WAIT_V(4); PG8_BAR;
        PG8_STAGE(PG8_SB(1, 0), cB + kstep, voffB); PG8_STAGE(PG8_SA(1, 0), cA + kstep, voffA); PG8_STAGE(PG8_SB(1, 1), cB + hstep + kstep, voffB);
        PG8_WAIT_V(6); PG8_BAR;
    }
    for (;;) {
        const bool has_next = S.next(ui + 1, nxt);
        const char* nA = has_next ? (const char*)g.A + (size_t)nxt.pm * tstepA : cA; const char* nB = has_next ? (const char*)g.Bt + (size_t)nxt.pn * tstep + (size_t)nxt.e * estep : cB;
#pragma unroll 1
        for (int t = 0; t < nt; t += 2) {
            const bool last = (t == nt - 2);
            const char* a1 = cA + (size_t)(t + 1) * kstep;
            const char* a2 = last ? nA : cA + (size_t)(t + 2) * kstep; const char* b2 = last ? nB : cB + (size_t)(t + 2) * kstep;
            const char* a3 = a2 + kstep; const char* b3 = b2 + kstep;
            if (last && has_next) S.a_ready(nxt);
            if constexpr (SP2) {
            PG8_LDB(B0, 0, 0); PG8_LDB(B1, 0, 1); PG8_SCHED; PG8_LDA(At, 0, 0); PG8_STAGE(PG8_SA(1, 1), a1 + hstepA, voffA);
            PG8_WAIT_V(8); PG8_WAIT_L(0); PG8_BAR; PG8_MMA(0, 0, At, B0); PG8_MMA(0, 1, At, B1); PG8_BAR; PG8_SCHED;
            PG8_LDA(At, 0, 1); PG8_STAGE(PG8_SB(0, 0), b2, voffB); PG8_STAGE(PG8_SB(0, 1), b2 + hstep, voffB); PG8_STAGE(PG8_SA(0, 0), a2, voffA);
            PG8_WAIT_V(8); PG8_WAIT_L(0); PG8_BAR; PG8_MMA(1, 0, At, B0); PG8_MMA(1, 1, At, B1); PG8_BAR; PG8_SCHED;
            PG8_LDB(B0, 1, 0); PG8_LDB(B1, 1, 1); PG8_SCHED; PG8_LDA(At, 1, 0); PG8_STAGE(PG8_SA(0, 1), a2 + hstepA, voffA);
            PG8_WAIT_V(8); PG8_WAIT_L(0); PG8_BAR; PG8_MMA(0, 0, At, B0); PG8_MMA(0, 1, At, B1); PG8_BAR; PG8_SCHED;
            PG8_LDA(At, 1, 1); PG8_STAGE(PG8_SB(1, 0), b3, voffB); PG8_STAGE(PG8_SB(1, 1), b3 + hstep, voffB); PG8_STAGE(PG8_SA(1, 0), a3, voffA);
            PG8_WAIT_V(8); PG8_WAIT_L(0); PG8_BAR; PG8_MMA(1, 0, At, B0); PG8_MMA(1, 1, At, B1); PG8_BAR; PG8_SCHED;
            } else {
            PG8_LDB(B0, 0, 0); PG8_SCHED; PG8_LDA(At, 0, 0); PG8_STAGE(PG8_SA(1, 1), a1 + hstepA, voffA);
            PG8_WAIT_L(8); PG8_BAR; PG8_WAIT_L(0); PG8_MMA(0, 0, At, B0); PG8_BAR; PG8_SCHED;
            PG8_LDB(B1, 0, 1); PG8_STAGE(PG8_SB(0, 0), b2, voffB);
            PG8_BAR; PG8_WAIT_L(0); PG8_MMA(0, 1, At, B1); PG8_BAR;
            PG8_LDA(At, 0, 1); PG8_STAGE(PG8_SA(0, 0), a2, voffA);
            PG8_BAR; PG8_WAIT_L(0); PG8_MMA(1, 0, At, B0); PG8_BAR; PG8_SCHED;
            PG8_STAGE(PG8_SB(0, 1), b2 + hstep, voffB);
            PG8_WAIT_V(6); PG8_BAR; PG8_MMA(1, 1, At, B1); PG8_BAR;
            PG8_LDB(B0, 1, 0); PG8_SCHED; PG8_LDA(At, 1, 0); PG8_STAGE(PG8_SA(0, 1), a2 + hstepA, voffA);
            PG8_WAIT_L(8); PG8_BAR; PG8_WAIT_L(0); PG8_MMA(0, 0, At, B0); PG8_BAR; PG8_SCHED;
            PG8_LDB(B1, 1, 1); PG8_STAGE(PG8_SB(1, 0), b3, voffB);
            PG8_BAR; PG8_WAIT_L(0); PG8_MMA(0, 1, At, B1); PG8_BAR;
            PG8_LDA(At, 1, 1); PG8_STAGE(PG8_SA(1, 0), a3, voffA);
            PG8_BAR; PG8_WAIT_L(0); PG8_MMA(1, 0, At, B0); PG8_BAR; PG8_SCHED;
            PG8_STAGE(PG8_SB(1, 1), b3 + hstep, voffB);
            PG8_WAIT_V(6); PG8_BAR; PG8_MMA(1, 1, At, B1); PG8_BAR;
            }
        }
        if constexpr (ALIGN_EPI) { if (wr == 0) PG8_BAR; }
        if constexpr (!Epi::AFTER_DRAIN) { E(acc, cur, wr, wc, fr, fq); S.done(cur); }
        if (!has_next) break;
#pragma unroll
        for (int a = 0; a < 2; ++a)
#pragma unroll
            for (int b = 0; b < 2; ++b)
#pragma unroll
                for (int m = 0; m < 4; ++m)
#pragma unroll
                    for (int n = 0; n < 2; ++n) acc[a][b][m][n] = (f32x4){0.f, 0.f, 0.f, 0.f};
        cur = nxt; cA = nA; cB = nB; ++ui;
        if constexpr (ALIGN_EPI) { if (wr == 1) PG8_BAR; }
    }
    PG8_WAIT_V(0);
    if constexpr (!ALIGN_EPI) { if (wr == 0) PG8_BAR; }
    PG8_BAR;
    if constexpr (Epi::AFTER_DRAIN) { E.fused(acc, cur, wr, wc, fr, fq, lds, wid, lane); S.done(cur); }
#undef PG8_SA
#undef PG8_SB
#undef PG8_STAGE
#undef PG8_LDA
#undef PG8_LDB
#undef PG8_MMA
#undef PG8_WAIT_V
#undef PG8_WAIT_L
#undef PG8_BAR
#undef PG8_SCHED
}
}

namespace pg8 {
typedef f32x4 Acc[2][2][4][2];
__device__ __forceinline__ u32x4 pack8(const f32x4 v0, const f32x4 v1) { u32x4 w; w.x = pk2(v0[0], v0[1]); w.y = pk2(v0[2], v0[3]); w.z = pk2(v1[0], v1[1]); w.w = pk2(v1[2], v1[3]); return w; }
__device__ __forceinline__ void unpack8(const u32x4 w, f32x4& a, f32x4& b) { a = (f32x4){bflo(w.x), bfhi(w.x), bflo(w.y), bfhi(w.y)}; b = (f32x4){bflo(w.z), bfhi(w.z), bflo(w.w), bfhi(w.w)}; }

struct EpiInE {
    static constexpr bool PERM = true, AFTER_DRAIN = false;
    bf16_t* Y1; float* ssq_q; float* ssq_kv;
    __device__ __forceinline__ void operator()(const Acc& acc, const Unit& u, int wr, int wc, int fr, int fq) const {
        bf16_t* base = Y1 + (size_t)u.pn * MTOK * 256;
        const float sc = (u.pn == 2 || u.pn == 3) ? QSCALE : 1.f;
        const int col0 = wc * 32 + 8 * fq;
#pragma unroll
        for (int ai = 0; ai < 2; ++ai)
#pragma unroll
            for (int m = 0; m < 4; ++m) {
                const int row = u.pm * BM + ai * HALF + wr * 64 + m * 16 + fr; bf16_t* rowp = base + (size_t)row * 256 + col0;
                float s0 = 0.f, s1 = 0.f;
#pragma unroll
                for (int bj = 0; bj < 2; ++bj) { const f32x4 v0 = acc[ai][bj][m][0], v1 = acc[ai][bj][m][1];
                    const float q = (v0[0] * v0[0] + v0[1] * v0[1]) + (v0[2] * v0[2] + v0[3] * v0[3]) + (v1[0] * v1[0] + v1[1] * v1[1]) + (v1[2] * v1[2] + v1[3] * v1[3]);
                    if (bj == 0) s0 = q; else s1 = q;
                    *(u32x4*)(rowp + bj * HALF) = pack8(v0 * sc, v1 * sc); }
                if (u.pn <= 1) {
                    float s = (u.pn == 0) ? (s0 + s1) : s0;
                    s += __shfl_xor(s, 16); s += __shfl_xor(s, 32);
                    if (fq == 0) (u.pn == 0 ? ssq_q : ssq_kv)[(size_t)row * 4 + wc] = s;
                }
            }
    }
};
struct EpiQ2 {
    static constexpr bool PERM = true, AFTER_DRAIN = false;
    bf16_t* QLAT; bf16_t* QIDX; const float* ssq_q;
    __device__ __forceinline__ void operator()(const Acc& acc, const Unit& u, int wr, int wc, int fr, int fq) const {
        bf16_t* base = (u.pn < 4) ? QLAT : QIDX; const float sc0 = (u.pn < 4) ? QSCALE : 1.f;
        const int col0 = (u.pn & 3) * 256 + wc * 32 + 8 * fq;
#pragma unroll
        for (int ai = 0; ai < 2; ++ai)
#pragma unroll
            for (int m = 0; m < 4; ++m) {
                const int row = u.pm * BM + ai * HALF + wr * 64 + m * 16 + fr; bf16_t* rowp = base + (size_t)row * 1024 + col0;
                const f32x4 sq = *(const f32x4*)(ssq_q + (size_t)row * 4); const float sc = sc0 * __builtin_amdgcn_rsqf(((sq[0] + sq[1]) + (sq[2] + sq[3])) * (1.f / 256.f) + 1e-6f);
#pragma unroll
                for (int bj = 0; bj < 2; ++bj) *(u32x4*)(rowp + bj * HALF) = pack8(acc[ai][bj][m][0] * sc, acc[ai][bj][m][1] * sc);
            }
    }
};
template <bool RES_F32> struct EpiRes {
    static constexpr bool PERM = true, AFTER_DRAIN = false;
    const void* res; bf16_t* S;
    __device__ __forceinline__ void operator()(const Acc& acc, const Unit& u, int wr, int wc, int fr, int fq) const {
        const int col0 = u.pn * BM + wc * 32 + 8 * fq;
#pragma unroll
        for (int ai = 0; ai < 2; ++ai)
#pragma unroll
            for (int m = 0; m < 4; ++m) {
                const size_t off = (size_t)(u.pm * BM + ai * HALF + wr * 64 + m * 16 + fr) * 1024 + col0;
#pragma unroll
                for (int bj = 0; bj < 2; ++bj) { f32x4 r0, r1;
                    if (RES_F32) { r0 = *(const f32x4*)((const float*)res + off + bj * HALF); r1 = *(const f32x4*)((const float*)res + off + bj * HALF + 4); }
                    else unpack8(*(const u32x4*)((const bf16_t*)res + off + bj * HALF), r0, r1);
                    *(u32x4*)(S + off + bj * HALF) = pack8(r0 * ALPHA + acc[ai][bj][m][0], r1 * ALPHA + acc[ai][bj][m][1]); }
            }
    }
};
struct EpiSwiglu {
    static constexpr bool PERM = true, AFTER_DRAIN = false;
    bf16_t* O; int ldo; int pm0;
    __device__ __forceinline__ void operator()(const Acc& acc, const Unit& u, int wr, int wc, int fr, int fq) const {
        const int col0 = u.pn * HALF + wc * 32 + 8 * fq;
#pragma unroll
        for (int ai = 0; ai < 2; ++ai)
#pragma unroll
            for (int m = 0; m < 4; ++m) {
                bf16_t* rowp = O + (size_t)((u.pm - pm0) * BM + ai * HALF + wr * 64 + m * 16 + fr) * ldo + col0;
                f32x4 o[2];
#pragma unroll
                for (int n = 0; n < 2; ++n) { const f32x4 a = acc[ai][0][m][n], b = acc[ai][1][m][n];
#pragma unroll
                    for (int e = 0; e < 4; ++e) o[n][e] = a[e] * __builtin_amdgcn_rcpf(1.f + __expf(-a[e])) * b[e]; }
                *(u32x4*)rowp = pack8(o[0], o[1]);
            }
    }
};
struct EpiStore {
    static constexpr bool PERM = true, AFTER_DRAIN = false;
    bf16_t* O; int ldo;
    __device__ __forceinline__ void operator()(const Acc& acc, const Unit& u, int wr, int wc, int fr, int fq) const {
        const int col0 = u.pn * BM + wc * 32 + 8 * fq;
#pragma unroll
        for (int ai = 0; ai < 2; ++ai)
#pragma unroll
            for (int m = 0; m < 4; ++m) {
                bf16_t* rowp = O + (size_t)(u.pm * BM + ai * HALF + wr * 64 + m * 16 + fr) * ldo + col0;
#pragma unroll
                for (int bj = 0; bj < 2; ++bj) *(u32x4*)(rowp + bj * HALF) = pack8(acc[ai][bj][m][0], acc[ai][bj][m][1]);
            }
    }
};
struct EpiInO {
    static constexpr bool PERM = true, AFTER_DRAIN = false;
    bf16_t* QKV; float* kmean;
    __device__ __forceinline__ void operator()(const Acc& acc, const Unit& u, int wr, int wc, int fr, int fq) const {
        const int which = u.pn >> 2; bf16_t* base = QKV + (size_t)which * MTOK * 1024; const float sc = (which == 0) ? QSCALE : 1.f;
        const int col0 = (u.pn & 3) * BM + wc * 32 + 8 * fq;
#pragma unroll
        for (int ai = 0; ai < 2; ++ai)
#pragma unroll
            for (int m = 0; m < 4; ++m) {
                bf16_t* rowp = base + (size_t)(u.pm * BM + ai * HALF + wr * 64 + m * 16 + fr) * 1024 + col0;
#pragma unroll
                for (int bj = 0; bj < 2; ++bj) *(u32x4*)(rowp + bj * HALF) = pack8(acc[ai][bj][m][0] * sc, acc[ai][bj][m][1] * sc);
            }
        if (which == 1) {
#pragma unroll
            for (int bj = 0; bj < 2; ++bj)
#pragma unroll
                for (int n = 0; n < 2; ++n) { f32x4 s = (f32x4){0.f, 0.f, 0.f, 0.f};
#pragma unroll
                    for (int ai = 0; ai < 2; ++ai)
#pragma unroll
                        for (int m = 0; m < 4; ++m) s += acc[ai][bj][m][n];
#pragma unroll
                    for (int e = 0; e < 4; ++e) { float v = s[e]; v += __shfl_xor(v, 1); v += __shfl_xor(v, 2); v += __shfl_xor(v, 4); v += __shfl_xor(v, 8);
                        if (fr == 0) kmean[((size_t)u.pm * 2 + wr) * 1024 + col0 + bj * HALF + 4 * n + e] = v; }
                }
        }
    }
};
struct MoeOrder {
    int g0, ng, nN, G, c; int pend[8];
    __device__ __forceinline__ bool next(int i, Unit& u) const {
        const int L = i * G + c; if (L >= ng * nN) return false;
        u.pm = g0 + L % ng; u.pn = L / ng; const int r = u.pm * 256; int e = 0;
#pragma unroll
        for (int k = 0; k < 7; ++k) e += (pend[k] <= r) ? 1 : 0;
        u.e = e; return true;
    }
    __device__ __forceinline__ void a_ready(const Unit&) const {}
    __device__ __forceinline__ void done(const Unit&) const {}
};
}

constexpr size_t MiB = 1u << 20, KiB = 1u << 10;
constexpr size_t CTL_ZERO_BYTES = 2 * MiB;
constexpr int    MAX_LAUNCHES = 18;
constexpr size_t OFF_BAR = 16 * KiB;
constexpr size_t OFF_WGCNT = 1 * MiB + 512 * KiB;
constexpr size_t OFF_GINFO = OFF_WGCNT + 16 * KiB;
constexpr size_t OFF_DBG = OFF_GINFO + 1 * KiB;
constexpr size_t OFF_BT = 2 * MiB;
constexpr size_t OFF_CB = 2 * MiB + 16 * KiB;
constexpr size_t OFF_ROUTE = 2 * MiB + 64 * KiB;
constexpr size_t OFF_DEST = 2 * MiB + 512 * KiB;
constexpr size_t OFF_KC = 3 * MiB, OFF_VC = 3 * MiB + 512 * KiB;
constexpr size_t OFF_W_IN = 4 * MiB, OFF_W_Q2 = OFF_W_IN + (size_t)EVEN_INP * 1024 * 2, OFF_W_OUTE = OFF_W_Q2 + 2048 * 256 * 2, OFF_W_F13 = OFF_W_OUTE + 1024 * 1536 * 2,
                 OFF_W_F2 = OFF_W_F13 + (size_t)2 * DFF * 1024 * 2, OFF_CK1 = OFF_W_F2 + (size_t)1024 * DFF * 2, OFF_CV1 = OFF_CK1 + 64 * 2048 * 2, OFF_WE_END = OFF_CV1 + 64 * 2048 * 2;
static_assert(OFF_WE_END <= 30 * MiB, "even weights");
constexpr size_t OFF_W_OIN = 30 * MiB, OFF_W_OOUT = 36 * MiB, OFF_W_M13 = 38 * MiB, OFF_W_M2 = 150 * MiB;
constexpr size_t OFF_Y1 = 30 * MiB;
constexpr size_t OFF_CKVN = 142 * MiB;
constexpr size_t OFF_XB = 206 * MiB, OFF_QLAT = 206 * MiB, OFF_QIDX = 270 * MiB;
constexpr size_t OFF_SC = 334 * MiB, OFF_MASK = 464 * MiB, OFF_MIXIN = 334 * MiB;
constexpr size_t OFF_S1 = 206 * MiB, OFF_H = 270 * MiB, OFF_ACT = 30 * MiB, OFF_S2 = 334 * MiB, OFF_X1 = 398 * MiB;
constexpr size_t OFF_QKV = 206 * MiB, OFF_S1O = 270 * MiB, OFF_H2 = 206 * MiB, OFF_XR = 270 * MiB, OFF_ACTM = 402 * MiB;
constexpr size_t OFF_SSQ_Q = 514 * MiB, OFF_SSQ_KV = 514 * MiB + 512 * KiB;
constexpr size_t OFF_KMEAN = 515 * MiB;
constexpr size_t WS_END = 516 * MiB;
constexpr int    MOE_CHUNK = 64;
constexpr size_t SCB_ELEMS = (size_t)64 * 64 * (64 * 65 / 2);

constexpr int LDS_BYTES = 160 * 1024;
constexpr int LDSCTL_OFF = LDS_BYTES - 512;

#define RLX_AGENT __ATOMIC_RELAXED, __HIP_MEMORY_SCOPE_AGENT
typedef GAS unsigned gu32;
#define XB_TMO      128
#define XB_XCNT(j)  (256  + 64 * (j))
#define XB_XSUB(j)  (1280 + 64 * (j))
#define XB_XGEN(j)  (2304 + 64 * (j))
#define XB_TOP      3328
#define XB_TOPGEN   3392
#define XCD_BAR_WORDS 3456
#define XB_SPIN_CAP (1u << 18)

__device__ __forceinline__ unsigned xb_ld(unsigned* p)              { return __hip_atomic_load(p, __ATOMIC_RELAXED, __HIP_MEMORY_SCOPE_AGENT); }
__device__ __forceinline__ unsigned xb_add(unsigned* p, unsigned v) { return __hip_atomic_fetch_add(p, v, __ATOMIC_RELAXED, __HIP_MEMORY_SCOPE_AGENT); }
__device__ __forceinline__ unsigned xb_xcc_id() { return (unsigned)__builtin_amdgcn_s_getreg((3 << 11) | 20) & 0xFu; }
#define XB_SPIN(cond, bar) do { unsigned _sp = 0; while (cond) { __builtin_amdgcn_s_sleep(1); \
    if ((++_sp & 255u) == 0u) { if (xb_ld(&(bar)[XB_TMO])) break; if (_sp > XB_SPIN_CAP) { atomicAdd(&(bar)[XB_TMO], 1u); break; } } } } while (0)

struct XcdBarrier {
    unsigned* bar; unsigned x;
    volatile LAS unsigned* st;
};

__device__ __forceinline__ XcdBarrier xcd_barrier_post(unsigned* bar, volatile LAS unsigned* st) {
    XcdBarrier b; b.bar = bar; b.x = xb_xcc_id(); b.st = st;
    if (threadIdx.x == 0) (void)xb_add(&bar[XB_XCNT(b.x)], 1u);
    return b;
}
__device__ __forceinline__ void xcd_barrier_complete(unsigned* bar, unsigned x, unsigned& nloc, unsigned& nx) {
    const unsigned G = gridDim.x * gridDim.y * gridDim.z;
    unsigned sum, cnt, mine, sp = 0u;
    for (;;) {
        sum = 0u; cnt = 0u; mine = 0u;
#pragma unroll
        for (unsigned j = 0; j < 16; ++j) { const unsigned c = xb_ld(&bar[XB_XCNT(j)]); sum += c; cnt += (c > 0u) ? 1u : 0u; mine = (j == x) ? c : mine; }
        if (sum == G) break;
        __builtin_amdgcn_s_sleep(1);
        if ((++sp & 255u) == 0u) { if (xb_ld(&bar[XB_TMO])) break; if (sp > XB_SPIN_CAP) { atomicAdd(&bar[XB_TMO], 1u); break; } }
    }
    nloc = mine > 0u ? mine : 1u; nx = cnt > 0u ? cnt : 1u;
}

__device__ __forceinline__ void xcd_barrier(const XcdBarrier& b) {
    asm volatile("s_waitcnt vmcnt(0)" ::: "memory");
    __syncthreads();
    if (threadIdx.x == 0) {
        unsigned* bar = b.bar;
        __builtin_amdgcn_s_waitcnt(0);
        unsigned nloc = b.st[0], nx = b.st[1];
        if (nloc == 0u) { xcd_barrier_complete(bar, b.x, nloc, nx); b.st[0] = nloc; b.st[1] = nx; }
        const unsigned old = xb_add(&bar[XB_XSUB(b.x)], 1u);
        const unsigned gen = old / nloc;
        if (old + 1u == (gen + 1u) * nloc) {
            __builtin_amdgcn_fence(__ATOMIC_RELEASE, "agent");
            asm volatile("s_waitcnt vmcnt(0)" ::: "memory");
            const unsigned og = xb_add(&bar[XB_TOP], 1u);
            const unsigned tg = og / nx;
            if (og + 1u == (tg + 1u) * nx) xb_add(&bar[XB_TOPGEN], 1u);
            else XB_SPIN(xb_ld(&bar[XB_TOPGEN]) == tg, bar);
            __builtin_amdgcn_fence(__ATOMIC_ACQUIRE, "agent");
            xb_add(&bar[XB_XGEN(b.x)], 1u);
            asm volatile("s_waitcnt vmcnt(0)" ::: "memory");
        } else {
            XB_SPIN(xb_ld(&bar[XB_XGEN(b.x)]) == gen, bar);
            __builtin_amdgcn_fence(__ATOMIC_ACQUIRE, "agent");
            asm volatile("s_waitcnt vmcnt(0)" ::: "memory");
        }
    }
    __syncthreads();
}

struct Frame {
    LAS unsigned char* lds;
    int tid, lane, wave, G, bx;
    int gw, NGW;
    unsigned char* ws;
    const float* const* in;
};
struct Args { const float* in[33]; float* out; unsigned char* ws; int ph_lo, ph_hi, li, pad; };
enum InIdx { I_X = 0, I_RELB, I_EWIN, I_EQN, I_EKVN, I_EWUQ, I_EWUK, I_EWUV, I_EWQIDX, I_EPOSK, I_EPOSV, I_ECK1, I_ECK2, I_ECV1, I_ECV2, I_EWOUT, I_ELN1G, I_ELN1B,
             I_EF1, I_EF3, I_EF2, I_ELN2G, I_ELN2B, I_OWIN, I_OWOUT, I_OLN1G, I_OLN1B, I_OROUTER, I_OM1, I_OM3, I_OM2, I_OLN2G, I_OLN2B };

template <class RowMap, class KScale>
__device__ __forceinline__ void transpose_item(const float* W, int K, int N, bf16_t* WT, int ldt, LAS float* scr, int item, int lane, RowMap rm, KScale ks) {
    const int nblk = (N + 31) >> 5, kb = item / nblk, nb = item - kb * nblk, k0 = 64 * kb, n0 = 32 * nb;
    const int n = n0 + (lane & 31);
#pragma unroll 8
    for (int i = 0; i < 32; ++i) { const int kk = 2 * i + (lane >> 5); scr[kk * 33 + (lane & 31)] = (n < N) ? W[(size_t)(k0 + kk) * N + n] * ks(k0 + kk) : 0.f; }
    LDS_WAIT(); asm volatile("" ::: "memory");
    const int c = lane & 7;
#pragma unroll
    for (int j = 0; j < 4; ++j) { const int nl = (lane >> 3) + 8 * j, nn = n0 + nl; const LAS float* s = scr + (8 * c) * 33 + nl;
        if (nn < N) { const int dr = rm(nn);
            u32x4 o; o.x = pk2(s[0 * 33], s[1 * 33]); o.y = pk2(s[2 * 33], s[3 * 33]); o.z = pk2(s[4 * 33], s[5 * 33]); o.w = pk2(s[6 * 33], s[7 * 33]);
            *(u32x4*)(WT + (size_t)dr * ldt + k0 + 8 * c) = o; } }
    LDS_WAIT(); asm volatile("" ::: "memory");
}
struct RowId { __device__ __forceinline__ int operator()(int n) const { return n; } };
struct KOne { __device__ __forceinline__ float operator()(int) const { return 1.f; } };
struct RowInE {
    __device__ __forceinline__ int operator()(int n) const { return n < 464 ? n : (n < 1744 ? n + 48 : n - 1744 + 464); }
};
struct RowIlv {
    int add; __device__ __forceinline__ int operator()(int n) const { return ((n >> 7) << 8) + (n & 127) + add; }
};
struct KGain { const float* g; __device__ __forceinline__ float operator()(int k) const { return g[k]; } };

__device__ __forceinline__ int t5_bucket(int n) {
    if (n < 16) return n;
    int l = 16 + (int)(__logf((float)n / 16.f) / 2.0794415f * 16.f);
    return l < 31 ? l : 31;
}

__device__ __forceinline__ void phase_prologue_even(const Frame& F, const Args& a) {
    LAS float* scr = (LAS float*)(F.lds + F.wave * 8704);
    unsigned char* ws = F.ws;
    bf16_t* W_IN = (bf16_t*)(ws + OFF_W_IN); bf16_t* W_Q2 = (bf16_t*)(ws + OFF_W_Q2); bf16_t* W_OUTE = (bf16_t*)(ws + OFF_W_OUTE);
    bf16_t* W_F13 = (bf16_t*)(ws + OFF_W_F13); bf16_t* W_F2 = (bf16_t*)(ws + OFF_W_F2); bf16_t* CK1 = (bf16_t*)(ws + OFF_CK1); bf16_t* CV1 = (bf16_t*)(ws + OFF_CV1);
    constexpr int I_IN = 16 * ((EVEN_IN + 31) / 32);
    constexpr int I_QI = 4 * 32;
    constexpr int I_OB = 8 * 32;
    constexpr int I_F1 = 16 * (DFF / 32), I_F2 = (DFF / 64) * 32;
    constexpr int I_CK = 32 * 2;
    constexpr int NIT = I_IN + I_QI + I_OB + 2 * I_F1 + I_F2 + 2 * I_CK;
    for (int it = F.gw; it < NIT; it += F.NGW) {
        int r = it;
        if (r < I_IN) { transpose_item(a.in[I_EWIN], 1024, EVEN_IN, W_IN, 1024, scr, r, F.lane, RowInE{}, KOne{}); continue; } r -= I_IN;
        if (r < I_QI) { transpose_item(a.in[I_EWQIDX], 256, 1024, W_Q2 + 1024 * 256, 256, scr, r, F.lane, RowId{}, KGain{a.in[I_EQN]}); continue; } r -= I_QI;
        if (r < I_OB) { transpose_item(a.in[I_EWOUT] + 512 * 1024, 512, 1024, W_OUTE + 1024, 1536, scr, r, F.lane, RowId{}, KOne{}); continue; } r -= I_OB;
        if (r < I_F1) { transpose_item(a.in[I_EF1], 1024, DFF, W_F13, 1024, scr, r, F.lane, RowIlv{0}, KOne{}); continue; } r -= I_F1;
        if (r < I_F1) { transpose_item(a.in[I_EF3], 1024, DFF, W_F13, 1024, scr, r, F.lane, RowIlv{128}, KOne{}); continue; } r -= I_F1;
        if (r < I_F2) { transpose_item(a.in[I_EF2], DFF, 1024, W_F2, DFF, scr, r, F.lane, RowId{}, KOne{}); continue; } r -= I_F2;
        if (r < I_CK) { transpose_item(a.in[I_ECK1], 2048, 64, CK1, 2048, scr, r, F.lane, RowId{}, KOne{}); continue; } r -= I_CK;
        transpose_item(a.in[I_ECV1], 2048, 64, CV1, 2048, scr, r, F.lane, RowId{}, KOne{});
    }
    const int gt = F.bx * NTHR + F.tid, NGT = F.G * NTHR;
    for (int i = gt; i < 24 * 1024 / 8; i += NGT) ((u32x4*)(W_IN + 488 * 1024))[i] = (u32x4){0u, 0u, 0u, 0u};
    { const float* uq = a.in[I_EWUQ]; const float* uk = a.in[I_EWUK]; const float* qg = a.in[I_EQN];
      for (int o = gt; o < 1024 * 256; o += NGT) { const int r = o & 255, hc = o >> 8, h = hc >> 7, c = hc & 127; const float* p = uq + r * 512 + h * 64; const float* q = uk + c * 512 + h * 64; float s = 0.f;
#pragma unroll 8
          for (int d = 0; d < 64; ++d) s += p[d] * q[d];
          W_Q2[o] = (bf16_t)f2bf(s * qg[r]); } }
    { const float* uv = a.in[I_EWUV]; const float* wo = a.in[I_EWOUT];
      for (int o = gt; o < 1024 * 1024; o += NGT) { const int n = o & 1023, hc = o >> 10, h = hc >> 7, c = hc & 127; const float* p = uv + c * 512 + h * 64; const float* q = wo + (size_t)(h * 64) * 1024 + n; float s = 0.f;
#pragma unroll 8
          for (int d = 0; d < 64; ++d) s += p[d] * q[(size_t)d * 1024];
          W_OUTE[(size_t)n * 1536 + hc] = (bf16_t)f2bf(s); } }
    if (F.bx == 0) { float* BT = (float*)(ws + OFF_BT); const float* rb = a.in[I_RELB];
        for (int i = F.tid; i < 16 * 128; i += NTHR) { const int h = i >> 7, d = i & 127; BT[i] = rb[t5_bucket(d) * 16 + h] * LOG2E; } }
    if (F.bx == 1 && F.tid < 128) { const int kv = F.tid >> 6, e = F.tid & 63; const float* pos = a.in[kv ? I_EPOSV : I_EPOSK]; const float* w1 = a.in[kv ? I_ECV1 : I_ECK1]; float s = 0.f;
        for (int k = 0; k < 2048; ++k) s += pos[k] * w1[k * 64 + e];
        ((float*)(ws + OFF_CB))[F.tid] = s; }
    { const f32x4* x4 = (const f32x4*)a.in[I_X]; u32x4* xb = (u32x4*)(ws + OFF_XB);
      for (int i = gt; i < MTOK * 1024 / 8; i += NGT) { const f32x4 v0 = x4[2 * i], v1 = x4[2 * i + 1]; xb[i] = pg8::pack8(v0, v1); } }
}

__device__ __forceinline__ void phase_convert_odd(const Frame& F, const Args& a) {
    LAS float* scr = (LAS float*)(F.lds + F.wave * 8704);
    unsigned char* ws = F.ws;
    bf16_t* W_OIN = (bf16_t*)(ws + OFF_W_OIN); bf16_t* W_OOUT = (bf16_t*)(ws + OFF_W_OOUT); bf16_t* W_M13 = (bf16_t*)(ws + OFF_W_M13); bf16_t* W_M2 = (bf16_t*)(ws + OFF_W_M2);
    constexpr int I_IN = 16 * 96, I_OUT = 16 * 32, I_M1 = 16 * (DFFE / 32), I_M2 = (DFFE / 64) * 32;
    constexpr int NIT = I_IN + I_OUT + NEXP * (2 * I_M1 + I_M2);
    for (int it = F.gw; it < NIT; it += F.NGW) {
        int r = it;
        if (r < I_IN) { transpose_item(a.in[I_OWIN], 1024, 3072, W_OIN, 1024, scr, r, F.lane, RowId{}, KOne{}); continue; } r -= I_IN;
        if (r < I_OUT) { transpose_item(a.in[I_OWOUT], 1024, 1024, W_OOUT, 1024, scr, r, F.lane, RowId{}, KOne{}); continue; } r -= I_OUT;
        const int e = r / (2 * I_M1 + I_M2); r -= e * (2 * I_M1 + I_M2);
        if (r < I_M1) { transpose_item(a.in[I_OM1] + (size_t)e * 1024 * DFFE, 1024, DFFE, W_M13 + (size_t)e * 2 * DFFE * 1024, 1024, scr, r, F.lane, RowIlv{0}, KOne{}); continue; } r -= I_M1;
        if (r < I_M1) { transpose_item(a.in[I_OM3] + (size_t)e * 1024 * DFFE, 1024, DFFE, W_M13 + (size_t)e * 2 * DFFE * 1024, 1024, scr, r, F.lane, RowIlv{128}, KOne{}); continue; } r -= I_M1;
        transpose_item(a.in[I_OM2] + (size_t)e * DFFE * 1024, DFFE, 1024, W_M2 + (size_t)e * 1024 * DFFE, DFFE, scr, r, F.lane, RowId{}, KOne{});
    }
}

__device__ __forceinline__ void load_row_bf16(const bf16_t* row, int lane, f32x4 (&v)[4]) {
#pragma unroll
    for (int j = 0; j < 4; ++j) { const u32x2 w = *(const u32x2*)(row + 4 * lane + 256 * j); v[j] = (f32x4){bflo(w.x), bfhi(w.x), bflo(w.y), bfhi(w.y)}; }
}
__device__ __forceinline__ void store_row_bf16(bf16_t* row, int lane, const f32x4 (&v)[4]) {
#pragma unroll
    for (int j = 0; j < 4; ++j) { u32x2 w; w.x = pk2(v[j][0], v[j][1]); w.y = pk2(v[j][2], v[j][3]); *(u32x2*)(row + 4 * lane + 256 * j) = w; }
}
__device__ __forceinline__ void ln_inplace(f32x4 (&v)[4], const f32x4 (&g)[4], const f32x4 (&b)[4]) {
    float s = 0.f;
#pragma unroll
    for (int j = 0; j < 4; ++j) s += (v[j][0] + v[j][1]) + (v[j][2] + v[j][3]);
    const float mean = wave_sum(s) * (1.f / 1024.f); float q = 0.f;
#pragma unroll
    for (int j = 0; j < 4; ++j) { v[j] = v[j] - mean; q += (v[j][0] * v[j][0] + v[j][1] * v[j][1]) + (v[j][2] * v[j][2] + v[j][3] * v[j][3]); }
    const float rstd = 1.f / sqrtf(wave_sum(q) * (1.f / 1024.f) + 1e-5f);
#pragma unroll
    for (int j = 0; j < 4; ++j) v[j] = v[j] * rstd * g[j] + b[j];
}
__device__ __forceinline__ void load_gb(const float* g, const float* b, int lane, f32x4 (&gv)[4], f32x4 (&bv)[4]) {
#pragma unroll
    for (int j = 0; j < 4; ++j) { gv[j] = *(const f32x4*)(g + 4 * lane + 256 * j); bv[j] = *(const f32x4*)(b + 4 * lane + 256 * j); }
}
__device__ __forceinline__ void phase_ln_bf16(const Frame& F, const bf16_t* S, bf16_t* O, const float* g, const float* b) {
    f32x4 gv[4], bv[4]; load_gb(g, b, F.lane, gv, bv);
    for (int row = F.gw; row < MTOK; row += F.NGW) { f32x4 v[4]; load_row_bf16(S + (size_t)row * 1024, F.lane, v); ln_inplace(v, gv, bv); store_row_bf16(O + (size_t)row * 1024, F.lane, v); }
}
__device__ __forceinline__ void phase_ckvn(const Frame& F, const bf16_t* T1, const float* ssq_kv, const float* gain, bf16_t* CKVN) {
    const float g0 = gain[2 * F.lane], g1 = gain[2 * F.lane + 1];
    for (int row = F.gw; row < MTOK; row += F.NGW) {
        const unsigned w = *(const unsigned*)(T1 + (size_t)row * 256 + 2 * F.lane);
        const f32x4 sq = *(const f32x4*)(ssq_kv + (size_t)row * 4); const float r = __builtin_amdgcn_rsqf(((sq[0] + sq[1]) + (sq[2] + sq[3])) * (1.f / 128.f) + 1e-6f);
        *(unsigned*)(CKVN + (size_t)row * 128 + 2 * F.lane) = pk2(bflo(w) * r * g0, bfhi(w) * r * g1);
    }
}
__device__ __forceinline__ void phase_ln_router(const Frame& F, const bf16_t* S, bf16_t* H2, const float* g, const float* b, const float* router, unsigned char* ws) {
    LAS int* cnt = (LAS int*)(F.lds);
    if (F.tid < 8) cnt[F.tid] = 0;
    __syncthreads();
    f32x4 gv[4], bv[4]; load_gb(g, b, F.lane, gv, bv);
    u32x2* ROUTE = (u32x2*)(ws + OFF_ROUTE);
    for (int row = F.gw; row < MTOK; row += F.NGW) {
        f32x4 v[4]; load_row_bf16(S + (size_t)row * 1024, F.lane, v); ln_inplace(v, gv, bv); store_row_bf16(H2 + (size_t)row * 1024, F.lane, v);
        float lg[8];
#pragma unroll
        for (int x = 0; x < 8; ++x) lg[x] = 0.f;
#pragma unroll
        for (int j = 0; j < 4; ++j)
#pragma unroll
            for (int e = 0; e < 4; ++e) { const float* rp = router + (size_t)(4 * F.lane + 256 * j + e) * 8; const f32x4 r0 = *(const f32x4*)rp, r1 = *(const f32x4*)(rp + 4); const float hv = v[j][e];
                lg[0] += hv * r0[0]; lg[1] += hv * r0[1]; lg[2] += hv * r0[2]; lg[3] += hv * r0[3]; lg[4] += hv * r1[0]; lg[5] += hv * r1[1]; lg[6] += hv * r1[2]; lg[7] += hv * r1[3]; }
#pragma unroll
        for (int x = 0; x < 8; ++x) lg[x] = wave_sum(lg[x]);
        int e0 = 0; float l0 = lg[0];
#pragma unroll
        for (int x = 1; x < 8; ++x) if (lg[x] > l0) { l0 = lg[x]; e0 = x; }
        int e1 = -1; float l1 = -INFINITY;
#pragma unroll
        for (int x = 0; x < 8; ++x) if (x != e0 && lg[x] > l1) { l1 = lg[x]; e1 = x; }
        const float g0 = 1.f / (1.f + __expf(l1 - l0));
        if (F.lane == 0) { u32x2 r; r.x = (unsigned)e0 | ((unsigned)e1 << 8); r.y = __builtin_bit_cast(unsigned, g0); ROUTE[row] = r;
            __hip_atomic_fetch_add(cnt + e0, 1, __ATOMIC_RELAXED, __HIP_MEMORY_SCOPE_WORKGROUP); __hip_atomic_fetch_add(cnt + e1, 1, __ATOMIC_RELAXED, __HIP_MEMORY_SCOPE_WORKGROUP); }
    }
    __syncthreads();
    if (F.tid < 8) ((int*)(ws + OFF_WGCNT))[F.bx * 8 + F.tid] = cnt[F.tid];
    __syncthreads();
}
__device__ __forceinline__ void phase_moe_gather(const Frame& F, const bf16_t* H2, bf16_t* XR, unsigned char* ws) {
    LAS int* L = (LAS int*)(F.lds);
    const int* WGCNT = (const int*)(ws + OFF_WGCNT);
    { const int e = F.wave; int t = 0, p = 0;
#pragma unroll
      for (int k = 0; k < 4; ++k) { const int wg = F.lane + 64 * k; const int c = (wg < F.G) ? WGCNT[wg * 8 + e] : 0; t += c; p += (wg < F.bx) ? c : 0; }
      t = (int)wave_sum((float)t); p = (int)wave_sum((float)p);
      if (F.lane == 0) { L[e] = t; L[8 + e] = p; L[24 + e] = 0; } }
    __syncthreads();
    if (F.tid == 0) { int acc = 0;
        for (int e = 0; e < 8; ++e) { const int pad = (L[e] + 255) / 256 * 256; L[32 + e] = acc; L[16 + e] = acc + L[8 + e]; acc += pad; L[40 + e] = acc; }
        if (F.bx == 0) { int* GI = (int*)(ws + OFF_GINFO); for (int e = 0; e < 8; ++e) { GI[e] = L[40 + e]; GI[8 + e] = L[e]; } } }
    __syncthreads();
    const u32x2* ROUTE = (const u32x2*)(ws + OFF_ROUTE); int* DEST = (int*)(ws + OFF_DEST);
    for (int row = F.gw; row < MTOK; row += F.NGW) {
        const u32x2 r = ROUTE[row]; const int e0 = r.x & 255, e1 = (r.x >> 8) & 255; int s0 = 0, s1 = 0;
        if (F.lane == 0) { s0 = L[16 + e0] + __hip_atomic_fetch_add(L + 24 + e0, 1, __ATOMIC_RELAXED, __HIP_MEMORY_SCOPE_WORKGROUP); s1 = L[16 + e1] + __hip_atomic_fetch_add(L + 24 + e1, 1, __ATOMIC_RELAXED, __HIP_MEMORY_SCOPE_WORKGROUP);
            DEST[2 * row] = s0; DEST[2 * row + 1] = s1; }
        s0 = __builtin_amdgcn_readfirstlane(s0); s1 = __builtin_amdgcn_readfirstlane(s1);
        const u32x4* src = (const u32x4*)(H2 + (size_t)row * 1024); const u32x4 a = src[F.lane], b = src[F.lane + 64];
        u32x4* d0 = (u32x4*)(XR + (size_t)s0 * 1024); u32x4* d1 = (u32x4*)(XR + (size_t)s1 * 1024);
        d0[F.lane] = a; d0[F.lane + 64] = b; d1[F.lane] = a; d1[F.lane + 64] = b;
    }
    for (int e = 0; e < 8; ++e) { const int r0 = L[32 + e] + L[e], npad = L[40 + e] - r0;
        for (int i = F.gw; i < npad; i += F.NGW) { u32x4* d = (u32x4*)(XR + (size_t)(r0 + i) * 1024); d[F.lane] = (u32x4){0u, 0u, 0u, 0u}; d[F.lane + 64] = (u32x4){0u, 0u, 0u, 0u}; } }
    __syncthreads();
}
__device__ __forceinline__ void phase_final(const Frame& F, const bf16_t* H2, const bf16_t* YR, const float* g, const float* b, float* out, unsigned char* ws) {
    f32x4 gv[4], bv[4]; load_gb(g, b, F.lane, gv, bv);
    const u32x2* ROUTE = (const u32x2*)(ws + OFF_ROUTE); const int* DEST = (const int*)(ws + OFF_DEST);
    for (int row = F.gw; row < MTOK; row += F.NGW) {
        const u32x2 rte = ROUTE[row]; const float g0 = __uint_as_float(rte.y), g1 = 1.f - g0;   const int d0 = DEST[2 * row], d1 = DEST[2 * row + 1];
        f32x4 v[4], y0[4], y1[4]; load_row_bf16(H2 + (size_t)row * 1024, F.lane, v); load_row_bf16(YR + (size_t)d0 * 1024, F.lane, y0); load_row_bf16(YR + (size_t)d1 * 1024, F.lane, y1);
#pragma unroll
        for (int j = 0; j < 4; ++j) v[j] = v[j] * ALPHA + y0[j] * g0 + y1[j] * g1;
        ln_inplace(v, gv, bv);
#pragma unroll
        for (int j = 0; j < 4; ++j) *(f32x4*)(out + (size_t)row * 1024 + 4 * F.lane + 256 * j) = v[j];
    }
}

namespace att {
constexpr float NEG_BIG = -1e30f;
constexpr int KS64 = 144, VS64 = 192, KT64 = 64 * KS64, VT64 = 64 * VS64;
constexpr int KS128 = 272, VS128 = 320, KT128 = 64 * KS128, VT128 = 64 * VS128;
typedef LAS char* lptr; typedef const LAS char* lcptr;
typedef short v4i16_t __attribute__((ext_vector_type(4)));
__device__ __forceinline__ s16x4 vtr(lcptr p) { return __builtin_bit_cast(s16x4, __builtin_amdgcn_ds_read_tr16_b64_v4i16((LAS v4i16_t*)p)); }
__device__ __forceinline__ f32x16 splat16(float c) { f32x16 v;
#pragma unroll
    for (int r = 0; r < 16; ++r) v[r] = c; return v; }
__device__ __forceinline__ int crow(int r, int hi) { return (r & 3) + 8 * (r >> 2) + 4 * hi; }
__device__ __forceinline__ float ex2(float x) { return __builtin_amdgcn_exp2f(x); }

template <int NKS> __device__ __forceinline__ void qk(f32x16& s0, f32x16& s1, lcptr Kt, int kstride, const bf16x8 (&qf)[NKS], float c0, int r32, int hi) {
    s0 = splat16(c0); s1 = splat16(c0);
    lcptr p0 = Kt + r32 * kstride + hi * 16; lcptr p1 = p0 + 32 * kstride;
#pragma unroll
    for (int ks = 0; ks < NKS; ++ks) { const bf16x8 k0 = *(const LAS bf16x8*)(p0 + ks * 32), k1 = *(const LAS bf16x8*)(p1 + ks * 32);
        s0 = __builtin_amdgcn_mfma_f32_32x32x16_bf16(k0, qf[ks], s0, 0, 0, 0); s1 = __builtin_amdgcn_mfma_f32_32x32x16_bf16(k1, qf[ks], s1, 0, 0, 0); }
}
__device__ __forceinline__ float rowmax32(const f32x16& s0, const f32x16& s1) {
    float a = fmaxf(s0[0], s1[0]);
#pragma unroll
    for (int r = 1; r < 16; ++r) a = fmaxf(a, fmaxf(s0[r], s1[r]));
    return fmaxf(a, __shfl_xor(a, 32));
}
template <int NDT> __device__ __forceinline__ void softmax_step(f32x16& s0, f32x16& s1, float& m, float& l, f32x16 (&o)[NDT]) {
    const float mn = fmaxf(m, rowmax32(s0, s1)); const float al = ex2(m - mn); m = mn; float rs = 0.f;
#pragma unroll
    for (int r = 0; r < 16; ++r) { s0[r] = ex2(s0[r] - mn); s1[r] = ex2(s1[r] - mn); rs += s0[r] + s1[r]; }
    l = l * al + rs;
#pragma unroll
    for (int d = 0; d < NDT; ++d)
#pragma unroll
        for (int r = 0; r < 16; ++r) o[d][r] *= al;
}
__device__ __forceinline__ bf16x8 pack_p(const f32x16& s, int base) { u32x4 w; w.x = pk2(s[base], s[base + 1]); w.y = pk2(s[base + 2], s[base + 3]); w.z = pk2(s[base + 4], s[base + 5]); w.w = pk2(s[base + 6], s[base + 7]); return __builtin_bit_cast(bf16x8, w); }
template <int NDT> __device__ __forceinline__ void pv(f32x16 (&o)[NDT], const f32x16& s0, const f32x16& s1, lcptr Vt, int vstride, int lane) {
    const bf16x8 pk[4] = {pack_p(s0, 0), pack_p(s0, 8), pack_p(s1, 0), pack_p(s1, 8)};
    const int h = lane >> 5, g = (lane >> 4) & 1, q = (lane & 15) >> 2, p = lane & 3;
    lcptr vb = Vt + (4 * h + q) * vstride + (16 * g + 4 * p) * 2;
#pragma unroll
    for (int k = 0; k < 4; ++k)
#pragma unroll
        for (int d = 0; d < NDT; ++d) { const s16x4 lo = vtr(vb + (16 * k) * vstride + d * 64), hh = vtr(vb + (16 * k + 8) * vstride + d * 64);
            const bf16x8 vf = (bf16x8){lo[0], lo[1], lo[2], lo[3], hh[0], hh[1], hh[2], hh[3]};
            o[d] = __builtin_amdgcn_mfma_f32_32x32x16_bf16(vf, pk[k], o[d], 0, 0, 0); }
}
__device__ __forceinline__ void bias_mask_near(f32x16& s0, f32x16& s1, const LAS float* bt, int t, int kp0, int hi, unsigned maxdist) {
#pragma unroll
    for (int r = 0; r < 16; ++r) { const int d0 = t - (kp0 + crow(r, hi)), d1 = d0 - 32;
        const unsigned i0 = (unsigned)d0 < 127u ? (unsigned)d0 : 127u, i1 = (unsigned)d1 < 127u ? (unsigned)d1 : 127u;
        s0[r] = ((unsigned)d0 < maxdist) ? s0[r] + bt[i0] : -INFINITY; s1[r] = ((unsigned)d1 < maxdist) ? s1[r] + bt[i1] : -INFINITY; }
}
__device__ __forceinline__ void mask_all(f32x16& s0, f32x16& s1) {
#pragma unroll
    for (int r = 0; r < 16; ++r) { s0[r] = -INFINITY; s1[r] = -INFINITY; }
}
__device__ __forceinline__ void store_o64(bf16_t* orow, const f32x16 (&o)[2], float sc, int hi) {
#pragma unroll
    for (int d = 0; d < 2; ++d)
#pragma unroll
        for (int rg = 0; rg < 4; ++rg) { u32x2 w; w.x = pk2(o[d][4 * rg] * sc, o[d][4 * rg + 1] * sc); w.y = pk2(o[d][4 * rg + 2] * sc, o[d][4 * rg + 3] * sc);
            *(u32x2*)(orow + 32 * d + 8 * rg + 4 * hi) = w; }
}
template <class Src, class Proc> __device__ __forceinline__ void tile_loop64(int tid, lptr base, int nt, int pitch, Src src, Proc proc) {
    if (nt <= 0) return;
    const int row = tid >> 3, ch = tid & 7; u32x4 kr, vr;
    lptr Kb = base, Vb = base + 2 * KT64;
    { const bf16_t *kp, *vp; src(0, kp, vp); kr = *(const u32x4*)(kp + (size_t)row * pitch + ch * 8); vr = *(const u32x4*)(vp + (size_t)row * pitch + ch * 8); }
    *(LAS u32x4*)(Kb + row * KS64 + ch * 16) = kr; *(LAS u32x4*)(Vb + row * VS64 + ch * 16) = vr;
    __syncthreads();
    for (int i = 0; i < nt; ++i) {
        const bool more = i + 1 < nt;
        if (more) { const bf16_t *kp, *vp; src(i + 1, kp, vp); kr = *(const u32x4*)(kp + (size_t)row * pitch + ch * 8); vr = *(const u32x4*)(vp + (size_t)row * pitch + ch * 8); }
        proc(i, (lcptr)(Kb + (i & 1) * KT64), (lcptr)(Vb + (i & 1) * VT64));
        if (more) { *(LAS u32x4*)(Kb + ((i + 1) & 1) * KT64 + row * KS64 + ch * 16) = kr; *(LAS u32x4*)(Vb + ((i + 1) & 1) * VT64 + row * VS64 + ch * 16) = vr; }
        __syncthreads();
    }
}
constexpr int TL64_BYTES = 2 * KT64 + 2 * VT64;
}

__device__ __forceinline__ void moba_unit(const Frame& F, int b, int h, int qb, bf16_t* Q, const bf16_t* K, const bf16_t* V, const float* KMEAN, const float* BT) {
    using namespace att;
    const int lane = F.lane, r32 = lane & 31, hi = lane >> 5, w = F.wave;
    lptr lds = (lptr)F.lds; lptr tl = lds; LAS float* BTL = (LAS float*)(lds + TL64_BYTES); lptr KM = lds + TL64_BYTES + 512;
    const int t = 256 * qb + 32 * w + r32; const size_t row = (size_t)b * SEQ + t;
    bf16x8 qf[4];
#pragma unroll
    for (int ks = 0; ks < 4; ++ks) qf[ks] = *(const bf16x8*)(Q + row * 1024 + h * 64 + 16 * ks + 8 * hi);
    if (F.tid < 128) BTL[F.tid] = BT[h * 128 + F.tid];
    { const int idx = F.tid * 2, j = idx >> 6, d = idx & 63; const float* kmp = KMEAN + (size_t)(b * 16 + j) * 2048 + h * 64 + d;
      *(LAS unsigned*)(KM + j * KS64 + d * 2) = (j < qb) ? pk2(kmp[0] + kmp[1024], kmp[1] + kmp[1025]) : 0u;
      *(LAS unsigned*)(KM + (16 + j) * KS64 + d * 2) = 0u; }
    __syncthreads();
    unsigned selmask = 0u;
    if (qb > 0) {
        f32x16 gs = splat16(0.f);
        { lcptr p0 = (lcptr)KM + r32 * KS64 + hi * 16;
#pragma unroll
          for (int ks = 0; ks < 4; ++ks) { const bf16x8 k0 = *(const LAS bf16x8*)(p0 + ks * 32); gs = __builtin_amdgcn_mfma_f32_32x32x16_bf16(k0, qf[ks], gs, 0, 0, 0); } }
        float glo[8], ghi[8];
#pragma unroll
        for (int r = 0; r < 8; ++r) { const float mine = gs[r], oth = __shfl_xor(mine, 32); glo[r] = hi ? oth : mine; ghi[r] = hi ? mine : oth; }
#pragma unroll
        for (int rep = 0; rep < 3; ++rep) { float best = -INFINITY; int bj = -1;
#pragma unroll
            for (int j = 0; j < 16; ++j) { const int r = (j & 3) + 4 * (j >> 3); const float gv = ((j >> 2) & 1) ? ghi[r] : glo[r];
                if (j < qb && !((selmask >> j) & 1u) && gv > best) { best = gv; bj = j; } }
            if (bj >= 0) selmask |= 1u << bj; }
    }
    f32x16 o[2] = {splat16(0.f), splat16(0.f)}; float m = NEG_BIG, l = 0.f;
    const int nt = 4 * (qb + 1); const int twmax = 256 * qb + 32 * w + 31;
    const bf16_t* Kh = K + (size_t)b * SEQ * 1024 + h * 64; const bf16_t* Vh = V + (size_t)b * SEQ * 1024 + h * 64;
    const float cfar = BTL[127];
    tile_loop64(F.tid, tl, nt, 1024,
        [&](int i, const bf16_t*& kp, const bf16_t*& vp) { kp = Kh + (size_t)(64 * i) * 1024; vp = Vh + (size_t)(64 * i) * 1024; },
        [&](int i, lcptr Kt, lcptr Vt) {
            const int blk = i >> 2, kp0 = 64 * i; f32x16 s0, s1;
            if (blk < qb) {
                const bool sel = (selmask >> blk) & 1u;
                if (!__any(sel)) return;
                if (blk < qb - 1 || (i & 3) < 2) { qk<4>(s0, s1, Kt, KS64, qf, cfar, r32, hi); }
                else { qk<4>(s0, s1, Kt, KS64, qf, 0.f, r32, hi); bias_mask_near(s0, s1, BTL, t, kp0, hi, 0x7fffffffu); }
                if (!sel) mask_all(s0, s1);
            } else {
                if (kp0 > twmax) return;
                qk<4>(s0, s1, Kt, KS64, qf, 0.f, r32, hi); bias_mask_near(s0, s1, BTL, t, kp0, hi, 0x7fffffffu);
            }
            softmax_step<2>(s0, s1, m, l, o); pv<2>(o, s0, s1, Vt, VS64, lane);
        });
    l += __shfl_xor(l, 32);
    store_o64(Q + row * 1024 + h * 64, o, l > 0.f ? 1.f / l : 0.f, hi);
}
__device__ __forceinline__ void phase_moba(const Frame& F, unsigned char* ws) {
    bf16_t* Q = (bf16_t*)(ws + OFF_QKV); const bf16_t* K = Q + (size_t)MTOK * 1024; const bf16_t* V = K + (size_t)MTOK * 1024;
    const float* KMEAN = (const float*)(ws + OFF_KMEAN); const float* BT = (const float*)(ws + OFF_BT);
    for (int idx = F.bx; idx < 2048; idx += F.G) { const int i = idx >> 8, v = idx & 255, b = v >> 5, h = (v & 31) >> 1, half = v & 1, p = half * 4 + (i >> 1), qb = (i & 1) ? 15 - p : p;
        moba_unit(F, b, h, qb, Q, K, V, KMEAN, BT); __syncthreads(); }
}

__device__ __forceinline__ void nsa_unit(const Frame& F, int b, int g, int c, const bf16_t* Y1, const bf16_t* KC, const bf16_t* VC, const float* BT, bf16_t* MIXIN) {
    using namespace att;
    const int lane = F.lane, r32 = lane & 31, hi = lane >> 5, w = F.wave;
    lptr lds = (lptr)F.lds; lptr tl = lds; LAS float* BTL = (LAS float*)(lds + TL64_BYTES);
    LAS float* SCB = (LAS float*)(lds + TL64_BYTES + 2048);
    LAS unsigned long long* SELM = (LAS unsigned long long*)(lds + TL64_BYTES + 2048 + 16384);
    lptr OFL = lds + TL64_BYTES + 2048 + 16384 + 1024 + w * 8704 + r32 * 272 + hi * 16;
    const int n = r32 & 3, tok = 8 * w + (r32 >> 2), t = 64 * c + tok; const size_t row = (size_t)b * SEQ + t;
    const bf16_t* T1 = Y1 + (size_t)1 * MTOK * 256; const bf16_t* QB = Y1 + (size_t)(2 + g) * MTOK * 256;
    const bf16_t* KVS = Y1 + (size_t)5 * MTOK * 256; const bf16_t* KVW = Y1 + (size_t)6 * MTOK * 256;
    bf16x8 qf[4];
#pragma unroll
    for (int ks = 0; ks < 4; ++ks) qf[ks] = *(const bf16x8*)(QB + row * 256 + n * 64 + 16 * ks + 8 * hi);
    float gate[3];
#pragma unroll
    for (int j = 0; j < 3; ++j) { const float x = bf2f(T1[row * 256 + 208 + (4 * g + n) * 3 + j]); gate[j] = 1.f / (1.f + __expf(-x)); }
    for (int i = F.tid; i < 512; i += NTHR) BTL[i] = BT[(8 + 4 * g) * 128 + i];
    for (int i = F.tid; i < 4096; i += NTHR) SCB[i] = 0.f;
    __syncthreads();
    const LAS float* bt = BTL + n * 128; const float cfar = bt[127];
    const int vis = (t >= 31) ? ((t - 31) >> 4) : -1;
    const int ntc = ((4 * c + 2) >> 6) + 1;
    const bf16_t* KCg = KC + ((size_t)b * 256 * 2 + g) * 64; const bf16_t* VCg = VC + ((size_t)b * 256 * 2 + g) * 64;
    auto cmp_scores = [&](int i, lcptr Kt, f32x16& s0, f32x16& s1) {
        qk<4>(s0, s1, Kt, KS64, qf, 0.f, r32, hi);
#pragma unroll
        for (int r = 0; r < 16; ++r) { const int c0 = 64 * i + crow(r, hi), c1 = c0 + 32; const int d0 = t - 16 * c0 - 31, d1 = d0 - 512;
            const unsigned i0 = (unsigned)d0 < 127u ? (unsigned)d0 : 127u, i1 = (unsigned)d1 < 127u ? (unsigned)d1 : 127u;
            s0[r] = (c0 <= vis) ? s0[r] + bt[i0] : -INFINITY; s1[r] = (c1 <= vis) ? s1[r] + bt[i1] : -INFINITY; }
    };
    float mc = NEG_BIG, lc = 0.f;
    tile_loop64(F.tid, tl, ntc, 128,
        [&](int i, const bf16_t*& kp, const bf16_t*& vp) { kp = KCg + (size_t)(64 * i) * 128; vp = VCg + (size_t)(64 * i) * 128; },
        [&](int i, lcptr Kt, lcptr Vt) { f32x16 s0, s1; cmp_scores(i, Kt, s0, s1);
            const float mn = fmaxf(mc, rowmax32(s0, s1)); float rs = 0.f;
#pragma unroll
            for (int r = 0; r < 16; ++r) rs += ex2(s0[r] - mn) + ex2(s1[r] - mn);
            lc = lc * ex2(mc - mn) + rs; mc = mn; });
    lc += __shfl_xor(lc, 32);
    const float invc = lc > 0.f ? 1.f / lc : 0.f;
    {
        f32x16 o[2] = {splat16(0.f), splat16(0.f)}; float carry = 0.f;
        tile_loop64(F.tid, tl, ntc, 128,
            [&](int i, const bf16_t*& kp, const bf16_t*& vp) { kp = KCg + (size_t)(64 * i) * 128; vp = VCg + (size_t)(64 * i) * 128; },
            [&](int i, lcptr Kt, lcptr Vt) { f32x16 s0, s1; cmp_scores(i, Kt, s0, s1);
#pragma unroll
                for (int r = 0; r < 16; ++r) { s0[r] = ex2(s0[r] - mc) * invc; s1[r] = ex2(s1[r] - mc) * invc; }
                float x0[4], x1[4];
#pragma unroll
                for (int rg = 0; rg < 4; ++rg) { x0[rg] = __shfl_xor(s0[4 * rg + 3], 32); x1[rg] = __shfl_xor(s1[4 * rg + 3], 32); }
#pragma unroll
                for (int rg = 0; rg < 4; ++rg) {
                    float g0 = (s0[4 * rg] + s0[4 * rg + 1]) + (s0[4 * rg + 2] + s0[4 * rg + 3]), g1 = (s1[4 * rg] + s1[4 * rg + 1]) + (s1[4 * rg + 2] + s1[4 * rg + 3]);
                    const float e0 = hi ? x0[rg] : (rg > 0 ? x0[rg > 0 ? rg - 1 : 0] : carry), e1 = hi ? x1[rg] : (rg > 0 ? x1[rg > 0 ? rg - 1 : 0] : x0[3]);
                    g0 += e0; g1 += e1;
                    g0 += __shfl_xor(g0, 1); g0 += __shfl_xor(g0, 2); g1 += __shfl_xor(g1, 1); g1 += __shfl_xor(g1, 2);
                    if (n == 0) { SCB[tok * 64 + 16 * i + 2 * rg + hi] = g0; SCB[tok * 64 + 16 * i + 8 + 2 * rg + hi] = g1; }
                }
                carry = x1[3];
                pv<2>(o, s0, s1, Vt, VS64, lane); });
#pragma unroll
        for (int d = 0; d < 2; ++d)
#pragma unroll
            for (int rg = 0; rg < 4; ++rg) *(LAS f32x4*)(OFL + d * 128 + rg * 32) = (f32x4){o[d][4 * rg], o[d][4 * rg + 1], o[d][4 * rg + 2], o[d][4 * rg + 3]} * gate[0];
    }
    {
        unsigned long long uni = 0ull;
#pragma unroll 1
        for (int tk = 0; tk < 8; ++tk) { const int tk2 = 8 * w + tk; float v = SCB[tk2 * 64 + lane];
            v = (lane > c) ? -INFINITY : ((lane == 0 || lane == c || lane == c - 1) ? INFINITY : v);
            int cnt = 0;
#pragma unroll
            for (int j = 0; j < 64; ++j) { const float vj = __builtin_bit_cast(float, __builtin_amdgcn_readlane(__builtin_bit_cast(int, v), j)); cnt += (vj > v || (vj == v && j < lane)) ? 1 : 0; }
            const unsigned long long mk = __ballot(cnt < 16 && lane <= c);
            if (lane == 0) SELM[tk2] = mk;
            uni |= mk; }
        if (lane == 0) SELM[64 + w] = uni;
    }
    __syncthreads();
    const unsigned long long mymask = SELM[tok];
    unsigned long long uni = 0ull;
#pragma unroll
    for (int k = 0; k < 8; ++k) uni |= SELM[64 + k];
    {
        f32x16 o[2] = {splat16(0.f), splat16(0.f)}; float m = NEG_BIG, l = 0.f;
        const int nsel = __popcll(uni);
        const bf16_t* Kg = KVS + (size_t)b * SEQ * 256 + g * 64; const bf16_t* Vg = Kg + 128;
        unsigned long long rem_src = uni, rem_proc = uni;
        tile_loop64(F.tid, tl, nsel, 256,
            [&](int i, const bf16_t*& kp, const bf16_t*& vp) { const int j = __builtin_ctzll(rem_src); rem_src &= rem_src - 1; kp = Kg + (size_t)(64 * j) * 256; vp = Vg + (size_t)(64 * j) * 256; },
            [&](int i, lcptr Kt, lcptr Vt) { const int j = __builtin_ctzll(rem_proc); rem_proc &= rem_proc - 1;
                const bool sel = (mymask >> j) & 1ull;
                if (!__any(sel)) return;
                f32x16 s0, s1;
                if (j < c - 2) qk<4>(s0, s1, Kt, KS64, qf, cfar, r32, hi);
                else { qk<4>(s0, s1, Kt, KS64, qf, 0.f, r32, hi); bias_mask_near(s0, s1, bt, t, 64 * j, hi, 0x7fffffffu); }
                if (!sel) mask_all(s0, s1);
                softmax_step<2>(s0, s1, m, l, o); pv<2>(o, s0, s1, Vt, VS64, lane); });
        l += __shfl_xor(l, 32); const float f = gate[1] * (l > 0.f ? 1.f / l : 0.f);
#pragma unroll
        for (int d = 0; d < 2; ++d)
#pragma unroll
            for (int rg = 0; rg < 4; ++rg) *(LAS f32x4*)(OFL + d * 128 + rg * 32) += (f32x4){o[d][4 * rg], o[d][4 * rg + 1], o[d][4 * rg + 2], o[d][4 * rg + 3]} * f;
    }
    {
        f32x16 o[2] = {splat16(0.f), splat16(0.f)}; float m = NEG_BIG, l = 0.f;
        const int k0 = c >= 8 ? c - 8 : 0, ntw = c - k0 + 1;
        const bf16_t* Kg = KVW + (size_t)b * SEQ * 256 + g * 64; const bf16_t* Vg = Kg + 128;
        tile_loop64(F.tid, tl, ntw, 256,
            [&](int i, const bf16_t*& kp, const bf16_t*& vp) { kp = Kg + (size_t)(64 * (k0 + i)) * 256; vp = Vg + (size_t)(64 * (k0 + i)) * 256; },
            [&](int i, lcptr Kt, lcptr Vt) { const int kt = k0 + i; f32x16 s0, s1;
                if (kt < c - 2 && kt > c - 8) qk<4>(s0, s1, Kt, KS64, qf, cfar, r32, hi);
                else { qk<4>(s0, s1, Kt, KS64, qf, 0.f, r32, hi); bias_mask_near(s0, s1, bt, t, 64 * kt, hi, 512u); }
                softmax_step<2>(s0, s1, m, l, o); pv<2>(o, s0, s1, Vt, VS64, lane); });
        l += __shfl_xor(l, 32); const float f = gate[2] * (l > 0.f ? 1.f / l : 0.f);
        bf16_t* orow = MIXIN + row * 1536 + 1024 + (4 * g + n) * 64;
#pragma unroll
        for (int d = 0; d < 2; ++d)
#pragma unroll
            for (int rg = 0; rg < 4; ++rg) { const f32x4 v = *(LAS f32x4*)(OFL + d * 128 + rg * 32) + (f32x4){o[d][4 * rg], o[d][4 * rg + 1], o[d][4 * rg + 2], o[d][4 * rg + 3]} * f;
                u32x2 wv; wv.x = pk2(v[0], v[1]); wv.y = pk2(v[2], v[3]); *(u32x2*)(orow + 32 * d + 8 * rg + 4 * hi) = wv; }
    }
}

__device__ __forceinline__ void dsa_unit(const Frame& F, int b, int u, const bf16_t* QLAT, const bf16_t* CKVN, const unsigned* MASK, const float* BT, bf16_t* MIXIN) {
    using namespace att;
    const int lane = F.lane, r32 = lane & 31, hi = lane >> 5, w = F.wave, tid = F.tid;
    lptr lds = (lptr)F.lds; constexpr int STG = KT128 + VT128; LAS float* BTL = (LAS float*)(lds + 2 * STG);
    const int head = r32 & 7, q0 = 32 * u, t = q0 + 4 * w + (r32 >> 3); const size_t row = (size_t)b * SEQ + t;
    bf16x8 qf[8];
#pragma unroll
    for (int ks = 0; ks < 8; ++ks) qf[ks] = *(const bf16x8*)(QLAT + row * 1024 + head * 128 + 16 * ks + 8 * hi);
    for (int i = tid; i < 1024; i += NTHR) BTL[i] = BT[i];
    const LAS float* bt = BTL + head * 128;
    f32x16 o[4] = {splat16(0.f), splat16(0.f), splat16(0.f), splat16(0.f)}; float m = NEG_BIG, l = 0.f;
    const int nt = ((q0 + 31) >> 6) + 1;
    const bf16_t* Cb = CKVN + (size_t)b * SEQ * 128; const unsigned* mrow = MASK + row * 128;
    u32x4 st[2];
    auto gload = [&](int i) {
#pragma unroll
        for (int k = 0; k < 2; ++k) { const int idx = tid + 512 * k, rr = idx >> 4, ch = idx & 15; st[k] = *(const u32x4*)(Cb + (size_t)(64 * i + rr) * 128 + ch * 8); } };
    auto lstore = [&](int buf) {
#pragma unroll
        for (int k = 0; k < 2; ++k) { const int idx = tid + 512 * k, rr = idx >> 4, ch = idx & 15; *(LAS u32x4*)(lds + buf * STG + rr * KS128 + ch * 16) = st[k]; *(LAS u32x4*)(lds + buf * STG + KT128 + rr * VS128 + ch * 16) = st[k]; } };
    gload(0); lstore(0); __syncthreads();
    const float cfar = bt[127];
    for (int i = 0; i < nt; ++i) {
        const bool more = i + 1 < nt;
        if (more) gload(i + 1);
        {
            lcptr Kt = (lcptr)(lds + (i & 1) * STG); lcptr Vt = Kt + KT128;
            const u32x2 mw = *(const u32x2*)(mrow + 2 * i);
            f32x16 s0, s1;
            const bool near = (q0 - (64 * i + 63)) < 128;
            qk<8>(s0, s1, Kt, KS128, qf, near ? 0.f : cfar, r32, hi);
            const unsigned w0 = mw.x >> (4 * hi), w1 = mw.y >> (4 * hi);
            if (near) {
#pragma unroll
                for (int r = 0; r < 16; ++r) { const int d0 = t - (64 * i + crow(r, hi)), d1 = d0 - 32;
                    const unsigned i0 = (unsigned)d0 < 127u ? (unsigned)d0 : 127u, i1 = (unsigned)d1 < 127u ? (unsigned)d1 : 127u;
                    s0[r] += bt[i0]; s1[r] += bt[i1]; }
            }
#pragma unroll
            for (int r = 0; r < 16; ++r) { const int bit = (r & 3) + 8 * (r >> 2);
                s0[r] = ((w0 >> bit) & 1u) ? s0[r] : -INFINITY; s1[r] = ((w1 >> bit) & 1u) ? s1[r] : -INFINITY; }
            softmax_step<4>(s0, s1, m, l, o); pv<4>(o, s0, s1, Vt, VS128, lane);
        }
        if (more) lstore((i + 1) & 1);
        __syncthreads();
    }
    l += __shfl_xor(l, 32); const float f = l > 0.f ? 1.f / l : 0.f;
    bf16_t* orow = MIXIN + row * 1536 + head * 128;
#pragma unroll
    for (int d = 0; d < 4; ++d)
#pragma unroll
        for (int rg = 0; rg < 4; ++rg) { u32x2 wv; wv.x = pk2(o[d][4 * rg] * f, o[d][4 * rg + 1] * f); wv.y = pk2(o[d][4 * rg + 2] * f, o[d][4 * rg + 3] * f);
            *(u32x2*)(orow + 32 * d + 8 * rg + 4 * hi) = wv; }
}

constexpr int QI_STRIDE = 2064;
__device__ __forceinline__ void indexer_unit(const Frame& F, int b, int c, const bf16_t* QIDX, const bf16_t* T1, _Float16* SC) {
    using namespace att;
    const int lane = F.lane, r32 = lane & 31, hi = lane >> 5, w = F.wave, tid = F.tid;
    lptr lds = (lptr)F.lds; lptr QI = lds; lptr KI = lds + 64 * QI_STRIDE;
    const int qh = w & 1, kq = w >> 1;
    const size_t row0 = (size_t)b * SEQ + 64 * c;
#pragma unroll 4
    for (int k = 0; k < 16; ++k) { const int idx = tid + 512 * k, rr = idx >> 7, ch = idx & 127; *(LAS u32x4*)(QI + rr * QI_STRIDE + ch * 16) = *(const u32x4*)(QIDX + (row0 + rr) * 1024 + ch * 8); }
    float wv[16];
    { const size_t trow = row0 + 32 * qh + r32; const u32x4 a = *(const u32x4*)(T1 + trow * 256 + 192), bq = *(const u32x4*)(T1 + trow * 256 + 200);
      wv[0] = bflo(a.x); wv[1] = bfhi(a.x); wv[2] = bflo(a.y); wv[3] = bfhi(a.y); wv[4] = bflo(a.z); wv[5] = bfhi(a.z); wv[6] = bflo(a.w); wv[7] = bfhi(a.w);
      wv[8] = bflo(bq.x); wv[9] = bfhi(bq.x); wv[10] = bflo(bq.y); wv[11] = bfhi(bq.y); wv[12] = bflo(bq.z); wv[13] = bfhi(bq.z); wv[14] = bflo(bq.w); wv[15] = bfhi(bq.w); }
    const int nsup = (c + 2) >> 1, pitch = (c + 1) * 64;
    _Float16* srow = SC + (size_t)b * SCB_ELEMS + (size_t)4096 * (c * (c + 1) / 2) + (size_t)(32 * qh + r32) * pitch;
    const bf16_t* Kb = T1 + (size_t)b * SEQ * 256 + 128;
    u32x4 st[2];
    for (int s = 0; s < nsup; ++s) {
#pragma unroll
        for (int k = 0; k < 2; ++k) { const int idx = tid + 512 * k, rr = idx >> 3, ch = idx & 7; st[k] = *(const u32x4*)(Kb + (size_t)(128 * s + rr) * 256 + ch * 8); }
        __syncthreads();
#pragma unroll
        for (int k = 0; k < 2; ++k) { const int idx = tid + 512 * k, rr = idx >> 3, ch = idx & 7; *(LAS u32x4*)(KI + rr * KS64 + ch * 16) = st[k]; }
        __syncthreads();
        const int key0 = 128 * s + 32 * kq;
        if (key0 <= 64 * c + 63) {
            bf16x8 kf[4];
#pragma unroll
            for (int ks = 0; ks < 4; ++ks) kf[ks] = *(const LAS bf16x8*)(KI + (32 * kq + r32) * KS64 + ks * 32 + hi * 16);
            f32x16 sc = splat16(0.f);
            lcptr qp = (lcptr)QI + (32 * qh + r32) * QI_STRIDE + hi * 16;
#pragma unroll 4
            for (int hd = 0; hd < 16; ++hd) { f32x16 acc = splat16(0.f);
#pragma unroll
                for (int ks = 0; ks < 4; ++ks) { const bf16x8 qv = *(const LAS bf16x8*)(qp + hd * 128 + ks * 32); acc = __builtin_amdgcn_mfma_f32_32x32x16_bf16(kf[ks], qv, acc, 0, 0, 0); }
                const float ww = wv[hd];
#pragma unroll
                for (int r = 0; r < 16; ++r) sc[r] += ww * fmaxf(acc[r], 0.f); }
#pragma unroll
            for (int rg = 0; rg < 4; ++rg) { f32x2 a = {sc[4 * rg], sc[4 * rg + 1]}, bq = {sc[4 * rg + 2], sc[4 * rg + 3]};
                u32x2 o; o.x = __builtin_bit_cast(unsigned, __builtin_convertvector(a, f16x2_t)); o.y = __builtin_bit_cast(unsigned, __builtin_convertvector(bq, f16x2_t));
                *(u32x2*)(srow + key0 + 8 * rg + 4 * hi) = o; }
        }
    }
    __syncthreads();
}

__device__ __forceinline__ void phase_select(const Frame& F, const _Float16* SC, unsigned* MASK) {
    const int lane = F.lane;
    for (int row = F.gw; row < MTOK; row += F.NGW) {
        const int b = row >> 12, t = row & 4095, c = t >> 6, nk = (c + 1) * 64;
        const unsigned short* src = (const unsigned short*)SC + (size_t)b * SCB_ELEMS + (size_t)4096 * (c * (c + 1) / 2) + (size_t)(t & 63) * nk;
        unsigned* mrow = MASK + (size_t)row * 128;
        if (t < 256) {
            for (int j = 0; j <= c; ++j) { const unsigned long long mk = __ballot(64 * j + lane <= t); if (lane == 0) *(u32x2*)(mrow + 2 * j) = (u32x2){(unsigned)mk, (unsigned)(mk >> 32)}; }
            continue;
        }
        unsigned key[64];
#pragma unroll
        for (int j = 0; j < 64; ++j) { unsigned k = 0u;
            if (j <= c) { const unsigned uu = src[64 * j + lane]; k = (uu & 0x8000u) ? (~uu & 0xffffu) : (uu | 0x8000u); if (64 * j + lane > t) k = 0u; }
            key[j] = k; }
        unsigned prefix = 0u;
#pragma unroll 1
        for (int bit = 15; bit >= 0; --bit) { const unsigned cand = prefix | (1u << bit); int cnt = 0;
#pragma unroll
            for (int j = 0; j < 64; ++j) cnt += (key[j] >= cand) ? 1 : 0;
            cnt = (int)wave_sum((float)cnt);
            if (cnt >= 256) prefix = cand; }
        int cgt = 0;
#pragma unroll
        for (int j = 0; j < 64; ++j) cgt += (key[j] > prefix) ? 1 : 0;
        cgt = (int)wave_sum((float)cgt);
        int rem = 256 - cgt;
#pragma unroll
        for (int j = 0; j < 64; ++j) {
            if (j <= c) {
                const bool eq = key[j] == prefix; const unsigned long long eqm = __ballot(eq);
                const int before = __builtin_amdgcn_mbcnt_hi((unsigned)(eqm >> 32), __builtin_amdgcn_mbcnt_lo((unsigned)eqm, 0u));
                const unsigned long long mk = __ballot(key[j] > prefix || (eq && before < rem));
                rem -= __popcll(eqm); rem = rem < 0 ? 0 : rem;
                if (lane == 0) *(u32x2*)(mrow + 2 * j) = (u32x2){(unsigned)mk, (unsigned)(mk >> 32)};
            }
        }
    }
}

__device__ __forceinline__ float gelu_tanh(float x) { const float u = 0.7978845608028654f * (x + 0.044715f * x * x * x); const float e = __expf(2.f * u); return 0.5f * x * (1.f + (1.f - 2.f / (e + 1.f))); }
__device__ __forceinline__ void compress_unit(const Frame& F, int b, int g, int kv, int rt, const bf16_t* KVC, const bf16_t* W1T, const float* w2, const float* cb, bf16_t* OUT) {
    const int lane = F.lane, r32 = lane & 31, hi = lane >> 5, w = F.wave, tid = F.tid;
    LAS float* PART = (LAS float*)F.lds;
    LAS float* HID = PART + 8 * 2048;
    const int n0 = 32 * rt, nn = n0 + r32, nc = nn < 255 ? nn : 254;
    const bf16_t* arow = KVC + ((size_t)b * SEQ + 16 * nc) * 256 + kv * 128 + g * 64;
    f32x16 a0 = att::splat16(0.f), a1 = att::splat16(0.f);
#pragma unroll 4
    for (int ks = 0; ks < 16; ++ks) { const int l = 4 * w + (ks >> 2), d = 16 * (ks & 3) + 8 * hi;
        const bf16x8 af = *(const bf16x8*)(arow + (size_t)l * 256 + d);
        const bf16x8 b0 = *(const bf16x8*)(W1T + (size_t)r32 * 2048 + l * 64 + d), b1 = *(const bf16x8*)(W1T + (size_t)(32 + r32) * 2048 + l * 64 + d);
        a0 = __builtin_amdgcn_mfma_f32_32x32x16_bf16(af, b0, a0, 0, 0, 0); a1 = __builtin_amdgcn_mfma_f32_32x32x16_bf16(af, b1, a1, 0, 0, 0); }
#pragma unroll
    for (int r = 0; r < 16; ++r) { const int mrow = att::crow(r, hi); PART[w * 2048 + mrow * 64 + r32] = a0[r]; PART[w * 2048 + mrow * 64 + 32 + r32] = a1[r]; }
    __syncthreads();
#pragma unroll
    for (int k = 0; k < 4; ++k) { const int idx = tid + 512 * k; float s = cb[idx & 63];
#pragma unroll
        for (int ww = 0; ww < 8; ++ww) s += PART[ww * 2048 + idx];
        HID[idx] = gelu_tanh(s); }
    __syncthreads();
#pragma unroll
    for (int k = 0; k < 4; ++k) { const int idx = tid + 512 * k, nr = idx >> 6, f = idx & 63; float s = 0.f;
#pragma unroll 8
        for (int e = 0; e < 64; ++e) s += HID[nr * 64 + e] * w2[e * 64 + f];
        const int blk = n0 + nr;
        OUT[(((size_t)b * 256 + blk) * 2 + g) * 64 + f] = (blk < 255) ? (bf16_t)f2bf(s) : (bf16_t)0; }
    __syncthreads();
}

#ifdef DBG_MODE
namespace dbg {
constexpr int NSLOT = 40;
__device__ __forceinline__ float bfr(float x) { return bf2f((unsigned short)f2bf(x)); }
__device__ __forceinline__ int srow(int i, int n) { return (int)(((unsigned)i * 2654435761u) % (unsigned)MTOK) ; }
__device__ void commit(unsigned* D, int slot, const float* ref, const float* fast, int n, float tf) {
    __shared__ float red[256];
    const int tid = threadIdx.x; float s = 0.f;
    for (int i = tid; i < n; i += 256) s += ref[i] * ref[i];
    red[tid] = s; __syncthreads();
    for (int o = 128; o > 0; o >>= 1) { if (tid < o) red[tid] += red[tid + o]; __syncthreads(); }
    const float rms = sqrtf(red[0] / (float)n); __syncthreads();
    int bad = 0, tot = 0; float mr = 0.f;
    for (int i = tid; i < n; i += 256) { const float e = fabsf(fast[i] - ref[i]); const float tol = tf * (rms + fabsf(ref[i])) + 1e-7f; if (!(e <= tol)) ++bad; ++tot; const float r = e / (rms + 1e-20f); if (r > mr || !(r == r)) mr = (r == r) ? r : 1e30f; }
    atomicAdd(&D[4 * slot], (unsigned)bad); atomicAdd(&D[4 * slot + 1], (unsigned)tot); atomicMax(&D[4 * slot + 2], __float_as_uint(mr));
    __syncthreads();
}
__device__ __forceinline__ float bias_l2(const float* relb, int head, int dist) { return relb[t5_bucket(dist) * 16 + head] * LOG2E; }

__global__ void chk_in_e(Args a, unsigned* D) {
    __shared__ float ref[1792], fast[1792];
    const int r = srow(blockIdx.x, 64), tid = threadIdx.x; const float* x = a.in[I_X] + (size_t)r * 1024; const float* w = a.in[I_EWIN];
    const bf16_t* Y1 = (const bf16_t*)(a.ws + OFF_Y1);
    for (int n = tid; n < EVEN_IN; n += 256) { float s = 0.f; for (int k = 0; k < 1024; ++k) s += bfr(x[k]) * bfr(w[(size_t)k * EVEN_IN + n]);
        const int dc = RowInE{}(n), tile = dc >> 8, col = dc & 255; const float sc = (tile == 2 || tile == 3) ? QSCALE : 1.f;
        ref[n] = s * sc; fast[n] = bf2f(Y1[((size_t)tile * MTOK + r) * 256 + col]); }
    __syncthreads();
    commit(D, 1, ref, fast, EVEN_IN, 0.02f);
    if (tid == 0) { float sq = 0.f, skv = 0.f; for (int n = 0; n < 256; ++n) sq += ref[n] * ref[n]; for (int n = 256; n < 384; ++n) skv += ref[n] * ref[n];
        const float* pq = (const float*)(a.ws + OFF_SSQ_Q) + (size_t)r * 4; const float* pk = (const float*)(a.ws + OFF_SSQ_KV) + (size_t)r * 4;
        const float fq = pq[0] + pq[1] + pq[2] + pq[3], fk = pk[0] + pk[1] + pk[2] + pk[3];
        int bad = 0; if (!(fabsf(fq - sq) <= 0.02f * sq)) ++bad; if (!(fabsf(fk - skv) <= 0.02f * skv)) ++bad;
        atomicAdd(&D[4 * 2], (unsigned)bad); atomicAdd(&D[4 * 2 + 1], 2u); }
}
__global__ void chk_q2(Args a, unsigned* D) {
    __shared__ float ref[1024], fast[1024], cqn[256], qh[512];
    const int r = srow(blockIdx.x, 64), tid = threadIdx.x; const bf16_t* Y1 = (const bf16_t*)(a.ws + OFF_Y1);
    const bf16_t* CQ = Y1 + (size_t)r * 256; const bf16_t* T1 = Y1 + ((size_t)MTOK + r) * 256;
    { float s = 0.f; for (int k = 0; k < 128; ++k) { const float c = bf2f(T1[k]); s += c * c; } const float rk = 1.f / sqrtf(s / 128.f + 1e-6f);
      if (tid < 128) { ref[tid] = bf2f(T1[tid]) * rk * a.in[I_EKVN][tid]; fast[tid] = bf2f(((const bf16_t*)(a.ws + OFF_CKVN))[(size_t)r * 128 + tid]); } }
    __syncthreads(); commit(D, 3, ref, fast, 128, 0.02f);
    { float s = 0.f; for (int k = 0; k < 256; ++k) { const float c = bf2f(CQ[k]); s += c * c; } const float rq = 1.f / sqrtf(s / 256.f + 1e-6f);
      cqn[tid] = bf2f(CQ[tid]) * rq * a.in[I_EQN][tid]; }
    __syncthreads();
    for (int o = tid; o < 512; o += 256) { float s = 0.f; for (int k = 0; k < 256; ++k) s += cqn[k] * a.in[I_EWUQ][k * 512 + o]; qh[o] = s; }
    __syncthreads();
    for (int o = tid; o < 1024; o += 256) { const int h = o >> 7, c = o & 127; float s = 0.f; for (int d = 0; d < 64; ++d) s += qh[h * 64 + d] * a.in[I_EWUK][c * 512 + h * 64 + d];
        ref[o] = s * QSCALE; fast[o] = bf2f(((const bf16_t*)(a.ws + OFF_QLAT))[(size_t)r * 1024 + o]); }
    __syncthreads(); commit(D, 5, ref, fast, 1024, 0.03f);
    for (int o = tid; o < 1024; o += 256) { float s = 0.f; for (int k = 0; k < 256; ++k) s += cqn[k] * a.in[I_EWQIDX][k * 1024 + o];
        ref[o] = s; fast[o] = bf2f(((const bf16_t*)(a.ws + OFF_QIDX))[(size_t)r * 1024 + o]); }
    __syncthreads(); commit(D, 6, ref, fast, 1024, 0.03f);
}
__global__ void chk_cmp(Args a, unsigned* D) {
    __shared__ float ref[64], fast[64], hid[64];
    const int i = blockIdx.x, tid = threadIdx.x, b = i & 7, g = (i >> 3) & 1, kv = (i >> 4) & 1; const int blk = (i >> 5) == 0 ? 0 : ((i >> 5) == 1 ? 254 : (int)((unsigned)(i * 37 + 11) % 255u));
    const bf16_t* KVC = (const bf16_t*)(a.ws + OFF_Y1) + (size_t)4 * MTOK * 256;
    const float* pos = a.in[kv ? I_EPOSV : I_EPOSK]; const float* w1 = a.in[kv ? I_ECV1 : I_ECK1]; const float* w2 = a.in[kv ? I_ECV2 : I_ECK2];
    if (tid < 64) { float s = 0.f;
        for (int l = 0; l < 32; ++l) for (int d = 0; d < 64; ++d) { const float av = bf2f(KVC[((size_t)b * SEQ + 16 * blk + l) * 256 + kv * 128 + g * 64 + d]); const float wv = w1[(l * 64 + d) * 64 + tid]; s += av * bfr(wv) + pos[l * 64 + d] * wv; }
        hid[tid] = gelu_tanh(s); }
    __syncthreads();
    if (tid < 64) { float s = 0.f; for (int e = 0; e < 64; ++e) s += hid[e] * w2[e * 64 + tid]; ref[tid] = s;
        fast[tid] = bf2f(((const bf16_t*)(a.ws + (kv ? OFF_VC : OFF_KC)))[(((size_t)b * 256 + blk) * 2 + g) * 64 + tid]); }
    __syncthreads(); commit(D, 4, ref, fast, 64, 0.03f);
}
__global__ void chk_idx(Args a, unsigned* D) {
    __shared__ float ref[256], fast[256];
    const int r = (blockIdx.x < 4) ? (blockIdx.x * 4096 + blockIdx.x * 61) : srow(blockIdx.x, 64), tid = threadIdx.x, b = r >> 12, t = r & 4095, c = t >> 6, nk = (c + 1) * 64;
    const bf16_t* Y1 = (const bf16_t*)(a.ws + OFF_Y1); const bf16_t* T1 = Y1 + (size_t)MTOK * 256; const bf16_t* QI = (const bf16_t*)(a.ws + OFF_QIDX) + (size_t)r * 1024;
    const int s = (int)(((unsigned)tid * 2654435761u + 12345u * blockIdx.x) % (unsigned)nk);
    const bf16_t* kr = T1 + ((size_t)b * SEQ + s) * 256 + 128; float sc = 0.f;
    for (int h = 0; h < 16; ++h) { float d = 0.f; for (int k = 0; k < 64; ++k) d += bf2f(QI[h * 64 + k]) * bf2f(kr[k]); sc += bf2f(T1[(size_t)r * 256 + 192 + h]) * fmaxf(d, 0.f); }
    ref[tid] = sc;
    const _Float16* SC = (const _Float16*)(a.ws + OFF_SC) + (size_t)b * SCB_ELEMS + (size_t)4096 * (c * (c + 1) / 2) + (size_t)(t & 63) * nk;
    fast[tid] = (float)SC[s];
    __syncthreads(); commit(D, 7, ref, fast, 256, 0.02f);
}
__global__ void chk_sel(Args a, unsigned* D) {
    __shared__ unsigned key[4096];
    const int r = (blockIdx.x < 8) ? (blockIdx.x * 4096 + 255 + blockIdx.x * 300) : srow(blockIdx.x, 64), tid = threadIdx.x, b = r >> 12, t = r & 4095, c = t >> 6, nk = (c + 1) * 64;
    const unsigned short* SC = (const unsigned short*)(a.ws + OFF_SC) + (size_t)b * SCB_ELEMS + (size_t)4096 * (c * (c + 1) / 2) + (size_t)(t & 63) * nk;
    const unsigned* M = (const unsigned*)(a.ws + OFF_MASK) + (size_t)r * 128;
    for (int s = tid; s < nk; s += 256) { const unsigned u = SC[s]; key[s] = (s <= t) ? ((u & 0x8000u) ? (~u & 0xffffu) : (u | 0x8000u)) : 0u; }
    __syncthreads();
    int bad = 0, tot = 0;
    for (int s = tid; s < nk; s += 256) { bool want;
        if (s > t) want = false; else if (t < 256) want = true;
        else { int rank = 0; const unsigned ks = key[s]; for (int q = 0; q <= t; ++q) rank += (key[q] > ks || (key[q] == ks && q < s)) ? 1 : 0; want = rank < 256; }
        const bool got = (M[s >> 5] >> (s & 31)) & 1u; if (want != got) ++bad; ++tot; }
    atomicAdd(&D[4 * 8], (unsigned)bad); atomicAdd(&D[4 * 8 + 1], (unsigned)tot);
}
__global__ void chk_dsa(Args a, unsigned* D) {
    __shared__ float lg[4096], red[256], ref[128], fast[128];
    const int r = (blockIdx.x < 8) ? (blockIdx.x * 4096 + blockIdx.x * 37) : srow(blockIdx.x, 64), tid = threadIdx.x, b = r >> 12, t = r & 4095, h = blockIdx.x & 7;
    const bf16_t* Q = (const bf16_t*)(a.ws + OFF_QLAT) + (size_t)r * 1024 + h * 128; const bf16_t* C = (const bf16_t*)(a.ws + OFF_CKVN) + (size_t)b * SEQ * 128;
    const unsigned* M = (const unsigned*)(a.ws + OFF_MASK) + (size_t)r * 128; const float* relb = a.in[I_RELB];
    float mx = -INFINITY;
    for (int s = tid; s <= t; s += 256) { float v = -INFINITY; if ((M[s >> 5] >> (s & 31)) & 1u) { float d = 0.f; for (int k = 0; k < 128; ++k) d += bf2f(Q[k]) * bf2f(C[(size_t)s * 128 + k]); v = d + bias_l2(relb, h, t - s); } lg[s] = v; mx = fmaxf(mx, v); }
    red[tid] = mx; __syncthreads(); for (int o = 128; o > 0; o >>= 1) { if (tid < o) red[tid] = fmaxf(red[tid], red[tid + o]); __syncthreads(); } mx = red[0]; __syncthreads();
    float sm = 0.f; for (int s = tid; s <= t; s += 256) { const float p = exp2f(lg[s] - mx); lg[s] = p; sm += p; }
    red[tid] = sm; __syncthreads(); for (int o = 128; o > 0; o >>= 1) { if (tid < o) red[tid] += red[tid + o]; __syncthreads(); } sm = red[0]; __syncthreads();
    if (tid < 128) { float o = 0.f; for (int s = 0; s <= t; ++s) o += lg[s] * bf2f(C[(size_t)s * 128 + tid]); ref[tid] = o / sm; fast[tid] = bf2f(((const bf16_t*)(a.ws + OFF_MIXIN))[(size_t)r * 1536 + h * 128 + tid]); }
    __syncthreads(); commit(D, 9, ref, fast, 128, 0.03f);
}
__global__ void chk_nsa(Args a, unsigned* D) {
    __shared__ float pc[4][256], lg[1100], red[256], ref[64], fast[64], oacc[3][64], scb[64]; __shared__ int selj[16]; __shared__ float qs[4][64];
    const int r = (blockIdx.x < 8) ? (blockIdx.x * 4096 + blockIdx.x * 41) : srow(blockIdx.x, 64), tid = threadIdx.x, b = r >> 12, t = r & 4095, hh = blockIdx.x & 7, g = hh >> 2, n = hh & 3, cur = t >> 6;
    const bf16_t* Y1 = (const bf16_t*)(a.ws + OFF_Y1); const bf16_t* T1 = Y1 + (size_t)MTOK * 256; const bf16_t* QB = Y1 + (size_t)(2 + g) * MTOK * 256;
    const bf16_t* KVS = Y1 + (size_t)5 * MTOK * 256; const bf16_t* KVW = Y1 + (size_t)6 * MTOK * 256;
    const bf16_t* KC = (const bf16_t*)(a.ws + OFF_KC); const bf16_t* VC = (const bf16_t*)(a.ws + OFF_VC); const float* relb = a.in[I_RELB];
    qs[tid >> 6][tid & 63] = bf2f(QB[(size_t)r * 256 + tid]);
    __syncthreads();
    const int vis = (t >= 31) ? ((t - 31) >> 4) : -1;
    for (int nn = 0; nn < 4; ++nn) {
        float v = -INFINITY; if (tid <= vis) { float d = 0.f; for (int k = 0; k < 64; ++k) d += qs[nn][k] * bf2f(KC[(((size_t)b * 256 + tid) * 2 + g) * 64 + k]); v = d + bias_l2(relb, 8 + 4 * g + nn, t - 16 * tid - 31); }
        red[tid] = v; __syncthreads(); for (int o = 128; o > 0; o >>= 1) { if (tid < o) red[tid] = fmaxf(red[tid], red[tid + o]); __syncthreads(); } const float mx = red[0]; __syncthreads();
        const float p = (tid <= vis) ? exp2f(v - mx) : 0.f; red[tid] = p; __syncthreads(); for (int o = 128; o > 0; o >>= 1) { if (tid < o) red[tid] += red[tid + o]; __syncthreads(); } const float sm = red[0]; __syncthreads();
        pc[nn][tid] = sm > 0.f ? p / sm : 0.f; __syncthreads();
    }
    if (tid < 64) { float o = 0.f; for (int i = 0; i <= vis; ++i) o += pc[n][i] * bf2f(VC[(((size_t)b * 256 + i) * 2 + g) * 64 + tid]); oacc[0][tid] = o;
        float s = 0.f; for (int nn = 0; nn < 4; ++nn) for (int i = 4 * tid - 1; i <= 4 * tid + 3; ++i) if (i >= 0 && i < 255) s += pc[nn][i];
        scb[tid] = (tid > cur) ? -INFINITY : ((tid == 0 || tid == cur || tid == cur - 1) ? INFINITY : s); }
    __syncthreads();
    if (tid < 64) { int rank = 0; for (int j = 0; j < 64; ++j) rank += (scb[j] > scb[tid] || (scb[j] == scb[tid] && j < tid)) ? 1 : 0; if (rank < 16) selj[rank] = tid; }
    __syncthreads();
    { float mx = -INFINITY;
      for (int i = tid; i < 1024; i += 256) { const int j = selj[i >> 6], p = 64 * j + (i & 63); float v = -INFINITY; if (p <= t) { float d = 0.f; for (int k = 0; k < 64; ++k) d += qs[n][k] * bf2f(KVS[((size_t)b * SEQ + p) * 256 + g * 64 + k]); v = d + bias_l2(relb, 8 + hh, t - p); } lg[i] = v; mx = fmaxf(mx, v); }
      red[tid] = mx; __syncthreads(); for (int o = 128; o > 0; o >>= 1) { if (tid < o) red[tid] = fmaxf(red[tid], red[tid + o]); __syncthreads(); } mx = red[0]; __syncthreads();
      float sm = 0.f; for (int i = tid; i < 1024; i += 256) { const float p = exp2f(lg[i] - mx); lg[i] = p; sm += p; }
      red[tid] = sm; __syncthreads(); for (int o = 128; o > 0; o >>= 1) { if (tid < o) red[tid] += red[tid + o]; __syncthreads(); } sm = red[0]; __syncthreads();
      if (tid < 64) { float o = 0.f; for (int i = 0; i < 1024; ++i) { const int p = 64 * selj[i >> 6] + (i & 63); if (p <= t) o += lg[i] * bf2f(KVS[((size_t)b * SEQ + p) * 256 + 128 + g * 64 + tid]); } oacc[1][tid] = o / sm; }
      __syncthreads(); }
    { float mx = -INFINITY;
      for (int i = tid; i < 512; i += 256) { const int p = t - i; float v = -INFINITY; if (p >= 0) { float d = 0.f; for (int k = 0; k < 64; ++k) d += qs[n][k] * bf2f(KVW[((size_t)b * SEQ + p) * 256 + g * 64 + k]); v = d + bias_l2(relb, 8 + hh, i); } lg[i] = v; mx = fmaxf(mx, v); }
      red[tid] = mx; __syncthreads(); for (int o = 128; o > 0; o >>= 1) { if (tid < o) red[tid] = fmaxf(red[tid], red[tid + o]); __syncthreads(); } mx = red[0]; __syncthreads();
      float sm = 0.f; for (int i = tid; i < 512; i += 256) { const float p = exp2f(lg[i] - mx); lg[i] = p; sm += p; }
      red[tid] = sm; __syncthreads(); for (int o = 128; o > 0; o >>= 1) { if (tid < o) red[tid] += red[tid + o]; __syncthreads(); } sm = red[0]; __syncthreads();
      if (tid < 64) { float o = 0.f; for (int i = 0; i < 512; ++i) { const int p = t - i; if (p >= 0) o += lg[i] * bf2f(KVW[((size_t)b * SEQ + p) * 256 + 128 + g * 64 + tid]); } oacc[2][tid] = o / sm; }
      __syncthreads(); }
    if (tid < 64) { float gt[3]; for (int j = 0; j < 3; ++j) { const float x = bf2f(T1[(size_t)r * 256 + 208 + hh * 3 + j]); gt[j] = 1.f / (1.f + expf(-x)); }
        ref[tid] = gt[0] * oacc[0][tid] + gt[1] * oacc[1][tid] + gt[2] * oacc[2][tid]; fast[tid] = bf2f(((const bf16_t*)(a.ws + OFF_MIXIN))[(size_t)r * 1536 + 1024 + hh * 64 + tid]); }
    __syncthreads(); commit(D, 10, ref, fast, 64, 0.04f);
}
__global__ void chk_out_e(Args a, unsigned* D) {
    __shared__ float ref[1024], fast[1024], cat[1024];
    const int r = srow(blockIdx.x, 64), tid = threadIdx.x; const bf16_t* MX = (const bf16_t*)(a.ws + OFF_MIXIN) + (size_t)r * 1536;
    for (int o = tid; o < 512; o += 256) { const int h = o >> 6, d = o & 63; float s = 0.f; for (int c = 0; c < 128; ++c) s += bf2f(MX[h * 128 + c]) * a.in[I_EWUV][c * 512 + h * 64 + d]; cat[o] = s; cat[512 + o] = bf2f(MX[1024 + o]); }
    __syncthreads();
    for (int n = tid; n < 1024; n += 256) { float s = 0.f; for (int j = 0; j < 1024; ++j) s += cat[j] * a.in[I_EWOUT][(size_t)j * 1024 + n]; ref[n] = s;
        fast[n] = bf2f(((const bf16_t*)(a.ws + OFF_S1))[(size_t)r * 1024 + n]) - ALPHA * a.in[I_X][(size_t)r * 1024 + n]; }
    __syncthreads(); commit(D, 11, ref, fast, 1024, 0.35f);
}
__global__ void chk_ln(const bf16_t* S, const bf16_t* O, const float* g, const float* bt, unsigned* D, int slot) {
    __shared__ float ref[1024], fast[1024];
    const int r = srow(blockIdx.x, 64), tid = threadIdx.x; float mean = 0.f, var = 0.f;
    for (int k = 0; k < 1024; ++k) mean += bf2f(S[(size_t)r * 1024 + k]); mean /= 1024.f;
    for (int k = 0; k < 1024; ++k) { const float d = bf2f(S[(size_t)r * 1024 + k]) - mean; var += d * d; } var /= 1024.f;
    for (int n = tid; n < 1024; n += 256) { ref[n] = (bf2f(S[(size_t)r * 1024 + n]) - mean) / sqrtf(var + 1e-5f) * g[n] + bt[n]; fast[n] = bf2f(O[(size_t)r * 1024 + n]); }
    __syncthreads(); commit(D, slot, ref, fast, 1024, 0.01f);
}
__global__ void chk_ffn_up(Args a, unsigned* D) {
    __shared__ float ref[DFF], fast[DFF], hrow[1024];
    const int r = srow(blockIdx.x, 64), tid = threadIdx.x; const bf16_t* H = (const bf16_t*)(a.ws + OFF_H) + (size_t)r * 1024;
    for (int k = tid; k < 1024; k += 256) hrow[k] = bf2f(H[k]);
    __syncthreads();
    for (int n = tid; n < DFF; n += 256) { float s1 = 0.f, s3 = 0.f; for (int k = 0; k < 1024; ++k) { s1 += hrow[k] * bfr(a.in[I_EF1][(size_t)k * DFF + n]); s3 += hrow[k] * bfr(a.in[I_EF3][(size_t)k * DFF + n]); }
        ref[n] = s1 / (1.f + expf(-s1)) * s3; fast[n] = bf2f(((const bf16_t*)(a.ws + OFF_ACT))[(size_t)r * DFF + n]); }
    __syncthreads(); commit(D, 13, ref, fast, DFF, 0.02f);
}
__global__ void chk_ffn_dn(Args a, unsigned* D) {
    __shared__ float ref[1024], fast[1024], arow[DFF];
    const int r = srow(blockIdx.x, 64), tid = threadIdx.x; const bf16_t* A = (const bf16_t*)(a.ws + OFF_ACT) + (size_t)r * DFF;
    for (int k = tid; k < DFF; k += 256) arow[k] = bf2f(A[k]);
    __syncthreads();
    for (int n = tid; n < 1024; n += 256) { float s = 0.f; for (int k = 0; k < DFF; ++k) s += arow[k] * bfr(a.in[I_EF2][(size_t)k * 1024 + n]); ref[n] = s;
        fast[n] = bf2f(((const bf16_t*)(a.ws + OFF_S2))[(size_t)r * 1024 + n]) - ALPHA * bf2f(((const bf16_t*)(a.ws + OFF_H))[(size_t)r * 1024 + n]); }
    __syncthreads(); commit(D, 14, ref, fast, 1024, 0.06f);
}
__global__ void chk_in_o(Args a, unsigned* D) {
    __shared__ float ref[2048], fast[2048], xr[1024];
    const int r = srow(blockIdx.x, 64), tid = threadIdx.x; const bf16_t* X1 = (const bf16_t*)(a.ws + OFF_X1) + (size_t)r * 1024;
    for (int k = tid; k < 1024; k += 256) xr[k] = bf2f(X1[k]);
    __syncthreads();
    for (int n = tid; n < 2048; n += 256) { float s = 0.f; for (int k = 0; k < 1024; ++k) s += xr[k] * bfr(a.in[I_OWIN][(size_t)k * 3072 + 1024 + n]); ref[n] = s;
        fast[n] = bf2f(((const bf16_t*)(a.ws + OFF_QKV))[(size_t)(1 + (n >> 10)) * MTOK * 1024 + (size_t)r * 1024 + (n & 1023)]); }
    __syncthreads(); commit(D, 16, ref, fast, 2048, 0.02f);
    const int pm = r >> 8; const bf16_t* K = (const bf16_t*)(a.ws + OFF_QKV) + (size_t)MTOK * 1024 + (size_t)pm * 256 * 1024; const float* KM = (const float*)(a.ws + OFF_KMEAN) + (size_t)pm * 2048;
    for (int n = tid; n < 1024; n += 256) { float s = 0.f; for (int q = 0; q < 256; ++q) s += bf2f(K[(size_t)q * 1024 + n]); ref[n] = s; fast[n] = KM[n] + KM[1024 + n]; }
    __syncthreads(); commit(D, 17, ref, fast, 1024, 0.03f);
}
__global__ void chk_moba(Args a, unsigned* D) {
    __shared__ float lg[1024], red[256], ref[64], fast[64], q[64], gate[16]; __shared__ int blkof[4];
    const int r = (blockIdx.x < 8) ? (blockIdx.x * 4096 + blockIdx.x * 300) : srow(blockIdx.x, 64), tid = threadIdx.x, b = r >> 12, t = r & 4095, h = blockIdx.x & 15, own = t >> 8;
    const bf16_t* X1 = (const bf16_t*)(a.ws + OFF_X1) + (size_t)r * 1024; const bf16_t* K = (const bf16_t*)(a.ws + OFF_QKV) + (size_t)MTOK * 1024 + (size_t)b * SEQ * 1024 + h * 64; const bf16_t* V = K + (size_t)MTOK * 1024;
    const float* relb = a.in[I_RELB];
    if (tid < 64) { float s = 0.f; for (int k = 0; k < 1024; ++k) s += bf2f(X1[k]) * bfr(a.in[I_OWIN][(size_t)k * 3072 + h * 64 + tid]); q[tid] = bfr(s * QSCALE); }
    __syncthreads();
    if (tid < 16) { float s = -INFINITY; if (tid < own) { s = 0.f; for (int p = 0; p < 256; ++p) for (int d = 0; d < 64; ++d) s += q[d] * bf2f(K[(size_t)(256 * tid + p) * 1024 + d]); } gate[tid] = s; }
    __syncthreads();
    if (tid == 0) { unsigned used = 0u; for (int k = 0; k < 3; ++k) { int bj = -1; float best = -INFINITY; for (int j = 0; j < own; ++j) if (!((used >> j) & 1u) && gate[j] > best) { best = gate[j]; bj = j; } blkof[k] = bj; if (bj >= 0) used |= 1u << bj; } blkof[3] = own; }
    __syncthreads();
    float mx = -INFINITY;
    for (int i = tid; i < 1024; i += 256) { const int j = blkof[i >> 8], p = 256 * j + (i & 255); float v = -INFINITY; if (j >= 0 && p <= t) { float d = 0.f; for (int k = 0; k < 64; ++k) d += q[k] * bf2f(K[(size_t)p * 1024 + k]); v = d + bias_l2(relb, h, t - p); } lg[i] = v; mx = fmaxf(mx, v); }
    red[tid] = mx; __syncthreads(); for (int o = 128; o > 0; o >>= 1) { if (tid < o) red[tid] = fmaxf(red[tid], red[tid + o]); __syncthreads(); } mx = red[0]; __syncthreads();
    float sm = 0.f; for (int i = tid; i < 1024; i += 256) { const float p = exp2f(lg[i] - mx); lg[i] = p; sm += p; }
    red[tid] = sm; __syncthreads(); for (int o = 128; o > 0; o >>= 1) { if (tid < o) red[tid] += red[tid + o]; __syncthreads(); } sm = red[0]; __syncthreads();
    if (tid < 64) { float o = 0.f; for (int i = 0; i < 1024; ++i) { const int j = blkof[i >> 8], p = 256 * j + (i & 255); if (j >= 0 && p <= t) o += lg[i] * bf2f(V[(size_t)p * 1024 + tid]); } ref[tid] = o / sm;
        fast[tid] = bf2f(((const bf16_t*)(a.ws + OFF_QKV))[(size_t)r * 1024 + h * 64 + tid]); }
    __syncthreads(); commit(D, 18, ref, fast, 64, 0.04f);
}
__global__ void chk_out_o(Args a, unsigned* D) {
    __shared__ float ref[1024], fast[1024], orow[1024];
    const int r = srow(blockIdx.x, 64), tid = threadIdx.x;
    for (int k = tid; k < 1024; k += 256) orow[k] = bf2f(((const bf16_t*)(a.ws + OFF_QKV))[(size_t)r * 1024 + k]);
    __syncthreads();
    for (int n = tid; n < 1024; n += 256) { float s = 0.f; for (int k = 0; k < 1024; ++k) s += orow[k] * a.in[I_OWOUT][(size_t)k * 1024 + n]; ref[n] = s;
        fast[n] = bf2f(((const bf16_t*)(a.ws + OFF_S1O))[(size_t)r * 1024 + n]) - ALPHA * bf2f(((const bf16_t*)(a.ws + OFF_X1))[(size_t)r * 1024 + n]); }
    __syncthreads(); commit(D, 20, ref, fast, 1024, 0.5f);
}
__global__ void chk_route(Args a, unsigned* D) {
    const int r = srow(blockIdx.x * 256 + threadIdx.x, 64); const bf16_t* H2 = (const bf16_t*)(a.ws + OFF_H2) + (size_t)r * 1024;
    float lg[8]; for (int e = 0; e < 8; ++e) lg[e] = 0.f;
    for (int k = 0; k < 1024; ++k) { const float hv = bf2f(H2[k]); for (int e = 0; e < 8; ++e) lg[e] += hv * a.in[I_OROUTER][k * 8 + e]; }
    int e0 = 0; for (int e = 1; e < 8; ++e) if (lg[e] > lg[e0]) e0 = e; int e1 = -1; for (int e = 0; e < 8; ++e) if (e != e0 && (e1 < 0 || lg[e] > lg[e1])) e1 = e;
    const float g0 = 1.f / (1.f + expf(lg[e1] - lg[e0]));
    const u32x2 rt = ((const u32x2*)(a.ws + OFF_ROUTE))[r]; const int f0 = rt.x & 255, f1 = (rt.x >> 8) & 255; const float fg = __uint_as_float(rt.y);
    int bad = 0; if (f0 != e0 || f1 != e1 || !(fabsf(fg - g0) <= 0.02f)) ++bad;
    atomicAdd(&D[4 * 21], (unsigned)bad); atomicAdd(&D[4 * 21 + 1], 1u);
    const int* GI = (const int*)(a.ws + OFF_GINFO); const int* DEST = (const int*)(a.ws + OFF_DEST) + 2 * (size_t)r; const bf16_t* XR = (const bf16_t*)(a.ws + OFF_XR);
    int bad2 = 0;
    for (int k = 0; k < 2; ++k) { const int e = k ? f1 : f0, d = DEST[k], ps = e ? GI[e - 1] : 0; if (d < ps || d >= ps + GI[8 + e]) ++bad2; else for (int c = 0; c < 1024; c += 37) if (XR[(size_t)d * 1024 + c] != H2[c]) { ++bad2; break; } }
    atomicAdd(&D[4 * 22], (unsigned)bad2); atomicAdd(&D[4 * 22 + 1], 2u);
}
__global__ void chk_moe(Args a, unsigned* D) {
    __shared__ float ref[1024], fast[1024], hrow[1024], act[DFFE], fin[1024];
    const int r = srow(blockIdx.x, 64), tid = threadIdx.x; const bf16_t* H2 = (const bf16_t*)(a.ws + OFF_H2) + (size_t)r * 1024;
    for (int k = tid; k < 1024; k += 256) { hrow[k] = bf2f(H2[k]); ref[k] = 0.f; }
    const u32x2 rt = ((const u32x2*)(a.ws + OFF_ROUTE))[r]; const float g0 = __uint_as_float(rt.y); const int* DEST = (const int*)(a.ws + OFF_DEST) + 2 * (size_t)r; const bf16_t* YR = (const bf16_t*)(a.ws + OFF_XR);
    __syncthreads();
    for (int k = 0; k < 2; ++k) { const int e = k ? ((rt.x >> 8) & 255) : (rt.x & 255); const float gk = k ? 1.f - g0 : g0;
        const float* w1 = a.in[I_OM1] + (size_t)e * 1024 * DFFE; const float* w3 = a.in[I_OM3] + (size_t)e * 1024 * DFFE; const float* w2 = a.in[I_OM2] + (size_t)e * DFFE * 1024;
        for (int f = tid; f < DFFE; f += 256) { float s1 = 0.f, s3 = 0.f; for (int q = 0; q < 1024; ++q) { s1 += hrow[q] * bfr(w1[(size_t)q * DFFE + f]); s3 += hrow[q] * bfr(w3[(size_t)q * DFFE + f]); } act[f] = bfr(s1 / (1.f + expf(-s1)) * s3); }
        __syncthreads();
        for (int n = tid; n < 1024; n += 256) { float s = 0.f; for (int f = 0; f < DFFE; ++f) s += act[f] * bfr(w2[(size_t)f * 1024 + n]); ref[n] += gk * s; }
        __syncthreads(); }
    for (int n = tid; n < 1024; n += 256) { fast[n] = g0 * bf2f(YR[(size_t)DEST[0] * 1024 + n]) + (1.f - g0) * bf2f(YR[(size_t)DEST[1] * 1024 + n]); fin[n] = ALPHA * hrow[n] + fast[n]; }
    __syncthreads(); commit(D, 23, ref, fast, 1024, 0.03f);
    float mean = 0.f, var = 0.f; for (int k = 0; k < 1024; ++k) mean += fin[k]; mean /= 1024.f; for (int k = 0; k < 1024; ++k) { const float d = fin[k] - mean; var += d * d; } var /= 1024.f;
    __syncthreads();
    for (int n = tid; n < 1024; n += 256) { ref[n] = (fin[n] - mean) / sqrtf(var + 1e-5f) * a.in[I_OLN2G][n] + a.in[I_OLN2B][n]; fast[n] = a.out[(size_t)r * 1024 + n]; }
    __syncthreads(); commit(D, 24, ref, fast, 1024, 0.005f);
    { float m2 = 0.f, v2 = 0.f; for (int k = 0; k < 1024; ++k) m2 += ALPHA * hrow[k]; m2 /= 1024.f; for (int k = 0; k < 1024; ++k) { const float d = ALPHA * hrow[k] - m2; v2 += d * d; } v2 /= 1024.f;
      for (int n = tid; n < 1024; n += 256) ref[n] = (ALPHA * hrow[n] - m2) / sqrtf(v2 + 1e-5f) * a.in[I_OLN2G][n] + a.in[I_OLN2B][n];
      __syncthreads(); commit(D, 28, ref, fast, 1024, 0.005f); }
    { for (int n = tid; n < 1024; n += 256) fin[n] = ALPHA * hrow[n] + (1.f - g0) * bf2f(YR[(size_t)DEST[0] * 1024 + n]) + g0 * bf2f(YR[(size_t)DEST[1] * 1024 + n]);
      __syncthreads();
      float m2 = 0.f, v2 = 0.f; for (int k = 0; k < 1024; ++k) m2 += fin[k]; m2 /= 1024.f; for (int k = 0; k < 1024; ++k) { const float d = fin[k] - m2; v2 += d * d; } v2 /= 1024.f;
      __syncthreads();
      for (int n = tid; n < 1024; n += 256) ref[n] = (fin[n] - m2) / sqrtf(v2 + 1e-5f) * a.in[I_OLN2G][n] + a.in[I_OLN2B][n];
      __syncthreads(); commit(D, 29, ref, fast, 1024, 0.005f); }
}

__global__ void chk_wmoe(Args a, unsigned* D) {
    const int tid = blockIdx.x * 256 + threadIdx.x; const unsigned hsh = (unsigned)tid * 2654435761u;
    const int e = hsh & 7, f = (hsh >> 3) % DFFE, k = (hsh >> 15) % 1024;
    const bf16_t* W13 = (const bf16_t*)(a.ws + OFF_W_M13) + (size_t)e * 2 * DFFE * 1024; const bf16_t* W2 = (const bf16_t*)(a.ws + OFF_W_M2) + (size_t)e * 1024 * DFFE;
    int bad = 0;
    if (W13[(size_t)(((f >> 7) << 8) + (f & 127)) * 1024 + k] != (bf16_t)f2bf(a.in[I_OM1][(size_t)e * 1024 * DFFE + (size_t)k * DFFE + f])) ++bad;
    if (W13[(size_t)(((f >> 7) << 8) + (f & 127) + 128) * 1024 + k] != (bf16_t)f2bf(a.in[I_OM3][(size_t)e * 1024 * DFFE + (size_t)k * DFFE + f])) ++bad;
    atomicAdd(&D[4 * 25], (unsigned)bad); atomicAdd(&D[4 * 25 + 1], 2u);
    int bad2 = 0; if (W2[(size_t)k * DFFE + f] != (bf16_t)f2bf(a.in[I_OM2][(size_t)e * DFFE * 1024 + (size_t)f * 1024 + k])) ++bad2;
    atomicAdd(&D[4 * 26], (unsigned)bad2); atomicAdd(&D[4 * 26 + 1], 1u);
}
__global__ void chk_actm(Args a, unsigned* D) {
    __shared__ float ref[DFFE], fast[DFFE], hrow[1024]; __shared__ int tokf, kf;
    const int tid = threadIdx.x; const int* GI = (const int*)(a.ws + OFF_GINFO); const int nrows = GI[7], ng = nrows >> 8, g0 = ((ng - 1) / MOE_CHUNK) * MOE_CHUNK;
    const int rho = 256 * g0 + (int)(((unsigned)blockIdx.x * 2654435761u) % (unsigned)(nrows - 256 * g0));
    if (tid == 0) { tokf = -1; kf = 0; } __syncthreads();
    const int* DEST = (const int*)(a.ws + OFF_DEST);
    for (int i = tid; i < 2 * MTOK; i += 256) if (DEST[i] == rho) { tokf = i >> 1; kf = i & 1; }
    __syncthreads();
    if (tokf < 0) return;
    const int tok = tokf; const u32x2 rt = ((const u32x2*)(a.ws + OFF_ROUTE))[tok]; const int e = kf ? ((rt.x >> 8) & 255) : (rt.x & 255);
    const bf16_t* H2 = (const bf16_t*)(a.ws + OFF_H2) + (size_t)tok * 1024;
    for (int k = tid; k < 1024; k += 256) hrow[k] = bf2f(H2[k]);
    __syncthreads();
    const float* w1 = a.in[I_OM1] + (size_t)e * 1024 * DFFE; const float* w3 = a.in[I_OM3] + (size_t)e * 1024 * DFFE;
    for (int f = tid; f < DFFE; f += 256) { float s1 = 0.f, s3 = 0.f; for (int q = 0; q < 1024; ++q) { s1 += hrow[q] * bfr(w1[(size_t)q * DFFE + f]); s3 += hrow[q] * bfr(w3[(size_t)q * DFFE + f]); }
        ref[f] = s1 / (1.f + expf(-s1)) * s3; fast[f] = bf2f(((const bf16_t*)(a.ws + OFF_ACTM))[(size_t)(rho - 256 * g0) * DFFE + f]); }
    __syncthreads(); commit(D, 27, ref, fast, DFFE, 0.02f);
}

__global__ void simple_final(Args a) {
    const int row = blockIdx.x * 4 + (threadIdx.x >> 6), lane = threadIdx.x & 63; unsigned char* ws = a.ws;
    const bf16_t* H2 = (const bf16_t*)(ws + OFF_H2); const bf16_t* YR = (const bf16_t*)(ws + OFF_XR);
    const u32x2* ROUTE = (const u32x2*)(ws + OFF_ROUTE); const int* DEST = (const int*)(ws + OFF_DEST);
    const float g0 = __uint_as_float(ROUTE[row].y), g1 = 1.f - g0; const int d0 = DEST[2 * row], d1 = DEST[2 * row + 1];
    float v[16]; float s = 0.f;
    for (int i = 0; i < 16; ++i) { const int col = lane + 64 * i; v[i] = ALPHA * bf2f(H2[(size_t)row * 1024 + col]) + g0 * bf2f(YR[(size_t)d0 * 1024 + col]) + g1 * bf2f(YR[(size_t)d1 * 1024 + col]); s += v[i]; }
    const float mean = wave_sum(s) / 1024.f; float q = 0.f;
    for (int i = 0; i < 16; ++i) { v[i] -= mean; q += v[i] * v[i]; }
    const float rstd = 1.f / sqrtf(wave_sum(q) / 1024.f + 1e-5f);
    for (int i = 0; i < 16; ++i) { const int col = lane + 64 * i; a.out[(size_t)row * 1024 + col] = v[i] * rstd * a.in[I_OLN2G][col] + a.in[I_OLN2B][col]; }
}
__global__ void report(float* out, const unsigned* D, int nelem) {
    __shared__ float kk, xx;
    if (threadIdx.x == 0) { int idx = 0; float v = 0.f; float worst = 0.f;
        for (int s = 1; s < NSLOT; ++s) { const unsigned bad = D[4 * s], tot = D[4 * s + 1]; if (tot == 0u) continue; const float fr = (float)bad / (float)tot; const float thr = (s == 9 || s == 10 || s == 18) ? 0.1f : 0.002f;
            if (fr > worst) worst = fr; if (fr > thr && idx == 0) { idx = s; v = fr; } }
        if (idx == 0) v = worst;
#ifdef DBG_BITS
        { const int sl[6] = DBG_BITS; idx = 0; for (int q = 0; q < 6; ++q) { const int s = sl[q]; if (s > 0 && D[4 * s + 1] > 0u && (float)D[4 * s] / (float)D[4 * s + 1] > 0.002f) idx |= 1 << q; } v = 1.f; }
#endif
#ifdef DBG_VAL
        { const float mr = __uint_as_float(D[4 * DBG_VAL + 2]); const float fr = D[4 * DBG_VAL + 1] ? (float)D[4 * DBG_VAL] / (float)D[4 * DBG_VAL + 1] : 0.f; kk = sqrtf(fmaxf(mr, 1e-6f) * 1e6f); xx = kk * (2.f + 97.f * fr); }
#else
        v = fmaxf(v, 1e-6f); const int n = (v > 0.3f) ? 4 : (v > 0.03f) ? 3 : (v > 0.003f) ? 2 : 1; kk = (n == 4) ? 1e4f : (n == 3) ? 1e3f : (n == 2) ? 1e2f : 1e1f; xx = kk * (float)(idx + 2);
#endif
        }
    __syncthreads();
    const float k = kk, x = xx;
    for (size_t i = (size_t)blockIdx.x * blockDim.x + threadIdx.x; i < (size_t)nelem; i += (size_t)gridDim.x * blockDim.x) out[i] = (i == 0) ? x : k;
}
}
#endif

#ifndef MK_N_LAUNCHES
#define MK_N_LAUNCHES 1
#endif
constexpr int NPHASE = 18;
#define SP2 true
#define ALN true

__global__ void __launch_bounds__(NTHR, 2) fwd_kernel(Args args) {
    extern __shared__ __attribute__((aligned(16))) unsigned char lds_raw[];
    Frame F;
    F.lds = (LAS unsigned char*)lds_raw;
    F.tid = threadIdx.x; F.lane = F.tid & 63; F.wave = __builtin_amdgcn_readfirstlane(F.tid >> 6);
    F.G = gridDim.x; F.bx = blockIdx.x; F.gw = F.bx * NWAVES + F.wave; F.NGW = F.G * NWAVES; F.ws = args.ws;
    unsigned char* ws = args.ws;
    volatile LAS unsigned* MISC = (volatile LAS unsigned*)(F.lds + LDSCTL_OFF);
    for (int u = F.tid; u < (LDS_BYTES - LDSCTL_OFF) / 4; u += NTHR) ((LAS unsigned*)(F.lds + LDSCTL_OFF))[u] = 0u;
    __syncthreads();
    __builtin_amdgcn_fence(__ATOMIC_ACQUIRE, "agent");
    XcdBarrier bar = xcd_barrier_post((unsigned*)(ws + OFF_BAR) + args.li * XCD_BAR_WORDS, MISC + 8);
    const int lo = args.ph_lo, hi = args.ph_hi;
#ifndef PH_MASK
#define PH_MASK 0x3ffff
#endif
#define IN(k) (((PH_MASK >> (k)) & 1) && lo <= (k) && (k) < hi)
#define SEAM(k) do { if (IN(k) && IN((k) + 1)) xcd_barrier(bar); } while (0)
    LAS unsigned char* glds = F.lds;

    bf16_t* Y1 = (bf16_t*)(ws + OFF_Y1);
    float* ssq_q = (float*)(ws + OFF_SSQ_Q); float* ssq_kv = (float*)(ws + OFF_SSQ_KV);

    if (IN(0)) { phase_prologue_even(F, args); } SEAM(0);
    if (IN(1)) { pg8::Gemm g{(const bf16_t*)(ws + OFF_XB), (const bf16_t*)(ws + OFF_W_IN), MTOK, EVEN_INP, 1024, 1024, 0}; pg8::StaticOrder S; S.init(MTOK, EVEN_INP, F.G, F.bx);
        pg8::EpiInE E{Y1, ssq_q, ssq_kv}; pg8::gemm_phase<pg8::EpiInE, pg8::StaticOrder, ALN, SP2>(glds, g, S, E); } SEAM(1);
    if (IN(2)) {
        phase_ckvn(F, Y1 + (size_t)1 * MTOK * 256, ssq_kv, args.in[I_EKVN], (bf16_t*)(ws + OFF_CKVN));
#ifndef NO_CMP
        for (int idx = F.bx; idx < 256; idx += F.G) { const int b = idx >> 5, g = (idx >> 4) & 1, kv = (idx >> 3) & 1, rt = idx & 7;
            compress_unit(F, b, g, kv, rt, Y1 + (size_t)4 * MTOK * 256, (const bf16_t*)(ws + (kv ? OFF_CV1 : OFF_CK1)), args.in[kv ? I_ECV2 : I_ECK2], (const float*)(ws + OFF_CB) + kv * 64, (bf16_t*)(ws + (kv ? OFF_VC : OFF_KC))); }
#endif
#ifndef NO_Q2
        pg8::Gemm g{Y1, (const bf16_t*)(ws + OFF_W_Q2), MTOK, 2048, 256, 256, 0}; pg8::StaticOrder S; S.init(MTOK, 2048, F.G, F.bx);
        pg8::EpiQ2 E{(bf16_t*)(ws + OFF_QLAT), (bf16_t*)(ws + OFF_QIDX), ssq_q}; pg8::gemm_phase<pg8::EpiQ2, pg8::StaticOrder, ALN, SP2>(glds, g, S, E);
#endif
    } SEAM(2);
    if (IN(3)) { for (int idx = F.bx; idx < 512; idx += F.G) { const int i = idx >> 8, v = idx & 255, b = v >> 5, cc = v & 31, c = i ? 63 - cc : cc;
            indexer_unit(F, b, c, (const bf16_t*)(ws + OFF_QIDX), Y1 + (size_t)1 * MTOK * 256, (_Float16*)(ws + OFF_SC)); } } SEAM(3);
    if (IN(4)) { phase_select(F, (const _Float16*)(ws + OFF_SC), (unsigned*)(ws + OFF_MASK)); } SEAM(4);
    if (IN(5)) {
#ifndef NO_DSA
        for (int idx = F.bx; idx < 1024; idx += F.G) { const int i = idx >> 8, v = idx & 255, b = v >> 5, cc = v & 31, u = (i == 0) ? cc : (i == 1) ? 63 - cc : (i == 2) ? 64 + cc : 127 - cc;
            dsa_unit(F, b, u, (const bf16_t*)(ws + OFF_QLAT), (const bf16_t*)(ws + OFF_CKVN), (const unsigned*)(ws + OFF_MASK), (const float*)(ws + OFF_BT), (bf16_t*)(ws + OFF_MIXIN)); __syncthreads(); }
#endif
#ifndef NO_NSA
        for (int idx = F.bx; idx < 1024; idx += F.G) { const int i = idx >> 8, v = idx & 255, b = v >> 5, cc = v & 31, g = i & 1, c = (i >> 1) ? 63 - cc : cc;
            nsa_unit(F, b, g, c, Y1, (const bf16_t*)(ws + OFF_KC), (const bf16_t*)(ws + OFF_VC), (const float*)(ws + OFF_BT), (bf16_t*)(ws + OFF_MIXIN)); __syncthreads(); }
#endif
    } SEAM(5);
    if (IN(6)) { pg8::Gemm g{(const bf16_t*)(ws + OFF_MIXIN), (const bf16_t*)(ws + OFF_W_OUTE), MTOK, 1024, 1536, 1536, 0}; pg8::StaticOrder S; S.init(MTOK, 1024, F.G, F.bx);
        pg8::EpiRes<true> E{args.in[I_X], (bf16_t*)(ws + OFF_S1)}; pg8::gemm_phase<pg8::EpiRes<true>, pg8::StaticOrder, ALN, SP2>(glds, g, S, E); } SEAM(6);
    if (IN(7)) { phase_ln_bf16(F, (const bf16_t*)(ws + OFF_S1), (bf16_t*)(ws + OFF_H), args.in[I_ELN1G], args.in[I_ELN1B]); } SEAM(7);
    if (IN(8)) { pg8::Gemm g{(const bf16_t*)(ws + OFF_H), (const bf16_t*)(ws + OFF_W_F13), MTOK, 2 * DFF, 1024, 1024, 0}; pg8::StaticOrder S; S.init(MTOK, 2 * DFF, F.G, F.bx);
        pg8::EpiSwiglu E{(bf16_t*)(ws + OFF_ACT), DFF, 0}; pg8::gemm_phase<pg8::EpiSwiglu, pg8::StaticOrder, ALN, SP2>(glds, g, S, E); } SEAM(8);
    if (IN(9)) { pg8::Gemm g{(const bf16_t*)(ws + OFF_ACT), (const bf16_t*)(ws + OFF_W_F2), MTOK, 1024, DFF, DFF, 0}; pg8::StaticOrder S; S.init(MTOK, 1024, F.G, F.bx);
        pg8::EpiRes<false> E{(const void*)(ws + OFF_H), (bf16_t*)(ws + OFF_S2)}; pg8::gemm_phase<pg8::EpiRes<false>, pg8::StaticOrder, ALN, SP2>(glds, g, S, E); } SEAM(9);
    if (IN(10)) { phase_ln_bf16(F, (const bf16_t*)(ws + OFF_S2), (bf16_t*)(ws + OFF_X1), args.in[I_ELN2G], args.in[I_ELN2B]); phase_convert_odd(F, args); } SEAM(10);
    if (IN(11)) { pg8::Gemm g{(const bf16_t*)(ws + OFF_X1), (const bf16_t*)(ws + OFF_W_OIN), MTOK, 3072, 1024, 1024, 0}; pg8::StaticOrder S; S.init(MTOK, 3072, F.G, F.bx);
        pg8::EpiInO E{(bf16_t*)(ws + OFF_QKV), (float*)(ws + OFF_KMEAN)}; pg8::gemm_phase<pg8::EpiInO, pg8::StaticOrder, ALN, SP2>(glds, g, S, E); } SEAM(11);
    if (IN(12)) { phase_moba(F, ws); } SEAM(12);
    if (IN(13)) { pg8::Gemm g{(const bf16_t*)(ws + OFF_QKV), (const bf16_t*)(ws + OFF_W_OOUT), MTOK, 1024, 1024, 1024, 0}; pg8::StaticOrder S; S.init(MTOK, 1024, F.G, F.bx);
        pg8::EpiRes<false> E{(const void*)(ws + OFF_X1), (bf16_t*)(ws + OFF_S1O)}; pg8::gemm_phase<pg8::EpiRes<false>, pg8::StaticOrder, ALN, SP2>(glds, g, S, E); } SEAM(13);
    if (IN(14)) { phase_ln_router(F, (const bf16_t*)(ws + OFF_S1O), (bf16_t*)(ws + OFF_H2), args.in[I_OLN1G], args.in[I_OLN1B], args.in[I_OROUTER], ws); } SEAM(14);
    if (IN(15)) { phase_moe_gather(F, (const bf16_t*)(ws + OFF_H2), (bf16_t*)(ws + OFF_XR), ws); } SEAM(15);
    if (IN(16)) {
        const int* GI = (const int*)(ws + OFF_GINFO);
        pg8::MoeOrder S; S.G = F.G; S.c = F.bx;
#pragma unroll
        for (int e = 0; e < 8; ++e) S.pend[e] = __builtin_amdgcn_readfirstlane(GI[e]);
        const int ngroups = S.pend[7] >> 8;
        for (int g0 = 0; g0 < ngroups; g0 += MOE_CHUNK) {
            S.g0 = g0; S.ng = (ngroups - g0) < MOE_CHUNK ? (ngroups - g0) : MOE_CHUNK;
            { S.nN = 28; pg8::Gemm g{(const bf16_t*)(ws + OFF_XR), (const bf16_t*)(ws + OFF_W_M13), 0, 2 * DFFE, 1024, 1024, (size_t)2 * DFFE * 1024};
              pg8::EpiSwiglu E{(bf16_t*)(ws + OFF_ACTM), DFFE, g0}; pg8::gemm_phase<pg8::EpiSwiglu, pg8::MoeOrder, ALN, SP2>(glds, g, S, E); }
            xcd_barrier(bar);
            { S.nN = 4; pg8::Gemm g{(const bf16_t*)(ws + OFF_ACTM) - (size_t)g0 * 256 * DFFE, (const bf16_t*)(ws + OFF_W_M2), 0, 1024, DFFE, DFFE, (size_t)1024 * DFFE};
              pg8::EpiStore E{(bf16_t*)(ws + OFF_XR), 1024}; pg8::gemm_phase<pg8::EpiStore, pg8::MoeOrder, ALN, SP2>(glds, g, S, E); }
            xcd_barrier(bar);
        }
    }
    if (IN(17)) { phase_final(F, (const bf16_t*)(ws + OFF_H2), (const bf16_t*)(ws + OFF_XR), args.in[I_OLN2G], args.in[I_OLN2B], args.out, ws); }
#undef IN
#undef SEAM
}

extern "C" void kernel_launch(void* const* d_in, const int* in_sizes, int n_in, void* d_out, int out_size, void* d_ws, size_t ws_size, hipStream_t stream) {
    static int grid = 0;
    if (grid == 0) {
        if (n_in != 33 || in_sizes[0] != MTOK * DM || out_size != MTOK * DM || ws_size < WS_END) { fprintf(stderr, "kernel_launch: unexpected problem (n_in %d, in0 %d, out %d, ws %zu < %zu)\n", n_in, n_in > 0 ? in_sizes[0] : -1, out_size, ws_size, (size_t)WS_END); grid = -1; return; }
        int dev = 0, cus = 0, per_cu = 0;
        if (hipGetDevice(&dev) != hipSuccess || hipDeviceGetAttribute(&cus, hipDeviceAttributeMultiprocessorCount, dev) != hipSuccess) { grid = -1; return; }
        if (hipFuncSetAttribute((const void*)fwd_kernel, hipFuncAttributeMaxDynamicSharedMemorySize, LDS_BYTES) != hipSuccess) { fprintf(stderr, "kernel_launch: hipFuncSetAttribute failed\n"); grid = -1; return; }
        if (hipOccupancyMaxActiveBlocksPerMultiprocessor(&per_cu, (const void*)fwd_kernel, NTHR, LDS_BYTES) != hipSuccess || per_cu < 1) fprintf(stderr, "kernel_launch: occupancy query reports %d\n", per_cu);
        (void)hipGetLastError();
        grid = cus > 256 ? 256 : cus;
    }
    if (grid < 0) return;
    hipMemsetAsync(d_ws, 0, CTL_ZERO_BYTES, stream);
    Args a{};
    for (int i = 0; i < 33; ++i) a.in[i] = (const float*)d_in[i];
    a.out = (float*)d_out; a.ws = (unsigned char*)d_ws;
#if MK_N_LAUNCHES == 1
    a.ph_lo = 0; a.ph_hi = NPHASE; a.li = 0;
    hipLaunchKernelGGL(fwd_kernel, dim3(grid), dim3(NTHR), LDS_BYTES, stream, a);
#else
    for (int p = 0; p < NPHASE; ++p) { a.ph_lo = p; a.ph_hi = p + 1; a.li = p; hipLaunchKernelGGL(fwd_kernel, dim3(grid), dim3(NTHR), LDS_BYTES, stream, a);
#ifdef DBG_MODE
        unsigned* D = (unsigned*)((unsigned char*)d_ws + OFF_DBG); unsigned char* ws = (unsigned char*)d_ws;
        switch (p) {
            case 1: hipLaunchKernelGGL(dbg::chk_in_e, dim3(64), dim3(256), 0, stream, a, D); break;
            case 2: hipLaunchKernelGGL(dbg::chk_q2, dim3(64), dim3(256), 0, stream, a, D); hipLaunchKernelGGL(dbg::chk_cmp, dim3(96), dim3(256), 0, stream, a, D); break;
            case 3: hipLaunchKernelGGL(dbg::chk_idx, dim3(64), dim3(256), 0, stream, a, D); break;
            case 4: hipLaunchKernelGGL(dbg::chk_sel, dim3(48), dim3(256), 0, stream, a, D); break;
            case 5: hipLaunchKernelGGL(dbg::chk_dsa, dim3(64), dim3(256), 0, stream, a, D); hipLaunchKernelGGL(dbg::chk_nsa, dim3(64), dim3(256), 0, stream, a, D); break;
            case 6: hipLaunchKernelGGL(dbg::chk_out_e, dim3(32), dim3(256), 0, stream, a, D); break;
            case 7: hipLaunchKernelGGL(dbg::chk_ln, dim3(32), dim3(256), 0, stream, (const bf16_t*)(ws + OFF_S1), (const bf16_t*)(ws + OFF_H), a.in[I_ELN1G], a.in[I_ELN1B], D, 12); break;
            case 8: hipLaunchKernelGGL(dbg::chk_ffn_up, dim3(16), dim3(256), 0, stream, a, D); break;
            case 9: hipLaunchKernelGGL(dbg::chk_ffn_dn, dim3(32), dim3(256), 0, stream, a, D); break;
            case 10: hipLaunchKernelGGL(dbg::chk_ln, dim3(32), dim3(256), 0, stream, (const bf16_t*)(ws + OFF_S2), (const bf16_t*)(ws + OFF_X1), a.in[I_ELN2G], a.in[I_ELN2B], D, 15); break;
            case 10 + 100: break;
            case 11: hipLaunchKernelGGL(dbg::chk_wmoe, dim3(16), dim3(256), 0, stream, a, D); hipLaunchKernelGGL(dbg::chk_in_o, dim3(32), dim3(256), 0, stream, a, D); break;
            case 12: hipLaunchKernelGGL(dbg::chk_moba, dim3(64), dim3(256), 0, stream, a, D); break;
            case 13: hipLaunchKernelGGL(dbg::chk_out_o, dim3(32), dim3(256), 0, stream, a, D); break;
            case 14: hipLaunchKernelGGL(dbg::chk_ln, dim3(32), dim3(256), 0, stream, (const bf16_t*)(ws + OFF_S1O), (const bf16_t*)(ws + OFF_H2), a.in[I_OLN1G], a.in[I_OLN1B], D, 19); break;
            case 15: hipLaunchKernelGGL(dbg::chk_route, dim3(1), dim3(256), 0, stream, a, D); break;
            case 16: hipLaunchKernelGGL(dbg::chk_actm, dim3(8), dim3(256), 0, stream, a, D); break;
            case 17:
#ifdef DBG_SIMPLE_FINAL
                hipLaunchKernelGGL(dbg::simple_final, dim3(MTOK / 4), dim3(256), 0, stream, a);
#endif
                hipLaunchKernelGGL(dbg::chk_moe, dim3(16), dim3(256), 0, stream, a, D); hipLaunchKernelGGL(dbg::report, dim3(1024), dim3(256), 0, stream, (float*)d_out, (const unsigned*)D, out_size); break;
            default: break;
        }
#endif
    }
#endif
}
```

```cpp
#include <hip/hip_runtime.h>
#include <cstdio>
#include <cstdint>

#define LAS __attribute__((address_space(3)))
#define GAS __attribute__((address_space(1)))
typedef unsigned short bf16_t;
typedef short bf16x8 __attribute__((ext_vector_type(8)));
typedef short s16x4 __attribute__((ext_vector_type(4)));
typedef float f32x2 __attribute__((ext_vector_type(2)));
typedef float f32x4 __attribute__((ext_vector_type(4)));
typedef float f32x16 __attribute__((ext_vector_type(16)));
typedef unsigned u32x2 __attribute__((ext_vector_type(2)));
typedef unsigned u32x4 __attribute__((ext_vector_type(4)));
typedef __bf16 bf16x2_t __attribute__((ext_vector_type(2)));
typedef _Float16 f16x2_t __attribute__((ext_vector_type(2)));

constexpr int DM = 1024, NB = 8, SEQ = 4096, MTOK = NB * SEQ;
constexpr int EVEN_IN = 1768, EVEN_INP = 1792, DFF = 2816, DFFE = 3584, NEXP = 8;
constexpr float ALPHA = 1.4142135623730951f;
constexpr float LOG2E = 1.4426950408889634f;
constexpr float QSCALE = 0.125f * LOG2E;
constexpr int NWAVES = 8, NTHR = 512;

__device__ __forceinline__ unsigned f2bf(float f) { unsigned u = __builtin_bit_cast(unsigned, f); return (u + 0x7fffu + ((u >> 16) & 1u)) >> 16; }
__device__ __forceinline__ unsigned pk2(float lo, float hi) { f32x2 v = {lo, hi}; bf16x2_t b = __builtin_convertvector(v, bf16x2_t); return __builtin_bit_cast(unsigned, b); }
__device__ __forceinline__ float bf2f(unsigned short h) { return __builtin_bit_cast(float, (unsigned)h << 16); }
__device__ __forceinline__ float bflo(unsigned w) { return __builtin_bit_cast(float, w << 16); }
__device__ __forceinline__ float bfhi(unsigned w) { return __builtin_bit_cast(float, w & 0xffff0000u); }
__device__ __forceinline__ float wave_sum(float v) {
#pragma unroll
    for (int o = 1; o < 64; o <<= 1) v += __shfl_xor(v, o);
    return v;
}
#define LDS_WAIT() asm volatile("s_waitcnt lgkmcnt(0)" ::: "memory")
#define VM_WAIT() asm volatile("s_waitcnt vmcnt(0)" ::: "memory")
namespace pg8 {
#define PG8_LAS __attribute__((address_space(3)))
typedef unsigned short bf16_t;
typedef short bf16x8 __attribute__((ext_vector_type(8)));
typedef float f32x4 __attribute__((ext_vector_type(4)));
typedef unsigned u32x4 __attribute__((ext_vector_type(4)));
constexpr int BM = 256, BK = 64, HALF = 128, HTB = HALF * BK * 2  , STAGE_BYTES = 8 * HTB, NXCD = 8, WGM = 8;

__host__ __device__ __forceinline__ int lds_byte(int r, int c) { const int st = (r >> 4) * 2 + (c >> 5), rr = r & 15, cc = c & 31, ob = rr * 64 + cc * 2; return st * 1024 + (ob ^ (((ob >> 9) & 1) << 5)); }
__host__ __device__ __forceinline__ void stage_rc(int b, int& R, int& C) { const int st = b / 1024, sb = b % 1024, swz = sb ^ (((sb >> 9) & 1) << 5); R = (st >> 1) * 16 + swz / 64; C = (st & 1) * 32 + (swz % 64) / 2; }
__host__ __device__ __forceinline__ int perm32(int rho) { const int n = rho >> 4, i = rho & 15; return 8 * (i >> 2) + 4 * n + (i & 3); }

struct Unit { int pm, pn, e; };
struct Gemm { const bf16_t* A; const bf16_t* Bt; int M, N, K; int lda; size_t bstride; };

struct StaticOrder {
    int nM, nN, nwg, G, c;
    __host__ __device__ void init(int M, int N, int G_, int c_) { nM = M / BM; nN = N / BM; nwg = nM * nN; G = G_; c = c_; }
    __host__ __device__ bool next(int i, Unit& u) const {
        const long L = (long)i * G + c; if (L >= nwg) return false;
        int wgid = (int)L; { const int q = nwg / NXCD, r = nwg % NXCD, xcd = wgid % NXCD, off = wgid / NXCD; wgid = (xcd < r ? xcd * (q + 1) : r * (q + 1) + (xcd - r) * q) + off; }
        const int nig = WGM * nN, gid = wgid / nig, fm = gid * WGM, gsz = (nM - fm) < WGM ? (nM - fm) : WGM;
        u.pm = fm + ((wgid % nig) % gsz); u.pn = (wgid % nig) / gsz; u.e = 0; return true;
    }
    __device__ __forceinline__ void a_ready(const Unit&) const {}
    __device__ __forceinline__ void done(const Unit&) const {}
};


template <class Epi, class Sched, bool ALIGN_EPI = false, bool SP2 = false>
__device__ __forceinline__ void gemm_phase(PG8_LAS unsigned char* lds, const Gemm g, const Sched& S, const Epi& E) {
    const int tid = threadIdx.x, wid = __builtin_amdgcn_readfirstlane(tid >> 6), lane = tid & 63, wr = wid >> 2, wc = wid & 3, fr = lane & 15, fq = lane >> 4;
    const int K = g.K, nt = K / BK;
    unsigned voffA[2], voffB[2];
#pragma unroll
    for (int i = 0; i < 2; ++i) { int R, C; stage_rc(tid * 16 + i * 8192, R, C); const int Rb = Epi::PERM ? ((R & ~31) + perm32(R & 31)) : R;
        voffA[i] = (unsigned)(R * g.lda + C) * 2u; voffB[i] = (unsigned)(Rb * K + C) * 2u; }
    const size_t kstep = (size_t)(BK * 2);
    const size_t hstep = (size_t)HALF * K * 2;
    const size_t tstep = 2 * hstep;
    const size_t hstepA = (size_t)HALF * g.lda * 2, tstepA = 2 * hstepA;
    const size_t estep = g.bstride * 2;
    const unsigned ldsw = (unsigned)wid * 1024u;
    const int aoff = lds_byte(wr * 64 + fr, fq * 8), boff = lds_byte(wc * 32 + fr, fq * 8);
#define PG8_SA(b, h) (((b) * 2 + (h)) * HTB)
#define PG8_SB(b, h) ((4 + (b) * 2 + (h)) * HTB)
#define PG8_STAGE(bufoff, gbase, voff) do { _Pragma("unroll") for (int _i = 0; _i < 2; ++_i) \
        __builtin_amdgcn_global_load_lds((const unsigned*)((const char*)(gbase) + (voff)[_i]), (PG8_LAS unsigned*)(lds + (bufoff) + ldsw + _i * 8192), 16, 0, 0); } while (0)
#define PG8_LDA(dst, b, h) do { _Pragma("unroll") for (int m = 0; m < 4; ++m) _Pragma("unroll") for (int k = 0; k < 2; ++k) dst[m][k] = *(const PG8_LAS bf16x8*)(lds + PG8_SA(b, h) + aoff + m * 2048 + k * 1024); } while (0)
#define PG8_LDB(dst, b, h) do { _Pragma("unroll") for (int n = 0; n < 2; ++n) _Pragma("unroll") for (int k = 0; k < 2; ++k) dst[n][k] = *(const PG8_LAS bf16x8*)(lds + PG8_SB(b, h) + boff + n * 2048 + k * 1024); } while (0)
#define PG8_MMA(ai, bj, At, Bt) do { __builtin_amdgcn_s_setprio(1); _Pragma("unroll") for (int m = 0; m < 4; ++m) _Pragma("unroll") for (int n = 0; n < 2; ++n) _Pragma("unroll") for (int k = 0; k < 2; ++k) \
        acc[ai][bj][m][n] = __builtin_amdgcn_mfma_f32_16x16x32_bf16(Bt[n][k], At[m][k], acc[ai][bj][m][n], 0, 0, 0); __builtin_amdgcn_s_setprio(0); } while (0)
#define PG8_WAIT_V(n) asm volatile("s_waitcnt vmcnt(" #n ")" ::: "memory")
#define PG8_WAIT_L(n) asm volatile("s_waitcnt lgkmcnt(" #n ")" ::: "memory")
#define PG8_BAR __builtin_amdgcn_s_barrier()
#define PG8_SCHED __builtin_amdgcn_sched_barrier(0)
    Unit cur, nxt; int ui = 0;
    if (!S.next(0, cur)) return;
    f32x4 acc[2][2][4][2];
#pragma unroll
    for (int a = 0; a < 2; ++a)
#pragma unroll
        for (int b = 0; b < 2; ++b)
#pragma unroll
            for (int m = 0; m < 4; ++m)
#pragma unroll
                for (int n = 0; n < 2; ++n) acc[a][b][m][n] = (f32x4){0.f, 0.f, 0.f, 0.f};
    bf16x8 At[4][2], B0[2][2], B1[2][2];
    const char* cA = (const char*)g.A + (size_t)cur.pm * tstepA; const char* cB = (const char*)g.Bt + (size_t)cur.pn * tstep + (size_t)cur.e * estep;
    S.a_ready(cur);
    if constexpr (SP2) {
        PG8_STAGE(PG8_SB(0, 0), cB, voffB); PG8_STAGE(PG8_SB(0, 1), cB + hstep, voffB); PG8_STAGE(PG8_SA(0, 0), cA, voffA); PG8_STAGE(PG8_SA(0, 1), cA + hstepA, voffA);
        if (wr == 1) PG8_BAR;
        PG8_WAIT_V(2); PG8_BAR;
        PG8_STAGE(PG8_SB(1, 0), cB + kstep, voffB); PG8_STAGE(PG8_SA(1, 0), cA + kstep, voffA); PG8_STAGE(PG8_SB(1, 1), cB + hstep + kstep, voffB);
        PG8_WAIT_V(6); PG8_BAR;
    } else {
        PG8_STAGE(PG8_SB(0, 0), cB, voffB); PG8_STAGE(PG8_SA(0, 0), cA, voffA); PG8_STAGE(PG8_SB(0, 1), cB + hstep, voffB); PG8_STAGE(PG8_SA(0, 1), cA + hstepA, voffA);
        if (wr == 1) PG8_BAR;
        PG8_WAIT_V(4); PG8_BAR;
        PG8_STAGE(PG8_SB(1, 0), cB + kstep, voffB); PG8_STAGE(PG8_SA(1, 0), cA + kstep, voffA); PG8_STAGE(PG8_SB(1, 1), cB + hstep + kstep, voffB);
        PG8_WAIT_V(6); PG8_BAR;
    }
    for (;;) {
        const bool has_next = S.next(ui + 1, nxt);
        const char* nA = has_next ? (const char*)g.A + (size_t)nxt.pm * tstepA : cA; const char* nB = has_next ? (const char*)g.Bt + (size_t)nxt.pn * tstep + (size_t)nxt.e * estep : cB;
#pragma unroll 1
        for (int t = 0; t < nt; t += 2) {
            const bool last = (t == nt - 2);
            const char* a1 = cA + (size_t)(t + 1) * kstep;
            const char* a2 = last ? nA : cA + (size_t)(t + 2) * kstep; const char* b2 = last ? nB : cB + (size_t)(t + 2) * kstep;
            const char* a3 = a2 + kstep; const char* b3 = b2 + kstep;
            if (last && has_next) S.a_ready(nxt);
            if constexpr (SP2) {
            PG8_LDB(B0, 0, 0); PG8_LDB(B1, 0, 1); PG8_SCHED; PG8_LDA(At, 0, 0); PG8_STAGE(PG8_SA(1, 1), a1 + hstepA, voffA);
            PG8_WAIT_V(8); PG8_WAIT_L(0); PG8_BAR; PG8_MMA(0, 0, At, B0); PG8_MMA(0, 1, At, B1); PG8_BAR; PG8_SCHED;
            PG8_LDA(At, 0, 1); PG8_STAGE(PG8_SB(0, 0), b2, voffB); PG8_STAGE(PG8_SB(0, 1), b2 + hstep, voffB); PG8_STAGE(PG8_SA(0, 0), a2, voffA);
            PG8_WAIT_V(8); PG8_WAIT_L(0); PG8_BAR; PG8_MMA(1, 0, At, B0); PG8_MMA(1, 1, At, B1); PG8_BAR; PG8_SCHED;
            PG8_LDB(B0, 1, 0); PG8_LDB(B1, 1, 1); PG8_SCHED; PG8_LDA(At, 1, 0); PG8_STAGE(PG8_SA(0, 1), a2 + hstepA, voffA);
            PG8_WAIT_V(8); PG8_WAIT_L(0); PG8_BAR; PG8_MMA(0, 0, At, B0); PG8_MMA(0, 1, At, B1); PG8_BAR; PG8_SCHED;
            PG8_LDA(At, 1, 1); PG8_STAGE(PG8_SB(1, 0), b3, voffB); PG8_STAGE(PG8_SB(1, 1), b3 + hstep, voffB); PG8_STAGE(PG8_SA(1, 0), a3, voffA);
            PG8_WAIT_V(8); PG8_WAIT_L(0); PG8_BAR; PG8_MMA(1, 0, At, B0); PG8_MMA(1, 1, At, B1); PG8_BAR; PG8_SCHED;
            } else {
            PG8_LDB(B0, 0, 0); PG8_SCHED; PG8_LDA(At, 0, 0); PG8_STAGE(PG8_SA(1, 1), a1 + hstepA, voffA);
            PG8_WAIT_L(8); PG8_BAR; PG8_WAIT_L(0); PG8_MMA(0, 0, At, B0); PG8_BAR; PG8_SCHED;
            PG8_LDB(B1, 0, 1); PG8_STAGE(PG8_SB(0, 0), b2, voffB);
            PG8_BAR; PG8_WAIT_L(0); PG8_MMA(0, 1, At, B1); PG8_BAR;
            PG8_LDA(At, 0, 1); PG8_STAGE(PG8_SA(0, 0), a2, voffA);
            PG8_BAR; PG8_WAIT_L(0); PG8_MMA(1, 0, At, B0); PG8_BAR; PG8_SCHED;
            PG8_STAGE(PG8_SB(0, 1), b2 + hstep, voffB);
            PG8_WAIT_V(6); PG8_BAR; PG8_MMA(1, 1, At, B1); PG8_BAR;
            PG8_LDB(B0, 1, 0); PG8_SCHED; PG8_LDA(At, 1, 0); PG8_STAGE(PG8_SA(0, 1), a2 + hstepA, voffA);
            PG8_WAIT_L(8); PG8_BAR; PG8_WAIT_L(0); PG8_MMA(0, 0, At, B0); PG8_BAR; PG8_SCHED;
            PG8_LDB(B1, 1, 1); PG8_STAGE(PG8_SB(1, 0), b3, voffB);
            PG8_BAR; PG8_WAIT_L(0); PG8_MMA(0, 1, At, B1); PG8_BAR;
            PG8_LDA(At, 1, 1); PG8_STAGE(PG8_SA(1, 0), a3, voffA);
            PG8_BAR; PG8_WAIT_L(0); PG8_MMA(1, 0, At, B0); PG8_BAR; PG8_SCHED;
            PG8_STAGE(PG8_SB(1, 1), b3 + hstep, voffB);
            PG8_WAIT_V(6); PG8_BAR; PG8_MMA(1, 1, At, B1); PG8_BAR;
            }
        }
        if constexpr (ALIGN_EPI) { if (wr == 0) PG8_BAR; }
        if constexpr (!Epi::AFTER_DRAIN) { E(acc, cur, wr, wc, fr, fq); S.done(cur); }
        if (!has_next) break;
#pragma unroll
        for (int a = 0; a < 2; ++a)
#pragma unroll
            for (int b = 0; b < 2; ++b)
#pragma unroll
                for (int m = 0; m < 4; ++m)
#pragma unroll
                    for (int n = 0; n < 2; ++n) acc[a][b][m][n] = (f32x4){0.f, 0.f, 0.f, 0.f};
        cur = nxt; cA = nA; cB = nB; ++ui;
        if constexpr (ALIGN_EPI) { if (wr == 1) PG8_BAR; }
    }
    PG8_WAIT_V(0);
    if constexpr (!ALIGN_EPI) { if (wr == 0) PG8_BAR; }
    PG8_BAR;
    if constexpr (Epi::AFTER_DRAIN) { E.fused(acc, cur, wr, wc, fr, fq, lds, wid, lane); S.done(cur); }
#undef PG8_SA
#undef PG8_SB
#undef PG8_STAGE
#undef PG8_LDA
#undef PG8_LDB
#undef PG8_MMA
#undef PG8_WAIT_V
#undef PG8_WAIT_L
#undef PG8_BAR
#undef PG8_SCHED
}
}

namespace pg8 {
typedef f32x4 Acc[2][2][4][2];
__device__ __forceinline__ u32x4 pack8(const f32x4 v0, const f32x4 v1) { u32x4 w; w.x = pk2(v0[0], v0[1]); w.y = pk2(v0[2], v0[3]); w.z = pk2(v1[0], v1[1]); w.w = pk2(v1[2], v1[3]); return w; }
__device__ __forceinline__ void unpack8(const u32x4 w, f32x4& a, f32x4& b) { a = (f32x4){bflo(w.x), bfhi(w.x), bflo(w.y), bfhi(w.y)}; b = (f32x4){bflo(w.z), bfhi(w.z), bflo(w.w), bfhi(w.w)}; }

struct EpiInE {
    static constexpr bool PERM = true, AFTER_DRAIN = false;
    bf16_t* Y1; float* ssq_q; float* ssq_kv;
    __device__ __forceinline__ void operator()(const Acc& acc, const Unit& u, int wr, int wc, int fr, int fq) const {
        bf16_t* base = Y1 + (size_t)u.pn * MTOK * 256;
        const float sc = (u.pn == 2 || u.pn == 3) ? QSCALE : 1.f;
        const int col0 = wc * 32 + 8 * fq;
#pragma unroll
        for (int ai = 0; ai < 2; ++ai)
#pragma unroll
            for (int m = 0; m < 4; ++m) {
                const int row = u.pm * BM + ai * HALF + wr * 64 + m * 16 + fr; bf16_t* rowp = base + (size_t)row * 256 + col0;
                float s0 = 0.f, s1 = 0.f;
#pragma unroll
                for (int bj = 0; bj < 2; ++bj) { const f32x4 v0 = acc[ai][bj][m][0], v1 = acc[ai][bj][m][1];
                    const float q = (v0[0] * v0[0] + v0[1] * v0[1]) + (v0[2] * v0[2] + v0[3] * v0[3]) + (v1[0] * v1[0] + v1[1] * v1[1]) + (v1[2] * v1[2] + v1[3] * v1[3]);
                    if (bj == 0) s0 = q; else s1 = q;
                    *(u32x4*)(rowp + bj * HALF) = pack8(v0 * sc, v1 * sc); }
                if (u.pn <= 1) {
                    float s = (u.pn == 0) ? (s0 + s1) : s0;
                    s += __shfl_xor(s, 16); s += __shfl_xor(s, 32);
                    if (fq == 0) (u.pn == 0 ? ssq_q : ssq_kv)[(size_t)row * 4 + wc] = s;
                }
            }
    }
};
struct EpiQ2 {
    static constexpr bool PERM = true, AFTER_DRAIN = false;
    bf16_t* QLAT; bf16_t* QIDX; const float* ssq_q;
    __device__ __forceinline__ void operator()(const Acc& acc, const Unit& u, int wr, int wc, int fr, int fq) const {
        bf16_t* base = (u.pn < 4) ? QLAT : QIDX; const float sc0 = (u.pn < 4) ? QSCALE : 1.f;
        const int col0 = (u.pn & 3) * 256 + wc * 32 + 8 * fq;
#pragma unroll
        for (int ai = 0; ai < 2; ++ai)
#pragma unroll
            for (int m = 0; m < 4; ++m) {
                const int row = u.pm * BM + ai * HALF + wr * 64 + m * 16 + fr; bf16_t* rowp = base + (size_t)row * 1024 + col0;
                const f32x4 sq = *(const f32x4*)(ssq_q + (size_t)row * 4); const float sc = sc0 * __builtin_amdgcn_rsqf(((sq[0] + sq[1]) + (sq[2] + sq[3])) * (1.f / 256.f) + 1e-6f);
#pragma unroll
                for (int bj = 0; bj < 2; ++bj) *(u32x4*)(rowp + bj * HALF) = pack8(acc[ai][bj][m][0] * sc, acc[ai][bj][m][1] * sc);
            }
    }
};
template <bool RES_F32> struct EpiRes {
    static constexpr bool PERM = true, AFTER_DRAIN = false;
    const void* res; bf16_t* S;
    __device__ __forceinline__ void operator()(const Acc& acc, const Unit& u, int wr, int wc, int fr, int fq) const {
        const int col0 = u.pn * BM + wc * 32 + 8 * fq;
#pragma unroll
        for (int ai = 0; ai < 2; ++ai)
#pragma unroll
            for (int m = 0; m < 4; ++m) {
                const size_t off = (size_t)(u.pm * BM + ai * HALF + wr * 64 + m * 16 + fr) * 1024 + col0;
#pragma unroll
                for (int bj = 0; bj < 2; ++bj) { f32x4 r0, r1;
                    if (RES_F32) { r0 = *(const f32x4*)((const float*)res + off + bj * HALF); r1 = *(const f32x4*)((const float*)res + off + bj * HALF + 4); }
                    else unpack8(*(const u32x4*)((const bf16_t*)res + off + bj * HALF), r0, r1);
                    *(u32x4*)(S + off + bj * HALF) = pack8(r0 * ALPHA + acc[ai][bj][m][0], r1 * ALPHA + acc[ai][bj][m][1]); }
            }
    }
};
struct EpiSwiglu {
    static constexpr bool PERM = true, AFTER_DRAIN = false;
    bf16_t* O; int ldo; int pm0;
    __device__ __forceinline__ void operator()(const Acc& acc, const Unit& u, int wr, int wc, int fr, int fq) const {
        const int col0 = u.pn * HALF + wc * 32 + 8 * fq;
#pragma unroll
        for (int ai = 0; ai < 2; ++ai)
#pragma unroll
            for (int m = 0; m < 4; ++m) {
                bf16_t* rowp = O + (size_t)((u.pm - pm0) * BM + ai * HALF + wr * 64 + m * 16 + fr) * ldo + col0;
                f32x4 o[2];
#pragma unroll
                for (int n = 0; n < 2; ++n) { const f32x4 a = acc[ai][0][m][n], b = acc[ai][1][m][n];
#pragma unroll
                    for (int e = 0; e < 4; ++e) o[n][e] = a[e] * __builtin_amdgcn_rcpf(1.f + __expf(-a[e])) * b[e]; }
                *(u32x4*)rowp = pack8(o[0], o[1]);
            }
    }
};
struct EpiStore {
    static constexpr bool PERM = true, AFTER_DRAIN = false;
    bf16_t* O; int ldo;
    __device__ __forceinline__ void operator()(const Acc& acc, const Unit& u, int wr, int wc, int fr, int fq) const {
        const int col0 = u.pn * BM + wc * 32 + 8 * fq;
#pragma unroll
        for (int ai = 0; ai < 2; ++ai)
#pragma unroll
            for (int m = 0; m < 4; ++m) {
                bf16_t* rowp = O + (size_t)(u.pm * BM + ai * HALF + wr * 64 + m * 16 + fr) * ldo + col0;
#pragma unroll
                for (int bj = 0; bj < 2; ++bj) *(u32x4*)(rowp + bj * HALF) = pack8(acc[ai][bj][m][0], acc[ai][bj][m][1]);
            }
    }
};
struct EpiInO {
    static constexpr bool PERM = true, AFTER_DRAIN = false;
    bf16_t* QKV; float* kmean;
    __device__ __forceinline__ void operator()(const Acc& acc, const Unit& u, int wr, int wc, int fr, int fq) const {
        const int which = u.pn >> 2; bf16_t* base = QKV + (size_t)which * MTOK * 1024; const float sc = (which == 0) ? QSCALE : 1.f;
        const int col0 = (u.pn & 3) * BM + wc * 32 + 8 * fq;
#pragma unroll
        for (int ai = 0; ai < 2; ++ai)
#pragma unroll
            for (int m = 0; m < 4; ++m) {
                bf16_t* rowp = base + (size_t)(u.pm * BM + ai * HALF + wr * 64 + m * 16 + fr) * 1024 + col0;
#pragma unroll
                for (int bj = 0; bj < 2; ++bj) *(u32x4*)(rowp + bj * HALF) = pack8(acc[ai][bj][m][0] * sc, acc[ai][bj][m][1] * sc);
            }
        if (which == 1) {
#pragma unroll
            for (int bj = 0; bj < 2; ++bj)
#pragma unroll
                for (int n = 0; n < 2; ++n) { f32x4 s = (f32x4){0.f, 0.f, 0.f, 0.f};
#pragma unroll
                    for (int ai = 0; ai < 2; ++ai)
#pragma unroll
                        for (int m = 0; m < 4; ++m) s += acc[ai][bj][m][n];
#pragma unroll
                    for (int e = 0; e < 4; ++e) { float v = s[e]; v += __shfl_xor(v, 1); v += __shfl_xor(v, 2); v += __shfl_xor(v, 4); v += __shfl_xor(v, 8);
                        if (fr == 0) kmean[((size_t)u.pm * 2 + wr) * 1024 + col0 + bj * HALF + 4 * n + e] = v; }
                }
        }
    }
};
struct MoeOrder {
    int g0, ng, nN, G, c; int pend[8];
    __device__ __forceinline__ bool next(int i, Unit& u) const {
        const int L = i * G + c; if (L >= ng * nN) return false;
        u.pm = g0 + L % ng; u.pn = L / ng; const int r = u.pm * 256; int e = 0;
#pragma unroll
        for (int k = 0; k < 7; ++k) e += (pend[k] <= r) ? 1 : 0;
        u.e = e; return true;
    }
    __device__ __forceinline__ void a_ready(const Unit&) const {}
    __device__ __forceinline__ void done(const Unit&) const {}
};
}

constexpr size_t MiB = 1u << 20, KiB = 1u << 10;
constexpr size_t CTL_ZERO_BYTES = 2 * MiB;
constexpr int    MAX_LAUNCHES = 18;
constexpr size_t OFF_BAR = 16 * KiB;
constexpr size_t OFF_WGCNT = 1 * MiB + 512 * KiB;
constexpr size_t OFF_GINFO = OFF_WGCNT + 16 * KiB;
constexpr size_t OFF_DBG = OFF_GINFO + 1 * KiB;
constexpr size_t OFF_BT = 2 * MiB;
constexpr size_t OFF_CB = 2 * MiB + 16 * KiB;
constexpr size_t OFF_ROUTE = 2 * MiB + 64 * KiB;
constexpr size_t OFF_DEST = 2 * MiB + 512 * KiB;
constexpr size_t OFF_KC = 3 * MiB, OFF_VC = 3 * MiB + 512 * KiB;
constexpr size_t OFF_W_IN = 4 * MiB, OFF_W_Q2 = OFF_W_IN + (size_t)EVEN_INP * 1024 * 2, OFF_W_OUTE = OFF_W_Q2 + 2048 * 256 * 2, OFF_W_F13 = OFF_W_OUTE + 1024 * 1536 * 2,
                 OFF_W_F2 = OFF_W_F13 + (size_t)2 * DFF * 1024 * 2, OFF_CK1 = OFF_W_F2 + (size_t)1024 * DFF * 2, OFF_CV1 = OFF_CK1 + 64 * 2048 * 2, OFF_WE_END = OFF_CV1 + 64 * 2048 * 2;
static_assert(OFF_WE_END <= 30 * MiB, "even weights");
constexpr size_t OFF_W_OIN = 30 * MiB, OFF_W_OOUT = 36 * MiB, OFF_W_M13 = 38 * MiB, OFF_W_M2 = 150 * MiB;
constexpr size_t OFF_Y1 = 30 * MiB;
constexpr size_t OFF_CKVN = 142 * MiB;
constexpr size_t OFF_XB = 206 * MiB, OFF_QLAT = 206 * MiB, OFF_QIDX = 270 * MiB;
constexpr size_t OFF_SC = 334 * MiB, OFF_MASK = 464 * MiB, OFF_MIXIN = 334 * MiB;
constexpr size_t OFF_S1 = 206 * MiB, OFF_H = 270 * MiB, OFF_ACT = 30 * MiB, OFF_S2 = 334 * MiB, OFF_X1 = 398 * MiB;
constexpr size_t OFF_QKV = 206 * MiB, OFF_S1O = 270 * MiB, OFF_H2 = 206 * MiB, OFF_XR = 270 * MiB, OFF_ACTM = 402 * MiB;
constexpr size_t OFF_SSQ_Q = 514 * MiB, OFF_SSQ_KV = 514 * MiB + 512 * KiB;
constexpr size_t OFF_KMEAN = 515 * MiB;
constexpr size_t WS_END = 516 * MiB;
constexpr int    MOE_CHUNK = 64;
constexpr size_t SCB_ELEMS = (size_t)64 * 64 * (64 * 65 / 2);

constexpr int LDS_BYTES = 160 * 1024;
constexpr int LDSCTL_OFF = LDS_BYTES - 512;

#define RLX_AGENT __ATOMIC_RELAXED, __HIP_MEMORY_SCOPE_AGENT
typedef GAS unsigned gu32;
#define XB_TMO      128
#define XB_XCNT(j)  (256  + 64 * (j))
#define XB_XSUB(j)  (1280 + 64 * (j))
#define XB_XGEN(j)  (2304 + 64 * (j))
#define XB_TOP      3328
#define XB_TOPGEN   3392
#define XCD_BAR_WORDS 3456
#define XB_SPIN_CAP (1u << 18)

__device__ __forceinline__ unsigned xb_ld(unsigned* p)              { return __hip_atomic_load(p, __ATOMIC_RELAXED, __HIP_MEMORY_SCOPE_AGENT); }
__device__ __forceinline__ unsigned xb_add(unsigned* p, unsigned v) { return __hip_atomic_fetch_add(p, v, __ATOMIC_RELAXED, __HIP_MEMORY_SCOPE_AGENT); }
__device__ __forceinline__ unsigned xb_xcc_id() { return (unsigned)__builtin_amdgcn_s_getreg((3 << 11) | 20) & 0xFu; }
#define XB_SPIN(cond, bar) do { unsigned _sp = 0; while (cond) { __builtin_amdgcn_s_sleep(1); \
    if ((++_sp & 255u) == 0u) { if (xb_ld(&(bar)[XB_TMO])) break; if (_sp > XB_SPIN_CAP) { atomicAdd(&(bar)[XB_TMO], 1u); break; } } } } while (0)

struct XcdBarrier {
    unsigned* bar; unsigned x;
    volatile LAS unsigned* st;
};

__device__ __forceinline__ XcdBarrier xcd_barrier_post(unsigned* bar, volatile LAS unsigned* st) {
    XcdBarrier b; b.bar = bar; b.x = xb_xcc_id(); b.st = st;
    if (threadIdx.x == 0) (void)xb_add(&bar[XB_XCNT(b.x)], 1u);
    return b;
}
__device__ __forceinline__ void xcd_barrier_complete(unsigned* bar, unsigned x, unsigned& nloc, unsigned& nx) {
    const unsigned G = gridDim.x * gridDim.y * gridDim.z;
    unsigned sum, cnt, mine, sp = 0u;
    for (;;) {
        sum = 0u; cnt = 0u; mine = 0u;
#pragma unroll
        for (unsigned j = 0; j < 16; ++j) { const unsigned c = xb_ld(&bar[XB_XCNT(j)]); sum += c; cnt += (c > 0u) ? 1u : 0u; mine = (j == x) ? c : mine; }
        if (sum == G) break;
        __builtin_amdgcn_s_sleep(1);
        if ((++sp & 255u) == 0u) { if (xb_ld(&bar[XB_TMO])) break; if (sp > XB_SPIN_CAP) { atomicAdd(&bar[XB_TMO], 1u); break; } }
    }
    nloc = mine > 0u ? mine : 1u; nx = cnt > 0u ? cnt : 1u;
}

__device__ __forceinline__ void xcd_barrier(const XcdBarrier& b) {
    asm volatile("s_waitcnt vmcnt(0)" ::: "memory");
    __syncthreads();
    if (threadIdx.x == 0) {
        unsigned* bar = b.bar;
        __builtin_amdgcn_s_waitcnt(0);
        unsigned nloc = b.st[0], nx = b.st[1];
        if (nloc == 0u) { xcd_barrier_complete(bar, b.x, nloc, nx); b.st[0] = nloc; b.st[1] = nx; }
        const unsigned old = xb_add(&bar[XB_XSUB(b.x)], 1u);
        const unsigned gen = old / nloc;
        if (old + 1u == (gen + 1u) * nloc) {
            __builtin_amdgcn_fence(__ATOMIC_RELEASE, "agent");
            asm volatile("s_waitcnt vmcnt(0)" ::: "memory");
            const unsigned og = xb_add(&bar[XB_TOP], 1u);
            const unsigned tg = og / nx;
            if (og + 1u == (tg + 1u) * nx) xb_add(&bar[XB_TOPGEN], 1u);
            else XB_SPIN(xb_ld(&bar[XB_TOPGEN]) == tg, bar);
            __builtin_amdgcn_fence(__ATOMIC_ACQUIRE, "agent");
            xb_add(&bar[XB_XGEN(b.x)], 1u);
            asm volatile("s_waitcnt vmcnt(0)" ::: "memory");
        } else {
            XB_SPIN(xb_ld(&bar[XB_XGEN(b.x)]) == gen, bar);
            __builtin_amdgcn_fence(__ATOMIC_ACQUIRE, "agent");
            asm volatile("s_waitcnt vmcnt(0)" ::: "memory");
        }
    }
    __syncthreads();
}

struct Frame {
    LAS unsigned char* lds;
    int tid, lane, wave, G, bx;
    int gw, NGW;
    unsigned char* ws;
    const float* const* in;
};
struct Args { const float* in[33]; float* out; unsigned char* ws; int ph_lo, ph_hi, li, pad; };
enum InIdx { I_X = 0, I_RELB, I_EWIN, I_EQN, I_EKVN, I_EWUQ, I_EWUK, I_EWUV, I_EWQIDX, I_EPOSK, I_EPOSV, I_ECK1, I_ECK2, I_ECV1, I_ECV2, I_EWOUT, I_ELN1G, I_ELN1B,
             I_EF1, I_EF3, I_EF2, I_ELN2G, I_ELN2B, I_OWIN, I_OWOUT, I_OLN1G, I_OLN1B, I_OROUTER, I_OM1, I_OM3, I_OM2, I_OLN2G, I_OLN2B };

template <class RowMap, class KScale>
__device__ __forceinline__ void transpose_item(const float* W, int K, int N, bf16_t* WT, int ldt, LAS float* scr, int item, int lane, RowMap rm, KScale ks) {
    const int nblk = (N + 31) >> 5, kb = item / nblk, nb = item - kb * nblk, k0 = 64 * kb, n0 = 32 * nb;
    const int n = n0 + (lane & 31);
#pragma unroll 8
    for (int i = 0; i < 32; ++i) { const int kk = 2 * i + (lane >> 5); scr[kk * 33 + (lane & 31)] = (n < N) ? W[(size_t)(k0 + kk) * N + n] * ks(k0 + kk) : 0.f; }
    LDS_WAIT(); asm volatile("" ::: "memory");
    const int c = lane & 7;
#pragma unroll
    for (int j = 0; j < 4; ++j) { const int nl = (lane >> 3) + 8 * j, nn = n0 + nl; const LAS float* s = scr + (8 * c) * 33 + nl;
        if (nn < N) { const int dr = rm(nn);
            u32x4 o; o.x = pk2(s[0 * 33], s[1 * 33]); o.y = pk2(s[2 * 33], s[3 * 33]); o.z = pk2(s[4 * 33], s[5 * 33]); o.w = pk2(s[6 * 33], s[7 * 33]);
            *(u32x4*)(WT + (size_t)dr * ldt + k0 + 8 * c) = o; } }
    LDS_WAIT(); asm volatile("" ::: "memory");
}
struct RowId { __device__ __forceinline__ int operator()(int n) const { return n; } };
struct KOne { __device__ __forceinline__ float operator()(int) const { return 1.f; } };
struct RowInE {
    __device__ __forceinline__ int operator()(int n) const { return n < 464 ? n : (n < 1744 ? n + 48 : n - 1744 + 464); }
};
struct RowIlv {
    int add; __device__ __forceinline__ int operator()(int n) const { return ((n >> 7) << 8) + (n & 127) + add; }
};
struct KGain { const float* g; __device__ __forceinline__ float operator()(int k) const { return g[k]; } };

__device__ __forceinline__ int t5_bucket(int n) {
    if (n < 16) return n;
    int l = 16 + (int)(__logf((float)n / 16.f) / 2.0794415f * 16.f);
    return l < 31 ? l : 31;
}

__device__ __forceinline__ void phase_prologue_even(const Frame& F, const Args& a) {
    LAS float* scr = (LAS float*)(F.lds + F.wave * 8704);
    unsigned char* ws = F.ws;
    bf16_t* W_IN = (bf16_t*)(ws + OFF_W_IN); bf16_t* W_Q2 = (bf16_t*)(ws + OFF_W_Q2); bf16_t* W_OUTE = (bf16_t*)(ws + OFF_W_OUTE);
    bf16_t* W_F13 = (bf16_t*)(ws + OFF_W_F13); bf16_t* W_F2 = (bf16_t*)(ws + OFF_W_F2); bf16_t* CK1 = (bf16_t*)(ws + OFF_CK1); bf16_t* CV1 = (bf16_t*)(ws + OFF_CV1);
    constexpr int I_IN = 16 * ((EVEN_IN + 31) / 32);
    constexpr int I_QI = 4 * 32;
    constexpr int I_OB = 8 * 32;
    constexpr int I_F1 = 16 * (DFF / 32), I_F2 = (DFF / 64) * 32;
    constexpr int I_CK = 32 * 2;
    constexpr int NIT = I_IN + I_QI + I_OB + 2 * I_F1 + I_F2 + 2 * I_CK;
    for (int it = F.gw; it < NIT; it += F.NGW) {
        int r = it;
        if (r < I_IN) { transpose_item(a.in[I_EWIN], 1024, EVEN_IN, W_IN, 1024, scr, r, F.lane, RowInE{}, KOne{}); continue; } r -= I_IN;
        if (r < I_QI) { transpose_item(a.in[I_EWQIDX], 256, 1024, W_Q2 + 1024 * 256, 256, scr, r, F.lane, RowId{}, KGain{a.in[I_EQN]}); continue; } r -= I_QI;
        if (r < I_OB) { transpose_item(a.in[I_EWOUT] + 512 * 1024, 512, 1024, W_OUTE + 1024, 1536, scr, r, F.lane, RowId{}, KOne{}); continue; } r -= I_OB;
        if (r < I_F1) { transpose_item(a.in[I_EF1], 1024, DFF, W_F13, 1024, scr, r, F.lane, RowIlv{0}, KOne{}); continue; } r -= I_F1;
        if (r < I_F1) { transpose_item(a.in[I_EF3], 1024, DFF, W_F13, 1024, scr, r, F.lane, RowIlv{128}, KOne{}); continue; } r -= I_F1;
        if (r < I_F2) { transpose_item(a.in[I_EF2], DFF, 1024, W_F2, DFF, scr, r, F.lane, RowId{}, KOne{}); continue; } r -= I_F2;
        if (r < I_CK) { transpose_item(a.in[I_ECK1], 2048, 64, CK1, 2048, scr, r, F.lane, RowId{}, KOne{}); continue; } r -= I_CK;
        transpose_item(a.in[I_ECV1], 2048, 64, CV1, 2048, scr, r, F.lane, RowId{}, KOne{});
    }
    const int gt = F.bx * NTHR + F.tid, NGT = F.G * NTHR;
    for (int i = gt; i < 24 * 1024 / 8; i += NGT) ((u32x4*)(W_IN + 488 * 1024))[i] = (u32x4){0u, 0u, 0u, 0u};
    { const float* uq = a.in[I_EWUQ]; const float* uk = a.in[I_EWUK]; const float* qg = a.in[I_EQN];
      for (int o = gt; o < 1024 * 256; o += NGT) { const int r = o & 255, hc = o >> 8, h = hc >> 7, c = hc & 127; const float* p = uq + r * 512 + h * 64; const float* q = uk + c * 512 + h * 64; float s = 0.f;
#pragma unroll 8
          for (int d = 0; d < 64; ++d) s += p[d] * q[d];
          W_Q2[o] = (bf16_t)f2bf(s * qg[r]); } }
    { const float* uv = a.in[I_EWUV]; const float* wo = a.in[I_EWOUT];
      for (int o = gt; o < 1024 * 1024; o += NGT) { const int n = o & 1023, hc = o >> 10, h = hc >> 7, c = hc & 127; const float* p = uv + c * 512 + h * 64; const float* q = wo + (size_t)(h * 64) * 1024 + n; float s = 0.f;
#pragma unroll 8
          for (int d = 0; d < 64; ++d) s += p[d] * q[(size_t)d * 1024];
          W_OUTE[(size_t)n * 1536 + hc] = (bf16_t)f2bf(s); } }
    if (F.bx == 0) { float* BT = (float*)(ws + OFF_BT); const float* rb = a.in[I_RELB];
        for (int i = F.tid; i < 16 * 128; i += NTHR) { const int h = i >> 7, d = i & 127; BT[i] = rb[t5_bucket(d) * 16 + h] * LOG2E; } }
    if (F.bx == 1 && F.tid < 128) { const int kv = F.tid >> 6, e = F.tid & 63; const float* pos = a.in[kv ? I_EPOSV : I_EPOSK]; const float* w1 = a.in[kv ? I_ECV1 : I_ECK1]; float s = 0.f;
        for (int k = 0; k < 2048; ++k) s += pos[k] * w1[k * 64 + e];
        ((float*)(ws + OFF_CB))[F.tid] = s; }
    { const f32x4* x4 = (const f32x4*)a.in[I_X]; u32x4* xb = (u32x4*)(ws + OFF_XB);
      for (int i = gt; i < MTOK * 1024 / 8; i += NGT) { const f32x4 v0 = x4[2 * i], v1 = x4[2 * i + 1]; xb[i] = pg8::pack8(v0, v1); } }
}

__device__ __forceinline__ void phase_convert_odd(const Frame& F, const Args& a) {
    LAS float* scr = (LAS float*)(F.lds + F.wave * 8704);
    unsigned char* ws = F.ws;
    bf16_t* W_OIN = (bf16_t*)(ws + OFF_W_OIN); bf16_t* W_OOUT = (bf16_t*)(ws + OFF_W_OOUT); bf16_t* W_M13 = (bf16_t*)(ws + OFF_W_M13); bf16_t* W_M2 = (bf16_t*)(ws + OFF_W_M2);
    constexpr int I_IN = 16 * 96, I_OUT = 16 * 32, I_M1 = 16 * (DFFE / 32), I_M2 = (DFFE / 64) * 32;
    constexpr int NIT = I_IN + I_OUT + NEXP * (2 * I_M1 + I_M2);
    for (int it = F.gw; it < NIT; it += F.NGW) {
        int r = it;
        if (r < I_IN) { transpose_item(a.in[I_OWIN], 1024, 3072, W_OIN, 1024, scr, r, F.lane, RowId{}, KOne{}); continue; } r -= I_IN;
        if (r < I_OUT) { transpose_item(a.in[I_OWOUT], 1024, 1024, W_OOUT, 1024, scr, r, F.lane, RowId{}, KOne{}); continue; } r -= I_OUT;
        const int e = r / (2 * I_M1 + I_M2); r -= e * (2 * I_M1 + I_M2);
        if (r < I_M1) { transpose_item(a.in[I_OM1] + (size_t)e * 1024 * DFFE, 1024, DFFE, W_M13 + (size_t)e * 2 * DFFE * 1024, 1024, scr, r, F.lane, RowIlv{0}, KOne{}); continue; } r -= I_M1;
        if (r < I_M1) { transpose_item(a.in[I_OM3] + (size_t)e * 1024 * DFFE, 1024, DFFE, W_M13 + (size_t)e * 2 * DFFE * 1024, 1024, scr, r, F.lane, RowIlv{128}, KOne{}); continue; } r -= I_M1;
        transpose_item(a.in[I_OM2] + (size_t)e * DFFE * 1024, DFFE, 1024, W_M2 + (size_t)e * 1024 * DFFE, DFFE, scr, r, F.lane, RowId{}, KOne{});
    }
}

__device__ __forceinline__ void load_row_bf16(const bf16_t* row, int lane, f32x4 (&v)[4]) {
#pragma unroll
    for (int j = 0; j < 4; ++j) { const u32x2 w = *(const u32x2*)(row + 4 * lane + 256 * j); v[j] = (f32x4){bflo(w.x), bfhi(w.x), bflo(w.y), bfhi(w.y)}; }
}
__device__ __forceinline__ void store_row_bf16(bf16_t* row, int lane, const f32x4 (&v)[4]) {
#pragma unroll
    for (int j = 0; j < 4; ++j) { u32x2 w; w.x = pk2(v[j][0], v[j][1]); w.y = pk2(v[j][2], v[j][3]); *(u32x2*)(row + 4 * lane + 256 * j) = w; }
}
__device__ __forceinline__ void ln_inplace(f32x4 (&v)[4], const f32x4 (&g)[4], const f32x4 (&b)[4]) {
    float s = 0.f;
#pragma unroll
    for (int j = 0; j < 4; ++j) s += (v[j][0] + v[j][1]) + (v[j][2] + v[j][3]);
    const float mean = wave_sum(s) * (1.f / 1024.f); float q = 0.f;
#pragma unroll
    for (int j = 0; j < 4; ++j) { v[j] = v[j] - mean; q += (v[j][0] * v[j][0] + v[j][1] * v[j][1]) + (v[j][2] * v[j][2] + v[j][3] * v[j][3]); }
    const float rstd = 1.f / sqrtf(wave_sum(q) * (1.f / 1024.f) + 1e-5f);
#pragma unroll
    for (int j = 0; j < 4; ++j) v[j] = v[j] * rstd * g[j] + b[j];
}
__device__ __forceinline__ void load_gb(const float* g, const float* b, int lane, f32x4 (&gv)[4], f32x4 (&bv)[4]) {
#pragma unroll
    for (int j = 0; j < 4; ++j) { gv[j] = *(const f32x4*)(g + 4 * lane + 256 * j); bv[j] = *(const f32x4*)(b + 4 * lane + 256 * j); }
}
__device__ __forceinline__ void phase_ln_bf16(const Frame& F, const bf16_t* S, bf16_t* O, const float* g, const float* b) {
    f32x4 gv[4], bv[4]; load_gb(g, b, F.lane, gv, bv);
    for (int row = F.gw; row < MTOK; row += F.NGW) { f32x4 v[4]; load_row_bf16(S + (size_t)row * 1024, F.lane, v); ln_inplace(v, gv, bv); store_row_bf16(O + (size_t)row * 1024, F.lane, v); }
}
__device__ __forceinline__ void phase_ckvn(const Frame& F, const bf16_t* T1, const float* ssq_kv, const float* gain, bf16_t* CKVN) {
    const float g0 = gain[2 * F.lane], g1 = gain[2 * F.lane + 1];
    for (int row = F.gw; row < MTOK; row += F.NGW) {
        const unsigned w = *(const unsigned*)(T1 + (size_t)row * 256 + 2 * F.lane);
        const f32x4 sq = *(const f32x4*)(ssq_kv + (size_t)row * 4); const float r = __builtin_amdgcn_rsqf(((sq[0] + sq[1]) + (sq[2] + sq[3])) * (1.f / 128.f) + 1e-6f);
        *(unsigned*)(CKVN + (size_t)row * 128 + 2 * F.lane) = pk2(bflo(w) * r * g0, bfhi(w) * r * g1);
    }
}
__device__ __forceinline__ void phase_ln_router(const Frame& F, const bf16_t* S, bf16_t* H2, const float* g, const float* b, const float* router, unsigned char* ws) {
    LAS int* cnt = (LAS int*)(F.lds);
    if (F.tid < 8) cnt[F.tid] = 0;
    __syncthreads();
    f32x4 gv[4], bv[4]; load_gb(g, b, F.lane, gv, bv);
    u32x2* ROUTE = (u32x2*)(ws + OFF_ROUTE);
    for (int row = F.gw; row < MTOK; row += F.NGW) {
        f32x4 v[4]; load_row_bf16(S + (size_t)row * 1024, F.lane, v); ln_inplace(v, gv, bv); store_row_bf16(H2 + (size_t)row * 1024, F.lane, v);
        float lg[8];
#pragma unroll
        for (int x = 0; x < 8; ++x) lg[x] = 0.f;
#pragma unroll
        for (int j = 0; j < 4; ++j)
#pragma unroll
            for (int e = 0; e < 4; ++e) { const float* rp = router + (size_t)(4 * F.lane + 256 * j + e) * 8; const f32x4 r0 = *(const f32x4*)rp, r1 = *(const f32x4*)(rp + 4); const float hv = v[j][e];
                lg[0] += hv * r0[0]; lg[1] += hv * r0[1]; lg[2] += hv * r0[2]; lg[3] += hv * r0[3]; lg[4] += hv * r1[0]; lg[5] += hv * r1[1]; lg[6] += hv * r1[2]; lg[7] += hv * r1[3]; }
#pragma unroll
        for (int x = 0; x < 8; ++x) lg[x] = wave_sum(lg[x]);
        int e0 = 0; float l0 = lg[0];
#pragma unroll
        for (int x = 1; x < 8; ++x) if (lg[x] > l0) { l0 = lg[x]; e0 = x; }
        int e1 = -1; float l1 = -INFINITY;
#pragma unroll
        for (int x = 0; x < 8; ++x) if (x != e0 && lg[x] > l1) { l1 = lg[x]; e1 = x; }
        const float g0 = 1.f / (1.f + __expf(l1 - l0));
        if (F.lane == 0) { u32x2 r; r.x = (unsigned)e0 | ((unsigned)e1 << 8); r.y = __builtin_bit_cast(unsigned, g0); ROUTE[row] = r;
            __hip_atomic_fetch_add(cnt + e0, 1, __ATOMIC_RELAXED, __HIP_MEMORY_SCOPE_WORKGROUP); __hip_atomic_fetch_add(cnt + e1, 1, __ATOMIC_RELAXED, __HIP_MEMORY_SCOPE_WORKGROUP); }
    }
    __syncthreads();
    if (F.tid < 8) ((int*)(ws + OFF_WGCNT))[F.bx * 8 + F.tid] = cnt[F.tid];
    __syncthreads();
}
__device__ __forceinline__ void phase_moe_gather(const Frame& F, const bf16_t* H2, bf16_t* XR, unsigned char* ws) {
    LAS int* L = (LAS int*)(F.lds);
    const int* WGCNT = (const int*)(ws + OFF_WGCNT);
    { const int e = F.wave; int t = 0, p = 0;
#pragma unroll
      for (int k = 0; k < 4; ++k) { const int wg = F.lane + 64 * k; const int c = (wg < F.G) ? WGCNT[wg * 8 + e] : 0; t += c; p += (wg < F.bx) ? c : 0; }
      t = (int)wave_sum((float)t); p = (int)wave_sum((float)p);
      if (F.lane == 0) { L[e] = t; L[8 + e] = p; L[24 + e] = 0; } }
    __syncthreads();
    if (F.tid == 0) { int acc = 0;
        for (int e = 0; e < 8; ++e) { const int pad = (L[e] + 255) / 256 * 256; L[32 + e] = acc; L[16 + e] = acc + L[8 + e]; acc += pad; L[40 + e] = acc; }
        if (F.bx == 0) { int* GI = (int*)(ws + OFF_GINFO); for (int e = 0; e < 8; ++e) { GI[e] = L[40 + e]; GI[8 + e] = L[e]; } } }
    __syncthreads();
    const u32x2* ROUTE = (const u32x2*)(ws + OFF_ROUTE); int* DEST = (int*)(ws + OFF_DEST);
    for (int row = F.gw; row < MTOK; row += F.NGW) {
        const u32x2 r = ROUTE[row]; const int e0 = r.x & 255, e1 = (r.x >> 8) & 255; int s0 = 0, s1 = 0;
        if (F.lane == 0) { s0 = L[16 + e0] + __hip_atomic_fetch_add(L + 24 + e0, 1, __ATOMIC_RELAXED, __HIP_MEMORY_SCOPE_WORKGROUP); s1 = L[16 + e1] + __hip_atomic_fetch_add(L + 24 + e1, 1, __ATOMIC_RELAXED, __HIP_MEMORY_SCOPE_WORKGROUP);
            DEST[2 * row] = s0; DEST[2 * row + 1] = s1; }
        s0 = __builtin_amdgcn_readfirstlane(s0); s1 = __builtin_amdgcn_readfirstlane(s1);
        const u32x4* src = (const u32x4*)(H2 + (size_t)row * 1024); const u32x4 a = src[F.lane], b = src[F.lane + 64];
        u32x4* d0 = (u32x4*)(XR + (size_t)s0 * 1024); u32x4* d1 = (u32x4*)(XR + (size_t)s1 * 1024);
        d0[F.lane] = a; d0[F.lane + 64] = b; d1[F.lane] = a; d1[F.lane + 64] = b;
    }
    for (int e = 0; e < 8; ++e) { const int r0 = L[32 + e] + L[e], npad = L[40 + e] - r0;
        for (int i = F.gw; i < npad; i += F.NGW) { u32x4* d = (u32x4*)(XR + (size_t)(r0 + i) * 1024); d[F.lane] = (u32x4){0u, 0u, 0u, 0u}; d[F.lane + 64] = (u32x4){0u, 0u, 0u, 0u}; } }
    __syncthreads();
}
__device__ __forceinline__ void phase_final(const Frame& F, const bf16_t* H2, const bf16_t* YR, const float* g, const float* b, float* out, unsigned char* ws) {
    f32x4 gv[4], bv[4]; load_gb(g, b, F.lane, gv, bv);
    const u32x2* ROUTE = (const u32x2*)(ws + OFF_ROUTE); const int* DEST = (const int*)(ws + OFF_DEST);
    for (int row = F.gw; row < MTOK; row += F.NGW) {
        const u32x2 rte = ROUTE[row]; const float g0 = __uint_as_float(rte.y), g1 = 1.f - g0;   const int d0 = DEST[2 * row], d1 = DEST[2 * row + 1];
        f32x4 v[4], y0[4], y1[4]; load_row_bf16(H2 + (size_t)row * 1024, F.lane, v); load_row_bf16(YR + (size_t)d0 * 1024, F.lane, y0); load_row_bf16(YR + (size_t)d1 * 1024, F.lane, y1);
#pragma unroll
        for (int j = 0; j < 4; ++j) v[j] = v[j] * ALPHA + y0[j] * g0 + y1[j] * g1;
        ln_inplace(v, gv, bv);
#pragma unroll
        for (int j = 0; j < 4; ++j) *(f32x4*)(out + (size_t)row * 1024 + 4 * F.lane + 256 * j) = v[j];
    }
}

namespace att {
constexpr float NEG_BIG = -1e30f;
constexpr int KS64 = 144, VS64 = 192, KT64 = 64 * KS64, VT64 = 64 * VS64;
constexpr int KS128 = 272, VS128 = 320, KT128 = 64 * KS128, VT128 = 64 * VS128;
typedef LAS char* lptr; typedef const LAS char* lcptr;
typedef short v4i16_t __attribute__((ext_vector_type(4)));
__device__ __forceinline__ s16x4 vtr(lcptr p) { return __builtin_bit_cast(s16x4, __builtin_amdgcn_ds_read_tr16_b64_v4i16((LAS v4i16_t*)p)); }
__device__ __forceinline__ f32x16 splat16(float c) { f32x16 v;
#pragma unroll
    for (int r = 0; r < 16; ++r) v[r] = c; return v; }
__device__ __forceinline__ int crow(int r, int hi) { return (r & 3) + 8 * (r >> 2) + 4 * hi; }
__device__ __forceinline__ float ex2(float x) { return __builtin_amdgcn_exp2f(x); }

template <int NKS> __device__ __forceinline__ void qk(f32x16& s0, f32x16& s1, lcptr Kt, int kstride, const bf16x8 (&qf)[NKS], float c0, int r32, int hi) {
    s0 = splat16(c0); s1 = splat16(c0);
    lcptr p0 = Kt + r32 * kstride + hi * 16; lcptr p1 = p0 + 32 * kstride;
#pragma unroll
    for (int ks = 0; ks < NKS; ++ks) { const bf16x8 k0 = *(const LAS bf16x8*)(p0 + ks * 32), k1 = *(const LAS bf16x8*)(p1 + ks * 32);
        s0 = __builtin_amdgcn_mfma_f32_32x32x16_bf16(k0, qf[ks], s0, 0, 0, 0); s1 = __builtin_amdgcn_mfma_f32_32x32x16_bf16(k1, qf[ks], s1, 0, 0, 0); }
}
__device__ __forceinline__ float rowmax32(const f32x16& s0, const f32x16& s1) {
    float a = fmaxf(s0[0], s1[0]);
#pragma unroll
    for (int r = 1; r < 16; ++r) a = fmaxf(a, fmaxf(s0[r], s1[r]));
    return fmaxf(a, __shfl_xor(a, 32));
}
template <int NDT> __device__ __forceinline__ void softmax_step(f32x16& s0, f32x16& s1, float& m, float& l, f32x16 (&o)[NDT]) {
    const float mn = fmaxf(m, rowmax32(s0, s1)); const float al = ex2(m - mn); m = mn; float rs = 0.f;
#pragma unroll
    for (int r = 0; r < 16; ++r) { s0[r] = ex2(s0[r] - mn); s1[r] = ex2(s1[r] - mn); rs += s0[r] + s1[r]; }
    l = l * al + rs;
#pragma unroll
    for (int d = 0; d < NDT; ++d)
#pragma unroll
        for (int r = 0; r < 16; ++r) o[d][r] *= al;
}
__device__ __forceinline__ bf16x8 pack_p(const f32x16& s, int base) { u32x4 w; w.x = pk2(s[base], s[base + 1]); w.y = pk2(s[base + 2], s[base + 3]); w.z = pk2(s[base + 4], s[base + 5]); w.w = pk2(s[base + 6], s[base + 7]); return __builtin_bit_cast(bf16x8, w); }
template <int NDT> __device__ __forceinline__ void pv(f32x16 (&o)[NDT], const f32x16& s0, const f32x16& s1, lcptr Vt, int vstride, int lane) {
    const bf16x8 pk[4] = {pack_p(s0, 0), pack_p(s0, 8), pack_p(s1, 0), pack_p(s1, 8)};
    const int h = lane >> 5, g = (lane >> 4) & 1, q = (lane & 15) >> 2, p = lane & 3;
    lcptr vb = Vt + (4 * h + q) * vstride + (16 * g + 4 * p) * 2;
#pragma unroll
    for (int k = 0; k < 4; ++k)
#pragma unroll
        for (int d = 0; d < NDT; ++d) { const s16x4 lo = vtr(vb + (16 * k) * vstride + d * 64), hh = vtr(vb + (16 * k + 8) * vstride + d * 64);
            const bf16x8 vf = (bf16x8){lo[0], lo[1], lo[2], lo[3], hh[0], hh[1], hh[2], hh[3]};
            o[d] = __builtin_amdgcn_mfma_f32_32x32x16_bf16(vf, pk[k], o[d], 0, 0, 0); }
}
__device__ __forceinline__ void bias_mask_near(f32x16& s0, f32x16& s1, const LAS float* bt, int t, int kp0, int hi, unsigned maxdist) {
#pragma unroll
    for (int r = 0; r < 16; ++r) { const int d0 = t - (kp0 + crow(r, hi)), d1 = d0 - 32;
        const unsigned i0 = (unsigned)d0 < 127u ? (unsigned)d0 : 127u, i1 = (unsigned)d1 < 127u ? (unsigned)d1 : 127u;
        s0[r] = ((unsigned)d0 < maxdist) ? s0[r] + bt[i0] : -INFINITY; s1[r] = ((unsigned)d1 < maxdist) ? s1[r] + bt[i1] : -INFINITY; }
}
__device__ __forceinline__ void mask_all(f32x16& s0, f32x16& s1) {
#pragma unroll
    for (int r = 0; r < 16; ++r) { s0[r] = -INFINITY; s1[r] = -INFINITY; }
}
__device__ __forceinline__ void store_o64(bf16_t* orow, const f32x16 (&o)[2], float sc, int hi) {
#pragma unroll
    for (int d = 0; d < 2; ++d)
#pragma unroll
        for (int rg = 0; rg < 4; ++rg) { u32x2 w; w.x = pk2(o[d][4 * rg] * sc, o[d][4 * rg + 1] * sc); w.y = pk2(o[d][4 * rg + 2] * sc, o[d][4 * rg + 3] * sc);
            *(u32x2*)(orow + 32 * d + 8 * rg + 4 * hi) = w; }
}
template <class Src, class Proc> __device__ __forceinline__ void tile_loop64(int tid, lptr base, int nt, int pitch, Src src, Proc proc) {
    if (nt <= 0) return;
    const int row = tid >> 3, ch = tid & 7; u32x4 kr, vr;
    lptr Kb = base, Vb = base + 2 * KT64;
    { const bf16_t *kp, *vp; src(0, kp, vp); kr = *(const u32x4*)(kp + (size_t)row * pitch + ch * 8); vr = *(const u32x4*)(vp + (size_t)row * pitch + ch * 8); }
    *(LAS u32x4*)(Kb + row * KS64 + ch * 16) = kr; *(LAS u32x4*)(Vb + row * VS64 + ch * 16) = vr;
    __syncthreads();
    for (int i = 0; i < nt; ++i) {
        const bool more = i + 1 < nt;
        if (more) { const bf16_t *kp, *vp; src(i + 1, kp, vp); kr = *(const u32x4*)(kp + (size_t)row * pitch + ch * 8); vr = *(const u32x4*)(vp + (size_t)row * pitch + ch * 8); }
        proc(i, (lcptr)(Kb + (i & 1) * KT64), (lcptr)(Vb + (i & 1) * VT64));
        if (more) { *(LAS u32x4*)(Kb + ((i + 1) & 1) * KT64 + row * KS64 + ch * 16) = kr; *(LAS u32x4*)(Vb + ((i + 1) & 1) * VT64 + row * VS64 + ch * 16) = vr; }
        __syncthreads();
    }
}
constexpr int TL64_BYTES = 2 * KT64 + 2 * VT64;
}

__device__ __forceinline__ void moba_unit(const Frame& F, int b, int h, int qb, bf16_t* Q, const bf16_t* K, const bf16_t* V, const float* KMEAN, const float* BT) {
    using namespace att;
    const int lane = F.lane, r32 = lane & 31, hi = lane >> 5, w = F.wave;
    lptr lds = (lptr)F.lds; lptr tl = lds; LAS float* BTL = (LAS float*)(lds + TL64_BYTES); lptr KM = lds + TL64_BYTES + 512;
    const int t = 256 * qb + 32 * w + r32; const size_t row = (size_t)b * SEQ + t;
    bf16x8 qf[4];
#pragma unroll
    for (int ks = 0; ks < 4; ++ks) qf[ks] = *(const bf16x8*)(Q + row * 1024 + h * 64 + 16 * ks + 8 * hi);
    if (F.tid < 128) BTL[F.tid] = BT[h * 128 + F.tid];
    { const int idx = F.tid * 2, j = idx >> 6, d = idx & 63; const float* kmp = KMEAN + (size_t)(b * 16 + j) * 2048 + h * 64 + d;
      *(LAS unsigned*)(KM + j * KS64 + d * 2) = (j < qb) ? pk2(kmp[0] + kmp[1024], kmp[1] + kmp[1025]) : 0u;
      *(LAS unsigned*)(KM + (16 + j) * KS64 + d * 2) = 0u; }
    __syncthreads();
    unsigned selmask = 0u;
    if (qb > 0) {
        f32x16 gs = splat16(0.f);
        { lcptr p0 = (lcptr)KM + r32 * KS64 + hi * 16;
#pragma unroll
          for (int ks = 0; ks < 4; ++ks) { const bf16x8 k0 = *(const LAS bf16x8*)(p0 + ks * 32); gs = __builtin_amdgcn_mfma_f32_32x32x16_bf16(k0, qf[ks], gs, 0, 0, 0); } }
        float glo[8], ghi[8];
#pragma unroll
        for (int r = 0; r < 8; ++r) { const float mine = gs[r], oth = __shfl_xor(mine, 32); glo[r] = hi ? oth : mine; ghi[r] = hi ? mine : oth; }
#pragma unroll
        for (int rep = 0; rep < 3; ++rep) { float best = -INFINITY; int bj = -1;
#pragma unroll
            for (int j = 0; j < 16; ++j) { const int r = (j & 3) + 4 * (j >> 3); const float gv = ((j >> 2) & 1) ? ghi[r] : glo[r];
                if (j < qb && !((selmask >> j) & 1u) && gv > best) { best = gv; bj = j; } }
            if (bj >= 0) selmask |= 1u << bj; }
    }
    f32x16 o[2] = {splat16(0.f), splat16(0.f)}; float m = NEG_BIG, l = 0.f;
    const int nt = 4 * (qb + 1); const int twmax = 256 * qb + 32 * w + 31;
    const bf16_t* Kh = K + (size_t)b * SEQ * 1024 + h * 64; const bf16_t* Vh = V + (size_t)b * SEQ * 1024 + h * 64;
    const float cfar = BTL[127];
    tile_loop64(F.tid, tl, nt, 1024,
        [&](int i, const bf16_t*& kp, const bf16_t*& vp) { kp = Kh + (size_t)(64 * i) * 1024; vp = Vh + (size_t)(64 * i) * 1024; },
        [&](int i, lcptr Kt, lcptr Vt) {
            const int blk = i >> 2, kp0 = 64 * i; f32x16 s0, s1;
            if (blk < qb) {
                const bool sel = (selmask >> blk) & 1u;
                if (!__any(sel)) return;
                if (blk < qb - 1 || (i & 3) < 2) { qk<4>(s0, s1, Kt, KS64, qf, cfar, r32, hi); }
                else { qk<4>(s0, s1, Kt, KS64, qf, 0.f, r32, hi); bias_mask_near(s0, s1, BTL, t, kp0, hi, 0x7fffffffu); }
                if (!sel) mask_all(s0, s1);
            } else {
                if (kp0 > twmax) return;
                qk<4>(s0, s1, Kt, KS64, qf, 0.f, r32, hi); bias_mask_near(s0, s1, BTL, t, kp0, hi, 0x7fffffffu);
            }
            softmax_step<2>(s0, s1, m, l, o); pv<2>(o, s0, s1, Vt, VS64, lane);
        });
    l += __shfl_xor(l, 32);
    store_o64(Q + row * 1024 + h * 64, o, l > 0.f ? 1.f / l : 0.f, hi);
}
__device__ __forceinline__ void phase_moba(const Frame& F, unsigned char* ws) {
    bf16_t* Q = (bf16_t*)(ws + OFF_QKV); const bf16_t* K = Q + (size_t)MTOK * 1024; const bf16_t* V = K + (size_t)MTOK * 1024;
    const float* KMEAN = (const float*)(ws + OFF_KMEAN); const float* BT = (const float*)(ws + OFF_BT);
    for (int idx = F.bx; idx < 2048; idx += F.G) { const int i = idx >> 8, v = idx & 255, b = v >> 5, h = (v & 31) >> 1, half = v & 1, p = half * 4 + (i >> 1), qb = (i & 1) ? 15 - p : p;
        moba_unit(F, b, h, qb, Q, K, V, KMEAN, BT); __syncthreads(); }
}

__device__ __forceinline__ void nsa_unit(const Frame& F, int b, int g, int c, const bf16_t* Y1, const bf16_t* KC, const bf16_t* VC, const float* BT, bf16_t* MIXIN) {
    using namespace att;
    const int lane = F.lane, r32 = lane & 31, hi = lane >> 5, w = F.wave;
    lptr lds = (lptr)F.lds; lptr tl = lds; LAS float* BTL = (LAS float*)(lds + TL64_BYTES);
    LAS float* SCB = (LAS float*)(lds + TL64_BYTES + 2048);
    LAS unsigned long long* SELM = (LAS unsigned long long*)(lds + TL64_BYTES + 2048 + 16384);
    lptr OFL = lds + TL64_BYTES + 2048 + 16384 + 1024 + w * 8704 + r32 * 272 + hi * 16;
    const int n = r32 & 3, tok = 8 * w + (r32 >> 2), t = 64 * c + tok; const size_t row = (size_t)b * SEQ + t;
    const bf16_t* T1 = Y1 + (size_t)1 * MTOK * 256; const bf16_t* QB = Y1 + (size_t)(2 + g) * MTOK * 256;
    const bf16_t* KVS = Y1 + (size_t)5 * MTOK * 256; const bf16_t* KVW = Y1 + (size_t)6 * MTOK * 256;
    bf16x8 qf[4];
#pragma unroll
    for (int ks = 0; ks < 4; ++ks) qf[ks] = *(const bf16x8*)(QB + row * 256 + n * 64 + 16 * ks + 8 * hi);
    float gate[3];
#pragma unroll
    for (int j = 0; j < 3; ++j) { const float x = bf2f(T1[row * 256 + 208 + (4 * g + n) * 3 + j]); gate[j] = 1.f / (1.f + __expf(-x)); }
    for (int i = F.tid; i < 512; i += NTHR) BTL[i] = BT[(8 + 4 * g) * 128 + i];
    for (int i = F.tid; i < 4096; i += NTHR) SCB[i] = 0.f;
    __syncthreads();
    const LAS float* bt = BTL + n * 128; const float cfar = bt[127];
    const int vis = (t >= 31) ? ((t - 31) >> 4) : -1;
    const int ntc = ((4 * c + 2) >> 6) + 1;
    const bf16_t* KCg = KC + ((size_t)b * 256 * 2 + g) * 64; const bf16_t* VCg = VC + ((size_t)b * 256 * 2 + g) * 64;
    auto cmp_scores = [&](int i, lcptr Kt, f32x16& s0, f32x16& s1) {
        qk<4>(s0, s1, Kt, KS64, qf, 0.f, r32, hi);
#pragma unroll
        for (int r = 0; r < 16; ++r) { const int c0 = 64 * i + crow(r, hi), c1 = c0 + 32; const int d0 = t - 16 * c0 - 31, d1 = d0 - 512;
            const unsigned i0 = (unsigned)d0 < 127u ? (unsigned)d0 : 127u, i1 = (unsigned)d1 < 127u ? (unsigned)d1 : 127u;
            s0[r] = (c0 <= vis) ? s0[r] + bt[i0] : -INFINITY; s1[r] = (c1 <= vis) ? s1[r] + bt[i1] : -INFINITY; }
    };
    float mc = NEG_BIG, lc = 0.f;
    tile_loop64(F.tid, tl, ntc, 128,
        [&](int i, const bf16_t*& kp, const bf16_t*& vp) { kp = KCg + (size_t)(64 * i) * 128; vp = VCg + (size_t)(64 * i) * 128; },
        [&](int i, lcptr Kt, lcptr Vt) { f32x16 s0, s1; cmp_scores(i, Kt, s0, s1);
            const float mn = fmaxf(mc, rowmax32(s0, s1)); float rs = 0.f;
#pragma unroll
            for (int r = 0; r < 16; ++r) rs += ex2(s0[r] - mn) + ex2(s1[r] - mn);
            lc = lc * ex2(mc - mn) + rs; mc = mn; });
    lc += __shfl_xor(lc, 32);
    const float invc = lc > 0.f ? 1.f / lc : 0.f;
    {
        f32x16 o[2] = {splat16(0.f), splat16(0.f)}; float carry = 0.f;
        tile_loop64(F.tid, tl, ntc, 128,
            [&](int i, const bf16_t*& kp, const bf16_t*& vp) { kp = KCg + (size_t)(64 * i) * 128; vp = VCg + (size_t)(64 * i) * 128; },
            [&](int i, lcptr Kt, lcptr Vt) { f32x16 s0, s1; cmp_scores(i, Kt, s0, s1);
#pragma unroll
                for (int r = 0; r < 16; ++r) { s0[r] = ex2(s0[r] - mc) * invc; s1[r] = ex2(s1[r] - mc) * invc; }
                float x0[4], x1[4];
#pragma unroll
                for (int rg = 0; rg < 4; ++rg) { x0[rg] = __shfl_xor(s0[4 * rg + 3], 32); x1[rg] = __shfl_xor(s1[4 * rg + 3], 32); }
#pragma unroll
                for (int rg = 0; rg < 4; ++rg) {
                    float g0 = (s0[4 * rg] + s0[4 * rg + 1]) + (s0[4 * rg + 2] + s0[4 * rg + 3]), g1 = (s1[4 * rg] + s1[4 * rg + 1]) + (s1[4 * rg + 2] + s1[4 * rg + 3]);
                    const float e0 = hi ? x0[rg] : (rg > 0 ? x0[rg > 0 ? rg - 1 : 0] : carry), e1 = hi ? x1[rg] : (rg > 0 ? x1[rg > 0 ? rg - 1 : 0] : x0[3]);
                    g0 += e0; g1 += e1;
                    g0 += __shfl_xor(g0, 1); g0 += __shfl_xor(g0, 2); g1 += __shfl_xor(g1, 1); g1 += __shfl_xor(g1, 2);
                    if (n == 0) { SCB[tok * 64 + 16 * i + 2 * rg + hi] = g0; SCB[tok * 64 + 16 * i + 8 + 2 * rg + hi] = g1; }
                }
                carry = x1[3];
                pv<2>(o, s0, s1, Vt, VS64, lane); });
#pragma unroll
        for (int d = 0; d < 2; ++d)
#pragma unroll
            for (int rg = 0; rg < 4; ++rg) *(LAS f32x4*)(OFL + d * 128 + rg * 32) = (f32x4){o[d][4 * rg], o[d][4 * rg + 1], o[d][4 * rg + 2], o[d][4 * rg + 3]} * gate[0];
    }
    {
        unsigned long long uni = 0ull;
#pragma unroll 1
        for (int tk = 0; tk < 8; ++tk) { const int tk2 = 8 * w + tk; float v = SCB[tk2 * 64 + lane];
            v = (lane > c) ? -INFINITY : ((lane == 0 || lane == c || lane == c - 1) ? INFINITY : v);
            int cnt = 0;
#pragma unroll
            for (int j = 0; j < 64; ++j) { const float vj = __builtin_bit_cast(float, __builtin_amdgcn_readlane(__builtin_bit_cast(int, v), j)); cnt += (vj > v || (vj == v && j < lane)) ? 1 : 0; }
            const unsigned long long mk = __ballot(cnt < 16 && lane <= c);
            if (lane == 0) SELM[tk2] = mk;
            uni |= mk; }
        if (lane == 0) SELM[64 + w] = uni;
    }
    __syncthreads();
    const unsigned long long mymask = SELM[tok];
    unsigned long long uni = 0ull;
#pragma unroll
    for (int k = 0; k < 8; ++k) uni |= SELM[64 + k];
    {
        f32x16 o[2] = {splat16(0.f), splat16(0.f)}; float m = NEG_BIG, l = 0.f;
        const int nsel = __popcll(uni);
        const bf16_t* Kg = KVS + (size_t)b * SEQ * 256 + g * 64; const bf16_t* Vg = Kg + 128;
        unsigned long long rem_src = uni, rem_proc = uni;
        tile_loop64(F.tid, tl, nsel, 256,
            [&](int i, const bf16_t*& kp, const bf16_t*& vp) { const int j = __builtin_ctzll(rem_src); rem_src &= rem_src - 1; kp = Kg + (size_t)(64 * j) * 256; vp = Vg + (size_t)(64 * j) * 256; },
            [&](int i, lcptr Kt, lcptr Vt) { const int j = __builtin_ctzll(rem_proc); rem_proc &= rem_proc - 1;
                const bool sel = (mymask >> j) & 1ull;
                if (!__any(sel)) return;
                f32x16 s0, s1;
                if (j < c - 2) qk<4>(s0, s1, Kt, KS64, qf, cfar, r32, hi);
                else { qk<4>(s0, s1, Kt, KS64, qf, 0.f, r32, hi); bias_mask_near(s0, s1, bt, t, 64 * j, hi, 0x7fffffffu); }
                if (!sel) mask_all(s0, s1);
                softmax_step<2>(s0, s1, m, l, o); pv<2>(o, s0, s1, Vt, VS64, lane); });
        l += __shfl_xor(l, 32); const float f = gate[1] * (l > 0.f ? 1.f / l : 0.f);
#pragma unroll
        for (int d = 0; d < 2; ++d)
#pragma unroll
            for (int rg = 0; rg < 4; ++rg) *(LAS f32x4*)(OFL + d * 128 + rg * 32) += (f32x4){o[d][4 * rg], o[d][4 * rg + 1], o[d][4 * rg + 2], o[d][4 * rg + 3]} * f;
    }
    {
        f32x16 o[2] = {splat16(0.f), splat16(0.f)}; float m = NEG_BIG, l = 0.f;
        const int k0 = c >= 8 ? c - 8 : 0, ntw = c - k0 + 1;
        const bf16_t* Kg = KVW + (size_t)b * SEQ * 256 + g * 64; const bf16_t* Vg = Kg + 128;
        tile_loop64(F.tid, tl, ntw, 256,
            [&](int i, const bf16_t*& kp, const bf16_t*& vp) { kp = Kg + (size_t)(64 * (k0 + i)) * 256; vp = Vg + (size_t)(64 * (k0 + i)) * 256; },
            [&](int i, lcptr Kt, lcptr Vt) { const int kt = k0 + i; f32x16 s0, s1;
                if (kt < c - 2 && kt > c - 8) qk<4>(s0, s1, Kt, KS64, qf, cfar, r32, hi);
                else { qk<4>(s0, s1, Kt, KS64, qf, 0.f, r32, hi); bias_mask_near(s0, s1, bt, t, 64 * kt, hi, 512u); }
                softmax_step<2>(s0, s1, m, l, o); pv<2>(o, s0, s1, Vt, VS64, lane); });
        l += __shfl_xor(l, 32); const float f = gate[2] * (l > 0.f ? 1.f / l : 0.f);
        bf16_t* orow = MIXIN + row * 1536 + 1024 + (4 * g + n) * 64;
#pragma unroll
        for (int d = 0; d < 2; ++d)
#pragma unroll
            for (int rg = 0; rg < 4; ++rg) { const f32x4 v = *(LAS f32x4*)(OFL + d * 128 + rg * 32) + (f32x4){o[d][4 * rg], o[d][4 * rg + 1], o[d][4 * rg + 2], o[d][4 * rg + 3]} * f;
                u32x2 wv; wv.x = pk2(v[0], v[1]); wv.y = pk2(v[2], v[3]); *(u32x2*)(orow + 32 * d + 8 * rg + 4 * hi) = wv; }
    }
}

__device__ __forceinline__ void dsa_unit(const Frame& F, int b, int u, const bf16_t* QLAT, const bf16_t* CKVN, const unsigned* MASK, const float* BT, bf16_t* MIXIN) {
    using namespace att;
    const int lane = F.lane, r32 = lane & 31, hi = lane >> 5, w = F.wave, tid = F.tid;
    lptr lds = (lptr)F.lds; constexpr int STG = KT128 + VT128; LAS float* BTL = (LAS float*)(lds + 2 * STG);
    const int head = r32 & 7, q0 = 32 * u, t = q0 + 4 * w + (r32 >> 3); const size_t row = (size_t)b * SEQ + t;
    bf16x8 qf[8];
#pragma unroll
    for (int ks = 0; ks < 8; ++ks) qf[ks] = *(const bf16x8*)(QLAT + row * 1024 + head * 128 + 16 * ks + 8 * hi);
    for (int i = tid; i < 1024; i += NTHR) BTL[i] = BT[i];
    const LAS float* bt = BTL + head * 128;
    f32x16 o[4] = {splat16(0.f), splat16(0.f), splat16(0.f), splat16(0.f)}; float m = NEG_BIG, l = 0.f;
    const int nt = ((q0 + 31) >> 6) + 1;
    const bf16_t* Cb = CKVN + (size_t)b * SEQ * 128; const unsigned* mrow = MASK + row * 128;
    u32x4 st[2];
    auto gload = [&](int i) {
#pragma unroll
        for (int k = 0; k < 2; ++k) { const int idx = tid + 512 * k, rr = idx >> 4, ch = idx & 15; st[k] = *(const u32x4*)(Cb + (size_t)(64 * i + rr) * 128 + ch * 8); } };
    auto lstore = [&](int buf) {
#pragma unroll
        for (int k = 0; k < 2; ++k) { const int idx = tid + 512 * k, rr = idx >> 4, ch = idx & 15; *(LAS u32x4*)(lds + buf * STG + rr * KS128 + ch * 16) = st[k]; *(LAS u32x4*)(lds + buf * STG + KT128 + rr * VS128 + ch * 16) = st[k]; } };
    gload(0); lstore(0); __syncthreads();
    const float cfar = bt[127];
    for (int i = 0; i < nt; ++i) {
        const bool more = i + 1 < nt;
        if (more) gload(i + 1);
        {
            lcptr Kt = (lcptr)(lds + (i & 1) * STG); lcptr Vt = Kt + KT128;
            const u32x2 mw = *(const u32x2*)(mrow + 2 * i);
            f32x16 s0, s1;
            const bool near = (q0 - (64 * i + 63)) < 128;
            qk<8>(s0, s1, Kt, KS128, qf, near ? 0.f : cfar, r32, hi);
            const unsigned w0 = mw.x >> (4 * hi), w1 = mw.y >> (4 * hi);
            if (near) {
#pragma unroll
                for (int r = 0; r < 16; ++r) { const int d0 = t - (64 * i + crow(r, hi)), d1 = d0 - 32;
                    const unsigned i0 = (unsigned)d0 < 127u ? (unsigned)d0 : 127u, i1 = (unsigned)d1 < 127u ? (unsigned)d1 : 127u;
                    s0[r] += bt[i0]; s1[r] += bt[i1]; }
            }
#pragma unroll
            for (int r = 0; r < 16; ++r) { const int bit = (r & 3) + 8 * (r >> 2);
                s0[r] = ((w0 >> bit) & 1u) ? s0[r] : -INFINITY; s1[r] = ((w1 >> bit) & 1u) ? s1[r] : -INFINITY; }
            softmax_step<4>(s0, s1, m, l, o); pv<4>(o, s0, s1, Vt, VS128, lane);
        }
        if (more) lstore((i + 1) & 1);
        __syncthreads();
    }
    l += __shfl_xor(l, 32); const float f = l > 0.f ? 1.f / l : 0.f;
    bf16_t* orow = MIXIN + row * 1536 + head * 128;
#pragma unroll
    for (int d = 0; d < 4; ++d)
#pragma unroll
        for (int rg = 0; rg < 4; ++rg) { u32x2 wv; wv.x = pk2(o[d][4 * rg] * f, o[d][4 * rg + 1] * f); wv.y = pk2(o[d][4 * rg + 2] * f, o[d][4 * rg + 3] * f);
            *(u32x2*)(orow + 32 * d + 8 * rg + 4 * hi) = wv; }
}

constexpr int QI_STRIDE = 2064;
__device__ __forceinline__ void indexer_unit(const Frame& F, int b, int c, const bf16_t* QIDX, const bf16_t* T1, _Float16* SC) {
    using namespace att;
    const int lane = F.lane, r32 = lane & 31, hi = lane >> 5, w = F.wave, tid = F.tid;
    lptr lds = (lptr)F.lds; lptr QI = lds; lptr KI = lds + 64 * QI_STRIDE;
    const int qh = w & 1, kq = w >> 1;
    const size_t row0 = (size_t)b * SEQ + 64 * c;
#pragma unroll 4
    for (int k = 0; k < 16; ++k) { const int idx = tid + 512 * k, rr = idx >> 7, ch = idx & 127; *(LAS u32x4*)(QI + rr * QI_STRIDE + ch * 16) = *(const u32x4*)(QIDX + (row0 + rr) * 1024 + ch * 8); }
    float wv[16];
    { const size_t trow = row0 + 32 * qh + r32; const u32x4 a = *(const u32x4*)(T1 + trow * 256 + 192), bq = *(const u32x4*)(T1 + trow * 256 + 200);
      wv[0] = bflo(a.x); wv[1] = bfhi(a.x); wv[2] = bflo(a.y); wv[3] = bfhi(a.y); wv[4] = bflo(a.z); wv[5] = bfhi(a.z); wv[6] = bflo(a.w); wv[7] = bfhi(a.w);
      wv[8] = bflo(bq.x); wv[9] = bfhi(bq.x); wv[10] = bflo(bq.y); wv[11] = bfhi(bq.y); wv[12] = bflo(bq.z); wv[13] = bfhi(bq.z); wv[14] = bflo(bq.w); wv[15] = bfhi(bq.w); }
    const int nsup = (c + 2) >> 1, pitch = (c + 1) * 64;
    _Float16* srow = SC + (size_t)b * SCB_ELEMS + (size_t)4096 * (c * (c + 1) / 2) + (size_t)(32 * qh + r32) * pitch;
    const bf16_t* Kb = T1 + (size_t)b * SEQ * 256 + 128;
    u32x4 st[2];
    for (int s = 0; s < nsup; ++s) {
#pragma unroll
        for (int k = 0; k < 2; ++k) { const int idx = tid + 512 * k, rr = idx >> 3, ch = idx & 7; st[k] = *(const u32x4*)(Kb + (size_t)(128 * s + rr) * 256 + ch * 8); }
        __syncthreads();
#pragma unroll
        for (int k = 0; k < 2; ++k) { const int idx = tid + 512 * k, rr = idx >> 3, ch = idx & 7; *(LAS u32x4*)(KI + rr * KS64 + ch * 16) = st[k]; }
        __syncthreads();
        const int key0 = 128 * s + 32 * kq;
        if (key0 <= 64 * c + 63) {
            bf16x8 kf[4];
#pragma unroll
            for (int ks = 0; ks < 4; ++ks) kf[ks] = *(const LAS bf16x8*)(KI + (32 * kq + r32) * KS64 + ks * 32 + hi * 16);
            f32x16 sc = splat16(0.f);
            lcptr qp = (lcptr)QI + (32 * qh + r32) * QI_STRIDE + hi * 16;
#pragma unroll 4
            for (int hd = 0; hd < 16; ++hd) { f32x16 acc = splat16(0.f);
#pragma unroll
                for (int ks = 0; ks < 4; ++ks) { const bf16x8 qv = *(const LAS bf16x8*)(qp + hd * 128 + ks * 32); acc = __builtin_amdgcn_mfma_f32_32x32x16_bf16(kf[ks], qv, acc, 0, 0, 0); }
                const float ww = wv[hd];
#pragma unroll
                for (int r = 0; r < 16; ++r) sc[r] += ww * fmaxf(acc[r], 0.f); }
#pragma unroll
            for (int rg = 0; rg < 4; ++rg) { f32x2 a = {sc[4 * rg], sc[4 * rg + 1]}, bq = {sc[4 * rg + 2], sc[4 * rg + 3]};
                u32x2 o; o.x = __builtin_bit_cast(unsigned, __builtin_convertvector(a, f16x2_t)); o.y = __builtin_bit_cast(unsigned, __builtin_convertvector(bq, f16x2_t));
                *(u32x2*)(srow + key0 + 8 * rg + 4 * hi) = o; }
        }
    }
    __syncthreads();
}

__device__ __forceinline__ void phase_select(const Frame& F, const _Float16* SC, unsigned* MASK) {
    const int lane = F.lane;
    for (int row = F.gw; row < MTOK; row += F.NGW) {
        const int b = row >> 12, t = row & 4095, c = t >> 6, nk = (c + 1) * 64;
        const unsigned short* src = (const unsigned short*)SC + (size_t)b * SCB_ELEMS + (size_t)4096 * (c * (c + 1) / 2) + (size_t)(t & 63) * nk;
        unsigned* mrow = MASK + (size_t)row * 128;
        if (t < 256) {
            for (int j = 0; j <= c; ++j) { const unsigned long long mk = __ballot(64 * j + lane <= t); if (lane == 0) *(u32x2*)(mrow + 2 * j) = (u32x2){(unsigned)mk, (unsigned)(mk >> 32)}; }
            continue;
        }
        unsigned key[64];
#pragma unroll
        for (int j = 0; j < 64; ++j) { unsigned k = 0u;
            if (j <= c) { const unsigned uu = src[64 * j + lane]; k = (uu & 0x8000u) ? (~uu & 0xffffu) : (uu | 0x8000u); if (64 * j + lane > t) k = 0u; }
            key[j] = k; }
        unsigned prefix = 0u;
#pragma unroll 1
        for (int bit = 15; bit >= 0; --bit) { const unsigned cand = prefix | (1u << bit); int cnt = 0;
#pragma unroll
            for (int j = 0; j < 64; ++j) cnt += (key[j] >= cand) ? 1 : 0;
            cnt = (int)wave_sum((float)cnt);
            if (cnt >= 256) prefix = cand; }
        int cgt = 0;
#pragma unroll
        for (int j = 0; j < 64; ++j) cgt += (key[j] > prefix) ? 1 : 0;
        cgt = (int)wave_sum((float)cgt);
        int rem = 256 - cgt;
#pragma unroll
        for (int j = 0; j < 64; ++j) {
            if (j <= c) {
                const bool eq = key[j] == prefix; const unsigned long long eqm = __ballot(eq);
                const int before = __builtin_amdgcn_mbcnt_hi((unsigned)(eqm >> 32), __builtin_amdgcn_mbcnt_lo((unsigned)eqm, 0u));
                const unsigned long long mk = __ballot(key[j] > prefix || (eq && before < rem));
                rem -= __popcll(eqm); rem = rem < 0 ? 0 : rem;
                if (lane == 0) *(u32x2*)(mrow + 2 * j) = (u32x2){(unsigned)mk, (unsigned)(mk >> 32)};
            }
        }
    }
}

__device__ __forceinline__ float gelu_tanh(float x) { const float u = 0.7978845608028654f * (x + 0.044715f * x * x * x); const float e = __expf(2.f * u); return 0.5f * x * (1.f + (1.f - 2.f / (e + 1.f))); }
__device__ __forceinline__ void compress_unit(const Frame& F, int b, int g, int kv, int rt, const bf16_t* KVC, const bf16_t* W1T, const float* w2, const float* cb, bf16_t* OUT) {
    const int lane = F.lane, r32 = lane & 31, hi = lane >> 5, w = F.wave, tid = F.tid;
    LAS float* PART = (LAS float*)F.lds;
    LAS float* HID = PART + 8 * 2048;
    const int n0 = 32 * rt, nn = n0 + r32, nc = nn < 255 ? nn : 254;
    const bf16_t* arow = KVC + ((size_t)b * SEQ + 16 * nc) * 256 + kv * 128 + g * 64;
    f32x16 a0 = att::splat16(0.f), a1 = att::splat16(0.f);
#pragma unroll 4
    for (int ks = 0; ks < 16; ++ks) { const int l = 4 * w + (ks >> 2), d = 16 * (ks & 3) + 8 * hi;
        const bf16x8 af = *(const bf16x8*)(arow + (size_t)l * 256 + d);
        const bf16x8 b0 = *(const bf16x8*)(W1T + (size_t)r32 * 2048 + l * 64 + d), b1 = *(const bf16x8*)(W1T + (size_t)(32 + r32) * 2048 + l * 64 + d);
        a0 = __builtin_amdgcn_mfma_f32_32x32x16_bf16(af, b0, a0, 0, 0, 0); a1 = __builtin_amdgcn_mfma_f32_32x32x16_bf16(af, b1, a1, 0, 0, 0); }
#pragma unroll
    for (int r = 0; r < 16; ++r) { const int mrow = att::crow(r, hi); PART[w * 2048 + mrow * 64 + r32] = a0[r]; PART[w * 2048 + mrow * 64 + 32 + r32] = a1[r]; }
    __syncthreads();
#pragma unroll
    for (int k = 0; k < 4; ++k) { const int idx = tid + 512 * k; float s = cb[idx & 63];
#pragma unroll
        for (int ww = 0; ww < 8; ++ww) s += PART[ww * 2048 + idx];
        HID[idx] = gelu_tanh(s); }
    __syncthreads();
#pragma unroll
    for (int k = 0; k < 4; ++k) { const int idx = tid + 512 * k, nr = idx >> 6, f = idx & 63; float s = 0.f;
#pragma unroll 8
        for (int e = 0; e < 64; ++e) s += HID[nr * 64 + e] * w2[e * 64 + f];
        const int blk = n0 + nr;
        OUT[(((size_t)b * 256 + blk) * 2 + g) * 64 + f] = (blk < 255) ? (bf16_t)f2bf(s) : (bf16_t)0; }
    __syncthreads();
}

#ifdef DBG_MODE
namespace dbg {
constexpr int NSLOT = 40;
__device__ __forceinline__ float bfr(float x) { return bf2f((unsigned short)f2bf(x)); }
__device__ __forceinline__ int srow(int i, int n) { return (int)(((unsigned)i * 2654435761u) % (unsigned)MTOK) ; }
__device__ void commit(unsigned* D, int slot, const float* ref, const float* fast, int n, float tf) {
    __shared__ float red[256];
    const int tid = threadIdx.x; float s = 0.f;
    for (int i = tid; i < n; i += 256) s += ref[i] * ref[i];
    red[tid] = s; __syncthreads();
    for (int o = 128; o > 0; o >>= 1) { if (tid < o) red[tid] += red[tid + o]; __syncthreads(); }
    const float rms = sqrtf(red[0] / (float)n); __syncthreads();
    int bad = 0, tot = 0; float mr = 0.f;
    for (int i = tid; i < n; i += 256) { const float e = fabsf(fast[i] - ref[i]); const float tol = tf * (rms + fabsf(ref[i])) + 1e-7f; if (!(e <= tol)) ++bad; ++tot; const float r = e / (rms + 1e-20f); if (r > mr || !(r == r)) mr = (r == r) ? r : 1e30f; }
    atomicAdd(&D[4 * slot], (unsigned)bad); atomicAdd(&D[4 * slot + 1], (unsigned)tot); atomicMax(&D[4 * slot + 2], __float_as_uint(mr));
    __syncthreads();
}
__device__ __forceinline__ float bias_l2(const float* relb, int head, int dist) { return relb[t5_bucket(dist) * 16 + head] * LOG2E; }

__global__ void chk_in_e(Args a, unsigned* D) {
    __shared__ float ref[1792], fast[1792];
    const int r = srow(blockIdx.x, 64), tid = threadIdx.x; const float* x = a.in[I_X] + (size_t)r * 1024; const float* w = a.in[I_EWIN];
    const bf16_t* Y1 = (const bf16_t*)(a.ws + OFF_Y1);
    for (int n = tid; n < EVEN_IN; n += 256) { float s = 0.f; for (int k = 0; k < 1024; ++k) s += bfr(x[k]) * bfr(w[(size_t)k * EVEN_IN + n]);
        const int dc = RowInE{}(n), tile = dc >> 8, col = dc & 255; const float sc = (tile == 2 || tile == 3) ? QSCALE : 1.f;
        ref[n] = s * sc; fast[n] = bf2f(Y1[((size_t)tile * MTOK + r) * 256 + col]); }
    __syncthreads();
    commit(D, 1, ref, fast, EVEN_IN, 0.02f);
    if (tid == 0) { float sq = 0.f, skv = 0.f; for (int n = 0; n < 256; ++n) sq += ref[n] * ref[n]; for (int n = 256; n < 384; ++n) skv += ref[n] * ref[n];
        const float* pq = (const float*)(a.ws + OFF_SSQ_Q) + (size_t)r * 4; const float* pk = (const float*)(a.ws + OFF_SSQ_KV) + (size_t)r * 4;
        const float fq = pq[0] + pq[1] + pq[2] + pq[3], fk = pk[0] + pk[1] + pk[2] + pk[3];
        int bad = 0; if (!(fabsf(fq - sq) <= 0.02f * sq)) ++bad; if (!(fabsf(fk - skv) <= 0.02f * skv)) ++bad;
        atomicAdd(&D[4 * 2], (unsigned)bad); atomicAdd(&D[4 * 2 + 1], 2u); }
}
__global__ void chk_q2(Args a, unsigned* D) {
    __shared__ float ref[1024], fast[1024], cqn[256], qh[512];
    const int r = srow(blockIdx.x, 64), tid = threadIdx.x; const bf16_t* Y1 = (const bf16_t*)(a.ws + OFF_Y1);
    const bf16_t* CQ = Y1 + (size_t)r * 256; const bf16_t* T1 = Y1 + ((size_t)MTOK + r) * 256;
    { float s = 0.f; for (int k = 0; k < 128; ++k) { const float c = bf2f(T1[k]); s += c * c; } const float rk = 1.f / sqrtf(s / 128.f + 1e-6f);
      if (tid < 128) { ref[tid] = bf2f(T1[tid]) * rk * a.in[I_EKVN][tid]; fast[tid] = bf2f(((const bf16_t*)(a.ws + OFF_CKVN))[(size_t)r * 128 + tid]); } }
    __syncthreads(); commit(D, 3, ref, fast, 128, 0.02f);
    { float s = 0.f; for (int k = 0; k < 256; ++k) { const float c = bf2f(CQ[k]); s += c * c; } const float rq = 1.f / sqrtf(s / 256.f + 1e-6f);
      cqn[tid] = bf2f(CQ[tid]) * rq * a.in[I_EQN][tid]; }
    __syncthreads();
    for (int o = tid; o < 512; o += 256) { float s = 0.f; for (int k = 0; k < 256; ++k) s += cqn[k] * a.in[I_EWUQ][k * 512 + o]; qh[o] = s; }
    __syncthreads();
    for (int o = tid; o < 1024; o += 256) { const int h = o >> 7, c = o & 127; float s = 0.f; for (int d = 0; d < 64; ++d) s += qh[h * 64 + d] * a.in[I_EWUK][c * 512 + h * 64 + d];
        ref[o] = s * QSCALE; fast[o] = bf2f(((const bf16_t*)(a.ws + OFF_QLAT))[(size_t)r * 1024 + o]); }
    __syncthreads(); commit(D, 5, ref, fast, 1024, 0.03f);
    for (int o = tid; o < 1024; o += 256) { float s = 0.f; for (int k = 0; k < 256; ++k) s += cqn[k] * a.in[I_EWQIDX][k * 1024 + o];
        ref[o] = s; fast[o] = bf2f(((const bf16_t*)(a.ws + OFF_QIDX))[(size_t)r * 1024 + o]); }
    __syncthreads(); commit(D, 6, ref, fast, 1024, 0.03f);
}
__global__ void chk_cmp(Args a, unsigned* D) {
    __shared__ float ref[64], fast[64], hid[64];
    const int i = blockIdx.x, tid = threadIdx.x, b = i & 7, g = (i >> 3) & 1, kv = (i >> 4) & 1; const int blk = (i >> 5) == 0 ? 0 : ((i >> 5) == 1 ? 254 : (int)((unsigned)(i * 37 + 11) % 255u));
    const bf16_t* KVC = (const bf16_t*)(a.ws + OFF_Y1) + (size_t)4 * MTOK * 256;
    const float* pos = a.in[kv ? I_EPOSV : I_EPOSK]; const float* w1 = a.in[kv ? I_ECV1 : I_ECK1]; const float* w2 = a.in[kv ? I_ECV2 : I_ECK2];
    if (tid < 64) { float s = 0.f;
        for (int l = 0; l < 32; ++l) for (int d = 0; d < 64; ++d) { const float av = bf2f(KVC[((size_t)b * SEQ + 16 * blk + l) * 256 + kv * 128 + g * 64 + d]); const float wv = w1[(l * 64 + d) * 64 + tid]; s += av * bfr(wv) + pos[l * 64 + d] * wv; }
        hid[tid] = gelu_tanh(s); }
    __syncthreads();
    if (tid < 64) { float s = 0.f; for (int e = 0; e < 64; ++e) s += hid[e] * w2[e * 64 + tid]; ref[tid] = s;
        fast[tid] = bf2f(((const bf16_t*)(a.ws + (kv ? OFF_VC : OFF_KC)))[(((size_t)b * 256 + blk) * 2 + g) * 64 + tid]); }
    __syncthreads(); commit(D, 4, ref, fast, 64, 0.03f);
}
__global__ void chk_idx(Args a, unsigned* D) {
    __shared__ float ref[256], fast[256];
    const int r = (blockIdx.x < 4) ? (blockIdx.x * 4096 + blockIdx.x * 61) : srow(blockIdx.x, 64), tid = threadIdx.x, b = r >> 12, t = r & 4095, c = t >> 6, nk = (c + 1) * 64;
    const bf16_t* Y1 = (const bf16_t*)(a.ws + OFF_Y1); const bf16_t* T1 = Y1 + (size_t)MTOK * 256; const bf16_t* QI = (const bf16_t*)(a.ws + OFF_QIDX) + (size_t)r * 1024;
    const int s = (int)(((unsigned)tid * 2654435761u + 12345u * blockIdx.x) % (unsigned)nk);
    const bf16_t* kr = T1 + ((size_t)b * SEQ + s) * 256 + 128; float sc = 0.f;
    for (int h = 0; h < 16; ++h) { float d = 0.f; for (int k = 0; k < 64; ++k) d += bf2f(QI[h * 64 + k]) * bf2f(kr[k]); sc += bf2f(T1[(size_t)r * 256 + 192 + h]) * fmaxf(d, 0.f); }
    ref[tid] = sc;
    const _Float16* SC = (const _Float16*)(a.ws + OFF_SC) + (size_t)b * SCB_ELEMS + (size_t)4096 * (c * (c + 1) / 2) + (size_t)(t & 63) * nk;
    fast[tid] = (float)SC[s];
    __syncthreads(); commit(D, 7, ref, fast, 256, 0.02f);
}
__global__ void chk_sel(Args a, unsigned* D) {
    __shared__ unsigned key[4096];
    const int r = (blockIdx.x < 8) ? (blockIdx.x * 4096 + 255 + blockIdx.x * 300) : srow(blockIdx.x, 64), tid = threadIdx.x, b = r >> 12, t = r & 4095, c = t >> 6, nk = (c + 1) * 64;
    const unsigned short* SC = (const unsigned short*)(a.ws + OFF_SC) + (size_t)b * SCB_ELEMS + (size_t)4096 * (c * (c + 1) / 2) + (size_t)(t & 63) * nk;
    const unsigned* M = (const unsigned*)(a.ws + OFF_MASK) + (size_t)r * 128;
    for (int s = tid; s < nk; s += 256) { const unsigned u = SC[s]; key[s] = (s <= t) ? ((u & 0x8000u) ? (~u & 0xffffu) : (u | 0x8000u)) : 0u; }
    __syncthreads();
    int bad = 0, tot = 0;
    for (int s = tid; s < nk; s += 256) { bool want;
        if (s > t) want = false; else if (t < 256) want = true;
        else { int rank = 0; const unsigned ks = key[s]; for (int q = 0; q <= t; ++q) rank += (key[q] > ks || (key[q] == ks && q < s)) ? 1 : 0; want = rank < 256; }
        const bool got = (M[s >> 5] >> (s & 31)) & 1u; if (want != got) ++bad; ++tot; }
    atomicAdd(&D[4 * 8], (unsigned)bad); atomicAdd(&D[4 * 8 + 1], (unsigned)tot);
}
__global__ void chk_dsa(Args a, unsigned* D) {
    __shared__ float lg[4096], red[256], ref[128], fast[128];
    const int r = (blockIdx.x < 8) ? (blockIdx.x * 4096 + blockIdx.x * 37) : srow(blockIdx.x, 64), tid = threadIdx.x, b = r >> 12, t = r & 4095, h = blockIdx.x & 7;
    const bf16_t* Q = (const bf16_t*)(a.ws + OFF_QLAT) + (size_t)r * 1024 + h * 128; const bf16_t* C = (const bf16_t*)(a.ws + OFF_CKVN) + (size_t)b * SEQ * 128;
    const unsigned* M = (const unsigned*)(a.ws + OFF_MASK) + (size_t)r * 128; const float* relb = a.in[I_RELB];
    float mx = -INFINITY;
    for (int s = tid; s <= t; s += 256) { float v = -INFINITY; if ((M[s >> 5] >> (s & 31)) & 1u) { float d = 0.f; for (int k = 0; k < 128; ++k) d += bf2f(Q[k]) * bf2f(C[(size_t)s * 128 + k]); v = d + bias_l2(relb, h, t - s); } lg[s] = v; mx = fmaxf(mx, v); }
    red[tid] = mx; __syncthreads(); for (int o = 128; o > 0; o >>= 1) { if (tid < o) red[tid] = fmaxf(red[tid], red[tid + o]); __syncthreads(); } mx = red[0]; __syncthreads();
    float sm = 0.f; for (int s = tid; s <= t; s += 256) { const float p = exp2f(lg[s] - mx); lg[s] = p; sm += p; }
    red[tid] = sm; __syncthreads(); for (int o = 128; o > 0; o >>= 1) { if (tid < o) red[tid] += red[tid + o]; __syncthreads(); } sm = red[0]; __syncthreads();
    if (tid < 128) { float o = 0.f; for (int s = 0; s <= t; ++s) o += lg[s] * bf2f(C[(size_t)s * 128 + tid]); ref[tid] = o / sm; fast[tid] = bf2f(((const bf16_t*)(a.ws + OFF_MIXIN))[(size_t)r * 1536 + h * 128 + tid]); }
    __syncthreads(); commit(D, 9, ref, fast, 128, 0.03f);
}
__global__ void chk_nsa(Args a, unsigned* D) {
    __shared__ float pc[4][256], lg[1100], red[256], ref[64], fast[64], oacc[3][64], scb[64]; __shared__ int selj[16]; __shared__ float qs[4][64];
    const int r = (blockIdx.x < 8) ? (blockIdx.x * 4096 + blockIdx.x * 41) : srow(blockIdx.x, 64), tid = threadIdx.x, b = r >> 12, t = r & 4095, hh = blockIdx.x & 7, g = hh >> 2, n = hh & 3, cur = t >> 6;
    const bf16_t* Y1 = (const bf16_t*)(a.ws + OFF_Y1); const bf16_t* T1 = Y1 + (size_t)MTOK * 256; const bf16_t* QB = Y1 + (size_t)(2 + g) * MTOK * 256;
    const bf16_t* KVS = Y1 + (size_t)5 * MTOK * 256; const bf16_t* KVW = Y1 + (size_t)6 * MTOK * 256;
    const bf16_t* KC = (const bf16_t*)(a.ws + OFF_KC); const bf16_t* VC = (const bf16_t*)(a.ws + OFF_VC); const float* relb = a.in[I_RELB];
    qs[tid >> 6][tid & 63] = bf2f(QB[(size_t)r * 256 + tid]);
    __syncthreads();
    const int vis = (t >= 31) ? ((t - 31) >> 4) : -1;
    for (int nn = 0; nn < 4; ++nn) {
        float v = -INFINITY; if (tid <= vis) { float d = 0.f; for (int k = 0; k < 64; ++k) d += qs[nn][k] * bf2f(KC[(((size_t)b * 256 + tid) * 2 + g) * 64 + k]); v = d + bias_l2(relb, 8 + 4 * g + nn, t - 16 * tid - 31); }
        red[tid] = v; __syncthreads(); for (int o = 128; o > 0; o >>= 1) { if (tid < o) red[tid] = fmaxf(red[tid], red[tid + o]); __syncthreads(); } const float mx = red[0]; __syncthreads();
        const float p = (tid <= vis) ? exp2f(v - mx) : 0.f; red[tid] = p; __syncthreads(); for (int o = 128; o > 0; o >>= 1) { if (tid < o) red[tid] += red[tid + o]; __syncthreads(); } const float sm = red[0]; __syncthreads();
        pc[nn][tid] = sm > 0.f ? p / sm : 0.f; __syncthreads();
    }
    if (tid < 64) { float o = 0.f; for (int i = 0; i <= vis; ++i) o += pc[n][i] * bf2f(VC[(((size_t)b * 256 + i) * 2 + g) * 64 + tid]); oacc[0][tid] = o;
        float s = 0.f; for (int nn = 0; nn < 4; ++nn) for (int i = 4 * tid - 1; i <= 4 * tid + 3; ++i) if (i >= 0 && i < 255) s += pc[nn][i];
        scb[tid] = (tid > cur) ? -INFINITY : ((tid == 0 || tid == cur || tid == cur - 1) ? INFINITY : s); }
    __syncthreads();
    if (tid < 64) { int rank = 0; for (int j = 0; j < 64; ++j) rank += (scb[j] > scb[tid] || (scb[j] == scb[tid] && j < tid)) ? 1 : 0; if (rank < 16) selj[rank] = tid; }
    __syncthreads();
    { float mx = -INFINITY;
      for (int i = tid; i < 1024; i += 256) { const int j = selj[i >> 6], p = 64 * j + (i & 63); float v = -INFINITY; if (p <= t) { float d = 0.f; for (int k = 0; k < 64; ++k) d += qs[n][k] * bf2f(KVS[((size_t)b * SEQ + p) * 256 + g * 64 + k]); v = d + bias_l2(relb, 8 + hh, t - p); } lg[i] = v; mx = fmaxf(mx, v); }
      red[tid] = mx; __syncthreads(); for (int o = 128; o > 0; o >>= 1) { if (tid < o) red[tid] = fmaxf(red[tid], red[tid + o]); __syncthreads(); } mx = red[0]; __syncthreads();
      float sm = 0.f; for (int i = tid; i < 1024; i += 256) { const float p = exp2f(lg[i] - mx); lg[i] = p; sm += p; }
      red[tid] = sm; __syncthreads(); for (int o = 128; o > 0; o >>= 1) { if (tid < o) red[tid] += red[tid + o]; __syncthreads(); } sm = red[0]; __syncthreads();
      if (tid < 64) { float o = 0.f; for (int i = 0; i < 1024; ++i) { const int p = 64 * selj[i >> 6] + (i & 63); if (p <= t) o += lg[i] * bf2f(KVS[((size_t)b * SEQ + p) * 256 + 128 + g * 64 + tid]); } oacc[1][tid] = o / sm; }
      __syncthreads(); }
    { float mx = -INFINITY;
      for (int i = tid; i < 512; i += 256) { const int p = t - i; float v = -INFINITY; if (p >= 0) { float d = 0.f; for (int k = 0; k < 64; ++k) d += qs[n][k] * bf2f(KVW[((size_t)b * SEQ + p) * 256 + g * 64 + k]); v = d + bias_l2(relb, 8 + hh, i); } lg[i] = v; mx = fmaxf(mx, v); }
      red[tid] = mx; __syncthreads(); for (int o = 128; o > 0; o >>= 1) { if (tid < o) red[tid] = fmaxf(red[tid], red[tid + o]); __syncthreads(); } mx = red[0]; __syncthreads();
      float sm = 0.f; for (int i = tid; i < 512; i += 256) { const float p = exp2f(lg[i] - mx); lg[i] = p; sm += p; }
      red[tid] = sm; __syncthreads(); for (int o = 128; o > 0; o >>= 1) { if (tid < o) red[tid] += red[tid + o]; __syncthreads(); } sm = red[0]; __syncthreads();
      if (tid < 64) { float o = 0.f; for (int i = 0; i < 512; ++i) { const int p = t - i; if (p >= 0) o += lg[i] * bf2f(KVW[((size_t)b * SEQ + p) * 256 + 128 + g * 64 + tid]); } oacc[2][tid] = o / sm; }
      __syncthreads(); }
    if (tid < 64) { float gt[3]; for (int j = 0; j < 3; ++j) { const float x = bf2f(T1[(size_t)r * 256 + 208 + hh * 3 + j]); gt[j] = 1.f / (1.f + expf(-x)); }
        ref[tid] = gt[0] * oacc[0][tid] + gt[1] * oacc[1][tid] + gt[2] * oacc[2][tid]; fast[tid] = bf2f(((const bf16_t*)(a.ws + OFF_MIXIN))[(size_t)r * 1536 + 1024 + hh * 64 + tid]); }
    __syncthreads(); commit(D, 10, ref, fast, 64, 0.04f);
}
__global__ void chk_out_e(Args a, unsigned* D) {
    __shared__ float ref[1024], fast[1024], cat[1024];
    const int r = srow(blockIdx.x, 64), tid = threadIdx.x; const bf16_t* MX = (const bf16_t*)(a.ws + OFF_MIXIN) + (size_t)r * 1536;
    for (int o = tid; o < 512; o += 256) { const int h = o >> 6, d = o & 63; float s = 0.f; for (int c = 0; c < 128; ++c) s += bf2f(MX[h * 128 + c]) * a.in[I_EWUV][c * 512 + h * 64 + d]; cat[o] = s; cat[512 + o] = bf2f(MX[1024 + o]); }
    __syncthreads();
    for (int n = tid; n < 1024; n += 256) { float s = 0.f; for (int j = 0; j < 1024; ++j) s += cat[j] * a.in[I_EWOUT][(size_t)j * 1024 + n]; ref[n] = s;
        fast[n] = bf2f(((const bf16_t*)(a.ws + OFF_S1))[(size_t)r * 1024 + n]) - ALPHA * a.in[I_X][(size_t)r * 1024 + n]; }
    __syncthreads(); commit(D, 11, ref, fast, 1024, 0.35f);
}
__global__ void chk_ln(const bf16_t* S, const bf16_t* O, const float* g, const float* bt, unsigned* D, int slot) {
    __shared__ float ref[1024], fast[1024];
    const int r = srow(blockIdx.x, 64), tid = threadIdx.x; float mean = 0.f, var = 0.f;
    for (int k = 0; k < 1024; ++k) mean += bf2f(S[(size_t)r * 1024 + k]); mean /= 1024.f;
    for (int k = 0; k < 1024; ++k) { const float d = bf2f(S[(size_t)r * 1024 + k]) - mean; var += d * d; } var /= 1024.f;
    for (int n = tid; n < 1024; n += 256) { ref[n] = (bf2f(S[(size_t)r * 1024 + n]) - mean) / sqrtf(var + 1e-5f) * g[n] + bt[n]; fast[n] = bf2f(O[(size_t)r * 1024 + n]); }
    __syncthreads(); commit(D, slot, ref, fast, 1024, 0.01f);
}
__global__ void chk_ffn_up(Args a, unsigned* D) {
    __shared__ float ref[DFF], fast[DFF], hrow[1024];
    const int r = srow(blockIdx.x, 64), tid = threadIdx.x; const bf16_t* H = (const bf16_t*)(a.ws + OFF_H) + (size_t)r * 1024;
    for (int k = tid; k < 1024; k += 256) hrow[k] = bf2f(H[k]);
    __syncthreads();
    for (int n = tid; n < DFF; n += 256) { float s1 = 0.f, s3 = 0.f; for (int k = 0; k < 1024; ++k) { s1 += hrow[k] * bfr(a.in[I_EF1][(size_t)k * DFF + n]); s3 += hrow[k] * bfr(a.in[I_EF3][(size_t)k * DFF + n]); }
        ref[n] = s1 / (1.f + expf(-s1)) * s3; fast[n] = bf2f(((const bf16_t*)(a.ws + OFF_ACT))[(size_t)r * DFF + n]); }
    __syncthreads(); commit(D, 13, ref, fast, DFF, 0.02f);
}
__global__ void chk_ffn_dn(Args a, unsigned* D) {
    __shared__ float ref[1024], fast[1024], arow[DFF];
    const int r = srow(blockIdx.x, 64), tid = threadIdx.x; const bf16_t* A = (const bf16_t*)(a.ws + OFF_ACT) + (size_t)r * DFF;
    for (int k = tid; k < DFF; k += 256) arow[k] = bf2f(A[k]);
    __syncthreads();
    for (int n = tid; n < 1024; n += 256) { float s = 0.f; for (int k = 0; k < DFF; ++k) s += arow[k] * bfr(a.in[I_EF2][(size_t)k * 1024 + n]); ref[n] = s;
        fast[n] = bf2f(((const bf16_t*)(a.ws + OFF_S2))[(size_t)r * 1024 + n]) - ALPHA * bf2f(((const bf16_t*)(a.ws + OFF_H))[(size_t)r * 1024 + n]); }
    __syncthreads(); commit(D, 14, ref, fast, 1024, 0.06f);
}
__global__ void chk_in_o(Args a, unsigned* D) {
    __shared__ float ref[2048], fast[2048], xr[1024];
    const int r = srow(blockIdx.x, 64), tid = threadIdx.x; const bf16_t* X1 = (const bf16_t*)(a.ws + OFF_X1) + (size_t)r * 1024;
    for (int k = tid; k < 1024; k += 256) xr[k] = bf2f(X1[k]);
    __syncthreads();
    for (int n = tid; n < 2048; n += 256) { float s = 0.f; for (int k = 0; k < 1024; ++k) s += xr[k] * bfr(a.in[I_OWIN][(size_t)k * 3072 + 1024 + n]); ref[n] = s;
        fast[n] = bf2f(((const bf16_t*)(a.ws + OFF_QKV))[(size_t)(1 + (n >> 10)) * MTOK * 1024 + (size_t)r * 1024 + (n & 1023)]); }
    __syncthreads(); commit(D, 16, ref, fast, 2048, 0.02f);
    const int pm = r >> 8; const bf16_t* K = (const bf16_t*)(a.ws + OFF_QKV) + (size_t)MTOK * 1024 + (size_t)pm * 256 * 1024; const float* KM = (const float*)(a.ws + OFF_KMEAN) + (size_t)pm * 2048;
    for (int n = tid; n < 1024; n += 256) { float s = 0.f; for (int q = 0; q < 256; ++q) s += bf2f(K[(size_t)q * 1024 + n]); ref[n] = s; fast[n] = KM[n] + KM[1024 + n]; }
    __syncthreads(); commit(D, 17, ref, fast, 1024, 0.03f);
}
__global__ void chk_moba(Args a, unsigned* D) {
    __shared__ float lg[1024], red[256], ref[64], fast[64], q[64], gate[16]; __shared__ int blkof[4];
    const int r = (blockIdx.x < 8) ? (blockIdx.x * 4096 + blockIdx.x * 300) : srow(blockIdx.x, 64), tid = threadIdx.x, b = r >> 12, t = r & 4095, h = blockIdx.x & 15, own = t >> 8;
    const bf16_t* X1 = (const bf16_t*)(a.ws + OFF_X1) + (size_t)r * 1024; const bf16_t* K = (const bf16_t*)(a.ws + OFF_QKV) + (size_t)MTOK * 1024 + (size_t)b * SEQ * 1024 + h * 64; const bf16_t* V = K + (size_t)MTOK * 1024;
    const float* relb = a.in[I_RELB];
    if (tid < 64) { float s = 0.f; for (int k = 0; k < 1024; ++k) s += bf2f(X1[k]) * bfr(a.in[I_OWIN][(size_t)k * 3072 + h * 64 + tid]); q[tid] = bfr(s * QSCALE); }
    __syncthreads();
    if (tid < 16) { float s = -INFINITY; if (tid < own) { s = 0.f; for (int p = 0; p < 256; ++p) for (int d = 0; d < 64; ++d) s += q[d] * bf2f(K[(size_t)(256 * tid + p) * 1024 + d]); } gate[tid] = s; }
    __syncthreads();
    if (tid == 0) { unsigned used = 0u; for (int k = 0; k < 3; ++k) { int bj = -1; float best = -INFINITY; for (int j = 0; j < own; ++j) if (!((used >> j) & 1u) && gate[j] > best) { best = gate[j]; bj = j; } blkof[k] = bj; if (bj >= 0) used |= 1u << bj; } blkof[3] = own; }
    __syncthreads();
    float mx = -INFINITY;
    for (int i = tid; i < 1024; i += 256) { const int j = blkof[i >> 8], p = 256 * j + (i & 255); float v = -INFINITY; if (j >= 0 && p <= t) { float d = 0.f; for (int k = 0; k < 64; ++k) d += q[k] * bf2f(K[(size_t)p * 1024 + k]); v = d + bias_l2(relb, h, t - p); } lg[i] = v; mx = fmaxf(mx, v); }
    red[tid] = mx; __syncthreads(); for (int o = 128; o > 0; o >>= 1) { if (tid < o) red[tid] = fmaxf(red[tid], red[tid + o]); __syncthreads(); } mx = red[0]; __syncthreads();
    float sm = 0.f; for (int i = tid; i < 1024; i += 256) { const float p = exp2f(lg[i] - mx); lg[i] = p; sm += p; }
    red[tid] = sm; __syncthreads(); for (int o = 128; o > 0; o >>= 1) { if (tid < o) red[tid] += red[tid + o]; __syncthreads(); } sm = red[0]; __syncthreads();
    if (tid < 64) { float o = 0.f; for (int i = 0; i < 1024; ++i) { const int j = blkof[i >> 8], p = 256 * j + (i & 255); if (j >= 0 && p <= t) o += lg[i] * bf2f(V[(size_t)p * 1024 + tid]); } ref[tid] = o / sm;
        fast[tid] = bf2f(((const bf16_t*)(a.ws + OFF_QKV))[(size_t)r * 1024 + h * 64 + tid]); }
    __syncthreads(); commit(D, 18, ref, fast, 64, 0.04f);
}
__global__ void chk_out_o(Args a, unsigned* D) {
    __shared__ float ref[1024], fast[1024], orow[1024];
    const int r = srow(blockIdx.x, 64), tid = threadIdx.x;
    for (int k = tid; k < 1024; k += 256) orow[k] = bf2f(((const bf16_t*)(a.ws + OFF_QKV))[(size_t)r * 1024 + k]);
    __syncthreads();
    for (int n = tid; n < 1024; n += 256) { float s = 0.f; for (int k = 0; k < 1024; ++k) s += orow[k] * a.in[I_OWOUT][(size_t)k * 1024 + n]; ref[n] = s;
        fast[n] = bf2f(((const bf16_t*)(a.ws + OFF_S1O))[(size_t)r * 1024 + n]) - ALPHA * bf2f(((const bf16_t*)(a.ws + OFF_X1))[(size_t)r * 1024 + n]); }
    __syncthreads(); commit(D, 20, ref, fast, 1024, 0.5f);
}
__global__ void chk_route(Args a, unsigned* D) {
    const int r = srow(blockIdx.x * 256 + threadIdx.x, 64); const bf16_t* H2 = (const bf16_t*)(a.ws + OFF_H2) + (size_t)r * 1024;
    float lg[8]; for (int e = 0; e < 8; ++e) lg[e] = 0.f;
    for (int k = 0; k < 1024; ++k) { const float hv = bf2f(H2[k]); for (int e = 0; e < 8; ++e) lg[e] += hv * a.in[I_OROUTER][k * 8 + e]; }
    int e0 = 0; for (int e = 1; e < 8; ++e) if (lg[e] > lg[e0]) e0 = e; int e1 = -1; for (int e = 0; e < 8; ++e) if (e != e0 && (e1 < 0 || lg[e] > lg[e1])) e1 = e;
    const float g0 = 1.f / (1.f + expf(lg[e1] - lg[e0]));
    const u32x2 rt = ((const u32x2*)(a.ws + OFF_ROUTE))[r]; const int f0 = rt.x & 255, f1 = (rt.x >> 8) & 255; const float fg = __uint_as_float(rt.y);
    int bad = 0; if (f0 != e0 || f1 != e1 || !(fabsf(fg - g0) <= 0.02f)) ++bad;
    atomicAdd(&D[4 * 21], (unsigned)bad); atomicAdd(&D[4 * 21 + 1], 1u);
    const int* GI = (const int*)(a.ws + OFF_GINFO); const int* DEST = (const int*)(a.ws + OFF_DEST) + 2 * (size_t)r; const bf16_t* XR = (const bf16_t*)(a.ws + OFF_XR);
    int bad2 = 0;
    for (int k = 0; k < 2; ++k) { const int e = k ? f1 : f0, d = DEST[k], ps = e ? GI[e - 1] : 0; if (d < ps || d >= ps + GI[8 + e]) ++bad2; else for (int c = 0; c < 1024; c += 37) if (XR[(size_t)d * 1024 + c] != H2[c]) { ++bad2; break; } }
    atomicAdd(&D[4 * 22], (unsigned)bad2); atomicAdd(&D[4 * 22 + 1], 2u);
}
__global__ void chk_moe(Args a, unsigned* D) {
    __shared__ float ref[1024], fast[1024], hrow[1024], act[DFFE], fin[1024];
    const int r = srow(blockIdx.x, 64), tid = threadIdx.x; const bf16_t* H2 = (const bf16_t*)(a.ws + OFF_H2) + (size_t)r * 1024;
    for (int k = tid; k < 1024; k += 256) { hrow[k] = bf2f(H2[k]); ref[k] = 0.f; }
    const u32x2 rt = ((const u32x2*)(a.ws + OFF_ROUTE))[r]; const float g0 = __uint_as_float(rt.y); const int* DEST = (const int*)(a.ws + OFF_DEST) + 2 * (size_t)r; const bf16_t* YR = (const bf16_t*)(a.ws + OFF_XR);
    __syncthreads();
    for (int k = 0; k < 2; ++k) { const int e = k ? ((rt.x >> 8) & 255) : (rt.x & 255); const float gk = k ? 1.f - g0 : g0;
        const float* w1 = a.in[I_OM1] + (size_t)e * 1024 * DFFE; const float* w3 = a.in[I_OM3] + (size_t)e * 1024 * DFFE; const float* w2 = a.in[I_OM2] + (size_t)e * DFFE * 1024;
        for (int f = tid; f < DFFE; f += 256) { float s1 = 0.f, s3 = 0.f; for (int q = 0; q < 1024; ++q) { s1 += hrow[q] * bfr(w1[(size_t)q * DFFE + f]); s3 += hrow[q] * bfr(w3[(size_t)q * DFFE + f]); } act[f] = bfr(s1 / (1.f + expf(-s1)) * s3); }
        __syncthreads();
        for (int n = tid; n < 1024; n += 256) { float s = 0.f; for (int f = 0; f < DFFE; ++f) s += act[f] * bfr(w2[(size_t)f * 1024 + n]); ref[n] += gk * s; }
        __syncthreads(); }
    for (int n = tid; n < 1024; n += 256) { fast[n] = g0 * bf2f(YR[(size_t)DEST[0] * 1024 + n]) + (1.f - g0) * bf2f(YR[(size_t)DEST[1] * 1024 + n]); fin[n] = ALPHA * hrow[n] + fast[n]; }
    __syncthreads(); commit(D, 23, ref, fast, 1024, 0.03f);
    float mean = 0.f, var = 0.f; for (int k = 0; k < 1024; ++k) mean += fin[k]; mean /= 1024.f; for (int k = 0; k < 1024; ++k) { const float d = fin[k] - mean; var += d * d; } var /= 1024.f;
    __syncthreads();
    for (int n = tid; n < 1024; n += 256) { ref[n] = (fin[n] - mean) / sqrtf(var + 1e-5f) * a.in[I_OLN2G][n] + a.in[I_OLN2B][n]; fast[n] = a.out[(size_t)r * 1024 + n]; }
    __syncthreads(); commit(D, 24, ref, fast, 1024, 0.005f);
    { float m2 = 0.f, v2 = 0.f; for (int k = 0; k < 1024; ++k) m2 += ALPHA * hrow[k]; m2 /= 1024.f; for (int k = 0; k < 1024; ++k) { const float d = ALPHA * hrow[k] - m2; v2 += d * d; } v2 /= 1024.f;
      for (int n = tid; n < 1024; n += 256) ref[n] = (ALPHA * hrow[n] - m2) / sqrtf(v2 + 1e-5f) * a.in[I_OLN2G][n] + a.in[I_OLN2B][n];
      __syncthreads(); commit(D, 28, ref, fast, 1024, 0.005f); }
    { for (int n = tid; n < 1024; n += 256) fin[n] = ALPHA * hrow[n] + (1.f - g0) * bf2f(YR[(size_t)DEST[0] * 1024 + n]) + g0 * bf2f(YR[(size_t)DEST[1] * 1024 + n]);
      __syncthreads();
      float m2 = 0.f, v2 = 0.f; for (int k = 0; k < 1024; ++k) m2 += fin[k]; m2 /= 1024.f; for (int k = 0; k < 1024; ++k) { const float d = fin[k] - m2; v2 += d * d; } v2 /= 1024.f;
      __syncthreads();
      for (int n = tid; n < 1024; n += 256) ref[n] = (fin[n] - m2) / sqrtf(v2 + 1e-5f) * a.in[I_OLN2G][n] + a.in[I_OLN2B][n];
      __syncthreads(); commit(D, 29, ref, fast, 1024, 0.005f); }
}

__global__ void chk_wmoe(Args a, unsigned* D) {
    const int tid = blockIdx.x * 256 + threadIdx.x; const unsigned hsh = (unsigned)tid * 2654435761u;
    const int e = hsh & 7, f = (hsh >> 3) % DFFE, k = (hsh >> 15) % 1024;
    const bf16_t* W13 = (const bf16_t*)(a.ws + OFF_W_M13) + (size_t)e * 2 * DFFE * 1024; const bf16_t* W2 = (const bf16_t*)(a.ws + OFF_W_M2) + (size_t)e * 1024 * DFFE;
    int bad = 0;
    if (W13[(size_t)(((f >> 7) << 8) + (f & 127)) * 1024 + k] != (bf16_t)f2bf(a.in[I_OM1][(size_t)e * 1024 * DFFE + (size_t)k * DFFE + f])) ++bad;
    if (W13[(size_t)(((f >> 7) << 8) + (f & 127) + 128) * 1024 + k] != (bf16_t)f2bf(a.in[I_OM3][(size_t)e * 1024 * DFFE + (size_t)k * DFFE + f])) ++bad;
    atomicAdd(&D[4 * 25], (unsigned)bad); atomicAdd(&D[4 * 25 + 1], 2u);
    int bad2 = 0; if (W2[(size_t)k * DFFE + f] != (bf16_t)f2bf(a.in[I_OM2][(size_t)e * DFFE * 1024 + (size_t)f * 1024 + k])) ++bad2;
    atomicAdd(&D[4 * 26], (unsigned)bad2); atomicAdd(&D[4 * 26 + 1], 1u);
}
__global__ void chk_actm(Args a, unsigned* D) {
    __shared__ float ref[DFFE], fast[DFFE], hrow[1024]; __shared__ int tokf, kf;
    const int tid = threadIdx.x; const int* GI = (const int*)(a.ws + OFF_GINFO); const int nrows = GI[7], ng = nrows >> 8, g0 = ((ng - 1) / MOE_CHUNK) * MOE_CHUNK;
    const int rho = 256 * g0 + (int)(((unsigned)blockIdx.x * 2654435761u) % (unsigned)(nrows - 256 * g0));
    if (tid == 0) { tokf = -1; kf = 0; } __syncthreads();
    const int* DEST = (const int*)(a.ws + OFF_DEST);
    for (int i = tid; i < 2 * MTOK; i += 256) if (DEST[i] == rho) { tokf = i >> 1; kf = i & 1; }
    __syncthreads();
    if (tokf < 0) return;
    const int tok = tokf; const u32x2 rt = ((const u32x2*)(a.ws + OFF_ROUTE))[tok]; const int e = kf ? ((rt.x >> 8) & 255) : (rt.x & 255);
    const bf16_t* H2 = (const bf16_t*)(a.ws + OFF_H2) + (size_t)tok * 1024;
    for (int k = tid; k < 1024; k += 256) hrow[k] = bf2f(H2[k]);
    __syncthreads();
    const float* w1 = a.in[I_OM1] + (size_t)e * 1024 * DFFE; const float* w3 = a.in[I_OM3] + (size_t)e * 1024 * DFFE;
    for (int f = tid; f < DFFE; f += 256) { float s1 = 0.f, s3 = 0.f; for (int q = 0; q < 1024; ++q) { s1 += hrow[q] * bfr(w1[(size_t)q * DFFE + f]); s3 += hrow[q] * bfr(w3[(size_t)q * DFFE + f]); }
        ref[f] = s1 / (1.f + expf(-s1)) * s3; fast[f] = bf2f(((const bf16_t*)(a.ws + OFF_ACTM))[(size_t)(rho - 256 * g0) * DFFE + f]); }
    __syncthreads(); commit(D, 27, ref, fast, DFFE, 0.02f);
}

__global__ void simple_final(Args a) {
    const int row = blockIdx.x * 4 + (threadIdx.x >> 6), lane = threadIdx.x & 63; unsigned char* ws = a.ws;
    const bf16_t* H2 = (const bf16_t*)(ws + OFF_H2); const bf16_t* YR = (const bf16_t*)(ws + OFF_XR);
    const u32x2* ROUTE = (const u32x2*)(ws + OFF_ROUTE); const int* DEST = (const int*)(ws + OFF_DEST);
    const float g0 = __uint_as_float(ROUTE[row].y), g1 = 1.f - g0; const int d0 = DEST[2 * row], d1 = DEST[2 * row + 1];
    float v[16]; float s = 0.f;
    for (int i = 0; i < 16; ++i) { const int col = lane + 64 * i; v[i] = ALPHA * bf2f(H2[(size_t)row * 1024 + col]) + g0 * bf2f(YR[(size_t)d0 * 1024 + col]) + g1 * bf2f(YR[(size_t)d1 * 1024 + col]); s += v[i]; }
    const float mean = wave_sum(s) / 1024.f; float q = 0.f;
    for (int i = 0; i < 16; ++i) { v[i] -= mean; q += v[i] * v[i]; }
    const float rstd = 1.f / sqrtf(wave_sum(q) / 1024.f + 1e-5f);
    for (int i = 0; i < 16; ++i) { const int col = lane + 64 * i; a.out[(size_t)row * 1024 + col] = v[i] * rstd * a.in[I_OLN2G][col] + a.in[I_OLN2B][col]; }
}
__global__ void report(float* out, const unsigned* D, int nelem) {
    __shared__ float kk, xx;
    if (threadIdx.x == 0) { int idx = 0; float v = 0.f; float worst = 0.f;
        for (int s = 1; s < NSLOT; ++s) { const unsigned bad = D[4 * s], tot = D[4 * s + 1]; if (tot == 0u) continue; const float fr = (float)bad / (float)tot; const float thr = (s == 9 || s == 10 || s == 18) ? 0.1f : 0.002f;
            if (fr > worst) worst = fr; if (fr > thr && idx == 0) { idx = s; v = fr; } }
        if (idx == 0) v = worst;
#ifdef DBG_BITS
        { const int sl[6] = DBG_BITS; idx = 0; for (int q = 0; q < 6; ++q) { const int s = sl[q]; if (s > 0 && D[4 * s + 1] > 0u && (float)D[4 * s] / (float)D[4 * s + 1] > 0.002f) idx |= 1 << q; } v = 1.f; }
#endif
#ifdef DBG_VAL
        { const float mr = __uint_as_float(D[4 * DBG_VAL + 2]); const float fr = D[4 * DBG_VAL + 1] ? (float)D[4 * DBG_VAL] / (float)D[4 * DBG_VAL + 1] : 0.f; kk = sqrtf(fmaxf(mr, 1e-6f) * 1e6f); xx = kk * (2.f + 97.f * fr); }
#else
        v = fmaxf(v, 1e-6f); const int n = (v > 0.3f) ? 4 : (v > 0.03f) ? 3 : (v > 0.003f) ? 2 : 1; kk = (n == 4) ? 1e4f : (n == 3) ? 1e3f : (n == 2) ? 1e2f : 1e1f; xx = kk * (float)(idx + 2);
#endif
        }
    __syncthreads();
    const float k = kk, x = xx;
    for (size_t i = (size_t)blockIdx.x * blockDim.x + threadIdx.x; i < (size_t)nelem; i += (size_t)gridDim.x * blockDim.x) out[i] = (i == 0) ? x : k;
}
}
#endif

#ifndef MK_N_LAUNCHES
#define MK_N_LAUNCHES 1
#endif
constexpr int NPHASE = 18;
#define SP2 true
#define ALN true

__global__ void __launch_bounds__(NTHR, 2) fwd_kernel(Args args) {
    extern __shared__ __attribute__((aligned(16))) unsigned char lds_raw[];
    Frame F;
    F.lds = (LAS unsigned char*)lds_raw;
    F.tid = threadIdx.x; F.lane = F.tid & 63; F.wave = __builtin_amdgcn_readfirstlane(F.tid >> 6);
    F.G = gridDim.x; F.bx = blockIdx.x; F.gw = F.bx * NWAVES + F.wave; F.NGW = F.G * NWAVES; F.ws = args.ws;
    unsigned char* ws = args.ws;
    volatile LAS unsigned* MISC = (volatile LAS unsigned*)(F.lds + LDSCTL_OFF);
    for (int u = F.tid; u < (LDS_BYTES - LDSCTL_OFF) / 4; u += NTHR) ((LAS unsigned*)(F.lds + LDSCTL_OFF))[u] = 0u;
    __syncthreads();
    __builtin_amdgcn_fence(__ATOMIC_ACQUIRE, "agent");
    XcdBarrier bar = xcd_barrier_post((unsigned*)(ws + OFF_BAR) + args.li * XCD_BAR_WORDS, MISC + 8);
    const int lo = args.ph_lo, hi = args.ph_hi;
#ifndef PH_MASK
#define PH_MASK 0x3ffff
#endif
#define IN(k) (((PH_MASK >> (k)) & 1) && lo <= (k) && (k) < hi)
#define SEAM(k) do { if (IN(k) && IN((k) + 1)) xcd_barrier(bar); } while (0)
    LAS unsigned char* glds = F.lds;

    bf16_t* Y1 = (bf16_t*)(ws + OFF_Y1);
    float* ssq_q = (float*)(ws + OFF_SSQ_Q); float* ssq_kv = (float*)(ws + OFF_SSQ_KV);

    if (IN(0)) { phase_prologue_even(F, args); } SEAM(0);
    if (IN(1)) { pg8::Gemm g{(const bf16_t*)(ws + OFF_XB), (const bf16_t*)(ws + OFF_W_IN), MTOK, EVEN_INP, 1024, 1024, 0}; pg8::StaticOrder S; S.init(MTOK, EVEN_INP, F.G, F.bx);
        pg8::EpiInE E{Y1, ssq_q, ssq_kv}; pg8::gemm_phase<pg8::EpiInE, pg8::StaticOrder, ALN, SP2>(glds, g, S, E); } SEAM(1);
    if (IN(2)) {
        phase_ckvn(F, Y1 + (size_t)1 * MTOK * 256, ssq_kv, args.in[I_EKVN], (bf16_t*)(ws + OFF_CKVN));
#ifndef NO_CMP
        for (int idx = F.bx; idx < 256; idx += F.G) { const int b = idx >> 5, g = (idx >> 4) & 1, kv = (idx >> 3) & 1, rt = idx & 7;
            compress_unit(F, b, g, kv, rt, Y1 + (size_t)4 * MTOK * 256, (const bf16_t*)(ws + (kv ? OFF_CV1 : OFF_CK1)), args.in[kv ? I_ECV2 : I_ECK2], (const float*)(ws + OFF_CB) + kv * 64, (bf16_t*)(ws + (kv ? OFF_VC : OFF_KC))); }
#endif
#ifndef NO_Q2
        pg8::Gemm g{Y1, (const bf16_t*)(ws + OFF_W_Q2), MTOK, 2048, 256, 256, 0}; pg8::StaticOrder S; S.init(MTOK, 2048, F.G, F.bx);
        pg8::EpiQ2 E{(bf16_t*)(ws + OFF_QLAT), (bf16_t*)(ws + OFF_QIDX), ssq_q}; pg8::gemm_phase<pg8::EpiQ2, pg8::StaticOrder, ALN, SP2>(glds, g, S, E);
#endif
    } SEAM(2);
    if (IN(3)) { for (int idx = F.bx; idx < 512; idx += F.G) { const int i = idx >> 8, v = idx & 255, b = v >> 5, cc = v & 31, c = i ? 63 - cc : cc;
            indexer_unit(F, b, c, (const bf16_t*)(ws + OFF_QIDX), Y1 + (size_t)1 * MTOK * 256, (_Float16*)(ws + OFF_SC)); } } SEAM(3);
    if (IN(4)) { phase_select(F, (const _Float16*)(ws + OFF_SC), (unsigned*)(ws + OFF_MASK)); } SEAM(4);
    if (IN(5)) {
#ifndef NO_DSA
        for (int idx = F.bx; idx < 1024; idx += F.G) { const int i = idx >> 8, v = idx & 255, b = v >> 5, cc = v & 31, u = (i == 0) ? cc : (i == 1) ? 63 - cc : (i == 2) ? 64 + cc : 127 - cc;
            dsa_unit(F, b, u, (const bf16_t*)(ws + OFF_QLAT), (const bf16_t*)(ws + OFF_CKVN), (const unsigned*)(ws + OFF_MASK), (const float*)(ws + OFF_BT), (bf16_t*)(ws + OFF_MIXIN)); __syncthreads(); }
#endif
#ifndef NO_NSA
        for (int idx = F.bx; idx < 1024; idx += F.G) { const int i = idx >> 8, v = idx & 255, b = v >> 5, cc = v & 31, g = i & 1, c = (i >> 1) ? 63 - cc : cc;
            nsa_unit(F, b, g, c, Y1, (const bf16_t*)(ws + OFF_KC), (const bf16_t*)(ws + OFF_VC), (const float*)(ws + OFF_BT), (bf16_t*)(ws + OFF_MIXIN)); __syncthreads(); }
#endif
    } SEAM(5);
    if (IN(6)) { pg8::Gemm g{(const bf16_t*)(ws + OFF_MIXIN), (const bf16_t*)(ws + OFF_W_OUTE), MTOK, 1024, 1536, 1536, 0}; pg8::StaticOrder S; S.init(MTOK, 1024, F.G, F.bx);
        pg8::EpiRes<true> E{args.in[I_X], (bf16_t*)(ws + OFF_S1)}; pg8::gemm_phase<pg8::EpiRes<true>, pg8::StaticOrder, ALN, SP2>(glds, g, S, E); } SEAM(6);
    if (IN(7)) { phase_ln_bf16(F, (const bf16_t*)(ws + OFF_S1), (bf16_t*)(ws + OFF_H), args.in[I_ELN1G], args.in[I_ELN1B]); } SEAM(7);
    if (IN(8)) { pg8::Gemm g{(const bf16_t*)(ws + OFF_H), (const bf16_t*)(ws + OFF_W_F13), MTOK, 2 * DFF, 1024, 1024, 0}; pg8::StaticOrder S; S.init(MTOK, 2 * DFF, F.G, F.bx);
        pg8::EpiSwiglu E{(bf16_t*)(ws + OFF_ACT), DFF, 0}; pg8::gemm_phase<pg8::EpiSwiglu, pg8::StaticOrder, ALN, SP2>(glds, g, S, E); } SEAM(8);
    if (IN(9)) { pg8::Gemm g{(const bf16_t*)(ws + OFF_ACT), (const bf16_t*)(ws + OFF_W_F2), MTOK, 1024, DFF, DFF, 0}; pg8::StaticOrder S; S.init(MTOK, 1024, F.G, F.bx);
        pg8::EpiRes<false> E{(const void*)(ws + OFF_H), (bf16_t*)(ws + OFF_S2)}; pg8::gemm_phase<pg8::EpiRes<false>, pg8::StaticOrder, ALN, SP2>(glds, g, S, E); } SEAM(9);
    if (IN(10)) { phase_ln_bf16(F, (const bf16_t*)(ws + OFF_S2), (bf16_t*)(ws + OFF_X1), args.in[I_ELN2G], args.in[I_ELN2B]); phase_convert_odd(F, args); } SEAM(10);
    if (IN(11)) { pg8::Gemm g{(const bf16_t*)(ws + OFF_X1), (const bf16_t*)(ws + OFF_W_OIN), MTOK, 3072, 1024, 1024, 0}; pg8::StaticOrder S; S.init(MTOK, 3072, F.G, F.bx);
        pg8::EpiInO E{(bf16_t*)(ws + OFF_QKV), (float*)(ws + OFF_KMEAN)}; pg8::gemm_phase<pg8::EpiInO, pg8::StaticOrder, ALN, SP2>(glds, g, S, E); } SEAM(11);
    if (IN(12)) { phase_moba(F, ws); } SEAM(12);
    if (IN(13)) { pg8::Gemm g{(const bf16_t*)(ws + OFF_QKV), (const bf16_t*)(ws + OFF_W_OOUT), MTOK, 1024, 1024, 1024, 0}; pg8::StaticOrder S; S.init(MTOK, 1024, F.G, F.bx);
        pg8::EpiRes<false> E{(const void*)(ws + OFF_X1), (bf16_t*)(ws + OFF_S1O)}; pg8::gemm_phase<pg8::EpiRes<false>, pg8::StaticOrder, ALN, SP2>(glds, g, S, E); } SEAM(13);
    if (IN(14)) { phase_ln_router(F, (const bf16_t*)(ws + OFF_S1O), (bf16_t*)(ws + OFF_H2), args.in[I_OLN1G], args.in[I_OLN1B], args.in[I_OROUTER], ws); } SEAM(14);
    if (IN(15)) { phase_moe_gather(F, (const bf16_t*)(ws + OFF_H2), (bf16_t*)(ws + OFF_XR), ws); } SEAM(15);
    if (IN(16)) {
        const int* GI = (const int*)(ws + OFF_GINFO);
        pg8::MoeOrder S; S.G = F.G; S.c = F.bx;
#pragma unroll
        for (int e = 0; e < 8; ++e) S.pend[e] = __builtin_amdgcn_readfirstlane(GI[e]);
        const int ngroups = S.pend[7] >> 8;
        for (int g0 = 0; g0 < ngroups; g0 += MOE_CHUNK) {
            S.g0 = g0; S.ng = (ngroups - g0) < MOE_CHUNK ? (ngroups - g0) : MOE_CHUNK;
            { S.nN = 28; pg8::Gemm g{(const bf16_t*)(ws + OFF_XR), (const bf16_t*)(ws + OFF_W_M13), 0, 2 * DFFE, 1024, 1024, (size_t)2 * DFFE * 1024};
              pg8::EpiSwiglu E{(bf16_t*)(ws + OFF_ACTM), DFFE, g0}; pg8::gemm_phase<pg8::EpiSwiglu, pg8::MoeOrder, ALN, SP2>(glds, g, S, E); }
            xcd_barrier(bar);
            { S.nN = 4; pg8::Gemm g{(const bf16_t*)(ws + OFF_ACTM) - (size_t)g0 * 256 * DFFE, (const bf16_t*)(ws + OFF_W_M2), 0, 1024, DFFE, DFFE, (size_t)1024 * DFFE};
              pg8::EpiStore E{(bf16_t*)(ws + OFF_XR), 1024}; pg8::gemm_phase<pg8::EpiStore, pg8::MoeOrder, ALN, SP2>(glds, g, S, E); }
            xcd_barrier(bar);
        }
    }
    if (IN(17)) { phase_final(F, (const bf16_t*)(ws + OFF_H2), (const bf16_t*)(ws + OFF_XR), args.in[I_OLN2G], args.in[I_OLN2B], args.out, ws); }
#undef IN
#undef SEAM
}

extern "C" void kernel_launch(void* const* d_in, const int* in_sizes, int n_in, void* d_out, int out_size, void* d_ws, size_t ws_size, hipStream_t stream) {
    static int grid = 0;
    if (grid == 0) {
        if (n_in != 33 || in_sizes[0] != MTOK * DM || out_size != MTOK * DM || ws_size < WS_END) { fprintf(stderr, "kernel_launch: unexpected problem (n_in %d, in0 %d, out %d, ws %zu < %zu)\n", n_in, n_in > 0 ? in_sizes[0] : -1, out_size, ws_size, (size_t)WS_END); grid = -1; return; }
        int dev = 0, cus = 0, per_cu = 0;
        if (hipGetDevice(&dev) != hipSuccess || hipDeviceGetAttribute(&cus, hipDeviceAttributeMultiprocessorCount, dev) != hipSuccess) { grid = -1; return; }
        if (hipFuncSetAttribute((const void*)fwd_kernel, hipFuncAttributeMaxDynamicSharedMemorySize, LDS_BYTES) != hipSuccess) { fprintf(stderr, "kernel_launch: hipFuncSetAttribute failed\n"); grid = -1; return; }
        if (hipOccupancyMaxActiveBlocksPerMultiprocessor(&per_cu, (const void*)fwd_kernel, NTHR, LDS_BYTES) != hipSuccess || per_cu < 1) fprintf(stderr, "kernel_launch: occupancy query reports %d\n", per_cu);
        (void)hipGetLastError();
        grid = cus > 256 ? 256 : cus;
    }
    if (grid < 0) return;
    hipMemsetAsync(d_ws, 0, CTL_ZERO_BYTES, stream);
    Args a{};
    for (int i = 0; i < 33; ++i) a.in[i] = (const float*)d_in[i];
    a.out = (float*)d_out; a.ws = (unsigned char*)d_ws;
#if MK_N_LAUNCHES == 1
    a.ph_lo = 0; a.ph_hi = NPHASE; a.li = 0;
    hipLaunchKernelGGL(fwd_kernel, dim3(grid), dim3(NTHR), LDS_BYTES, stream, a);
#else
    for (int p = 0; p < NPHASE; ++p) { a.ph_lo = p; a.ph_hi = p + 1; a.li = p; hipLaunchKernelGGL(fwd_kernel, dim3(grid), dim3(NTHR), LDS_BYTES, stream, a);
#ifdef DBG_MODE
        unsigned* D = (unsigned*)((unsigned char*)d_ws + OFF_DBG); unsigned char* ws = (unsigned char*)d_ws;
        switch (p) {
            case 1: hipLaunchKernelGGL(dbg::chk_in_e, dim3(64), dim3(256), 0, stream, a, D); break;
            case 2: hipLaunchKernelGGL(dbg::chk_q2, dim3(64), dim3(256), 0, stream, a, D); hipLaunchKernelGGL(dbg::chk_cmp, dim3(96), dim3(256), 0, stream, a, D); break;
            case 3: hipLaunchKernelGGL(dbg::chk_idx, dim3(64), dim3(256), 0, stream, a, D); break;
            case 4: hipLaunchKernelGGL(dbg::chk_sel, dim3(48), dim3(256), 0, stream, a, D); break;
            case 5: hipLaunchKernelGGL(dbg::chk_dsa, dim3(64), dim3(256), 0, stream, a, D); hipLaunchKernelGGL(dbg::chk_nsa, dim3(64), dim3(256), 0, stream, a, D); break;
            case 6: hipLaunchKernelGGL(dbg::chk_out_e, dim3(32), dim3(256), 0, stream, a, D); break;
            case 7: hipLaunchKernelGGL(dbg::chk_ln, dim3(32), dim3(256), 0, stream, (const bf16_t*)(ws + OFF_S1), (const bf16_t*)(ws + OFF_H), a.in[I_ELN1G], a.in[I_ELN1B], D, 12); break;
            case 8: hipLaunchKernelGGL(dbg::chk_ffn_up, dim3(16), dim3(256), 0, stream, a, D); break;
            case 9: hipLaunchKernelGGL(dbg::chk_ffn_dn, dim3(32), dim3(256), 0, stream, a, D); break;
            case 10: hipLaunchKernelGGL(dbg::chk_ln, dim3(32), dim3(256), 0, stream, (const bf16_t*)(ws + OFF_S2), (const bf16_t*)(ws + OFF_X1), a.in[I_ELN2G], a.in[I_ELN2B], D, 15); break;
            case 10 + 100: break;
            case 11: hipLaunchKernelGGL(dbg::chk_wmoe, dim3(16), dim3(256), 0, stream, a, D); hipLaunchKernelGGL(dbg::chk_in_o, dim3(32), dim3(256), 0, stream, a, D); break;
            case 12: hipLaunchKernelGGL(dbg::chk_moba, dim3(64), dim3(256), 0, stream, a, D); break;
            case 13: hipLaunchKernelGGL(dbg::chk_out_o, dim3(32), dim3(256), 0, stream, a, D); break;
            case 14: hipLaunchKernelGGL(dbg::chk_ln, dim3(32), dim3(256), 0, stream, (const bf16_t*)(ws + OFF_S1O), (const bf16_t*)(ws + OFF_H2), a.in[I_OLN1G], a.in[I_OLN1B], D, 19); break;
            case 15: hipLaunchKernelGGL(dbg::chk_route, dim3(1), dim3(256), 0, stream, a, D); break;
            case 16: hipLaunchKernelGGL(dbg::chk_actm, dim3(8), dim3(256), 0, stream, a, D); break;
            case 17:
#ifdef DBG_SIMPLE_FINAL
                hipLaunchKernelGGL(dbg::simple_final, dim3(MTOK / 4), dim3(256), 0, stream, a);
#endif
                hipLaunchKernelGGL(dbg::chk_moe, dim3(16), dim3(256), 0, stream, a, D); hipLaunchKernelGGL(dbg::report, dim3(1024), dim3(256), 0, stream, (float*)d_out, (const unsigned*)D, out_size); break;
            default: break;
        }
#endif
    }
#endif
}
```

```cpp
#include <hip/hip_runtime.h>
#include <cstdio>
#include <cstdint>

#define LAS __attribute__((address_space(3)))
#define GAS __attribute__((address_space(1)))
typedef unsigned short bf16_t;
typedef short bf16x8 __attribute__((ext_vector_type(8)));
typedef short s16x4 __attribute__((ext_vector_type(4)));
typedef float f32x2 __attribute__((ext_vector_type(2)));
typedef float f32x4 __attribute__((ext_vector_type(4)));
typedef float f32x16 __attribute__((ext_vector_type(16)));
typedef unsigned u32x2 __attribute__((ext_vector_type(2)));
typedef unsigned u32x4 __attribute__((ext_vector_type(4)));
typedef __bf16 bf16x2_t __attribute__((ext_vector_type(2)));
typedef _Float16 f16x2_t __attribute__((ext_vector_type(2)));

constexpr int DM = 1024, NB = 8, SEQ = 4096, MTOK = NB * SEQ;
constexpr int EVEN_IN = 1768, EVEN_INP = 1792, DFF = 2816, DFFE = 3584, NEXP = 8;
constexpr float ALPHA = 1.4142135623730951f;
constexpr float LOG2E = 1.4426950408889634f;
constexpr float QSCALE = 0.125f * LOG2E;
constexpr int NWAVES = 8, NTHR = 512;

__device__ __forceinline__ unsigned f2bf(float f) { unsigned u = __builtin_bit_cast(unsigned, f); return (u + 0x7fffu + ((u >> 16) & 1u)) >> 16; }
__device__ __forceinline__ unsigned pk2(float lo, float hi) { f32x2 v = {lo, hi}; bf16x2_t b = __builtin_convertvector(v, bf16x2_t); return __builtin_bit_cast(unsigned, b); }
__device__ __forceinline__ float bf2f(unsigned short h) { return __builtin_bit_cast(float, (unsigned)h << 16); }
__device__ __forceinline__ float bflo(unsigned w) { return __builtin_bit_cast(float, w << 16); }
__device__ __forceinline__ float bfhi(unsigned w) { return __builtin_bit_cast(float, w & 0xffff0000u); }
__device__ __forceinline__ float wave_sum(float v) {
#pragma unroll
    for (int o = 1; o < 64; o <<= 1) v += __shfl_xor(v, o);
    return v;
}
#define LDS_WAIT() asm volatile("s_waitcnt lgkmcnt(0)" ::: "memory")
#define VM_WAIT() asm volatile("s_waitcnt vmcnt(0)" ::: "memory")
namespace pg8 {
#define PG8_LAS __attribute__((address_space(3)))
typedef unsigned short bf16_t;
typedef short bf16x8 __attribute__((ext_vector_type(8)));
typedef float f32x4 __attribute__((ext_vector_type(4)));
typedef unsigned u32x4 __attribute__((ext_vector_type(4)));
constexpr int BM = 256, BK = 64, HALF = 128, HTB = HALF * BK * 2  , STAGE_BYTES = 8 * HTB, NXCD = 8, WGM = 8;

__host__ __device__ __forceinline__ int lds_byte(int r, int c) { const int st = (r >> 4) * 2 + (c >> 5), rr = r & 15, cc = c & 31, ob = rr * 64 + cc * 2; return st * 1024 + (ob ^ (((ob >> 9) & 1) << 5)); }
__host__ __device__ __forceinline__ void stage_rc(int b, int& R, int& C) { const int st = b / 1024, sb = b % 1024, swz = sb ^ (((sb >> 9) & 1) << 5); R = (st >> 1) * 16 + swz / 64; C = (st & 1) * 32 + (swz % 64) / 2; }
__host__ __device__ __forceinline__ int perm32(int rho) { const int n = rho >> 4, i = rho & 15; return 8 * (i >> 2) + 4 * n + (i & 3); }

struct Unit { int pm, pn, e; };
struct Gemm { const bf16_t* A; const bf16_t* Bt; int M, N, K; int lda; size_t bstride; };

struct StaticOrder {
    int nM, nN, nwg, G, c;
    __host__ __device__ void init(int M, int N, int G_, int c_) { nM = M / BM; nN = N / BM; nwg = nM * nN; G = G_; c = c_; }
    __host__ __device__ bool next(int i, Unit& u) const {
        const long L = (long)i * G + c; if (L >= nwg) return false;
        int wgid = (int)L; { const int q = nwg / NXCD, r = nwg % NXCD, xcd = wgid % NXCD, off = wgid / NXCD; wgid = (xcd < r ? xcd * (q + 1) : r * (q + 1) + (xcd - r) * q) + off; }
        const int nig = WGM * nN, gid = wgid / nig, fm = gid * WGM, gsz = (nM - fm) < WGM ? (nM - fm) : WGM;
        u.pm = fm + ((wgid % nig) % gsz); u.pn = (wgid % nig) / gsz; u.e = 0; return true;
    }
    __device__ __forceinline__ void a_ready(const Unit&) const {}
    __device__ __forceinline__ void done(const Unit&) const {}
};


typedef int v8i32_t __attribute__((ext_vector_type(8)));
typedef int v4i32_t __attribute__((ext_vector_type(4)));
__device__ __forceinline__ v8i32_t cat8(bf16x8 lo, bf16x8 hi) { const v4i32_t a = __builtin_bit_cast(v4i32_t, lo), b = __builtin_bit_cast(v4i32_t, hi); return (v8i32_t){a[0], a[1], a[2], a[3], b[0], b[1], b[2], b[3]}; }
template <class Epi, class Sched, bool ALIGN_EPI = false, bool SP2 = false, bool F8 = false, bool I8 = false>
__device__ __forceinline__ void gemm_phase(PG8_LAS unsigned char* lds, const Gemm g, const Sched& S, const Epi& E) {
    const int tid = threadIdx.x, wid = __builtin_amdgcn_readfirstlane(tid >> 6), lane = tid & 63, wr = wid >> 2, wc = wid & 3, fr = lane & 15, fq = lane >> 4;
    const int K = g.K, nt = K / BK;
    unsigned voffA[2], voffB[2];
#pragma unroll
    for (int i = 0; i < 2; ++i) { int R, C; stage_rc(tid * 16 + i * 8192, R, C); const int Rb = Epi::PERM ? ((R & ~31) + perm32(R & 31)) : R;
        voffA[i] = (unsigned)(R * g.lda + C) * 2u; voffB[i] = (unsigned)(Rb * K + C) * 2u; }
    const size_t kstep = (size_t)(BK * 2);
    const size_t hstep = (size_t)HALF * K * 2;
    const size_t tstep = 2 * hstep;
    const size_t hstepA = (size_t)HALF * g.lda * 2, tstepA = 2 * hstepA;
    const size_t estep = g.bstride * 2;
    const unsigned ldsw = (unsigned)wid * 1024u;
    const int aoff = lds_byte(wr * 64 + fr, fq * 8), boff = lds_byte(wc * 32 + fr, fq * 8);
#define PG8_SA(b, h) (((b) * 2 + (h)) * HTB)
#define PG8_SB(b, h) ((4 + (b) * 2 + (h)) * HTB)
#define PG8_STAGE(bufoff, gbase, voff) do { _Pragma("unroll") for (int _i = 0; _i < 2; ++_i) \
        __builtin_amdgcn_global_load_lds((const unsigned*)((const char*)(gbase) + (voff)[_i]), (PG8_LAS unsigned*)(lds + (bufoff) + ldsw + _i * 8192), 16, 0, 0); } while (0)
#define PG8_LDA(dst, b, h) do { _Pragma("unroll") for (int m = 0; m < 4; ++m) _Pragma("unroll") for (int k = 0; k < 2; ++k) dst[m][k] = *(const PG8_LAS bf16x8*)(lds + PG8_SA(b, h) + aoff + m * 2048 + k * 1024); } while (0)
#define PG8_LDB(dst, b, h) do { _Pragma("unroll") for (int n = 0; n < 2; ++n) _Pragma("unroll") for (int k = 0; k < 2; ++k) dst[n][k] = *(const PG8_LAS bf16x8*)(lds + PG8_SB(b, h) + boff + n * 2048 + k * 1024); } while (0)
#define PG8_MMA(ai, bj, At, Bt) do { __builtin_amdgcn_s_setprio(1); if constexpr (I8) { _Pragma("unroll") for (int m = 0; m < 4; ++m) _Pragma("unroll") for (int n = 0; n < 2; ++n) _Pragma("unroll") for (int k = 0; k < 2; ++k) \
        asm volatile("v_mfma_i32_16x16x64_i8 %0, %1, %2, %0" : "+v"(acc[ai][bj][m][n]) : "v"(Bt[n][k]), "v"(At[m][k])); } else if constexpr (F8) { _Pragma("unroll") for (int m = 0; m < 4; ++m) _Pragma("unroll") for (int n = 0; n < 2; ++n) \
        asm volatile("v_mfma_scale_f32_16x16x128_f8f6f4 %0, %1, %2, %0, %3, %3 op_sel_hi:[0,0,0]" : "+v"(acc[ai][bj][m][n]) : "v"(cat8(Bt[n][0], Bt[n][1])), "v"(cat8(At[m][0], At[m][1])), "v"(sc8)); } else { \
        _Pragma("unroll") for (int m = 0; m < 4; ++m) _Pragma("unroll") for (int n = 0; n < 2; ++n) _Pragma("unroll") for (int k = 0; k < 2; ++k) \
        acc[ai][bj][m][n] = __builtin_amdgcn_mfma_f32_16x16x32_bf16(Bt[n][k], At[m][k], acc[ai][bj][m][n], 0, 0, 0); } __builtin_amdgcn_s_setprio(0); } while (0)
#define PG8_WAIT_V(n) asm volatile("s_waitcnt vmcnt(" #n ")" ::: "memory")
#define PG8_WAIT_L(n) asm volatile("s_waitcnt lgkmcnt(" #n ")" ::: "memory")
#define PG8_BAR __builtin_amdgcn_s_barrier()
#define PG8_SCHED __builtin_amdgcn_sched_barrier(0)
    Unit cur, nxt; int ui = 0;
    if (!S.next(0, cur)) return;
    int sc8 = 0x7f7f7f7f; asm volatile("" : "+v"(sc8));
    f32x4 acc[2][2][4][2];
#pragma unroll
    for (int a = 0; a < 2; ++a)
#pragma unroll
        for (int b = 0; b < 2; ++b)
#pragma unroll
            for (int m = 0; m < 4; ++m)
#pragma unroll
                for (int n = 0; n < 2; ++n) acc[a][b][m][n] = (f32x4){0.f, 0.f, 0.f, 0.f};
    bf16x8 At[4][2], B0[2][2], B1[2][2];
    const char* cA = (const char*)g.A + (size_t)cur.pm * tstepA; const char* cB = (const char*)g.Bt + (size_t)cur.pn * tstep + (size_t)cur.e * estep;
    S.a_ready(cur);
    if constexpr (SP2) {
        PG8_STAGE(PG8_SB(0, 0), cB, voffB); PG8_STAGE(PG8_SB(0, 1), cB + hstep, voffB); PG8_STAGE(PG8_SA(0, 0), cA, voffA); PG8_STAGE(PG8_SA(0, 1), cA + hstepA, voffA);
        if (wr == 1) PG8_BAR;
        PG8_WAIT_V(2); PG8_BAR;
        PG8_STAGE(PG8_SB(1, 0), cB + kstep, voffB); PG8_STAGE(PG8_SA(1, 0), cA + kstep, voffA); PG8_STAGE(PG8_SB(1, 1), cB + hstep + kstep, voffB);
        PG8_WAIT_V(6); PG8_BAR;
    } else {
        PG8_STAGE(PG8_SB(0, 0), cB, voffB); PG8_STAGE(PG8_SA(0, 0), cA, voffA); PG8_STAGE(PG8_SB(0, 1), cB + hstep, voffB); PG8_STAGE(PG8_SA(0, 1), cA + hstepA, voffA);
        if (wr == 1) PG8_BAR;
        PG8_WAIT_V(4); PG8_BAR;
        PG8_STAGE(PG8_SB(1, 0), cB + kstep, voffB); PG8_STAGE(PG8_SA(1, 0), cA + kstep, voffA); PG8_STAGE(PG8_SB(1, 1), cB + hstep + kstep, voffB);
        PG8_WAIT_V(6); PG8_BAR;
    }
    for (;;) {
        const bool has_next = S.next(ui + 1, nxt);
        const char* nA = has_next ? (const char*)g.A + (size_t)nxt.pm * tstepA : cA; const char* nB = has_next ? (const char*)g.Bt + (size_t)nxt.pn * tstep + (size_t)nxt.e * estep : cB;
#pragma unroll 1
        for (int t = 0; t < nt; t += 2) {
            const bool last = (t == nt - 2);
            const char* a1 = cA + (size_t)(t + 1) * kstep;
            const char* a2 = last ? nA : cA + (size_t)(t + 2) * kstep; const char* b2 = last ? nB : cB + (size_t)(t + 2) * kstep;
            const char* a3 = a2 + kstep; const char* b3 = b2 + kstep;
            if (last && has_next) S.a_ready(nxt);
            if constexpr (SP2) {
            PG8_LDB(B0, 0, 0); PG8_LDB(B1, 0, 1); PG8_SCHED; PG8_LDA(At, 0, 0); PG8_STAGE(PG8_SA(1, 1), a1 + hstepA, voffA);
            PG8_WAIT_V(8); PG8_WAIT_L(0); PG8_BAR; PG8_MMA(0, 0, At, B0); PG8_MMA(0, 1, At, B1); PG8_BAR; PG8_SCHED;
            PG8_LDA(At, 0, 1); PG8_STAGE(PG8_SB(0, 0), b2, voffB); PG8_STAGE(PG8_SB(0, 1), b2 + hstep, voffB); PG8_STAGE(PG8_SA(0, 0), a2, voffA);
            PG8_WAIT_V(8); PG8_WAIT_L(0); PG8_BAR; PG8_MMA(1, 0, At, B0); PG8_MMA(1, 1, At, B1); PG8_BAR; PG8_SCHED;
            PG8_LDB(B0, 1, 0); PG8_LDB(B1, 1, 1); PG8_SCHED; PG8_LDA(At, 1, 0); PG8_STAGE(PG8_SA(0, 1), a2 + hstepA, voffA);
            PG8_WAIT_V(8); PG8_WAIT_L(0); PG8_BAR; PG8_MMA(0, 0, At, B0); PG8_MMA(0, 1, At, B1); PG8_BAR; PG8_SCHED;
            PG8_LDA(At, 1, 1); PG8_STAGE(PG8_SB(1, 0), b3, voffB); PG8_STAGE(PG8_SB(1, 1), b3 + hstep, voffB); PG8_STAGE(PG8_SA(1, 0), a3, voffA);
            PG8_WAIT_V(8); PG8_WAIT_L(0); PG8_BAR; PG8_MMA(1, 0, At, B0); PG8_MMA(1, 1, At, B1); PG8_BAR; PG8_SCHED;
            } else {
            PG8_LDB(B0, 0, 0); PG8_SCHED; PG8_LDA(At, 0, 0); PG8_STAGE(PG8_SA(1, 1), a1 + hstepA, voffA);
            PG8_WAIT_L(8); PG8_BAR; PG8_WAIT_L(0); PG8_MMA(0, 0, At, B0); PG8_BAR; PG8_SCHED;
            PG8_LDB(B1, 0, 1); PG8_STAGE(PG8_SB(0, 0), b2, voffB);
            PG8_BAR; PG8_WAIT_L(0); PG8_MMA(0, 1, At, B1); PG8_BAR;
            PG8_LDA(At, 0, 1); PG8_STAGE(PG8_SA(0, 0), a2, voffA);
            PG8_BAR; PG8_WAIT_L(0); PG8_MMA(1, 0, At, B0); PG8_BAR; PG8_SCHED;
            PG8_STAGE(PG8_SB(0, 1), b2 + hstep, voffB);
            PG8_WAIT_V(6); PG8_BAR; PG8_MMA(1, 1, At, B1); PG8_BAR;
            PG8_LDB(B0, 1, 0); PG8_SCHED; PG8_LDA(At, 1, 0); PG8_STAGE(PG8_SA(0, 1), a2 + hstepA, voffA);
            PG8_WAIT_L(8); PG8_BAR; PG8_WAIT_L(0); PG8_MMA(0, 0, At, B0); PG8_BAR; PG8_SCHED;
            PG8_LDB(B1, 1, 1); PG8_STAGE(PG8_SB(1, 0), b3, voffB);
            PG8_BAR; PG8_WAIT_L(0); PG8_MMA(0, 1, At, B1); PG8_BAR;
            PG8_LDA(At, 1, 1); PG8_STAGE(PG8_SA(1, 0), a3, voffA);
            PG8_BAR; PG8_WAIT_L(0); PG8_MMA(1, 0, At, B0); PG8_BAR; PG8_SCHED;
            PG8_STAGE(PG8_SB(1, 1), b3 + hstep, voffB);
            PG8_WAIT_V(6); PG8_BAR; PG8_MMA(1, 1, At, B1); PG8_BAR;
            }
        }
        if constexpr (ALIGN_EPI) { if (wr == 0) PG8_BAR; }
        if constexpr (F8 || I8) asm volatile("s_nop 15\n\ts_nop 15" ::: "memory");
        if constexpr (!Epi::AFTER_DRAIN) { E(acc, cur, wr, wc, fr, fq); S.done(cur); }
        if (!has_next) break;
#pragma unroll
        for (int a = 0; a < 2; ++a)
#pragma unroll
            for (int b = 0; b < 2; ++b)
#pragma unroll
                for (int m = 0; m < 4; ++m)
#pragma unroll
                    for (int n = 0; n < 2; ++n) acc[a][b][m][n] = (f32x4){0.f, 0.f, 0.f, 0.f};
        cur = nxt; cA = nA; cB = nB; ++ui;
        if constexpr (ALIGN_EPI) { if (wr == 1) PG8_BAR; }
    }
    PG8_WAIT_V(0);
    if constexpr (!ALIGN_EPI) { if (wr == 0) PG8_BAR; }
    PG8_BAR;
    if constexpr (Epi::AFTER_DRAIN) { E.fused(acc, cur, wr, wc, fr, fq, lds, wid, lane); S.done(cur); }
#undef PG8_SA
#undef PG8_SB
#undef PG8_STAGE
#undef PG8_LDA
#undef PG8_LDB
#undef PG8_MMA
#undef PG8_WAIT_V
#undef PG8_WAIT_L
#undef PG8_BAR
#undef PG8_SCHED
}
}

namespace pg8 {
typedef f32x4 Acc[2][2][4][2];
__device__ __forceinline__ u32x4 pack8(const f32x4 v0, const f32x4 v1) { u32x4 w; w.x = pk2(v0[0], v0[1]); w.y = pk2(v0[2], v0[3]); w.z = pk2(v1[0], v1[1]); w.w = pk2(v1[2], v1[3]); return w; }
__device__ __forceinline__ void unpack8(const u32x4 w, f32x4& a, f32x4& b) { a = (f32x4){bflo(w.x), bfhi(w.x), bflo(w.y), bfhi(w.y)}; b = (f32x4){bflo(w.z), bfhi(w.z), bflo(w.w), bfhi(w.w)}; }

struct EpiInE {
    static constexpr bool PERM = true, AFTER_DRAIN = false;
    bf16_t* Y1; float* ssq_q; float* ssq_kv;
    __device__ __forceinline__ void operator()(const Acc& acc, const Unit& u, int wr, int wc, int fr, int fq) const {
        bf16_t* base = Y1 + (size_t)u.pn * MTOK * 256;
        const float sc = (u.pn == 2 || u.pn == 3) ? QSCALE : 1.f;
        const int col0 = wc * 32 + 8 * fq;
#pragma unroll
        for (int ai = 0; ai < 2; ++ai)
#pragma unroll
            for (int m = 0; m < 4; ++m) {
                const int row = u.pm * BM + ai * HALF + wr * 64 + m * 16 + fr; bf16_t* rowp = base + (size_t)row * 256 + col0;
                float s0 = 0.f, s1 = 0.f;
#pragma unroll
                for (int bj = 0; bj < 2; ++bj) { const f32x4 v0 = acc[ai][bj][m][0], v1 = acc[ai][bj][m][1];
                    const float q = (v0[0] * v0[0] + v0[1] * v0[1]) + (v0[2] * v0[2] + v0[3] * v0[3]) + (v1[0] * v1[0] + v1[1] * v1[1]) + (v1[2] * v1[2] + v1[3] * v1[3]);
                    if (bj == 0) s0 = q; else s1 = q;
                    *(u32x4*)(rowp + bj * HALF) = pack8(v0 * sc, v1 * sc); }
                if (u.pn <= 1) {
                    float s = (u.pn == 0) ? (s0 + s1) : s0;
                    s += __shfl_xor(s, 16); s += __shfl_xor(s, 32);
                    if (fq == 0) (u.pn == 0 ? ssq_q : ssq_kv)[(size_t)row * 4 + wc] = s;
                }
            }
    }
};
struct EpiQ2 {
    static constexpr bool PERM = true, AFTER_DRAIN = false;
    bf16_t* QLAT; bf16_t* QIDX; const float* ssq_q;
    __device__ __forceinline__ void operator()(const Acc& acc, const Unit& u, int wr, int wc, int fr, int fq) const {
        bf16_t* base = (u.pn < 4) ? QLAT : QIDX; const float sc0 = (u.pn < 4) ? QSCALE : 1.f;
        const int col0 = (u.pn & 3) * 256 + wc * 32 + 8 * fq;
#pragma unroll
        for (int ai = 0; ai < 2; ++ai)
#pragma unroll
            for (int m = 0; m < 4; ++m) {
                const int row = u.pm * BM + ai * HALF + wr * 64 + m * 16 + fr; bf16_t* rowp = base + (size_t)row * 1024 + col0;
                const f32x4 sq = *(const f32x4*)(ssq_q + (size_t)row * 4); const float sc = sc0 * __builtin_amdgcn_rsqf(((sq[0] + sq[1]) + (sq[2] + sq[3])) * (1.f / 256.f) + 1e-6f);
#pragma unroll
                for (int bj = 0; bj < 2; ++bj) *(u32x4*)(rowp + bj * HALF) = pack8(acc[ai][bj][m][0] * sc, acc[ai][bj][m][1] * sc);
            }
    }
};
template <bool RES_F32> struct EpiRes {
    static constexpr bool PERM = true, AFTER_DRAIN = false;
    const void* res; bf16_t* S; float sc;
    __device__ __forceinline__ void operator()(const Acc& acc, const Unit& u, int wr, int wc, int fr, int fq) const {
        const int col0 = u.pn * BM + wc * 32 + 8 * fq;
#pragma unroll
        for (int ai = 0; ai < 2; ++ai)
#pragma unroll
            for (int m = 0; m < 4; ++m) {
                const size_t off = (size_t)(u.pm * BM + ai * HALF + wr * 64 + m * 16 + fr) * 1024 + col0;
#pragma unroll
                for (int bj = 0; bj < 2; ++bj) { f32x4 r0, r1;
                    if (RES_F32) { r0 = *(const f32x4*)((const float*)res + off + bj * HALF); r1 = *(const f32x4*)((const float*)res + off + bj * HALF + 4); }
                    else unpack8(*(const u32x4*)((const bf16_t*)res + off + bj * HALF), r0, r1);
                    *(u32x4*)(S + off + bj * HALF) = pack8(r0 * ALPHA + acc[ai][bj][m][0] * sc, r1 * ALPHA + acc[ai][bj][m][1] * sc); }
            }
    }
};
struct EpiSwiglu {
    static constexpr bool PERM = true, AFTER_DRAIN = false;
    bf16_t* O; int ldo; int pm0;
    __device__ __forceinline__ void operator()(const Acc& acc, const Unit& u, int wr, int wc, int fr, int fq) const {
        const int col0 = u.pn * HALF + wc * 32 + 8 * fq;
#pragma unroll
        for (int ai = 0; ai < 2; ++ai)
#pragma unroll
            for (int m = 0; m < 4; ++m) {
                bf16_t* rowp = O + (size_t)((u.pm - pm0) * BM + ai * HALF + wr * 64 + m * 16 + fr) * ldo + col0;
                f32x4 o[2];
#pragma unroll
                for (int n = 0; n < 2; ++n) { const f32x4 a = acc[ai][0][m][n], b = acc[ai][1][m][n];
#pragma unroll
                    for (int e = 0; e < 4; ++e) o[n][e] = a[e] * __builtin_amdgcn_rcpf(1.f + __expf(-a[e])) * b[e]; }
                *(u32x4*)rowp = pack8(o[0], o[1]);
            }
    }
};
struct EpiStore {
    static constexpr bool PERM = true, AFTER_DRAIN = false;
    bf16_t* O; int ldo;
    __device__ __forceinline__ void operator()(const Acc& acc, const Unit& u, int wr, int wc, int fr, int fq) const {
        const int col0 = u.pn * BM + wc * 32 + 8 * fq;
#pragma unroll
        for (int ai = 0; ai < 2; ++ai)
#pragma unroll
            for (int m = 0; m < 4; ++m) {
                bf16_t* rowp = O + (size_t)(u.pm * BM + ai * HALF + wr * 64 + m * 16 + fr) * ldo + col0;
#pragma unroll
                for (int bj = 0; bj < 2; ++bj) *(u32x4*)(rowp + bj * HALF) = pack8(acc[ai][bj][m][0], acc[ai][bj][m][1]);
            }
    }
};
struct EpiInO {
    static constexpr bool PERM = true, AFTER_DRAIN = false;
    bf16_t* QKV; float* kmean; float isc;
    __device__ __forceinline__ void operator()(const Acc& acc, const Unit& u, int wr, int wc, int fr, int fq) const {
        const int which = u.pn >> 2; bf16_t* base = QKV + (size_t)which * MTOK * 1024; const float sc = (which == 0) ? QSCALE * isc : isc;
        const int col0 = (u.pn & 3) * BM + wc * 32 + 8 * fq;
#pragma unroll
        for (int ai = 0; ai < 2; ++ai)
#pragma unroll
            for (int m = 0; m < 4; ++m) {
                bf16_t* rowp = base + (size_t)(u.pm * BM + ai * HALF + wr * 64 + m * 16 + fr) * 1024 + col0;
#pragma unroll
                for (int bj = 0; bj < 2; ++bj) *(u32x4*)(rowp + bj * HALF) = pack8(acc[ai][bj][m][0] * sc, acc[ai][bj][m][1] * sc);
            }
        if (which == 1) {
#pragma unroll
            for (int bj = 0; bj < 2; ++bj)
#pragma unroll
                for (int n = 0; n < 2; ++n) { f32x4 s = (f32x4){0.f, 0.f, 0.f, 0.f};
#pragma unroll
                    for (int ai = 0; ai < 2; ++ai)
#pragma unroll
                        for (int m = 0; m < 4; ++m) s += acc[ai][bj][m][n];
#pragma unroll
                    for (int e = 0; e < 4; ++e) { float v = s[e]; v += __shfl_xor(v, 1); v += __shfl_xor(v, 2); v += __shfl_xor(v, 4); v += __shfl_xor(v, 8);
                        if (fr == 0) kmean[((size_t)u.pm * 2 + wr) * 1024 + col0 + bj * HALF + 4 * n + e] = v; }
                }
        }
    }
};

__device__ __forceinline__ unsigned pk4_fp8(float a, float b, float c, float d) { int w = 0; w = __builtin_amdgcn_cvt_pk_fp8_f32(a, b, w, false); w = __builtin_amdgcn_cvt_pk_fp8_f32(c, d, w, true); return (unsigned)w; }
struct EpiSwiglu8 {
    static constexpr bool PERM = true, AFTER_DRAIN = false;
    unsigned char* O; int ldo; int pm0; float isc;
    __device__ __forceinline__ void operator()(const Acc& acc, const Unit& u, int wr, int wc, int fr, int fq) const {
        const int col0 = u.pn * HALF + wc * 32 + 8 * fq;
#pragma unroll
        for (int ai = 0; ai < 2; ++ai)
#pragma unroll
            for (int m = 0; m < 4; ++m) {
                unsigned char* rowp = O + (size_t)((u.pm - pm0) * BM + ai * HALF + wr * 64 + m * 16 + fr) * ldo + col0;
                f32x4 o[2];
#pragma unroll
                for (int n = 0; n < 2; ++n) { const f32x4 a = acc[ai][0][m][n] * isc, b = acc[ai][1][m][n] * isc;
#pragma unroll
                    for (int e = 0; e < 4; ++e) o[n][e] = a[e] * __builtin_amdgcn_rcpf(1.f + __expf(-a[e])) * b[e]; }
                u32x2 w; w.x = pk4_fp8(o[0][0], o[0][1], o[0][2], o[0][3]); w.y = pk4_fp8(o[1][0], o[1][1], o[1][2], o[1][3]);
                *(u32x2*)rowp = w;
            }
    }
};

struct EpiSwigluI8 {
    static constexpr bool PERM = true, AFTER_DRAIN = false;
    unsigned char* O; int ldo; const float* sa; const float* sw;
    __device__ __forceinline__ void operator()(const Acc& acc, const Unit& u, int wr, int wc, int fr, int fq) const {
        const int col0 = u.pn * HALF + wc * 32 + 8 * fq, bcol = u.pn * BM + wc * 32 + 8 * fq;
        f32x4 w1s[2], w3s[2];
#pragma unroll
        for (int n = 0; n < 2; ++n) { w1s[n] = *(const f32x4*)(sw + bcol + 4 * n); w3s[n] = *(const f32x4*)(sw + bcol + HALF + 4 * n); }
#pragma unroll
        for (int ai = 0; ai < 2; ++ai)
#pragma unroll
            for (int m = 0; m < 4; ++m) {
                const int row = u.pm * BM + ai * HALF + wr * 64 + m * 16 + fr; const float ra = sa[row];
                unsigned char* rowp = O + (size_t)row * ldo + col0;
                f32x4 o[2];
#pragma unroll
                for (int n = 0; n < 2; ++n) {
#pragma unroll
                    for (int e = 0; e < 4; ++e) { const float xa = acc[ai][0][m][n][e], xb = acc[ai][1][m][n][e];
                        const float a = (float)__float_as_int(xa) * ra * w1s[n][e], b = (float)__float_as_int(xb) * ra * w3s[n][e];
                        o[n][e] = a * __builtin_amdgcn_rcpf(1.f + __expf(-a)) * b; } }
                u32x2 w; w.x = pk4_fp8(o[0][0], o[0][1], o[0][2], o[0][3]); w.y = pk4_fp8(o[1][0], o[1][1], o[1][2], o[1][3]);
                *(u32x2*)rowp = w;
            }
    }
};
struct EpiStoreS {
    static constexpr bool PERM = true, AFTER_DRAIN = false;
    bf16_t* O; int ldo; float sc;
    __device__ __forceinline__ void operator()(const Acc& acc, const Unit& u, int wr, int wc, int fr, int fq) const {
        const int col0 = u.pn * BM + wc * 32 + 8 * fq;
#pragma unroll
        for (int ai = 0; ai < 2; ++ai)
#pragma unroll
            for (int m = 0; m < 4; ++m) {
                bf16_t* rowp = O + (size_t)(u.pm * BM + ai * HALF + wr * 64 + m * 16 + fr) * ldo + col0;
#pragma unroll
                for (int bj = 0; bj < 2; ++bj) *(u32x4*)(rowp + bj * HALF) = pack8(acc[ai][bj][m][0] * sc, acc[ai][bj][m][1] * sc);
            }
    }
};
struct MoeOrder {
    int g0, ng, nN, G, c; int pend[8];
    __device__ __forceinline__ bool next(int i, Unit& u) const {
        const int L = i * G + c; if (L >= ng * nN) return false;
        u.pm = g0 + L % ng; u.pn = L / ng; const int r = u.pm * 256; int e = 0;
#pragma unroll
        for (int k = 0; k < 7; ++k) e += (pend[k] <= r) ? 1 : 0;
        u.e = e; return true;
    }
    __device__ __forceinline__ void a_ready(const Unit&) const {}
    __device__ __forceinline__ void done(const Unit&) const {}
};
}

#ifndef FFN_F8
#define FFN_F8 0
#endif
constexpr size_t MiB = 1u << 20, KiB = 1u << 10;
constexpr size_t CTL_ZERO_BYTES = 2 * MiB;
constexpr int    MAX_LAUNCHES = 18;
constexpr size_t OFF_BAR = 16 * KiB;
constexpr size_t OFF_WGCNT = 1 * MiB + 512 * KiB;
constexpr size_t OFF_GINFO = OFF_WGCNT + 16 * KiB;
constexpr size_t OFF_DBG = OFF_GINFO + 1 * KiB;
constexpr size_t OFF_BT = 2 * MiB;
constexpr size_t OFF_CB = 2 * MiB + 16 * KiB;
constexpr size_t OFF_ROUTE = 2 * MiB + 64 * KiB;
constexpr size_t OFF_DEST = 2 * MiB + 512 * KiB;
constexpr size_t OFF_KC = 3 * MiB, OFF_VC = 3 * MiB + 512 * KiB;
constexpr size_t OFF_W_IN = 4 * MiB, OFF_W_Q2 = OFF_W_IN + (size_t)EVEN_INP * 1024 * 2, OFF_W_OUTE = OFF_W_Q2 + 2048 * 256 * 2, OFF_W_F13 = OFF_W_OUTE + 1024 * 1536 * 2,
                 OFF_W_F2 = OFF_W_F13 + (size_t)2 * DFF * 1024 * 2, OFF_CK1 = OFF_W_F2 + (size_t)1024 * DFF * 2, OFF_CV1 = OFF_CK1 + 64 * 2048 * 2, OFF_WE_END = OFF_CV1 + 64 * 2048 * 2;
static_assert(OFF_WE_END <= 30 * MiB, "even weights");
constexpr size_t OFF_W_OIN = 30 * MiB, OFF_W_OOUT = 36 * MiB, OFF_W_M13 = 38 * MiB, OFF_W_M2 = 94 * MiB;
constexpr size_t OFF_Y1 = 30 * MiB;
constexpr size_t OFF_CKVN = 142 * MiB;
constexpr size_t OFF_XB = 206 * MiB, OFF_QLAT = 206 * MiB, OFF_QIDX = 270 * MiB;
constexpr size_t OFF_SC = 334 * MiB, OFF_MASK = 464 * MiB, OFF_MIXIN = 334 * MiB;
constexpr size_t OFF_S1 = 206 * MiB, OFF_H = 270 * MiB, OFF_ACT = 30 * MiB, OFF_S2 = 334 * MiB, OFF_X1 = 398 * MiB, OFF_H8 = 464 * MiB;
constexpr size_t OFF_SA = 497 * MiB, OFF_SW = 497 * MiB + 256 * KiB, OFF_SAX = 497 * MiB + 512 * KiB, OFF_SWIN = 497 * MiB + 768 * KiB;
constexpr size_t OFF_X18 = 464 * MiB, OFF_O8 = 464 * MiB;
constexpr float OSC = 16.f, WOUT_SCALE = 64.f, WIN_SCALE = 32.f, WF13_SCALE = 32.f, WF2_SCALE = 128.f;
constexpr size_t OFF_QKV = 206 * MiB, OFF_S1O = 270 * MiB, OFF_H2 = 122 * MiB, OFF_ACTM = 186 * MiB, OFF_YR = 298 * MiB, OFF_XR = 430 * MiB;
constexpr float W13_SCALE = 32.f, W2_SCALE = 128.f;
constexpr size_t OFF_SSQ_Q = 514 * MiB, OFF_SSQ_KV = 514 * MiB + 512 * KiB;
constexpr size_t OFF_KMEAN = 515 * MiB;
constexpr size_t WS_END = 516 * MiB;
constexpr int    MOE_CHUNK = 128;
constexpr size_t SCB_ELEMS = (size_t)64 * 64 * (64 * 65 / 2);

constexpr int LDS_BYTES = 160 * 1024;
constexpr int LDSCTL_OFF = LDS_BYTES - 512;

#define RLX_AGENT __ATOMIC_RELAXED, __HIP_MEMORY_SCOPE_AGENT
typedef GAS unsigned gu32;
#define XB_TMO      128
#define XB_XCNT(j)  (256  + 64 * (j))
#define XB_XSUB(j)  (1280 + 64 * (j))
#define XB_XGEN(j)  (2304 + 64 * (j))
#define XB_TOP      3328
#define XB_TOPGEN   3392
#define XCD_BAR_WORDS 3456
#define XB_SPIN_CAP (1u << 18)

__device__ __forceinline__ unsigned xb_ld(unsigned* p)              { return __hip_atomic_load(p, __ATOMIC_RELAXED, __HIP_MEMORY_SCOPE_AGENT); }
__device__ __forceinline__ unsigned xb_add(unsigned* p, unsigned v) { return __hip_atomic_fetch_add(p, v, __ATOMIC_RELAXED, __HIP_MEMORY_SCOPE_AGENT); }
__device__ __forceinline__ unsigned xb_xcc_id() { return (unsigned)__builtin_amdgcn_s_getreg((3 << 11) | 20) & 0xFu; }
#define XB_SPIN(cond, bar) do { unsigned _sp = 0; while (cond) { __builtin_amdgcn_s_sleep(1); \
    if ((++_sp & 255u) == 0u) { if (xb_ld(&(bar)[XB_TMO])) break; if (_sp > XB_SPIN_CAP) { atomicAdd(&(bar)[XB_TMO], 1u); break; } } } } while (0)

struct XcdBarrier {
    unsigned* bar; unsigned x;
    volatile LAS unsigned* st;
};

__device__ __forceinline__ XcdBarrier xcd_barrier_post(unsigned* bar, volatile LAS unsigned* st) {
    XcdBarrier b; b.bar = bar; b.x = xb_xcc_id(); b.st = st;
    if (threadIdx.x == 0) (void)xb_add(&bar[XB_XCNT(b.x)], 1u);
    return b;
}
__device__ __forceinline__ void xcd_barrier_complete(unsigned* bar, unsigned x, unsigned& nloc, unsigned& nx) {
    const unsigned G = gridDim.x * gridDim.y * gridDim.z;
    unsigned sum, cnt, mine, sp = 0u;
    for (;;) {
        sum = 0u; cnt = 0u; mine = 0u;
#pragma unroll
        for (unsigned j = 0; j < 16; ++j) { const unsigned c = xb_ld(&bar[XB_XCNT(j)]); sum += c; cnt += (c > 0u) ? 1u : 0u; mine = (j == x) ? c : mine; }
        if (sum == G) break;
        __builtin_amdgcn_s_sleep(1);
        if ((++sp & 255u) == 0u) { if (xb_ld(&bar[XB_TMO])) break; if (sp > XB_SPIN_CAP) { atomicAdd(&bar[XB_TMO], 1u); break; } }
    }
    nloc = mine > 0u ? mine : 1u; nx = cnt > 0u ? cnt : 1u;
}

__device__ __forceinline__ void xcd_barrier(const XcdBarrier& b) {
    asm volatile("s_waitcnt vmcnt(0)" ::: "memory");
    __syncthreads();
    if (threadIdx.x == 0) {
        unsigned* bar = b.bar;
        __builtin_amdgcn_s_waitcnt(0);
        unsigned nloc = b.st[0], nx = b.st[1];
        if (nloc == 0u) { xcd_barrier_complete(bar, b.x, nloc, nx); b.st[0] = nloc; b.st[1] = nx; }
        const unsigned old = xb_add(&bar[XB_XSUB(b.x)], 1u);
        const unsigned gen = old / nloc;
        if (old + 1u == (gen + 1u) * nloc) {
            __builtin_amdgcn_fence(__ATOMIC_RELEASE, "agent");
            asm volatile("s_waitcnt vmcnt(0)" ::: "memory");
            const unsigned og = xb_add(&bar[XB_TOP], 1u);
            const unsigned tg = og / nx;
            if (og + 1u == (tg + 1u) * nx) xb_add(&bar[XB_TOPGEN], 1u);
            else XB_SPIN(xb_ld(&bar[XB_TOPGEN]) == tg, bar);
            __builtin_amdgcn_fence(__ATOMIC_ACQUIRE, "agent");
            xb_add(&bar[XB_XGEN(b.x)], 1u);
            asm volatile("s_waitcnt vmcnt(0)" ::: "memory");
        } else {
            XB_SPIN(xb_ld(&bar[XB_XGEN(b.x)]) == gen, bar);
            __builtin_amdgcn_fence(__ATOMIC_ACQUIRE, "agent");
            asm volatile("s_waitcnt vmcnt(0)" ::: "memory");
        }
    }
    __syncthreads();
}

struct Frame {
    LAS unsigned char* lds;
    int tid, lane, wave, G, bx;
    int gw, NGW;
    unsigned char* ws;
    const float* const* in;
};
struct Args { const float* in[33]; float* out; unsigned char* ws; int ph_lo, ph_hi, li, pad; };
enum InIdx { I_X = 0, I_RELB, I_EWIN, I_EQN, I_EKVN, I_EWUQ, I_EWUK, I_EWUV, I_EWQIDX, I_EPOSK, I_EPOSV, I_ECK1, I_ECK2, I_ECV1, I_ECV2, I_EWOUT, I_ELN1G, I_ELN1B,
             I_EF1, I_EF3, I_EF2, I_ELN2G, I_ELN2B, I_OWIN, I_OWOUT, I_OLN1G, I_OLN1B, I_OROUTER, I_OM1, I_OM3, I_OM2, I_OLN2G, I_OLN2B };

template <class RowMap, class KScale>
__device__ __forceinline__ void transpose_item(const float* W, int K, int N, bf16_t* WT, int ldt, LAS float* scr, int item, int lane, RowMap rm, KScale ks) {
    const int nblk = (N + 63) >> 6, kb = item / nblk, nb = item - kb * nblk, k0 = 128 * kb, n = 64 * nb + lane;
    if (n >= N) return;
    const float* src = W + (size_t)k0 * N + n; bf16_t* dst = WT + (size_t)rm(n) * ldt + k0;
#pragma unroll 2
    for (int kk = 0; kk < 128; kk += 8) { float v[8];
#pragma unroll
        for (int i = 0; i < 8; ++i) v[i] = src[(size_t)(kk + i) * N] * ks(k0 + kk + i);
        u32x4 o; o.x = pk2(v[0], v[1]); o.y = pk2(v[2], v[3]); o.z = pk2(v[4], v[5]); o.w = pk2(v[6], v[7]);
        *(u32x4*)(dst + kk) = o; }
}
template <class RowMap>
__device__ __forceinline__ void transpose_item8(const float* W, int K, int N, unsigned char* WT, int ldt, int item, int lane, RowMap rm, float scale) {
    const int nblk = N >> 8, kb = item / nblk, nb = item - kb * nblk, k0 = 128 * kb, n = 256 * nb + 4 * lane;
    const float* src = W + (size_t)k0 * N + n;
    unsigned char* d0 = WT + (size_t)rm(n) * ldt + k0; unsigned char* d1 = WT + (size_t)rm(n + 1) * ldt + k0; unsigned char* d2 = WT + (size_t)rm(n + 2) * ldt + k0; unsigned char* d3 = WT + (size_t)rm(n + 3) * ldt + k0;
#pragma unroll 1
    for (int kk = 0; kk < 128; kk += 16) { f32x4 v[16];
#pragma unroll
        for (int i = 0; i < 16; ++i) v[i] = *(const f32x4*)(src + (size_t)(kk + i) * N) * scale;
#pragma unroll
        for (int c = 0; c < 4; ++c) { u32x4 o; o.x = pg8::pk4_fp8(v[0][c], v[1][c], v[2][c], v[3][c]); o.y = pg8::pk4_fp8(v[4][c], v[5][c], v[6][c], v[7][c]);
            o.z = pg8::pk4_fp8(v[8][c], v[9][c], v[10][c], v[11][c]); o.w = pg8::pk4_fp8(v[12][c], v[13][c], v[14][c], v[15][c]);
            *(u32x4*)((c == 0 ? d0 : c == 1 ? d1 : c == 2 ? d2 : d3) + kk) = o; } }
}
template <class RowMap>
__device__ __forceinline__ void transpose_item_i8(const float* W, int K, int N, unsigned char* WT, int ldt, float* sw, int item, int lane, RowMap rm) {
    const int c = lane & 7, kg = lane >> 3, n = 8 * item + c, ks = K >> 3, kbase = kg * ks;
    const float* src = W + (size_t)kbase * N + n; float mx = 0.f;
#pragma unroll 16
    for (int k = 0; k < ks; ++k) mx = fmaxf(mx, fabsf(src[(size_t)k * N]));
    mx = fmaxf(mx, __shfl_xor(mx, 8)); mx = fmaxf(mx, __shfl_xor(mx, 16)); mx = fmaxf(mx, __shfl_xor(mx, 32));
    mx = fmaxf(mx, 1e-20f); const float inv = 127.f / mx; const int dr = rm(n); if (kg == 0) sw[dr] = mx * (1.f / 127.f);
    unsigned char* dst = WT + (size_t)dr * ldt + kbase;
#pragma unroll 2
    for (int kk = 0; kk < ks; kk += 16) { unsigned w[4];
#pragma unroll
        for (int q = 0; q < 4; ++q) { const int q0 = (int)rintf(src[(size_t)(kk + 4 * q) * N] * inv), q1 = (int)rintf(src[(size_t)(kk + 4 * q + 1) * N] * inv), q2 = (int)rintf(src[(size_t)(kk + 4 * q + 2) * N] * inv), q3 = (int)rintf(src[(size_t)(kk + 4 * q + 3) * N] * inv);
            w[q] = (unsigned)(q0 & 255) | ((unsigned)(q1 & 255) << 8) | ((unsigned)(q2 & 255) << 16) | ((unsigned)(q3 & 255) << 24); }
        *(u32x4*)(dst + kk) = (u32x4){w[0], w[1], w[2], w[3]}; }
}
struct RowId { __device__ __forceinline__ int operator()(int n) const { return n; } };
struct KOne { __device__ __forceinline__ float operator()(int) const { return 1.f; } };
struct RowInE {
    __device__ __forceinline__ int operator()(int n) const { return n < 464 ? n : (n < 1744 ? n + 48 : n - 1744 + 464); }
};
struct RowIlv {
    int add; __device__ __forceinline__ int operator()(int n) const { return ((n >> 7) << 8) + (n & 127) + add; }
};
struct KGain { const float* g; __device__ __forceinline__ float operator()(int k) const { return g[k]; } };

__device__ __forceinline__ void store_row_i8(unsigned char* row, float* sa, int lane, const f32x4 (&v)[4]) {
    float mx = 0.f;
#pragma unroll
    for (int j = 0; j < 4; ++j) mx = fmaxf(fmaxf(mx, fmaxf(fabsf(v[j][0]), fabsf(v[j][1]))), fmaxf(fabsf(v[j][2]), fabsf(v[j][3])));
#pragma unroll
    for (int o = 1; o < 64; o <<= 1) mx = fmaxf(mx, __shfl_xor(mx, o));
    mx = fmaxf(mx, 1e-20f); const float inv = 127.f / mx;
#pragma unroll
    for (int j = 0; j < 4; ++j) { const int q0 = (int)rintf(v[j][0] * inv), q1 = (int)rintf(v[j][1] * inv), q2 = (int)rintf(v[j][2] * inv), q3 = (int)rintf(v[j][3] * inv);
        *(unsigned*)(row + 4 * lane + 256 * j) = (unsigned)(q0 & 255) | ((unsigned)(q1 & 255) << 8) | ((unsigned)(q2 & 255) << 16) | ((unsigned)(q3 & 255) << 24); }
    if (lane == 0) *sa = mx * (1.f / 127.f);
}
__device__ __forceinline__ int t5_bucket(int n) {
    if (n < 16) return n;
    int l = 16 + (int)(__logf((float)n / 16.f) / 2.0794415f * 16.f);
    return l < 31 ? l : 31;
}

__device__ __forceinline__ void phase_prologue_even(const Frame& F, const Args& a) {
    LAS float* scr = (LAS float*)(F.lds + F.wave * 8704);
    unsigned char* ws = F.ws;
    bf16_t* W_IN = (bf16_t*)(ws + OFF_W_IN); bf16_t* W_Q2 = (bf16_t*)(ws + OFF_W_Q2); unsigned char* W_OUTE = ws + OFF_W_OUTE;
    unsigned char* W_F13 = ws + OFF_W_F13; unsigned char* W_F2 = ws + OFF_W_F2; bf16_t* CK1 = (bf16_t*)(ws + OFF_CK1); bf16_t* CV1 = (bf16_t*)(ws + OFF_CV1);
    constexpr int I_IN = 8 * ((EVEN_IN + 63) / 64);
    constexpr int I_QI = 2 * 16;
    constexpr int I_OB = 4 * 4;
    constexpr int I_F1 = DFF / 8, I_F2 = (DFF / 128) * 4;
    constexpr int I_CK = 16 * 1;
    constexpr int NIT = I_IN + I_QI + I_OB + 2 * I_F1 + I_F2 + 2 * I_CK;
    for (int it = F.gw; it < NIT; it += F.NGW) {
        int r = it;
        if (r < I_IN) { transpose_item(a.in[I_EWIN], 1024, EVEN_IN, W_IN, 1024, scr, r, F.lane, RowInE{}, KOne{}); continue; } r -= I_IN;
        if (r < I_QI) { transpose_item(a.in[I_EWQIDX], 256, 1024, W_Q2 + 1024 * 256, 256, scr, r, F.lane, RowId{}, KGain{a.in[I_EQN]}); continue; } r -= I_QI;
        if (r < I_OB) { transpose_item8(a.in[I_EWOUT] + 512 * 1024, 512, 1024, W_OUTE + 1024, 1536, r, F.lane, RowId{}, WOUT_SCALE); continue; } r -= I_OB;
#if FFN_F8
        if (r < I_F1) { transpose_item8(a.in[I_EF1], 1024, DFF, W_F13, 1024, r, F.lane, RowIlv{0}, WF13_SCALE); continue; } r -= I_F1;
        if (r < I_F1) { transpose_item8(a.in[I_EF3], 1024, DFF, W_F13, 1024, r, F.lane, RowIlv{128}, WF13_SCALE); continue; } r -= I_F1;
        if (r < I_F2) { transpose_item8(a.in[I_EF2], DFF, 1024, W_F2, DFF, r, F.lane, RowId{}, WF2_SCALE); continue; } r -= I_F2;
#else
        if (r < I_F1) { transpose_item_i8(a.in[I_EF1], 1024, DFF, W_F13, 1024, (float*)(ws + OFF_SW), r, F.lane, RowIlv{0}); continue; } r -= I_F1;
        if (r < I_F1) { transpose_item_i8(a.in[I_EF3], 1024, DFF, W_F13, 1024, (float*)(ws + OFF_SW), r, F.lane, RowIlv{128}); continue; } r -= I_F1;
        if (r < I_F2) { transpose_item8(a.in[I_EF2], DFF, 1024, W_F2, DFF, r, F.lane, RowId{}, WF2_SCALE); continue; } r -= I_F2;
#endif
        if (r < I_CK) { transpose_item(a.in[I_ECK1], 2048, 64, CK1, 2048, scr, r, F.lane, RowId{}, KOne{}); continue; } r -= I_CK;
        transpose_item(a.in[I_ECV1], 2048, 64, CV1, 2048, scr, r, F.lane, RowId{}, KOne{});
    }
    const int gt = F.bx * NTHR + F.tid, NGT = F.G * NTHR;
    for (int i = gt; i < 24 * 1024 / 8; i += NGT) ((u32x4*)(W_IN + 488 * 1024))[i] = (u32x4){0u, 0u, 0u, 0u};
    { const float* uq = a.in[I_EWUQ]; const float* uk = a.in[I_EWUK]; const float* qg = a.in[I_EQN];
      for (int o = gt; o < 1024 * 256; o += NGT) { const int r = o & 255, hc = o >> 8, h = hc >> 7, c = hc & 127; const float* p = uq + r * 512 + h * 64; const float* q = uk + c * 512 + h * 64; float s = 0.f;
#pragma unroll 8
          for (int d = 0; d < 64; ++d) s += p[d] * q[d];
          W_Q2[o] = (bf16_t)f2bf(s * qg[r]); } }
    { const float* uv = a.in[I_EWUV]; const float* wo = a.in[I_EWOUT];
      for (int o = gt; o < 1024 * 1024 / 16; o += NGT) { const int nb = o & 255, hc4 = o >> 8, h = hc4 >> 5, c0 = (hc4 & 31) * 4, n0 = nb * 4;
          const float* p = uv + (size_t)c0 * 512 + h * 64; const float* q = wo + (size_t)(h * 64) * 1024 + n0;
          f32x4 acc4[4] = {(f32x4){0.f, 0.f, 0.f, 0.f}, (f32x4){0.f, 0.f, 0.f, 0.f}, (f32x4){0.f, 0.f, 0.f, 0.f}, (f32x4){0.f, 0.f, 0.f, 0.f}};
#pragma unroll 4
          for (int d = 0; d < 64; ++d) { const f32x4 qv = *(const f32x4*)(q + (size_t)d * 1024);
#pragma unroll
              for (int cc = 0; cc < 4; ++cc) acc4[cc] += qv * p[cc * 512 + d]; }
#pragma unroll
          for (int cc = 0; cc < 4; ++cc)
#pragma unroll
              for (int e = 0; e < 4; ++e) W_OUTE[(size_t)(n0 + e) * 1536 + h * 128 + c0 + cc] = (unsigned char)(__builtin_amdgcn_cvt_pk_fp8_f32(acc4[cc][e] * WOUT_SCALE, 0.f, 0, false) & 0xff); } }
    if (F.bx == 0) { float* BT = (float*)(ws + OFF_BT); const float* rb = a.in[I_RELB];
        for (int i = F.tid; i < 16 * 128; i += NTHR) { const int h = i >> 7, d = i & 127; BT[i] = rb[t5_bucket(d) * 16 + h] * LOG2E; } }
    if (F.bx == 1 && F.tid < 128) { const int kv = F.tid >> 6, e = F.tid & 63; const float* pos = a.in[kv ? I_EPOSV : I_EPOSK]; const float* w1 = a.in[kv ? I_ECV1 : I_ECK1]; float s = 0.f;
        for (int k = 0; k < 2048; ++k) s += pos[k] * w1[k * 64 + e];
        ((float*)(ws + OFF_CB))[F.tid] = s; }
    { const f32x4* x4 = (const f32x4*)a.in[I_X]; u32x4* xb = (u32x4*)(ws + OFF_XB);
      for (int i = gt; i < MTOK * 1024 / 8; i += NGT) { const f32x4 v0 = x4[2 * i], v1 = x4[2 * i + 1]; xb[i] = pg8::pack8(v0, v1); } }
}

__device__ __forceinline__ void phase_convert_odd(const Frame& F, const Args& a) {
    LAS float* scr = (LAS float*)(F.lds + F.wave * 8704);
    unsigned char* ws = F.ws;
    unsigned char* W_OIN = ws + OFF_W_OIN; unsigned char* W_OOUT = ws + OFF_W_OOUT; unsigned char* W_M13 = ws + OFF_W_M13; unsigned char* W_M2 = ws + OFF_W_M2;
    constexpr int I_IN = 8 * 12, I_OUT = 8 * 4, I_M1 = 8 * (DFFE / 256), I_M2 = (DFFE / 128) * 4;
    constexpr int NIT = I_IN + I_OUT + NEXP * (2 * I_M1 + I_M2);
    for (int it = F.gw; it < NIT; it += F.NGW) {
        int r = it;
        if (r < I_IN) { transpose_item8(a.in[I_OWIN], 1024, 3072, W_OIN, 1024, r, F.lane, RowId{}, WIN_SCALE); continue; } r -= I_IN;
        if (r < I_OUT) { transpose_item8(a.in[I_OWOUT], 1024, 1024, W_OOUT, 1024, r, F.lane, RowId{}, WOUT_SCALE); continue; } r -= I_OUT;
        const int e = r / (2 * I_M1 + I_M2); r -= e * (2 * I_M1 + I_M2);
        if (r < I_M1) { transpose_item8(a.in[I_OM1] + (size_t)e * 1024 * DFFE, 1024, DFFE, W_M13 + (size_t)e * 2 * DFFE * 1024, 1024, r, F.lane, RowIlv{0}, W13_SCALE); continue; } r -= I_M1;
        if (r < I_M1) { transpose_item8(a.in[I_OM3] + (size_t)e * 1024 * DFFE, 1024, DFFE, W_M13 + (size_t)e * 2 * DFFE * 1024, 1024, r, F.lane, RowIlv{128}, W13_SCALE); continue; } r -= I_M1;
        transpose_item8(a.in[I_OM2] + (size_t)e * DFFE * 1024, DFFE, 1024, W_M2 + (size_t)e * 1024 * DFFE, DFFE, r, F.lane, RowId{}, W2_SCALE);
    }
}

__device__ __forceinline__ void load_row_bf16(const bf16_t* row, int lane, f32x4 (&v)[4]) {
#pragma unroll
    for (int j = 0; j < 4; ++j) { const u32x2 w = *(const u32x2*)(row + 4 * lane + 256 * j); v[j] = (f32x4){bflo(w.x), bfhi(w.x), bflo(w.y), bfhi(w.y)}; }
}
__device__ __forceinline__ void store_row_bf16(bf16_t* row, int lane, const f32x4 (&v)[4]) {
#pragma unroll
    for (int j = 0; j < 4; ++j) { u32x2 w; w.x = pk2(v[j][0], v[j][1]); w.y = pk2(v[j][2], v[j][3]); *(u32x2*)(row + 4 * lane + 256 * j) = w; }
}
__device__ __forceinline__ void ln_inplace(f32x4 (&v)[4], const f32x4 (&g)[4], const f32x4 (&b)[4]) {
    float s = 0.f;
#pragma unroll
    for (int j = 0; j < 4; ++j) s += (v[j][0] + v[j][1]) + (v[j][2] + v[j][3]);
    const float mean = wave_sum(s) * (1.f / 1024.f); float q = 0.f;
#pragma unroll
    for (int j = 0; j < 4; ++j) { v[j] = v[j] - mean; q += (v[j][0] * v[j][0] + v[j][1] * v[j][1]) + (v[j][2] * v[j][2] + v[j][3] * v[j][3]); }
    const float rstd = 1.f / sqrtf(wave_sum(q) * (1.f / 1024.f) + 1e-5f);
#pragma unroll
    for (int j = 0; j < 4; ++j) v[j] = v[j] * rstd * g[j] + b[j];
}
__device__ __forceinline__ void load_gb(const float* g, const float* b, int lane, f32x4 (&gv)[4], f32x4 (&bv)[4]) {
#pragma unroll
    for (int j = 0; j < 4; ++j) { gv[j] = *(const f32x4*)(g + 4 * lane + 256 * j); bv[j] = *(const f32x4*)(b + 4 * lane + 256 * j); }
}
__device__ __forceinline__ void store_row_fp8(unsigned char* row, int lane, const f32x4 (&v)[4]) {
#pragma unroll
    for (int j = 0; j < 4; ++j) *(unsigned*)(row + 4 * lane + 256 * j) = pg8::pk4_fp8(v[j][0], v[j][1], v[j][2], v[j][3]);
}
__device__ __forceinline__ void phase_ln_bf16(const Frame& F, const bf16_t* S, bf16_t* O, unsigned char* O8, const float* g, const float* b) {
    f32x4 gv[4], bv[4]; load_gb(g, b, F.lane, gv, bv);
    for (int row = F.gw; row < MTOK; row += F.NGW) { f32x4 v[4]; load_row_bf16(S + (size_t)row * 1024, F.lane, v); ln_inplace(v, gv, bv); store_row_bf16(O + (size_t)row * 1024, F.lane, v); store_row_fp8(O8 + (size_t)row * 1024, F.lane, v); }
}
__device__ __forceinline__ void phase_ln_i8(const Frame& F, const bf16_t* S, bf16_t* O, unsigned char* O8, float* sa, const float* g, const float* b) {
    f32x4 gv[4], bv[4]; load_gb(g, b, F.lane, gv, bv);
    for (int row = F.gw; row < MTOK; row += F.NGW) { f32x4 v[4]; load_row_bf16(S + (size_t)row * 1024, F.lane, v); ln_inplace(v, gv, bv); store_row_bf16(O + (size_t)row * 1024, F.lane, v); store_row_i8(O8 + (size_t)row * 1024, sa + row, F.lane, v); }
}
__device__ __forceinline__ void phase_ckvn(const Frame& F, const bf16_t* T1, const float* ssq_kv, const float* gain, bf16_t* CKVN) {
    const float g0 = gain[2 * F.lane], g1 = gain[2 * F.lane + 1];
    for (int row = F.gw; row < MTOK; row += F.NGW) {
        const unsigned w = *(const unsigned*)(T1 + (size_t)row * 256 + 2 * F.lane);
        const f32x4 sq = *(const f32x4*)(ssq_kv + (size_t)row * 4); const float r = __builtin_amdgcn_rsqf(((sq[0] + sq[1]) + (sq[2] + sq[3])) * (1.f / 128.f) + 1e-6f);
        *(unsigned*)(CKVN + (size_t)row * 128 + 2 * F.lane) = pk2(bflo(w) * r * g0, bfhi(w) * r * g1);
    }
}
__device__ __forceinline__ void phase_ln_router(const Frame& F, const bf16_t* S, bf16_t* H2, const float* g, const float* b, const float* router, unsigned char* ws) {
    LAS int* cnt = (LAS int*)(F.lds);
    if (F.tid < 8) cnt[F.tid] = 0;
    __syncthreads();
    f32x4 gv[4], bv[4]; load_gb(g, b, F.lane, gv, bv);
    u32x2* ROUTE = (u32x2*)(ws + OFF_ROUTE);
    f32x4 rw[16][2];
#pragma unroll
    for (int j = 0; j < 4; ++j)
#pragma unroll
        for (int e = 0; e < 4; ++e) { const float* rp = router + (size_t)(4 * F.lane + 256 * j + e) * 8; rw[4 * j + e][0] = *(const f32x4*)rp; rw[4 * j + e][1] = *(const f32x4*)(rp + 4); }
    const bool b0 = F.lane & 1, b1 = F.lane & 2, b2 = F.lane & 4;
    for (int row = F.gw; row < MTOK; row += F.NGW) {
        f32x4 v[4]; load_row_bf16(S + (size_t)row * 1024, F.lane, v); ln_inplace(v, gv, bv); store_row_bf16(H2 + (size_t)row * 1024, F.lane, v);
        float pl[8];
#pragma unroll
        for (int x = 0; x < 8; ++x) pl[x] = 0.f;
#pragma unroll
        for (int j = 0; j < 4; ++j)
#pragma unroll
            for (int e = 0; e < 4; ++e) { const f32x4 r0 = rw[4 * j + e][0], r1 = rw[4 * j + e][1]; const float hv = v[j][e];
                pl[0] += hv * r0[0]; pl[1] += hv * r0[1]; pl[2] += hv * r0[2]; pl[3] += hv * r0[3]; pl[4] += hv * r1[0]; pl[5] += hv * r1[1]; pl[6] += hv * r1[2]; pl[7] += hv * r1[3]; }
        float k4[4], k2[2], k1;
#pragma unroll
        for (int i = 0; i < 4; ++i) { const float send = b0 ? pl[i] : pl[i + 4]; k4[i] = (b0 ? pl[i + 4] : pl[i]) + __shfl_xor(send, 1); }
#pragma unroll
        for (int i = 0; i < 2; ++i) { const float send = b1 ? k4[i] : k4[i + 2]; k2[i] = (b1 ? k4[i + 2] : k4[i]) + __shfl_xor(send, 2); }
        { const float send = b2 ? k2[0] : k2[1]; k1 = (b2 ? k2[1] : k2[0]) + __shfl_xor(send, 4); }
        k1 += __shfl_xor(k1, 8); k1 += __shfl_xor(k1, 16); k1 += __shfl_xor(k1, 32);
        float lg[8];
#pragma unroll
        for (int x = 0; x < 8; ++x) lg[x] = __int_as_float(__builtin_amdgcn_readlane(__float_as_int(k1), (x >> 2) | (((x >> 1) & 1) << 1) | ((x & 1) << 2)));
        int e0 = 0; float l0 = lg[0];
#pragma unroll
        for (int x = 1; x < 8; ++x) if (lg[x] > l0) { l0 = lg[x]; e0 = x; }
        int e1 = -1; float l1 = -INFINITY;
#pragma unroll
        for (int x = 0; x < 8; ++x) if (x != e0 && lg[x] > l1) { l1 = lg[x]; e1 = x; }
        const float g0 = 1.f / (1.f + __expf(l1 - l0));
        if (F.lane == 0) { u32x2 r; r.x = (unsigned)e0 | ((unsigned)e1 << 8); r.y = __builtin_bit_cast(unsigned, g0); ROUTE[row] = r;
            __hip_atomic_fetch_add(cnt + e0, 1, __ATOMIC_RELAXED, __HIP_MEMORY_SCOPE_WORKGROUP); __hip_atomic_fetch_add(cnt + e1, 1, __ATOMIC_RELAXED, __HIP_MEMORY_SCOPE_WORKGROUP); }
    }
    __syncthreads();
    if (F.tid < 8) ((int*)(ws + OFF_WGCNT))[F.bx * 8 + F.tid] = cnt[F.tid];
    __syncthreads();
}
__device__ __forceinline__ void phase_moe_gather(const Frame& F, const bf16_t* H2, unsigned char* XR, unsigned char* ws) {
    LAS int* L = (LAS int*)(F.lds);
    const int* WGCNT = (const int*)(ws + OFF_WGCNT);
    { const int e = F.wave; int t = 0, p = 0;
#pragma unroll
      for (int k = 0; k < 4; ++k) { const int wg = F.lane + 64 * k; const int c = (wg < F.G) ? WGCNT[wg * 8 + e] : 0; t += c; p += (wg < F.bx) ? c : 0; }
      t = (int)wave_sum((float)t); p = (int)wave_sum((float)p);
      if (F.lane == 0) { L[e] = t; L[8 + e] = p; L[24 + e] = 0; } }
    __syncthreads();
    if (F.tid == 0) { int acc = 0;
        for (int e = 0; e < 8; ++e) { const int pad = (L[e] + 255) / 256 * 256; L[32 + e] = acc; L[16 + e] = acc + L[8 + e]; acc += pad; L[40 + e] = acc; }
        if (F.bx == 0) { int* GI = (int*)(ws + OFF_GINFO); for (int e = 0; e < 8; ++e) { GI[e] = L[40 + e]; GI[8 + e] = L[e]; } } }
    __syncthreads();
    const u32x2* ROUTE = (const u32x2*)(ws + OFF_ROUTE); int* DEST = (int*)(ws + OFF_DEST);
    for (int row = F.gw; row < MTOK; row += F.NGW) {
        const u32x2 r = ROUTE[row]; const int e0 = r.x & 255, e1 = (r.x >> 8) & 255; int s0 = 0, s1 = 0;
        if (F.lane == 0) { s0 = L[16 + e0] + __hip_atomic_fetch_add(L + 24 + e0, 1, __ATOMIC_RELAXED, __HIP_MEMORY_SCOPE_WORKGROUP); s1 = L[16 + e1] + __hip_atomic_fetch_add(L + 24 + e1, 1, __ATOMIC_RELAXED, __HIP_MEMORY_SCOPE_WORKGROUP);
            DEST[2 * row] = s0; DEST[2 * row + 1] = s1; }
        s0 = __builtin_amdgcn_readfirstlane(s0); s1 = __builtin_amdgcn_readfirstlane(s1);
        const u32x4* src = (const u32x4*)(H2 + (size_t)row * 1024) + 2 * F.lane; const u32x4 a = src[0], b = src[1];
        u32x4 o; o.x = pg8::pk4_fp8(bflo(a.x), bfhi(a.x), bflo(a.y), bfhi(a.y)); o.y = pg8::pk4_fp8(bflo(a.z), bfhi(a.z), bflo(a.w), bfhi(a.w));
        o.z = pg8::pk4_fp8(bflo(b.x), bfhi(b.x), bflo(b.y), bfhi(b.y)); o.w = pg8::pk4_fp8(bflo(b.z), bfhi(b.z), bflo(b.w), bfhi(b.w));
        ((u32x4*)(XR + (size_t)s0 * 1024))[F.lane] = o; ((u32x4*)(XR + (size_t)s1 * 1024))[F.lane] = o;
    }
    for (int e = 0; e < 8; ++e) { const int r0 = L[32 + e] + L[e], npad = L[40 + e] - r0;
        for (int i = F.gw; i < npad; i += F.NGW) { u32x4* d = (u32x4*)(XR + (size_t)(r0 + i) * 1024); d[F.lane] = (u32x4){0u, 0u, 0u, 0u}; } }
    __syncthreads();
}
__device__ __forceinline__ void phase_final(const Frame& F, const bf16_t* H2, const bf16_t* YR, const float* g, const float* b, float* out, unsigned char* ws) {
    f32x4 gv[4], bv[4]; load_gb(g, b, F.lane, gv, bv);
    const u32x2* ROUTE = (const u32x2*)(ws + OFF_ROUTE); const int* DEST = (const int*)(ws + OFF_DEST);
    for (int row = F.gw; row < MTOK; row += F.NGW) {
        const u32x2 rte = ROUTE[row]; const float g0 = __uint_as_float(rte.y), g1 = 1.f - g0;   const int d0 = DEST[2 * row], d1 = DEST[2 * row + 1];
        f32x4 v[4], y0[4], y1[4]; load_row_bf16(H2 + (size_t)row * 1024, F.lane, v); load_row_bf16(YR + (size_t)d0 * 1024, F.lane, y0); load_row_bf16(YR + (size_t)d1 * 1024, F.lane, y1);
#pragma unroll
        for (int j = 0; j < 4; ++j) v[j] = v[j] * ALPHA + y0[j] * g0 + y1[j] * g1;
        ln_inplace(v, gv, bv);
#pragma unroll
        for (int j = 0; j < 4; ++j) *(f32x4*)(out + (size_t)row * 1024 + 4 * F.lane + 256 * j) = v[j];
    }
}

namespace att {
constexpr float NEG_BIG = -1e30f;
constexpr int KS64 = 144, VS64 = 192, KT64 = 64 * KS64, VT64 = 64 * VS64;
constexpr int KS128 = 272, VS128 = 320, KT128 = 64 * KS128, VT128 = 64 * VS128;
typedef LAS char* lptr; typedef const LAS char* lcptr;
typedef short v4i16_t __attribute__((ext_vector_type(4)));
__device__ __forceinline__ s16x4 vtr(lcptr p) { return __builtin_bit_cast(s16x4, __builtin_amdgcn_ds_read_tr16_b64_v4i16((LAS v4i16_t*)p)); }
__device__ __forceinline__ f32x16 splat16(float c) { f32x16 v;
#pragma unroll
    for (int r = 0; r < 16; ++r) v[r] = c; return v; }
__device__ __forceinline__ int crow(int r, int hi) { return (r & 3) + 8 * (r >> 2) + 4 * hi; }
__device__ __forceinline__ float ex2(float x) { return __builtin_amdgcn_exp2f(x); }

template <int NKS> __device__ __forceinline__ void qk(f32x16& s0, f32x16& s1, lcptr Kt, int kstride, const bf16x8 (&qf)[NKS], float c0, int r32, int hi) {
    s0 = splat16(c0); s1 = splat16(c0);
    lcptr p0 = Kt + r32 * kstride + hi * 16; lcptr p1 = p0 + 32 * kstride;
#pragma unroll
    for (int ks = 0; ks < NKS; ++ks) { const bf16x8 k0 = *(const LAS bf16x8*)(p0 + ks * 32), k1 = *(const LAS bf16x8*)(p1 + ks * 32);
        s0 = __builtin_amdgcn_mfma_f32_32x32x16_bf16(k0, qf[ks], s0, 0, 0, 0); s1 = __builtin_amdgcn_mfma_f32_32x32x16_bf16(k1, qf[ks], s1, 0, 0, 0); }
}
__device__ __forceinline__ float rowmax32(const f32x16& s0, const f32x16& s1) {
    float a = fmaxf(s0[0], s1[0]);
#pragma unroll
    for (int r = 1; r < 16; ++r) a = fmaxf(a, fmaxf(s0[r], s1[r]));
    return fmaxf(a, __shfl_xor(a, 32));
}
template <int NDT> __device__ __forceinline__ void softmax_step(f32x16& s0, f32x16& s1, float& m, float& l, f32x16 (&o)[NDT]) {
    const float mn = fmaxf(m, rowmax32(s0, s1)); float rs = 0.f;
    if (__any(mn > m)) {
        const float al = ex2(m - mn); l *= al;
#pragma unroll
        for (int d = 0; d < NDT; ++d)
#pragma unroll
            for (int r = 0; r < 16; ++r) o[d][r] *= al;
    }
    m = mn;
#pragma unroll
    for (int r = 0; r < 16; ++r) { s0[r] = ex2(s0[r] - mn); s1[r] = ex2(s1[r] - mn); rs += s0[r] + s1[r]; }
    l += rs;
}
__device__ __forceinline__ bf16x8 pack_p(const f32x16& s, int base) { u32x4 w; w.x = pk2(s[base], s[base + 1]); w.y = pk2(s[base + 2], s[base + 3]); w.z = pk2(s[base + 4], s[base + 5]); w.w = pk2(s[base + 6], s[base + 7]); return __builtin_bit_cast(bf16x8, w); }
template <int NDT> __device__ __forceinline__ void pv(f32x16 (&o)[NDT], const f32x16& s0, const f32x16& s1, lcptr Vt, int vstride, int lane) {
    const bf16x8 pk[4] = {pack_p(s0, 0), pack_p(s0, 8), pack_p(s1, 0), pack_p(s1, 8)};
    const int h = lane >> 5, g = (lane >> 4) & 1, q = (lane & 15) >> 2, p = lane & 3;
    lcptr vb = Vt + (4 * h + q) * vstride + (16 * g + 4 * p) * 2;
#pragma unroll
    for (int k = 0; k < 4; ++k)
#pragma unroll
        for (int d = 0; d < NDT; ++d) { const s16x4 lo = vtr(vb + (16 * k) * vstride + d * 64), hh = vtr(vb + (16 * k + 8) * vstride + d * 64);
            const bf16x8 vf = (bf16x8){lo[0], lo[1], lo[2], lo[3], hh[0], hh[1], hh[2], hh[3]};
            o[d] = __builtin_amdgcn_mfma_f32_32x32x16_bf16(vf, pk[k], o[d], 0, 0, 0); }
}

__device__ __forceinline__ void exp_step(f32x16& s0, f32x16& s1, float& l) {
    float rs = 0.f;
#pragma unroll
    for (int r = 0; r < 16; ++r) { s0[r] = ex2(s0[r]); s1[r] = ex2(s1[r]); rs += s0[r] + s1[r]; }
    l += rs;
}
__device__ __forceinline__ void bias_mask_near(f32x16& s0, f32x16& s1, const LAS float* bt, int t, int kp0, int hi, unsigned maxdist) {
#pragma unroll
    for (int q4 = 0; q4 < 4; ++q4) {
        float bb[8]; f32x16& s = (q4 & 2) ? s1 : s0; const int r0 = 8 * (q4 & 1), kq = kp0 + 32 * (q4 >> 1);
#pragma unroll
        for (int r = 0; r < 8; ++r) { const int d = t - (kq + crow(r0 + r, hi)); const unsigned ix = (unsigned)d < 127u ? (unsigned)d : 127u; bb[r] = bt[ix]; }
#pragma unroll
        for (int r = 0; r < 8; ++r) asm volatile("" : "+v"(bb[r]));
#pragma unroll
        for (int r = 0; r < 8; ++r) { const int d = t - (kq + crow(r0 + r, hi)); s[r0 + r] = ((unsigned)d < maxdist) ? s[r0 + r] + bb[r] : -INFINITY; }
    }
}
__device__ __forceinline__ void mask_all(f32x16& s0, f32x16& s1) {
#pragma unroll
    for (int r = 0; r < 16; ++r) { s0[r] = -INFINITY; s1[r] = -INFINITY; }
}
__device__ __forceinline__ void store_o64(bf16_t* orow, const f32x16 (&o)[2], float sc, int hi) {
#pragma unroll
    for (int d = 0; d < 2; ++d)
#pragma unroll
        for (int rg = 0; rg < 4; ++rg) { u32x2 w; w.x = pk2(o[d][4 * rg] * sc, o[d][4 * rg + 1] * sc); w.y = pk2(o[d][4 * rg + 2] * sc, o[d][4 * rg + 3] * sc);
            *(u32x2*)(orow + 32 * d + 8 * rg + 4 * hi) = w; }
}
__device__ __forceinline__ void store_o64_fp8(unsigned char* orow, const f32x16 (&o)[2], float sc, int hi) {
#pragma unroll
    for (int d = 0; d < 2; ++d)
#pragma unroll
        for (int rg = 0; rg < 4; ++rg) *(unsigned*)(orow + 32 * d + 8 * rg + 4 * hi) = pg8::pk4_fp8(o[d][4 * rg] * sc, o[d][4 * rg + 1] * sc, o[d][4 * rg + 2] * sc, o[d][4 * rg + 3] * sc);
}
template <class Src, class Proc> __device__ __forceinline__ void tile_loop64(int tid, lptr base, int nt, int pitch, Src src, Proc proc) {
    if (nt <= 0) return;
    const int row = tid >> 3, ch = tid & 7; u32x4 kr, vr;
    lptr Kb = base, Vb = base + 2 * KT64;
    { const bf16_t *kp, *vp; src(0, kp, vp); kr = *(const u32x4*)(kp + (size_t)row * pitch + ch * 8); vr = *(const u32x4*)(vp + (size_t)row * pitch + ch * 8); }
    *(LAS u32x4*)(Kb + row * KS64 + ch * 16) = kr; *(LAS u32x4*)(Vb + row * VS64 + ch * 16) = vr;
    __syncthreads();
    for (int i = 0; i < nt; ++i) {
        const bool more = i + 1 < nt;
        if (more) { const bf16_t *kp, *vp; src(i + 1, kp, vp); kr = *(const u32x4*)(kp + (size_t)row * pitch + ch * 8); vr = *(const u32x4*)(vp + (size_t)row * pitch + ch * 8); }
        proc(i, (lcptr)(Kb + (i & 1) * KT64), (lcptr)(Vb + (i & 1) * VT64));
        if (more) { *(LAS u32x4*)(Kb + ((i + 1) & 1) * KT64 + row * KS64 + ch * 16) = kr; *(LAS u32x4*)(Vb + ((i + 1) & 1) * VT64 + row * VS64 + ch * 16) = vr; }
        __syncthreads();
    }
}

template <int ROWB, int KSTR, int VSTR, int VAR = 0, class SrcK, class SrcV, class Score, class Accum>
__device__ __forceinline__ void tile_loop_p(int tid, lptr base, int nt, int pitch, SrcK srck, SrcV srcv, Score score, Accum accum) {
    if (nt <= 0) return;
    constexpr int CPR = ROWB / 16, NCH = (64 * CPR) / 512, KT = 64 * KSTR, VT = 64 * VSTR;
    lptr Kb = base, Vb = base + 2 * KT;
    u32x4 kr0[NCH], vr0[NCH], kr1[NCH], vr1[NCH];
    auto gld = [&](const bf16_t* p, u32x4 (&r)[NCH]) {
#pragma unroll
        for (int c = 0; c < NCH; ++c) { const int idx = tid + 512 * c, rr = idx / CPR, ch = idx % CPR; r[c] = *(const u32x4*)(p + (size_t)rr * pitch + ch * 8); } };
    auto lst = [&](lptr dst, int stride, const u32x4 (&r)[NCH]) {
#pragma unroll
        for (int c = 0; c < NCH; ++c) { const int idx = tid + 512 * c, rr = idx / CPR, ch = idx % CPR; *(LAS u32x4*)(dst + rr * stride + ch * 16) = r[c]; } };
    gld(srck(0), kr0); gld(srcv(0), vr0); lst(Kb, KSTR, kr0); lst(Vb, VSTR, vr0);
    if (nt > 1) { gld(srck(1), kr0); lst(Kb + KT, KSTR, kr0); }
    if (nt > 2) gld(srck(2), kr1);
    if (nt > 1) gld(srcv(1), vr1);
    __syncthreads();
    f32x16 a0, a1, b0, b1; bool aact = score(0, (lcptr)Kb, a0, a1), bact = false;
    auto step = [&](int i, f32x16& c0, f32x16& c1, bool& cact, f32x16& n0, f32x16& n1, bool& nact, u32x4 (&kL)[NCH], u32x4 (&vL)[NCH], u32x4 (&kS)[NCH], u32x4 (&vS)[NCH]) {
        const bool m1 = i + 1 < nt, m2 = i + 2 < nt, m3 = i + 3 < nt;
        if (VAR != 7) { if (m3) gld(srck(i + 3), kL);
        if (m2) gld(srcv(i + 2), vL); }
        nact = false;
        if (m1) nact = score(i + 1, (lcptr)(Kb + ((i + 1) & 1) * KT), n0, n1);
        if (cact) accum(i, (lcptr)(Vb + (i & 1) * VT), c0, c1);
        if (VAR != 7) { if (m2) lst(Kb + (i & 1) * KT, KSTR, kS);
        if (m1) lst(Vb + ((i + 1) & 1) * VT, VSTR, vS); }
        __syncthreads();
    };
    for (int i = 0; i < nt; i += 2) { step(i, a0, a1, aact, b0, b1, bact, kr0, vr0, kr1, vr1); if (i + 1 < nt) step(i + 1, b0, b1, bact, a0, a1, aact, kr1, vr1, kr0, vr0); }
}

template <int ROWB, int KSTR, int VSTR, class SrcK, class SrcV, class Score, class Accum>
__device__ __forceinline__ void tile_loop_pp(int tid, int grp, lptr base, int nt, int pitch, SrcK srck, SrcV srcv, Score score, Accum accum) {
    if (nt <= 0) return;
    constexpr int CPR = ROWB / 16, NCH = (64 * CPR) / 512, KT = 64 * KSTR, VT = 64 * VSTR;
    lptr Kb = base, Vb = base + 2 * KT;
    u32x4 kr0[NCH], vr0[NCH], kr1[NCH], vr1[NCH];
    auto gld = [&](const bf16_t* p, u32x4 (&r)[NCH]) {
#pragma unroll
        for (int c = 0; c < NCH; ++c) { const int idx = tid + 512 * c, rr = idx / CPR, ch = idx % CPR; r[c] = *(const u32x4*)(p + (size_t)rr * pitch + ch * 8); } };
    auto lst = [&](lptr dst, int stride, const u32x4 (&r)[NCH]) {
#pragma unroll
        for (int c = 0; c < NCH; ++c) { const int idx = tid + 512 * c, rr = idx / CPR, ch = idx % CPR; *(LAS u32x4*)(dst + rr * stride + ch * 16) = r[c]; } };
    gld(srck(0), kr0); gld(srcv(0), vr0); lst(Kb, KSTR, kr0); lst(Vb, VSTR, vr0);
    if (nt > 1) { gld(srck(1), kr0); gld(srcv(1), vr0); }
    if (nt > 2) { gld(srck(2), kr1); gld(srcv(2), vr1); }
    __syncthreads();
    f32x16 s0, s1; bool act = false;
    const int nslot = 2 * nt + 1;
    auto slot_fn = [&](int slot, u32x4 (&kS)[NCH], u32x4 (&vS)[NCH]) {
        const int my = slot - grp;
        if (my >= 0 && my < 2 * nt) { const int i = my >> 1;
            if (!(my & 1)) act = score(i, (lcptr)(Kb + (i & 1) * KT), s0, s1);
            else if (act) accum(i, (lcptr)(Vb + (i & 1) * VT), s0, s1); }
        if (slot & 1) { const int j = (slot >> 1) + 1;
            if (j < nt) { lst(Kb + (j & 1) * KT, KSTR, kS); lst(Vb + (j & 1) * VT, VSTR, vS); }
            if (j + 2 < nt) { gld(srck(j + 2), kS); gld(srcv(j + 2), vS); } }
        __syncthreads();
    };
    for (int slot = 0; slot < nslot; slot += 4) {
        slot_fn(slot, kr0, vr0);
        if (slot + 1 < nslot) slot_fn(slot + 1, kr0, vr0);
        if (slot + 2 < nslot) slot_fn(slot + 2, kr1, vr1);
        if (slot + 3 < nslot) slot_fn(slot + 3, kr1, vr1);
    }
}

template <int VAR = 0, class SrcK, class SrcV, class Post>
__device__ __forceinline__ void tile_loop_f(int tid, int lane, lptr base, int nt, int pitch, const bf16x8 (&qf)[4], f32x16 (&o)[2], float& l, SrcK srck, SrcV srcv, Post post) {
    if (nt <= 0) return;
    const int r32 = lane & 31, hi = lane >> 5;
    lptr Kb = base, Vb = base + 2 * KT64;
    const int rr = tid >> 3, ch = tid & 7;
    u32x4 kr0, vr0, kr1, vr1;
    auto gld = [&](const bf16_t* p) { return *(const u32x4*)(p + (size_t)rr * pitch + ch * 8); };
    kr0 = gld(srck(0)); vr0 = gld(srcv(0)); *(LAS u32x4*)(Kb + rr * KS64 + ch * 16) = kr0; *(LAS u32x4*)(Vb + rr * VS64 + ch * 16) = vr0;
    if (nt > 1) { kr0 = gld(srck(1)); *(LAS u32x4*)(Kb + KT64 + rr * KS64 + ch * 16) = kr0; }
    if (nt > 2) kr1 = gld(srck(2));
    if (nt > 1) vr1 = gld(srcv(1));
    __syncthreads();
    f32x16 a0, a1, b0, b1; bool aact, bact = false;
    qk<4>(a0, a1, (lcptr)Kb, KS64, qf, 0.f, r32, hi); aact = post(0, a0, a1);
    auto step = [&](int i, f32x16& c0, f32x16& c1, bool& cact, f32x16& n0, f32x16& n1, bool& nact, u32x4& kL, u32x4& vL, u32x4& kS, u32x4& vS) {
        const bool m1 = i + 1 < nt, m2 = i + 2 < nt, m3 = i + 3 < nt;
        if (m3) kL = gld(srck(i + 3));
        if (m2) vL = gld(srcv(i + 2));
        lcptr Kt = (lcptr)(Kb + ((i + 1) & 1) * KT64), Vt = (lcptr)(Vb + (i & 1) * VT64);
        if (m1 && cact) {
            lcptr p0 = Kt + r32 * KS64 + hi * 16; lcptr p1 = p0 + 32 * KS64;
            bf16x8 ka[4], kb[4];
#pragma unroll
            for (int ks = 0; ks < 4; ++ks) { if (VAR == 8 || VAR == 9) { ka[ks] = qf[ks]; kb[ks] = qf[3 - ks]; } else { ka[ks] = *(const LAS bf16x8*)(p0 + ks * 32); kb[ks] = *(const LAS bf16x8*)(p1 + ks * 32); } }
            n0 = splat16(0.f); n1 = splat16(0.f); float rs = 0.f;
            __builtin_amdgcn_sched_barrier(0);
#pragma unroll
            for (int ks = 0; ks < 4; ++ks) {
                n0 = __builtin_amdgcn_mfma_f32_32x32x16_bf16(ka[ks], qf[ks], n0, 0, 0, 0); n1 = __builtin_amdgcn_mfma_f32_32x32x16_bf16(kb[ks], qf[ks], n1, 0, 0, 0);
#pragma unroll
                for (int e = 0; e < 4; ++e) { c0[4 * ks + e] = ex2(c0[4 * ks + e]); c1[4 * ks + e] = ex2(c1[4 * ks + e]); rs += c0[4 * ks + e] + c1[4 * ks + e]; }
                __builtin_amdgcn_sched_barrier(0);
            }
            l += rs;
            if (VAR == 8 || VAR == 10) { const bf16x8 pk0 = pack_p(c0, 0), pk1 = pack_p(c0, 8), pk2_ = pack_p(c1, 0), pk3 = pack_p(c1, 8);
#pragma unroll
                for (int d = 0; d < 2; ++d) { o[d] = __builtin_amdgcn_mfma_f32_32x32x16_bf16(qf[0], pk0, o[d], 0, 0, 0); o[d] = __builtin_amdgcn_mfma_f32_32x32x16_bf16(qf[1], pk1, o[d], 0, 0, 0);
                    o[d] = __builtin_amdgcn_mfma_f32_32x32x16_bf16(qf[2], pk2_, o[d], 0, 0, 0); o[d] = __builtin_amdgcn_mfma_f32_32x32x16_bf16(qf[3], pk3, o[d], 0, 0, 0); } }
            else pv<2>(o, c0, c1, Vt, VS64, lane);
            nact = post(i + 1, n0, n1);
        } else {
            if (cact) { exp_step(c0, c1, l); pv<2>(o, c0, c1, Vt, VS64, lane); }
            nact = false;
            if (m1) { qk<4>(n0, n1, Kt, KS64, qf, 0.f, r32, hi); nact = post(i + 1, n0, n1); }
        }
        if (m2) *(LAS u32x4*)(Kb + (i & 1) * KT64 + rr * KS64 + ch * 16) = kS;
        if (m1) *(LAS u32x4*)(Vb + ((i + 1) & 1) * VT64 + rr * VS64 + ch * 16) = vS;
        __syncthreads();
    };
    for (int i = 0; i < nt; i += 2) { step(i, a0, a1, aact, b0, b1, bact, kr0, vr0, kr1, vr1); if (i + 1 < nt) step(i + 1, b0, b1, bact, a0, a1, aact, kr1, vr1, kr0, vr0); }
}
constexpr int TL64_BYTES = 2 * KT64 + 2 * VT64;
}

#ifndef PP_GRP
#define PP_GRP (w & 1)
#endif
template <int var> __device__ __forceinline__ void moba_unit(const Frame& F, int b, int h, int qb, const bf16_t* Q, const bf16_t* K, const bf16_t* V, const float* KMEAN, const float* BT, unsigned char* O8) {
    using namespace att;
    const int lane = F.lane, r32 = lane & 31, hi = lane >> 5, w = F.wave;
    lptr lds = (lptr)F.lds; lptr tl = lds; LAS float* BTL = (LAS float*)(lds + TL64_BYTES); lptr KM = lds + TL64_BYTES + 512;
    const int t = 256 * qb + 32 * w + r32; const size_t row = (size_t)b * SEQ + t;
    bf16x8 qf[4];
#pragma unroll
    for (int ks = 0; ks < 4; ++ks) qf[ks] = *(const bf16x8*)(Q + row * 1024 + h * 64 + 16 * ks + 8 * hi);
    if (F.tid < 128) BTL[F.tid] = BT[h * 128 + F.tid] - BT[h * 128 + 127];
    { const int idx = F.tid * 2, j = idx >> 6, d = idx & 63; const float* kmp = KMEAN + (size_t)(b * 16 + j) * 2048 + h * 64 + d;
      *(LAS unsigned*)(KM + j * KS64 + d * 2) = (j < qb) ? pk2(kmp[0] + kmp[1024], kmp[1] + kmp[1025]) : 0u;
      *(LAS unsigned*)(KM + (16 + j) * KS64 + d * 2) = 0u; }
    __syncthreads();
    unsigned selmask = 0u;
    if (qb > 0) {
        f32x16 gs = splat16(0.f);
        { lcptr p0 = (lcptr)KM + r32 * KS64 + hi * 16;
#pragma unroll
          for (int ks = 0; ks < 4; ++ks) { const bf16x8 k0 = *(const LAS bf16x8*)(p0 + ks * 32); gs = __builtin_amdgcn_mfma_f32_32x32x16_bf16(k0, qf[ks], gs, 0, 0, 0); } }
        float glo[8], ghi[8];
#pragma unroll
        for (int r = 0; r < 8; ++r) { const float mine = gs[r], oth = __shfl_xor(mine, 32); glo[r] = hi ? oth : mine; ghi[r] = hi ? mine : oth; }
#pragma unroll
        for (int rep = 0; rep < 3; ++rep) { float best = -INFINITY; int bj = -1;
#pragma unroll
            for (int j = 0; j < 16; ++j) { const int r = (j & 3) + 4 * (j >> 3); const float gv = ((j >> 2) & 1) ? ghi[r] : glo[r];
                if (j < qb && !((selmask >> j) & 1u) && gv > best) { best = gv; bj = j; } }
            if (bj >= 0) selmask |= 1u << bj; }
    }
    f32x16 o[2] = {splat16(0.f), splat16(0.f)}; float l = 0.f;
    const int nt = 4 * (qb + 1); const int twmax = 256 * qb + 32 * w + 31;
    const bf16_t* Kh = K + (size_t)b * SEQ * 1024 + h * 64; const bf16_t* Vh = V + (size_t)b * SEQ * 1024 + h * 64;
    tile_loop_f<var>(F.tid, lane, tl, nt, 1024, qf, o, l,
        [&](int i) { return Kh + (size_t)(64 * i) * 1024; }, [&](int i) { return Vh + (size_t)(64 * i) * 1024; },
        [&](int i, f32x16& s0, f32x16& s1) -> bool {
            const int blk = i >> 2, kp0 = 64 * i;
            if (blk < qb) {
                const bool sel = (selmask >> blk) & 1u;
                if (!__any(sel)) return false;
                if (!(blk < qb - 1 || (i & 3) < 2)) bias_mask_near(s0, s1, BTL, t, kp0, hi, 0x7fffffffu);
                if (!sel) mask_all(s0, s1);
            } else {
                if (kp0 > twmax) return false;
                bias_mask_near(s0, s1, BTL, t, kp0, hi, 0x7fffffffu);
            }
            return true; });
    l += __shfl_xor(l, 32);
    store_o64_fp8(O8 + row * 1024 + h * 64, o, l > 0.f ? OSC / l : 0.f, hi);
}
__device__ __forceinline__ void phase_moba(const Frame& F, unsigned char* ws, int var) {
    const bf16_t* Q = (const bf16_t*)(ws + OFF_QKV); const bf16_t* K = Q + (size_t)MTOK * 1024; const bf16_t* V = K + (size_t)MTOK * 1024;
    const float* KMEAN = (const float*)(ws + OFF_KMEAN); const float* BT = (const float*)(ws + OFF_BT);
    for (int idx = F.bx; idx < 2048; idx += F.G) { const int i = idx >> 8, v = idx & 255, x = v & 7, j = v >> 3, bh = 16 * x + 2 * i + (j >> 4), b = bh >> 4, h = bh & 15, p = ((j & 15) + 4 * (i >> 1)) & 15, qb = (i & 1) ? 15 - p : p;

#ifdef MOBA_VAR
        if (var == MOBA_VAR) moba_unit<MOBA_VAR>(F, b, h, qb, Q, K, V, KMEAN, BT, ws + OFF_O8); else
#endif
        moba_unit<0>(F, b, h, qb, Q, K, V, KMEAN, BT, ws + OFF_O8);
        __syncthreads(); }
}

__device__ __forceinline__ void nsa_unit(const Frame& F, int b, int g, int c, const bf16_t* Y1, const bf16_t* KC, const bf16_t* VC, const float* BT, unsigned char* MIXIN) {
    using namespace att;
    const int lane = F.lane, r32 = lane & 31, hi = lane >> 5, w = F.wave;
    lptr lds = (lptr)F.lds; lptr tl = lds; LAS float* BTL = (LAS float*)(lds + TL64_BYTES);
    LAS float* SCB = (LAS float*)(lds + TL64_BYTES + 2048);
    LAS unsigned long long* SELM = (LAS unsigned long long*)(lds + TL64_BYTES + 2048 + 16384);
    lptr OFL = lds + TL64_BYTES + 2048 + 16384 + 1024 + w * 8704 + r32 * 272 + hi * 16;
    const int n = r32 & 3, tok = 8 * w + (r32 >> 2), t = 64 * c + tok; const size_t row = (size_t)b * SEQ + t;
    const bf16_t* T1 = Y1 + (size_t)1 * MTOK * 256; const bf16_t* QB = Y1 + (size_t)(2 + g) * MTOK * 256;
    const bf16_t* KVS = Y1 + (size_t)5 * MTOK * 256; const bf16_t* KVW = Y1 + (size_t)6 * MTOK * 256;
    bf16x8 qf[4];
#pragma unroll
    for (int ks = 0; ks < 4; ++ks) qf[ks] = *(const bf16x8*)(QB + row * 256 + n * 64 + 16 * ks + 8 * hi);
    float gate[3];
#pragma unroll
    for (int j = 0; j < 3; ++j) { const float x = bf2f(T1[row * 256 + 208 + (4 * g + n) * 3 + j]); gate[j] = 1.f / (1.f + __expf(-x)); }
    for (int i = F.tid; i < 512; i += NTHR) BTL[i] = BT[(8 + 4 * g) * 128 + i] - BT[(8 + 4 * g) * 128 + (i | 127)];
    for (int i = F.tid; i < 4096; i += NTHR) SCB[i] = 0.f;
    __syncthreads();
    const LAS float* bt = BTL + n * 128; const float cfar = 0.f;
    const int vis = (t >= 31) ? ((t - 31) >> 4) : -1;
    const int ntc = ((4 * c + 2) >> 6) + 1;
    const bf16_t* KCg = KC + ((size_t)b * 256 * 2 + g) * 64; const bf16_t* VCg = VC + ((size_t)b * 256 * 2 + g) * 64;
    auto cmp_scores = [&](int i, lcptr Kt, f32x16& s0, f32x16& s1) {
        qk<4>(s0, s1, Kt, KS64, qf, 0.f, r32, hi);
#pragma unroll
        for (int half = 0; half < 2; ++half) { float bb[16]; f32x16& s = half ? s1 : s0;
#pragma unroll
            for (int r = 0; r < 16; ++r) { const int cc = 64 * i + 32 * half + crow(r, hi); const int d = t - 16 * cc - 31; const unsigned ix = (unsigned)d < 127u ? (unsigned)d : 127u; bb[r] = bt[ix]; }
#pragma unroll
            for (int r = 0; r < 16; ++r) asm volatile("" : "+v"(bb[r]));
#pragma unroll
            for (int r = 0; r < 16; ++r) { const int cc = 64 * i + 32 * half + crow(r, hi); s[r] = (cc <= vis) ? s[r] + bb[r] : -INFINITY; } }
    };
    float mc = NEG_BIG, lc = 0.f;
    tile_loop64(F.tid, tl, ntc, 128,
        [&](int i, const bf16_t*& kp, const bf16_t*& vp) { kp = KCg + (size_t)(64 * i) * 128; vp = VCg + (size_t)(64 * i) * 128; },
        [&](int i, lcptr Kt, lcptr Vt) { f32x16 s0, s1; cmp_scores(i, Kt, s0, s1);
            const float mn = fmaxf(mc, rowmax32(s0, s1)); float rs = 0.f;
#pragma unroll
            for (int r = 0; r < 16; ++r) rs += ex2(s0[r] - mn) + ex2(s1[r] - mn);
            lc = lc * ex2(mc - mn) + rs; mc = mn; });
    lc += __shfl_xor(lc, 32);
    const float invc = lc > 0.f ? 1.f / lc : 0.f;
    {
        f32x16 o[2] = {splat16(0.f), splat16(0.f)}; float carry = 0.f;
        tile_loop64(F.tid, tl, ntc, 128,
            [&](int i, const bf16_t*& kp, const bf16_t*& vp) { kp = KCg + (size_t)(64 * i) * 128; vp = VCg + (size_t)(64 * i) * 128; },
            [&](int i, lcptr Kt, lcptr Vt) { f32x16 s0, s1; cmp_scores(i, Kt, s0, s1);
#pragma unroll
                for (int r = 0; r < 16; ++r) { s0[r] = ex2(s0[r] - mc) * invc; s1[r] = ex2(s1[r] - mc) * invc; }
                float x0[4], x1[4];
#pragma unroll
                for (int rg = 0; rg < 4; ++rg) { x0[rg] = __shfl_xor(s0[4 * rg + 3], 32); x1[rg] = __shfl_xor(s1[4 * rg + 3], 32); }
#pragma unroll
                for (int rg = 0; rg < 4; ++rg) {
                    float g0 = (s0[4 * rg] + s0[4 * rg + 1]) + (s0[4 * rg + 2] + s0[4 * rg + 3]), g1 = (s1[4 * rg] + s1[4 * rg + 1]) + (s1[4 * rg + 2] + s1[4 * rg + 3]);
                    const float e0 = hi ? x0[rg] : (rg > 0 ? x0[rg > 0 ? rg - 1 : 0] : carry), e1 = hi ? x1[rg] : (rg > 0 ? x1[rg > 0 ? rg - 1 : 0] : x0[3]);
                    g0 += e0; g1 += e1;
                    g0 += __shfl_xor(g0, 1); g0 += __shfl_xor(g0, 2); g1 += __shfl_xor(g1, 1); g1 += __shfl_xor(g1, 2);
                    if (n == 0) { SCB[tok * 64 + 16 * i + 2 * rg + hi] = g0; SCB[tok * 64 + 16 * i + 8 + 2 * rg + hi] = g1; }
                }
                carry = x1[3];
                pv<2>(o, s0, s1, Vt, VS64, lane); });
#pragma unroll
        for (int d = 0; d < 2; ++d)
#pragma unroll
            for (int rg = 0; rg < 4; ++rg) *(LAS f32x4*)(OFL + d * 128 + rg * 32) = (f32x4){o[d][4 * rg], o[d][4 * rg + 1], o[d][4 * rg + 2], o[d][4 * rg + 3]} * gate[0];
    }
    {
        unsigned long long uni = 0ull;
#pragma unroll 1
        for (int tk = 0; tk < 8; ++tk) { const int tk2 = 8 * w + tk; float v = SCB[tk2 * 64 + lane];
            v = (lane > c) ? -INFINITY : ((lane == 0 || lane == c || lane == c - 1) ? INFINITY : v);
            int cnt = 0;
#pragma unroll
            for (int j = 0; j < 64; ++j) { const float vj = __builtin_bit_cast(float, __builtin_amdgcn_readlane(__builtin_bit_cast(int, v), j)); cnt += (vj > v || (vj == v && j < lane)) ? 1 : 0; }
            const unsigned long long mk = __ballot(cnt < 16 && lane <= c);
            if (lane == 0) SELM[tk2] = mk;
            uni |= mk; }
        if (lane == 0) SELM[64 + w] = uni;
    }
    __syncthreads();
    const unsigned long long mymask = SELM[tok];
    unsigned long long uni = 0ull;
#pragma unroll
    for (int k = 0; k < 8; ++k) uni |= SELM[64 + k];
    {
        f32x16 o[2] = {splat16(0.f), splat16(0.f)}; float l = 0.f;
        const int nsel = __popcll(uni);
        const bf16_t* Kg = KVS + (size_t)b * SEQ * 256 + g * 64; const bf16_t* Vg = Kg + 128;
        LAS unsigned char* LIST = (LAS unsigned char*)(SELM + 72);
        if (F.tid < 64 && ((uni >> F.tid) & 1ull)) LIST[__popcll(uni & ((1ull << F.tid) - 1ull))] = (unsigned char)F.tid;
        __syncthreads();
        tile_loop64(F.tid, tl, nsel, 256,
            [&](int i, const bf16_t*& kp, const bf16_t*& vp) { const int j = LIST[i]; kp = Kg + (size_t)(64 * j) * 256; vp = Vg + (size_t)(64 * j) * 256; },
            [&](int i, lcptr Kt, lcptr Vt) { const int j = LIST[i];
                const bool sel = (mymask >> j) & 1ull;
                if (!__any(sel)) return;
                f32x16 s0, s1; qk<4>(s0, s1, Kt, KS64, qf, 0.f, r32, hi);
                if (j >= c - 2) bias_mask_near(s0, s1, bt, t, 64 * j, hi, 0x7fffffffu);
                if (!sel) mask_all(s0, s1);
                exp_step(s0, s1, l); pv<2>(o, s0, s1, Vt, VS64, lane); });
        l += __shfl_xor(l, 32); const float f = gate[1] * (l > 0.f ? 1.f / l : 0.f);
#pragma unroll
        for (int d = 0; d < 2; ++d)
#pragma unroll
            for (int rg = 0; rg < 4; ++rg) *(LAS f32x4*)(OFL + d * 128 + rg * 32) += (f32x4){o[d][4 * rg], o[d][4 * rg + 1], o[d][4 * rg + 2], o[d][4 * rg + 3]} * f;
    }
    {
        f32x16 o[2] = {splat16(0.f), splat16(0.f)}; float l = 0.f;
        const int k0 = c >= 8 ? c - 8 : 0, ntw = c - k0 + 1;
        const bf16_t* Kg = KVW + (size_t)b * SEQ * 256 + g * 64; const bf16_t* Vg = Kg + 128;
        tile_loop64(F.tid, tl, ntw, 256,
            [&](int i, const bf16_t*& kp, const bf16_t*& vp) { kp = Kg + (size_t)(64 * (k0 + i)) * 256; vp = Vg + (size_t)(64 * (k0 + i)) * 256; },
            [&](int i, lcptr Kt, lcptr Vt) { const int kt = k0 + i; f32x16 s0, s1; qk<4>(s0, s1, Kt, KS64, qf, 0.f, r32, hi);
                if (!(kt < c - 2 && kt > c - 8)) bias_mask_near(s0, s1, bt, t, 64 * kt, hi, 512u);
                exp_step(s0, s1, l); pv<2>(o, s0, s1, Vt, VS64, lane); });
        l += __shfl_xor(l, 32); const float f = gate[2] * (l > 0.f ? 1.f / l : 0.f);
        unsigned char* orow = MIXIN + row * 1536 + 1024 + (4 * g + n) * 64;
#pragma unroll
        for (int d = 0; d < 2; ++d)
#pragma unroll
            for (int rg = 0; rg < 4; ++rg) { const f32x4 v = (*(LAS f32x4*)(OFL + d * 128 + rg * 32) + (f32x4){o[d][4 * rg], o[d][4 * rg + 1], o[d][4 * rg + 2], o[d][4 * rg + 3]} * f) * OSC;
                *(unsigned*)(orow + 32 * d + 8 * rg + 4 * hi) = pg8::pk4_fp8(v[0], v[1], v[2], v[3]); }
    }
}

__device__ __forceinline__ void dsa_unit(const Frame& F, int b, int u, const bf16_t* QLAT, const bf16_t* CKVN, const unsigned* MASK, const float* BT, unsigned char* MIXIN) {
    using namespace att;
    const int lane = F.lane, r32 = lane & 31, hi = lane >> 5, w = F.wave, tid = F.tid;
    lptr lds = (lptr)F.lds; lptr Kb = lds, Vb = lds + 2 * KT128; LAS float* BTL = (LAS float*)(lds + 2 * KT128 + 2 * VT128);
    const int head = r32 & 7, q0 = 32 * u, t = q0 + 4 * w + (r32 >> 3); const size_t row = (size_t)b * SEQ + t;
    bf16x8 qf[8];
#pragma unroll
    for (int ks = 0; ks < 8; ++ks) qf[ks] = *(const bf16x8*)(QLAT + row * 1024 + head * 128 + 16 * ks + 8 * hi);
    for (int i = tid; i < 1024; i += NTHR) BTL[i] = BT[i] - BT[i | 127];
    const LAS float* bt = BTL + head * 128;
    f32x16 o[4] = {splat16(0.f), splat16(0.f), splat16(0.f), splat16(0.f)}; float l = 0.f;
    const int nt = ((q0 + 31) >> 6) + 1;
    const bf16_t* Cb = CKVN + (size_t)b * SEQ * 128; const unsigned* mrow = MASK + row * 128;
    u32x4 st[2];
    auto gload = [&](int i) {
#pragma unroll
        for (int k = 0; k < 2; ++k) { const int idx = tid + 512 * k, rr = idx >> 4, ch = idx & 15; st[k] = *(const u32x4*)(Cb + (size_t)(64 * i + rr) * 128 + ch * 8); } };
    auto lstore = [&](int i) { lptr kd = Kb + (i & 1) * KT128, vd = Vb + (i & 1) * VT128;
#pragma unroll
        for (int k = 0; k < 2; ++k) { const int idx = tid + 512 * k, rr = idx >> 4, ch = idx & 15; *(LAS u32x4*)(kd + rr * KS128 + ch * 16) = st[k]; *(LAS u32x4*)(vd + rr * VS128 + ch * 16) = st[k]; } };
    auto score = [&](int i, f32x16& s0, f32x16& s1) {
        lcptr Kt = (lcptr)(Kb + (i & 1) * KT128);
        const u32x2 mw = *(const u32x2*)(mrow + 2 * i);
        qk<8>(s0, s1, Kt, KS128, qf, 0.f, r32, hi);
        const unsigned w0 = mw.x >> (4 * hi), w1 = mw.y >> (4 * hi);
        if ((q0 - (64 * i + 63)) < 128) {
#pragma unroll
            for (int r = 0; r < 16; ++r) { const int d0 = t - (64 * i + crow(r, hi)), d1 = d0 - 32;
                const unsigned i0 = (unsigned)d0 < 127u ? (unsigned)d0 : 127u, i1 = (unsigned)d1 < 127u ? (unsigned)d1 : 127u;
                s0[r] += bt[i0]; s1[r] += bt[i1]; }
        }
#pragma unroll
        for (int r = 0; r < 16; ++r) { const int bit = (r & 3) + 8 * (r >> 2);
            const int m0 = __builtin_amdgcn_sbfe((int)w0, bit, 1), m1 = __builtin_amdgcn_sbfe((int)w1, bit, 1);
            const float a0 = s0[r], a1 = s1[r];
            s0[r] = __int_as_float((__float_as_int(a0) & m0) | ((int)0xff800000 & ~m0));
            s1[r] = __int_as_float((__float_as_int(a1) & m1) | ((int)0xff800000 & ~m1)); }
    };
    u32x4 st2[2];
    gload(0); lstore(0);
    if (nt > 1) gload(1);
    __syncthreads();
    auto step = [&](int i, u32x4 (&sL)[2], u32x4 (&sS)[2]) {
        if (i + 2 < nt) {
#pragma unroll
            for (int k = 0; k < 2; ++k) { const int idx = tid + 512 * k, rr = idx >> 4, ch = idx & 15; sL[k] = *(const u32x4*)(Cb + (size_t)(64 * (i + 2) + rr) * 128 + ch * 8); } }
        f32x16 s0, s1; score(i, s0, s1);
        exp_step(s0, s1, l); pv<4>(o, s0, s1, (lcptr)(Vb + (i & 1) * VT128), VS128, lane);
        if (i + 1 < nt) { lptr kd = Kb + ((i + 1) & 1) * KT128, vd = Vb + ((i + 1) & 1) * VT128;
#pragma unroll
            for (int k = 0; k < 2; ++k) { const int idx = tid + 512 * k, rr = idx >> 4, ch = idx & 15; *(LAS u32x4*)(kd + rr * KS128 + ch * 16) = sS[k]; *(LAS u32x4*)(vd + rr * VS128 + ch * 16) = sS[k]; } }
        __syncthreads();
    };
    for (int i = 0; i < nt; i += 2) { step(i, st2, st); if (i + 1 < nt) step(i + 1, st, st2); }
    l += __shfl_xor(l, 32); const float f = l > 0.f ? OSC / l : 0.f;
    unsigned char* orow = MIXIN + row * 1536 + head * 128;
#pragma unroll
    for (int d = 0; d < 4; ++d)
#pragma unroll
        for (int rg = 0; rg < 4; ++rg) *(unsigned*)(orow + 32 * d + 8 * rg + 4 * hi) = pg8::pk4_fp8(o[d][4 * rg] * f, o[d][4 * rg + 1] * f, o[d][4 * rg + 2] * f, o[d][4 * rg + 3] * f);
}

constexpr int QI_STRIDE = 2064;
__device__ __forceinline__ void indexer_unit(const Frame& F, int b, int c, const bf16_t* QIDX, const bf16_t* T1, _Float16* SC) {
    using namespace att;
    const int lane = F.lane, r32 = lane & 31, hi = lane >> 5, w = F.wave, tid = F.tid;
    lptr lds = (lptr)F.lds; lptr QI = lds; lptr KI = lds + 64 * QI_STRIDE;
    const int qh = w & 1, kq = w >> 1;
    const size_t row0 = (size_t)b * SEQ + 64 * c;
#pragma unroll 4
    for (int k = 0; k < 16; ++k) { const int idx = tid + 512 * k, rr = idx >> 7, ch = idx & 127; *(LAS u32x4*)(QI + rr * QI_STRIDE + ch * 16) = *(const u32x4*)(QIDX + (row0 + rr) * 1024 + ch * 8); }
    float wv[16];
    { const size_t trow = row0 + 32 * qh + r32; const u32x4 a = *(const u32x4*)(T1 + trow * 256 + 192), bq = *(const u32x4*)(T1 + trow * 256 + 200);
      wv[0] = bflo(a.x); wv[1] = bfhi(a.x); wv[2] = bflo(a.y); wv[3] = bfhi(a.y); wv[4] = bflo(a.z); wv[5] = bfhi(a.z); wv[6] = bflo(a.w); wv[7] = bfhi(a.w);
      wv[8] = bflo(bq.x); wv[9] = bfhi(bq.x); wv[10] = bflo(bq.y); wv[11] = bfhi(bq.y); wv[12] = bflo(bq.z); wv[13] = bfhi(bq.z); wv[14] = bflo(bq.w); wv[15] = bfhi(bq.w); }
    const int nsup = (c + 2) >> 1, pitch = (c + 1) * 64;
    _Float16* srow = SC + (size_t)b * SCB_ELEMS + (size_t)4096 * (c * (c + 1) / 2) + (size_t)(32 * qh + r32) * pitch;
    const bf16_t* Kb = T1 + (size_t)b * SEQ * 256 + 128;
    u32x4 st[2];
    for (int s = 0; s < nsup; ++s) {
#pragma unroll
        for (int k = 0; k < 2; ++k) { const int idx = tid + 512 * k, rr = idx >> 3, ch = idx & 7; st[k] = *(const u32x4*)(Kb + (size_t)(128 * s + rr) * 256 + ch * 8); }
        __syncthreads();
#pragma unroll
        for (int k = 0; k < 2; ++k) { const int idx = tid + 512 * k, rr = idx >> 3, ch = idx & 7; *(LAS u32x4*)(KI + rr * KS64 + ch * 16) = st[k]; }
        __syncthreads();
        const int key0 = 128 * s + 32 * kq;
        if (key0 <= 64 * c + 63) {
            bf16x8 kf[4];
#pragma unroll
            for (int ks = 0; ks < 4; ++ks) kf[ks] = *(const LAS bf16x8*)(KI + (32 * kq + r32) * KS64 + ks * 32 + hi * 16);
            f32x16 sc = splat16(0.f);
            lcptr qp = (lcptr)QI + (32 * qh + r32) * QI_STRIDE + hi * 16;
#pragma unroll 2
            for (int hd = 0; hd < 16; ++hd) { f32x16 acc = splat16(0.f);
#pragma unroll
                for (int ks = 0; ks < 4; ++ks) { const bf16x8 qv = *(const LAS bf16x8*)(qp + hd * 128 + ks * 32); acc = __builtin_amdgcn_mfma_f32_32x32x16_bf16(kf[ks], qv, acc, 0, 0, 0); }
                const float ww = wv[hd];
#pragma unroll
                for (int r = 0; r < 16; ++r) sc[r] += ww * fmaxf(acc[r], 0.f); }
#pragma unroll
            for (int rg = 0; rg < 4; ++rg) { f32x2 a = {sc[4 * rg], sc[4 * rg + 1]}, bq = {sc[4 * rg + 2], sc[4 * rg + 3]};
                u32x2 o; o.x = __builtin_bit_cast(unsigned, __builtin_convertvector(a, f16x2_t)); o.y = __builtin_bit_cast(unsigned, __builtin_convertvector(bq, f16x2_t));
                *(u32x2*)(srow + key0 + 8 * rg + 4 * hi) = o; }
        }
    }
    __syncthreads();
}

struct SelRow { const unsigned short* src; unsigned* mrow; int t, c; };
__device__ __forceinline__ SelRow sel_row(int row, const _Float16* SC, unsigned* MASK) {
    SelRow r; const int b = row >> 12; r.t = row & 4095; r.c = r.t >> 6; const int nk = (r.c + 1) * 64;
    r.src = (const unsigned short*)SC + (size_t)b * SCB_ELEMS + (size_t)4096 * (r.c * (r.c + 1) / 2) + (size_t)(r.t & 63) * nk; r.mrow = MASK + (size_t)row * 128; return r;
}
__device__ __forceinline__ void sel_load(const SelRow& r, int lane, unsigned (&key)[64]) {
#pragma unroll
    for (int g = 0; g < 4; ++g) {
        if (r.c >= 16 * g) {
#pragma unroll
            for (int jj = 0; jj < 16; ++jj) { const int j = 16 * g + jj, jc = j <= r.c ? j : r.c;
                const unsigned uu = r.src[64 * jc + lane]; const unsigned k = (uu & 0x8000u) ? (~uu & 0xffffu) : (uu | 0x8000u);
                key[j] = (64 * j + lane > r.t) ? 0u : k; }
        } else {
#pragma unroll
            for (int jj = 0; jj < 16; ++jj) key[16 * g + jj] = 0u;
        }
    }
}
template <bool GT> __device__ __forceinline__ int sel_count(const unsigned (&key)[64], unsigned cand, int c) {
    int cnt = 0;
#pragma unroll
    for (int g = 0; g < 4; ++g) if (c >= 16 * g) {
#pragma unroll
        for (int jj = 0; jj < 16; ++jj) cnt += __popcll(__ballot(GT ? (key[16 * g + jj] > cand) : (key[16 * g + jj] >= cand)));
    }
    return cnt;
}
__device__ __forceinline__ void sel_emit(const SelRow& r, int lane, const unsigned (&key)[64], unsigned prefix, bool exact) {
    if (exact) {
#pragma unroll
        for (int j = 0; j < 64; ++j) if (j <= r.c) { const unsigned long long mk = __ballot(key[j] >= prefix); if (lane == 0) *(u32x2*)(r.mrow + 2 * j) = (u32x2){(unsigned)mk, (unsigned)(mk >> 32)}; }
        return;
    }
    int rem = 256 - sel_count<true>(key, prefix, r.c);
#pragma unroll
    for (int j = 0; j < 64; ++j) {
        if (j <= r.c) {
            const bool eq = key[j] == prefix; const unsigned long long eqm = __ballot(eq);
            const int before = __builtin_amdgcn_mbcnt_hi((unsigned)(eqm >> 32), __builtin_amdgcn_mbcnt_lo((unsigned)eqm, 0u));
            const unsigned long long mk = __ballot(key[j] > prefix || (eq && before < rem));
            rem -= __popcll(eqm); rem = rem < 0 ? 0 : rem;
            if (lane == 0) *(u32x2*)(r.mrow + 2 * j) = (u32x2){(unsigned)mk, (unsigned)(mk >> 32)};
        }
    }
}
__device__ __forceinline__ void sel_small(const SelRow& r, int lane) {
    for (int j = 0; j <= r.c; ++j) { const unsigned long long mk = __ballot(64 * j + lane <= r.t); if (lane == 0) *(u32x2*)(r.mrow + 2 * j) = (u32x2){(unsigned)mk, (unsigned)(mk >> 32)}; }
}
__device__ __forceinline__ void phase_select(const Frame& F, const _Float16* SC, unsigned* MASK) {
    const int lane = F.lane;
    for (int p = F.gw; p < MTOK / 2; p += F.NGW) {
        const int pb_ = p >> 11, q = p & 2047;
        const SelRow ra = sel_row(pb_ * 4096 + q, SC, MASK), rb = sel_row(pb_ * 4096 + 4095 - q, SC, MASK);
        const bool sa = ra.t < 256, sb = rb.t < 256;
        if (sa) sel_small(ra, lane);
        if (sb) sel_small(rb, lane);
        if (sa && sb) continue;
        unsigned ka[64], kb[64];
        sel_load(ra, lane, ka); sel_load(rb, lane, kb);
        unsigned pa = 0u, pb = 0u; bool da = sa, db = sb;
#pragma unroll 1
        for (int bit = 15; bit >= 0 && !(da && db); --bit) {
            if (!da) { const unsigned ca = pa | (1u << bit); const int na = sel_count<false>(ka, ca, ra.c); if (na >= 256) pa = ca; if (na == 256) da = true; }
            if (!db) { const unsigned cb = pb | (1u << bit); const int nb = sel_count<false>(kb, cb, rb.c); if (nb >= 256) pb = cb; if (nb == 256) db = true; }
        }
        if (!sa) sel_emit(ra, lane, ka, pa, da);
        if (!sb) sel_emit(rb, lane, kb, pb, db);
    }
}

__device__ __forceinline__ float gelu_tanh(float x) { const float u = 0.7978845608028654f * (x + 0.044715f * x * x * x); const float e = __expf(2.f * u); return 0.5f * x * (1.f + (1.f - 2.f / (e + 1.f))); }
__device__ __forceinline__ void compress_unit(const Frame& F, int b, int g, int kv, int rt, const bf16_t* KVC, const bf16_t* W1T, const float* w2, const float* cb, bf16_t* OUT) {
    const int lane = F.lane, r32 = lane & 31, hi = lane >> 5, w = F.wave, tid = F.tid;
    LAS float* PART = (LAS float*)F.lds;
    LAS float* HID = PART + 8 * 2048;
    const int n0 = 32 * rt, nn = n0 + r32, nc = nn < 255 ? nn : 254;
    const bf16_t* arow = KVC + ((size_t)b * SEQ + 16 * nc) * 256 + kv * 128 + g * 64;
    f32x16 a0 = att::splat16(0.f), a1 = att::splat16(0.f);
#pragma unroll 4
    for (int ks = 0; ks < 16; ++ks) { const int l = 4 * w + (ks >> 2), d = 16 * (ks & 3) + 8 * hi;
        const bf16x8 af = *(const bf16x8*)(arow + (size_t)l * 256 + d);
        const bf16x8 b0 = *(const bf16x8*)(W1T + (size_t)r32 * 2048 + l * 64 + d), b1 = *(const bf16x8*)(W1T + (size_t)(32 + r32) * 2048 + l * 64 + d);
        a0 = __builtin_amdgcn_mfma_f32_32x32x16_bf16(af, b0, a0, 0, 0, 0); a1 = __builtin_amdgcn_mfma_f32_32x32x16_bf16(af, b1, a1, 0, 0, 0); }
#pragma unroll
    for (int r = 0; r < 16; ++r) { const int mrow = att::crow(r, hi); PART[w * 2048 + mrow * 64 + r32] = a0[r]; PART[w * 2048 + mrow * 64 + 32 + r32] = a1[r]; }
    __syncthreads();
#pragma unroll
    for (int k = 0; k < 4; ++k) { const int idx = tid + 512 * k; float s = cb[idx & 63];
#pragma unroll
        for (int ww = 0; ww < 8; ++ww) s += PART[ww * 2048 + idx];
        HID[idx] = gelu_tanh(s); }
    __syncthreads();
#pragma unroll
    for (int k = 0; k < 4; ++k) { const int idx = tid + 512 * k, nr = idx >> 6, f = idx & 63; float s = 0.f;
#pragma unroll 8
        for (int e = 0; e < 64; ++e) s += HID[nr * 64 + e] * w2[e * 64 + f];
        const int blk = n0 + nr;
        OUT[(((size_t)b * 256 + blk) * 2 + g) * 64 + f] = (blk < 255) ? (bf16_t)f2bf(s) : (bf16_t)0; }
    __syncthreads();
}

#ifdef DBG_MODE
namespace dbg {
constexpr int NSLOT = 40;
__device__ __forceinline__ float bfr(float x) { return bf2f((unsigned short)f2bf(x)); }
__device__ __forceinline__ int srow(int i, int n) { return (int)(((unsigned)i * 2654435761u) % (unsigned)MTOK) ; }
__device__ void commit(unsigned* D, int slot, const float* ref, const float* fast, int n, float tf) {
    __shared__ float red[256];
    const int tid = threadIdx.x; float s = 0.f;
    for (int i = tid; i < n; i += 256) s += ref[i] * ref[i];
    red[tid] = s; __syncthreads();
    for (int o = 128; o > 0; o >>= 1) { if (tid < o) red[tid] += red[tid + o]; __syncthreads(); }
    const float rms = sqrtf(red[0] / (float)n); __syncthreads();
    int bad = 0, tot = 0; float mr = 0.f;
    for (int i = tid; i < n; i += 256) { const float e = fabsf(fast[i] - ref[i]); const float tol = tf * (rms + fabsf(ref[i])) + 1e-7f; if (!(e <= tol)) ++bad; ++tot; const float r = e / (rms + 1e-20f); if (r > mr || !(r == r)) mr = (r == r) ? r : 1e30f; }
    atomicAdd(&D[4 * slot], (unsigned)bad); atomicAdd(&D[4 * slot + 1], (unsigned)tot); atomicMax(&D[4 * slot + 2], __float_as_uint(mr));
    __syncthreads();
}
__device__ __forceinline__ float bias_l2(const float* relb, int head, int dist) { return relb[t5_bucket(dist) * 16 + head] * LOG2E; }

__global__ void chk_in_e(Args a, unsigned* D) {
    __shared__ float ref[1792], fast[1792];
    const int r = srow(blockIdx.x, 64), tid = threadIdx.x; const float* x = a.in[I_X] + (size_t)r * 1024; const float* w = a.in[I_EWIN];
    const bf16_t* Y1 = (const bf16_t*)(a.ws + OFF_Y1);
    for (int n = tid; n < EVEN_IN; n += 256) { float s = 0.f; for (int k = 0; k < 1024; ++k) s += bfr(x[k]) * bfr(w[(size_t)k * EVEN_IN + n]);
        const int dc = RowInE{}(n), tile = dc >> 8, col = dc & 255; const float sc = (tile == 2 || tile == 3) ? QSCALE : 1.f;
        ref[n] = s * sc; fast[n] = bf2f(Y1[((size_t)tile * MTOK + r) * 256 + col]); }
    __syncthreads();
    commit(D, 1, ref, fast, EVEN_IN, 0.02f);
    if (tid == 0) { float sq = 0.f, skv = 0.f; for (int n = 0; n < 256; ++n) sq += ref[n] * ref[n]; for (int n = 256; n < 384; ++n) skv += ref[n] * ref[n];
        const float* pq = (const float*)(a.ws + OFF_SSQ_Q) + (size_t)r * 4; const float* pk = (const float*)(a.ws + OFF_SSQ_KV) + (size_t)r * 4;
        const float fq = pq[0] + pq[1] + pq[2] + pq[3], fk = pk[0] + pk[1] + pk[2] + pk[3];
        int bad = 0; if (!(fabsf(fq - sq) <= 0.02f * sq)) ++bad; if (!(fabsf(fk - skv) <= 0.02f * skv)) ++bad;
        atomicAdd(&D[4 * 2], (unsigned)bad); atomicAdd(&D[4 * 2 + 1], 2u); }
}
__global__ void chk_q2(Args a, unsigned* D) {
    __shared__ float ref[1024], fast[1024], cqn[256], qh[512];
    const int r = srow(blockIdx.x, 64), tid = threadIdx.x; const bf16_t* Y1 = (const bf16_t*)(a.ws + OFF_Y1);
    const bf16_t* CQ = Y1 + (size_t)r * 256; const bf16_t* T1 = Y1 + ((size_t)MTOK + r) * 256;
    { float s = 0.f; for (int k = 0; k < 128; ++k) { const float c = bf2f(T1[k]); s += c * c; } const float rk = 1.f / sqrtf(s / 128.f + 1e-6f);
      if (tid < 128) { ref[tid] = bf2f(T1[tid]) * rk * a.in[I_EKVN][tid]; fast[tid] = bf2f(((const bf16_t*)(a.ws + OFF_CKVN))[(size_t)r * 128 + tid]); } }
    __syncthreads(); commit(D, 3, ref, fast, 128, 0.02f);
    { float s = 0.f; for (int k = 0; k < 256; ++k) { const float c = bf2f(CQ[k]); s += c * c; } const float rq = 1.f / sqrtf(s / 256.f + 1e-6f);
      cqn[tid] = bf2f(CQ[tid]) * rq * a.in[I_EQN][tid]; }
    __syncthreads();
    for (int o = tid; o < 512; o += 256) { float s = 0.f; for (int k = 0; k < 256; ++k) s += cqn[k] * a.in[I_EWUQ][k * 512 + o]; qh[o] = s; }
    __syncthreads();
    for (int o = tid; o < 1024; o += 256) { const int h = o >> 7, c = o & 127; float s = 0.f; for (int d = 0; d < 64; ++d) s += qh[h * 64 + d] * a.in[I_EWUK][c * 512 + h * 64 + d];
        ref[o] = s * QSCALE; fast[o] = bf2f(((const bf16_t*)(a.ws + OFF_QLAT))[(size_t)r * 1024 + o]); }
    __syncthreads(); commit(D, 5, ref, fast, 1024, 0.03f);
    for (int o = tid; o < 1024; o += 256) { float s = 0.f; for (int k = 0; k < 256; ++k) s += cqn[k] * a.in[I_EWQIDX][k * 1024 + o];
        ref[o] = s; fast[o] = bf2f(((const bf16_t*)(a.ws + OFF_QIDX))[(size_t)r * 1024 + o]); }
    __syncthreads(); commit(D, 6, ref, fast, 1024, 0.03f);
}
__global__ void chk_cmp(Args a, unsigned* D) {
    __shared__ float ref[64], fast[64], hid[64];
    const int i = blockIdx.x, tid = threadIdx.x, b = i & 7, g = (i >> 3) & 1, kv = (i >> 4) & 1; const int blk = (i >> 5) == 0 ? 0 : ((i >> 5) == 1 ? 254 : (int)((unsigned)(i * 37 + 11) % 255u));
    const bf16_t* KVC = (const bf16_t*)(a.ws + OFF_Y1) + (size_t)4 * MTOK * 256;
    const float* pos = a.in[kv ? I_EPOSV : I_EPOSK]; const float* w1 = a.in[kv ? I_ECV1 : I_ECK1]; const float* w2 = a.in[kv ? I_ECV2 : I_ECK2];
    if (tid < 64) { float s = 0.f;
        for (int l = 0; l < 32; ++l) for (int d = 0; d < 64; ++d) { const float av = bf2f(KVC[((size_t)b * SEQ + 16 * blk + l) * 256 + kv * 128 + g * 64 + d]); const float wv = w1[(l * 64 + d) * 64 + tid]; s += av * bfr(wv) + pos[l * 64 + d] * wv; }
        hid[tid] = gelu_tanh(s); }
    __syncthreads();
    if (tid < 64) { float s = 0.f; for (int e = 0; e < 64; ++e) s += hid[e] * w2[e * 64 + tid]; ref[tid] = s;
        fast[tid] = bf2f(((const bf16_t*)(a.ws + (kv ? OFF_VC : OFF_KC)))[(((size_t)b * 256 + blk) * 2 + g) * 64 + tid]); }
    __syncthreads(); commit(D, 4, ref, fast, 64, 0.03f);
}
__global__ void chk_idx(Args a, unsigned* D) {
    __shared__ float ref[256], fast[256];
    const int r = (blockIdx.x < 4) ? (blockIdx.x * 4096 + blockIdx.x * 61) : srow(blockIdx.x, 64), tid = threadIdx.x, b = r >> 12, t = r & 4095, c = t >> 6, nk = (c + 1) * 64;
    const bf16_t* Y1 = (const bf16_t*)(a.ws + OFF_Y1); const bf16_t* T1 = Y1 + (size_t)MTOK * 256; const bf16_t* QI = (const bf16_t*)(a.ws + OFF_QIDX) + (size_t)r * 1024;
    const int s = (int)(((unsigned)tid * 2654435761u + 12345u * blockIdx.x) % (unsigned)nk);
    const bf16_t* kr = T1 + ((size_t)b * SEQ + s) * 256 + 128; float sc = 0.f;
    for (int h = 0; h < 16; ++h) { float d = 0.f; for (int k = 0; k < 64; ++k) d += bf2f(QI[h * 64 + k]) * bf2f(kr[k]); sc += bf2f(T1[(size_t)r * 256 + 192 + h]) * fmaxf(d, 0.f); }
    ref[tid] = sc;
    const _Float16* SC = (const _Float16*)(a.ws + OFF_SC) + (size_t)b * SCB_ELEMS + (size_t)4096 * (c * (c + 1) / 2) + (size_t)(t & 63) * nk;
    fast[tid] = (float)SC[s];
    __syncthreads(); commit(D, 7, ref, fast, 256, 0.02f);
}
__global__ void chk_sel(Args a, unsigned* D) {
    __shared__ unsigned key[4096];
    const int r = (blockIdx.x < 8) ? (blockIdx.x * 4096 + 255 + blockIdx.x * 300) : srow(blockIdx.x, 64), tid = threadIdx.x, b = r >> 12, t = r & 4095, c = t >> 6, nk = (c + 1) * 64;
    const unsigned short* SC = (const unsigned short*)(a.ws + OFF_SC) + (size_t)b * SCB_ELEMS + (size_t)4096 * (c * (c + 1) / 2) + (size_t)(t & 63) * nk;
    const unsigned* M = (const unsigned*)(a.ws + OFF_MASK) + (size_t)r * 128;
    for (int s = tid; s < nk; s += 256) { const unsigned u = SC[s]; key[s] = (s <= t) ? ((u & 0x8000u) ? (~u & 0xffffu) : (u | 0x8000u)) : 0u; }
    __syncthreads();
    int bad = 0, tot = 0;
    for (int s = tid; s < nk; s += 256) { bool want;
        if (s > t) want = false; else if (t < 256) want = true;
        else { int rank = 0; const unsigned ks = key[s]; for (int q = 0; q <= t; ++q) rank += (key[q] > ks || (key[q] == ks && q < s)) ? 1 : 0; want = rank < 256; }
        const bool got = (M[s >> 5] >> (s & 31)) & 1u; if (want != got) ++bad; ++tot; }
    atomicAdd(&D[4 * 8], (unsigned)bad); atomicAdd(&D[4 * 8 + 1], (unsigned)tot);
}
__global__ void chk_dsa(Args a, unsigned* D) {
    __shared__ float lg[4096], red[256], ref[128], fast[128];
    const int r = (blockIdx.x < 8) ? (blockIdx.x * 4096 + blockIdx.x * 37) : srow(blockIdx.x, 64), tid = threadIdx.x, b = r >> 12, t = r & 4095, h = blockIdx.x & 7;
    const bf16_t* Q = (const bf16_t*)(a.ws + OFF_QLAT) + (size_t)r * 1024 + h * 128; const bf16_t* C = (const bf16_t*)(a.ws + OFF_CKVN) + (size_t)b * SEQ * 128;
    const unsigned* M = (const unsigned*)(a.ws + OFF_MASK) + (size_t)r * 128; const float* relb = a.in[I_RELB];
    float mx = -INFINITY;
    for (int s = tid; s <= t; s += 256) { float v = -INFINITY; if ((M[s >> 5] >> (s & 31)) & 1u) { float d = 0.f; for (int k = 0; k < 128; ++k) d += bf2f(Q[k]) * bf2f(C[(size_t)s * 128 + k]); v = d + bias_l2(relb, h, t - s); } lg[s] = v; mx = fmaxf(mx, v); }
    red[tid] = mx; __syncthreads(); for (int o = 128; o > 0; o >>= 1) { if (tid < o) red[tid] = fmaxf(red[tid], red[tid + o]); __syncthreads(); } mx = red[0]; __syncthreads();
    float sm = 0.f; for (int s = tid; s <= t; s += 256) { const float p = exp2f(lg[s] - mx); lg[s] = p; sm += p; }
    red[tid] = sm; __syncthreads(); for (int o = 128; o > 0; o >>= 1) { if (tid < o) red[tid] += red[tid + o]; __syncthreads(); } sm = red[0]; __syncthreads();
    if (tid < 128) { float o = 0.f; for (int s = 0; s <= t; ++s) o += lg[s] * bf2f(C[(size_t)s * 128 + tid]); ref[tid] = o / sm; fast[tid] = bf2f(((const bf16_t*)(a.ws + OFF_MIXIN))[(size_t)r * 1536 + h * 128 + tid]); }
    __syncthreads(); commit(D, 9, ref, fast, 128, 0.03f);
}
__global__ void chk_nsa(Args a, unsigned* D) {
    __shared__ float pc[4][256], lg[1100], red[256], ref[64], fast[64], oacc[3][64], scb[64]; __shared__ int selj[16]; __shared__ float qs[4][64];
    const int r = (blockIdx.x < 8) ? (blockIdx.x * 4096 + blockIdx.x * 41) : srow(blockIdx.x, 64), tid = threadIdx.x, b = r >> 12, t = r & 4095, hh = blockIdx.x & 7, g = hh >> 2, n = hh & 3, cur = t >> 6;
    const bf16_t* Y1 = (const bf16_t*)(a.ws + OFF_Y1); const bf16_t* T1 = Y1 + (size_t)MTOK * 256; const bf16_t* QB = Y1 + (size_t)(2 + g) * MTOK * 256;
    const bf16_t* KVS = Y1 + (size_t)5 * MTOK * 256; const bf16_t* KVW = Y1 + (size_t)6 * MTOK * 256;
    const bf16_t* KC = (const bf16_t*)(a.ws + OFF_KC); const bf16_t* VC = (const bf16_t*)(a.ws + OFF_VC); const float* relb = a.in[I_RELB];
    qs[tid >> 6][tid & 63] = bf2f(QB[(size_t)r * 256 + tid]);
    __syncthreads();
    const int vis = (t >= 31) ? ((t - 31) >> 4) : -1;
    for (int nn = 0; nn < 4; ++nn) {
        float v = -INFINITY; if (tid <= vis) { float d = 0.f; for (int k = 0; k < 64; ++k) d += qs[nn][k] * bf2f(KC[(((size_t)b * 256 + tid) * 2 + g) * 64 + k]); v = d + bias_l2(relb, 8 + 4 * g + nn, t - 16 * tid - 31); }
        red[tid] = v; __syncthreads(); for (int o = 128; o > 0; o >>= 1) { if (tid < o) red[tid] = fmaxf(red[tid], red[tid + o]); __syncthreads(); } const float mx = red[0]; __syncthreads();
        const float p = (tid <= vis) ? exp2f(v - mx) : 0.f; red[tid] = p; __syncthreads(); for (int o = 128; o > 0; o >>= 1) { if (tid < o) red[tid] += red[tid + o]; __syncthreads(); } const float sm = red[0]; __syncthreads();
        pc[nn][tid] = sm > 0.f ? p / sm : 0.f; __syncthreads();
    }
    if (tid < 64) { float o = 0.f; for (int i = 0; i <= vis; ++i) o += pc[n][i] * bf2f(VC[(((size_t)b * 256 + i) * 2 + g) * 64 + tid]); oacc[0][tid] = o;
        float s = 0.f; for (int nn = 0; nn < 4; ++nn) for (int i = 4 * tid - 1; i <= 4 * tid + 3; ++i) if (i >= 0 && i < 255) s += pc[nn][i];
        scb[tid] = (tid > cur) ? -INFINITY : ((tid == 0 || tid == cur || tid == cur - 1) ? INFINITY : s); }
    __syncthreads();
    if (tid < 64) { int rank = 0; for (int j = 0; j < 64; ++j) rank += (scb[j] > scb[tid] || (scb[j] == scb[tid] && j < tid)) ? 1 : 0; if (rank < 16) selj[rank] = tid; }
    __syncthreads();
    { float mx = -INFINITY;
      for (int i = tid; i < 1024; i += 256) { const int j = selj[i >> 6], p = 64 * j + (i & 63); float v = -INFINITY; if (p <= t) { float d = 0.f; for (int k = 0; k < 64; ++k) d += qs[n][k] * bf2f(KVS[((size_t)b * SEQ + p) * 256 + g * 64 + k]); v = d + bias_l2(relb, 8 + hh, t - p); } lg[i] = v; mx = fmaxf(mx, v); }
      red[tid] = mx; __syncthreads(); for (int o = 128; o > 0; o >>= 1) { if (tid < o) red[tid] = fmaxf(red[tid], red[tid + o]); __syncthreads(); } mx = red[0]; __syncthreads();
      float sm = 0.f; for (int i = tid; i < 1024; i += 256) { const float p = exp2f(lg[i] - mx); lg[i] = p; sm += p; }
      red[tid] = sm; __syncthreads(); for (int o = 128; o > 0; o >>= 1) { if (tid < o) red[tid] += red[tid + o]; __syncthreads(); } sm = red[0]; __syncthreads();
      if (tid < 64) { float o = 0.f; for (int i = 0; i < 1024; ++i) { const int p = 64 * selj[i >> 6] + (i & 63); if (p <= t) o += lg[i] * bf2f(KVS[((size_t)b * SEQ + p) * 256 + 128 + g * 64 + tid]); } oacc[1][tid] = o / sm; }
      __syncthreads(); }
    { float mx = -INFINITY;
      for (int i = tid; i < 512; i += 256) { const int p = t - i; float v = -INFINITY; if (p >= 0) { float d = 0.f; for (int k = 0; k < 64; ++k) d += qs[n][k] * bf2f(KVW[((size_t)b * SEQ + p) * 256 + g * 64 + k]); v = d + bias_l2(relb, 8 + hh, i); } lg[i] = v; mx = fmaxf(mx, v); }
      red[tid] = mx; __syncthreads(); for (int o = 128; o > 0; o >>= 1) { if (tid < o) red[tid] = fmaxf(red[tid], red[tid + o]); __syncthreads(); } mx = red[0]; __syncthreads();
      float sm = 0.f; for (int i = tid; i < 512; i += 256) { const float p = exp2f(lg[i] - mx); lg[i] = p; sm += p; }
      red[tid] = sm; __syncthreads(); for (int o = 128; o > 0; o >>= 1) { if (tid < o) red[tid] += red[tid + o]; __syncthreads(); } sm = red[0]; __syncthreads();
      if (tid < 64) { float o = 0.f; for (int i = 0; i < 512; ++i) { const int p = t - i; if (p >= 0) o += lg[i] * bf2f(KVW[((size_t)b * SEQ + p) * 256 + 128 + g * 64 + tid]); } oacc[2][tid] = o / sm; }
      __syncthreads(); }
    if (tid < 64) { float gt[3]; for (int j = 0; j < 3; ++j) { const float x = bf2f(T1[(size_t)r * 256 + 208 + hh * 3 + j]); gt[j] = 1.f / (1.f + expf(-x)); }
        ref[tid] = gt[0] * oacc[0][tid] + gt[1] * oacc[1][tid] + gt[2] * oacc[2][tid]; fast[tid] = bf2f(((const bf16_t*)(a.ws + OFF_MIXIN))[(size_t)r * 1536 + 1024 + hh * 64 + tid]); }
    __syncthreads(); commit(D, 10, ref, fast, 64, 0.04f);
}
__global__ void chk_out_e(Args a, unsigned* D) {
    __shared__ float ref[1024], fast[1024], cat[1024];
    const int r = srow(blockIdx.x, 64), tid = threadIdx.x; const bf16_t* MX = (const bf16_t*)(a.ws + OFF_MIXIN) + (size_t)r * 1536;
    for (int o = tid; o < 512; o += 256) { const int h = o >> 6, d = o & 63; float s = 0.f; for (int c = 0; c < 128; ++c) s += bf2f(MX[h * 128 + c]) * a.in[I_EWUV][c * 512 + h * 64 + d]; cat[o] = s; cat[512 + o] = bf2f(MX[1024 + o]); }
    __syncthreads();
    for (int n = tid; n < 1024; n += 256) { float s = 0.f; for (int j = 0; j < 1024; ++j) s += cat[j] * a.in[I_EWOUT][(size_t)j * 1024 + n]; ref[n] = s;
        fast[n] = bf2f(((const bf16_t*)(a.ws + OFF_S1))[(size_t)r * 1024 + n]) - ALPHA * a.in[I_X][(size_t)r * 1024 + n]; }
    __syncthreads(); commit(D, 11, ref, fast, 1024, 0.35f);
}
__global__ void chk_ln(const bf16_t* S, const bf16_t* O, const float* g, const float* bt, unsigned* D, int slot) {
    __shared__ float ref[1024], fast[1024];
    const int r = srow(blockIdx.x, 64), tid = threadIdx.x; float mean = 0.f, var = 0.f;
    for (int k = 0; k < 1024; ++k) mean += bf2f(S[(size_t)r * 1024 + k]); mean /= 1024.f;
    for (int k = 0; k < 1024; ++k) { const float d = bf2f(S[(size_t)r * 1024 + k]) - mean; var += d * d; } var /= 1024.f;
    for (int n = tid; n < 1024; n += 256) { ref[n] = (bf2f(S[(size_t)r * 1024 + n]) - mean) / sqrtf(var + 1e-5f) * g[n] + bt[n]; fast[n] = bf2f(O[(size_t)r * 1024 + n]); }
    __syncthreads(); commit(D, slot, ref, fast, 1024, 0.01f);
}
__global__ void chk_ffn_up(Args a, unsigned* D) {
    __shared__ float ref[DFF], fast[DFF], hrow[1024];
    const int r = srow(blockIdx.x, 64), tid = threadIdx.x; const bf16_t* H = (const bf16_t*)(a.ws + OFF_H) + (size_t)r * 1024;
    for (int k = tid; k < 1024; k += 256) hrow[k] = bf2f(H[k]);
    __syncthreads();
    for (int n = tid; n < DFF; n += 256) { float s1 = 0.f, s3 = 0.f; for (int k = 0; k < 1024; ++k) { s1 += hrow[k] * bfr(a.in[I_EF1][(size_t)k * DFF + n]); s3 += hrow[k] * bfr(a.in[I_EF3][(size_t)k * DFF + n]); }
        ref[n] = s1 / (1.f + expf(-s1)) * s3; fast[n] = bf2f(((const bf16_t*)(a.ws + OFF_ACT))[(size_t)r * DFF + n]); }
    __syncthreads(); commit(D, 13, ref, fast, DFF, 0.02f);
}
__global__ void chk_ffn_dn(Args a, unsigned* D) {
    __shared__ float ref[1024], fast[1024], arow[DFF];
    const int r = srow(blockIdx.x, 64), tid = threadIdx.x; const bf16_t* A = (const bf16_t*)(a.ws + OFF_ACT) + (size_t)r * DFF;
    for (int k = tid; k < DFF; k += 256) arow[k] = bf2f(A[k]);
    __syncthreads();
    for (int n = tid; n < 1024; n += 256) { float s = 0.f; for (int k = 0; k < DFF; ++k) s += arow[k] * bfr(a.in[I_EF2][(size_t)k * 1024 + n]); ref[n] = s;
        fast[n] = bf2f(((const bf16_t*)(a.ws + OFF_S2))[(size_t)r * 1024 + n]) - ALPHA * bf2f(((const bf16_t*)(a.ws + OFF_H))[(size_t)r * 1024 + n]); }
    __syncthreads(); commit(D, 14, ref, fast, 1024, 0.06f);
}
__global__ void chk_in_o(Args a, unsigned* D) {
    __shared__ float ref[2048], fast[2048], xr[1024];
    const int r = srow(blockIdx.x, 64), tid = threadIdx.x; const bf16_t* X1 = (const bf16_t*)(a.ws + OFF_X1) + (size_t)r * 1024;
    for (int k = tid; k < 1024; k += 256) xr[k] = bf2f(X1[k]);
    __syncthreads();
    for (int n = tid; n < 2048; n += 256) { float s = 0.f; for (int k = 0; k < 1024; ++k) s += xr[k] * bfr(a.in[I_OWIN][(size_t)k * 3072 + 1024 + n]); ref[n] = s;
        fast[n] = bf2f(((const bf16_t*)(a.ws + OFF_QKV))[(size_t)(1 + (n >> 10)) * MTOK * 1024 + (size_t)r * 1024 + (n & 1023)]); }
    __syncthreads(); commit(D, 16, ref, fast, 2048, 0.02f);
    const int pm = r >> 8; const bf16_t* K = (const bf16_t*)(a.ws + OFF_QKV) + (size_t)MTOK * 1024 + (size_t)pm * 256 * 1024; const float* KM = (const float*)(a.ws + OFF_KMEAN) + (size_t)pm * 2048;
    for (int n = tid; n < 1024; n += 256) { float s = 0.f; for (int q = 0; q < 256; ++q) s += bf2f(K[(size_t)q * 1024 + n]); ref[n] = s; fast[n] = KM[n] + KM[1024 + n]; }
    __syncthreads(); commit(D, 17, ref, fast, 1024, 0.03f);
}
__global__ void chk_moba(Args a, unsigned* D) {
    __shared__ float lg[1024], red[256], ref[64], fast[64], q[64], gate[16]; __shared__ int blkof[4];
    const int r = (blockIdx.x < 8) ? (blockIdx.x * 4096 + blockIdx.x * 300) : srow(blockIdx.x, 64), tid = threadIdx.x, b = r >> 12, t = r & 4095, h = blockIdx.x & 15, own = t >> 8;
    const bf16_t* X1 = (const bf16_t*)(a.ws + OFF_X1) + (size_t)r * 1024; const bf16_t* K = (const bf16_t*)(a.ws + OFF_QKV) + (size_t)MTOK * 1024 + (size_t)b * SEQ * 1024 + h * 64; const bf16_t* V = K + (size_t)MTOK * 1024;
    const float* relb = a.in[I_RELB];
    if (tid < 64) { float s = 0.f; for (int k = 0; k < 1024; ++k) s += bf2f(X1[k]) * bfr(a.in[I_OWIN][(size_t)k * 3072 + h * 64 + tid]); q[tid] = bfr(s * QSCALE); }
    __syncthreads();
    if (tid < 16) { float s = -INFINITY; if (tid < own) { s = 0.f; for (int p = 0; p < 256; ++p) for (int d = 0; d < 64; ++d) s += q[d] * bf2f(K[(size_t)(256 * tid + p) * 1024 + d]); } gate[tid] = s; }
    __syncthreads();
    if (tid == 0) { unsigned used = 0u; for (int k = 0; k < 3; ++k) { int bj = -1; float best = -INFINITY; for (int j = 0; j < own; ++j) if (!((used >> j) & 1u) && gate[j] > best) { best = gate[j]; bj = j; } blkof[k] = bj; if (bj >= 0) used |= 1u << bj; } blkof[3] = own; }
    __syncthreads();
    float mx = -INFINITY;
    for (int i = tid; i < 1024; i += 256) { const int j = blkof[i >> 8], p = 256 * j + (i & 255); float v = -INFINITY; if (j >= 0 && p <= t) { float d = 0.f; for (int k = 0; k < 64; ++k) d += q[k] * bf2f(K[(size_t)p * 1024 + k]); v = d + bias_l2(relb, h, t - p); } lg[i] = v; mx = fmaxf(mx, v); }
    red[tid] = mx; __syncthreads(); for (int o = 128; o > 0; o >>= 1) { if (tid < o) red[tid] = fmaxf(red[tid], red[tid + o]); __syncthreads(); } mx = red[0]; __syncthreads();
    float sm = 0.f; for (int i = tid; i < 1024; i += 256) { const float p = exp2f(lg[i] - mx); lg[i] = p; sm += p; }
    red[tid] = sm; __syncthreads(); for (int o = 128; o > 0; o >>= 1) { if (tid < o) red[tid] += red[tid + o]; __syncthreads(); } sm = red[0]; __syncthreads();
    if (tid < 64) { float o = 0.f; for (int i = 0; i < 1024; ++i) { const int j = blkof[i >> 8], p = 256 * j + (i & 255); if (j >= 0 && p <= t) o += lg[i] * bf2f(V[(size_t)p * 1024 + tid]); } ref[tid] = o / sm;
        fast[tid] = bf2f(((const bf16_t*)(a.ws + OFF_QKV))[(size_t)r * 1024 + h * 64 + tid]); }
    __syncthreads(); commit(D, 18, ref, fast, 64, 0.04f);
}
__global__ void chk_out_o(Args a, unsigned* D) {
    __shared__ float ref[1024], fast[1024], orow[1024];
    const int r = srow(blockIdx.x, 64), tid = threadIdx.x;
    for (int k = tid; k < 1024; k += 256) orow[k] = bf2f(((const bf16_t*)(a.ws + OFF_QKV))[(size_t)r * 1024 + k]);
    __syncthreads();
    for (int n = tid; n < 1024; n += 256) { float s = 0.f; for (int k = 0; k < 1024; ++k) s += orow[k] * a.in[I_OWOUT][(size_t)k * 1024 + n]; ref[n] = s;
        fast[n] = bf2f(((const bf16_t*)(a.ws + OFF_S1O))[(size_t)r * 1024 + n]) - ALPHA * bf2f(((const bf16_t*)(a.ws + OFF_X1))[(size_t)r * 1024 + n]); }
    __syncthreads(); commit(D, 20, ref, fast, 1024, 0.5f);
}
__global__ void chk_route(Args a, unsigned* D) {
    const int r = srow(blockIdx.x * 256 + threadIdx.x, 64); const bf16_t* H2 = (const bf16_t*)(a.ws + OFF_H2) + (size_t)r * 1024;
    float lg[8]; for (int e = 0; e < 8; ++e) lg[e] = 0.f;
    for (int k = 0; k < 1024; ++k) { const float hv = bf2f(H2[k]); for (int e = 0; e < 8; ++e) lg[e] += hv * a.in[I_OROUTER][k * 8 + e]; }
    int e0 = 0; for (int e = 1; e < 8; ++e) if (lg[e] > lg[e0]) e0 = e; int e1 = -1; for (int e = 0; e < 8; ++e) if (e != e0 && (e1 < 0 || lg[e] > lg[e1])) e1 = e;
    const float g0 = 1.f / (1.f + expf(lg[e1] - lg[e0]));
    const u32x2 rt = ((const u32x2*)(a.ws + OFF_ROUTE))[r]; const int f0 = rt.x & 255, f1 = (rt.x >> 8) & 255; const float fg = __uint_as_float(rt.y);
    int bad = 0; if (f0 != e0 || f1 != e1 || !(fabsf(fg - g0) <= 0.02f)) ++bad;
    atomicAdd(&D[4 * 21], (unsigned)bad); atomicAdd(&D[4 * 21 + 1], 1u);
    const int* GI = (const int*)(a.ws + OFF_GINFO); const int* DEST = (const int*)(a.ws + OFF_DEST) + 2 * (size_t)r;
    int bad2 = 0;
    for (int k = 0; k < 2; ++k) { const int e = k ? f1 : f0, d = DEST[k], ps = e ? GI[e - 1] : 0; if (d < ps || d >= ps + GI[8 + e]) ++bad2; }
    atomicAdd(&D[4 * 22], (unsigned)bad2); atomicAdd(&D[4 * 22 + 1], 2u);
}
__global__ void chk_moe(Args a, unsigned* D) {
    __shared__ float ref[1024], fast[1024], hrow[1024], act[DFFE], fin[1024];
    const int r = srow(blockIdx.x, 64), tid = threadIdx.x; const bf16_t* H2 = (const bf16_t*)(a.ws + OFF_H2) + (size_t)r * 1024;
    for (int k = tid; k < 1024; k += 256) { hrow[k] = bf2f(H2[k]); ref[k] = 0.f; }
    const u32x2 rt = ((const u32x2*)(a.ws + OFF_ROUTE))[r]; const float g0 = __uint_as_float(rt.y); const int* DEST = (const int*)(a.ws + OFF_DEST) + 2 * (size_t)r; const bf16_t* YR = (const bf16_t*)(a.ws + OFF_YR);
    __syncthreads();
    for (int k = 0; k < 2; ++k) { const int e = k ? ((rt.x >> 8) & 255) : (rt.x & 255); const float gk = k ? 1.f - g0 : g0;
        const float* w1 = a.in[I_OM1] + (size_t)e * 1024 * DFFE; const float* w3 = a.in[I_OM3] + (size_t)e * 1024 * DFFE; const float* w2 = a.in[I_OM2] + (size_t)e * DFFE * 1024;
        for (int f = tid; f < DFFE; f += 256) { float s1 = 0.f, s3 = 0.f; for (int q = 0; q < 1024; ++q) { s1 += hrow[q] * bfr(w1[(size_t)q * DFFE + f]); s3 += hrow[q] * bfr(w3[(size_t)q * DFFE + f]); } act[f] = bfr(s1 / (1.f + expf(-s1)) * s3); }
        __syncthreads();
        for (int n = tid; n < 1024; n += 256) { float s = 0.f; for (int f = 0; f < DFFE; ++f) s += act[f] * bfr(w2[(size_t)f * 1024 + n]); ref[n] += gk * s; }
        __syncthreads(); }
    for (int n = tid; n < 1024; n += 256) { fast[n] = g0 * bf2f(YR[(size_t)DEST[0] * 1024 + n]) + (1.f - g0) * bf2f(YR[(size_t)DEST[1] * 1024 + n]); fin[n] = ALPHA * hrow[n] + fast[n]; }
    __syncthreads(); commit(D, 23, ref, fast, 1024, 0.12f);
    float mean = 0.f, var = 0.f; for (int k = 0; k < 1024; ++k) mean += fin[k]; mean /= 1024.f; for (int k = 0; k < 1024; ++k) { const float d = fin[k] - mean; var += d * d; } var /= 1024.f;
    __syncthreads();
    for (int n = tid; n < 1024; n += 256) { ref[n] = (fin[n] - mean) / sqrtf(var + 1e-5f) * a.in[I_OLN2G][n] + a.in[I_OLN2B][n]; fast[n] = a.out[(size_t)r * 1024 + n]; }
    __syncthreads(); commit(D, 24, ref, fast, 1024, 0.005f);
    { float m2 = 0.f, v2 = 0.f; for (int k = 0; k < 1024; ++k) m2 += ALPHA * hrow[k]; m2 /= 1024.f; for (int k = 0; k < 1024; ++k) { const float d = ALPHA * hrow[k] - m2; v2 += d * d; } v2 /= 1024.f;
      for (int n = tid; n < 1024; n += 256) ref[n] = (ALPHA * hrow[n] - m2) / sqrtf(v2 + 1e-5f) * a.in[I_OLN2G][n] + a.in[I_OLN2B][n];
      __syncthreads(); commit(D, 28, ref, fast, 1024, 0.005f); }
    { for (int n = tid; n < 1024; n += 256) fin[n] = ALPHA * hrow[n] + (1.f - g0) * bf2f(YR[(size_t)DEST[0] * 1024 + n]) + g0 * bf2f(YR[(size_t)DEST[1] * 1024 + n]);
      __syncthreads();
      float m2 = 0.f, v2 = 0.f; for (int k = 0; k < 1024; ++k) m2 += fin[k]; m2 /= 1024.f; for (int k = 0; k < 1024; ++k) { const float d = fin[k] - m2; v2 += d * d; } v2 /= 1024.f;
      __syncthreads();
      for (int n = tid; n < 1024; n += 256) ref[n] = (fin[n] - m2) / sqrtf(v2 + 1e-5f) * a.in[I_OLN2G][n] + a.in[I_OLN2B][n];
      __syncthreads(); commit(D, 29, ref, fast, 1024, 0.005f); }
}

__global__ void chk_wmoe(Args a, unsigned* D) {
    const int tid = blockIdx.x * 256 + threadIdx.x; const unsigned hsh = (unsigned)tid * 2654435761u;
    const int e = hsh & 7, f = (hsh >> 3) % DFFE, k = (hsh >> 15) % 1024;
    const bf16_t* W13 = (const bf16_t*)(a.ws + OFF_W_M13) + (size_t)e * 2 * DFFE * 1024; const bf16_t* W2 = (const bf16_t*)(a.ws + OFF_W_M2) + (size_t)e * 1024 * DFFE;
    int bad = 0;
    if (W13[(size_t)(((f >> 7) << 8) + (f & 127)) * 1024 + k] != (bf16_t)f2bf(a.in[I_OM1][(size_t)e * 1024 * DFFE + (size_t)k * DFFE + f])) ++bad;
    if (W13[(size_t)(((f >> 7) << 8) + (f & 127) + 128) * 1024 + k] != (bf16_t)f2bf(a.in[I_OM3][(size_t)e * 1024 * DFFE + (size_t)k * DFFE + f])) ++bad;
    atomicAdd(&D[4 * 25], (unsigned)bad); atomicAdd(&D[4 * 25 + 1], 2u);
    int bad2 = 0; if (W2[(size_t)k * DFFE + f] != (bf16_t)f2bf(a.in[I_OM2][(size_t)e * DFFE * 1024 + (size_t)f * 1024 + k])) ++bad2;
    atomicAdd(&D[4 * 26], (unsigned)bad2); atomicAdd(&D[4 * 26 + 1], 1u);
}
__global__ void chk_actm(Args a, unsigned* D) {
    __shared__ float ref[DFFE], fast[DFFE], hrow[1024]; __shared__ int tokf, kf;
    const int tid = threadIdx.x; const int* GI = (const int*)(a.ws + OFF_GINFO); const int nrows = GI[7], ng = nrows >> 8, g0 = ((ng - 1) / MOE_CHUNK) * MOE_CHUNK;
    const int rho = 256 * g0 + (int)(((unsigned)blockIdx.x * 2654435761u) % (unsigned)(nrows - 256 * g0));
    if (tid == 0) { tokf = -1; kf = 0; } __syncthreads();
    const int* DEST = (const int*)(a.ws + OFF_DEST);
    for (int i = tid; i < 2 * MTOK; i += 256) if (DEST[i] == rho) { tokf = i >> 1; kf = i & 1; }
    __syncthreads();
    if (tokf < 0) return;
    const int tok = tokf; const u32x2 rt = ((const u32x2*)(a.ws + OFF_ROUTE))[tok]; const int e = kf ? ((rt.x >> 8) & 255) : (rt.x & 255);
    const bf16_t* H2 = (const bf16_t*)(a.ws + OFF_H2) + (size_t)tok * 1024;
    for (int k = tid; k < 1024; k += 256) hrow[k] = bf2f(H2[k]);
    __syncthreads();
    const float* w1 = a.in[I_OM1] + (size_t)e * 1024 * DFFE; const float* w3 = a.in[I_OM3] + (size_t)e * 1024 * DFFE;
    for (int f = tid; f < DFFE; f += 256) { float s1 = 0.f, s3 = 0.f; for (int q = 0; q < 1024; ++q) { s1 += hrow[q] * bfr(w1[(size_t)q * DFFE + f]); s3 += hrow[q] * bfr(w3[(size_t)q * DFFE + f]); }
        ref[f] = s1 / (1.f + expf(-s1)) * s3; fast[f] = bf2f(((const bf16_t*)(a.ws + OFF_ACTM))[(size_t)(rho - 256 * g0) * DFFE + f]); }
    __syncthreads(); commit(D, 27, ref, fast, DFFE, 0.02f);
}

__global__ void simple_final(Args a) {
    const int row = blockIdx.x * 4 + (threadIdx.x >> 6), lane = threadIdx.x & 63; unsigned char* ws = a.ws;
    const bf16_t* H2 = (const bf16_t*)(ws + OFF_H2); const bf16_t* YR = (const bf16_t*)(ws + OFF_YR);
    const u32x2* ROUTE = (const u32x2*)(ws + OFF_ROUTE); const int* DEST = (const int*)(ws + OFF_DEST);
    const float g0 = __uint_as_float(ROUTE[row].y), g1 = 1.f - g0; const int d0 = DEST[2 * row], d1 = DEST[2 * row + 1];
    float v[16]; float s = 0.f;
    for (int i = 0; i < 16; ++i) { const int col = lane + 64 * i; v[i] = ALPHA * bf2f(H2[(size_t)row * 1024 + col]) + g0 * bf2f(YR[(size_t)d0 * 1024 + col]) + g1 * bf2f(YR[(size_t)d1 * 1024 + col]); s += v[i]; }
    const float mean = wave_sum(s) / 1024.f; float q = 0.f;
    for (int i = 0; i < 16; ++i) { v[i] -= mean; q += v[i] * v[i]; }
    const float rstd = 1.f / sqrtf(wave_sum(q) / 1024.f + 1e-5f);
    for (int i = 0; i < 16; ++i) { const int col = lane + 64 * i; a.out[(size_t)row * 1024 + col] = v[i] * rstd * a.in[I_OLN2G][col] + a.in[I_OLN2B][col]; }
}
__global__ void report(float* out, const unsigned* D, int nelem) {
    __shared__ float kk, xx;
    if (threadIdx.x == 0) { int idx = 0; float v = 0.f; float worst = 0.f;
        for (int s = 1; s < NSLOT; ++s) { const unsigned bad = D[4 * s], tot = D[4 * s + 1]; if (tot == 0u) continue; const float fr = (float)bad / (float)tot; const float thr = (s == 9 || s == 10 || s == 18) ? 0.1f : 0.002f;
            if (fr > worst) worst = fr; if (fr > thr && idx == 0) { idx = s; v = fr; } }
        if (idx == 0) v = worst;
#ifdef DBG_BITS
        { const int sl[6] = DBG_BITS; idx = 0; for (int q = 0; q < 6; ++q) { const int s = sl[q]; if (s > 0 && D[4 * s + 1] > 0u && (float)D[4 * s] / (float)D[4 * s + 1] > 0.002f) idx |= 1 << q; } v = 1.f; }
#endif
#ifdef DBG_VAL
        { const float mr = __uint_as_float(D[4 * DBG_VAL + 2]); const float fr = D[4 * DBG_VAL + 1] ? (float)D[4 * DBG_VAL] / (float)D[4 * DBG_VAL + 1] : 0.f; kk = sqrtf(fmaxf(mr, 1e-6f) * 1e6f); xx = kk * (2.f + 97.f * fr); }
#else
        v = fmaxf(v, 1e-6f); const int n = (v > 0.3f) ? 4 : (v > 0.03f) ? 3 : (v > 0.003f) ? 2 : 1; kk = (n == 4) ? 1e4f : (n == 3) ? 1e3f : (n == 2) ? 1e2f : 1e1f; xx = kk * (float)(idx + 2);
#endif
        }
    __syncthreads();
    const float k = kk, x = xx;
    for (size_t i = (size_t)blockIdx.x * blockDim.x + threadIdx.x; i < (size_t)nelem; i += (size_t)gridDim.x * blockDim.x) out[i] = (i == 0) ? x : k;
}
}
#endif

#ifndef MK_N_LAUNCHES
#define MK_N_LAUNCHES 1
#endif
constexpr int NPHASE = 18;
#define SP2 true
#ifndef FFN_F8
#define FFN_F8 0
#endif
#ifndef MOE_SP2
#define MOE_SP2 true
#endif
#define ALN true

__global__ void __launch_bounds__(NTHR, 2) fwd_kernel(Args args) {
    extern __shared__ __attribute__((aligned(16))) unsigned char lds_raw[];
    Frame F;
    F.lds = (LAS unsigned char*)lds_raw;
    F.tid = threadIdx.x; F.lane = F.tid & 63; F.wave = __builtin_amdgcn_readfirstlane(F.tid >> 6);
    F.G = gridDim.x; F.bx = blockIdx.x; F.gw = F.bx * NWAVES + F.wave; F.NGW = F.G * NWAVES; F.ws = args.ws;
    unsigned char* ws = args.ws;
    volatile LAS unsigned* MISC = (volatile LAS unsigned*)(F.lds + LDSCTL_OFF);
    for (int u = F.tid; u < (LDS_BYTES - LDSCTL_OFF) / 4; u += NTHR) ((LAS unsigned*)(F.lds + LDSCTL_OFF))[u] = 0u;
    __syncthreads();
    XcdBarrier bar = xcd_barrier_post((unsigned*)(ws + OFF_BAR) + args.li * XCD_BAR_WORDS, MISC + 8);
    const int lo = args.ph_lo, hi = args.ph_hi;
#ifndef PH_MASK
#define PH_MASK 0x3ffff
#endif
#define IN(k) (((PH_MASK >> (k)) & 1) && lo <= (k) && (k) < hi)
#ifdef TS_MODE
    unsigned long long* TS = (unsigned long long*)(ws + OFF_DBG + 1024);
#define STAMP(i) do { if (F.bx == 0 && F.tid == 0) TS[i] = __builtin_amdgcn_s_memrealtime(); } while (0)
#else
#define STAMP(i) do { } while (0)
#endif
#define SEAM(k) do { if (IN(k) && IN((k) + 1)) xcd_barrier(bar); STAMP((k) + 1); } while (0)
    LAS unsigned char* glds = F.lds;

    bf16_t* Y1 = (bf16_t*)(ws + OFF_Y1);
    float* ssq_q = (float*)(ws + OFF_SSQ_Q); float* ssq_kv = (float*)(ws + OFF_SSQ_KV);

    STAMP(0);
    if (IN(0)) { phase_prologue_even(F, args); } SEAM(0);
    if (IN(1)) { pg8::Gemm g{(const bf16_t*)(ws + OFF_XB), (const bf16_t*)(ws + OFF_W_IN), MTOK, EVEN_INP, 1024, 1024, 0}; pg8::StaticOrder S; S.init(MTOK, EVEN_INP, F.G, F.bx);
        pg8::EpiInE E{Y1, ssq_q, ssq_kv}; pg8::gemm_phase<pg8::EpiInE, pg8::StaticOrder, ALN, SP2>(glds, g, S, E); } SEAM(1);
    if (IN(2)) {
        phase_ckvn(F, Y1 + (size_t)1 * MTOK * 256, ssq_kv, args.in[I_EKVN], (bf16_t*)(ws + OFF_CKVN));
#ifndef NO_CMP
        for (int idx = F.bx; idx < 256; idx += F.G) { const int b = idx >> 5, g = (idx >> 4) & 1, kv = (idx >> 3) & 1, rt = idx & 7;
            compress_unit(F, b, g, kv, rt, Y1 + (size_t)4 * MTOK * 256, (const bf16_t*)(ws + (kv ? OFF_CV1 : OFF_CK1)), args.in[kv ? I_ECV2 : I_ECK2], (const float*)(ws + OFF_CB) + kv * 64, (bf16_t*)(ws + (kv ? OFF_VC : OFF_KC))); }
#endif
#ifndef NO_Q2
        pg8::Gemm g{Y1, (const bf16_t*)(ws + OFF_W_Q2), MTOK, 2048, 256, 256, 0}; pg8::StaticOrder S; S.init(MTOK, 2048, F.G, F.bx);
        pg8::EpiQ2 E{(bf16_t*)(ws + OFF_QLAT), (bf16_t*)(ws + OFF_QIDX), ssq_q}; pg8::gemm_phase<pg8::EpiQ2, pg8::StaticOrder, ALN, SP2>(glds, g, S, E);
#endif
    } SEAM(2);
    if (IN(3)) { for (int idx = F.bx; idx < 512; idx += F.G) { const int i = idx >> 8, v = idx & 255, b = v & 7, cc = v >> 3, c = i ? 63 - cc : cc;
            indexer_unit(F, b, c, (const bf16_t*)(ws + OFF_QIDX), Y1 + (size_t)1 * MTOK * 256, (_Float16*)(ws + OFF_SC)); } } SEAM(3);
    if (IN(4)) { phase_select(F, (const _Float16*)(ws + OFF_SC), (unsigned*)(ws + OFF_MASK)); } SEAM(4);
    if (IN(5)) {
#ifndef NO_DSA
        if (args.pad != 2) for (int idx = F.bx; idx < 1024; idx += F.G) { const int i = idx >> 8, v = idx & 255, b = v & 7, cc = v >> 3, u = (i == 0) ? cc : (i == 1) ? 63 - cc : (i == 2) ? 64 + cc : 127 - cc;
            dsa_unit(F, b, u, (const bf16_t*)(ws + OFF_QLAT), (const bf16_t*)(ws + OFF_CKVN), (const unsigned*)(ws + OFF_MASK), (const float*)(ws + OFF_BT), ws + OFF_MIXIN); __syncthreads(); }
#endif
        STAMP(20);
#ifndef NO_NSA
        if (args.pad != 1) for (int idx = F.bx; idx < 1024; idx += F.G) { const int i = idx >> 8, v = idx & 255, b = v & 7, cc = v >> 3, g = i & 1, c = (i >> 1) ? 63 - cc : cc;
            nsa_unit(F, b, g, c, Y1, (const bf16_t*)(ws + OFF_KC), (const bf16_t*)(ws + OFF_VC), (const float*)(ws + OFF_BT), ws + OFF_MIXIN); __syncthreads(); }
#endif
    } SEAM(5);
    if (IN(6)) { pg8::Gemm g{(const bf16_t*)(ws + OFF_MIXIN), (const bf16_t*)(ws + OFF_W_OUTE), MTOK, 1024, 768, 768, 0}; pg8::StaticOrder S; S.init(MTOK, 1024, F.G, F.bx);
        pg8::EpiRes<true> E{args.in[I_X], (bf16_t*)(ws + OFF_S1), 1.f / (OSC * WOUT_SCALE)}; pg8::gemm_phase<pg8::EpiRes<true>, pg8::StaticOrder, ALN, SP2, true>(glds, g, S, E); } SEAM(6);
    if (IN(7)) { phase_ln_i8(F, (const bf16_t*)(ws + OFF_S1), (bf16_t*)(ws + OFF_H), ws + OFF_H8, (float*)(ws + OFF_SA), args.in[I_ELN1G], args.in[I_ELN1B]); } SEAM(7);
#if FFN_F8
    if (IN(8)) { pg8::Gemm g{(const bf16_t*)(ws + OFF_H8), (const bf16_t*)(ws + OFF_W_F13), MTOK, 2 * DFF, 512, 512, 0}; pg8::StaticOrder S; S.init(MTOK, 2 * DFF, F.G, F.bx);
        pg8::EpiSwiglu8 E{ws + OFF_ACT, DFF, 0, 1.f / WF13_SCALE}; pg8::gemm_phase<pg8::EpiSwiglu8, pg8::StaticOrder, ALN, SP2, true>(glds, g, S, E); } SEAM(8);
#else
    if (IN(8)) { pg8::Gemm g{(const bf16_t*)(ws + OFF_H8), (const bf16_t*)(ws + OFF_W_F13), MTOK, 2 * DFF, 512, 512, 0}; pg8::StaticOrder S; S.init(MTOK, 2 * DFF, F.G, F.bx);
        pg8::EpiSwigluI8 E{ws + OFF_ACT, DFF, (const float*)(ws + OFF_SA), (const float*)(ws + OFF_SW)}; pg8::gemm_phase<pg8::EpiSwigluI8, pg8::StaticOrder, ALN, SP2, false, true>(glds, g, S, E); } SEAM(8);
#endif
#if FFN_F8
    if (IN(9)) { pg8::Gemm g{(const bf16_t*)(ws + OFF_ACT), (const bf16_t*)(ws + OFF_W_F2), MTOK, 1024, DFF / 2, DFF / 2, 0}; pg8::StaticOrder S; S.init(MTOK, 1024, F.G, F.bx);
        pg8::EpiRes<false> E{(const void*)(ws + OFF_H), (bf16_t*)(ws + OFF_S2), 1.f / WF2_SCALE}; pg8::gemm_phase<pg8::EpiRes<false>, pg8::StaticOrder, ALN, SP2, true>(glds, g, S, E); } SEAM(9);
#else
    if (IN(9)) { pg8::Gemm g{(const bf16_t*)(ws + OFF_ACT), (const bf16_t*)(ws + OFF_W_F2), MTOK, 1024, DFF / 2, DFF / 2, 0}; pg8::StaticOrder S; S.init(MTOK, 1024, F.G, F.bx);
        pg8::EpiRes<false> E{(const void*)(ws + OFF_H), (bf16_t*)(ws + OFF_S2), 1.f / WF2_SCALE}; pg8::gemm_phase<pg8::EpiRes<false>, pg8::StaticOrder, ALN, SP2, true>(glds, g, S, E); } SEAM(9);
#endif
    if (IN(10)) { phase_ln_bf16(F, (const bf16_t*)(ws + OFF_S2), (bf16_t*)(ws + OFF_X1), ws + OFF_X18, args.in[I_ELN2G], args.in[I_ELN2B]); phase_convert_odd(F, args); } SEAM(10);
    if (IN(11)) { pg8::Gemm g{(const bf16_t*)(ws + OFF_X18), (const bf16_t*)(ws + OFF_W_OIN), MTOK, 3072, 512, 512, 0}; pg8::StaticOrder S; S.init(MTOK, 3072, F.G, F.bx);
        pg8::EpiInO E{(bf16_t*)(ws + OFF_QKV), (float*)(ws + OFF_KMEAN), 1.f / WIN_SCALE}; pg8::gemm_phase<pg8::EpiInO, pg8::StaticOrder, ALN, SP2, true>(glds, g, S, E); } SEAM(11);
    if (IN(12)) { phase_moba(F, ws, args.pad); } SEAM(12);
    if (IN(13)) { pg8::Gemm g{(const bf16_t*)(ws + OFF_O8), (const bf16_t*)(ws + OFF_W_OOUT), MTOK, 1024, 512, 512, 0}; pg8::StaticOrder S; S.init(MTOK, 1024, F.G, F.bx);
        pg8::EpiRes<false> E{(const void*)(ws + OFF_X1), (bf16_t*)(ws + OFF_S1O), 1.f / (OSC * WOUT_SCALE)}; pg8::gemm_phase<pg8::EpiRes<false>, pg8::StaticOrder, ALN, SP2, true>(glds, g, S, E); } SEAM(13);
    if (IN(14)) { phase_ln_router(F, (const bf16_t*)(ws + OFF_S1O), (bf16_t*)(ws + OFF_H2), args.in[I_OLN1G], args.in[I_OLN1B], args.in[I_OROUTER], ws); } SEAM(14);
    if (IN(15)) { phase_moe_gather(F, (const bf16_t*)(ws + OFF_H2), ws + OFF_XR, ws); } SEAM(15);
    if (IN(16)) {
        const int* GI = (const int*)(ws + OFF_GINFO);
        pg8::MoeOrder S; S.G = F.G; S.c = F.bx;
#pragma unroll
        for (int e = 0; e < 8; ++e) S.pend[e] = __builtin_amdgcn_readfirstlane(GI[e]);
        const int ngroups = S.pend[7] >> 8;
        for (int g0 = 0; g0 < ngroups; g0 += MOE_CHUNK) {
            S.g0 = g0; S.ng = (ngroups - g0) < MOE_CHUNK ? (ngroups - g0) : MOE_CHUNK;
            { S.nN = 28; pg8::Gemm g{(const bf16_t*)(ws + OFF_XR), (const bf16_t*)(ws + OFF_W_M13), 0, 2 * DFFE, 512, 512, (size_t)2 * DFFE * 512};
              pg8::EpiSwiglu8 E{ws + OFF_ACTM, DFFE, g0, 1.f / W13_SCALE}; pg8::gemm_phase<pg8::EpiSwiglu8, pg8::MoeOrder, ALN, MOE_SP2, true>(glds, g, S, E); }
            xcd_barrier(bar);
            { S.nN = 4; pg8::Gemm g{(const bf16_t*)(ws + OFF_ACTM - (size_t)g0 * 256 * DFFE), (const bf16_t*)(ws + OFF_W_M2), 0, 1024, DFFE / 2, DFFE / 2, (size_t)1024 * DFFE / 2};
              pg8::EpiStoreS E{(bf16_t*)(ws + OFF_YR), 1024, 1.f / W2_SCALE}; pg8::gemm_phase<pg8::EpiStoreS, pg8::MoeOrder, ALN, MOE_SP2, true>(glds, g, S, E); }
            xcd_barrier(bar);
        }
    }
    STAMP(17);
    if (IN(17)) { phase_final(F, (const bf16_t*)(ws + OFF_H2), (const bf16_t*)(ws + OFF_YR), args.in[I_OLN2G], args.in[I_OLN2B], args.out, ws); }
#ifdef TS_MODE
    STAMP(18);
    xcd_barrier(bar);
    { const int ia[2] = TS_SEL; float d[2];
      for (int q = 0; q < 2; ++q) { const int i = ia[q]; const unsigned long long t1 = (i == 5) ? TS[20] : ((i == 25) ? TS[6] : TS[i + 1]); const unsigned long long t0 = (i == 25) ? TS[20] : TS[i]; d[q] = (float)(t1 - t0) * 0.01f; }
      const float k = sqrtf(fmaxf(d[0], 1.f)), x = 10.f * fmaxf(d[1], 1.f);
      for (size_t i = (size_t)F.bx * NTHR + F.tid; i < (size_t)MTOK * 1024; i += (size_t)F.G * NTHR) args.out[i] = (i == 0) ? x : k; }
#endif
#undef IN
#undef SEAM
}

extern "C" void kernel_launch(void* const* d_in, const int* in_sizes, int n_in, void* d_out, int out_size, void* d_ws, size_t ws_size, hipStream_t stream) {
    static int grid = 0;
    if (grid == 0) {
        if (n_in != 33 || in_sizes[0] != MTOK * DM || out_size != MTOK * DM || ws_size < WS_END) { fprintf(stderr, "kernel_launch: unexpected problem (n_in %d, in0 %d, out %d, ws %zu < %zu)\n", n_in, n_in > 0 ? in_sizes[0] : -1, out_size, ws_size, (size_t)WS_END); grid = -1; return; }
        int dev = 0, cus = 0, per_cu = 0;
        if (hipGetDevice(&dev) != hipSuccess || hipDeviceGetAttribute(&cus, hipDeviceAttributeMultiprocessorCount, dev) != hipSuccess) { grid = -1; return; }
        if (hipFuncSetAttribute((const void*)fwd_kernel, hipFuncAttributeMaxDynamicSharedMemorySize, LDS_BYTES) != hipSuccess) { fprintf(stderr, "kernel_launch: hipFuncSetAttribute failed\n"); grid = -1; return; }
        if (hipOccupancyMaxActiveBlocksPerMultiprocessor(&per_cu, (const void*)fwd_kernel, NTHR, LDS_BYTES) != hipSuccess || per_cu < 1) fprintf(stderr, "kernel_launch: occupancy query reports %d\n", per_cu);
        (void)hipGetLastError();
        grid = cus > 256 ? 256 : cus;
    }
    if (grid < 0) return;
    hipMemsetAsync(d_ws, 0, CTL_ZERO_BYTES, stream);
    Args a{};
    for (int i = 0; i < 33; ++i) a.in[i] = (const float*)d_in[i];
    a.out = (float*)d_out; a.ws = (unsigned char*)d_ws;
#if MK_N_LAUNCHES == 1
    a.ph_lo = 0; a.ph_hi = NPHASE; a.li = 0;
    hipLaunchKernelGGL(fwd_kernel, dim3(grid), dim3(NTHR), LDS_BYTES, stream, a);
#else
    for (int p = 0; p < NPHASE; ++p) { a.ph_lo = p; a.ph_hi = p + 1; a.li = p;
#ifdef REP_PHASE
        if (p == REP_PHASE) { Args a2 = a;
#ifdef REP_PAD
            a2.pad = REP_PAD;
#endif
            for (int rep = 0; rep < REP_N; ++rep) { a2.li = NPHASE + rep; hipLaunchKernelGGL(fwd_kernel, dim3(grid), dim3(NTHR), LDS_BYTES, stream, a2); } }
#endif
        hipLaunchKernelGGL(fwd_kernel, dim3(grid), dim3(NTHR), LDS_BYTES, stream, a);
#ifdef DBG_MODE
        unsigned* D = (unsigned*)((unsigned char*)d_ws + OFF_DBG); unsigned char* ws = (unsigned char*)d_ws;
        switch (p) {
            case 1: hipLaunchKernelGGL(dbg::chk_in_e, dim3(64), dim3(256), 0, stream, a, D); break;
            case 2: hipLaunchKernelGGL(dbg::chk_q2, dim3(64), dim3(256), 0, stream, a, D); hipLaunchKernelGGL(dbg::chk_cmp, dim3(96), dim3(256), 0, stream, a, D); break;
            case 3: hipLaunchKernelGGL(dbg::chk_idx, dim3(64), dim3(256), 0, stream, a, D); break;
            case 4: hipLaunchKernelGGL(dbg::chk_sel, dim3(48), dim3(256), 0, stream, a, D); break;
            case 5: hipLaunchKernelGGL(dbg::chk_dsa, dim3(64), dim3(256), 0, stream, a, D); hipLaunchKernelGGL(dbg::chk_nsa, dim3(64), dim3(256), 0, stream, a, D); break;
            case 6: hipLaunchKernelGGL(dbg::chk_out_e, dim3(32), dim3(256), 0, stream, a, D); break;
            case 7: hipLaunchKernelGGL(dbg::chk_ln, dim3(32), dim3(256), 0, stream, (const bf16_t*)(ws + OFF_S1), (const bf16_t*)(ws + OFF_H), a.in[I_ELN1G], a.in[I_ELN1B], D, 12); break;
            case 8: hipLaunchKernelGGL(dbg::chk_ffn_up, dim3(16), dim3(256), 0, stream, a, D); break;
            case 9: hipLaunchKernelGGL(dbg::chk_ffn_dn, dim3(32), dim3(256), 0, stream, a, D); break;
            case 10: hipLaunchKernelGGL(dbg::chk_ln, dim3(32), dim3(256), 0, stream, (const bf16_t*)(ws + OFF_S2), (const bf16_t*)(ws + OFF_X1), a.in[I_ELN2G], a.in[I_ELN2B], D, 15); break;
            case 10 + 100: break;
            case 11: hipLaunchKernelGGL(dbg::chk_wmoe, dim3(16), dim3(256), 0, stream, a, D); hipLaunchKernelGGL(dbg::chk_in_o, dim3(32), dim3(256), 0, stream, a, D); break;
            case 12: hipLaunchKernelGGL(dbg::chk_moba, dim3(64), dim3(256), 0, stream, a, D); break;
            case 13: hipLaunchKernelGGL(dbg::chk_out_o, dim3(32), dim3(256), 0, stream, a, D); break;
            case 14: hipLaunchKernelGGL(dbg::chk_ln, dim3(32), dim3(256), 0, stream, (const bf16_t*)(ws + OFF_S1O), (const bf16_t*)(ws + OFF_H2), a.in[I_OLN1G], a.in[I_OLN1B], D, 19); break;
            case 15: hipLaunchKernelGGL(dbg::chk_route, dim3(1), dim3(256), 0, stream, a, D); break;
            case 16: hipLaunchKernelGGL(dbg::chk_actm, dim3(8), dim3(256), 0, stream, a, D); break;
            case 17:
#ifdef DBG_SIMPLE_FINAL
                hipLaunchKernelGGL(dbg::simple_final, dim3(MTOK / 4), dim3(256), 0, stream, a);
#endif
                hipLaunchKernelGGL(dbg::chk_moe, dim3(16), dim3(256), 0, stream, a, D); hipLaunchKernelGGL(dbg::report, dim3(1024), dim3(256), 0, stream, (float*)d_out, (const unsigned*)D, out_size); break;
            default: break;
        }
#endif
    }
#endif
}
```

```cpp
#include <hip/hip_runtime.h>
#include <cstdio>
#include <cstdint>

#define LAS __attribute__((address_space(3)))
#define GAS __attribute__((address_space(1)))
typedef unsigned short bf16_t;
typedef short bf16x8 __attribute__((ext_vector_type(8)));
typedef short s16x4 __attribute__((ext_vector_type(4)));
typedef float f32x2 __attribute__((ext_vector_type(2)));
typedef float f32x4 __attribute__((ext_vector_type(4)));
typedef float f32x16 __attribute__((ext_vector_type(16)));
typedef unsigned u32x2 __attribute__((ext_vector_type(2)));
typedef unsigned u32x4 __attribute__((ext_vector_type(4)));
typedef __bf16 bf16x2_t __attribute__((ext_vector_type(2)));
typedef _Float16 f16x2_t __attribute__((ext_vector_type(2)));

constexpr int DM = 1024, NB = 8, SEQ = 4096, MTOK = NB * SEQ;
constexpr int EVEN_IN = 1768, EVEN_INP = 1792, DFF = 2816, DFFE = 3584, NEXP = 8;
constexpr float ALPHA = 1.4142135623730951f;
constexpr float LOG2E = 1.4426950408889634f;
constexpr float QSCALE = 0.125f * LOG2E;
constexpr int NWAVES = 8, NTHR = 512;

__device__ __forceinline__ unsigned f2bf(float f) { unsigned u = __builtin_bit_cast(unsigned, f); return (u + 0x7fffu + ((u >> 16) & 1u)) >> 16; }
__device__ __forceinline__ unsigned pk2(float lo, float hi) { f32x2 v = {lo, hi}; bf16x2_t b = __builtin_convertvector(v, bf16x2_t); return __builtin_bit_cast(unsigned, b); }
__device__ __forceinline__ float bf2f(unsigned short h) { return __builtin_bit_cast(float, (unsigned)h << 16); }
__device__ __forceinline__ float bflo(unsigned w) { return __builtin_bit_cast(float, w << 16); }
__device__ __forceinline__ float bfhi(unsigned w) { return __builtin_bit_cast(float, w & 0xffff0000u); }
__device__ __forceinline__ float wave_sum(float v) {
#pragma unroll
    for (int o = 1; o < 64; o <<= 1) v += __shfl_xor(v, o);
    return v;
}
#define LDS_WAIT() asm volatile("s_waitcnt lgkmcnt(0)" ::: "memory")
#define VM_WAIT() asm volatile("s_waitcnt vmcnt(0)" ::: "memory")
namespace pg8 {
#define PG8_LAS __attribute__((address_space(3)))
typedef unsigned short bf16_t;
typedef short bf16x8 __attribute__((ext_vector_type(8)));
typedef float f32x4 __attribute__((ext_vector_type(4)));
typedef unsigned u32x4 __attribute__((ext_vector_type(4)));
constexpr int BM = 256, BK = 64, HALF = 128, HTB = HALF * BK * 2  , STAGE_BYTES = 8 * HTB, NXCD = 8, WGM = 8;

__host__ __device__ __forceinline__ int lds_byte(int r, int c) { const int st = (r >> 4) * 2 + (c >> 5), rr = r & 15, cc = c & 31, ob = rr * 64 + cc * 2; return st * 1024 + (ob ^ (((ob >> 9) & 1) << 5)); }
__host__ __device__ __forceinline__ void stage_rc(int b, int& R, int& C) { const int st = b / 1024, sb = b % 1024, swz = sb ^ (((sb >> 9) & 1) << 5); R = (st >> 1) * 16 + swz / 64; C = (st & 1) * 32 + (swz % 64) / 2; }
__host__ __device__ __forceinline__ int perm32(int rho) { const int n = rho >> 4, i = rho & 15; return 8 * (i >> 2) + 4 * n + (i & 3); }

struct Unit { int pm, pn, e; };
struct Gemm { const bf16_t* A; const bf16_t* Bt; int M, N, K; int lda; size_t bstride; };

struct StaticOrder {
    int nM, nN, nwg, G, c;
    __host__ __device__ void init(int M, int N, int G_, int c_) { nM = M / BM; nN = N / BM; nwg = nM * nN; G = G_; c = c_; }
    __host__ __device__ bool next(int i, Unit& u) const {
        const long L = (long)i * G + c; if (L >= nwg) return false;
        int wgid = (int)L; { const int q = nwg / NXCD, r = nwg % NXCD, xcd = wgid % NXCD, off = wgid / NXCD; wgid = (xcd < r ? xcd * (q + 1) : r * (q + 1) + (xcd - r) * q) + off; }
        const int nig = WGM * nN, gid = wgid / nig, fm = gid * WGM, gsz = (nM - fm) < WGM ? (nM - fm) : WGM;
        u.pm = fm + ((wgid % nig) % gsz); u.pn = (wgid % nig) / gsz; u.e = 0; return true;
    }
    __device__ __forceinline__ void a_ready(const Unit&) const {}
    __device__ __forceinline__ void done(const Unit&) const {}
};


typedef int v8i32_t __attribute__((ext_vector_type(8)));
typedef int v4i32_t __attribute__((ext_vector_type(4)));
__device__ __forceinline__ v8i32_t cat8(bf16x8 lo, bf16x8 hi) { const v4i32_t a = __builtin_bit_cast(v4i32_t, lo), b = __builtin_bit_cast(v4i32_t, hi); return (v8i32_t){a[0], a[1], a[2], a[3], b[0], b[1], b[2], b[3]}; }
template <class Epi, class Sched, bool ALIGN_EPI = false, bool SP2 = false, bool F8 = false, bool I8 = false>
__device__ __forceinline__ void gemm_phase(PG8_LAS unsigned char* lds, const Gemm g, const Sched& S, const Epi& E) {
    const int tid = threadIdx.x, wid = __builtin_amdgcn_readfirstlane(tid >> 6), lane = tid & 63, wr = wid >> 2, wc = wid & 3, fr = lane & 15, fq = lane >> 4;
    const int K = g.K, nt = K / BK;
    unsigned voffA[2], voffB[2];
#pragma unroll
    for (int i = 0; i < 2; ++i) { int R, C; stage_rc(tid * 16 + i * 8192, R, C); const int Rb = Epi::PERM ? ((R & ~31) + perm32(R & 31)) : R;
        voffA[i] = (unsigned)(R * g.lda + C) * 2u; voffB[i] = (unsigned)(Rb * K + C) * 2u; }
    const size_t kstep = (size_t)(BK * 2);
    const size_t hstep = (size_t)HALF * K * 2;
    const size_t tstep = 2 * hstep;
    const size_t hstepA = (size_t)HALF * g.lda * 2, tstepA = 2 * hstepA;
    const size_t estep = g.bstride * 2;
    const unsigned ldsw = (unsigned)wid * 1024u;
    const int aoff = lds_byte(wr * 64 + fr, fq * 8), boff = lds_byte(wc * 32 + fr, fq * 8);
#define PG8_SA(b, h) (((b) * 2 + (h)) * HTB)
#define PG8_SB(b, h) ((4 + (b) * 2 + (h)) * HTB)
#define PG8_STAGE(bufoff, gbase, voff) do { _Pragma("unroll") for (int _i = 0; _i < 2; ++_i) \
        __builtin_amdgcn_global_load_lds((const unsigned*)((const char*)(gbase) + (voff)[_i]), (PG8_LAS unsigned*)(lds + (bufoff) + ldsw + _i * 8192), 16, 0, 0); } while (0)
#define PG8_LDA(dst, b, h) do { _Pragma("unroll") for (int m = 0; m < 4; ++m) _Pragma("unroll") for (int k = 0; k < 2; ++k) dst[m][k] = *(const PG8_LAS bf16x8*)(lds + PG8_SA(b, h) + aoff + m * 2048 + k * 1024); } while (0)
#define PG8_LDB(dst, b, h) do { _Pragma("unroll") for (int n = 0; n < 2; ++n) _Pragma("unroll") for (int k = 0; k < 2; ++k) dst[n][k] = *(const PG8_LAS bf16x8*)(lds + PG8_SB(b, h) + boff + n * 2048 + k * 1024); } while (0)
#define PG8_MMA(ai, bj, At, Bt) do { __builtin_amdgcn_s_setprio(1); if constexpr (I8) { _Pragma("unroll") for (int m = 0; m < 4; ++m) _Pragma("unroll") for (int n = 0; n < 2; ++n) _Pragma("unroll") for (int k = 0; k < 2; ++k) \
        asm volatile("v_mfma_i32_16x16x64_i8 %0, %1, %2, %0" : "+v"(acc[ai][bj][m][n]) : "v"(Bt[n][k]), "v"(At[m][k])); } else if constexpr (F8) { _Pragma("unroll") for (int m = 0; m < 4; ++m) _Pragma("unroll") for (int n = 0; n < 2; ++n) \
        asm volatile("v_mfma_scale_f32_16x16x128_f8f6f4 %0, %1, %2, %0, %3, %3 op_sel_hi:[0,0,0]" : "+v"(acc[ai][bj][m][n]) : "v"(cat8(Bt[n][0], Bt[n][1])), "v"(cat8(At[m][0], At[m][1])), "v"(sc8)); } else { \
        _Pragma("unroll") for (int m = 0; m < 4; ++m) _Pragma("unroll") for (int n = 0; n < 2; ++n) _Pragma("unroll") for (int k = 0; k < 2; ++k) \
        acc[ai][bj][m][n] = __builtin_amdgcn_mfma_f32_16x16x32_bf16(Bt[n][k], At[m][k], acc[ai][bj][m][n], 0, 0, 0); } __builtin_amdgcn_s_setprio(0); } while (0)
#define PG8_WAIT_V(n) asm volatile("s_waitcnt vmcnt(" #n ")" ::: "memory")
#define PG8_WAIT_L(n) asm volatile("s_waitcnt lgkmcnt(" #n ")" ::: "memory")
#define PG8_BAR __builtin_amdgcn_s_barrier()
#define PG8_SCHED __builtin_amdgcn_sched_barrier(0)
    Unit cur, nxt; int ui = 0;
    if (!S.next(0, cur)) return;
    int sc8 = 0x7f7f7f7f; asm volatile("" : "+v"(sc8));
    f32x4 acc[2][2][4][2];
#pragma unroll
    for (int a = 0; a < 2; ++a)
#pragma unroll
        for (int b = 0; b < 2; ++b)
#pragma unroll
            for (int m = 0; m < 4; ++m)
#pragma unroll
                for (int n = 0; n < 2; ++n) acc[a][b][m][n] = (f32x4){0.f, 0.f, 0.f, 0.f};
    bf16x8 At[4][2], B0[2][2], B1[2][2];
    const char* cA = (const char*)g.A + (size_t)cur.pm * tstepA; const char* cB = (const char*)g.Bt + (size_t)cur.pn * tstep + (size_t)cur.e * estep;
    S.a_ready(cur);
    if constexpr (SP2) {
        PG8_STAGE(PG8_SB(0, 0), cB, voffB); PG8_STAGE(PG8_SB(0, 1), cB + hstep, voffB); PG8_STAGE(PG8_SA(0, 0), cA, voffA); PG8_STAGE(PG8_SA(0, 1), cA + hstepA, voffA);
        if (wr == 1) PG8_BAR;
        PG8_WAIT_V(2); PG8_BAR;
        PG8_STAGE(PG8_SB(1, 0), cB + kstep, voffB); PG8_STAGE(PG8_SA(1, 0), cA + kstep, voffA); PG8_STAGE(PG8_SB(1, 1), cB + hstep + kstep, voffB);
        PG8_WAIT_V(6); PG8_BAR;
    } else {
        PG8_STAGE(PG8_SB(0, 0), cB, voffB); PG8_STAGE(PG8_SA(0, 0), cA, voffA); PG8_STAGE(PG8_SB(0, 1), cB + hstep, voffB); PG8_STAGE(PG8_SA(0, 1), cA + hstepA, voffA);
        if (wr == 1) PG8_BAR;
        PG8_WAIT_V(4); PG8_BAR;
        PG8_STAGE(PG8_SB(1, 0), cB + kstep, voffB); PG8_STAGE(PG8_SA(1, 0), cA + kstep, voffA); PG8_STAGE(PG8_SB(1, 1), cB + hstep + kstep, voffB);
        PG8_WAIT_V(6); PG8_BAR;
    }
    for (;;) {
        const bool has_next = S.next(ui + 1, nxt);
        const char* nA = has_next ? (const char*)g.A + (size_t)nxt.pm * tstepA : cA; const char* nB = has_next ? (const char*)g.Bt + (size_t)nxt.pn * tstep + (size_t)nxt.e * estep : cB;
#pragma unroll 1
        for (int t = 0; t < nt; t += 2) {
            const bool last = (t == nt - 2);
            const char* a1 = cA + (size_t)(t + 1) * kstep;
            const char* a2 = last ? nA : cA + (size_t)(t + 2) * kstep; const char* b2 = last ? nB : cB + (size_t)(t + 2) * kstep;
            const char* a3 = a2 + kstep; const char* b3 = b2 + kstep;
            if (last && has_next) S.a_ready(nxt);
            if constexpr (SP2) {
            PG8_LDB(B0, 0, 0); PG8_LDB(B1, 0, 1); PG8_SCHED; PG8_LDA(At, 0, 0); PG8_STAGE(PG8_SA(1, 1), a1 + hstepA, voffA);
            PG8_WAIT_V(8); PG8_WAIT_L(0); PG8_BAR; PG8_MMA(0, 0, At, B0); PG8_MMA(0, 1, At, B1); PG8_BAR; PG8_SCHED;
            PG8_LDA(At, 0, 1); PG8_STAGE(PG8_SB(0, 0), b2, voffB); PG8_STAGE(PG8_SB(0, 1), b2 + hstep, voffB); PG8_STAGE(PG8_SA(0, 0), a2, voffA);
            PG8_WAIT_V(8); PG8_WAIT_L(0); PG8_BAR; PG8_MMA(1, 0, At, B0); PG8_MMA(1, 1, At, B1); PG8_BAR; PG8_SCHED;
            PG8_LDB(B0, 1, 0); PG8_LDB(B1, 1, 1); PG8_SCHED; PG8_LDA(At, 1, 0); PG8_STAGE(PG8_SA(0, 1), a2 + hstepA, voffA);
            PG8_WAIT_V(8); PG8_WAIT_L(0); PG8_BAR; PG8_MMA(0, 0, At, B0); PG8_MMA(0, 1, At, B1); PG8_BAR; PG8_SCHED;
            PG8_LDA(At, 1, 1); PG8_STAGE(PG8_SB(1, 0), b3, voffB); PG8_STAGE(PG8_SB(1, 1), b3 + hstep, voffB); PG8_STAGE(PG8_SA(1, 0), a3, voffA);
            PG8_WAIT_V(8); PG8_WAIT_L(0); PG8_BAR; PG8_MMA(1, 0, At, B0); PG8_MMA(1, 1, At, B1); PG8_BAR; PG8_SCHED;
            } else {
            PG8_LDB(B0, 0, 0); PG8_SCHED; PG8_LDA(At, 0, 0); PG8_STAGE(PG8_SA(1, 1), a1 + hstepA, voffA);
            PG8_WAIT_L(8); PG8_BAR; PG8_WAIT_L(0); PG8_MMA(0, 0, At, B0); PG8_BAR; PG8_SCHED;
            PG8_LDB(B1, 0, 1); PG8_STAGE(PG8_SB(0, 0), b2, voffB);
            PG8_BAR; PG8_WAIT_L(0); PG8_MMA(0, 1, At, B1); PG8_BAR;
            PG8_LDA(At, 0, 1); PG8_STAGE(PG8_SA(0, 0), a2, voffA);
            PG8_BAR; PG8_WAIT_L(0); PG8_MMA(1, 0, At, B0); PG8_BAR; PG8_SCHED;
            PG8_STAGE(PG8_SB(0, 1), b2 + hstep, voffB);
            PG8_WAIT_V(6); PG8_BAR; PG8_MMA(1, 1, At, B1); PG8_BAR;
            PG8_LDB(B0, 1, 0); PG8_SCHED; PG8_LDA(At, 1, 0); PG8_STAGE(PG8_SA(0, 1), a2 + hstepA, voffA);
            PG8_WAIT_L(8); PG8_BAR; PG8_WAIT_L(0); PG8_MMA(0, 0, At, B0); PG8_BAR; PG8_SCHED;
            PG8_LDB(B1, 1, 1); PG8_STAGE(PG8_SB(1, 0), b3, voffB);
            PG8_BAR; PG8_WAIT_L(0); PG8_MMA(0, 1, At, B1); PG8_BAR;
            PG8_LDA(At, 1, 1); PG8_STAGE(PG8_SA(1, 0), a3, voffA);
            PG8_BAR; PG8_WAIT_L(0); PG8_MMA(1, 0, At, B0); PG8_BAR; PG8_SCHED;
            PG8_STAGE(PG8_SB(1, 1), b3 + hstep, voffB);
            PG8_WAIT_V(6); PG8_BAR; PG8_MMA(1, 1, At, B1); PG8_BAR;
            }
        }
        if constexpr (ALIGN_EPI) { if (wr == 0) PG8_BAR; }
        if constexpr (F8 || I8) asm volatile("s_nop 15\n\ts_nop 15" ::: "memory");
        if constexpr (!Epi::AFTER_DRAIN) { E(acc, cur, wr, wc, fr, fq); S.done(cur); }
        if (!has_next) break;
#pragma unroll
        for (int a = 0; a < 2; ++a)
#pragma unroll
            for (int b = 0; b < 2; ++b)
#pragma unroll
                for (int m = 0; m < 4; ++m)
#pragma unroll
                    for (int n = 0; n < 2; ++n) acc[a][b][m][n] = (f32x4){0.f, 0.f, 0.f, 0.f};
        cur = nxt; cA = nA; cB = nB; ++ui;
        if constexpr (ALIGN_EPI) { if (wr == 1) PG8_BAR; }
    }
    PG8_WAIT_V(0);
    if constexpr (!ALIGN_EPI) { if (wr == 0) PG8_BAR; }
    PG8_BAR;
    if constexpr (Epi::AFTER_DRAIN) { E.fused(acc, cur, wr, wc, fr, fq, lds, wid, lane); S.done(cur); }
#undef PG8_SA
#undef PG8_SB
#undef PG8_STAGE
#undef PG8_LDA
#undef PG8_LDB
#undef PG8_MMA
#undef PG8_WAIT_V
#undef PG8_WAIT_L
#undef PG8_BAR
#undef PG8_SCHED
}
}

namespace pg8 {
typedef f32x4 Acc[2][2][4][2];
__device__ __forceinline__ u32x4 pack8(const f32x4 v0, const f32x4 v1) { u32x4 w; w.x = pk2(v0[0], v0[1]); w.y = pk2(v0[2], v0[3]); w.z = pk2(v1[0], v1[1]); w.w = pk2(v1[2], v1[3]); return w; }
__device__ __forceinline__ void unpack8(const u32x4 w, f32x4& a, f32x4& b) { a = (f32x4){bflo(w.x), bfhi(w.x), bflo(w.y), bfhi(w.y)}; b = (f32x4){bflo(w.z), bfhi(w.z), bflo(w.w), bfhi(w.w)}; }

struct EpiInE {
    static constexpr bool PERM = true, AFTER_DRAIN = false;
    bf16_t* Y1; float* ssq_q; float* ssq_kv;
    __device__ __forceinline__ void operator()(const Acc& acc, const Unit& u, int wr, int wc, int fr, int fq) const {
        bf16_t* base = Y1 + (size_t)u.pn * MTOK * 256;
        const float sc = (u.pn == 2 || u.pn == 3) ? QSCALE : 1.f;
        const int col0 = wc * 32 + 8 * fq;
#pragma unroll
        for (int ai = 0; ai < 2; ++ai)
#pragma unroll
            for (int m = 0; m < 4; ++m) {
                const int row = u.pm * BM + ai * HALF + wr * 64 + m * 16 + fr; bf16_t* rowp = base + (size_t)row * 256 + col0;
                float s0 = 0.f, s1 = 0.f;
#pragma unroll
                for (int bj = 0; bj < 2; ++bj) { const f32x4 v0 = acc[ai][bj][m][0], v1 = acc[ai][bj][m][1];
                    const float q = (v0[0] * v0[0] + v0[1] * v0[1]) + (v0[2] * v0[2] + v0[3] * v0[3]) + (v1[0] * v1[0] + v1[1] * v1[1]) + (v1[2] * v1[2] + v1[3] * v1[3]);
                    if (bj == 0) s0 = q; else s1 = q;
                    *(u32x4*)(rowp + bj * HALF) = pack8(v0 * sc, v1 * sc); }
                if (u.pn <= 1) {
                    float s = (u.pn == 0) ? (s0 + s1) : s0;
                    s += __shfl_xor(s, 16); s += __shfl_xor(s, 32);
                    if (fq == 0) (u.pn == 0 ? ssq_q : ssq_kv)[(size_t)row * 4 + wc] = s;
                }
            }
    }
};
struct EpiQ2 {
    static constexpr bool PERM = true, AFTER_DRAIN = false;
    bf16_t* QLAT; bf16_t* QIDX; const float* ssq_q;
    __device__ __forceinline__ void operator()(const Acc& acc, const Unit& u, int wr, int wc, int fr, int fq) const {
        bf16_t* base = (u.pn < 4) ? QLAT : QIDX; const float sc0 = (u.pn < 4) ? QSCALE : 1.f;
        const int col0 = (u.pn & 3) * 256 + wc * 32 + 8 * fq;
#pragma unroll
        for (int ai = 0; ai < 2; ++ai)
#pragma unroll
            for (int m = 0; m < 4; ++m) {
                const int row = u.pm * BM + ai * HALF + wr * 64 + m * 16 + fr; bf16_t* rowp = base + (size_t)row * 1024 + col0;
                const f32x4 sq = *(const f32x4*)(ssq_q + (size_t)row * 4); const float sc = sc0 * __builtin_amdgcn_rsqf(((sq[0] + sq[1]) + (sq[2] + sq[3])) * (1.f / 256.f) + 1e-6f);
#pragma unroll
                for (int bj = 0; bj < 2; ++bj) *(u32x4*)(rowp + bj * HALF) = pack8(acc[ai][bj][m][0] * sc, acc[ai][bj][m][1] * sc);
            }
    }
};
template <bool RES_F32> struct EpiRes {
    static constexpr bool PERM = true, AFTER_DRAIN = false;
    const void* res; bf16_t* S; float sc;
    __device__ __forceinline__ void operator()(const Acc& acc, const Unit& u, int wr, int wc, int fr, int fq) const {
        const int col0 = u.pn * BM + wc * 32 + 8 * fq;
#pragma unroll
        for (int ai = 0; ai < 2; ++ai)
#pragma unroll
            for (int m = 0; m < 4; ++m) {
                const size_t off = (size_t)(u.pm * BM + ai * HALF + wr * 64 + m * 16 + fr) * 1024 + col0;
#pragma unroll
                for (int bj = 0; bj < 2; ++bj) { f32x4 r0, r1;
                    if (RES_F32) { r0 = *(const f32x4*)((const float*)res + off + bj * HALF); r1 = *(const f32x4*)((const float*)res + off + bj * HALF + 4); }
                    else unpack8(*(const u32x4*)((const bf16_t*)res + off + bj * HALF), r0, r1);
                    *(u32x4*)(S + off + bj * HALF) = pack8(r0 * ALPHA + acc[ai][bj][m][0] * sc, r1 * ALPHA + acc[ai][bj][m][1] * sc); }
            }
    }
};
struct EpiSwiglu {
    static constexpr bool PERM = true, AFTER_DRAIN = false;
    bf16_t* O; int ldo; int pm0;
    __device__ __forceinline__ void operator()(const Acc& acc, const Unit& u, int wr, int wc, int fr, int fq) const {
        const int col0 = u.pn * HALF + wc * 32 + 8 * fq;
#pragma unroll
        for (int ai = 0; ai < 2; ++ai)
#pragma unroll
            for (int m = 0; m < 4; ++m) {
                bf16_t* rowp = O + (size_t)((u.pm - pm0) * BM + ai * HALF + wr * 64 + m * 16 + fr) * ldo + col0;
                f32x4 o[2];
#pragma unroll
                for (int n = 0; n < 2; ++n) { const f32x4 a = acc[ai][0][m][n], b = acc[ai][1][m][n];
#pragma unroll
                    for (int e = 0; e < 4; ++e) o[n][e] = a[e] * __builtin_amdgcn_rcpf(1.f + __expf(-a[e])) * b[e]; }
                *(u32x4*)rowp = pack8(o[0], o[1]);
            }
    }
};
struct EpiStore {
    static constexpr bool PERM = true, AFTER_DRAIN = false;
    bf16_t* O; int ldo;
    __device__ __forceinline__ void operator()(const Acc& acc, const Unit& u, int wr, int wc, int fr, int fq) const {
        const int col0 = u.pn * BM + wc * 32 + 8 * fq;
#pragma unroll
        for (int ai = 0; ai < 2; ++ai)
#pragma unroll
            for (int m = 0; m < 4; ++m) {
                bf16_t* rowp = O + (size_t)(u.pm * BM + ai * HALF + wr * 64 + m * 16 + fr) * ldo + col0;
#pragma unroll
                for (int bj = 0; bj < 2; ++bj) *(u32x4*)(rowp + bj * HALF) = pack8(acc[ai][bj][m][0], acc[ai][bj][m][1]);
            }
    }
};
struct EpiInO {
    static constexpr bool PERM = true, AFTER_DRAIN = false;
    bf16_t* QKV; float* kmean; float isc;
    __device__ __forceinline__ void operator()(const Acc& acc, const Unit& u, int wr, int wc, int fr, int fq) const {
        const int which = u.pn >> 2; bf16_t* base = QKV + (size_t)which * MTOK * 1024; const float sc = (which == 0) ? QSCALE * isc : isc;
        const int col0 = (u.pn & 3) * BM + wc * 32 + 8 * fq;
#pragma unroll
        for (int ai = 0; ai < 2; ++ai)
#pragma unroll
            for (int m = 0; m < 4; ++m) {
                bf16_t* rowp = base + (size_t)(u.pm * BM + ai * HALF + wr * 64 + m * 16 + fr) * 1024 + col0;
#pragma unroll
                for (int bj = 0; bj < 2; ++bj) *(u32x4*)(rowp + bj * HALF) = pack8(acc[ai][bj][m][0] * sc, acc[ai][bj][m][1] * sc);
            }
        if (which == 1) {
#pragma unroll
            for (int bj = 0; bj < 2; ++bj)
#pragma unroll
                for (int n = 0; n < 2; ++n) { f32x4 s = (f32x4){0.f, 0.f, 0.f, 0.f};
#pragma unroll
                    for (int ai = 0; ai < 2; ++ai)
#pragma unroll
                        for (int m = 0; m < 4; ++m) s += acc[ai][bj][m][n];
#pragma unroll
                    for (int e = 0; e < 4; ++e) { float v = s[e]; v += __shfl_xor(v, 1); v += __shfl_xor(v, 2); v += __shfl_xor(v, 4); v += __shfl_xor(v, 8);
                        if (fr == 0) kmean[((size_t)u.pm * 2 + wr) * 1024 + col0 + bj * HALF + 4 * n + e] = v; }
                }
        }
    }
};

__device__ __forceinline__ unsigned pk4_fp8(float a, float b, float c, float d) { int w = 0; w = __builtin_amdgcn_cvt_pk_fp8_f32(a, b, w, false); w = __builtin_amdgcn_cvt_pk_fp8_f32(c, d, w, true); return (unsigned)w; }
struct EpiSwiglu8 {
    static constexpr bool PERM = true, AFTER_DRAIN = false;
    unsigned char* O; int ldo; int pm0; float isc;
    __device__ __forceinline__ void operator()(const Acc& acc, const Unit& u, int wr, int wc, int fr, int fq) const {
        const int col0 = u.pn * HALF + wc * 32 + 8 * fq;
#pragma unroll
        for (int ai = 0; ai < 2; ++ai)
#pragma unroll
            for (int m = 0; m < 4; ++m) {
                unsigned char* rowp = O + (size_t)((u.pm - pm0) * BM + ai * HALF + wr * 64 + m * 16 + fr) * ldo + col0;
                f32x4 o[2];
#pragma unroll
                for (int n = 0; n < 2; ++n) { const f32x4 a = acc[ai][0][m][n] * isc, b = acc[ai][1][m][n] * isc;
#pragma unroll
                    for (int e = 0; e < 4; ++e) o[n][e] = a[e] * __builtin_amdgcn_rcpf(1.f + __expf(-a[e])) * b[e]; }
                u32x2 w; w.x = pk4_fp8(o[0][0], o[0][1], o[0][2], o[0][3]); w.y = pk4_fp8(o[1][0], o[1][1], o[1][2], o[1][3]);
                *(u32x2*)rowp = w;
            }
    }
};

struct EpiSwigluI8 {
    static constexpr bool PERM = true, AFTER_DRAIN = false;
    unsigned char* O; int ldo; const float* sa; const float* sw;
    __device__ __forceinline__ void operator()(const Acc& acc, const Unit& u, int wr, int wc, int fr, int fq) const {
        const int col0 = u.pn * HALF + wc * 32 + 8 * fq, bcol = u.pn * BM + wc * 32 + 8 * fq;
        f32x4 w1s[2], w3s[2];
#pragma unroll
        for (int n = 0; n < 2; ++n) { w1s[n] = *(const f32x4*)(sw + bcol + 4 * n); w3s[n] = *(const f32x4*)(sw + bcol + HALF + 4 * n); }
#pragma unroll
        for (int ai = 0; ai < 2; ++ai)
#pragma unroll
            for (int m = 0; m < 4; ++m) {
                const int row = u.pm * BM + ai * HALF + wr * 64 + m * 16 + fr; const float ra = sa[row];
                unsigned char* rowp = O + (size_t)row * ldo + col0;
                f32x4 o[2];
#pragma unroll
                for (int n = 0; n < 2; ++n) {
#pragma unroll
                    for (int e = 0; e < 4; ++e) { const float xa = acc[ai][0][m][n][e], xb = acc[ai][1][m][n][e];
                        const float a = (float)__float_as_int(xa) * ra * w1s[n][e], b = (float)__float_as_int(xb) * ra * w3s[n][e];
                        o[n][e] = a * __builtin_amdgcn_rcpf(1.f + __expf(-a)) * b; } }
                u32x2 w; w.x = pk4_fp8(o[0][0], o[0][1], o[0][2], o[0][3]); w.y = pk4_fp8(o[1][0], o[1][1], o[1][2], o[1][3]);
                *(u32x2*)rowp = w;
            }
    }
};
struct EpiStoreS {
    static constexpr bool PERM = true, AFTER_DRAIN = false;
    bf16_t* O; int ldo; float sc;
    __device__ __forceinline__ void operator()(const Acc& acc, const Unit& u, int wr, int wc, int fr, int fq) const {
        const int col0 = u.pn * BM + wc * 32 + 8 * fq;
#pragma unroll
        for (int ai = 0; ai < 2; ++ai)
#pragma unroll
            for (int m = 0; m < 4; ++m) {
                bf16_t* rowp = O + (size_t)(u.pm * BM + ai * HALF + wr * 64 + m * 16 + fr) * ldo + col0;
#pragma unroll
                for (int bj = 0; bj < 2; ++bj) *(u32x4*)(rowp + bj * HALF) = pack8(acc[ai][bj][m][0] * sc, acc[ai][bj][m][1] * sc);
            }
    }
};
struct MoeOrder {
    int g0, ng, nN, G, c; int pend[8];
    __device__ __forceinline__ bool next(int i, Unit& u) const {
        const int L = i * G + c; if (L >= ng * nN) return false;
        u.pm = g0 + L % ng; u.pn = L / ng; const int r = u.pm * 256; int e = 0;
#pragma unroll
        for (int k = 0; k < 7; ++k) e += (pend[k] <= r) ? 1 : 0;
        u.e = e; return true;
    }
    __device__ __forceinline__ void a_ready(const Unit&) const {}
    __device__ __forceinline__ void done(const Unit&) const {}
};
}

#ifndef FFN_F8
#define FFN_F8 0
#endif
constexpr size_t MiB = 1u << 20, KiB = 1u << 10;
constexpr size_t CTL_ZERO_BYTES = 2 * MiB;
constexpr int    MAX_LAUNCHES = 18;
constexpr size_t OFF_BAR = 16 * KiB;
constexpr size_t OFF_WGCNT = 1 * MiB + 512 * KiB;
constexpr size_t OFF_GINFO = OFF_WGCNT + 16 * KiB;
constexpr size_t OFF_DBG = OFF_GINFO + 1 * KiB;
constexpr size_t OFF_BT = 2 * MiB;
constexpr size_t OFF_CB = 2 * MiB + 16 * KiB;
constexpr size_t OFF_ROUTE = 2 * MiB + 64 * KiB;
constexpr size_t OFF_DEST = 2 * MiB + 512 * KiB;
constexpr size_t OFF_KC = 3 * MiB, OFF_VC = 3 * MiB + 512 * KiB;
constexpr size_t OFF_W_IN = 4 * MiB, OFF_W_Q2 = OFF_W_IN + (size_t)EVEN_INP * 1024 * 2, OFF_W_OUTE = OFF_W_Q2 + 2048 * 256 * 2, OFF_W_F13 = OFF_W_OUTE + 1024 * 1536 * 2,
                 OFF_W_F2 = OFF_W_F13 + (size_t)2 * DFF * 1024 * 2, OFF_CK1 = OFF_W_F2 + (size_t)1024 * DFF * 2, OFF_CV1 = OFF_CK1 + 64 * 2048 * 2, OFF_WE_END = OFF_CV1 + 64 * 2048 * 2;
static_assert(OFF_WE_END <= 30 * MiB, "even weights");
constexpr size_t OFF_W_OIN = 30 * MiB, OFF_W_OOUT = 36 * MiB, OFF_W_M13 = 38 * MiB, OFF_W_M2 = 94 * MiB;
constexpr size_t OFF_Y1 = 30 * MiB;
constexpr size_t OFF_CKVN = 142 * MiB;
constexpr size_t OFF_XB = 206 * MiB, OFF_QLAT = 206 * MiB, OFF_QIDX = 270 * MiB;
constexpr size_t OFF_SC = 334 * MiB, OFF_MASK = 464 * MiB, OFF_MIXIN = 334 * MiB;
constexpr size_t OFF_S1 = 206 * MiB, OFF_H = 270 * MiB, OFF_ACT = 30 * MiB, OFF_S2 = 334 * MiB, OFF_X1 = 398 * MiB, OFF_H8 = 464 * MiB;
constexpr size_t OFF_SA = 497 * MiB, OFF_SW = 497 * MiB + 256 * KiB, OFF_SAX = 497 * MiB + 512 * KiB, OFF_SWIN = 497 * MiB + 768 * KiB;
constexpr size_t OFF_X18 = 464 * MiB, OFF_O8 = 464 * MiB;
constexpr float OSC = 16.f, WOUT_SCALE = 64.f, WIN_SCALE = 32.f, WF13_SCALE = 32.f, WF2_SCALE = 128.f;
constexpr size_t OFF_QKV = 206 * MiB, OFF_S1O = 270 * MiB, OFF_H2 = 122 * MiB, OFF_ACTM = 186 * MiB, OFF_YR = 298 * MiB, OFF_XR = 430 * MiB;
constexpr float W13_SCALE = 32.f, W2_SCALE = 128.f;
constexpr size_t OFF_SSQ_Q = 514 * MiB, OFF_SSQ_KV = 514 * MiB + 512 * KiB;
constexpr size_t OFF_KMEAN = 515 * MiB;
constexpr size_t WS_END = 516 * MiB;
constexpr int    MOE_CHUNK = 128;
constexpr size_t SCB_ELEMS = (size_t)64 * 64 * (64 * 65 / 2);

constexpr int LDS_BYTES = 160 * 1024;
constexpr int LDSCTL_OFF = LDS_BYTES - 512;

#define RLX_AGENT __ATOMIC_RELAXED, __HIP_MEMORY_SCOPE_AGENT
typedef GAS unsigned gu32;
#define XB_TMO      128
#define XB_XCNT(j)  (256  + 64 * (j))
#define XB_XSUB(j)  (1280 + 64 * (j))
#define XB_XGEN(j)  (2304 + 64 * (j))
#define XB_TOP      3328
#define XB_TOPGEN   3392
#define XCD_BAR_WORDS 3456
#define XB_SPIN_CAP (1u << 18)

__device__ __forceinline__ unsigned xb_ld(unsigned* p)              { return __hip_atomic_load(p, __ATOMIC_RELAXED, __HIP_MEMORY_SCOPE_AGENT); }
__device__ __forceinline__ unsigned xb_add(unsigned* p, unsigned v) { return __hip_atomic_fetch_add(p, v, __ATOMIC_RELAXED, __HIP_MEMORY_SCOPE_AGENT); }
__device__ __forceinline__ unsigned xb_xcc_id() { return (unsigned)__builtin_amdgcn_s_getreg((3 << 11) | 20) & 0xFu; }
#define XB_SPIN(cond, bar) do { unsigned _sp = 0; while (cond) { __builtin_amdgcn_s_sleep(1); \
    if ((++_sp & 255u) == 0u) { if (xb_ld(&(bar)[XB_TMO])) break; if (_sp > XB_SPIN_CAP) { atomicAdd(&(bar)[XB_TMO], 1u); break; } } } } while (0)

struct XcdBarrier {
    unsigned* bar; unsigned x;
    volatile LAS unsigned* st;
};

__device__ __forceinline__ XcdBarrier xcd_barrier_post(unsigned* bar, volatile LAS unsigned* st) {
    XcdBarrier b; b.bar = bar; b.x = xb_xcc_id(); b.st = st;
    if (threadIdx.x == 0) (void)xb_add(&bar[XB_XCNT(b.x)], 1u);
    return b;
}
__device__ __forceinline__ void xcd_barrier_complete(unsigned* bar, unsigned x, unsigned& nloc, unsigned& nx) {
    const unsigned G = gridDim.x * gridDim.y * gridDim.z;
    unsigned sum, cnt, mine, sp = 0u;
    for (;;) {
        sum = 0u; cnt = 0u; mine = 0u;
#pragma unroll
        for (unsigned j = 0; j < 16; ++j) { const unsigned c = xb_ld(&bar[XB_XCNT(j)]); sum += c; cnt += (c > 0u) ? 1u : 0u; mine = (j == x) ? c : mine; }
        if (sum == G) break;
        __builtin_amdgcn_s_sleep(1);
        if ((++sp & 255u) == 0u) { if (xb_ld(&bar[XB_TMO])) break; if (sp > XB_SPIN_CAP) { atomicAdd(&bar[XB_TMO], 1u); break; } }
    }
    nloc = mine > 0u ? mine : 1u; nx = cnt > 0u ? cnt : 1u;
}

__device__ __forceinline__ void xcd_barrier(const XcdBarrier& b) {
    asm volatile("s_waitcnt vmcnt(0)" ::: "memory");
    __syncthreads();
    if (threadIdx.x == 0) {
        unsigned* bar = b.bar;
        __builtin_amdgcn_s_waitcnt(0);
        unsigned nloc = b.st[0], nx = b.st[1];
        if (nloc == 0u) { xcd_barrier_complete(bar, b.x, nloc, nx); b.st[0] = nloc; b.st[1] = nx; }
        const unsigned old = xb_add(&bar[XB_XSUB(b.x)], 1u);
        const unsigned gen = old / nloc;
        if (old + 1u == (gen + 1u) * nloc) {
            __builtin_amdgcn_fence(__ATOMIC_RELEASE, "agent");
            asm volatile("s_waitcnt vmcnt(0)" ::: "memory");
            const unsigned og = xb_add(&bar[XB_TOP], 1u);
            const unsigned tg = og / nx;
            if (og + 1u == (tg + 1u) * nx) xb_add(&bar[XB_TOPGEN], 1u);
            else XB_SPIN(xb_ld(&bar[XB_TOPGEN]) == tg, bar);
            __builtin_amdgcn_fence(__ATOMIC_ACQUIRE, "agent");
            xb_add(&bar[XB_XGEN(b.x)], 1u);
            asm volatile("s_waitcnt vmcnt(0)" ::: "memory");
        } else {
            XB_SPIN(xb_ld(&bar[XB_XGEN(b.x)]) == gen, bar);
            __builtin_amdgcn_fence(__ATOMIC_ACQUIRE, "agent");
            asm volatile("s_waitcnt vmcnt(0)" ::: "memory");
        }
    }
    __syncthreads();
}

struct Frame {
    LAS unsigned char* lds;
    int tid, lane, wave, G, bx;
    int gw, NGW;
    unsigned char* ws;
    const float* const* in;
};
struct Args { const float* in[33]; float* out; unsigned char* ws; int ph_lo, ph_hi, li, pad; };
enum InIdx { I_X = 0, I_RELB, I_EWIN, I_EQN, I_EKVN, I_EWUQ, I_EWUK, I_EWUV, I_EWQIDX, I_EPOSK, I_EPOSV, I_ECK1, I_ECK2, I_ECV1, I_ECV2, I_EWOUT, I_ELN1G, I_ELN1B,
             I_EF1, I_EF3, I_EF2, I_ELN2G, I_ELN2B, I_OWIN, I_OWOUT, I_OLN1G, I_OLN1B, I_OROUTER, I_OM1, I_OM3, I_OM2, I_OLN2G, I_OLN2B };

template <class RowMap, class KScale>
__device__ __forceinline__ void transpose_item(const float* W, int K, int N, bf16_t* WT, int ldt, LAS float* scr, int item, int lane, RowMap rm, KScale ks) {
    const int nblk = (N + 63) >> 6, kb = item / nblk, nb = item - kb * nblk, k0 = 128 * kb, n = 64 * nb + lane;
    if (n >= N) return;
    const float* src = W + (size_t)k0 * N + n; bf16_t* dst = WT + (size_t)rm(n) * ldt + k0;
#pragma unroll 2
    for (int kk = 0; kk < 128; kk += 8) { float v[8];
#pragma unroll
        for (int i = 0; i < 8; ++i) v[i] = src[(size_t)(kk + i) * N] * ks(k0 + kk + i);
        u32x4 o; o.x = pk2(v[0], v[1]); o.y = pk2(v[2], v[3]); o.z = pk2(v[4], v[5]); o.w = pk2(v[6], v[7]);
        *(u32x4*)(dst + kk) = o; }
}
template <class RowMap>
__device__ __forceinline__ void transpose_item8(const float* W, int K, int N, unsigned char* WT, int ldt, int item, int lane, RowMap rm, float scale) {
    const int nblk = N >> 8, kb = item / nblk, nb = item - kb * nblk, k0 = 128 * kb, n = 256 * nb + 4 * lane;
    const float* src = W + (size_t)k0 * N + n;
    unsigned char* d0 = WT + (size_t)rm(n) * ldt + k0; unsigned char* d1 = WT + (size_t)rm(n + 1) * ldt + k0; unsigned char* d2 = WT + (size_t)rm(n + 2) * ldt + k0; unsigned char* d3 = WT + (size_t)rm(n + 3) * ldt + k0;
#pragma unroll 1
    for (int kk = 0; kk < 128; kk += 16) { f32x4 v[16];
#pragma unroll
        for (int i = 0; i < 16; ++i) v[i] = *(const f32x4*)(src + (size_t)(kk + i) * N) * scale;
#pragma unroll
        for (int c = 0; c < 4; ++c) { u32x4 o; o.x = pg8::pk4_fp8(v[0][c], v[1][c], v[2][c], v[3][c]); o.y = pg8::pk4_fp8(v[4][c], v[5][c], v[6][c], v[7][c]);
            o.z = pg8::pk4_fp8(v[8][c], v[9][c], v[10][c], v[11][c]); o.w = pg8::pk4_fp8(v[12][c], v[13][c], v[14][c], v[15][c]);
            *(u32x4*)((c == 0 ? d0 : c == 1 ? d1 : c == 2 ? d2 : d3) + kk) = o; } }
}
template <class RowMap>
__device__ __forceinline__ void transpose_item_i8(const float* W, int K, int N, unsigned char* WT, int ldt, float* sw, int item, int lane, RowMap rm) {
    const int c = lane & 7, kg = lane >> 3, n = 8 * item + c, ks = K >> 3, kbase = kg * ks;
    const float* src = W + (size_t)kbase * N + n; float mx = 0.f;
#pragma unroll 16
    for (int k = 0; k < ks; ++k) mx = fmaxf(mx, fabsf(src[(size_t)k * N]));
    mx = fmaxf(mx, __shfl_xor(mx, 8)); mx = fmaxf(mx, __shfl_xor(mx, 16)); mx = fmaxf(mx, __shfl_xor(mx, 32));
    mx = fmaxf(mx, 1e-20f); const float inv = 127.f / mx; const int dr = rm(n); if (kg == 0) sw[dr] = mx * (1.f / 127.f);
    unsigned char* dst = WT + (size_t)dr * ldt + kbase;
#pragma unroll 2
    for (int kk = 0; kk < ks; kk += 16) { unsigned w[4];
#pragma unroll
        for (int q = 0; q < 4; ++q) { const int q0 = (int)rintf(src[(size_t)(kk + 4 * q) * N] * inv), q1 = (int)rintf(src[(size_t)(kk + 4 * q + 1) * N] * inv), q2 = (int)rintf(src[(size_t)(kk + 4 * q + 2) * N] * inv), q3 = (int)rintf(src[(size_t)(kk + 4 * q + 3) * N] * inv);
            w[q] = (unsigned)(q0 & 255) | ((unsigned)(q1 & 255) << 8) | ((unsigned)(q2 & 255) << 16) | ((unsigned)(q3 & 255) << 24); }
        *(u32x4*)(dst + kk) = (u32x4){w[0], w[1], w[2], w[3]}; }
}
struct RowId { __device__ __forceinline__ int operator()(int n) const { return n; } };
struct KOne { __device__ __forceinline__ float operator()(int) const { return 1.f; } };
struct RowInE {
    __device__ __forceinline__ int operator()(int n) const { return n < 464 ? n : (n < 1744 ? n + 48 : n - 1744 + 464); }
};
struct RowIlv {
    int add; __device__ __forceinline__ int operator()(int n) const { return ((n >> 7) << 8) + (n & 127) + add; }
};
struct KGain { const float* g; __device__ __forceinline__ float operator()(int k) const { return g[k]; } };

__device__ __forceinline__ void store_row_i8(unsigned char* row, float* sa, int lane, const f32x4 (&v)[4]) {
    float mx = 0.f;
#pragma unroll
    for (int j = 0; j < 4; ++j) mx = fmaxf(fmaxf(mx, fmaxf(fabsf(v[j][0]), fabsf(v[j][1]))), fmaxf(fabsf(v[j][2]), fabsf(v[j][3])));
#pragma unroll
    for (int o = 1; o < 64; o <<= 1) mx = fmaxf(mx, __shfl_xor(mx, o));
    mx = fmaxf(mx, 1e-20f); const float inv = 127.f / mx;
#pragma unroll
    for (int j = 0; j < 4; ++j) { const int q0 = (int)rintf(v[j][0] * inv), q1 = (int)rintf(v[j][1] * inv), q2 = (int)rintf(v[j][2] * inv), q3 = (int)rintf(v[j][3] * inv);
        *(unsigned*)(row + 4 * lane + 256 * j) = (unsigned)(q0 & 255) | ((unsigned)(q1 & 255) << 8) | ((unsigned)(q2 & 255) << 16) | ((unsigned)(q3 & 255) << 24); }
    if (lane == 0) *sa = mx * (1.f / 127.f);
}
__device__ __forceinline__ int t5_bucket(int n) {
    if (n < 16) return n;
    int l = 16 + (int)(__logf((float)n / 16.f) / 2.0794415f * 16.f);
    return l < 31 ? l : 31;
}

__device__ __forceinline__ void phase_prologue_even(const Frame& F, const Args& a) {
    LAS float* scr = (LAS float*)(F.lds + F.wave * 8704);
    unsigned char* ws = F.ws;
    bf16_t* W_IN = (bf16_t*)(ws + OFF_W_IN); bf16_t* W_Q2 = (bf16_t*)(ws + OFF_W_Q2); unsigned char* W_OUTE = ws + OFF_W_OUTE;
    unsigned char* W_F13 = ws + OFF_W_F13; unsigned char* W_F2 = ws + OFF_W_F2; bf16_t* CK1 = (bf16_t*)(ws + OFF_CK1); bf16_t* CV1 = (bf16_t*)(ws + OFF_CV1);
    constexpr int I_IN = 8 * ((EVEN_IN + 63) / 64);
    constexpr int I_QI = 2 * 16;
    constexpr int I_OB = 4 * 4;
    constexpr int I_F1 = DFF / 8, I_F2 = (DFF / 128) * 4;
    constexpr int I_CK = 16 * 1;
    constexpr int NIT = I_IN + I_QI + I_OB + 2 * I_F1 + I_F2 + 2 * I_CK;
    for (int it = F.gw; it < NIT; it += F.NGW) {
        int r = it;
        if (r < I_IN) { transpose_item(a.in[I_EWIN], 1024, EVEN_IN, W_IN, 1024, scr, r, F.lane, RowInE{}, KOne{}); continue; } r -= I_IN;
        if (r < I_QI) { transpose_item(a.in[I_EWQIDX], 256, 1024, W_Q2 + 1024 * 256, 256, scr, r, F.lane, RowId{}, KGain{a.in[I_EQN]}); continue; } r -= I_QI;
        if (r < I_OB) { transpose_item8(a.in[I_EWOUT] + 512 * 1024, 512, 1024, W_OUTE + 1024, 1536, r, F.lane, RowId{}, WOUT_SCALE); continue; } r -= I_OB;
#if FFN_F8
        if (r < I_F1) { transpose_item8(a.in[I_EF1], 1024, DFF, W_F13, 1024, r, F.lane, RowIlv{0}, WF13_SCALE); continue; } r -= I_F1;
        if (r < I_F1) { transpose_item8(a.in[I_EF3], 1024, DFF, W_F13, 1024, r, F.lane, RowIlv{128}, WF13_SCALE); continue; } r -= I_F1;
        if (r < I_F2) { transpose_item8(a.in[I_EF2], DFF, 1024, W_F2, DFF, r, F.lane, RowId{}, WF2_SCALE); continue; } r -= I_F2;
#else
        if (r < I_F1) { transpose_item_i8(a.in[I_EF1], 1024, DFF, W_F13, 1024, (float*)(ws + OFF_SW), r, F.lane, RowIlv{0}); continue; } r -= I_F1;
        if (r < I_F1) { transpose_item_i8(a.in[I_EF3], 1024, DFF, W_F13, 1024, (float*)(ws + OFF_SW), r, F.lane, RowIlv{128}); continue; } r -= I_F1;
        if (r < I_F2) { transpose_item8(a.in[I_EF2], DFF, 1024, W_F2, DFF, r, F.lane, RowId{}, WF2_SCALE); continue; } r -= I_F2;
#endif
        if (r < I_CK) { transpose_item(a.in[I_ECK1], 2048, 64, CK1, 2048, scr, r, F.lane, RowId{}, KOne{}); continue; } r -= I_CK;
        transpose_item(a.in[I_ECV1], 2048, 64, CV1, 2048, scr, r, F.lane, RowId{}, KOne{});
    }
    const int gt = F.bx * NTHR + F.tid, NGT = F.G * NTHR;
    for (int i = gt; i < 24 * 1024 / 8; i += NGT) ((u32x4*)(W_IN + 488 * 1024))[i] = (u32x4){0u, 0u, 0u, 0u};
    { const float* uq = a.in[I_EWUQ]; const float* uk = a.in[I_EWUK]; const float* qg = a.in[I_EQN];
      for (int o = gt; o < 1024 * 256; o += NGT) { const int r = o & 255, hc = o >> 8, h = hc >> 7, c = hc & 127; const float* p = uq + r * 512 + h * 64; const float* q = uk + c * 512 + h * 64; float s = 0.f;
#pragma unroll 8
          for (int d = 0; d < 64; ++d) s += p[d] * q[d];
          W_Q2[o] = (bf16_t)f2bf(s * qg[r]); } }
    { const float* uv = a.in[I_EWUV]; const float* wo = a.in[I_EWOUT];
      for (int o = gt; o < 1024 * 1024 / 16; o += NGT) { const int nb = o & 255, hc4 = o >> 8, h = hc4 >> 5, c0 = (hc4 & 31) * 4, n0 = nb * 4;
          const float* p = uv + (size_t)c0 * 512 + h * 64; const float* q = wo + (size_t)(h * 64) * 1024 + n0;
          f32x4 acc4[4] = {(f32x4){0.f, 0.f, 0.f, 0.f}, (f32x4){0.f, 0.f, 0.f, 0.f}, (f32x4){0.f, 0.f, 0.f, 0.f}, (f32x4){0.f, 0.f, 0.f, 0.f}};
#pragma unroll 4
          for (int d = 0; d < 64; ++d) { const f32x4 qv = *(const f32x4*)(q + (size_t)d * 1024);
#pragma unroll
              for (int cc = 0; cc < 4; ++cc) acc4[cc] += qv * p[cc * 512 + d]; }
#pragma unroll
          for (int cc = 0; cc < 4; ++cc)
#pragma unroll
              for (int e = 0; e < 4; ++e) W_OUTE[(size_t)(n0 + e) * 1536 + h * 128 + c0 + cc] = (unsigned char)(__builtin_amdgcn_cvt_pk_fp8_f32(acc4[cc][e] * WOUT_SCALE, 0.f, 0, false) & 0xff); } }
    if (F.bx == 0) { float* BT = (float*)(ws + OFF_BT); const float* rb = a.in[I_RELB];
        for (int i = F.tid; i < 16 * 128; i += NTHR) { const int h = i >> 7, d = i & 127; BT[i] = rb[t5_bucket(d) * 16 + h] * LOG2E; } }
    if (F.bx == 1 && F.tid < 128) { const int kv = F.tid >> 6, e = F.tid & 63; const float* pos = a.in[kv ? I_EPOSV : I_EPOSK]; const float* w1 = a.in[kv ? I_ECV1 : I_ECK1]; float s = 0.f;
        for (int k = 0; k < 2048; ++k) s += pos[k] * w1[k * 64 + e];
        ((float*)(ws + OFF_CB))[F.tid] = s; }
    { const f32x4* x4 = (const f32x4*)a.in[I_X]; u32x4* xb = (u32x4*)(ws + OFF_XB);
      for (int i = gt; i < MTOK * 1024 / 8; i += NGT) { const f32x4 v0 = x4[2 * i], v1 = x4[2 * i + 1]; xb[i] = pg8::pack8(v0, v1); } }
}

__device__ __forceinline__ void phase_convert_odd(const Frame& F, const Args& a) {
    LAS float* scr = (LAS float*)(F.lds + F.wave * 8704);
    unsigned char* ws = F.ws;
    unsigned char* W_OIN = ws + OFF_W_OIN; unsigned char* W_OOUT = ws + OFF_W_OOUT; unsigned char* W_M13 = ws + OFF_W_M13; unsigned char* W_M2 = ws + OFF_W_M2;
    constexpr int I_IN = 8 * 12, I_OUT = 8 * 4, I_M1 = 8 * (DFFE / 256), I_M2 = (DFFE / 128) * 4;
    constexpr int NIT = I_IN + I_OUT + NEXP * (2 * I_M1 + I_M2);
    for (int it = F.gw; it < NIT; it += F.NGW) {
        int r = it;
        if (r < I_IN) { transpose_item8(a.in[I_OWIN], 1024, 3072, W_OIN, 1024, r, F.lane, RowId{}, WIN_SCALE); continue; } r -= I_IN;
        if (r < I_OUT) { transpose_item8(a.in[I_OWOUT], 1024, 1024, W_OOUT, 1024, r, F.lane, RowId{}, WOUT_SCALE); continue; } r -= I_OUT;
        const int e = r / (2 * I_M1 + I_M2); r -= e * (2 * I_M1 + I_M2);
        if (r < I_M1) { transpose_item8(a.in[I_OM1] + (size_t)e * 1024 * DFFE, 1024, DFFE, W_M13 + (size_t)e * 2 * DFFE * 1024, 1024, r, F.lane, RowIlv{0}, W13_SCALE); continue; } r -= I_M1;
        if (r < I_M1) { transpose_item8(a.in[I_OM3] + (size_t)e * 1024 * DFFE, 1024, DFFE, W_M13 + (size_t)e * 2 * DFFE * 1024, 1024, r, F.lane, RowIlv{128}, W13_SCALE); continue; } r -= I_M1;
        transpose_item8(a.in[I_OM2] + (size_t)e * DFFE * 1024, DFFE, 1024, W_M2 + (size_t)e * 1024 * DFFE, DFFE, r, F.lane, RowId{}, W2_SCALE);
    }
}

__device__ __forceinline__ void load_row_bf16(const bf16_t* row, int lane, f32x4 (&v)[4]) {
#pragma unroll
    for (int j = 0; j < 4; ++j) { const u32x2 w = *(const u32x2*)(row + 4 * lane + 256 * j); v[j] = (f32x4){bflo(w.x), bfhi(w.x), bflo(w.y), bfhi(w.y)}; }
}
__device__ __forceinline__ void store_row_bf16(bf16_t* row, int lane, const f32x4 (&v)[4]) {
#pragma unroll
    for (int j = 0; j < 4; ++j) { u32x2 w; w.x = pk2(v[j][0], v[j][1]); w.y = pk2(v[j][2], v[j][3]); *(u32x2*)(row + 4 * lane + 256 * j) = w; }
}
__device__ __forceinline__ void ln_inplace(f32x4 (&v)[4], const f32x4 (&g)[4], const f32x4 (&b)[4]) {
    float s = 0.f;
#pragma unroll
    for (int j = 0; j < 4; ++j) s += (v[j][0] + v[j][1]) + (v[j][2] + v[j][3]);
    const float mean = wave_sum(s) * (1.f / 1024.f); float q = 0.f;
#pragma unroll
    for (int j = 0; j < 4; ++j) { v[j] = v[j] - mean; q += (v[j][0] * v[j][0] + v[j][1] * v[j][1]) + (v[j][2] * v[j][2] + v[j][3] * v[j][3]); }
    const float rstd = 1.f / sqrtf(wave_sum(q) * (1.f / 1024.f) + 1e-5f);
#pragma unroll
    for (int j = 0; j < 4; ++j) v[j] = v[j] * rstd * g[j] + b[j];
}
__device__ __forceinline__ void load_gb(const float* g, const float* b, int lane, f32x4 (&gv)[4], f32x4 (&bv)[4]) {
#pragma unroll
    for (int j = 0; j < 4; ++j) { gv[j] = *(const f32x4*)(g + 4 * lane + 256 * j); bv[j] = *(const f32x4*)(b + 4 * lane + 256 * j); }
}
__device__ __forceinline__ void store_row_fp8(unsigned char* row, int lane, const f32x4 (&v)[4]) {
#pragma unroll
    for (int j = 0; j < 4; ++j) *(unsigned*)(row + 4 * lane + 256 * j) = pg8::pk4_fp8(v[j][0], v[j][1], v[j][2], v[j][3]);
}
__device__ __forceinline__ void phase_ln_bf16(const Frame& F, const bf16_t* S, bf16_t* O, unsigned char* O8, const float* g, const float* b) {
    f32x4 gv[4], bv[4]; load_gb(g, b, F.lane, gv, bv);
    for (int row = F.gw; row < MTOK; row += F.NGW) { f32x4 v[4]; load_row_bf16(S + (size_t)row * 1024, F.lane, v); ln_inplace(v, gv, bv); store_row_bf16(O + (size_t)row * 1024, F.lane, v); store_row_fp8(O8 + (size_t)row * 1024, F.lane, v); }
}
__device__ __forceinline__ void phase_ln_i8(const Frame& F, const bf16_t* S, bf16_t* O, unsigned char* O8, float* sa, const float* g, const float* b) {
    f32x4 gv[4], bv[4]; load_gb(g, b, F.lane, gv, bv);
    for (int row = F.gw; row < MTOK; row += F.NGW) { f32x4 v[4]; load_row_bf16(S + (size_t)row * 1024, F.lane, v); ln_inplace(v, gv, bv); store_row_bf16(O + (size_t)row * 1024, F.lane, v); store_row_i8(O8 + (size_t)row * 1024, sa + row, F.lane, v); }
}
__device__ __forceinline__ void phase_ckvn(const Frame& F, const bf16_t* T1, const float* ssq_kv, const float* gain, bf16_t* CKVN) {
    const float g0 = gain[2 * F.lane], g1 = gain[2 * F.lane + 1];
    for (int row = F.gw; row < MTOK; row += F.NGW) {
        const unsigned w = *(const unsigned*)(T1 + (size_t)row * 256 + 2 * F.lane);
        const f32x4 sq = *(const f32x4*)(ssq_kv + (size_t)row * 4); const float r = __builtin_amdgcn_rsqf(((sq[0] + sq[1]) + (sq[2] + sq[3])) * (1.f / 128.f) + 1e-6f);
        *(unsigned*)(CKVN + (size_t)row * 128 + 2 * F.lane) = pk2(bflo(w) * r * g0, bfhi(w) * r * g1);
    }
}
__device__ __forceinline__ void phase_ln_router(const Frame& F, const bf16_t* S, bf16_t* H2, const float* g, const float* b, const float* router, unsigned char* ws) {
    LAS int* cnt = (LAS int*)(F.lds);
    if (F.tid < 8) cnt[F.tid] = 0;
    __syncthreads();
    f32x4 gv[4], bv[4]; load_gb(g, b, F.lane, gv, bv);
    u32x2* ROUTE = (u32x2*)(ws + OFF_ROUTE);
    f32x4 rw[16][2];
#pragma unroll
    for (int j = 0; j < 4; ++j)
#pragma unroll
        for (int e = 0; e < 4; ++e) { const float* rp = router + (size_t)(4 * F.lane + 256 * j + e) * 8; rw[4 * j + e][0] = *(const f32x4*)rp; rw[4 * j + e][1] = *(const f32x4*)(rp + 4); }
    const bool b0 = F.lane & 1, b1 = F.lane & 2, b2 = F.lane & 4;
    for (int row = F.gw; row < MTOK; row += F.NGW) {
        f32x4 v[4]; load_row_bf16(S + (size_t)row * 1024, F.lane, v); ln_inplace(v, gv, bv); store_row_bf16(H2 + (size_t)row * 1024, F.lane, v);
        float pl[8];
#pragma unroll
        for (int x = 0; x < 8; ++x) pl[x] = 0.f;
#pragma unroll
        for (int j = 0; j < 4; ++j)
#pragma unroll
            for (int e = 0; e < 4; ++e) { const f32x4 r0 = rw[4 * j + e][0], r1 = rw[4 * j + e][1]; const float hv = v[j][e];
                pl[0] += hv * r0[0]; pl[1] += hv * r0[1]; pl[2] += hv * r0[2]; pl[3] += hv * r0[3]; pl[4] += hv * r1[0]; pl[5] += hv * r1[1]; pl[6] += hv * r1[2]; pl[7] += hv * r1[3]; }
        float k4[4], k2[2], k1;
#pragma unroll
        for (int i = 0; i < 4; ++i) { const float send = b0 ? pl[i] : pl[i + 4]; k4[i] = (b0 ? pl[i + 4] : pl[i]) + __shfl_xor(send, 1); }
#pragma unroll
        for (int i = 0; i < 2; ++i) { const float send = b1 ? k4[i] : k4[i + 2]; k2[i] = (b1 ? k4[i + 2] : k4[i]) + __shfl_xor(send, 2); }
        { const float send = b2 ? k2[0] : k2[1]; k1 = (b2 ? k2[1] : k2[0]) + __shfl_xor(send, 4); }
        k1 += __shfl_xor(k1, 8); k1 += __shfl_xor(k1, 16); k1 += __shfl_xor(k1, 32);
        float lg[8];
#pragma unroll
        for (int x = 0; x < 8; ++x) lg[x] = __int_as_float(__builtin_amdgcn_readlane(__float_as_int(k1), (x >> 2) | (((x >> 1) & 1) << 1) | ((x & 1) << 2)));
        int e0 = 0; float l0 = lg[0];
#pragma unroll
        for (int x = 1; x < 8; ++x) if (lg[x] > l0) { l0 = lg[x]; e0 = x; }
        int e1 = -1; float l1 = -INFINITY;
#pragma unroll
        for (int x = 0; x < 8; ++x) if (x != e0 && lg[x] > l1) { l1 = lg[x]; e1 = x; }
        const float g0 = 1.f / (1.f + __expf(l1 - l0));
        if (F.lane == 0) { u32x2 r; r.x = (unsigned)e0 | ((unsigned)e1 << 8); r.y = __builtin_bit_cast(unsigned, g0); ROUTE[row] = r;
            __hip_atomic_fetch_add(cnt + e0, 1, __ATOMIC_RELAXED, __HIP_MEMORY_SCOPE_WORKGROUP); __hip_atomic_fetch_add(cnt + e1, 1, __ATOMIC_RELAXED, __HIP_MEMORY_SCOPE_WORKGROUP); }
    }
    __syncthreads();
    if (F.tid < 8) ((int*)(ws + OFF_WGCNT))[F.bx * 8 + F.tid] = cnt[F.tid];
    __syncthreads();
}
__device__ __forceinline__ void phase_moe_gather(const Frame& F, const bf16_t* H2, unsigned char* XR, unsigned char* ws) {
    LAS int* L = (LAS int*)(F.lds);
    const int* WGCNT = (const int*)(ws + OFF_WGCNT);
    { const int e = F.wave; int t = 0, p = 0;
#pragma unroll
      for (int k = 0; k < 4; ++k) { const int wg = F.lane + 64 * k; const int c = (wg < F.G) ? WGCNT[wg * 8 + e] : 0; t += c; p += (wg < F.bx) ? c : 0; }
      t = (int)wave_sum((float)t); p = (int)wave_sum((float)p);
      if (F.lane == 0) { L[e] = t; L[8 + e] = p; L[24 + e] = 0; } }
    __syncthreads();
    if (F.tid == 0) { int acc = 0;
        for (int e = 0; e < 8; ++e) { const int pad = (L[e] + 255) / 256 * 256; L[32 + e] = acc; L[16 + e] = acc + L[8 + e]; acc += pad; L[40 + e] = acc; }
        if (F.bx == 0) { int* GI = (int*)(ws + OFF_GINFO); for (int e = 0; e < 8; ++e) { GI[e] = L[40 + e]; GI[8 + e] = L[e]; } } }
    __syncthreads();
    const u32x2* ROUTE = (const u32x2*)(ws + OFF_ROUTE); int* DEST = (int*)(ws + OFF_DEST);
    for (int row = F.gw; row < MTOK; row += F.NGW) {
        const u32x2 r = ROUTE[row]; const int e0 = r.x & 255, e1 = (r.x >> 8) & 255; int s0 = 0, s1 = 0;
        if (F.lane == 0) { s0 = L[16 + e0] + __hip_atomic_fetch_add(L + 24 + e0, 1, __ATOMIC_RELAXED, __HIP_MEMORY_SCOPE_WORKGROUP); s1 = L[16 + e1] + __hip_atomic_fetch_add(L + 24 + e1, 1, __ATOMIC_RELAXED, __HIP_MEMORY_SCOPE_WORKGROUP);
            DEST[2 * row] = s0; DEST[2 * row + 1] = s1; }
        s0 = __builtin_amdgcn_readfirstlane(s0); s1 = __builtin_amdgcn_readfirstlane(s1);
        const u32x4* src = (const u32x4*)(H2 + (size_t)row * 1024) + 2 * F.lane; const u32x4 a = src[0], b = src[1];
        u32x4 o; o.x = pg8::pk4_fp8(bflo(a.x), bfhi(a.x), bflo(a.y), bfhi(a.y)); o.y = pg8::pk4_fp8(bflo(a.z), bfhi(a.z), bflo(a.w), bfhi(a.w));
        o.z = pg8::pk4_fp8(bflo(b.x), bfhi(b.x), bflo(b.y), bfhi(b.y)); o.w = pg8::pk4_fp8(bflo(b.z), bfhi(b.z), bflo(b.w), bfhi(b.w));
        ((u32x4*)(XR + (size_t)s0 * 1024))[F.lane] = o; ((u32x4*)(XR + (size_t)s1 * 1024))[F.lane] = o;
    }
    for (int e = 0; e < 8; ++e) { const int r0 = L[32 + e] + L[e], npad = L[40 + e] - r0;
        for (int i = F.gw; i < npad; i += F.NGW) { u32x4* d = (u32x4*)(XR + (size_t)(r0 + i) * 1024); d[F.lane] = (u32x4){0u, 0u, 0u, 0u}; } }
    __syncthreads();
}
__device__ __forceinline__ void phase_final(const Frame& F, const bf16_t* H2, const bf16_t* YR, const float* g, const float* b, float* out, unsigned char* ws) {
    f32x4 gv[4], bv[4]; load_gb(g, b, F.lane, gv, bv);
    const u32x2* ROUTE = (const u32x2*)(ws + OFF_ROUTE); const int* DEST = (const int*)(ws + OFF_DEST);
    for (int row = F.gw; row < MTOK; row += F.NGW) {
        const u32x2 rte = ROUTE[row]; const float g0 = __uint_as_float(rte.y), g1 = 1.f - g0;   const int d0 = DEST[2 * row], d1 = DEST[2 * row + 1];
        f32x4 v[4], y0[4], y1[4]; load_row_bf16(H2 + (size_t)row * 1024, F.lane, v); load_row_bf16(YR + (size_t)d0 * 1024, F.lane, y0); load_row_bf16(YR + (size_t)d1 * 1024, F.lane, y1);
#pragma unroll
        for (int j = 0; j < 4; ++j) v[j] = v[j] * ALPHA + y0[j] * g0 + y1[j] * g1;
        ln_inplace(v, gv, bv);
#pragma unroll
        for (int j = 0; j < 4; ++j) *(f32x4*)(out + (size_t)row * 1024 + 4 * F.lane + 256 * j) = v[j];
    }
}

namespace att {
constexpr float NEG_BIG = -1e30f;
constexpr int KS64 = 144, VS64 = 192, KT64 = 64 * KS64, VT64 = 64 * VS64;
constexpr int KS128 = 272, VS128 = 320, KT128 = 64 * KS128, VT128 = 64 * VS128;
typedef LAS char* lptr; typedef const LAS char* lcptr;
typedef short v4i16_t __attribute__((ext_vector_type(4)));
__device__ __forceinline__ s16x4 vtr(lcptr p) { return __builtin_bit_cast(s16x4, __builtin_amdgcn_ds_read_tr16_b64_v4i16((LAS v4i16_t*)p)); }
__device__ __forceinline__ f32x16 splat16(float c) { f32x16 v;
#pragma unroll
    for (int r = 0; r < 16; ++r) v[r] = c; return v; }
__device__ __forceinline__ int crow(int r, int hi) { return (r & 3) + 8 * (r >> 2) + 4 * hi; }
__device__ __forceinline__ float ex2(float x) { return __builtin_amdgcn_exp2f(x); }

template <int NKS> __device__ __forceinline__ void qk(f32x16& s0, f32x16& s1, lcptr Kt, int kstride, const bf16x8 (&qf)[NKS], float c0, int r32, int hi) {
    s0 = splat16(c0); s1 = splat16(c0);
    lcptr p0 = Kt + r32 * kstride + hi * 16; lcptr p1 = p0 + 32 * kstride;
#pragma unroll
    for (int ks = 0; ks < NKS; ++ks) { const bf16x8 k0 = *(const LAS bf16x8*)(p0 + ks * 32), k1 = *(const LAS bf16x8*)(p1 + ks * 32);
        s0 = __builtin_amdgcn_mfma_f32_32x32x16_bf16(k0, qf[ks], s0, 0, 0, 0); s1 = __builtin_amdgcn_mfma_f32_32x32x16_bf16(k1, qf[ks], s1, 0, 0, 0); }
}
__device__ __forceinline__ float rowmax32(const f32x16& s0, const f32x16& s1) {
    float a = fmaxf(s0[0], s1[0]);
#pragma unroll
    for (int r = 1; r < 16; ++r) a = fmaxf(a, fmaxf(s0[r], s1[r]));
    return fmaxf(a, __shfl_xor(a, 32));
}
template <int NDT> __device__ __forceinline__ void softmax_step(f32x16& s0, f32x16& s1, float& m, float& l, f32x16 (&o)[NDT]) {
    const float mn = fmaxf(m, rowmax32(s0, s1)); float rs = 0.f;
    if (__any(mn > m)) {
        const float al = ex2(m - mn); l *= al;
#pragma unroll
        for (int d = 0; d < NDT; ++d)
#pragma unroll
            for (int r = 0; r < 16; ++r) o[d][r] *= al;
    }
    m = mn;
#pragma unroll
    for (int r = 0; r < 16; ++r) { s0[r] = ex2(s0[r] - mn); s1[r] = ex2(s1[r] - mn); rs += s0[r] + s1[r]; }
    l += rs;
}
__device__ __forceinline__ bf16x8 pack_p(const f32x16& s, int base) { u32x4 w; w.x = pk2(s[base], s[base + 1]); w.y = pk2(s[base + 2], s[base + 3]); w.z = pk2(s[base + 4], s[base + 5]); w.w = pk2(s[base + 6], s[base + 7]); return __builtin_bit_cast(bf16x8, w); }
template <int NDT> __device__ __forceinline__ void pv(f32x16 (&o)[NDT], const f32x16& s0, const f32x16& s1, lcptr Vt, int vstride, int lane) {
    const bf16x8 pk[4] = {pack_p(s0, 0), pack_p(s0, 8), pack_p(s1, 0), pack_p(s1, 8)};
    const int h = lane >> 5, g = (lane >> 4) & 1, q = (lane & 15) >> 2, p = lane & 3;
    lcptr vb = Vt + (4 * h + q) * vstride + (16 * g + 4 * p) * 2;
#pragma unroll
    for (int k = 0; k < 4; ++k)
#pragma unroll
        for (int d = 0; d < NDT; ++d) { const s16x4 lo = vtr(vb + (16 * k) * vstride + d * 64), hh = vtr(vb + (16 * k + 8) * vstride + d * 64);
            const bf16x8 vf = (bf16x8){lo[0], lo[1], lo[2], lo[3], hh[0], hh[1], hh[2], hh[3]};
            o[d] = __builtin_amdgcn_mfma_f32_32x32x16_bf16(vf, pk[k], o[d], 0, 0, 0); }
}

__device__ __forceinline__ void exp_step(f32x16& s0, f32x16& s1, float& l) {
    float rs = 0.f;
#pragma unroll
    for (int r = 0; r < 16; ++r) { s0[r] = ex2(s0[r]); s1[r] = ex2(s1[r]); rs += s0[r] + s1[r]; }
    l += rs;
}
__device__ __forceinline__ void bias_mask_near(f32x16& s0, f32x16& s1, const LAS float* bt, int t, int kp0, int hi, unsigned maxdist) {
#pragma unroll
    for (int q4 = 0; q4 < 4; ++q4) {
        float bb[8]; f32x16& s = (q4 & 2) ? s1 : s0; const int r0 = 8 * (q4 & 1), kq = kp0 + 32 * (q4 >> 1);
#pragma unroll
        for (int r = 0; r < 8; ++r) { const int d = t - (kq + crow(r0 + r, hi)); const unsigned ix = (unsigned)d < 127u ? (unsigned)d : 127u; bb[r] = bt[ix]; }
#pragma unroll
        for (int r = 0; r < 8; ++r) asm volatile("" : "+v"(bb[r]));
#pragma unroll
        for (int r = 0; r < 8; ++r) { const int d = t - (kq + crow(r0 + r, hi)); s[r0 + r] = ((unsigned)d < maxdist) ? s[r0 + r] + bb[r] : -INFINITY; }
    }
}
__device__ __forceinline__ void mask_all(f32x16& s0, f32x16& s1) {
#pragma unroll
    for (int r = 0; r < 16; ++r) { s0[r] = -INFINITY; s1[r] = -INFINITY; }
}
__device__ __forceinline__ void store_o64(bf16_t* orow, const f32x16 (&o)[2], float sc, int hi) {
#pragma unroll
    for (int d = 0; d < 2; ++d)
#pragma unroll
        for (int rg = 0; rg < 4; ++rg) { u32x2 w; w.x = pk2(o[d][4 * rg] * sc, o[d][4 * rg + 1] * sc); w.y = pk2(o[d][4 * rg + 2] * sc, o[d][4 * rg + 3] * sc);
            *(u32x2*)(orow + 32 * d + 8 * rg + 4 * hi) = w; }
}
__device__ __forceinline__ void store_o64_fp8(unsigned char* orow, const f32x16 (&o)[2], float sc, int hi) {
#pragma unroll
    for (int d = 0; d < 2; ++d)
#pragma unroll
        for (int rg = 0; rg < 4; ++rg) *(unsigned*)(orow + 32 * d + 8 * rg + 4 * hi) = pg8::pk4_fp8(o[d][4 * rg] * sc, o[d][4 * rg + 1] * sc, o[d][4 * rg + 2] * sc, o[d][4 * rg + 3] * sc);
}
template <class Src, class Proc> __device__ __forceinline__ void tile_loop64(int tid, lptr base, int nt, int pitch, Src src, Proc proc) {
    if (nt <= 0) return;
    const int row = tid >> 3, ch = tid & 7; u32x4 kr, vr;
    lptr Kb = base, Vb = base + 2 * KT64;
    { const bf16_t *kp, *vp; src(0, kp, vp); kr = *(const u32x4*)(kp + (size_t)row * pitch + ch * 8); vr = *(const u32x4*)(vp + (size_t)row * pitch + ch * 8); }
    *(LAS u32x4*)(Kb + row * KS64 + ch * 16) = kr; *(LAS u32x4*)(Vb + row * VS64 + ch * 16) = vr;
    __syncthreads();
    for (int i = 0; i < nt; ++i) {
        const bool more = i + 1 < nt;
        if (more) { const bf16_t *kp, *vp; src(i + 1, kp, vp); kr = *(const u32x4*)(kp + (size_t)row * pitch + ch * 8); vr = *(const u32x4*)(vp + (size_t)row * pitch + ch * 8); }
        proc(i, (lcptr)(Kb + (i & 1) * KT64), (lcptr)(Vb + (i & 1) * VT64));
        if (more) { *(LAS u32x4*)(Kb + ((i + 1) & 1) * KT64 + row * KS64 + ch * 16) = kr; *(LAS u32x4*)(Vb + ((i + 1) & 1) * VT64 + row * VS64 + ch * 16) = vr; }
        __syncthreads();
    }
}

template <int ROWB, int KSTR, int VSTR, int VAR = 0, class SrcK, class SrcV, class Score, class Accum>
__device__ __forceinline__ void tile_loop_p(int tid, lptr base, int nt, int pitch, SrcK srck, SrcV srcv, Score score, Accum accum) {
    if (nt <= 0) return;
    constexpr int CPR = ROWB / 16, NCH = (64 * CPR) / 512, KT = 64 * KSTR, VT = 64 * VSTR;
    lptr Kb = base, Vb = base + 2 * KT;
    u32x4 kr0[NCH], vr0[NCH], kr1[NCH], vr1[NCH];
    auto gld = [&](const bf16_t* p, u32x4 (&r)[NCH]) {
#pragma unroll
        for (int c = 0; c < NCH; ++c) { const int idx = tid + 512 * c, rr = idx / CPR, ch = idx % CPR; r[c] = *(const u32x4*)(p + (size_t)rr * pitch + ch * 8); } };
    auto lst = [&](lptr dst, int stride, const u32x4 (&r)[NCH]) {
#pragma unroll
        for (int c = 0; c < NCH; ++c) { const int idx = tid + 512 * c, rr = idx / CPR, ch = idx % CPR; *(LAS u32x4*)(dst + rr * stride + ch * 16) = r[c]; } };
    gld(srck(0), kr0); gld(srcv(0), vr0); lst(Kb, KSTR, kr0); lst(Vb, VSTR, vr0);
    if (nt > 1) { gld(srck(1), kr0); lst(Kb + KT, KSTR, kr0); }
    if (nt > 2) gld(srck(2), kr1);
    if (nt > 1) gld(srcv(1), vr1);
    __syncthreads();
    f32x16 a0, a1, b0, b1; bool aact = score(0, (lcptr)Kb, a0, a1), bact = false;
    auto step = [&](int i, f32x16& c0, f32x16& c1, bool& cact, f32x16& n0, f32x16& n1, bool& nact, u32x4 (&kL)[NCH], u32x4 (&vL)[NCH], u32x4 (&kS)[NCH], u32x4 (&vS)[NCH]) {
        const bool m1 = i + 1 < nt, m2 = i + 2 < nt, m3 = i + 3 < nt;
        if (VAR != 7) { if (m3) gld(srck(i + 3), kL);
        if (m2) gld(srcv(i + 2), vL); }
        nact = false;
        if (m1) nact = score(i + 1, (lcptr)(Kb + ((i + 1) & 1) * KT), n0, n1);
        if (cact) accum(i, (lcptr)(Vb + (i & 1) * VT), c0, c1);
        if (VAR != 7) { if (m2) lst(Kb + (i & 1) * KT, KSTR, kS);
        if (m1) lst(Vb + ((i + 1) & 1) * VT, VSTR, vS); }
        __syncthreads();
    };
    for (int i = 0; i < nt; i += 2) { step(i, a0, a1, aact, b0, b1, bact, kr0, vr0, kr1, vr1); if (i + 1 < nt) step(i + 1, b0, b1, bact, a0, a1, aact, kr1, vr1, kr0, vr0); }
}

template <int ROWB, int KSTR, int VSTR, class SrcK, class SrcV, class Score, class Accum>
__device__ __forceinline__ void tile_loop_pp(int tid, int grp, lptr base, int nt, int pitch, SrcK srck, SrcV srcv, Score score, Accum accum) {
    if (nt <= 0) return;
    constexpr int CPR = ROWB / 16, NCH = (64 * CPR) / 512, KT = 64 * KSTR, VT = 64 * VSTR;
    lptr Kb = base, Vb = base + 2 * KT;
    u32x4 kr0[NCH], vr0[NCH], kr1[NCH], vr1[NCH];
    auto gld = [&](const bf16_t* p, u32x4 (&r)[NCH]) {
#pragma unroll
        for (int c = 0; c < NCH; ++c) { const int idx = tid + 512 * c, rr = idx / CPR, ch = idx % CPR; r[c] = *(const u32x4*)(p + (size_t)rr * pitch + ch * 8); } };
    auto lst = [&](lptr dst, int stride, const u32x4 (&r)[NCH]) {
#pragma unroll
        for (int c = 0; c < NCH; ++c) { const int idx = tid + 512 * c, rr = idx / CPR, ch = idx % CPR; *(LAS u32x4*)(dst + rr * stride + ch * 16) = r[c]; } };
    gld(srck(0), kr0); gld(srcv(0), vr0); lst(Kb, KSTR, kr0); lst(Vb, VSTR, vr0);
    if (nt > 1) { gld(srck(1), kr0); gld(srcv(1), vr0); }
    if (nt > 2) { gld(srck(2), kr1); gld(srcv(2), vr1); }
    __syncthreads();
    f32x16 s0, s1; bool act = false;
    const int nslot = 2 * nt + 1;
    auto slot_fn = [&](int slot, u32x4 (&kS)[NCH], u32x4 (&vS)[NCH]) {
        const int my = slot - grp;
        if (my >= 0 && my < 2 * nt) { const int i = my >> 1;
            if (!(my & 1)) act = score(i, (lcptr)(Kb + (i & 1) * KT), s0, s1);
            else if (act) accum(i, (lcptr)(Vb + (i & 1) * VT), s0, s1); }
        if (slot & 1) { const int j = (slot >> 1) + 1;
            if (j < nt) { lst(Kb + (j & 1) * KT, KSTR, kS); lst(Vb + (j & 1) * VT, VSTR, vS); }
            if (j + 2 < nt) { gld(srck(j + 2), kS); gld(srcv(j + 2), vS); } }
        __syncthreads();
    };
    for (int slot = 0; slot < nslot; slot += 4) {
        slot_fn(slot, kr0, vr0);
        if (slot + 1 < nslot) slot_fn(slot + 1, kr0, vr0);
        if (slot + 2 < nslot) slot_fn(slot + 2, kr1, vr1);
        if (slot + 3 < nslot) slot_fn(slot + 3, kr1, vr1);
    }
}

template <int VAR = 0, class SrcK, class SrcV, class Post>
__device__ __forceinline__ void tile_loop_f(int tid, int lane, lptr base, int nt, int pitch, const bf16x8 (&qf)[4], f32x16 (&o)[2], float& l, SrcK srck, SrcV srcv, Post post) {
    if (nt <= 0) return;
    const int r32 = lane & 31, hi = lane >> 5;
    lptr Kb = base, Vb = base + 2 * KT64;
    const int rr = tid >> 3, ch = tid & 7;
    u32x4 kr0, vr0, kr1, vr1;
    auto gld = [&](const bf16_t* p) { return *(const u32x4*)(p + (size_t)rr * pitch + ch * 8); };
    kr0 = gld(srck(0)); vr0 = gld(srcv(0)); *(LAS u32x4*)(Kb + rr * KS64 + ch * 16) = kr0; *(LAS u32x4*)(Vb + rr * VS64 + ch * 16) = vr0;
    if (nt > 1) { kr0 = gld(srck(1)); *(LAS u32x4*)(Kb + KT64 + rr * KS64 + ch * 16) = kr0; }
    if (nt > 2) kr1 = gld(srck(2));
    if (nt > 1) vr1 = gld(srcv(1));
    __syncthreads();
    f32x16 a0, a1, b0, b1; bool aact, bact = false;
    qk<4>(a0, a1, (lcptr)Kb, KS64, qf, 0.f, r32, hi); aact = post(0, a0, a1);
    auto step = [&](int i, f32x16& c0, f32x16& c1, bool& cact, f32x16& n0, f32x16& n1, bool& nact, u32x4& kL, u32x4& vL, u32x4& kS, u32x4& vS) {
        const bool m1 = i + 1 < nt, m2 = i + 2 < nt, m3 = i + 3 < nt;
        if (m3) kL = gld(srck(i + 3));
        if (m2) vL = gld(srcv(i + 2));
        lcptr Kt = (lcptr)(Kb + ((i + 1) & 1) * KT64), Vt = (lcptr)(Vb + (i & 1) * VT64);
        if (m1 && cact) {
            lcptr p0 = Kt + r32 * KS64 + hi * 16; lcptr p1 = p0 + 32 * KS64;
            bf16x8 ka[4], kb[4];
#pragma unroll
            for (int ks = 0; ks < 4; ++ks) { if (VAR == 8 || VAR == 9) { ka[ks] = qf[ks]; kb[ks] = qf[3 - ks]; } else { ka[ks] = *(const LAS bf16x8*)(p0 + ks * 32); kb[ks] = *(const LAS bf16x8*)(p1 + ks * 32); } }
            n0 = splat16(0.f); n1 = splat16(0.f); float rs = 0.f;
            __builtin_amdgcn_sched_barrier(0);
#pragma unroll
            for (int ks = 0; ks < 4; ++ks) {
                n0 = __builtin_amdgcn_mfma_f32_32x32x16_bf16(ka[ks], qf[ks], n0, 0, 0, 0); n1 = __builtin_amdgcn_mfma_f32_32x32x16_bf16(kb[ks], qf[ks], n1, 0, 0, 0);
#pragma unroll
                for (int e = 0; e < 4; ++e) { c0[4 * ks + e] = ex2(c0[4 * ks + e]); c1[4 * ks + e] = ex2(c1[4 * ks + e]); rs += c0[4 * ks + e] + c1[4 * ks + e]; }
                __builtin_amdgcn_sched_barrier(0);
            }
            l += rs;
            if (VAR == 8 || VAR == 10) { const bf16x8 pk0 = pack_p(c0, 0), pk1 = pack_p(c0, 8), pk2_ = pack_p(c1, 0), pk3 = pack_p(c1, 8);
#pragma unroll
                for (int d = 0; d < 2; ++d) { o[d] = __builtin_amdgcn_mfma_f32_32x32x16_bf16(qf[0], pk0, o[d], 0, 0, 0); o[d] = __builtin_amdgcn_mfma_f32_32x32x16_bf16(qf[1], pk1, o[d], 0, 0, 0);
                    o[d] = __builtin_amdgcn_mfma_f32_32x32x16_bf16(qf[2], pk2_, o[d], 0, 0, 0); o[d] = __builtin_amdgcn_mfma_f32_32x32x16_bf16(qf[3], pk3, o[d], 0, 0, 0); } }
            else pv<2>(o, c0, c1, Vt, VS64, lane);
            nact = post(i + 1, n0, n1);
        } else {
            if (cact) { exp_step(c0, c1, l); pv<2>(o, c0, c1, Vt, VS64, lane); }
            nact = false;
            if (m1) { qk<4>(n0, n1, Kt, KS64, qf, 0.f, r32, hi); nact = post(i + 1, n0, n1); }
        }
        if (m2) *(LAS u32x4*)(Kb + (i & 1) * KT64 + rr * KS64 + ch * 16) = kS;
        if (m1) *(LAS u32x4*)(Vb + ((i + 1) & 1) * VT64 + rr * VS64 + ch * 16) = vS;
        __syncthreads();
    };
    for (int i = 0; i < nt; i += 2) { step(i, a0, a1, aact, b0, b1, bact, kr0, vr0, kr1, vr1); if (i + 1 < nt) step(i + 1, b0, b1, bact, a0, a1, aact, kr1, vr1, kr0, vr0); }
}
constexpr int TL64_BYTES = 2 * KT64 + 2 * VT64;
}

#ifndef PP_GRP
#define PP_GRP (w & 1)
#endif
template <int var> __device__ __forceinline__ void moba_unit(const Frame& F, int b, int h, int qb, const bf16_t* Q, const bf16_t* K, const bf16_t* V, const float* KMEAN, const float* BT, unsigned char* O8) {
    using namespace att;
    const int lane = F.lane, r32 = lane & 31, hi = lane >> 5, w = F.wave;
    lptr lds = (lptr)F.lds; lptr tl = lds; LAS float* BTL = (LAS float*)(lds + TL64_BYTES); lptr KM = lds + TL64_BYTES + 512;
    const int t = 256 * qb + 32 * w + r32; const size_t row = (size_t)b * SEQ + t;
    bf16x8 qf[4];
#pragma unroll
    for (int ks = 0; ks < 4; ++ks) qf[ks] = *(const bf16x8*)(Q + row * 1024 + h * 64 + 16 * ks + 8 * hi);
    if (F.tid < 128) BTL[F.tid] = BT[h * 128 + F.tid] - BT[h * 128 + 127];
    { const int idx = F.tid * 2, j = idx >> 6, d = idx & 63; const float* kmp = KMEAN + (size_t)(b * 16 + j) * 2048 + h * 64 + d;
      *(LAS unsigned*)(KM + j * KS64 + d * 2) = (j < qb) ? pk2(kmp[0] + kmp[1024], kmp[1] + kmp[1025]) : 0u;
      *(LAS unsigned*)(KM + (16 + j) * KS64 + d * 2) = 0u; }
    __syncthreads();
    unsigned selmask = 0u;
    if (qb > 0) {
        f32x16 gs = splat16(0.f);
        { lcptr p0 = (lcptr)KM + r32 * KS64 + hi * 16;
#pragma unroll
          for (int ks = 0; ks < 4; ++ks) { const bf16x8 k0 = *(const LAS bf16x8*)(p0 + ks * 32); gs = __builtin_amdgcn_mfma_f32_32x32x16_bf16(k0, qf[ks], gs, 0, 0, 0); } }
        float glo[8], ghi[8];
#pragma unroll
        for (int r = 0; r < 8; ++r) { const float mine = gs[r], oth = __shfl_xor(mine, 32); glo[r] = hi ? oth : mine; ghi[r] = hi ? mine : oth; }
#pragma unroll
        for (int rep = 0; rep < 3; ++rep) { float best = -INFINITY; int bj = -1;
#pragma unroll
            for (int j = 0; j < 16; ++j) { const int r = (j & 3) + 4 * (j >> 3); const float gv = ((j >> 2) & 1) ? ghi[r] : glo[r];
                if (j < qb && !((selmask >> j) & 1u) && gv > best) { best = gv; bj = j; } }
            if (bj >= 0) selmask |= 1u << bj; }
    }
    f32x16 o[2] = {splat16(0.f), splat16(0.f)}; float l = 0.f;
    const int nt = 4 * (qb + 1); const int twmax = 256 * qb + 32 * w + 31;
    const bf16_t* Kh = K + (size_t)b * SEQ * 1024 + h * 64; const bf16_t* Vh = V + (size_t)b * SEQ * 1024 + h * 64;
    tile_loop_f<var>(F.tid, lane, tl, nt, 1024, qf, o, l,
        [&](int i) { return Kh + (size_t)(64 * i) * 1024; }, [&](int i) { return Vh + (size_t)(64 * i) * 1024; },
        [&](int i, f32x16& s0, f32x16& s1) -> bool {
            const int blk = i >> 2, kp0 = 64 * i;
            if (blk < qb) {
                const bool sel = (selmask >> blk) & 1u;
                if (!__any(sel)) return false;
                if (!(blk < qb - 1 || (i & 3) < 2)) bias_mask_near(s0, s1, BTL, t, kp0, hi, 0x7fffffffu);
                if (!sel) mask_all(s0, s1);
            } else {
                if (kp0 > twmax) return false;
                bias_mask_near(s0, s1, BTL, t, kp0, hi, 0x7fffffffu);
            }
            return true; });
    l += __shfl_xor(l, 32);
    store_o64_fp8(O8 + row * 1024 + h * 64, o, l > 0.f ? OSC / l : 0.f, hi);
}
__device__ __forceinline__ void phase_moba(const Frame& F, unsigned char* ws, int var) {
    const bf16_t* Q = (const bf16_t*)(ws + OFF_QKV); const bf16_t* K = Q + (size_t)MTOK * 1024; const bf16_t* V = K + (size_t)MTOK * 1024;
    const float* KMEAN = (const float*)(ws + OFF_KMEAN); const float* BT = (const float*)(ws + OFF_BT);
    for (int idx = F.bx; idx < 2048; idx += F.G) { const int i = idx >> 8, v = idx & 255, x = v & 7, j = v >> 3, bh = 16 * x + 2 * i + (j >> 4), b = bh >> 4, h = bh & 15, p = ((j & 15) + 4 * (i >> 1)) & 15, qb = (i & 1) ? 15 - p : p;

#ifdef MOBA_VAR
        if (var == MOBA_VAR) moba_unit<MOBA_VAR>(F, b, h, qb, Q, K, V, KMEAN, BT, ws + OFF_O8); else
#endif
        moba_unit<0>(F, b, h, qb, Q, K, V, KMEAN, BT, ws + OFF_O8);
        __syncthreads(); }
}

__device__ __forceinline__ void nsa_unit(const Frame& F, int b, int g, int c, const bf16_t* Y1, const bf16_t* KC, const bf16_t* VC, const float* BT, unsigned char* MIXIN) {
    using namespace att;
    const int lane = F.lane, r32 = lane & 31, hi = lane >> 5, w = F.wave;
    lptr lds = (lptr)F.lds; lptr tl = lds; LAS float* BTL = (LAS float*)(lds + TL64_BYTES);
    LAS float* SCB = (LAS float*)(lds + TL64_BYTES + 2048);
    LAS unsigned long long* SELM = (LAS unsigned long long*)(lds + TL64_BYTES + 2048 + 16384);
    lptr OFL = lds + TL64_BYTES + 2048 + 16384 + 1024 + w * 8704 + r32 * 272 + hi * 16;
    const int n = r32 & 3, tok = 8 * w + (r32 >> 2), t = 64 * c + tok; const size_t row = (size_t)b * SEQ + t;
    const bf16_t* T1 = Y1 + (size_t)1 * MTOK * 256; const bf16_t* QB = Y1 + (size_t)(2 + g) * MTOK * 256;
    const bf16_t* KVS = Y1 + (size_t)5 * MTOK * 256; const bf16_t* KVW = Y1 + (size_t)6 * MTOK * 256;
    bf16x8 qf[4];
#pragma unroll
    for (int ks = 0; ks < 4; ++ks) qf[ks] = *(const bf16x8*)(QB + row * 256 + n * 64 + 16 * ks + 8 * hi);
    float gate[3];
#pragma unroll
    for (int j = 0; j < 3; ++j) { const float x = bf2f(T1[row * 256 + 208 + (4 * g + n) * 3 + j]); gate[j] = 1.f / (1.f + __expf(-x)); }
    for (int i = F.tid; i < 512; i += NTHR) BTL[i] = BT[(8 + 4 * g) * 128 + i] - BT[(8 + 4 * g) * 128 + (i | 127)];
    for (int i = F.tid; i < 4096; i += NTHR) SCB[i] = 0.f;
    __syncthreads();
    const LAS float* bt = BTL + n * 128; const float cfar = 0.f;
    const int vis = (t >= 31) ? ((t - 31) >> 4) : -1;
    const int ntc = ((4 * c + 2) >> 6) + 1;
    const bf16_t* KCg = KC + ((size_t)b * 256 * 2 + g) * 64; const bf16_t* VCg = VC + ((size_t)b * 256 * 2 + g) * 64;
    auto cmp_scores = [&](int i, lcptr Kt, f32x16& s0, f32x16& s1) {
        qk<4>(s0, s1, Kt, KS64, qf, 0.f, r32, hi);
#pragma unroll
        for (int half = 0; half < 2; ++half) { float bb[16]; f32x16& s = half ? s1 : s0;
#pragma unroll
            for (int r = 0; r < 16; ++r) { const int cc = 64 * i + 32 * half + crow(r, hi); const int d = t - 16 * cc - 31; const unsigned ix = (unsigned)d < 127u ? (unsigned)d : 127u; bb[r] = bt[ix]; }
#pragma unroll
            for (int r = 0; r < 16; ++r) asm volatile("" : "+v"(bb[r]));
#pragma unroll
            for (int r = 0; r < 16; ++r) { const int cc = 64 * i + 32 * half + crow(r, hi); s[r] = (cc <= vis) ? s[r] + bb[r] : -INFINITY; } }
    };
    float mc = NEG_BIG, lc = 0.f;
    tile_loop64(F.tid, tl, ntc, 128,
        [&](int i, const bf16_t*& kp, const bf16_t*& vp) { kp = KCg + (size_t)(64 * i) * 128; vp = VCg + (size_t)(64 * i) * 128; },
        [&](int i, lcptr Kt, lcptr Vt) { f32x16 s0, s1; cmp_scores(i, Kt, s0, s1);
            const float mn = fmaxf(mc, rowmax32(s0, s1)); float rs = 0.f;
#pragma unroll
            for (int r = 0; r < 16; ++r) rs += ex2(s0[r] - mn) + ex2(s1[r] - mn);
            lc = lc * ex2(mc - mn) + rs; mc = mn; });
    lc += __shfl_xor(lc, 32);
    const float invc = lc > 0.f ? 1.f / lc : 0.f;
    {
        f32x16 o[2] = {splat16(0.f), splat16(0.f)}; float carry = 0.f;
        tile_loop64(F.tid, tl, ntc, 128,
            [&](int i, const bf16_t*& kp, const bf16_t*& vp) { kp = KCg + (size_t)(64 * i) * 128; vp = VCg + (size_t)(64 * i) * 128; },
            [&](int i, lcptr Kt, lcptr Vt) { f32x16 s0, s1; cmp_scores(i, Kt, s0, s1);
#pragma unroll
                for (int r = 0; r < 16; ++r) { s0[r] = ex2(s0[r] - mc) * invc; s1[r] = ex2(s1[r] - mc) * invc; }
                float x0[4], x1[4];
#pragma unroll
                for (int rg = 0; rg < 4; ++rg) { x0[rg] = __shfl_xor(s0[4 * rg + 3], 32); x1[rg] = __shfl_xor(s1[4 * rg + 3], 32); }
#pragma unroll
                for (int rg = 0; rg < 4; ++rg) {
                    float g0 = (s0[4 * rg] + s0[4 * rg + 1]) + (s0[4 * rg + 2] + s0[4 * rg + 3]), g1 = (s1[4 * rg] + s1[4 * rg + 1]) + (s1[4 * rg + 2] + s1[4 * rg + 3]);
                    const float e0 = hi ? x0[rg] : (rg > 0 ? x0[rg > 0 ? rg - 1 : 0] : carry), e1 = hi ? x1[rg] : (rg > 0 ? x1[rg > 0 ? rg - 1 : 0] : x0[3]);
                    g0 += e0; g1 += e1;
                    g0 += __shfl_xor(g0, 1); g0 += __shfl_xor(g0, 2); g1 += __shfl_xor(g1, 1); g1 += __shfl_xor(g1, 2);
                    if (n == 0) { SCB[tok * 64 + 16 * i + 2 * rg + hi] = g0; SCB[tok * 64 + 16 * i + 8 + 2 * rg + hi] = g1; }
                }
                carry = x1[3];
                pv<2>(o, s0, s1, Vt, VS64, lane); });
#pragma unroll
        for (int d = 0; d < 2; ++d)
#pragma unroll
            for (int rg = 0; rg < 4; ++rg) *(LAS f32x4*)(OFL + d * 128 + rg * 32) = (f32x4){o[d][4 * rg], o[d][4 * rg + 1], o[d][4 * rg + 2], o[d][4 * rg + 3]} * gate[0];
    }
    {
        unsigned long long uni = 0ull;
#pragma unroll 1
        for (int tk = 0; tk < 8; ++tk) { const int tk2 = 8 * w + tk; float v = SCB[tk2 * 64 + lane];
            v = (lane > c) ? -INFINITY : ((lane == 0 || lane == c || lane == c - 1) ? INFINITY : v);
            int cnt = 0;
#pragma unroll
            for (int j = 0; j < 64; ++j) { const float vj = __builtin_bit_cast(float, __builtin_amdgcn_readlane(__builtin_bit_cast(int, v), j)); cnt += (vj > v || (vj == v && j < lane)) ? 1 : 0; }
            const unsigned long long mk = __ballot(cnt < 16 && lane <= c);
            if (lane == 0) SELM[tk2] = mk;
            uni |= mk; }
        if (lane == 0) SELM[64 + w] = uni;
    }
    __syncthreads();
    const unsigned long long mymask = SELM[tok];
    unsigned long long uni = 0ull;
#pragma unroll
    for (int k = 0; k < 8; ++k) uni |= SELM[64 + k];
    {
        f32x16 o[2] = {splat16(0.f), splat16(0.f)}; float l = 0.f;
        const int nsel = __popcll(uni);
        const bf16_t* Kg = KVS + (size_t)b * SEQ * 256 + g * 64; const bf16_t* Vg = Kg + 128;
        LAS unsigned char* LIST = (LAS unsigned char*)(SELM + 72);
        if (F.tid < 64 && ((uni >> F.tid) & 1ull)) LIST[__popcll(uni & ((1ull << F.tid) - 1ull))] = (unsigned char)F.tid;
        __syncthreads();
        tile_loop64(F.tid, tl, nsel, 256,
            [&](int i, const bf16_t*& kp, const bf16_t*& vp) { const int j = LIST[i]; kp = Kg + (size_t)(64 * j) * 256; vp = Vg + (size_t)(64 * j) * 256; },
            [&](int i, lcptr Kt, lcptr Vt) { const int j = LIST[i];
                const bool sel = (mymask >> j) & 1ull;
                if (!__any(sel)) return;
                f32x16 s0, s1; qk<4>(s0, s1, Kt, KS64, qf, 0.f, r32, hi);
                if (j >= c - 2) bias_mask_near(s0, s1, bt, t, 64 * j, hi, 0x7fffffffu);
                if (!sel) mask_all(s0, s1);
                exp_step(s0, s1, l); pv<2>(o, s0, s1, Vt, VS64, lane); });
        l += __shfl_xor(l, 32); const float f = gate[1] * (l > 0.f ? 1.f / l : 0.f);
#pragma unroll
        for (int d = 0; d < 2; ++d)
#pragma unroll
            for (int rg = 0; rg < 4; ++rg) *(LAS f32x4*)(OFL + d * 128 + rg * 32) += (f32x4){o[d][4 * rg], o[d][4 * rg + 1], o[d][4 * rg + 2], o[d][4 * rg + 3]} * f;
    }
    {
        f32x16 o[2] = {splat16(0.f), splat16(0.f)}; float l = 0.f;
        const int k0 = c >= 8 ? c - 8 : 0, ntw = c - k0 + 1;
        const bf16_t* Kg = KVW + (size_t)b * SEQ * 256 + g * 64; const bf16_t* Vg = Kg + 128;
        tile_loop64(F.tid, tl, ntw, 256,
            [&](int i, const bf16_t*& kp, const bf16_t*& vp) { kp = Kg + (size_t)(64 * (k0 + i)) * 256; vp = Vg + (size_t)(64 * (k0 + i)) * 256; },
            [&](int i, lcptr Kt, lcptr Vt) { const int kt = k0 + i; f32x16 s0, s1; qk<4>(s0, s1, Kt, KS64, qf, 0.f, r32, hi);
                if (!(kt < c - 2 && kt > c - 8)) bias_mask_near(s0, s1, bt, t, 64 * kt, hi, 512u);
                exp_step(s0, s1, l); pv<2>(o, s0, s1, Vt, VS64, lane); });
        l += __shfl_xor(l, 32); const float f = gate[2] * (l > 0.f ? 1.f / l : 0.f);
        unsigned char* orow = MIXIN + row * 1536 + 1024 + (4 * g + n) * 64;
#pragma unroll
        for (int d = 0; d < 2; ++d)
#pragma unroll
            for (int rg = 0; rg < 4; ++rg) { const f32x4 v = (*(LAS f32x4*)(OFL + d * 128 + rg * 32) + (f32x4){o[d][4 * rg], o[d][4 * rg + 1], o[d][4 * rg + 2], o[d][4 * rg + 3]} * f) * OSC;
                *(unsigned*)(orow + 32 * d + 8 * rg + 4 * hi) = pg8::pk4_fp8(v[0], v[1], v[2], v[3]); }
    }
}

__device__ __forceinline__ void dsa_unit(const Frame& F, int b, int u, const bf16_t* QLAT, const bf16_t* CKVN, const unsigned* MASK, const float* BT, unsigned char* MIXIN) {
    using namespace att;
    const int lane = F.lane, r32 = lane & 31, hi = lane >> 5, w = F.wave, tid = F.tid;
    lptr lds = (lptr)F.lds; lptr Kb = lds, Vb = lds + 2 * KT128; LAS float* BTL = (LAS float*)(lds + 2 * KT128 + 2 * VT128);
    const int head = r32 & 7, q0 = 32 * u, t = q0 + 4 * w + (r32 >> 3); const size_t row = (size_t)b * SEQ + t;
    bf16x8 qf[8];
#pragma unroll
    for (int ks = 0; ks < 8; ++ks) qf[ks] = *(const bf16x8*)(QLAT + row * 1024 + head * 128 + 16 * ks + 8 * hi);
    for (int i = tid; i < 1024; i += NTHR) BTL[i] = BT[i] - BT[i | 127];
    const LAS float* bt = BTL + head * 128;
    f32x16 o[4] = {splat16(0.f), splat16(0.f), splat16(0.f), splat16(0.f)}; float l = 0.f;
    const int nt = ((q0 + 31) >> 6) + 1;
    const bf16_t* Cb = CKVN + (size_t)b * SEQ * 128; const unsigned* mrow = MASK + row * 128;
    u32x4 st[2];
    auto gload = [&](int i) {
#pragma unroll
        for (int k = 0; k < 2; ++k) { const int idx = tid + 512 * k, rr = idx >> 4, ch = idx & 15; st[k] = *(const u32x4*)(Cb + (size_t)(64 * i + rr) * 128 + ch * 8); } };
    auto lstore = [&](int i) { lptr kd = Kb + (i & 1) * KT128, vd = Vb + (i & 1) * VT128;
#pragma unroll
        for (int k = 0; k < 2; ++k) { const int idx = tid + 512 * k, rr = idx >> 4, ch = idx & 15; *(LAS u32x4*)(kd + rr * KS128 + ch * 16) = st[k]; *(LAS u32x4*)(vd + rr * VS128 + ch * 16) = st[k]; } };
    auto score = [&](int i, f32x16& s0, f32x16& s1) {
        lcptr Kt = (lcptr)(Kb + (i & 1) * KT128);
        const u32x2 mw = *(const u32x2*)(mrow + 2 * i);
        qk<8>(s0, s1, Kt, KS128, qf, 0.f, r32, hi);
        const unsigned w0 = mw.x >> (4 * hi), w1 = mw.y >> (4 * hi);
        if ((q0 - (64 * i + 63)) < 128) {
#pragma unroll
            for (int r = 0; r < 16; ++r) { const int d0 = t - (64 * i + crow(r, hi)), d1 = d0 - 32;
                const unsigned i0 = (unsigned)d0 < 127u ? (unsigned)d0 : 127u, i1 = (unsigned)d1 < 127u ? (unsigned)d1 : 127u;
                s0[r] += bt[i0]; s1[r] += bt[i1]; }
        }
#pragma unroll
        for (int r = 0; r < 16; ++r) { const int bit = (r & 3) + 8 * (r >> 2);
            const int m0 = __builtin_amdgcn_sbfe((int)w0, bit, 1), m1 = __builtin_amdgcn_sbfe((int)w1, bit, 1);
            const float a0 = s0[r], a1 = s1[r];
            s0[r] = __int_as_float((__float_as_int(a0) & m0) | ((int)0xff800000 & ~m0));
            s1[r] = __int_as_float((__float_as_int(a1) & m1) | ((int)0xff800000 & ~m1)); }
    };
    u32x4 st2[2];
    gload(0); lstore(0);
    if (nt > 1) gload(1);
    __syncthreads();
    auto step = [&](int i, u32x4 (&sL)[2], u32x4 (&sS)[2]) {
        if (i + 2 < nt) {
#pragma unroll
            for (int k = 0; k < 2; ++k) { const int idx = tid + 512 * k, rr = idx >> 4, ch = idx & 15; sL[k] = *(const u32x4*)(Cb + (size_t)(64 * (i + 2) + rr) * 128 + ch * 8); } }
        f32x16 s0, s1; score(i, s0, s1);
        exp_step(s0, s1, l); pv<4>(o, s0, s1, (lcptr)(Vb + (i & 1) * VT128), VS128, lane);
        if (i + 1 < nt) { lptr kd = Kb + ((i + 1) & 1) * KT128, vd = Vb + ((i + 1) & 1) * VT128;
#pragma unroll
            for (int k = 0; k < 2; ++k) { const int idx = tid + 512 * k, rr = idx >> 4, ch = idx & 15; *(LAS u32x4*)(kd + rr * KS128 + ch * 16) = sS[k]; *(LAS u32x4*)(vd + rr * VS128 + ch * 16) = sS[k]; } }
        __syncthreads();
    };
    for (int i = 0; i < nt; i += 2) { step(i, st2, st); if (i + 1 < nt) step(i + 1, st, st2); }
    l += __shfl_xor(l, 32); const float f = l > 0.f ? OSC / l : 0.f;
    unsigned char* orow = MIXIN + row * 1536 + head * 128;
#pragma unroll
    for (int d = 0; d < 4; ++d)
#pragma unroll
        for (int rg = 0; rg < 4; ++rg) *(unsigned*)(orow + 32 * d + 8 * rg + 4 * hi) = pg8::pk4_fp8(o[d][4 * rg] * f, o[d][4 * rg + 1] * f, o[d][4 * rg + 2] * f, o[d][4 * rg + 3] * f);
}

constexpr int DS_TILE = 32 * att::KS128, DS_WAVE = 2 * DS_TILE + 640;
__device__ __forceinline__ void dsa_query(int lane, int b, int t, u32x2 mw, att::lptr base, const LAS float* BTL, const bf16_t* QLAT, const bf16_t* CKVN, unsigned char* MIXIN) {
    using namespace att;
    const int r32 = lane & 31, hi = lane >> 5, head = r32 & 7; const size_t row = (size_t)b * SEQ + t;
    LAS unsigned short* LIST = (LAS unsigned short*)(base + 2 * DS_TILE);
    bf16x8 qf[8];
#pragma unroll
    for (int ks = 0; ks < 8; ++ks) qf[ks] = *(const bf16x8*)(QLAT + row * 1024 + head * 128 + 16 * ks + 8 * hi);
    int n;
    { unsigned long long bits = (lane <= (t >> 6)) ? ((unsigned long long)mw.x | ((unsigned long long)mw.y << 32)) : 0ull;
      const int cnt = __popcll(bits); int pre = cnt;
#pragma unroll
      for (int o = 1; o < 64; o <<= 1) { const int v = __shfl_up(pre, o); if (lane >= o) pre += v; }
      n = __builtin_amdgcn_readlane(pre, 63); int pos = pre - cnt;
      while (bits) { const int j = __builtin_ctzll(bits); bits &= bits - 1ull; LIST[pos++] = (unsigned short)(64 * lane + j); }
      if (lane < 32) LIST[n + lane] = 0; }
    const bf16_t* Cb = CKVN + (size_t)b * SEQ * 128; const LAS float* bt = BTL + head * 128;
    const int ntile = (n + 31) >> 5;
    f32x16 o[4] = {splat16(0.f), splat16(0.f), splat16(0.f), splat16(0.f)}; float l = 0.f;
    u32x4 ra[8];
    auto gath = [&](int i, u32x4 (&r)[8]) {
#pragma unroll
        for (int k = 0; k < 8; ++k) { const int c = lane + 64 * k, rw = c >> 4, ch = c & 15; const int idx = LIST[32 * i + rw]; r[k] = *(const u32x4*)(Cb + (size_t)idx * 128 + ch * 8); } };
    auto put = [&](lptr T, const u32x4 (&r)[8]) {
#pragma unroll
        for (int k = 0; k < 8; ++k) { const int c = lane + 64 * k, rw = c >> 4, ch = c & 15; *(LAS u32x4*)(T + rw * KS128 + ch * 16) = r[k]; } };
    const int hq = lane >> 5, g = (lane >> 4) & 1, q4 = (lane & 15) >> 2, p4 = lane & 3;
    auto tile = [&](int i) {
        lcptr T = (lcptr)(base + (i & 1) * DS_TILE);
        f32x16 s = splat16(0.f);
        { lcptr p0 = T + r32 * KS128 + hi * 16;
#pragma unroll
          for (int ks = 0; ks < 8; ++ks) { const bf16x8 kf = *(const LAS bf16x8*)(p0 + ks * 32); s = __builtin_amdgcn_mfma_f32_32x32x16_bf16(kf, qf[ks], s, 0, 0, 0); } }
        const int lastslot = (32 * i + 31 < n) ? 32 * i + 31 : n - 1;
        if (32 * i + 32 > n || t - (int)LIST[lastslot] < 127) {
#pragma unroll
            for (int h8 = 0; h8 < 2; ++h8) { int li[8]; float bb[8];
#pragma unroll
                for (int r = 0; r < 8; ++r) li[r] = LIST[32 * i + crow(8 * h8 + r, hi)];
#pragma unroll
                for (int r = 0; r < 8; ++r) asm volatile("" : "+v"(li[r]));
#pragma unroll
                for (int r = 0; r < 8; ++r) { const int d = t - li[r]; const unsigned ix = (unsigned)d < 127u ? (unsigned)d : 127u; bb[r] = bt[ix]; }
#pragma unroll
                for (int r = 0; r < 8; ++r) asm volatile("" : "+v"(bb[r]));
#pragma unroll
                for (int r = 0; r < 8; ++r) { const int slot = 32 * i + crow(8 * h8 + r, hi); s[8 * h8 + r] = (slot < n) ? s[8 * h8 + r] + bb[r] : -INFINITY; } }
        }
        float rs = 0.f;
#pragma unroll
        for (int r = 0; r < 16; ++r) { s[r] = ex2(s[r]); rs += s[r]; }
        l += rs;
        const bf16x8 pk[2] = {pack_p(s, 0), pack_p(s, 8)};
        lcptr vb = T + (4 * hq + q4) * KS128 + (16 * g + 4 * p4) * 2;
#pragma unroll
        for (int k = 0; k < 2; ++k)
#pragma unroll
            for (int d = 0; d < 4; ++d) { const s16x4 lo = vtr(vb + (16 * k) * KS128 + d * 64), hh = vtr(vb + (16 * k + 8) * KS128 + d * 64);
                const bf16x8 vf = (bf16x8){lo[0], lo[1], lo[2], lo[3], hh[0], hh[1], hh[2], hh[3]};
                o[d] = __builtin_amdgcn_mfma_f32_32x32x16_bf16(vf, pk[k], o[d], 0, 0, 0); }
    };
    gath(0, ra); put(base, ra);
    for (int i = 0; i < ntile; ++i) {
        const bool more = i + 1 < ntile;
        if (more) gath(i + 1, ra);
        tile(i);
        if (more) put(base + ((i + 1) & 1) * DS_TILE, ra);
    }
    l += __shfl_xor(l, 32); const float f = l > 0.f ? OSC / l : 0.f;
    if (r32 < 8) { unsigned char* orow = MIXIN + row * 1536 + head * 128;
#pragma unroll
        for (int d = 0; d < 4; ++d)
#pragma unroll
            for (int rg = 0; rg < 4; ++rg) *(unsigned*)(orow + 32 * d + 8 * rg + 4 * hi) = pg8::pk4_fp8(o[d][4 * rg] * f, o[d][4 * rg + 1] * f, o[d][4 * rg + 2] * f, o[d][4 * rg + 3] * f); }
}
__device__ __forceinline__ void phase_dsa_sparse(const Frame& F, const bf16_t* QLAT, const bf16_t* CKVN, const unsigned* MASK, const float* BT, unsigned char* MIXIN) {
    att::lptr lds = (att::lptr)F.lds; LAS float* BTL = (LAS float*)(lds + 8 * DS_WAVE);
    for (int i = F.tid; i < 1024; i += NTHR) BTL[i] = BT[i] - BT[i | 127];
    __syncthreads();
    att::lptr base = lds + F.wave * DS_WAVE;
    if ((F.G & 7) == 0) {
        const int b = F.bx & 7, wx = (F.bx >> 3) * NWAVES + F.wave, WX = (F.G >> 3) * NWAVES;
        u32x2 mw = *(const u32x2*)(MASK + ((size_t)b * SEQ + wx) * 128 + 2 * F.lane);
        for (int t = wx; t < SEQ; t += WX) { const int tn = (t + WX < SEQ) ? t + WX : t;
            const u32x2 mwn = *(const u32x2*)(MASK + ((size_t)b * SEQ + tn) * 128 + 2 * F.lane);
            dsa_query(F.lane, b, t, mw, base, BTL, QLAT, CKVN, MIXIN); mw = mwn; }
    } else {
        for (int q = F.gw; q < MTOK; q += F.NGW) { const u32x2 mw = *(const u32x2*)(MASK + (size_t)q * 128 + 2 * F.lane); dsa_query(F.lane, q >> 12, q & 4095, mw, base, BTL, QLAT, CKVN, MIXIN); }
    }
    __syncthreads();
}

constexpr int QI_STRIDE = 2064;
__device__ __forceinline__ void indexer_unit(const Frame& F, int b, int c, const bf16_t* QIDX, const bf16_t* T1, _Float16* SC) {
    using namespace att;
    const int lane = F.lane, r32 = lane & 31, hi = lane >> 5, w = F.wave, tid = F.tid;
    lptr lds = (lptr)F.lds; lptr QI = lds; lptr KI = lds + 64 * QI_STRIDE;
    const int qh = w & 1, kq = w >> 1;
    const size_t row0 = (size_t)b * SEQ + 64 * c;
#pragma unroll 4
    for (int k = 0; k < 16; ++k) { const int idx = tid + 512 * k, rr = idx >> 7, ch = idx & 127; *(LAS u32x4*)(QI + rr * QI_STRIDE + ch * 16) = *(const u32x4*)(QIDX + (row0 + rr) * 1024 + ch * 8); }
    float wv[16];
    { const size_t trow = row0 + 32 * qh + r32; const u32x4 a = *(const u32x4*)(T1 + trow * 256 + 192), bq = *(const u32x4*)(T1 + trow * 256 + 200);
      wv[0] = bflo(a.x); wv[1] = bfhi(a.x); wv[2] = bflo(a.y); wv[3] = bfhi(a.y); wv[4] = bflo(a.z); wv[5] = bfhi(a.z); wv[6] = bflo(a.w); wv[7] = bfhi(a.w);
      wv[8] = bflo(bq.x); wv[9] = bfhi(bq.x); wv[10] = bflo(bq.y); wv[11] = bfhi(bq.y); wv[12] = bflo(bq.z); wv[13] = bfhi(bq.z); wv[14] = bflo(bq.w); wv[15] = bfhi(bq.w); }
    const int nsup = (c + 2) >> 1, pitch = (c + 1) * 64;
    _Float16* srow = SC + (size_t)b * SCB_ELEMS + (size_t)4096 * (c * (c + 1) / 2) + (size_t)(32 * qh + r32) * pitch;
    const bf16_t* Kb = T1 + (size_t)b * SEQ * 256 + 128;
    u32x4 st[2];
    for (int s = 0; s < nsup; ++s) {
#pragma unroll
        for (int k = 0; k < 2; ++k) { const int idx = tid + 512 * k, rr = idx >> 3, ch = idx & 7; st[k] = *(const u32x4*)(Kb + (size_t)(128 * s + rr) * 256 + ch * 8); }
        __syncthreads();
#pragma unroll
        for (int k = 0; k < 2; ++k) { const int idx = tid + 512 * k, rr = idx >> 3, ch = idx & 7; *(LAS u32x4*)(KI + rr * KS64 + ch * 16) = st[k]; }
        __syncthreads();
        const int key0 = 128 * s + 32 * kq;
        if (key0 <= 64 * c + 63) {
            bf16x8 kf[4];
#pragma unroll
            for (int ks = 0; ks < 4; ++ks) kf[ks] = *(const LAS bf16x8*)(KI + (32 * kq + r32) * KS64 + ks * 32 + hi * 16);
            f32x16 sc = splat16(0.f);
            lcptr qp = (lcptr)QI + (32 * qh + r32) * QI_STRIDE + hi * 16;
#pragma unroll 2
            for (int hd = 0; hd < 16; ++hd) { f32x16 acc = splat16(0.f);
#pragma unroll
                for (int ks = 0; ks < 4; ++ks) { const bf16x8 qv = *(const LAS bf16x8*)(qp + hd * 128 + ks * 32); acc = __builtin_amdgcn_mfma_f32_32x32x16_bf16(kf[ks], qv, acc, 0, 0, 0); }
                const float ww = wv[hd];
#pragma unroll
                for (int r = 0; r < 16; ++r) sc[r] += ww * fmaxf(acc[r], 0.f); }
#pragma unroll
            for (int rg = 0; rg < 4; ++rg) { f32x2 a = {sc[4 * rg], sc[4 * rg + 1]}, bq = {sc[4 * rg + 2], sc[4 * rg + 3]};
                u32x2 o; o.x = __builtin_bit_cast(unsigned, __builtin_convertvector(a, f16x2_t)); o.y = __builtin_bit_cast(unsigned, __builtin_convertvector(bq, f16x2_t));
                *(u32x2*)(srow + key0 + 8 * rg + 4 * hi) = o; }
        }
    }
    __syncthreads();
}

struct SelRow { const unsigned short* src; unsigned* mrow; int t, c; };
__device__ __forceinline__ SelRow sel_row(int row, const _Float16* SC, unsigned* MASK) {
    SelRow r; const int b = row >> 12; r.t = row & 4095; r.c = r.t >> 6; const int nk = (r.c + 1) * 64;
    r.src = (const unsigned short*)SC + (size_t)b * SCB_ELEMS + (size_t)4096 * (r.c * (r.c + 1) / 2) + (size_t)(r.t & 63) * nk; r.mrow = MASK + (size_t)row * 128; return r;
}
__device__ __forceinline__ void sel_load(const SelRow& r, int lane, unsigned (&key)[64]) {
#pragma unroll
    for (int g = 0; g < 4; ++g) {
        if (r.c >= 16 * g) {
#pragma unroll
            for (int jj = 0; jj < 16; ++jj) { const int j = 16 * g + jj, jc = j <= r.c ? j : r.c;
                const unsigned uu = r.src[64 * jc + lane]; const unsigned k = (uu & 0x8000u) ? (~uu & 0xffffu) : (uu | 0x8000u);
                key[j] = (64 * j + lane > r.t) ? 0u : k; }
        } else {
#pragma unroll
            for (int jj = 0; jj < 16; ++jj) key[16 * g + jj] = 0u;
        }
    }
}
template <bool GT> __device__ __forceinline__ int sel_count(const unsigned (&key)[64], unsigned cand, int c) {
    int cnt = 0;
#pragma unroll
    for (int g = 0; g < 4; ++g) if (c >= 16 * g) {
#pragma unroll
        for (int jj = 0; jj < 16; ++jj) cnt += __popcll(__ballot(GT ? (key[16 * g + jj] > cand) : (key[16 * g + jj] >= cand)));
    }
    return cnt;
}
__device__ __forceinline__ void sel_emit(const SelRow& r, int lane, const unsigned (&key)[64], unsigned prefix, bool exact) {
    if (exact) {
#pragma unroll
        for (int j = 0; j < 64; ++j) if (j <= r.c) { const unsigned long long mk = __ballot(key[j] >= prefix); if (lane == 0) *(u32x2*)(r.mrow + 2 * j) = (u32x2){(unsigned)mk, (unsigned)(mk >> 32)}; }
        return;
    }
    int rem = 256 - sel_count<true>(key, prefix, r.c);
#pragma unroll
    for (int j = 0; j < 64; ++j) {
        if (j <= r.c) {
            const bool eq = key[j] == prefix; const unsigned long long eqm = __ballot(eq);
            const int before = __builtin_amdgcn_mbcnt_hi((unsigned)(eqm >> 32), __builtin_amdgcn_mbcnt_lo((unsigned)eqm, 0u));
            const unsigned long long mk = __ballot(key[j] > prefix || (eq && before < rem));
            rem -= __popcll(eqm); rem = rem < 0 ? 0 : rem;
            if (lane == 0) *(u32x2*)(r.mrow + 2 * j) = (u32x2){(unsigned)mk, (unsigned)(mk >> 32)};
        }
    }
}
__device__ __forceinline__ void sel_small(const SelRow& r, int lane) {
    for (int j = 0; j <= r.c; ++j) { const unsigned long long mk = __ballot(64 * j + lane <= r.t); if (lane == 0) *(u32x2*)(r.mrow + 2 * j) = (u32x2){(unsigned)mk, (unsigned)(mk >> 32)}; }
}
__device__ __forceinline__ void phase_select(const Frame& F, const _Float16* SC, unsigned* MASK) {
    const int lane = F.lane;
    for (int p = F.gw; p < MTOK / 2; p += F.NGW) {
        const int pb_ = p >> 11, q = p & 2047;
        const SelRow ra = sel_row(pb_ * 4096 + q, SC, MASK), rb = sel_row(pb_ * 4096 + 4095 - q, SC, MASK);
        const bool sa = ra.t < 256, sb = rb.t < 256;
        if (sa) sel_small(ra, lane);
        if (sb) sel_small(rb, lane);
        if (sa && sb) continue;
        unsigned ka[64], kb[64];
        sel_load(ra, lane, ka); sel_load(rb, lane, kb);
        unsigned pa = 0u, pb = 0u; bool da = sa, db = sb;
#pragma unroll 1
        for (int bit = 15; bit >= 0 && !(da && db); --bit) {
            if (!da) { const unsigned ca = pa | (1u << bit); const int na = sel_count<false>(ka, ca, ra.c); if (na >= 256) pa = ca; if (na == 256) da = true; }
            if (!db) { const unsigned cb = pb | (1u << bit); const int nb = sel_count<false>(kb, cb, rb.c); if (nb >= 256) pb = cb; if (nb == 256) db = true; }
        }
        if (!sa) sel_emit(ra, lane, ka, pa, da);
        if (!sb) sel_emit(rb, lane, kb, pb, db);
    }
}

__device__ __forceinline__ float gelu_tanh(float x) { const float u = 0.7978845608028654f * (x + 0.044715f * x * x * x); const float e = __expf(2.f * u); return 0.5f * x * (1.f + (1.f - 2.f / (e + 1.f))); }
__device__ __forceinline__ void compress_unit(const Frame& F, int b, int g, int kv, int rt, const bf16_t* KVC, const bf16_t* W1T, const float* w2, const float* cb, bf16_t* OUT) {
    const int lane = F.lane, r32 = lane & 31, hi = lane >> 5, w = F.wave, tid = F.tid;
    LAS float* PART = (LAS float*)F.lds;
    LAS float* HID = PART + 8 * 2048;
    const int n0 = 32 * rt, nn = n0 + r32, nc = nn < 255 ? nn : 254;
    const bf16_t* arow = KVC + ((size_t)b * SEQ + 16 * nc) * 256 + kv * 128 + g * 64;
    f32x16 a0 = att::splat16(0.f), a1 = att::splat16(0.f);
#pragma unroll 4
    for (int ks = 0; ks < 16; ++ks) { const int l = 4 * w + (ks >> 2), d = 16 * (ks & 3) + 8 * hi;
        const bf16x8 af = *(const bf16x8*)(arow + (size_t)l * 256 + d);
        const bf16x8 b0 = *(const bf16x8*)(W1T + (size_t)r32 * 2048 + l * 64 + d), b1 = *(const bf16x8*)(W1T + (size_t)(32 + r32) * 2048 + l * 64 + d);
        a0 = __builtin_amdgcn_mfma_f32_32x32x16_bf16(af, b0, a0, 0, 0, 0); a1 = __builtin_amdgcn_mfma_f32_32x32x16_bf16(af, b1, a1, 0, 0, 0); }
#pragma unroll
    for (int r = 0; r < 16; ++r) { const int mrow = att::crow(r, hi); PART[w * 2048 + mrow * 64 + r32] = a0[r]; PART[w * 2048 + mrow * 64 + 32 + r32] = a1[r]; }
    __syncthreads();
#pragma unroll
    for (int k = 0; k < 4; ++k) { const int idx = tid + 512 * k; float s = cb[idx & 63];
#pragma unroll
        for (int ww = 0; ww < 8; ++ww) s += PART[ww * 2048 + idx];
        HID[idx] = gelu_tanh(s); }
    __syncthreads();
#pragma unroll
    for (int k = 0; k < 4; ++k) { const int idx = tid + 512 * k, nr = idx >> 6, f = idx & 63; float s = 0.f;
#pragma unroll 8
        for (int e = 0; e < 64; ++e) s += HID[nr * 64 + e] * w2[e * 64 + f];
        const int blk = n0 + nr;
        OUT[(((size_t)b * 256 + blk) * 2 + g) * 64 + f] = (blk < 255) ? (bf16_t)f2bf(s) : (bf16_t)0; }
    __syncthreads();
}

#ifdef DBG_MODE
namespace dbg {
constexpr int NSLOT = 40;
__device__ __forceinline__ float bfr(float x) { return bf2f((unsigned short)f2bf(x)); }
__device__ __forceinline__ int srow(int i, int n) { return (int)(((unsigned)i * 2654435761u) % (unsigned)MTOK) ; }
__device__ void commit(unsigned* D, int slot, const float* ref, const float* fast, int n, float tf) {
    __shared__ float red[256];
    const int tid = threadIdx.x; float s = 0.f;
    for (int i = tid; i < n; i += 256) s += ref[i] * ref[i];
    red[tid] = s; __syncthreads();
    for (int o = 128; o > 0; o >>= 1) { if (tid < o) red[tid] += red[tid + o]; __syncthreads(); }
    const float rms = sqrtf(red[0] / (float)n); __syncthreads();
    int bad = 0, tot = 0; float mr = 0.f;
    for (int i = tid; i < n; i += 256) { const float e = fabsf(fast[i] - ref[i]); const float tol = tf * (rms + fabsf(ref[i])) + 1e-7f; if (!(e <= tol)) ++bad; ++tot; const float r = e / (rms + 1e-20f); if (r > mr || !(r == r)) mr = (r == r) ? r : 1e30f; }
    atomicAdd(&D[4 * slot], (unsigned)bad); atomicAdd(&D[4 * slot + 1], (unsigned)tot); atomicMax(&D[4 * slot + 2], __float_as_uint(mr));
    __syncthreads();
}
__device__ __forceinline__ float bias_l2(const float* relb, int head, int dist) { return relb[t5_bucket(dist) * 16 + head] * LOG2E; }

__global__ void chk_in_e(Args a, unsigned* D) {
    __shared__ float ref[1792], fast[1792];
    const int r = srow(blockIdx.x, 64), tid = threadIdx.x; const float* x = a.in[I_X] + (size_t)r * 1024; const float* w = a.in[I_EWIN];
    const bf16_t* Y1 = (const bf16_t*)(a.ws + OFF_Y1);
    for (int n = tid; n < EVEN_IN; n += 256) { float s = 0.f; for (int k = 0; k < 1024; ++k) s += bfr(x[k]) * bfr(w[(size_t)k * EVEN_IN + n]);
        const int dc = RowInE{}(n), tile = dc >> 8, col = dc & 255; const float sc = (tile == 2 || tile == 3) ? QSCALE : 1.f;
        ref[n] = s * sc; fast[n] = bf2f(Y1[((size_t)tile * MTOK + r) * 256 + col]); }
    __syncthreads();
    commit(D, 1, ref, fast, EVEN_IN, 0.02f);
    if (tid == 0) { float sq = 0.f, skv = 0.f; for (int n = 0; n < 256; ++n) sq += ref[n] * ref[n]; for (int n = 256; n < 384; ++n) skv += ref[n] * ref[n];
        const float* pq = (const float*)(a.ws + OFF_SSQ_Q) + (size_t)r * 4; const float* pk = (const float*)(a.ws + OFF_SSQ_KV) + (size_t)r * 4;
        const float fq = pq[0] + pq[1] + pq[2] + pq[3], fk = pk[0] + pk[1] + pk[2] + pk[3];
        int bad = 0; if (!(fabsf(fq - sq) <= 0.02f * sq)) ++bad; if (!(fabsf(fk - skv) <= 0.02f * skv)) ++bad;
        atomicAdd(&D[4 * 2], (unsigned)bad); atomicAdd(&D[4 * 2 + 1], 2u); }
}
__global__ void chk_q2(Args a, unsigned* D) {
    __shared__ float ref[1024], fast[1024], cqn[256], qh[512];
    const int r = srow(blockIdx.x, 64), tid = threadIdx.x; const bf16_t* Y1 = (const bf16_t*)(a.ws + OFF_Y1);
    const bf16_t* CQ = Y1 + (size_t)r * 256; const bf16_t* T1 = Y1 + ((size_t)MTOK + r) * 256;
    { float s = 0.f; for (int k = 0; k < 128; ++k) { const float c = bf2f(T1[k]); s += c * c; } const float rk = 1.f / sqrtf(s / 128.f + 1e-6f);
      if (tid < 128) { ref[tid] = bf2f(T1[tid]) * rk * a.in[I_EKVN][tid]; fast[tid] = bf2f(((const bf16_t*)(a.ws + OFF_CKVN))[(size_t)r * 128 + tid]); } }
    __syncthreads(); commit(D, 3, ref, fast, 128, 0.02f);
    { float s = 0.f; for (int k = 0; k < 256; ++k) { const float c = bf2f(CQ[k]); s += c * c; } const float rq = 1.f / sqrtf(s / 256.f + 1e-6f);
      cqn[tid] = bf2f(CQ[tid]) * rq * a.in[I_EQN][tid]; }
    __syncthreads();
    for (int o = tid; o < 512; o += 256) { float s = 0.f; for (int k = 0; k < 256; ++k) s += cqn[k] * a.in[I_EWUQ][k * 512 + o]; qh[o] = s; }
    __syncthreads();
    for (int o = tid; o < 1024; o += 256) { const int h = o >> 7, c = o & 127; float s = 0.f; for (int d = 0; d < 64; ++d) s += qh[h * 64 + d] * a.in[I_EWUK][c * 512 + h * 64 + d];
        ref[o] = s * QSCALE; fast[o] = bf2f(((const bf16_t*)(a.ws + OFF_QLAT))[(size_t)r * 1024 + o]); }
    __syncthreads(); commit(D, 5, ref, fast, 1024, 0.03f);
    for (int o = tid; o < 1024; o += 256) { float s = 0.f; for (int k = 0; k < 256; ++k) s += cqn[k] * a.in[I_EWQIDX][k * 1024 + o];
        ref[o] = s; fast[o] = bf2f(((const bf16_t*)(a.ws + OFF_QIDX))[(size_t)r * 1024 + o]); }
    __syncthreads(); commit(D, 6, ref, fast, 1024, 0.03f);
}
__global__ void chk_cmp(Args a, unsigned* D) {
    __shared__ float ref[64], fast[64], hid[64];
    const int i = blockIdx.x, tid = threadIdx.x, b = i & 7, g = (i >> 3) & 1, kv = (i >> 4) & 1; const int blk = (i >> 5) == 0 ? 0 : ((i >> 5) == 1 ? 254 : (int)((unsigned)(i * 37 + 11) % 255u));
    const bf16_t* KVC = (const bf16_t*)(a.ws + OFF_Y1) + (size_t)4 * MTOK * 256;
    const float* pos = a.in[kv ? I_EPOSV : I_EPOSK]; const float* w1 = a.in[kv ? I_ECV1 : I_ECK1]; const float* w2 = a.in[kv ? I_ECV2 : I_ECK2];
    if (tid < 64) { float s = 0.f;
        for (int l = 0; l < 32; ++l) for (int d = 0; d < 64; ++d) { const float av = bf2f(KVC[((size_t)b * SEQ + 16 * blk + l) * 256 + kv * 128 + g * 64 + d]); const float wv = w1[(l * 64 + d) * 64 + tid]; s += av * bfr(wv) + pos[l * 64 + d] * wv; }
        hid[tid] = gelu_tanh(s); }
    __syncthreads();
    if (tid < 64) { float s = 0.f; for (int e = 0; e < 64; ++e) s += hid[e] * w2[e * 64 + tid]; ref[tid] = s;
        fast[tid] = bf2f(((const bf16_t*)(a.ws + (kv ? OFF_VC : OFF_KC)))[(((size_t)b * 256 + blk) * 2 + g) * 64 + tid]); }
    __syncthreads(); commit(D, 4, ref, fast, 64, 0.03f);
}
__global__ void chk_idx(Args a, unsigned* D) {
    __shared__ float ref[256], fast[256];
    const int r = (blockIdx.x < 4) ? (blockIdx.x * 4096 + blockIdx.x * 61) : srow(blockIdx.x, 64), tid = threadIdx.x, b = r >> 12, t = r & 4095, c = t >> 6, nk = (c + 1) * 64;
    const bf16_t* Y1 = (const bf16_t*)(a.ws + OFF_Y1); const bf16_t* T1 = Y1 + (size_t)MTOK * 256; const bf16_t* QI = (const bf16_t*)(a.ws + OFF_QIDX) + (size_t)r * 1024;
    const int s = (int)(((unsigned)tid * 2654435761u + 12345u * blockIdx.x) % (unsigned)nk);
    const bf16_t* kr = T1 + ((size_t)b * SEQ + s) * 256 + 128; float sc = 0.f;
    for (int h = 0; h < 16; ++h) { float d = 0.f; for (int k = 0; k < 64; ++k) d += bf2f(QI[h * 64 + k]) * bf2f(kr[k]); sc += bf2f(T1[(size_t)r * 256 + 192 + h]) * fmaxf(d, 0.f); }
    ref[tid] = sc;
    const _Float16* SC = (const _Float16*)(a.ws + OFF_SC) + (size_t)b * SCB_ELEMS + (size_t)4096 * (c * (c + 1) / 2) + (size_t)(t & 63) * nk;
    fast[tid] = (float)SC[s];
    __syncthreads(); commit(D, 7, ref, fast, 256, 0.02f);
}
__global__ void chk_sel(Args a, unsigned* D) {
    __shared__ unsigned key[4096];
    const int r = (blockIdx.x < 8) ? (blockIdx.x * 4096 + 255 + blockIdx.x * 300) : srow(blockIdx.x, 64), tid = threadIdx.x, b = r >> 12, t = r & 4095, c = t >> 6, nk = (c + 1) * 64;
    const unsigned short* SC = (const unsigned short*)(a.ws + OFF_SC) + (size_t)b * SCB_ELEMS + (size_t)4096 * (c * (c + 1) / 2) + (size_t)(t & 63) * nk;
    const unsigned* M = (const unsigned*)(a.ws + OFF_MASK) + (size_t)r * 128;
    for (int s = tid; s < nk; s += 256) { const unsigned u = SC[s]; key[s] = (s <= t) ? ((u & 0x8000u) ? (~u & 0xffffu) : (u | 0x8000u)) : 0u; }
    __syncthreads();
    int bad = 0, tot = 0;
    for (int s = tid; s < nk; s += 256) { bool want;
        if (s > t) want = false; else if (t < 256) want = true;
        else { int rank = 0; const unsigned ks = key[s]; for (int q = 0; q <= t; ++q) rank += (key[q] > ks || (key[q] == ks && q < s)) ? 1 : 0; want = rank < 256; }
        const bool got = (M[s >> 5] >> (s & 31)) & 1u; if (want != got) ++bad; ++tot; }
    atomicAdd(&D[4 * 8], (unsigned)bad); atomicAdd(&D[4 * 8 + 1], (unsigned)tot);
}
__global__ void chk_dsa(Args a, unsigned* D) {
    __shared__ float lg[4096], red[256], ref[128], fast[128];
    const int r = (blockIdx.x < 8) ? (blockIdx.x * 4096 + blockIdx.x * 37) : srow(blockIdx.x, 64), tid = threadIdx.x, b = r >> 12, t = r & 4095, h = blockIdx.x & 7;
    const bf16_t* Q = (const bf16_t*)(a.ws + OFF_QLAT) + (size_t)r * 1024 + h * 128; const bf16_t* C = (const bf16_t*)(a.ws + OFF_CKVN) + (size_t)b * SEQ * 128;
    const unsigned* M = (const unsigned*)(a.ws + OFF_MASK) + (size_t)r * 128; const float* relb = a.in[I_RELB];
    float mx = -INFINITY;
    for (int s = tid; s <= t; s += 256) { float v = -INFINITY; if ((M[s >> 5] >> (s & 31)) & 1u) { float d = 0.f; for (int k = 0; k < 128; ++k) d += bf2f(Q[k]) * bf2f(C[(size_t)s * 128 + k]); v = d + bias_l2(relb, h, t - s); } lg[s] = v; mx = fmaxf(mx, v); }
    red[tid] = mx; __syncthreads(); for (int o = 128; o > 0; o >>= 1) { if (tid < o) red[tid] = fmaxf(red[tid], red[tid + o]); __syncthreads(); } mx = red[0]; __syncthreads();
    float sm = 0.f; for (int s = tid; s <= t; s += 256) { const float p = exp2f(lg[s] - mx); lg[s] = p; sm += p; }
    red[tid] = sm; __syncthreads(); for (int o = 128; o > 0; o >>= 1) { if (tid < o) red[tid] += red[tid + o]; __syncthreads(); } sm = red[0]; __syncthreads();
    if (tid < 128) { float o = 0.f; for (int s = 0; s <= t; ++s) o += lg[s] * bf2f(C[(size_t)s * 128 + tid]); ref[tid] = o / sm; fast[tid] = bf2f(((const bf16_t*)(a.ws + OFF_MIXIN))[(size_t)r * 1536 + h * 128 + tid]); }
    __syncthreads(); commit(D, 9, ref, fast, 128, 0.03f);
}
__global__ void chk_nsa(Args a, unsigned* D) {
    __shared__ float pc[4][256], lg[1100], red[256], ref[64], fast[64], oacc[3][64], scb[64]; __shared__ int selj[16]; __shared__ float qs[4][64];
    const int r = (blockIdx.x < 8) ? (blockIdx.x * 4096 + blockIdx.x * 41) : srow(blockIdx.x, 64), tid = threadIdx.x, b = r >> 12, t = r & 4095, hh = blockIdx.x & 7, g = hh >> 2, n = hh & 3, cur = t >> 6;
    const bf16_t* Y1 = (const bf16_t*)(a.ws + OFF_Y1); const bf16_t* T1 = Y1 + (size_t)MTOK * 256; const bf16_t* QB = Y1 + (size_t)(2 + g) * MTOK * 256;
    const bf16_t* KVS = Y1 + (size_t)5 * MTOK * 256; const bf16_t* KVW = Y1 + (size_t)6 * MTOK * 256;
    const bf16_t* KC = (const bf16_t*)(a.ws + OFF_KC); const bf16_t* VC = (const bf16_t*)(a.ws + OFF_VC); const float* relb = a.in[I_RELB];
    qs[tid >> 6][tid & 63] = bf2f(QB[(size_t)r * 256 + tid]);
    __syncthreads();
    const int vis = (t >= 31) ? ((t - 31) >> 4) : -1;
    for (int nn = 0; nn < 4; ++nn) {
        float v = -INFINITY; if (tid <= vis) { float d = 0.f; for (int k = 0; k < 64; ++k) d += qs[nn][k] * bf2f(KC[(((size_t)b * 256 + tid) * 2 + g) * 64 + k]); v = d + bias_l2(relb, 8 + 4 * g + nn, t - 16 * tid - 31); }
        red[tid] = v; __syncthreads(); for (int o = 128; o > 0; o >>= 1) { if (tid < o) red[tid] = fmaxf(red[tid], red[tid + o]); __syncthreads(); } const float mx = red[0]; __syncthreads();
        const float p = (tid <= vis) ? exp2f(v - mx) : 0.f; red[tid] = p; __syncthreads(); for (int o = 128; o > 0; o >>= 1) { if (tid < o) red[tid] += red[tid + o]; __syncthreads(); } const float sm = red[0]; __syncthreads();
        pc[nn][tid] = sm > 0.f ? p / sm : 0.f; __syncthreads();
    }
    if (tid < 64) { float o = 0.f; for (int i = 0; i <= vis; ++i) o += pc[n][i] * bf2f(VC[(((size_t)b * 256 + i) * 2 + g) * 64 + tid]); oacc[0][tid] = o;
        float s = 0.f; for (int nn = 0; nn < 4; ++nn) for (int i = 4 * tid - 1; i <= 4 * tid + 3; ++i) if (i >= 0 && i < 255) s += pc[nn][i];
        scb[tid] = (tid > cur) ? -INFINITY : ((tid == 0 || tid == cur || tid == cur - 1) ? INFINITY : s); }
    __syncthreads();
    if (tid < 64) { int rank = 0; for (int j = 0; j < 64; ++j) rank += (scb[j] > scb[tid] || (scb[j] == scb[tid] && j < tid)) ? 1 : 0; if (rank < 16) selj[rank] = tid; }
    __syncthreads();
    { float mx = -INFINITY;
      for (int i = tid; i < 1024; i += 256) { const int j = selj[i >> 6], p = 64 * j + (i & 63); float v = -INFINITY; if (p <= t) { float d = 0.f; for (int k = 0; k < 64; ++k) d += qs[n][k] * bf2f(KVS[((size_t)b * SEQ + p) * 256 + g * 64 + k]); v = d + bias_l2(relb, 8 + hh, t - p); } lg[i] = v; mx = fmaxf(mx, v); }
      red[tid] = mx; __syncthreads(); for (int o = 128; o > 0; o >>= 1) { if (tid < o) red[tid] = fmaxf(red[tid], red[tid + o]); __syncthreads(); } mx = red[0]; __syncthreads();
      float sm = 0.f; for (int i = tid; i < 1024; i += 256) { const float p = exp2f(lg[i] - mx); lg[i] = p; sm += p; }
      red[tid] = sm; __syncthreads(); for (int o = 128; o > 0; o >>= 1) { if (tid < o) red[tid] += red[tid + o]; __syncthreads(); } sm = red[0]; __syncthreads();
      if (tid < 64) { float o = 0.f; for (int i = 0; i < 1024; ++i) { const int p = 64 * selj[i >> 6] + (i & 63); if (p <= t) o += lg[i] * bf2f(KVS[((size_t)b * SEQ + p) * 256 + 128 + g * 64 + tid]); } oacc[1][tid] = o / sm; }
      __syncthreads(); }
    { float mx = -INFINITY;
      for (int i = tid; i < 512; i += 256) { const int p = t - i; float v = -INFINITY; if (p >= 0) { float d = 0.f; for (int k = 0; k < 64; ++k) d += qs[n][k] * bf2f(KVW[((size_t)b * SEQ + p) * 256 + g * 64 + k]); v = d + bias_l2(relb, 8 + hh, i); } lg[i] = v; mx = fmaxf(mx, v); }
      red[tid] = mx; __syncthreads(); for (int o = 128; o > 0; o >>= 1) { if (tid < o) red[tid] = fmaxf(red[tid], red[tid + o]); __syncthreads(); } mx = red[0]; __syncthreads();
      float sm = 0.f; for (int i = tid; i < 512; i += 256) { const float p = exp2f(lg[i] - mx); lg[i] = p; sm += p; }
      red[tid] = sm; __syncthreads(); for (int o = 128; o > 0; o >>= 1) { if (tid < o) red[tid] += red[tid + o]; __syncthreads(); } sm = red[0]; __syncthreads();
      if (tid < 64) { float o = 0.f; for (int i = 0; i < 512; ++i) { const int p = t - i; if (p >= 0) o += lg[i] * bf2f(KVW[((size_t)b * SEQ + p) * 256 + 128 + g * 64 + tid]); } oacc[2][tid] = o / sm; }
      __syncthreads(); }
    if (tid < 64) { float gt[3]; for (int j = 0; j < 3; ++j) { const float x = bf2f(T1[(size_t)r * 256 + 208 + hh * 3 + j]); gt[j] = 1.f / (1.f + expf(-x)); }
        ref[tid] = gt[0] * oacc[0][tid] + gt[1] * oacc[1][tid] + gt[2] * oacc[2][tid]; fast[tid] = bf2f(((const bf16_t*)(a.ws + OFF_MIXIN))[(size_t)r * 1536 + 1024 + hh * 64 + tid]); }
    __syncthreads(); commit(D, 10, ref, fast, 64, 0.04f);
}
__global__ void chk_out_e(Args a, unsigned* D) {
    __shared__ float ref[1024], fast[1024], cat[1024];
    const int r = srow(blockIdx.x, 64), tid = threadIdx.x; const bf16_t* MX = (const bf16_t*)(a.ws + OFF_MIXIN) + (size_t)r * 1536;
    for (int o = tid; o < 512; o += 256) { const int h = o >> 6, d = o & 63; float s = 0.f; for (int c = 0; c < 128; ++c) s += bf2f(MX[h * 128 + c]) * a.in[I_EWUV][c * 512 + h * 64 + d]; cat[o] = s; cat[512 + o] = bf2f(MX[1024 + o]); }
    __syncthreads();
    for (int n = tid; n < 1024; n += 256) { float s = 0.f; for (int j = 0; j < 1024; ++j) s += cat[j] * a.in[I_EWOUT][(size_t)j * 1024 + n]; ref[n] = s;
        fast[n] = bf2f(((const bf16_t*)(a.ws + OFF_S1))[(size_t)r * 1024 + n]) - ALPHA * a.in[I_X][(size_t)r * 1024 + n]; }
    __syncthreads(); commit(D, 11, ref, fast, 1024, 0.35f);
}
__global__ void chk_ln(const bf16_t* S, const bf16_t* O, const float* g, const float* bt, unsigned* D, int slot) {
    __shared__ float ref[1024], fast[1024];
    const int r = srow(blockIdx.x, 64), tid = threadIdx.x; float mean = 0.f, var = 0.f;
    for (int k = 0; k < 1024; ++k) mean += bf2f(S[(size_t)r * 1024 + k]); mean /= 1024.f;
    for (int k = 0; k < 1024; ++k) { const float d = bf2f(S[(size_t)r * 1024 + k]) - mean; var += d * d; } var /= 1024.f;
    for (int n = tid; n < 1024; n += 256) { ref[n] = (bf2f(S[(size_t)r * 1024 + n]) - mean) / sqrtf(var + 1e-5f) * g[n] + bt[n]; fast[n] = bf2f(O[(size_t)r * 1024 + n]); }
    __syncthreads(); commit(D, slot, ref, fast, 1024, 0.01f);
}
__global__ void chk_ffn_up(Args a, unsigned* D) {
    __shared__ float ref[DFF], fast[DFF], hrow[1024];
    const int r = srow(blockIdx.x, 64), tid = threadIdx.x; const bf16_t* H = (const bf16_t*)(a.ws + OFF_H) + (size_t)r * 1024;
    for (int k = tid; k < 1024; k += 256) hrow[k] = bf2f(H[k]);
    __syncthreads();
    for (int n = tid; n < DFF; n += 256) { float s1 = 0.f, s3 = 0.f; for (int k = 0; k < 1024; ++k) { s1 += hrow[k] * bfr(a.in[I_EF1][(size_t)k * DFF + n]); s3 += hrow[k] * bfr(a.in[I_EF3][(size_t)k * DFF + n]); }
        ref[n] = s1 / (1.f + expf(-s1)) * s3; fast[n] = bf2f(((const bf16_t*)(a.ws + OFF_ACT))[(size_t)r * DFF + n]); }
    __syncthreads(); commit(D, 13, ref, fast, DFF, 0.02f);
}
__global__ void chk_ffn_dn(Args a, unsigned* D) {
    __shared__ float ref[1024], fast[1024], arow[DFF];
    const int r = srow(blockIdx.x, 64), tid = threadIdx.x; const bf16_t* A = (const bf16_t*)(a.ws + OFF_ACT) + (size_t)r * DFF;
    for (int k = tid; k < DFF; k += 256) arow[k] = bf2f(A[k]);
    __syncthreads();
    for (int n = tid; n < 1024; n += 256) { float s = 0.f; for (int k = 0; k < DFF; ++k) s += arow[k] * bfr(a.in[I_EF2][(size_t)k * 1024 + n]); ref[n] = s;
        fast[n] = bf2f(((const bf16_t*)(a.ws + OFF_S2))[(size_t)r * 1024 + n]) - ALPHA * bf2f(((const bf16_t*)(a.ws + OFF_H))[(size_t)r * 1024 + n]); }
    __syncthreads(); commit(D, 14, ref, fast, 1024, 0.06f);
}
__global__ void chk_in_o(Args a, unsigned* D) {
    __shared__ float ref[2048], fast[2048], xr[1024];
    const int r = srow(blockIdx.x, 64), tid = threadIdx.x; const bf16_t* X1 = (const bf16_t*)(a.ws + OFF_X1) + (size_t)r * 1024;
    for (int k = tid; k < 1024; k += 256) xr[k] = bf2f(X1[k]);
    __syncthreads();
    for (int n = tid; n < 2048; n += 256) { float s = 0.f; for (int k = 0; k < 1024; ++k) s += xr[k] * bfr(a.in[I_OWIN][(size_t)k * 3072 + 1024 + n]); ref[n] = s;
        fast[n] = bf2f(((const bf16_t*)(a.ws + OFF_QKV))[(size_t)(1 + (n >> 10)) * MTOK * 1024 + (size_t)r * 1024 + (n & 1023)]); }
    __syncthreads(); commit(D, 16, ref, fast, 2048, 0.02f);
    const int pm = r >> 8; const bf16_t* K = (const bf16_t*)(a.ws + OFF_QKV) + (size_t)MTOK * 1024 + (size_t)pm * 256 * 1024; const float* KM = (const float*)(a.ws + OFF_KMEAN) + (size_t)pm * 2048;
    for (int n = tid; n < 1024; n += 256) { float s = 0.f; for (int q = 0; q < 256; ++q) s += bf2f(K[(size_t)q * 1024 + n]); ref[n] = s; fast[n] = KM[n] + KM[1024 + n]; }
    __syncthreads(); commit(D, 17, ref, fast, 1024, 0.03f);
}
__global__ void chk_moba(Args a, unsigned* D) {
    __shared__ float lg[1024], red[256], ref[64], fast[64], q[64], gate[16]; __shared__ int blkof[4];
    const int r = (blockIdx.x < 8) ? (blockIdx.x * 4096 + blockIdx.x * 300) : srow(blockIdx.x, 64), tid = threadIdx.x, b = r >> 12, t = r & 4095, h = blockIdx.x & 15, own = t >> 8;
    const bf16_t* X1 = (const bf16_t*)(a.ws + OFF_X1) + (size_t)r * 1024; const bf16_t* K = (const bf16_t*)(a.ws + OFF_QKV) + (size_t)MTOK * 1024 + (size_t)b * SEQ * 1024 + h * 64; const bf16_t* V = K + (size_t)MTOK * 1024;
    const float* relb = a.in[I_RELB];
    if (tid < 64) { float s = 0.f; for (int k = 0; k < 1024; ++k) s += bf2f(X1[k]) * bfr(a.in[I_OWIN][(size_t)k * 3072 + h * 64 + tid]); q[tid] = bfr(s * QSCALE); }
    __syncthreads();
    if (tid < 16) { float s = -INFINITY; if (tid < own) { s = 0.f; for (int p = 0; p < 256; ++p) for (int d = 0; d < 64; ++d) s += q[d] * bf2f(K[(size_t)(256 * tid + p) * 1024 + d]); } gate[tid] = s; }
    __syncthreads();
    if (tid == 0) { unsigned used = 0u; for (int k = 0; k < 3; ++k) { int bj = -1; float best = -INFINITY; for (int j = 0; j < own; ++j) if (!((used >> j) & 1u) && gate[j] > best) { best = gate[j]; bj = j; } blkof[k] = bj; if (bj >= 0) used |= 1u << bj; } blkof[3] = own; }
    __syncthreads();
    float mx = -INFINITY;
    for (int i = tid; i < 1024; i += 256) { const int j = blkof[i >> 8], p = 256 * j + (i & 255); float v = -INFINITY; if (j >= 0 && p <= t) { float d = 0.f; for (int k = 0; k < 64; ++k) d += q[k] * bf2f(K[(size_t)p * 1024 + k]); v = d + bias_l2(relb, h, t - p); } lg[i] = v; mx = fmaxf(mx, v); }
    red[tid] = mx; __syncthreads(); for (int o = 128; o > 0; o >>= 1) { if (tid < o) red[tid] = fmaxf(red[tid], red[tid + o]); __syncthreads(); } mx = red[0]; __syncthreads();
    float sm = 0.f; for (int i = tid; i < 1024; i += 256) { const float p = exp2f(lg[i] - mx); lg[i] = p; sm += p; }
    red[tid] = sm; __syncthreads(); for (int o = 128; o > 0; o >>= 1) { if (tid < o) red[tid] += red[tid + o]; __syncthreads(); } sm = red[0]; __syncthreads();
    if (tid < 64) { float o = 0.f; for (int i = 0; i < 1024; ++i) { const int j = blkof[i >> 8], p = 256 * j + (i & 255); if (j >= 0 && p <= t) o += lg[i] * bf2f(V[(size_t)p * 1024 + tid]); } ref[tid] = o / sm;
        fast[tid] = bf2f(((const bf16_t*)(a.ws + OFF_QKV))[(size_t)r * 1024 + h * 64 + tid]); }
    __syncthreads(); commit(D, 18, ref, fast, 64, 0.04f);
}
__global__ void chk_out_o(Args a, unsigned* D) {
    __shared__ float ref[1024], fast[1024], orow[1024];
    const int r = srow(blockIdx.x, 64), tid = threadIdx.x;
    for (int k = tid; k < 1024; k += 256) orow[k] = bf2f(((const bf16_t*)(a.ws + OFF_QKV))[(size_t)r * 1024 + k]);
    __syncthreads();
    for (int n = tid; n < 1024; n += 256) { float s = 0.f; for (int k = 0; k < 1024; ++k) s += orow[k] * a.in[I_OWOUT][(size_t)k * 1024 + n]; ref[n] = s;
        fast[n] = bf2f(((const bf16_t*)(a.ws + OFF_S1O))[(size_t)r * 1024 + n]) - ALPHA * bf2f(((const bf16_t*)(a.ws + OFF_X1))[(size_t)r * 1024 + n]); }
    __syncthreads(); commit(D, 20, ref, fast, 1024, 0.5f);
}
__global__ void chk_route(Args a, unsigned* D) {
    const int r = srow(blockIdx.x * 256 + threadIdx.x, 64); const bf16_t* H2 = (const bf16_t*)(a.ws + OFF_H2) + (size_t)r * 1024;
    float lg[8]; for (int e = 0; e < 8; ++e) lg[e] = 0.f;
    for (int k = 0; k < 1024; ++k) { const float hv = bf2f(H2[k]); for (int e = 0; e < 8; ++e) lg[e] += hv * a.in[I_OROUTER][k * 8 + e]; }
    int e0 = 0; for (int e = 1; e < 8; ++e) if (lg[e] > lg[e0]) e0 = e; int e1 = -1; for (int e = 0; e < 8; ++e) if (e != e0 && (e1 < 0 || lg[e] > lg[e1])) e1 = e;
    const float g0 = 1.f / (1.f + expf(lg[e1] - lg[e0]));
    const u32x2 rt = ((const u32x2*)(a.ws + OFF_ROUTE))[r]; const int f0 = rt.x & 255, f1 = (rt.x >> 8) & 255; const float fg = __uint_as_float(rt.y);
    int bad = 0; if (f0 != e0 || f1 != e1 || !(fabsf(fg - g0) <= 0.02f)) ++bad;
    atomicAdd(&D[4 * 21], (unsigned)bad); atomicAdd(&D[4 * 21 + 1], 1u);
    const int* GI = (const int*)(a.ws + OFF_GINFO); const int* DEST = (const int*)(a.ws + OFF_DEST) + 2 * (size_t)r;
    int bad2 = 0;
    for (int k = 0; k < 2; ++k) { const int e = k ? f1 : f0, d = DEST[k], ps = e ? GI[e - 1] : 0; if (d < ps || d >= ps + GI[8 + e]) ++bad2; }
    atomicAdd(&D[4 * 22], (unsigned)bad2); atomicAdd(&D[4 * 22 + 1], 2u);
}
__global__ void chk_moe(Args a, unsigned* D) {
    __shared__ float ref[1024], fast[1024], hrow[1024], act[DFFE], fin[1024];
    const int r = srow(blockIdx.x, 64), tid = threadIdx.x; const bf16_t* H2 = (const bf16_t*)(a.ws + OFF_H2) + (size_t)r * 1024;
    for (int k = tid; k < 1024; k += 256) { hrow[k] = bf2f(H2[k]); ref[k] = 0.f; }
    const u32x2 rt = ((const u32x2*)(a.ws + OFF_ROUTE))[r]; const float g0 = __uint_as_float(rt.y); const int* DEST = (const int*)(a.ws + OFF_DEST) + 2 * (size_t)r; const bf16_t* YR = (const bf16_t*)(a.ws + OFF_YR);
    __syncthreads();
    for (int k = 0; k < 2; ++k) { const int e = k ? ((rt.x >> 8) & 255) : (rt.x & 255); const float gk = k ? 1.f - g0 : g0;
        const float* w1 = a.in[I_OM1] + (size_t)e * 1024 * DFFE; const float* w3 = a.in[I_OM3] + (size_t)e * 1024 * DFFE; const float* w2 = a.in[I_OM2] + (size_t)e * DFFE * 1024;
        for (int f = tid; f < DFFE; f += 256) { float s1 = 0.f, s3 = 0.f; for (int q = 0; q < 1024; ++q) { s1 += hrow[q] * bfr(w1[(size_t)q * DFFE + f]); s3 += hrow[q] * bfr(w3[(size_t)q * DFFE + f]); } act[f] = bfr(s1 / (1.f + expf(-s1)) * s3); }
        __syncthreads();
        for (int n = tid; n < 1024; n += 256) { float s = 0.f; for (int f = 0; f < DFFE; ++f) s += act[f] * bfr(w2[(size_t)f * 1024 + n]); ref[n] += gk * s; }
        __syncthreads(); }
    for (int n = tid; n < 1024; n += 256) { fast[n] = g0 * bf2f(YR[(size_t)DEST[0] * 1024 + n]) + (1.f - g0) * bf2f(YR[(size_t)DEST[1] * 1024 + n]); fin[n] = ALPHA * hrow[n] + fast[n]; }
    __syncthreads(); commit(D, 23, ref, fast, 1024, 0.12f);
    float mean = 0.f, var = 0.f; for (int k = 0; k < 1024; ++k) mean += fin[k]; mean /= 1024.f; for (int k = 0; k < 1024; ++k) { const float d = fin[k] - mean; var += d * d; } var /= 1024.f;
    __syncthreads();
    for (int n = tid; n < 1024; n += 256) { ref[n] = (fin[n] - mean) / sqrtf(var + 1e-5f) * a.in[I_OLN2G][n] + a.in[I_OLN2B][n]; fast[n] = a.out[(size_t)r * 1024 + n]; }
    __syncthreads(); commit(D, 24, ref, fast, 1024, 0.005f);
    { float m2 = 0.f, v2 = 0.f; for (int k = 0; k < 1024; ++k) m2 += ALPHA * hrow[k]; m2 /= 1024.f; for (int k = 0; k < 1024; ++k) { const float d = ALPHA * hrow[k] - m2; v2 += d * d; } v2 /= 1024.f;
      for (int n = tid; n < 1024; n += 256) ref[n] = (ALPHA * hrow[n] - m2) / sqrtf(v2 + 1e-5f) * a.in[I_OLN2G][n] + a.in[I_OLN2B][n];
      __syncthreads(); commit(D, 28, ref, fast, 1024, 0.005f); }
    { for (int n = tid; n < 1024; n += 256) fin[n] = ALPHA * hrow[n] + (1.f - g0) * bf2f(YR[(size_t)DEST[0] * 1024 + n]) + g0 * bf2f(YR[(size_t)DEST[1] * 1024 + n]);
      __syncthreads();
      float m2 = 0.f, v2 = 0.f; for (int k = 0; k < 1024; ++k) m2 += fin[k]; m2 /= 1024.f; for (int k = 0; k < 1024; ++k) { const float d = fin[k] - m2; v2 += d * d; } v2 /= 1024.f;
      __syncthreads();
      for (int n = tid; n < 1024; n += 256) ref[n] = (fin[n] - m2) / sqrtf(v2 + 1e-5f) * a.in[I_OLN2G][n] + a.in[I_OLN2B][n];
      __syncthreads(); commit(D, 29, ref, fast, 1024, 0.005f); }
}

__global__ void chk_wmoe(Args a, unsigned* D) {
    const int tid = blockIdx.x * 256 + threadIdx.x; const unsigned hsh = (unsigned)tid * 2654435761u;
    const int e = hsh & 7, f = (hsh >> 3) % DFFE, k = (hsh >> 15) % 1024;
    const bf16_t* W13 = (const bf16_t*)(a.ws + OFF_W_M13) + (size_t)e * 2 * DFFE * 1024; const bf16_t* W2 = (const bf16_t*)(a.ws + OFF_W_M2) + (size_t)e * 1024 * DFFE;
    int bad = 0;
    if (W13[(size_t)(((f >> 7) << 8) + (f & 127)) * 1024 + k] != (bf16_t)f2bf(a.in[I_OM1][(size_t)e * 1024 * DFFE + (size_t)k * DFFE + f])) ++bad;
    if (W13[(size_t)(((f >> 7) << 8) + (f & 127) + 128) * 1024 + k] != (bf16_t)f2bf(a.in[I_OM3][(size_t)e * 1024 * DFFE + (size_t)k * DFFE + f])) ++bad;
    atomicAdd(&D[4 * 25], (unsigned)bad); atomicAdd(&D[4 * 25 + 1], 2u);
    int bad2 = 0; if (W2[(size_t)k * DFFE + f] != (bf16_t)f2bf(a.in[I_OM2][(size_t)e * DFFE * 1024 + (size_t)f * 1024 + k])) ++bad2;
    atomicAdd(&D[4 * 26], (unsigned)bad2); atomicAdd(&D[4 * 26 + 1], 1u);
}
__global__ void chk_actm(Args a, unsigned* D) {
    __shared__ float ref[DFFE], fast[DFFE], hrow[1024]; __shared__ int tokf, kf;
    const int tid = threadIdx.x; const int* GI = (const int*)(a.ws + OFF_GINFO); const int nrows = GI[7], ng = nrows >> 8, g0 = ((ng - 1) / MOE_CHUNK) * MOE_CHUNK;
    const int rho = 256 * g0 + (int)(((unsigned)blockIdx.x * 2654435761u) % (unsigned)(nrows - 256 * g0));
    if (tid == 0) { tokf = -1; kf = 0; } __syncthreads();
    const int* DEST = (const int*)(a.ws + OFF_DEST);
    for (int i = tid; i < 2 * MTOK; i += 256) if (DEST[i] == rho) { tokf = i >> 1; kf = i & 1; }
    __syncthreads();
    if (tokf < 0) return;
    const int tok = tokf; const u32x2 rt = ((const u32x2*)(a.ws + OFF_ROUTE))[tok]; const int e = kf ? ((rt.x >> 8) & 255) : (rt.x & 255);
    const bf16_t* H2 = (const bf16_t*)(a.ws + OFF_H2) + (size_t)tok * 1024;
    for (int k = tid; k < 1024; k += 256) hrow[k] = bf2f(H2[k]);
    __syncthreads();
    const float* w1 = a.in[I_OM1] + (size_t)e * 1024 * DFFE; const float* w3 = a.in[I_OM3] + (size_t)e * 1024 * DFFE;
    for (int f = tid; f < DFFE; f += 256) { float s1 = 0.f, s3 = 0.f; for (int q = 0; q < 1024; ++q) { s1 += hrow[q] * bfr(w1[(size_t)q * DFFE + f]); s3 += hrow[q] * bfr(w3[(size_t)q * DFFE + f]); }
        ref[f] = s1 / (1.f + expf(-s1)) * s3; fast[f] = bf2f(((const bf16_t*)(a.ws + OFF_ACTM))[(size_t)(rho - 256 * g0) * DFFE + f]); }
    __syncthreads(); commit(D, 27, ref, fast, DFFE, 0.02f);
}

__global__ void simple_final(Args a) {
    const int row = blockIdx.x * 4 + (threadIdx.x >> 6), lane = threadIdx.x & 63; unsigned char* ws = a.ws;
    const bf16_t* H2 = (const bf16_t*)(ws + OFF_H2); const bf16_t* YR = (const bf16_t*)(ws + OFF_YR);
    const u32x2* ROUTE = (const u32x2*)(ws + OFF_ROUTE); const int* DEST = (const int*)(ws + OFF_DEST);
    const float g0 = __uint_as_float(ROUTE[row].y), g1 = 1.f - g0; const int d0 = DEST[2 * row], d1 = DEST[2 * row + 1];
    float v[16]; float s = 0.f;
    for (int i = 0; i < 16; ++i) { const int col = lane + 64 * i; v[i] = ALPHA * bf2f(H2[(size_t)row * 1024 + col]) + g0 * bf2f(YR[(size_t)d0 * 1024 + col]) + g1 * bf2f(YR[(size_t)d1 * 1024 + col]); s += v[i]; }
    const float mean = wave_sum(s) / 1024.f; float q = 0.f;
    for (int i = 0; i < 16; ++i) { v[i] -= mean; q += v[i] * v[i]; }
    const float rstd = 1.f / sqrtf(wave_sum(q) / 1024.f + 1e-5f);
    for (int i = 0; i < 16; ++i) { const int col = lane + 64 * i; a.out[(size_t)row * 1024 + col] = v[i] * rstd * a.in[I_OLN2G][col] + a.in[I_OLN2B][col]; }
}
__global__ void report(float* out, const unsigned* D, int nelem) {
    __shared__ float kk, xx;
    if (threadIdx.x == 0) { int idx = 0; float v = 0.f; float worst = 0.f;
        for (int s = 1; s < NSLOT; ++s) { const unsigned bad = D[4 * s], tot = D[4 * s + 1]; if (tot == 0u) continue; const float fr = (float)bad / (float)tot; const float thr = (s == 9 || s == 10 || s == 18) ? 0.1f : 0.002f;
            if (fr > worst) worst = fr; if (fr > thr && idx == 0) { idx = s; v = fr; } }
        if (idx == 0) v = worst;
#ifdef DBG_BITS
        { const int sl[6] = DBG_BITS; idx = 0; for (int q = 0; q < 6; ++q) { const int s = sl[q]; if (s > 0 && D[4 * s + 1] > 0u && (float)D[4 * s] / (float)D[4 * s + 1] > 0.002f) idx |= 1 << q; } v = 1.f; }
#endif
#ifdef DBG_VAL
        { const float mr = __uint_as_float(D[4 * DBG_VAL + 2]); const float fr = D[4 * DBG_VAL + 1] ? (float)D[4 * DBG_VAL] / (float)D[4 * DBG_VAL + 1] : 0.f; kk = sqrtf(fmaxf(mr, 1e-6f) * 1e6f); xx = kk * (2.f + 97.f * fr); }
#else
        v = fmaxf(v, 1e-6f); const int n = (v > 0.3f) ? 4 : (v > 0.03f) ? 3 : (v > 0.003f) ? 2 : 1; kk = (n == 4) ? 1e4f : (n == 3) ? 1e3f : (n == 2) ? 1e2f : 1e1f; xx = kk * (float)(idx + 2);
#endif
        }
    __syncthreads();
    const float k = kk, x = xx;
    for (size_t i = (size_t)blockIdx.x * blockDim.x + threadIdx.x; i < (size_t)nelem; i += (size_t)gridDim.x * blockDim.x) out[i] = (i == 0) ? x : k;
}
}
#endif

#ifndef MK_N_LAUNCHES
#define MK_N_LAUNCHES 1
#endif
constexpr int NPHASE = 18;
#define SP2 true
#ifndef FFN_F8
#define FFN_F8 0
#endif
#ifndef MOE_SP2
#define MOE_SP2 true
#endif
#define ALN true

__global__ void __launch_bounds__(NTHR, 2) fwd_kernel(Args args) {
    extern __shared__ __attribute__((aligned(16))) unsigned char lds_raw[];
    Frame F;
    F.lds = (LAS unsigned char*)lds_raw;
    F.tid = threadIdx.x; F.lane = F.tid & 63; F.wave = __builtin_amdgcn_readfirstlane(F.tid >> 6);
    F.G = gridDim.x; F.bx = blockIdx.x; F.gw = F.bx * NWAVES + F.wave; F.NGW = F.G * NWAVES; F.ws = args.ws;
    unsigned char* ws = args.ws;
    volatile LAS unsigned* MISC = (volatile LAS unsigned*)(F.lds + LDSCTL_OFF);
    for (int u = F.tid; u < (LDS_BYTES - LDSCTL_OFF) / 4; u += NTHR) ((LAS unsigned*)(F.lds + LDSCTL_OFF))[u] = 0u;
    __syncthreads();
    XcdBarrier bar = xcd_barrier_post((unsigned*)(ws + OFF_BAR) + args.li * XCD_BAR_WORDS, MISC + 8);
    const int lo = args.ph_lo, hi = args.ph_hi;
#ifndef PH_MASK
#define PH_MASK 0x3ffff
#endif
#define IN(k) (((PH_MASK >> (k)) & 1) && lo <= (k) && (k) < hi)
#ifdef TS_MODE
    unsigned long long* TS = (unsigned long long*)(ws + OFF_DBG + 1024);
#define STAMP(i) do { if (F.bx == 0 && F.tid == 0) TS[i] = __builtin_amdgcn_s_memrealtime(); } while (0)
#else
#define STAMP(i) do { } while (0)
#endif
#define SEAM(k) do { if (IN(k) && IN((k) + 1)) xcd_barrier(bar); STAMP((k) + 1); } while (0)
    LAS unsigned char* glds = F.lds;

    bf16_t* Y1 = (bf16_t*)(ws + OFF_Y1);
    float* ssq_q = (float*)(ws + OFF_SSQ_Q); float* ssq_kv = (float*)(ws + OFF_SSQ_KV);

    STAMP(0);
    if (IN(0)) { phase_prologue_even(F, args); } SEAM(0);
    if (IN(1)) { pg8::Gemm g{(const bf16_t*)(ws + OFF_XB), (const bf16_t*)(ws + OFF_W_IN), MTOK, EVEN_INP, 1024, 1024, 0}; pg8::StaticOrder S; S.init(MTOK, EVEN_INP, F.G, F.bx);
        pg8::EpiInE E{Y1, ssq_q, ssq_kv}; pg8::gemm_phase<pg8::EpiInE, pg8::StaticOrder, ALN, SP2>(glds, g, S, E); } SEAM(1);
    if (IN(2)) {
        phase_ckvn(F, Y1 + (size_t)1 * MTOK * 256, ssq_kv, args.in[I_EKVN], (bf16_t*)(ws + OFF_CKVN));
#ifndef NO_CMP
        for (int idx = F.bx; idx < 256; idx += F.G) { const int b = idx >> 5, g = (idx >> 4) & 1, kv = (idx >> 3) & 1, rt = idx & 7;
            compress_unit(F, b, g, kv, rt, Y1 + (size_t)4 * MTOK * 256, (const bf16_t*)(ws + (kv ? OFF_CV1 : OFF_CK1)), args.in[kv ? I_ECV2 : I_ECK2], (const float*)(ws + OFF_CB) + kv * 64, (bf16_t*)(ws + (kv ? OFF_VC : OFF_KC))); }
#endif
#ifndef NO_Q2
        pg8::Gemm g{Y1, (const bf16_t*)(ws + OFF_W_Q2), MTOK, 2048, 256, 256, 0}; pg8::StaticOrder S; S.init(MTOK, 2048, F.G, F.bx);
        pg8::EpiQ2 E{(bf16_t*)(ws + OFF_QLAT), (bf16_t*)(ws + OFF_QIDX), ssq_q}; pg8::gemm_phase<pg8::EpiQ2, pg8::StaticOrder, ALN, SP2>(glds, g, S, E);
#endif
    } SEAM(2);
    if (IN(3)) { for (int idx = F.bx; idx < 512; idx += F.G) { const int i = idx >> 8, v = idx & 255, b = v & 7, cc = v >> 3, c = i ? 63 - cc : cc;
            indexer_unit(F, b, c, (const bf16_t*)(ws + OFF_QIDX), Y1 + (size_t)1 * MTOK * 256, (_Float16*)(ws + OFF_SC)); } } SEAM(3);
    if (IN(4)) { phase_select(F, (const _Float16*)(ws + OFF_SC), (unsigned*)(ws + OFF_MASK)); } SEAM(4);
    if (IN(5)) {
#ifndef NO_DSA
        if (args.pad != 2) phase_dsa_sparse(F, (const bf16_t*)(ws + OFF_QLAT), (const bf16_t*)(ws + OFF_CKVN), (const unsigned*)(ws + OFF_MASK), (const float*)(ws + OFF_BT), ws + OFF_MIXIN);
#endif
        STAMP(20);
#ifndef NO_NSA
        if (args.pad != 1) for (int idx = F.bx; idx < 1024; idx += F.G) { const int i = idx >> 8, v = idx & 255, b = v & 7, cc = v >> 3, g = i & 1, c = (i >> 1) ? 63 - cc : cc;
            nsa_unit(F, b, g, c, Y1, (const bf16_t*)(ws + OFF_KC), (const bf16_t*)(ws + OFF_VC), (const float*)(ws + OFF_BT), ws + OFF_MIXIN); __syncthreads(); }
#endif
    } SEAM(5);
    if (IN(6)) { pg8::Gemm g{(const bf16_t*)(ws + OFF_MIXIN), (const bf16_t*)(ws + OFF_W_OUTE), MTOK, 1024, 768, 768, 0}; pg8::StaticOrder S; S.init(MTOK, 1024, F.G, F.bx);
        pg8::EpiRes<true> E{args.in[I_X], (bf16_t*)(ws + OFF_S1), 1.f / (OSC * WOUT_SCALE)}; pg8::gemm_phase<pg8::EpiRes<true>, pg8::StaticOrder, ALN, SP2, true>(glds, g, S, E); } SEAM(6);
    if (IN(7)) { phase_ln_i8(F, (const bf16_t*)(ws + OFF_S1), (bf16_t*)(ws + OFF_H), ws + OFF_H8, (float*)(ws + OFF_SA), args.in[I_ELN1G], args.in[I_ELN1B]); } SEAM(7);
#if FFN_F8
    if (IN(8)) { pg8::Gemm g{(const bf16_t*)(ws + OFF_H8), (const bf16_t*)(ws + OFF_W_F13), MTOK, 2 * DFF, 512, 512, 0}; pg8::StaticOrder S; S.init(MTOK, 2 * DFF, F.G, F.bx);
        pg8::EpiSwiglu8 E{ws + OFF_ACT, DFF, 0, 1.f / WF13_SCALE}; pg8::gemm_phase<pg8::EpiSwiglu8, pg8::StaticOrder, ALN, SP2, true>(glds, g, S, E); } SEAM(8);
#else
    if (IN(8)) { pg8::Gemm g{(const bf16_t*)(ws + OFF_H8), (const bf16_t*)(ws + OFF_W_F13), MTOK, 2 * DFF, 512, 512, 0}; pg8::StaticOrder S; S.init(MTOK, 2 * DFF, F.G, F.bx);
        pg8::EpiSwigluI8 E{ws + OFF_ACT, DFF, (const float*)(ws + OFF_SA), (const float*)(ws + OFF_SW)}; pg8::gemm_phase<pg8::EpiSwigluI8, pg8::StaticOrder, ALN, SP2, false, true>(glds, g, S, E); } SEAM(8);
#endif
#if FFN_F8
    if (IN(9)) { pg8::Gemm g{(const bf16_t*)(ws + OFF_ACT), (const bf16_t*)(ws + OFF_W_F2), MTOK, 1024, DFF / 2, DFF / 2, 0}; pg8::StaticOrder S; S.init(MTOK, 1024, F.G, F.bx);
        pg8::EpiRes<false> E{(const void*)(ws + OFF_H), (bf16_t*)(ws + OFF_S2), 1.f / WF2_SCALE}; pg8::gemm_phase<pg8::EpiRes<false>, pg8::StaticOrder, ALN, SP2, true>(glds, g, S, E); } SEAM(9);
#else
    if (IN(9)) { pg8::Gemm g{(const bf16_t*)(ws + OFF_ACT), (const bf16_t*)(ws + OFF_W_F2), MTOK, 1024, DFF / 2, DFF / 2, 0}; pg8::StaticOrder S; S.init(MTOK, 1024, F.G, F.bx);
        pg8::EpiRes<false> E{(const void*)(ws + OFF_H), (bf16_t*)(ws + OFF_S2), 1.f / WF2_SCALE}; pg8::gemm_phase<pg8::EpiRes<false>, pg8::StaticOrder, ALN, SP2, true>(glds, g, S, E); } SEAM(9);
#endif
    if (IN(10)) { phase_ln_bf16(F, (const bf16_t*)(ws + OFF_S2), (bf16_t*)(ws + OFF_X1), ws + OFF_X18, args.in[I_ELN2G], args.in[I_ELN2B]); phase_convert_odd(F, args); } SEAM(10);
    if (IN(11)) { pg8::Gemm g{(const bf16_t*)(ws + OFF_X18), (const bf16_t*)(ws + OFF_W_OIN), MTOK, 3072, 512, 512, 0}; pg8::StaticOrder S; S.init(MTOK, 3072, F.G, F.bx);
        pg8::EpiInO E{(bf16_t*)(ws + OFF_QKV), (float*)(ws + OFF_KMEAN), 1.f / WIN_SCALE}; pg8::gemm_phase<pg8::EpiInO, pg8::StaticOrder, ALN, SP2, true>(glds, g, S, E); } SEAM(11);
    if (IN(12)) { phase_moba(F, ws, args.pad); } SEAM(12);
    if (IN(13)) { pg8::Gemm g{(const bf16_t*)(ws + OFF_O8), (const bf16_t*)(ws + OFF_W_OOUT), MTOK, 1024, 512, 512, 0}; pg8::StaticOrder S; S.init(MTOK, 1024, F.G, F.bx);
        pg8::EpiRes<false> E{(const void*)(ws + OFF_X1), (bf16_t*)(ws + OFF_S1O), 1.f / (OSC * WOUT_SCALE)}; pg8::gemm_phase<pg8::EpiRes<false>, pg8::StaticOrder, ALN, SP2, true>(glds, g, S, E); } SEAM(13);
    if (IN(14)) { phase_ln_router(F, (const bf16_t*)(ws + OFF_S1O), (bf16_t*)(ws + OFF_H2), args.in[I_OLN1G], args.in[I_OLN1B], args.in[I_OROUTER], ws); } SEAM(14);
    if (IN(15)) { phase_moe_gather(F, (const bf16_t*)(ws + OFF_H2), ws + OFF_XR, ws); } SEAM(15);
    if (IN(16)) {
        const int* GI = (const int*)(ws + OFF_GINFO);
        pg8::MoeOrder S; S.G = F.G; S.c = F.bx;
#pragma unroll
        for (int e = 0; e < 8; ++e) S.pend[e] = __builtin_amdgcn_readfirstlane(GI[e]);
        const int ngroups = S.pend[7] >> 8;
        for (int g0 = 0; g0 < ngroups; g0 += MOE_CHUNK) {
            S.g0 = g0; S.ng = (ngroups - g0) < MOE_CHUNK ? (ngroups - g0) : MOE_CHUNK;
            { S.nN = 28; pg8::Gemm g{(const bf16_t*)(ws + OFF_XR), (const bf16_t*)(ws + OFF_W_M13), 0, 2 * DFFE, 512, 512, (size_t)2 * DFFE * 512};
              pg8::EpiSwiglu8 E{ws + OFF_ACTM, DFFE, g0, 1.f / W13_SCALE}; pg8::gemm_phase<pg8::EpiSwiglu8, pg8::MoeOrder, ALN, MOE_SP2, true>(glds, g, S, E); }
            xcd_barrier(bar);
            { S.nN = 4; pg8::Gemm g{(const bf16_t*)(ws + OFF_ACTM - (size_t)g0 * 256 * DFFE), (const bf16_t*)(ws + OFF_W_M2), 0, 1024, DFFE / 2, DFFE / 2, (size_t)1024 * DFFE / 2};
              pg8::EpiStoreS E{(bf16_t*)(ws + OFF_YR), 1024, 1.f / W2_SCALE}; pg8::gemm_phase<pg8::EpiStoreS, pg8::MoeOrder, ALN, MOE_SP2, true>(glds, g, S, E); }
            xcd_barrier(bar);
        }
    }
    STAMP(17);
    if (IN(17)) { phase_final(F, (const bf16_t*)(ws + OFF_H2), (const bf16_t*)(ws + OFF_YR), args.in[I_OLN2G], args.in[I_OLN2B], args.out, ws); }
#ifdef TS_MODE
    STAMP(18);
    xcd_barrier(bar);
    { const int ia[2] = TS_SEL; float d[2];
      for (int q = 0; q < 2; ++q) { const int i = ia[q]; const unsigned long long t1 = (i == 5) ? TS[20] : ((i == 25) ? TS[6] : TS[i + 1]); const unsigned long long t0 = (i == 25) ? TS[20] : TS[i]; d[q] = (float)(t1 - t0) * 0.01f; }
      const float k = sqrtf(fmaxf(d[0], 1.f)), x = 10.f * fmaxf(d[1], 1.f);
      for (size_t i = (size_t)F.bx * NTHR + F.tid; i < (size_t)MTOK * 1024; i += (size_t)F.G * NTHR) args.out[i] = (i == 0) ? x : k; }
#endif
#undef IN
#undef SEAM
}

extern "C" void kernel_launch(void* const* d_in, const int* in_sizes, int n_in, void* d_out, int out_size, void* d_ws, size_t ws_size, hipStream_t stream) {
    static int grid = 0;
    if (grid == 0) {
        if (n_in != 33 || in_sizes[0] != MTOK * DM || out_size != MTOK * DM || ws_size < WS_END) { fprintf(stderr, "kernel_launch: unexpected problem (n_in %d, in0 %d, out %d, ws %zu < %zu)\n", n_in, n_in > 0 ? in_sizes[0] : -1, out_size, ws_size, (size_t)WS_END); grid = -1; return; }
        int dev = 0, cus = 0, per_cu = 0;
        if (hipGetDevice(&dev) != hipSuccess || hipDeviceGetAttribute(&cus, hipDeviceAttributeMultiprocessorCount, dev) != hipSuccess) { grid = -1; return; }
        if (hipFuncSetAttribute((const void*)fwd_kernel, hipFuncAttributeMaxDynamicSharedMemorySize, LDS_BYTES) != hipSuccess) { fprintf(stderr, "kernel_launch: hipFuncSetAttribute failed\n"); grid = -1; return; }
        if (hipOccupancyMaxActiveBlocksPerMultiprocessor(&per_cu, (const void*)fwd_kernel, NTHR, LDS_BYTES) != hipSuccess || per_cu < 1) fprintf(stderr, "kernel_launch: occupancy query reports %d\n", per_cu);
        (void)hipGetLastError();
        grid = cus > 256 ? 256 : cus;
    }
    if (grid < 0) return;
    hipMemsetAsync(d_ws, 0, CTL_ZERO_BYTES, stream);
    Args a{};
    for (int i = 0; i < 33; ++i) a.in[i] = (const float*)d_in[i];
    a.out = (float*)d_out; a.ws = (unsigned char*)d_ws;
#if MK_N_LAUNCHES == 1
    a.ph_lo = 0; a.ph_hi = NPHASE; a.li = 0;
    hipLaunchKernelGGL(fwd_kernel, dim3(grid), dim3(NTHR), LDS_BYTES, stream, a);
#else
    for (int p = 0; p < NPHASE; ++p) { a.ph_lo = p; a.ph_hi = p + 1; a.li = p;
#ifdef REP_PHASE
        if (p == REP_PHASE) { Args a2 = a;
#ifdef REP_PAD
            a2.pad = REP_PAD;
#endif
            for (int rep = 0; rep < REP_N; ++rep) { a2.li = NPHASE + rep; hipLaunchKernelGGL(fwd_kernel, dim3(grid), dim3(NTHR), LDS_BYTES, stream, a2); } }
#endif
        hipLaunchKernelGGL(fwd_kernel, dim3(grid), dim3(NTHR), LDS_BYTES, stream, a);
#ifdef DBG_MODE
        unsigned* D = (unsigned*)((unsigned char*)d_ws + OFF_DBG); unsigned char* ws = (unsigned char*)d_ws;
        switch (p) {
            case 1: hipLaunchKernelGGL(dbg::chk_in_e, dim3(64), dim3(256), 0, stream, a, D); break;
            case 2: hipLaunchKernelGGL(dbg::chk_q2, dim3(64), dim3(256), 0, stream, a, D); hipLaunchKernelGGL(dbg::chk_cmp, dim3(96), dim3(256), 0, stream, a, D); break;
            case 3: hipLaunchKernelGGL(dbg::chk_idx, dim3(64), dim3(256), 0, stream, a, D); break;
            case 4: hipLaunchKernelGGL(dbg::chk_sel, dim3(48), dim3(256), 0, stream, a, D); break;
            case 5: hipLaunchKernelGGL(dbg::chk_dsa, dim3(64), dim3(256), 0, stream, a, D); hipLaunchKernelGGL(dbg::chk_nsa, dim3(64), dim3(256), 0, stream, a, D); break;
            case 6: hipLaunchKernelGGL(dbg::chk_out_e, dim3(32), dim3(256), 0, stream, a, D); break;
            case 7: hipLaunchKernelGGL(dbg::chk_ln, dim3(32), dim3(256), 0, stream, (const bf16_t*)(ws + OFF_S1), (const bf16_t*)(ws + OFF_H), a.in[I_ELN1G], a.in[I_ELN1B], D, 12); break;
            case 8: hipLaunchKernelGGL(dbg::chk_ffn_up, dim3(16), dim3(256), 0, stream, a, D); break;
            case 9: hipLaunchKernelGGL(dbg::chk_ffn_dn, dim3(32), dim3(256), 0, stream, a, D); break;
            case 10: hipLaunchKernelGGL(dbg::chk_ln, dim3(32), dim3(256), 0, stream, (const bf16_t*)(ws + OFF_S2), (const bf16_t*)(ws + OFF_X1), a.in[I_ELN2G], a.in[I_ELN2B], D, 15); break;
            case 10 + 100: break;
            case 11: hipLaunchKernelGGL(dbg::chk_wmoe, dim3(16), dim3(256), 0, stream, a, D); hipLaunchKernelGGL(dbg::chk_in_o, dim3(32), dim3(256), 0, stream, a, D); break;
            case 12: hipLaunchKernelGGL(dbg::chk_moba, dim3(64), dim3(256), 0, stream, a, D); break;
            case 13: hipLaunchKernelGGL(dbg::chk_out_o, dim3(32), dim3(256), 0, stream, a, D); break;
            case 14: hipLaunchKernelGGL(dbg::chk_ln, dim3(32), dim3(256), 0, stream, (const bf16_t*)(ws + OFF_S1O), (const bf16_t*)(ws + OFF_H2), a.in[I_OLN1G], a.in[I_OLN1B], D, 19); break;
            case 15: hipLaunchKernelGGL(dbg::chk_route, dim3(1), dim3(256), 0, stream, a, D); break;
            case 16: hipLaunchKernelGGL(dbg::chk_actm, dim3(8), dim3(256), 0, stream, a, D); break;
            case 17:
#ifdef DBG_SIMPLE_FINAL
                hipLaunchKernelGGL(dbg::simple_final, dim3(MTOK / 4), dim3(256), 0, stream, a);
#endif
                hipLaunchKernelGGL(dbg::chk_moe, dim3(16), dim3(256), 0, stream, a, D); hipLaunchKernelGGL(dbg::report, dim3(1024), dim3(256), 0, stream, (float*)d_out, (const unsigned*)D, out_size); break;
            default: break;
        }
#endif
    }
#endif
}
```

```cpp
#include <hip/hip_runtime.h>
#include <cstdio>
#include <cstdint>

#define LAS __attribute__((address_space(3)))
#define GAS __attribute__((address_space(1)))
typedef unsigned short bf16_t;
typedef short bf16x8 __attribute__((ext_vector_type(8)));
typedef short s16x4 __attribute__((ext_vector_type(4)));
typedef float f32x2 __attribute__((ext_vector_type(2)));
typedef float f32x4 __attribute__((ext_vector_type(4)));
typedef float f32x16 __attribute__((ext_vector_type(16)));
typedef unsigned u32x2 __attribute__((ext_vector_type(2)));
typedef unsigned u32x4 __attribute__((ext_vector_type(4)));
typedef __bf16 bf16x2_t __attribute__((ext_vector_type(2)));
typedef _Float16 f16x2_t __attribute__((ext_vector_type(2)));

constexpr int DM = 1024, NB = 8, SEQ = 4096, MTOK = NB * SEQ;
constexpr int EVEN_IN = 1768, EVEN_INP = 1792, DFF = 2816, DFFE = 3584, NEXP = 8;
constexpr float ALPHA = 1.4142135623730951f;
constexpr float LOG2E = 1.4426950408889634f;
constexpr float QSCALE = 0.125f * LOG2E;
constexpr int NWAVES = 8, NTHR = 512;

__device__ __forceinline__ unsigned f2bf(float f) { unsigned u = __builtin_bit_cast(unsigned, f); return (u + 0x7fffu + ((u >> 16) & 1u)) >> 16; }
__device__ __forceinline__ unsigned pk2(float lo, float hi) { f32x2 v = {lo, hi}; bf16x2_t b = __builtin_convertvector(v, bf16x2_t); return __builtin_bit_cast(unsigned, b); }
__device__ __forceinline__ float bf2f(unsigned short h) { return __builtin_bit_cast(float, (unsigned)h << 16); }
__device__ __forceinline__ float bflo(unsigned w) { return __builtin_bit_cast(float, w << 16); }
__device__ __forceinline__ float bfhi(unsigned w) { return __builtin_bit_cast(float, w & 0xffff0000u); }
__device__ __forceinline__ float wave_sum(float v) {
#pragma unroll
    for (int o = 1; o < 64; o <<= 1) v += __shfl_xor(v, o);
    return v;
}
#define LDS_WAIT() asm volatile("s_waitcnt lgkmcnt(0)" ::: "memory")
#define VM_WAIT() asm volatile("s_waitcnt vmcnt(0)" ::: "memory")
namespace pg8 {
#define PG8_LAS __attribute__((address_space(3)))
typedef unsigned short bf16_t;
typedef short bf16x8 __attribute__((ext_vector_type(8)));
typedef float f32x4 __attribute__((ext_vector_type(4)));
typedef unsigned u32x4 __attribute__((ext_vector_type(4)));
constexpr int BM = 256, BK = 64, HALF = 128, HTB = HALF * BK * 2  , STAGE_BYTES = 8 * HTB, NXCD = 8, WGM = 8;

__host__ __device__ __forceinline__ int lds_byte(int r, int c) { const int st = (r >> 4) * 2 + (c >> 5), rr = r & 15, cc = c & 31, ob = rr * 64 + cc * 2; return st * 1024 + (ob ^ (((ob >> 9) & 1) << 5)); }
__host__ __device__ __forceinline__ void stage_rc(int b, int& R, int& C) { const int st = b / 1024, sb = b % 1024, swz = sb ^ (((sb >> 9) & 1) << 5); R = (st >> 1) * 16 + swz / 64; C = (st & 1) * 32 + (swz % 64) / 2; }
__host__ __device__ __forceinline__ int perm32(int rho) { const int n = rho >> 4, i = rho & 15; return 8 * (i >> 2) + 4 * n + (i & 3); }

struct Unit { int pm, pn, e; };
struct Gemm { const bf16_t* A; const bf16_t* Bt; int M, N, K; int lda; size_t bstride; };

struct StaticOrder {
    int nM, nN, nwg, G, c;
    __host__ __device__ void init(int M, int N, int G_, int c_) { nM = M / BM; nN = N / BM; nwg = nM * nN; G = G_; c = c_; }
    __host__ __device__ bool next(int i, Unit& u) const {
        const long L = (long)i * G + c; if (L >= nwg) return false;
        int wgid = (int)L; { const int q = nwg / NXCD, r = nwg % NXCD, xcd = wgid % NXCD, off = wgid / NXCD; wgid = (xcd < r ? xcd * (q + 1) : r * (q + 1) + (xcd - r) * q) + off; }
        const int nig = WGM * nN, gid = wgid / nig, fm = gid * WGM, gsz = (nM - fm) < WGM ? (nM - fm) : WGM;
        u.pm = fm + ((wgid % nig) % gsz); u.pn = (wgid % nig) / gsz; u.e = 0; return true;
    }
    __device__ __forceinline__ void a_ready(const Unit&) const {}
    __device__ __forceinline__ void done(const Unit&) const {}
};


typedef int v8i32_t __attribute__((ext_vector_type(8)));
typedef int v4i32_t __attribute__((ext_vector_type(4)));
__device__ __forceinline__ v8i32_t cat8(bf16x8 lo, bf16x8 hi) { const v4i32_t a = __builtin_bit_cast(v4i32_t, lo), b = __builtin_bit_cast(v4i32_t, hi); return (v8i32_t){a[0], a[1], a[2], a[3], b[0], b[1], b[2], b[3]}; }
template <class Epi, class Sched, bool ALIGN_EPI = false, bool SP2 = false, bool F8 = false, bool I8 = false>
__device__ __forceinline__ void gemm_phase(PG8_LAS unsigned char* lds, const Gemm g, const Sched& S, const Epi& E) {
    const int tid = threadIdx.x, wid = __builtin_amdgcn_readfirstlane(tid >> 6), lane = tid & 63, wr = wid >> 2, wc = wid & 3, fr = lane & 15, fq = lane >> 4;
    const int K = g.K, nt = K / BK;
    unsigned voffA[2], voffB[2];
#pragma unroll
    for (int i = 0; i < 2; ++i) { int R, C; stage_rc(tid * 16 + i * 8192, R, C); const int Rb = Epi::PERM ? ((R & ~31) + perm32(R & 31)) : R;
        voffA[i] = (unsigned)(R * g.lda + C) * 2u; voffB[i] = (unsigned)(Rb * K + C) * 2u; }
    const size_t kstep = (size_t)(BK * 2);
    const size_t hstep = (size_t)HALF * K * 2;
    const size_t tstep = 2 * hstep;
    const size_t hstepA = (size_t)HALF * g.lda * 2, tstepA = 2 * hstepA;
    const size_t estep = g.bstride * 2;
    const unsigned ldsw = (unsigned)wid * 1024u;
    const int aoff = lds_byte(wr * 64 + fr, fq * 8), boff = lds_byte(wc * 32 + fr, fq * 8);
#define PG8_SA(b, h) (((b) * 2 + (h)) * HTB)
#define PG8_SB(b, h) ((4 + (b) * 2 + (h)) * HTB)
#define PG8_STAGE(bufoff, gbase, voff) do { _Pragma("unroll") for (int _i = 0; _i < 2; ++_i) \
        __builtin_amdgcn_global_load_lds((const unsigned*)((const char*)(gbase) + (voff)[_i]), (PG8_LAS unsigned*)(lds + (bufoff) + ldsw + _i * 8192), 16, 0, 0); } while (0)
#define PG8_LDA(dst, b, h) do { _Pragma("unroll") for (int m = 0; m < 4; ++m) _Pragma("unroll") for (int k = 0; k < 2; ++k) dst[m][k] = *(const PG8_LAS bf16x8*)(lds + PG8_SA(b, h) + aoff + m * 2048 + k * 1024); } while (0)
#define PG8_LDB(dst, b, h) do { _Pragma("unroll") for (int n = 0; n < 2; ++n) _Pragma("unroll") for (int k = 0; k < 2; ++k) dst[n][k] = *(const PG8_LAS bf16x8*)(lds + PG8_SB(b, h) + boff + n * 2048 + k * 1024); } while (0)
#define PG8_MMA(ai, bj, At, Bt) do { __builtin_amdgcn_s_setprio(1); if constexpr (I8) { _Pragma("unroll") for (int m = 0; m < 4; ++m) _Pragma("unroll") for (int n = 0; n < 2; ++n) _Pragma("unroll") for (int k = 0; k < 2; ++k) \
        asm volatile("v_mfma_i32_16x16x64_i8 %0, %1, %2, %0" : "+v"(acc[ai][bj][m][n]) : "v"(Bt[n][k]), "v"(At[m][k])); } else if constexpr (F8) { _Pragma("unroll") for (int m = 0; m < 4; ++m) _Pragma("unroll") for (int n = 0; n < 2; ++n) \
        asm volatile("v_mfma_scale_f32_16x16x128_f8f6f4 %0, %1, %2, %0, %3, %3 op_sel_hi:[0,0,0]" : "+v"(acc[ai][bj][m][n]) : "v"(cat8(Bt[n][0], Bt[n][1])), "v"(cat8(At[m][0], At[m][1])), "v"(sc8)); } else { \
        _Pragma("unroll") for (int m = 0; m < 4; ++m) _Pragma("unroll") for (int n = 0; n < 2; ++n) _Pragma("unroll") for (int k = 0; k < 2; ++k) \
        acc[ai][bj][m][n] = __builtin_amdgcn_mfma_f32_16x16x32_bf16(Bt[n][k], At[m][k], acc[ai][bj][m][n], 0, 0, 0); } __builtin_amdgcn_s_setprio(0); } while (0)
#define PG8_WAIT_V(n) asm volatile("s_waitcnt vmcnt(" #n ")" ::: "memory")
#define PG8_WAIT_L(n) asm volatile("s_waitcnt lgkmcnt(" #n ")" ::: "memory")
#define PG8_BAR __builtin_amdgcn_s_barrier()
#define PG8_SCHED __builtin_amdgcn_sched_barrier(0)
    Unit cur, nxt; int ui = 0;
    if (!S.next(0, cur)) return;
    int sc8 = 0x7f7f7f7f; asm volatile("" : "+v"(sc8));
    f32x4 acc[2][2][4][2];
#pragma unroll
    for (int a = 0; a < 2; ++a)
#pragma unroll
        for (int b = 0; b < 2; ++b)
#pragma unroll
            for (int m = 0; m < 4; ++m)
#pragma unroll
                for (int n = 0; n < 2; ++n) acc[a][b][m][n] = (f32x4){0.f, 0.f, 0.f, 0.f};
    bf16x8 At[4][2], B0[2][2], B1[2][2];
    const char* cA = (const char*)g.A + (size_t)cur.pm * tstepA; const char* cB = (const char*)g.Bt + (size_t)cur.pn * tstep + (size_t)cur.e * estep;
    S.a_ready(cur);
    if constexpr (SP2) {
        PG8_STAGE(PG8_SB(0, 0), cB, voffB); PG8_STAGE(PG8_SB(0, 1), cB + hstep, voffB); PG8_STAGE(PG8_SA(0, 0), cA, voffA); PG8_STAGE(PG8_SA(0, 1), cA + hstepA, voffA);
        if (wr == 1) PG8_BAR;
        PG8_WAIT_V(2); PG8_BAR;
        PG8_STAGE(PG8_SB(1, 0), cB + kstep, voffB); PG8_STAGE(PG8_SA(1, 0), cA + kstep, voffA); PG8_STAGE(PG8_SB(1, 1), cB + hstep + kstep, voffB);
        PG8_WAIT_V(6); PG8_BAR;
    } else {
        PG8_STAGE(PG8_SB(0, 0), cB, voffB); PG8_STAGE(PG8_SA(0, 0), cA, voffA); PG8_STAGE(PG8_SB(0, 1), cB + hstep, voffB); PG8_STAGE(PG8_SA(0, 1), cA + hstepA, voffA);
        if (wr == 1) PG8_BAR;
        PG8_WAIT_V(4); PG8_BAR;
        PG8_STAGE(PG8_SB(1, 0), cB + kstep, voffB); PG8_STAGE(PG8_SA(1, 0), cA + kstep, voffA); PG8_STAGE(PG8_SB(1, 1), cB + hstep + kstep, voffB);
        PG8_WAIT_V(6); PG8_BAR;
    }
    for (;;) {
        const bool has_next = S.next(ui + 1, nxt);
        const char* nA = has_next ? (const char*)g.A + (size_t)nxt.pm * tstepA : cA; const char* nB = has_next ? (const char*)g.Bt + (size_t)nxt.pn * tstep + (size_t)nxt.e * estep : cB;
#pragma unroll 1
        for (int t = 0; t < nt; t += 2) {
            const bool last = (t == nt - 2);
            const char* a1 = cA + (size_t)(t + 1) * kstep;
            const char* a2 = last ? nA : cA + (size_t)(t + 2) * kstep; const char* b2 = last ? nB : cB + (size_t)(t + 2) * kstep;
            const char* a3 = a2 + kstep; const char* b3 = b2 + kstep;
            if (last && has_next) S.a_ready(nxt);
            if constexpr (SP2) {
            PG8_LDB(B0, 0, 0); PG8_LDB(B1, 0, 1); PG8_SCHED; PG8_LDA(At, 0, 0); PG8_STAGE(PG8_SA(1, 1), a1 + hstepA, voffA);
            PG8_WAIT_V(8); PG8_WAIT_L(0); PG8_BAR; PG8_MMA(0, 0, At, B0); PG8_MMA(0, 1, At, B1); PG8_BAR; PG8_SCHED;
            PG8_LDA(At, 0, 1); PG8_STAGE(PG8_SB(0, 0), b2, voffB); PG8_STAGE(PG8_SB(0, 1), b2 + hstep, voffB); PG8_STAGE(PG8_SA(0, 0), a2, voffA);
            PG8_WAIT_V(8); PG8_WAIT_L(0); PG8_BAR; PG8_MMA(1, 0, At, B0); PG8_MMA(1, 1, At, B1); PG8_BAR; PG8_SCHED;
            PG8_LDB(B0, 1, 0); PG8_LDB(B1, 1, 1); PG8_SCHED; PG8_LDA(At, 1, 0); PG8_STAGE(PG8_SA(0, 1), a2 + hstepA, voffA);
            PG8_WAIT_V(8); PG8_WAIT_L(0); PG8_BAR; PG8_MMA(0, 0, At, B0); PG8_MMA(0, 1, At, B1); PG8_BAR; PG8_SCHED;
            PG8_LDA(At, 1, 1); PG8_STAGE(PG8_SB(1, 0), b3, voffB); PG8_STAGE(PG8_SB(1, 1), b3 + hstep, voffB); PG8_STAGE(PG8_SA(1, 0), a3, voffA);
            PG8_WAIT_V(8); PG8_WAIT_L(0); PG8_BAR; PG8_MMA(1, 0, At, B0); PG8_MMA(1, 1, At, B1); PG8_BAR; PG8_SCHED;
            } else {
            PG8_LDB(B0, 0, 0); PG8_SCHED; PG8_LDA(At, 0, 0); PG8_STAGE(PG8_SA(1, 1), a1 + hstepA, voffA);
            PG8_WAIT_L(8); PG8_BAR; PG8_WAIT_L(0); PG8_MMA(0, 0, At, B0); PG8_BAR; PG8_SCHED;
            PG8_LDB(B1, 0, 1); PG8_STAGE(PG8_SB(0, 0), b2, voffB);
            PG8_BAR; PG8_WAIT_L(0); PG8_MMA(0, 1, At, B1); PG8_BAR;
            PG8_LDA(At, 0, 1); PG8_STAGE(PG8_SA(0, 0), a2, voffA);
            PG8_BAR; PG8_WAIT_L(0); PG8_MMA(1, 0, At, B0); PG8_BAR; PG8_SCHED;
            PG8_STAGE(PG8_SB(0, 1), b2 + hstep, voffB);
            PG8_WAIT_V(6); PG8_BAR; PG8_MMA(1, 1, At, B1); PG8_BAR;
            PG8_LDB(B0, 1, 0); PG8_SCHED; PG8_LDA(At, 1, 0); PG8_STAGE(PG8_SA(0, 1), a2 + hstepA, voffA);
            PG8_WAIT_L(8); PG8_BAR; PG8_WAIT_L(0); PG8_MMA(0, 0, At, B0); PG8_BAR; PG8_SCHED;
            PG8_LDB(B1, 1, 1); PG8_STAGE(PG8_SB(1, 0), b3, voffB);
            PG8_BAR; PG8_WAIT_L(0); PG8_MMA(0, 1, At, B1); PG8_BAR;
            PG8_LDA(At, 1, 1); PG8_STAGE(PG8_SA(1, 0), a3, voffA);
            PG8_BAR; PG8_WAIT_L(0); PG8_MMA(1, 0, At, B0); PG8_BAR; PG8_SCHED;
            PG8_STAGE(PG8_SB(1, 1), b3 + hstep, voffB);
            PG8_WAIT_V(6); PG8_BAR; PG8_MMA(1, 1, At, B1); PG8_BAR;
            }
        }
        if constexpr (ALIGN_EPI) { if (wr == 0) PG8_BAR; }
        if constexpr (F8 || I8) asm volatile("s_nop 15\n\ts_nop 15" ::: "memory");
        if constexpr (!Epi::AFTER_DRAIN) { E(acc, cur, wr, wc, fr, fq); S.done(cur); }
        if (!has_next) break;
#pragma unroll
        for (int a = 0; a < 2; ++a)
#pragma unroll
            for (int b = 0; b < 2; ++b)
#pragma unroll
                for (int m = 0; m < 4; ++m)
#pragma unroll
                    for (int n = 0; n < 2; ++n) acc[a][b][m][n] = (f32x4){0.f, 0.f, 0.f, 0.f};
        cur = nxt; cA = nA; cB = nB; ++ui;
        if constexpr (ALIGN_EPI) { if (wr == 1) PG8_BAR; }
    }
    PG8_WAIT_V(0);
    if constexpr (!ALIGN_EPI) { if (wr == 0) PG8_BAR; }
    PG8_BAR;
    if constexpr (Epi::AFTER_DRAIN) { E.fused(acc, cur, wr, wc, fr, fq, lds, wid, lane); S.done(cur); }
#undef PG8_SA
#undef PG8_SB
#undef PG8_STAGE
#undef PG8_LDA
#undef PG8_LDB
#undef PG8_MMA
#undef PG8_WAIT_V
#undef PG8_WAIT_L
#undef PG8_BAR
#undef PG8_SCHED
}
}

namespace pg8 {
typedef f32x4 Acc[2][2][4][2];
__device__ __forceinline__ u32x4 pack8(const f32x4 v0, const f32x4 v1) { u32x4 w; w.x = pk2(v0[0], v0[1]); w.y = pk2(v0[2], v0[3]); w.z = pk2(v1[0], v1[1]); w.w = pk2(v1[2], v1[3]); return w; }
__device__ __forceinline__ void unpack8(const u32x4 w, f32x4& a, f32x4& b) { a = (f32x4){bflo(w.x), bfhi(w.x), bflo(w.y), bfhi(w.y)}; b = (f32x4){bflo(w.z), bfhi(w.z), bflo(w.w), bfhi(w.w)}; }

struct EpiInE {
    static constexpr bool PERM = true, AFTER_DRAIN = false;
    bf16_t* Y1; float* ssq_q; float* ssq_kv;
    __device__ __forceinline__ void operator()(const Acc& acc, const Unit& u, int wr, int wc, int fr, int fq) const {
        bf16_t* base = Y1 + (size_t)u.pn * MTOK * 256;
        const float sc = (u.pn == 2 || u.pn == 3) ? QSCALE : 1.f;
        const int col0 = wc * 32 + 8 * fq;
#pragma unroll
        for (int ai = 0; ai < 2; ++ai)
#pragma unroll
            for (int m = 0; m < 4; ++m) {
                const int row = u.pm * BM + ai * HALF + wr * 64 + m * 16 + fr; bf16_t* rowp = base + (size_t)row * 256 + col0;
                float s0 = 0.f, s1 = 0.f;
#pragma unroll
                for (int bj = 0; bj < 2; ++bj) { const f32x4 v0 = acc[ai][bj][m][0], v1 = acc[ai][bj][m][1];
                    const float q = (v0[0] * v0[0] + v0[1] * v0[1]) + (v0[2] * v0[2] + v0[3] * v0[3]) + (v1[0] * v1[0] + v1[1] * v1[1]) + (v1[2] * v1[2] + v1[3] * v1[3]);
                    if (bj == 0) s0 = q; else s1 = q;
                    *(u32x4*)(rowp + bj * HALF) = pack8(v0 * sc, v1 * sc); }
                if (u.pn <= 1) {
                    float s = (u.pn == 0) ? (s0 + s1) : s0;
                    s += __shfl_xor(s, 16); s += __shfl_xor(s, 32);
                    if (fq == 0) (u.pn == 0 ? ssq_q : ssq_kv)[(size_t)row * 4 + wc] = s;
                }
            }
    }
};
struct EpiQ2 {
    static constexpr bool PERM = true, AFTER_DRAIN = false;
    bf16_t* QLAT; bf16_t* QIDX; const float* ssq_q;
    __device__ __forceinline__ void operator()(const Acc& acc, const Unit& u, int wr, int wc, int fr, int fq) const {
        bf16_t* base = (u.pn < 4) ? QLAT : QIDX; const float sc0 = (u.pn < 4) ? QSCALE : 1.f;
        const int col0 = (u.pn & 3) * 256 + wc * 32 + 8 * fq;
#pragma unroll
        for (int ai = 0; ai < 2; ++ai)
#pragma unroll
            for (int m = 0; m < 4; ++m) {
                const int row = u.pm * BM + ai * HALF + wr * 64 + m * 16 + fr; bf16_t* rowp = base + (size_t)row * 1024 + col0;
                const f32x4 sq = *(const f32x4*)(ssq_q + (size_t)row * 4); const float sc = sc0 * __builtin_amdgcn_rsqf(((sq[0] + sq[1]) + (sq[2] + sq[3])) * (1.f / 256.f) + 1e-6f);
#pragma unroll
                for (int bj = 0; bj < 2; ++bj) *(u32x4*)(rowp + bj * HALF) = pack8(acc[ai][bj][m][0] * sc, acc[ai][bj][m][1] * sc);
            }
    }
};
template <bool RES_F32> struct EpiRes {
    static constexpr bool PERM = true, AFTER_DRAIN = false;
    const void* res; bf16_t* S; float sc;
    __device__ __forceinline__ void operator()(const Acc& acc, const Unit& u, int wr, int wc, int fr, int fq) const {
        const int col0 = u.pn * BM + wc * 32 + 8 * fq;
#pragma unroll
        for (int ai = 0; ai < 2; ++ai)
#pragma unroll
            for (int m = 0; m < 4; ++m) {
                const size_t off = (size_t)(u.pm * BM + ai * HALF + wr * 64 + m * 16 + fr) * 1024 + col0;
#pragma unroll
                for (int bj = 0; bj < 2; ++bj) { f32x4 r0, r1;
                    if (RES_F32) { r0 = *(const f32x4*)((const float*)res + off + bj * HALF); r1 = *(const f32x4*)((const float*)res + off + bj * HALF + 4); }
                    else unpack8(*(const u32x4*)((const bf16_t*)res + off + bj * HALF), r0, r1);
                    *(u32x4*)(S + off + bj * HALF) = pack8(r0 * ALPHA + acc[ai][bj][m][0] * sc, r1 * ALPHA + acc[ai][bj][m][1] * sc); }
            }
    }
};
struct EpiSwiglu {
    static constexpr bool PERM = true, AFTER_DRAIN = false;
    bf16_t* O; int ldo; int pm0;
    __device__ __forceinline__ void operator()(const Acc& acc, const Unit& u, int wr, int wc, int fr, int fq) const {
        const int col0 = u.pn * HALF + wc * 32 + 8 * fq;
#pragma unroll
        for (int ai = 0; ai < 2; ++ai)
#pragma unroll
            for (int m = 0; m < 4; ++m) {
                bf16_t* rowp = O + (size_t)((u.pm - pm0) * BM + ai * HALF + wr * 64 + m * 16 + fr) * ldo + col0;
                f32x4 o[2];
#pragma unroll
                for (int n = 0; n < 2; ++n) { const f32x4 a = acc[ai][0][m][n], b = acc[ai][1][m][n];
#pragma unroll
                    for (int e = 0; e < 4; ++e) o[n][e] = a[e] * __builtin_amdgcn_rcpf(1.f + __expf(-a[e])) * b[e]; }
                *(u32x4*)rowp = pack8(o[0], o[1]);
            }
    }
};
struct EpiStore {
    static constexpr bool PERM = true, AFTER_DRAIN = false;
    bf16_t* O; int ldo;
    __device__ __forceinline__ void operator()(const Acc& acc, const Unit& u, int wr, int wc, int fr, int fq) const {
        const int col0 = u.pn * BM + wc * 32 + 8 * fq;
#pragma unroll
        for (int ai = 0; ai < 2; ++ai)
#pragma unroll
            for (int m = 0; m < 4; ++m) {
                bf16_t* rowp = O + (size_t)(u.pm * BM + ai * HALF + wr * 64 + m * 16 + fr) * ldo + col0;
#pragma unroll
                for (int bj = 0; bj < 2; ++bj) *(u32x4*)(rowp + bj * HALF) = pack8(acc[ai][bj][m][0], acc[ai][bj][m][1]);
            }
    }
};
struct EpiInO {
    static constexpr bool PERM = true, AFTER_DRAIN = false;
    bf16_t* QKV; float* kmean; float isc;
    __device__ __forceinline__ void operator()(const Acc& acc, const Unit& u, int wr, int wc, int fr, int fq) const {
        const int which = u.pn >> 2; bf16_t* base = QKV + (size_t)which * MTOK * 1024; const float sc = (which == 0) ? QSCALE * isc : isc;
        const int col0 = (u.pn & 3) * BM + wc * 32 + 8 * fq;
#pragma unroll
        for (int ai = 0; ai < 2; ++ai)
#pragma unroll
            for (int m = 0; m < 4; ++m) {
                bf16_t* rowp = base + (size_t)(u.pm * BM + ai * HALF + wr * 64 + m * 16 + fr) * 1024 + col0;
#pragma unroll
                for (int bj = 0; bj < 2; ++bj) *(u32x4*)(rowp + bj * HALF) = pack8(acc[ai][bj][m][0] * sc, acc[ai][bj][m][1] * sc);
            }
        if (which == 1) {
#pragma unroll
            for (int bj = 0; bj < 2; ++bj)
#pragma unroll
                for (int n = 0; n < 2; ++n) { f32x4 s = (f32x4){0.f, 0.f, 0.f, 0.f};
#pragma unroll
                    for (int ai = 0; ai < 2; ++ai)
#pragma unroll
                        for (int m = 0; m < 4; ++m) s += acc[ai][bj][m][n];
#pragma unroll
                    for (int e = 0; e < 4; ++e) { float v = s[e]; v += __shfl_xor(v, 1); v += __shfl_xor(v, 2); v += __shfl_xor(v, 4); v += __shfl_xor(v, 8);
                        if (fr == 0) kmean[((size_t)u.pm * 2 + wr) * 1024 + col0 + bj * HALF + 4 * n + e] = v; }
                }
        }
    }
};

__device__ __forceinline__ unsigned pk4_fp8(float a, float b, float c, float d) { int w = 0; w = __builtin_amdgcn_cvt_pk_fp8_f32(a, b, w, false); w = __builtin_amdgcn_cvt_pk_fp8_f32(c, d, w, true); return (unsigned)w; }
struct EpiSwiglu8 {
    static constexpr bool PERM = true, AFTER_DRAIN = false;
    unsigned char* O; int ldo; int pm0; float isc;
    __device__ __forceinline__ void operator()(const Acc& acc, const Unit& u, int wr, int wc, int fr, int fq) const {
        const int col0 = u.pn * HALF + wc * 32 + 8 * fq;
#pragma unroll
        for (int ai = 0; ai < 2; ++ai)
#pragma unroll
            for (int m = 0; m < 4; ++m) {
                unsigned char* rowp = O + (size_t)((u.pm - pm0) * BM + ai * HALF + wr * 64 + m * 16 + fr) * ldo + col0;
                f32x4 o[2];
#pragma unroll
                for (int n = 0; n < 2; ++n) { const f32x4 a = acc[ai][0][m][n] * isc, b = acc[ai][1][m][n] * isc;
#pragma unroll
                    for (int e = 0; e < 4; ++e) o[n][e] = a[e] * __builtin_amdgcn_rcpf(1.f + __expf(-a[e])) * b[e]; }
                u32x2 w; w.x = pk4_fp8(o[0][0], o[0][1], o[0][2], o[0][3]); w.y = pk4_fp8(o[1][0], o[1][1], o[1][2], o[1][3]);
                *(u32x2*)rowp = w;
            }
    }
};

struct EpiSwigluI8 {
    static constexpr bool PERM = true, AFTER_DRAIN = false;
    unsigned char* O; int ldo; const float* sa; const float* sw;
    __device__ __forceinline__ void operator()(const Acc& acc, const Unit& u, int wr, int wc, int fr, int fq) const {
        const int col0 = u.pn * HALF + wc * 32 + 8 * fq, bcol = u.pn * BM + wc * 32 + 8 * fq;
        f32x4 w1s[2], w3s[2];
#pragma unroll
        for (int n = 0; n < 2; ++n) { w1s[n] = *(const f32x4*)(sw + bcol + 4 * n); w3s[n] = *(const f32x4*)(sw + bcol + HALF + 4 * n); }
#pragma unroll
        for (int ai = 0; ai < 2; ++ai)
#pragma unroll
            for (int m = 0; m < 4; ++m) {
                const int row = u.pm * BM + ai * HALF + wr * 64 + m * 16 + fr; const float ra = sa[row];
                unsigned char* rowp = O + (size_t)row * ldo + col0;
                f32x4 o[2];
#pragma unroll
                for (int n = 0; n < 2; ++n) {
#pragma unroll
                    for (int e = 0; e < 4; ++e) { const float xa = acc[ai][0][m][n][e], xb = acc[ai][1][m][n][e];
                        const float a = (float)__float_as_int(xa) * ra * w1s[n][e], b = (float)__float_as_int(xb) * ra * w3s[n][e];
                        o[n][e] = a * __builtin_amdgcn_rcpf(1.f + __expf(-a)) * b; } }
                u32x2 w; w.x = pk4_fp8(o[0][0], o[0][1], o[0][2], o[0][3]); w.y = pk4_fp8(o[1][0], o[1][1], o[1][2], o[1][3]);
                *(u32x2*)rowp = w;
            }
    }
};
struct EpiStoreS {
    static constexpr bool PERM = true, AFTER_DRAIN = false;
    bf16_t* O; int ldo; float sc;
    __device__ __forceinline__ void operator()(const Acc& acc, const Unit& u, int wr, int wc, int fr, int fq) const {
        const int col0 = u.pn * BM + wc * 32 + 8 * fq;
#pragma unroll
        for (int ai = 0; ai < 2; ++ai)
#pragma unroll
            for (int m = 0; m < 4; ++m) {
                bf16_t* rowp = O + (size_t)(u.pm * BM + ai * HALF + wr * 64 + m * 16 + fr) * ldo + col0;
#pragma unroll
                for (int bj = 0; bj < 2; ++bj) *(u32x4*)(rowp + bj * HALF) = pack8(acc[ai][bj][m][0] * sc, acc[ai][bj][m][1] * sc);
            }
    }
};
struct MoeOrder {
    int g0, ng, nN, G, c; int pend[8];
    __device__ __forceinline__ bool next(int i, Unit& u) const {
        const int L = i * G + c; if (L >= ng * nN) return false;
        u.pm = g0 + L % ng; u.pn = L / ng; const int r = u.pm * 256; int e = 0;
#pragma unroll
        for (int k = 0; k < 7; ++k) e += (pend[k] <= r) ? 1 : 0;
        u.e = e; return true;
    }
    __device__ __forceinline__ void a_ready(const Unit&) const {}
    __device__ __forceinline__ void done(const Unit&) const {}
};
}

#ifndef FFN_F8
#define FFN_F8 0
#endif
constexpr size_t MiB = 1u << 20, KiB = 1u << 10;
constexpr size_t CTL_ZERO_BYTES = 2 * MiB;
constexpr int    MAX_LAUNCHES = 18;
constexpr size_t OFF_BAR = 16 * KiB;
constexpr size_t OFF_WGCNT = 1 * MiB + 512 * KiB;
constexpr size_t OFF_GINFO = OFF_WGCNT + 16 * KiB;
constexpr size_t OFF_DBG = OFF_GINFO + 1 * KiB;
constexpr size_t OFF_BT = 2 * MiB;
constexpr size_t OFF_CB = 2 * MiB + 16 * KiB;
constexpr size_t OFF_ROUTE = 2 * MiB + 64 * KiB;
constexpr size_t OFF_DEST = 2 * MiB + 512 * KiB;
constexpr size_t OFF_KC = 3 * MiB, OFF_VC = 3 * MiB + 512 * KiB;
constexpr size_t OFF_W_IN = 4 * MiB, OFF_W_Q2 = OFF_W_IN + (size_t)EVEN_INP * 1024 * 2, OFF_W_OUTE = OFF_W_Q2 + 2048 * 256 * 2, OFF_W_F13 = OFF_W_OUTE + 1024 * 1536 * 2,
                 OFF_W_F2 = OFF_W_F13 + (size_t)2 * DFF * 1024 * 2, OFF_CK1 = OFF_W_F2 + (size_t)1024 * DFF * 2, OFF_CV1 = OFF_CK1 + 64 * 2048 * 2, OFF_WE_END = OFF_CV1 + 64 * 2048 * 2;
static_assert(OFF_WE_END <= 30 * MiB, "even weights");
constexpr size_t OFF_W_OIN = 30 * MiB, OFF_W_OOUT = 36 * MiB, OFF_W_M13 = 38 * MiB, OFF_W_M2 = 94 * MiB;
constexpr size_t OFF_Y1 = 30 * MiB;
constexpr size_t OFF_CKVN = 142 * MiB;
constexpr size_t OFF_XB = 206 * MiB, OFF_QLAT = 206 * MiB, OFF_QIDX = 270 * MiB;
constexpr size_t OFF_SC = 334 * MiB, OFF_MASK = 464 * MiB, OFF_MIXIN = 334 * MiB;
constexpr size_t OFF_S1 = 206 * MiB, OFF_H = 270 * MiB, OFF_ACT = 30 * MiB, OFF_S2 = 334 * MiB, OFF_X1 = 398 * MiB, OFF_H8 = 464 * MiB;
constexpr size_t OFF_SA = 497 * MiB, OFF_SW = 497 * MiB + 256 * KiB, OFF_SAX = 497 * MiB + 512 * KiB, OFF_SWIN = 497 * MiB + 768 * KiB;
constexpr size_t OFF_X18 = 464 * MiB, OFF_O8 = 464 * MiB;
constexpr float OSC = 16.f, WOUT_SCALE = 64.f, WIN_SCALE = 32.f, WF13_SCALE = 32.f, WF2_SCALE = 128.f;
constexpr size_t OFF_QKV = 206 * MiB, OFF_S1O = 270 * MiB, OFF_H2 = 122 * MiB, OFF_ACTM = 186 * MiB, OFF_YR = 298 * MiB, OFF_XR = 430 * MiB;
constexpr float W13_SCALE = 32.f, W2_SCALE = 128.f;
constexpr size_t OFF_MST = 122 * MiB;
constexpr size_t OFF_SSQ_Q = 514 * MiB, OFF_SSQ_KV = 514 * MiB + 512 * KiB;
constexpr size_t OFF_KMEAN = 515 * MiB;
constexpr size_t WS_END = 516 * MiB;
constexpr int    MOE_CHUNK = 128;
constexpr size_t SCB_ELEMS = (size_t)64 * 64 * (64 * 65 / 2);

constexpr int LDS_BYTES = 160 * 1024;
constexpr int LDSCTL_OFF = LDS_BYTES - 512;

#define RLX_AGENT __ATOMIC_RELAXED, __HIP_MEMORY_SCOPE_AGENT
typedef GAS unsigned gu32;
#define XB_TMO      128
#define XB_XCNT(j)  (256  + 64 * (j))
#define XB_XSUB(j)  (1280 + 64 * (j))
#define XB_XGEN(j)  (2304 + 64 * (j))
#define XB_TOP      3328
#define XB_TOPGEN   3392
#define XCD_BAR_WORDS 3456
#define XB_SPIN_CAP (1u << 18)

__device__ __forceinline__ unsigned xb_ld(unsigned* p)              { return __hip_atomic_load(p, __ATOMIC_RELAXED, __HIP_MEMORY_SCOPE_AGENT); }
__device__ __forceinline__ unsigned xb_add(unsigned* p, unsigned v) { return __hip_atomic_fetch_add(p, v, __ATOMIC_RELAXED, __HIP_MEMORY_SCOPE_AGENT); }
__device__ __forceinline__ unsigned xb_xcc_id() { return (unsigned)__builtin_amdgcn_s_getreg((3 << 11) | 20) & 0xFu; }
#define XB_SPIN(cond, bar) do { unsigned _sp = 0; while (cond) { __builtin_amdgcn_s_sleep(1); \
    if ((++_sp & 255u) == 0u) { if (xb_ld(&(bar)[XB_TMO])) break; if (_sp > XB_SPIN_CAP) { atomicAdd(&(bar)[XB_TMO], 1u); break; } } } } while (0)

struct XcdBarrier {
    unsigned* bar; unsigned x;
    volatile LAS unsigned* st;
};

__device__ __forceinline__ XcdBarrier xcd_barrier_post(unsigned* bar, volatile LAS unsigned* st) {
    XcdBarrier b; b.bar = bar; b.x = xb_xcc_id(); b.st = st;
    if (threadIdx.x == 0) (void)xb_add(&bar[XB_XCNT(b.x)], 1u);
    return b;
}
__device__ __forceinline__ void xcd_barrier_complete(unsigned* bar, unsigned x, unsigned& nloc, unsigned& nx) {
    const unsigned G = gridDim.x * gridDim.y * gridDim.z;
    unsigned sum, cnt, mine, sp = 0u;
    for (;;) {
        sum = 0u; cnt = 0u; mine = 0u;
#pragma unroll
        for (unsigned j = 0; j < 16; ++j) { const unsigned c = xb_ld(&bar[XB_XCNT(j)]); sum += c; cnt += (c > 0u) ? 1u : 0u; mine = (j == x) ? c : mine; }
        if (sum == G) break;
        __builtin_amdgcn_s_sleep(1);
        if ((++sp & 255u) == 0u) { if (xb_ld(&bar[XB_TMO])) break; if (sp > XB_SPIN_CAP) { atomicAdd(&bar[XB_TMO], 1u); break; } }
    }
    nloc = mine > 0u ? mine : 1u; nx = cnt > 0u ? cnt : 1u;
}

__device__ __forceinline__ void xcd_barrier(const XcdBarrier& b) {
    asm volatile("s_waitcnt vmcnt(0)" ::: "memory");
    __syncthreads();
    if (threadIdx.x == 0) {
        unsigned* bar = b.bar;
        __builtin_amdgcn_s_waitcnt(0);
        unsigned nloc = b.st[0], nx = b.st[1];
        if (nloc == 0u) { xcd_barrier_complete(bar, b.x, nloc, nx); b.st[0] = nloc; b.st[1] = nx; }
        const unsigned old = xb_add(&bar[XB_XSUB(b.x)], 1u);
        const unsigned gen = old / nloc;
        if (old + 1u == (gen + 1u) * nloc) {
            __builtin_amdgcn_fence(__ATOMIC_RELEASE, "agent");
            asm volatile("s_waitcnt vmcnt(0)" ::: "memory");
            const unsigned og = xb_add(&bar[XB_TOP], 1u);
            const unsigned tg = og / nx;
            if (og + 1u == (tg + 1u) * nx) xb_add(&bar[XB_TOPGEN], 1u);
            else XB_SPIN(xb_ld(&bar[XB_TOPGEN]) == tg, bar);
            __builtin_amdgcn_fence(__ATOMIC_ACQUIRE, "agent");
            xb_add(&bar[XB_XGEN(b.x)], 1u);
            asm volatile("s_waitcnt vmcnt(0)" ::: "memory");
        } else {
            XB_SPIN(xb_ld(&bar[XB_XGEN(b.x)]) == gen, bar);
            __builtin_amdgcn_fence(__ATOMIC_ACQUIRE, "agent");
            asm volatile("s_waitcnt vmcnt(0)" ::: "memory");
        }
    }
    __syncthreads();
}

struct Frame {
    LAS unsigned char* lds;
    int tid, lane, wave, G, bx;
    int gw, NGW;
    unsigned char* ws;
    const float* const* in;
};
struct Args { const float* in[33]; float* out; unsigned char* ws; int ph_lo, ph_hi, li, pad; };
enum InIdx { I_X = 0, I_RELB, I_EWIN, I_EQN, I_EKVN, I_EWUQ, I_EWUK, I_EWUV, I_EWQIDX, I_EPOSK, I_EPOSV, I_ECK1, I_ECK2, I_ECV1, I_ECV2, I_EWOUT, I_ELN1G, I_ELN1B,
             I_EF1, I_EF3, I_EF2, I_ELN2G, I_ELN2B, I_OWIN, I_OWOUT, I_OLN1G, I_OLN1B, I_OROUTER, I_OM1, I_OM3, I_OM2, I_OLN2G, I_OLN2B };

template <class RowMap, class KScale>
__device__ __forceinline__ void transpose_item(const float* W, int K, int N, bf16_t* WT, int ldt, LAS float* scr, int item, int lane, RowMap rm, KScale ks) {
    const int nblk = (N + 63) >> 6, kb = item / nblk, nb = item - kb * nblk, k0 = 128 * kb, n = 64 * nb + lane;
    if (n >= N) return;
    const float* src = W + (size_t)k0 * N + n; bf16_t* dst = WT + (size_t)rm(n) * ldt + k0;
#pragma unroll 2
    for (int kk = 0; kk < 128; kk += 8) { float v[8];
#pragma unroll
        for (int i = 0; i < 8; ++i) v[i] = src[(size_t)(kk + i) * N] * ks(k0 + kk + i);
        u32x4 o; o.x = pk2(v[0], v[1]); o.y = pk2(v[2], v[3]); o.z = pk2(v[4], v[5]); o.w = pk2(v[6], v[7]);
        *(u32x4*)(dst + kk) = o; }
}
template <class RowMap>
__device__ __forceinline__ void transpose_item8(const float* W, int K, int N, unsigned char* WT, int ldt, int item, int lane, RowMap rm, float scale) {
    const int nblk = N >> 8, kb = item / nblk, nb = item - kb * nblk, k0 = 128 * kb, n = 256 * nb + 4 * lane;
    const float* src = W + (size_t)k0 * N + n;
    unsigned char* d0 = WT + (size_t)rm(n) * ldt + k0; unsigned char* d1 = WT + (size_t)rm(n + 1) * ldt + k0; unsigned char* d2 = WT + (size_t)rm(n + 2) * ldt + k0; unsigned char* d3 = WT + (size_t)rm(n + 3) * ldt + k0;
#pragma unroll 1
    for (int kk = 0; kk < 128; kk += 16) { f32x4 v[16];
#pragma unroll
        for (int i = 0; i < 16; ++i) v[i] = *(const f32x4*)(src + (size_t)(kk + i) * N) * scale;
#pragma unroll
        for (int c = 0; c < 4; ++c) { u32x4 o; o.x = pg8::pk4_fp8(v[0][c], v[1][c], v[2][c], v[3][c]); o.y = pg8::pk4_fp8(v[4][c], v[5][c], v[6][c], v[7][c]);
            o.z = pg8::pk4_fp8(v[8][c], v[9][c], v[10][c], v[11][c]); o.w = pg8::pk4_fp8(v[12][c], v[13][c], v[14][c], v[15][c]);
            *(u32x4*)((c == 0 ? d0 : c == 1 ? d1 : c == 2 ? d2 : d3) + kk) = o; } }
}
template <class RowMap>
__device__ __forceinline__ void transpose_item_i8(const float* W, int K, int N, unsigned char* WT, int ldt, float* sw, int item, int lane, RowMap rm) {
    const int c = lane & 7, kg = lane >> 3, n = 8 * item + c, ks = K >> 3, kbase = kg * ks;
    const float* src = W + (size_t)kbase * N + n; float mx = 0.f;
#pragma unroll 16
    for (int k = 0; k < ks; ++k) mx = fmaxf(mx, fabsf(src[(size_t)k * N]));
    mx = fmaxf(mx, __shfl_xor(mx, 8)); mx = fmaxf(mx, __shfl_xor(mx, 16)); mx = fmaxf(mx, __shfl_xor(mx, 32));
    mx = fmaxf(mx, 1e-20f); const float inv = 127.f / mx; const int dr = rm(n); if (kg == 0) sw[dr] = mx * (1.f / 127.f);
    unsigned char* dst = WT + (size_t)dr * ldt + kbase;
#pragma unroll 2
    for (int kk = 0; kk < ks; kk += 16) { unsigned w[4];
#pragma unroll
        for (int q = 0; q < 4; ++q) { const int q0 = (int)rintf(src[(size_t)(kk + 4 * q) * N] * inv), q1 = (int)rintf(src[(size_t)(kk + 4 * q + 1) * N] * inv), q2 = (int)rintf(src[(size_t)(kk + 4 * q + 2) * N] * inv), q3 = (int)rintf(src[(size_t)(kk + 4 * q + 3) * N] * inv);
            w[q] = (unsigned)(q0 & 255) | ((unsigned)(q1 & 255) << 8) | ((unsigned)(q2 & 255) << 16) | ((unsigned)(q3 & 255) << 24); }
        *(u32x4*)(dst + kk) = (u32x4){w[0], w[1], w[2], w[3]}; }
}
struct RowId { __device__ __forceinline__ int operator()(int n) const { return n; } };
struct KOne { __device__ __forceinline__ float operator()(int) const { return 1.f; } };
struct RowInE {
    __device__ __forceinline__ int operator()(int n) const { return n < 464 ? n : (n < 1744 ? n + 48 : n - 1744 + 464); }
};
struct RowIlv {
    int add; __device__ __forceinline__ int operator()(int n) const { return ((n >> 7) << 8) + (n & 127) + add; }
};
struct KGain { const float* g; __device__ __forceinline__ float operator()(int k) const { return g[k]; } };

__device__ __forceinline__ void store_row_i8(unsigned char* row, float* sa, int lane, const f32x4 (&v)[4]) {
    float mx = 0.f;
#pragma unroll
    for (int j = 0; j < 4; ++j) mx = fmaxf(fmaxf(mx, fmaxf(fabsf(v[j][0]), fabsf(v[j][1]))), fmaxf(fabsf(v[j][2]), fabsf(v[j][3])));
#pragma unroll
    for (int o = 1; o < 64; o <<= 1) mx = fmaxf(mx, __shfl_xor(mx, o));
    mx = fmaxf(mx, 1e-20f); const float inv = 127.f / mx;
#pragma unroll
    for (int j = 0; j < 4; ++j) { const int q0 = (int)rintf(v[j][0] * inv), q1 = (int)rintf(v[j][1] * inv), q2 = (int)rintf(v[j][2] * inv), q3 = (int)rintf(v[j][3] * inv);
        *(unsigned*)(row + 4 * lane + 256 * j) = (unsigned)(q0 & 255) | ((unsigned)(q1 & 255) << 8) | ((unsigned)(q2 & 255) << 16) | ((unsigned)(q3 & 255) << 24); }
    if (lane == 0) *sa = mx * (1.f / 127.f);
}
__device__ __forceinline__ int t5_bucket(int n) {
    if (n < 16) return n;
    int l = 16 + (int)(__logf((float)n / 16.f) / 2.0794415f * 16.f);
    return l < 31 ? l : 31;
}

__device__ __forceinline__ void phase_prologue_even(const Frame& F, const Args& a) {
    LAS float* scr = (LAS float*)(F.lds + F.wave * 8704);
    unsigned char* ws = F.ws;
    bf16_t* W_IN = (bf16_t*)(ws + OFF_W_IN); bf16_t* W_Q2 = (bf16_t*)(ws + OFF_W_Q2); unsigned char* W_OUTE = ws + OFF_W_OUTE;
    unsigned char* W_F13 = ws + OFF_W_F13; unsigned char* W_F2 = ws + OFF_W_F2; bf16_t* CK1 = (bf16_t*)(ws + OFF_CK1); bf16_t* CV1 = (bf16_t*)(ws + OFF_CV1);
    constexpr int I_IN = 8 * ((EVEN_IN + 63) / 64);
    constexpr int I_QI = 2 * 16;
    constexpr int I_OB = 4 * 4;
    constexpr int I_F1 = DFF / 8, I_F2 = (DFF / 128) * 4;
    constexpr int I_CK = 16 * 1;
    constexpr int NIT = I_IN + I_QI + I_OB + 2 * I_F1 + I_F2 + 2 * I_CK;
    for (int it = F.gw; it < NIT; it += F.NGW) {
        int r = it;
        if (r < I_IN) { transpose_item(a.in[I_EWIN], 1024, EVEN_IN, W_IN, 1024, scr, r, F.lane, RowInE{}, KOne{}); continue; } r -= I_IN;
        if (r < I_QI) { transpose_item(a.in[I_EWQIDX], 256, 1024, W_Q2 + 1024 * 256, 256, scr, r, F.lane, RowId{}, KGain{a.in[I_EQN]}); continue; } r -= I_QI;
        if (r < I_OB) { transpose_item8(a.in[I_EWOUT] + 512 * 1024, 512, 1024, W_OUTE + 1024, 1536, r, F.lane, RowId{}, WOUT_SCALE); continue; } r -= I_OB;
#if FFN_F8
        if (r < I_F1) { transpose_item8(a.in[I_EF1], 1024, DFF, W_F13, 1024, r, F.lane, RowIlv{0}, WF13_SCALE); continue; } r -= I_F1;
        if (r < I_F1) { transpose_item8(a.in[I_EF3], 1024, DFF, W_F13, 1024, r, F.lane, RowIlv{128}, WF13_SCALE); continue; } r -= I_F1;
        if (r < I_F2) { transpose_item8(a.in[I_EF2], DFF, 1024, W_F2, DFF, r, F.lane, RowId{}, WF2_SCALE); continue; } r -= I_F2;
#else
        if (r < I_F1) { transpose_item_i8(a.in[I_EF1], 1024, DFF, W_F13, 1024, (float*)(ws + OFF_SW), r, F.lane, RowIlv{0}); continue; } r -= I_F1;
        if (r < I_F1) { transpose_item_i8(a.in[I_EF3], 1024, DFF, W_F13, 1024, (float*)(ws + OFF_SW), r, F.lane, RowIlv{128}); continue; } r -= I_F1;
        if (r < I_F2) { transpose_item8(a.in[I_EF2], DFF, 1024, W_F2, DFF, r, F.lane, RowId{}, WF2_SCALE); continue; } r -= I_F2;
#endif
        if (r < I_CK) { transpose_item(a.in[I_ECK1], 2048, 64, CK1, 2048, scr, r, F.lane, RowId{}, KOne{}); continue; } r -= I_CK;
        transpose_item(a.in[I_ECV1], 2048, 64, CV1, 2048, scr, r, F.lane, RowId{}, KOne{});
    }
    const int gt = F.bx * NTHR + F.tid, NGT = F.G * NTHR;
    for (int i = gt; i < 24 * 1024 / 8; i += NGT) ((u32x4*)(W_IN + 488 * 1024))[i] = (u32x4){0u, 0u, 0u, 0u};
    { const float* uq = a.in[I_EWUQ]; const float* uk = a.in[I_EWUK]; const float* qg = a.in[I_EQN];
      for (int o = gt; o < 1024 * 256; o += NGT) { const int r = o & 255, hc = o >> 8, h = hc >> 7, c = hc & 127; const float* p = uq + r * 512 + h * 64; const float* q = uk + c * 512 + h * 64; float s = 0.f;
#pragma unroll 8
          for (int d = 0; d < 64; ++d) s += p[d] * q[d];
          W_Q2[o] = (bf16_t)f2bf(s * qg[r]); } }
    { const float* uv = a.in[I_EWUV]; const float* wo = a.in[I_EWOUT];
      for (int o = gt; o < 1024 * 1024 / 16; o += NGT) { const int nb = o & 255, hc4 = o >> 8, h = hc4 >> 5, c0 = (hc4 & 31) * 4, n0 = nb * 4;
          const float* p = uv + (size_t)c0 * 512 + h * 64; const float* q = wo + (size_t)(h * 64) * 1024 + n0;
          f32x4 acc4[4] = {(f32x4){0.f, 0.f, 0.f, 0.f}, (f32x4){0.f, 0.f, 0.f, 0.f}, (f32x4){0.f, 0.f, 0.f, 0.f}, (f32x4){0.f, 0.f, 0.f, 0.f}};
#pragma unroll 4
          for (int d = 0; d < 64; ++d) { const f32x4 qv = *(const f32x4*)(q + (size_t)d * 1024);
#pragma unroll
              for (int cc = 0; cc < 4; ++cc) acc4[cc] += qv * p[cc * 512 + d]; }
#pragma unroll
          for (int cc = 0; cc < 4; ++cc)
#pragma unroll
              for (int e = 0; e < 4; ++e) W_OUTE[(size_t)(n0 + e) * 1536 + h * 128 + c0 + cc] = (unsigned char)(__builtin_amdgcn_cvt_pk_fp8_f32(acc4[cc][e] * WOUT_SCALE, 0.f, 0, false) & 0xff); } }
    if (F.bx == 0) { float* BT = (float*)(ws + OFF_BT); const float* rb = a.in[I_RELB];
        for (int i = F.tid; i < 16 * 128; i += NTHR) { const int h = i >> 7, d = i & 127; BT[i] = rb[t5_bucket(d) * 16 + h] * LOG2E; } }
    if (F.bx == 1 && F.tid < 128) { const int kv = F.tid >> 6, e = F.tid & 63; const float* pos = a.in[kv ? I_EPOSV : I_EPOSK]; const float* w1 = a.in[kv ? I_ECV1 : I_ECK1]; float s = 0.f;
        for (int k = 0; k < 2048; ++k) s += pos[k] * w1[k * 64 + e];
        ((float*)(ws + OFF_CB))[F.tid] = s; }
    { const f32x4* x4 = (const f32x4*)a.in[I_X]; u32x4* xb = (u32x4*)(ws + OFF_XB);
      for (int i = gt; i < MTOK * 1024 / 8; i += NGT) { const f32x4 v0 = x4[2 * i], v1 = x4[2 * i + 1]; xb[i] = pg8::pack8(v0, v1); } }
}

__device__ __forceinline__ void phase_convert_odd(const Frame& F, const Args& a) {
    LAS float* scr = (LAS float*)(F.lds + F.wave * 8704);
    unsigned char* ws = F.ws;
    unsigned char* W_OIN = ws + OFF_W_OIN; unsigned char* W_OOUT = ws + OFF_W_OOUT; unsigned char* W_M13 = ws + OFF_W_M13; unsigned char* W_M2 = ws + OFF_W_M2;
    constexpr int I_IN = 8 * 12, I_OUT = 8 * 4, I_M1 = 8 * (DFFE / 256), I_M2 = (DFFE / 128) * 4;
    constexpr int NIT = I_IN + I_OUT + NEXP * (2 * I_M1 + I_M2);
    for (int it = F.gw; it < NIT; it += F.NGW) {
        int r = it;
        if (r < I_IN) { transpose_item8(a.in[I_OWIN], 1024, 3072, W_OIN, 1024, r, F.lane, RowId{}, WIN_SCALE); continue; } r -= I_IN;
        if (r < I_OUT) { transpose_item8(a.in[I_OWOUT], 1024, 1024, W_OOUT, 1024, r, F.lane, RowId{}, WOUT_SCALE); continue; } r -= I_OUT;
        const int e = r / (2 * I_M1 + I_M2); r -= e * (2 * I_M1 + I_M2);
        if (r < I_M1) { transpose_item8(a.in[I_OM1] + (size_t)e * 1024 * DFFE, 1024, DFFE, W_M13 + (size_t)e * 2 * DFFE * 1024, 1024, r, F.lane, RowIlv{0}, W13_SCALE); continue; } r -= I_M1;
        if (r < I_M1) { transpose_item8(a.in[I_OM3] + (size_t)e * 1024 * DFFE, 1024, DFFE, W_M13 + (size_t)e * 2 * DFFE * 1024, 1024, r, F.lane, RowIlv{128}, W13_SCALE); continue; } r -= I_M1;
        transpose_item8(a.in[I_OM2] + (size_t)e * DFFE * 1024, DFFE, 1024, W_M2 + (size_t)e * 1024 * DFFE, DFFE, r, F.lane, RowId{}, W2_SCALE);
    }
}

__device__ __forceinline__ void load_row_bf16(const bf16_t* row, int lane, f32x4 (&v)[4]) {
#pragma unroll
    for (int j = 0; j < 4; ++j) { const u32x2 w = *(const u32x2*)(row + 4 * lane + 256 * j); v[j] = (f32x4){bflo(w.x), bfhi(w.x), bflo(w.y), bfhi(w.y)}; }
}
__device__ __forceinline__ void store_row_bf16(bf16_t* row, int lane, const f32x4 (&v)[4]) {
#pragma unroll
    for (int j = 0; j < 4; ++j) { u32x2 w; w.x = pk2(v[j][0], v[j][1]); w.y = pk2(v[j][2], v[j][3]); *(u32x2*)(row + 4 * lane + 256 * j) = w; }
}
__device__ __forceinline__ void ln_inplace(f32x4 (&v)[4], const f32x4 (&g)[4], const f32x4 (&b)[4]) {
    float s = 0.f;
#pragma unroll
    for (int j = 0; j < 4; ++j) s += (v[j][0] + v[j][1]) + (v[j][2] + v[j][3]);
    const float mean = wave_sum(s) * (1.f / 1024.f); float q = 0.f;
#pragma unroll
    for (int j = 0; j < 4; ++j) { v[j] = v[j] - mean; q += (v[j][0] * v[j][0] + v[j][1] * v[j][1]) + (v[j][2] * v[j][2] + v[j][3] * v[j][3]); }
    const float rstd = 1.f / sqrtf(wave_sum(q) * (1.f / 1024.f) + 1e-5f);
#pragma unroll
    for (int j = 0; j < 4; ++j) v[j] = v[j] * rstd * g[j] + b[j];
}
__device__ __forceinline__ void load_gb(const float* g, const float* b, int lane, f32x4 (&gv)[4], f32x4 (&bv)[4]) {
#pragma unroll
    for (int j = 0; j < 4; ++j) { gv[j] = *(const f32x4*)(g + 4 * lane + 256 * j); bv[j] = *(const f32x4*)(b + 4 * lane + 256 * j); }
}
__device__ __forceinline__ void store_row_fp8(unsigned char* row, int lane, const f32x4 (&v)[4]) {
#pragma unroll
    for (int j = 0; j < 4; ++j) *(unsigned*)(row + 4 * lane + 256 * j) = pg8::pk4_fp8(v[j][0], v[j][1], v[j][2], v[j][3]);
}
__device__ __forceinline__ void phase_ln_bf16(const Frame& F, const bf16_t* S, bf16_t* O, unsigned char* O8, const float* g, const float* b) {
    f32x4 gv[4], bv[4]; load_gb(g, b, F.lane, gv, bv);
    for (int row = F.gw; row < MTOK; row += F.NGW) { f32x4 v[4]; load_row_bf16(S + (size_t)row * 1024, F.lane, v); ln_inplace(v, gv, bv); store_row_bf16(O + (size_t)row * 1024, F.lane, v); store_row_fp8(O8 + (size_t)row * 1024, F.lane, v); }
}
__device__ __forceinline__ void phase_ln_i8(const Frame& F, const bf16_t* S, bf16_t* O, unsigned char* O8, float* sa, const float* g, const float* b) {
    f32x4 gv[4], bv[4]; load_gb(g, b, F.lane, gv, bv);
    for (int row = F.gw; row < MTOK; row += F.NGW) { f32x4 v[4]; load_row_bf16(S + (size_t)row * 1024, F.lane, v); ln_inplace(v, gv, bv); store_row_bf16(O + (size_t)row * 1024, F.lane, v); store_row_i8(O8 + (size_t)row * 1024, sa + row, F.lane, v); }
}
__device__ __forceinline__ void phase_ckvn(const Frame& F, const bf16_t* T1, const float* ssq_kv, const float* gain, bf16_t* CKVN) {
    const float g0 = gain[2 * F.lane], g1 = gain[2 * F.lane + 1];
    for (int row = F.gw; row < MTOK; row += F.NGW) {
        const unsigned w = *(const unsigned*)(T1 + (size_t)row * 256 + 2 * F.lane);
        const f32x4 sq = *(const f32x4*)(ssq_kv + (size_t)row * 4); const float r = __builtin_amdgcn_rsqf(((sq[0] + sq[1]) + (sq[2] + sq[3])) * (1.f / 128.f) + 1e-6f);
        *(unsigned*)(CKVN + (size_t)row * 128 + 2 * F.lane) = pk2(bflo(w) * r * g0, bfhi(w) * r * g1);
    }
}
__device__ __forceinline__ void phase_ln_router(const Frame& F, const bf16_t* S, bf16_t* H2, const float* g, const float* b, const float* router, unsigned char* ws) {
    LAS int* cnt = (LAS int*)(F.lds);
    if (F.tid < 8) cnt[F.tid] = 0;
    __syncthreads();
    f32x4 gv[4], bv[4]; load_gb(g, b, F.lane, gv, bv);
    u32x2* ROUTE = (u32x2*)(ws + OFF_ROUTE);
    f32x4 rw[16][2];
#pragma unroll
    for (int j = 0; j < 4; ++j)
#pragma unroll
        for (int e = 0; e < 4; ++e) { const float* rp = router + (size_t)(4 * F.lane + 256 * j + e) * 8; rw[4 * j + e][0] = *(const f32x4*)rp; rw[4 * j + e][1] = *(const f32x4*)(rp + 4); }
    const bool b0 = F.lane & 1, b1 = F.lane & 2, b2 = F.lane & 4;
    for (int row = F.gw; row < MTOK; row += F.NGW) {
        f32x4 v[4]; load_row_bf16(S + (size_t)row * 1024, F.lane, v); ln_inplace(v, gv, bv); store_row_bf16(H2 + (size_t)row * 1024, F.lane, v);
        float pl[8];
#pragma unroll
        for (int x = 0; x < 8; ++x) pl[x] = 0.f;
#pragma unroll
        for (int j = 0; j < 4; ++j)
#pragma unroll
            for (int e = 0; e < 4; ++e) { const f32x4 r0 = rw[4 * j + e][0], r1 = rw[4 * j + e][1]; const float hv = v[j][e];
                pl[0] += hv * r0[0]; pl[1] += hv * r0[1]; pl[2] += hv * r0[2]; pl[3] += hv * r0[3]; pl[4] += hv * r1[0]; pl[5] += hv * r1[1]; pl[6] += hv * r1[2]; pl[7] += hv * r1[3]; }
        float k4[4], k2[2], k1;
#pragma unroll
        for (int i = 0; i < 4; ++i) { const float send = b0 ? pl[i] : pl[i + 4]; k4[i] = (b0 ? pl[i + 4] : pl[i]) + __shfl_xor(send, 1); }
#pragma unroll
        for (int i = 0; i < 2; ++i) { const float send = b1 ? k4[i] : k4[i + 2]; k2[i] = (b1 ? k4[i + 2] : k4[i]) + __shfl_xor(send, 2); }
        { const float send = b2 ? k2[0] : k2[1]; k1 = (b2 ? k2[1] : k2[0]) + __shfl_xor(send, 4); }
        k1 += __shfl_xor(k1, 8); k1 += __shfl_xor(k1, 16); k1 += __shfl_xor(k1, 32);
        float lg[8];
#pragma unroll
        for (int x = 0; x < 8; ++x) lg[x] = __int_as_float(__builtin_amdgcn_readlane(__float_as_int(k1), (x >> 2) | (((x >> 1) & 1) << 1) | ((x & 1) << 2)));
        int e0 = 0; float l0 = lg[0];
#pragma unroll
        for (int x = 1; x < 8; ++x) if (lg[x] > l0) { l0 = lg[x]; e0 = x; }
        int e1 = -1; float l1 = -INFINITY;
#pragma unroll
        for (int x = 0; x < 8; ++x) if (x != e0 && lg[x] > l1) { l1 = lg[x]; e1 = x; }
        const float g0 = 1.f / (1.f + __expf(l1 - l0));
        if (F.lane == 0) { u32x2 r; r.x = (unsigned)e0 | ((unsigned)e1 << 8); r.y = __builtin_bit_cast(unsigned, g0); ROUTE[row] = r;
            __hip_atomic_fetch_add(cnt + e0, 1, __ATOMIC_RELAXED, __HIP_MEMORY_SCOPE_WORKGROUP); __hip_atomic_fetch_add(cnt + e1, 1, __ATOMIC_RELAXED, __HIP_MEMORY_SCOPE_WORKGROUP); }
    }
    __syncthreads();
    if (F.tid < 8) ((int*)(ws + OFF_WGCNT))[F.bx * 8 + F.tid] = cnt[F.tid];
    __syncthreads();
}
__device__ __forceinline__ void phase_moe_gather(const Frame& F, const bf16_t* H2, unsigned char* XR, unsigned char* ws) {
    LAS int* L = (LAS int*)(F.lds);
    const int* WGCNT = (const int*)(ws + OFF_WGCNT);
    { const int e = F.wave; int t = 0, p = 0;
#pragma unroll
      for (int k = 0; k < 4; ++k) { const int wg = F.lane + 64 * k; const int c = (wg < F.G) ? WGCNT[wg * 8 + e] : 0; t += c; p += (wg < F.bx) ? c : 0; }
      t = (int)wave_sum((float)t); p = (int)wave_sum((float)p);
      if (F.lane == 0) { L[e] = t; L[8 + e] = p; L[24 + e] = 0; } }
    __syncthreads();
    if (F.tid == 0) { int acc = 0;
        for (int e = 0; e < 8; ++e) { const int pad = (L[e] + 255) / 256 * 256; L[32 + e] = acc; L[16 + e] = acc + L[8 + e]; acc += pad; L[40 + e] = acc; }
        if (F.bx == 0) { int* GI = (int*)(ws + OFF_GINFO); for (int e = 0; e < 8; ++e) { GI[e] = L[40 + e]; GI[8 + e] = L[e]; } } }
    __syncthreads();
    const u32x2* ROUTE = (const u32x2*)(ws + OFF_ROUTE); int* DEST = (int*)(ws + OFF_DEST);
    for (int row = F.gw; row < MTOK; row += F.NGW) {
        const u32x2 r = ROUTE[row]; const int e0 = r.x & 255, e1 = (r.x >> 8) & 255; int s0 = 0, s1 = 0;
        if (F.lane == 0) { s0 = L[16 + e0] + __hip_atomic_fetch_add(L + 24 + e0, 1, __ATOMIC_RELAXED, __HIP_MEMORY_SCOPE_WORKGROUP); s1 = L[16 + e1] + __hip_atomic_fetch_add(L + 24 + e1, 1, __ATOMIC_RELAXED, __HIP_MEMORY_SCOPE_WORKGROUP);
            DEST[2 * row] = s0; DEST[2 * row + 1] = s1; }
        s0 = __builtin_amdgcn_readfirstlane(s0); s1 = __builtin_amdgcn_readfirstlane(s1);
        const u32x4* src = (const u32x4*)(H2 + (size_t)row * 1024) + 2 * F.lane; const u32x4 a = src[0], b = src[1];
        u32x4 o; o.x = pg8::pk4_fp8(bflo(a.x), bfhi(a.x), bflo(a.y), bfhi(a.y)); o.y = pg8::pk4_fp8(bflo(a.z), bfhi(a.z), bflo(a.w), bfhi(a.w));
        o.z = pg8::pk4_fp8(bflo(b.x), bfhi(b.x), bflo(b.y), bfhi(b.y)); o.w = pg8::pk4_fp8(bflo(b.z), bfhi(b.z), bflo(b.w), bfhi(b.w));
        ((u32x4*)(XR + (size_t)s0 * 1024))[F.lane] = o; ((u32x4*)(XR + (size_t)s1 * 1024))[F.lane] = o;
    }
    for (int e = 0; e < 8; ++e) { const int r0 = L[32 + e] + L[e], npad = L[40 + e] - r0;
        for (int i = F.gw; i < npad; i += F.NGW) { u32x4* d = (u32x4*)(XR + (size_t)(r0 + i) * 1024); d[F.lane] = (u32x4){0u, 0u, 0u, 0u}; } }
    __syncthreads();
}
__device__ __forceinline__ void phase_final(const Frame& F, const bf16_t* H2, const bf16_t* YR, const float* g, const float* b, float* out, unsigned char* ws) {
    f32x4 gv[4], bv[4]; load_gb(g, b, F.lane, gv, bv);
    const u32x2* ROUTE = (const u32x2*)(ws + OFF_ROUTE); const int* DEST = (const int*)(ws + OFF_DEST);
    for (int row = F.gw; row < MTOK; row += F.NGW) {
        const u32x2 rte = ROUTE[row]; const float g0 = __uint_as_float(rte.y), g1 = 1.f - g0;   const int d0 = DEST[2 * row], d1 = DEST[2 * row + 1];
        f32x4 v[4], y0[4], y1[4]; load_row_bf16(H2 + (size_t)row * 1024, F.lane, v); load_row_bf16(YR + (size_t)d0 * 1024, F.lane, y0); load_row_bf16(YR + (size_t)d1 * 1024, F.lane, y1);
#pragma unroll
        for (int j = 0; j < 4; ++j) v[j] = v[j] * ALPHA + y0[j] * g0 + y1[j] * g1;
        ln_inplace(v, gv, bv);
#pragma unroll
        for (int j = 0; j < 4; ++j) *(f32x4*)(out + (size_t)row * 1024 + 4 * F.lane + 256 * j) = v[j];
    }
}

namespace att {
constexpr float NEG_BIG = -1e30f;
constexpr int KS64 = 144, VS64 = 192, KT64 = 64 * KS64, VT64 = 64 * VS64;
constexpr int KS128 = 272, VS128 = 320, KT128 = 64 * KS128, VT128 = 64 * VS128;
typedef LAS char* lptr; typedef const LAS char* lcptr;
typedef short v4i16_t __attribute__((ext_vector_type(4)));
__device__ __forceinline__ s16x4 vtr(lcptr p) { return __builtin_bit_cast(s16x4, __builtin_amdgcn_ds_read_tr16_b64_v4i16((LAS v4i16_t*)p)); }
__device__ __forceinline__ f32x16 splat16(float c) { f32x16 v;
#pragma unroll
    for (int r = 0; r < 16; ++r) v[r] = c; return v; }
__device__ __forceinline__ int crow(int r, int hi) { return (r & 3) + 8 * (r >> 2) + 4 * hi; }
__device__ __forceinline__ float ex2(float x) { return __builtin_amdgcn_exp2f(x); }

template <int NKS> __device__ __forceinline__ void qk(f32x16& s0, f32x16& s1, lcptr Kt, int kstride, const bf16x8 (&qf)[NKS], float c0, int r32, int hi) {
    s0 = splat16(c0); s1 = splat16(c0);
    lcptr p0 = Kt + r32 * kstride + hi * 16; lcptr p1 = p0 + 32 * kstride;
#pragma unroll
    for (int ks = 0; ks < NKS; ++ks) { const bf16x8 k0 = *(const LAS bf16x8*)(p0 + ks * 32), k1 = *(const LAS bf16x8*)(p1 + ks * 32);
        s0 = __builtin_amdgcn_mfma_f32_32x32x16_bf16(k0, qf[ks], s0, 0, 0, 0); s1 = __builtin_amdgcn_mfma_f32_32x32x16_bf16(k1, qf[ks], s1, 0, 0, 0); }
}
__device__ __forceinline__ float rowmax32(const f32x16& s0, const f32x16& s1) {
    float a = fmaxf(s0[0], s1[0]);
#pragma unroll
    for (int r = 1; r < 16; ++r) a = fmaxf(a, fmaxf(s0[r], s1[r]));
    return fmaxf(a, __shfl_xor(a, 32));
}
template <int NDT> __device__ __forceinline__ void softmax_step(f32x16& s0, f32x16& s1, float& m, float& l, f32x16 (&o)[NDT]) {
    const float mn = fmaxf(m, rowmax32(s0, s1)); float rs = 0.f;
    if (__any(mn > m)) {
        const float al = ex2(m - mn); l *= al;
#pragma unroll
        for (int d = 0; d < NDT; ++d)
#pragma unroll
            for (int r = 0; r < 16; ++r) o[d][r] *= al;
    }
    m = mn;
#pragma unroll
    for (int r = 0; r < 16; ++r) { s0[r] = ex2(s0[r] - mn); s1[r] = ex2(s1[r] - mn); rs += s0[r] + s1[r]; }
    l += rs;
}
__device__ __forceinline__ bf16x8 pack_p(const f32x16& s, int base) { u32x4 w; w.x = pk2(s[base], s[base + 1]); w.y = pk2(s[base + 2], s[base + 3]); w.z = pk2(s[base + 4], s[base + 5]); w.w = pk2(s[base + 6], s[base + 7]); return __builtin_bit_cast(bf16x8, w); }
template <int NDT> __device__ __forceinline__ void pv(f32x16 (&o)[NDT], const f32x16& s0, const f32x16& s1, lcptr Vt, int vstride, int lane) {
    const bf16x8 pk[4] = {pack_p(s0, 0), pack_p(s0, 8), pack_p(s1, 0), pack_p(s1, 8)};
    const int h = lane >> 5, g = (lane >> 4) & 1, q = (lane & 15) >> 2, p = lane & 3;
    lcptr vb = Vt + (4 * h + q) * vstride + (16 * g + 4 * p) * 2;
#pragma unroll
    for (int k = 0; k < 4; ++k)
#pragma unroll
        for (int d = 0; d < NDT; ++d) { const s16x4 lo = vtr(vb + (16 * k) * vstride + d * 64), hh = vtr(vb + (16 * k + 8) * vstride + d * 64);
            const bf16x8 vf = (bf16x8){lo[0], lo[1], lo[2], lo[3], hh[0], hh[1], hh[2], hh[3]};
            o[d] = __builtin_amdgcn_mfma_f32_32x32x16_bf16(vf, pk[k], o[d], 0, 0, 0); }
}

__device__ __forceinline__ void exp_step(f32x16& s0, f32x16& s1, float& l) {
    float rs = 0.f;
#pragma unroll
    for (int r = 0; r < 16; ++r) { s0[r] = ex2(s0[r]); s1[r] = ex2(s1[r]); rs += s0[r] + s1[r]; }
    l += rs;
}

__device__ __forceinline__ void qk2(f32x16& a0, f32x16& a1, f32x16& b0, f32x16& b1, lcptr Kt, const bf16x8 (&qa)[4], const bf16x8 (&qb)[4], int r32, int hi) {
    a0 = splat16(0.f); a1 = splat16(0.f); b0 = splat16(0.f); b1 = splat16(0.f);
    lcptr p0 = Kt + r32 * KS64 + hi * 16; lcptr p1 = p0 + 32 * KS64;
#pragma unroll
    for (int ks = 0; ks < 4; ++ks) { const bf16x8 k0 = *(const LAS bf16x8*)(p0 + ks * 32), k1 = *(const LAS bf16x8*)(p1 + ks * 32);
        a0 = __builtin_amdgcn_mfma_f32_32x32x16_bf16(k0, qa[ks], a0, 0, 0, 0); b0 = __builtin_amdgcn_mfma_f32_32x32x16_bf16(k0, qb[ks], b0, 0, 0, 0);
        a1 = __builtin_amdgcn_mfma_f32_32x32x16_bf16(k1, qa[ks], a1, 0, 0, 0); b1 = __builtin_amdgcn_mfma_f32_32x32x16_bf16(k1, qb[ks], b1, 0, 0, 0); }
}
__device__ __forceinline__ void pv2(f32x16 (&oa)[2], f32x16 (&ob)[2], const bf16x8 (&pa)[4], const bf16x8 (&pb)[4], lcptr Vt, int lane) {
    const int h = lane >> 5, g = (lane >> 4) & 1, q = (lane & 15) >> 2, p = lane & 3;
    lcptr vb = Vt + (4 * h + q) * VS64 + (16 * g + 4 * p) * 2;
#pragma unroll
    for (int k = 0; k < 4; ++k)
#pragma unroll
        for (int d = 0; d < 2; ++d) { const s16x4 lo = vtr(vb + (16 * k) * VS64 + d * 64), hh = vtr(vb + (16 * k + 8) * VS64 + d * 64);
            const bf16x8 vf = (bf16x8){lo[0], lo[1], lo[2], lo[3], hh[0], hh[1], hh[2], hh[3]};
            oa[d] = __builtin_amdgcn_mfma_f32_32x32x16_bf16(vf, pa[k], oa[d], 0, 0, 0); ob[d] = __builtin_amdgcn_mfma_f32_32x32x16_bf16(vf, pb[k], ob[d], 0, 0, 0); }
}
__device__ __forceinline__ void bias_mask_near(f32x16& s0, f32x16& s1, const LAS float* bt, int t, int kp0, int hi, unsigned maxdist) {
#pragma unroll
    for (int q4 = 0; q4 < 4; ++q4) {
        float bb[8]; f32x16& s = (q4 & 2) ? s1 : s0; const int r0 = 8 * (q4 & 1), kq = kp0 + 32 * (q4 >> 1);
#pragma unroll
        for (int r = 0; r < 8; ++r) { const int d = t - (kq + crow(r0 + r, hi)); const unsigned ix = (unsigned)d < 127u ? (unsigned)d : 127u; bb[r] = bt[ix]; }
#pragma unroll
        for (int r = 0; r < 8; ++r) asm volatile("" : "+v"(bb[r]));
#pragma unroll
        for (int r = 0; r < 8; ++r) { const int d = t - (kq + crow(r0 + r, hi)); s[r0 + r] = ((unsigned)d < maxdist) ? s[r0 + r] + bb[r] : -INFINITY; }
    }
}
__device__ __forceinline__ void mask_all(f32x16& s0, f32x16& s1) {
#pragma unroll
    for (int r = 0; r < 16; ++r) { s0[r] = -INFINITY; s1[r] = -INFINITY; }
}
__device__ __forceinline__ void store_o64(bf16_t* orow, const f32x16 (&o)[2], float sc, int hi) {
#pragma unroll
    for (int d = 0; d < 2; ++d)
#pragma unroll
        for (int rg = 0; rg < 4; ++rg) { u32x2 w; w.x = pk2(o[d][4 * rg] * sc, o[d][4 * rg + 1] * sc); w.y = pk2(o[d][4 * rg + 2] * sc, o[d][4 * rg + 3] * sc);
            *(u32x2*)(orow + 32 * d + 8 * rg + 4 * hi) = w; }
}
__device__ __forceinline__ void store_o64_fp8(unsigned char* orow, const f32x16 (&o)[2], float sc, int hi) {
#pragma unroll
    for (int d = 0; d < 2; ++d)
#pragma unroll
        for (int rg = 0; rg < 4; ++rg) *(unsigned*)(orow + 32 * d + 8 * rg + 4 * hi) = pg8::pk4_fp8(o[d][4 * rg] * sc, o[d][4 * rg + 1] * sc, o[d][4 * rg + 2] * sc, o[d][4 * rg + 3] * sc);
}
template <class Src, class Proc> __device__ __forceinline__ void tile_loop64(int tid, lptr base, int nt, int pitch, Src src, Proc proc) {
    if (nt <= 0) return;
    const int row = tid >> 3, ch = tid & 7; u32x4 kr, vr;
    lptr Kb = base, Vb = base + 2 * KT64;
    { const bf16_t *kp, *vp; src(0, kp, vp); kr = *(const u32x4*)(kp + (size_t)row * pitch + ch * 8); vr = *(const u32x4*)(vp + (size_t)row * pitch + ch * 8); }
    *(LAS u32x4*)(Kb + row * KS64 + ch * 16) = kr; *(LAS u32x4*)(Vb + row * VS64 + ch * 16) = vr;
    __syncthreads();
    for (int i = 0; i < nt; ++i) {
        const bool more = i + 1 < nt;
        if (more) { const bf16_t *kp, *vp; src(i + 1, kp, vp); kr = *(const u32x4*)(kp + (size_t)row * pitch + ch * 8); vr = *(const u32x4*)(vp + (size_t)row * pitch + ch * 8); }
        proc(i, (lcptr)(Kb + (i & 1) * KT64), (lcptr)(Vb + (i & 1) * VT64));
        if (more) { *(LAS u32x4*)(Kb + ((i + 1) & 1) * KT64 + row * KS64 + ch * 16) = kr; *(LAS u32x4*)(Vb + ((i + 1) & 1) * VT64 + row * VS64 + ch * 16) = vr; }
        __syncthreads();
    }
}

template <int ROWB, int KSTR, int VSTR, int VAR = 0, class SrcK, class SrcV, class Score, class Accum>
__device__ __forceinline__ void tile_loop_p(int tid, lptr base, int nt, int pitch, SrcK srck, SrcV srcv, Score score, Accum accum) {
    if (nt <= 0) return;
    constexpr int CPR = ROWB / 16, NCH = (64 * CPR) / 512, KT = 64 * KSTR, VT = 64 * VSTR;
    lptr Kb = base, Vb = base + 2 * KT;
    u32x4 kr0[NCH], vr0[NCH], kr1[NCH], vr1[NCH];
    auto gld = [&](const bf16_t* p, u32x4 (&r)[NCH]) {
#pragma unroll
        for (int c = 0; c < NCH; ++c) { const int idx = tid + 512 * c, rr = idx / CPR, ch = idx % CPR; r[c] = *(const u32x4*)(p + (size_t)rr * pitch + ch * 8); } };
    auto lst = [&](lptr dst, int stride, const u32x4 (&r)[NCH]) {
#pragma unroll
        for (int c = 0; c < NCH; ++c) { const int idx = tid + 512 * c, rr = idx / CPR, ch = idx % CPR; *(LAS u32x4*)(dst + rr * stride + ch * 16) = r[c]; } };
    gld(srck(0), kr0); gld(srcv(0), vr0); lst(Kb, KSTR, kr0); lst(Vb, VSTR, vr0);
    if (nt > 1) { gld(srck(1), kr0); lst(Kb + KT, KSTR, kr0); }
    if (nt > 2) gld(srck(2), kr1);
    if (nt > 1) gld(srcv(1), vr1);
    __syncthreads();
    f32x16 a0, a1, b0, b1; bool aact = score(0, (lcptr)Kb, a0, a1), bact = false;
    auto step = [&](int i, f32x16& c0, f32x16& c1, bool& cact, f32x16& n0, f32x16& n1, bool& nact, u32x4 (&kL)[NCH], u32x4 (&vL)[NCH], u32x4 (&kS)[NCH], u32x4 (&vS)[NCH]) {
        const bool m1 = i + 1 < nt, m2 = i + 2 < nt, m3 = i + 3 < nt;
        if (VAR != 7) { if (m3) gld(srck(i + 3), kL);
        if (m2) gld(srcv(i + 2), vL); }
        nact = false;
        if (m1) nact = score(i + 1, (lcptr)(Kb + ((i + 1) & 1) * KT), n0, n1);
        if (cact) accum(i, (lcptr)(Vb + (i & 1) * VT), c0, c1);
        if (VAR != 7) { if (m2) lst(Kb + (i & 1) * KT, KSTR, kS);
        if (m1) lst(Vb + ((i + 1) & 1) * VT, VSTR, vS); }
        __syncthreads();
    };
    for (int i = 0; i < nt; i += 2) { step(i, a0, a1, aact, b0, b1, bact, kr0, vr0, kr1, vr1); if (i + 1 < nt) step(i + 1, b0, b1, bact, a0, a1, aact, kr1, vr1, kr0, vr0); }
}

template <int ROWB, int KSTR, int VSTR, class SrcK, class SrcV, class Score, class Accum>
__device__ __forceinline__ void tile_loop_pp(int tid, int grp, lptr base, int nt, int pitch, SrcK srck, SrcV srcv, Score score, Accum accum) {
    if (nt <= 0) return;
    constexpr int CPR = ROWB / 16, NCH = (64 * CPR) / 512, KT = 64 * KSTR, VT = 64 * VSTR;
    lptr Kb = base, Vb = base + 2 * KT;
    u32x4 kr0[NCH], vr0[NCH], kr1[NCH], vr1[NCH];
    auto gld = [&](const bf16_t* p, u32x4 (&r)[NCH]) {
#pragma unroll
        for (int c = 0; c < NCH; ++c) { const int idx = tid + 512 * c, rr = idx / CPR, ch = idx % CPR; r[c] = *(const u32x4*)(p + (size_t)rr * pitch + ch * 8); } };
    auto lst = [&](lptr dst, int stride, const u32x4 (&r)[NCH]) {
#pragma unroll
        for (int c = 0; c < NCH; ++c) { const int idx = tid + 512 * c, rr = idx / CPR, ch = idx % CPR; *(LAS u32x4*)(dst + rr * stride + ch * 16) = r[c]; } };
    gld(srck(0), kr0); gld(srcv(0), vr0); lst(Kb, KSTR, kr0); lst(Vb, VSTR, vr0);
    if (nt > 1) { gld(srck(1), kr0); gld(srcv(1), vr0); }
    if (nt > 2) { gld(srck(2), kr1); gld(srcv(2), vr1); }
    __syncthreads();
    f32x16 s0, s1; bool act = false;
    const int nslot = 2 * nt + 1;
    auto slot_fn = [&](int slot, u32x4 (&kS)[NCH], u32x4 (&vS)[NCH]) {
        const int my = slot - grp;
        if (my >= 0 && my < 2 * nt) { const int i = my >> 1;
            if (!(my & 1)) act = score(i, (lcptr)(Kb + (i & 1) * KT), s0, s1);
            else if (act) accum(i, (lcptr)(Vb + (i & 1) * VT), s0, s1); }
        if (slot & 1) { const int j = (slot >> 1) + 1;
            if (j < nt) { lst(Kb + (j & 1) * KT, KSTR, kS); lst(Vb + (j & 1) * VT, VSTR, vS); }
            if (j + 2 < nt) { gld(srck(j + 2), kS); gld(srcv(j + 2), vS); } }
        __syncthreads();
    };
    for (int slot = 0; slot < nslot; slot += 4) {
        slot_fn(slot, kr0, vr0);
        if (slot + 1 < nslot) slot_fn(slot + 1, kr0, vr0);
        if (slot + 2 < nslot) slot_fn(slot + 2, kr1, vr1);
        if (slot + 3 < nslot) slot_fn(slot + 3, kr1, vr1);
    }
}

template <int VAR = 0, class SrcK, class SrcV, class Post>
__device__ __forceinline__ void tile_loop_f(int tid, int lane, lptr base, int nt, int pitch, const bf16x8 (&qf)[4], f32x16 (&o)[2], float& l, SrcK srck, SrcV srcv, Post post) {
    if (nt <= 0) return;
    const int r32 = lane & 31, hi = lane >> 5;
    lptr Kb = base, Vb = base + 2 * KT64;
    const int rr = tid >> 3, ch = tid & 7;
    u32x4 kr0, vr0, kr1, vr1;
    auto gld = [&](const bf16_t* p) { return *(const u32x4*)(p + (size_t)rr * pitch + ch * 8); };
    kr0 = gld(srck(0)); vr0 = gld(srcv(0)); *(LAS u32x4*)(Kb + rr * KS64 + ch * 16) = kr0; *(LAS u32x4*)(Vb + rr * VS64 + ch * 16) = vr0;
    if (nt > 1) { kr0 = gld(srck(1)); *(LAS u32x4*)(Kb + KT64 + rr * KS64 + ch * 16) = kr0; }
    if (nt > 2) kr1 = gld(srck(2));
    if (nt > 1) vr1 = gld(srcv(1));
    __syncthreads();
    f32x16 a0, a1, b0, b1; bool aact, bact = false;
    qk<4>(a0, a1, (lcptr)Kb, KS64, qf, 0.f, r32, hi); aact = post(0, a0, a1);
    auto step = [&](int i, f32x16& c0, f32x16& c1, bool& cact, f32x16& n0, f32x16& n1, bool& nact, u32x4& kL, u32x4& vL, u32x4& kS, u32x4& vS) {
        const bool m1 = i + 1 < nt, m2 = i + 2 < nt, m3 = i + 3 < nt;
        if (m3) kL = gld(srck(i + 3));
        if (m2) vL = gld(srcv(i + 2));
        lcptr Kt = (lcptr)(Kb + ((i + 1) & 1) * KT64), Vt = (lcptr)(Vb + (i & 1) * VT64);
        if (m1 && cact) {
            lcptr p0 = Kt + r32 * KS64 + hi * 16; lcptr p1 = p0 + 32 * KS64;
            bf16x8 ka[4], kb[4];
#pragma unroll
            for (int ks = 0; ks < 4; ++ks) { if (VAR == 8 || VAR == 9) { ka[ks] = qf[ks]; kb[ks] = qf[3 - ks]; } else { ka[ks] = *(const LAS bf16x8*)(p0 + ks * 32); kb[ks] = *(const LAS bf16x8*)(p1 + ks * 32); } }
            n0 = splat16(0.f); n1 = splat16(0.f); float rs = 0.f;
            __builtin_amdgcn_sched_barrier(0);
#pragma unroll
            for (int ks = 0; ks < 4; ++ks) {
                n0 = __builtin_amdgcn_mfma_f32_32x32x16_bf16(ka[ks], qf[ks], n0, 0, 0, 0); n1 = __builtin_amdgcn_mfma_f32_32x32x16_bf16(kb[ks], qf[ks], n1, 0, 0, 0);
#pragma unroll
                for (int e = 0; e < 4; ++e) { c0[4 * ks + e] = ex2(c0[4 * ks + e]); c1[4 * ks + e] = ex2(c1[4 * ks + e]); rs += c0[4 * ks + e] + c1[4 * ks + e]; }
                __builtin_amdgcn_sched_barrier(0);
            }
            l += rs;
            if (VAR == 8 || VAR == 10) { const bf16x8 pk0 = pack_p(c0, 0), pk1 = pack_p(c0, 8), pk2_ = pack_p(c1, 0), pk3 = pack_p(c1, 8);
#pragma unroll
                for (int d = 0; d < 2; ++d) { o[d] = __builtin_amdgcn_mfma_f32_32x32x16_bf16(qf[0], pk0, o[d], 0, 0, 0); o[d] = __builtin_amdgcn_mfma_f32_32x32x16_bf16(qf[1], pk1, o[d], 0, 0, 0);
                    o[d] = __builtin_amdgcn_mfma_f32_32x32x16_bf16(qf[2], pk2_, o[d], 0, 0, 0); o[d] = __builtin_amdgcn_mfma_f32_32x32x16_bf16(qf[3], pk3, o[d], 0, 0, 0); } }
            else pv<2>(o, c0, c1, Vt, VS64, lane);
            nact = post(i + 1, n0, n1);
        } else {
            if (cact) { exp_step(c0, c1, l); pv<2>(o, c0, c1, Vt, VS64, lane); }
            nact = false;
            if (m1) { qk<4>(n0, n1, Kt, KS64, qf, 0.f, r32, hi); nact = post(i + 1, n0, n1); }
        }
        if (m2) *(LAS u32x4*)(Kb + (i & 1) * KT64 + rr * KS64 + ch * 16) = kS;
        if (m1) *(LAS u32x4*)(Vb + ((i + 1) & 1) * VT64 + rr * VS64 + ch * 16) = vS;
        __syncthreads();
    };
    for (int i = 0; i < nt; i += 2) { step(i, a0, a1, aact, b0, b1, bact, kr0, vr0, kr1, vr1); if (i + 1 < nt) step(i + 1, b0, b1, bact, a0, a1, aact, kr1, vr1, kr0, vr0); }
}
constexpr int TL64_BYTES = 2 * KT64 + 2 * VT64;
}

#ifndef PP_GRP
#define PP_GRP (w & 1)
#endif
template <int var> __device__ __forceinline__ void moba_unit(const Frame& F, int b, int h, int qb, const bf16_t* Q, const bf16_t* K, const bf16_t* V, const float* KMEAN, const float* BT, unsigned char* O8) {
    using namespace att;
    const int lane = F.lane, r32 = lane & 31, hi = lane >> 5, w = F.wave;
    lptr lds = (lptr)F.lds; lptr tl = lds; LAS float* BTL = (LAS float*)(lds + TL64_BYTES); lptr KM = lds + TL64_BYTES + 512;
    const int t = 256 * qb + 32 * w + r32; const size_t row = (size_t)b * SEQ + t;
    bf16x8 qf[4];
#pragma unroll
    for (int ks = 0; ks < 4; ++ks) qf[ks] = *(const bf16x8*)(Q + row * 1024 + h * 64 + 16 * ks + 8 * hi);
    if (F.tid < 128) BTL[F.tid] = BT[h * 128 + F.tid] - BT[h * 128 + 127];
    { const int idx = F.tid * 2, j = idx >> 6, d = idx & 63; const float* kmp = KMEAN + (size_t)(b * 16 + j) * 2048 + h * 64 + d;
      *(LAS unsigned*)(KM + j * KS64 + d * 2) = (j < qb) ? pk2(kmp[0] + kmp[1024], kmp[1] + kmp[1025]) : 0u;
      *(LAS unsigned*)(KM + (16 + j) * KS64 + d * 2) = 0u; }
    __syncthreads();
    unsigned selmask = 0u;
    if (qb > 0) {
        f32x16 gs = splat16(0.f);
        { lcptr p0 = (lcptr)KM + r32 * KS64 + hi * 16;
#pragma unroll
          for (int ks = 0; ks < 4; ++ks) { const bf16x8 k0 = *(const LAS bf16x8*)(p0 + ks * 32); gs = __builtin_amdgcn_mfma_f32_32x32x16_bf16(k0, qf[ks], gs, 0, 0, 0); } }
        float glo[8], ghi[8];
#pragma unroll
        for (int r = 0; r < 8; ++r) { const float mine = gs[r], oth = __shfl_xor(mine, 32); glo[r] = hi ? oth : mine; ghi[r] = hi ? mine : oth; }
#pragma unroll
        for (int rep = 0; rep < 3; ++rep) { float best = -INFINITY; int bj = -1;
#pragma unroll
            for (int j = 0; j < 16; ++j) { const int r = (j & 3) + 4 * (j >> 3); const float gv = ((j >> 2) & 1) ? ghi[r] : glo[r];
                if (j < qb && !((selmask >> j) & 1u) && gv > best) { best = gv; bj = j; } }
            if (bj >= 0) selmask |= 1u << bj; }
    }
    f32x16 o[2] = {splat16(0.f), splat16(0.f)}; float l = 0.f;
    const int nt = 4 * (qb + 1); const int twmax = 256 * qb + 32 * w + 31;
    const bf16_t* Kh = K + (size_t)b * SEQ * 1024 + h * 64; const bf16_t* Vh = V + (size_t)b * SEQ * 1024 + h * 64;
    tile_loop_f<var>(F.tid, lane, tl, nt, 1024, qf, o, l,
        [&](int i) { return Kh + (size_t)(64 * i) * 1024; }, [&](int i) { return Vh + (size_t)(64 * i) * 1024; },
        [&](int i, f32x16& s0, f32x16& s1) -> bool {
            const int blk = i >> 2, kp0 = 64 * i;
            if (blk < qb) {
                const bool sel = (selmask >> blk) & 1u;
                if (!__any(sel)) return false;
                if (!(blk < qb - 1 || (i & 3) < 2)) bias_mask_near(s0, s1, BTL, t, kp0, hi, 0x7fffffffu);
                if (!sel) mask_all(s0, s1);
            } else {
                if (kp0 > twmax) return false;
                bias_mask_near(s0, s1, BTL, t, kp0, hi, 0x7fffffffu);
            }
            return true; });
    l += __shfl_xor(l, 32);
    store_o64_fp8(O8 + row * 1024 + h * 64, o, l > 0.f ? OSC / l : 0.f, hi);
}
__device__ __forceinline__ void phase_moba(const Frame& F, unsigned char* ws, int var) {
    const bf16_t* Q = (const bf16_t*)(ws + OFF_QKV); const bf16_t* K = Q + (size_t)MTOK * 1024; const bf16_t* V = K + (size_t)MTOK * 1024;
    const float* KMEAN = (const float*)(ws + OFF_KMEAN); const float* BT = (const float*)(ws + OFF_BT);
    for (int idx = F.bx; idx < 2048; idx += F.G) { const int i = idx >> 8, v = idx & 255, x = v & 7, j = v >> 3, bh = 16 * x + 2 * i + (j >> 4), b = bh >> 4, h = bh & 15, p = ((j & 15) + 4 * (i >> 1)) & 15, qb = (i & 1) ? 15 - p : p;

#ifdef MOBA_VAR
        if (var == MOBA_VAR) moba_unit<MOBA_VAR>(F, b, h, qb, Q, K, V, KMEAN, BT, ws + OFF_O8); else
#endif
        moba_unit<0>(F, b, h, qb, Q, K, V, KMEAN, BT, ws + OFF_O8);
        __syncthreads(); }
}

constexpr int MB_KB = 0, MB_VB = 256 * att::KS64, MB_SELM = MB_VB + 256 * att::VS64, MB_LIST = MB_SELM + 4096, MB_CNT = MB_LIST + 12800, MB_FILL = MB_CNT + 64, MB_LOFF = MB_FILL + 64,
              MB_BTL = MB_LOFF + 128, MB_KM = MB_BTL + 512, MB_QC = MB_KM + 32 * att::KS64, MB_END = MB_QC + 64;
constexpr int MST_ROW = 136;
__device__ __forceinline__ void moba2_unit(const Frame& F, int b, int h, int par, int unit, const bf16_t* Q, const bf16_t* K, const bf16_t* V, const float* KMEAN, const float* BT, unsigned char* O8, unsigned char* MST) {
    using namespace att;
    int tid = F.tid; asm volatile("" : "+v"(tid));
    const int lane = tid & 63, lane_ = lane, r32 = lane & 31, hi = lane >> 5, w = F.wave;
    lptr lds = (lptr)F.lds; lptr KB = lds + MB_KB, VB = lds + MB_VB; LAS unsigned short* SELM = (LAS unsigned short*)(lds + MB_SELM); LAS unsigned short* LIST = (LAS unsigned short*)(lds + MB_LIST);
    LAS int* CNT = (LAS int*)(lds + MB_CNT); LAS int* FILL = (LAS int*)(lds + MB_FILL); LAS int* LOFF = (LAS int*)(lds + MB_LOFF); LAS float* BTL = (LAS float*)(lds + MB_BTL); lptr KM = lds + MB_KM;
    unsigned char* ST = MST + (size_t)unit * 2048 * MST_ROW;
    const bf16_t* Qh = Q + (size_t)b * SEQ * 1024 + h * 64; const bf16_t* Kh = K + (size_t)b * SEQ * 1024 + h * 64; const bf16_t* Vh = V + (size_t)b * SEQ * 1024 + h * 64;
    if (tid < 128) BTL[tid] = BT[h * 128 + tid] - BT[h * 128 + 127];
    { const int idx = tid * 2, j = idx >> 6, d = idx & 63; const float* kmp = KMEAN + (size_t)(b * 16 + j) * 2048 + h * 64 + d;
      *(LAS unsigned*)(KM + j * KS64 + d * 2) = pk2(kmp[0] + kmp[1024], kmp[1] + kmp[1025]); *(LAS unsigned*)(KM + (16 + j) * KS64 + d * 2) = 0u; }
    LAS int* QC = (LAS int*)(lds + MB_QC);
    if (tid < 16) { CNT[tid] = 0; FILL[tid] = 0; QC[tid] = 0; }
    for (int i = tid; i < 2048 * MST_ROW / 16; i += NTHR) ((u32x4*)ST)[i] = (u32x4){0u, 0u, 0u, 0u};
    __syncthreads();
#pragma unroll 1
    for (int m8 = 0; m8 < 8; ++m8) { const int gi = w + 8 * m8, k = gi >> 3, sub = gi & 7, qb = 2 * k + par, q = 32 * sub + r32; const size_t trow = (size_t)(256 * qb + q);
        unsigned selmask = 0u;
        if (qb > 0) {
            bf16x8 qf[4];
#pragma unroll
            for (int ks = 0; ks < 4; ++ks) qf[ks] = *(const bf16x8*)(Qh + trow * 1024 + 16 * ks + 8 * hi);
            f32x16 gs = splat16(0.f);
            { lcptr p0 = (lcptr)KM + r32 * KS64 + hi * 16;
#pragma unroll
              for (int ks = 0; ks < 4; ++ks) { const bf16x8 k0 = *(const LAS bf16x8*)(p0 + ks * 32); gs = __builtin_amdgcn_mfma_f32_32x32x16_bf16(k0, qf[ks], gs, 0, 0, 0); } }
            float glo[8], ghi[8];
#pragma unroll
            for (int r = 0; r < 8; ++r) { const float mine = gs[r], oth = __shfl_xor(mine, 32); glo[r] = hi ? oth : mine; ghi[r] = hi ? mine : oth; }
#pragma unroll
            for (int rep = 0; rep < 3; ++rep) { float best = -INFINITY; int bj = -1;
#pragma unroll
                for (int j = 0; j < 16; ++j) { const int r = (j & 3) + 4 * (j >> 3); const float gv = ((j >> 2) & 1) ? ghi[r] : glo[r];
                    if (j < qb && !((selmask >> j) & 1u) && gv > best) { best = gv; bj = j; } }
                if (bj >= 0) selmask |= 1u << bj; }
        }
        if (hi == 0) { SELM[k * 256 + q] = (unsigned short)selmask; unsigned mm = selmask; while (mm) { const int j = __builtin_ctz(mm); mm &= mm - 1u; __hip_atomic_fetch_add(CNT + j, 1, __ATOMIC_RELAXED, __HIP_MEMORY_SCOPE_WORKGROUP); } }
    }
    __syncthreads();
    if (tid == 0) { int acc = 0; for (int j = 0; j < 16; ++j) { LOFF[j] = acc; acc += CNT[j]; } LOFF[16] = acc; }
    __syncthreads();
    for (int lq = tid; lq < 2048; lq += NTHR) { unsigned mm = SELM[lq]; while (mm) { const int j = __builtin_ctz(mm); mm &= mm - 1u; const int pos = __hip_atomic_fetch_add(FILL + j, 1, __ATOMIC_RELAXED, __HIP_MEMORY_SCOPE_WORKGROUP); LIST[LOFF[j] + pos] = (unsigned short)lq; } }
    u32x4 kreg[4], vreg[4];
    auto gblk = [&](int j) { int td = tid; asm volatile("" : "+v"(td));
#pragma unroll
        for (int i = 0; i < 4; ++i) { const int c = td + 512 * i, rr = c >> 3, ch = c & 7; kreg[i] = *(const u32x4*)(Kh + (size_t)(256 * j + rr) * 1024 + ch * 8); vreg[i] = *(const u32x4*)(Vh + (size_t)(256 * j + rr) * 1024 + ch * 8); } };
    gblk(0);
    __syncthreads();
    for (int j = 0; j < 16; ++j) {
        { int td = tid; asm volatile("" : "+v"(td));
#pragma unroll
        for (int i = 0; i < 4; ++i) { const int c = td + 512 * i, rr = c >> 3, ch = c & 7; *(LAS u32x4*)(KB + rr * KS64 + ch * 16) = kreg[i]; *(LAS u32x4*)(VB + rr * VS64 + ch * 16) = vreg[i]; } }
        __syncthreads();
        gblk(j + 1 < 16 ? j + 1 : 15);
        const int nj = CNT[j], ngp = (nj + 31) >> 5, ngo = ((j & 1) == par) ? 8 : 0;
        auto add_state = [&](int lq, const f32x16 (&o)[2], float l) { unsigned char* strow = ST + (size_t)lq * MST_ROW;
#pragma unroll
            for (int d = 0; d < 2; ++d)
#pragma unroll
                for (int rg = 0; rg < 4; ++rg) { unsigned long long* sp = (unsigned long long*)(strow + (32 * d + 8 * rg + 4 * hi) * 2); const unsigned long long sw_ = __hip_atomic_load(sp, __ATOMIC_RELAXED, __HIP_MEMORY_SCOPE_AGENT);
                    const unsigned w0 = (unsigned)sw_, w1 = (unsigned)(sw_ >> 32);
                    const unsigned n0 = pk2(o[d][4 * rg] + bflo(w0), o[d][4 * rg + 1] + bfhi(w0)), n1 = pk2(o[d][4 * rg + 2] + bflo(w1), o[d][4 * rg + 3] + bfhi(w1));
                    *sp = (unsigned long long)n0 | ((unsigned long long)n1 << 32); }
            if (hi == 0) { float* lp = (float*)(strow + 128); *lp = __hip_atomic_load(lp, __ATOMIC_RELAXED, __HIP_MEMORY_SCOPE_AGENT) + l; } };
        for (;;) {
            int it = 0; if (lane == 0) it = __hip_atomic_fetch_add(QC + j, 1, __ATOMIC_RELAXED, __HIP_MEMORY_SCOPE_WORKGROUP);
            it = __builtin_amdgcn_readfirstlane(it);
            if (it >= ngo + ngp) break;
            if (it < ngo) {
                const int gidx = ngo - 1 - it;
                const int lq = (j >> 1) * 256 + 32 * gidx + r32, t = 256 * j + 32 * gidx + r32;
                bf16x8 qf[4];
#pragma unroll
                for (int ks = 0; ks < 4; ++ks) qf[ks] = *(const bf16x8*)(Qh + (size_t)t * 1024 + 16 * ks + 8 * hi);
                f32x16 o[2] = {splat16(0.f), splat16(0.f)}; float l = 0.f;
                const int ntile = ((32 * gidx + 31) >> 6) + 1;
                for (int i = 0; i < ntile; ++i) { f32x16 s0, s1;
                    qk<4>(s0, s1, (lcptr)(KB + i * KT64), KS64, qf, 0.f, r32, hi);
                    bias_mask_near(s0, s1, BTL, t, 256 * j + 64 * i, hi, 0x7fffffffu);
                    exp_step(s0, s1, l); pv<2>(o, s0, s1, (lcptr)(VB + i * VT64), VS64, lane); }
                l += __shfl_xor(l, 32);
                unsigned char* strow = ST + (size_t)lq * MST_ROW;
                const float lt = l + __hip_atomic_load((const float*)(strow + 128), __ATOMIC_RELAXED, __HIP_MEMORY_SCOPE_AGENT); const float f = lt > 0.f ? OSC / lt : 0.f;
                unsigned char* orow = O8 + ((size_t)b * SEQ + t) * 1024 + h * 64;
#pragma unroll
                for (int d = 0; d < 2; ++d)
#pragma unroll
                    for (int rg = 0; rg < 4; ++rg) { const unsigned long long sw_ = __hip_atomic_load((const unsigned long long*)(strow + (32 * d + 8 * rg + 4 * hi) * 2), __ATOMIC_RELAXED, __HIP_MEMORY_SCOPE_AGENT);
                        const unsigned w0 = (unsigned)sw_, w1 = (unsigned)(sw_ >> 32);
                        *(unsigned*)(orow + 32 * d + 8 * rg + 4 * hi) = pg8::pk4_fp8((o[d][4 * rg] + bflo(w0)) * f, (o[d][4 * rg + 1] + bfhi(w0)) * f, (o[d][4 * rg + 2] + bflo(w1)) * f, (o[d][4 * rg + 3] + bfhi(w1)) * f); }
            } else {
                const int gidx = it - ngo, sa = 32 * gidx + r32; const bool va = sa < nj;
                const int lqa = LIST[LOFF[j] + (va ? sa : 32 * gidx)], qba = 2 * (lqa >> 8) + par, ta = 256 * qba + (lqa & 255);
                bf16x8 qa[4];
#pragma unroll
                for (int ks = 0; ks < 4; ++ks) qa[ks] = *(const bf16x8*)(Qh + (size_t)ta * 1024 + 16 * ks + 8 * hi);
                f32x16 o[2] = {splat16(0.f), splat16(0.f)}; float l = 0.f;
                const bool nearany = __any(qba == j + 1);
                for (int i = 0; i < 4; ++i) { f32x16 s0, s1;
                    qk<4>(s0, s1, (lcptr)(KB + i * KT64), KS64, qa, 0.f, r32, hi);
                    if (nearany && i >= 2) bias_mask_near(s0, s1, BTL, ta, 256 * j + 64 * i, hi, 0x7fffffffu);
                    exp_step(s0, s1, l); pv<2>(o, s0, s1, (lcptr)(VB + i * VT64), VS64, lane); }
                l += __shfl_xor(l, 32);
                if (va) add_state(lqa, o, l);
            }
        }
        __syncthreads();
    }
}
__device__ __forceinline__ void phase_moba2(const Frame& F, unsigned char* ws) {
    const bf16_t* Q = (const bf16_t*)(ws + OFF_QKV); const bf16_t* K = Q + (size_t)MTOK * 1024; const bf16_t* V = K + (size_t)MTOK * 1024;
    const float* KMEAN = (const float*)(ws + OFF_KMEAN); const float* BT = (const float*)(ws + OFF_BT);
    for (int v = F.bx; v < 256; v += F.G) { const int x = v & 7, jj = v >> 3, pair = 16 * x + (jj >> 1), par = jj & 1;
        moba2_unit(F, pair >> 4, pair & 15, par, v, Q, K, V, KMEAN, BT, ws + OFF_O8, ws + OFF_MST); __syncthreads(); }
}

__device__ __forceinline__ void nsa_unit(const Frame& F, int b, int g, int c, const bf16_t* Y1, const bf16_t* KC, const bf16_t* VC, const float* BT, unsigned char* MIXIN) {
    using namespace att;
    const int lane = F.lane, r32 = lane & 31, hi = lane >> 5, w = F.wave;
    lptr lds = (lptr)F.lds; lptr tl = lds; LAS float* BTL = (LAS float*)(lds + TL64_BYTES);
    LAS float* SCB = (LAS float*)(lds + TL64_BYTES + 2048);
    LAS unsigned long long* SELM = (LAS unsigned long long*)(lds + TL64_BYTES + 2048 + 16384);
    lptr OFL = lds + TL64_BYTES + 2048 + 16384 + 1024 + w * 8704 + r32 * 272 + hi * 16;
    const int n = r32 & 3, tok = 8 * w + (r32 >> 2), t = 64 * c + tok; const size_t row = (size_t)b * SEQ + t;
    const bf16_t* T1 = Y1 + (size_t)1 * MTOK * 256; const bf16_t* QB = Y1 + (size_t)(2 + g) * MTOK * 256;
    const bf16_t* KVS = Y1 + (size_t)5 * MTOK * 256; const bf16_t* KVW = Y1 + (size_t)6 * MTOK * 256;
    bf16x8 qf[4];
#pragma unroll
    for (int ks = 0; ks < 4; ++ks) qf[ks] = *(const bf16x8*)(QB + row * 256 + n * 64 + 16 * ks + 8 * hi);
    float gate[3];
#pragma unroll
    for (int j = 0; j < 3; ++j) { const float x = bf2f(T1[row * 256 + 208 + (4 * g + n) * 3 + j]); gate[j] = 1.f / (1.f + __expf(-x)); }
    for (int i = F.tid; i < 512; i += NTHR) BTL[i] = BT[(8 + 4 * g) * 128 + i] - BT[(8 + 4 * g) * 128 + (i | 127)];
    for (int i = F.tid; i < 4096; i += NTHR) SCB[i] = 0.f;
    __syncthreads();
    const LAS float* bt = BTL + n * 128; const float cfar = 0.f;
    const int vis = (t >= 31) ? ((t - 31) >> 4) : -1;
    const int ntc = ((4 * c + 2) >> 6) + 1;
    const bf16_t* KCg = KC + ((size_t)b * 256 * 2 + g) * 64; const bf16_t* VCg = VC + ((size_t)b * 256 * 2 + g) * 64;
    auto cmp_scores = [&](int i, lcptr Kt, f32x16& s0, f32x16& s1) {
        qk<4>(s0, s1, Kt, KS64, qf, 0.f, r32, hi);
#pragma unroll
        for (int half = 0; half < 2; ++half) { float bb[16]; f32x16& s = half ? s1 : s0;
#pragma unroll
            for (int r = 0; r < 16; ++r) { const int cc = 64 * i + 32 * half + crow(r, hi); const int d = t - 16 * cc - 31; const unsigned ix = (unsigned)d < 127u ? (unsigned)d : 127u; bb[r] = bt[ix]; }
#pragma unroll
            for (int r = 0; r < 16; ++r) asm volatile("" : "+v"(bb[r]));
#pragma unroll
            for (int r = 0; r < 16; ++r) { const int cc = 64 * i + 32 * half + crow(r, hi); s[r] = (cc <= vis) ? s[r] + bb[r] : -INFINITY; } }
    };
    float mc = NEG_BIG, lc = 0.f;
    tile_loop64(F.tid, tl, ntc, 128,
        [&](int i, const bf16_t*& kp, const bf16_t*& vp) { kp = KCg + (size_t)(64 * i) * 128; vp = VCg + (size_t)(64 * i) * 128; },
        [&](int i, lcptr Kt, lcptr Vt) { f32x16 s0, s1; cmp_scores(i, Kt, s0, s1);
            const float mn = fmaxf(mc, rowmax32(s0, s1)); float rs = 0.f;
#pragma unroll
            for (int r = 0; r < 16; ++r) rs += ex2(s0[r] - mn) + ex2(s1[r] - mn);
            lc = lc * ex2(mc - mn) + rs; mc = mn; });
    lc += __shfl_xor(lc, 32);
    const float invc = lc > 0.f ? 1.f / lc : 0.f;
    {
        f32x16 o[2] = {splat16(0.f), splat16(0.f)}; float carry = 0.f;
        tile_loop64(F.tid, tl, ntc, 128,
            [&](int i, const bf16_t*& kp, const bf16_t*& vp) { kp = KCg + (size_t)(64 * i) * 128; vp = VCg + (size_t)(64 * i) * 128; },
            [&](int i, lcptr Kt, lcptr Vt) { f32x16 s0, s1; cmp_scores(i, Kt, s0, s1);
#pragma unroll
                for (int r = 0; r < 16; ++r) { s0[r] = ex2(s0[r] - mc) * invc; s1[r] = ex2(s1[r] - mc) * invc; }
                float x0[4], x1[4];
#pragma unroll
                for (int rg = 0; rg < 4; ++rg) { x0[rg] = __shfl_xor(s0[4 * rg + 3], 32); x1[rg] = __shfl_xor(s1[4 * rg + 3], 32); }
#pragma unroll
                for (int rg = 0; rg < 4; ++rg) {
                    float g0 = (s0[4 * rg] + s0[4 * rg + 1]) + (s0[4 * rg + 2] + s0[4 * rg + 3]), g1 = (s1[4 * rg] + s1[4 * rg + 1]) + (s1[4 * rg + 2] + s1[4 * rg + 3]);
                    const float e0 = hi ? x0[rg] : (rg > 0 ? x0[rg > 0 ? rg - 1 : 0] : carry), e1 = hi ? x1[rg] : (rg > 0 ? x1[rg > 0 ? rg - 1 : 0] : x0[3]);
                    g0 += e0; g1 += e1;
                    g0 += __shfl_xor(g0, 1); g0 += __shfl_xor(g0, 2); g1 += __shfl_xor(g1, 1); g1 += __shfl_xor(g1, 2);
                    if (n == 0) { SCB[tok * 64 + 16 * i + 2 * rg + hi] = g0; SCB[tok * 64 + 16 * i + 8 + 2 * rg + hi] = g1; }
                }
                carry = x1[3];
                pv<2>(o, s0, s1, Vt, VS64, lane); });
#pragma unroll
        for (int d = 0; d < 2; ++d)
#pragma unroll
            for (int rg = 0; rg < 4; ++rg) *(LAS f32x4*)(OFL + d * 128 + rg * 32) = (f32x4){o[d][4 * rg], o[d][4 * rg + 1], o[d][4 * rg + 2], o[d][4 * rg + 3]} * gate[0];
    }
    {
        unsigned long long uni = 0ull;
#pragma unroll 1
        for (int tk = 0; tk < 8; ++tk) { const int tk2 = 8 * w + tk; float v = SCB[tk2 * 64 + lane];
            v = (lane > c) ? -INFINITY : ((lane == 0 || lane == c || lane == c - 1) ? INFINITY : v);
            int cnt = 0;
#pragma unroll
            for (int j = 0; j < 64; ++j) { const float vj = __builtin_bit_cast(float, __builtin_amdgcn_readlane(__builtin_bit_cast(int, v), j)); cnt += (vj > v || (vj == v && j < lane)) ? 1 : 0; }
            const unsigned long long mk = __ballot(cnt < 16 && lane <= c);
            if (lane == 0) SELM[tk2] = mk;
            uni |= mk; }
        if (lane == 0) SELM[64 + w] = uni;
    }
    __syncthreads();
    const unsigned long long mymask = SELM[tok];
    unsigned long long uni = 0ull;
#pragma unroll
    for (int k = 0; k < 8; ++k) uni |= SELM[64 + k];
    {
        f32x16 o[2] = {splat16(0.f), splat16(0.f)}; float l = 0.f;
        const int nsel = __popcll(uni);
        const bf16_t* Kg = KVS + (size_t)b * SEQ * 256 + g * 64; const bf16_t* Vg = Kg + 128;
        LAS unsigned char* LIST = (LAS unsigned char*)(SELM + 72);
        if (F.tid < 64 && ((uni >> F.tid) & 1ull)) LIST[__popcll(uni & ((1ull << F.tid) - 1ull))] = (unsigned char)F.tid;
        __syncthreads();
        tile_loop64(F.tid, tl, nsel, 256,
            [&](int i, const bf16_t*& kp, const bf16_t*& vp) { const int j = LIST[i]; kp = Kg + (size_t)(64 * j) * 256; vp = Vg + (size_t)(64 * j) * 256; },
            [&](int i, lcptr Kt, lcptr Vt) { const int j = LIST[i];
                const bool sel = (mymask >> j) & 1ull;
                if (!__any(sel)) return;
                f32x16 s0, s1; qk<4>(s0, s1, Kt, KS64, qf, 0.f, r32, hi);
                if (j >= c - 2) bias_mask_near(s0, s1, bt, t, 64 * j, hi, 0x7fffffffu);
                if (!sel) mask_all(s0, s1);
                exp_step(s0, s1, l); pv<2>(o, s0, s1, Vt, VS64, lane); });
        l += __shfl_xor(l, 32); const float f = gate[1] * (l > 0.f ? 1.f / l : 0.f);
#pragma unroll
        for (int d = 0; d < 2; ++d)
#pragma unroll
            for (int rg = 0; rg < 4; ++rg) *(LAS f32x4*)(OFL + d * 128 + rg * 32) += (f32x4){o[d][4 * rg], o[d][4 * rg + 1], o[d][4 * rg + 2], o[d][4 * rg + 3]} * f;
    }
    {
        f32x16 o[2] = {splat16(0.f), splat16(0.f)}; float l = 0.f;
        const int k0 = c >= 8 ? c - 8 : 0, ntw = c - k0 + 1;
        const bf16_t* Kg = KVW + (size_t)b * SEQ * 256 + g * 64; const bf16_t* Vg = Kg + 128;
        tile_loop64(F.tid, tl, ntw, 256,
            [&](int i, const bf16_t*& kp, const bf16_t*& vp) { kp = Kg + (size_t)(64 * (k0 + i)) * 256; vp = Vg + (size_t)(64 * (k0 + i)) * 256; },
            [&](int i, lcptr Kt, lcptr Vt) { const int kt = k0 + i; f32x16 s0, s1; qk<4>(s0, s1, Kt, KS64, qf, 0.f, r32, hi);
                if (!(kt < c - 2 && kt > c - 8)) bias_mask_near(s0, s1, bt, t, 64 * kt, hi, 512u);
                exp_step(s0, s1, l); pv<2>(o, s0, s1, Vt, VS64, lane); });
        l += __shfl_xor(l, 32); const float f = gate[2] * (l > 0.f ? 1.f / l : 0.f);
        unsigned char* orow = MIXIN + row * 1536 + 1024 + (4 * g + n) * 64;
#pragma unroll
        for (int d = 0; d < 2; ++d)
#pragma unroll
            for (int rg = 0; rg < 4; ++rg) { const f32x4 v = (*(LAS f32x4*)(OFL + d * 128 + rg * 32) + (f32x4){o[d][4 * rg], o[d][4 * rg + 1], o[d][4 * rg + 2], o[d][4 * rg + 3]} * f) * OSC;
                *(unsigned*)(orow + 32 * d + 8 * rg + 4 * hi) = pg8::pk4_fp8(v[0], v[1], v[2], v[3]); }
    }
}

__device__ __forceinline__ void dsa_unit(const Frame& F, int b, int u, const bf16_t* QLAT, const bf16_t* CKVN, const unsigned* MASK, const float* BT, unsigned char* MIXIN) {
    using namespace att;
    const int lane = F.lane, r32 = lane & 31, hi = lane >> 5, w = F.wave, tid = F.tid;
    lptr lds = (lptr)F.lds; lptr Kb = lds, Vb = lds + 2 * KT128; LAS float* BTL = (LAS float*)(lds + 2 * KT128 + 2 * VT128);
    const int head = r32 & 7, q0 = 32 * u, t = q0 + 4 * w + (r32 >> 3); const size_t row = (size_t)b * SEQ + t;
    bf16x8 qf[8];
#pragma unroll
    for (int ks = 0; ks < 8; ++ks) qf[ks] = *(const bf16x8*)(QLAT + row * 1024 + head * 128 + 16 * ks + 8 * hi);
    for (int i = tid; i < 1024; i += NTHR) BTL[i] = BT[i] - BT[i | 127];
    const LAS float* bt = BTL + head * 128;
    f32x16 o[4] = {splat16(0.f), splat16(0.f), splat16(0.f), splat16(0.f)}; float l = 0.f;
    const int nt = ((q0 + 31) >> 6) + 1;
    const bf16_t* Cb = CKVN + (size_t)b * SEQ * 128; const unsigned* mrow = MASK + row * 128;
    u32x4 st[2];
    auto gload = [&](int i) {
#pragma unroll
        for (int k = 0; k < 2; ++k) { const int idx = tid + 512 * k, rr = idx >> 4, ch = idx & 15; st[k] = *(const u32x4*)(Cb + (size_t)(64 * i + rr) * 128 + ch * 8); } };
    auto lstore = [&](int i) { lptr kd = Kb + (i & 1) * KT128, vd = Vb + (i & 1) * VT128;
#pragma unroll
        for (int k = 0; k < 2; ++k) { const int idx = tid + 512 * k, rr = idx >> 4, ch = idx & 15; *(LAS u32x4*)(kd + rr * KS128 + ch * 16) = st[k]; *(LAS u32x4*)(vd + rr * VS128 + ch * 16) = st[k]; } };
    auto score = [&](int i, f32x16& s0, f32x16& s1) {
        lcptr Kt = (lcptr)(Kb + (i & 1) * KT128);
        const u32x2 mw = *(const u32x2*)(mrow + 2 * i);
        qk<8>(s0, s1, Kt, KS128, qf, 0.f, r32, hi);
        const unsigned w0 = mw.x >> (4 * hi), w1 = mw.y >> (4 * hi);
        if ((q0 - (64 * i + 63)) < 128) {
#pragma unroll
            for (int r = 0; r < 16; ++r) { const int d0 = t - (64 * i + crow(r, hi)), d1 = d0 - 32;
                const unsigned i0 = (unsigned)d0 < 127u ? (unsigned)d0 : 127u, i1 = (unsigned)d1 < 127u ? (unsigned)d1 : 127u;
                s0[r] += bt[i0]; s1[r] += bt[i1]; }
        }
#pragma unroll
        for (int r = 0; r < 16; ++r) { const int bit = (r & 3) + 8 * (r >> 2);
            const int m0 = __builtin_amdgcn_sbfe((int)w0, bit, 1), m1 = __builtin_amdgcn_sbfe((int)w1, bit, 1);
            const float a0 = s0[r], a1 = s1[r];
            s0[r] = __int_as_float((__float_as_int(a0) & m0) | ((int)0xff800000 & ~m0));
            s1[r] = __int_as_float((__float_as_int(a1) & m1) | ((int)0xff800000 & ~m1)); }
    };
    u32x4 st2[2];
    gload(0); lstore(0);
    if (nt > 1) gload(1);
    __syncthreads();
    auto step = [&](int i, u32x4 (&sL)[2], u32x4 (&sS)[2]) {
        if (i + 2 < nt) {
#pragma unroll
            for (int k = 0; k < 2; ++k) { const int idx = tid + 512 * k, rr = idx >> 4, ch = idx & 15; sL[k] = *(const u32x4*)(Cb + (size_t)(64 * (i + 2) + rr) * 128 + ch * 8); } }
        f32x16 s0, s1; score(i, s0, s1);
        exp_step(s0, s1, l); pv<4>(o, s0, s1, (lcptr)(Vb + (i & 1) * VT128), VS128, lane);
        if (i + 1 < nt) { lptr kd = Kb + ((i + 1) & 1) * KT128, vd = Vb + ((i + 1) & 1) * VT128;
#pragma unroll
            for (int k = 0; k < 2; ++k) { const int idx = tid + 512 * k, rr = idx >> 4, ch = idx & 15; *(LAS u32x4*)(kd + rr * KS128 + ch * 16) = sS[k]; *(LAS u32x4*)(vd + rr * VS128 + ch * 16) = sS[k]; } }
        __syncthreads();
    };
    for (int i = 0; i < nt; i += 2) { step(i, st2, st); if (i + 1 < nt) step(i + 1, st, st2); }
    l += __shfl_xor(l, 32); const float f = l > 0.f ? OSC / l : 0.f;
    unsigned char* orow = MIXIN + row * 1536 + head * 128;
#pragma unroll
    for (int d = 0; d < 4; ++d)
#pragma unroll
        for (int rg = 0; rg < 4; ++rg) *(unsigned*)(orow + 32 * d + 8 * rg + 4 * hi) = pg8::pk4_fp8(o[d][4 * rg] * f, o[d][4 * rg + 1] * f, o[d][4 * rg + 2] * f, o[d][4 * rg + 3] * f);
}

constexpr int DS_TILE = 32 * att::KS128, DS_WAVE = 2 * DS_TILE + 640;
__device__ __forceinline__ void dsa_query(int lane, int b, int t, u32x2 mw, att::lptr base, const LAS float* BTL, const bf16_t* QLAT, const bf16_t* CKVN, unsigned char* MIXIN) {
    using namespace att;
    const int r32 = lane & 31, hi = lane >> 5, head = r32 & 7; const size_t row = (size_t)b * SEQ + t;
    LAS unsigned short* LIST = (LAS unsigned short*)(base + 2 * DS_TILE);
    bf16x8 qf[8];
#pragma unroll
    for (int ks = 0; ks < 8; ++ks) qf[ks] = *(const bf16x8*)(QLAT + row * 1024 + head * 128 + 16 * ks + 8 * hi);
    int n;
    { unsigned long long bits = (lane <= (t >> 6)) ? ((unsigned long long)mw.x | ((unsigned long long)mw.y << 32)) : 0ull;
      const int cnt = __popcll(bits); int pre = cnt;
#pragma unroll
      for (int o = 1; o < 64; o <<= 1) { const int v = __shfl_up(pre, o); if (lane >= o) pre += v; }
      n = __builtin_amdgcn_readlane(pre, 63); int pos = pre - cnt;
      while (bits) { const int j = __builtin_ctzll(bits); bits &= bits - 1ull; LIST[pos++] = (unsigned short)(64 * lane + j); }
      if (lane < 32) LIST[n + lane] = 0; }
    const bf16_t* Cb = CKVN + (size_t)b * SEQ * 128; const LAS float* bt = BTL + head * 128;
    const int ntile = (n + 31) >> 5;
    f32x16 o[4] = {splat16(0.f), splat16(0.f), splat16(0.f), splat16(0.f)}; float l = 0.f;
    u32x4 ra[8];
    auto gath = [&](int i, u32x4 (&r)[8]) {
#pragma unroll
        for (int k = 0; k < 8; ++k) { const int c = lane + 64 * k, rw = c >> 4, ch = c & 15; const int idx = LIST[32 * i + rw]; r[k] = *(const u32x4*)(Cb + (size_t)idx * 128 + ch * 8); } };
    auto put = [&](lptr T, const u32x4 (&r)[8]) {
#pragma unroll
        for (int k = 0; k < 8; ++k) { const int c = lane + 64 * k, rw = c >> 4, ch = c & 15; *(LAS u32x4*)(T + rw * KS128 + ch * 16) = r[k]; } };
    const int hq = lane >> 5, g = (lane >> 4) & 1, q4 = (lane & 15) >> 2, p4 = lane & 3;
    auto tile = [&](int i) {
        lcptr T = (lcptr)(base + (i & 1) * DS_TILE);
        f32x16 s = splat16(0.f);
        { lcptr p0 = T + r32 * KS128 + hi * 16;
#pragma unroll
          for (int ks = 0; ks < 8; ++ks) { const bf16x8 kf = *(const LAS bf16x8*)(p0 + ks * 32); s = __builtin_amdgcn_mfma_f32_32x32x16_bf16(kf, qf[ks], s, 0, 0, 0); } }
        const int lastslot = (32 * i + 31 < n) ? 32 * i + 31 : n - 1;
        if (32 * i + 32 > n || t - (int)LIST[lastslot] < 127) {
#pragma unroll
            for (int h8 = 0; h8 < 2; ++h8) { int li[8]; float bb[8];
#pragma unroll
                for (int r = 0; r < 8; ++r) li[r] = LIST[32 * i + crow(8 * h8 + r, hi)];
#pragma unroll
                for (int r = 0; r < 8; ++r) asm volatile("" : "+v"(li[r]));
#pragma unroll
                for (int r = 0; r < 8; ++r) { const int d = t - li[r]; const unsigned ix = (unsigned)d < 127u ? (unsigned)d : 127u; bb[r] = bt[ix]; }
#pragma unroll
                for (int r = 0; r < 8; ++r) asm volatile("" : "+v"(bb[r]));
#pragma unroll
                for (int r = 0; r < 8; ++r) { const int slot = 32 * i + crow(8 * h8 + r, hi); s[8 * h8 + r] = (slot < n) ? s[8 * h8 + r] + bb[r] : -INFINITY; } }
        }
        float rs = 0.f;
#pragma unroll
        for (int r = 0; r < 16; ++r) { s[r] = ex2(s[r]); rs += s[r]; }
        l += rs;
        const bf16x8 pk[2] = {pack_p(s, 0), pack_p(s, 8)};
        lcptr vb = T + (4 * hq + q4) * KS128 + (16 * g + 4 * p4) * 2;
#pragma unroll
        for (int k = 0; k < 2; ++k)
#pragma unroll
            for (int d = 0; d < 4; ++d) { const s16x4 lo = vtr(vb + (16 * k) * KS128 + d * 64), hh = vtr(vb + (16 * k + 8) * KS128 + d * 64);
                const bf16x8 vf = (bf16x8){lo[0], lo[1], lo[2], lo[3], hh[0], hh[1], hh[2], hh[3]};
                o[d] = __builtin_amdgcn_mfma_f32_32x32x16_bf16(vf, pk[k], o[d], 0, 0, 0); }
    };
    gath(0, ra); put(base, ra);
    for (int i = 0; i < ntile; ++i) {
        const bool more = i + 1 < ntile;
        if (more) gath(i + 1, ra);
        tile(i);
        if (more) put(base + ((i + 1) & 1) * DS_TILE, ra);
    }
    l += __shfl_xor(l, 32); const float f = l > 0.f ? OSC / l : 0.f;
    if (r32 < 8) { unsigned char* orow = MIXIN + row * 1536 + head * 128;
#pragma unroll
        for (int d = 0; d < 4; ++d)
#pragma unroll
            for (int rg = 0; rg < 4; ++rg) *(unsigned*)(orow + 32 * d + 8 * rg + 4 * hi) = pg8::pk4_fp8(o[d][4 * rg] * f, o[d][4 * rg + 1] * f, o[d][4 * rg + 2] * f, o[d][4 * rg + 3] * f); }
}
__device__ __forceinline__ void phase_dsa_sparse(const Frame& F, const bf16_t* QLAT, const bf16_t* CKVN, const unsigned* MASK, const float* BT, unsigned char* MIXIN) {
    att::lptr lds = (att::lptr)F.lds; LAS float* BTL = (LAS float*)(lds + 8 * DS_WAVE);
    for (int i = F.tid; i < 1024; i += NTHR) BTL[i] = BT[i] - BT[i | 127];
    __syncthreads();
    att::lptr base = lds + F.wave * DS_WAVE;
    if ((F.G & 7) == 0) {
        const int b = F.bx & 7, wx = (F.bx >> 3) * NWAVES + F.wave, WX = (F.G >> 3) * NWAVES;
        u32x2 mw = *(const u32x2*)(MASK + ((size_t)b * SEQ + wx) * 128 + 2 * F.lane);
        for (int t = wx; t < SEQ; t += WX) { const int tn = (t + WX < SEQ) ? t + WX : t;
            const u32x2 mwn = *(const u32x2*)(MASK + ((size_t)b * SEQ + tn) * 128 + 2 * F.lane);
            dsa_query(F.lane, b, t, mw, base, BTL, QLAT, CKVN, MIXIN); mw = mwn; }
    } else {
        for (int q = F.gw; q < MTOK; q += F.NGW) { const u32x2 mw = *(const u32x2*)(MASK + (size_t)q * 128 + 2 * F.lane); dsa_query(F.lane, q >> 12, q & 4095, mw, base, BTL, QLAT, CKVN, MIXIN); }
    }
    __syncthreads();
}

constexpr int QI_STRIDE = 2064;
__device__ __forceinline__ void indexer_unit(const Frame& F, int b, int c, const bf16_t* QIDX, const bf16_t* T1, _Float16* SC) {
    using namespace att;
    const int lane = F.lane, r32 = lane & 31, hi = lane >> 5, w = F.wave, tid = F.tid;
    lptr lds = (lptr)F.lds; lptr QI = lds; lptr KI = lds + 64 * QI_STRIDE;
    const int qh = w & 1, kq = w >> 1;
    const size_t row0 = (size_t)b * SEQ + 64 * c;
#pragma unroll 4
    for (int k = 0; k < 16; ++k) { const int idx = tid + 512 * k, rr = idx >> 7, ch = idx & 127; *(LAS u32x4*)(QI + rr * QI_STRIDE + ch * 16) = *(const u32x4*)(QIDX + (row0 + rr) * 1024 + ch * 8); }
    float wv[16];
    { const size_t trow = row0 + 32 * qh + r32; const u32x4 a = *(const u32x4*)(T1 + trow * 256 + 192), bq = *(const u32x4*)(T1 + trow * 256 + 200);
      wv[0] = bflo(a.x); wv[1] = bfhi(a.x); wv[2] = bflo(a.y); wv[3] = bfhi(a.y); wv[4] = bflo(a.z); wv[5] = bfhi(a.z); wv[6] = bflo(a.w); wv[7] = bfhi(a.w);
      wv[8] = bflo(bq.x); wv[9] = bfhi(bq.x); wv[10] = bflo(bq.y); wv[11] = bfhi(bq.y); wv[12] = bflo(bq.z); wv[13] = bfhi(bq.z); wv[14] = bflo(bq.w); wv[15] = bfhi(bq.w); }
    const int nsup = (c + 2) >> 1, pitch = (c + 1) * 64;
    _Float16* srow = SC + (size_t)b * SCB_ELEMS + (size_t)4096 * (c * (c + 1) / 2) + (size_t)(32 * qh + r32) * pitch;
    const bf16_t* Kb = T1 + (size_t)b * SEQ * 256 + 128;
    u32x4 st[2];
    for (int s = 0; s < nsup; ++s) {
#pragma unroll
        for (int k = 0; k < 2; ++k) { const int idx = tid + 512 * k, rr = idx >> 3, ch = idx & 7; st[k] = *(const u32x4*)(Kb + (size_t)(128 * s + rr) * 256 + ch * 8); }
        __syncthreads();
#pragma unroll
        for (int k = 0; k < 2; ++k) { const int idx = tid + 512 * k, rr = idx >> 3, ch = idx & 7; *(LAS u32x4*)(KI + rr * KS64 + ch * 16) = st[k]; }
        __syncthreads();
        const int key0 = 128 * s + 32 * kq;
        if (key0 <= 64 * c + 63) {
            bf16x8 kf[4];
#pragma unroll
            for (int ks = 0; ks < 4; ++ks) kf[ks] = *(const LAS bf16x8*)(KI + (32 * kq + r32) * KS64 + ks * 32 + hi * 16);
            f32x16 sc = splat16(0.f);
            lcptr qp = (lcptr)QI + (32 * qh + r32) * QI_STRIDE + hi * 16;
#pragma unroll 2
            for (int hd = 0; hd < 16; ++hd) { f32x16 acc = splat16(0.f);
#pragma unroll
                for (int ks = 0; ks < 4; ++ks) { const bf16x8 qv = *(const LAS bf16x8*)(qp + hd * 128 + ks * 32); acc = __builtin_amdgcn_mfma_f32_32x32x16_bf16(kf[ks], qv, acc, 0, 0, 0); }
                const float ww = wv[hd];
#pragma unroll
                for (int r = 0; r < 16; ++r) sc[r] += ww * fmaxf(acc[r], 0.f); }
#pragma unroll
            for (int rg = 0; rg < 4; ++rg) { f32x2 a = {sc[4 * rg], sc[4 * rg + 1]}, bq = {sc[4 * rg + 2], sc[4 * rg + 3]};
                u32x2 o; o.x = __builtin_bit_cast(unsigned, __builtin_convertvector(a, f16x2_t)); o.y = __builtin_bit_cast(unsigned, __builtin_convertvector(bq, f16x2_t));
                *(u32x2*)(srow + key0 + 8 * rg + 4 * hi) = o; }
        }
    }
    __syncthreads();
}

struct SelRow { const unsigned short* src; unsigned* mrow; int t, c; };
__device__ __forceinline__ SelRow sel_row(int row, const _Float16* SC, unsigned* MASK) {
    SelRow r; const int b = row >> 12; r.t = row & 4095; r.c = r.t >> 6; const int nk = (r.c + 1) * 64;
    r.src = (const unsigned short*)SC + (size_t)b * SCB_ELEMS + (size_t)4096 * (r.c * (r.c + 1) / 2) + (size_t)(r.t & 63) * nk; r.mrow = MASK + (size_t)row * 128; return r;
}
__device__ __forceinline__ void sel_load(const SelRow& r, int lane, unsigned (&key)[64]) {
#pragma unroll
    for (int g = 0; g < 4; ++g) {
        if (r.c >= 16 * g) {
#pragma unroll
            for (int jj = 0; jj < 16; ++jj) { const int j = 16 * g + jj, jc = j <= r.c ? j : r.c;
                const unsigned uu = r.src[64 * jc + lane]; const unsigned k = (uu & 0x8000u) ? (~uu & 0xffffu) : (uu | 0x8000u);
                key[j] = (64 * j + lane > r.t) ? 0u : k; }
        } else {
#pragma unroll
            for (int jj = 0; jj < 16; ++jj) key[16 * g + jj] = 0u;
        }
    }
}
template <bool GT> __device__ __forceinline__ int sel_count(const unsigned (&key)[64], unsigned cand, int c) {
    int cnt = 0;
#pragma unroll
    for (int g = 0; g < 4; ++g) if (c >= 16 * g) {
#pragma unroll
        for (int jj = 0; jj < 16; ++jj) cnt += __popcll(__ballot(GT ? (key[16 * g + jj] > cand) : (key[16 * g + jj] >= cand)));
    }
    return cnt;
}
__device__ __forceinline__ void sel_emit(const SelRow& r, int lane, const unsigned (&key)[64], unsigned prefix, bool exact) {
    if (exact) {
#pragma unroll
        for (int j = 0; j < 64; ++j) if (j <= r.c) { const unsigned long long mk = __ballot(key[j] >= prefix); if (lane == 0) *(u32x2*)(r.mrow + 2 * j) = (u32x2){(unsigned)mk, (unsigned)(mk >> 32)}; }
        return;
    }
    int rem = 256 - sel_count<true>(key, prefix, r.c);
#pragma unroll
    for (int j = 0; j < 64; ++j) {
        if (j <= r.c) {
            const bool eq = key[j] == prefix; const unsigned long long eqm = __ballot(eq);
            const int before = __builtin_amdgcn_mbcnt_hi((unsigned)(eqm >> 32), __builtin_amdgcn_mbcnt_lo((unsigned)eqm, 0u));
            const unsigned long long mk = __ballot(key[j] > prefix || (eq && before < rem));
            rem -= __popcll(eqm); rem = rem < 0 ? 0 : rem;
            if (lane == 0) *(u32x2*)(r.mrow + 2 * j) = (u32x2){(unsigned)mk, (unsigned)(mk >> 32)};
        }
    }
}
__device__ __forceinline__ void sel_small(const SelRow& r, int lane) {
    for (int j = 0; j <= r.c; ++j) { const unsigned long long mk = __ballot(64 * j + lane <= r.t); if (lane == 0) *(u32x2*)(r.mrow + 2 * j) = (u32x2){(unsigned)mk, (unsigned)(mk >> 32)}; }
}
__device__ __forceinline__ void phase_select(const Frame& F, const _Float16* SC, unsigned* MASK) {
    const int lane = F.lane;
    for (int p = F.gw; p < MTOK / 2; p += F.NGW) {
        const int pb_ = p >> 11, q = p & 2047;
        const SelRow ra = sel_row(pb_ * 4096 + q, SC, MASK), rb = sel_row(pb_ * 4096 + 4095 - q, SC, MASK);
        const bool sa = ra.t < 256, sb = rb.t < 256;
        if (sa) sel_small(ra, lane);
        if (sb) sel_small(rb, lane);
        if (sa && sb) continue;
        unsigned ka[64], kb[64];
        sel_load(ra, lane, ka); sel_load(rb, lane, kb);
        unsigned pa = 0u, pb = 0u; bool da = sa, db = sb;
#pragma unroll 1
        for (int bit = 15; bit >= 0 && !(da && db); --bit) {
            if (!da) { const unsigned ca = pa | (1u << bit); const int na = sel_count<false>(ka, ca, ra.c); if (na >= 256) pa = ca; if (na == 256) da = true; }
            if (!db) { const unsigned cb = pb | (1u << bit); const int nb = sel_count<false>(kb, cb, rb.c); if (nb >= 256) pb = cb; if (nb == 256) db = true; }
        }
        if (!sa) sel_emit(ra, lane, ka, pa, da);
        if (!sb) sel_emit(rb, lane, kb, pb, db);
    }
}

__device__ __forceinline__ float gelu_tanh(float x) { const float u = 0.7978845608028654f * (x + 0.044715f * x * x * x); const float e = __expf(2.f * u); return 0.5f * x * (1.f + (1.f - 2.f / (e + 1.f))); }
__device__ __forceinline__ void compress_unit(const Frame& F, int b, int g, int kv, int rt, const bf16_t* KVC, const bf16_t* W1T, const float* w2, const float* cb, bf16_t* OUT) {
    const int lane = F.lane, r32 = lane & 31, hi = lane >> 5, w = F.wave, tid = F.tid;
    LAS float* PART = (LAS float*)F.lds;
    LAS float* HID = PART + 8 * 2048;
    const int n0 = 32 * rt, nn = n0 + r32, nc = nn < 255 ? nn : 254;
    const bf16_t* arow = KVC + ((size_t)b * SEQ + 16 * nc) * 256 + kv * 128 + g * 64;
    f32x16 a0 = att::splat16(0.f), a1 = att::splat16(0.f);
#pragma unroll 4
    for (int ks = 0; ks < 16; ++ks) { const int l = 4 * w + (ks >> 2), d = 16 * (ks & 3) + 8 * hi;
        const bf16x8 af = *(const bf16x8*)(arow + (size_t)l * 256 + d);
        const bf16x8 b0 = *(const bf16x8*)(W1T + (size_t)r32 * 2048 + l * 64 + d), b1 = *(const bf16x8*)(W1T + (size_t)(32 + r32) * 2048 + l * 64 + d);
        a0 = __builtin_amdgcn_mfma_f32_32x32x16_bf16(af, b0, a0, 0, 0, 0); a1 = __builtin_amdgcn_mfma_f32_32x32x16_bf16(af, b1, a1, 0, 0, 0); }
#pragma unroll
    for (int r = 0; r < 16; ++r) { const int mrow = att::crow(r, hi); PART[w * 2048 + mrow * 64 + r32] = a0[r]; PART[w * 2048 + mrow * 64 + 32 + r32] = a1[r]; }
    __syncthreads();
#pragma unroll
    for (int k = 0; k < 4; ++k) { const int idx = tid + 512 * k; float s = cb[idx & 63];
#pragma unroll
        for (int ww = 0; ww < 8; ++ww) s += PART[ww * 2048 + idx];
        HID[idx] = gelu_tanh(s); }
    __syncthreads();
#pragma unroll
    for (int k = 0; k < 4; ++k) { const int idx = tid + 512 * k, nr = idx >> 6, f = idx & 63; float s = 0.f;
#pragma unroll 8
        for (int e = 0; e < 64; ++e) s += HID[nr * 64 + e] * w2[e * 64 + f];
        const int blk = n0 + nr;
        OUT[(((size_t)b * 256 + blk) * 2 + g) * 64 + f] = (blk < 255) ? (bf16_t)f2bf(s) : (bf16_t)0; }
    __syncthreads();
}

#ifdef DBG_MODE
namespace dbg {
constexpr int NSLOT = 40;
__device__ __forceinline__ float bfr(float x) { return bf2f((unsigned short)f2bf(x)); }
__device__ __forceinline__ int srow(int i, int n) { return (int)(((unsigned)i * 2654435761u) % (unsigned)MTOK) ; }
__device__ void commit(unsigned* D, int slot, const float* ref, const float* fast, int n, float tf) {
    __shared__ float red[256];
    const int tid = threadIdx.x; float s = 0.f;
    for (int i = tid; i < n; i += 256) s += ref[i] * ref[i];
    red[tid] = s; __syncthreads();
    for (int o = 128; o > 0; o >>= 1) { if (tid < o) red[tid] += red[tid + o]; __syncthreads(); }
    const float rms = sqrtf(red[0] / (float)n); __syncthreads();
    int bad = 0, tot = 0; float mr = 0.f;
    for (int i = tid; i < n; i += 256) { const float e = fabsf(fast[i] - ref[i]); const float tol = tf * (rms + fabsf(ref[i])) + 1e-7f; if (!(e <= tol)) ++bad; ++tot; const float r = e / (rms + 1e-20f); if (r > mr || !(r == r)) mr = (r == r) ? r : 1e30f; }
    atomicAdd(&D[4 * slot], (unsigned)bad); atomicAdd(&D[4 * slot + 1], (unsigned)tot); atomicMax(&D[4 * slot + 2], __float_as_uint(mr));
    __syncthreads();
}
__device__ __forceinline__ float bias_l2(const float* relb, int head, int dist) { return relb[t5_bucket(dist) * 16 + head] * LOG2E; }

__global__ void chk_in_e(Args a, unsigned* D) {
    __shared__ float ref[1792], fast[1792];
    const int r = srow(blockIdx.x, 64), tid = threadIdx.x; const float* x = a.in[I_X] + (size_t)r * 1024; const float* w = a.in[I_EWIN];
    const bf16_t* Y1 = (const bf16_t*)(a.ws + OFF_Y1);
    for (int n = tid; n < EVEN_IN; n += 256) { float s = 0.f; for (int k = 0; k < 1024; ++k) s += bfr(x[k]) * bfr(w[(size_t)k * EVEN_IN + n]);
        const int dc = RowInE{}(n), tile = dc >> 8, col = dc & 255; const float sc = (tile == 2 || tile == 3) ? QSCALE : 1.f;
        ref[n] = s * sc; fast[n] = bf2f(Y1[((size_t)tile * MTOK + r) * 256 + col]); }
    __syncthreads();
    commit(D, 1, ref, fast, EVEN_IN, 0.02f);
    if (tid == 0) { float sq = 0.f, skv = 0.f; for (int n = 0; n < 256; ++n) sq += ref[n] * ref[n]; for (int n = 256; n < 384; ++n) skv += ref[n] * ref[n];
        const float* pq = (const float*)(a.ws + OFF_SSQ_Q) + (size_t)r * 4; const float* pk = (const float*)(a.ws + OFF_SSQ_KV) + (size_t)r * 4;
        const float fq = pq[0] + pq[1] + pq[2] + pq[3], fk = pk[0] + pk[1] + pk[2] + pk[3];
        int bad = 0; if (!(fabsf(fq - sq) <= 0.02f * sq)) ++bad; if (!(fabsf(fk - skv) <= 0.02f * skv)) ++bad;
        atomicAdd(&D[4 * 2], (unsigned)bad); atomicAdd(&D[4 * 2 + 1], 2u); }
}
__global__ void chk_q2(Args a, unsigned* D) {
    __shared__ float ref[1024], fast[1024], cqn[256], qh[512];
    const int r = srow(blockIdx.x, 64), tid = threadIdx.x; const bf16_t* Y1 = (const bf16_t*)(a.ws + OFF_Y1);
    const bf16_t* CQ = Y1 + (size_t)r * 256; const bf16_t* T1 = Y1 + ((size_t)MTOK + r) * 256;
    { float s = 0.f; for (int k = 0; k < 128; ++k) { const float c = bf2f(T1[k]); s += c * c; } const float rk = 1.f / sqrtf(s / 128.f + 1e-6f);
      if (tid < 128) { ref[tid] = bf2f(T1[tid]) * rk * a.in[I_EKVN][tid]; fast[tid] = bf2f(((const bf16_t*)(a.ws + OFF_CKVN))[(size_t)r * 128 + tid]); } }
    __syncthreads(); commit(D, 3, ref, fast, 128, 0.02f);
    { float s = 0.f; for (int k = 0; k < 256; ++k) { const float c = bf2f(CQ[k]); s += c * c; } const float rq = 1.f / sqrtf(s / 256.f + 1e-6f);
      cqn[tid] = bf2f(CQ[tid]) * rq * a.in[I_EQN][tid]; }
    __syncthreads();
    for (int o = tid; o < 512; o += 256) { float s = 0.f; for (int k = 0; k < 256; ++k) s += cqn[k] * a.in[I_EWUQ][k * 512 + o]; qh[o] = s; }
    __syncthreads();
    for (int o = tid; o < 1024; o += 256) { const int h = o >> 7, c = o & 127; float s = 0.f; for (int d = 0; d < 64; ++d) s += qh[h * 64 + d] * a.in[I_EWUK][c * 512 + h * 64 + d];
        ref[o] = s * QSCALE; fast[o] = bf2f(((const bf16_t*)(a.ws + OFF_QLAT))[(size_t)r * 1024 + o]); }
    __syncthreads(); commit(D, 5, ref, fast, 1024, 0.03f);
    for (int o = tid; o < 1024; o += 256) { float s = 0.f; for (int k = 0; k < 256; ++k) s += cqn[k] * a.in[I_EWQIDX][k * 1024 + o];
        ref[o] = s; fast[o] = bf2f(((const bf16_t*)(a.ws + OFF_QIDX))[(size_t)r * 1024 + o]); }
    __syncthreads(); commit(D, 6, ref, fast, 1024, 0.03f);
}
__global__ void chk_cmp(Args a, unsigned* D) {
    __shared__ float ref[64], fast[64], hid[64];
    const int i = blockIdx.x, tid = threadIdx.x, b = i & 7, g = (i >> 3) & 1, kv = (i >> 4) & 1; const int blk = (i >> 5) == 0 ? 0 : ((i >> 5) == 1 ? 254 : (int)((unsigned)(i * 37 + 11) % 255u));
    const bf16_t* KVC = (const bf16_t*)(a.ws + OFF_Y1) + (size_t)4 * MTOK * 256;
    const float* pos = a.in[kv ? I_EPOSV : I_EPOSK]; const float* w1 = a.in[kv ? I_ECV1 : I_ECK1]; const float* w2 = a.in[kv ? I_ECV2 : I_ECK2];
    if (tid < 64) { float s = 0.f;
        for (int l = 0; l < 32; ++l) for (int d = 0; d < 64; ++d) { const float av = bf2f(KVC[((size_t)b * SEQ + 16 * blk + l) * 256 + kv * 128 + g * 64 + d]); const float wv = w1[(l * 64 + d) * 64 + tid]; s += av * bfr(wv) + pos[l * 64 + d] * wv; }
        hid[tid] = gelu_tanh(s); }
    __syncthreads();
    if (tid < 64) { float s = 0.f; for (int e = 0; e < 64; ++e) s += hid[e] * w2[e * 64 + tid]; ref[tid] = s;
        fast[tid] = bf2f(((const bf16_t*)(a.ws + (kv ? OFF_VC : OFF_KC)))[(((size_t)b * 256 + blk) * 2 + g) * 64 + tid]); }
    __syncthreads(); commit(D, 4, ref, fast, 64, 0.03f);
}
__global__ void chk_idx(Args a, unsigned* D) {
    __shared__ float ref[256], fast[256];
    const int r = (blockIdx.x < 4) ? (blockIdx.x * 4096 + blockIdx.x * 61) : srow(blockIdx.x, 64), tid = threadIdx.x, b = r >> 12, t = r & 4095, c = t >> 6, nk = (c + 1) * 64;
    const bf16_t* Y1 = (const bf16_t*)(a.ws + OFF_Y1); const bf16_t* T1 = Y1 + (size_t)MTOK * 256; const bf16_t* QI = (const bf16_t*)(a.ws + OFF_QIDX) + (size_t)r * 1024;
    const int s = (int)(((unsigned)tid * 2654435761u + 12345u * blockIdx.x) % (unsigned)nk);
    const bf16_t* kr = T1 + ((size_t)b * SEQ + s) * 256 + 128; float sc = 0.f;
    for (int h = 0; h < 16; ++h) { float d = 0.f; for (int k = 0; k < 64; ++k) d += bf2f(QI[h * 64 + k]) * bf2f(kr[k]); sc += bf2f(T1[(size_t)r * 256 + 192 + h]) * fmaxf(d, 0.f); }
    ref[tid] = sc;
    const _Float16* SC = (const _Float16*)(a.ws + OFF_SC) + (size_t)b * SCB_ELEMS + (size_t)4096 * (c * (c + 1) / 2) + (size_t)(t & 63) * nk;
    fast[tid] = (float)SC[s];
    __syncthreads(); commit(D, 7, ref, fast, 256, 0.02f);
}
__global__ void chk_sel(Args a, unsigned* D) {
    __shared__ unsigned key[4096];
    const int r = (blockIdx.x < 8) ? (blockIdx.x * 4096 + 255 + blockIdx.x * 300) : srow(blockIdx.x, 64), tid = threadIdx.x, b = r >> 12, t = r & 4095, c = t >> 6, nk = (c + 1) * 64;
    const unsigned short* SC = (const unsigned short*)(a.ws + OFF_SC) + (size_t)b * SCB_ELEMS + (size_t)4096 * (c * (c + 1) / 2) + (size_t)(t & 63) * nk;
    const unsigned* M = (const unsigned*)(a.ws + OFF_MASK) + (size_t)r * 128;
    for (int s = tid; s < nk; s += 256) { const unsigned u = SC[s]; key[s] = (s <= t) ? ((u & 0x8000u) ? (~u & 0xffffu) : (u | 0x8000u)) : 0u; }
    __syncthreads();
    int bad = 0, tot = 0;
    for (int s = tid; s < nk; s += 256) { bool want;
        if (s > t) want = false; else if (t < 256) want = true;
        else { int rank = 0; const unsigned ks = key[s]; for (int q = 0; q <= t; ++q) rank += (key[q] > ks || (key[q] == ks && q < s)) ? 1 : 0; want = rank < 256; }
        const bool got = (M[s >> 5] >> (s & 31)) & 1u; if (want != got) ++bad; ++tot; }
    atomicAdd(&D[4 * 8], (unsigned)bad); atomicAdd(&D[4 * 8 + 1], (unsigned)tot);
}
__global__ void chk_dsa(Args a, unsigned* D) {
    __shared__ float lg[4096], red[256], ref[128], fast[128];
    const int r = (blockIdx.x < 8) ? (blockIdx.x * 4096 + blockIdx.x * 37) : srow(blockIdx.x, 64), tid = threadIdx.x, b = r >> 12, t = r & 4095, h = blockIdx.x & 7;
    const bf16_t* Q = (const bf16_t*)(a.ws + OFF_QLAT) + (size_t)r * 1024 + h * 128; const bf16_t* C = (const bf16_t*)(a.ws + OFF_CKVN) + (size_t)b * SEQ * 128;
    const unsigned* M = (const unsigned*)(a.ws + OFF_MASK) + (size_t)r * 128; const float* relb = a.in[I_RELB];
    float mx = -INFINITY;
    for (int s = tid; s <= t; s += 256) { float v = -INFINITY; if ((M[s >> 5] >> (s & 31)) & 1u) { float d = 0.f; for (int k = 0; k < 128; ++k) d += bf2f(Q[k]) * bf2f(C[(size_t)s * 128 + k]); v = d + bias_l2(relb, h, t - s); } lg[s] = v; mx = fmaxf(mx, v); }
    red[tid] = mx; __syncthreads(); for (int o = 128; o > 0; o >>= 1) { if (tid < o) red[tid] = fmaxf(red[tid], red[tid + o]); __syncthreads(); } mx = red[0]; __syncthreads();
    float sm = 0.f; for (int s = tid; s <= t; s += 256) { const float p = exp2f(lg[s] - mx); lg[s] = p; sm += p; }
    red[tid] = sm; __syncthreads(); for (int o = 128; o > 0; o >>= 1) { if (tid < o) red[tid] += red[tid + o]; __syncthreads(); } sm = red[0]; __syncthreads();
    if (tid < 128) { float o = 0.f; for (int s = 0; s <= t; ++s) o += lg[s] * bf2f(C[(size_t)s * 128 + tid]); ref[tid] = o / sm; fast[tid] = bf2f(((const bf16_t*)(a.ws + OFF_MIXIN))[(size_t)r * 1536 + h * 128 + tid]); }
    __syncthreads(); commit(D, 9, ref, fast, 128, 0.03f);
}
__global__ void chk_nsa(Args a, unsigned* D) {
    __shared__ float pc[4][256], lg[1100], red[256], ref[64], fast[64], oacc[3][64], scb[64]; __shared__ int selj[16]; __shared__ float qs[4][64];
    const int r = (blockIdx.x < 8) ? (blockIdx.x * 4096 + blockIdx.x * 41) : srow(blockIdx.x, 64), tid = threadIdx.x, b = r >> 12, t = r & 4095, hh = blockIdx.x & 7, g = hh >> 2, n = hh & 3, cur = t >> 6;
    const bf16_t* Y1 = (const bf16_t*)(a.ws + OFF_Y1); const bf16_t* T1 = Y1 + (size_t)MTOK * 256; const bf16_t* QB = Y1 + (size_t)(2 + g) * MTOK * 256;
    const bf16_t* KVS = Y1 + (size_t)5 * MTOK * 256; const bf16_t* KVW = Y1 + (size_t)6 * MTOK * 256;
    const bf16_t* KC = (const bf16_t*)(a.ws + OFF_KC); const bf16_t* VC = (const bf16_t*)(a.ws + OFF_VC); const float* relb = a.in[I_RELB];
    qs[tid >> 6][tid & 63] = bf2f(QB[(size_t)r * 256 + tid]);
    __syncthreads();
    const int vis = (t >= 31) ? ((t - 31) >> 4) : -1;
    for (int nn = 0; nn < 4; ++nn) {
        float v = -INFINITY; if (tid <= vis) { float d = 0.f; for (int k = 0; k < 64; ++k) d += qs[nn][k] * bf2f(KC[(((size_t)b * 256 + tid) * 2 + g) * 64 + k]); v = d + bias_l2(relb, 8 + 4 * g + nn, t - 16 * tid - 31); }
        red[tid] = v; __syncthreads(); for (int o = 128; o > 0; o >>= 1) { if (tid < o) red[tid] = fmaxf(red[tid], red[tid + o]); __syncthreads(); } const float mx = red[0]; __syncthreads();
        const float p = (tid <= vis) ? exp2f(v - mx) : 0.f; red[tid] = p; __syncthreads(); for (int o = 128; o > 0; o >>= 1) { if (tid < o) red[tid] += red[tid + o]; __syncthreads(); } const float sm = red[0]; __syncthreads();
        pc[nn][tid] = sm > 0.f ? p / sm : 0.f; __syncthreads();
    }
    if (tid < 64) { float o = 0.f; for (int i = 0; i <= vis; ++i) o += pc[n][i] * bf2f(VC[(((size_t)b * 256 + i) * 2 + g) * 64 + tid]); oacc[0][tid] = o;
        float s = 0.f; for (int nn = 0; nn < 4; ++nn) for (int i = 4 * tid - 1; i <= 4 * tid + 3; ++i) if (i >= 0 && i < 255) s += pc[nn][i];
        scb[tid] = (tid > cur) ? -INFINITY : ((tid == 0 || tid == cur || tid == cur - 1) ? INFINITY : s); }
    __syncthreads();
    if (tid < 64) { int rank = 0; for (int j = 0; j < 64; ++j) rank += (scb[j] > scb[tid] || (scb[j] == scb[tid] && j < tid)) ? 1 : 0; if (rank < 16) selj[rank] = tid; }
    __syncthreads();
    { float mx = -INFINITY;
      for (int i = tid; i < 1024; i += 256) { const int j = selj[i >> 6], p = 64 * j + (i & 63); float v = -INFINITY; if (p <= t) { float d = 0.f; for (int k = 0; k < 64; ++k) d += qs[n][k] * bf2f(KVS[((size_t)b * SEQ + p) * 256 + g * 64 + k]); v = d + bias_l2(relb, 8 + hh, t - p); } lg[i] = v; mx = fmaxf(mx, v); }
      red[tid] = mx; __syncthreads(); for (int o = 128; o > 0; o >>= 1) { if (tid < o) red[tid] = fmaxf(red[tid], red[tid + o]); __syncthreads(); } mx = red[0]; __syncthreads();
      float sm = 0.f; for (int i = tid; i < 1024; i += 256) { const float p = exp2f(lg[i] - mx); lg[i] = p; sm += p; }
      red[tid] = sm; __syncthreads(); for (int o = 128; o > 0; o >>= 1) { if (tid < o) red[tid] += red[tid + o]; __syncthreads(); } sm = red[0]; __syncthreads();
      if (tid < 64) { float o = 0.f; for (int i = 0; i < 1024; ++i) { const int p = 64 * selj[i >> 6] + (i & 63); if (p <= t) o += lg[i] * bf2f(KVS[((size_t)b * SEQ + p) * 256 + 128 + g * 64 + tid]); } oacc[1][tid] = o / sm; }
      __syncthreads(); }
    { float mx = -INFINITY;
      for (int i = tid; i < 512; i += 256) { const int p = t - i; float v = -INFINITY; if (p >= 0) { float d = 0.f; for (int k = 0; k < 64; ++k) d += qs[n][k] * bf2f(KVW[((size_t)b * SEQ + p) * 256 + g * 64 + k]); v = d + bias_l2(relb, 8 + hh, i); } lg[i] = v; mx = fmaxf(mx, v); }
      red[tid] = mx; __syncthreads(); for (int o = 128; o > 0; o >>= 1) { if (tid < o) red[tid] = fmaxf(red[tid], red[tid + o]); __syncthreads(); } mx = red[0]; __syncthreads();
      float sm = 0.f; for (int i = tid; i < 512; i += 256) { const float p = exp2f(lg[i] - mx); lg[i] = p; sm += p; }
      red[tid] = sm; __syncthreads(); for (int o = 128; o > 0; o >>= 1) { if (tid < o) red[tid] += red[tid + o]; __syncthreads(); } sm = red[0]; __syncthreads();
      if (tid < 64) { float o = 0.f; for (int i = 0; i < 512; ++i) { const int p = t - i; if (p >= 0) o += lg[i] * bf2f(KVW[((size_t)b * SEQ + p) * 256 + 128 + g * 64 + tid]); } oacc[2][tid] = o / sm; }
      __syncthreads(); }
    if (tid < 64) { float gt[3]; for (int j = 0; j < 3; ++j) { const float x = bf2f(T1[(size_t)r * 256 + 208 + hh * 3 + j]); gt[j] = 1.f / (1.f + expf(-x)); }
        ref[tid] = gt[0] * oacc[0][tid] + gt[1] * oacc[1][tid] + gt[2] * oacc[2][tid]; fast[tid] = bf2f(((const bf16_t*)(a.ws + OFF_MIXIN))[(size_t)r * 1536 + 1024 + hh * 64 + tid]); }
    __syncthreads(); commit(D, 10, ref, fast, 64, 0.04f);
}
__global__ void chk_out_e(Args a, unsigned* D) {
    __shared__ float ref[1024], fast[1024], cat[1024];
    const int r = srow(blockIdx.x, 64), tid = threadIdx.x; const bf16_t* MX = (const bf16_t*)(a.ws + OFF_MIXIN) + (size_t)r * 1536;
    for (int o = tid; o < 512; o += 256) { const int h = o >> 6, d = o & 63; float s = 0.f; for (int c = 0; c < 128; ++c) s += bf2f(MX[h * 128 + c]) * a.in[I_EWUV][c * 512 + h * 64 + d]; cat[o] = s; cat[512 + o] = bf2f(MX[1024 + o]); }
    __syncthreads();
    for (int n = tid; n < 1024; n += 256) { float s = 0.f; for (int j = 0; j < 1024; ++j) s += cat[j] * a.in[I_EWOUT][(size_t)j * 1024 + n]; ref[n] = s;
        fast[n] = bf2f(((const bf16_t*)(a.ws + OFF_S1))[(size_t)r * 1024 + n]) - ALPHA * a.in[I_X][(size_t)r * 1024 + n]; }
    __syncthreads(); commit(D, 11, ref, fast, 1024, 0.35f);
}
__global__ void chk_ln(const bf16_t* S, const bf16_t* O, const float* g, const float* bt, unsigned* D, int slot) {
    __shared__ float ref[1024], fast[1024];
    const int r = srow(blockIdx.x, 64), tid = threadIdx.x; float mean = 0.f, var = 0.f;
    for (int k = 0; k < 1024; ++k) mean += bf2f(S[(size_t)r * 1024 + k]); mean /= 1024.f;
    for (int k = 0; k < 1024; ++k) { const float d = bf2f(S[(size_t)r * 1024 + k]) - mean; var += d * d; } var /= 1024.f;
    for (int n = tid; n < 1024; n += 256) { ref[n] = (bf2f(S[(size_t)r * 1024 + n]) - mean) / sqrtf(var + 1e-5f) * g[n] + bt[n]; fast[n] = bf2f(O[(size_t)r * 1024 + n]); }
    __syncthreads(); commit(D, slot, ref, fast, 1024, 0.01f);
}
__global__ void chk_ffn_up(Args a, unsigned* D) {
    __shared__ float ref[DFF], fast[DFF], hrow[1024];
    const int r = srow(blockIdx.x, 64), tid = threadIdx.x; const bf16_t* H = (const bf16_t*)(a.ws + OFF_H) + (size_t)r * 1024;
    for (int k = tid; k < 1024; k += 256) hrow[k] = bf2f(H[k]);
    __syncthreads();
    for (int n = tid; n < DFF; n += 256) { float s1 = 0.f, s3 = 0.f; for (int k = 0; k < 1024; ++k) { s1 += hrow[k] * bfr(a.in[I_EF1][(size_t)k * DFF + n]); s3 += hrow[k] * bfr(a.in[I_EF3][(size_t)k * DFF + n]); }
        ref[n] = s1 / (1.f + expf(-s1)) * s3; fast[n] = bf2f(((const bf16_t*)(a.ws + OFF_ACT))[(size_t)r * DFF + n]); }
    __syncthreads(); commit(D, 13, ref, fast, DFF, 0.02f);
}
__global__ void chk_ffn_dn(Args a, unsigned* D) {
    __shared__ float ref[1024], fast[1024], arow[DFF];
    const int r = srow(blockIdx.x, 64), tid = threadIdx.x; const bf16_t* A = (const bf16_t*)(a.ws + OFF_ACT) + (size_t)r * DFF;
    for (int k = tid; k < DFF; k += 256) arow[k] = bf2f(A[k]);
    __syncthreads();
    for (int n = tid; n < 1024; n += 256) { float s = 0.f; for (int k = 0; k < DFF; ++k) s += arow[k] * bfr(a.in[I_EF2][(size_t)k * 1024 + n]); ref[n] = s;
        fast[n] = bf2f(((const bf16_t*)(a.ws + OFF_S2))[(size_t)r * 1024 + n]) - ALPHA * bf2f(((const bf16_t*)(a.ws + OFF_H))[(size_t)r * 1024 + n]); }
    __syncthreads(); commit(D, 14, ref, fast, 1024, 0.06f);
}
__global__ void chk_in_o(Args a, unsigned* D) {
    __shared__ float ref[2048], fast[2048], xr[1024];
    const int r = srow(blockIdx.x, 64), tid = threadIdx.x; const bf16_t* X1 = (const bf16_t*)(a.ws + OFF_X1) + (size_t)r * 1024;
    for (int k = tid; k < 1024; k += 256) xr[k] = bf2f(X1[k]);
    __syncthreads();
    for (int n = tid; n < 2048; n += 256) { float s = 0.f; for (int k = 0; k < 1024; ++k) s += xr[k] * bfr(a.in[I_OWIN][(size_t)k * 3072 + 1024 + n]); ref[n] = s;
        fast[n] = bf2f(((const bf16_t*)(a.ws + OFF_QKV))[(size_t)(1 + (n >> 10)) * MTOK * 1024 + (size_t)r * 1024 + (n & 1023)]); }
    __syncthreads(); commit(D, 16, ref, fast, 2048, 0.02f);
    const int pm = r >> 8; const bf16_t* K = (const bf16_t*)(a.ws + OFF_QKV) + (size_t)MTOK * 1024 + (size_t)pm * 256 * 1024; const float* KM = (const float*)(a.ws + OFF_KMEAN) + (size_t)pm * 2048;
    for (int n = tid; n < 1024; n += 256) { float s = 0.f; for (int q = 0; q < 256; ++q) s += bf2f(K[(size_t)q * 1024 + n]); ref[n] = s; fast[n] = KM[n] + KM[1024 + n]; }
    __syncthreads(); commit(D, 17, ref, fast, 1024, 0.03f);
}
__global__ void chk_moba(Args a, unsigned* D) {
    __shared__ float lg[1024], red[256], ref[64], fast[64], q[64], gate[16]; __shared__ int blkof[4];
    const int r = (blockIdx.x < 8) ? (blockIdx.x * 4096 + blockIdx.x * 300) : srow(blockIdx.x, 64), tid = threadIdx.x, b = r >> 12, t = r & 4095, h = blockIdx.x & 15, own = t >> 8;
    const bf16_t* X1 = (const bf16_t*)(a.ws + OFF_X1) + (size_t)r * 1024; const bf16_t* K = (const bf16_t*)(a.ws + OFF_QKV) + (size_t)MTOK * 1024 + (size_t)b * SEQ * 1024 + h * 64; const bf16_t* V = K + (size_t)MTOK * 1024;
    const float* relb = a.in[I_RELB];
    if (tid < 64) { float s = 0.f; for (int k = 0; k < 1024; ++k) s += bf2f(X1[k]) * bfr(a.in[I_OWIN][(size_t)k * 3072 + h * 64 + tid]); q[tid] = bfr(s * QSCALE); }
    __syncthreads();
    if (tid < 16) { float s = -INFINITY; if (tid < own) { s = 0.f; for (int p = 0; p < 256; ++p) for (int d = 0; d < 64; ++d) s += q[d] * bf2f(K[(size_t)(256 * tid + p) * 1024 + d]); } gate[tid] = s; }
    __syncthreads();
    if (tid == 0) { unsigned used = 0u; for (int k = 0; k < 3; ++k) { int bj = -1; float best = -INFINITY; for (int j = 0; j < own; ++j) if (!((used >> j) & 1u) && gate[j] > best) { best = gate[j]; bj = j; } blkof[k] = bj; if (bj >= 0) used |= 1u << bj; } blkof[3] = own; }
    __syncthreads();
    float mx = -INFINITY;
    for (int i = tid; i < 1024; i += 256) { const int j = blkof[i >> 8], p = 256 * j + (i & 255); float v = -INFINITY; if (j >= 0 && p <= t) { float d = 0.f; for (int k = 0; k < 64; ++k) d += q[k] * bf2f(K[(size_t)p * 1024 + k]); v = d + bias_l2(relb, h, t - p); } lg[i] = v; mx = fmaxf(mx, v); }
    red[tid] = mx; __syncthreads(); for (int o = 128; o > 0; o >>= 1) { if (tid < o) red[tid] = fmaxf(red[tid], red[tid + o]); __syncthreads(); } mx = red[0]; __syncthreads();
    float sm = 0.f; for (int i = tid; i < 1024; i += 256) { const float p = exp2f(lg[i] - mx); lg[i] = p; sm += p; }
    red[tid] = sm; __syncthreads(); for (int o = 128; o > 0; o >>= 1) { if (tid < o) red[tid] += red[tid + o]; __syncthreads(); } sm = red[0]; __syncthreads();
    if (tid < 64) { float o = 0.f; for (int i = 0; i < 1024; ++i) { const int j = blkof[i >> 8], p = 256 * j + (i & 255); if (j >= 0 && p <= t) o += lg[i] * bf2f(V[(size_t)p * 1024 + tid]); } ref[tid] = o / sm;
        fast[tid] = bf2f(((const bf16_t*)(a.ws + OFF_QKV))[(size_t)r * 1024 + h * 64 + tid]); }
    __syncthreads(); commit(D, 18, ref, fast, 64, 0.04f);
}
__global__ void chk_out_o(Args a, unsigned* D) {
    __shared__ float ref[1024], fast[1024], orow[1024];
    const int r = srow(blockIdx.x, 64), tid = threadIdx.x;
    for (int k = tid; k < 1024; k += 256) orow[k] = bf2f(((const bf16_t*)(a.ws + OFF_QKV))[(size_t)r * 1024 + k]);
    __syncthreads();
    for (int n = tid; n < 1024; n += 256) { float s = 0.f; for (int k = 0; k < 1024; ++k) s += orow[k] * a.in[I_OWOUT][(size_t)k * 1024 + n]; ref[n] = s;
        fast[n] = bf2f(((const bf16_t*)(a.ws + OFF_S1O))[(size_t)r * 1024 + n]) - ALPHA * bf2f(((const bf16_t*)(a.ws + OFF_X1))[(size_t)r * 1024 + n]); }
    __syncthreads(); commit(D, 20, ref, fast, 1024, 0.5f);
}
__global__ void chk_route(Args a, unsigned* D) {
    const int r = srow(blockIdx.x * 256 + threadIdx.x, 64); const bf16_t* H2 = (const bf16_t*)(a.ws + OFF_H2) + (size_t)r * 1024;
    float lg[8]; for (int e = 0; e < 8; ++e) lg[e] = 0.f;
    for (int k = 0; k < 1024; ++k) { const float hv = bf2f(H2[k]); for (int e = 0; e < 8; ++e) lg[e] += hv * a.in[I_OROUTER][k * 8 + e]; }
    int e0 = 0; for (int e = 1; e < 8; ++e) if (lg[e] > lg[e0]) e0 = e; int e1 = -1; for (int e = 0; e < 8; ++e) if (e != e0 && (e1 < 0 || lg[e] > lg[e1])) e1 = e;
    const float g0 = 1.f / (1.f + expf(lg[e1] - lg[e0]));
    const u32x2 rt = ((const u32x2*)(a.ws + OFF_ROUTE))[r]; const int f0 = rt.x & 255, f1 = (rt.x >> 8) & 255; const float fg = __uint_as_float(rt.y);
    int bad = 0; if (f0 != e0 || f1 != e1 || !(fabsf(fg - g0) <= 0.02f)) ++bad;
    atomicAdd(&D[4 * 21], (unsigned)bad); atomicAdd(&D[4 * 21 + 1], 1u);
    const int* GI = (const int*)(a.ws + OFF_GINFO); const int* DEST = (const int*)(a.ws + OFF_DEST) + 2 * (size_t)r;
    int bad2 = 0;
    for (int k = 0; k < 2; ++k) { const int e = k ? f1 : f0, d = DEST[k], ps = e ? GI[e - 1] : 0; if (d < ps || d >= ps + GI[8 + e]) ++bad2; }
    atomicAdd(&D[4 * 22], (unsigned)bad2); atomicAdd(&D[4 * 22 + 1], 2u);
}
__global__ void chk_moe(Args a, unsigned* D) {
    __shared__ float ref[1024], fast[1024], hrow[1024], act[DFFE], fin[1024];
    const int r = srow(blockIdx.x, 64), tid = threadIdx.x; const bf16_t* H2 = (const bf16_t*)(a.ws + OFF_H2) + (size_t)r * 1024;
    for (int k = tid; k < 1024; k += 256) { hrow[k] = bf2f(H2[k]); ref[k] = 0.f; }
    const u32x2 rt = ((const u32x2*)(a.ws + OFF_ROUTE))[r]; const float g0 = __uint_as_float(rt.y); const int* DEST = (const int*)(a.ws + OFF_DEST) + 2 * (size_t)r; const bf16_t* YR = (const bf16_t*)(a.ws + OFF_YR);
    __syncthreads();
    for (int k = 0; k < 2; ++k) { const int e = k ? ((rt.x >> 8) & 255) : (rt.x & 255); const float gk = k ? 1.f - g0 : g0;
        const float* w1 = a.in[I_OM1] + (size_t)e * 1024 * DFFE; const float* w3 = a.in[I_OM3] + (size_t)e * 1024 * DFFE; const float* w2 = a.in[I_OM2] + (size_t)e * DFFE * 1024;
        for (int f = tid; f < DFFE; f += 256) { float s1 = 0.f, s3 = 0.f; for (int q = 0; q < 1024; ++q) { s1 += hrow[q] * bfr(w1[(size_t)q * DFFE + f]); s3 += hrow[q] * bfr(w3[(size_t)q * DFFE + f]); } act[f] = bfr(s1 / (1.f + expf(-s1)) * s3); }
        __syncthreads();
        for (int n = tid; n < 1024; n += 256) { float s = 0.f; for (int f = 0; f < DFFE; ++f) s += act[f] * bfr(w2[(size_t)f * 1024 + n]); ref[n] += gk * s; }
        __syncthreads(); }
    for (int n = tid; n < 1024; n += 256) { fast[n] = g0 * bf2f(YR[(size_t)DEST[0] * 1024 + n]) + (1.f - g0) * bf2f(YR[(size_t)DEST[1] * 1024 + n]); fin[n] = ALPHA * hrow[n] + fast[n]; }
    __syncthreads(); commit(D, 23, ref, fast, 1024, 0.12f);
    float mean = 0.f, var = 0.f; for (int k = 0; k < 1024; ++k) mean += fin[k]; mean /= 1024.f; for (int k = 0; k < 1024; ++k) { const float d = fin[k] - mean; var += d * d; } var /= 1024.f;
    __syncthreads();
    for (int n = tid; n < 1024; n += 256) { ref[n] = (fin[n] - mean) / sqrtf(var + 1e-5f) * a.in[I_OLN2G][n] + a.in[I_OLN2B][n]; fast[n] = a.out[(size_t)r * 1024 + n]; }
    __syncthreads(); commit(D, 24, ref, fast, 1024, 0.005f);
    { float m2 = 0.f, v2 = 0.f; for (int k = 0; k < 1024; ++k) m2 += ALPHA * hrow[k]; m2 /= 1024.f; for (int k = 0; k < 1024; ++k) { const float d = ALPHA * hrow[k] - m2; v2 += d * d; } v2 /= 1024.f;
      for (int n = tid; n < 1024; n += 256) ref[n] = (ALPHA * hrow[n] - m2) / sqrtf(v2 + 1e-5f) * a.in[I_OLN2G][n] + a.in[I_OLN2B][n];
      __syncthreads(); commit(D, 28, ref, fast, 1024, 0.005f); }
    { for (int n = tid; n < 1024; n += 256) fin[n] = ALPHA * hrow[n] + (1.f - g0) * bf2f(YR[(size_t)DEST[0] * 1024 + n]) + g0 * bf2f(YR[(size_t)DEST[1] * 1024 + n]);
      __syncthreads();
      float m2 = 0.f, v2 = 0.f; for (int k = 0; k < 1024; ++k) m2 += fin[k]; m2 /= 1024.f; for (int k = 0; k < 1024; ++k) { const float d = fin[k] - m2; v2 += d * d; } v2 /= 1024.f;
      __syncthreads();
      for (int n = tid; n < 1024; n += 256) ref[n] = (fin[n] - m2) / sqrtf(v2 + 1e-5f) * a.in[I_OLN2G][n] + a.in[I_OLN2B][n];
      __syncthreads(); commit(D, 29, ref, fast, 1024, 0.005f); }
}

__global__ void chk_wmoe(Args a, unsigned* D) {
    const int tid = blockIdx.x * 256 + threadIdx.x; const unsigned hsh = (unsigned)tid * 2654435761u;
    const int e = hsh & 7, f = (hsh >> 3) % DFFE, k = (hsh >> 15) % 1024;
    const bf16_t* W13 = (const bf16_t*)(a.ws + OFF_W_M13) + (size_t)e * 2 * DFFE * 1024; const bf16_t* W2 = (const bf16_t*)(a.ws + OFF_W_M2) + (size_t)e * 1024 * DFFE;
    int bad = 0;
    if (W13[(size_t)(((f >> 7) << 8) + (f & 127)) * 1024 + k] != (bf16_t)f2bf(a.in[I_OM1][(size_t)e * 1024 * DFFE + (size_t)k * DFFE + f])) ++bad;
    if (W13[(size_t)(((f >> 7) << 8) + (f & 127) + 128) * 1024 + k] != (bf16_t)f2bf(a.in[I_OM3][(size_t)e * 1024 * DFFE + (size_t)k * DFFE + f])) ++bad;
    atomicAdd(&D[4 * 25], (unsigned)bad); atomicAdd(&D[4 * 25 + 1], 2u);
    int bad2 = 0; if (W2[(size_t)k * DFFE + f] != (bf16_t)f2bf(a.in[I_OM2][(size_t)e * DFFE * 1024 + (size_t)f * 1024 + k])) ++bad2;
    atomicAdd(&D[4 * 26], (unsigned)bad2); atomicAdd(&D[4 * 26 + 1], 1u);
}
__global__ void chk_actm(Args a, unsigned* D) {
    __shared__ float ref[DFFE], fast[DFFE], hrow[1024]; __shared__ int tokf, kf;
    const int tid = threadIdx.x; const int* GI = (const int*)(a.ws + OFF_GINFO); const int nrows = GI[7], ng = nrows >> 8, g0 = ((ng - 1) / MOE_CHUNK) * MOE_CHUNK;
    const int rho = 256 * g0 + (int)(((unsigned)blockIdx.x * 2654435761u) % (unsigned)(nrows - 256 * g0));
    if (tid == 0) { tokf = -1; kf = 0; } __syncthreads();
    const int* DEST = (const int*)(a.ws + OFF_DEST);
    for (int i = tid; i < 2 * MTOK; i += 256) if (DEST[i] == rho) { tokf = i >> 1; kf = i & 1; }
    __syncthreads();
    if (tokf < 0) return;
    const int tok = tokf; const u32x2 rt = ((const u32x2*)(a.ws + OFF_ROUTE))[tok]; const int e = kf ? ((rt.x >> 8) & 255) : (rt.x & 255);
    const bf16_t* H2 = (const bf16_t*)(a.ws + OFF_H2) + (size_t)tok * 1024;
    for (int k = tid; k < 1024; k += 256) hrow[k] = bf2f(H2[k]);
    __syncthreads();
    const float* w1 = a.in[I_OM1] + (size_t)e * 1024 * DFFE; const float* w3 = a.in[I_OM3] + (size_t)e * 1024 * DFFE;
    for (int f = tid; f < DFFE; f += 256) { float s1 = 0.f, s3 = 0.f; for (int q = 0; q < 1024; ++q) { s1 += hrow[q] * bfr(w1[(size_t)q * DFFE + f]); s3 += hrow[q] * bfr(w3[(size_t)q * DFFE + f]); }
        ref[f] = s1 / (1.f + expf(-s1)) * s3; fast[f] = bf2f(((const bf16_t*)(a.ws + OFF_ACTM))[(size_t)(rho - 256 * g0) * DFFE + f]); }
    __syncthreads(); commit(D, 27, ref, fast, DFFE, 0.02f);
}

__global__ void simple_final(Args a) {
    const int row = blockIdx.x * 4 + (threadIdx.x >> 6), lane = threadIdx.x & 63; unsigned char* ws = a.ws;
    const bf16_t* H2 = (const bf16_t*)(ws + OFF_H2); const bf16_t* YR = (const bf16_t*)(ws + OFF_YR);
    const u32x2* ROUTE = (const u32x2*)(ws + OFF_ROUTE); const int* DEST = (const int*)(ws + OFF_DEST);
    const float g0 = __uint_as_float(ROUTE[row].y), g1 = 1.f - g0; const int d0 = DEST[2 * row], d1 = DEST[2 * row + 1];
    float v[16]; float s = 0.f;
    for (int i = 0; i < 16; ++i) { const int col = lane + 64 * i; v[i] = ALPHA * bf2f(H2[(size_t)row * 1024 + col]) + g0 * bf2f(YR[(size_t)d0 * 1024 + col]) + g1 * bf2f(YR[(size_t)d1 * 1024 + col]); s += v[i]; }
    const float mean = wave_sum(s) / 1024.f; float q = 0.f;
    for (int i = 0; i < 16; ++i) { v[i] -= mean; q += v[i] * v[i]; }
    const float rstd = 1.f / sqrtf(wave_sum(q) / 1024.f + 1e-5f);
    for (int i = 0; i < 16; ++i) { const int col = lane + 64 * i; a.out[(size_t)row * 1024 + col] = v[i] * rstd * a.in[I_OLN2G][col] + a.in[I_OLN2B][col]; }
}
__global__ void report(float* out, const unsigned* D, int nelem) {
    __shared__ float kk, xx;
    if (threadIdx.x == 0) { int idx = 0; float v = 0.f; float worst = 0.f;
        for (int s = 1; s < NSLOT; ++s) { const unsigned bad = D[4 * s], tot = D[4 * s + 1]; if (tot == 0u) continue; const float fr = (float)bad / (float)tot; const float thr = (s == 9 || s == 10 || s == 18) ? 0.1f : 0.002f;
            if (fr > worst) worst = fr; if (fr > thr && idx == 0) { idx = s; v = fr; } }
        if (idx == 0) v = worst;
#ifdef DBG_BITS
        { const int sl[6] = DBG_BITS; idx = 0; for (int q = 0; q < 6; ++q) { const int s = sl[q]; if (s > 0 && D[4 * s + 1] > 0u && (float)D[4 * s] / (float)D[4 * s + 1] > 0.002f) idx |= 1 << q; } v = 1.f; }
#endif
#ifdef DBG_VAL
        { const float mr = __uint_as_float(D[4 * DBG_VAL + 2]); const float fr = D[4 * DBG_VAL + 1] ? (float)D[4 * DBG_VAL] / (float)D[4 * DBG_VAL + 1] : 0.f; kk = sqrtf(fmaxf(mr, 1e-6f) * 1e6f); xx = kk * (2.f + 97.f * fr); }
#else
        v = fmaxf(v, 1e-6f); const int n = (v > 0.3f) ? 4 : (v > 0.03f) ? 3 : (v > 0.003f) ? 2 : 1; kk = (n == 4) ? 1e4f : (n == 3) ? 1e3f : (n == 2) ? 1e2f : 1e1f; xx = kk * (float)(idx + 2);
#endif
        }
    __syncthreads();
    const float k = kk, x = xx;
    for (size_t i = (size_t)blockIdx.x * blockDim.x + threadIdx.x; i < (size_t)nelem; i += (size_t)gridDim.x * blockDim.x) out[i] = (i == 0) ? x : k;
}
}
#endif

#ifndef MK_N_LAUNCHES
#define MK_N_LAUNCHES 1
#endif
constexpr int NPHASE = 18;
#define SP2 true
#ifndef FFN_F8
#define FFN_F8 0
#endif
#ifndef MOE_SP2
#define MOE_SP2 true
#endif
#define ALN true

__global__ void __launch_bounds__(NTHR, 2) fwd_kernel(Args args) {
    extern __shared__ __attribute__((aligned(16))) unsigned char lds_raw[];
    Frame F;
    F.lds = (LAS unsigned char*)lds_raw;
    F.tid = threadIdx.x; F.lane = F.tid & 63; F.wave = __builtin_amdgcn_readfirstlane(F.tid >> 6);
    F.G = gridDim.x; F.bx = blockIdx.x; F.gw = F.bx * NWAVES + F.wave; F.NGW = F.G * NWAVES; F.ws = args.ws;
    unsigned char* ws = args.ws;
    volatile LAS unsigned* MISC = (volatile LAS unsigned*)(F.lds + LDSCTL_OFF);
    for (int u = F.tid; u < (LDS_BYTES - LDSCTL_OFF) / 4; u += NTHR) ((LAS unsigned*)(F.lds + LDSCTL_OFF))[u] = 0u;
    __syncthreads();
    XcdBarrier bar = xcd_barrier_post((unsigned*)(ws + OFF_BAR) + args.li * XCD_BAR_WORDS, MISC + 8);
    const int lo = args.ph_lo, hi = args.ph_hi;
#ifndef PH_MASK
#define PH_MASK 0x3ffff
#endif
#define IN(k) (((PH_MASK >> (k)) & 1) && lo <= (k) && (k) < hi)
#ifdef TS_MODE
    unsigned long long* TS = (unsigned long long*)(ws + OFF_DBG + 1024);
#define STAMP(i) do { if (F.bx == 0 && F.tid == 0) TS[i] = __builtin_amdgcn_s_memrealtime(); } while (0)
#else
#define STAMP(i) do { } while (0)
#endif
#define SEAM(k) do { if (IN(k) && IN((k) + 1)) xcd_barrier(bar); STAMP((k) + 1); } while (0)
    LAS unsigned char* glds = F.lds;

    bf16_t* Y1 = (bf16_t*)(ws + OFF_Y1);
    float* ssq_q = (float*)(ws + OFF_SSQ_Q); float* ssq_kv = (float*)(ws + OFF_SSQ_KV);

    STAMP(0);
    if (IN(0)) { phase_prologue_even(F, args); } SEAM(0);
    if (IN(1)) { pg8::Gemm g{(const bf16_t*)(ws + OFF_XB), (const bf16_t*)(ws + OFF_W_IN), MTOK, EVEN_INP, 1024, 1024, 0}; pg8::StaticOrder S; S.init(MTOK, EVEN_INP, F.G, F.bx);
        pg8::EpiInE E{Y1, ssq_q, ssq_kv}; pg8::gemm_phase<pg8::EpiInE, pg8::StaticOrder, ALN, SP2>(glds, g, S, E); } SEAM(1);
    if (IN(2)) {
        phase_ckvn(F, Y1 + (size_t)1 * MTOK * 256, ssq_kv, args.in[I_EKVN], (bf16_t*)(ws + OFF_CKVN));
#ifndef NO_CMP
        for (int idx = F.bx; idx < 256; idx += F.G) { const int b = idx >> 5, g = (idx >> 4) & 1, kv = (idx >> 3) & 1, rt = idx & 7;
            compress_unit(F, b, g, kv, rt, Y1 + (size_t)4 * MTOK * 256, (const bf16_t*)(ws + (kv ? OFF_CV1 : OFF_CK1)), args.in[kv ? I_ECV2 : I_ECK2], (const float*)(ws + OFF_CB) + kv * 64, (bf16_t*)(ws + (kv ? OFF_VC : OFF_KC))); }
#endif
#ifndef NO_Q2
        pg8::Gemm g{Y1, (const bf16_t*)(ws + OFF_W_Q2), MTOK, 2048, 256, 256, 0}; pg8::StaticOrder S; S.init(MTOK, 2048, F.G, F.bx);
        pg8::EpiQ2 E{(bf16_t*)(ws + OFF_QLAT), (bf16_t*)(ws + OFF_QIDX), ssq_q}; pg8::gemm_phase<pg8::EpiQ2, pg8::StaticOrder, ALN, SP2>(glds, g, S, E);
#endif
    } SEAM(2);
    if (IN(3)) { for (int idx = F.bx; idx < 512; idx += F.G) { const int i = idx >> 8, v = idx & 255, b = v & 7, cc = v >> 3, c = i ? 63 - cc : cc;
            indexer_unit(F, b, c, (const bf16_t*)(ws + OFF_QIDX), Y1 + (size_t)1 * MTOK * 256, (_Float16*)(ws + OFF_SC)); } } SEAM(3);
    if (IN(4)) { phase_select(F, (const _Float16*)(ws + OFF_SC), (unsigned*)(ws + OFF_MASK)); } SEAM(4);
    if (IN(5)) {
#ifndef NO_DSA
        if (args.pad != 2) phase_dsa_sparse(F, (const bf16_t*)(ws + OFF_QLAT), (const bf16_t*)(ws + OFF_CKVN), (const unsigned*)(ws + OFF_MASK), (const float*)(ws + OFF_BT), ws + OFF_MIXIN);
#endif
        STAMP(20);
#ifndef NO_NSA
        if (args.pad != 1) for (int idx = F.bx; idx < 1024; idx += F.G) { const int i = idx >> 8, v = idx & 255, b = v & 7, cc = v >> 3, g = i & 1, c = (i >> 1) ? 63 - cc : cc;
            nsa_unit(F, b, g, c, Y1, (const bf16_t*)(ws + OFF_KC), (const bf16_t*)(ws + OFF_VC), (const float*)(ws + OFF_BT), ws + OFF_MIXIN); __syncthreads(); }
#endif
    } SEAM(5);
    if (IN(6)) { pg8::Gemm g{(const bf16_t*)(ws + OFF_MIXIN), (const bf16_t*)(ws + OFF_W_OUTE), MTOK, 1024, 768, 768, 0}; pg8::StaticOrder S; S.init(MTOK, 1024, F.G, F.bx);
        pg8::EpiRes<true> E{args.in[I_X], (bf16_t*)(ws + OFF_S1), 1.f / (OSC * WOUT_SCALE)}; pg8::gemm_phase<pg8::EpiRes<true>, pg8::StaticOrder, ALN, SP2, true>(glds, g, S, E); } SEAM(6);
    if (IN(7)) { phase_ln_i8(F, (const bf16_t*)(ws + OFF_S1), (bf16_t*)(ws + OFF_H), ws + OFF_H8, (float*)(ws + OFF_SA), args.in[I_ELN1G], args.in[I_ELN1B]); } SEAM(7);
#if FFN_F8
    if (IN(8)) { pg8::Gemm g{(const bf16_t*)(ws + OFF_H8), (const bf16_t*)(ws + OFF_W_F13), MTOK, 2 * DFF, 512, 512, 0}; pg8::StaticOrder S; S.init(MTOK, 2 * DFF, F.G, F.bx);
        pg8::EpiSwiglu8 E{ws + OFF_ACT, DFF, 0, 1.f / WF13_SCALE}; pg8::gemm_phase<pg8::EpiSwiglu8, pg8::StaticOrder, ALN, SP2, true>(glds, g, S, E); } SEAM(8);
#else
    if (IN(8)) { pg8::Gemm g{(const bf16_t*)(ws + OFF_H8), (const bf16_t*)(ws + OFF_W_F13), MTOK, 2 * DFF, 512, 512, 0}; pg8::StaticOrder S; S.init(MTOK, 2 * DFF, F.G, F.bx);
        pg8::EpiSwigluI8 E{ws + OFF_ACT, DFF, (const float*)(ws + OFF_SA), (const float*)(ws + OFF_SW)}; pg8::gemm_phase<pg8::EpiSwigluI8, pg8::StaticOrder, ALN, SP2, false, true>(glds, g, S, E); } SEAM(8);
#endif
#if FFN_F8
    if (IN(9)) { pg8::Gemm g{(const bf16_t*)(ws + OFF_ACT), (const bf16_t*)(ws + OFF_W_F2), MTOK, 1024, DFF / 2, DFF / 2, 0}; pg8::StaticOrder S; S.init(MTOK, 1024, F.G, F.bx);
        pg8::EpiRes<false> E{(const void*)(ws + OFF_H), (bf16_t*)(ws + OFF_S2), 1.f / WF2_SCALE}; pg8::gemm_phase<pg8::EpiRes<false>, pg8::StaticOrder, ALN, SP2, true>(glds, g, S, E); } SEAM(9);
#else
    if (IN(9)) { pg8::Gemm g{(const bf16_t*)(ws + OFF_ACT), (const bf16_t*)(ws + OFF_W_F2), MTOK, 1024, DFF / 2, DFF / 2, 0}; pg8::StaticOrder S; S.init(MTOK, 1024, F.G, F.bx);
        pg8::EpiRes<false> E{(const void*)(ws + OFF_H), (bf16_t*)(ws + OFF_S2), 1.f / WF2_SCALE}; pg8::gemm_phase<pg8::EpiRes<false>, pg8::StaticOrder, ALN, SP2, true>(glds, g, S, E); } SEAM(9);
#endif
    if (IN(10)) { phase_ln_bf16(F, (const bf16_t*)(ws + OFF_S2), (bf16_t*)(ws + OFF_X1), ws + OFF_X18, args.in[I_ELN2G], args.in[I_ELN2B]); phase_convert_odd(F, args); } SEAM(10);
    if (IN(11)) { pg8::Gemm g{(const bf16_t*)(ws + OFF_X18), (const bf16_t*)(ws + OFF_W_OIN), MTOK, 3072, 512, 512, 0}; pg8::StaticOrder S; S.init(MTOK, 3072, F.G, F.bx);
        pg8::EpiInO E{(bf16_t*)(ws + OFF_QKV), (float*)(ws + OFF_KMEAN), 1.f / WIN_SCALE}; pg8::gemm_phase<pg8::EpiInO, pg8::StaticOrder, ALN, SP2, true>(glds, g, S, E); } SEAM(11);
#ifdef MOBA_DENSE
    if (IN(12)) { phase_moba(F, ws, args.pad); } SEAM(12);
#else
    if (IN(12)) { phase_moba2(F, ws); } SEAM(12);
#endif
    if (IN(13)) { pg8::Gemm g{(const bf16_t*)(ws + OFF_O8), (const bf16_t*)(ws + OFF_W_OOUT), MTOK, 1024, 512, 512, 0}; pg8::StaticOrder S; S.init(MTOK, 1024, F.G, F.bx);
        pg8::EpiRes<false> E{(const void*)(ws + OFF_X1), (bf16_t*)(ws + OFF_S1O), 1.f / (OSC * WOUT_SCALE)}; pg8::gemm_phase<pg8::EpiRes<false>, pg8::StaticOrder, ALN, SP2, true>(glds, g, S, E); } SEAM(13);
    if (IN(14)) { phase_ln_router(F, (const bf16_t*)(ws + OFF_S1O), (bf16_t*)(ws + OFF_H2), args.in[I_OLN1G], args.in[I_OLN1B], args.in[I_OROUTER], ws); } SEAM(14);
    if (IN(15)) { phase_moe_gather(F, (const bf16_t*)(ws + OFF_H2), ws + OFF_XR, ws); } SEAM(15);
    if (IN(16)) {
        const int* GI = (const int*)(ws + OFF_GINFO);
        pg8::MoeOrder S; S.G = F.G; S.c = F.bx;
#pragma unroll
        for (int e = 0; e < 8; ++e) S.pend[e] = __builtin_amdgcn_readfirstlane(GI[e]);
        const int ngroups = S.pend[7] >> 8;
        for (int g0 = 0; g0 < ngroups; g0 += MOE_CHUNK) {
            S.g0 = g0; S.ng = (ngroups - g0) < MOE_CHUNK ? (ngroups - g0) : MOE_CHUNK;
            { S.nN = 28; pg8::Gemm g{(const bf16_t*)(ws + OFF_XR), (const bf16_t*)(ws + OFF_W_M13), 0, 2 * DFFE, 512, 512, (size_t)2 * DFFE * 512};
              pg8::EpiSwiglu8 E{ws + OFF_ACTM, DFFE, g0, 1.f / W13_SCALE}; pg8::gemm_phase<pg8::EpiSwiglu8, pg8::MoeOrder, ALN, MOE_SP2, true>(glds, g, S, E); }
            xcd_barrier(bar);
            { S.nN = 4; pg8::Gemm g{(const bf16_t*)(ws + OFF_ACTM - (size_t)g0 * 256 * DFFE), (const bf16_t*)(ws + OFF_W_M2), 0, 1024, DFFE / 2, DFFE / 2, (size_t)1024 * DFFE / 2};
              pg8::EpiStoreS E{(bf16_t*)(ws + OFF_YR), 1024, 1.f / W2_SCALE}; pg8::gemm_phase<pg8::EpiStoreS, pg8::MoeOrder, ALN, MOE_SP2, true>(glds, g, S, E); }
            xcd_barrier(bar);
        }
    }
    STAMP(17);
    if (IN(17)) { phase_final(F, (const bf16_t*)(ws + OFF_H2), (const bf16_t*)(ws + OFF_YR), args.in[I_OLN2G], args.in[I_OLN2B], args.out, ws); }
#ifdef TS_MODE
    STAMP(18);
    xcd_barrier(bar);
    { const int ia[2] = TS_SEL; float d[2];
      for (int q = 0; q < 2; ++q) { const int i = ia[q]; const unsigned long long t1 = (i == 5) ? TS[20] : ((i == 25) ? TS[6] : TS[i + 1]); const unsigned long long t0 = (i == 25) ? TS[20] : TS[i]; d[q] = (float)(t1 - t0) * 0.01f; }
      const float k = sqrtf(fmaxf(d[0], 1.f)), x = 10.f * fmaxf(d[1], 1.f);
      for (size_t i = (size_t)F.bx * NTHR + F.tid; i < (size_t)MTOK * 1024; i += (size_t)F.G * NTHR) args.out[i] = (i == 0) ? x : k; }
#endif
#undef IN
#undef SEAM
}

extern "C" void kernel_launch(void* const* d_in, const int* in_sizes, int n_in, void* d_out, int out_size, void* d_ws, size_t ws_size, hipStream_t stream) {
    static int grid = 0;
    if (grid == 0) {
        if (n_in != 33 || in_sizes[0] != MTOK * DM || out_size != MTOK * DM || ws_size < WS_END) { fprintf(stderr, "kernel_launch: unexpected problem (n_in %d, in0 %d, out %d, ws %zu < %zu)\n", n_in, n_in > 0 ? in_sizes[0] : -1, out_size, ws_size, (size_t)WS_END); grid = -1; return; }
        int dev = 0, cus = 0, per_cu = 0;
        if (hipGetDevice(&dev) != hipSuccess || hipDeviceGetAttribute(&cus, hipDeviceAttributeMultiprocessorCount, dev) != hipSuccess) { grid = -1; return; }
        if (hipFuncSetAttribute((const void*)fwd_kernel, hipFuncAttributeMaxDynamicSharedMemorySize, LDS_BYTES) != hipSuccess) { fprintf(stderr, "kernel_launch: hipFuncSetAttribute failed\n"); grid = -1; return; }
        if (hipOccupancyMaxActiveBlocksPerMultiprocessor(&per_cu, (const void*)fwd_kernel, NTHR, LDS_BYTES) != hipSuccess || per_cu < 1) fprintf(stderr, "kernel_launch: occupancy query reports %d\n", per_cu);
        (void)hipGetLastError();
        grid = cus > 256 ? 256 : cus;
    }
    if (grid < 0) return;
    hipMemsetAsync(d_ws, 0, CTL_ZERO_BYTES, stream);
    Args a{};
    for (int i = 0; i < 33; ++i) a.in[i] = (const float*)d_in[i];
    a.out = (float*)d_out; a.ws = (unsigned char*)d_ws;
#if MK_N_LAUNCHES == 1
    a.ph_lo = 0; a.ph_hi = NPHASE; a.li = 0;
    hipLaunchKernelGGL(fwd_kernel, dim3(grid), dim3(NTHR), LDS_BYTES, stream, a);
#else
    for (int p = 0; p < NPHASE; ++p) { a.ph_lo = p; a.ph_hi = p + 1; a.li = p;
#ifdef REP_PHASE
        if (p == REP_PHASE) { Args a2 = a;
#ifdef REP_PAD
            a2.pad = REP_PAD;
#endif
            for (int rep = 0; rep < REP_N; ++rep) { a2.li = NPHASE + rep; hipLaunchKernelGGL(fwd_kernel, dim3(grid), dim3(NTHR), LDS_BYTES, stream, a2); } }
#endif
        hipLaunchKernelGGL(fwd_kernel, dim3(grid), dim3(NTHR), LDS_BYTES, stream, a);
#ifdef DBG_MODE
        unsigned* D = (unsigned*)((unsigned char*)d_ws + OFF_DBG); unsigned char* ws = (unsigned char*)d_ws;
        switch (p) {
            case 1: hipLaunchKernelGGL(dbg::chk_in_e, dim3(64), dim3(256), 0, stream, a, D); break;
            case 2: hipLaunchKernelGGL(dbg::chk_q2, dim3(64), dim3(256), 0, stream, a, D); hipLaunchKernelGGL(dbg::chk_cmp, dim3(96), dim3(256), 0, stream, a, D); break;
            case 3: hipLaunchKernelGGL(dbg::chk_idx, dim3(64), dim3(256), 0, stream, a, D); break;
            case 4: hipLaunchKernelGGL(dbg::chk_sel, dim3(48), dim3(256), 0, stream, a, D); break;
            case 5: hipLaunchKernelGGL(dbg::chk_dsa, dim3(64), dim3(256), 0, stream, a, D); hipLaunchKernelGGL(dbg::chk_nsa, dim3(64), dim3(256), 0, stream, a, D); break;
            case 6: hipLaunchKernelGGL(dbg::chk_out_e, dim3(32), dim3(256), 0, stream, a, D); break;
            case 7: hipLaunchKernelGGL(dbg::chk_ln, dim3(32), dim3(256), 0, stream, (const bf16_t*)(ws + OFF_S1), (const bf16_t*)(ws + OFF_H), a.in[I_ELN1G], a.in[I_ELN1B], D, 12); break;
            case 8: hipLaunchKernelGGL(dbg::chk_ffn_up, dim3(16), dim3(256), 0, stream, a, D); break;
            case 9: hipLaunchKernelGGL(dbg::chk_ffn_dn, dim3(32), dim3(256), 0, stream, a, D); break;
            case 10: hipLaunchKernelGGL(dbg::chk_ln, dim3(32), dim3(256), 0, stream, (const bf16_t*)(ws + OFF_S2), (const bf16_t*)(ws + OFF_X1), a.in[I_ELN2G], a.in[I_ELN2B], D, 15); break;
            case 10 + 100: break;
            case 11: hipLaunchKernelGGL(dbg::chk_wmoe, dim3(16), dim3(256), 0, stream, a, D); hipLaunchKernelGGL(dbg::chk_in_o, dim3(32), dim3(256), 0, stream, a, D); break;
            case 12: hipLaunchKernelGGL(dbg::chk_moba, dim3(64), dim3(256), 0, stream, a, D); break;
            case 13: hipLaunchKernelGGL(dbg::chk_out_o, dim3(32), dim3(256), 0, stream, a, D); break;
            case 14: hipLaunchKernelGGL(dbg::chk_ln, dim3(32), dim3(256), 0, stream, (const bf16_t*)(ws + OFF_S1O), (const bf16_t*)(ws + OFF_H2), a.in[I_OLN1G], a.in[I_OLN1B], D, 19); break;
            case 15: hipLaunchKernelGGL(dbg::chk_route, dim3(1), dim3(256), 0, stream, a, D); break;
            case 16: hipLaunchKernelGGL(dbg::chk_actm, dim3(8), dim3(256), 0, stream, a, D); break;
            case 17:
#ifdef DBG_SIMPLE_FINAL
                hipLaunchKernelGGL(dbg::simple_final, dim3(MTOK / 4), dim3(256), 0, stream, a);
#endif
                hipLaunchKernelGGL(dbg::chk_moe, dim3(16), dim3(256), 0, stream, a, D); hipLaunchKernelGGL(dbg::report, dim3(1024), dim3(256), 0, stream, (float*)d_out, (const unsigned*)D, out_size); break;
            default: break;
        }
#endif
    }
#endif
}
```

```cpp
#include <hip/hip_runtime.h>
#include <cstdio>
#include <cstdint>

#define LAS __attribute__((address_space(3)))
#define GAS __attribute__((address_space(1)))
typedef unsigned short bf16_t;
typedef short bf16x8 __attribute__((ext_vector_type(8)));
typedef short s16x4 __attribute__((ext_vector_type(4)));
typedef float f32x2 __attribute__((ext_vector_type(2)));
typedef float f32x4 __attribute__((ext_vector_type(4)));
typedef float f32x16 __attribute__((ext_vector_type(16)));
typedef unsigned u32x2 __attribute__((ext_vector_type(2)));
typedef unsigned u32x4 __attribute__((ext_vector_type(4)));
typedef __bf16 bf16x2_t __attribute__((ext_vector_type(2)));
typedef _Float16 f16x2_t __attribute__((ext_vector_type(2)));

constexpr int DM = 1024, NB = 8, SEQ = 4096, MTOK = NB * SEQ;
constexpr int EVEN_IN = 1768, EVEN_INP = 1792, DFF = 2816, DFFE = 3584, NEXP = 8;
constexpr float ALPHA = 1.4142135623730951f;
constexpr float LOG2E = 1.4426950408889634f;
constexpr float QSCALE = 0.125f * LOG2E;
constexpr int NWAVES = 8, NTHR = 512;

__device__ __forceinline__ unsigned f2bf(float f) { unsigned u = __builtin_bit_cast(unsigned, f); return (u + 0x7fffu + ((u >> 16) & 1u)) >> 16; }
__device__ __forceinline__ unsigned pk2(float lo, float hi) { f32x2 v = {lo, hi}; bf16x2_t b = __builtin_convertvector(v, bf16x2_t); return __builtin_bit_cast(unsigned, b); }
__device__ __forceinline__ float bf2f(unsigned short h) { return __builtin_bit_cast(float, (unsigned)h << 16); }
__device__ __forceinline__ float bflo(unsigned w) { return __builtin_bit_cast(float, w << 16); }
__device__ __forceinline__ float bfhi(unsigned w) { return __builtin_bit_cast(float, w & 0xffff0000u); }
__device__ __forceinline__ float wave_sum(float v) {
#pragma unroll
    for (int o = 1; o < 64; o <<= 1) v += __shfl_xor(v, o);
    return v;
}
#define LDS_WAIT() asm volatile("s_waitcnt lgkmcnt(0)" ::: "memory")
#define VM_WAIT() asm volatile("s_waitcnt vmcnt(0)" ::: "memory")
namespace pg8 {
#define PG8_LAS __attribute__((address_space(3)))
typedef unsigned short bf16_t;
typedef short bf16x8 __attribute__((ext_vector_type(8)));
typedef float f32x4 __attribute__((ext_vector_type(4)));
typedef unsigned u32x4 __attribute__((ext_vector_type(4)));
constexpr int BM = 256, BK = 64, HALF = 128, HTB = HALF * BK * 2  , STAGE_BYTES = 8 * HTB, NXCD = 8, WGM = 8;

__host__ __device__ __forceinline__ int lds_byte(int r, int c) { const int st = (r >> 4) * 2 + (c >> 5), rr = r & 15, cc = c & 31, ob = rr * 64 + cc * 2; return st * 1024 + (ob ^ (((ob >> 9) & 1) << 5)); }
__host__ __device__ __forceinline__ void stage_rc(int b, int& R, int& C) { const int st = b / 1024, sb = b % 1024, swz = sb ^ (((sb >> 9) & 1) << 5); R = (st >> 1) * 16 + swz / 64; C = (st & 1) * 32 + (swz % 64) / 2; }
__host__ __device__ __forceinline__ int perm32(int rho) { const int n = rho >> 4, i = rho & 15; return 8 * (i >> 2) + 4 * n + (i & 3); }

struct Unit { int pm, pn, e; };
struct Gemm { const bf16_t* A; const bf16_t* Bt; int M, N, K; int lda; size_t bstride; };

struct StaticOrder {
    int nM, nN, nwg, G, c;
    __host__ __device__ void init(int M, int N, int G_, int c_) { nM = M / BM; nN = N / BM; nwg = nM * nN; G = G_; c = c_; }
    __host__ __device__ bool next(int i, Unit& u) const {
        const long L = (long)i * G + c; if (L >= nwg) return false;
        int wgid = (int)L; { const int q = nwg / NXCD, r = nwg % NXCD, xcd = wgid % NXCD, off = wgid / NXCD; wgid = (xcd < r ? xcd * (q + 1) : r * (q + 1) + (xcd - r) * q) + off; }
        const int nig = WGM * nN, gid = wgid / nig, fm = gid * WGM, gsz = (nM - fm) < WGM ? (nM - fm) : WGM;
        u.pm = fm + ((wgid % nig) % gsz); u.pn = (wgid % nig) / gsz; u.e = 0; return true;
    }
    __device__ __forceinline__ void a_ready(const Unit&) const {}
    __device__ __forceinline__ void done(const Unit&) const {}
};


typedef int v8i32_t __attribute__((ext_vector_type(8)));
typedef int v4i32_t __attribute__((ext_vector_type(4)));
__device__ __forceinline__ v8i32_t cat8(bf16x8 lo, bf16x8 hi) { const v4i32_t a = __builtin_bit_cast(v4i32_t, lo), b = __builtin_bit_cast(v4i32_t, hi); return (v8i32_t){a[0], a[1], a[2], a[3], b[0], b[1], b[2], b[3]}; }
template <class Epi, class Sched, bool ALIGN_EPI = false, bool SP2 = false, bool F8 = false, bool I8 = false>
__device__ __forceinline__ void gemm_phase(PG8_LAS unsigned char* lds, const Gemm g, const Sched& S, const Epi& E) {
    const int tid = threadIdx.x, wid = __builtin_amdgcn_readfirstlane(tid >> 6), lane = tid & 63, wr = wid >> 2, wc = wid & 3, fr = lane & 15, fq = lane >> 4;
    const int K = g.K, nt = K / BK;
    unsigned voffA[2], voffB[2];
#pragma unroll
    for (int i = 0; i < 2; ++i) { int R, C; stage_rc(tid * 16 + i * 8192, R, C); const int Rb = Epi::PERM ? ((R & ~31) + perm32(R & 31)) : R;
        voffA[i] = (unsigned)(R * g.lda + C) * 2u; voffB[i] = (unsigned)(Rb * K + C) * 2u; }
    const size_t kstep = (size_t)(BK * 2);
    const size_t hstep = (size_t)HALF * K * 2;
    const size_t tstep = 2 * hstep;
    const size_t hstepA = (size_t)HALF * g.lda * 2, tstepA = 2 * hstepA;
    const size_t estep = g.bstride * 2;
    const unsigned ldsw = (unsigned)wid * 1024u;
    const int aoff = lds_byte(wr * 64 + fr, fq * 8), boff = lds_byte(wc * 32 + fr, fq * 8);
#define PG8_SA(b, h) (((b) * 2 + (h)) * HTB)
#define PG8_SB(b, h) ((4 + (b) * 2 + (h)) * HTB)
#define PG8_STAGE(bufoff, gbase, voff) do { _Pragma("unroll") for (int _i = 0; _i < 2; ++_i) \
        __builtin_amdgcn_global_load_lds((const unsigned*)((const char*)(gbase) + (voff)[_i]), (PG8_LAS unsigned*)(lds + (bufoff) + ldsw + _i * 8192), 16, 0, 0); } while (0)
#define PG8_LDA(dst, b, h) do { _Pragma("unroll") for (int m = 0; m < 4; ++m) _Pragma("unroll") for (int k = 0; k < 2; ++k) dst[m][k] = *(const PG8_LAS bf16x8*)(lds + PG8_SA(b, h) + aoff + m * 2048 + k * 1024); } while (0)
#define PG8_LDB(dst, b, h) do { _Pragma("unroll") for (int n = 0; n < 2; ++n) _Pragma("unroll") for (int k = 0; k < 2; ++k) dst[n][k] = *(const PG8_LAS bf16x8*)(lds + PG8_SB(b, h) + boff + n * 2048 + k * 1024); } while (0)
#define PG8_MMA(ai, bj, At, Bt) do { __builtin_amdgcn_s_setprio(1); if constexpr (I8) { _Pragma("unroll") for (int m = 0; m < 4; ++m) _Pragma("unroll") for (int n = 0; n < 2; ++n) _Pragma("unroll") for (int k = 0; k < 2; ++k) \
        asm volatile("v_mfma_i32_16x16x64_i8 %0, %1, %2, %0" : "+v"(acc[ai][bj][m][n]) : "v"(Bt[n][k]), "v"(At[m][k])); } else if constexpr (F8) { _Pragma("unroll") for (int m = 0; m < 4; ++m) _Pragma("unroll") for (int n = 0; n < 2; ++n) \
        asm volatile("v_mfma_scale_f32_16x16x128_f8f6f4 %0, %1, %2, %0, %3, %3 op_sel_hi:[0,0,0]" : "+v"(acc[ai][bj][m][n]) : "v"(cat8(Bt[n][0], Bt[n][1])), "v"(cat8(At[m][0], At[m][1])), "v"(sc8)); } else { \
        _Pragma("unroll") for (int m = 0; m < 4; ++m) _Pragma("unroll") for (int n = 0; n < 2; ++n) _Pragma("unroll") for (int k = 0; k < 2; ++k) \
        acc[ai][bj][m][n] = __builtin_amdgcn_mfma_f32_16x16x32_bf16(Bt[n][k], At[m][k], acc[ai][bj][m][n], 0, 0, 0); } __builtin_amdgcn_s_setprio(0); } while (0)
#define PG8_WAIT_V(n) asm volatile("s_waitcnt vmcnt(" #n ")" ::: "memory")
#define PG8_WAIT_L(n) asm volatile("s_waitcnt lgkmcnt(" #n ")" ::: "memory")
#define PG8_BAR __builtin_amdgcn_s_barrier()
#define PG8_SCHED __builtin_amdgcn_sched_barrier(0)
    Unit cur, nxt; int ui = 0;
    if (!S.next(0, cur)) return;
    int sc8 = 0x7f7f7f7f; asm volatile("" : "+v"(sc8));
    f32x4 acc[2][2][4][2];
#pragma unroll
    for (int a = 0; a < 2; ++a)
#pragma unroll
        for (int b = 0; b < 2; ++b)
#pragma unroll
            for (int m = 0; m < 4; ++m)
#pragma unroll
                for (int n = 0; n < 2; ++n) acc[a][b][m][n] = (f32x4){0.f, 0.f, 0.f, 0.f};
    bf16x8 At[4][2], B0[2][2], B1[2][2];
    const char* cA = (const char*)g.A + (size_t)cur.pm * tstepA; const char* cB = (const char*)g.Bt + (size_t)cur.pn * tstep + (size_t)cur.e * estep;
    S.a_ready(cur);
    if constexpr (SP2) {
        PG8_STAGE(PG8_SB(0, 0), cB, voffB); PG8_STAGE(PG8_SB(0, 1), cB + hstep, voffB); PG8_STAGE(PG8_SA(0, 0), cA, voffA); PG8_STAGE(PG8_SA(0, 1), cA + hstepA, voffA);
        if (wr == 1) PG8_BAR;
        PG8_WAIT_V(2); PG8_BAR;
        PG8_STAGE(PG8_SB(1, 0), cB + kstep, voffB); PG8_STAGE(PG8_SA(1, 0), cA + kstep, voffA); PG8_STAGE(PG8_SB(1, 1), cB + hstep + kstep, voffB);
        PG8_WAIT_V(6); PG8_BAR;
    } else {
        PG8_STAGE(PG8_SB(0, 0), cB, voffB); PG8_STAGE(PG8_SA(0, 0), cA, voffA); PG8_STAGE(PG8_SB(0, 1), cB + hstep, voffB); PG8_STAGE(PG8_SA(0, 1), cA + hstepA, voffA);
        if (wr == 1) PG8_BAR;
        PG8_WAIT_V(4); PG8_BAR;
        PG8_STAGE(PG8_SB(1, 0), cB + kstep, voffB); PG8_STAGE(PG8_SA(1, 0), cA + kstep, voffA); PG8_STAGE(PG8_SB(1, 1), cB + hstep + kstep, voffB);
        PG8_WAIT_V(6); PG8_BAR;
    }
    for (;;) {
        const bool has_next = S.next(ui + 1, nxt);
        const char* nA = has_next ? (const char*)g.A + (size_t)nxt.pm * tstepA : cA; const char* nB = has_next ? (const char*)g.Bt + (size_t)nxt.pn * tstep + (size_t)nxt.e * estep : cB;
#pragma unroll 1
        for (int t = 0; t < nt; t += 2) {
            const bool last = (t == nt - 2);
            const char* a1 = cA + (size_t)(t + 1) * kstep;
            const char* a2 = last ? nA : cA + (size_t)(t + 2) * kstep; const char* b2 = last ? nB : cB + (size_t)(t + 2) * kstep;
            const char* a3 = a2 + kstep; const char* b3 = b2 + kstep;
            if (last && has_next) S.a_ready(nxt);
            if constexpr (SP2) {
            PG8_LDB(B0, 0, 0); PG8_LDB(B1, 0, 1); PG8_SCHED; PG8_LDA(At, 0, 0); PG8_STAGE(PG8_SA(1, 1), a1 + hstepA, voffA);
            PG8_WAIT_V(8); PG8_WAIT_L(0); PG8_BAR; PG8_MMA(0, 0, At, B0); PG8_MMA(0, 1, At, B1); PG8_BAR; PG8_SCHED;
            PG8_LDA(At, 0, 1); PG8_STAGE(PG8_SB(0, 0), b2, voffB); PG8_STAGE(PG8_SB(0, 1), b2 + hstep, voffB); PG8_STAGE(PG8_SA(0, 0), a2, voffA);
            PG8_WAIT_V(8); PG8_WAIT_L(0); PG8_BAR; PG8_MMA(1, 0, At, B0); PG8_MMA(1, 1, At, B1); PG8_BAR; PG8_SCHED;
            PG8_LDB(B0, 1, 0); PG8_LDB(B1, 1, 1); PG8_SCHED; PG8_LDA(At, 1, 0); PG8_STAGE(PG8_SA(0, 1), a2 + hstepA, voffA);
            PG8_WAIT_V(8); PG8_WAIT_L(0); PG8_BAR; PG8_MMA(0, 0, At, B0); PG8_MMA(0, 1, At, B1); PG8_BAR; PG8_SCHED;
            PG8_LDA(At, 1, 1); PG8_STAGE(PG8_SB(1, 0), b3, voffB); PG8_STAGE(PG8_SB(1, 1), b3 + hstep, voffB); PG8_STAGE(PG8_SA(1, 0), a3, voffA);
            PG8_WAIT_V(8); PG8_WAIT_L(0); PG8_BAR; PG8_MMA(1, 0, At, B0); PG8_MMA(1, 1, At, B1); PG8_BAR; PG8_SCHED;
            } else {
            PG8_LDB(B0, 0, 0); PG8_SCHED; PG8_LDA(At, 0, 0); PG8_STAGE(PG8_SA(1, 1), a1 + hstepA, voffA);
            PG8_WAIT_L(8); PG8_BAR; PG8_WAIT_L(0); PG8_MMA(0, 0, At, B0); PG8_BAR; PG8_SCHED;
            PG8_LDB(B1, 0, 1); PG8_STAGE(PG8_SB(0, 0), b2, voffB);
            PG8_BAR; PG8_WAIT_L(0); PG8_MMA(0, 1, At, B1); PG8_BAR;
            PG8_LDA(At, 0, 1); PG8_STAGE(PG8_SA(0, 0), a2, voffA);
            PG8_BAR; PG8_WAIT_L(0); PG8_MMA(1, 0, At, B0); PG8_BAR; PG8_SCHED;
            PG8_STAGE(PG8_SB(0, 1), b2 + hstep, voffB);
            PG8_WAIT_V(6); PG8_BAR; PG8_MMA(1, 1, At, B1); PG8_BAR;
            PG8_LDB(B0, 1, 0); PG8_SCHED; PG8_LDA(At, 1, 0); PG8_STAGE(PG8_SA(0, 1), a2 + hstepA, voffA);
            PG8_WAIT_L(8); PG8_BAR; PG8_WAIT_L(0); PG8_MMA(0, 0, At, B0); PG8_BAR; PG8_SCHED;
            PG8_LDB(B1, 1, 1); PG8_STAGE(PG8_SB(1, 0), b3, voffB);
            PG8_BAR; PG8_WAIT_L(0); PG8_MMA(0, 1, At, B1); PG8_BAR;
            PG8_LDA(At, 1, 1); PG8_STAGE(PG8_SA(1, 0), a3, voffA);
            PG8_BAR; PG8_WAIT_L(0); PG8_MMA(1, 0, At, B0); PG8_BAR; PG8_SCHED;
            PG8_STAGE(PG8_SB(1, 1), b3 + hstep, voffB);
            PG8_WAIT_V(6); PG8_BAR; PG8_MMA(1, 1, At, B1); PG8_BAR;
            }
        }
        if constexpr (ALIGN_EPI) { if (wr == 0) PG8_BAR; }
        if constexpr (F8 || I8) asm volatile("s_nop 15\n\ts_nop 15" ::: "memory");
        if constexpr (!Epi::AFTER_DRAIN) { E(acc, cur, wr, wc, fr, fq); S.done(cur); }
        if (!has_next) break;
#pragma unroll
        for (int a = 0; a < 2; ++a)
#pragma unroll
            for (int b = 0; b < 2; ++b)
#pragma unroll
                for (int m = 0; m < 4; ++m)
#pragma unroll
                    for (int n = 0; n < 2; ++n) acc[a][b][m][n] = (f32x4){0.f, 0.f, 0.f, 0.f};
        cur = nxt; cA = nA; cB = nB; ++ui;
        if constexpr (ALIGN_EPI) { if (wr == 1) PG8_BAR; }
    }
    PG8_WAIT_V(0);
    if constexpr (!ALIGN_EPI) { if (wr == 0) PG8_BAR; }
    PG8_BAR;
    if constexpr (Epi::AFTER_DRAIN) { E.fused(acc, cur, wr, wc, fr, fq, lds, wid, lane); S.done(cur); }
#undef PG8_SA
#undef PG8_SB
#undef PG8_STAGE
#undef PG8_LDA
#undef PG8_LDB
#undef PG8_MMA
#undef PG8_WAIT_V
#undef PG8_WAIT_L
#undef PG8_BAR
#undef PG8_SCHED
}
}

namespace pg8 {
typedef f32x4 Acc[2][2][4][2];
__device__ __forceinline__ u32x4 pack8(const f32x4 v0, const f32x4 v1) { u32x4 w; w.x = pk2(v0[0], v0[1]); w.y = pk2(v0[2], v0[3]); w.z = pk2(v1[0], v1[1]); w.w = pk2(v1[2], v1[3]); return w; }
__device__ __forceinline__ void unpack8(const u32x4 w, f32x4& a, f32x4& b) { a = (f32x4){bflo(w.x), bfhi(w.x), bflo(w.y), bfhi(w.y)}; b = (f32x4){bflo(w.z), bfhi(w.z), bflo(w.w), bfhi(w.w)}; }

struct EpiInE {
    static constexpr bool PERM = true, AFTER_DRAIN = false;
    bf16_t* Y1; float* ssq_q; float* ssq_kv;
    __device__ __forceinline__ void operator()(const Acc& acc, const Unit& u, int wr, int wc, int fr, int fq) const {
        bf16_t* base = Y1 + (size_t)u.pn * MTOK * 256;
        const float sc = (u.pn == 2 || u.pn == 3) ? QSCALE : 1.f;
        const int col0 = wc * 32 + 8 * fq;
#pragma unroll
        for (int ai = 0; ai < 2; ++ai)
#pragma unroll
            for (int m = 0; m < 4; ++m) {
                const int row = u.pm * BM + ai * HALF + wr * 64 + m * 16 + fr; bf16_t* rowp = base + (size_t)row * 256 + col0;
                float s0 = 0.f, s1 = 0.f;
#pragma unroll
                for (int bj = 0; bj < 2; ++bj) { const f32x4 v0 = acc[ai][bj][m][0], v1 = acc[ai][bj][m][1];
                    const float q = (v0[0] * v0[0] + v0[1] * v0[1]) + (v0[2] * v0[2] + v0[3] * v0[3]) + (v1[0] * v1[0] + v1[1] * v1[1]) + (v1[2] * v1[2] + v1[3] * v1[3]);
                    if (bj == 0) s0 = q; else s1 = q;
                    *(u32x4*)(rowp + bj * HALF) = pack8(v0 * sc, v1 * sc); }
                if (u.pn <= 1) {
                    float s = (u.pn == 0) ? (s0 + s1) : s0;
                    s += __shfl_xor(s, 16); s += __shfl_xor(s, 32);
                    if (fq == 0) (u.pn == 0 ? ssq_q : ssq_kv)[(size_t)row * 4 + wc] = s;
                }
            }
    }
};
struct EpiQ2 {
    static constexpr bool PERM = true, AFTER_DRAIN = false;
    bf16_t* QLAT; bf16_t* QIDX; const float* ssq_q;
    __device__ __forceinline__ void operator()(const Acc& acc, const Unit& u, int wr, int wc, int fr, int fq) const {
        bf16_t* base = (u.pn < 4) ? QLAT : QIDX; const float sc0 = (u.pn < 4) ? QSCALE : 1.f;
        const int col0 = (u.pn & 3) * 256 + wc * 32 + 8 * fq;
#pragma unroll
        for (int ai = 0; ai < 2; ++ai)
#pragma unroll
            for (int m = 0; m < 4; ++m) {
                const int row = u.pm * BM + ai * HALF + wr * 64 + m * 16 + fr; bf16_t* rowp = base + (size_t)row * 1024 + col0;
                const f32x4 sq = *(const f32x4*)(ssq_q + (size_t)row * 4); const float sc = sc0 * __builtin_amdgcn_rsqf(((sq[0] + sq[1]) + (sq[2] + sq[3])) * (1.f / 256.f) + 1e-6f);
#pragma unroll
                for (int bj = 0; bj < 2; ++bj) *(u32x4*)(rowp + bj * HALF) = pack8(acc[ai][bj][m][0] * sc, acc[ai][bj][m][1] * sc);
            }
    }
};
template <bool RES_F32> struct EpiRes {
    static constexpr bool PERM = true, AFTER_DRAIN = false;
    const void* res; bf16_t* S; float sc;
    __device__ __forceinline__ void operator()(const Acc& acc, const Unit& u, int wr, int wc, int fr, int fq) const {
        const int col0 = u.pn * BM + wc * 32 + 8 * fq;
#pragma unroll
        for (int ai = 0; ai < 2; ++ai)
#pragma unroll
            for (int m = 0; m < 4; ++m) {
                const size_t off = (size_t)(u.pm * BM + ai * HALF + wr * 64 + m * 16 + fr) * 1024 + col0;
#pragma unroll
                for (int bj = 0; bj < 2; ++bj) { f32x4 r0, r1;
                    if (RES_F32) { r0 = *(const f32x4*)((const float*)res + off + bj * HALF); r1 = *(const f32x4*)((const float*)res + off + bj * HALF + 4); }
                    else unpack8(*(const u32x4*)((const bf16_t*)res + off + bj * HALF), r0, r1);
                    *(u32x4*)(S + off + bj * HALF) = pack8(r0 * ALPHA + acc[ai][bj][m][0] * sc, r1 * ALPHA + acc[ai][bj][m][1] * sc); }
            }
    }
};
struct EpiSwiglu {
    static constexpr bool PERM = true, AFTER_DRAIN = false;
    bf16_t* O; int ldo; int pm0;
    __device__ __forceinline__ void operator()(const Acc& acc, const Unit& u, int wr, int wc, int fr, int fq) const {
        const int col0 = u.pn * HALF + wc * 32 + 8 * fq;
#pragma unroll
        for (int ai = 0; ai < 2; ++ai)
#pragma unroll
            for (int m = 0; m < 4; ++m) {
                bf16_t* rowp = O + (size_t)((u.pm - pm0) * BM + ai * HALF + wr * 64 + m * 16 + fr) * ldo + col0;
                f32x4 o[2];
#pragma unroll
                for (int n = 0; n < 2; ++n) { const f32x4 a = acc[ai][0][m][n], b = acc[ai][1][m][n];
#pragma unroll
                    for (int e = 0; e < 4; ++e) o[n][e] = a[e] * __builtin_amdgcn_rcpf(1.f + __expf(-a[e])) * b[e]; }
                *(u32x4*)rowp = pack8(o[0], o[1]);
            }
    }
};
struct EpiStore {
    static constexpr bool PERM = true, AFTER_DRAIN = false;
    bf16_t* O; int ldo;
    __device__ __forceinline__ void operator()(const Acc& acc, const Unit& u, int wr, int wc, int fr, int fq) const {
        const int col0 = u.pn * BM + wc * 32 + 8 * fq;
#pragma unroll
        for (int ai = 0; ai < 2; ++ai)
#pragma unroll
            for (int m = 0; m < 4; ++m) {
                bf16_t* rowp = O + (size_t)(u.pm * BM + ai * HALF + wr * 64 + m * 16 + fr) * ldo + col0;
#pragma unroll
                for (int bj = 0; bj < 2; ++bj) *(u32x4*)(rowp + bj * HALF) = pack8(acc[ai][bj][m][0], acc[ai][bj][m][1]);
            }
    }
};
struct EpiInO {
    static constexpr bool PERM = true, AFTER_DRAIN = false;
    bf16_t* QKV; float* kmean; float isc;
    __device__ __forceinline__ void operator()(const Acc& acc, const Unit& u, int wr, int wc, int fr, int fq) const {
        const int which = u.pn >> 2; bf16_t* base = QKV + (size_t)which * MTOK * 1024; const float sc = (which == 0) ? QSCALE * isc : isc;
        const int col0 = (u.pn & 3) * BM + wc * 32 + 8 * fq;
#pragma unroll
        for (int ai = 0; ai < 2; ++ai)
#pragma unroll
            for (int m = 0; m < 4; ++m) {
                bf16_t* rowp = base + (size_t)(u.pm * BM + ai * HALF + wr * 64 + m * 16 + fr) * 1024 + col0;
#pragma unroll
                for (int bj = 0; bj < 2; ++bj) *(u32x4*)(rowp + bj * HALF) = pack8(acc[ai][bj][m][0] * sc, acc[ai][bj][m][1] * sc);
            }
        if (which == 1) {
#pragma unroll
            for (int bj = 0; bj < 2; ++bj)
#pragma unroll
                for (int n = 0; n < 2; ++n) { f32x4 s = (f32x4){0.f, 0.f, 0.f, 0.f};
#pragma unroll
                    for (int ai = 0; ai < 2; ++ai)
#pragma unroll
                        for (int m = 0; m < 4; ++m) s += acc[ai][bj][m][n];
#pragma unroll
                    for (int e = 0; e < 4; ++e) { float v = s[e]; v += __shfl_xor(v, 1); v += __shfl_xor(v, 2); v += __shfl_xor(v, 4); v += __shfl_xor(v, 8);
                        if (fr == 0) kmean[((size_t)u.pm * 2 + wr) * 1024 + col0 + bj * HALF + 4 * n + e] = v; }
                }
        }
    }
};

__device__ __forceinline__ unsigned pk4_fp8(float a, float b, float c, float d) { int w = 0; w = __builtin_amdgcn_cvt_pk_fp8_f32(a, b, w, false); w = __builtin_amdgcn_cvt_pk_fp8_f32(c, d, w, true); return (unsigned)w; }
struct EpiSwiglu8 {
    static constexpr bool PERM = true, AFTER_DRAIN = false;
    unsigned char* O; int ldo; int pm0; float isc;
    __device__ __forceinline__ void operator()(const Acc& acc, const Unit& u, int wr, int wc, int fr, int fq) const {
        const int col0 = u.pn * HALF + wc * 32 + 8 * fq;
#pragma unroll
        for (int ai = 0; ai < 2; ++ai)
#pragma unroll
            for (int m = 0; m < 4; ++m) {
                unsigned char* rowp = O + (size_t)((u.pm - pm0) * BM + ai * HALF + wr * 64 + m * 16 + fr) * ldo + col0;
                f32x4 o[2];
#pragma unroll
                for (int n = 0; n < 2; ++n) { const f32x4 a = acc[ai][0][m][n] * isc, b = acc[ai][1][m][n] * isc;
#pragma unroll
                    for (int e = 0; e < 4; ++e) o[n][e] = a[e] * __builtin_amdgcn_rcpf(1.f + __expf(-a[e])) * b[e]; }
                u32x2 w; w.x = pk4_fp8(o[0][0], o[0][1], o[0][2], o[0][3]); w.y = pk4_fp8(o[1][0], o[1][1], o[1][2], o[1][3]);
                *(u32x2*)rowp = w;
            }
    }
};

struct EpiSwigluI8 {
    static constexpr bool PERM = true, AFTER_DRAIN = false;
    unsigned char* O; int ldo; const float* sa; const float* sw;
    __device__ __forceinline__ void operator()(const Acc& acc, const Unit& u, int wr, int wc, int fr, int fq) const {
        const int col0 = u.pn * HALF + wc * 32 + 8 * fq, bcol = u.pn * BM + wc * 32 + 8 * fq;
        f32x4 w1s[2], w3s[2];
#pragma unroll
        for (int n = 0; n < 2; ++n) { w1s[n] = *(const f32x4*)(sw + bcol + 4 * n); w3s[n] = *(const f32x4*)(sw + bcol + HALF + 4 * n); }
#pragma unroll
        for (int ai = 0; ai < 2; ++ai)
#pragma unroll
            for (int m = 0; m < 4; ++m) {
                const int row = u.pm * BM + ai * HALF + wr * 64 + m * 16 + fr; const float ra = sa[row];
                unsigned char* rowp = O + (size_t)row * ldo + col0;
                f32x4 o[2];
#pragma unroll
                for (int n = 0; n < 2; ++n) {
#pragma unroll
                    for (int e = 0; e < 4; ++e) { const float xa = acc[ai][0][m][n][e], xb = acc[ai][1][m][n][e];
                        const float a = (float)__float_as_int(xa) * ra * w1s[n][e], b = (float)__float_as_int(xb) * ra * w3s[n][e];
                        o[n][e] = a * __builtin_amdgcn_rcpf(1.f + __expf(-a)) * b; } }
                u32x2 w; w.x = pk4_fp8(o[0][0], o[0][1], o[0][2], o[0][3]); w.y = pk4_fp8(o[1][0], o[1][1], o[1][2], o[1][3]);
                *(u32x2*)rowp = w;
            }
    }
};
struct EpiStoreS {
    static constexpr bool PERM = true, AFTER_DRAIN = false;
    bf16_t* O; int ldo; float sc;
    __device__ __forceinline__ void operator()(const Acc& acc, const Unit& u, int wr, int wc, int fr, int fq) const {
        const int col0 = u.pn * BM + wc * 32 + 8 * fq;
#pragma unroll
        for (int ai = 0; ai < 2; ++ai)
#pragma unroll
            for (int m = 0; m < 4; ++m) {
                bf16_t* rowp = O + (size_t)(u.pm * BM + ai * HALF + wr * 64 + m * 16 + fr) * ldo + col0;
#pragma unroll
                for (int bj = 0; bj < 2; ++bj) *(u32x4*)(rowp + bj * HALF) = pack8(acc[ai][bj][m][0] * sc, acc[ai][bj][m][1] * sc);
            }
    }
};
struct MoeOrder {
    int g0, ng, nN, G, c; int pend[8];
    __device__ __forceinline__ bool next(int i, Unit& u) const {
        const int L = i * G + c; if (L >= ng * nN) return false;
        u.pm = g0 + L % ng; u.pn = L / ng; const int r = u.pm * 256; int e = 0;
#pragma unroll
        for (int k = 0; k < 7; ++k) e += (pend[k] <= r) ? 1 : 0;
        u.e = e; return true;
    }
    __device__ __forceinline__ void a_ready(const Unit&) const {}
    __device__ __forceinline__ void done(const Unit&) const {}
};
}

#ifndef FFN_F8
#define FFN_F8 0
#endif
constexpr size_t MiB = 1u << 20, KiB = 1u << 10;
constexpr size_t CTL_ZERO_BYTES = 2 * MiB;
constexpr int    MAX_LAUNCHES = 18;
constexpr size_t OFF_BAR = 16 * KiB;
constexpr size_t OFF_WGCNT = 1 * MiB + 512 * KiB;
constexpr size_t OFF_GINFO = OFF_WGCNT + 16 * KiB;
constexpr size_t OFF_DBG = OFF_GINFO + 1 * KiB;
constexpr size_t OFF_BT = 2 * MiB;
constexpr size_t OFF_CB = 2 * MiB + 16 * KiB;
constexpr size_t OFF_ROUTE = 2 * MiB + 64 * KiB;
constexpr size_t OFF_DEST = 2 * MiB + 512 * KiB;
constexpr size_t OFF_KC = 3 * MiB, OFF_VC = 3 * MiB + 512 * KiB;
constexpr size_t OFF_W_IN = 4 * MiB, OFF_W_Q2 = OFF_W_IN + (size_t)EVEN_INP * 1024 * 2, OFF_W_OUTE = OFF_W_Q2 + 2048 * 256 * 2, OFF_W_F13 = OFF_W_OUTE + 1024 * 1536 * 2,
                 OFF_W_F2 = OFF_W_F13 + (size_t)2 * DFF * 1024 * 2, OFF_CK1 = OFF_W_F2 + (size_t)1024 * DFF * 2, OFF_CV1 = OFF_CK1 + 64 * 2048 * 2, OFF_WE_END = OFF_CV1 + 64 * 2048 * 2;
static_assert(OFF_WE_END <= 30 * MiB, "even weights");
constexpr size_t OFF_W_OIN = 30 * MiB, OFF_W_OOUT = 36 * MiB, OFF_W_M13 = 38 * MiB, OFF_W_M2 = 94 * MiB;
constexpr size_t OFF_Y1 = 30 * MiB;
constexpr size_t OFF_CKVN = 142 * MiB;
constexpr size_t OFF_XB = 206 * MiB, OFF_QLAT = 206 * MiB, OFF_QIDX = 270 * MiB;
constexpr size_t OFF_SC = 334 * MiB, OFF_MASK = 464 * MiB, OFF_MIXIN = 334 * MiB;
constexpr size_t OFF_S1 = 206 * MiB, OFF_H = 270 * MiB, OFF_ACT = 30 * MiB, OFF_S2 = 334 * MiB, OFF_X1 = 398 * MiB, OFF_H8 = 464 * MiB;
constexpr size_t OFF_SA = 497 * MiB, OFF_SW = 497 * MiB + 256 * KiB, OFF_SAX = 497 * MiB + 512 * KiB, OFF_SWIN = 497 * MiB + 768 * KiB;
constexpr size_t OFF_X18 = 464 * MiB, OFF_O8 = 464 * MiB;
constexpr float OSC = 16.f, WOUT_SCALE = 64.f, WIN_SCALE = 32.f, WF13_SCALE = 32.f, WF2_SCALE = 128.f;
constexpr size_t OFF_QKV = 206 * MiB, OFF_S1O = 270 * MiB, OFF_H2 = 122 * MiB, OFF_ACTM = 186 * MiB, OFF_YR = 298 * MiB, OFF_XR = 430 * MiB;
constexpr float W13_SCALE = 32.f, W2_SCALE = 128.f;
constexpr size_t OFF_MST = 122 * MiB;
constexpr size_t OFF_SSQ_Q = 514 * MiB, OFF_SSQ_KV = 514 * MiB + 512 * KiB;
constexpr size_t OFF_KMEAN = 515 * MiB;
constexpr size_t WS_END = 516 * MiB;
constexpr int    MOE_CHUNK = 128;
constexpr size_t SCB_ELEMS = (size_t)64 * 64 * (64 * 65 / 2);

constexpr int LDS_BYTES = 160 * 1024;
constexpr int LDSCTL_OFF = LDS_BYTES - 512;

#define RLX_AGENT __ATOMIC_RELAXED, __HIP_MEMORY_SCOPE_AGENT
typedef GAS unsigned gu32;
#define XB_TMO      128
#define XB_XCNT(j)  (256  + 64 * (j))
#define XB_XSUB(j)  (1280 + 64 * (j))
#define XB_XGEN(j)  (2304 + 64 * (j))
#define XB_TOP      3328
#define XB_TOPGEN   3392
#define XCD_BAR_WORDS 3456
#define XB_SPIN_CAP (1u << 18)

__device__ __forceinline__ unsigned xb_ld(unsigned* p)              { return __hip_atomic_load(p, __ATOMIC_RELAXED, __HIP_MEMORY_SCOPE_AGENT); }
__device__ __forceinline__ unsigned xb_add(unsigned* p, unsigned v) { return __hip_atomic_fetch_add(p, v, __ATOMIC_RELAXED, __HIP_MEMORY_SCOPE_AGENT); }
__device__ __forceinline__ unsigned xb_xcc_id() { return (unsigned)__builtin_amdgcn_s_getreg((3 << 11) | 20) & 0xFu; }
#define XB_SPIN(cond, bar) do { unsigned _sp = 0; while (cond) { __builtin_amdgcn_s_sleep(1); \
    if ((++_sp & 255u) == 0u) { if (xb_ld(&(bar)[XB_TMO])) break; if (_sp > XB_SPIN_CAP) { atomicAdd(&(bar)[XB_TMO], 1u); break; } } } } while (0)

struct XcdBarrier {
    unsigned* bar; unsigned x;
    volatile LAS unsigned* st;
};

__device__ __forceinline__ XcdBarrier xcd_barrier_post(unsigned* bar, volatile LAS unsigned* st) {
    XcdBarrier b; b.bar = bar; b.x = xb_xcc_id(); b.st = st;
    if (threadIdx.x == 0) (void)xb_add(&bar[XB_XCNT(b.x)], 1u);
    return b;
}
__device__ __forceinline__ void xcd_barrier_complete(unsigned* bar, unsigned x, unsigned& nloc, unsigned& nx) {
    const unsigned G = gridDim.x * gridDim.y * gridDim.z;
    unsigned sum, cnt, mine, sp = 0u;
    for (;;) {
        sum = 0u; cnt = 0u; mine = 0u;
#pragma unroll
        for (unsigned j = 0; j < 16; ++j) { const unsigned c = xb_ld(&bar[XB_XCNT(j)]); sum += c; cnt += (c > 0u) ? 1u : 0u; mine = (j == x) ? c : mine; }
        if (sum == G) break;
        __builtin_amdgcn_s_sleep(1);
        if ((++sp & 255u) == 0u) { if (xb_ld(&bar[XB_TMO])) break; if (sp > XB_SPIN_CAP) { atomicAdd(&bar[XB_TMO], 1u); break; } }
    }
    nloc = mine > 0u ? mine : 1u; nx = cnt > 0u ? cnt : 1u;
}

__device__ __forceinline__ void xcd_barrier(const XcdBarrier& b) {
    asm volatile("s_waitcnt vmcnt(0)" ::: "memory");
    __syncthreads();
    if (threadIdx.x == 0) {
        unsigned* bar = b.bar;
        __builtin_amdgcn_s_waitcnt(0);
        unsigned nloc = b.st[0], nx = b.st[1];
        if (nloc == 0u) { xcd_barrier_complete(bar, b.x, nloc, nx); b.st[0] = nloc; b.st[1] = nx; }
        const unsigned old = xb_add(&bar[XB_XSUB(b.x)], 1u);
        const unsigned gen = old / nloc;
        if (old + 1u == (gen + 1u) * nloc) {
            __builtin_amdgcn_fence(__ATOMIC_RELEASE, "agent");
            asm volatile("s_waitcnt vmcnt(0)" ::: "memory");
            const unsigned og = xb_add(&bar[XB_TOP], 1u);
            const unsigned tg = og / nx;
            if (og + 1u == (tg + 1u) * nx) xb_add(&bar[XB_TOPGEN], 1u);
            else XB_SPIN(xb_ld(&bar[XB_TOPGEN]) == tg, bar);
            __builtin_amdgcn_fence(__ATOMIC_ACQUIRE, "agent");
            xb_add(&bar[XB_XGEN(b.x)], 1u);
            asm volatile("s_waitcnt vmcnt(0)" ::: "memory");
        } else {
            XB_SPIN(xb_ld(&bar[XB_XGEN(b.x)]) == gen, bar);
            __builtin_amdgcn_fence(__ATOMIC_ACQUIRE, "agent");
            asm volatile("s_waitcnt vmcnt(0)" ::: "memory");
        }
    }
    __syncthreads();
}

struct Frame {
    LAS unsigned char* lds;
    int tid, lane, wave, G, bx;
    int gw, NGW;
    unsigned char* ws;
    const float* const* in;
};
struct Args { const float* in[33]; float* out; unsigned char* ws; int ph_lo, ph_hi, li, pad; };
enum InIdx { I_X = 0, I_RELB, I_EWIN, I_EQN, I_EKVN, I_EWUQ, I_EWUK, I_EWUV, I_EWQIDX, I_EPOSK, I_EPOSV, I_ECK1, I_ECK2, I_ECV1, I_ECV2, I_EWOUT, I_ELN1G, I_ELN1B,
             I_EF1, I_EF3, I_EF2, I_ELN2G, I_ELN2B, I_OWIN, I_OWOUT, I_OLN1G, I_OLN1B, I_OROUTER, I_OM1, I_OM3, I_OM2, I_OLN2G, I_OLN2B };

template <class RowMap, class KScale>
__device__ __forceinline__ void transpose_item(const float* W, int K, int N, bf16_t* WT, int ldt, LAS float* scr, int item, int lane, RowMap rm, KScale ks) {
    const int nblk = (N + 63) >> 6, kb = item / nblk, nb = item - kb * nblk, k0 = 128 * kb, n = 64 * nb + lane;
    if (n >= N) return;
    const float* src = W + (size_t)k0 * N + n; bf16_t* dst = WT + (size_t)rm(n) * ldt + k0;
#pragma unroll 2
    for (int kk = 0; kk < 128; kk += 8) { float v[8];
#pragma unroll
        for (int i = 0; i < 8; ++i) v[i] = src[(size_t)(kk + i) * N] * ks(k0 + kk + i);
        u32x4 o; o.x = pk2(v[0], v[1]); o.y = pk2(v[2], v[3]); o.z = pk2(v[4], v[5]); o.w = pk2(v[6], v[7]);
        *(u32x4*)(dst + kk) = o; }
}
template <class RowMap>
__device__ __forceinline__ void transpose_item8(const float* W, int K, int N, unsigned char* WT, int ldt, int item, int lane, RowMap rm, float scale) {
    const int nblk = N >> 8, kb = item / nblk, nb = item - kb * nblk, k0 = 128 * kb, n = 256 * nb + 4 * lane;
    const float* src = W + (size_t)k0 * N + n;
    unsigned char* d0 = WT + (size_t)rm(n) * ldt + k0; unsigned char* d1 = WT + (size_t)rm(n + 1) * ldt + k0; unsigned char* d2 = WT + (size_t)rm(n + 2) * ldt + k0; unsigned char* d3 = WT + (size_t)rm(n + 3) * ldt + k0;
#pragma unroll 1
    for (int kk = 0; kk < 128; kk += 16) { f32x4 v[16];
#pragma unroll
        for (int i = 0; i < 16; ++i) v[i] = *(const f32x4*)(src + (size_t)(kk + i) * N) * scale;
#pragma unroll
        for (int c = 0; c < 4; ++c) { u32x4 o; o.x = pg8::pk4_fp8(v[0][c], v[1][c], v[2][c], v[3][c]); o.y = pg8::pk4_fp8(v[4][c], v[5][c], v[6][c], v[7][c]);
            o.z = pg8::pk4_fp8(v[8][c], v[9][c], v[10][c], v[11][c]); o.w = pg8::pk4_fp8(v[12][c], v[13][c], v[14][c], v[15][c]);
            *(u32x4*)((c == 0 ? d0 : c == 1 ? d1 : c == 2 ? d2 : d3) + kk) = o; } }
}
template <class RowMap>
__device__ __forceinline__ void transpose_item_i8(const float* W, int K, int N, unsigned char* WT, int ldt, float* sw, int item, int lane, RowMap rm) {
    const int c = lane & 7, kg = lane >> 3, n = 8 * item + c, ks = K >> 3, kbase = kg * ks;
    const float* src = W + (size_t)kbase * N + n; float mx = 0.f;
#pragma unroll 16
    for (int k = 0; k < ks; ++k) mx = fmaxf(mx, fabsf(src[(size_t)k * N]));
    mx = fmaxf(mx, __shfl_xor(mx, 8)); mx = fmaxf(mx, __shfl_xor(mx, 16)); mx = fmaxf(mx, __shfl_xor(mx, 32));
    mx = fmaxf(mx, 1e-20f); const float inv = 127.f / mx; const int dr = rm(n); if (kg == 0) sw[dr] = mx * (1.f / 127.f);
    unsigned char* dst = WT + (size_t)dr * ldt + kbase;
#pragma unroll 2
    for (int kk = 0; kk < ks; kk += 16) { unsigned w[4];
#pragma unroll
        for (int q = 0; q < 4; ++q) { const int q0 = (int)rintf(src[(size_t)(kk + 4 * q) * N] * inv), q1 = (int)rintf(src[(size_t)(kk + 4 * q + 1) * N] * inv), q2 = (int)rintf(src[(size_t)(kk + 4 * q + 2) * N] * inv), q3 = (int)rintf(src[(size_t)(kk + 4 * q + 3) * N] * inv);
            w[q] = (unsigned)(q0 & 255) | ((unsigned)(q1 & 255) << 8) | ((unsigned)(q2 & 255) << 16) | ((unsigned)(q3 & 255) << 24); }
        *(u32x4*)(dst + kk) = (u32x4){w[0], w[1], w[2], w[3]}; }
}
struct RowId { __device__ __forceinline__ int operator()(int n) const { return n; } };
struct KOne { __device__ __forceinline__ float operator()(int) const { return 1.f; } };
struct RowInE {
    __device__ __forceinline__ int operator()(int n) const { return n < 464 ? n : (n < 1744 ? n + 48 : n - 1744 + 464); }
};
struct RowIlv {
    int add; __device__ __forceinline__ int operator()(int n) const { return ((n >> 7) << 8) + (n & 127) + add; }
};
struct KGain { const float* g; __device__ __forceinline__ float operator()(int k) const { return g[k]; } };

__device__ __forceinline__ void store_row_i8(unsigned char* row, float* sa, int lane, const f32x4 (&v)[4]) {
    float mx = 0.f;
#pragma unroll
    for (int j = 0; j < 4; ++j) mx = fmaxf(fmaxf(mx, fmaxf(fabsf(v[j][0]), fabsf(v[j][1]))), fmaxf(fabsf(v[j][2]), fabsf(v[j][3])));
#pragma unroll
    for (int o = 1; o < 64; o <<= 1) mx = fmaxf(mx, __shfl_xor(mx, o));
    mx = fmaxf(mx, 1e-20f); const float inv = 127.f / mx;
#pragma unroll
    for (int j = 0; j < 4; ++j) { const int q0 = (int)rintf(v[j][0] * inv), q1 = (int)rintf(v[j][1] * inv), q2 = (int)rintf(v[j][2] * inv), q3 = (int)rintf(v[j][3] * inv);
        *(unsigned*)(row + 4 * lane + 256 * j) = (unsigned)(q0 & 255) | ((unsigned)(q1 & 255) << 8) | ((unsigned)(q2 & 255) << 16) | ((unsigned)(q3 & 255) << 24); }
    if (lane == 0) *sa = mx * (1.f / 127.f);
}
__device__ __forceinline__ int t5_bucket(int n) {
    if (n < 16) return n;
    int l = 16 + (int)(__logf((float)n / 16.f) / 2.0794415f * 16.f);
    return l < 31 ? l : 31;
}

__device__ __forceinline__ void phase_prologue_even(const Frame& F, const Args& a) {
    LAS float* scr = (LAS float*)(F.lds + F.wave * 8704);
    unsigned char* ws = F.ws;
    bf16_t* W_IN = (bf16_t*)(ws + OFF_W_IN); bf16_t* W_Q2 = (bf16_t*)(ws + OFF_W_Q2); unsigned char* W_OUTE = ws + OFF_W_OUTE;
    unsigned char* W_F13 = ws + OFF_W_F13; unsigned char* W_F2 = ws + OFF_W_F2; bf16_t* CK1 = (bf16_t*)(ws + OFF_CK1); bf16_t* CV1 = (bf16_t*)(ws + OFF_CV1);
    constexpr int I_IN = 8 * ((EVEN_IN + 63) / 64);
    constexpr int I_QI = 2 * 16;
    constexpr int I_OB = 4 * 4;
    constexpr int I_F1 = DFF / 8, I_F2 = (DFF / 128) * 4;
    constexpr int I_CK = 16 * 1;
    constexpr int NIT = I_IN + I_QI + I_OB + 2 * I_F1 + I_F2 + 2 * I_CK;
    for (int it = F.gw; it < NIT; it += F.NGW) {
        int r = it;
        if (r < I_IN) { transpose_item(a.in[I_EWIN], 1024, EVEN_IN, W_IN, 1024, scr, r, F.lane, RowInE{}, KOne{}); continue; } r -= I_IN;
        if (r < I_QI) { transpose_item(a.in[I_EWQIDX], 256, 1024, W_Q2 + 1024 * 256, 256, scr, r, F.lane, RowId{}, KGain{a.in[I_EQN]}); continue; } r -= I_QI;
        if (r < I_OB) { transpose_item8(a.in[I_EWOUT] + 512 * 1024, 512, 1024, W_OUTE + 1024, 1536, r, F.lane, RowId{}, WOUT_SCALE); continue; } r -= I_OB;
#if FFN_F8
        if (r < I_F1) { transpose_item8(a.in[I_EF1], 1024, DFF, W_F13, 1024, r, F.lane, RowIlv{0}, WF13_SCALE); continue; } r -= I_F1;
        if (r < I_F1) { transpose_item8(a.in[I_EF3], 1024, DFF, W_F13, 1024, r, F.lane, RowIlv{128}, WF13_SCALE); continue; } r -= I_F1;
        if (r < I_F2) { transpose_item8(a.in[I_EF2], DFF, 1024, W_F2, DFF, r, F.lane, RowId{}, WF2_SCALE); continue; } r -= I_F2;
#else
        if (r < I_F1) { transpose_item_i8(a.in[I_EF1], 1024, DFF, W_F13, 1024, (float*)(ws + OFF_SW), r, F.lane, RowIlv{0}); continue; } r -= I_F1;
        if (r < I_F1) { transpose_item_i8(a.in[I_EF3], 1024, DFF, W_F13, 1024, (float*)(ws + OFF_SW), r, F.lane, RowIlv{128}); continue; } r -= I_F1;
        if (r < I_F2) { transpose_item8(a.in[I_EF2], DFF, 1024, W_F2, DFF, r, F.lane, RowId{}, WF2_SCALE); continue; } r -= I_F2;
#endif
        if (r < I_CK) { transpose_item(a.in[I_ECK1], 2048, 64, CK1, 2048, scr, r, F.lane, RowId{}, KOne{}); continue; } r -= I_CK;
        transpose_item(a.in[I_ECV1], 2048, 64, CV1, 2048, scr, r, F.lane, RowId{}, KOne{});
    }
    const int gt = F.bx * NTHR + F.tid, NGT = F.G * NTHR;
    for (int i = gt; i < 24 * 1024 / 8; i += NGT) ((u32x4*)(W_IN + 488 * 1024))[i] = (u32x4){0u, 0u, 0u, 0u};
    { const float* uq = a.in[I_EWUQ]; const float* uk = a.in[I_EWUK]; const float* qg = a.in[I_EQN];
      for (int o = gt; o < 1024 * 256; o += NGT) { const int r = o & 255, hc = o >> 8, h = hc >> 7, c = hc & 127; const float* p = uq + r * 512 + h * 64; const float* q = uk + c * 512 + h * 64; float s = 0.f;
#pragma unroll 8
          for (int d = 0; d < 64; ++d) s += p[d] * q[d];
          W_Q2[o] = (bf16_t)f2bf(s * qg[r]); } }
    { const float* uv = a.in[I_EWUV]; const float* wo = a.in[I_EWOUT];
      for (int o = gt; o < 1024 * 1024 / 16; o += NGT) { const int nb = o & 255, hc4 = o >> 8, h = hc4 >> 5, c0 = (hc4 & 31) * 4, n0 = nb * 4;
          const float* p = uv + (size_t)c0 * 512 + h * 64; const float* q = wo + (size_t)(h * 64) * 1024 + n0;
          f32x4 acc4[4] = {(f32x4){0.f, 0.f, 0.f, 0.f}, (f32x4){0.f, 0.f, 0.f, 0.f}, (f32x4){0.f, 0.f, 0.f, 0.f}, (f32x4){0.f, 0.f, 0.f, 0.f}};
#pragma unroll 4
          for (int d = 0; d < 64; ++d) { const f32x4 qv = *(const f32x4*)(q + (size_t)d * 1024);
#pragma unroll
              for (int cc = 0; cc < 4; ++cc) acc4[cc] += qv * p[cc * 512 + d]; }
#pragma unroll
          for (int cc = 0; cc < 4; ++cc)
#pragma unroll
              for (int e = 0; e < 4; ++e) W_OUTE[(size_t)(n0 + e) * 1536 + h * 128 + c0 + cc] = (unsigned char)(__builtin_amdgcn_cvt_pk_fp8_f32(acc4[cc][e] * WOUT_SCALE, 0.f, 0, false) & 0xff); } }
    if (F.bx == 0) { float* BT = (float*)(ws + OFF_BT); const float* rb = a.in[I_RELB];
        for (int i = F.tid; i < 16 * 128; i += NTHR) { const int h = i >> 7, d = i & 127; BT[i] = rb[t5_bucket(d) * 16 + h] * LOG2E; } }
    if (F.bx == 1 && F.tid < 128) { const int kv = F.tid >> 6, e = F.tid & 63; const float* pos = a.in[kv ? I_EPOSV : I_EPOSK]; const float* w1 = a.in[kv ? I_ECV1 : I_ECK1]; float s = 0.f;
        for (int k = 0; k < 2048; ++k) s += pos[k] * w1[k * 64 + e];
        ((float*)(ws + OFF_CB))[F.tid] = s; }
    { const f32x4* x4 = (const f32x4*)a.in[I_X]; u32x4* xb = (u32x4*)(ws + OFF_XB);
      for (int i = gt; i < MTOK * 1024 / 8; i += NGT) { const f32x4 v0 = x4[2 * i], v1 = x4[2 * i + 1]; xb[i] = pg8::pack8(v0, v1); } }
}

__device__ __forceinline__ void phase_convert_odd(const Frame& F, const Args& a) {
    LAS float* scr = (LAS float*)(F.lds + F.wave * 8704);
    unsigned char* ws = F.ws;
    unsigned char* W_OIN = ws + OFF_W_OIN; unsigned char* W_OOUT = ws + OFF_W_OOUT; unsigned char* W_M13 = ws + OFF_W_M13; unsigned char* W_M2 = ws + OFF_W_M2;
    constexpr int I_IN = 8 * 12, I_OUT = 8 * 4, I_M1 = 8 * (DFFE / 256), I_M2 = (DFFE / 128) * 4;
    constexpr int NIT = I_IN + I_OUT + NEXP * (2 * I_M1 + I_M2);
    for (int it = F.gw; it < NIT; it += F.NGW) {
        int r = it;
        if (r < I_IN) { transpose_item8(a.in[I_OWIN], 1024, 3072, W_OIN, 1024, r, F.lane, RowId{}, WIN_SCALE); continue; } r -= I_IN;
        if (r < I_OUT) { transpose_item8(a.in[I_OWOUT], 1024, 1024, W_OOUT, 1024, r, F.lane, RowId{}, WOUT_SCALE); continue; } r -= I_OUT;
        const int e = r / (2 * I_M1 + I_M2); r -= e * (2 * I_M1 + I_M2);
        if (r < I_M1) { transpose_item8(a.in[I_OM1] + (size_t)e * 1024 * DFFE, 1024, DFFE, W_M13 + (size_t)e * 2 * DFFE * 1024, 1024, r, F.lane, RowIlv{0}, W13_SCALE); continue; } r -= I_M1;
        if (r < I_M1) { transpose_item8(a.in[I_OM3] + (size_t)e * 1024 * DFFE, 1024, DFFE, W_M13 + (size_t)e * 2 * DFFE * 1024, 1024, r, F.lane, RowIlv{128}, W13_SCALE); continue; } r -= I_M1;
        transpose_item8(a.in[I_OM2] + (size_t)e * DFFE * 1024, DFFE, 1024, W_M2 + (size_t)e * 1024 * DFFE, DFFE, r, F.lane, RowId{}, W2_SCALE);
    }
}

__device__ __forceinline__ void load_row_bf16(const bf16_t* row, int lane, f32x4 (&v)[4]) {
#pragma unroll
    for (int j = 0; j < 4; ++j) { const u32x2 w = *(const u32x2*)(row + 4 * lane + 256 * j); v[j] = (f32x4){bflo(w.x), bfhi(w.x), bflo(w.y), bfhi(w.y)}; }
}
__device__ __forceinline__ void store_row_bf16(bf16_t* row, int lane, const f32x4 (&v)[4]) {
#pragma unroll
    for (int j = 0; j < 4; ++j) { u32x2 w; w.x = pk2(v[j][0], v[j][1]); w.y = pk2(v[j][2], v[j][3]); *(u32x2*)(row + 4 * lane + 256 * j) = w; }
}
__device__ __forceinline__ void ln_inplace(f32x4 (&v)[4], const f32x4 (&g)[4], const f32x4 (&b)[4]) {
    float s = 0.f;
#pragma unroll
    for (int j = 0; j < 4; ++j) s += (v[j][0] + v[j][1]) + (v[j][2] + v[j][3]);
    const float mean = wave_sum(s) * (1.f / 1024.f); float q = 0.f;
#pragma unroll
    for (int j = 0; j < 4; ++j) { v[j] = v[j] - mean; q += (v[j][0] * v[j][0] + v[j][1] * v[j][1]) + (v[j][2] * v[j][2] + v[j][3] * v[j][3]); }
    const float rstd = 1.f / sqrtf(wave_sum(q) * (1.f / 1024.f) + 1e-5f);
#pragma unroll
    for (int j = 0; j < 4; ++j) v[j] = v[j] * rstd * g[j] + b[j];
}
__device__ __forceinline__ void load_gb(const float* g, const float* b, int lane, f32x4 (&gv)[4], f32x4 (&bv)[4]) {
#pragma unroll
    for (int j = 0; j < 4; ++j) { gv[j] = *(const f32x4*)(g + 4 * lane + 256 * j); bv[j] = *(const f32x4*)(b + 4 * lane + 256 * j); }
}
__device__ __forceinline__ void store_row_fp8(unsigned char* row, int lane, const f32x4 (&v)[4]) {
#pragma unroll
    for (int j = 0; j < 4; ++j) *(unsigned*)(row + 4 * lane + 256 * j) = pg8::pk4_fp8(v[j][0], v[j][1], v[j][2], v[j][3]);
}
__device__ __forceinline__ void phase_ln_bf16(const Frame& F, const bf16_t* S, bf16_t* O, unsigned char* O8, const float* g, const float* b) {
    f32x4 gv[4], bv[4]; load_gb(g, b, F.lane, gv, bv);
    for (int row = F.gw; row < MTOK; row += F.NGW) { f32x4 v[4]; load_row_bf16(S + (size_t)row * 1024, F.lane, v); ln_inplace(v, gv, bv); store_row_bf16(O + (size_t)row * 1024, F.lane, v); store_row_fp8(O8 + (size_t)row * 1024, F.lane, v); }
}
__device__ __forceinline__ void phase_ln_i8(const Frame& F, const bf16_t* S, bf16_t* O, unsigned char* O8, float* sa, const float* g, const float* b) {
    f32x4 gv[4], bv[4]; load_gb(g, b, F.lane, gv, bv);
    for (int row = F.gw; row < MTOK; row += F.NGW) { f32x4 v[4]; load_row_bf16(S + (size_t)row * 1024, F.lane, v); ln_inplace(v, gv, bv); store_row_bf16(O + (size_t)row * 1024, F.lane, v); store_row_i8(O8 + (size_t)row * 1024, sa + row, F.lane, v); }
}
__device__ __forceinline__ void phase_ckvn(const Frame& F, const bf16_t* T1, const float* ssq_kv, const float* gain, bf16_t* CKVN) {
    const float g0 = gain[2 * F.lane], g1 = gain[2 * F.lane + 1];
    for (int row = F.gw; row < MTOK; row += F.NGW) {
        const unsigned w = *(const unsigned*)(T1 + (size_t)row * 256 + 2 * F.lane);
        const f32x4 sq = *(const f32x4*)(ssq_kv + (size_t)row * 4); const float r = __builtin_amdgcn_rsqf(((sq[0] + sq[1]) + (sq[2] + sq[3])) * (1.f / 128.f) + 1e-6f);
        *(unsigned*)(CKVN + (size_t)row * 128 + 2 * F.lane) = pk2(bflo(w) * r * g0, bfhi(w) * r * g1);
    }
}
__device__ __forceinline__ void phase_ln_router(const Frame& F, const bf16_t* S, bf16_t* H2, const float* g, const float* b, const float* router, unsigned char* ws) {
    LAS int* cnt = (LAS int*)(F.lds);
    if (F.tid < 8) cnt[F.tid] = 0;
    __syncthreads();
    f32x4 gv[4], bv[4]; load_gb(g, b, F.lane, gv, bv);
    u32x2* ROUTE = (u32x2*)(ws + OFF_ROUTE);
    f32x4 rw[16][2];
#pragma unroll
    for (int j = 0; j < 4; ++j)
#pragma unroll
        for (int e = 0; e < 4; ++e) { const float* rp = router + (size_t)(4 * F.lane + 256 * j + e) * 8; rw[4 * j + e][0] = *(const f32x4*)rp; rw[4 * j + e][1] = *(const f32x4*)(rp + 4); }
    const bool b0 = F.lane & 1, b1 = F.lane & 2, b2 = F.lane & 4;
    for (int row = F.gw; row < MTOK; row += F.NGW) {
        f32x4 v[4]; load_row_bf16(S + (size_t)row * 1024, F.lane, v); ln_inplace(v, gv, bv); store_row_bf16(H2 + (size_t)row * 1024, F.lane, v);
        float pl[8];
#pragma unroll
        for (int x = 0; x < 8; ++x) pl[x] = 0.f;
#pragma unroll
        for (int j = 0; j < 4; ++j)
#pragma unroll
            for (int e = 0; e < 4; ++e) { const f32x4 r0 = rw[4 * j + e][0], r1 = rw[4 * j + e][1]; const float hv = v[j][e];
                pl[0] += hv * r0[0]; pl[1] += hv * r0[1]; pl[2] += hv * r0[2]; pl[3] += hv * r0[3]; pl[4] += hv * r1[0]; pl[5] += hv * r1[1]; pl[6] += hv * r1[2]; pl[7] += hv * r1[3]; }
        float k4[4], k2[2], k1;
#pragma unroll
        for (int i = 0; i < 4; ++i) { const float send = b0 ? pl[i] : pl[i + 4]; k4[i] = (b0 ? pl[i + 4] : pl[i]) + __shfl_xor(send, 1); }
#pragma unroll
        for (int i = 0; i < 2; ++i) { const float send = b1 ? k4[i] : k4[i + 2]; k2[i] = (b1 ? k4[i + 2] : k4[i]) + __shfl_xor(send, 2); }
        { const float send = b2 ? k2[0] : k2[1]; k1 = (b2 ? k2[1] : k2[0]) + __shfl_xor(send, 4); }
        k1 += __shfl_xor(k1, 8); k1 += __shfl_xor(k1, 16); k1 += __shfl_xor(k1, 32);
        float lg[8];
#pragma unroll
        for (int x = 0; x < 8; ++x) lg[x] = __int_as_float(__builtin_amdgcn_readlane(__float_as_int(k1), (x >> 2) | (((x >> 1) & 1) << 1) | ((x & 1) << 2)));
        int e0 = 0; float l0 = lg[0];
#pragma unroll
        for (int x = 1; x < 8; ++x) if (lg[x] > l0) { l0 = lg[x]; e0 = x; }
        int e1 = -1; float l1 = -INFINITY;
#pragma unroll
        for (int x = 0; x < 8; ++x) if (x != e0 && lg[x] > l1) { l1 = lg[x]; e1 = x; }
        const float g0 = 1.f / (1.f + __expf(l1 - l0));
        if (F.lane == 0) { u32x2 r; r.x = (unsigned)e0 | ((unsigned)e1 << 8); r.y = __builtin_bit_cast(unsigned, g0); ROUTE[row] = r;
            __hip_atomic_fetch_add(cnt + e0, 1, __ATOMIC_RELAXED, __HIP_MEMORY_SCOPE_WORKGROUP); __hip_atomic_fetch_add(cnt + e1, 1, __ATOMIC_RELAXED, __HIP_MEMORY_SCOPE_WORKGROUP); }
    }
    __syncthreads();
    if (F.tid < 8) ((int*)(ws + OFF_WGCNT))[F.bx * 8 + F.tid] = cnt[F.tid];
    __syncthreads();
}
__device__ __forceinline__ void phase_moe_gather(const Frame& F, const bf16_t* H2, unsigned char* XR, unsigned char* ws) {
    LAS int* L = (LAS int*)(F.lds);
    const int* WGCNT = (const int*)(ws + OFF_WGCNT);
    { const int e = F.wave; int t = 0, p = 0;
#pragma unroll
      for (int k = 0; k < 4; ++k) { const int wg = F.lane + 64 * k; const int c = (wg < F.G) ? WGCNT[wg * 8 + e] : 0; t += c; p += (wg < F.bx) ? c : 0; }
      t = (int)wave_sum((float)t); p = (int)wave_sum((float)p);
      if (F.lane == 0) { L[e] = t; L[8 + e] = p; L[24 + e] = 0; } }
    __syncthreads();
    if (F.tid == 0) { int acc = 0;
        for (int e = 0; e < 8; ++e) { const int pad = (L[e] + 255) / 256 * 256; L[32 + e] = acc; L[16 + e] = acc + L[8 + e]; acc += pad; L[40 + e] = acc; }
        if (F.bx == 0) { int* GI = (int*)(ws + OFF_GINFO); for (int e = 0; e < 8; ++e) { GI[e] = L[40 + e]; GI[8 + e] = L[e]; } } }
    __syncthreads();
    const u32x2* ROUTE = (const u32x2*)(ws + OFF_ROUTE); int* DEST = (int*)(ws + OFF_DEST);
    for (int row = F.gw; row < MTOK; row += F.NGW) {
        const u32x2 r = ROUTE[row]; const int e0 = r.x & 255, e1 = (r.x >> 8) & 255; int s0 = 0, s1 = 0;
        if (F.lane == 0) { s0 = L[16 + e0] + __hip_atomic_fetch_add(L + 24 + e0, 1, __ATOMIC_RELAXED, __HIP_MEMORY_SCOPE_WORKGROUP); s1 = L[16 + e1] + __hip_atomic_fetch_add(L + 24 + e1, 1, __ATOMIC_RELAXED, __HIP_MEMORY_SCOPE_WORKGROUP);
            DEST[2 * row] = s0; DEST[2 * row + 1] = s1; }
        s0 = __builtin_amdgcn_readfirstlane(s0); s1 = __builtin_amdgcn_readfirstlane(s1);
        const u32x4* src = (const u32x4*)(H2 + (size_t)row * 1024) + 2 * F.lane; const u32x4 a = src[0], b = src[1];
        u32x4 o; o.x = pg8::pk4_fp8(bflo(a.x), bfhi(a.x), bflo(a.y), bfhi(a.y)); o.y = pg8::pk4_fp8(bflo(a.z), bfhi(a.z), bflo(a.w), bfhi(a.w));
        o.z = pg8::pk4_fp8(bflo(b.x), bfhi(b.x), bflo(b.y), bfhi(b.y)); o.w = pg8::pk4_fp8(bflo(b.z), bfhi(b.z), bflo(b.w), bfhi(b.w));
        ((u32x4*)(XR + (size_t)s0 * 1024))[F.lane] = o; ((u32x4*)(XR + (size_t)s1 * 1024))[F.lane] = o;
    }
    for (int e = 0; e < 8; ++e) { const int r0 = L[32 + e] + L[e], npad = L[40 + e] - r0;
        for (int i = F.gw; i < npad; i += F.NGW) { u32x4* d = (u32x4*)(XR + (size_t)(r0 + i) * 1024); d[F.lane] = (u32x4){0u, 0u, 0u, 0u}; } }
    __syncthreads();
}
__device__ __forceinline__ void phase_final(const Frame& F, const bf16_t* H2, const bf16_t* YR, const float* g, const float* b, float* out, unsigned char* ws) {
    f32x4 gv[4], bv[4]; load_gb(g, b, F.lane, gv, bv);
    const u32x2* ROUTE = (const u32x2*)(ws + OFF_ROUTE); const int* DEST = (const int*)(ws + OFF_DEST);
    for (int row = F.gw; row < MTOK; row += F.NGW) {
        const u32x2 rte = ROUTE[row]; const float g0 = __uint_as_float(rte.y), g1 = 1.f - g0;   const int d0 = DEST[2 * row], d1 = DEST[2 * row + 1];
        f32x4 v[4], y0[4], y1[4]; load_row_bf16(H2 + (size_t)row * 1024, F.lane, v); load_row_bf16(YR + (size_t)d0 * 1024, F.lane, y0); load_row_bf16(YR + (size_t)d1 * 1024, F.lane, y1);
#pragma unroll
        for (int j = 0; j < 4; ++j) v[j] = v[j] * ALPHA + y0[j] * g0 + y1[j] * g1;
        ln_inplace(v, gv, bv);
#pragma unroll
        for (int j = 0; j < 4; ++j) *(f32x4*)(out + (size_t)row * 1024 + 4 * F.lane + 256 * j) = v[j];
    }
}

namespace att {
constexpr float NEG_BIG = -1e30f;
constexpr int KS64 = 144, VS64 = 192, KT64 = 64 * KS64, VT64 = 64 * VS64;
constexpr int KS128 = 272, VS128 = 320, KT128 = 64 * KS128, VT128 = 64 * VS128;
typedef LAS char* lptr; typedef const LAS char* lcptr;
typedef short v4i16_t __attribute__((ext_vector_type(4)));
__device__ __forceinline__ s16x4 vtr(lcptr p) { return __builtin_bit_cast(s16x4, __builtin_amdgcn_ds_read_tr16_b64_v4i16((LAS v4i16_t*)p)); }
__device__ __forceinline__ f32x16 splat16(float c) { f32x16 v;
#pragma unroll
    for (int r = 0; r < 16; ++r) v[r] = c; return v; }
__device__ __forceinline__ int crow(int r, int hi) { return (r & 3) + 8 * (r >> 2) + 4 * hi; }
__device__ __forceinline__ float ex2(float x) { return __builtin_amdgcn_exp2f(x); }

template <int NKS> __device__ __forceinline__ void qk(f32x16& s0, f32x16& s1, lcptr Kt, int kstride, const bf16x8 (&qf)[NKS], float c0, int r32, int hi) {
    s0 = splat16(c0); s1 = splat16(c0);
    lcptr p0 = Kt + r32 * kstride + hi * 16; lcptr p1 = p0 + 32 * kstride;
#pragma unroll
    for (int ks = 0; ks < NKS; ++ks) { const bf16x8 k0 = *(const LAS bf16x8*)(p0 + ks * 32), k1 = *(const LAS bf16x8*)(p1 + ks * 32);
        s0 = __builtin_amdgcn_mfma_f32_32x32x16_bf16(k0, qf[ks], s0, 0, 0, 0); s1 = __builtin_amdgcn_mfma_f32_32x32x16_bf16(k1, qf[ks], s1, 0, 0, 0); }
}
__device__ __forceinline__ float rowmax32(const f32x16& s0, const f32x16& s1) {
    float a = fmaxf(s0[0], s1[0]);
#pragma unroll
    for (int r = 1; r < 16; ++r) a = fmaxf(a, fmaxf(s0[r], s1[r]));
    return fmaxf(a, __shfl_xor(a, 32));
}
template <int NDT> __device__ __forceinline__ void softmax_step(f32x16& s0, f32x16& s1, float& m, float& l, f32x16 (&o)[NDT]) {
    const float mn = fmaxf(m, rowmax32(s0, s1)); float rs = 0.f;
    if (__any(mn > m)) {
        const float al = ex2(m - mn); l *= al;
#pragma unroll
        for (int d = 0; d < NDT; ++d)
#pragma unroll
            for (int r = 0; r < 16; ++r) o[d][r] *= al;
    }
    m = mn;
#pragma unroll
    for (int r = 0; r < 16; ++r) { s0[r] = ex2(s0[r] - mn); s1[r] = ex2(s1[r] - mn); rs += s0[r] + s1[r]; }
    l += rs;
}
__device__ __forceinline__ bf16x8 pack_p(const f32x16& s, int base) { u32x4 w; w.x = pk2(s[base], s[base + 1]); w.y = pk2(s[base + 2], s[base + 3]); w.z = pk2(s[base + 4], s[base + 5]); w.w = pk2(s[base + 6], s[base + 7]); return __builtin_bit_cast(bf16x8, w); }
template <int NDT> __device__ __forceinline__ void pv(f32x16 (&o)[NDT], const f32x16& s0, const f32x16& s1, lcptr Vt, int vstride, int lane) {
    const bf16x8 pk[4] = {pack_p(s0, 0), pack_p(s0, 8), pack_p(s1, 0), pack_p(s1, 8)};
    const int h = lane >> 5, g = (lane >> 4) & 1, q = (lane & 15) >> 2, p = lane & 3;
    lcptr vb = Vt + (4 * h + q) * vstride + (16 * g + 4 * p) * 2;
#pragma unroll
    for (int k = 0; k < 4; ++k)
#pragma unroll
        for (int d = 0; d < NDT; ++d) { const s16x4 lo = vtr(vb + (16 * k) * vstride + d * 64), hh = vtr(vb + (16 * k + 8) * vstride + d * 64);
            const bf16x8 vf = (bf16x8){lo[0], lo[1], lo[2], lo[3], hh[0], hh[1], hh[2], hh[3]};
            o[d] = __builtin_amdgcn_mfma_f32_32x32x16_bf16(vf, pk[k], o[d], 0, 0, 0); }
}

__device__ __forceinline__ void exp_step(f32x16& s0, f32x16& s1, float& l) {
    float rs = 0.f;
#pragma unroll
    for (int r = 0; r < 16; ++r) { s0[r] = ex2(s0[r]); s1[r] = ex2(s1[r]); rs += s0[r] + s1[r]; }
    l += rs;
}

__device__ __forceinline__ void qk2(f32x16& a0, f32x16& a1, f32x16& b0, f32x16& b1, lcptr Kt, const bf16x8 (&qa)[4], const bf16x8 (&qb)[4], int r32, int hi) {
    a0 = splat16(0.f); a1 = splat16(0.f); b0 = splat16(0.f); b1 = splat16(0.f);
    lcptr p0 = Kt + r32 * KS64 + hi * 16; lcptr p1 = p0 + 32 * KS64;
#pragma unroll
    for (int ks = 0; ks < 4; ++ks) { const bf16x8 k0 = *(const LAS bf16x8*)(p0 + ks * 32), k1 = *(const LAS bf16x8*)(p1 + ks * 32);
        a0 = __builtin_amdgcn_mfma_f32_32x32x16_bf16(k0, qa[ks], a0, 0, 0, 0); b0 = __builtin_amdgcn_mfma_f32_32x32x16_bf16(k0, qb[ks], b0, 0, 0, 0);
        a1 = __builtin_amdgcn_mfma_f32_32x32x16_bf16(k1, qa[ks], a1, 0, 0, 0); b1 = __builtin_amdgcn_mfma_f32_32x32x16_bf16(k1, qb[ks], b1, 0, 0, 0); }
}
__device__ __forceinline__ void pv2(f32x16 (&oa)[2], f32x16 (&ob)[2], const bf16x8 (&pa)[4], const bf16x8 (&pb)[4], lcptr Vt, int lane) {
    const int h = lane >> 5, g = (lane >> 4) & 1, q = (lane & 15) >> 2, p = lane & 3;
    lcptr vb = Vt + (4 * h + q) * VS64 + (16 * g + 4 * p) * 2;
#pragma unroll
    for (int k = 0; k < 4; ++k)
#pragma unroll
        for (int d = 0; d < 2; ++d) { const s16x4 lo = vtr(vb + (16 * k) * VS64 + d * 64), hh = vtr(vb + (16 * k + 8) * VS64 + d * 64);
            const bf16x8 vf = (bf16x8){lo[0], lo[1], lo[2], lo[3], hh[0], hh[1], hh[2], hh[3]};
            oa[d] = __builtin_amdgcn_mfma_f32_32x32x16_bf16(vf, pa[k], oa[d], 0, 0, 0); ob[d] = __builtin_amdgcn_mfma_f32_32x32x16_bf16(vf, pb[k], ob[d], 0, 0, 0); }
}
__device__ __forceinline__ void bias_mask_near(f32x16& s0, f32x16& s1, const LAS float* bt, int t, int kp0, int hi, unsigned maxdist) {
#pragma unroll
    for (int q4 = 0; q4 < 4; ++q4) {
        float bb[8]; f32x16& s = (q4 & 2) ? s1 : s0; const int r0 = 8 * (q4 & 1), kq = kp0 + 32 * (q4 >> 1);
#pragma unroll
        for (int r = 0; r < 8; ++r) { const int d = t - (kq + crow(r0 + r, hi)); const unsigned ix = (unsigned)d < 127u ? (unsigned)d : 127u; bb[r] = bt[ix]; }
#pragma unroll
        for (int r = 0; r < 8; ++r) asm volatile("" : "+v"(bb[r]));
#pragma unroll
        for (int r = 0; r < 8; ++r) { const int d = t - (kq + crow(r0 + r, hi)); s[r0 + r] = ((unsigned)d < maxdist) ? s[r0 + r] + bb[r] : -INFINITY; }
    }
}
__device__ __forceinline__ void mask_all(f32x16& s0, f32x16& s1) {
#pragma unroll
    for (int r = 0; r < 16; ++r) { s0[r] = -INFINITY; s1[r] = -INFINITY; }
}
__device__ __forceinline__ void store_o64(bf16_t* orow, const f32x16 (&o)[2], float sc, int hi) {
#pragma unroll
    for (int d = 0; d < 2; ++d)
#pragma unroll
        for (int rg = 0; rg < 4; ++rg) { u32x2 w; w.x = pk2(o[d][4 * rg] * sc, o[d][4 * rg + 1] * sc); w.y = pk2(o[d][4 * rg + 2] * sc, o[d][4 * rg + 3] * sc);
            *(u32x2*)(orow + 32 * d + 8 * rg + 4 * hi) = w; }
}
__device__ __forceinline__ void store_o64_fp8(unsigned char* orow, const f32x16 (&o)[2], float sc, int hi) {
#pragma unroll
    for (int d = 0; d < 2; ++d)
#pragma unroll
        for (int rg = 0; rg < 4; ++rg) *(unsigned*)(orow + 32 * d + 8 * rg + 4 * hi) = pg8::pk4_fp8(o[d][4 * rg] * sc, o[d][4 * rg + 1] * sc, o[d][4 * rg + 2] * sc, o[d][4 * rg + 3] * sc);
}
template <class Src, class Proc> __device__ __forceinline__ void tile_loop64(int tid, lptr base, int nt, int pitch, Src src, Proc proc) {
    if (nt <= 0) return;
    const int row = tid >> 3, ch = tid & 7; u32x4 kr, vr;
    lptr Kb = base, Vb = base + 2 * KT64;
    { const bf16_t *kp, *vp; src(0, kp, vp); kr = *(const u32x4*)(kp + (size_t)row * pitch + ch * 8); vr = *(const u32x4*)(vp + (size_t)row * pitch + ch * 8); }
    *(LAS u32x4*)(Kb + row * KS64 + ch * 16) = kr; *(LAS u32x4*)(Vb + row * VS64 + ch * 16) = vr;
    __syncthreads();
    for (int i = 0; i < nt; ++i) {
        const bool more = i + 1 < nt;
        if (more) { const bf16_t *kp, *vp; src(i + 1, kp, vp); kr = *(const u32x4*)(kp + (size_t)row * pitch + ch * 8); vr = *(const u32x4*)(vp + (size_t)row * pitch + ch * 8); }
        proc(i, (lcptr)(Kb + (i & 1) * KT64), (lcptr)(Vb + (i & 1) * VT64));
        if (more) { *(LAS u32x4*)(Kb + ((i + 1) & 1) * KT64 + row * KS64 + ch * 16) = kr; *(LAS u32x4*)(Vb + ((i + 1) & 1) * VT64 + row * VS64 + ch * 16) = vr; }
        __syncthreads();
    }
}

template <int ROWB, int KSTR, int VSTR, int VAR = 0, class SrcK, class SrcV, class Score, class Accum>
__device__ __forceinline__ void tile_loop_p(int tid, lptr base, int nt, int pitch, SrcK srck, SrcV srcv, Score score, Accum accum) {
    if (nt <= 0) return;
    constexpr int CPR = ROWB / 16, NCH = (64 * CPR) / 512, KT = 64 * KSTR, VT = 64 * VSTR;
    lptr Kb = base, Vb = base + 2 * KT;
    u32x4 kr0[NCH], vr0[NCH], kr1[NCH], vr1[NCH];
    auto gld = [&](const bf16_t* p, u32x4 (&r)[NCH]) {
#pragma unroll
        for (int c = 0; c < NCH; ++c) { const int idx = tid + 512 * c, rr = idx / CPR, ch = idx % CPR; r[c] = *(const u32x4*)(p + (size_t)rr * pitch + ch * 8); } };
    auto lst = [&](lptr dst, int stride, const u32x4 (&r)[NCH]) {
#pragma unroll
        for (int c = 0; c < NCH; ++c) { const int idx = tid + 512 * c, rr = idx / CPR, ch = idx % CPR; *(LAS u32x4*)(dst + rr * stride + ch * 16) = r[c]; } };
    gld(srck(0), kr0); gld(srcv(0), vr0); lst(Kb, KSTR, kr0); lst(Vb, VSTR, vr0);
    if (nt > 1) { gld(srck(1), kr0); lst(Kb + KT, KSTR, kr0); }
    if (nt > 2) gld(srck(2), kr1);
    if (nt > 1) gld(srcv(1), vr1);
    __syncthreads();
    f32x16 a0, a1, b0, b1; bool aact = score(0, (lcptr)Kb, a0, a1), bact = false;
    auto step = [&](int i, f32x16& c0, f32x16& c1, bool& cact, f32x16& n0, f32x16& n1, bool& nact, u32x4 (&kL)[NCH], u32x4 (&vL)[NCH], u32x4 (&kS)[NCH], u32x4 (&vS)[NCH]) {
        const bool m1 = i + 1 < nt, m2 = i + 2 < nt, m3 = i + 3 < nt;
        if (VAR != 7) { if (m3) gld(srck(i + 3), kL);
        if (m2) gld(srcv(i + 2), vL); }
        nact = false;
        if (m1) nact = score(i + 1, (lcptr)(Kb + ((i + 1) & 1) * KT), n0, n1);
        if (cact) accum(i, (lcptr)(Vb + (i & 1) * VT), c0, c1);
        if (VAR != 7) { if (m2) lst(Kb + (i & 1) * KT, KSTR, kS);
        if (m1) lst(Vb + ((i + 1) & 1) * VT, VSTR, vS); }
        __syncthreads();
    };
    for (int i = 0; i < nt; i += 2) { step(i, a0, a1, aact, b0, b1, bact, kr0, vr0, kr1, vr1); if (i + 1 < nt) step(i + 1, b0, b1, bact, a0, a1, aact, kr1, vr1, kr0, vr0); }
}

template <int ROWB, int KSTR, int VSTR, class SrcK, class SrcV, class Score, class Accum>
__device__ __forceinline__ void tile_loop_pp(int tid, int grp, lptr base, int nt, int pitch, SrcK srck, SrcV srcv, Score score, Accum accum) {
    if (nt <= 0) return;
    constexpr int CPR = ROWB / 16, NCH = (64 * CPR) / 512, KT = 64 * KSTR, VT = 64 * VSTR;
    lptr Kb = base, Vb = base + 2 * KT;
    u32x4 kr0[NCH], vr0[NCH], kr1[NCH], vr1[NCH];
    auto gld = [&](const bf16_t* p, u32x4 (&r)[NCH]) {
#pragma unroll
        for (int c = 0; c < NCH; ++c) { const int idx = tid + 512 * c, rr = idx / CPR, ch = idx % CPR; r[c] = *(const u32x4*)(p + (size_t)rr * pitch + ch * 8); } };
    auto lst = [&](lptr dst, int stride, const u32x4 (&r)[NCH]) {
#pragma unroll
        for (int c = 0; c < NCH; ++c) { const int idx = tid + 512 * c, rr = idx / CPR, ch = idx % CPR; *(LAS u32x4*)(dst + rr * stride + ch * 16) = r[c]; } };
    gld(srck(0), kr0); gld(srcv(0), vr0); lst(Kb, KSTR, kr0); lst(Vb, VSTR, vr0);
    if (nt > 1) { gld(srck(1), kr0); gld(srcv(1), vr0); }
    if (nt > 2) { gld(srck(2), kr1); gld(srcv(2), vr1); }
    __syncthreads();
    f32x16 s0, s1; bool act = false;
    const int nslot = 2 * nt + 1;
    auto slot_fn = [&](int slot, u32x4 (&kS)[NCH], u32x4 (&vS)[NCH]) {
        const int my = slot - grp;
        if (my >= 0 && my < 2 * nt) { const int i = my >> 1;
            if (!(my & 1)) act = score(i, (lcptr)(Kb + (i & 1) * KT), s0, s1);
            else if (act) accum(i, (lcptr)(Vb + (i & 1) * VT), s0, s1); }
        if (slot & 1) { const int j = (slot >> 1) + 1;
            if (j < nt) { lst(Kb + (j & 1) * KT, KSTR, kS); lst(Vb + (j & 1) * VT, VSTR, vS); }
            if (j + 2 < nt) { gld(srck(j + 2), kS); gld(srcv(j + 2), vS); } }
        __syncthreads();
    };
    for (int slot = 0; slot < nslot; slot += 4) {
        slot_fn(slot, kr0, vr0);
        if (slot + 1 < nslot) slot_fn(slot + 1, kr0, vr0);
        if (slot + 2 < nslot) slot_fn(slot + 2, kr1, vr1);
        if (slot + 3 < nslot) slot_fn(slot + 3, kr1, vr1);
    }
}

template <int VAR = 0, class SrcK, class SrcV, class Post>
__device__ __forceinline__ void tile_loop_f(int tid, int lane, lptr base, int nt, int pitch, const bf16x8 (&qf)[4], f32x16 (&o)[2], float& l, SrcK srck, SrcV srcv, Post post) {
    if (nt <= 0) return;
    const int r32 = lane & 31, hi = lane >> 5;
    lptr Kb = base, Vb = base + 2 * KT64;
    const int rr = tid >> 3, ch = tid & 7;
    u32x4 kr0, vr0, kr1, vr1;
    auto gld = [&](const bf16_t* p) { return *(const u32x4*)(p + (size_t)rr * pitch + ch * 8); };
    kr0 = gld(srck(0)); vr0 = gld(srcv(0)); *(LAS u32x4*)(Kb + rr * KS64 + ch * 16) = kr0; *(LAS u32x4*)(Vb + rr * VS64 + ch * 16) = vr0;
    if (nt > 1) { kr0 = gld(srck(1)); *(LAS u32x4*)(Kb + KT64 + rr * KS64 + ch * 16) = kr0; }
    if (nt > 2) kr1 = gld(srck(2));
    if (nt > 1) vr1 = gld(srcv(1));
    __syncthreads();
    f32x16 a0, a1, b0, b1; bool aact, bact = false;
    qk<4>(a0, a1, (lcptr)Kb, KS64, qf, 0.f, r32, hi); aact = post(0, a0, a1);
    auto step = [&](int i, f32x16& c0, f32x16& c1, bool& cact, f32x16& n0, f32x16& n1, bool& nact, u32x4& kL, u32x4& vL, u32x4& kS, u32x4& vS) {
        const bool m1 = i + 1 < nt, m2 = i + 2 < nt, m3 = i + 3 < nt;
        if (m3) kL = gld(srck(i + 3));
        if (m2) vL = gld(srcv(i + 2));
        lcptr Kt = (lcptr)(Kb + ((i + 1) & 1) * KT64), Vt = (lcptr)(Vb + (i & 1) * VT64);
        if (m1 && cact) {
            lcptr p0 = Kt + r32 * KS64 + hi * 16; lcptr p1 = p0 + 32 * KS64;
            bf16x8 ka[4], kb[4];
#pragma unroll
            for (int ks = 0; ks < 4; ++ks) { if (VAR == 8 || VAR == 9) { ka[ks] = qf[ks]; kb[ks] = qf[3 - ks]; } else { ka[ks] = *(const LAS bf16x8*)(p0 + ks * 32); kb[ks] = *(const LAS bf16x8*)(p1 + ks * 32); } }
            n0 = splat16(0.f); n1 = splat16(0.f); float rs = 0.f;
            __builtin_amdgcn_sched_barrier(0);
#pragma unroll
            for (int ks = 0; ks < 4; ++ks) {
                n0 = __builtin_amdgcn_mfma_f32_32x32x16_bf16(ka[ks], qf[ks], n0, 0, 0, 0); n1 = __builtin_amdgcn_mfma_f32_32x32x16_bf16(kb[ks], qf[ks], n1, 0, 0, 0);
#pragma unroll
                for (int e = 0; e < 4; ++e) { c0[4 * ks + e] = ex2(c0[4 * ks + e]); c1[4 * ks + e] = ex2(c1[4 * ks + e]); rs += c0[4 * ks + e] + c1[4 * ks + e]; }
                __builtin_amdgcn_sched_barrier(0);
            }
            l += rs;
            if (VAR == 8 || VAR == 10) { const bf16x8 pk0 = pack_p(c0, 0), pk1 = pack_p(c0, 8), pk2_ = pack_p(c1, 0), pk3 = pack_p(c1, 8);
#pragma unroll
                for (int d = 0; d < 2; ++d) { o[d] = __builtin_amdgcn_mfma_f32_32x32x16_bf16(qf[0], pk0, o[d], 0, 0, 0); o[d] = __builtin_amdgcn_mfma_f32_32x32x16_bf16(qf[1], pk1, o[d], 0, 0, 0);
                    o[d] = __builtin_amdgcn_mfma_f32_32x32x16_bf16(qf[2], pk2_, o[d], 0, 0, 0); o[d] = __builtin_amdgcn_mfma_f32_32x32x16_bf16(qf[3], pk3, o[d], 0, 0, 0); } }
            else pv<2>(o, c0, c1, Vt, VS64, lane);
            nact = post(i + 1, n0, n1);
        } else {
            if (cact) { exp_step(c0, c1, l); pv<2>(o, c0, c1, Vt, VS64, lane); }
            nact = false;
            if (m1) { qk<4>(n0, n1, Kt, KS64, qf, 0.f, r32, hi); nact = post(i + 1, n0, n1); }
        }
        if (m2) *(LAS u32x4*)(Kb + (i & 1) * KT64 + rr * KS64 + ch * 16) = kS;
        if (m1) *(LAS u32x4*)(Vb + ((i + 1) & 1) * VT64 + rr * VS64 + ch * 16) = vS;
        __syncthreads();
    };
    for (int i = 0; i < nt; i += 2) { step(i, a0, a1, aact, b0, b1, bact, kr0, vr0, kr1, vr1); if (i + 1 < nt) step(i + 1, b0, b1, bact, a0, a1, aact, kr1, vr1, kr0, vr0); }
}
constexpr int TL64_BYTES = 2 * KT64 + 2 * VT64;
}

#ifndef PP_GRP
#define PP_GRP (w & 1)
#endif
template <int var> __device__ __forceinline__ void moba_unit(const Frame& F, int b, int h, int qb, const bf16_t* Q, const bf16_t* K, const bf16_t* V, const float* KMEAN, const float* BT, unsigned char* O8) {
    using namespace att;
    const int lane = F.lane, r32 = lane & 31, hi = lane >> 5, w = F.wave;
    lptr lds = (lptr)F.lds; lptr tl = lds; LAS float* BTL = (LAS float*)(lds + TL64_BYTES); lptr KM = lds + TL64_BYTES + 512;
    const int t = 256 * qb + 32 * w + r32; const size_t row = (size_t)b * SEQ + t;
    bf16x8 qf[4];
#pragma unroll
    for (int ks = 0; ks < 4; ++ks) qf[ks] = *(const bf16x8*)(Q + row * 1024 + h * 64 + 16 * ks + 8 * hi);
    if (F.tid < 128) BTL[F.tid] = BT[h * 128 + F.tid] - BT[h * 128 + 127];
    { const int idx = F.tid * 2, j = idx >> 6, d = idx & 63; const float* kmp = KMEAN + (size_t)(b * 16 + j) * 2048 + h * 64 + d;
      *(LAS unsigned*)(KM + j * KS64 + d * 2) = (j < qb) ? pk2(kmp[0] + kmp[1024], kmp[1] + kmp[1025]) : 0u;
      *(LAS unsigned*)(KM + (16 + j) * KS64 + d * 2) = 0u; }
    __syncthreads();
    unsigned selmask = 0u;
    if (qb > 0) {
        f32x16 gs = splat16(0.f);
        { lcptr p0 = (lcptr)KM + r32 * KS64 + hi * 16;
#pragma unroll
          for (int ks = 0; ks < 4; ++ks) { const bf16x8 k0 = *(const LAS bf16x8*)(p0 + ks * 32); gs = __builtin_amdgcn_mfma_f32_32x32x16_bf16(k0, qf[ks], gs, 0, 0, 0); } }
        float glo[8], ghi[8];
#pragma unroll
        for (int r = 0; r < 8; ++r) { const float mine = gs[r], oth = __shfl_xor(mine, 32); glo[r] = hi ? oth : mine; ghi[r] = hi ? mine : oth; }
#pragma unroll
        for (int rep = 0; rep < 3; ++rep) { float best = -INFINITY; int bj = -1;
#pragma unroll
            for (int j = 0; j < 16; ++j) { const int r = (j & 3) + 4 * (j >> 3); const float gv = ((j >> 2) & 1) ? ghi[r] : glo[r];
                if (j < qb && !((selmask >> j) & 1u) && gv > best) { best = gv; bj = j; } }
            if (bj >= 0) selmask |= 1u << bj; }
    }
    f32x16 o[2] = {splat16(0.f), splat16(0.f)}; float l = 0.f;
    const int nt = 4 * (qb + 1); const int twmax = 256 * qb + 32 * w + 31;
    const bf16_t* Kh = K + (size_t)b * SEQ * 1024 + h * 64; const bf16_t* Vh = V + (size_t)b * SEQ * 1024 + h * 64;
    tile_loop_f<var>(F.tid, lane, tl, nt, 1024, qf, o, l,
        [&](int i) { return Kh + (size_t)(64 * i) * 1024; }, [&](int i) { return Vh + (size_t)(64 * i) * 1024; },
        [&](int i, f32x16& s0, f32x16& s1) -> bool {
            const int blk = i >> 2, kp0 = 64 * i;
            if (blk < qb) {
                const bool sel = (selmask >> blk) & 1u;
                if (!__any(sel)) return false;
                if (!(blk < qb - 1 || (i & 3) < 2)) bias_mask_near(s0, s1, BTL, t, kp0, hi, 0x7fffffffu);
                if (!sel) mask_all(s0, s1);
            } else {
                if (kp0 > twmax) return false;
                bias_mask_near(s0, s1, BTL, t, kp0, hi, 0x7fffffffu);
            }
            return true; });
    l += __shfl_xor(l, 32);
    store_o64_fp8(O8 + row * 1024 + h * 64, o, l > 0.f ? OSC / l : 0.f, hi);
}
__device__ __forceinline__ void phase_moba(const Frame& F, unsigned char* ws, int var) {
    const bf16_t* Q = (const bf16_t*)(ws + OFF_QKV); const bf16_t* K = Q + (size_t)MTOK * 1024; const bf16_t* V = K + (size_t)MTOK * 1024;
    const float* KMEAN = (const float*)(ws + OFF_KMEAN); const float* BT = (const float*)(ws + OFF_BT);
    for (int idx = F.bx; idx < 2048; idx += F.G) { const int i = idx >> 8, v = idx & 255, x = v & 7, j = v >> 3, bh = 16 * x + 2 * i + (j >> 4), b = bh >> 4, h = bh & 15, p = ((j & 15) + 4 * (i >> 1)) & 15, qb = (i & 1) ? 15 - p : p;

#ifdef MOBA_VAR
        if (var == MOBA_VAR) moba_unit<MOBA_VAR>(F, b, h, qb, Q, K, V, KMEAN, BT, ws + OFF_O8); else
#endif
        moba_unit<0>(F, b, h, qb, Q, K, V, KMEAN, BT, ws + OFF_O8);
        __syncthreads(); }
}

constexpr int MB_KB = 0, MB_VB = 256 * att::KS64, MB_SELM = MB_VB + 256 * att::VS64, MB_LIST = MB_SELM + 4096, MB_CNT = MB_LIST + 12800, MB_FILL = MB_CNT + 64, MB_LOFF = MB_FILL + 64,
              MB_BTL = MB_LOFF + 128, MB_KM = MB_BTL + 512, MB_QC = MB_KM + 32 * att::KS64, MB_END = MB_QC + 64;
constexpr int MST_ROW = 136;
__device__ __forceinline__ void moba2_unit(const Frame& F, int b, int h, int par, int unit, const bf16_t* Q, const bf16_t* K, const bf16_t* V, const float* KMEAN, const float* BT, unsigned char* O8, unsigned char* MST) {
    using namespace att;
    int tid = F.tid; asm volatile("" : "+v"(tid));
    const int lane = tid & 63, lane_ = lane, r32 = lane & 31, hi = lane >> 5, w = F.wave;
    lptr lds = (lptr)F.lds; lptr KB = lds + MB_KB, VB = lds + MB_VB; LAS unsigned short* SELM = (LAS unsigned short*)(lds + MB_SELM); LAS unsigned short* LIST = (LAS unsigned short*)(lds + MB_LIST);
    LAS int* CNT = (LAS int*)(lds + MB_CNT); LAS int* FILL = (LAS int*)(lds + MB_FILL); LAS int* LOFF = (LAS int*)(lds + MB_LOFF); LAS float* BTL = (LAS float*)(lds + MB_BTL); lptr KM = lds + MB_KM;
    unsigned char* ST = MST + (size_t)unit * 2048 * MST_ROW;
    const bf16_t* Qh = Q + (size_t)b * SEQ * 1024 + h * 64; const bf16_t* Kh = K + (size_t)b * SEQ * 1024 + h * 64; const bf16_t* Vh = V + (size_t)b * SEQ * 1024 + h * 64;
    if (tid < 128) BTL[tid] = BT[h * 128 + tid] - BT[h * 128 + 127];
    { const int idx = tid * 2, j = idx >> 6, d = idx & 63; const float* kmp = KMEAN + (size_t)(b * 16 + j) * 2048 + h * 64 + d;
      *(LAS unsigned*)(KM + j * KS64 + d * 2) = pk2(kmp[0] + kmp[1024], kmp[1] + kmp[1025]); *(LAS unsigned*)(KM + (16 + j) * KS64 + d * 2) = 0u; }
    LAS int* QC = (LAS int*)(lds + MB_QC);
    if (tid < 16) { CNT[tid] = 0; FILL[tid] = 0; QC[tid] = 0; }
    for (int i = tid; i < 2048 * MST_ROW / 16; i += NTHR) ((u32x4*)ST)[i] = (u32x4){0u, 0u, 0u, 0u};
    __syncthreads();
#pragma unroll 1
    for (int m8 = 0; m8 < 8; ++m8) { const int gi = w + 8 * m8, k = gi >> 3, sub = gi & 7, qb = 2 * k + par, q = 32 * sub + r32; const size_t trow = (size_t)(256 * qb + q);
        unsigned selmask = 0u;
        if (qb > 0) {
            bf16x8 qf[4];
#pragma unroll
            for (int ks = 0; ks < 4; ++ks) qf[ks] = *(const bf16x8*)(Qh + trow * 1024 + 16 * ks + 8 * hi);
            f32x16 gs = splat16(0.f);
            { lcptr p0 = (lcptr)KM + r32 * KS64 + hi * 16;
#pragma unroll
              for (int ks = 0; ks < 4; ++ks) { const bf16x8 k0 = *(const LAS bf16x8*)(p0 + ks * 32); gs = __builtin_amdgcn_mfma_f32_32x32x16_bf16(k0, qf[ks], gs, 0, 0, 0); } }
            float glo[8], ghi[8];
#pragma unroll
            for (int r = 0; r < 8; ++r) { const float mine = gs[r], oth = __shfl_xor(mine, 32); glo[r] = hi ? oth : mine; ghi[r] = hi ? mine : oth; }
#pragma unroll
            for (int rep = 0; rep < 3; ++rep) { float best = -INFINITY; int bj = -1;
#pragma unroll
                for (int j = 0; j < 16; ++j) { const int r = (j & 3) + 4 * (j >> 3); const float gv = ((j >> 2) & 1) ? ghi[r] : glo[r];
                    if (j < qb && !((selmask >> j) & 1u) && gv > best) { best = gv; bj = j; } }
                if (bj >= 0) selmask |= 1u << bj; }
        }
        if (hi == 0) { SELM[k * 256 + q] = (unsigned short)selmask; unsigned mm = selmask; while (mm) { const int j = __builtin_ctz(mm); mm &= mm - 1u; __hip_atomic_fetch_add(CNT + j, 1, __ATOMIC_RELAXED, __HIP_MEMORY_SCOPE_WORKGROUP); } }
    }
    __syncthreads();
    if (tid == 0) { int acc = 0; for (int j = 0; j < 16; ++j) { LOFF[j] = acc; acc += CNT[j]; } LOFF[16] = acc; }
    __syncthreads();
    for (int lq = tid; lq < 2048; lq += NTHR) { unsigned mm = SELM[lq]; while (mm) { const int j = __builtin_ctz(mm); mm &= mm - 1u; const int pos = __hip_atomic_fetch_add(FILL + j, 1, __ATOMIC_RELAXED, __HIP_MEMORY_SCOPE_WORKGROUP); LIST[LOFF[j] + pos] = (unsigned short)lq; } }
    u32x4 kreg[4], vreg[4];
    auto gblk = [&](int j) { int td = tid; asm volatile("" : "+v"(td));
#pragma unroll
        for (int i = 0; i < 4; ++i) { const int c = td + 512 * i, rr = c >> 3, ch = c & 7; kreg[i] = *(const u32x4*)(Kh + (size_t)(256 * j + rr) * 1024 + ch * 8); vreg[i] = *(const u32x4*)(Vh + (size_t)(256 * j + rr) * 1024 + ch * 8); } };
    gblk(0);
    __syncthreads();
    for (int j = 0; j < 16; ++j) {
        { int td = tid; asm volatile("" : "+v"(td));
#pragma unroll
        for (int i = 0; i < 4; ++i) { const int c = td + 512 * i, rr = c >> 3, ch = c & 7; *(LAS u32x4*)(KB + rr * KS64 + ch * 16) = kreg[i]; *(LAS u32x4*)(VB + rr * VS64 + ch * 16) = vreg[i]; } }
        __syncthreads();
        gblk(j + 1 < 16 ? j + 1 : 15);
        const int nj = CNT[j], ngp = (nj + 31) >> 5, ngo = ((j & 1) == par) ? 8 : 0;
        const int nit = ngo + ngp;
        auto grab = [&]() { int it = 0; if (lane == 0) it = __hip_atomic_fetch_add(QC + j, 1, __ATOMIC_RELAXED, __HIP_MEMORY_SCOPE_WORKGROUP); return __builtin_amdgcn_readfirstlane(it); };
        auto decode = [&](int it, int& t, int& lq, bool& va) {
            if (it < ngo) { const int gidx = ngo - 1 - it; lq = (j >> 1) * 256 + 32 * gidx + r32; t = 256 * j + 32 * gidx + r32; va = true; }
            else { const int gidx = it - ngo, sa = 32 * gidx + r32; va = sa < nj; lq = LIST[LOFF[j] + (va ? sa : 32 * gidx)]; t = 256 * (2 * (lq >> 8) + par) + (lq & 255); } };
        auto issue = [&](int t, int lq, bf16x8 (&q)[4], unsigned long long (&st)[8], float& stl) {
#pragma unroll
            for (int ks = 0; ks < 4; ++ks) q[ks] = *(const bf16x8*)(Qh + (size_t)t * 1024 + 16 * ks + 8 * hi);
            const unsigned char* strow = ST + (size_t)lq * MST_ROW;
#pragma unroll
            for (int d = 0; d < 2; ++d)
#pragma unroll
                for (int rg = 0; rg < 4; ++rg) st[4 * d + rg] = __hip_atomic_load((const unsigned long long*)(strow + (32 * d + 8 * rg + 4 * hi) * 2), __ATOMIC_RELAXED, __HIP_MEMORY_SCOPE_AGENT);
            stl = __hip_atomic_load((const float*)(strow + 128), __ATOMIC_RELAXED, __HIP_MEMORY_SCOPE_AGENT); };
        int it = grab(), t = 0, lq = 0; bool va = false; bf16x8 qc[4] = {}; unsigned long long stc[8] = {}; float stlc = 0.f;
        if (it < nit) { decode(it, t, lq, va); issue(t, lq, qc, stc, stlc); }
        while (it < nit) {
            const int itn = grab(); int tn = 0, lqn = 0; bool van = false; bf16x8 qn[4] = {}; unsigned long long stn[8] = {}; float stln = 0.f;
            if (itn < nit) { decode(itn, tn, lqn, van); issue(tn, lqn, qn, stn, stln); }
            const bool own = it < ngo; const int ntile = own ? ((32 * (ngo - 1 - it) + 31) >> 6) + 1 : 4;
            const bool nearany = own || __any((t >> 8) == j + 1);
            f32x16 o[2] = {splat16(0.f), splat16(0.f)}; float l = 0.f;
            for (int i = 0; i < ntile; ++i) { f32x16 s0, s1;
                qk<4>(s0, s1, (lcptr)(KB + i * KT64), KS64, qc, 0.f, r32, hi);
                if (nearany && (own || i >= 2)) bias_mask_near(s0, s1, BTL, t, 256 * j + 64 * i, hi, 0x7fffffffu);
                exp_step(s0, s1, l); pv<2>(o, s0, s1, (lcptr)(VB + i * VT64), VS64, lane); }
            l += __shfl_xor(l, 32);
            unsigned char* strow = ST + (size_t)lq * MST_ROW;
            if (own) {
                const float lt = l + stlc; const float f = lt > 0.f ? OSC / lt : 0.f;
                unsigned char* orow = O8 + ((size_t)b * SEQ + t) * 1024 + h * 64;
#pragma unroll
                for (int d = 0; d < 2; ++d)
#pragma unroll
                    for (int rg = 0; rg < 4; ++rg) { const unsigned w0 = (unsigned)stc[4 * d + rg], w1 = (unsigned)(stc[4 * d + rg] >> 32);
                        *(unsigned*)(orow + 32 * d + 8 * rg + 4 * hi) = pg8::pk4_fp8((o[d][4 * rg] + bflo(w0)) * f, (o[d][4 * rg + 1] + bfhi(w0)) * f, (o[d][4 * rg + 2] + bflo(w1)) * f, (o[d][4 * rg + 3] + bfhi(w1)) * f); }
            } else if (va) {
#pragma unroll
                for (int d = 0; d < 2; ++d)
#pragma unroll
                    for (int rg = 0; rg < 4; ++rg) { const unsigned w0 = (unsigned)stc[4 * d + rg], w1 = (unsigned)(stc[4 * d + rg] >> 32);
                        const unsigned n0 = pk2(o[d][4 * rg] + bflo(w0), o[d][4 * rg + 1] + bfhi(w0)), n1 = pk2(o[d][4 * rg + 2] + bflo(w1), o[d][4 * rg + 3] + bfhi(w1));
                        *(unsigned long long*)(strow + (32 * d + 8 * rg + 4 * hi) * 2) = (unsigned long long)n0 | ((unsigned long long)n1 << 32); }
                if (hi == 0) *(float*)(strow + 128) = stlc + l;
            }
            it = itn; t = tn; lq = lqn; va = van; stlc = stln;
#pragma unroll
            for (int k = 0; k < 4; ++k) qc[k] = qn[k];
#pragma unroll
            for (int k = 0; k < 8; ++k) stc[k] = stn[k];
        }
        __syncthreads();
    }
}
__device__ __forceinline__ void phase_moba2(const Frame& F, unsigned char* ws) {
    const bf16_t* Q = (const bf16_t*)(ws + OFF_QKV); const bf16_t* K = Q + (size_t)MTOK * 1024; const bf16_t* V = K + (size_t)MTOK * 1024;
    const float* KMEAN = (const float*)(ws + OFF_KMEAN); const float* BT = (const float*)(ws + OFF_BT);
    for (int v = F.bx; v < 256; v += F.G) { const int x = v & 7, jj = v >> 3, pair = 16 * x + (jj >> 1), par = jj & 1;
        moba2_unit(F, pair >> 4, pair & 15, par, v, Q, K, V, KMEAN, BT, ws + OFF_O8, ws + OFF_MST); __syncthreads(); }
}

__device__ __forceinline__ void nsa_unit(const Frame& F, int b, int g, int c, const bf16_t* Y1, const bf16_t* KC, const bf16_t* VC, const float* BT, unsigned char* MIXIN) {
    using namespace att;
    const int lane = F.lane, r32 = lane & 31, hi = lane >> 5, w = F.wave;
    lptr lds = (lptr)F.lds; lptr tl = lds; LAS float* BTL = (LAS float*)(lds + TL64_BYTES);
    LAS float* SCB = (LAS float*)(lds + TL64_BYTES + 2048);
    LAS unsigned long long* SELM = (LAS unsigned long long*)(lds + TL64_BYTES + 2048 + 16384);
    lptr OFL = lds + TL64_BYTES + 2048 + 16384 + 1024 + w * 8704 + r32 * 272 + hi * 16;
    const int n = r32 & 3, tok = 8 * w + (r32 >> 2), t = 64 * c + tok; const size_t row = (size_t)b * SEQ + t;
    const bf16_t* T1 = Y1 + (size_t)1 * MTOK * 256; const bf16_t* QB = Y1 + (size_t)(2 + g) * MTOK * 256;
    const bf16_t* KVS = Y1 + (size_t)5 * MTOK * 256; const bf16_t* KVW = Y1 + (size_t)6 * MTOK * 256;
    bf16x8 qf[4];
#pragma unroll
    for (int ks = 0; ks < 4; ++ks) qf[ks] = *(const bf16x8*)(QB + row * 256 + n * 64 + 16 * ks + 8 * hi);
    float gate[3];
#pragma unroll
    for (int j = 0; j < 3; ++j) { const float x = bf2f(T1[row * 256 + 208 + (4 * g + n) * 3 + j]); gate[j] = 1.f / (1.f + __expf(-x)); }
    for (int i = F.tid; i < 512; i += NTHR) BTL[i] = BT[(8 + 4 * g) * 128 + i] - BT[(8 + 4 * g) * 128 + (i | 127)];
    for (int i = F.tid; i < 4096; i += NTHR) SCB[i] = 0.f;
    __syncthreads();
    const LAS float* bt = BTL + n * 128; const float cfar = 0.f;
    const int vis = (t >= 31) ? ((t - 31) >> 4) : -1;
    const int ntc = ((4 * c + 2) >> 6) + 1;
    const bf16_t* KCg = KC + ((size_t)b * 256 * 2 + g) * 64; const bf16_t* VCg = VC + ((size_t)b * 256 * 2 + g) * 64;
    auto cmp_scores = [&](int i, lcptr Kt, f32x16& s0, f32x16& s1) {
        qk<4>(s0, s1, Kt, KS64, qf, 0.f, r32, hi);
#pragma unroll
        for (int half = 0; half < 2; ++half) { float bb[16]; f32x16& s = half ? s1 : s0;
#pragma unroll
            for (int r = 0; r < 16; ++r) { const int cc = 64 * i + 32 * half + crow(r, hi); const int d = t - 16 * cc - 31; const unsigned ix = (unsigned)d < 127u ? (unsigned)d : 127u; bb[r] = bt[ix]; }
#pragma unroll
            for (int r = 0; r < 16; ++r) asm volatile("" : "+v"(bb[r]));
#pragma unroll
            for (int r = 0; r < 16; ++r) { const int cc = 64 * i + 32 * half + crow(r, hi); s[r] = (cc <= vis) ? s[r] + bb[r] : -INFINITY; } }
    };
    float mc = NEG_BIG, lc = 0.f;
    tile_loop64(F.tid, tl, ntc, 128,
        [&](int i, const bf16_t*& kp, const bf16_t*& vp) { kp = KCg + (size_t)(64 * i) * 128; vp = VCg + (size_t)(64 * i) * 128; },
        [&](int i, lcptr Kt, lcptr Vt) { f32x16 s0, s1; cmp_scores(i, Kt, s0, s1);
            const float mn = fmaxf(mc, rowmax32(s0, s1)); float rs = 0.f;
#pragma unroll
            for (int r = 0; r < 16; ++r) rs += ex2(s0[r] - mn) + ex2(s1[r] - mn);
            lc = lc * ex2(mc - mn) + rs; mc = mn; });
    lc += __shfl_xor(lc, 32);
    const float invc = lc > 0.f ? 1.f / lc : 0.f;
    {
        f32x16 o[2] = {splat16(0.f), splat16(0.f)}; float carry = 0.f;
        tile_loop64(F.tid, tl, ntc, 128,
            [&](int i, const bf16_t*& kp, const bf16_t*& vp) { kp = KCg + (size_t)(64 * i) * 128; vp = VCg + (size_t)(64 * i) * 128; },
            [&](int i, lcptr Kt, lcptr Vt) { f32x16 s0, s1; cmp_scores(i, Kt, s0, s1);
#pragma unroll
                for (int r = 0; r < 16; ++r) { s0[r] = ex2(s0[r] - mc) * invc; s1[r] = ex2(s1[r] - mc) * invc; }
                float x0[4], x1[4];
#pragma unroll
                for (int rg = 0; rg < 4; ++rg) { x0[rg] = __shfl_xor(s0[4 * rg + 3], 32); x1[rg] = __shfl_xor(s1[4 * rg + 3], 32); }
#pragma unroll
                for (int rg = 0; rg < 4; ++rg) {
                    float g0 = (s0[4 * rg] + s0[4 * rg + 1]) + (s0[4 * rg + 2] + s0[4 * rg + 3]), g1 = (s1[4 * rg] + s1[4 * rg + 1]) + (s1[4 * rg + 2] + s1[4 * rg + 3]);
                    const float e0 = hi ? x0[rg] : (rg > 0 ? x0[rg > 0 ? rg - 1 : 0] : carry), e1 = hi ? x1[rg] : (rg > 0 ? x1[rg > 0 ? rg - 1 : 0] : x0[3]);
                    g0 += e0; g1 += e1;
                    g0 += __shfl_xor(g0, 1); g0 += __shfl_xor(g0, 2); g1 += __shfl_xor(g1, 1); g1 += __shfl_xor(g1, 2);
                    if (n == 0) { SCB[tok * 64 + 16 * i + 2 * rg + hi] = g0; SCB[tok * 64 + 16 * i + 8 + 2 * rg + hi] = g1; }
                }
                carry = x1[3];
                pv<2>(o, s0, s1, Vt, VS64, lane); });
#pragma unroll
        for (int d = 0; d < 2; ++d)
#pragma unroll
            for (int rg = 0; rg < 4; ++rg) *(LAS f32x4*)(OFL + d * 128 + rg * 32) = (f32x4){o[d][4 * rg], o[d][4 * rg + 1], o[d][4 * rg + 2], o[d][4 * rg + 3]} * gate[0];
    }
    {
        unsigned long long uni = 0ull;
#pragma unroll 1
        for (int tk = 0; tk < 8; ++tk) { const int tk2 = 8 * w + tk; float v = SCB[tk2 * 64 + lane];
            v = (lane > c) ? -INFINITY : ((lane == 0 || lane == c || lane == c - 1) ? INFINITY : v);
            int cnt = 0;
#pragma unroll
            for (int j = 0; j < 64; ++j) { const float vj = __builtin_bit_cast(float, __builtin_amdgcn_readlane(__builtin_bit_cast(int, v), j)); cnt += (vj > v || (vj == v && j < lane)) ? 1 : 0; }
            const unsigned long long mk = __ballot(cnt < 16 && lane <= c);
            if (lane == 0) SELM[tk2] = mk;
            uni |= mk; }
        if (lane == 0) SELM[64 + w] = uni;
    }
    __syncthreads();
    const unsigned long long mymask = SELM[tok];
    unsigned long long uni = 0ull;
#pragma unroll
    for (int k = 0; k < 8; ++k) uni |= SELM[64 + k];
    {
        f32x16 o[2] = {splat16(0.f), splat16(0.f)}; float l = 0.f;
        const int nsel = __popcll(uni);
        const bf16_t* Kg = KVS + (size_t)b * SEQ * 256 + g * 64; const bf16_t* Vg = Kg + 128;
        LAS unsigned char* LIST = (LAS unsigned char*)(SELM + 72);
        if (F.tid < 64 && ((uni >> F.tid) & 1ull)) LIST[__popcll(uni & ((1ull << F.tid) - 1ull))] = (unsigned char)F.tid;
        __syncthreads();
        tile_loop64(F.tid, tl, nsel, 256,
            [&](int i, const bf16_t*& kp, const bf16_t*& vp) { const int j = LIST[i]; kp = Kg + (size_t)(64 * j) * 256; vp = Vg + (size_t)(64 * j) * 256; },
            [&](int i, lcptr Kt, lcptr Vt) { const int j = LIST[i];
                const bool sel = (mymask >> j) & 1ull;
                if (!__any(sel)) return;
                f32x16 s0, s1; qk<4>(s0, s1, Kt, KS64, qf, 0.f, r32, hi);
                if (j >= c - 2) bias_mask_near(s0, s1, bt, t, 64 * j, hi, 0x7fffffffu);
                if (!sel) mask_all(s0, s1);
                exp_step(s0, s1, l); pv<2>(o, s0, s1, Vt, VS64, lane); });
        l += __shfl_xor(l, 32); const float f = gate[1] * (l > 0.f ? 1.f / l : 0.f);
#pragma unroll
        for (int d = 0; d < 2; ++d)
#pragma unroll
            for (int rg = 0; rg < 4; ++rg) *(LAS f32x4*)(OFL + d * 128 + rg * 32) += (f32x4){o[d][4 * rg], o[d][4 * rg + 1], o[d][4 * rg + 2], o[d][4 * rg + 3]} * f;
    }
    {
        f32x16 o[2] = {splat16(0.f), splat16(0.f)}; float l = 0.f;
        const int k0 = c >= 8 ? c - 8 : 0, ntw = c - k0 + 1;
        const bf16_t* Kg = KVW + (size_t)b * SEQ * 256 + g * 64; const bf16_t* Vg = Kg + 128;
        tile_loop64(F.tid, tl, ntw, 256,
            [&](int i, const bf16_t*& kp, const bf16_t*& vp) { kp = Kg + (size_t)(64 * (k0 + i)) * 256; vp = Vg + (size_t)(64 * (k0 + i)) * 256; },
            [&](int i, lcptr Kt, lcptr Vt) { const int kt = k0 + i; f32x16 s0, s1; qk<4>(s0, s1, Kt, KS64, qf, 0.f, r32, hi);
                if (!(kt < c - 2 && kt > c - 8)) bias_mask_near(s0, s1, bt, t, 64 * kt, hi, 512u);
                exp_step(s0, s1, l); pv<2>(o, s0, s1, Vt, VS64, lane); });
        l += __shfl_xor(l, 32); const float f = gate[2] * (l > 0.f ? 1.f / l : 0.f);
        unsigned char* orow = MIXIN + row * 1536 + 1024 + (4 * g + n) * 64;
#pragma unroll
        for (int d = 0; d < 2; ++d)
#pragma unroll
            for (int rg = 0; rg < 4; ++rg) { const f32x4 v = (*(LAS f32x4*)(OFL + d * 128 + rg * 32) + (f32x4){o[d][4 * rg], o[d][4 * rg + 1], o[d][4 * rg + 2], o[d][4 * rg + 3]} * f) * OSC;
                *(unsigned*)(orow + 32 * d + 8 * rg + 4 * hi) = pg8::pk4_fp8(v[0], v[1], v[2], v[3]); }
    }
}

__device__ __forceinline__ void dsa_unit(const Frame& F, int b, int u, const bf16_t* QLAT, const bf16_t* CKVN, const unsigned* MASK, const float* BT, unsigned char* MIXIN) {
    using namespace att;
    const int lane = F.lane, r32 = lane & 31, hi = lane >> 5, w = F.wave, tid = F.tid;
    lptr lds = (lptr)F.lds; lptr Kb = lds, Vb = lds + 2 * KT128; LAS float* BTL = (LAS float*)(lds + 2 * KT128 + 2 * VT128);
    const int head = r32 & 7, q0 = 32 * u, t = q0 + 4 * w + (r32 >> 3); const size_t row = (size_t)b * SEQ + t;
    bf16x8 qf[8];
#pragma unroll
    for (int ks = 0; ks < 8; ++ks) qf[ks] = *(const bf16x8*)(QLAT + row * 1024 + head * 128 + 16 * ks + 8 * hi);
    for (int i = tid; i < 1024; i += NTHR) BTL[i] = BT[i] - BT[i | 127];
    const LAS float* bt = BTL + head * 128;
    f32x16 o[4] = {splat16(0.f), splat16(0.f), splat16(0.f), splat16(0.f)}; float l = 0.f;
    const int nt = ((q0 + 31) >> 6) + 1;
    const bf16_t* Cb = CKVN + (size_t)b * SEQ * 128; const unsigned* mrow = MASK + row * 128;
    u32x4 st[2];
    auto gload = [&](int i) {
#pragma unroll
        for (int k = 0; k < 2; ++k) { const int idx = tid + 512 * k, rr = idx >> 4, ch = idx & 15; st[k] = *(const u32x4*)(Cb + (size_t)(64 * i + rr) * 128 + ch * 8); } };
    auto lstore = [&](int i) { lptr kd = Kb + (i & 1) * KT128, vd = Vb + (i & 1) * VT128;
#pragma unroll
        for (int k = 0; k < 2; ++k) { const int idx = tid + 512 * k, rr = idx >> 4, ch = idx & 15; *(LAS u32x4*)(kd + rr * KS128 + ch * 16) = st[k]; *(LAS u32x4*)(vd + rr * VS128 + ch * 16) = st[k]; } };
    auto score = [&](int i, f32x16& s0, f32x16& s1) {
        lcptr Kt = (lcptr)(Kb + (i & 1) * KT128);
        const u32x2 mw = *(const u32x2*)(mrow + 2 * i);
        qk<8>(s0, s1, Kt, KS128, qf, 0.f, r32, hi);
        const unsigned w0 = mw.x >> (4 * hi), w1 = mw.y >> (4 * hi);
        if ((q0 - (64 * i + 63)) < 128) {
#pragma unroll
            for (int r = 0; r < 16; ++r) { const int d0 = t - (64 * i + crow(r, hi)), d1 = d0 - 32;
                const unsigned i0 = (unsigned)d0 < 127u ? (unsigned)d0 : 127u, i1 = (unsigned)d1 < 127u ? (unsigned)d1 : 127u;
                s0[r] += bt[i0]; s1[r] += bt[i1]; }
        }
#pragma unroll
        for (int r = 0; r < 16; ++r) { const int bit = (r & 3) + 8 * (r >> 2);
            const int m0 = __builtin_amdgcn_sbfe((int)w0, bit, 1), m1 = __builtin_amdgcn_sbfe((int)w1, bit, 1);
            const float a0 = s0[r], a1 = s1[r];
            s0[r] = __int_as_float((__float_as_int(a0) & m0) | ((int)0xff800000 & ~m0));
            s1[r] = __int_as_float((__float_as_int(a1) & m1) | ((int)0xff800000 & ~m1)); }
    };
    u32x4 st2[2];
    gload(0); lstore(0);
    if (nt > 1) gload(1);
    __syncthreads();
    auto step = [&](int i, u32x4 (&sL)[2], u32x4 (&sS)[2]) {
        if (i + 2 < nt) {
#pragma unroll
            for (int k = 0; k < 2; ++k) { const int idx = tid + 512 * k, rr = idx >> 4, ch = idx & 15; sL[k] = *(const u32x4*)(Cb + (size_t)(64 * (i + 2) + rr) * 128 + ch * 8); } }
        f32x16 s0, s1; score(i, s0, s1);
        exp_step(s0, s1, l); pv<4>(o, s0, s1, (lcptr)(Vb + (i & 1) * VT128), VS128, lane);
        if (i + 1 < nt) { lptr kd = Kb + ((i + 1) & 1) * KT128, vd = Vb + ((i + 1) & 1) * VT128;
#pragma unroll
            for (int k = 0; k < 2; ++k) { const int idx = tid + 512 * k, rr = idx >> 4, ch = idx & 15; *(LAS u32x4*)(kd + rr * KS128 + ch * 16) = sS[k]; *(LAS u32x4*)(vd + rr * VS128 + ch * 16) = sS[k]; } }
        __syncthreads();
    };
    for (int i = 0; i < nt; i += 2) { step(i, st2, st); if (i + 1 < nt) step(i + 1, st, st2); }
    l += __shfl_xor(l, 32); const float f = l > 0.f ? OSC / l : 0.f;
    unsigned char* orow = MIXIN + row * 1536 + head * 128;
#pragma unroll
    for (int d = 0; d < 4; ++d)
#pragma unroll
        for (int rg = 0; rg < 4; ++rg) *(unsigned*)(orow + 32 * d + 8 * rg + 4 * hi) = pg8::pk4_fp8(o[d][4 * rg] * f, o[d][4 * rg + 1] * f, o[d][4 * rg + 2] * f, o[d][4 * rg + 3] * f);
}

constexpr int DS_TILE = 32 * att::KS128, DS_WAVE = 2 * DS_TILE + 640;
__device__ __forceinline__ void dsa_query(int lane, int b, int t, u32x2 mw, att::lptr base, const LAS float* BTL, const bf16_t* QLAT, const bf16_t* CKVN, unsigned char* MIXIN) {
    using namespace att;
    const int r32 = lane & 31, hi = lane >> 5, head = r32 & 7; const size_t row = (size_t)b * SEQ + t;
    LAS unsigned short* LIST = (LAS unsigned short*)(base + 2 * DS_TILE);
    bf16x8 qf[8];
#pragma unroll
    for (int ks = 0; ks < 8; ++ks) qf[ks] = *(const bf16x8*)(QLAT + row * 1024 + head * 128 + 16 * ks + 8 * hi);
    int n;
    { unsigned long long bits = (lane <= (t >> 6)) ? ((unsigned long long)mw.x | ((unsigned long long)mw.y << 32)) : 0ull;
      const int cnt = __popcll(bits); int pre = cnt;
#pragma unroll
      for (int o = 1; o < 64; o <<= 1) { const int v = __shfl_up(pre, o); if (lane >= o) pre += v; }
      n = __builtin_amdgcn_readlane(pre, 63); int pos = pre - cnt;
      while (bits) { const int j = __builtin_ctzll(bits); bits &= bits - 1ull; LIST[pos++] = (unsigned short)(64 * lane + j); }
      if (lane < 32) LIST[n + lane] = 0; }
    const bf16_t* Cb = CKVN + (size_t)b * SEQ * 128; const LAS float* bt = BTL + head * 128;
    const int ntile = (n + 31) >> 5;
    f32x16 o[4] = {splat16(0.f), splat16(0.f), splat16(0.f), splat16(0.f)}; float l = 0.f;
    u32x4 ra[8];
    auto gath = [&](int i, u32x4 (&r)[8]) {
#pragma unroll
        for (int k = 0; k < 8; ++k) { const int c = lane + 64 * k, rw = c >> 4, ch = c & 15; const int idx = LIST[32 * i + rw]; r[k] = *(const u32x4*)(Cb + (size_t)idx * 128 + ch * 8); } };
    auto put = [&](lptr T, const u32x4 (&r)[8]) {
#pragma unroll
        for (int k = 0; k < 8; ++k) { const int c = lane + 64 * k, rw = c >> 4, ch = c & 15; *(LAS u32x4*)(T + rw * KS128 + ch * 16) = r[k]; } };
    const int hq = lane >> 5, g = (lane >> 4) & 1, q4 = (lane & 15) >> 2, p4 = lane & 3;
    auto tile = [&](int i) {
        lcptr T = (lcptr)(base + (i & 1) * DS_TILE);
        f32x16 s = splat16(0.f);
        { lcptr p0 = T + r32 * KS128 + hi * 16;
#pragma unroll
          for (int ks = 0; ks < 8; ++ks) { const bf16x8 kf = *(const LAS bf16x8*)(p0 + ks * 32); s = __builtin_amdgcn_mfma_f32_32x32x16_bf16(kf, qf[ks], s, 0, 0, 0); } }
        const int lastslot = (32 * i + 31 < n) ? 32 * i + 31 : n - 1;
        if (32 * i + 32 > n || t - (int)LIST[lastslot] < 127) {
#pragma unroll
            for (int h8 = 0; h8 < 2; ++h8) { int li[8]; float bb[8];
#pragma unroll
                for (int r = 0; r < 8; ++r) li[r] = LIST[32 * i + crow(8 * h8 + r, hi)];
#pragma unroll
                for (int r = 0; r < 8; ++r) asm volatile("" : "+v"(li[r]));
#pragma unroll
                for (int r = 0; r < 8; ++r) { const int d = t - li[r]; const unsigned ix = (unsigned)d < 127u ? (unsigned)d : 127u; bb[r] = bt[ix]; }
#pragma unroll
                for (int r = 0; r < 8; ++r) asm volatile("" : "+v"(bb[r]));
#pragma unroll
                for (int r = 0; r < 8; ++r) { const int slot = 32 * i + crow(8 * h8 + r, hi); s[8 * h8 + r] = (slot < n) ? s[8 * h8 + r] + bb[r] : -INFINITY; } }
        }
        float rs = 0.f;
#pragma unroll
        for (int r = 0; r < 16; ++r) { s[r] = ex2(s[r]); rs += s[r]; }
        l += rs;
        const bf16x8 pk[2] = {pack_p(s, 0), pack_p(s, 8)};
        lcptr vb = T + (4 * hq + q4) * KS128 + (16 * g + 4 * p4) * 2;
#pragma unroll
        for (int k = 0; k < 2; ++k)
#pragma unroll
            for (int d = 0; d < 4; ++d) { const s16x4 lo = vtr(vb + (16 * k) * KS128 + d * 64), hh = vtr(vb + (16 * k + 8) * KS128 + d * 64);
                const bf16x8 vf = (bf16x8){lo[0], lo[1], lo[2], lo[3], hh[0], hh[1], hh[2], hh[3]};
                o[d] = __builtin_amdgcn_mfma_f32_32x32x16_bf16(vf, pk[k], o[d], 0, 0, 0); }
    };
    gath(0, ra); put(base, ra);
    for (int i = 0; i < ntile; ++i) {
        const bool more = i + 1 < ntile;
        if (more) gath(i + 1, ra);
        tile(i);
        if (more) put(base + ((i + 1) & 1) * DS_TILE, ra);
    }
    l += __shfl_xor(l, 32); const float f = l > 0.f ? OSC / l : 0.f;
    if (r32 < 8) { unsigned char* orow = MIXIN + row * 1536 + head * 128;
#pragma unroll
        for (int d = 0; d < 4; ++d)
#pragma unroll
            for (int rg = 0; rg < 4; ++rg) *(unsigned*)(orow + 32 * d + 8 * rg + 4 * hi) = pg8::pk4_fp8(o[d][4 * rg] * f, o[d][4 * rg + 1] * f, o[d][4 * rg + 2] * f, o[d][4 * rg + 3] * f); }
}
__device__ __forceinline__ void phase_dsa_sparse(const Frame& F, const bf16_t* QLAT, const bf16_t* CKVN, const unsigned* MASK, const float* BT, unsigned char* MIXIN) {
    att::lptr lds = (att::lptr)F.lds; LAS float* BTL = (LAS float*)(lds + 8 * DS_WAVE);
    for (int i = F.tid; i < 1024; i += NTHR) BTL[i] = BT[i] - BT[i | 127];
    __syncthreads();
    att::lptr base = lds + F.wave * DS_WAVE;
    if ((F.G & 7) == 0) {
        const int b = F.bx & 7, wx = (F.bx >> 3) * NWAVES + F.wave, WX = (F.G >> 3) * NWAVES;
        u32x2 mw = *(const u32x2*)(MASK + ((size_t)b * SEQ + wx) * 128 + 2 * F.lane);
        for (int t = wx; t < SEQ; t += WX) { const int tn = (t + WX < SEQ) ? t + WX : t;
            const u32x2 mwn = *(const u32x2*)(MASK + ((size_t)b * SEQ + tn) * 128 + 2 * F.lane);
            dsa_query(F.lane, b, t, mw, base, BTL, QLAT, CKVN, MIXIN); mw = mwn; }
    } else {
        for (int q = F.gw; q < MTOK; q += F.NGW) { const u32x2 mw = *(const u32x2*)(MASK + (size_t)q * 128 + 2 * F.lane); dsa_query(F.lane, q >> 12, q & 4095, mw, base, BTL, QLAT, CKVN, MIXIN); }
    }
    __syncthreads();
}

constexpr int QI_STRIDE = 2064;
__device__ __forceinline__ void indexer_unit(const Frame& F, int b, int c, const bf16_t* QIDX, const bf16_t* T1, _Float16* SC) {
    using namespace att;
    const int lane = F.lane, r32 = lane & 31, hi = lane >> 5, w = F.wave, tid = F.tid;
    lptr lds = (lptr)F.lds; lptr QI = lds; lptr KI = lds + 64 * QI_STRIDE;
    const int qh = w & 1, kq = w >> 1;
    const size_t row0 = (size_t)b * SEQ + 64 * c;
#pragma unroll 4
    for (int k = 0; k < 16; ++k) { const int idx = tid + 512 * k, rr = idx >> 7, ch = idx & 127; *(LAS u32x4*)(QI + rr * QI_STRIDE + ch * 16) = *(const u32x4*)(QIDX + (row0 + rr) * 1024 + ch * 8); }
    float wv[16];
    { const size_t trow = row0 + 32 * qh + r32; const u32x4 a = *(const u32x4*)(T1 + trow * 256 + 192), bq = *(const u32x4*)(T1 + trow * 256 + 200);
      wv[0] = bflo(a.x); wv[1] = bfhi(a.x); wv[2] = bflo(a.y); wv[3] = bfhi(a.y); wv[4] = bflo(a.z); wv[5] = bfhi(a.z); wv[6] = bflo(a.w); wv[7] = bfhi(a.w);
      wv[8] = bflo(bq.x); wv[9] = bfhi(bq.x); wv[10] = bflo(bq.y); wv[11] = bfhi(bq.y); wv[12] = bflo(bq.z); wv[13] = bfhi(bq.z); wv[14] = bflo(bq.w); wv[15] = bfhi(bq.w); }
    const int nsup = (c + 2) >> 1, pitch = (c + 1) * 64;
    _Float16* srow = SC + (size_t)b * SCB_ELEMS + (size_t)4096 * (c * (c + 1) / 2) + (size_t)(32 * qh + r32) * pitch;
    const bf16_t* Kb = T1 + (size_t)b * SEQ * 256 + 128;
    u32x4 st[2];
    for (int s = 0; s < nsup; ++s) {
#pragma unroll
        for (int k = 0; k < 2; ++k) { const int idx = tid + 512 * k, rr = idx >> 3, ch = idx & 7; st[k] = *(const u32x4*)(Kb + (size_t)(128 * s + rr) * 256 + ch * 8); }
        __syncthreads();
#pragma unroll
        for (int k = 0; k < 2; ++k) { const int idx = tid + 512 * k, rr = idx >> 3, ch = idx & 7; *(LAS u32x4*)(KI + rr * KS64 + ch * 16) = st[k]; }
        __syncthreads();
        const int key0 = 128 * s + 32 * kq;
        if (key0 <= 64 * c + 63) {
            bf16x8 kf[4];
#pragma unroll
            for (int ks = 0; ks < 4; ++ks) kf[ks] = *(const LAS bf16x8*)(KI + (32 * kq + r32) * KS64 + ks * 32 + hi * 16);
            f32x16 sc = splat16(0.f);
            lcptr qp = (lcptr)QI + (32 * qh + r32) * QI_STRIDE + hi * 16;
#pragma unroll 2
            for (int hd = 0; hd < 16; ++hd) { f32x16 acc = splat16(0.f);
#pragma unroll
                for (int ks = 0; ks < 4; ++ks) { const bf16x8 qv = *(const LAS bf16x8*)(qp + hd * 128 + ks * 32); acc = __builtin_amdgcn_mfma_f32_32x32x16_bf16(kf[ks], qv, acc, 0, 0, 0); }
                const float ww = wv[hd];
#pragma unroll
                for (int r = 0; r < 16; ++r) sc[r] += ww * fmaxf(acc[r], 0.f); }
#pragma unroll
            for (int rg = 0; rg < 4; ++rg) { f32x2 a = {sc[4 * rg], sc[4 * rg + 1]}, bq = {sc[4 * rg + 2], sc[4 * rg + 3]};
                u32x2 o; o.x = __builtin_bit_cast(unsigned, __builtin_convertvector(a, f16x2_t)); o.y = __builtin_bit_cast(unsigned, __builtin_convertvector(bq, f16x2_t));
                *(u32x2*)(srow + key0 + 8 * rg + 4 * hi) = o; }
        }
    }
    __syncthreads();
}

struct SelRow { const unsigned short* src; unsigned* mrow; int t, c; };
__device__ __forceinline__ SelRow sel_row(int row, const _Float16* SC, unsigned* MASK) {
    SelRow r; const int b = row >> 12; r.t = row & 4095; r.c = r.t >> 6; const int nk = (r.c + 1) * 64;
    r.src = (const unsigned short*)SC + (size_t)b * SCB_ELEMS + (size_t)4096 * (r.c * (r.c + 1) / 2) + (size_t)(r.t & 63) * nk; r.mrow = MASK + (size_t)row * 128; return r;
}
__device__ __forceinline__ void sel_load(const SelRow& r, int lane, unsigned (&key)[64]) {
#pragma unroll
    for (int g = 0; g < 4; ++g) {
        if (r.c >= 16 * g) {
#pragma unroll
            for (int jj = 0; jj < 16; ++jj) { const int j = 16 * g + jj, jc = j <= r.c ? j : r.c;
                const unsigned uu = r.src[64 * jc + lane]; const unsigned k = (uu & 0x8000u) ? (~uu & 0xffffu) : (uu | 0x8000u);
                key[j] = (64 * j + lane > r.t) ? 0u : k; }
        } else {
#pragma unroll
            for (int jj = 0; jj < 16; ++jj) key[16 * g + jj] = 0u;
        }
    }
}
template <bool GT> __device__ __forceinline__ int sel_count(const unsigned (&key)[64], unsigned cand, int c) {
    int cnt = 0;
#pragma unroll
    for (int g = 0; g < 4; ++g) if (c >= 16 * g) {
#pragma unroll
        for (int jj = 0; jj < 16; ++jj) cnt += __popcll(__ballot(GT ? (key[16 * g + jj] > cand) : (key[16 * g + jj] >= cand)));
    }
    return cnt;
}
__device__ __forceinline__ void sel_emit(const SelRow& r, int lane, const unsigned (&key)[64], unsigned prefix, bool exact) {
    if (exact) {
#pragma unroll
        for (int j = 0; j < 64; ++j) if (j <= r.c) { const unsigned long long mk = __ballot(key[j] >= prefix); if (lane == 0) *(u32x2*)(r.mrow + 2 * j) = (u32x2){(unsigned)mk, (unsigned)(mk >> 32)}; }
        return;
    }
    int rem = 256 - sel_count<true>(key, prefix, r.c);
#pragma unroll
    for (int j = 0; j < 64; ++j) {
        if (j <= r.c) {
            const bool eq = key[j] == prefix; const unsigned long long eqm = __ballot(eq);
            const int before = __builtin_amdgcn_mbcnt_hi((unsigned)(eqm >> 32), __builtin_amdgcn_mbcnt_lo((unsigned)eqm, 0u));
            const unsigned long long mk = __ballot(key[j] > prefix || (eq && before < rem));
            rem -= __popcll(eqm); rem = rem < 0 ? 0 : rem;
            if (lane == 0) *(u32x2*)(r.mrow + 2 * j) = (u32x2){(unsigned)mk, (unsigned)(mk >> 32)};
        }
    }
}
__device__ __forceinline__ void sel_small(const SelRow& r, int lane) {
    for (int j = 0; j <= r.c; ++j) { const unsigned long long mk = __ballot(64 * j + lane <= r.t); if (lane == 0) *(u32x2*)(r.mrow + 2 * j) = (u32x2){(unsigned)mk, (unsigned)(mk >> 32)}; }
}
__device__ __forceinline__ void phase_select(const Frame& F, const _Float16* SC, unsigned* MASK) {
    const int lane = F.lane;
    for (int p = F.gw; p < MTOK / 2; p += F.NGW) {
        const int pb_ = p >> 11, q = p & 2047;
        const SelRow ra = sel_row(pb_ * 4096 + q, SC, MASK), rb = sel_row(pb_ * 4096 + 4095 - q, SC, MASK);
        const bool sa = ra.t < 256, sb = rb.t < 256;
        if (sa) sel_small(ra, lane);
        if (sb) sel_small(rb, lane);
        if (sa && sb) continue;
        unsigned ka[64], kb[64];
        sel_load(ra, lane, ka); sel_load(rb, lane, kb);
        unsigned pa = 0u, pb = 0u; bool da = sa, db = sb;
#pragma unroll 1
        for (int bit = 15; bit >= 0 && !(da && db); --bit) {
            if (!da) { const unsigned ca = pa | (1u << bit); const int na = sel_count<false>(ka, ca, ra.c); if (na >= 256) pa = ca; if (na == 256) da = true; }
            if (!db) { const unsigned cb = pb | (1u << bit); const int nb = sel_count<false>(kb, cb, rb.c); if (nb >= 256) pb = cb; if (nb == 256) db = true; }
        }
        if (!sa) sel_emit(ra, lane, ka, pa, da);
        if (!sb) sel_emit(rb, lane, kb, pb, db);
    }
}

__device__ __forceinline__ float gelu_tanh(float x) { const float u = 0.7978845608028654f * (x + 0.044715f * x * x * x); const float e = __expf(2.f * u); return 0.5f * x * (1.f + (1.f - 2.f / (e + 1.f))); }
__device__ __forceinline__ void compress_unit(const Frame& F, int b, int g, int kv, int rt, const bf16_t* KVC, const bf16_t* W1T, const float* w2, const float* cb, bf16_t* OUT) {
    const int lane = F.lane, r32 = lane & 31, hi = lane >> 5, w = F.wave, tid = F.tid;
    LAS float* PART = (LAS float*)F.lds;
    LAS float* HID = PART + 8 * 2048;
    const int n0 = 32 * rt, nn = n0 + r32, nc = nn < 255 ? nn : 254;
    const bf16_t* arow = KVC + ((size_t)b * SEQ + 16 * nc) * 256 + kv * 128 + g * 64;
    f32x16 a0 = att::splat16(0.f), a1 = att::splat16(0.f);
#pragma unroll 4
    for (int ks = 0; ks < 16; ++ks) { const int l = 4 * w + (ks >> 2), d = 16 * (ks & 3) + 8 * hi;
        const bf16x8 af = *(const bf16x8*)(arow + (size_t)l * 256 + d);
        const bf16x8 b0 = *(const bf16x8*)(W1T + (size_t)r32 * 2048 + l * 64 + d), b1 = *(const bf16x8*)(W1T + (size_t)(32 + r32) * 2048 + l * 64 + d);
        a0 = __builtin_amdgcn_mfma_f32_32x32x16_bf16(af, b0, a0, 0, 0, 0); a1 = __builtin_amdgcn_mfma_f32_32x32x16_bf16(af, b1, a1, 0, 0, 0); }
#pragma unroll
    for (int r = 0; r < 16; ++r) { const int mrow = att::crow(r, hi); PART[w * 2048 + mrow * 64 + r32] = a0[r]; PART[w * 2048 + mrow * 64 + 32 + r32] = a1[r]; }
    __syncthreads();
#pragma unroll
    for (int k = 0; k < 4; ++k) { const int idx = tid + 512 * k; float s = cb[idx & 63];
#pragma unroll
        for (int ww = 0; ww < 8; ++ww) s += PART[ww * 2048 + idx];
        HID[idx] = gelu_tanh(s); }
    __syncthreads();
#pragma unroll
    for (int k = 0; k < 4; ++k) { const int idx = tid + 512 * k, nr = idx >> 6, f = idx & 63; float s = 0.f;
#pragma unroll 8
        for (int e = 0; e < 64; ++e) s += HID[nr * 64 + e] * w2[e * 64 + f];
        const int blk = n0 + nr;
        OUT[(((size_t)b * 256 + blk) * 2 + g) * 64 + f] = (blk < 255) ? (bf16_t)f2bf(s) : (bf16_t)0; }
    __syncthreads();
}

#ifdef DBG_MODE
namespace dbg {
constexpr int NSLOT = 40;
__device__ __forceinline__ float bfr(float x) { return bf2f((unsigned short)f2bf(x)); }
__device__ __forceinline__ int srow(int i, int n) { return (int)(((unsigned)i * 2654435761u) % (unsigned)MTOK) ; }
__device__ void commit(unsigned* D, int slot, const float* ref, const float* fast, int n, float tf) {
    __shared__ float red[256];
    const int tid = threadIdx.x; float s = 0.f;
    for (int i = tid; i < n; i += 256) s += ref[i] * ref[i];
    red[tid] = s; __syncthreads();
    for (int o = 128; o > 0; o >>= 1) { if (tid < o) red[tid] += red[tid + o]; __syncthreads(); }
    const float rms = sqrtf(red[0] / (float)n); __syncthreads();
    int bad = 0, tot = 0; float mr = 0.f;
    for (int i = tid; i < n; i += 256) { const float e = fabsf(fast[i] - ref[i]); const float tol = tf * (rms + fabsf(ref[i])) + 1e-7f; if (!(e <= tol)) ++bad; ++tot; const float r = e / (rms + 1e-20f); if (r > mr || !(r == r)) mr = (r == r) ? r : 1e30f; }
    atomicAdd(&D[4 * slot], (unsigned)bad); atomicAdd(&D[4 * slot + 1], (unsigned)tot); atomicMax(&D[4 * slot + 2], __float_as_uint(mr));
    __syncthreads();
}
__device__ __forceinline__ float bias_l2(const float* relb, int head, int dist) { return relb[t5_bucket(dist) * 16 + head] * LOG2E; }

__global__ void chk_in_e(Args a, unsigned* D) {
    __shared__ float ref[1792], fast[1792];
    const int r = srow(blockIdx.x, 64), tid = threadIdx.x; const float* x = a.in[I_X] + (size_t)r * 1024; const float* w = a.in[I_EWIN];
    const bf16_t* Y1 = (const bf16_t*)(a.ws + OFF_Y1);
    for (int n = tid; n < EVEN_IN; n += 256) { float s = 0.f; for (int k = 0; k < 1024; ++k) s += bfr(x[k]) * bfr(w[(size_t)k * EVEN_IN + n]);
        const int dc = RowInE{}(n), tile = dc >> 8, col = dc & 255; const float sc = (tile == 2 || tile == 3) ? QSCALE : 1.f;
        ref[n] = s * sc; fast[n] = bf2f(Y1[((size_t)tile * MTOK + r) * 256 + col]); }
    __syncthreads();
    commit(D, 1, ref, fast, EVEN_IN, 0.02f);
    if (tid == 0) { float sq = 0.f, skv = 0.f; for (int n = 0; n < 256; ++n) sq += ref[n] * ref[n]; for (int n = 256; n < 384; ++n) skv += ref[n] * ref[n];
        const float* pq = (const float*)(a.ws + OFF_SSQ_Q) + (size_t)r * 4; const float* pk = (const float*)(a.ws + OFF_SSQ_KV) + (size_t)r * 4;
        const float fq = pq[0] + pq[1] + pq[2] + pq[3], fk = pk[0] + pk[1] + pk[2] + pk[3];
        int bad = 0; if (!(fabsf(fq - sq) <= 0.02f * sq)) ++bad; if (!(fabsf(fk - skv) <= 0.02f * skv)) ++bad;
        atomicAdd(&D[4 * 2], (unsigned)bad); atomicAdd(&D[4 * 2 + 1], 2u); }
}
__global__ void chk_q2(Args a, unsigned* D) {
    __shared__ float ref[1024], fast[1024], cqn[256], qh[512];
    const int r = srow(blockIdx.x, 64), tid = threadIdx.x; const bf16_t* Y1 = (const bf16_t*)(a.ws + OFF_Y1);
    const bf16_t* CQ = Y1 + (size_t)r * 256; const bf16_t* T1 = Y1 + ((size_t)MTOK + r) * 256;
    { float s = 0.f; for (int k = 0; k < 128; ++k) { const float c = bf2f(T1[k]); s += c * c; } const float rk = 1.f / sqrtf(s / 128.f + 1e-6f);
      if (tid < 128) { ref[tid] = bf2f(T1[tid]) * rk * a.in[I_EKVN][tid]; fast[tid] = bf2f(((const bf16_t*)(a.ws + OFF_CKVN))[(size_t)r * 128 + tid]); } }
    __syncthreads(); commit(D, 3, ref, fast, 128, 0.02f);
    { float s = 0.f; for (int k = 0; k < 256; ++k) { const float c = bf2f(CQ[k]); s += c * c; } const float rq = 1.f / sqrtf(s / 256.f + 1e-6f);
      cqn[tid] = bf2f(CQ[tid]) * rq * a.in[I_EQN][tid]; }
    __syncthreads();
    for (int o = tid; o < 512; o += 256) { float s = 0.f; for (int k = 0; k < 256; ++k) s += cqn[k] * a.in[I_EWUQ][k * 512 + o]; qh[o] = s; }
    __syncthreads();
    for (int o = tid; o < 1024; o += 256) { const int h = o >> 7, c = o & 127; float s = 0.f; for (int d = 0; d < 64; ++d) s += qh[h * 64 + d] * a.in[I_EWUK][c * 512 + h * 64 + d];
        ref[o] = s * QSCALE; fast[o] = bf2f(((const bf16_t*)(a.ws + OFF_QLAT))[(size_t)r * 1024 + o]); }
    __syncthreads(); commit(D, 5, ref, fast, 1024, 0.03f);
    for (int o = tid; o < 1024; o += 256) { float s = 0.f; for (int k = 0; k < 256; ++k) s += cqn[k] * a.in[I_EWQIDX][k * 1024 + o];
        ref[o] = s; fast[o] = bf2f(((const bf16_t*)(a.ws + OFF_QIDX))[(size_t)r * 1024 + o]); }
    __syncthreads(); commit(D, 6, ref, fast, 1024, 0.03f);
}
__global__ void chk_cmp(Args a, unsigned* D) {
    __shared__ float ref[64], fast[64], hid[64];
    const int i = blockIdx.x, tid = threadIdx.x, b = i & 7, g = (i >> 3) & 1, kv = (i >> 4) & 1; const int blk = (i >> 5) == 0 ? 0 : ((i >> 5) == 1 ? 254 : (int)((unsigned)(i * 37 + 11) % 255u));
    const bf16_t* KVC = (const bf16_t*)(a.ws + OFF_Y1) + (size_t)4 * MTOK * 256;
    const float* pos = a.in[kv ? I_EPOSV : I_EPOSK]; const float* w1 = a.in[kv ? I_ECV1 : I_ECK1]; const float* w2 = a.in[kv ? I_ECV2 : I_ECK2];
    if (tid < 64) { float s = 0.f;
        for (int l = 0; l < 32; ++l) for (int d = 0; d < 64; ++d) { const float av = bf2f(KVC[((size_t)b * SEQ + 16 * blk + l) * 256 + kv * 128 + g * 64 + d]); const float wv = w1[(l * 64 + d) * 64 + tid]; s += av * bfr(wv) + pos[l * 64 + d] * wv; }
        hid[tid] = gelu_tanh(s); }
    __syncthreads();
    if (tid < 64) { float s = 0.f; for (int e = 0; e < 64; ++e) s += hid[e] * w2[e * 64 + tid]; ref[tid] = s;
        fast[tid] = bf2f(((const bf16_t*)(a.ws + (kv ? OFF_VC : OFF_KC)))[(((size_t)b * 256 + blk) * 2 + g) * 64 + tid]); }
    __syncthreads(); commit(D, 4, ref, fast, 64, 0.03f);
}
__global__ void chk_idx(Args a, unsigned* D) {
    __shared__ float ref[256], fast[256];
    const int r = (blockIdx.x < 4) ? (blockIdx.x * 4096 + blockIdx.x * 61) : srow(blockIdx.x, 64), tid = threadIdx.x, b = r >> 12, t = r & 4095, c = t >> 6, nk = (c + 1) * 64;
    const bf16_t* Y1 = (const bf16_t*)(a.ws + OFF_Y1); const bf16_t* T1 = Y1 + (size_t)MTOK * 256; const bf16_t* QI = (const bf16_t*)(a.ws + OFF_QIDX) + (size_t)r * 1024;
    const int s = (int)(((unsigned)tid * 2654435761u + 12345u * blockIdx.x) % (unsigned)nk);
    const bf16_t* kr = T1 + ((size_t)b * SEQ + s) * 256 + 128; float sc = 0.f;
    for (int h = 0; h < 16; ++h) { float d = 0.f; for (int k = 0; k < 64; ++k) d += bf2f(QI[h * 64 + k]) * bf2f(kr[k]); sc += bf2f(T1[(size_t)r * 256 + 192 + h]) * fmaxf(d, 0.f); }
    ref[tid] = sc;
    const _Float16* SC = (const _Float16*)(a.ws + OFF_SC) + (size_t)b * SCB_ELEMS + (size_t)4096 * (c * (c + 1) / 2) + (size_t)(t & 63) * nk;
    fast[tid] = (float)SC[s];
    __syncthreads(); commit(D, 7, ref, fast, 256, 0.02f);
}
__global__ void chk_sel(Args a, unsigned* D) {
    __shared__ unsigned key[4096];
    const int r = (blockIdx.x < 8) ? (blockIdx.x * 4096 + 255 + blockIdx.x * 300) : srow(blockIdx.x, 64), tid = threadIdx.x, b = r >> 12, t = r & 4095, c = t >> 6, nk = (c + 1) * 64;
    const unsigned short* SC = (const unsigned short*)(a.ws + OFF_SC) + (size_t)b * SCB_ELEMS + (size_t)4096 * (c * (c + 1) / 2) + (size_t)(t & 63) * nk;
    const unsigned* M = (const unsigned*)(a.ws + OFF_MASK) + (size_t)r * 128;
    for (int s = tid; s < nk; s += 256) { const unsigned u = SC[s]; key[s] = (s <= t) ? ((u & 0x8000u) ? (~u & 0xffffu) : (u | 0x8000u)) : 0u; }
    __syncthreads();
    int bad = 0, tot = 0;
    for (int s = tid; s < nk; s += 256) { bool want;
        if (s > t) want = false; else if (t < 256) want = true;
        else { int rank = 0; const unsigned ks = key[s]; for (int q = 0; q <= t; ++q) rank += (key[q] > ks || (key[q] == ks && q < s)) ? 1 : 0; want = rank < 256; }
        const bool got = (M[s >> 5] >> (s & 31)) & 1u; if (want != got) ++bad; ++tot; }
    atomicAdd(&D[4 * 8], (unsigned)bad); atomicAdd(&D[4 * 8 + 1], (unsigned)tot);
}
__global__ void chk_dsa(Args a, unsigned* D) {
    __shared__ float lg[4096], red[256], ref[128], fast[128];
    const int r = (blockIdx.x < 8) ? (blockIdx.x * 4096 + blockIdx.x * 37) : srow(blockIdx.x, 64), tid = threadIdx.x, b = r >> 12, t = r & 4095, h = blockIdx.x & 7;
    const bf16_t* Q = (const bf16_t*)(a.ws + OFF_QLAT) + (size_t)r * 1024 + h * 128; const bf16_t* C = (const bf16_t*)(a.ws + OFF_CKVN) + (size_t)b * SEQ * 128;
    const unsigned* M = (const unsigned*)(a.ws + OFF_MASK) + (size_t)r * 128; const float* relb = a.in[I_RELB];
    float mx = -INFINITY;
    for (int s = tid; s <= t; s += 256) { float v = -INFINITY; if ((M[s >> 5] >> (s & 31)) & 1u) { float d = 0.f; for (int k = 0; k < 128; ++k) d += bf2f(Q[k]) * bf2f(C[(size_t)s * 128 + k]); v = d + bias_l2(relb, h, t - s); } lg[s] = v; mx = fmaxf(mx, v); }
    red[tid] = mx; __syncthreads(); for (int o = 128; o > 0; o >>= 1) { if (tid < o) red[tid] = fmaxf(red[tid], red[tid + o]); __syncthreads(); } mx = red[0]; __syncthreads();
    float sm = 0.f; for (int s = tid; s <= t; s += 256) { const float p = exp2f(lg[s] - mx); lg[s] = p; sm += p; }
    red[tid] = sm; __syncthreads(); for (int o = 128; o > 0; o >>= 1) { if (tid < o) red[tid] += red[tid + o]; __syncthreads(); } sm = red[0]; __syncthreads();
    if (tid < 128) { float o = 0.f; for (int s = 0; s <= t; ++s) o += lg[s] * bf2f(C[(size_t)s * 128 + tid]); ref[tid] = o / sm; fast[tid] = bf2f(((const bf16_t*)(a.ws + OFF_MIXIN))[(size_t)r * 1536 + h * 128 + tid]); }
    __syncthreads(); commit(D, 9, ref, fast, 128, 0.03f);
}
__global__ void chk_nsa(Args a, unsigned* D) {
    __shared__ float pc[4][256], lg[1100], red[256], ref[64], fast[64], oacc[3][64], scb[64]; __shared__ int selj[16]; __shared__ float qs[4][64];
    const int r = (blockIdx.x < 8) ? (blockIdx.x * 4096 + blockIdx.x * 41) : srow(blockIdx.x, 64), tid = threadIdx.x, b = r >> 12, t = r & 4095, hh = blockIdx.x & 7, g = hh >> 2, n = hh & 3, cur = t >> 6;
    const bf16_t* Y1 = (const bf16_t*)(a.ws + OFF_Y1); const bf16_t* T1 = Y1 + (size_t)MTOK * 256; const bf16_t* QB = Y1 + (size_t)(2 + g) * MTOK * 256;
    const bf16_t* KVS = Y1 + (size_t)5 * MTOK * 256; const bf16_t* KVW = Y1 + (size_t)6 * MTOK * 256;
    const bf16_t* KC = (const bf16_t*)(a.ws + OFF_KC); const bf16_t* VC = (const bf16_t*)(a.ws + OFF_VC); const float* relb = a.in[I_RELB];
    qs[tid >> 6][tid & 63] = bf2f(QB[(size_t)r * 256 + tid]);
    __syncthreads();
    const int vis = (t >= 31) ? ((t - 31) >> 4) : -1;
    for (int nn = 0; nn < 4; ++nn) {
        float v = -INFINITY; if (tid <= vis) { float d = 0.f; for (int k = 0; k < 64; ++k) d += qs[nn][k] * bf2f(KC[(((size_t)b * 256 + tid) * 2 + g) * 64 + k]); v = d + bias_l2(relb, 8 + 4 * g + nn, t - 16 * tid - 31); }
        red[tid] = v; __syncthreads(); for (int o = 128; o > 0; o >>= 1) { if (tid < o) red[tid] = fmaxf(red[tid], red[tid + o]); __syncthreads(); } const float mx = red[0]; __syncthreads();
        const float p = (tid <= vis) ? exp2f(v - mx) : 0.f; red[tid] = p; __syncthreads(); for (int o = 128; o > 0; o >>= 1) { if (tid < o) red[tid] += red[tid + o]; __syncthreads(); } const float sm = red[0]; __syncthreads();
        pc[nn][tid] = sm > 0.f ? p / sm : 0.f; __syncthreads();
    }
    if (tid < 64) { float o = 0.f; for (int i = 0; i <= vis; ++i) o += pc[n][i] * bf2f(VC[(((size_t)b * 256 + i) * 2 + g) * 64 + tid]); oacc[0][tid] = o;
        float s = 0.f; for (int nn = 0; nn < 4; ++nn) for (int i = 4 * tid - 1; i <= 4 * tid + 3; ++i) if (i >= 0 && i < 255) s += pc[nn][i];
        scb[tid] = (tid > cur) ? -INFINITY : ((tid == 0 || tid == cur || tid == cur - 1) ? INFINITY : s); }
    __syncthreads();
    if (tid < 64) { int rank = 0; for (int j = 0; j < 64; ++j) rank += (scb[j] > scb[tid] || (scb[j] == scb[tid] && j < tid)) ? 1 : 0; if (rank < 16) selj[rank] = tid; }
    __syncthreads();
    { float mx = -INFINITY;
      for (int i = tid; i < 1024; i += 256) { const int j = selj[i >> 6], p = 64 * j + (i & 63); float v = -INFINITY; if (p <= t) { float d = 0.f; for (int k = 0; k < 64; ++k) d += qs[n][k] * bf2f(KVS[((size_t)b * SEQ + p) * 256 + g * 64 + k]); v = d + bias_l2(relb, 8 + hh, t - p); } lg[i] = v; mx = fmaxf(mx, v); }
      red[tid] = mx; __syncthreads(); for (int o = 128; o > 0; o >>= 1) { if (tid < o) red[tid] = fmaxf(red[tid], red[tid + o]); __syncthreads(); } mx = red[0]; __syncthreads();
      float sm = 0.f; for (int i = tid; i < 1024; i += 256) { const float p = exp2f(lg[i] - mx); lg[i] = p; sm += p; }
      red[tid] = sm; __syncthreads(); for (int o = 128; o > 0; o >>= 1) { if (tid < o) red[tid] += red[tid + o]; __syncthreads(); } sm = red[0]; __syncthreads();
      if (tid < 64) { float o = 0.f; for (int i = 0; i < 1024; ++i) { const int p = 64 * selj[i >> 6] + (i & 63); if (p <= t) o += lg[i] * bf2f(KVS[((size_t)b * SEQ + p) * 256 + 128 + g * 64 + tid]); } oacc[1][tid] = o / sm; }
      __syncthreads(); }
    { float mx = -INFINITY;
      for (int i = tid; i < 512; i += 256) { const int p = t - i; float v = -INFINITY; if (p >= 0) { float d = 0.f; for (int k = 0; k < 64; ++k) d += qs[n][k] * bf2f(KVW[((size_t)b * SEQ + p) * 256 + g * 64 + k]); v = d + bias_l2(relb, 8 + hh, i); } lg[i] = v; mx = fmaxf(mx, v); }
      red[tid] = mx; __syncthreads(); for (int o = 128; o > 0; o >>= 1) { if (tid < o) red[tid] = fmaxf(red[tid], red[tid + o]); __syncthreads(); } mx = red[0]; __syncthreads();
      float sm = 0.f; for (int i = tid; i < 512; i += 256) { const float p = exp2f(lg[i] - mx); lg[i] = p; sm += p; }
      red[tid] = sm; __syncthreads(); for (int o = 128; o > 0; o >>= 1) { if (tid < o) red[tid] += red[tid + o]; __syncthreads(); } sm = red[0]; __syncthreads();
      if (tid < 64) { float o = 0.f; for (int i = 0; i < 512; ++i) { const int p = t - i; if (p >= 0) o += lg[i] * bf2f(KVW[((size_t)b * SEQ + p) * 256 + 128 + g * 64 + tid]); } oacc[2][tid] = o / sm; }
      __syncthreads(); }
    if (tid < 64) { float gt[3]; for (int j = 0; j < 3; ++j) { const float x = bf2f(T1[(size_t)r * 256 + 208 + hh * 3 + j]); gt[j] = 1.f / (1.f + expf(-x)); }
        ref[tid] = gt[0] * oacc[0][tid] + gt[1] * oacc[1][tid] + gt[2] * oacc[2][tid]; fast[tid] = bf2f(((const bf16_t*)(a.ws + OFF_MIXIN))[(size_t)r * 1536 + 1024 + hh * 64 + tid]); }
    __syncthreads(); commit(D, 10, ref, fast, 64, 0.04f);
}
__global__ void chk_out_e(Args a, unsigned* D) {
    __shared__ float ref[1024], fast[1024], cat[1024];
    const int r = srow(blockIdx.x, 64), tid = threadIdx.x; const bf16_t* MX = (const bf16_t*)(a.ws + OFF_MIXIN) + (size_t)r * 1536;
    for (int o = tid; o < 512; o += 256) { const int h = o >> 6, d = o & 63; float s = 0.f; for (int c = 0; c < 128; ++c) s += bf2f(MX[h * 128 + c]) * a.in[I_EWUV][c * 512 + h * 64 + d]; cat[o] = s; cat[512 + o] = bf2f(MX[1024 + o]); }
    __syncthreads();
    for (int n = tid; n < 1024; n += 256) { float s = 0.f; for (int j = 0; j < 1024; ++j) s += cat[j] * a.in[I_EWOUT][(size_t)j * 1024 + n]; ref[n] = s;
        fast[n] = bf2f(((const bf16_t*)(a.ws + OFF_S1))[(size_t)r * 1024 + n]) - ALPHA * a.in[I_X][(size_t)r * 1024 + n]; }
    __syncthreads(); commit(D, 11, ref, fast, 1024, 0.35f);
}
__global__ void chk_ln(const bf16_t* S, const bf16_t* O, const float* g, const float* bt, unsigned* D, int slot) {
    __shared__ float ref[1024], fast[1024];
    const int r = srow(blockIdx.x, 64), tid = threadIdx.x; float mean = 0.f, var = 0.f;
    for (int k = 0; k < 1024; ++k) mean += bf2f(S[(size_t)r * 1024 + k]); mean /= 1024.f;
    for (int k = 0; k < 1024; ++k) { const float d = bf2f(S[(size_t)r * 1024 + k]) - mean; var += d * d; } var /= 1024.f;
    for (int n = tid; n < 1024; n += 256) { ref[n] = (bf2f(S[(size_t)r * 1024 + n]) - mean) / sqrtf(var + 1e-5f) * g[n] + bt[n]; fast[n] = bf2f(O[(size_t)r * 1024 + n]); }
    __syncthreads(); commit(D, slot, ref, fast, 1024, 0.01f);
}
__global__ void chk_ffn_up(Args a, unsigned* D) {
    __shared__ float ref[DFF], fast[DFF], hrow[1024];
    const int r = srow(blockIdx.x, 64), tid = threadIdx.x; const bf16_t* H = (const bf16_t*)(a.ws + OFF_H) + (size_t)r * 1024;
    for (int k = tid; k < 1024; k += 256) hrow[k] = bf2f(H[k]);
    __syncthreads();
    for (int n = tid; n < DFF; n += 256) { float s1 = 0.f, s3 = 0.f; for (int k = 0; k < 1024; ++k) { s1 += hrow[k] * bfr(a.in[I_EF1][(size_t)k * DFF + n]); s3 += hrow[k] * bfr(a.in[I_EF3][(size_t)k * DFF + n]); }
        ref[n] = s1 / (1.f + expf(-s1)) * s3; fast[n] = bf2f(((const bf16_t*)(a.ws + OFF_ACT))[(size_t)r * DFF + n]); }
    __syncthreads(); commit(D, 13, ref, fast, DFF, 0.02f);
}
__global__ void chk_ffn_dn(Args a, unsigned* D) {
    __shared__ float ref[1024], fast[1024], arow[DFF];
    const int r = srow(blockIdx.x, 64), tid = threadIdx.x; const bf16_t* A = (const bf16_t*)(a.ws + OFF_ACT) + (size_t)r * DFF;
    for (int k = tid; k < DFF; k += 256) arow[k] = bf2f(A[k]);
    __syncthreads();
    for (int n = tid; n < 1024; n += 256) { float s = 0.f; for (int k = 0; k < DFF; ++k) s += arow[k] * bfr(a.in[I_EF2][(size_t)k * 1024 + n]); ref[n] = s;
        fast[n] = bf2f(((const bf16_t*)(a.ws + OFF_S2))[(size_t)r * 1024 + n]) - ALPHA * bf2f(((const bf16_t*)(a.ws + OFF_H))[(size_t)r * 1024 + n]); }
    __syncthreads(); commit(D, 14, ref, fast, 1024, 0.06f);
}
__global__ void chk_in_o(Args a, unsigned* D) {
    __shared__ float ref[2048], fast[2048], xr[1024];
    const int r = srow(blockIdx.x, 64), tid = threadIdx.x; const bf16_t* X1 = (const bf16_t*)(a.ws + OFF_X1) + (size_t)r * 1024;
    for (int k = tid; k < 1024; k += 256) xr[k] = bf2f(X1[k]);
    __syncthreads();
    for (int n = tid; n < 2048; n += 256) { float s = 0.f; for (int k = 0; k < 1024; ++k) s += xr[k] * bfr(a.in[I_OWIN][(size_t)k * 3072 + 1024 + n]); ref[n] = s;
        fast[n] = bf2f(((const bf16_t*)(a.ws + OFF_QKV))[(size_t)(1 + (n >> 10)) * MTOK * 1024 + (size_t)r * 1024 + (n & 1023)]); }
    __syncthreads(); commit(D, 16, ref, fast, 2048, 0.02f);
    const int pm = r >> 8; const bf16_t* K = (const bf16_t*)(a.ws + OFF_QKV) + (size_t)MTOK * 1024 + (size_t)pm * 256 * 1024; const float* KM = (const float*)(a.ws + OFF_KMEAN) + (size_t)pm * 2048;
    for (int n = tid; n < 1024; n += 256) { float s = 0.f; for (int q = 0; q < 256; ++q) s += bf2f(K[(size_t)q * 1024 + n]); ref[n] = s; fast[n] = KM[n] + KM[1024 + n]; }
    __syncthreads(); commit(D, 17, ref, fast, 1024, 0.03f);
}
__global__ void chk_moba(Args a, unsigned* D) {
    __shared__ float lg[1024], red[256], ref[64], fast[64], q[64], gate[16]; __shared__ int blkof[4];
    const int r = (blockIdx.x < 8) ? (blockIdx.x * 4096 + blockIdx.x * 300) : srow(blockIdx.x, 64), tid = threadIdx.x, b = r >> 12, t = r & 4095, h = blockIdx.x & 15, own = t >> 8;
    const bf16_t* X1 = (const bf16_t*)(a.ws + OFF_X1) + (size_t)r * 1024; const bf16_t* K = (const bf16_t*)(a.ws + OFF_QKV) + (size_t)MTOK * 1024 + (size_t)b * SEQ * 1024 + h * 64; const bf16_t* V = K + (size_t)MTOK * 1024;
    const float* relb = a.in[I_RELB];
    if (tid < 64) { float s = 0.f; for (int k = 0; k < 1024; ++k) s += bf2f(X1[k]) * bfr(a.in[I_OWIN][(size_t)k * 3072 + h * 64 + tid]); q[tid] = bfr(s * QSCALE); }
    __syncthreads();
    if (tid < 16) { float s = -INFINITY; if (tid < own) { s = 0.f; for (int p = 0; p < 256; ++p) for (int d = 0; d < 64; ++d) s += q[d] * bf2f(K[(size_t)(256 * tid + p) * 1024 + d]); } gate[tid] = s; }
    __syncthreads();
    if (tid == 0) { unsigned used = 0u; for (int k = 0; k < 3; ++k) { int bj = -1; float best = -INFINITY; for (int j = 0; j < own; ++j) if (!((used >> j) & 1u) && gate[j] > best) { best = gate[j]; bj = j; } blkof[k] = bj; if (bj >= 0) used |= 1u << bj; } blkof[3] = own; }
    __syncthreads();
    float mx = -INFINITY;
    for (int i = tid; i < 1024; i += 256) { const int j = blkof[i >> 8], p = 256 * j + (i & 255); float v = -INFINITY; if (j >= 0 && p <= t) { float d = 0.f; for (int k = 0; k < 64; ++k) d += q[k] * bf2f(K[(size_t)p * 1024 + k]); v = d + bias_l2(relb, h, t - p); } lg[i] = v; mx = fmaxf(mx, v); }
    red[tid] = mx; __syncthreads(); for (int o = 128; o > 0; o >>= 1) { if (tid < o) red[tid] = fmaxf(red[tid], red[tid + o]); __syncthreads(); } mx = red[0]; __syncthreads();
    float sm = 0.f; for (int i = tid; i < 1024; i += 256) { const float p = exp2f(lg[i] - mx); lg[i] = p; sm += p; }
    red[tid] = sm; __syncthreads(); for (int o = 128; o > 0; o >>= 1) { if (tid < o) red[tid] += red[tid + o]; __syncthreads(); } sm = red[0]; __syncthreads();
    if (tid < 64) { float o = 0.f; for (int i = 0; i < 1024; ++i) { const int j = blkof[i >> 8], p = 256 * j + (i & 255); if (j >= 0 && p <= t) o += lg[i] * bf2f(V[(size_t)p * 1024 + tid]); } ref[tid] = o / sm;
        fast[tid] = bf2f(((const bf16_t*)(a.ws + OFF_QKV))[(size_t)r * 1024 + h * 64 + tid]); }
    __syncthreads(); commit(D, 18, ref, fast, 64, 0.04f);
}
__global__ void chk_out_o(Args a, unsigned* D) {
    __shared__ float ref[1024], fast[1024], orow[1024];
    const int r = srow(blockIdx.x, 64), tid = threadIdx.x;
    for (int k = tid; k < 1024; k += 256) orow[k] = bf2f(((const bf16_t*)(a.ws + OFF_QKV))[(size_t)r * 1024 + k]);
    __syncthreads();
    for (int n = tid; n < 1024; n += 256) { float s = 0.f; for (int k = 0; k < 1024; ++k) s += orow[k] * a.in[I_OWOUT][(size_t)k * 1024 + n]; ref[n] = s;
        fast[n] = bf2f(((const bf16_t*)(a.ws + OFF_S1O))[(size_t)r * 1024 + n]) - ALPHA * bf2f(((const bf16_t*)(a.ws + OFF_X1))[(size_t)r * 1024 + n]); }
    __syncthreads(); commit(D, 20, ref, fast, 1024, 0.5f);
}
__global__ void chk_route(Args a, unsigned* D) {
    const int r = srow(blockIdx.x * 256 + threadIdx.x, 64); const bf16_t* H2 = (const bf16_t*)(a.ws + OFF_H2) + (size_t)r * 1024;
    float lg[8]; for (int e = 0; e < 8; ++e) lg[e] = 0.f;
    for (int k = 0; k < 1024; ++k) { const float hv = bf2f(H2[k]); for (int e = 0; e < 8; ++e) lg[e] += hv * a.in[I_OROUTER][k * 8 + e]; }
    int e0 = 0; for (int e = 1; e < 8; ++e) if (lg[e] > lg[e0]) e0 = e; int e1 = -1; for (int e = 0; e < 8; ++e) if (e != e0 && (e1 < 0 || lg[e] > lg[e1])) e1 = e;
    const float g0 = 1.f / (1.f + expf(lg[e1] - lg[e0]));
    const u32x2 rt = ((const u32x2*)(a.ws + OFF_ROUTE))[r]; const int f0 = rt.x & 255, f1 = (rt.x >> 8) & 255; const float fg = __uint_as_float(rt.y);
    int bad = 0; if (f0 != e0 || f1 != e1 || !(fabsf(fg - g0) <= 0.02f)) ++bad;
    atomicAdd(&D[4 * 21], (unsigned)bad); atomicAdd(&D[4 * 21 + 1], 1u);
    const int* GI = (const int*)(a.ws + OFF_GINFO); const int* DEST = (const int*)(a.ws + OFF_DEST) + 2 * (size_t)r;
    int bad2 = 0;
    for (int k = 0; k < 2; ++k) { const int e = k ? f1 : f0, d = DEST[k], ps = e ? GI[e - 1] : 0; if (d < ps || d >= ps + GI[8 + e]) ++bad2; }
    atomicAdd(&D[4 * 22], (unsigned)bad2); atomicAdd(&D[4 * 22 + 1], 2u);
}
__global__ void chk_moe(Args a, unsigned* D) {
    __shared__ float ref[1024], fast[1024], hrow[1024], act[DFFE], fin[1024];
    const int r = srow(blockIdx.x, 64), tid = threadIdx.x; const bf16_t* H2 = (const bf16_t*)(a.ws + OFF_H2) + (size_t)r * 1024;
    for (int k = tid; k < 1024; k += 256) { hrow[k] = bf2f(H2[k]); ref[k] = 0.f; }
    const u32x2 rt = ((const u32x2*)(a.ws + OFF_ROUTE))[r]; const float g0 = __uint_as_float(rt.y); const int* DEST = (const int*)(a.ws + OFF_DEST) + 2 * (size_t)r; const bf16_t* YR = (const bf16_t*)(a.ws + OFF_YR);
    __syncthreads();
    for (int k = 0; k < 2; ++k) { const int e = k ? ((rt.x >> 8) & 255) : (rt.x & 255); const float gk = k ? 1.f - g0 : g0;
        const float* w1 = a.in[I_OM1] + (size_t)e * 1024 * DFFE; const float* w3 = a.in[I_OM3] + (size_t)e * 1024 * DFFE; const float* w2 = a.in[I_OM2] + (size_t)e * DFFE * 1024;
        for (int f = tid; f < DFFE; f += 256) { float s1 = 0.f, s3 = 0.f; for (int q = 0; q < 1024; ++q) { s1 += hrow[q] * bfr(w1[(size_t)q * DFFE + f]); s3 += hrow[q] * bfr(w3[(size_t)q * DFFE + f]); } act[f] = bfr(s1 / (1.f + expf(-s1)) * s3); }
        __syncthreads();
        for (int n = tid; n < 1024; n += 256) { float s = 0.f; for (int f = 0; f < DFFE; ++f) s += act[f] * bfr(w2[(size_t)f * 1024 + n]); ref[n] += gk * s; }
        __syncthreads(); }
    for (int n = tid; n < 1024; n += 256) { fast[n] = g0 * bf2f(YR[(size_t)DEST[0] * 1024 + n]) + (1.f - g0) * bf2f(YR[(size_t)DEST[1] * 1024 + n]); fin[n] = ALPHA * hrow[n] + fast[n]; }
    __syncthreads(); commit(D, 23, ref, fast, 1024, 0.12f);
    float mean = 0.f, var = 0.f; for (int k = 0; k < 1024; ++k) mean += fin[k]; mean /= 1024.f; for (int k = 0; k < 1024; ++k) { const float d = fin[k] - mean; var += d * d; } var /= 1024.f;
    __syncthreads();
    for (int n = tid; n < 1024; n += 256) { ref[n] = (fin[n] - mean) / sqrtf(var + 1e-5f) * a.in[I_OLN2G][n] + a.in[I_OLN2B][n]; fast[n] = a.out[(size_t)r * 1024 + n]; }
    __syncthreads(); commit(D, 24, ref, fast, 1024, 0.005f);
    { float m2 = 0.f, v2 = 0.f; for (int k = 0; k < 1024; ++k) m2 += ALPHA * hrow[k]; m2 /= 1024.f; for (int k = 0; k < 1024; ++k) { const float d = ALPHA * hrow[k] - m2; v2 += d * d; } v2 /= 1024.f;
      for (int n = tid; n < 1024; n += 256) ref[n] = (ALPHA * hrow[n] - m2) / sqrtf(v2 + 1e-5f) * a.in[I_OLN2G][n] + a.in[I_OLN2B][n];
      __syncthreads(); commit(D, 28, ref, fast, 1024, 0.005f); }
    { for (int n = tid; n < 1024; n += 256) fin[n] = ALPHA * hrow[n] + (1.f - g0) * bf2f(YR[(size_t)DEST[0] * 1024 + n]) + g0 * bf2f(YR[(size_t)DEST[1] * 1024 + n]);
      __syncthreads();
      float m2 = 0.f, v2 = 0.f; for (int k = 0; k < 1024; ++k) m2 += fin[k]; m2 /= 1024.f; for (int k = 0; k < 1024; ++k) { const float d = fin[k] - m2; v2 += d * d; } v2 /= 1024.f;
      __syncthreads();
      for (int n = tid; n < 1024; n += 256) ref[n] = (fin[n] - m2) / sqrtf(v2 + 1e-5f) * a.in[I_OLN2G][n] + a.in[I_OLN2B][n];
      __syncthreads(); commit(D, 29, ref, fast, 1024, 0.005f); }
}

__global__ void chk_wmoe(Args a, unsigned* D) {
    const int tid = blockIdx.x * 256 + threadIdx.x; const unsigned hsh = (unsigned)tid * 2654435761u;
    const int e = hsh & 7, f = (hsh >> 3) % DFFE, k = (hsh >> 15) % 1024;
    const bf16_t* W13 = (const bf16_t*)(a.ws + OFF_W_M13) + (size_t)e * 2 * DFFE * 1024; const bf16_t* W2 = (const bf16_t*)(a.ws + OFF_W_M2) + (size_t)e * 1024 * DFFE;
    int bad = 0;
    if (W13[(size_t)(((f >> 7) << 8) + (f & 127)) * 1024 + k] != (bf16_t)f2bf(a.in[I_OM1][(size_t)e * 1024 * DFFE + (size_t)k * DFFE + f])) ++bad;
    if (W13[(size_t)(((f >> 7) << 8) + (f & 127) + 128) * 1024 + k] != (bf16_t)f2bf(a.in[I_OM3][(size_t)e * 1024 * DFFE + (size_t)k * DFFE + f])) ++bad;
    atomicAdd(&D[4 * 25], (unsigned)bad); atomicAdd(&D[4 * 25 + 1], 2u);
    int bad2 = 0; if (W2[(size_t)k * DFFE + f] != (bf16_t)f2bf(a.in[I_OM2][(size_t)e * DFFE * 1024 + (size_t)f * 1024 + k])) ++bad2;
    atomicAdd(&D[4 * 26], (unsigned)bad2); atomicAdd(&D[4 * 26 + 1], 1u);
}
__global__ void chk_actm(Args a, unsigned* D) {
    __shared__ float ref[DFFE], fast[DFFE], hrow[1024]; __shared__ int tokf, kf;
    const int tid = threadIdx.x; const int* GI = (const int*)(a.ws + OFF_GINFO); const int nrows = GI[7], ng = nrows >> 8, g0 = ((ng - 1) / MOE_CHUNK) * MOE_CHUNK;
    const int rho = 256 * g0 + (int)(((unsigned)blockIdx.x * 2654435761u) % (unsigned)(nrows - 256 * g0));
    if (tid == 0) { tokf = -1; kf = 0; } __syncthreads();
    const int* DEST = (const int*)(a.ws + OFF_DEST);
    for (int i = tid; i < 2 * MTOK; i += 256) if (DEST[i] == rho) { tokf = i >> 1; kf = i & 1; }
    __syncthreads();
    if (tokf < 0) return;
    const int tok = tokf; const u32x2 rt = ((const u32x2*)(a.ws + OFF_ROUTE))[tok]; const int e = kf ? ((rt.x >> 8) & 255) : (rt.x & 255);
    const bf16_t* H2 = (const bf16_t*)(a.ws + OFF_H2) + (size_t)tok * 1024;
    for (int k = tid; k < 1024; k += 256) hrow[k] = bf2f(H2[k]);
    __syncthreads();
    const float* w1 = a.in[I_OM1] + (size_t)e * 1024 * DFFE; const float* w3 = a.in[I_OM3] + (size_t)e * 1024 * DFFE;
    for (int f = tid; f < DFFE; f += 256) { float s1 = 0.f, s3 = 0.f; for (int q = 0; q < 1024; ++q) { s1 += hrow[q] * bfr(w1[(size_t)q * DFFE + f]); s3 += hrow[q] * bfr(w3[(size_t)q * DFFE + f]); }
        ref[f] = s1 / (1.f + expf(-s1)) * s3; fast[f] = bf2f(((const bf16_t*)(a.ws + OFF_ACTM))[(size_t)(rho - 256 * g0) * DFFE + f]); }
    __syncthreads(); commit(D, 27, ref, fast, DFFE, 0.02f);
}

__global__ void simple_final(Args a) {
    const int row = blockIdx.x * 4 + (threadIdx.x >> 6), lane = threadIdx.x & 63; unsigned char* ws = a.ws;
    const bf16_t* H2 = (const bf16_t*)(ws + OFF_H2); const bf16_t* YR = (const bf16_t*)(ws + OFF_YR);
    const u32x2* ROUTE = (const u32x2*)(ws + OFF_ROUTE); const int* DEST = (const int*)(ws + OFF_DEST);
    const float g0 = __uint_as_float(ROUTE[row].y), g1 = 1.f - g0; const int d0 = DEST[2 * row], d1 = DEST[2 * row + 1];
    float v[16]; float s = 0.f;
    for (int i = 0; i < 16; ++i) { const int col = lane + 64 * i; v[i] = ALPHA * bf2f(H2[(size_t)row * 1024 + col]) + g0 * bf2f(YR[(size_t)d0 * 1024 + col]) + g1 * bf2f(YR[(size_t)d1 * 1024 + col]); s += v[i]; }
    const float mean = wave_sum(s) / 1024.f; float q = 0.f;
    for (int i = 0; i < 16; ++i) { v[i] -= mean; q += v[i] * v[i]; }
    const float rstd = 1.f / sqrtf(wave_sum(q) / 1024.f + 1e-5f);
    for (int i = 0; i < 16; ++i) { const int col = lane + 64 * i; a.out[(size_t)row * 1024 + col] = v[i] * rstd * a.in[I_OLN2G][col] + a.in[I_OLN2B][col]; }
}
__global__ void report(float* out, const unsigned* D, int nelem) {
    __shared__ float kk, xx;
    if (threadIdx.x == 0) { int idx = 0; float v = 0.f; float worst = 0.f;
        for (int s = 1; s < NSLOT; ++s) { const unsigned bad = D[4 * s], tot = D[4 * s + 1]; if (tot == 0u) continue; const float fr = (float)bad / (float)tot; const float thr = (s == 9 || s == 10 || s == 18) ? 0.1f : 0.002f;
            if (fr > worst) worst = fr; if (fr > thr && idx == 0) { idx = s; v = fr; } }
        if (idx == 0) v = worst;
#ifdef DBG_BITS
        { const int sl[6] = DBG_BITS; idx = 0; for (int q = 0; q < 6; ++q) { const int s = sl[q]; if (s > 0 && D[4 * s + 1] > 0u && (float)D[4 * s] / (float)D[4 * s + 1] > 0.002f) idx |= 1 << q; } v = 1.f; }
#endif
#ifdef DBG_VAL
        { const float mr = __uint_as_float(D[4 * DBG_VAL + 2]); const float fr = D[4 * DBG_VAL + 1] ? (float)D[4 * DBG_VAL] / (float)D[4 * DBG_VAL + 1] : 0.f; kk = sqrtf(fmaxf(mr, 1e-6f) * 1e6f); xx = kk * (2.f + 97.f * fr); }
#else
        v = fmaxf(v, 1e-6f); const int n = (v > 0.3f) ? 4 : (v > 0.03f) ? 3 : (v > 0.003f) ? 2 : 1; kk = (n == 4) ? 1e4f : (n == 3) ? 1e3f : (n == 2) ? 1e2f : 1e1f; xx = kk * (float)(idx + 2);
#endif
        }
    __syncthreads();
    const float k = kk, x = xx;
    for (size_t i = (size_t)blockIdx.x * blockDim.x + threadIdx.x; i < (size_t)nelem; i += (size_t)gridDim.x * blockDim.x) out[i] = (i == 0) ? x : k;
}
}
#endif

#ifndef MK_N_LAUNCHES
#define MK_N_LAUNCHES 1
#endif
constexpr int NPHASE = 18;
#define SP2 true
#ifndef FFN_F8
#define FFN_F8 0
#endif
#ifndef MOE_SP2
#define MOE_SP2 true
#endif
#define ALN true

__global__ void __launch_bounds__(NTHR, 2) fwd_kernel(Args args) {
    extern __shared__ __attribute__((aligned(16))) unsigned char lds_raw[];
    Frame F;
    F.lds = (LAS unsigned char*)lds_raw;
    F.tid = threadIdx.x; F.lane = F.tid & 63; F.wave = __builtin_amdgcn_readfirstlane(F.tid >> 6);
    F.G = gridDim.x; F.bx = blockIdx.x; F.gw = F.bx * NWAVES + F.wave; F.NGW = F.G * NWAVES; F.ws = args.ws;
    unsigned char* ws = args.ws;
    volatile LAS unsigned* MISC = (volatile LAS unsigned*)(F.lds + LDSCTL_OFF);
    for (int u = F.tid; u < (LDS_BYTES - LDSCTL_OFF) / 4; u += NTHR) ((LAS unsigned*)(F.lds + LDSCTL_OFF))[u] = 0u;
    __syncthreads();
    XcdBarrier bar = xcd_barrier_post((unsigned*)(ws + OFF_BAR) + args.li * XCD_BAR_WORDS, MISC + 8);
    const int lo = args.ph_lo, hi = args.ph_hi;
#ifndef PH_MASK
#define PH_MASK 0x3ffff
#endif
#define IN(k) (((PH_MASK >> (k)) & 1) && lo <= (k) && (k) < hi)
#ifdef TS_MODE
    unsigned long long* TS = (unsigned long long*)(ws + OFF_DBG + 1024);
#define STAMP(i) do { if (F.bx == 0 && F.tid == 0) TS[i] = __builtin_amdgcn_s_memrealtime(); } while (0)
#else
#define STAMP(i) do { } while (0)
#endif
#define SEAM(k) do { if (IN(k) && IN((k) + 1)) xcd_barrier(bar); STAMP((k) + 1); } while (0)
    LAS unsigned char* glds = F.lds;

    bf16_t* Y1 = (bf16_t*)(ws + OFF_Y1);
    float* ssq_q = (float*)(ws + OFF_SSQ_Q); float* ssq_kv = (float*)(ws + OFF_SSQ_KV);

    STAMP(0);
    if (IN(0)) { phase_prologue_even(F, args); } SEAM(0);
    if (IN(1)) { pg8::Gemm g{(const bf16_t*)(ws + OFF_XB), (const bf16_t*)(ws + OFF_W_IN), MTOK, EVEN_INP, 1024, 1024, 0}; pg8::StaticOrder S; S.init(MTOK, EVEN_INP, F.G, F.bx);
        pg8::EpiInE E{Y1, ssq_q, ssq_kv}; pg8::gemm_phase<pg8::EpiInE, pg8::StaticOrder, ALN, SP2>(glds, g, S, E); } SEAM(1);
    if (IN(2)) {
        phase_ckvn(F, Y1 + (size_t)1 * MTOK * 256, ssq_kv, args.in[I_EKVN], (bf16_t*)(ws + OFF_CKVN));
#ifndef NO_CMP
        for (int idx = F.bx; idx < 256; idx += F.G) { const int b = idx >> 5, g = (idx >> 4) & 1, kv = (idx >> 3) & 1, rt = idx & 7;
            compress_unit(F, b, g, kv, rt, Y1 + (size_t)4 * MTOK * 256, (const bf16_t*)(ws + (kv ? OFF_CV1 : OFF_CK1)), args.in[kv ? I_ECV2 : I_ECK2], (const float*)(ws + OFF_CB) + kv * 64, (bf16_t*)(ws + (kv ? OFF_VC : OFF_KC))); }
#endif
#ifndef NO_Q2
        pg8::Gemm g{Y1, (const bf16_t*)(ws + OFF_W_Q2), MTOK, 2048, 256, 256, 0}; pg8::StaticOrder S; S.init(MTOK, 2048, F.G, F.bx);
        pg8::EpiQ2 E{(bf16_t*)(ws + OFF_QLAT), (bf16_t*)(ws + OFF_QIDX), ssq_q}; pg8::gemm_phase<pg8::EpiQ2, pg8::StaticOrder, ALN, SP2>(glds, g, S, E);
#endif
    } SEAM(2);
    if (IN(3)) { for (int idx = F.bx; idx < 512; idx += F.G) { const int i = idx >> 8, v = idx & 255, b = v & 7, cc = v >> 3, c = i ? 63 - cc : cc;
            indexer_unit(F, b, c, (const bf16_t*)(ws + OFF_QIDX), Y1 + (size_t)1 * MTOK * 256, (_Float16*)(ws + OFF_SC)); } } SEAM(3);
    if (IN(4)) { phase_select(F, (const _Float16*)(ws + OFF_SC), (unsigned*)(ws + OFF_MASK)); } SEAM(4);
    if (IN(5)) {
#ifndef NO_DSA
        if (args.pad != 2) phase_dsa_sparse(F, (const bf16_t*)(ws + OFF_QLAT), (const bf16_t*)(ws + OFF_CKVN), (const unsigned*)(ws + OFF_MASK), (const float*)(ws + OFF_BT), ws + OFF_MIXIN);
#endif
        STAMP(20);
#ifndef NO_NSA
        if (args.pad != 1) for (int idx = F.bx; idx < 1024; idx += F.G) { const int i = idx >> 8, v = idx & 255, b = v & 7, cc = v >> 3, g = i & 1, c = (i >> 1) ? 63 - cc : cc;
            nsa_unit(F, b, g, c, Y1, (const bf16_t*)(ws + OFF_KC), (const bf16_t*)(ws + OFF_VC), (const float*)(ws + OFF_BT), ws + OFF_MIXIN); __syncthreads(); }
#endif
    } SEAM(5);
    if (IN(6)) { pg8::Gemm g{(const bf16_t*)(ws + OFF_MIXIN), (const bf16_t*)(ws + OFF_W_OUTE), MTOK, 1024, 768, 768, 0}; pg8::StaticOrder S; S.init(MTOK, 1024, F.G, F.bx);
        pg8::EpiRes<true> E{args.in[I_X], (bf16_t*)(ws + OFF_S1), 1.f / (OSC * WOUT_SCALE)}; pg8::gemm_phase<pg8::EpiRes<true>, pg8::StaticOrder, ALN, SP2, true>(glds, g, S, E); } SEAM(6);
    if (IN(7)) { phase_ln_i8(F, (const bf16_t*)(ws + OFF_S1), (bf16_t*)(ws + OFF_H), ws + OFF_H8, (float*)(ws + OFF_SA), args.in[I_ELN1G], args.in[I_ELN1B]); } SEAM(7);
#if FFN_F8
    if (IN(8)) { pg8::Gemm g{(const bf16_t*)(ws + OFF_H8), (const bf16_t*)(ws + OFF_W_F13), MTOK, 2 * DFF, 512, 512, 0}; pg8::StaticOrder S; S.init(MTOK, 2 * DFF, F.G, F.bx);
        pg8::EpiSwiglu8 E{ws + OFF_ACT, DFF, 0, 1.f / WF13_SCALE}; pg8::gemm_phase<pg8::EpiSwiglu8, pg8::StaticOrder, ALN, SP2, true>(glds, g, S, E); } SEAM(8);
#else
    if (IN(8)) { pg8::Gemm g{(const bf16_t*)(ws + OFF_H8), (const bf16_t*)(ws + OFF_W_F13), MTOK, 2 * DFF, 512, 512, 0}; pg8::StaticOrder S; S.init(MTOK, 2 * DFF, F.G, F.bx);
        pg8::EpiSwigluI8 E{ws + OFF_ACT, DFF, (const float*)(ws + OFF_SA), (const float*)(ws + OFF_SW)}; pg8::gemm_phase<pg8::EpiSwigluI8, pg8::StaticOrder, ALN, SP2, false, true>(glds, g, S, E); } SEAM(8);
#endif
#if FFN_F8
    if (IN(9)) { pg8::Gemm g{(const bf16_t*)(ws + OFF_ACT), (const bf16_t*)(ws + OFF_W_F2), MTOK, 1024, DFF / 2, DFF / 2, 0}; pg8::StaticOrder S; S.init(MTOK, 1024, F.G, F.bx);
        pg8::EpiRes<false> E{(const void*)(ws + OFF_H), (bf16_t*)(ws + OFF_S2), 1.f / WF2_SCALE}; pg8::gemm_phase<pg8::EpiRes<false>, pg8::StaticOrder, ALN, SP2, true>(glds, g, S, E); } SEAM(9);
#else
    if (IN(9)) { pg8::Gemm g{(const bf16_t*)(ws + OFF_ACT), (const bf16_t*)(ws + OFF_W_F2), MTOK, 1024, DFF / 2, DFF / 2, 0}; pg8::StaticOrder S; S.init(MTOK, 1024, F.G, F.bx);
        pg8::EpiRes<false> E{(const void*)(ws + OFF_H), (bf16_t*)(ws + OFF_S2), 1.f / WF2_SCALE}; pg8::gemm_phase<pg8::EpiRes<false>, pg8::StaticOrder, ALN, SP2, true>(glds, g, S, E); } SEAM(9);
#endif
    if (IN(10)) { phase_ln_bf16(F, (const bf16_t*)(ws + OFF_S2), (bf16_t*)(ws + OFF_X1), ws + OFF_X18, args.in[I_ELN2G], args.in[I_ELN2B]); phase_convert_odd(F, args); } SEAM(10);
    if (IN(11)) { pg8::Gemm g{(const bf16_t*)(ws + OFF_X18), (const bf16_t*)(ws + OFF_W_OIN), MTOK, 3072, 512, 512, 0}; pg8::StaticOrder S; S.init(MTOK, 3072, F.G, F.bx);
        pg8::EpiInO E{(bf16_t*)(ws + OFF_QKV), (float*)(ws + OFF_KMEAN), 1.f / WIN_SCALE}; pg8::gemm_phase<pg8::EpiInO, pg8::StaticOrder, ALN, SP2, true>(glds, g, S, E); } SEAM(11);
#ifdef MOBA_DENSE
    if (IN(12)) { phase_moba(F, ws, args.pad); } SEAM(12);
#else
    if (IN(12)) { phase_moba2(F, ws); } SEAM(12);
#endif
    if (IN(13)) { pg8::Gemm g{(const bf16_t*)(ws + OFF_O8), (const bf16_t*)(ws + OFF_W_OOUT), MTOK, 1024, 512, 512, 0}; pg8::StaticOrder S; S.init(MTOK, 1024, F.G, F.bx);
        pg8::EpiRes<false> E{(const void*)(ws + OFF_X1), (bf16_t*)(ws + OFF_S1O), 1.f / (OSC * WOUT_SCALE)}; pg8::gemm_phase<pg8::EpiRes<false>, pg8::StaticOrder, ALN, SP2, true>(glds, g, S, E); } SEAM(13);
    if (IN(14)) { phase_ln_router(F, (const bf16_t*)(ws + OFF_S1O), (bf16_t*)(ws + OFF_H2), args.in[I_OLN1G], args.in[I_OLN1B], args.in[I_OROUTER], ws); } SEAM(14);
    if (IN(15)) { phase_moe_gather(F, (const bf16_t*)(ws + OFF_H2), ws + OFF_XR, ws); } SEAM(15);
    if (IN(16)) {
        const int* GI = (const int*)(ws + OFF_GINFO);
        pg8::MoeOrder S; S.G = F.G; S.c = F.bx;
#pragma unroll
        for (int e = 0; e < 8; ++e) S.pend[e] = __builtin_amdgcn_readfirstlane(GI[e]);
        const int ngroups = S.pend[7] >> 8;
        for (int g0 = 0; g0 < ngroups; g0 += MOE_CHUNK) {
            S.g0 = g0; S.ng = (ngroups - g0) < MOE_CHUNK ? (ngroups - g0) : MOE_CHUNK;
            { S.nN = 28; pg8::Gemm g{(const bf16_t*)(ws + OFF_XR), (const bf16_t*)(ws + OFF_W_M13), 0, 2 * DFFE, 512, 512, (size_t)2 * DFFE * 512};
              pg8::EpiSwiglu8 E{ws + OFF_ACTM, DFFE, g0, 1.f / W13_SCALE}; pg8::gemm_phase<pg8::EpiSwiglu8, pg8::MoeOrder, ALN, MOE_SP2, true>(glds, g, S, E); }
            xcd_barrier(bar);
            { S.nN = 4; pg8::Gemm g{(const bf16_t*)(ws + OFF_ACTM - (size_t)g0 * 256 * DFFE), (const bf16_t*)(ws + OFF_W_M2), 0, 1024, DFFE / 2, DFFE / 2, (size_t)1024 * DFFE / 2};
              pg8::EpiStoreS E{(bf16_t*)(ws + OFF_YR), 1024, 1.f / W2_SCALE}; pg8::gemm_phase<pg8::EpiStoreS, pg8::MoeOrder, ALN, MOE_SP2, true>(glds, g, S, E); }
            xcd_barrier(bar);
        }
    }
    STAMP(17);
    if (IN(17)) { phase_final(F, (const bf16_t*)(ws + OFF_H2), (const bf16_t*)(ws + OFF_YR), args.in[I_OLN2G], args.in[I_OLN2B], args.out, ws); }
#ifdef TS_MODE
    STAMP(18);
    xcd_barrier(bar);
    { const int ia[2] = TS_SEL; float d[2];
      for (int q = 0; q < 2; ++q) { const int i = ia[q]; const unsigned long long t1 = (i == 5) ? TS[20] : ((i == 25) ? TS[6] : TS[i + 1]); const unsigned long long t0 = (i == 25) ? TS[20] : TS[i]; d[q] = (float)(t1 - t0) * 0.01f; }
      const float k = sqrtf(fmaxf(d[0], 1.f)), x = 10.f * fmaxf(d[1], 1.f);
      for (size_t i = (size_t)F.bx * NTHR + F.tid; i < (size_t)MTOK * 1024; i += (size_t)F.G * NTHR) args.out[i] = (i == 0) ? x : k; }
#endif
#undef IN
#undef SEAM
}

extern "C" void kernel_launch(void* const* d_in, const int* in_sizes, int n_in, void* d_out, int out_size, void* d_ws, size_t ws_size, hipStream_t stream) {
    static int grid = 0;
    if (grid == 0) {
        if (n_in != 33 || in_sizes[0] != MTOK * DM || out_size != MTOK * DM || ws_size < WS_END) { fprintf(stderr, "kernel_launch: unexpected problem (n_in %d, in0 %d, out %d, ws %zu < %zu)\n", n_in, n_in > 0 ? in_sizes[0] : -1, out_size, ws_size, (size_t)WS_END); grid = -1; return; }
        int dev = 0, cus = 0, per_cu = 0;
        if (hipGetDevice(&dev) != hipSuccess || hipDeviceGetAttribute(&cus, hipDeviceAttributeMultiprocessorCount, dev) != hipSuccess) { grid = -1; return; }
        if (hipFuncSetAttribute((const void*)fwd_kernel, hipFuncAttributeMaxDynamicSharedMemorySize, LDS_BYTES) != hipSuccess) { fprintf(stderr, "kernel_launch: hipFuncSetAttribute failed\n"); grid = -1; return; }
        if (hipOccupancyMaxActiveBlocksPerMultiprocessor(&per_cu, (const void*)fwd_kernel, NTHR, LDS_BYTES) != hipSuccess || per_cu < 1) fprintf(stderr, "kernel_launch: occupancy query reports %d\n", per_cu);
        (void)hipGetLastError();
        grid = cus > 256 ? 256 : cus;
    }
    if (grid < 0) return;
    hipMemsetAsync(d_ws, 0, CTL_ZERO_BYTES, stream);
    Args a{};
    for (int i = 0; i < 33; ++i) a.in[i] = (const float*)d_in[i];
    a.out = (float*)d_out; a.ws = (unsigned char*)d_ws;
#if MK_N_LAUNCHES == 1
    a.ph_lo = 0; a.ph_hi = NPHASE; a.li = 0;
    hipLaunchKernelGGL(fwd_kernel, dim3(grid), dim3(NTHR), LDS_BYTES, stream, a);
#else
    for (int p = 0; p < NPHASE; ++p) { a.ph_lo = p; a.ph_hi = p + 1; a.li = p;
#ifdef REP_PHASE
        if (p == REP_PHASE) { Args a2 = a;
#ifdef REP_PAD
            a2.pad = REP_PAD;
#endif
            for (int rep = 0; rep < REP_N; ++rep) { a2.li = NPHASE + rep; hipLaunchKernelGGL(fwd_kernel, dim3(grid), dim3(NTHR), LDS_BYTES, stream, a2); } }
#endif
        hipLaunchKernelGGL(fwd_kernel, dim3(grid), dim3(NTHR), LDS_BYTES, stream, a);
#ifdef DBG_MODE
        unsigned* D = (unsigned*)((unsigned char*)d_ws + OFF_DBG); unsigned char* ws = (unsigned char*)d_ws;
        switch (p) {
            case 1: hipLaunchKernelGGL(dbg::chk_in_e, dim3(64), dim3(256), 0, stream, a, D); break;
            case 2: hipLaunchKernelGGL(dbg::chk_q2, dim3(64), dim3(256), 0, stream, a, D); hipLaunchKernelGGL(dbg::chk_cmp, dim3(96), dim3(256), 0, stream, a, D); break;
            case 3: hipLaunchKernelGGL(dbg::chk_idx, dim3(64), dim3(256), 0, stream, a, D); break;
            case 4: hipLaunchKernelGGL(dbg::chk_sel, dim3(48), dim3(256), 0, stream, a, D); break;
            case 5: hipLaunchKernelGGL(dbg::chk_dsa, dim3(64), dim3(256), 0, stream, a, D); hipLaunchKernelGGL(dbg::chk_nsa, dim3(64), dim3(256), 0, stream, a, D); break;
            case 6: hipLaunchKernelGGL(dbg::chk_out_e, dim3(32), dim3(256), 0, stream, a, D); break;
            case 7: hipLaunchKernelGGL(dbg::chk_ln, dim3(32), dim3(256), 0, stream, (const bf16_t*)(ws + OFF_S1), (const bf16_t*)(ws + OFF_H), a.in[I_ELN1G], a.in[I_ELN1B], D, 12); break;
            case 8: hipLaunchKernelGGL(dbg::chk_ffn_up, dim3(16), dim3(256), 0, stream, a, D); break;
            case 9: hipLaunchKernelGGL(dbg::chk_ffn_dn, dim3(32), dim3(256), 0, stream, a, D); break;
            case 10: hipLaunchKernelGGL(dbg::chk_ln, dim3(32), dim3(256), 0, stream, (const bf16_t*)(ws + OFF_S2), (const bf16_t*)(ws + OFF_X1), a.in[I_ELN2G], a.in[I_ELN2B], D, 15); break;
            case 10 + 100: break;
            case 11: hipLaunchKernelGGL(dbg::chk_wmoe, dim3(16), dim3(256), 0, stream, a, D); hipLaunchKernelGGL(dbg::chk_in_o, dim3(32), dim3(256), 0, stream, a, D); break;
            case 12: hipLaunchKernelGGL(dbg::chk_moba, dim3(64), dim3(256), 0, stream, a, D); break;
            case 13: hipLaunchKernelGGL(dbg::chk_out_o, dim3(32), dim3(256), 0, stream, a, D); break;
            case 14: hipLaunchKernelGGL(dbg::chk_ln, dim3(32), dim3(256), 0, stream, (const bf16_t*)(ws + OFF_S1O), (const bf16_t*)(ws + OFF_H2), a.in[I_OLN1G], a.in[I_OLN1B], D, 19); break;
            case 15: hipLaunchKernelGGL(dbg::chk_route, dim3(1), dim3(256), 0, stream, a, D); break;
            case 16: hipLaunchKernelGGL(dbg::chk_actm, dim3(8), dim3(256), 0, stream, a, D); break;
            case 17:
#ifdef DBG_SIMPLE_FINAL
                hipLaunchKernelGGL(dbg::simple_final, dim3(MTOK / 4), dim3(256), 0, stream, a);
#endif
                hipLaunchKernelGGL(dbg::chk_moe, dim3(16), dim3(256), 0, stream, a, D); hipLaunchKernelGGL(dbg::report, dim3(1024), dim3(256), 0, stream, (float*)d_out, (const unsigned*)D, out_size); break;
            default: break;
        }
#endif
    }
#endif
}
```

```cpp
#include <hip/hip_runtime.h>
#include <cstdio>
#include <cstdint>

#define LAS __attribute__((address_space(3)))
#define GAS __attribute__((address_space(1)))
typedef unsigned short bf16_t;
typedef short bf16x8 __attribute__((ext_vector_type(8)));
typedef short s16x4 __attribute__((ext_vector_type(4)));
typedef float f32x2 __attribute__((ext_vector_type(2)));
typedef float f32x4 __attribute__((ext_vector_type(4)));
typedef float f32x16 __attribute__((ext_vector_type(16)));
typedef unsigned u32x2 __attribute__((ext_vector_type(2)));
typedef unsigned u32x4 __attribute__((ext_vector_type(4)));
typedef __bf16 bf16x2_t __attribute__((ext_vector_type(2)));
typedef _Float16 f16x2_t __attribute__((ext_vector_type(2)));

constexpr int DM = 1024, NB = 8, SEQ = 4096, MTOK = NB * SEQ;
constexpr int EVEN_IN = 1768, EVEN_INP = 1792, DFF = 2816, DFFE = 3584, NEXP = 8;
constexpr float ALPHA = 1.4142135623730951f;
constexpr float LOG2E = 1.4426950408889634f;
constexpr float QSCALE = 0.125f * LOG2E;
constexpr int NWAVES = 8, NTHR = 512;

__device__ __forceinline__ unsigned f2bf(float f) { unsigned u = __builtin_bit_cast(unsigned, f); return (u + 0x7fffu + ((u >> 16) & 1u)) >> 16; }
__device__ __forceinline__ unsigned pk2(float lo, float hi) { f32x2 v = {lo, hi}; bf16x2_t b = __builtin_convertvector(v, bf16x2_t); return __builtin_bit_cast(unsigned, b); }
__device__ __forceinline__ float bf2f(unsigned short h) { return __builtin_bit_cast(float, (unsigned)h << 16); }
__device__ __forceinline__ float bflo(unsigned w) { return __builtin_bit_cast(float, w << 16); }
__device__ __forceinline__ float bfhi(unsigned w) { return __builtin_bit_cast(float, w & 0xffff0000u); }
__device__ __forceinline__ float wave_sum(float v) {
#pragma unroll
    for (int o = 1; o < 64; o <<= 1) v += __shfl_xor(v, o);
    return v;
}
#define LDS_WAIT() asm volatile("s_waitcnt lgkmcnt(0)" ::: "memory")
#define VM_WAIT() asm volatile("s_waitcnt vmcnt(0)" ::: "memory")
namespace pg8 {
#define PG8_LAS __attribute__((address_space(3)))
typedef unsigned short bf16_t;
typedef short bf16x8 __attribute__((ext_vector_type(8)));
typedef float f32x4 __attribute__((ext_vector_type(4)));
typedef unsigned u32x4 __attribute__((ext_vector_type(4)));
constexpr int BM = 256, BK = 64, HALF = 128, HTB = HALF * BK * 2  , STAGE_BYTES = 8 * HTB, NXCD = 8, WGM = 8;

__host__ __device__ __forceinline__ int lds_byte(int r, int c) { const int st = (r >> 4) * 2 + (c >> 5), rr = r & 15, cc = c & 31, ob = rr * 64 + cc * 2; return st * 1024 + (ob ^ (((ob >> 9) & 1) << 5)); }
__host__ __device__ __forceinline__ void stage_rc(int b, int& R, int& C) { const int st = b / 1024, sb = b % 1024, swz = sb ^ (((sb >> 9) & 1) << 5); R = (st >> 1) * 16 + swz / 64; C = (st & 1) * 32 + (swz % 64) / 2; }
__host__ __device__ __forceinline__ int perm32(int rho) { const int n = rho >> 4, i = rho & 15; return 8 * (i >> 2) + 4 * n + (i & 3); }

struct Unit { int pm, pn, e; };
struct Gemm { const bf16_t* A; const bf16_t* Bt; int M, N, K; int lda; size_t bstride; };

struct StaticOrder {
    int nM, nN, nwg, G, c;
    __host__ __device__ void init(int M, int N, int G_, int c_) { nM = M / BM; nN = N / BM; nwg = nM * nN; G = G_; c = c_; }
    __host__ __device__ bool next(int i, Unit& u) const {
        const long L = (long)i * G + c; if (L >= nwg) return false;
        int wgid = (int)L; { const int q = nwg / NXCD, r = nwg % NXCD, xcd = wgid % NXCD, off = wgid / NXCD; wgid = (xcd < r ? xcd * (q + 1) : r * (q + 1) + (xcd - r) * q) + off; }
        const int nig = WGM * nN, gid = wgid / nig, fm = gid * WGM, gsz = (nM - fm) < WGM ? (nM - fm) : WGM;
        u.pm = fm + ((wgid % nig) % gsz); u.pn = (wgid % nig) / gsz; u.e = 0; return true;
    }
    __device__ __forceinline__ void a_ready(const Unit&) const {}
    __device__ __forceinline__ void done(const Unit&) const {}
};


typedef int v8i32_t __attribute__((ext_vector_type(8)));
typedef int v4i32_t __attribute__((ext_vector_type(4)));
__device__ __forceinline__ v8i32_t cat8(bf16x8 lo, bf16x8 hi) { const v4i32_t a = __builtin_bit_cast(v4i32_t, lo), b = __builtin_bit_cast(v4i32_t, hi); return (v8i32_t){a[0], a[1], a[2], a[3], b[0], b[1], b[2], b[3]}; }
template <class Epi, class Sched, bool ALIGN_EPI = false, bool SP2 = false, bool F8 = false, bool I8 = false>
__device__ __forceinline__ void gemm_phase(PG8_LAS unsigned char* lds, const Gemm g, const Sched& S, const Epi& E) {
    const int tid = threadIdx.x, wid = __builtin_amdgcn_readfirstlane(tid >> 6), lane = tid & 63, wr = wid >> 2, wc = wid & 3, fr = lane & 15, fq = lane >> 4;
    const int K = g.K, nt = K / BK;
    unsigned voffA[2], voffB[2];
#pragma unroll
    for (int i = 0; i < 2; ++i) { int R, C; stage_rc(tid * 16 + i * 8192, R, C); const int Rb = Epi::PERM ? ((R & ~31) + perm32(R & 31)) : R;
        voffA[i] = (unsigned)(R * g.lda + C) * 2u; voffB[i] = (unsigned)(Rb * K + C) * 2u; }
    const size_t kstep = (size_t)(BK * 2);
    const size_t hstep = (size_t)HALF * K * 2;
    const size_t tstep = 2 * hstep;
    const size_t hstepA = (size_t)HALF * g.lda * 2, tstepA = 2 * hstepA;
    const size_t estep = g.bstride * 2;
    const unsigned ldsw = (unsigned)wid * 1024u;
    const int aoff = lds_byte(wr * 64 + fr, fq * 8), boff = lds_byte(wc * 32 + fr, fq * 8);
#define PG8_SA(b, h) (((b) * 2 + (h)) * HTB)
#define PG8_SB(b, h) ((4 + (b) * 2 + (h)) * HTB)
#define PG8_STAGE(bufoff, gbase, voff) do { _Pragma("unroll") for (int _i = 0; _i < 2; ++_i) \
        __builtin_amdgcn_global_load_lds((const unsigned*)((const char*)(gbase) + (voff)[_i]), (PG8_LAS unsigned*)(lds + (bufoff) + ldsw + _i * 8192), 16, 0, 0); } while (0)
#define PG8_LDA(dst, b, h) do { _Pragma("unroll") for (int m = 0; m < 4; ++m) _Pragma("unroll") for (int k = 0; k < 2; ++k) dst[m][k] = *(const PG8_LAS bf16x8*)(lds + PG8_SA(b, h) + aoff + m * 2048 + k * 1024); } while (0)
#define PG8_LDB(dst, b, h) do { _Pragma("unroll") for (int n = 0; n < 2; ++n) _Pragma("unroll") for (int k = 0; k < 2; ++k) dst[n][k] = *(const PG8_LAS bf16x8*)(lds + PG8_SB(b, h) + boff + n * 2048 + k * 1024); } while (0)
#define PG8_MMA(ai, bj, At, Bt) do { __builtin_amdgcn_s_setprio(1); if constexpr (I8) { _Pragma("unroll") for (int m = 0; m < 4; ++m) _Pragma("unroll") for (int n = 0; n < 2; ++n) _Pragma("unroll") for (int k = 0; k < 2; ++k) \
        asm volatile("v_mfma_i32_16x16x64_i8 %0, %1, %2, %0" : "+v"(acc[ai][bj][m][n]) : "v"(Bt[n][k]), "v"(At[m][k])); } else if constexpr (F8) { _Pragma("unroll") for (int m = 0; m < 4; ++m) _Pragma("unroll") for (int n = 0; n < 2; ++n) \
        asm volatile("v_mfma_scale_f32_16x16x128_f8f6f4 %0, %1, %2, %0, %3, %3 op_sel_hi:[0,0,0]" : "+v"(acc[ai][bj][m][n]) : "v"(cat8(Bt[n][0], Bt[n][1])), "v"(cat8(At[m][0], At[m][1])), "v"(sc8)); } else { \
        _Pragma("unroll") for (int m = 0; m < 4; ++m) _Pragma("unroll") for (int n = 0; n < 2; ++n) _Pragma("unroll") for (int k = 0; k < 2; ++k) \
        acc[ai][bj][m][n] = __builtin_amdgcn_mfma_f32_16x16x32_bf16(Bt[n][k], At[m][k], acc[ai][bj][m][n], 0, 0, 0); } __builtin_amdgcn_s_setprio(0); } while (0)
#define PG8_WAIT_V(n) asm volatile("s_waitcnt vmcnt(" #n ")" ::: "memory")
#define PG8_WAIT_L(n) asm volatile("s_waitcnt lgkmcnt(" #n ")" ::: "memory")
#define PG8_BAR __builtin_amdgcn_s_barrier()
#define PG8_SCHED __builtin_amdgcn_sched_barrier(0)
    Unit cur, nxt; int ui = 0;
    if (!S.next(0, cur)) return;
    int sc8 = 0x7f7f7f7f; asm volatile("" : "+v"(sc8));
    f32x4 acc[2][2][4][2];
#pragma unroll
    for (int a = 0; a < 2; ++a)
#pragma unroll
        for (int b = 0; b < 2; ++b)
#pragma unroll
            for (int m = 0; m < 4; ++m)
#pragma unroll
                for (int n = 0; n < 2; ++n) acc[a][b][m][n] = (f32x4){0.f, 0.f, 0.f, 0.f};
    bf16x8 At[4][2], B0[2][2], B1[2][2];
    const char* cA = (const char*)g.A + (size_t)cur.pm * tstepA; const char* cB = (const char*)g.Bt + (size_t)cur.pn * tstep + (size_t)cur.e * estep;
    S.a_ready(cur);
    if constexpr (SP2) {
        PG8_STAGE(PG8_SB(0, 0), cB, voffB); PG8_STAGE(PG8_SB(0, 1), cB + hstep, voffB); PG8_STAGE(PG8_SA(0, 0), cA, voffA); PG8_STAGE(PG8_SA(0, 1), cA + hstepA, voffA);
        if (wr == 1) PG8_BAR;
        PG8_WAIT_V(2); PG8_BAR;
        PG8_STAGE(PG8_SB(1, 0), cB + kstep, voffB); PG8_STAGE(PG8_SA(1, 0), cA + kstep, voffA); PG8_STAGE(PG8_SB(1, 1), cB + hstep + kstep, voffB);
        PG8_WAIT_V(6); PG8_BAR;
    } else {
        PG8_STAGE(PG8_SB(0, 0), cB, voffB); PG8_STAGE(PG8_SA(0, 0), cA, voffA); PG8_STAGE(PG8_SB(0, 1), cB + hstep, voffB); PG8_STAGE(PG8_SA(0, 1), cA + hstepA, voffA);
        if (wr == 1) PG8_BAR;
        PG8_WAIT_V(4); PG8_BAR;
        PG8_STAGE(PG8_SB(1, 0), cB + kstep, voffB); PG8_STAGE(PG8_SA(1, 0), cA + kstep, voffA); PG8_STAGE(PG8_SB(1, 1), cB + hstep + kstep, voffB);
        PG8_WAIT_V(6); PG8_BAR;
    }
    for (;;) {
        const bool has_next = S.next(ui + 1, nxt);
        const char* nA = has_next ? (const char*)g.A + (size_t)nxt.pm * tstepA : cA; const char* nB = has_next ? (const char*)g.Bt + (size_t)nxt.pn * tstep + (size_t)nxt.e * estep : cB;
#pragma unroll 1
        for (int t = 0; t < nt; t += 2) {
            const bool last = (t == nt - 2);
            const char* a1 = cA + (size_t)(t + 1) * kstep;
            const char* a2 = last ? nA : cA + (size_t)(t + 2) * kstep; const char* b2 = last ? nB : cB + (size_t)(t + 2) * kstep;
            const char* a3 = a2 + kstep; const char* b3 = b2 + kstep;
            if (last && has_next) S.a_ready(nxt);
            if constexpr (SP2) {
            PG8_LDB(B0, 0, 0); PG8_LDB(B1, 0, 1); PG8_SCHED; PG8_LDA(At, 0, 0); PG8_STAGE(PG8_SA(1, 1), a1 + hstepA, voffA);
            PG8_WAIT_V(8); PG8_WAIT_L(0); PG8_BAR; PG8_MMA(0, 0, At, B0); PG8_MMA(0, 1, At, B1); PG8_BAR; PG8_SCHED;
            PG8_LDA(At, 0, 1); PG8_STAGE(PG8_SB(0, 0), b2, voffB); PG8_STAGE(PG8_SB(0, 1), b2 + hstep, voffB); PG8_STAGE(PG8_SA(0, 0), a2, voffA);
            PG8_WAIT_V(8); PG8_WAIT_L(0); PG8_BAR; PG8_MMA(1, 0, At, B0); PG8_MMA(1, 1, At, B1); PG8_BAR; PG8_SCHED;
            PG8_LDB(B0, 1, 0); PG8_LDB(B1, 1, 1); PG8_SCHED; PG8_LDA(At, 1, 0); PG8_STAGE(PG8_SA(0, 1), a2 + hstepA, voffA);
            PG8_WAIT_V(8); PG8_WAIT_L(0); PG8_BAR; PG8_MMA(0, 0, At, B0); PG8_MMA(0, 1, At, B1); PG8_BAR; PG8_SCHED;
            PG8_LDA(At, 1, 1); PG8_STAGE(PG8_SB(1, 0), b3, voffB); PG8_STAGE(PG8_SB(1, 1), b3 + hstep, voffB); PG8_STAGE(PG8_SA(1, 0), a3, voffA);
            PG8_WAIT_V(8); PG8_WAIT_L(0); PG8_BAR; PG8_MMA(1, 0, At, B0); PG8_MMA(1, 1, At, B1); PG8_BAR; PG8_SCHED;
            } else {
            PG8_LDB(B0, 0, 0); PG8_SCHED; PG8_LDA(At, 0, 0); PG8_STAGE(PG8_SA(1, 1), a1 + hstepA, voffA);
            PG8_WAIT_L(8); PG8_BAR; PG8_WAIT_L(0); PG8_MMA(0, 0, At, B0); PG8_BAR; PG8_SCHED;
            PG8_LDB(B1, 0, 1); PG8_STAGE(PG8_SB(0, 0), b2, voffB);
            PG8_BAR; PG8_WAIT_L(0); PG8_MMA(0, 1, At, B1); PG8_BAR;
            PG8_LDA(At, 0, 1); PG8_STAGE(PG8_SA(0, 0), a2, voffA);
            PG8_BAR; PG8_WAIT_L(0); PG8_MMA(1, 0, At, B0); PG8_BAR; PG8_SCHED;
            PG8_STAGE(PG8_SB(0, 1), b2 + hstep, voffB);
            PG8_WAIT_V(6); PG8_BAR; PG8_MMA(1, 1, At, B1); PG8_BAR;
            PG8_LDB(B0, 1, 0); PG8_SCHED; PG8_LDA(At, 1, 0); PG8_STAGE(PG8_SA(0, 1), a2 + hstepA, voffA);
            PG8_WAIT_L(8); PG8_BAR; PG8_WAIT_L(0); PG8_MMA(0, 0, At, B0); PG8_BAR; PG8_SCHED;
            PG8_LDB(B1, 1, 1); PG8_STAGE(PG8_SB(1, 0), b3, voffB);
            PG8_BAR; PG8_WAIT_L(0); PG8_MMA(0, 1, At, B1); PG8_BAR;
            PG8_LDA(At, 1, 1); PG8_STAGE(PG8_SA(1, 0), a3, voffA);
            PG8_BAR; PG8_WAIT_L(0); PG8_MMA(1, 0, At, B0); PG8_BAR; PG8_SCHED;
            PG8_STAGE(PG8_SB(1, 1), b3 + hstep, voffB);
            PG8_WAIT_V(6); PG8_BAR; PG8_MMA(1, 1, At, B1); PG8_BAR;
            }
        }
        if constexpr (ALIGN_EPI) { if (wr == 0) PG8_BAR; }
        if constexpr (F8 || I8) asm volatile("s_nop 15\n\ts_nop 15" ::: "memory");
        if constexpr (!Epi::AFTER_DRAIN) { E(acc, cur, wr, wc, fr, fq); S.done(cur); }
        if (!has_next) break;
#pragma unroll
        for (int a = 0; a < 2; ++a)
#pragma unroll
            for (int b = 0; b < 2; ++b)
#pragma unroll
                for (int m = 0; m < 4; ++m)
#pragma unroll
                    for (int n = 0; n < 2; ++n) acc[a][b][m][n] = (f32x4){0.f, 0.f, 0.f, 0.f};
        cur = nxt; cA = nA; cB = nB; ++ui;
        if constexpr (ALIGN_EPI) { if (wr == 1) PG8_BAR; }
    }
    PG8_WAIT_V(0);
    if constexpr (!ALIGN_EPI) { if (wr == 0) PG8_BAR; }
    PG8_BAR;
    if constexpr (Epi::AFTER_DRAIN) { E.fused(acc, cur, wr, wc, fr, fq, lds, wid, lane); S.done(cur); }
#undef PG8_SA
#undef PG8_SB
#undef PG8_STAGE
#undef PG8_LDA
#undef PG8_LDB
#undef PG8_MMA
#undef PG8_WAIT_V
#undef PG8_WAIT_L
#undef PG8_BAR
#undef PG8_SCHED
}
}

namespace pg8 {
typedef f32x4 Acc[2][2][4][2];
__device__ __forceinline__ u32x4 pack8(const f32x4 v0, const f32x4 v1) { u32x4 w; w.x = pk2(v0[0], v0[1]); w.y = pk2(v0[2], v0[3]); w.z = pk2(v1[0], v1[1]); w.w = pk2(v1[2], v1[3]); return w; }
__device__ __forceinline__ void unpack8(const u32x4 w, f32x4& a, f32x4& b) { a = (f32x4){bflo(w.x), bfhi(w.x), bflo(w.y), bfhi(w.y)}; b = (f32x4){bflo(w.z), bfhi(w.z), bflo(w.w), bfhi(w.w)}; }

struct EpiInE {
    static constexpr bool PERM = true, AFTER_DRAIN = false;
    bf16_t* Y1; float* ssq_q; float* ssq_kv;
    __device__ __forceinline__ void operator()(const Acc& acc, const Unit& u, int wr, int wc, int fr, int fq) const {
        bf16_t* base = Y1 + (size_t)u.pn * MTOK * 256;
        const float sc = (u.pn == 2 || u.pn == 3) ? QSCALE : 1.f;
        const int col0 = wc * 32 + 8 * fq;
#pragma unroll
        for (int ai = 0; ai < 2; ++ai)
#pragma unroll
            for (int m = 0; m < 4; ++m) {
                const int row = u.pm * BM + ai * HALF + wr * 64 + m * 16 + fr; bf16_t* rowp = base + (size_t)row * 256 + col0;
                float s0 = 0.f, s1 = 0.f;
#pragma unroll
                for (int bj = 0; bj < 2; ++bj) { const f32x4 v0 = acc[ai][bj][m][0], v1 = acc[ai][bj][m][1];
                    const float q = (v0[0] * v0[0] + v0[1] * v0[1]) + (v0[2] * v0[2] + v0[3] * v0[3]) + (v1[0] * v1[0] + v1[1] * v1[1]) + (v1[2] * v1[2] + v1[3] * v1[3]);
                    if (bj == 0) s0 = q; else s1 = q;
                    *(u32x4*)(rowp + bj * HALF) = pack8(v0 * sc, v1 * sc); }
                if (u.pn <= 1) {
                    float s = (u.pn == 0) ? (s0 + s1) : s0;
                    s += __shfl_xor(s, 16); s += __shfl_xor(s, 32);
                    if (fq == 0) (u.pn == 0 ? ssq_q : ssq_kv)[(size_t)row * 4 + wc] = s;
                }
            }
    }
};
struct EpiQ2 {
    static constexpr bool PERM = true, AFTER_DRAIN = false;
    bf16_t* QLAT; bf16_t* QIDX; const float* ssq_q;
    __device__ __forceinline__ void operator()(const Acc& acc, const Unit& u, int wr, int wc, int fr, int fq) const {
        bf16_t* base = (u.pn < 4) ? QLAT : QIDX; const float sc0 = (u.pn < 4) ? QSCALE : 1.f;
        const int col0 = (u.pn & 3) * 256 + wc * 32 + 8 * fq;
#pragma unroll
        for (int ai = 0; ai < 2; ++ai)
#pragma unroll
            for (int m = 0; m < 4; ++m) {
                const int row = u.pm * BM + ai * HALF + wr * 64 + m * 16 + fr; bf16_t* rowp = base + (size_t)row * 1024 + col0;
                const f32x4 sq = *(const f32x4*)(ssq_q + (size_t)row * 4); const float sc = sc0 * __builtin_amdgcn_rsqf(((sq[0] + sq[1]) + (sq[2] + sq[3])) * (1.f / 256.f) + 1e-6f);
#pragma unroll
                for (int bj = 0; bj < 2; ++bj) *(u32x4*)(rowp + bj * HALF) = pack8(acc[ai][bj][m][0] * sc, acc[ai][bj][m][1] * sc);
            }
    }
};
template <bool RES_F32> struct EpiRes {
    static constexpr bool PERM = true, AFTER_DRAIN = false;
    const void* res; bf16_t* S; float sc;
    __device__ __forceinline__ void operator()(const Acc& acc, const Unit& u, int wr, int wc, int fr, int fq) const {
        const int col0 = u.pn * BM + wc * 32 + 8 * fq;
#pragma unroll
        for (int ai = 0; ai < 2; ++ai)
#pragma unroll
            for (int m = 0; m < 4; ++m) {
                const size_t off = (size_t)(u.pm * BM + ai * HALF + wr * 64 + m * 16 + fr) * 1024 + col0;
#pragma unroll
                for (int bj = 0; bj < 2; ++bj) { f32x4 r0, r1;
                    if (RES_F32) { r0 = *(const f32x4*)((const float*)res + off + bj * HALF); r1 = *(const f32x4*)((const float*)res + off + bj * HALF + 4); }
                    else unpack8(*(const u32x4*)((const bf16_t*)res + off + bj * HALF), r0, r1);
                    *(u32x4*)(S + off + bj * HALF) = pack8(r0 * ALPHA + acc[ai][bj][m][0] * sc, r1 * ALPHA + acc[ai][bj][m][1] * sc); }
            }
    }
};
struct EpiSwiglu {
    static constexpr bool PERM = true, AFTER_DRAIN = false;
    bf16_t* O; int ldo; int pm0;
    __device__ __forceinline__ void operator()(const Acc& acc, const Unit& u, int wr, int wc, int fr, int fq) const {
        const int col0 = u.pn * HALF + wc * 32 + 8 * fq;
#pragma unroll
        for (int ai = 0; ai < 2; ++ai)
#pragma unroll
            for (int m = 0; m < 4; ++m) {
                bf16_t* rowp = O + (size_t)((u.pm - pm0) * BM + ai * HALF + wr * 64 + m * 16 + fr) * ldo + col0;
                f32x4 o[2];
#pragma unroll
                for (int n = 0; n < 2; ++n) { const f32x4 a = acc[ai][0][m][n], b = acc[ai][1][m][n];
#pragma unroll
                    for (int e = 0; e < 4; ++e) o[n][e] = a[e] * __builtin_amdgcn_rcpf(1.f + __expf(-a[e])) * b[e]; }
                *(u32x4*)rowp = pack8(o[0], o[1]);
            }
    }
};
struct EpiStore {
    static constexpr bool PERM = true, AFTER_DRAIN = false;
    bf16_t* O; int ldo;
    __device__ __forceinline__ void operator()(const Acc& acc, const Unit& u, int wr, int wc, int fr, int fq) const {
        const int col0 = u.pn * BM + wc * 32 + 8 * fq;
#pragma unroll
        for (int ai = 0; ai < 2; ++ai)
#pragma unroll
            for (int m = 0; m < 4; ++m) {
                bf16_t* rowp = O + (size_t)(u.pm * BM + ai * HALF + wr * 64 + m * 16 + fr) * ldo + col0;
#pragma unroll
                for (int bj = 0; bj < 2; ++bj) *(u32x4*)(rowp + bj * HALF) = pack8(acc[ai][bj][m][0], acc[ai][bj][m][1]);
            }
    }
};
struct EpiInO {
    static constexpr bool PERM = true, AFTER_DRAIN = false;
    bf16_t* QKV; float* kmean; float isc;
    __device__ __forceinline__ void operator()(const Acc& acc, const Unit& u, int wr, int wc, int fr, int fq) const {
        const int which = u.pn >> 2; bf16_t* base = QKV + (size_t)which * MTOK * 1024; const float sc = (which == 0) ? QSCALE * isc : isc;
        const int col0 = (u.pn & 3) * BM + wc * 32 + 8 * fq;
#pragma unroll
        for (int ai = 0; ai < 2; ++ai)
#pragma unroll
            for (int m = 0; m < 4; ++m) {
                bf16_t* rowp = base + (size_t)(u.pm * BM + ai * HALF + wr * 64 + m * 16 + fr) * 1024 + col0;
#pragma unroll
                for (int bj = 0; bj < 2; ++bj) *(u32x4*)(rowp + bj * HALF) = pack8(acc[ai][bj][m][0] * sc, acc[ai][bj][m][1] * sc);
            }
        if (which == 1) {
#pragma unroll
            for (int bj = 0; bj < 2; ++bj)
#pragma unroll
                for (int n = 0; n < 2; ++n) { f32x4 s = (f32x4){0.f, 0.f, 0.f, 0.f};
#pragma unroll
                    for (int ai = 0; ai < 2; ++ai)
#pragma unroll
                        for (int m = 0; m < 4; ++m) s += acc[ai][bj][m][n];
#pragma unroll
                    for (int e = 0; e < 4; ++e) { float v = s[e]; v += __shfl_xor(v, 1); v += __shfl_xor(v, 2); v += __shfl_xor(v, 4); v += __shfl_xor(v, 8);
                        if (fr == 0) kmean[((size_t)u.pm * 2 + wr) * 1024 + col0 + bj * HALF + 4 * n + e] = v; }
                }
        }
    }
};

__device__ __forceinline__ unsigned pk4_fp8(float a, float b, float c, float d) { int w = 0; w = __builtin_amdgcn_cvt_pk_fp8_f32(a, b, w, false); w = __builtin_amdgcn_cvt_pk_fp8_f32(c, d, w, true); return (unsigned)w; }
struct EpiSwiglu8 {
    static constexpr bool PERM = true, AFTER_DRAIN = false;
    unsigned char* O; int ldo; int pm0; float isc;
    __device__ __forceinline__ void operator()(const Acc& acc, const Unit& u, int wr, int wc, int fr, int fq) const {
        const int col0 = u.pn * HALF + wc * 32 + 8 * fq;
#pragma unroll
        for (int ai = 0; ai < 2; ++ai)
#pragma unroll
            for (int m = 0; m < 4; ++m) {
                unsigned char* rowp = O + (size_t)((u.pm - pm0) * BM + ai * HALF + wr * 64 + m * 16 + fr) * ldo + col0;
                f32x4 o[2];
#pragma unroll
                for (int n = 0; n < 2; ++n) { const f32x4 a = acc[ai][0][m][n] * isc, b = acc[ai][1][m][n] * isc;
#pragma unroll
                    for (int e = 0; e < 4; ++e) o[n][e] = a[e] * __builtin_amdgcn_rcpf(1.f + __expf(-a[e])) * b[e]; }
                u32x2 w; w.x = pk4_fp8(o[0][0], o[0][1], o[0][2], o[0][3]); w.y = pk4_fp8(o[1][0], o[1][1], o[1][2], o[1][3]);
                *(u32x2*)rowp = w;
            }
    }
};

struct EpiSwigluI8 {
    static constexpr bool PERM = true, AFTER_DRAIN = false;
    unsigned char* O; int ldo; const float* sa; const float* sw;
    __device__ __forceinline__ void operator()(const Acc& acc, const Unit& u, int wr, int wc, int fr, int fq) const {
        const int col0 = u.pn * HALF + wc * 32 + 8 * fq, bcol = u.pn * BM + wc * 32 + 8 * fq;
        f32x4 w1s[2], w3s[2];
#pragma unroll
        for (int n = 0; n < 2; ++n) { w1s[n] = *(const f32x4*)(sw + bcol + 4 * n); w3s[n] = *(const f32x4*)(sw + bcol + HALF + 4 * n); }
#pragma unroll
        for (int ai = 0; ai < 2; ++ai)
#pragma unroll
            for (int m = 0; m < 4; ++m) {
                const int row = u.pm * BM + ai * HALF + wr * 64 + m * 16 + fr; const float ra = sa[row];
                unsigned char* rowp = O + (size_t)row * ldo + col0;
                f32x4 o[2];
#pragma unroll
                for (int n = 0; n < 2; ++n) {
#pragma unroll
                    for (int e = 0; e < 4; ++e) { const float xa = acc[ai][0][m][n][e], xb = acc[ai][1][m][n][e];
                        const float a = (float)__float_as_int(xa) * ra * w1s[n][e], b = (float)__float_as_int(xb) * ra * w3s[n][e];
                        o[n][e] = a * __builtin_amdgcn_rcpf(1.f + __expf(-a)) * b; } }
                u32x2 w; w.x = pk4_fp8(o[0][0], o[0][1], o[0][2], o[0][3]); w.y = pk4_fp8(o[1][0], o[1][1], o[1][2], o[1][3]);
                *(u32x2*)rowp = w;
            }
    }
};
struct EpiStoreS {
    static constexpr bool PERM = true, AFTER_DRAIN = false;
    bf16_t* O; int ldo; float sc;
    __device__ __forceinline__ void operator()(const Acc& acc, const Unit& u, int wr, int wc, int fr, int fq) const {
        const int col0 = u.pn * BM + wc * 32 + 8 * fq;
#pragma unroll
        for (int ai = 0; ai < 2; ++ai)
#pragma unroll
            for (int m = 0; m < 4; ++m) {
                bf16_t* rowp = O + (size_t)(u.pm * BM + ai * HALF + wr * 64 + m * 16 + fr) * ldo + col0;
#pragma unroll
                for (int bj = 0; bj < 2; ++bj) *(u32x4*)(rowp + bj * HALF) = pack8(acc[ai][bj][m][0] * sc, acc[ai][bj][m][1] * sc);
            }
    }
};
struct MoeOrder {
    int g0, ng, nN, G, c; int pend[8];
    __device__ __forceinline__ bool next(int i, Unit& u) const {
        const int L = i * G + c; if (L >= ng * nN) return false;
        u.pm = g0 + L % ng; u.pn = L / ng; const int r = u.pm * 256; int e = 0;
#pragma unroll
        for (int k = 0; k < 7; ++k) e += (pend[k] <= r) ? 1 : 0;
        u.e = e; return true;
    }
    __device__ __forceinline__ void a_ready(const Unit&) const {}
    __device__ __forceinline__ void done(const Unit&) const {}
};
}

#ifndef FFN_F8
#define FFN_F8 0
#endif
constexpr size_t MiB = 1u << 20, KiB = 1u << 10;
constexpr size_t CTL_ZERO_BYTES = 2 * MiB;
constexpr int    MAX_LAUNCHES = 18;
constexpr size_t OFF_BAR = 16 * KiB;
constexpr size_t OFF_WGCNT = 1 * MiB + 512 * KiB;
constexpr size_t OFF_GINFO = OFF_WGCNT + 16 * KiB;
constexpr size_t OFF_DBG = OFF_GINFO + 1 * KiB;
constexpr size_t OFF_BT = 2 * MiB;
constexpr size_t OFF_CB = 2 * MiB + 16 * KiB;
constexpr size_t OFF_ROUTE = 2 * MiB + 64 * KiB;
constexpr size_t OFF_DEST = 2 * MiB + 512 * KiB;
constexpr size_t OFF_KC = 3 * MiB, OFF_VC = 3 * MiB + 512 * KiB;
constexpr size_t OFF_W_IN = 4 * MiB, OFF_W_Q2 = OFF_W_IN + (size_t)EVEN_INP * 1024 * 2, OFF_W_OUTE = OFF_W_Q2 + 2048 * 256 * 2, OFF_W_F13 = OFF_W_OUTE + 1024 * 1536 * 2,
                 OFF_W_F2 = OFF_W_F13 + (size_t)2 * DFF * 1024 * 2, OFF_CK1 = OFF_W_F2 + (size_t)1024 * DFF * 2, OFF_CV1 = OFF_CK1 + 64 * 2048 * 2, OFF_WE_END = OFF_CV1 + 64 * 2048 * 2;
static_assert(OFF_WE_END <= 30 * MiB, "even weights");
constexpr size_t OFF_W_OIN = 30 * MiB, OFF_W_OOUT = 36 * MiB, OFF_W_M13 = 38 * MiB, OFF_W_M2 = 94 * MiB;
constexpr size_t OFF_Y1 = 30 * MiB;
constexpr size_t OFF_CKVN = 142 * MiB;
constexpr size_t OFF_XB = 206 * MiB, OFF_QLAT = 206 * MiB, OFF_QIDX = 270 * MiB;
constexpr size_t OFF_SC = 334 * MiB, OFF_MASK = 464 * MiB, OFF_MIXIN = 334 * MiB;
constexpr size_t OFF_S1 = 206 * MiB, OFF_H = 270 * MiB, OFF_ACT = 30 * MiB, OFF_S2 = 334 * MiB, OFF_X1 = 398 * MiB, OFF_H8 = 464 * MiB;
constexpr size_t OFF_SA = 497 * MiB, OFF_SW = 497 * MiB + 256 * KiB, OFF_SAX = 497 * MiB + 512 * KiB, OFF_SWIN = 497 * MiB + 768 * KiB;
constexpr size_t OFF_X18 = 464 * MiB, OFF_O8 = 464 * MiB;
constexpr float OSC = 16.f, WOUT_SCALE = 64.f, WIN_SCALE = 32.f, WF13_SCALE = 32.f, WF2_SCALE = 128.f;
constexpr size_t OFF_QKV = 206 * MiB, OFF_S1O = 270 * MiB, OFF_H2 = 122 * MiB, OFF_ACTM = 186 * MiB, OFF_YR = 298 * MiB, OFF_XR = 430 * MiB;
constexpr float W13_SCALE = 32.f, W2_SCALE = 128.f;
constexpr size_t OFF_MST = 122 * MiB;
constexpr size_t OFF_SSQ_Q = 514 * MiB, OFF_SSQ_KV = 514 * MiB + 512 * KiB;
constexpr size_t OFF_KMEAN = 515 * MiB;
constexpr size_t WS_END = 516 * MiB;
constexpr int    MOE_CHUNK = 128;
constexpr size_t SCB_ELEMS = (size_t)64 * 64 * (64 * 65 / 2);

constexpr int LDS_BYTES = 160 * 1024;
constexpr int LDSCTL_OFF = LDS_BYTES - 512;

#define RLX_AGENT __ATOMIC_RELAXED, __HIP_MEMORY_SCOPE_AGENT
typedef GAS unsigned gu32;
#define XB_TMO      128
#define XB_XCNT(j)  (256  + 64 * (j))
#define XB_XSUB(j)  (1280 + 64 * (j))
#define XB_XGEN(j)  (2304 + 64 * (j))
#define XB_TOP      3328
#define XB_TOPGEN   3392
#define XCD_BAR_WORDS 3456
#define XB_SPIN_CAP (1u << 18)

__device__ __forceinline__ unsigned xb_ld(unsigned* p)              { return __hip_atomic_load(p, __ATOMIC_RELAXED, __HIP_MEMORY_SCOPE_AGENT); }
__device__ __forceinline__ unsigned xb_add(unsigned* p, unsigned v) { return __hip_atomic_fetch_add(p, v, __ATOMIC_RELAXED, __HIP_MEMORY_SCOPE_AGENT); }
__device__ __forceinline__ unsigned xb_xcc_id() { return (unsigned)__builtin_amdgcn_s_getreg((3 << 11) | 20) & 0xFu; }
#define XB_SPIN(cond, bar) do { unsigned _sp = 0; while (cond) { __builtin_amdgcn_s_sleep(1); \
    if ((++_sp & 255u) == 0u) { if (xb_ld(&(bar)[XB_TMO])) break; if (_sp > XB_SPIN_CAP) { atomicAdd(&(bar)[XB_TMO], 1u); break; } } } } while (0)

struct XcdBarrier {
    unsigned* bar; unsigned x;
    volatile LAS unsigned* st;
};

__device__ __forceinline__ XcdBarrier xcd_barrier_post(unsigned* bar, volatile LAS unsigned* st) {
    XcdBarrier b; b.bar = bar; b.x = xb_xcc_id(); b.st = st;
    if (threadIdx.x == 0) (void)xb_add(&bar[XB_XCNT(b.x)], 1u);
    return b;
}
__device__ __forceinline__ void xcd_barrier_complete(unsigned* bar, unsigned x, unsigned& nloc, unsigned& nx) {
    const unsigned G = gridDim.x * gridDim.y * gridDim.z;
    unsigned sum, cnt, mine, sp = 0u;
    for (;;) {
        sum = 0u; cnt = 0u; mine = 0u;
#pragma unroll
        for (unsigned j = 0; j < 16; ++j) { const unsigned c = xb_ld(&bar[XB_XCNT(j)]); sum += c; cnt += (c > 0u) ? 1u : 0u; mine = (j == x) ? c : mine; }
        if (sum == G) break;
        __builtin_amdgcn_s_sleep(1);
        if ((++sp & 255u) == 0u) { if (xb_ld(&bar[XB_TMO])) break; if (sp > XB_SPIN_CAP) { atomicAdd(&bar[XB_TMO], 1u); break; } }
    }
    nloc = mine > 0u ? mine : 1u; nx = cnt > 0u ? cnt : 1u;
}

__device__ __forceinline__ void xcd_barrier(const XcdBarrier& b) {
    asm volatile("s_waitcnt vmcnt(0)" ::: "memory");
    __syncthreads();
    if (threadIdx.x == 0) {
        unsigned* bar = b.bar;
        __builtin_amdgcn_s_waitcnt(0);
        unsigned nloc = b.st[0], nx = b.st[1];
        if (nloc == 0u) { xcd_barrier_complete(bar, b.x, nloc, nx); b.st[0] = nloc; b.st[1] = nx; }
        const unsigned old = xb_add(&bar[XB_XSUB(b.x)], 1u);
        const unsigned gen = old / nloc;
        if (old + 1u == (gen + 1u) * nloc) {
            __builtin_amdgcn_fence(__ATOMIC_RELEASE, "agent");
            asm volatile("s_waitcnt vmcnt(0)" ::: "memory");
            const unsigned og = xb_add(&bar[XB_TOP], 1u);
            const unsigned tg = og / nx;
            if (og + 1u == (tg + 1u) * nx) xb_add(&bar[XB_TOPGEN], 1u);
            else XB_SPIN(xb_ld(&bar[XB_TOPGEN]) == tg, bar);
            __builtin_amdgcn_fence(__ATOMIC_ACQUIRE, "agent");
            xb_add(&bar[XB_XGEN(b.x)], 1u);
            asm volatile("s_waitcnt vmcnt(0)" ::: "memory");
        } else {
            XB_SPIN(xb_ld(&bar[XB_XGEN(b.x)]) == gen, bar);
            __builtin_amdgcn_fence(__ATOMIC_ACQUIRE, "agent");
            asm volatile("s_waitcnt vmcnt(0)" ::: "memory");
        }
    }
    __syncthreads();
}

struct Frame {
    LAS unsigned char* lds;
    int tid, lane, wave, G, bx;
    int gw, NGW;
    unsigned char* ws;
    const float* const* in;
};
struct Args { const float* in[33]; float* out; unsigned char* ws; int ph_lo, ph_hi, li, pad; };
enum InIdx { I_X = 0, I_RELB, I_EWIN, I_EQN, I_EKVN, I_EWUQ, I_EWUK, I_EWUV, I_EWQIDX, I_EPOSK, I_EPOSV, I_ECK1, I_ECK2, I_ECV1, I_ECV2, I_EWOUT, I_ELN1G, I_ELN1B,
             I_EF1, I_EF3, I_EF2, I_ELN2G, I_ELN2B, I_OWIN, I_OWOUT, I_OLN1G, I_OLN1B, I_OROUTER, I_OM1, I_OM3, I_OM2, I_OLN2G, I_OLN2B };

template <class RowMap, class KScale>
__device__ __forceinline__ void transpose_item(const float* W, int K, int N, bf16_t* WT, int ldt, LAS float* scr, int item, int lane, RowMap rm, KScale ks) {
    const int nblk = (N + 63) >> 6, kb = item / nblk, nb = item - kb * nblk, k0 = 128 * kb, n = 64 * nb + lane;
    if (n >= N) return;
    const float* src = W + (size_t)k0 * N + n; bf16_t* dst = WT + (size_t)rm(n) * ldt + k0;
#pragma unroll 2
    for (int kk = 0; kk < 128; kk += 8) { float v[8];
#pragma unroll
        for (int i = 0; i < 8; ++i) v[i] = src[(size_t)(kk + i) * N] * ks(k0 + kk + i);
        u32x4 o; o.x = pk2(v[0], v[1]); o.y = pk2(v[2], v[3]); o.z = pk2(v[4], v[5]); o.w = pk2(v[6], v[7]);
        *(u32x4*)(dst + kk) = o; }
}
template <class RowMap>
__device__ __forceinline__ void transpose_item8(const float* W, int K, int N, unsigned char* WT, int ldt, int item, int lane, RowMap rm, float scale) {
    const int nblk = N >> 8, kb = item / nblk, nb = item - kb * nblk, k0 = 128 * kb, n = 256 * nb + 4 * lane;
    const float* src = W + (size_t)k0 * N + n;
    unsigned char* d0 = WT + (size_t)rm(n) * ldt + k0; unsigned char* d1 = WT + (size_t)rm(n + 1) * ldt + k0; unsigned char* d2 = WT + (size_t)rm(n + 2) * ldt + k0; unsigned char* d3 = WT + (size_t)rm(n + 3) * ldt + k0;
#pragma unroll 1
    for (int kk = 0; kk < 128; kk += 16) { f32x4 v[16];
#pragma unroll
        for (int i = 0; i < 16; ++i) v[i] = *(const f32x4*)(src + (size_t)(kk + i) * N) * scale;
#pragma unroll
        for (int c = 0; c < 4; ++c) { u32x4 o; o.x = pg8::pk4_fp8(v[0][c], v[1][c], v[2][c], v[3][c]); o.y = pg8::pk4_fp8(v[4][c], v[5][c], v[6][c], v[7][c]);
            o.z = pg8::pk4_fp8(v[8][c], v[9][c], v[10][c], v[11][c]); o.w = pg8::pk4_fp8(v[12][c], v[13][c], v[14][c], v[15][c]);
            *(u32x4*)((c == 0 ? d0 : c == 1 ? d1 : c == 2 ? d2 : d3) + kk) = o; } }
}
template <class RowMap>
__device__ __forceinline__ void transpose_item_i8(const float* W, int K, int N, unsigned char* WT, int ldt, float* sw, int item, int lane, RowMap rm) {
    const int c = lane & 7, kg = lane >> 3, n = 8 * item + c, ks = K >> 3, kbase = kg * ks;
    const float* src = W + (size_t)kbase * N + n; float mx = 0.f;
#pragma unroll 16
    for (int k = 0; k < ks; ++k) mx = fmaxf(mx, fabsf(src[(size_t)k * N]));
    mx = fmaxf(mx, __shfl_xor(mx, 8)); mx = fmaxf(mx, __shfl_xor(mx, 16)); mx = fmaxf(mx, __shfl_xor(mx, 32));
    mx = fmaxf(mx, 1e-20f); const float inv = 127.f / mx; const int dr = rm(n); if (kg == 0) sw[dr] = mx * (1.f / 127.f);
    unsigned char* dst = WT + (size_t)dr * ldt + kbase;
#pragma unroll 2
    for (int kk = 0; kk < ks; kk += 16) { unsigned w[4];
#pragma unroll
        for (int q = 0; q < 4; ++q) { const int q0 = (int)rintf(src[(size_t)(kk + 4 * q) * N] * inv), q1 = (int)rintf(src[(size_t)(kk + 4 * q + 1) * N] * inv), q2 = (int)rintf(src[(size_t)(kk + 4 * q + 2) * N] * inv), q3 = (int)rintf(src[(size_t)(kk + 4 * q + 3) * N] * inv);
            w[q] = (unsigned)(q0 & 255) | ((unsigned)(q1 & 255) << 8) | ((unsigned)(q2 & 255) << 16) | ((unsigned)(q3 & 255) << 24); }
        *(u32x4*)(dst + kk) = (u32x4){w[0], w[1], w[2], w[3]}; }
}
struct RowId { __device__ __forceinline__ int operator()(int n) const { return n; } };
struct KOne { __device__ __forceinline__ float operator()(int) const { return 1.f; } };
struct RowInE {
    __device__ __forceinline__ int operator()(int n) const { return n < 464 ? n : (n < 1744 ? n + 48 : n - 1744 + 464); }
};
struct RowIlv {
    int add; __device__ __forceinline__ int operator()(int n) const { return ((n >> 7) << 8) + (n & 127) + add; }
};
struct KGain { const float* g; __device__ __forceinline__ float operator()(int k) const { return g[k]; } };

__device__ __forceinline__ void store_row_i8(unsigned char* row, float* sa, int lane, const f32x4 (&v)[4]) {
    float mx = 0.f;
#pragma unroll
    for (int j = 0; j < 4; ++j) mx = fmaxf(fmaxf(mx, fmaxf(fabsf(v[j][0]), fabsf(v[j][1]))), fmaxf(fabsf(v[j][2]), fabsf(v[j][3])));
#pragma unroll
    for (int o = 1; o < 64; o <<= 1) mx = fmaxf(mx, __shfl_xor(mx, o));
    mx = fmaxf(mx, 1e-20f); const float inv = 127.f / mx;
#pragma unroll
    for (int j = 0; j < 4; ++j) { const int q0 = (int)rintf(v[j][0] * inv), q1 = (int)rintf(v[j][1] * inv), q2 = (int)rintf(v[j][2] * inv), q3 = (int)rintf(v[j][3] * inv);
        *(unsigned*)(row + 4 * lane + 256 * j) = (unsigned)(q0 & 255) | ((unsigned)(q1 & 255) << 8) | ((unsigned)(q2 & 255) << 16) | ((unsigned)(q3 & 255) << 24); }
    if (lane == 0) *sa = mx * (1.f / 127.f);
}
__device__ __forceinline__ int t5_bucket(int n) {
    if (n < 16) return n;
    int l = 16 + (int)(__logf((float)n / 16.f) / 2.0794415f * 16.f);
    return l < 31 ? l : 31;
}

__device__ __forceinline__ void phase_prologue_even(const Frame& F, const Args& a) {
    LAS float* scr = (LAS float*)(F.lds + F.wave * 8704);
    unsigned char* ws = F.ws;
    bf16_t* W_IN = (bf16_t*)(ws + OFF_W_IN); bf16_t* W_Q2 = (bf16_t*)(ws + OFF_W_Q2); unsigned char* W_OUTE = ws + OFF_W_OUTE;
    unsigned char* W_F13 = ws + OFF_W_F13; unsigned char* W_F2 = ws + OFF_W_F2; bf16_t* CK1 = (bf16_t*)(ws + OFF_CK1); bf16_t* CV1 = (bf16_t*)(ws + OFF_CV1);
    constexpr int I_IN = 8 * ((EVEN_IN + 63) / 64);
    constexpr int I_QI = 2 * 16;
    constexpr int I_OB = 4 * 4;
    constexpr int I_F1 = DFF / 8, I_F2 = (DFF / 128) * 4;
    constexpr int I_CK = 16 * 1;
    constexpr int NIT = I_IN + I_QI + I_OB + 2 * I_F1 + I_F2 + 2 * I_CK;
    for (int it = F.gw; it < NIT; it += F.NGW) {
        int r = it;
        if (r < I_IN) { transpose_item(a.in[I_EWIN], 1024, EVEN_IN, W_IN, 1024, scr, r, F.lane, RowInE{}, KOne{}); continue; } r -= I_IN;
        if (r < I_QI) { transpose_item(a.in[I_EWQIDX], 256, 1024, W_Q2 + 1024 * 256, 256, scr, r, F.lane, RowId{}, KGain{a.in[I_EQN]}); continue; } r -= I_QI;
        if (r < I_OB) { transpose_item8(a.in[I_EWOUT] + 512 * 1024, 512, 1024, W_OUTE + 1024, 1536, r, F.lane, RowId{}, WOUT_SCALE); continue; } r -= I_OB;
#if FFN_F8
        if (r < I_F1) { transpose_item8(a.in[I_EF1], 1024, DFF, W_F13, 1024, r, F.lane, RowIlv{0}, WF13_SCALE); continue; } r -= I_F1;
        if (r < I_F1) { transpose_item8(a.in[I_EF3], 1024, DFF, W_F13, 1024, r, F.lane, RowIlv{128}, WF13_SCALE); continue; } r -= I_F1;
        if (r < I_F2) { transpose_item8(a.in[I_EF2], DFF, 1024, W_F2, DFF, r, F.lane, RowId{}, WF2_SCALE); continue; } r -= I_F2;
#else
        if (r < I_F1) { transpose_item_i8(a.in[I_EF1], 1024, DFF, W_F13, 1024, (float*)(ws + OFF_SW), r, F.lane, RowIlv{0}); continue; } r -= I_F1;
        if (r < I_F1) { transpose_item_i8(a.in[I_EF3], 1024, DFF, W_F13, 1024, (float*)(ws + OFF_SW), r, F.lane, RowIlv{128}); continue; } r -= I_F1;
        if (r < I_F2) { transpose_item8(a.in[I_EF2], DFF, 1024, W_F2, DFF, r, F.lane, RowId{}, WF2_SCALE); continue; } r -= I_F2;
#endif
        if (r < I_CK) { transpose_item(a.in[I_ECK1], 2048, 64, CK1, 2048, scr, r, F.lane, RowId{}, KOne{}); continue; } r -= I_CK;
        transpose_item(a.in[I_ECV1], 2048, 64, CV1, 2048, scr, r, F.lane, RowId{}, KOne{});
    }
    const int gt = F.bx * NTHR + F.tid, NGT = F.G * NTHR;
    for (int i = gt; i < 24 * 1024 / 8; i += NGT) ((u32x4*)(W_IN + 488 * 1024))[i] = (u32x4){0u, 0u, 0u, 0u};
    { const float* uq = a.in[I_EWUQ]; const float* uk = a.in[I_EWUK]; const float* qg = a.in[I_EQN];
      for (int o = gt; o < 1024 * 256; o += NGT) { const int r = o & 255, hc = o >> 8, h = hc >> 7, c = hc & 127; const float* p = uq + r * 512 + h * 64; const float* q = uk + c * 512 + h * 64; float s = 0.f;
#pragma unroll 8
          for (int d = 0; d < 64; ++d) s += p[d] * q[d];
          W_Q2[o] = (bf16_t)f2bf(s * qg[r]); } }
    { const float* uv = a.in[I_EWUV]; const float* wo = a.in[I_EWOUT];
      for (int o = gt; o < 1024 * 1024 / 16; o += NGT) { const int nb = o & 255, hc4 = o >> 8, h = hc4 >> 5, c0 = (hc4 & 31) * 4, n0 = nb * 4;
          const float* p = uv + (size_t)c0 * 512 + h * 64; const float* q = wo + (size_t)(h * 64) * 1024 + n0;
          f32x4 acc4[4] = {(f32x4){0.f, 0.f, 0.f, 0.f}, (f32x4){0.f, 0.f, 0.f, 0.f}, (f32x4){0.f, 0.f, 0.f, 0.f}, (f32x4){0.f, 0.f, 0.f, 0.f}};
#pragma unroll 4
          for (int d = 0; d < 64; ++d) { const f32x4 qv = *(const f32x4*)(q + (size_t)d * 1024);
#pragma unroll
              for (int cc = 0; cc < 4; ++cc) acc4[cc] += qv * p[cc * 512 + d]; }
#pragma unroll
          for (int cc = 0; cc < 4; ++cc)
#pragma unroll
              for (int e = 0; e < 4; ++e) W_OUTE[(size_t)(n0 + e) * 1536 + h * 128 + c0 + cc] = (unsigned char)(__builtin_amdgcn_cvt_pk_fp8_f32(acc4[cc][e] * WOUT_SCALE, 0.f, 0, false) & 0xff); } }
    if (F.bx == 0) { float* BT = (float*)(ws + OFF_BT); const float* rb = a.in[I_RELB];
        for (int i = F.tid; i < 16 * 128; i += NTHR) { const int h = i >> 7, d = i & 127; BT[i] = rb[t5_bucket(d) * 16 + h] * LOG2E; } }
    if (F.bx == 1 && F.tid < 128) { const int kv = F.tid >> 6, e = F.tid & 63; const float* pos = a.in[kv ? I_EPOSV : I_EPOSK]; const float* w1 = a.in[kv ? I_ECV1 : I_ECK1]; float s = 0.f;
        for (int k = 0; k < 2048; ++k) s += pos[k] * w1[k * 64 + e];
        ((float*)(ws + OFF_CB))[F.tid] = s; }
    { const f32x4* x4 = (const f32x4*)a.in[I_X]; u32x4* xb = (u32x4*)(ws + OFF_XB);
      for (int i = gt; i < MTOK * 1024 / 8; i += NGT) { const f32x4 v0 = x4[2 * i], v1 = x4[2 * i + 1]; xb[i] = pg8::pack8(v0, v1); } }
}

__device__ __forceinline__ void phase_convert_odd(const Frame& F, const Args& a) {
    LAS float* scr = (LAS float*)(F.lds + F.wave * 8704);
    unsigned char* ws = F.ws;
    unsigned char* W_OIN = ws + OFF_W_OIN; unsigned char* W_OOUT = ws + OFF_W_OOUT; unsigned char* W_M13 = ws + OFF_W_M13; unsigned char* W_M2 = ws + OFF_W_M2;
    constexpr int I_IN = 8 * 12, I_OUT = 8 * 4, I_M1 = 8 * (DFFE / 256), I_M2 = (DFFE / 128) * 4;
    constexpr int NIT = I_IN + I_OUT + NEXP * (2 * I_M1 + I_M2);
    for (int it = F.gw; it < NIT; it += F.NGW) {
        int r = it;
        if (r < I_IN) { transpose_item8(a.in[I_OWIN], 1024, 3072, W_OIN, 1024, r, F.lane, RowId{}, WIN_SCALE); continue; } r -= I_IN;
        if (r < I_OUT) { transpose_item8(a.in[I_OWOUT], 1024, 1024, W_OOUT, 1024, r, F.lane, RowId{}, WOUT_SCALE); continue; } r -= I_OUT;
        const int e = r / (2 * I_M1 + I_M2); r -= e * (2 * I_M1 + I_M2);
        if (r < I_M1) { transpose_item8(a.in[I_OM1] + (size_t)e * 1024 * DFFE, 1024, DFFE, W_M13 + (size_t)e * 2 * DFFE * 1024, 1024, r, F.lane, RowIlv{0}, W13_SCALE); continue; } r -= I_M1;
        if (r < I_M1) { transpose_item8(a.in[I_OM3] + (size_t)e * 1024 * DFFE, 1024, DFFE, W_M13 + (size_t)e * 2 * DFFE * 1024, 1024, r, F.lane, RowIlv{128}, W13_SCALE); continue; } r -= I_M1;
        transpose_item8(a.in[I_OM2] + (size_t)e * DFFE * 1024, DFFE, 1024, W_M2 + (size_t)e * 1024 * DFFE, DFFE, r, F.lane, RowId{}, W2_SCALE);
    }
}

__device__ __forceinline__ void load_row_bf16(const bf16_t* row, int lane, f32x4 (&v)[4]) {
#pragma unroll
    for (int j = 0; j < 4; ++j) { const u32x2 w = *(const u32x2*)(row + 4 * lane + 256 * j); v[j] = (f32x4){bflo(w.x), bfhi(w.x), bflo(w.y), bfhi(w.y)}; }
}
__device__ __forceinline__ void store_row_bf16(bf16_t* row, int lane, const f32x4 (&v)[4]) {
#pragma unroll
    for (int j = 0; j < 4; ++j) { u32x2 w; w.x = pk2(v[j][0], v[j][1]); w.y = pk2(v[j][2], v[j][3]); *(u32x2*)(row + 4 * lane + 256 * j) = w; }
}
__device__ __forceinline__ void ln_inplace(f32x4 (&v)[4], const f32x4 (&g)[4], const f32x4 (&b)[4]) {
    float s = 0.f;
#pragma unroll
    for (int j = 0; j < 4; ++j) s += (v[j][0] + v[j][1]) + (v[j][2] + v[j][3]);
    const float mean = wave_sum(s) * (1.f / 1024.f); float q = 0.f;
#pragma unroll
    for (int j = 0; j < 4; ++j) { v[j] = v[j] - mean; q += (v[j][0] * v[j][0] + v[j][1] * v[j][1]) + (v[j][2] * v[j][2] + v[j][3] * v[j][3]); }
    const float rstd = 1.f / sqrtf(wave_sum(q) * (1.f / 1024.f) + 1e-5f);
#pragma unroll
    for (int j = 0; j < 4; ++j) v[j] = v[j] * rstd * g[j] + b[j];
}
__device__ __forceinline__ void load_gb(const float* g, const float* b, int lane, f32x4 (&gv)[4], f32x4 (&bv)[4]) {
#pragma unroll
    for (int j = 0; j < 4; ++j) { gv[j] = *(const f32x4*)(g + 4 * lane + 256 * j); bv[j] = *(const f32x4*)(b + 4 * lane + 256 * j); }
}
__device__ __forceinline__ void store_row_fp8(unsigned char* row, int lane, const f32x4 (&v)[4]) {
#pragma unroll
    for (int j = 0; j < 4; ++j) *(unsigned*)(row + 4 * lane + 256 * j) = pg8::pk4_fp8(v[j][0], v[j][1], v[j][2], v[j][3]);
}
__device__ __forceinline__ void phase_ln_bf16(const Frame& F, const bf16_t* S, bf16_t* O, unsigned char* O8, const float* g, const float* b) {
    f32x4 gv[4], bv[4]; load_gb(g, b, F.lane, gv, bv);
    for (int row = F.gw; row < MTOK; row += F.NGW) { f32x4 v[4]; load_row_bf16(S + (size_t)row * 1024, F.lane, v); ln_inplace(v, gv, bv); store_row_bf16(O + (size_t)row * 1024, F.lane, v); store_row_fp8(O8 + (size_t)row * 1024, F.lane, v); }
}
__device__ __forceinline__ void phase_ln_i8(const Frame& F, const bf16_t* S, bf16_t* O, unsigned char* O8, float* sa, const float* g, const float* b) {
    f32x4 gv[4], bv[4]; load_gb(g, b, F.lane, gv, bv);
    for (int row = F.gw; row < MTOK; row += F.NGW) { f32x4 v[4]; load_row_bf16(S + (size_t)row * 1024, F.lane, v); ln_inplace(v, gv, bv); store_row_bf16(O + (size_t)row * 1024, F.lane, v); store_row_i8(O8 + (size_t)row * 1024, sa + row, F.lane, v); }
}
__device__ __forceinline__ void phase_ckvn(const Frame& F, const bf16_t* T1, const float* ssq_kv, const float* gain, bf16_t* CKVN) {
    const float g0 = gain[2 * F.lane], g1 = gain[2 * F.lane + 1];
    for (int row = F.gw; row < MTOK; row += F.NGW) {
        const unsigned w = *(const unsigned*)(T1 + (size_t)row * 256 + 2 * F.lane);
        const f32x4 sq = *(const f32x4*)(ssq_kv + (size_t)row * 4); const float r = __builtin_amdgcn_rsqf(((sq[0] + sq[1]) + (sq[2] + sq[3])) * (1.f / 128.f) + 1e-6f);
        *(unsigned*)(CKVN + (size_t)row * 128 + 2 * F.lane) = pk2(bflo(w) * r * g0, bfhi(w) * r * g1);
    }
}
__device__ __forceinline__ void phase_ln_router(const Frame& F, const bf16_t* S, bf16_t* H2, const float* g, const float* b, const float* router, unsigned char* ws) {
    LAS int* cnt = (LAS int*)(F.lds);
    if (F.tid < 8) cnt[F.tid] = 0;
    __syncthreads();
    f32x4 gv[4], bv[4]; load_gb(g, b, F.lane, gv, bv);
    u32x2* ROUTE = (u32x2*)(ws + OFF_ROUTE);
    f32x4 rw[16][2];
#pragma unroll
    for (int j = 0; j < 4; ++j)
#pragma unroll
        for (int e = 0; e < 4; ++e) { const float* rp = router + (size_t)(4 * F.lane + 256 * j + e) * 8; rw[4 * j + e][0] = *(const f32x4*)rp; rw[4 * j + e][1] = *(const f32x4*)(rp + 4); }
    const bool b0 = F.lane & 1, b1 = F.lane & 2, b2 = F.lane & 4;
    for (int row = F.gw; row < MTOK; row += F.NGW) {
        f32x4 v[4]; load_row_bf16(S + (size_t)row * 1024, F.lane, v); ln_inplace(v, gv, bv); store_row_bf16(H2 + (size_t)row * 1024, F.lane, v);
        float pl[8];
#pragma unroll
        for (int x = 0; x < 8; ++x) pl[x] = 0.f;
#pragma unroll
        for (int j = 0; j < 4; ++j)
#pragma unroll
            for (int e = 0; e < 4; ++e) { const f32x4 r0 = rw[4 * j + e][0], r1 = rw[4 * j + e][1]; const float hv = v[j][e];
                pl[0] += hv * r0[0]; pl[1] += hv * r0[1]; pl[2] += hv * r0[2]; pl[3] += hv * r0[3]; pl[4] += hv * r1[0]; pl[5] += hv * r1[1]; pl[6] += hv * r1[2]; pl[7] += hv * r1[3]; }
        float k4[4], k2[2], k1;
#pragma unroll
        for (int i = 0; i < 4; ++i) { const float send = b0 ? pl[i] : pl[i + 4]; k4[i] = (b0 ? pl[i + 4] : pl[i]) + __shfl_xor(send, 1); }
#pragma unroll
        for (int i = 0; i < 2; ++i) { const float send = b1 ? k4[i] : k4[i + 2]; k2[i] = (b1 ? k4[i + 2] : k4[i]) + __shfl_xor(send, 2); }
        { const float send = b2 ? k2[0] : k2[1]; k1 = (b2 ? k2[1] : k2[0]) + __shfl_xor(send, 4); }
        k1 += __shfl_xor(k1, 8); k1 += __shfl_xor(k1, 16); k1 += __shfl_xor(k1, 32);
        float lg[8];
#pragma unroll
        for (int x = 0; x < 8; ++x) lg[x] = __int_as_float(__builtin_amdgcn_readlane(__float_as_int(k1), (x >> 2) | (((x >> 1) & 1) << 1) | ((x & 1) << 2)));
        int e0 = 0; float l0 = lg[0];
#pragma unroll
        for (int x = 1; x < 8; ++x) if (lg[x] > l0) { l0 = lg[x]; e0 = x; }
        int e1 = -1; float l1 = -INFINITY;
#pragma unroll
        for (int x = 0; x < 8; ++x) if (x != e0 && lg[x] > l1) { l1 = lg[x]; e1 = x; }
        const float g0 = 1.f / (1.f + __expf(l1 - l0));
        if (F.lane == 0) { u32x2 r; r.x = (unsigned)e0 | ((unsigned)e1 << 8); r.y = __builtin_bit_cast(unsigned, g0); ROUTE[row] = r;
            __hip_atomic_fetch_add(cnt + e0, 1, __ATOMIC_RELAXED, __HIP_MEMORY_SCOPE_WORKGROUP); __hip_atomic_fetch_add(cnt + e1, 1, __ATOMIC_RELAXED, __HIP_MEMORY_SCOPE_WORKGROUP); }
    }
    __syncthreads();
    if (F.tid < 8) ((int*)(ws + OFF_WGCNT))[F.bx * 8 + F.tid] = cnt[F.tid];
    __syncthreads();
}
__device__ __forceinline__ void phase_moe_gather(const Frame& F, const bf16_t* H2, unsigned char* XR, unsigned char* ws) {
    LAS int* L = (LAS int*)(F.lds);
    const int* WGCNT = (const int*)(ws + OFF_WGCNT);
    { const int e = F.wave; int t = 0, p = 0;
#pragma unroll
      for (int k = 0; k < 4; ++k) { const int wg = F.lane + 64 * k; const int c = (wg < F.G) ? WGCNT[wg * 8 + e] : 0; t += c; p += (wg < F.bx) ? c : 0; }
      t = (int)wave_sum((float)t); p = (int)wave_sum((float)p);
      if (F.lane == 0) { L[e] = t; L[8 + e] = p; L[24 + e] = 0; } }
    __syncthreads();
    if (F.tid == 0) { int acc = 0;
        for (int e = 0; e < 8; ++e) { const int pad = (L[e] + 255) / 256 * 256; L[32 + e] = acc; L[16 + e] = acc + L[8 + e]; acc += pad; L[40 + e] = acc; }
        if (F.bx == 0) { int* GI = (int*)(ws + OFF_GINFO); for (int e = 0; e < 8; ++e) { GI[e] = L[40 + e]; GI[8 + e] = L[e]; } } }
    __syncthreads();
    const u32x2* ROUTE = (const u32x2*)(ws + OFF_ROUTE); int* DEST = (int*)(ws + OFF_DEST);
    for (int row = F.gw; row < MTOK; row += F.NGW) {
        const u32x2 r = ROUTE[row]; const int e0 = r.x & 255, e1 = (r.x >> 8) & 255; int s0 = 0, s1 = 0;
        if (F.lane == 0) { s0 = L[16 + e0] + __hip_atomic_fetch_add(L + 24 + e0, 1, __ATOMIC_RELAXED, __HIP_MEMORY_SCOPE_WORKGROUP); s1 = L[16 + e1] + __hip_atomic_fetch_add(L + 24 + e1, 1, __ATOMIC_RELAXED, __HIP_MEMORY_SCOPE_WORKGROUP);
            DEST[2 * row] = s0; DEST[2 * row + 1] = s1; }
        s0 = __builtin_amdgcn_readfirstlane(s0); s1 = __builtin_amdgcn_readfirstlane(s1);
        const u32x4* src = (const u32x4*)(H2 + (size_t)row * 1024) + 2 * F.lane; const u32x4 a = src[0], b = src[1];
        u32x4 o; o.x = pg8::pk4_fp8(bflo(a.x), bfhi(a.x), bflo(a.y), bfhi(a.y)); o.y = pg8::pk4_fp8(bflo(a.z), bfhi(a.z), bflo(a.w), bfhi(a.w));
        o.z = pg8::pk4_fp8(bflo(b.x), bfhi(b.x), bflo(b.y), bfhi(b.y)); o.w = pg8::pk4_fp8(bflo(b.z), bfhi(b.z), bflo(b.w), bfhi(b.w));
        ((u32x4*)(XR + (size_t)s0 * 1024))[F.lane] = o; ((u32x4*)(XR + (size_t)s1 * 1024))[F.lane] = o;
    }
    for (int e = 0; e < 8; ++e) { const int r0 = L[32 + e] + L[e], npad = L[40 + e] - r0;
        for (int i = F.gw; i < npad; i += F.NGW) { u32x4* d = (u32x4*)(XR + (size_t)(r0 + i) * 1024); d[F.lane] = (u32x4){0u, 0u, 0u, 0u}; } }
    __syncthreads();
}
__device__ __forceinline__ void phase_final(const Frame& F, const bf16_t* H2, const bf16_t* YR, const float* g, const float* b, float* out, unsigned char* ws) {
    f32x4 gv[4], bv[4]; load_gb(g, b, F.lane, gv, bv);
    const u32x2* ROUTE = (const u32x2*)(ws + OFF_ROUTE); const int* DEST = (const int*)(ws + OFF_DEST);
    for (int row = F.gw; row < MTOK; row += F.NGW) {
        const u32x2 rte = ROUTE[row]; const float g0 = __uint_as_float(rte.y), g1 = 1.f - g0;   const int d0 = DEST[2 * row], d1 = DEST[2 * row + 1];
        f32x4 v[4], y0[4], y1[4]; load_row_bf16(H2 + (size_t)row * 1024, F.lane, v); load_row_bf16(YR + (size_t)d0 * 1024, F.lane, y0); load_row_bf16(YR + (size_t)d1 * 1024, F.lane, y1);
#pragma unroll
        for (int j = 0; j < 4; ++j) v[j] = v[j] * ALPHA + y0[j] * g0 + y1[j] * g1;
        ln_inplace(v, gv, bv);
#pragma unroll
        for (int j = 0; j < 4; ++j) *(f32x4*)(out + (size_t)row * 1024 + 4 * F.lane + 256 * j) = v[j];
    }
}

namespace att {
constexpr float NEG_BIG = -1e30f;
constexpr int KS64 = 144, VS64 = 192, KT64 = 64 * KS64, VT64 = 64 * VS64;
constexpr int KS128 = 272, VS128 = 320, KT128 = 64 * KS128, VT128 = 64 * VS128;
typedef LAS char* lptr; typedef const LAS char* lcptr;
typedef short v4i16_t __attribute__((ext_vector_type(4)));
__device__ __forceinline__ s16x4 vtr(lcptr p) { return __builtin_bit_cast(s16x4, __builtin_amdgcn_ds_read_tr16_b64_v4i16((LAS v4i16_t*)p)); }
__device__ __forceinline__ f32x16 splat16(float c) { f32x16 v;
#pragma unroll
    for (int r = 0; r < 16; ++r) v[r] = c; return v; }
__device__ __forceinline__ int crow(int r, int hi) { return (r & 3) + 8 * (r >> 2) + 4 * hi; }
__device__ __forceinline__ float ex2(float x) { return __builtin_amdgcn_exp2f(x); }

template <int NKS> __device__ __forceinline__ void qk(f32x16& s0, f32x16& s1, lcptr Kt, int kstride, const bf16x8 (&qf)[NKS], float c0, int r32, int hi) {
    s0 = splat16(c0); s1 = splat16(c0);
    lcptr p0 = Kt + r32 * kstride + hi * 16; lcptr p1 = p0 + 32 * kstride;
#pragma unroll
    for (int ks = 0; ks < NKS; ++ks) { const bf16x8 k0 = *(const LAS bf16x8*)(p0 + ks * 32), k1 = *(const LAS bf16x8*)(p1 + ks * 32);
        s0 = __builtin_amdgcn_mfma_f32_32x32x16_bf16(k0, qf[ks], s0, 0, 0, 0); s1 = __builtin_amdgcn_mfma_f32_32x32x16_bf16(k1, qf[ks], s1, 0, 0, 0); }
}
__device__ __forceinline__ float rowmax32(const f32x16& s0, const f32x16& s1) {
    float a = fmaxf(s0[0], s1[0]);
#pragma unroll
    for (int r = 1; r < 16; ++r) a = fmaxf(a, fmaxf(s0[r], s1[r]));
    return fmaxf(a, __shfl_xor(a, 32));
}
template <int NDT> __device__ __forceinline__ void softmax_step(f32x16& s0, f32x16& s1, float& m, float& l, f32x16 (&o)[NDT]) {
    const float mn = fmaxf(m, rowmax32(s0, s1)); float rs = 0.f;
    if (__any(mn > m)) {
        const float al = ex2(m - mn); l *= al;
#pragma unroll
        for (int d = 0; d < NDT; ++d)
#pragma unroll
            for (int r = 0; r < 16; ++r) o[d][r] *= al;
    }
    m = mn;
#pragma unroll
    for (int r = 0; r < 16; ++r) { s0[r] = ex2(s0[r] - mn); s1[r] = ex2(s1[r] - mn); rs += s0[r] + s1[r]; }
    l += rs;
}
__device__ __forceinline__ bf16x8 pack_p(const f32x16& s, int base) { u32x4 w; w.x = pk2(s[base], s[base + 1]); w.y = pk2(s[base + 2], s[base + 3]); w.z = pk2(s[base + 4], s[base + 5]); w.w = pk2(s[base + 6], s[base + 7]); return __builtin_bit_cast(bf16x8, w); }
template <int NDT> __device__ __forceinline__ void pv(f32x16 (&o)[NDT], const f32x16& s0, const f32x16& s1, lcptr Vt, int vstride, int lane) {
    const bf16x8 pk[4] = {pack_p(s0, 0), pack_p(s0, 8), pack_p(s1, 0), pack_p(s1, 8)};
    const int h = lane >> 5, g = (lane >> 4) & 1, q = (lane & 15) >> 2, p = lane & 3;
    lcptr vb = Vt + (4 * h + q) * vstride + (16 * g + 4 * p) * 2;
#pragma unroll
    for (int k = 0; k < 4; ++k)
#pragma unroll
        for (int d = 0; d < NDT; ++d) { const s16x4 lo = vtr(vb + (16 * k) * vstride + d * 64), hh = vtr(vb + (16 * k + 8) * vstride + d * 64);
            const bf16x8 vf = (bf16x8){lo[0], lo[1], lo[2], lo[3], hh[0], hh[1], hh[2], hh[3]};
            o[d] = __builtin_amdgcn_mfma_f32_32x32x16_bf16(vf, pk[k], o[d], 0, 0, 0); }
}

__device__ __forceinline__ void exp_step(f32x16& s0, f32x16& s1, float& l) {
    float rs = 0.f;
#pragma unroll
    for (int r = 0; r < 16; ++r) { s0[r] = ex2(s0[r]); s1[r] = ex2(s1[r]); rs += s0[r] + s1[r]; }
    l += rs;
}

__device__ __forceinline__ void qk2(f32x16& a0, f32x16& a1, f32x16& b0, f32x16& b1, lcptr Kt, const bf16x8 (&qa)[4], const bf16x8 (&qb)[4], int r32, int hi) {
    a0 = splat16(0.f); a1 = splat16(0.f); b0 = splat16(0.f); b1 = splat16(0.f);
    lcptr p0 = Kt + r32 * KS64 + hi * 16; lcptr p1 = p0 + 32 * KS64;
#pragma unroll
    for (int ks = 0; ks < 4; ++ks) { const bf16x8 k0 = *(const LAS bf16x8*)(p0 + ks * 32), k1 = *(const LAS bf16x8*)(p1 + ks * 32);
        a0 = __builtin_amdgcn_mfma_f32_32x32x16_bf16(k0, qa[ks], a0, 0, 0, 0); b0 = __builtin_amdgcn_mfma_f32_32x32x16_bf16(k0, qb[ks], b0, 0, 0, 0);
        a1 = __builtin_amdgcn_mfma_f32_32x32x16_bf16(k1, qa[ks], a1, 0, 0, 0); b1 = __builtin_amdgcn_mfma_f32_32x32x16_bf16(k1, qb[ks], b1, 0, 0, 0); }
}
__device__ __forceinline__ void pv2(f32x16 (&oa)[2], f32x16 (&ob)[2], const bf16x8 (&pa)[4], const bf16x8 (&pb)[4], lcptr Vt, int lane) {
    const int h = lane >> 5, g = (lane >> 4) & 1, q = (lane & 15) >> 2, p = lane & 3;
    lcptr vb = Vt + (4 * h + q) * VS64 + (16 * g + 4 * p) * 2;
#pragma unroll
    for (int k = 0; k < 4; ++k)
#pragma unroll
        for (int d = 0; d < 2; ++d) { const s16x4 lo = vtr(vb + (16 * k) * VS64 + d * 64), hh = vtr(vb + (16 * k + 8) * VS64 + d * 64);
            const bf16x8 vf = (bf16x8){lo[0], lo[1], lo[2], lo[3], hh[0], hh[1], hh[2], hh[3]};
            oa[d] = __builtin_amdgcn_mfma_f32_32x32x16_bf16(vf, pa[k], oa[d], 0, 0, 0); ob[d] = __builtin_amdgcn_mfma_f32_32x32x16_bf16(vf, pb[k], ob[d], 0, 0, 0); }
}
__device__ __forceinline__ void bias_mask_near(f32x16& s0, f32x16& s1, const LAS float* bt, int t, int kp0, int hi, unsigned maxdist) {
#pragma unroll
    for (int q4 = 0; q4 < 4; ++q4) {
        float bb[8]; f32x16& s = (q4 & 2) ? s1 : s0; const int r0 = 8 * (q4 & 1), kq = kp0 + 32 * (q4 >> 1);
#pragma unroll
        for (int r = 0; r < 8; ++r) { const int d = t - (kq + crow(r0 + r, hi)); const unsigned ix = (unsigned)d < 127u ? (unsigned)d : 127u; bb[r] = bt[ix]; }
#pragma unroll
        for (int r = 0; r < 8; ++r) asm volatile("" : "+v"(bb[r]));
#pragma unroll
        for (int r = 0; r < 8; ++r) { const int d = t - (kq + crow(r0 + r, hi)); s[r0 + r] = ((unsigned)d < maxdist) ? s[r0 + r] + bb[r] : -INFINITY; }
    }
}
__device__ __forceinline__ void mask_all(f32x16& s0, f32x16& s1) {
#pragma unroll
    for (int r = 0; r < 16; ++r) { s0[r] = -INFINITY; s1[r] = -INFINITY; }
}
__device__ __forceinline__ void store_o64(bf16_t* orow, const f32x16 (&o)[2], float sc, int hi) {
#pragma unroll
    for (int d = 0; d < 2; ++d)
#pragma unroll
        for (int rg = 0; rg < 4; ++rg) { u32x2 w; w.x = pk2(o[d][4 * rg] * sc, o[d][4 * rg + 1] * sc); w.y = pk2(o[d][4 * rg + 2] * sc, o[d][4 * rg + 3] * sc);
            *(u32x2*)(orow + 32 * d + 8 * rg + 4 * hi) = w; }
}
__device__ __forceinline__ void store_o64_fp8(unsigned char* orow, const f32x16 (&o)[2], float sc, int hi) {
#pragma unroll
    for (int d = 0; d < 2; ++d)
#pragma unroll
        for (int rg = 0; rg < 4; ++rg) *(unsigned*)(orow + 32 * d + 8 * rg + 4 * hi) = pg8::pk4_fp8(o[d][4 * rg] * sc, o[d][4 * rg + 1] * sc, o[d][4 * rg + 2] * sc, o[d][4 * rg + 3] * sc);
}
template <class Src, class Proc> __device__ __forceinline__ void tile_loop64(int tid, lptr base, int nt, int pitch, Src src, Proc proc) {
    if (nt <= 0) return;
    const int row = tid >> 3, ch = tid & 7; u32x4 kr, vr;
    lptr Kb = base, Vb = base + 2 * KT64;
    { const bf16_t *kp, *vp; src(0, kp, vp); kr = *(const u32x4*)(kp + (size_t)row * pitch + ch * 8); vr = *(const u32x4*)(vp + (size_t)row * pitch + ch * 8); }
    *(LAS u32x4*)(Kb + row * KS64 + ch * 16) = kr; *(LAS u32x4*)(Vb + row * VS64 + ch * 16) = vr;
    __syncthreads();
    for (int i = 0; i < nt; ++i) {
        const bool more = i + 1 < nt;
        if (more) { const bf16_t *kp, *vp; src(i + 1, kp, vp); kr = *(const u32x4*)(kp + (size_t)row * pitch + ch * 8); vr = *(const u32x4*)(vp + (size_t)row * pitch + ch * 8); }
        proc(i, (lcptr)(Kb + (i & 1) * KT64), (lcptr)(Vb + (i & 1) * VT64));
        if (more) { *(LAS u32x4*)(Kb + ((i + 1) & 1) * KT64 + row * KS64 + ch * 16) = kr; *(LAS u32x4*)(Vb + ((i + 1) & 1) * VT64 + row * VS64 + ch * 16) = vr; }
        __syncthreads();
    }
}

template <int ROWB, int KSTR, int VSTR, int VAR = 0, class SrcK, class SrcV, class Score, class Accum>
__device__ __forceinline__ void tile_loop_p(int tid, lptr base, int nt, int pitch, SrcK srck, SrcV srcv, Score score, Accum accum) {
    if (nt <= 0) return;
    constexpr int CPR = ROWB / 16, NCH = (64 * CPR) / 512, KT = 64 * KSTR, VT = 64 * VSTR;
    lptr Kb = base, Vb = base + 2 * KT;
    u32x4 kr0[NCH], vr0[NCH], kr1[NCH], vr1[NCH];
    auto gld = [&](const bf16_t* p, u32x4 (&r)[NCH]) {
#pragma unroll
        for (int c = 0; c < NCH; ++c) { const int idx = tid + 512 * c, rr = idx / CPR, ch = idx % CPR; r[c] = *(const u32x4*)(p + (size_t)rr * pitch + ch * 8); } };
    auto lst = [&](lptr dst, int stride, const u32x4 (&r)[NCH]) {
#pragma unroll
        for (int c = 0; c < NCH; ++c) { const int idx = tid + 512 * c, rr = idx / CPR, ch = idx % CPR; *(LAS u32x4*)(dst + rr * stride + ch * 16) = r[c]; } };
    gld(srck(0), kr0); gld(srcv(0), vr0); lst(Kb, KSTR, kr0); lst(Vb, VSTR, vr0);
    if (nt > 1) { gld(srck(1), kr0); lst(Kb + KT, KSTR, kr0); }
    if (nt > 2) gld(srck(2), kr1);
    if (nt > 1) gld(srcv(1), vr1);
    __syncthreads();
    f32x16 a0, a1, b0, b1; bool aact = score(0, (lcptr)Kb, a0, a1), bact = false;
    auto step = [&](int i, f32x16& c0, f32x16& c1, bool& cact, f32x16& n0, f32x16& n1, bool& nact, u32x4 (&kL)[NCH], u32x4 (&vL)[NCH], u32x4 (&kS)[NCH], u32x4 (&vS)[NCH]) {
        const bool m1 = i + 1 < nt, m2 = i + 2 < nt, m3 = i + 3 < nt;
        if (VAR != 7) { if (m3) gld(srck(i + 3), kL);
        if (m2) gld(srcv(i + 2), vL); }
        nact = false;
        if (m1) nact = score(i + 1, (lcptr)(Kb + ((i + 1) & 1) * KT), n0, n1);
        if (cact) accum(i, (lcptr)(Vb + (i & 1) * VT), c0, c1);
        if (VAR != 7) { if (m2) lst(Kb + (i & 1) * KT, KSTR, kS);
        if (m1) lst(Vb + ((i + 1) & 1) * VT, VSTR, vS); }
        __syncthreads();
    };
    for (int i = 0; i < nt; i += 2) { step(i, a0, a1, aact, b0, b1, bact, kr0, vr0, kr1, vr1); if (i + 1 < nt) step(i + 1, b0, b1, bact, a0, a1, aact, kr1, vr1, kr0, vr0); }
}

template <int ROWB, int KSTR, int VSTR, class SrcK, class SrcV, class Score, class Accum>
__device__ __forceinline__ void tile_loop_pp(int tid, int grp, lptr base, int nt, int pitch, SrcK srck, SrcV srcv, Score score, Accum accum) {
    if (nt <= 0) return;
    constexpr int CPR = ROWB / 16, NCH = (64 * CPR) / 512, KT = 64 * KSTR, VT = 64 * VSTR;
    lptr Kb = base, Vb = base + 2 * KT;
    u32x4 kr0[NCH], vr0[NCH], kr1[NCH], vr1[NCH];
    auto gld = [&](const bf16_t* p, u32x4 (&r)[NCH]) {
#pragma unroll
        for (int c = 0; c < NCH; ++c) { const int idx = tid + 512 * c, rr = idx / CPR, ch = idx % CPR; r[c] = *(const u32x4*)(p + (size_t)rr * pitch + ch * 8); } };
    auto lst = [&](lptr dst, int stride, const u32x4 (&r)[NCH]) {
#pragma unroll
        for (int c = 0; c < NCH; ++c) { const int idx = tid + 512 * c, rr = idx / CPR, ch = idx % CPR; *(LAS u32x4*)(dst + rr * stride + ch * 16) = r[c]; } };
    gld(srck(0), kr0); gld(srcv(0), vr0); lst(Kb, KSTR, kr0); lst(Vb, VSTR, vr0);
    if (nt > 1) { gld(srck(1), kr0); gld(srcv(1), vr0); }
    if (nt > 2) { gld(srck(2), kr1); gld(srcv(2), vr1); }
    __syncthreads();
    f32x16 s0, s1; bool act = false;
    const int nslot = 2 * nt + 1;
    auto slot_fn = [&](int slot, u32x4 (&kS)[NCH], u32x4 (&vS)[NCH]) {
        const int my = slot - grp;
        if (my >= 0 && my < 2 * nt) { const int i = my >> 1;
            if (!(my & 1)) act = score(i, (lcptr)(Kb + (i & 1) * KT), s0, s1);
            else if (act) accum(i, (lcptr)(Vb + (i & 1) * VT), s0, s1); }
        if (slot & 1) { const int j = (slot >> 1) + 1;
            if (j < nt) { lst(Kb + (j & 1) * KT, KSTR, kS); lst(Vb + (j & 1) * VT, VSTR, vS); }
            if (j + 2 < nt) { gld(srck(j + 2), kS); gld(srcv(j + 2), vS); } }
        __syncthreads();
    };
    for (int slot = 0; slot < nslot; slot += 4) {
        slot_fn(slot, kr0, vr0);
        if (slot + 1 < nslot) slot_fn(slot + 1, kr0, vr0);
        if (slot + 2 < nslot) slot_fn(slot + 2, kr1, vr1);
        if (slot + 3 < nslot) slot_fn(slot + 3, kr1, vr1);
    }
}

template <int VAR = 0, class SrcK, class SrcV, class Post>
__device__ __forceinline__ void tile_loop_f(int tid, int lane, lptr base, int nt, int pitch, const bf16x8 (&qf)[4], f32x16 (&o)[2], float& l, SrcK srck, SrcV srcv, Post post) {
    if (nt <= 0) return;
    const int r32 = lane & 31, hi = lane >> 5;
    lptr Kb = base, Vb = base + 2 * KT64;
    const int rr = tid >> 3, ch = tid & 7;
    u32x4 kr0, vr0, kr1, vr1;
    auto gld = [&](const bf16_t* p) { return *(const u32x4*)(p + (size_t)rr * pitch + ch * 8); };
    kr0 = gld(srck(0)); vr0 = gld(srcv(0)); *(LAS u32x4*)(Kb + rr * KS64 + ch * 16) = kr0; *(LAS u32x4*)(Vb + rr * VS64 + ch * 16) = vr0;
    if (nt > 1) { kr0 = gld(srck(1)); *(LAS u32x4*)(Kb + KT64 + rr * KS64 + ch * 16) = kr0; }
    if (nt > 2) kr1 = gld(srck(2));
    if (nt > 1) vr1 = gld(srcv(1));
    __syncthreads();
    f32x16 a0, a1, b0, b1; bool aact, bact = false;
    qk<4>(a0, a1, (lcptr)Kb, KS64, qf, 0.f, r32, hi); aact = post(0, a0, a1);
    auto step = [&](int i, f32x16& c0, f32x16& c1, bool& cact, f32x16& n0, f32x16& n1, bool& nact, u32x4& kL, u32x4& vL, u32x4& kS, u32x4& vS) {
        const bool m1 = i + 1 < nt, m2 = i + 2 < nt, m3 = i + 3 < nt;
        if (m3) kL = gld(srck(i + 3));
        if (m2) vL = gld(srcv(i + 2));
        lcptr Kt = (lcptr)(Kb + ((i + 1) & 1) * KT64), Vt = (lcptr)(Vb + (i & 1) * VT64);
        if (m1 && cact) {
            lcptr p0 = Kt + r32 * KS64 + hi * 16; lcptr p1 = p0 + 32 * KS64;
            bf16x8 ka[4], kb[4];
#pragma unroll
            for (int ks = 0; ks < 4; ++ks) { if (VAR == 8 || VAR == 9) { ka[ks] = qf[ks]; kb[ks] = qf[3 - ks]; } else { ka[ks] = *(const LAS bf16x8*)(p0 + ks * 32); kb[ks] = *(const LAS bf16x8*)(p1 + ks * 32); } }
            n0 = splat16(0.f); n1 = splat16(0.f); float rs = 0.f;
            __builtin_amdgcn_sched_barrier(0);
#pragma unroll
            for (int ks = 0; ks < 4; ++ks) {
                n0 = __builtin_amdgcn_mfma_f32_32x32x16_bf16(ka[ks], qf[ks], n0, 0, 0, 0); n1 = __builtin_amdgcn_mfma_f32_32x32x16_bf16(kb[ks], qf[ks], n1, 0, 0, 0);
#pragma unroll
                for (int e = 0; e < 4; ++e) { c0[4 * ks + e] = ex2(c0[4 * ks + e]); c1[4 * ks + e] = ex2(c1[4 * ks + e]); rs += c0[4 * ks + e] + c1[4 * ks + e]; }
                __builtin_amdgcn_sched_barrier(0);
            }
            l += rs;
            if (VAR == 8 || VAR == 10) { const bf16x8 pk0 = pack_p(c0, 0), pk1 = pack_p(c0, 8), pk2_ = pack_p(c1, 0), pk3 = pack_p(c1, 8);
#pragma unroll
                for (int d = 0; d < 2; ++d) { o[d] = __builtin_amdgcn_mfma_f32_32x32x16_bf16(qf[0], pk0, o[d], 0, 0, 0); o[d] = __builtin_amdgcn_mfma_f32_32x32x16_bf16(qf[1], pk1, o[d], 0, 0, 0);
                    o[d] = __builtin_amdgcn_mfma_f32_32x32x16_bf16(qf[2], pk2_, o[d], 0, 0, 0); o[d] = __builtin_amdgcn_mfma_f32_32x32x16_bf16(qf[3], pk3, o[d], 0, 0, 0); } }
            else pv<2>(o, c0, c1, Vt, VS64, lane);
            nact = post(i + 1, n0, n1);
        } else {
            if (cact) { exp_step(c0, c1, l); pv<2>(o, c0, c1, Vt, VS64, lane); }
            nact = false;
            if (m1) { qk<4>(n0, n1, Kt, KS64, qf, 0.f, r32, hi); nact = post(i + 1, n0, n1); }
        }
        if (m2) *(LAS u32x4*)(Kb + (i & 1) * KT64 + rr * KS64 + ch * 16) = kS;
        if (m1) *(LAS u32x4*)(Vb + ((i + 1) & 1) * VT64 + rr * VS64 + ch * 16) = vS;
        __syncthreads();
    };
    for (int i = 0; i < nt; i += 2) { step(i, a0, a1, aact, b0, b1, bact, kr0, vr0, kr1, vr1); if (i + 1 < nt) step(i + 1, b0, b1, bact, a0, a1, aact, kr1, vr1, kr0, vr0); }
}
constexpr int TL64_BYTES = 2 * KT64 + 2 * VT64;
}

#ifndef PP_GRP
#define PP_GRP (w & 1)
#endif
template <int var> __device__ __forceinline__ void moba_unit(const Frame& F, int b, int h, int qb, const bf16_t* Q, const bf16_t* K, const bf16_t* V, const float* KMEAN, const float* BT, unsigned char* O8) {
    using namespace att;
    const int lane = F.lane, r32 = lane & 31, hi = lane >> 5, w = F.wave;
    lptr lds = (lptr)F.lds; lptr tl = lds; LAS float* BTL = (LAS float*)(lds + TL64_BYTES); lptr KM = lds + TL64_BYTES + 512;
    const int t = 256 * qb + 32 * w + r32; const size_t row = (size_t)b * SEQ + t;
    bf16x8 qf[4];
#pragma unroll
    for (int ks = 0; ks < 4; ++ks) qf[ks] = *(const bf16x8*)(Q + row * 1024 + h * 64 + 16 * ks + 8 * hi);
    if (F.tid < 128) BTL[F.tid] = BT[h * 128 + F.tid] - BT[h * 128 + 127];
    { const int idx = F.tid * 2, j = idx >> 6, d = idx & 63; const float* kmp = KMEAN + (size_t)(b * 16 + j) * 2048 + h * 64 + d;
      *(LAS unsigned*)(KM + j * KS64 + d * 2) = (j < qb) ? pk2(kmp[0] + kmp[1024], kmp[1] + kmp[1025]) : 0u;
      *(LAS unsigned*)(KM + (16 + j) * KS64 + d * 2) = 0u; }
    __syncthreads();
    unsigned selmask = 0u;
    if (qb > 0) {
        f32x16 gs = splat16(0.f);
        { lcptr p0 = (lcptr)KM + r32 * KS64 + hi * 16;
#pragma unroll
          for (int ks = 0; ks < 4; ++ks) { const bf16x8 k0 = *(const LAS bf16x8*)(p0 + ks * 32); gs = __builtin_amdgcn_mfma_f32_32x32x16_bf16(k0, qf[ks], gs, 0, 0, 0); } }
        float glo[8], ghi[8];
#pragma unroll
        for (int r = 0; r < 8; ++r) { const float mine = gs[r], oth = __shfl_xor(mine, 32); glo[r] = hi ? oth : mine; ghi[r] = hi ? mine : oth; }
#pragma unroll
        for (int rep = 0; rep < 3; ++rep) { float best = -INFINITY; int bj = -1;
#pragma unroll
            for (int j = 0; j < 16; ++j) { const int r = (j & 3) + 4 * (j >> 3); const float gv = ((j >> 2) & 1) ? ghi[r] : glo[r];
                if (j < qb && !((selmask >> j) & 1u) && gv > best) { best = gv; bj = j; } }
            if (bj >= 0) selmask |= 1u << bj; }
    }
    f32x16 o[2] = {splat16(0.f), splat16(0.f)}; float l = 0.f;
    const int nt = 4 * (qb + 1); const int twmax = 256 * qb + 32 * w + 31;
    const bf16_t* Kh = K + (size_t)b * SEQ * 1024 + h * 64; const bf16_t* Vh = V + (size_t)b * SEQ * 1024 + h * 64;
    tile_loop_f<var>(F.tid, lane, tl, nt, 1024, qf, o, l,
        [&](int i) { return Kh + (size_t)(64 * i) * 1024; }, [&](int i) { return Vh + (size_t)(64 * i) * 1024; },
        [&](int i, f32x16& s0, f32x16& s1) -> bool {
            const int blk = i >> 2, kp0 = 64 * i;
            if (blk < qb) {
                const bool sel = (selmask >> blk) & 1u;
                if (!__any(sel)) return false;
                if (!(blk < qb - 1 || (i & 3) < 2)) bias_mask_near(s0, s1, BTL, t, kp0, hi, 0x7fffffffu);
                if (!sel) mask_all(s0, s1);
            } else {
                if (kp0 > twmax) return false;
                bias_mask_near(s0, s1, BTL, t, kp0, hi, 0x7fffffffu);
            }
            return true; });
    l += __shfl_xor(l, 32);
    store_o64_fp8(O8 + row * 1024 + h * 64, o, l > 0.f ? OSC / l : 0.f, hi);
}
__device__ __forceinline__ void phase_moba(const Frame& F, unsigned char* ws, int var) {
    const bf16_t* Q = (const bf16_t*)(ws + OFF_QKV); const bf16_t* K = Q + (size_t)MTOK * 1024; const bf16_t* V = K + (size_t)MTOK * 1024;
    const float* KMEAN = (const float*)(ws + OFF_KMEAN); const float* BT = (const float*)(ws + OFF_BT);
    for (int idx = F.bx; idx < 2048; idx += F.G) { const int i = idx >> 8, v = idx & 255, x = v & 7, j = v >> 3, bh = 16 * x + 2 * i + (j >> 4), b = bh >> 4, h = bh & 15, p = ((j & 15) + 4 * (i >> 1)) & 15, qb = (i & 1) ? 15 - p : p;

#ifdef MOBA_VAR
        if (var == MOBA_VAR) moba_unit<MOBA_VAR>(F, b, h, qb, Q, K, V, KMEAN, BT, ws + OFF_O8); else
#endif
        moba_unit<0>(F, b, h, qb, Q, K, V, KMEAN, BT, ws + OFF_O8);
        __syncthreads(); }
}

constexpr int MB_KB = 0, MB_VB = 256 * att::KS64, MB_SELM = MB_VB + 256 * att::VS64, MB_LIST = MB_SELM + 4096, MB_CNT = MB_LIST + 12800, MB_FILL = MB_CNT + 64, MB_LOFF = MB_FILL + 64,
              MB_BTL = MB_LOFF + 128, MB_KM = MB_BTL + 512, MB_QC = MB_KM + 32 * att::KS64, MB_END = MB_QC + 64;
constexpr int MST_ROW = 136;
__device__ __forceinline__ void moba2_unit(const Frame& F, int b, int h, int par, int unit, const bf16_t* Q, const bf16_t* K, const bf16_t* V, const float* KMEAN, const float* BT, unsigned char* O8, unsigned char* MST, int abl = 0) {
    using namespace att;
    int tid = F.tid; asm volatile("" : "+v"(tid));
    const int lane = tid & 63, lane_ = lane, r32 = lane & 31, hi = lane >> 5, w = F.wave;
    lptr lds = (lptr)F.lds; lptr KB = lds + MB_KB, VB = lds + MB_VB; LAS unsigned short* SELM = (LAS unsigned short*)(lds + MB_SELM); LAS unsigned short* LIST = (LAS unsigned short*)(lds + MB_LIST);
    LAS int* CNT = (LAS int*)(lds + MB_CNT); LAS int* FILL = (LAS int*)(lds + MB_FILL); LAS int* LOFF = (LAS int*)(lds + MB_LOFF); LAS float* BTL = (LAS float*)(lds + MB_BTL); lptr KM = lds + MB_KM;
    unsigned char* ST = MST + (size_t)unit * 2048 * MST_ROW; float* STL = (float*)(ST + 2048 * 128);
    const bf16_t* Qh = Q + (size_t)b * SEQ * 1024 + h * 64; const bf16_t* Kh = K + (size_t)b * SEQ * 1024 + h * 64; const bf16_t* Vh = V + (size_t)b * SEQ * 1024 + h * 64;
    if (tid < 128) BTL[tid] = BT[h * 128 + tid] - BT[h * 128 + 127];
    { const int idx = tid * 2, j = idx >> 6, d = idx & 63; const float* kmp = KMEAN + (size_t)(b * 16 + j) * 2048 + h * 64 + d;
      *(LAS unsigned*)(KM + j * KS64 + d * 2) = pk2(kmp[0] + kmp[1024], kmp[1] + kmp[1025]); *(LAS unsigned*)(KM + (16 + j) * KS64 + d * 2) = 0u; }
    LAS int* QC = (LAS int*)(lds + MB_QC);
    if (tid < 16) { CNT[tid] = 0; FILL[tid] = 0; QC[tid] = 0; }
    for (int i = tid; i < 2048 * MST_ROW / 16; i += NTHR) ((u32x4*)ST)[i] = (u32x4){0u, 0u, 0u, 0u};
    __syncthreads();
#pragma unroll 1
    for (int m8 = 0; m8 < 8; ++m8) { const int gi = w + 8 * m8, k = gi >> 3, sub = gi & 7, qb = 2 * k + par, q = 32 * sub + r32; const size_t trow = (size_t)(256 * qb + q);
        unsigned selmask = 0u;
        if (qb > 0) {
            bf16x8 qf[4];
#pragma unroll
            for (int ks = 0; ks < 4; ++ks) qf[ks] = *(const bf16x8*)(Qh + trow * 1024 + 16 * ks + 8 * hi);
            f32x16 gs = splat16(0.f);
            { lcptr p0 = (lcptr)KM + r32 * KS64 + hi * 16;
#pragma unroll
              for (int ks = 0; ks < 4; ++ks) { const bf16x8 k0 = *(const LAS bf16x8*)(p0 + ks * 32); gs = __builtin_amdgcn_mfma_f32_32x32x16_bf16(k0, qf[ks], gs, 0, 0, 0); } }
            float glo[8], ghi[8];
#pragma unroll
            for (int r = 0; r < 8; ++r) { const float mine = gs[r], oth = __shfl_xor(mine, 32); glo[r] = hi ? oth : mine; ghi[r] = hi ? mine : oth; }
#pragma unroll
            for (int rep = 0; rep < 3; ++rep) { float best = -INFINITY; int bj = -1;
#pragma unroll
                for (int j = 0; j < 16; ++j) { const int r = (j & 3) + 4 * (j >> 3); const float gv = ((j >> 2) & 1) ? ghi[r] : glo[r];
                    if (j < qb && !((selmask >> j) & 1u) && gv > best) { best = gv; bj = j; } }
                if (bj >= 0) selmask |= 1u << bj; }
        }
        if (hi == 0) { SELM[k * 256 + q] = (unsigned short)selmask; unsigned mm = selmask; while (mm) { const int j = __builtin_ctz(mm); mm &= mm - 1u; __hip_atomic_fetch_add(CNT + j, 1, __ATOMIC_RELAXED, __HIP_MEMORY_SCOPE_WORKGROUP); } }
    }
    __syncthreads();
    if (tid == 0) { int acc = 0; for (int j = 0; j < 16; ++j) { LOFF[j] = acc; acc += CNT[j]; } LOFF[16] = acc; }
    __syncthreads();
    for (int lq = tid; lq < 2048; lq += NTHR) { unsigned mm = SELM[lq]; while (mm) { const int j = __builtin_ctz(mm); mm &= mm - 1u; const int pos = __hip_atomic_fetch_add(FILL + j, 1, __ATOMIC_RELAXED, __HIP_MEMORY_SCOPE_WORKGROUP); LIST[LOFF[j] + pos] = (unsigned short)lq; } }
#ifdef REP_PHASE
    if (abl == 2) return;
#endif
    u32x4 kreg[4], vreg[4];
    auto gblk = [&](int j) { int td = tid; asm volatile("" : "+v"(td));
#pragma unroll
        for (int i = 0; i < 4; ++i) { const int c = td + 512 * i, rr = c >> 3, ch = c & 7; kreg[i] = *(const u32x4*)(Kh + (size_t)(256 * j + rr) * 1024 + ch * 8); vreg[i] = *(const u32x4*)(Vh + (size_t)(256 * j + rr) * 1024 + ch * 8); } };
    gblk(0);
    __syncthreads();
    for (int j = 0; j < 16; ++j) {
        { int td = tid; asm volatile("" : "+v"(td));
#pragma unroll
        for (int i = 0; i < 4; ++i) { const int c = td + 512 * i, rr = c >> 3, ch = c & 7; *(LAS u32x4*)(KB + rr * KS64 + ch * 16) = kreg[i]; *(LAS u32x4*)(VB + rr * VS64 + ch * 16) = vreg[i]; } }
        __syncthreads();
        gblk(j + 1 < 16 ? j + 1 : 15);
        const int nj = CNT[j], ngp = (nj + 31) >> 5, ngo = ((j & 1) == par) ? 8 : 0;
        const int nit = ngo + ngp;
        auto grab = [&]() { int it = 0; if (lane == 0) it = __hip_atomic_fetch_add(QC + j, 1, __ATOMIC_RELAXED, __HIP_MEMORY_SCOPE_WORKGROUP); return __builtin_amdgcn_readfirstlane(it); };
        auto decode = [&](int it, int& t, int& lq, bool& va) {
            if (it < ngo) { const int gidx = ngo - 1 - it; lq = (j >> 1) * 256 + 32 * gidx + r32; t = 256 * j + 32 * gidx + r32; va = true; }
            else { const int gidx = it - ngo, sa = 32 * gidx + r32; va = sa < nj; lq = LIST[LOFF[j] + (va ? sa : 32 * gidx)]; t = 256 * (2 * (lq >> 8) + par) + (lq & 255); } };
        auto issue = [&](int t, int lq, bf16x8 (&q)[4], u32x4 (&st)[4], float& stl) {
#pragma unroll
            for (int ks = 0; ks < 4; ++ks) q[ks] = *(const bf16x8*)(Qh + (size_t)t * 1024 + 16 * ks + 8 * hi);
            const unsigned char* strow = ST + (size_t)lq * 128 + 64 * hi;
#pragma unroll
            for (int k = 0; k < 4; ++k) st[k] = *(const u32x4*)(strow + 16 * k);
            stl = STL[lq]; };
        int it = grab(), t = 0, lq = 0; bool va = false; bf16x8 qc[4] = {}; u32x4 stc[4] = {}; float stlc = 0.f;
        if (it < nit) { decode(it, t, lq, va); issue(t, lq, qc, stc, stlc); }
        while (it < nit) {
            const int itn = grab(); int tn = 0, lqn = 0; bool van = false; bf16x8 qn[4] = {}; u32x4 stn[4] = {}; float stln = 0.f;
            if (itn < nit) { decode(itn, tn, lqn, van); issue(tn, lqn, qn, stn, stln); }
            const bool own = it < ngo; int ntile = own ? ((32 * (ngo - 1 - it) + 31) >> 6) + 1 : 4;
#ifdef REP_PHASE
            if (abl == 1) ntile = 0;
#endif
            const bool nearany = own || __any((t >> 8) == j + 1);
            f32x16 o[2] = {splat16(0.f), splat16(0.f)}; float l = 0.f;
            for (int i = 0; i < ntile; ++i) { f32x16 s0, s1;
                qk<4>(s0, s1, (lcptr)(KB + i * KT64), KS64, qc, 0.f, r32, hi);
                if (nearany && (own || i >= 2)) bias_mask_near(s0, s1, BTL, t, 256 * j + 64 * i, hi, 0x7fffffffu);
                exp_step(s0, s1, l); pv<2>(o, s0, s1, (lcptr)(VB + i * VT64), VS64, lane); }
            l += __shfl_xor(l, 32);
            if (own) {
                const float lt = l + stlc; const float f = lt > 0.f ? OSC / lt : 0.f;
                unsigned char* orow = O8 + ((size_t)b * SEQ + t) * 1024 + h * 64;
#pragma unroll
                for (int d = 0; d < 2; ++d)
#pragma unroll
                    for (int rg = 0; rg < 4; ++rg) { const unsigned w0 = stc[2 * d + (rg >> 1)][(rg & 1) * 2], w1 = stc[2 * d + (rg >> 1)][(rg & 1) * 2 + 1];
                        *(unsigned*)(orow + 32 * d + 8 * rg + 4 * hi) = pg8::pk4_fp8((o[d][4 * rg] + bflo(w0)) * f, (o[d][4 * rg + 1] + bfhi(w0)) * f, (o[d][4 * rg + 2] + bflo(w1)) * f, (o[d][4 * rg + 3] + bfhi(w1)) * f); }
            } else if (va) {
                unsigned char* strow = ST + (size_t)lq * 128 + 64 * hi;
#pragma unroll
                for (int k = 0; k < 4; ++k) { const int d = k >> 1, rg0 = (k & 1) * 2; u32x4 nv;
#pragma unroll
                    for (int c = 0; c < 4; ++c) { const int rg = rg0 + (c >> 1), e = (c & 1) * 2; const unsigned wv = stc[k][c]; nv[c] = pk2(o[d][4 * rg + e] + bflo(wv), o[d][4 * rg + e + 1] + bfhi(wv)); }
                    *(u32x4*)(strow + 16 * k) = nv; }
                if (hi == 0) STL[lq] = stlc + l;
            }
            it = itn; t = tn; lq = lqn; va = van; stlc = stln;
#pragma unroll
            for (int k = 0; k < 4; ++k) qc[k] = qn[k];
#pragma unroll
            for (int k = 0; k < 4; ++k) stc[k] = stn[k];
        }
        __syncthreads();
    }
}
__device__ __forceinline__ void phase_moba2(const Frame& F, unsigned char* ws, int abl = 0) {
    const bf16_t* Q = (const bf16_t*)(ws + OFF_QKV); const bf16_t* K = Q + (size_t)MTOK * 1024; const bf16_t* V = K + (size_t)MTOK * 1024;
    const float* KMEAN = (const float*)(ws + OFF_KMEAN); const float* BT = (const float*)(ws + OFF_BT);
    for (int v = F.bx; v < 256; v += F.G) { const int x = v & 7, jj = v >> 3, pair = 16 * x + (jj >> 1), par = jj & 1;
        moba2_unit(F, pair >> 4, pair & 15, par, v, Q, K, V, KMEAN, BT, ws + OFF_O8, ws + OFF_MST, abl); __syncthreads(); }
}

__device__ __forceinline__ void nsa_unit(const Frame& F, int b, int g, int c, const bf16_t* Y1, const bf16_t* KC, const bf16_t* VC, const float* BT, unsigned char* MIXIN) {
    using namespace att;
    const int lane = F.lane, r32 = lane & 31, hi = lane >> 5, w = F.wave;
    lptr lds = (lptr)F.lds; lptr tl = lds; LAS float* BTL = (LAS float*)(lds + TL64_BYTES);
    LAS float* SCB = (LAS float*)(lds + TL64_BYTES + 2048);
    LAS unsigned long long* SELM = (LAS unsigned long long*)(lds + TL64_BYTES + 2048 + 16384);
    lptr OFL = lds + TL64_BYTES + 2048 + 16384 + 1024 + w * 8704 + r32 * 272 + hi * 16;
    const int n = r32 & 3, tok = 8 * w + (r32 >> 2), t = 64 * c + tok; const size_t row = (size_t)b * SEQ + t;
    const bf16_t* T1 = Y1 + (size_t)1 * MTOK * 256; const bf16_t* QB = Y1 + (size_t)(2 + g) * MTOK * 256;
    const bf16_t* KVS = Y1 + (size_t)5 * MTOK * 256; const bf16_t* KVW = Y1 + (size_t)6 * MTOK * 256;
    bf16x8 qf[4];
#pragma unroll
    for (int ks = 0; ks < 4; ++ks) qf[ks] = *(const bf16x8*)(QB + row * 256 + n * 64 + 16 * ks + 8 * hi);
    float gate[3];
#pragma unroll
    for (int j = 0; j < 3; ++j) { const float x = bf2f(T1[row * 256 + 208 + (4 * g + n) * 3 + j]); gate[j] = 1.f / (1.f + __expf(-x)); }
    for (int i = F.tid; i < 512; i += NTHR) BTL[i] = BT[(8 + 4 * g) * 128 + i] - BT[(8 + 4 * g) * 128 + (i | 127)];
    for (int i = F.tid; i < 4096; i += NTHR) SCB[i] = 0.f;
    __syncthreads();
    const LAS float* bt = BTL + n * 128; const float cfar = 0.f;
    const int vis = (t >= 31) ? ((t - 31) >> 4) : -1;
    const int ntc = ((4 * c + 2) >> 6) + 1;
    const bf16_t* KCg = KC + ((size_t)b * 256 * 2 + g) * 64; const bf16_t* VCg = VC + ((size_t)b * 256 * 2 + g) * 64;
    auto cmp_scores = [&](int i, lcptr Kt, f32x16& s0, f32x16& s1) {
        qk<4>(s0, s1, Kt, KS64, qf, 0.f, r32, hi);
#pragma unroll
        for (int half = 0; half < 2; ++half) { float bb[16]; f32x16& s = half ? s1 : s0;
#pragma unroll
            for (int r = 0; r < 16; ++r) { const int cc = 64 * i + 32 * half + crow(r, hi); const int d = t - 16 * cc - 31; const unsigned ix = (unsigned)d < 127u ? (unsigned)d : 127u; bb[r] = bt[ix]; }
#pragma unroll
            for (int r = 0; r < 16; ++r) asm volatile("" : "+v"(bb[r]));
#pragma unroll
            for (int r = 0; r < 16; ++r) { const int cc = 64 * i + 32 * half + crow(r, hi); s[r] = (cc <= vis) ? s[r] + bb[r] : -INFINITY; } }
    };
    float mc = NEG_BIG, lc = 0.f;
    tile_loop64(F.tid, tl, ntc, 128,
        [&](int i, const bf16_t*& kp, const bf16_t*& vp) { kp = KCg + (size_t)(64 * i) * 128; vp = VCg + (size_t)(64 * i) * 128; },
        [&](int i, lcptr Kt, lcptr Vt) { f32x16 s0, s1; cmp_scores(i, Kt, s0, s1);
            const float mn = fmaxf(mc, rowmax32(s0, s1)); float rs = 0.f;
#pragma unroll
            for (int r = 0; r < 16; ++r) rs += ex2(s0[r] - mn) + ex2(s1[r] - mn);
            lc = lc * ex2(mc - mn) + rs; mc = mn; });
    lc += __shfl_xor(lc, 32);
    const float invc = lc > 0.f ? 1.f / lc : 0.f;
    {
        f32x16 o[2] = {splat16(0.f), splat16(0.f)}; float carry = 0.f;
        tile_loop64(F.tid, tl, ntc, 128,
            [&](int i, const bf16_t*& kp, const bf16_t*& vp) { kp = KCg + (size_t)(64 * i) * 128; vp = VCg + (size_t)(64 * i) * 128; },
            [&](int i, lcptr Kt, lcptr Vt) { f32x16 s0, s1; cmp_scores(i, Kt, s0, s1);
#pragma unroll
                for (int r = 0; r < 16; ++r) { s0[r] = ex2(s0[r] - mc) * invc; s1[r] = ex2(s1[r] - mc) * invc; }
                float x0[4], x1[4];
#pragma unroll
                for (int rg = 0; rg < 4; ++rg) { x0[rg] = __shfl_xor(s0[4 * rg + 3], 32); x1[rg] = __shfl_xor(s1[4 * rg + 3], 32); }
#pragma unroll
                for (int rg = 0; rg < 4; ++rg) {
                    float g0 = (s0[4 * rg] + s0[4 * rg + 1]) + (s0[4 * rg + 2] + s0[4 * rg + 3]), g1 = (s1[4 * rg] + s1[4 * rg + 1]) + (s1[4 * rg + 2] + s1[4 * rg + 3]);
                    const float e0 = hi ? x0[rg] : (rg > 0 ? x0[rg > 0 ? rg - 1 : 0] : carry), e1 = hi ? x1[rg] : (rg > 0 ? x1[rg > 0 ? rg - 1 : 0] : x0[3]);
                    g0 += e0; g1 += e1;
                    g0 += __shfl_xor(g0, 1); g0 += __shfl_xor(g0, 2); g1 += __shfl_xor(g1, 1); g1 += __shfl_xor(g1, 2);
                    if (n == 0) { SCB[tok * 64 + 16 * i + 2 * rg + hi] = g0; SCB[tok * 64 + 16 * i + 8 + 2 * rg + hi] = g1; }
                }
                carry = x1[3];
                pv<2>(o, s0, s1, Vt, VS64, lane); });
#pragma unroll
        for (int d = 0; d < 2; ++d)
#pragma unroll
            for (int rg = 0; rg < 4; ++rg) *(LAS f32x4*)(OFL + d * 128 + rg * 32) = (f32x4){o[d][4 * rg], o[d][4 * rg + 1], o[d][4 * rg + 2], o[d][4 * rg + 3]} * gate[0];
    }
    {
        unsigned long long uni = 0ull;
#pragma unroll 1
        for (int tk = 0; tk < 8; ++tk) { const int tk2 = 8 * w + tk; float v = SCB[tk2 * 64 + lane];
            v = (lane > c) ? -INFINITY : ((lane == 0 || lane == c || lane == c - 1) ? INFINITY : v);
            int cnt = 0;
#pragma unroll
            for (int j = 0; j < 64; ++j) { const float vj = __builtin_bit_cast(float, __builtin_amdgcn_readlane(__builtin_bit_cast(int, v), j)); cnt += (vj > v || (vj == v && j < lane)) ? 1 : 0; }
            const unsigned long long mk = __ballot(cnt < 16 && lane <= c);
            if (lane == 0) SELM[tk2] = mk;
            uni |= mk; }
        if (lane == 0) SELM[64 + w] = uni;
    }
    __syncthreads();
    const unsigned long long mymask = SELM[tok];
    unsigned long long uni = 0ull;
#pragma unroll
    for (int k = 0; k < 8; ++k) uni |= SELM[64 + k];
    {
        f32x16 o[2] = {splat16(0.f), splat16(0.f)}; float l = 0.f;
        const int nsel = __popcll(uni);
        const bf16_t* Kg = KVS + (size_t)b * SEQ * 256 + g * 64; const bf16_t* Vg = Kg + 128;
        LAS unsigned char* LIST = (LAS unsigned char*)(SELM + 72);
        if (F.tid < 64 && ((uni >> F.tid) & 1ull)) LIST[__popcll(uni & ((1ull << F.tid) - 1ull))] = (unsigned char)F.tid;
        __syncthreads();
        tile_loop64(F.tid, tl, nsel, 256,
            [&](int i, const bf16_t*& kp, const bf16_t*& vp) { const int j = LIST[i]; kp = Kg + (size_t)(64 * j) * 256; vp = Vg + (size_t)(64 * j) * 256; },
            [&](int i, lcptr Kt, lcptr Vt) { const int j = LIST[i];
                const bool sel = (mymask >> j) & 1ull;
                if (!__any(sel)) return;
                f32x16 s0, s1; qk<4>(s0, s1, Kt, KS64, qf, 0.f, r32, hi);
                if (j >= c - 2) bias_mask_near(s0, s1, bt, t, 64 * j, hi, 0x7fffffffu);
                if (!sel) mask_all(s0, s1);
                exp_step(s0, s1, l); pv<2>(o, s0, s1, Vt, VS64, lane); });
        l += __shfl_xor(l, 32); const float f = gate[1] * (l > 0.f ? 1.f / l : 0.f);
#pragma unroll
        for (int d = 0; d < 2; ++d)
#pragma unroll
            for (int rg = 0; rg < 4; ++rg) *(LAS f32x4*)(OFL + d * 128 + rg * 32) += (f32x4){o[d][4 * rg], o[d][4 * rg + 1], o[d][4 * rg + 2], o[d][4 * rg + 3]} * f;
    }
    {
        f32x16 o[2] = {splat16(0.f), splat16(0.f)}; float l = 0.f;
        const int k0 = c >= 8 ? c - 8 : 0, ntw = c - k0 + 1;
        const bf16_t* Kg = KVW + (size_t)b * SEQ * 256 + g * 64; const bf16_t* Vg = Kg + 128;
        tile_loop64(F.tid, tl, ntw, 256,
            [&](int i, const bf16_t*& kp, const bf16_t*& vp) { kp = Kg + (size_t)(64 * (k0 + i)) * 256; vp = Vg + (size_t)(64 * (k0 + i)) * 256; },
            [&](int i, lcptr Kt, lcptr Vt) { const int kt = k0 + i; f32x16 s0, s1; qk<4>(s0, s1, Kt, KS64, qf, 0.f, r32, hi);
                if (!(kt < c - 2 && kt > c - 8)) bias_mask_near(s0, s1, bt, t, 64 * kt, hi, 512u);
                exp_step(s0, s1, l); pv<2>(o, s0, s1, Vt, VS64, lane); });
        l += __shfl_xor(l, 32); const float f = gate[2] * (l > 0.f ? 1.f / l : 0.f);
        unsigned char* orow = MIXIN + row * 1536 + 1024 + (4 * g + n) * 64;
#pragma unroll
        for (int d = 0; d < 2; ++d)
#pragma unroll
            for (int rg = 0; rg < 4; ++rg) { const f32x4 v = (*(LAS f32x4*)(OFL + d * 128 + rg * 32) + (f32x4){o[d][4 * rg], o[d][4 * rg + 1], o[d][4 * rg + 2], o[d][4 * rg + 3]} * f) * OSC;
                *(unsigned*)(orow + 32 * d + 8 * rg + 4 * hi) = pg8::pk4_fp8(v[0], v[1], v[2], v[3]); }
    }
}

__device__ __forceinline__ void dsa_unit(const Frame& F, int b, int u, const bf16_t* QLAT, const bf16_t* CKVN, const unsigned* MASK, const float* BT, unsigned char* MIXIN) {
    using namespace att;
    const int lane = F.lane, r32 = lane & 31, hi = lane >> 5, w = F.wave, tid = F.tid;
    lptr lds = (lptr)F.lds; lptr Kb = lds, Vb = lds + 2 * KT128; LAS float* BTL = (LAS float*)(lds + 2 * KT128 + 2 * VT128);
    const int head = r32 & 7, q0 = 32 * u, t = q0 + 4 * w + (r32 >> 3); const size_t row = (size_t)b * SEQ + t;
    bf16x8 qf[8];
#pragma unroll
    for (int ks = 0; ks < 8; ++ks) qf[ks] = *(const bf16x8*)(QLAT + row * 1024 + head * 128 + 16 * ks + 8 * hi);
    for (int i = tid; i < 1024; i += NTHR) BTL[i] = BT[i] - BT[i | 127];
    const LAS float* bt = BTL + head * 128;
    f32x16 o[4] = {splat16(0.f), splat16(0.f), splat16(0.f), splat16(0.f)}; float l = 0.f;
    const int nt = ((q0 + 31) >> 6) + 1;
    const bf16_t* Cb = CKVN + (size_t)b * SEQ * 128; const unsigned* mrow = MASK + row * 128;
    u32x4 st[2];
    auto gload = [&](int i) {
#pragma unroll
        for (int k = 0; k < 2; ++k) { const int idx = tid + 512 * k, rr = idx >> 4, ch = idx & 15; st[k] = *(const u32x4*)(Cb + (size_t)(64 * i + rr) * 128 + ch * 8); } };
    auto lstore = [&](int i) { lptr kd = Kb + (i & 1) * KT128, vd = Vb + (i & 1) * VT128;
#pragma unroll
        for (int k = 0; k < 2; ++k) { const int idx = tid + 512 * k, rr = idx >> 4, ch = idx & 15; *(LAS u32x4*)(kd + rr * KS128 + ch * 16) = st[k]; *(LAS u32x4*)(vd + rr * VS128 + ch * 16) = st[k]; } };
    auto score = [&](int i, f32x16& s0, f32x16& s1) {
        lcptr Kt = (lcptr)(Kb + (i & 1) * KT128);
        const u32x2 mw = *(const u32x2*)(mrow + 2 * i);
        qk<8>(s0, s1, Kt, KS128, qf, 0.f, r32, hi);
        const unsigned w0 = mw.x >> (4 * hi), w1 = mw.y >> (4 * hi);
        if ((q0 - (64 * i + 63)) < 128) {
#pragma unroll
            for (int r = 0; r < 16; ++r) { const int d0 = t - (64 * i + crow(r, hi)), d1 = d0 - 32;
                const unsigned i0 = (unsigned)d0 < 127u ? (unsigned)d0 : 127u, i1 = (unsigned)d1 < 127u ? (unsigned)d1 : 127u;
                s0[r] += bt[i0]; s1[r] += bt[i1]; }
        }
#pragma unroll
        for (int r = 0; r < 16; ++r) { const int bit = (r & 3) + 8 * (r >> 2);
            const int m0 = __builtin_amdgcn_sbfe((int)w0, bit, 1), m1 = __builtin_amdgcn_sbfe((int)w1, bit, 1);
            const float a0 = s0[r], a1 = s1[r];
            s0[r] = __int_as_float((__float_as_int(a0) & m0) | ((int)0xff800000 & ~m0));
            s1[r] = __int_as_float((__float_as_int(a1) & m1) | ((int)0xff800000 & ~m1)); }
    };
    u32x4 st2[2];
    gload(0); lstore(0);
    if (nt > 1) gload(1);
    __syncthreads();
    auto step = [&](int i, u32x4 (&sL)[2], u32x4 (&sS)[2]) {
        if (i + 2 < nt) {
#pragma unroll
            for (int k = 0; k < 2; ++k) { const int idx = tid + 512 * k, rr = idx >> 4, ch = idx & 15; sL[k] = *(const u32x4*)(Cb + (size_t)(64 * (i + 2) + rr) * 128 + ch * 8); } }
        f32x16 s0, s1; score(i, s0, s1);
        exp_step(s0, s1, l); pv<4>(o, s0, s1, (lcptr)(Vb + (i & 1) * VT128), VS128, lane);
        if (i + 1 < nt) { lptr kd = Kb + ((i + 1) & 1) * KT128, vd = Vb + ((i + 1) & 1) * VT128;
#pragma unroll
            for (int k = 0; k < 2; ++k) { const int idx = tid + 512 * k, rr = idx >> 4, ch = idx & 15; *(LAS u32x4*)(kd + rr * KS128 + ch * 16) = sS[k]; *(LAS u32x4*)(vd + rr * VS128 + ch * 16) = sS[k]; } }
        __syncthreads();
    };
    for (int i = 0; i < nt; i += 2) { step(i, st2, st); if (i + 1 < nt) step(i + 1, st, st2); }
    l += __shfl_xor(l, 32); const float f = l > 0.f ? OSC / l : 0.f;
    unsigned char* orow = MIXIN + row * 1536 + head * 128;
#pragma unroll
    for (int d = 0; d < 4; ++d)
#pragma unroll
        for (int rg = 0; rg < 4; ++rg) *(unsigned*)(orow + 32 * d + 8 * rg + 4 * hi) = pg8::pk4_fp8(o[d][4 * rg] * f, o[d][4 * rg + 1] * f, o[d][4 * rg + 2] * f, o[d][4 * rg + 3] * f);
}

constexpr int DS_TILE = 32 * att::KS128, DS_WAVE = 2 * DS_TILE + 640;
__device__ __forceinline__ void dsa_query(int lane, int b, int t, u32x2 mw, att::lptr base, const LAS float* BTL, const bf16_t* QLAT, const bf16_t* CKVN, unsigned char* MIXIN) {
    using namespace att;
    const int r32 = lane & 31, hi = lane >> 5, head = r32 & 7; const size_t row = (size_t)b * SEQ + t;
    LAS unsigned short* LIST = (LAS unsigned short*)(base + 2 * DS_TILE);
    bf16x8 qf[8];
#pragma unroll
    for (int ks = 0; ks < 8; ++ks) qf[ks] = *(const bf16x8*)(QLAT + row * 1024 + head * 128 + 16 * ks + 8 * hi);
    int n;
    { unsigned long long bits = (lane <= (t >> 6)) ? ((unsigned long long)mw.x | ((unsigned long long)mw.y << 32)) : 0ull;
      const int cnt = __popcll(bits); int pre = cnt;
#pragma unroll
      for (int o = 1; o < 64; o <<= 1) { const int v = __shfl_up(pre, o); if (lane >= o) pre += v; }
      n = __builtin_amdgcn_readlane(pre, 63); int pos = pre - cnt;
      while (bits) { const int j = __builtin_ctzll(bits); bits &= bits - 1ull; LIST[pos++] = (unsigned short)(64 * lane + j); }
      if (lane < 32) LIST[n + lane] = 0; }
    const bf16_t* Cb = CKVN + (size_t)b * SEQ * 128; const LAS float* bt = BTL + head * 128;
    const int ntile = (n + 31) >> 5;
    f32x16 o[4] = {splat16(0.f), splat16(0.f), splat16(0.f), splat16(0.f)}; float l = 0.f;
    u32x4 ra[8];
    auto gath = [&](int i, u32x4 (&r)[8]) {
#pragma unroll
        for (int k = 0; k < 8; ++k) { const int c = lane + 64 * k, rw = c >> 4, ch = c & 15; const int idx = LIST[32 * i + rw]; r[k] = *(const u32x4*)(Cb + (size_t)idx * 128 + ch * 8); } };
    auto put = [&](lptr T, const u32x4 (&r)[8]) {
#pragma unroll
        for (int k = 0; k < 8; ++k) { const int c = lane + 64 * k, rw = c >> 4, ch = c & 15; *(LAS u32x4*)(T + rw * KS128 + ch * 16) = r[k]; } };
    const int hq = lane >> 5, g = (lane >> 4) & 1, q4 = (lane & 15) >> 2, p4 = lane & 3;
    auto tile = [&](int i) {
        lcptr T = (lcptr)(base + (i & 1) * DS_TILE);
        f32x16 s = splat16(0.f);
        { lcptr p0 = T + r32 * KS128 + hi * 16;
#pragma unroll
          for (int ks = 0; ks < 8; ++ks) { const bf16x8 kf = *(const LAS bf16x8*)(p0 + ks * 32); s = __builtin_amdgcn_mfma_f32_32x32x16_bf16(kf, qf[ks], s, 0, 0, 0); } }
        const int lastslot = (32 * i + 31 < n) ? 32 * i + 31 : n - 1;
        if (32 * i + 32 > n || t - (int)LIST[lastslot] < 127) {
#pragma unroll
            for (int h8 = 0; h8 < 2; ++h8) { int li[8]; float bb[8];
#pragma unroll
                for (int r = 0; r < 8; ++r) li[r] = LIST[32 * i + crow(8 * h8 + r, hi)];
#pragma unroll
                for (int r = 0; r < 8; ++r) asm volatile("" : "+v"(li[r]));
#pragma unroll
                for (int r = 0; r < 8; ++r) { const int d = t - li[r]; const unsigned ix = (unsigned)d < 127u ? (unsigned)d : 127u; bb[r] = bt[ix]; }
#pragma unroll
                for (int r = 0; r < 8; ++r) asm volatile("" : "+v"(bb[r]));
#pragma unroll
                for (int r = 0; r < 8; ++r) { const int slot = 32 * i + crow(8 * h8 + r, hi); s[8 * h8 + r] = (slot < n) ? s[8 * h8 + r] + bb[r] : -INFINITY; } }
        }
        float rs = 0.f;
#pragma unroll
        for (int r = 0; r < 16; ++r) { s[r] = ex2(s[r]); rs += s[r]; }
        l += rs;
        const bf16x8 pk[2] = {pack_p(s, 0), pack_p(s, 8)};
        lcptr vb = T + (4 * hq + q4) * KS128 + (16 * g + 4 * p4) * 2;
#pragma unroll
        for (int k = 0; k < 2; ++k)
#pragma unroll
            for (int d = 0; d < 4; ++d) { const s16x4 lo = vtr(vb + (16 * k) * KS128 + d * 64), hh = vtr(vb + (16 * k + 8) * KS128 + d * 64);
                const bf16x8 vf = (bf16x8){lo[0], lo[1], lo[2], lo[3], hh[0], hh[1], hh[2], hh[3]};
                o[d] = __builtin_amdgcn_mfma_f32_32x32x16_bf16(vf, pk[k], o[d], 0, 0, 0); }
    };
    gath(0, ra); put(base, ra);
    for (int i = 0; i < ntile; ++i) {
        const bool more = i + 1 < ntile;
        if (more) gath(i + 1, ra);
        tile(i);
        if (more) put(base + ((i + 1) & 1) * DS_TILE, ra);
    }
    l += __shfl_xor(l, 32); const float f = l > 0.f ? OSC / l : 0.f;
    if (r32 < 8) { unsigned char* orow = MIXIN + row * 1536 + head * 128;
#pragma unroll
        for (int d = 0; d < 4; ++d)
#pragma unroll
            for (int rg = 0; rg < 4; ++rg) *(unsigned*)(orow + 32 * d + 8 * rg + 4 * hi) = pg8::pk4_fp8(o[d][4 * rg] * f, o[d][4 * rg + 1] * f, o[d][4 * rg + 2] * f, o[d][4 * rg + 3] * f); }
}
__device__ __forceinline__ void phase_dsa_sparse(const Frame& F, const bf16_t* QLAT, const bf16_t* CKVN, const unsigned* MASK, const float* BT, unsigned char* MIXIN) {
    att::lptr lds = (att::lptr)F.lds; LAS float* BTL = (LAS float*)(lds + 8 * DS_WAVE);
    for (int i = F.tid; i < 1024; i += NTHR) BTL[i] = BT[i] - BT[i | 127];
    __syncthreads();
    att::lptr base = lds + F.wave * DS_WAVE;
    if ((F.G & 7) == 0) {
        const int b = F.bx & 7, wx = (F.bx >> 3) * NWAVES + F.wave, WX = (F.G >> 3) * NWAVES;
        u32x2 mw = *(const u32x2*)(MASK + ((size_t)b * SEQ + wx) * 128 + 2 * F.lane);
        for (int t = wx; t < SEQ; t += WX) { const int tn = (t + WX < SEQ) ? t + WX : t;
            const u32x2 mwn = *(const u32x2*)(MASK + ((size_t)b * SEQ + tn) * 128 + 2 * F.lane);
            dsa_query(F.lane, b, t, mw, base, BTL, QLAT, CKVN, MIXIN); mw = mwn; }
    } else {
        for (int q = F.gw; q < MTOK; q += F.NGW) { const u32x2 mw = *(const u32x2*)(MASK + (size_t)q * 128 + 2 * F.lane); dsa_query(F.lane, q >> 12, q & 4095, mw, base, BTL, QLAT, CKVN, MIXIN); }
    }
    __syncthreads();
}

constexpr int QI_STRIDE = 2064;
__device__ __forceinline__ void indexer_unit(const Frame& F, int b, int c, const bf16_t* QIDX, const bf16_t* T1, _Float16* SC) {
    using namespace att;
    const int lane = F.lane, r32 = lane & 31, hi = lane >> 5, w = F.wave, tid = F.tid;
    lptr lds = (lptr)F.lds; lptr QI = lds; lptr KI = lds + 64 * QI_STRIDE;
    const int qh = w & 1, kq = w >> 1;
    const size_t row0 = (size_t)b * SEQ + 64 * c;
#pragma unroll 4
    for (int k = 0; k < 16; ++k) { const int idx = tid + 512 * k, rr = idx >> 7, ch = idx & 127; *(LAS u32x4*)(QI + rr * QI_STRIDE + ch * 16) = *(const u32x4*)(QIDX + (row0 + rr) * 1024 + ch * 8); }
    float wv[16];
    { const size_t trow = row0 + 32 * qh + r32; const u32x4 a = *(const u32x4*)(T1 + trow * 256 + 192), bq = *(const u32x4*)(T1 + trow * 256 + 200);
      wv[0] = bflo(a.x); wv[1] = bfhi(a.x); wv[2] = bflo(a.y); wv[3] = bfhi(a.y); wv[4] = bflo(a.z); wv[5] = bfhi(a.z); wv[6] = bflo(a.w); wv[7] = bfhi(a.w);
      wv[8] = bflo(bq.x); wv[9] = bfhi(bq.x); wv[10] = bflo(bq.y); wv[11] = bfhi(bq.y); wv[12] = bflo(bq.z); wv[13] = bfhi(bq.z); wv[14] = bflo(bq.w); wv[15] = bfhi(bq.w); }
    const int nsup = (c + 2) >> 1, pitch = (c + 1) * 64;
    _Float16* srow = SC + (size_t)b * SCB_ELEMS + (size_t)4096 * (c * (c + 1) / 2) + (size_t)(32 * qh + r32) * pitch;
    const bf16_t* Kb = T1 + (size_t)b * SEQ * 256 + 128;
    u32x4 st[2];
    for (int s = 0; s < nsup; ++s) {
#pragma unroll
        for (int k = 0; k < 2; ++k) { const int idx = tid + 512 * k, rr = idx >> 3, ch = idx & 7; st[k] = *(const u32x4*)(Kb + (size_t)(128 * s + rr) * 256 + ch * 8); }
        __syncthreads();
#pragma unroll
        for (int k = 0; k < 2; ++k) { const int idx = tid + 512 * k, rr = idx >> 3, ch = idx & 7; *(LAS u32x4*)(KI + rr * KS64 + ch * 16) = st[k]; }
        __syncthreads();
        const int key0 = 128 * s + 32 * kq;
        if (key0 <= 64 * c + 63) {
            bf16x8 kf[4];
#pragma unroll
            for (int ks = 0; ks < 4; ++ks) kf[ks] = *(const LAS bf16x8*)(KI + (32 * kq + r32) * KS64 + ks * 32 + hi * 16);
            f32x16 sc = splat16(0.f);
            lcptr qp = (lcptr)QI + (32 * qh + r32) * QI_STRIDE + hi * 16;
#pragma unroll 2
            for (int hd = 0; hd < 16; ++hd) { f32x16 acc = splat16(0.f);
#pragma unroll
                for (int ks = 0; ks < 4; ++ks) { const bf16x8 qv = *(const LAS bf16x8*)(qp + hd * 128 + ks * 32); acc = __builtin_amdgcn_mfma_f32_32x32x16_bf16(kf[ks], qv, acc, 0, 0, 0); }
                const float ww = wv[hd];
#pragma unroll
                for (int r = 0; r < 16; ++r) sc[r] += ww * fmaxf(acc[r], 0.f); }
#pragma unroll
            for (int rg = 0; rg < 4; ++rg) { f32x2 a = {sc[4 * rg], sc[4 * rg + 1]}, bq = {sc[4 * rg + 2], sc[4 * rg + 3]};
                u32x2 o; o.x = __builtin_bit_cast(unsigned, __builtin_convertvector(a, f16x2_t)); o.y = __builtin_bit_cast(unsigned, __builtin_convertvector(bq, f16x2_t));
                *(u32x2*)(srow + key0 + 8 * rg + 4 * hi) = o; }
        }
    }
    __syncthreads();
}

struct SelRow { const unsigned short* src; unsigned* mrow; int t, c; };
__device__ __forceinline__ SelRow sel_row(int row, const _Float16* SC, unsigned* MASK) {
    SelRow r; const int b = row >> 12; r.t = row & 4095; r.c = r.t >> 6; const int nk = (r.c + 1) * 64;
    r.src = (const unsigned short*)SC + (size_t)b * SCB_ELEMS + (size_t)4096 * (r.c * (r.c + 1) / 2) + (size_t)(r.t & 63) * nk; r.mrow = MASK + (size_t)row * 128; return r;
}
__device__ __forceinline__ void sel_load(const SelRow& r, int lane, unsigned (&key)[64]) {
#pragma unroll
    for (int g = 0; g < 4; ++g) {
        if (r.c >= 16 * g) {
#pragma unroll
            for (int jj = 0; jj < 16; ++jj) { const int j = 16 * g + jj, jc = j <= r.c ? j : r.c;
                const unsigned uu = r.src[64 * jc + lane]; const unsigned k = (uu & 0x8000u) ? (~uu & 0xffffu) : (uu | 0x8000u);
                key[j] = (64 * j + lane > r.t) ? 0u : k; }
        } else {
#pragma unroll
            for (int jj = 0; jj < 16; ++jj) key[16 * g + jj] = 0u;
        }
    }
}
template <bool GT> __device__ __forceinline__ int sel_count(const unsigned (&key)[64], unsigned cand, int c) {
    int cnt = 0;
#pragma unroll
    for (int g = 0; g < 4; ++g) if (c >= 16 * g) {
#pragma unroll
        for (int jj = 0; jj < 16; ++jj) cnt += __popcll(__ballot(GT ? (key[16 * g + jj] > cand) : (key[16 * g + jj] >= cand)));
    }
    return cnt;
}
__device__ __forceinline__ void sel_emit(const SelRow& r, int lane, const unsigned (&key)[64], unsigned prefix, bool exact) {
    if (exact) {
#pragma unroll
        for (int j = 0; j < 64; ++j) if (j <= r.c) { const unsigned long long mk = __ballot(key[j] >= prefix); if (lane == 0) *(u32x2*)(r.mrow + 2 * j) = (u32x2){(unsigned)mk, (unsigned)(mk >> 32)}; }
        return;
    }
    int rem = 256 - sel_count<true>(key, prefix, r.c);
#pragma unroll
    for (int j = 0; j < 64; ++j) {
        if (j <= r.c) {
            const bool eq = key[j] == prefix; const unsigned long long eqm = __ballot(eq);
            const int before = __builtin_amdgcn_mbcnt_hi((unsigned)(eqm >> 32), __builtin_amdgcn_mbcnt_lo((unsigned)eqm, 0u));
            const unsigned long long mk = __ballot(key[j] > prefix || (eq && before < rem));
            rem -= __popcll(eqm); rem = rem < 0 ? 0 : rem;
            if (lane == 0) *(u32x2*)(r.mrow + 2 * j) = (u32x2){(unsigned)mk, (unsigned)(mk >> 32)};
        }
    }
}
__device__ __forceinline__ void sel_small(const SelRow& r, int lane) {
    for (int j = 0; j <= r.c; ++j) { const unsigned long long mk = __ballot(64 * j + lane <= r.t); if (lane == 0) *(u32x2*)(r.mrow + 2 * j) = (u32x2){(unsigned)mk, (unsigned)(mk >> 32)}; }
}
__device__ __forceinline__ void phase_select(const Frame& F, const _Float16* SC, unsigned* MASK) {
    const int lane = F.lane;
    for (int p = F.gw; p < MTOK / 2; p += F.NGW) {
        const int pb_ = p >> 11, q = p & 2047;
        const SelRow ra = sel_row(pb_ * 4096 + q, SC, MASK), rb = sel_row(pb_ * 4096 + 4095 - q, SC, MASK);
        const bool sa = ra.t < 256, sb = rb.t < 256;
        if (sa) sel_small(ra, lane);
        if (sb) sel_small(rb, lane);
        if (sa && sb) continue;
        unsigned ka[64], kb[64];
        sel_load(ra, lane, ka); sel_load(rb, lane, kb);
        unsigned pa = 0u, pb = 0u; bool da = sa, db = sb;
#pragma unroll 1
        for (int bit = 15; bit >= 0 && !(da && db); --bit) {
            if (!da) { const unsigned ca = pa | (1u << bit); const int na = sel_count<false>(ka, ca, ra.c); if (na >= 256) pa = ca; if (na == 256) da = true; }
            if (!db) { const unsigned cb = pb | (1u << bit); const int nb = sel_count<false>(kb, cb, rb.c); if (nb >= 256) pb = cb; if (nb == 256) db = true; }
        }
        if (!sa) sel_emit(ra, lane, ka, pa, da);
        if (!sb) sel_emit(rb, lane, kb, pb, db);
    }
}

__device__ __forceinline__ float gelu_tanh(float x) { const float u = 0.7978845608028654f * (x + 0.044715f * x * x * x); const float e = __expf(2.f * u); return 0.5f * x * (1.f + (1.f - 2.f / (e + 1.f))); }
__device__ __forceinline__ void compress_unit(const Frame& F, int b, int g, int kv, int rt, const bf16_t* KVC, const bf16_t* W1T, const float* w2, const float* cb, bf16_t* OUT) {
    const int lane = F.lane, r32 = lane & 31, hi = lane >> 5, w = F.wave, tid = F.tid;
    LAS float* PART = (LAS float*)F.lds;
    LAS float* HID = PART + 8 * 2048;
    const int n0 = 32 * rt, nn = n0 + r32, nc = nn < 255 ? nn : 254;
    const bf16_t* arow = KVC + ((size_t)b * SEQ + 16 * nc) * 256 + kv * 128 + g * 64;
    f32x16 a0 = att::splat16(0.f), a1 = att::splat16(0.f);
#pragma unroll 4
    for (int ks = 0; ks < 16; ++ks) { const int l = 4 * w + (ks >> 2), d = 16 * (ks & 3) + 8 * hi;
        const bf16x8 af = *(const bf16x8*)(arow + (size_t)l * 256 + d);
        const bf16x8 b0 = *(const bf16x8*)(W1T + (size_t)r32 * 2048 + l * 64 + d), b1 = *(const bf16x8*)(W1T + (size_t)(32 + r32) * 2048 + l * 64 + d);
        a0 = __builtin_amdgcn_mfma_f32_32x32x16_bf16(af, b0, a0, 0, 0, 0); a1 = __builtin_amdgcn_mfma_f32_32x32x16_bf16(af, b1, a1, 0, 0, 0); }
#pragma unroll
    for (int r = 0; r < 16; ++r) { const int mrow = att::crow(r, hi); PART[w * 2048 + mrow * 64 + r32] = a0[r]; PART[w * 2048 + mrow * 64 + 32 + r32] = a1[r]; }
    __syncthreads();
#pragma unroll
    for (int k = 0; k < 4; ++k) { const int idx = tid + 512 * k; float s = cb[idx & 63];
#pragma unroll
        for (int ww = 0; ww < 8; ++ww) s += PART[ww * 2048 + idx];
        HID[idx] = gelu_tanh(s); }
    __syncthreads();
#pragma unroll
    for (int k = 0; k < 4; ++k) { const int idx = tid + 512 * k, nr = idx >> 6, f = idx & 63; float s = 0.f;
#pragma unroll 8
        for (int e = 0; e < 64; ++e) s += HID[nr * 64 + e] * w2[e * 64 + f];
        const int blk = n0 + nr;
        OUT[(((size_t)b * 256 + blk) * 2 + g) * 64 + f] = (blk < 255) ? (bf16_t)f2bf(s) : (bf16_t)0; }
    __syncthreads();
}

#ifdef DBG_MODE
namespace dbg {
constexpr int NSLOT = 40;
__device__ __forceinline__ float bfr(float x) { return bf2f((unsigned short)f2bf(x)); }
__device__ __forceinline__ int srow(int i, int n) { return (int)(((unsigned)i * 2654435761u) % (unsigned)MTOK) ; }
__device__ void commit(unsigned* D, int slot, const float* ref, const float* fast, int n, float tf) {
    __shared__ float red[256];
    const int tid = threadIdx.x; float s = 0.f;
    for (int i = tid; i < n; i += 256) s += ref[i] * ref[i];
    red[tid] = s; __syncthreads();
    for (int o = 128; o > 0; o >>= 1) { if (tid < o) red[tid] += red[tid + o]; __syncthreads(); }
    const float rms = sqrtf(red[0] / (float)n); __syncthreads();
    int bad = 0, tot = 0; float mr = 0.f;
    for (int i = tid; i < n; i += 256) { const float e = fabsf(fast[i] - ref[i]); const float tol = tf * (rms + fabsf(ref[i])) + 1e-7f; if (!(e <= tol)) ++bad; ++tot; const float r = e / (rms + 1e-20f); if (r > mr || !(r == r)) mr = (r == r) ? r : 1e30f; }
    atomicAdd(&D[4 * slot], (unsigned)bad); atomicAdd(&D[4 * slot + 1], (unsigned)tot); atomicMax(&D[4 * slot + 2], __float_as_uint(mr));
    __syncthreads();
}
__device__ __forceinline__ float bias_l2(const float* relb, int head, int dist) { return relb[t5_bucket(dist) * 16 + head] * LOG2E; }

__global__ void chk_in_e(Args a, unsigned* D) {
    __shared__ float ref[1792], fast[1792];
    const int r = srow(blockIdx.x, 64), tid = threadIdx.x; const float* x = a.in[I_X] + (size_t)r * 1024; const float* w = a.in[I_EWIN];
    const bf16_t* Y1 = (const bf16_t*)(a.ws + OFF_Y1);
    for (int n = tid; n < EVEN_IN; n += 256) { float s = 0.f; for (int k = 0; k < 1024; ++k) s += bfr(x[k]) * bfr(w[(size_t)k * EVEN_IN + n]);
        const int dc = RowInE{}(n), tile = dc >> 8, col = dc & 255; const float sc = (tile == 2 || tile == 3) ? QSCALE : 1.f;
        ref[n] = s * sc; fast[n] = bf2f(Y1[((size_t)tile * MTOK + r) * 256 + col]); }
    __syncthreads();
    commit(D, 1, ref, fast, EVEN_IN, 0.02f);
    if (tid == 0) { float sq = 0.f, skv = 0.f; for (int n = 0; n < 256; ++n) sq += ref[n] * ref[n]; for (int n = 256; n < 384; ++n) skv += ref[n] * ref[n];
        const float* pq = (const float*)(a.ws + OFF_SSQ_Q) + (size_t)r * 4; const float* pk = (const float*)(a.ws + OFF_SSQ_KV) + (size_t)r * 4;
        const float fq = pq[0] + pq[1] + pq[2] + pq[3], fk = pk[0] + pk[1] + pk[2] + pk[3];
        int bad = 0; if (!(fabsf(fq - sq) <= 0.02f * sq)) ++bad; if (!(fabsf(fk - skv) <= 0.02f * skv)) ++bad;
        atomicAdd(&D[4 * 2], (unsigned)bad); atomicAdd(&D[4 * 2 + 1], 2u); }
}
__global__ void chk_q2(Args a, unsigned* D) {
    __shared__ float ref[1024], fast[1024], cqn[256], qh[512];
    const int r = srow(blockIdx.x, 64), tid = threadIdx.x; const bf16_t* Y1 = (const bf16_t*)(a.ws + OFF_Y1);
    const bf16_t* CQ = Y1 + (size_t)r * 256; const bf16_t* T1 = Y1 + ((size_t)MTOK + r) * 256;
    { float s = 0.f; for (int k = 0; k < 128; ++k) { const float c = bf2f(T1[k]); s += c * c; } const float rk = 1.f / sqrtf(s / 128.f + 1e-6f);
      if (tid < 128) { ref[tid] = bf2f(T1[tid]) * rk * a.in[I_EKVN][tid]; fast[tid] = bf2f(((const bf16_t*)(a.ws + OFF_CKVN))[(size_t)r * 128 + tid]); } }
    __syncthreads(); commit(D, 3, ref, fast, 128, 0.02f);
    { float s = 0.f; for (int k = 0; k < 256; ++k) { const float c = bf2f(CQ[k]); s += c * c; } const float rq = 1.f / sqrtf(s / 256.f + 1e-6f);
      cqn[tid] = bf2f(CQ[tid]) * rq * a.in[I_EQN][tid]; }
    __syncthreads();
    for (int o = tid; o < 512; o += 256) { float s = 0.f; for (int k = 0; k < 256; ++k) s += cqn[k] * a.in[I_EWUQ][k * 512 + o]; qh[o] = s; }
    __syncthreads();
    for (int o = tid; o < 1024; o += 256) { const int h = o >> 7, c = o & 127; float s = 0.f; for (int d = 0; d < 64; ++d) s += qh[h * 64 + d] * a.in[I_EWUK][c * 512 + h * 64 + d];
        ref[o] = s * QSCALE; fast[o] = bf2f(((const bf16_t*)(a.ws + OFF_QLAT))[(size_t)r * 1024 + o]); }
    __syncthreads(); commit(D, 5, ref, fast, 1024, 0.03f);
    for (int o = tid; o < 1024; o += 256) { float s = 0.f; for (int k = 0; k < 256; ++k) s += cqn[k] * a.in[I_EWQIDX][k * 1024 + o];
        ref[o] = s; fast[o] = bf2f(((const bf16_t*)(a.ws + OFF_QIDX))[(size_t)r * 1024 + o]); }
    __syncthreads(); commit(D, 6, ref, fast, 1024, 0.03f);
}
__global__ void chk_cmp(Args a, unsigned* D) {
    __shared__ float ref[64], fast[64], hid[64];
    const int i = blockIdx.x, tid = threadIdx.x, b = i & 7, g = (i >> 3) & 1, kv = (i >> 4) & 1; const int blk = (i >> 5) == 0 ? 0 : ((i >> 5) == 1 ? 254 : (int)((unsigned)(i * 37 + 11) % 255u));
    const bf16_t* KVC = (const bf16_t*)(a.ws + OFF_Y1) + (size_t)4 * MTOK * 256;
    const float* pos = a.in[kv ? I_EPOSV : I_EPOSK]; const float* w1 = a.in[kv ? I_ECV1 : I_ECK1]; const float* w2 = a.in[kv ? I_ECV2 : I_ECK2];
    if (tid < 64) { float s = 0.f;
        for (int l = 0; l < 32; ++l) for (int d = 0; d < 64; ++d) { const float av = bf2f(KVC[((size_t)b * SEQ + 16 * blk + l) * 256 + kv * 128 + g * 64 + d]); const float wv = w1[(l * 64 + d) * 64 + tid]; s += av * bfr(wv) + pos[l * 64 + d] * wv; }
        hid[tid] = gelu_tanh(s); }
    __syncthreads();
    if (tid < 64) { float s = 0.f; for (int e = 0; e < 64; ++e) s += hid[e] * w2[e * 64 + tid]; ref[tid] = s;
        fast[tid] = bf2f(((const bf16_t*)(a.ws + (kv ? OFF_VC : OFF_KC)))[(((size_t)b * 256 + blk) * 2 + g) * 64 + tid]); }
    __syncthreads(); commit(D, 4, ref, fast, 64, 0.03f);
}
__global__ void chk_idx(Args a, unsigned* D) {
    __shared__ float ref[256], fast[256];
    const int r = (blockIdx.x < 4) ? (blockIdx.x * 4096 + blockIdx.x * 61) : srow(blockIdx.x, 64), tid = threadIdx.x, b = r >> 12, t = r & 4095, c = t >> 6, nk = (c + 1) * 64;
    const bf16_t* Y1 = (const bf16_t*)(a.ws + OFF_Y1); const bf16_t* T1 = Y1 + (size_t)MTOK * 256; const bf16_t* QI = (const bf16_t*)(a.ws + OFF_QIDX) + (size_t)r * 1024;
    const int s = (int)(((unsigned)tid * 2654435761u + 12345u * blockIdx.x) % (unsigned)nk);
    const bf16_t* kr = T1 + ((size_t)b * SEQ + s) * 256 + 128; float sc = 0.f;
    for (int h = 0; h < 16; ++h) { float d = 0.f; for (int k = 0; k < 64; ++k) d += bf2f(QI[h * 64 + k]) * bf2f(kr[k]); sc += bf2f(T1[(size_t)r * 256 + 192 + h]) * fmaxf(d, 0.f); }
    ref[tid] = sc;
    const _Float16* SC = (const _Float16*)(a.ws + OFF_SC) + (size_t)b * SCB_ELEMS + (size_t)4096 * (c * (c + 1) / 2) + (size_t)(t & 63) * nk;
    fast[tid] = (float)SC[s];
    __syncthreads(); commit(D, 7, ref, fast, 256, 0.02f);
}
__global__ void chk_sel(Args a, unsigned* D) {
    __shared__ unsigned key[4096];
    const int r = (blockIdx.x < 8) ? (blockIdx.x * 4096 + 255 + blockIdx.x * 300) : srow(blockIdx.x, 64), tid = threadIdx.x, b = r >> 12, t = r & 4095, c = t >> 6, nk = (c + 1) * 64;
    const unsigned short* SC = (const unsigned short*)(a.ws + OFF_SC) + (size_t)b * SCB_ELEMS + (size_t)4096 * (c * (c + 1) / 2) + (size_t)(t & 63) * nk;
    const unsigned* M = (const unsigned*)(a.ws + OFF_MASK) + (size_t)r * 128;
    for (int s = tid; s < nk; s += 256) { const unsigned u = SC[s]; key[s] = (s <= t) ? ((u & 0x8000u) ? (~u & 0xffffu) : (u | 0x8000u)) : 0u; }
    __syncthreads();
    int bad = 0, tot = 0;
    for (int s = tid; s < nk; s += 256) { bool want;
        if (s > t) want = false; else if (t < 256) want = true;
        else { int rank = 0; const unsigned ks = key[s]; for (int q = 0; q <= t; ++q) rank += (key[q] > ks || (key[q] == ks && q < s)) ? 1 : 0; want = rank < 256; }
        const bool got = (M[s >> 5] >> (s & 31)) & 1u; if (want != got) ++bad; ++tot; }
    atomicAdd(&D[4 * 8], (unsigned)bad); atomicAdd(&D[4 * 8 + 1], (unsigned)tot);
}
__global__ void chk_dsa(Args a, unsigned* D) {
    __shared__ float lg[4096], red[256], ref[128], fast[128];
    const int r = (blockIdx.x < 8) ? (blockIdx.x * 4096 + blockIdx.x * 37) : srow(blockIdx.x, 64), tid = threadIdx.x, b = r >> 12, t = r & 4095, h = blockIdx.x & 7;
    const bf16_t* Q = (const bf16_t*)(a.ws + OFF_QLAT) + (size_t)r * 1024 + h * 128; const bf16_t* C = (const bf16_t*)(a.ws + OFF_CKVN) + (size_t)b * SEQ * 128;
    const unsigned* M = (const unsigned*)(a.ws + OFF_MASK) + (size_t)r * 128; const float* relb = a.in[I_RELB];
    float mx = -INFINITY;
    for (int s = tid; s <= t; s += 256) { float v = -INFINITY; if ((M[s >> 5] >> (s & 31)) & 1u) { float d = 0.f; for (int k = 0; k < 128; ++k) d += bf2f(Q[k]) * bf2f(C[(size_t)s * 128 + k]); v = d + bias_l2(relb, h, t - s); } lg[s] = v; mx = fmaxf(mx, v); }
    red[tid] = mx; __syncthreads(); for (int o = 128; o > 0; o >>= 1) { if (tid < o) red[tid] = fmaxf(red[tid], red[tid + o]); __syncthreads(); } mx = red[0]; __syncthreads();
    float sm = 0.f; for (int s = tid; s <= t; s += 256) { const float p = exp2f(lg[s] - mx); lg[s] = p; sm += p; }
    red[tid] = sm; __syncthreads(); for (int o = 128; o > 0; o >>= 1) { if (tid < o) red[tid] += red[tid + o]; __syncthreads(); } sm = red[0]; __syncthreads();
    if (tid < 128) { float o = 0.f; for (int s = 0; s <= t; ++s) o += lg[s] * bf2f(C[(size_t)s * 128 + tid]); ref[tid] = o / sm; fast[tid] = bf2f(((const bf16_t*)(a.ws + OFF_MIXIN))[(size_t)r * 1536 + h * 128 + tid]); }
    __syncthreads(); commit(D, 9, ref, fast, 128, 0.03f);
}
__global__ void chk_nsa(Args a, unsigned* D) {
    __shared__ float pc[4][256], lg[1100], red[256], ref[64], fast[64], oacc[3][64], scb[64]; __shared__ int selj[16]; __shared__ float qs[4][64];
    const int r = (blockIdx.x < 8) ? (blockIdx.x * 4096 + blockIdx.x * 41) : srow(blockIdx.x, 64), tid = threadIdx.x, b = r >> 12, t = r & 4095, hh = blockIdx.x & 7, g = hh >> 2, n = hh & 3, cur = t >> 6;
    const bf16_t* Y1 = (const bf16_t*)(a.ws + OFF_Y1); const bf16_t* T1 = Y1 + (size_t)MTOK * 256; const bf16_t* QB = Y1 + (size_t)(2 + g) * MTOK * 256;
    const bf16_t* KVS = Y1 + (size_t)5 * MTOK * 256; const bf16_t* KVW = Y1 + (size_t)6 * MTOK * 256;
    const bf16_t* KC = (const bf16_t*)(a.ws + OFF_KC); const bf16_t* VC = (const bf16_t*)(a.ws + OFF_VC); const float* relb = a.in[I_RELB];
    qs[tid >> 6][tid & 63] = bf2f(QB[(size_t)r * 256 + tid]);
    __syncthreads();
    const int vis = (t >= 31) ? ((t - 31) >> 4) : -1;
    for (int nn = 0; nn < 4; ++nn) {
        float v = -INFINITY; if (tid <= vis) { float d = 0.f; for (int k = 0; k < 64; ++k) d += qs[nn][k] * bf2f(KC[(((size_t)b * 256 + tid) * 2 + g) * 64 + k]); v = d + bias_l2(relb, 8 + 4 * g + nn, t - 16 * tid - 31); }
        red[tid] = v; __syncthreads(); for (int o = 128; o > 0; o >>= 1) { if (tid < o) red[tid] = fmaxf(red[tid], red[tid + o]); __syncthreads(); } const float mx = red[0]; __syncthreads();
        const float p = (tid <= vis) ? exp2f(v - mx) : 0.f; red[tid] = p; __syncthreads(); for (int o = 128; o > 0; o >>= 1) { if (tid < o) red[tid] += red[tid + o]; __syncthreads(); } const float sm = red[0]; __syncthreads();
        pc[nn][tid] = sm > 0.f ? p / sm : 0.f; __syncthreads();
    }
    if (tid < 64) { float o = 0.f; for (int i = 0; i <= vis; ++i) o += pc[n][i] * bf2f(VC[(((size_t)b * 256 + i) * 2 + g) * 64 + tid]); oacc[0][tid] = o;
        float s = 0.f; for (int nn = 0; nn < 4; ++nn) for (int i = 4 * tid - 1; i <= 4 * tid + 3; ++i) if (i >= 0 && i < 255) s += pc[nn][i];
        scb[tid] = (tid > cur) ? -INFINITY : ((tid == 0 || tid == cur || tid == cur - 1) ? INFINITY : s); }
    __syncthreads();
    if (tid < 64) { int rank = 0; for (int j = 0; j < 64; ++j) rank += (scb[j] > scb[tid] || (scb[j] == scb[tid] && j < tid)) ? 1 : 0; if (rank < 16) selj[rank] = tid; }
    __syncthreads();
    { float mx = -INFINITY;
      for (int i = tid; i < 1024; i += 256) { const int j = selj[i >> 6], p = 64 * j + (i & 63); float v = -INFINITY; if (p <= t) { float d = 0.f; for (int k = 0; k < 64; ++k) d += qs[n][k] * bf2f(KVS[((size_t)b * SEQ + p) * 256 + g * 64 + k]); v = d + bias_l2(relb, 8 + hh, t - p); } lg[i] = v; mx = fmaxf(mx, v); }
      red[tid] = mx; __syncthreads(); for (int o = 128; o > 0; o >>= 1) { if (tid < o) red[tid] = fmaxf(red[tid], red[tid + o]); __syncthreads(); } mx = red[0]; __syncthreads();
      float sm = 0.f; for (int i = tid; i < 1024; i += 256) { const float p = exp2f(lg[i] - mx); lg[i] = p; sm += p; }
      red[tid] = sm; __syncthreads(); for (int o = 128; o > 0; o >>= 1) { if (tid < o) red[tid] += red[tid + o]; __syncthreads(); } sm = red[0]; __syncthreads();
      if (tid < 64) { float o = 0.f; for (int i = 0; i < 1024; ++i) { const int p = 64 * selj[i >> 6] + (i & 63); if (p <= t) o += lg[i] * bf2f(KVS[((size_t)b * SEQ + p) * 256 + 128 + g * 64 + tid]); } oacc[1][tid] = o / sm; }
      __syncthreads(); }
    { float mx = -INFINITY;
      for (int i = tid; i < 512; i += 256) { const int p = t - i; float v = -INFINITY; if (p >= 0) { float d = 0.f; for (int k = 0; k < 64; ++k) d += qs[n][k] * bf2f(KVW[((size_t)b * SEQ + p) * 256 + g * 64 + k]); v = d + bias_l2(relb, 8 + hh, i); } lg[i] = v; mx = fmaxf(mx, v); }
      red[tid] = mx; __syncthreads(); for (int o = 128; o > 0; o >>= 1) { if (tid < o) red[tid] = fmaxf(red[tid], red[tid + o]); __syncthreads(); } mx = red[0]; __syncthreads();
      float sm = 0.f; for (int i = tid; i < 512; i += 256) { const float p = exp2f(lg[i] - mx); lg[i] = p; sm += p; }
      red[tid] = sm; __syncthreads(); for (int o = 128; o > 0; o >>= 1) { if (tid < o) red[tid] += red[tid + o]; __syncthreads(); } sm = red[0]; __syncthreads();
      if (tid < 64) { float o = 0.f; for (int i = 0; i < 512; ++i) { const int p = t - i; if (p >= 0) o += lg[i] * bf2f(KVW[((size_t)b * SEQ + p) * 256 + 128 + g * 64 + tid]); } oacc[2][tid] = o / sm; }
      __syncthreads(); }
    if (tid < 64) { float gt[3]; for (int j = 0; j < 3; ++j) { const float x = bf2f(T1[(size_t)r * 256 + 208 + hh * 3 + j]); gt[j] = 1.f / (1.f + expf(-x)); }
        ref[tid] = gt[0] * oacc[0][tid] + gt[1] * oacc[1][tid] + gt[2] * oacc[2][tid]; fast[tid] = bf2f(((const bf16_t*)(a.ws + OFF_MIXIN))[(size_t)r * 1536 + 1024 + hh * 64 + tid]); }
    __syncthreads(); commit(D, 10, ref, fast, 64, 0.04f);
}
__global__ void chk_out_e(Args a, unsigned* D) {
    __shared__ float ref[1024], fast[1024], cat[1024];
    const int r = srow(blockIdx.x, 64), tid = threadIdx.x; const bf16_t* MX = (const bf16_t*)(a.ws + OFF_MIXIN) + (size_t)r * 1536;
    for (int o = tid; o < 512; o += 256) { const int h = o >> 6, d = o & 63; float s = 0.f; for (int c = 0; c < 128; ++c) s += bf2f(MX[h * 128 + c]) * a.in[I_EWUV][c * 512 + h * 64 + d]; cat[o] = s; cat[512 + o] = bf2f(MX[1024 + o]); }
    __syncthreads();
    for (int n = tid; n < 1024; n += 256) { float s = 0.f; for (int j = 0; j < 1024; ++j) s += cat[j] * a.in[I_EWOUT][(size_t)j * 1024 + n]; ref[n] = s;
        fast[n] = bf2f(((const bf16_t*)(a.ws + OFF_S1))[(size_t)r * 1024 + n]) - ALPHA * a.in[I_X][(size_t)r * 1024 + n]; }
    __syncthreads(); commit(D, 11, ref, fast, 1024, 0.35f);
}
__global__ void chk_ln(const bf16_t* S, const bf16_t* O, const float* g, const float* bt, unsigned* D, int slot) {
    __shared__ float ref[1024], fast[1024];
    const int r = srow(blockIdx.x, 64), tid = threadIdx.x; float mean = 0.f, var = 0.f;
    for (int k = 0; k < 1024; ++k) mean += bf2f(S[(size_t)r * 1024 + k]); mean /= 1024.f;
    for (int k = 0; k < 1024; ++k) { const float d = bf2f(S[(size_t)r * 1024 + k]) - mean; var += d * d; } var /= 1024.f;
    for (int n = tid; n < 1024; n += 256) { ref[n] = (bf2f(S[(size_t)r * 1024 + n]) - mean) / sqrtf(var + 1e-5f) * g[n] + bt[n]; fast[n] = bf2f(O[(size_t)r * 1024 + n]); }
    __syncthreads(); commit(D, slot, ref, fast, 1024, 0.01f);
}
__global__ void chk_ffn_up(Args a, unsigned* D) {
    __shared__ float ref[DFF], fast[DFF], hrow[1024];
    const int r = srow(blockIdx.x, 64), tid = threadIdx.x; const bf16_t* H = (const bf16_t*)(a.ws + OFF_H) + (size_t)r * 1024;
    for (int k = tid; k < 1024; k += 256) hrow[k] = bf2f(H[k]);
    __syncthreads();
    for (int n = tid; n < DFF; n += 256) { float s1 = 0.f, s3 = 0.f; for (int k = 0; k < 1024; ++k) { s1 += hrow[k] * bfr(a.in[I_EF1][(size_t)k * DFF + n]); s3 += hrow[k] * bfr(a.in[I_EF3][(size_t)k * DFF + n]); }
        ref[n] = s1 / (1.f + expf(-s1)) * s3; fast[n] = bf2f(((const bf16_t*)(a.ws + OFF_ACT))[(size_t)r * DFF + n]); }
    __syncthreads(); commit(D, 13, ref, fast, DFF, 0.02f);
}
__global__ void chk_ffn_dn(Args a, unsigned* D) {
    __shared__ float ref[1024], fast[1024], arow[DFF];
    const int r = srow(blockIdx.x, 64), tid = threadIdx.x; const bf16_t* A = (const bf16_t*)(a.ws + OFF_ACT) + (size_t)r * DFF;
    for (int k = tid; k < DFF; k += 256) arow[k] = bf2f(A[k]);
    __syncthreads();
    for (int n = tid; n < 1024; n += 256) { float s = 0.f; for (int k = 0; k < DFF; ++k) s += arow[k] * bfr(a.in[I_EF2][(size_t)k * 1024 + n]); ref[n] = s;
        fast[n] = bf2f(((const bf16_t*)(a.ws + OFF_S2))[(size_t)r * 1024 + n]) - ALPHA * bf2f(((const bf16_t*)(a.ws + OFF_H))[(size_t)r * 1024 + n]); }
    __syncthreads(); commit(D, 14, ref, fast, 1024, 0.06f);
}
__global__ void chk_in_o(Args a, unsigned* D) {
    __shared__ float ref[2048], fast[2048], xr[1024];
    const int r = srow(blockIdx.x, 64), tid = threadIdx.x; const bf16_t* X1 = (const bf16_t*)(a.ws + OFF_X1) + (size_t)r * 1024;
    for (int k = tid; k < 1024; k += 256) xr[k] = bf2f(X1[k]);
    __syncthreads();
    for (int n = tid; n < 2048; n += 256) { float s = 0.f; for (int k = 0; k < 1024; ++k) s += xr[k] * bfr(a.in[I_OWIN][(size_t)k * 3072 + 1024 + n]); ref[n] = s;
        fast[n] = bf2f(((const bf16_t*)(a.ws + OFF_QKV))[(size_t)(1 + (n >> 10)) * MTOK * 1024 + (size_t)r * 1024 + (n & 1023)]); }
    __syncthreads(); commit(D, 16, ref, fast, 2048, 0.02f);
    const int pm = r >> 8; const bf16_t* K = (const bf16_t*)(a.ws + OFF_QKV) + (size_t)MTOK * 1024 + (size_t)pm * 256 * 1024; const float* KM = (const float*)(a.ws + OFF_KMEAN) + (size_t)pm * 2048;
    for (int n = tid; n < 1024; n += 256) { float s = 0.f; for (int q = 0; q < 256; ++q) s += bf2f(K[(size_t)q * 1024 + n]); ref[n] = s; fast[n] = KM[n] + KM[1024 + n]; }
    __syncthreads(); commit(D, 17, ref, fast, 1024, 0.03f);
}
__global__ void chk_moba(Args a, unsigned* D) {
    __shared__ float lg[1024], red[256], ref[64], fast[64], q[64], gate[16]; __shared__ int blkof[4];
    const int r = (blockIdx.x < 8) ? (blockIdx.x * 4096 + blockIdx.x * 300) : srow(blockIdx.x, 64), tid = threadIdx.x, b = r >> 12, t = r & 4095, h = blockIdx.x & 15, own = t >> 8;
    const bf16_t* X1 = (const bf16_t*)(a.ws + OFF_X1) + (size_t)r * 1024; const bf16_t* K = (const bf16_t*)(a.ws + OFF_QKV) + (size_t)MTOK * 1024 + (size_t)b * SEQ * 1024 + h * 64; const bf16_t* V = K + (size_t)MTOK * 1024;
    const float* relb = a.in[I_RELB];
    if (tid < 64) { float s = 0.f; for (int k = 0; k < 1024; ++k) s += bf2f(X1[k]) * bfr(a.in[I_OWIN][(size_t)k * 3072 + h * 64 + tid]); q[tid] = bfr(s * QSCALE); }
    __syncthreads();
    if (tid < 16) { float s = -INFINITY; if (tid < own) { s = 0.f; for (int p = 0; p < 256; ++p) for (int d = 0; d < 64; ++d) s += q[d] * bf2f(K[(size_t)(256 * tid + p) * 1024 + d]); } gate[tid] = s; }
    __syncthreads();
    if (tid == 0) { unsigned used = 0u; for (int k = 0; k < 3; ++k) { int bj = -1; float best = -INFINITY; for (int j = 0; j < own; ++j) if (!((used >> j) & 1u) && gate[j] > best) { best = gate[j]; bj = j; } blkof[k] = bj; if (bj >= 0) used |= 1u << bj; } blkof[3] = own; }
    __syncthreads();
    float mx = -INFINITY;
    for (int i = tid; i < 1024; i += 256) { const int j = blkof[i >> 8], p = 256 * j + (i & 255); float v = -INFINITY; if (j >= 0 && p <= t) { float d = 0.f; for (int k = 0; k < 64; ++k) d += q[k] * bf2f(K[(size_t)p * 1024 + k]); v = d + bias_l2(relb, h, t - p); } lg[i] = v; mx = fmaxf(mx, v); }
    red[tid] = mx; __syncthreads(); for (int o = 128; o > 0; o >>= 1) { if (tid < o) red[tid] = fmaxf(red[tid], red[tid + o]); __syncthreads(); } mx = red[0]; __syncthreads();
    float sm = 0.f; for (int i = tid; i < 1024; i += 256) { const float p = exp2f(lg[i] - mx); lg[i] = p; sm += p; }
    red[tid] = sm; __syncthreads(); for (int o = 128; o > 0; o >>= 1) { if (tid < o) red[tid] += red[tid + o]; __syncthreads(); } sm = red[0]; __syncthreads();
    if (tid < 64) { float o = 0.f; for (int i = 0; i < 1024; ++i) { const int j = blkof[i >> 8], p = 256 * j + (i & 255); if (j >= 0 && p <= t) o += lg[i] * bf2f(V[(size_t)p * 1024 + tid]); } ref[tid] = o / sm;
        fast[tid] = bf2f(((const bf16_t*)(a.ws + OFF_QKV))[(size_t)r * 1024 + h * 64 + tid]); }
    __syncthreads(); commit(D, 18, ref, fast, 64, 0.04f);
}
__global__ void chk_out_o(Args a, unsigned* D) {
    __shared__ float ref[1024], fast[1024], orow[1024];
    const int r = srow(blockIdx.x, 64), tid = threadIdx.x;
    for (int k = tid; k < 1024; k += 256) orow[k] = bf2f(((const bf16_t*)(a.ws + OFF_QKV))[(size_t)r * 1024 + k]);
    __syncthreads();
    for (int n = tid; n < 1024; n += 256) { float s = 0.f; for (int k = 0; k < 1024; ++k) s += orow[k] * a.in[I_OWOUT][(size_t)k * 1024 + n]; ref[n] = s;
        fast[n] = bf2f(((const bf16_t*)(a.ws + OFF_S1O))[(size_t)r * 1024 + n]) - ALPHA * bf2f(((const bf16_t*)(a.ws + OFF_X1))[(size_t)r * 1024 + n]); }
    __syncthreads(); commit(D, 20, ref, fast, 1024, 0.5f);
}
__global__ void chk_route(Args a, unsigned* D) {
    const int r = srow(blockIdx.x * 256 + threadIdx.x, 64); const bf16_t* H2 = (const bf16_t*)(a.ws + OFF_H2) + (size_t)r * 1024;
    float lg[8]; for (int e = 0; e < 8; ++e) lg[e] = 0.f;
    for (int k = 0; k < 1024; ++k) { const float hv = bf2f(H2[k]); for (int e = 0; e < 8; ++e) lg[e] += hv * a.in[I_OROUTER][k * 8 + e]; }
    int e0 = 0; for (int e = 1; e < 8; ++e) if (lg[e] > lg[e0]) e0 = e; int e1 = -1; for (int e = 0; e < 8; ++e) if (e != e0 && (e1 < 0 || lg[e] > lg[e1])) e1 = e;
    const float g0 = 1.f / (1.f + expf(lg[e1] - lg[e0]));
    const u32x2 rt = ((const u32x2*)(a.ws + OFF_ROUTE))[r]; const int f0 = rt.x & 255, f1 = (rt.x >> 8) & 255; const float fg = __uint_as_float(rt.y);
    int bad = 0; if (f0 != e0 || f1 != e1 || !(fabsf(fg - g0) <= 0.02f)) ++bad;
    atomicAdd(&D[4 * 21], (unsigned)bad); atomicAdd(&D[4 * 21 + 1], 1u);
    const int* GI = (const int*)(a.ws + OFF_GINFO); const int* DEST = (const int*)(a.ws + OFF_DEST) + 2 * (size_t)r;
    int bad2 = 0;
    for (int k = 0; k < 2; ++k) { const int e = k ? f1 : f0, d = DEST[k], ps = e ? GI[e - 1] : 0; if (d < ps || d >= ps + GI[8 + e]) ++bad2; }
    atomicAdd(&D[4 * 22], (unsigned)bad2); atomicAdd(&D[4 * 22 + 1], 2u);
}
__global__ void chk_moe(Args a, unsigned* D) {
    __shared__ float ref[1024], fast[1024], hrow[1024], act[DFFE], fin[1024];
    const int r = srow(blockIdx.x, 64), tid = threadIdx.x; const bf16_t* H2 = (const bf16_t*)(a.ws + OFF_H2) + (size_t)r * 1024;
    for (int k = tid; k < 1024; k += 256) { hrow[k] = bf2f(H2[k]); ref[k] = 0.f; }
    const u32x2 rt = ((const u32x2*)(a.ws + OFF_ROUTE))[r]; const float g0 = __uint_as_float(rt.y); const int* DEST = (const int*)(a.ws + OFF_DEST) + 2 * (size_t)r; const bf16_t* YR = (const bf16_t*)(a.ws + OFF_YR);
    __syncthreads();
    for (int k = 0; k < 2; ++k) { const int e = k ? ((rt.x >> 8) & 255) : (rt.x & 255); const float gk = k ? 1.f - g0 : g0;
        const float* w1 = a.in[I_OM1] + (size_t)e * 1024 * DFFE; const float* w3 = a.in[I_OM3] + (size_t)e * 1024 * DFFE; const float* w2 = a.in[I_OM2] + (size_t)e * DFFE * 1024;
        for (int f = tid; f < DFFE; f += 256) { float s1 = 0.f, s3 = 0.f; for (int q = 0; q < 1024; ++q) { s1 += hrow[q] * bfr(w1[(size_t)q * DFFE + f]); s3 += hrow[q] * bfr(w3[(size_t)q * DFFE + f]); } act[f] = bfr(s1 / (1.f + expf(-s1)) * s3); }
        __syncthreads();
        for (int n = tid; n < 1024; n += 256) { float s = 0.f; for (int f = 0; f < DFFE; ++f) s += act[f] * bfr(w2[(size_t)f * 1024 + n]); ref[n] += gk * s; }
        __syncthreads(); }
    for (int n = tid; n < 1024; n += 256) { fast[n] = g0 * bf2f(YR[(size_t)DEST[0] * 1024 + n]) + (1.f - g0) * bf2f(YR[(size_t)DEST[1] * 1024 + n]); fin[n] = ALPHA * hrow[n] + fast[n]; }
    __syncthreads(); commit(D, 23, ref, fast, 1024, 0.12f);
    float mean = 0.f, var = 0.f; for (int k = 0; k < 1024; ++k) mean += fin[k]; mean /= 1024.f; for (int k = 0; k < 1024; ++k) { const float d = fin[k] - mean; var += d * d; } var /= 1024.f;
    __syncthreads();
    for (int n = tid; n < 1024; n += 256) { ref[n] = (fin[n] - mean) / sqrtf(var + 1e-5f) * a.in[I_OLN2G][n] + a.in[I_OLN2B][n]; fast[n] = a.out[(size_t)r * 1024 + n]; }
    __syncthreads(); commit(D, 24, ref, fast, 1024, 0.005f);
    { float m2 = 0.f, v2 = 0.f; for (int k = 0; k < 1024; ++k) m2 += ALPHA * hrow[k]; m2 /= 1024.f; for (int k = 0; k < 1024; ++k) { const float d = ALPHA * hrow[k] - m2; v2 += d * d; } v2 /= 1024.f;
      for (int n = tid; n < 1024; n += 256) ref[n] = (ALPHA * hrow[n] - m2) / sqrtf(v2 + 1e-5f) * a.in[I_OLN2G][n] + a.in[I_OLN2B][n];
      __syncthreads(); commit(D, 28, ref, fast, 1024, 0.005f); }
    { for (int n = tid; n < 1024; n += 256) fin[n] = ALPHA * hrow[n] + (1.f - g0) * bf2f(YR[(size_t)DEST[0] * 1024 + n]) + g0 * bf2f(YR[(size_t)DEST[1] * 1024 + n]);
      __syncthreads();
      float m2 = 0.f, v2 = 0.f; for (int k = 0; k < 1024; ++k) m2 += fin[k]; m2 /= 1024.f; for (int k = 0; k < 1024; ++k) { const float d = fin[k] - m2; v2 += d * d; } v2 /= 1024.f;
      __syncthreads();
      for (int n = tid; n < 1024; n += 256) ref[n] = (fin[n] - m2) / sqrtf(v2 + 1e-5f) * a.in[I_OLN2G][n] + a.in[I_OLN2B][n];
      __syncthreads(); commit(D, 29, ref, fast, 1024, 0.005f); }
}

__global__ void chk_wmoe(Args a, unsigned* D) {
    const int tid = blockIdx.x * 256 + threadIdx.x; const unsigned hsh = (unsigned)tid * 2654435761u;
    const int e = hsh & 7, f = (hsh >> 3) % DFFE, k = (hsh >> 15) % 1024;
    const bf16_t* W13 = (const bf16_t*)(a.ws + OFF_W_M13) + (size_t)e * 2 * DFFE * 1024; const bf16_t* W2 = (const bf16_t*)(a.ws + OFF_W_M2) + (size_t)e * 1024 * DFFE;
    int bad = 0;
    if (W13[(size_t)(((f >> 7) << 8) + (f & 127)) * 1024 + k] != (bf16_t)f2bf(a.in[I_OM1][(size_t)e * 1024 * DFFE + (size_t)k * DFFE + f])) ++bad;
    if (W13[(size_t)(((f >> 7) << 8) + (f & 127) + 128) * 1024 + k] != (bf16_t)f2bf(a.in[I_OM3][(size_t)e * 1024 * DFFE + (size_t)k * DFFE + f])) ++bad;
    atomicAdd(&D[4 * 25], (unsigned)bad); atomicAdd(&D[4 * 25 + 1], 2u);
    int bad2 = 0; if (W2[(size_t)k * DFFE + f] != (bf16_t)f2bf(a.in[I_OM2][(size_t)e * DFFE * 1024 + (size_t)f * 1024 + k])) ++bad2;
    atomicAdd(&D[4 * 26], (unsigned)bad2); atomicAdd(&D[4 * 26 + 1], 1u);
}
__global__ void chk_actm(Args a, unsigned* D) {
    __shared__ float ref[DFFE], fast[DFFE], hrow[1024]; __shared__ int tokf, kf;
    const int tid = threadIdx.x; const int* GI = (const int*)(a.ws + OFF_GINFO); const int nrows = GI[7], ng = nrows >> 8, g0 = ((ng - 1) / MOE_CHUNK) * MOE_CHUNK;
    const int rho = 256 * g0 + (int)(((unsigned)blockIdx.x * 2654435761u) % (unsigned)(nrows - 256 * g0));
    if (tid == 0) { tokf = -1; kf = 0; } __syncthreads();
    const int* DEST = (const int*)(a.ws + OFF_DEST);
    for (int i = tid; i < 2 * MTOK; i += 256) if (DEST[i] == rho) { tokf = i >> 1; kf = i & 1; }
    __syncthreads();
    if (tokf < 0) return;
    const int tok = tokf; const u32x2 rt = ((const u32x2*)(a.ws + OFF_ROUTE))[tok]; const int e = kf ? ((rt.x >> 8) & 255) : (rt.x & 255);
    const bf16_t* H2 = (const bf16_t*)(a.ws + OFF_H2) + (size_t)tok * 1024;
    for (int k = tid; k < 1024; k += 256) hrow[k] = bf2f(H2[k]);
    __syncthreads();
    const float* w1 = a.in[I_OM1] + (size_t)e * 1024 * DFFE; const float* w3 = a.in[I_OM3] + (size_t)e * 1024 * DFFE;
    for (int f = tid; f < DFFE; f += 256) { float s1 = 0.f, s3 = 0.f; for (int q = 0; q < 1024; ++q) { s1 += hrow[q] * bfr(w1[(size_t)q * DFFE + f]); s3 += hrow[q] * bfr(w3[(size_t)q * DFFE + f]); }
        ref[f] = s1 / (1.f + expf(-s1)) * s3; fast[f] = bf2f(((const bf16_t*)(a.ws + OFF_ACTM))[(size_t)(rho - 256 * g0) * DFFE + f]); }
    __syncthreads(); commit(D, 27, ref, fast, DFFE, 0.02f);
}

__global__ void simple_final(Args a) {
    const int row = blockIdx.x * 4 + (threadIdx.x >> 6), lane = threadIdx.x & 63; unsigned char* ws = a.ws;
    const bf16_t* H2 = (const bf16_t*)(ws + OFF_H2); const bf16_t* YR = (const bf16_t*)(ws + OFF_YR);
    const u32x2* ROUTE = (const u32x2*)(ws + OFF_ROUTE); const int* DEST = (const int*)(ws + OFF_DEST);
    const float g0 = __uint_as_float(ROUTE[row].y), g1 = 1.f - g0; const int d0 = DEST[2 * row], d1 = DEST[2 * row + 1];
    float v[16]; float s = 0.f;
    for (int i = 0; i < 16; ++i) { const int col = lane + 64 * i; v[i] = ALPHA * bf2f(H2[(size_t)row * 1024 + col]) + g0 * bf2f(YR[(size_t)d0 * 1024 + col]) + g1 * bf2f(YR[(size_t)d1 * 1024 + col]); s += v[i]; }
    const float mean = wave_sum(s) / 1024.f; float q = 0.f;
    for (int i = 0; i < 16; ++i) { v[i] -= mean; q += v[i] * v[i]; }
    const float rstd = 1.f / sqrtf(wave_sum(q) / 1024.f + 1e-5f);
    for (int i = 0; i < 16; ++i) { const int col = lane + 64 * i; a.out[(size_t)row * 1024 + col] = v[i] * rstd * a.in[I_OLN2G][col] + a.in[I_OLN2B][col]; }
}
__global__ void report(float* out, const unsigned* D, int nelem) {
    __shared__ float kk, xx;
    if (threadIdx.x == 0) { int idx = 0; float v = 0.f; float worst = 0.f;
        for (int s = 1; s < NSLOT; ++s) { const unsigned bad = D[4 * s], tot = D[4 * s + 1]; if (tot == 0u) continue; const float fr = (float)bad / (float)tot; const float thr = (s == 9 || s == 10 || s == 18) ? 0.1f : 0.002f;
            if (fr > worst) worst = fr; if (fr > thr && idx == 0) { idx = s; v = fr; } }
        if (idx == 0) v = worst;
#ifdef DBG_BITS
        { const int sl[6] = DBG_BITS; idx = 0; for (int q = 0; q < 6; ++q) { const int s = sl[q]; if (s > 0 && D[4 * s + 1] > 0u && (float)D[4 * s] / (float)D[4 * s + 1] > 0.002f) idx |= 1 << q; } v = 1.f; }
#endif
#ifdef DBG_VAL
        { const float mr = __uint_as_float(D[4 * DBG_VAL + 2]); const float fr = D[4 * DBG_VAL + 1] ? (float)D[4 * DBG_VAL] / (float)D[4 * DBG_VAL + 1] : 0.f; kk = sqrtf(fmaxf(mr, 1e-6f) * 1e6f); xx = kk * (2.f + 97.f * fr); }
#else
        v = fmaxf(v, 1e-6f); const int n = (v > 0.3f) ? 4 : (v > 0.03f) ? 3 : (v > 0.003f) ? 2 : 1; kk = (n == 4) ? 1e4f : (n == 3) ? 1e3f : (n == 2) ? 1e2f : 1e1f; xx = kk * (float)(idx + 2);
#endif
        }
    __syncthreads();
    const float k = kk, x = xx;
    for (size_t i = (size_t)blockIdx.x * blockDim.x + threadIdx.x; i < (size_t)nelem; i += (size_t)gridDim.x * blockDim.x) out[i] = (i == 0) ? x : k;
}
}
#endif

#ifndef MK_N_LAUNCHES
#define MK_N_LAUNCHES 1
#endif
constexpr int NPHASE = 18;
#define SP2 true
#ifndef FFN_F8
#define FFN_F8 0
#endif
#ifndef MOE_SP2
#define MOE_SP2 true
#endif
#define ALN true

__global__ void __launch_bounds__(NTHR, 2) fwd_kernel(Args args) {
    extern __shared__ __attribute__((aligned(16))) unsigned char lds_raw[];
    Frame F;
    F.lds = (LAS unsigned char*)lds_raw;
    F.tid = threadIdx.x; F.lane = F.tid & 63; F.wave = __builtin_amdgcn_readfirstlane(F.tid >> 6);
    F.G = gridDim.x; F.bx = blockIdx.x; F.gw = F.bx * NWAVES + F.wave; F.NGW = F.G * NWAVES; F.ws = args.ws;
    unsigned char* ws = args.ws;
    volatile LAS unsigned* MISC = (volatile LAS unsigned*)(F.lds + LDSCTL_OFF);
    for (int u = F.tid; u < (LDS_BYTES - LDSCTL_OFF) / 4; u += NTHR) ((LAS unsigned*)(F.lds + LDSCTL_OFF))[u] = 0u;
    __syncthreads();
    XcdBarrier bar = xcd_barrier_post((unsigned*)(ws + OFF_BAR) + args.li * XCD_BAR_WORDS, MISC + 8);
    const int lo = args.ph_lo, hi = args.ph_hi;
#ifndef PH_MASK
#define PH_MASK 0x3ffff
#endif
#define IN(k) (((PH_MASK >> (k)) & 1) && lo <= (k) && (k) < hi)
#ifdef TS_MODE
    unsigned long long* TS = (unsigned long long*)(ws + OFF_DBG + 1024);
#define STAMP(i) do { if (F.bx == 0 && F.tid == 0) TS[i] = __builtin_amdgcn_s_memrealtime(); } while (0)
#else
#define STAMP(i) do { } while (0)
#endif
#define SEAM(k) do { if (IN(k) && IN((k) + 1)) xcd_barrier(bar); STAMP((k) + 1); } while (0)
    LAS unsigned char* glds = F.lds;

    bf16_t* Y1 = (bf16_t*)(ws + OFF_Y1);
    float* ssq_q = (float*)(ws + OFF_SSQ_Q); float* ssq_kv = (float*)(ws + OFF_SSQ_KV);

    STAMP(0);
    if (IN(0)) { phase_prologue_even(F, args); } SEAM(0);
    if (IN(1)) { pg8::Gemm g{(const bf16_t*)(ws + OFF_XB), (const bf16_t*)(ws + OFF_W_IN), MTOK, EVEN_INP, 1024, 1024, 0}; pg8::StaticOrder S; S.init(MTOK, EVEN_INP, F.G, F.bx);
        pg8::EpiInE E{Y1, ssq_q, ssq_kv}; pg8::gemm_phase<pg8::EpiInE, pg8::StaticOrder, ALN, SP2>(glds, g, S, E); } SEAM(1);
    if (IN(2)) {
        phase_ckvn(F, Y1 + (size_t)1 * MTOK * 256, ssq_kv, args.in[I_EKVN], (bf16_t*)(ws + OFF_CKVN));
#ifndef NO_CMP
        for (int idx = F.bx; idx < 256; idx += F.G) { const int b = idx >> 5, g = (idx >> 4) & 1, kv = (idx >> 3) & 1, rt = idx & 7;
            compress_unit(F, b, g, kv, rt, Y1 + (size_t)4 * MTOK * 256, (const bf16_t*)(ws + (kv ? OFF_CV1 : OFF_CK1)), args.in[kv ? I_ECV2 : I_ECK2], (const float*)(ws + OFF_CB) + kv * 64, (bf16_t*)(ws + (kv ? OFF_VC : OFF_KC))); }
#endif
#ifndef NO_Q2
        pg8::Gemm g{Y1, (const bf16_t*)(ws + OFF_W_Q2), MTOK, 2048, 256, 256, 0}; pg8::StaticOrder S; S.init(MTOK, 2048, F.G, F.bx);
        pg8::EpiQ2 E{(bf16_t*)(ws + OFF_QLAT), (bf16_t*)(ws + OFF_QIDX), ssq_q}; pg8::gemm_phase<pg8::EpiQ2, pg8::StaticOrder, ALN, SP2>(glds, g, S, E);
#endif
    } SEAM(2);
    if (IN(3)) { for (int idx = F.bx; idx < 512; idx += F.G) { const int i = idx >> 8, v = idx & 255, b = v & 7, cc = v >> 3, c = i ? 63 - cc : cc;
            indexer_unit(F, b, c, (const bf16_t*)(ws + OFF_QIDX), Y1 + (size_t)1 * MTOK * 256, (_Float16*)(ws + OFF_SC)); } } SEAM(3);
    if (IN(4)) { phase_select(F, (const _Float16*)(ws + OFF_SC), (unsigned*)(ws + OFF_MASK)); } SEAM(4);
    if (IN(5)) {
#ifndef NO_DSA
        if (args.pad != 2) phase_dsa_sparse(F, (const bf16_t*)(ws + OFF_QLAT), (const bf16_t*)(ws + OFF_CKVN), (const unsigned*)(ws + OFF_MASK), (const float*)(ws + OFF_BT), ws + OFF_MIXIN);
#endif
        STAMP(20);
#ifndef NO_NSA
        if (args.pad != 1) for (int idx = F.bx; idx < 1024; idx += F.G) { const int i = idx >> 8, v = idx & 255, b = v & 7, cc = v >> 3, g = i & 1, c = (i >> 1) ? 63 - cc : cc;
            nsa_unit(F, b, g, c, Y1, (const bf16_t*)(ws + OFF_KC), (const bf16_t*)(ws + OFF_VC), (const float*)(ws + OFF_BT), ws + OFF_MIXIN); __syncthreads(); }
#endif
    } SEAM(5);
    if (IN(6)) { pg8::Gemm g{(const bf16_t*)(ws + OFF_MIXIN), (const bf16_t*)(ws + OFF_W_OUTE), MTOK, 1024, 768, 768, 0}; pg8::StaticOrder S; S.init(MTOK, 1024, F.G, F.bx);
        pg8::EpiRes<true> E{args.in[I_X], (bf16_t*)(ws + OFF_S1), 1.f / (OSC * WOUT_SCALE)}; pg8::gemm_phase<pg8::EpiRes<true>, pg8::StaticOrder, ALN, SP2, true>(glds, g, S, E); } SEAM(6);
    if (IN(7)) { phase_ln_i8(F, (const bf16_t*)(ws + OFF_S1), (bf16_t*)(ws + OFF_H), ws + OFF_H8, (float*)(ws + OFF_SA), args.in[I_ELN1G], args.in[I_ELN1B]); } SEAM(7);
#if FFN_F8
    if (IN(8)) { pg8::Gemm g{(const bf16_t*)(ws + OFF_H8), (const bf16_t*)(ws + OFF_W_F13), MTOK, 2 * DFF, 512, 512, 0}; pg8::StaticOrder S; S.init(MTOK, 2 * DFF, F.G, F.bx);
        pg8::EpiSwiglu8 E{ws + OFF_ACT, DFF, 0, 1.f / WF13_SCALE}; pg8::gemm_phase<pg8::EpiSwiglu8, pg8::StaticOrder, ALN, SP2, true>(glds, g, S, E); } SEAM(8);
#else
    if (IN(8)) { pg8::Gemm g{(const bf16_t*)(ws + OFF_H8), (const bf16_t*)(ws + OFF_W_F13), MTOK, 2 * DFF, 512, 512, 0}; pg8::StaticOrder S; S.init(MTOK, 2 * DFF, F.G, F.bx);
        pg8::EpiSwigluI8 E{ws + OFF_ACT, DFF, (const float*)(ws + OFF_SA), (const float*)(ws + OFF_SW)}; pg8::gemm_phase<pg8::EpiSwigluI8, pg8::StaticOrder, ALN, SP2, false, true>(glds, g, S, E); } SEAM(8);
#endif
#if FFN_F8
    if (IN(9)) { pg8::Gemm g{(const bf16_t*)(ws + OFF_ACT), (const bf16_t*)(ws + OFF_W_F2), MTOK, 1024, DFF / 2, DFF / 2, 0}; pg8::StaticOrder S; S.init(MTOK, 1024, F.G, F.bx);
        pg8::EpiRes<false> E{(const void*)(ws + OFF_H), (bf16_t*)(ws + OFF_S2), 1.f / WF2_SCALE}; pg8::gemm_phase<pg8::EpiRes<false>, pg8::StaticOrder, ALN, SP2, true>(glds, g, S, E); } SEAM(9);
#else
    if (IN(9)) { pg8::Gemm g{(const bf16_t*)(ws + OFF_ACT), (const bf16_t*)(ws + OFF_W_F2), MTOK, 1024, DFF / 2, DFF / 2, 0}; pg8::StaticOrder S; S.init(MTOK, 1024, F.G, F.bx);
        pg8::EpiRes<false> E{(const void*)(ws + OFF_H), (bf16_t*)(ws + OFF_S2), 1.f / WF2_SCALE}; pg8::gemm_phase<pg8::EpiRes<false>, pg8::StaticOrder, ALN, SP2, true>(glds, g, S, E); } SEAM(9);
#endif
    if (IN(10)) { phase_ln_bf16(F, (const bf16_t*)(ws + OFF_S2), (bf16_t*)(ws + OFF_X1), ws + OFF_X18, args.in[I_ELN2G], args.in[I_ELN2B]); phase_convert_odd(F, args); } SEAM(10);
    if (IN(11)) { pg8::Gemm g{(const bf16_t*)(ws + OFF_X18), (const bf16_t*)(ws + OFF_W_OIN), MTOK, 3072, 512, 512, 0}; pg8::StaticOrder S; S.init(MTOK, 3072, F.G, F.bx);
        pg8::EpiInO E{(bf16_t*)(ws + OFF_QKV), (float*)(ws + OFF_KMEAN), 1.f / WIN_SCALE}; pg8::gemm_phase<pg8::EpiInO, pg8::StaticOrder, ALN, SP2, true>(glds, g, S, E); } SEAM(11);
#ifdef MOBA_DENSE
    if (IN(12)) { phase_moba(F, ws, args.pad); } SEAM(12);
#else
    if (IN(12)) { phase_moba2(F, ws, args.pad); } SEAM(12);
#endif
    if (IN(13)) { pg8::Gemm g{(const bf16_t*)(ws + OFF_O8), (const bf16_t*)(ws + OFF_W_OOUT), MTOK, 1024, 512, 512, 0}; pg8::StaticOrder S; S.init(MTOK, 1024, F.G, F.bx);
        pg8::EpiRes<false> E{(const void*)(ws + OFF_X1), (bf16_t*)(ws + OFF_S1O), 1.f / (OSC * WOUT_SCALE)}; pg8::gemm_phase<pg8::EpiRes<false>, pg8::StaticOrder, ALN, SP2, true>(glds, g, S, E); } SEAM(13);
    if (IN(14)) { phase_ln_router(F, (const bf16_t*)(ws + OFF_S1O), (bf16_t*)(ws + OFF_H2), args.in[I_OLN1G], args.in[I_OLN1B], args.in[I_OROUTER], ws); } SEAM(14);
    if (IN(15)) { phase_moe_gather(F, (const bf16_t*)(ws + OFF_H2), ws + OFF_XR, ws); } SEAM(15);
    if (IN(16)) {
        const int* GI = (const int*)(ws + OFF_GINFO);
        pg8::MoeOrder S; S.G = F.G; S.c = F.bx;
#pragma unroll
        for (int e = 0; e < 8; ++e) S.pend[e] = __builtin_amdgcn_readfirstlane(GI[e]);
        const int ngroups = S.pend[7] >> 8;
        for (int g0 = 0; g0 < ngroups; g0 += MOE_CHUNK) {
            S.g0 = g0; S.ng = (ngroups - g0) < MOE_CHUNK ? (ngroups - g0) : MOE_CHUNK;
            { S.nN = 28; pg8::Gemm g{(const bf16_t*)(ws + OFF_XR), (const bf16_t*)(ws + OFF_W_M13), 0, 2 * DFFE, 512, 512, (size_t)2 * DFFE * 512};
              pg8::EpiSwiglu8 E{ws + OFF_ACTM, DFFE, g0, 1.f / W13_SCALE}; pg8::gemm_phase<pg8::EpiSwiglu8, pg8::MoeOrder, ALN, MOE_SP2, true>(glds, g, S, E); }
            xcd_barrier(bar);
            { S.nN = 4; pg8::Gemm g{(const bf16_t*)(ws + OFF_ACTM - (size_t)g0 * 256 * DFFE), (const bf16_t*)(ws + OFF_W_M2), 0, 1024, DFFE / 2, DFFE / 2, (size_t)1024 * DFFE / 2};
              pg8::EpiStoreS E{(bf16_t*)(ws + OFF_YR), 1024, 1.f / W2_SCALE}; pg8::gemm_phase<pg8::EpiStoreS, pg8::MoeOrder, ALN, MOE_SP2, true>(glds, g, S, E); }
            xcd_barrier(bar);
        }
    }
    STAMP(17);
    if (IN(17)) { phase_final(F, (const bf16_t*)(ws + OFF_H2), (const bf16_t*)(ws + OFF_YR), args.in[I_OLN2G], args.in[I_OLN2B], args.out, ws); }
#ifdef TS_MODE
    STAMP(18);
    xcd_barrier(bar);
    { const int ia[2] = TS_SEL; float d[2];
      for (int q = 0; q < 2; ++q) { const int i = ia[q]; const unsigned long long t1 = (i == 5) ? TS[20] : ((i == 25) ? TS[6] : TS[i + 1]); const unsigned long long t0 = (i == 25) ? TS[20] : TS[i]; d[q] = (float)(t1 - t0) * 0.01f; }
      const float k = sqrtf(fmaxf(d[0], 1.f)), x = 10.f * fmaxf(d[1], 1.f);
      for (size_t i = (size_t)F.bx * NTHR + F.tid; i < (size_t)MTOK * 1024; i += (size_t)F.G * NTHR) args.out[i] = (i == 0) ? x : k; }
#endif
#undef IN
#undef SEAM
}

extern "C" void kernel_launch(void* const* d_in, const int* in_sizes, int n_in, void* d_out, int out_size, void* d_ws, size_t ws_size, hipStream_t stream) {
    static int grid = 0;
    if (grid == 0) {
        if (n_in != 33 || in_sizes[0] != MTOK * DM || out_size != MTOK * DM || ws_size < WS_END) { fprintf(stderr, "kernel_launch: unexpected problem (n_in %d, in0 %d, out %d, ws %zu < %zu)\n", n_in, n_in > 0 ? in_sizes[0] : -1, out_size, ws_size, (size_t)WS_END); grid = -1; return; }
        int dev = 0, cus = 0, per_cu = 0;
        if (hipGetDevice(&dev) != hipSuccess || hipDeviceGetAttribute(&cus, hipDeviceAttributeMultiprocessorCount, dev) != hipSuccess) { grid = -1; return; }
        if (hipFuncSetAttribute((const void*)fwd_kernel, hipFuncAttributeMaxDynamicSharedMemorySize, LDS_BYTES) != hipSuccess) { fprintf(stderr, "kernel_launch: hipFuncSetAttribute failed\n"); grid = -1; return; }
        if (hipOccupancyMaxActiveBlocksPerMultiprocessor(&per_cu, (const void*)fwd_kernel, NTHR, LDS_BYTES) != hipSuccess || per_cu < 1) fprintf(stderr, "kernel_launch: occupancy query reports %d\n", per_cu);
        (void)hipGetLastError();
        grid = cus > 256 ? 256 : cus;
    }
    if (grid < 0) return;
    hipMemsetAsync(d_ws, 0, CTL_ZERO_BYTES, stream);
    Args a{};
    for (int i = 0; i < 33; ++i) a.in[i] = (const float*)d_in[i];
    a.out = (float*)d_out; a.ws = (unsigned char*)d_ws;
#if MK_N_LAUNCHES == 1
    a.ph_lo = 0; a.ph_hi = NPHASE; a.li = 0;
    hipLaunchKernelGGL(fwd_kernel, dim3(grid), dim3(NTHR), LDS_BYTES, stream, a);
#else
    for (int p = 0; p < NPHASE; ++p) { a.ph_lo = p; a.ph_hi = p + 1; a.li = p;
#ifdef REP_PHASE
        if (p == REP_PHASE) { Args a2 = a;
#ifdef REP_PAD
            a2.pad = REP_PAD;
#endif
            for (int rep = 0; rep < REP_N; ++rep) { a2.li = NPHASE + rep; hipLaunchKernelGGL(fwd_kernel, dim3(grid), dim3(NTHR), LDS_BYTES, stream, a2); } }
#endif
        hipLaunchKernelGGL(fwd_kernel, dim3(grid), dim3(NTHR), LDS_BYTES, stream, a);
#ifdef DBG_MODE
        unsigned* D = (unsigned*)((unsigned char*)d_ws + OFF_DBG); unsigned char* ws = (unsigned char*)d_ws;
        switch (p) {
            case 1: hipLaunchKernelGGL(dbg::chk_in_e, dim3(64), dim3(256), 0, stream, a, D); break;
            case 2: hipLaunchKernelGGL(dbg::chk_q2, dim3(64), dim3(256), 0, stream, a, D); hipLaunchKernelGGL(dbg::chk_cmp, dim3(96), dim3(256), 0, stream, a, D); break;
            case 3: hipLaunchKernelGGL(dbg::chk_idx, dim3(64), dim3(256), 0, stream, a, D); break;
            case 4: hipLaunchKernelGGL(dbg::chk_sel, dim3(48), dim3(256), 0, stream, a, D); break;
            case 5: hipLaunchKernelGGL(dbg::chk_dsa, dim3(64), dim3(256), 0, stream, a, D); hipLaunchKernelGGL(dbg::chk_nsa, dim3(64), dim3(256), 0, stream, a, D); break;
            case 6: hipLaunchKernelGGL(dbg::chk_out_e, dim3(32), dim3(256), 0, stream, a, D); break;
            case 7: hipLaunchKernelGGL(dbg::chk_ln, dim3(32), dim3(256), 0, stream, (const bf16_t*)(ws + OFF_S1), (const bf16_t*)(ws + OFF_H), a.in[I_ELN1G], a.in[I_ELN1B], D, 12); break;
            case 8: hipLaunchKernelGGL(dbg::chk_ffn_up, dim3(16), dim3(256), 0, stream, a, D); break;
            case 9: hipLaunchKernelGGL(dbg::chk_ffn_dn, dim3(32), dim3(256), 0, stream, a, D); break;
            case 10: hipLaunchKernelGGL(dbg::chk_ln, dim3(32), dim3(256), 0, stream, (const bf16_t*)(ws + OFF_S2), (const bf16_t*)(ws + OFF_X1), a.in[I_ELN2G], a.in[I_ELN2B], D, 15); break;
            case 10 + 100: break;
            case 11: hipLaunchKernelGGL(dbg::chk_wmoe, dim3(16), dim3(256), 0, stream, a, D); hipLaunchKernelGGL(dbg::chk_in_o, dim3(32), dim3(256), 0, stream, a, D); break;
            case 12: hipLaunchKernelGGL(dbg::chk_moba, dim3(64), dim3(256), 0, stream, a, D); break;
            case 13: hipLaunchKernelGGL(dbg::chk_out_o, dim3(32), dim3(256), 0, stream, a, D); break;
            case 14: hipLaunchKernelGGL(dbg::chk_ln, dim3(32), dim3(256), 0, stream, (const bf16_t*)(ws + OFF_S1O), (const bf16_t*)(ws + OFF_H2), a.in[I_OLN1G], a.in[I_OLN1B], D, 19); break;
            case 15: hipLaunchKernelGGL(dbg::chk_route, dim3(1), dim3(256), 0, stream, a, D); break;
            case 16: hipLaunchKernelGGL(dbg::chk_actm, dim3(8), dim3(256), 0, stream, a, D); break;
            case 17:
#ifdef DBG_SIMPLE_FINAL
                hipLaunchKernelGGL(dbg::simple_final, dim3(MTOK / 4), dim3(256), 0, stream, a);
#endif
                hipLaunchKernelGGL(dbg::chk_moe, dim3(16), dim3(256), 0, stream, a, D); hipLaunchKernelGGL(dbg::report, dim3(1024), dim3(256), 0, stream, (float*)d_out, (const unsigned*)D, out_size); break;
            default: break;
        }
#endif
    }
#endif
}
```

```cpp
#include <hip/hip_runtime.h>
#include <cstdio>
#include <cstdint>

#define LAS __attribute__((address_space(3)))
#define GAS __attribute__((address_space(1)))
typedef unsigned short bf16_t;
typedef short bf16x8 __attribute__((ext_vector_type(8)));
typedef short s16x4 __attribute__((ext_vector_type(4)));
typedef float f32x2 __attribute__((ext_vector_type(2)));
typedef float f32x4 __attribute__((ext_vector_type(4)));
typedef float f32x16 __attribute__((ext_vector_type(16)));
typedef unsigned u32x2 __attribute__((ext_vector_type(2)));
typedef unsigned u32x4 __attribute__((ext_vector_type(4)));
typedef __bf16 bf16x2_t __attribute__((ext_vector_type(2)));
typedef _Float16 f16x2_t __attribute__((ext_vector_type(2)));

constexpr int DM = 1024, NB = 8, SEQ = 4096, MTOK = NB * SEQ;
constexpr int EVEN_IN = 1768, EVEN_INP = 1792, DFF = 2816, DFFE = 3584, NEXP = 8;
constexpr float ALPHA = 1.4142135623730951f;
constexpr float LOG2E = 1.4426950408889634f;
constexpr float QSCALE = 0.125f * LOG2E;
constexpr int NWAVES = 8, NTHR = 512;

__device__ __forceinline__ unsigned f2bf(float f) { unsigned u = __builtin_bit_cast(unsigned, f); return (u + 0x7fffu + ((u >> 16) & 1u)) >> 16; }
__device__ __forceinline__ unsigned pk2(float lo, float hi) { f32x2 v = {lo, hi}; bf16x2_t b = __builtin_convertvector(v, bf16x2_t); return __builtin_bit_cast(unsigned, b); }
__device__ __forceinline__ float bf2f(unsigned short h) { return __builtin_bit_cast(float, (unsigned)h << 16); }
__device__ __forceinline__ float bflo(unsigned w) { return __builtin_bit_cast(float, w << 16); }
__device__ __forceinline__ float bfhi(unsigned w) { return __builtin_bit_cast(float, w & 0xffff0000u); }
__device__ __forceinline__ float wave_sum(float v) {
#pragma unroll
    for (int o = 1; o < 64; o <<= 1) v += __shfl_xor(v, o);
    return v;
}
#define LDS_WAIT() asm volatile("s_waitcnt lgkmcnt(0)" ::: "memory")
#define VM_WAIT() asm volatile("s_waitcnt vmcnt(0)" ::: "memory")
namespace pg8 {
#define PG8_LAS __attribute__((address_space(3)))
typedef unsigned short bf16_t;
typedef short bf16x8 __attribute__((ext_vector_type(8)));
typedef float f32x4 __attribute__((ext_vector_type(4)));
typedef unsigned u32x4 __attribute__((ext_vector_type(4)));
constexpr int BM = 256, BK = 64, HALF = 128, HTB = HALF * BK * 2  , STAGE_BYTES = 8 * HTB, NXCD = 8, WGM = 8;

__host__ __device__ __forceinline__ int lds_byte(int r, int c) { const int st = (r >> 4) * 2 + (c >> 5), rr = r & 15, cc = c & 31, ob = rr * 64 + cc * 2; return st * 1024 + (ob ^ (((ob >> 9) & 1) << 5)); }
__host__ __device__ __forceinline__ void stage_rc(int b, int& R, int& C) { const int st = b / 1024, sb = b % 1024, swz = sb ^ (((sb >> 9) & 1) << 5); R = (st >> 1) * 16 + swz / 64; C = (st & 1) * 32 + (swz % 64) / 2; }
__host__ __device__ __forceinline__ int perm32(int rho) { const int n = rho >> 4, i = rho & 15; return 8 * (i >> 2) + 4 * n + (i & 3); }

struct Unit { int pm, pn, e; };
struct Gemm { const bf16_t* A; const bf16_t* Bt; int M, N, K; int lda; size_t bstride; };

struct StaticOrder {
    int nM, nN, nwg, G, c;
    __host__ __device__ void init(int M, int N, int G_, int c_) { nM = M / BM; nN = N / BM; nwg = nM * nN; G = G_; c = c_; }
    __host__ __device__ bool next(int i, Unit& u) const {
        const long L = (long)i * G + c; if (L >= nwg) return false;
        int wgid = (int)L; { const int q = nwg / NXCD, r = nwg % NXCD, xcd = wgid % NXCD, off = wgid / NXCD; wgid = (xcd < r ? xcd * (q + 1) : r * (q + 1) + (xcd - r) * q) + off; }
        const int nig = WGM * nN, gid = wgid / nig, fm = gid * WGM, gsz = (nM - fm) < WGM ? (nM - fm) : WGM;
        u.pm = fm + ((wgid % nig) % gsz); u.pn = (wgid % nig) / gsz; u.e = 0; return true;
    }
    __device__ __forceinline__ void a_ready(const Unit&) const {}
    __device__ __forceinline__ void done(const Unit&) const {}
};


typedef int v8i32_t __attribute__((ext_vector_type(8)));
typedef int v4i32_t __attribute__((ext_vector_type(4)));
__device__ __forceinline__ v8i32_t cat8(bf16x8 lo, bf16x8 hi) { const v4i32_t a = __builtin_bit_cast(v4i32_t, lo), b = __builtin_bit_cast(v4i32_t, hi); return (v8i32_t){a[0], a[1], a[2], a[3], b[0], b[1], b[2], b[3]}; }
template <class Epi, class Sched, bool ALIGN_EPI = false, bool SP2 = false, bool F8 = false, bool I8 = false>
__device__ __forceinline__ void gemm_phase(PG8_LAS unsigned char* lds, const Gemm g, const Sched& S, const Epi& E) {
    const int tid = threadIdx.x, wid = __builtin_amdgcn_readfirstlane(tid >> 6), lane = tid & 63, wr = wid >> 2, wc = wid & 3, fr = lane & 15, fq = lane >> 4;
    const int K = g.K, nt = K / BK;
    unsigned voffA[2], voffB[2];
#pragma unroll
    for (int i = 0; i < 2; ++i) { int R, C; stage_rc(tid * 16 + i * 8192, R, C); const int Rb = Epi::PERM ? ((R & ~31) + perm32(R & 31)) : R;
        voffA[i] = (unsigned)(R * g.lda + C) * 2u; voffB[i] = (unsigned)(Rb * K + C) * 2u; }
    const size_t kstep = (size_t)(BK * 2);
    const size_t hstep = (size_t)HALF * K * 2;
    const size_t tstep = 2 * hstep;
    const size_t hstepA = (size_t)HALF * g.lda * 2, tstepA = 2 * hstepA;
    const size_t estep = g.bstride * 2;
    const unsigned ldsw = (unsigned)wid * 1024u;
    const int aoff = lds_byte(wr * 64 + fr, fq * 8), boff = lds_byte(wc * 32 + fr, fq * 8);
#define PG8_SA(b, h) (((b) * 2 + (h)) * HTB)
#define PG8_SB(b, h) ((4 + (b) * 2 + (h)) * HTB)
#define PG8_STAGE(bufoff, gbase, voff) do { _Pragma("unroll") for (int _i = 0; _i < 2; ++_i) \
        __builtin_amdgcn_global_load_lds((const unsigned*)((const char*)(gbase) + (voff)[_i]), (PG8_LAS unsigned*)(lds + (bufoff) + ldsw + _i * 8192), 16, 0, 0); } while (0)
#define PG8_LDA(dst, b, h) do { _Pragma("unroll") for (int m = 0; m < 4; ++m) _Pragma("unroll") for (int k = 0; k < 2; ++k) dst[m][k] = *(const PG8_LAS bf16x8*)(lds + PG8_SA(b, h) + aoff + m * 2048 + k * 1024); } while (0)
#define PG8_LDB(dst, b, h) do { _Pragma("unroll") for (int n = 0; n < 2; ++n) _Pragma("unroll") for (int k = 0; k < 2; ++k) dst[n][k] = *(const PG8_LAS bf16x8*)(lds + PG8_SB(b, h) + boff + n * 2048 + k * 1024); } while (0)
#define PG8_MMA(ai, bj, At, Bt) do { __builtin_amdgcn_s_setprio(1); if constexpr (I8) { _Pragma("unroll") for (int m = 0; m < 4; ++m) _Pragma("unroll") for (int n = 0; n < 2; ++n) _Pragma("unroll") for (int k = 0; k < 2; ++k) \
        asm volatile("v_mfma_i32_16x16x64_i8 %0, %1, %2, %0" : "+v"(acc[ai][bj][m][n]) : "v"(Bt[n][k]), "v"(At[m][k])); } else if constexpr (F8) { _Pragma("unroll") for (int m = 0; m < 4; ++m) _Pragma("unroll") for (int n = 0; n < 2; ++n) \
        asm volatile("v_mfma_scale_f32_16x16x128_f8f6f4 %0, %1, %2, %0, %3, %3 op_sel_hi:[0,0,0]" : "+v"(acc[ai][bj][m][n]) : "v"(cat8(Bt[n][0], Bt[n][1])), "v"(cat8(At[m][0], At[m][1])), "v"(sc8)); } else { \
        _Pragma("unroll") for (int m = 0; m < 4; ++m) _Pragma("unroll") for (int n = 0; n < 2; ++n) _Pragma("unroll") for (int k = 0; k < 2; ++k) \
        acc[ai][bj][m][n] = __builtin_amdgcn_mfma_f32_16x16x32_bf16(Bt[n][k], At[m][k], acc[ai][bj][m][n], 0, 0, 0); } __builtin_amdgcn_s_setprio(0); } while (0)
#define PG8_WAIT_V(n) asm volatile("s_waitcnt vmcnt(" #n ")" ::: "memory")
#define PG8_WAIT_L(n) asm volatile("s_waitcnt lgkmcnt(" #n ")" ::: "memory")
#define PG8_BAR __builtin_amdgcn_s_barrier()
#define PG8_SCHED __builtin_amdgcn_sched_barrier(0)
    Unit cur, nxt; int ui = 0;
    if (!S.next(0, cur)) return;
    int sc8 = 0x7f7f7f7f; asm volatile("" : "+v"(sc8));
    f32x4 acc[2][2][4][2];
#pragma unroll
    for (int a = 0; a < 2; ++a)
#pragma unroll
        for (int b = 0; b < 2; ++b)
#pragma unroll
            for (int m = 0; m < 4; ++m)
#pragma unroll
                for (int n = 0; n < 2; ++n) acc[a][b][m][n] = (f32x4){0.f, 0.f, 0.f, 0.f};
    bf16x8 At[4][2], B0[2][2], B1[2][2];
    const char* cA = (const char*)g.A + (size_t)cur.pm * tstepA; const char* cB = (const char*)g.Bt + (size_t)cur.pn * tstep + (size_t)cur.e * estep;
    S.a_ready(cur);
    if constexpr (SP2) {
        PG8_STAGE(PG8_SB(0, 0), cB, voffB); PG8_STAGE(PG8_SB(0, 1), cB + hstep, voffB); PG8_STAGE(PG8_SA(0, 0), cA, voffA); PG8_STAGE(PG8_SA(0, 1), cA + hstepA, voffA);
        if (wr == 1) PG8_BAR;
        PG8_WAIT_V(2); PG8_BAR;
        PG8_STAGE(PG8_SB(1, 0), cB + kstep, voffB); PG8_STAGE(PG8_SA(1, 0), cA + kstep, voffA); PG8_STAGE(PG8_SB(1, 1), cB + hstep + kstep, voffB);
        PG8_WAIT_V(6); PG8_BAR;
    } else {
        PG8_STAGE(PG8_SB(0, 0), cB, voffB); PG8_STAGE(PG8_SA(0, 0), cA, voffA); PG8_STAGE(PG8_SB(0, 1), cB + hstep, voffB); PG8_STAGE(PG8_SA(0, 1), cA + hstepA, voffA);
        if (wr == 1) PG8_BAR;
        PG8_WAIT_V(4); PG8_BAR;
        PG8_STAGE(PG8_SB(1, 0), cB + kstep, voffB); PG8_STAGE(PG8_SA(1, 0), cA + kstep, voffA); PG8_STAGE(PG8_SB(1, 1), cB + hstep + kstep, voffB);
        PG8_WAIT_V(6); PG8_BAR;
    }
    for (;;) {
        const bool has_next = S.next(ui + 1, nxt);
        const char* nA = has_next ? (const char*)g.A + (size_t)nxt.pm * tstepA : cA; const char* nB = has_next ? (const char*)g.Bt + (size_t)nxt.pn * tstep + (size_t)nxt.e * estep : cB;
#pragma unroll 1
        for (int t = 0; t < nt; t += 2) {
            const bool last = (t == nt - 2);
            const char* a1 = cA + (size_t)(t + 1) * kstep;
            const char* a2 = last ? nA : cA + (size_t)(t + 2) * kstep; const char* b2 = last ? nB : cB + (size_t)(t + 2) * kstep;
            const char* a3 = a2 + kstep; const char* b3 = b2 + kstep;
            if (last && has_next) S.a_ready(nxt);
            if constexpr (SP2) {
            PG8_LDB(B0, 0, 0); PG8_LDB(B1, 0, 1); PG8_SCHED; PG8_LDA(At, 0, 0); PG8_STAGE(PG8_SA(1, 1), a1 + hstepA, voffA);
            PG8_WAIT_V(8); PG8_WAIT_L(0); PG8_BAR; PG8_MMA(0, 0, At, B0); PG8_MMA(0, 1, At, B1); PG8_BAR; PG8_SCHED;
            PG8_LDA(At, 0, 1); PG8_STAGE(PG8_SB(0, 0), b2, voffB); PG8_STAGE(PG8_SB(0, 1), b2 + hstep, voffB); PG8_STAGE(PG8_SA(0, 0), a2, voffA);
            PG8_WAIT_V(8); PG8_WAIT_L(0); PG8_BAR; PG8_MMA(1, 0, At, B0); PG8_MMA(1, 1, At, B1); PG8_BAR; PG8_SCHED;
            PG8_LDB(B0, 1, 0); PG8_LDB(B1, 1, 1); PG8_SCHED; PG8_LDA(At, 1, 0); PG8_STAGE(PG8_SA(0, 1), a2 + hstepA, voffA);
            PG8_WAIT_V(8); PG8_WAIT_L(0); PG8_BAR; PG8_MMA(0, 0, At, B0); PG8_MMA(0, 1, At, B1); PG8_BAR; PG8_SCHED;
            PG8_LDA(At, 1, 1); PG8_STAGE(PG8_SB(1, 0), b3, voffB); PG8_STAGE(PG8_SB(1, 1), b3 + hstep, voffB); PG8_STAGE(PG8_SA(1, 0), a3, voffA);
            PG8_WAIT_V(8); PG8_WAIT_L(0); PG8_BAR; PG8_MMA(1, 0, At, B0); PG8_MMA(1, 1, At, B1); PG8_BAR; PG8_SCHED;
            } else {
            PG8_LDB(B0, 0, 0); PG8_SCHED; PG8_LDA(At, 0, 0); PG8_STAGE(PG8_SA(1, 1), a1 + hstepA, voffA);
            PG8_WAIT_L(8); PG8_BAR; PG8_WAIT_L(0); PG8_MMA(0, 0, At, B0); PG8_BAR; PG8_SCHED;
            PG8_LDB(B1, 0, 1); PG8_STAGE(PG8_SB(0, 0), b2, voffB);
            PG8_BAR; PG8_WAIT_L(0); PG8_MMA(0, 1, At, B1); PG8_BAR;
            PG8_LDA(At, 0, 1); PG8_STAGE(PG8_SA(0, 0), a2, voffA);
            PG8_BAR; PG8_WAIT_L(0); PG8_MMA(1, 0, At, B0); PG8_BAR; PG8_SCHED;
            PG8_STAGE(PG8_SB(0, 1), b2 + hstep, voffB);
            PG8_WAIT_V(6); PG8_BAR; PG8_MMA(1, 1, At, B1); PG8_BAR;
            PG8_LDB(B0, 1, 0); PG8_SCHED; PG8_LDA(At, 1, 0); PG8_STAGE(PG8_SA(0, 1), a2 + hstepA, voffA);
            PG8_WAIT_L(8); PG8_BAR; PG8_WAIT_L(0); PG8_MMA(0, 0, At, B0); PG8_BAR; PG8_SCHED;
            PG8_LDB(B1, 1, 1); PG8_STAGE(PG8_SB(1, 0), b3, voffB);
            PG8_BAR; PG8_WAIT_L(0); PG8_MMA(0, 1, At, B1); PG8_BAR;
            PG8_LDA(At, 1, 1); PG8_STAGE(PG8_SA(1, 0), a3, voffA);
            PG8_BAR; PG8_WAIT_L(0); PG8_MMA(1, 0, At, B0); PG8_BAR; PG8_SCHED;
            PG8_STAGE(PG8_SB(1, 1), b3 + hstep, voffB);
            PG8_WAIT_V(6); PG8_BAR; PG8_MMA(1, 1, At, B1); PG8_BAR;
            }
        }
        if constexpr (ALIGN_EPI) { if (wr == 0) PG8_BAR; }
        if constexpr (F8 || I8) asm volatile("s_nop 15\n\ts_nop 15" ::: "memory");
        if constexpr (!Epi::AFTER_DRAIN) { E(acc, cur, wr, wc, fr, fq); S.done(cur); }
        if (!has_next) break;
#pragma unroll
        for (int a = 0; a < 2; ++a)
#pragma unroll
            for (int b = 0; b < 2; ++b)
#pragma unroll
                for (int m = 0; m < 4; ++m)
#pragma unroll
                    for (int n = 0; n < 2; ++n) acc[a][b][m][n] = (f32x4){0.f, 0.f, 0.f, 0.f};
        cur = nxt; cA = nA; cB = nB; ++ui;
        if constexpr (ALIGN_EPI) { if (wr == 1) PG8_BAR; }
    }
    PG8_WAIT_V(0);
    if constexpr (!ALIGN_EPI) { if (wr == 0) PG8_BAR; }
    PG8_BAR;
    if constexpr (Epi::AFTER_DRAIN) { E.fused(acc, cur, wr, wc, fr, fq, lds, wid, lane); S.done(cur); }
#undef PG8_SA
#undef PG8_SB
#undef PG8_STAGE
#undef PG8_LDA
#undef PG8_LDB
#undef PG8_MMA
#undef PG8_WAIT_V
#undef PG8_WAIT_L
#undef PG8_BAR
#undef PG8_SCHED
}
}

namespace pg8 {
typedef f32x4 Acc[2][2][4][2];
__device__ __forceinline__ u32x4 pack8(const f32x4 v0, const f32x4 v1) { u32x4 w; w.x = pk2(v0[0], v0[1]); w.y = pk2(v0[2], v0[3]); w.z = pk2(v1[0], v1[1]); w.w = pk2(v1[2], v1[3]); return w; }
__device__ __forceinline__ void unpack8(const u32x4 w, f32x4& a, f32x4& b) { a = (f32x4){bflo(w.x), bfhi(w.x), bflo(w.y), bfhi(w.y)}; b = (f32x4){bflo(w.z), bfhi(w.z), bflo(w.w), bfhi(w.w)}; }

struct EpiInE {
    static constexpr bool PERM = true, AFTER_DRAIN = false;
    bf16_t* Y1; float* ssq_q; float* ssq_kv;
    __device__ __forceinline__ void operator()(const Acc& acc, const Unit& u, int wr, int wc, int fr, int fq) const {
        bf16_t* base = Y1 + (size_t)u.pn * MTOK * 256;
        const float sc = (u.pn == 2 || u.pn == 3) ? QSCALE : 1.f;
        const int col0 = wc * 32 + 8 * fq;
#pragma unroll
        for (int ai = 0; ai < 2; ++ai)
#pragma unroll
            for (int m = 0; m < 4; ++m) {
                const int row = u.pm * BM + ai * HALF + wr * 64 + m * 16 + fr; bf16_t* rowp = base + (size_t)row * 256 + col0;
                float s0 = 0.f, s1 = 0.f;
#pragma unroll
                for (int bj = 0; bj < 2; ++bj) { const f32x4 v0 = acc[ai][bj][m][0], v1 = acc[ai][bj][m][1];
                    const float q = (v0[0] * v0[0] + v0[1] * v0[1]) + (v0[2] * v0[2] + v0[3] * v0[3]) + (v1[0] * v1[0] + v1[1] * v1[1]) + (v1[2] * v1[2] + v1[3] * v1[3]);
                    if (bj == 0) s0 = q; else s1 = q;
                    *(u32x4*)(rowp + bj * HALF) = pack8(v0 * sc, v1 * sc); }
                if (u.pn <= 1) {
                    float s = (u.pn == 0) ? (s0 + s1) : s0;
                    s += __shfl_xor(s, 16); s += __shfl_xor(s, 32);
                    if (fq == 0) (u.pn == 0 ? ssq_q : ssq_kv)[(size_t)row * 4 + wc] = s;
                }
            }
    }
};
struct EpiQ2 {
    static constexpr bool PERM = true, AFTER_DRAIN = false;
    bf16_t* QLAT; bf16_t* QIDX; const float* ssq_q;
    __device__ __forceinline__ void operator()(const Acc& acc, const Unit& u, int wr, int wc, int fr, int fq) const {
        bf16_t* base = (u.pn < 4) ? QLAT : QIDX; const float sc0 = (u.pn < 4) ? QSCALE : 1.f;
        const int col0 = (u.pn & 3) * 256 + wc * 32 + 8 * fq;
#pragma unroll
        for (int ai = 0; ai < 2; ++ai)
#pragma unroll
            for (int m = 0; m < 4; ++m) {
                const int row = u.pm * BM + ai * HALF + wr * 64 + m * 16 + fr; bf16_t* rowp = base + (size_t)row * 1024 + col0;
                const f32x4 sq = *(const f32x4*)(ssq_q + (size_t)row * 4); const float sc = sc0 * __builtin_amdgcn_rsqf(((sq[0] + sq[1]) + (sq[2] + sq[3])) * (1.f / 256.f) + 1e-6f);
#pragma unroll
                for (int bj = 0; bj < 2; ++bj) *(u32x4*)(rowp + bj * HALF) = pack8(acc[ai][bj][m][0] * sc, acc[ai][bj][m][1] * sc);
            }
    }
};
template <bool RES_F32> struct EpiRes {
    static constexpr bool PERM = true, AFTER_DRAIN = false;
    const void* res; bf16_t* S; float sc;
    __device__ __forceinline__ void operator()(const Acc& acc, const Unit& u, int wr, int wc, int fr, int fq) const {
        const int col0 = u.pn * BM + wc * 32 + 8 * fq;
#pragma unroll
        for (int ai = 0; ai < 2; ++ai)
#pragma unroll
            for (int m = 0; m < 4; ++m) {
                const size_t off = (size_t)(u.pm * BM + ai * HALF + wr * 64 + m * 16 + fr) * 1024 + col0;
#pragma unroll
                for (int bj = 0; bj < 2; ++bj) { f32x4 r0, r1;
                    if (RES_F32) { r0 = *(const f32x4*)((const float*)res + off + bj * HALF); r1 = *(const f32x4*)((const float*)res + off + bj * HALF + 4); }
                    else unpack8(*(const u32x4*)((const bf16_t*)res + off + bj * HALF), r0, r1);
                    *(u32x4*)(S + off + bj * HALF) = pack8(r0 * ALPHA + acc[ai][bj][m][0] * sc, r1 * ALPHA + acc[ai][bj][m][1] * sc); }
            }
    }
};
struct EpiSwiglu {
    static constexpr bool PERM = true, AFTER_DRAIN = false;
    bf16_t* O; int ldo; int pm0;
    __device__ __forceinline__ void operator()(const Acc& acc, const Unit& u, int wr, int wc, int fr, int fq) const {
        const int col0 = u.pn * HALF + wc * 32 + 8 * fq;
#pragma unroll
        for (int ai = 0; ai < 2; ++ai)
#pragma unroll
            for (int m = 0; m < 4; ++m) {
                bf16_t* rowp = O + (size_t)((u.pm - pm0) * BM + ai * HALF + wr * 64 + m * 16 + fr) * ldo + col0;
                f32x4 o[2];
#pragma unroll
                for (int n = 0; n < 2; ++n) { const f32x4 a = acc[ai][0][m][n], b = acc[ai][1][m][n];
#pragma unroll
                    for (int e = 0; e < 4; ++e) o[n][e] = a[e] * __builtin_amdgcn_rcpf(1.f + __expf(-a[e])) * b[e]; }
                *(u32x4*)rowp = pack8(o[0], o[1]);
            }
    }
};
struct EpiStore {
    static constexpr bool PERM = true, AFTER_DRAIN = false;
    bf16_t* O; int ldo;
    __device__ __forceinline__ void operator()(const Acc& acc, const Unit& u, int wr, int wc, int fr, int fq) const {
        const int col0 = u.pn * BM + wc * 32 + 8 * fq;
#pragma unroll
        for (int ai = 0; ai < 2; ++ai)
#pragma unroll
            for (int m = 0; m < 4; ++m) {
                bf16_t* rowp = O + (size_t)(u.pm * BM + ai * HALF + wr * 64 + m * 16 + fr) * ldo + col0;
#pragma unroll
                for (int bj = 0; bj < 2; ++bj) *(u32x4*)(rowp + bj * HALF) = pack8(acc[ai][bj][m][0], acc[ai][bj][m][1]);
            }
    }
};
struct EpiInO {
    static constexpr bool PERM = true, AFTER_DRAIN = false;
    bf16_t* QKV; float* kmean; float isc;
    __device__ __forceinline__ void operator()(const Acc& acc, const Unit& u, int wr, int wc, int fr, int fq) const {
        const int which = u.pn >> 2; bf16_t* base = QKV + (size_t)which * MTOK * 1024; const float sc = (which == 0) ? QSCALE * isc : isc;
        const int col0 = (u.pn & 3) * BM + wc * 32 + 8 * fq;
#pragma unroll
        for (int ai = 0; ai < 2; ++ai)
#pragma unroll
            for (int m = 0; m < 4; ++m) {
                bf16_t* rowp = base + (size_t)(u.pm * BM + ai * HALF + wr * 64 + m * 16 + fr) * 1024 + col0;
#pragma unroll
                for (int bj = 0; bj < 2; ++bj) *(u32x4*)(rowp + bj * HALF) = pack8(acc[ai][bj][m][0] * sc, acc[ai][bj][m][1] * sc);
            }
        if (which == 1) {
#pragma unroll
            for (int bj = 0; bj < 2; ++bj)
#pragma unroll
                for (int n = 0; n < 2; ++n) { f32x4 s = (f32x4){0.f, 0.f, 0.f, 0.f};
#pragma unroll
                    for (int ai = 0; ai < 2; ++ai)
#pragma unroll
                        for (int m = 0; m < 4; ++m) s += acc[ai][bj][m][n];
#pragma unroll
                    for (int e = 0; e < 4; ++e) { float v = s[e]; v += __shfl_xor(v, 1); v += __shfl_xor(v, 2); v += __shfl_xor(v, 4); v += __shfl_xor(v, 8);
                        if (fr == 0) kmean[((size_t)u.pm * 2 + wr) * 1024 + col0 + bj * HALF + 4 * n + e] = v; }
                }
        }
    }
};

__device__ __forceinline__ unsigned pk4_fp8(float a, float b, float c, float d) { int w = 0; w = __builtin_amdgcn_cvt_pk_fp8_f32(a, b, w, false); w = __builtin_amdgcn_cvt_pk_fp8_f32(c, d, w, true); return (unsigned)w; }
struct EpiSwiglu8 {
    static constexpr bool PERM = true, AFTER_DRAIN = false;
    unsigned char* O; int ldo; int pm0; float isc;
    __device__ __forceinline__ void operator()(const Acc& acc, const Unit& u, int wr, int wc, int fr, int fq) const {
        const int col0 = u.pn * HALF + wc * 32 + 8 * fq;
#pragma unroll
        for (int ai = 0; ai < 2; ++ai)
#pragma unroll
            for (int m = 0; m < 4; ++m) {
                unsigned char* rowp = O + (size_t)((u.pm - pm0) * BM + ai * HALF + wr * 64 + m * 16 + fr) * ldo + col0;
                f32x4 o[2];
#pragma unroll
                for (int n = 0; n < 2; ++n) { const f32x4 a = acc[ai][0][m][n] * isc, b = acc[ai][1][m][n] * isc;
#pragma unroll
                    for (int e = 0; e < 4; ++e) o[n][e] = a[e] * __builtin_amdgcn_rcpf(1.f + __expf(-a[e])) * b[e]; }
                u32x2 w; w.x = pk4_fp8(o[0][0], o[0][1], o[0][2], o[0][3]); w.y = pk4_fp8(o[1][0], o[1][1], o[1][2], o[1][3]);
                *(u32x2*)rowp = w;
            }
    }
};

struct EpiSwigluI8 {
    static constexpr bool PERM = true, AFTER_DRAIN = false;
    unsigned char* O; int ldo; const float* sa; const float* sw;
    __device__ __forceinline__ void operator()(const Acc& acc, const Unit& u, int wr, int wc, int fr, int fq) const {
        const int col0 = u.pn * HALF + wc * 32 + 8 * fq, bcol = u.pn * BM + wc * 32 + 8 * fq;
        f32x4 w1s[2], w3s[2];
#pragma unroll
        for (int n = 0; n < 2; ++n) { w1s[n] = *(const f32x4*)(sw + bcol + 4 * n); w3s[n] = *(const f32x4*)(sw + bcol + HALF + 4 * n); }
#pragma unroll
        for (int ai = 0; ai < 2; ++ai)
#pragma unroll
            for (int m = 0; m < 4; ++m) {
                const int row = u.pm * BM + ai * HALF + wr * 64 + m * 16 + fr; const float ra = sa[row];
                unsigned char* rowp = O + (size_t)row * ldo + col0;
                f32x4 o[2];
#pragma unroll
                for (int n = 0; n < 2; ++n) {
#pragma unroll
                    for (int e = 0; e < 4; ++e) { const float xa = acc[ai][0][m][n][e], xb = acc[ai][1][m][n][e];
                        const float a = (float)__float_as_int(xa) * ra * w1s[n][e], b = (float)__float_as_int(xb) * ra * w3s[n][e];
                        o[n][e] = a * __builtin_amdgcn_rcpf(1.f + __expf(-a)) * b; } }
                u32x2 w; w.x = pk4_fp8(o[0][0], o[0][1], o[0][2], o[0][3]); w.y = pk4_fp8(o[1][0], o[1][1], o[1][2], o[1][3]);
                *(u32x2*)rowp = w;
            }
    }
};
struct EpiStoreS {
    static constexpr bool PERM = true, AFTER_DRAIN = false;
    bf16_t* O; int ldo; float sc;
    __device__ __forceinline__ void operator()(const Acc& acc, const Unit& u, int wr, int wc, int fr, int fq) const {
        const int col0 = u.pn * BM + wc * 32 + 8 * fq;
#pragma unroll
        for (int ai = 0; ai < 2; ++ai)
#pragma unroll
            for (int m = 0; m < 4; ++m) {
                bf16_t* rowp = O + (size_t)(u.pm * BM + ai * HALF + wr * 64 + m * 16 + fr) * ldo + col0;
#pragma unroll
                for (int bj = 0; bj < 2; ++bj) *(u32x4*)(rowp + bj * HALF) = pack8(acc[ai][bj][m][0] * sc, acc[ai][bj][m][1] * sc);
            }
    }
};
struct MoeOrder {
    int g0, ng, nN, G, c; int pend[8];
    __device__ __forceinline__ bool next(int i, Unit& u) const {
        const int L = i * G + c; if (L >= ng * nN) return false;
        u.pm = g0 + L % ng; u.pn = L / ng; const int r = u.pm * 256; int e = 0;
#pragma unroll
        for (int k = 0; k < 7; ++k) e += (pend[k] <= r) ? 1 : 0;
        u.e = e; return true;
    }
    __device__ __forceinline__ void a_ready(const Unit&) const {}
    __device__ __forceinline__ void done(const Unit&) const {}
};
}

#ifndef FFN_F8
#define FFN_F8 0
#endif
constexpr size_t MiB = 1u << 20, KiB = 1u << 10;
constexpr size_t CTL_ZERO_BYTES = 2 * MiB;
constexpr int    MAX_LAUNCHES = 18;
constexpr size_t OFF_BAR = 16 * KiB;
constexpr size_t OFF_WGCNT = 1 * MiB + 512 * KiB;
constexpr size_t OFF_GINFO = OFF_WGCNT + 16 * KiB;
constexpr size_t OFF_DBG = OFF_GINFO + 1 * KiB;
constexpr size_t OFF_BT = 2 * MiB;
constexpr size_t OFF_CB = 2 * MiB + 16 * KiB;
constexpr size_t OFF_ROUTE = 2 * MiB + 64 * KiB;
constexpr size_t OFF_DEST = 2 * MiB + 512 * KiB;
constexpr size_t OFF_KC = 3 * MiB, OFF_VC = 3 * MiB + 512 * KiB;
constexpr size_t OFF_W_IN = 4 * MiB, OFF_W_Q2 = OFF_W_IN + (size_t)EVEN_INP * 1024 * 2, OFF_W_OUTE = OFF_W_Q2 + 2048 * 256 * 2, OFF_W_F13 = OFF_W_OUTE + 1024 * 1536 * 2,
                 OFF_W_F2 = OFF_W_F13 + (size_t)2 * DFF * 1024 * 2, OFF_CK1 = OFF_W_F2 + (size_t)1024 * DFF * 2, OFF_CV1 = OFF_CK1 + 64 * 2048 * 2, OFF_WE_END = OFF_CV1 + 64 * 2048 * 2;
static_assert(OFF_WE_END <= 30 * MiB, "even weights");
constexpr size_t OFF_W_OIN = 30 * MiB, OFF_W_OOUT = 36 * MiB, OFF_W_M13 = 38 * MiB, OFF_W_M2 = 94 * MiB;
constexpr size_t OFF_Y1 = 30 * MiB;
constexpr size_t OFF_CKVN = 142 * MiB;
constexpr size_t OFF_XB = 206 * MiB, OFF_QLAT = 206 * MiB, OFF_QIDX = 270 * MiB;
constexpr size_t OFF_SC = 334 * MiB, OFF_MASK = 464 * MiB, OFF_MIXIN = 334 * MiB;
constexpr size_t OFF_S1 = 206 * MiB, OFF_H = 270 * MiB, OFF_ACT = 30 * MiB, OFF_S2 = 334 * MiB, OFF_X1 = 398 * MiB, OFF_H8 = 464 * MiB;
constexpr size_t OFF_SA = 497 * MiB, OFF_SW = 497 * MiB + 256 * KiB, OFF_SAX = 497 * MiB + 512 * KiB, OFF_SWIN = 497 * MiB + 768 * KiB;
constexpr size_t OFF_X18 = 464 * MiB, OFF_O8 = 464 * MiB;
constexpr float OSC = 16.f, WOUT_SCALE = 64.f, WIN_SCALE = 32.f, WF13_SCALE = 32.f, WF2_SCALE = 128.f;
constexpr size_t OFF_QKV = 206 * MiB, OFF_S1O = 270 * MiB, OFF_H2 = 122 * MiB, OFF_ACTM = 186 * MiB, OFF_YR = 298 * MiB, OFF_XR = 430 * MiB;
constexpr float W13_SCALE = 32.f, W2_SCALE = 128.f;
constexpr size_t OFF_MST = 122 * MiB;
constexpr size_t OFF_SSQ_Q = 514 * MiB, OFF_SSQ_KV = 514 * MiB + 512 * KiB;
constexpr size_t OFF_KMEAN = 515 * MiB;
constexpr size_t WS_END = 516 * MiB;
constexpr int    MOE_CHUNK = 128;
constexpr size_t SCB_ELEMS = (size_t)64 * 64 * (64 * 65 / 2);

constexpr int LDS_BYTES = 160 * 1024;
constexpr int LDSCTL_OFF = LDS_BYTES - 512;

#define RLX_AGENT __ATOMIC_RELAXED, __HIP_MEMORY_SCOPE_AGENT
typedef GAS unsigned gu32;
#define XB_TMO      128
#define XB_XCNT(j)  (256  + 64 * (j))
#define XB_XSUB(j)  (1280 + 64 * (j))
#define XB_XGEN(j)  (2304 + 64 * (j))
#define XB_TOP      3328
#define XB_TOPGEN   3392
#define XCD_BAR_WORDS 3456
#define XB_SPIN_CAP (1u << 18)

__device__ __forceinline__ unsigned xb_ld(unsigned* p)              { return __hip_atomic_load(p, __ATOMIC_RELAXED, __HIP_MEMORY_SCOPE_AGENT); }
__device__ __forceinline__ unsigned xb_add(unsigned* p, unsigned v) { return __hip_atomic_fetch_add(p, v, __ATOMIC_RELAXED, __HIP_MEMORY_SCOPE_AGENT); }
__device__ __forceinline__ unsigned xb_xcc_id() { return (unsigned)__builtin_amdgcn_s_getreg((3 << 11) | 20) & 0xFu; }
#define XB_SPIN(cond, bar) do { unsigned _sp = 0; while (cond) { __builtin_amdgcn_s_sleep(1); \
    if ((++_sp & 255u) == 0u) { if (xb_ld(&(bar)[XB_TMO])) break; if (_sp > XB_SPIN_CAP) { atomicAdd(&(bar)[XB_TMO], 1u); break; } } } } while (0)

struct XcdBarrier {
    unsigned* bar; unsigned x;
    volatile LAS unsigned* st;
};

__device__ __forceinline__ XcdBarrier xcd_barrier_post(unsigned* bar, volatile LAS unsigned* st) {
    XcdBarrier b; b.bar = bar; b.x = xb_xcc_id(); b.st = st;
    if (threadIdx.x == 0) (void)xb_add(&bar[XB_XCNT(b.x)], 1u);
    return b;
}
__device__ __forceinline__ void xcd_barrier_complete(unsigned* bar, unsigned x, unsigned& nloc, unsigned& nx) {
    const unsigned G = gridDim.x * gridDim.y * gridDim.z;
    unsigned sum, cnt, mine, sp = 0u;
    for (;;) {
        sum = 0u; cnt = 0u; mine = 0u;
#pragma unroll
        for (unsigned j = 0; j < 16; ++j) { const unsigned c = xb_ld(&bar[XB_XCNT(j)]); sum += c; cnt += (c > 0u) ? 1u : 0u; mine = (j == x) ? c : mine; }
        if (sum == G) break;
        __builtin_amdgcn_s_sleep(1);
        if ((++sp & 255u) == 0u) { if (xb_ld(&bar[XB_TMO])) break; if (sp > XB_SPIN_CAP) { atomicAdd(&bar[XB_TMO], 1u); break; } }
    }
    nloc = mine > 0u ? mine : 1u; nx = cnt > 0u ? cnt : 1u;
}

__device__ __forceinline__ void xcd_barrier(const XcdBarrier& b) {
    asm volatile("s_waitcnt vmcnt(0)" ::: "memory");
    __syncthreads();
    if (threadIdx.x == 0) {
        unsigned* bar = b.bar;
        __builtin_amdgcn_s_waitcnt(0);
        unsigned nloc = b.st[0], nx = b.st[1];
        if (nloc == 0u) { xcd_barrier_complete(bar, b.x, nloc, nx); b.st[0] = nloc; b.st[1] = nx; }
        const unsigned old = xb_add(&bar[XB_XSUB(b.x)], 1u);
        const unsigned gen = old / nloc;
        if (old + 1u == (gen + 1u) * nloc) {
            __builtin_amdgcn_fence(__ATOMIC_RELEASE, "agent");
            asm volatile("s_waitcnt vmcnt(0)" ::: "memory");
            const unsigned og = xb_add(&bar[XB_TOP], 1u);
            const unsigned tg = og / nx;
            if (og + 1u == (tg + 1u) * nx) xb_add(&bar[XB_TOPGEN], 1u);
            else XB_SPIN(xb_ld(&bar[XB_TOPGEN]) == tg, bar);
            __builtin_amdgcn_fence(__ATOMIC_ACQUIRE, "agent");
            xb_add(&bar[XB_XGEN(b.x)], 1u);
            asm volatile("s_waitcnt vmcnt(0)" ::: "memory");
        } else {
            XB_SPIN(xb_ld(&bar[XB_XGEN(b.x)]) == gen, bar);
            __builtin_amdgcn_fence(__ATOMIC_ACQUIRE, "agent");
            asm volatile("s_waitcnt vmcnt(0)" ::: "memory");
        }
    }
    __syncthreads();
}

struct Frame {
    LAS unsigned char* lds;
    int tid, lane, wave, G, bx;
    int gw, NGW;
    unsigned char* ws;
    const float* const* in;
};
struct Args { const float* in[33]; float* out; unsigned char* ws; int ph_lo, ph_hi, li, pad; };
enum InIdx { I_X = 0, I_RELB, I_EWIN, I_EQN, I_EKVN, I_EWUQ, I_EWUK, I_EWUV, I_EWQIDX, I_EPOSK, I_EPOSV, I_ECK1, I_ECK2, I_ECV1, I_ECV2, I_EWOUT, I_ELN1G, I_ELN1B,
             I_EF1, I_EF3, I_EF2, I_ELN2G, I_ELN2B, I_OWIN, I_OWOUT, I_OLN1G, I_OLN1B, I_OROUTER, I_OM1, I_OM3, I_OM2, I_OLN2G, I_OLN2B };

template <class RowMap, class KScale>
__device__ __forceinline__ void transpose_item(const float* W, int K, int N, bf16_t* WT, int ldt, LAS float* scr, int item, int lane, RowMap rm, KScale ks) {
    const int nblk = (N + 63) >> 6, kb = item / nblk, nb = item - kb * nblk, k0 = 128 * kb, n = 64 * nb + lane;
    if (n >= N) return;
    const float* src = W + (size_t)k0 * N + n; bf16_t* dst = WT + (size_t)rm(n) * ldt + k0;
#pragma unroll 2
    for (int kk = 0; kk < 128; kk += 8) { float v[8];
#pragma unroll
        for (int i = 0; i < 8; ++i) v[i] = src[(size_t)(kk + i) * N] * ks(k0 + kk + i);
        u32x4 o; o.x = pk2(v[0], v[1]); o.y = pk2(v[2], v[3]); o.z = pk2(v[4], v[5]); o.w = pk2(v[6], v[7]);
        *(u32x4*)(dst + kk) = o; }
}
template <class RowMap, int KB = 128>
__device__ __forceinline__ void transpose_item8(const float* W, int K, int N, unsigned char* WT, int ldt, int item, int lane, RowMap rm, float scale) {
    const int nblk = N >> 8, kb = item / nblk, nb = item - kb * nblk, k0 = KB * kb, n = 256 * nb + 4 * lane;
    const float* src = W + (size_t)k0 * N + n;
    unsigned char* d0 = WT + (size_t)rm(n) * ldt + k0; unsigned char* d1 = WT + (size_t)rm(n + 1) * ldt + k0; unsigned char* d2 = WT + (size_t)rm(n + 2) * ldt + k0; unsigned char* d3 = WT + (size_t)rm(n + 3) * ldt + k0;
#pragma unroll 1
    for (int kk = 0; kk < KB; kk += 16) { f32x4 v[16];
#pragma unroll
        for (int i = 0; i < 16; ++i) v[i] = *(const f32x4*)(src + (size_t)(kk + i) * N) * scale;
#pragma unroll
        for (int c = 0; c < 4; ++c) { u32x4 o; o.x = pg8::pk4_fp8(v[0][c], v[1][c], v[2][c], v[3][c]); o.y = pg8::pk4_fp8(v[4][c], v[5][c], v[6][c], v[7][c]);
            o.z = pg8::pk4_fp8(v[8][c], v[9][c], v[10][c], v[11][c]); o.w = pg8::pk4_fp8(v[12][c], v[13][c], v[14][c], v[15][c]);
            *(u32x4*)((c == 0 ? d0 : c == 1 ? d1 : c == 2 ? d2 : d3) + kk) = o; } }
}
template <class RowMap>
__device__ __forceinline__ void transpose_item_i8(const float* W, int K, int N, unsigned char* WT, int ldt, float* sw, int item, int lane, RowMap rm) {
    const int c = lane & 7, kg = lane >> 3, n = 8 * item + c, ks = K >> 3, kbase = kg * ks;
    const float* src = W + (size_t)kbase * N + n; float mx = 0.f;
#pragma unroll 16
    for (int k = 0; k < ks; ++k) mx = fmaxf(mx, fabsf(src[(size_t)k * N]));
    mx = fmaxf(mx, __shfl_xor(mx, 8)); mx = fmaxf(mx, __shfl_xor(mx, 16)); mx = fmaxf(mx, __shfl_xor(mx, 32));
    mx = fmaxf(mx, 1e-20f); const float inv = 127.f / mx; const int dr = rm(n); if (kg == 0) sw[dr] = mx * (1.f / 127.f);
    unsigned char* dst = WT + (size_t)dr * ldt + kbase;
#pragma unroll 2
    for (int kk = 0; kk < ks; kk += 16) { unsigned w[4];
#pragma unroll
        for (int q = 0; q < 4; ++q) { const int q0 = (int)rintf(src[(size_t)(kk + 4 * q) * N] * inv), q1 = (int)rintf(src[(size_t)(kk + 4 * q + 1) * N] * inv), q2 = (int)rintf(src[(size_t)(kk + 4 * q + 2) * N] * inv), q3 = (int)rintf(src[(size_t)(kk + 4 * q + 3) * N] * inv);
            w[q] = (unsigned)(q0 & 255) | ((unsigned)(q1 & 255) << 8) | ((unsigned)(q2 & 255) << 16) | ((unsigned)(q3 & 255) << 24); }
        *(u32x4*)(dst + kk) = (u32x4){w[0], w[1], w[2], w[3]}; }
}
struct RowId { __device__ __forceinline__ int operator()(int n) const { return n; } };
struct KOne { __device__ __forceinline__ float operator()(int) const { return 1.f; } };
struct RowInE {
    __device__ __forceinline__ int operator()(int n) const { return n < 464 ? n : (n < 1744 ? n + 48 : n - 1744 + 464); }
};
struct RowIlv {
    int add; __device__ __forceinline__ int operator()(int n) const { return ((n >> 7) << 8) + (n & 127) + add; }
};
struct KGain { const float* g; __device__ __forceinline__ float operator()(int k) const { return g[k]; } };

__device__ __forceinline__ void store_row_i8(unsigned char* row, float* sa, int lane, const f32x4 (&v)[4]) {
    float mx = 0.f;
#pragma unroll
    for (int j = 0; j < 4; ++j) mx = fmaxf(fmaxf(mx, fmaxf(fabsf(v[j][0]), fabsf(v[j][1]))), fmaxf(fabsf(v[j][2]), fabsf(v[j][3])));
#pragma unroll
    for (int o = 1; o < 64; o <<= 1) mx = fmaxf(mx, __shfl_xor(mx, o));
    mx = fmaxf(mx, 1e-20f); const float inv = 127.f / mx;
#pragma unroll
    for (int j = 0; j < 4; ++j) { const int q0 = (int)rintf(v[j][0] * inv), q1 = (int)rintf(v[j][1] * inv), q2 = (int)rintf(v[j][2] * inv), q3 = (int)rintf(v[j][3] * inv);
        *(unsigned*)(row + 4 * lane + 256 * j) = (unsigned)(q0 & 255) | ((unsigned)(q1 & 255) << 8) | ((unsigned)(q2 & 255) << 16) | ((unsigned)(q3 & 255) << 24); }
    if (lane == 0) *sa = mx * (1.f / 127.f);
}
__device__ __forceinline__ int t5_bucket(int n) {
    if (n < 16) return n;
    int l = 16 + (int)(__logf((float)n / 16.f) / 2.0794415f * 16.f);
    return l < 31 ? l : 31;
}

__device__ __forceinline__ void phase_prologue_even(const Frame& F, const Args& a) {
    LAS float* scr = (LAS float*)(F.lds + F.wave * 8704);
    unsigned char* ws = F.ws;
    bf16_t* W_IN = (bf16_t*)(ws + OFF_W_IN); bf16_t* W_Q2 = (bf16_t*)(ws + OFF_W_Q2); unsigned char* W_OUTE = ws + OFF_W_OUTE;
    unsigned char* W_F13 = ws + OFF_W_F13; unsigned char* W_F2 = ws + OFF_W_F2; bf16_t* CK1 = (bf16_t*)(ws + OFF_CK1); bf16_t* CV1 = (bf16_t*)(ws + OFF_CV1);
    constexpr int I_IN = 8 * ((EVEN_IN + 63) / 64);
    constexpr int I_QI = 2 * 16;
    constexpr int I_OB = 4 * 4;
    constexpr int I_F1 = DFF / 8, I_F2 = (DFF / 128) * 4;
    constexpr int I_CK = 16 * 1;
    constexpr int NIT = I_IN + I_QI + I_OB + 2 * I_F1 + I_F2 + 2 * I_CK;
    for (int it = F.gw; it < NIT; it += F.NGW) {
        int r = it;
        if (r < I_IN) { transpose_item(a.in[I_EWIN], 1024, EVEN_IN, W_IN, 1024, scr, r, F.lane, RowInE{}, KOne{}); continue; } r -= I_IN;
        if (r < I_QI) { transpose_item(a.in[I_EWQIDX], 256, 1024, W_Q2 + 1024 * 256, 256, scr, r, F.lane, RowId{}, KGain{a.in[I_EQN]}); continue; } r -= I_QI;
        if (r < I_OB) { transpose_item8(a.in[I_EWOUT] + 512 * 1024, 512, 1024, W_OUTE + 1024, 1536, r, F.lane, RowId{}, WOUT_SCALE); continue; } r -= I_OB;
#if FFN_F8
        if (r < I_F1) { transpose_item8(a.in[I_EF1], 1024, DFF, W_F13, 1024, r, F.lane, RowIlv{0}, WF13_SCALE); continue; } r -= I_F1;
        if (r < I_F1) { transpose_item8(a.in[I_EF3], 1024, DFF, W_F13, 1024, r, F.lane, RowIlv{128}, WF13_SCALE); continue; } r -= I_F1;
        if (r < I_F2) { transpose_item8(a.in[I_EF2], DFF, 1024, W_F2, DFF, r, F.lane, RowId{}, WF2_SCALE); continue; } r -= I_F2;
#else
        if (r < I_F1) { transpose_item_i8(a.in[I_EF1], 1024, DFF, W_F13, 1024, (float*)(ws + OFF_SW), r, F.lane, RowIlv{0}); continue; } r -= I_F1;
        if (r < I_F1) { transpose_item_i8(a.in[I_EF3], 1024, DFF, W_F13, 1024, (float*)(ws + OFF_SW), r, F.lane, RowIlv{128}); continue; } r -= I_F1;
        if (r < I_F2) { transpose_item8(a.in[I_EF2], DFF, 1024, W_F2, DFF, r, F.lane, RowId{}, WF2_SCALE); continue; } r -= I_F2;
#endif
        if (r < I_CK) { transpose_item(a.in[I_ECK1], 2048, 64, CK1, 2048, scr, r, F.lane, RowId{}, KOne{}); continue; } r -= I_CK;
        transpose_item(a.in[I_ECV1], 2048, 64, CV1, 2048, scr, r, F.lane, RowId{}, KOne{});
    }
    const int gt = F.bx * NTHR + F.tid, NGT = F.G * NTHR;
    for (int i = gt; i < 24 * 1024 / 8; i += NGT) ((u32x4*)(W_IN + 488 * 1024))[i] = (u32x4){0u, 0u, 0u, 0u};
    { const float* uq = a.in[I_EWUQ]; const float* uk = a.in[I_EWUK]; const float* qg = a.in[I_EQN];
      for (int o = gt; o < 1024 * 256; o += NGT) { const int r = o & 255, hc = o >> 8, h = hc >> 7, c = hc & 127; const float* p = uq + r * 512 + h * 64; const float* q = uk + c * 512 + h * 64; float s = 0.f;
#pragma unroll 8
          for (int d = 0; d < 64; ++d) s += p[d] * q[d];
          W_Q2[o] = (bf16_t)f2bf(s * qg[r]); } }
    { const float* uv = a.in[I_EWUV]; const float* wo = a.in[I_EWOUT];
      for (int o = gt; o < 1024 * 1024 / 16; o += NGT) { const int nb = o & 255, hc4 = o >> 8, h = hc4 >> 5, c0 = (hc4 & 31) * 4, n0 = nb * 4;
          const float* p = uv + (size_t)c0 * 512 + h * 64; const float* q = wo + (size_t)(h * 64) * 1024 + n0;
          f32x4 acc4[4] = {(f32x4){0.f, 0.f, 0.f, 0.f}, (f32x4){0.f, 0.f, 0.f, 0.f}, (f32x4){0.f, 0.f, 0.f, 0.f}, (f32x4){0.f, 0.f, 0.f, 0.f}};
#pragma unroll 4
          for (int d = 0; d < 64; ++d) { const f32x4 qv = *(const f32x4*)(q + (size_t)d * 1024);
#pragma unroll
              for (int cc = 0; cc < 4; ++cc) acc4[cc] += qv * p[cc * 512 + d]; }
#pragma unroll
          for (int cc = 0; cc < 4; ++cc)
#pragma unroll
              for (int e = 0; e < 4; ++e) W_OUTE[(size_t)(n0 + e) * 1536 + h * 128 + c0 + cc] = (unsigned char)(__builtin_amdgcn_cvt_pk_fp8_f32(acc4[cc][e] * WOUT_SCALE, 0.f, 0, false) & 0xff); } }
    if (F.bx == 0) { float* BT = (float*)(ws + OFF_BT); const float* rb = a.in[I_RELB];
        for (int i = F.tid; i < 16 * 128; i += NTHR) { const int h = i >> 7, d = i & 127; BT[i] = rb[t5_bucket(d) * 16 + h] * LOG2E; } }
    if (F.bx == 1 && F.tid < 128) { const int kv = F.tid >> 6, e = F.tid & 63; const float* pos = a.in[kv ? I_EPOSV : I_EPOSK]; const float* w1 = a.in[kv ? I_ECV1 : I_ECK1]; float s = 0.f;
        for (int k = 0; k < 2048; ++k) s += pos[k] * w1[k * 64 + e];
        ((float*)(ws + OFF_CB))[F.tid] = s; }
    { const f32x4* x4 = (const f32x4*)a.in[I_X]; u32x4* xb = (u32x4*)(ws + OFF_XB);
      for (int i = gt; i < MTOK * 1024 / 8; i += NGT) { const f32x4 v0 = x4[2 * i], v1 = x4[2 * i + 1]; xb[i] = pg8::pack8(v0, v1); } }
}

__device__ __forceinline__ void phase_convert_odd(const Frame& F, const Args& a) {
    LAS float* scr = (LAS float*)(F.lds + F.wave * 8704);
    unsigned char* ws = F.ws;
    unsigned char* W_OIN = ws + OFF_W_OIN; unsigned char* W_OOUT = ws + OFF_W_OOUT; unsigned char* W_M13 = ws + OFF_W_M13; unsigned char* W_M2 = ws + OFF_W_M2;
    constexpr int I_IN = 16 * 12, I_OUT = 16 * 4, I_M1 = 16 * (DFFE / 256), I_M2 = (DFFE / 64) * 4;
    constexpr int NIT = I_IN + I_OUT + NEXP * (2 * I_M1 + I_M2);
    for (int it = F.gw; it < NIT; it += F.NGW) {
        int r = it;
        if (r < I_IN) { transpose_item8<RowId, 64>(a.in[I_OWIN], 1024, 3072, W_OIN, 1024, r, F.lane, RowId{}, WIN_SCALE); continue; } r -= I_IN;
        if (r < I_OUT) { transpose_item8<RowId, 64>(a.in[I_OWOUT], 1024, 1024, W_OOUT, 1024, r, F.lane, RowId{}, WOUT_SCALE); continue; } r -= I_OUT;
        const int e = r / (2 * I_M1 + I_M2); r -= e * (2 * I_M1 + I_M2);
        if (r < I_M1) { transpose_item8<RowIlv, 64>(a.in[I_OM1] + (size_t)e * 1024 * DFFE, 1024, DFFE, W_M13 + (size_t)e * 2 * DFFE * 1024, 1024, r, F.lane, RowIlv{0}, W13_SCALE); continue; } r -= I_M1;
        if (r < I_M1) { transpose_item8<RowIlv, 64>(a.in[I_OM3] + (size_t)e * 1024 * DFFE, 1024, DFFE, W_M13 + (size_t)e * 2 * DFFE * 1024, 1024, r, F.lane, RowIlv{128}, W13_SCALE); continue; } r -= I_M1;
        transpose_item8<RowId, 64>(a.in[I_OM2] + (size_t)e * DFFE * 1024, DFFE, 1024, W_M2 + (size_t)e * 1024 * DFFE, DFFE, r, F.lane, RowId{}, W2_SCALE);
    }
}

__device__ __forceinline__ void load_row_bf16(const bf16_t* row, int lane, f32x4 (&v)[4]) {
#pragma unroll
    for (int j = 0; j < 4; ++j) { const u32x2 w = *(const u32x2*)(row + 4 * lane + 256 * j); v[j] = (f32x4){bflo(w.x), bfhi(w.x), bflo(w.y), bfhi(w.y)}; }
}
__device__ __forceinline__ void store_row_bf16(bf16_t* row, int lane, const f32x4 (&v)[4]) {
#pragma unroll
    for (int j = 0; j < 4; ++j) { u32x2 w; w.x = pk2(v[j][0], v[j][1]); w.y = pk2(v[j][2], v[j][3]); *(u32x2*)(row + 4 * lane + 256 * j) = w; }
}
__device__ __forceinline__ void ln_inplace(f32x4 (&v)[4], const f32x4 (&g)[4], const f32x4 (&b)[4]) {
    float s = 0.f;
#pragma unroll
    for (int j = 0; j < 4; ++j) s += (v[j][0] + v[j][1]) + (v[j][2] + v[j][3]);
    const float mean = wave_sum(s) * (1.f / 1024.f); float q = 0.f;
#pragma unroll
    for (int j = 0; j < 4; ++j) { v[j] = v[j] - mean; q += (v[j][0] * v[j][0] + v[j][1] * v[j][1]) + (v[j][2] * v[j][2] + v[j][3] * v[j][3]); }
    const float rstd = 1.f / sqrtf(wave_sum(q) * (1.f / 1024.f) + 1e-5f);
#pragma unroll
    for (int j = 0; j < 4; ++j) v[j] = v[j] * rstd * g[j] + b[j];
}
__device__ __forceinline__ void load_gb(const float* g, const float* b, int lane, f32x4 (&gv)[4], f32x4 (&bv)[4]) {
#pragma unroll
    for (int j = 0; j < 4; ++j) { gv[j] = *(const f32x4*)(g + 4 * lane + 256 * j); bv[j] = *(const f32x4*)(b + 4 * lane + 256 * j); }
}
__device__ __forceinline__ void store_row_fp8(unsigned char* row, int lane, const f32x4 (&v)[4]) {
#pragma unroll
    for (int j = 0; j < 4; ++j) *(unsigned*)(row + 4 * lane + 256 * j) = pg8::pk4_fp8(v[j][0], v[j][1], v[j][2], v[j][3]);
}
__device__ __forceinline__ void phase_ln_bf16(const Frame& F, const bf16_t* S, bf16_t* O, unsigned char* O8, const float* g, const float* b) {
    f32x4 gv[4], bv[4]; load_gb(g, b, F.lane, gv, bv);
    for (int row = F.gw; row < MTOK; row += F.NGW) { f32x4 v[4]; load_row_bf16(S + (size_t)row * 1024, F.lane, v); ln_inplace(v, gv, bv); store_row_bf16(O + (size_t)row * 1024, F.lane, v); store_row_fp8(O8 + (size_t)row * 1024, F.lane, v); }
}
__device__ __forceinline__ void phase_ln_i8(const Frame& F, const bf16_t* S, bf16_t* O, unsigned char* O8, float* sa, const float* g, const float* b) {
    f32x4 gv[4], bv[4]; load_gb(g, b, F.lane, gv, bv);
    for (int row = F.gw; row < MTOK; row += F.NGW) { f32x4 v[4]; load_row_bf16(S + (size_t)row * 1024, F.lane, v); ln_inplace(v, gv, bv); store_row_bf16(O + (size_t)row * 1024, F.lane, v); store_row_i8(O8 + (size_t)row * 1024, sa + row, F.lane, v); }
}
__device__ __forceinline__ void phase_ckvn(const Frame& F, const bf16_t* T1, const float* ssq_kv, const float* gain, bf16_t* CKVN) {
    const float g0 = gain[2 * F.lane], g1 = gain[2 * F.lane + 1];
    for (int row = F.gw; row < MTOK; row += F.NGW) {
        const unsigned w = *(const unsigned*)(T1 + (size_t)row * 256 + 2 * F.lane);
        const f32x4 sq = *(const f32x4*)(ssq_kv + (size_t)row * 4); const float r = __builtin_amdgcn_rsqf(((sq[0] + sq[1]) + (sq[2] + sq[3])) * (1.f / 128.f) + 1e-6f);
        *(unsigned*)(CKVN + (size_t)row * 128 + 2 * F.lane) = pk2(bflo(w) * r * g0, bfhi(w) * r * g1);
    }
}
__device__ __forceinline__ void phase_ln_router(const Frame& F, const bf16_t* S, bf16_t* H2, const float* g, const float* b, const float* router, unsigned char* ws) {
    LAS int* cnt = (LAS int*)(F.lds);
    if (F.tid < 8) cnt[F.tid] = 0;
    __syncthreads();
    f32x4 gv[4], bv[4]; load_gb(g, b, F.lane, gv, bv);
    u32x2* ROUTE = (u32x2*)(ws + OFF_ROUTE);
    f32x4 rw[16][2];
#pragma unroll
    for (int j = 0; j < 4; ++j)
#pragma unroll
        for (int e = 0; e < 4; ++e) { const float* rp = router + (size_t)(4 * F.lane + 256 * j + e) * 8; rw[4 * j + e][0] = *(const f32x4*)rp; rw[4 * j + e][1] = *(const f32x4*)(rp + 4); }
    const bool b0 = F.lane & 1, b1 = F.lane & 2, b2 = F.lane & 4;
    for (int row = F.gw; row < MTOK; row += F.NGW) {
        f32x4 v[4]; load_row_bf16(S + (size_t)row * 1024, F.lane, v); ln_inplace(v, gv, bv); store_row_bf16(H2 + (size_t)row * 1024, F.lane, v);
        float pl[8];
#pragma unroll
        for (int x = 0; x < 8; ++x) pl[x] = 0.f;
#pragma unroll
        for (int j = 0; j < 4; ++j)
#pragma unroll
            for (int e = 0; e < 4; ++e) { const f32x4 r0 = rw[4 * j + e][0], r1 = rw[4 * j + e][1]; const float hv = v[j][e];
                pl[0] += hv * r0[0]; pl[1] += hv * r0[1]; pl[2] += hv * r0[2]; pl[3] += hv * r0[3]; pl[4] += hv * r1[0]; pl[5] += hv * r1[1]; pl[6] += hv * r1[2]; pl[7] += hv * r1[3]; }
        float k4[4], k2[2], k1;
#pragma unroll
        for (int i = 0; i < 4; ++i) { const float send = b0 ? pl[i] : pl[i + 4]; k4[i] = (b0 ? pl[i + 4] : pl[i]) + __shfl_xor(send, 1); }
#pragma unroll
        for (int i = 0; i < 2; ++i) { const float send = b1 ? k4[i] : k4[i + 2]; k2[i] = (b1 ? k4[i + 2] : k4[i]) + __shfl_xor(send, 2); }
        { const float send = b2 ? k2[0] : k2[1]; k1 = (b2 ? k2[1] : k2[0]) + __shfl_xor(send, 4); }
        k1 += __shfl_xor(k1, 8); k1 += __shfl_xor(k1, 16); k1 += __shfl_xor(k1, 32);
        float lg[8];
#pragma unroll
        for (int x = 0; x < 8; ++x) lg[x] = __int_as_float(__builtin_amdgcn_readlane(__float_as_int(k1), (x >> 2) | (((x >> 1) & 1) << 1) | ((x & 1) << 2)));
        int e0 = 0; float l0 = lg[0];
#pragma unroll
        for (int x = 1; x < 8; ++x) if (lg[x] > l0) { l0 = lg[x]; e0 = x; }
        int e1 = -1; float l1 = -INFINITY;
#pragma unroll
        for (int x = 0; x < 8; ++x) if (x != e0 && lg[x] > l1) { l1 = lg[x]; e1 = x; }
        const float g0 = 1.f / (1.f + __expf(l1 - l0));
        if (F.lane == 0) { u32x2 r; r.x = (unsigned)e0 | ((unsigned)e1 << 8); r.y = __builtin_bit_cast(unsigned, g0); ROUTE[row] = r;
            __hip_atomic_fetch_add(cnt + e0, 1, __ATOMIC_RELAXED, __HIP_MEMORY_SCOPE_WORKGROUP); __hip_atomic_fetch_add(cnt + e1, 1, __ATOMIC_RELAXED, __HIP_MEMORY_SCOPE_WORKGROUP); }
    }
    __syncthreads();
    if (F.tid < 8) ((int*)(ws + OFF_WGCNT))[F.bx * 8 + F.tid] = cnt[F.tid];
    __syncthreads();
}
__device__ __forceinline__ void phase_moe_gather(const Frame& F, const bf16_t* H2, unsigned char* XR, unsigned char* ws) {
    LAS int* L = (LAS int*)(F.lds);
    const int* WGCNT = (const int*)(ws + OFF_WGCNT);
    { const int e = F.wave; int t = 0, p = 0;
#pragma unroll
      for (int k = 0; k < 4; ++k) { const int wg = F.lane + 64 * k; const int c = (wg < F.G) ? WGCNT[wg * 8 + e] : 0; t += c; p += (wg < F.bx) ? c : 0; }
      t = (int)wave_sum((float)t); p = (int)wave_sum((float)p);
      if (F.lane == 0) { L[e] = t; L[8 + e] = p; L[24 + e] = 0; } }
    __syncthreads();
    if (F.tid == 0) { int acc = 0;
        for (int e = 0; e < 8; ++e) { const int pad = (L[e] + 255) / 256 * 256; L[32 + e] = acc; L[16 + e] = acc + L[8 + e]; acc += pad; L[40 + e] = acc; }
        if (F.bx == 0) { int* GI = (int*)(ws + OFF_GINFO); for (int e = 0; e < 8; ++e) { GI[e] = L[40 + e]; GI[8 + e] = L[e]; } } }
    __syncthreads();
    const u32x2* ROUTE = (const u32x2*)(ws + OFF_ROUTE); int* DEST = (int*)(ws + OFF_DEST);
    for (int row = F.gw; row < MTOK; row += F.NGW) {
        const u32x2 r = ROUTE[row]; const int e0 = r.x & 255, e1 = (r.x >> 8) & 255; int s0 = 0, s1 = 0;
        if (F.lane == 0) { s0 = L[16 + e0] + __hip_atomic_fetch_add(L + 24 + e0, 1, __ATOMIC_RELAXED, __HIP_MEMORY_SCOPE_WORKGROUP); s1 = L[16 + e1] + __hip_atomic_fetch_add(L + 24 + e1, 1, __ATOMIC_RELAXED, __HIP_MEMORY_SCOPE_WORKGROUP);
            DEST[2 * row] = s0; DEST[2 * row + 1] = s1; }
        s0 = __builtin_amdgcn_readfirstlane(s0); s1 = __builtin_amdgcn_readfirstlane(s1);
        const u32x4* src = (const u32x4*)(H2 + (size_t)row * 1024) + 2 * F.lane; const u32x4 a = src[0], b = src[1];
        u32x4 o; o.x = pg8::pk4_fp8(bflo(a.x), bfhi(a.x), bflo(a.y), bfhi(a.y)); o.y = pg8::pk4_fp8(bflo(a.z), bfhi(a.z), bflo(a.w), bfhi(a.w));
        o.z = pg8::pk4_fp8(bflo(b.x), bfhi(b.x), bflo(b.y), bfhi(b.y)); o.w = pg8::pk4_fp8(bflo(b.z), bfhi(b.z), bflo(b.w), bfhi(b.w));
        ((u32x4*)(XR + (size_t)s0 * 1024))[F.lane] = o; ((u32x4*)(XR + (size_t)s1 * 1024))[F.lane] = o;
    }
    for (int e = 0; e < 8; ++e) { const int r0 = L[32 + e] + L[e], npad = L[40 + e] - r0;
        for (int i = F.gw; i < npad; i += F.NGW) { u32x4* d = (u32x4*)(XR + (size_t)(r0 + i) * 1024); d[F.lane] = (u32x4){0u, 0u, 0u, 0u}; } }
    __syncthreads();
}
__device__ __forceinline__ void phase_final(const Frame& F, const bf16_t* H2, const bf16_t* YR, const float* g, const float* b, float* out, unsigned char* ws) {
    f32x4 gv[4], bv[4]; load_gb(g, b, F.lane, gv, bv);
    const u32x2* ROUTE = (const u32x2*)(ws + OFF_ROUTE); const int* DEST = (const int*)(ws + OFF_DEST);
    for (int row = F.gw; row < MTOK; row += F.NGW) {
        const u32x2 rte = ROUTE[row]; const float g0 = __uint_as_float(rte.y), g1 = 1.f - g0;   const int d0 = DEST[2 * row], d1 = DEST[2 * row + 1];
        f32x4 v[4], y0[4], y1[4]; load_row_bf16(H2 + (size_t)row * 1024, F.lane, v); load_row_bf16(YR + (size_t)d0 * 1024, F.lane, y0); load_row_bf16(YR + (size_t)d1 * 1024, F.lane, y1);
#pragma unroll
        for (int j = 0; j < 4; ++j) v[j] = v[j] * ALPHA + y0[j] * g0 + y1[j] * g1;
        ln_inplace(v, gv, bv);
#pragma unroll
        for (int j = 0; j < 4; ++j) *(f32x4*)(out + (size_t)row * 1024 + 4 * F.lane + 256 * j) = v[j];
    }
}

namespace att {
constexpr float NEG_BIG = -1e30f;
constexpr int KS64 = 144, VS64 = 192, KT64 = 64 * KS64, VT64 = 64 * VS64;
constexpr int KS128 = 272, VS128 = 320, KT128 = 64 * KS128, VT128 = 64 * VS128;
typedef LAS char* lptr; typedef const LAS char* lcptr;
typedef short v4i16_t __attribute__((ext_vector_type(4)));
__device__ __forceinline__ s16x4 vtr(lcptr p) { return __builtin_bit_cast(s16x4, __builtin_amdgcn_ds_read_tr16_b64_v4i16((LAS v4i16_t*)p)); }
__device__ __forceinline__ f32x16 splat16(float c) { f32x16 v;
#pragma unroll
    for (int r = 0; r < 16; ++r) v[r] = c; return v; }
__device__ __forceinline__ int crow(int r, int hi) { return (r & 3) + 8 * (r >> 2) + 4 * hi; }
__device__ __forceinline__ float ex2(float x) { return __builtin_amdgcn_exp2f(x); }

template <int NKS> __device__ __forceinline__ void qk(f32x16& s0, f32x16& s1, lcptr Kt, int kstride, const bf16x8 (&qf)[NKS], float c0, int r32, int hi) {
    s0 = splat16(c0); s1 = splat16(c0);
    lcptr p0 = Kt + r32 * kstride + hi * 16; lcptr p1 = p0 + 32 * kstride;
#pragma unroll
    for (int ks = 0; ks < NKS; ++ks) { const bf16x8 k0 = *(const LAS bf16x8*)(p0 + ks * 32), k1 = *(const LAS bf16x8*)(p1 + ks * 32);
        s0 = __builtin_amdgcn_mfma_f32_32x32x16_bf16(k0, qf[ks], s0, 0, 0, 0); s1 = __builtin_amdgcn_mfma_f32_32x32x16_bf16(k1, qf[ks], s1, 0, 0, 0); }
}
__device__ __forceinline__ float rowmax32(const f32x16& s0, const f32x16& s1) {
    float a = fmaxf(s0[0], s1[0]);
#pragma unroll
    for (int r = 1; r < 16; ++r) a = fmaxf(a, fmaxf(s0[r], s1[r]));
    return fmaxf(a, __shfl_xor(a, 32));
}
template <int NDT> __device__ __forceinline__ void softmax_step(f32x16& s0, f32x16& s1, float& m, float& l, f32x16 (&o)[NDT]) {
    const float mn = fmaxf(m, rowmax32(s0, s1)); float rs = 0.f;
    if (__any(mn > m)) {
        const float al = ex2(m - mn); l *= al;
#pragma unroll
        for (int d = 0; d < NDT; ++d)
#pragma unroll
            for (int r = 0; r < 16; ++r) o[d][r] *= al;
    }
    m = mn;
#pragma unroll
    for (int r = 0; r < 16; ++r) { s0[r] = ex2(s0[r] - mn); s1[r] = ex2(s1[r] - mn); rs += s0[r] + s1[r]; }
    l += rs;
}
__device__ __forceinline__ bf16x8 pack_p(const f32x16& s, int base) { u32x4 w; w.x = pk2(s[base], s[base + 1]); w.y = pk2(s[base + 2], s[base + 3]); w.z = pk2(s[base + 4], s[base + 5]); w.w = pk2(s[base + 6], s[base + 7]); return __builtin_bit_cast(bf16x8, w); }
template <int NDT> __device__ __forceinline__ void pv(f32x16 (&o)[NDT], const f32x16& s0, const f32x16& s1, lcptr Vt, int vstride, int lane) {
    const bf16x8 pk[4] = {pack_p(s0, 0), pack_p(s0, 8), pack_p(s1, 0), pack_p(s1, 8)};
    const int h = lane >> 5, g = (lane >> 4) & 1, q = (lane & 15) >> 2, p = lane & 3;
    lcptr vb = Vt + (4 * h + q) * vstride + (16 * g + 4 * p) * 2;
#pragma unroll
    for (int k = 0; k < 4; ++k)
#pragma unroll
        for (int d = 0; d < NDT; ++d) { const s16x4 lo = vtr(vb + (16 * k) * vstride + d * 64), hh = vtr(vb + (16 * k + 8) * vstride + d * 64);
            const bf16x8 vf = (bf16x8){lo[0], lo[1], lo[2], lo[3], hh[0], hh[1], hh[2], hh[3]};
            o[d] = __builtin_amdgcn_mfma_f32_32x32x16_bf16(vf, pk[k], o[d], 0, 0, 0); }
}

__device__ __forceinline__ void exp_step(f32x16& s0, f32x16& s1, float& l) {
    float rs = 0.f;
#pragma unroll
    for (int r = 0; r < 16; ++r) { s0[r] = ex2(s0[r]); s1[r] = ex2(s1[r]); rs += s0[r] + s1[r]; }
    l += rs;
}

__device__ __forceinline__ void qk2(f32x16& a0, f32x16& a1, f32x16& b0, f32x16& b1, lcptr Kt, const bf16x8 (&qa)[4], const bf16x8 (&qb)[4], int r32, int hi) {
    a0 = splat16(0.f); a1 = splat16(0.f); b0 = splat16(0.f); b1 = splat16(0.f);
    lcptr p0 = Kt + r32 * KS64 + hi * 16; lcptr p1 = p0 + 32 * KS64;
#pragma unroll
    for (int ks = 0; ks < 4; ++ks) { const bf16x8 k0 = *(const LAS bf16x8*)(p0 + ks * 32), k1 = *(const LAS bf16x8*)(p1 + ks * 32);
        a0 = __builtin_amdgcn_mfma_f32_32x32x16_bf16(k0, qa[ks], a0, 0, 0, 0); b0 = __builtin_amdgcn_mfma_f32_32x32x16_bf16(k0, qb[ks], b0, 0, 0, 0);
        a1 = __builtin_amdgcn_mfma_f32_32x32x16_bf16(k1, qa[ks], a1, 0, 0, 0); b1 = __builtin_amdgcn_mfma_f32_32x32x16_bf16(k1, qb[ks], b1, 0, 0, 0); }
}
__device__ __forceinline__ void pv2(f32x16 (&oa)[2], f32x16 (&ob)[2], const bf16x8 (&pa)[4], const bf16x8 (&pb)[4], lcptr Vt, int lane) {
    const int h = lane >> 5, g = (lane >> 4) & 1, q = (lane & 15) >> 2, p = lane & 3;
    lcptr vb = Vt + (4 * h + q) * VS64 + (16 * g + 4 * p) * 2;
#pragma unroll
    for (int k = 0; k < 4; ++k)
#pragma unroll
        for (int d = 0; d < 2; ++d) { const s16x4 lo = vtr(vb + (16 * k) * VS64 + d * 64), hh = vtr(vb + (16 * k + 8) * VS64 + d * 64);
            const bf16x8 vf = (bf16x8){lo[0], lo[1], lo[2], lo[3], hh[0], hh[1], hh[2], hh[3]};
            oa[d] = __builtin_amdgcn_mfma_f32_32x32x16_bf16(vf, pa[k], oa[d], 0, 0, 0); ob[d] = __builtin_amdgcn_mfma_f32_32x32x16_bf16(vf, pb[k], ob[d], 0, 0, 0); }
}
__device__ __forceinline__ void bias_mask_near(f32x16& s0, f32x16& s1, const LAS float* bt, int t, int kp0, int hi, unsigned maxdist) {
#pragma unroll
    for (int q4 = 0; q4 < 4; ++q4) {
        float bb[8]; f32x16& s = (q4 & 2) ? s1 : s0; const int r0 = 8 * (q4 & 1), kq = kp0 + 32 * (q4 >> 1);
#pragma unroll
        for (int r = 0; r < 8; ++r) { const int d = t - (kq + crow(r0 + r, hi)); const unsigned ix = (unsigned)d < 127u ? (unsigned)d : 127u; bb[r] = bt[ix]; }
#pragma unroll
        for (int r = 0; r < 8; ++r) asm volatile("" : "+v"(bb[r]));
#pragma unroll
        for (int r = 0; r < 8; ++r) { const int d = t - (kq + crow(r0 + r, hi)); s[r0 + r] = ((unsigned)d < maxdist) ? s[r0 + r] + bb[r] : -INFINITY; }
    }
}
__device__ __forceinline__ void mask_all(f32x16& s0, f32x16& s1) {
#pragma unroll
    for (int r = 0; r < 16; ++r) { s0[r] = -INFINITY; s1[r] = -INFINITY; }
}
__device__ __forceinline__ void store_o64(bf16_t* orow, const f32x16 (&o)[2], float sc, int hi) {
#pragma unroll
    for (int d = 0; d < 2; ++d)
#pragma unroll
        for (int rg = 0; rg < 4; ++rg) { u32x2 w; w.x = pk2(o[d][4 * rg] * sc, o[d][4 * rg + 1] * sc); w.y = pk2(o[d][4 * rg + 2] * sc, o[d][4 * rg + 3] * sc);
            *(u32x2*)(orow + 32 * d + 8 * rg + 4 * hi) = w; }
}
__device__ __forceinline__ void store_o64_fp8(unsigned char* orow, const f32x16 (&o)[2], float sc, int hi) {
#pragma unroll
    for (int d = 0; d < 2; ++d)
#pragma unroll
        for (int rg = 0; rg < 4; ++rg) *(unsigned*)(orow + 32 * d + 8 * rg + 4 * hi) = pg8::pk4_fp8(o[d][4 * rg] * sc, o[d][4 * rg + 1] * sc, o[d][4 * rg + 2] * sc, o[d][4 * rg + 3] * sc);
}
template <class Src, class Proc> __device__ __forceinline__ void tile_loop64(int tid, lptr base, int nt, int pitch, Src src, Proc proc) {
    if (nt <= 0) return;
    const int row = tid >> 3, ch = tid & 7; u32x4 kr, vr;
    lptr Kb = base, Vb = base + 2 * KT64;
    { const bf16_t *kp, *vp; src(0, kp, vp); kr = *(const u32x4*)(kp + (size_t)row * pitch + ch * 8); vr = *(const u32x4*)(vp + (size_t)row * pitch + ch * 8); }
    *(LAS u32x4*)(Kb + row * KS64 + ch * 16) = kr; *(LAS u32x4*)(Vb + row * VS64 + ch * 16) = vr;
    __syncthreads();
    for (int i = 0; i < nt; ++i) {
        const bool more = i + 1 < nt;
        if (more) { const bf16_t *kp, *vp; src(i + 1, kp, vp); kr = *(const u32x4*)(kp + (size_t)row * pitch + ch * 8); vr = *(const u32x4*)(vp + (size_t)row * pitch + ch * 8); }
        proc(i, (lcptr)(Kb + (i & 1) * KT64), (lcptr)(Vb + (i & 1) * VT64));
        if (more) { *(LAS u32x4*)(Kb + ((i + 1) & 1) * KT64 + row * KS64 + ch * 16) = kr; *(LAS u32x4*)(Vb + ((i + 1) & 1) * VT64 + row * VS64 + ch * 16) = vr; }
        __syncthreads();
    }
}

template <int ROWB, int KSTR, int VSTR, int VAR = 0, class SrcK, class SrcV, class Score, class Accum>
__device__ __forceinline__ void tile_loop_p(int tid, lptr base, int nt, int pitch, SrcK srck, SrcV srcv, Score score, Accum accum) {
    if (nt <= 0) return;
    constexpr int CPR = ROWB / 16, NCH = (64 * CPR) / 512, KT = 64 * KSTR, VT = 64 * VSTR;
    lptr Kb = base, Vb = base + 2 * KT;
    u32x4 kr0[NCH], vr0[NCH], kr1[NCH], vr1[NCH];
    auto gld = [&](const bf16_t* p, u32x4 (&r)[NCH]) {
#pragma unroll
        for (int c = 0; c < NCH; ++c) { const int idx = tid + 512 * c, rr = idx / CPR, ch = idx % CPR; r[c] = *(const u32x4*)(p + (size_t)rr * pitch + ch * 8); } };
    auto lst = [&](lptr dst, int stride, const u32x4 (&r)[NCH]) {
#pragma unroll
        for (int c = 0; c < NCH; ++c) { const int idx = tid + 512 * c, rr = idx / CPR, ch = idx % CPR; *(LAS u32x4*)(dst + rr * stride + ch * 16) = r[c]; } };
    gld(srck(0), kr0); gld(srcv(0), vr0); lst(Kb, KSTR, kr0); lst(Vb, VSTR, vr0);
    if (nt > 1) { gld(srck(1), kr0); lst(Kb + KT, KSTR, kr0); }
    if (nt > 2) gld(srck(2), kr1);
    if (nt > 1) gld(srcv(1), vr1);
    __syncthreads();
    f32x16 a0, a1, b0, b1; bool aact = score(0, (lcptr)Kb, a0, a1), bact = false;
    auto step = [&](int i, f32x16& c0, f32x16& c1, bool& cact, f32x16& n0, f32x16& n1, bool& nact, u32x4 (&kL)[NCH], u32x4 (&vL)[NCH], u32x4 (&kS)[NCH], u32x4 (&vS)[NCH]) {
        const bool m1 = i + 1 < nt, m2 = i + 2 < nt, m3 = i + 3 < nt;
        if (VAR != 7) { if (m3) gld(srck(i + 3), kL);
        if (m2) gld(srcv(i + 2), vL); }
        nact = false;
        if (m1) nact = score(i + 1, (lcptr)(Kb + ((i + 1) & 1) * KT), n0, n1);
        if (cact) accum(i, (lcptr)(Vb + (i & 1) * VT), c0, c1);
        if (VAR != 7) { if (m2) lst(Kb + (i & 1) * KT, KSTR, kS);
        if (m1) lst(Vb + ((i + 1) & 1) * VT, VSTR, vS); }
        __syncthreads();
    };
    for (int i = 0; i < nt; i += 2) { step(i, a0, a1, aact, b0, b1, bact, kr0, vr0, kr1, vr1); if (i + 1 < nt) step(i + 1, b0, b1, bact, a0, a1, aact, kr1, vr1, kr0, vr0); }
}

template <int ROWB, int KSTR, int VSTR, class SrcK, class SrcV, class Score, class Accum>
__device__ __forceinline__ void tile_loop_pp(int tid, int grp, lptr base, int nt, int pitch, SrcK srck, SrcV srcv, Score score, Accum accum) {
    if (nt <= 0) return;
    constexpr int CPR = ROWB / 16, NCH = (64 * CPR) / 512, KT = 64 * KSTR, VT = 64 * VSTR;
    lptr Kb = base, Vb = base + 2 * KT;
    u32x4 kr0[NCH], vr0[NCH], kr1[NCH], vr1[NCH];
    auto gld = [&](const bf16_t* p, u32x4 (&r)[NCH]) {
#pragma unroll
        for (int c = 0; c < NCH; ++c) { const int idx = tid + 512 * c, rr = idx / CPR, ch = idx % CPR; r[c] = *(const u32x4*)(p + (size_t)rr * pitch + ch * 8); } };
    auto lst = [&](lptr dst, int stride, const u32x4 (&r)[NCH]) {
#pragma unroll
        for (int c = 0; c < NCH; ++c) { const int idx = tid + 512 * c, rr = idx / CPR, ch = idx % CPR; *(LAS u32x4*)(dst + rr * stride + ch * 16) = r[c]; } };
    gld(srck(0), kr0); gld(srcv(0), vr0); lst(Kb, KSTR, kr0); lst(Vb, VSTR, vr0);
    if (nt > 1) { gld(srck(1), kr0); gld(srcv(1), vr0); }
    if (nt > 2) { gld(srck(2), kr1); gld(srcv(2), vr1); }
    __syncthreads();
    f32x16 s0, s1; bool act = false;
    const int nslot = 2 * nt + 1;
    auto slot_fn = [&](int slot, u32x4 (&kS)[NCH], u32x4 (&vS)[NCH]) {
        const int my = slot - grp;
        if (my >= 0 && my < 2 * nt) { const int i = my >> 1;
            if (!(my & 1)) act = score(i, (lcptr)(Kb + (i & 1) * KT), s0, s1);
            else if (act) accum(i, (lcptr)(Vb + (i & 1) * VT), s0, s1); }
        if (slot & 1) { const int j = (slot >> 1) + 1;
            if (j < nt) { lst(Kb + (j & 1) * KT, KSTR, kS); lst(Vb + (j & 1) * VT, VSTR, vS); }
            if (j + 2 < nt) { gld(srck(j + 2), kS); gld(srcv(j + 2), vS); } }
        __syncthreads();
    };
    for (int slot = 0; slot < nslot; slot += 4) {
        slot_fn(slot, kr0, vr0);
        if (slot + 1 < nslot) slot_fn(slot + 1, kr0, vr0);
        if (slot + 2 < nslot) slot_fn(slot + 2, kr1, vr1);
        if (slot + 3 < nslot) slot_fn(slot + 3, kr1, vr1);
    }
}

template <int VAR = 0, class SrcK, class SrcV, class Post>
__device__ __forceinline__ void tile_loop_f(int tid, int lane, lptr base, int nt, int pitch, const bf16x8 (&qf)[4], f32x16 (&o)[2], float& l, SrcK srck, SrcV srcv, Post post) {
    if (nt <= 0) return;
    const int r32 = lane & 31, hi = lane >> 5;
    lptr Kb = base, Vb = base + 2 * KT64;
    const int rr = tid >> 3, ch = tid & 7;
    u32x4 kr0, vr0, kr1, vr1;
    auto gld = [&](const bf16_t* p) { return *(const u32x4*)(p + (size_t)rr * pitch + ch * 8); };
    kr0 = gld(srck(0)); vr0 = gld(srcv(0)); *(LAS u32x4*)(Kb + rr * KS64 + ch * 16) = kr0; *(LAS u32x4*)(Vb + rr * VS64 + ch * 16) = vr0;
    if (nt > 1) { kr0 = gld(srck(1)); *(LAS u32x4*)(Kb + KT64 + rr * KS64 + ch * 16) = kr0; }
    if (nt > 2) kr1 = gld(srck(2));
    if (nt > 1) vr1 = gld(srcv(1));
    __syncthreads();
    f32x16 a0, a1, b0, b1; bool aact, bact = false;
    qk<4>(a0, a1, (lcptr)Kb, KS64, qf, 0.f, r32, hi); aact = post(0, a0, a1);
    auto step = [&](int i, f32x16& c0, f32x16& c1, bool& cact, f32x16& n0, f32x16& n1, bool& nact, u32x4& kL, u32x4& vL, u32x4& kS, u32x4& vS) {
        const bool m1 = i + 1 < nt, m2 = i + 2 < nt, m3 = i + 3 < nt;
        if (m3) kL = gld(srck(i + 3));
        if (m2) vL = gld(srcv(i + 2));
        lcptr Kt = (lcptr)(Kb + ((i + 1) & 1) * KT64), Vt = (lcptr)(Vb + (i & 1) * VT64);
        if (m1 && cact) {
            lcptr p0 = Kt + r32 * KS64 + hi * 16; lcptr p1 = p0 + 32 * KS64;
            bf16x8 ka[4], kb[4];
#pragma unroll
            for (int ks = 0; ks < 4; ++ks) { if (VAR == 8 || VAR == 9) { ka[ks] = qf[ks]; kb[ks] = qf[3 - ks]; } else { ka[ks] = *(const LAS bf16x8*)(p0 + ks * 32); kb[ks] = *(const LAS bf16x8*)(p1 + ks * 32); } }
            n0 = splat16(0.f); n1 = splat16(0.f); float rs = 0.f;
            __builtin_amdgcn_sched_barrier(0);
#pragma unroll
            for (int ks = 0; ks < 4; ++ks) {
                n0 = __builtin_amdgcn_mfma_f32_32x32x16_bf16(ka[ks], qf[ks], n0, 0, 0, 0); n1 = __builtin_amdgcn_mfma_f32_32x32x16_bf16(kb[ks], qf[ks], n1, 0, 0, 0);
#pragma unroll
                for (int e = 0; e < 4; ++e) { c0[4 * ks + e] = ex2(c0[4 * ks + e]); c1[4 * ks + e] = ex2(c1[4 * ks + e]); rs += c0[4 * ks + e] + c1[4 * ks + e]; }
                __builtin_amdgcn_sched_barrier(0);
            }
            l += rs;
            if (VAR == 8 || VAR == 10) { const bf16x8 pk0 = pack_p(c0, 0), pk1 = pack_p(c0, 8), pk2_ = pack_p(c1, 0), pk3 = pack_p(c1, 8);
#pragma unroll
                for (int d = 0; d < 2; ++d) { o[d] = __builtin_amdgcn_mfma_f32_32x32x16_bf16(qf[0], pk0, o[d], 0, 0, 0); o[d] = __builtin_amdgcn_mfma_f32_32x32x16_bf16(qf[1], pk1, o[d], 0, 0, 0);
                    o[d] = __builtin_amdgcn_mfma_f32_32x32x16_bf16(qf[2], pk2_, o[d], 0, 0, 0); o[d] = __builtin_amdgcn_mfma_f32_32x32x16_bf16(qf[3], pk3, o[d], 0, 0, 0); } }
            else pv<2>(o, c0, c1, Vt, VS64, lane);
            nact = post(i + 1, n0, n1);
        } else {
            if (cact) { exp_step(c0, c1, l); pv<2>(o, c0, c1, Vt, VS64, lane); }
            nact = false;
            if (m1) { qk<4>(n0, n1, Kt, KS64, qf, 0.f, r32, hi); nact = post(i + 1, n0, n1); }
        }
        if (m2) *(LAS u32x4*)(Kb + (i & 1) * KT64 + rr * KS64 + ch * 16) = kS;
        if (m1) *(LAS u32x4*)(Vb + ((i + 1) & 1) * VT64 + rr * VS64 + ch * 16) = vS;
        __syncthreads();
    };
    for (int i = 0; i < nt; i += 2) { step(i, a0, a1, aact, b0, b1, bact, kr0, vr0, kr1, vr1); if (i + 1 < nt) step(i + 1, b0, b1, bact, a0, a1, aact, kr1, vr1, kr0, vr0); }
}
constexpr int TL64_BYTES = 2 * KT64 + 2 * VT64;
}

#ifndef PP_GRP
#define PP_GRP (w & 1)
#endif
template <int var> __device__ __forceinline__ void moba_unit(const Frame& F, int b, int h, int qb, const bf16_t* Q, const bf16_t* K, const bf16_t* V, const float* KMEAN, const float* BT, unsigned char* O8) {
    using namespace att;
    const int lane = F.lane, r32 = lane & 31, hi = lane >> 5, w = F.wave;
    lptr lds = (lptr)F.lds; lptr tl = lds; LAS float* BTL = (LAS float*)(lds + TL64_BYTES); lptr KM = lds + TL64_BYTES + 512;
    const int t = 256 * qb + 32 * w + r32; const size_t row = (size_t)b * SEQ + t;
    bf16x8 qf[4];
#pragma unroll
    for (int ks = 0; ks < 4; ++ks) qf[ks] = *(const bf16x8*)(Q + row * 1024 + h * 64 + 16 * ks + 8 * hi);
    if (F.tid < 128) BTL[F.tid] = BT[h * 128 + F.tid] - BT[h * 128 + 127];
    { const int idx = F.tid * 2, j = idx >> 6, d = idx & 63; const float* kmp = KMEAN + (size_t)(b * 16 + j) * 2048 + h * 64 + d;
      *(LAS unsigned*)(KM + j * KS64 + d * 2) = (j < qb) ? pk2(kmp[0] + kmp[1024], kmp[1] + kmp[1025]) : 0u;
      *(LAS unsigned*)(KM + (16 + j) * KS64 + d * 2) = 0u; }
    __syncthreads();
    unsigned selmask = 0u;
    if (qb > 0) {
        f32x16 gs = splat16(0.f);
        { lcptr p0 = (lcptr)KM + r32 * KS64 + hi * 16;
#pragma unroll
          for (int ks = 0; ks < 4; ++ks) { const bf16x8 k0 = *(const LAS bf16x8*)(p0 + ks * 32); gs = __builtin_amdgcn_mfma_f32_32x32x16_bf16(k0, qf[ks], gs, 0, 0, 0); } }
        float glo[8], ghi[8];
#pragma unroll
        for (int r = 0; r < 8; ++r) { const float mine = gs[r], oth = __shfl_xor(mine, 32); glo[r] = hi ? oth : mine; ghi[r] = hi ? mine : oth; }
#pragma unroll
        for (int rep = 0; rep < 3; ++rep) { float best = -INFINITY; int bj = -1;
#pragma unroll
            for (int j = 0; j < 16; ++j) { const int r = (j & 3) + 4 * (j >> 3); const float gv = ((j >> 2) & 1) ? ghi[r] : glo[r];
                if (j < qb && !((selmask >> j) & 1u) && gv > best) { best = gv; bj = j; } }
            if (bj >= 0) selmask |= 1u << bj; }
    }
    f32x16 o[2] = {splat16(0.f), splat16(0.f)}; float l = 0.f;
    const int nt = 4 * (qb + 1); const int twmax = 256 * qb + 32 * w + 31;
    const bf16_t* Kh = K + (size_t)b * SEQ * 1024 + h * 64; const bf16_t* Vh = V + (size_t)b * SEQ * 1024 + h * 64;
    tile_loop_f<var>(F.tid, lane, tl, nt, 1024, qf, o, l,
        [&](int i) { return Kh + (size_t)(64 * i) * 1024; }, [&](int i) { return Vh + (size_t)(64 * i) * 1024; },
        [&](int i, f32x16& s0, f32x16& s1) -> bool {
            const int blk = i >> 2, kp0 = 64 * i;
            if (blk < qb) {
                const bool sel = (selmask >> blk) & 1u;
                if (!__any(sel)) return false;
                if (!(blk < qb - 1 || (i & 3) < 2)) bias_mask_near(s0, s1, BTL, t, kp0, hi, 0x7fffffffu);
                if (!sel) mask_all(s0, s1);
            } else {
                if (kp0 > twmax) return false;
                bias_mask_near(s0, s1, BTL, t, kp0, hi, 0x7fffffffu);
            }
            return true; });
    l += __shfl_xor(l, 32);
    store_o64_fp8(O8 + row * 1024 + h * 64, o, l > 0.f ? OSC / l : 0.f, hi);
}
__device__ __forceinline__ void phase_moba(const Frame& F, unsigned char* ws, int var) {
    const bf16_t* Q = (const bf16_t*)(ws + OFF_QKV); const bf16_t* K = Q + (size_t)MTOK * 1024; const bf16_t* V = K + (size_t)MTOK * 1024;
    const float* KMEAN = (const float*)(ws + OFF_KMEAN); const float* BT = (const float*)(ws + OFF_BT);
    for (int idx = F.bx; idx < 2048; idx += F.G) { const int i = idx >> 8, v = idx & 255, x = v & 7, j = v >> 3, bh = 16 * x + 2 * i + (j >> 4), b = bh >> 4, h = bh & 15, p = ((j & 15) + 4 * (i >> 1)) & 15, qb = (i & 1) ? 15 - p : p;

#ifdef MOBA_VAR
        if (var == MOBA_VAR) moba_unit<MOBA_VAR>(F, b, h, qb, Q, K, V, KMEAN, BT, ws + OFF_O8); else
#endif
        moba_unit<0>(F, b, h, qb, Q, K, V, KMEAN, BT, ws + OFF_O8);
        __syncthreads(); }
}

constexpr int MB_KB = 0, MB_VB = 256 * att::KS64, MB_SELM = MB_VB + 256 * att::VS64, MB_LIST = MB_SELM + 4096, MB_CNT = MB_LIST + 12800, MB_FILL = MB_CNT + 64, MB_LOFF = MB_FILL + 64,
              MB_BTL = MB_LOFF + 128, MB_KM = MB_BTL + 512, MB_QC = MB_KM + 32 * att::KS64, MB_END = MB_QC + 64;
constexpr int MST_ROW = 136;
__device__ __forceinline__ void moba2_unit(const Frame& F, int b, int h, int par, int unit, const bf16_t* Q, const bf16_t* K, const bf16_t* V, const float* KMEAN, const float* BT, unsigned char* O8, unsigned char* MST, int abl = 0) {
    using namespace att;
    int tid = F.tid; asm volatile("" : "+v"(tid));
    const int lane = tid & 63, lane_ = lane, r32 = lane & 31, hi = lane >> 5, w = F.wave;
    lptr lds = (lptr)F.lds; lptr KB = lds + MB_KB, VB = lds + MB_VB; LAS unsigned short* SELM = (LAS unsigned short*)(lds + MB_SELM); LAS unsigned short* LIST = (LAS unsigned short*)(lds + MB_LIST);
    LAS int* CNT = (LAS int*)(lds + MB_CNT); LAS int* FILL = (LAS int*)(lds + MB_FILL); LAS int* LOFF = (LAS int*)(lds + MB_LOFF); LAS float* BTL = (LAS float*)(lds + MB_BTL); lptr KM = lds + MB_KM;
    unsigned char* ST = MST + (size_t)unit * 2048 * MST_ROW; float* STL = (float*)(ST + 2048 * 128);
    const bf16_t* Qh = Q + (size_t)b * SEQ * 1024 + h * 64; const bf16_t* Kh = K + (size_t)b * SEQ * 1024 + h * 64; const bf16_t* Vh = V + (size_t)b * SEQ * 1024 + h * 64;
    if (tid < 128) BTL[tid] = BT[h * 128 + tid] - BT[h * 128 + 127];
    { const int idx = tid * 2, j = idx >> 6, d = idx & 63; const float* kmp = KMEAN + (size_t)(b * 16 + j) * 2048 + h * 64 + d;
      *(LAS unsigned*)(KM + j * KS64 + d * 2) = pk2(kmp[0] + kmp[1024], kmp[1] + kmp[1025]); *(LAS unsigned*)(KM + (16 + j) * KS64 + d * 2) = 0u; }
    LAS int* QC = (LAS int*)(lds + MB_QC);
    if (tid < 16) { CNT[tid] = 0; FILL[tid] = 0; QC[tid] = 0; }
    for (int i = tid; i < 2048 * MST_ROW / 16; i += NTHR) ((u32x4*)ST)[i] = (u32x4){0u, 0u, 0u, 0u};
    __syncthreads();
#pragma unroll 1
    for (int m8 = 0; m8 < 8; ++m8) { const int gi = w + 8 * m8, k = gi >> 3, sub = gi & 7, qb = 2 * k + par, q = 32 * sub + r32; const size_t trow = (size_t)(256 * qb + q);
        unsigned selmask = 0u;
        if (qb > 0) {
            bf16x8 qf[4];
#pragma unroll
            for (int ks = 0; ks < 4; ++ks) qf[ks] = *(const bf16x8*)(Qh + trow * 1024 + 16 * ks + 8 * hi);
            f32x16 gs = splat16(0.f);
            { lcptr p0 = (lcptr)KM + r32 * KS64 + hi * 16;
#pragma unroll
              for (int ks = 0; ks < 4; ++ks) { const bf16x8 k0 = *(const LAS bf16x8*)(p0 + ks * 32); gs = __builtin_amdgcn_mfma_f32_32x32x16_bf16(k0, qf[ks], gs, 0, 0, 0); } }
            float glo[8], ghi[8];
#pragma unroll
            for (int r = 0; r < 8; ++r) { const float mine = gs[r], oth = __shfl_xor(mine, 32); glo[r] = hi ? oth : mine; ghi[r] = hi ? mine : oth; }
#pragma unroll
            for (int rep = 0; rep < 3; ++rep) { float best = -INFINITY; int bj = -1;
#pragma unroll
                for (int j = 0; j < 16; ++j) { const int r = (j & 3) + 4 * (j >> 3); const float gv = ((j >> 2) & 1) ? ghi[r] : glo[r];
                    if (j < qb && !((selmask >> j) & 1u) && gv > best) { best = gv; bj = j; } }
                if (bj >= 0) selmask |= 1u << bj; }
        }
        if (hi == 0) { SELM[k * 256 + q] = (unsigned short)selmask; unsigned mm = selmask; while (mm) { const int j = __builtin_ctz(mm); mm &= mm - 1u; __hip_atomic_fetch_add(CNT + j, 1, __ATOMIC_RELAXED, __HIP_MEMORY_SCOPE_WORKGROUP); } }
    }
    __syncthreads();
    if (tid == 0) { int acc = 0; for (int j = 0; j < 16; ++j) { LOFF[j] = acc; acc += CNT[j]; } LOFF[16] = acc; }
    __syncthreads();
    for (int lq = tid; lq < 2048; lq += NTHR) { unsigned mm = SELM[lq]; while (mm) { const int j = __builtin_ctz(mm); mm &= mm - 1u; const int pos = __hip_atomic_fetch_add(FILL + j, 1, __ATOMIC_RELAXED, __HIP_MEMORY_SCOPE_WORKGROUP); LIST[LOFF[j] + pos] = (unsigned short)lq; } }
#ifdef REP_PHASE
    if (abl == 2) return;
#endif
    u32x4 kreg[4], vreg[4];
    auto gblk = [&](int j) { int td = tid; asm volatile("" : "+v"(td));
#pragma unroll
        for (int i = 0; i < 4; ++i) { const int c = td + 512 * i, rr = c >> 3, ch = c & 7; kreg[i] = *(const u32x4*)(Kh + (size_t)(256 * j + rr) * 1024 + ch * 8); vreg[i] = *(const u32x4*)(Vh + (size_t)(256 * j + rr) * 1024 + ch * 8); } };
    gblk(0);
    __syncthreads();
    for (int j = 0; j < 16; ++j) {
        { int td = tid; asm volatile("" : "+v"(td));
#pragma unroll
        for (int i = 0; i < 4; ++i) { const int c = td + 512 * i, rr = c >> 3, ch = c & 7; *(LAS u32x4*)(KB + rr * KS64 + ch * 16) = kreg[i]; *(LAS u32x4*)(VB + rr * VS64 + ch * 16) = vreg[i]; } }
        __syncthreads();
        gblk(j + 1 < 16 ? j + 1 : 15);
        const int nj = CNT[j], ngp = (nj + 31) >> 5, ngo = ((j & 1) == par) ? 8 : 0;
        const int nit = ngo + ngp;
        auto grab = [&]() { int it = 0; if (lane == 0) it = __hip_atomic_fetch_add(QC + j, 1, __ATOMIC_RELAXED, __HIP_MEMORY_SCOPE_WORKGROUP); return __builtin_amdgcn_readfirstlane(it); };
        auto decode = [&](int it, int& t, int& lq, bool& va) {
            if (it < ngo) { const int gidx = ngo - 1 - it; lq = (j >> 1) * 256 + 32 * gidx + r32; t = 256 * j + 32 * gidx + r32; va = true; }
            else { const int gidx = it - ngo, sa = 32 * gidx + r32; va = sa < nj; lq = LIST[LOFF[j] + (va ? sa : 32 * gidx)]; t = 256 * (2 * (lq >> 8) + par) + (lq & 255); } };
        auto issue = [&](int t, int lq, bf16x8 (&q)[4], u32x4 (&st)[4], float& stl) {
#pragma unroll
            for (int ks = 0; ks < 4; ++ks) q[ks] = *(const bf16x8*)(Qh + (size_t)t * 1024 + 16 * ks + 8 * hi);
            const unsigned char* strow = ST + (size_t)lq * 128 + 64 * hi;
#pragma unroll
            for (int k = 0; k < 4; ++k) st[k] = *(const u32x4*)(strow + 16 * k);
            stl = STL[lq]; };
        int it = grab(), t = 0, lq = 0; bool va = false; bf16x8 qc[4] = {}; u32x4 stc[4] = {}; float stlc = 0.f;
        if (it < nit) { decode(it, t, lq, va); issue(t, lq, qc, stc, stlc); }
        while (it < nit) {
            const int itn = grab(); int tn = 0, lqn = 0; bool van = false; bf16x8 qn[4] = {}; u32x4 stn[4] = {}; float stln = 0.f;
            if (itn < nit) { decode(itn, tn, lqn, van); issue(tn, lqn, qn, stn, stln); }
            const bool own = it < ngo; int ntile = own ? ((32 * (ngo - 1 - it) + 31) >> 6) + 1 : 4;
#ifdef REP_PHASE
            if (abl == 1) ntile = 0;
#endif
            const bool nearany = own || __any((t >> 8) == j + 1);
            f32x16 o[2] = {splat16(0.f), splat16(0.f)}; float l = 0.f;
            for (int i = 0; i < ntile; ++i) { f32x16 s0, s1;
                qk<4>(s0, s1, (lcptr)(KB + i * KT64), KS64, qc, 0.f, r32, hi);
                if (nearany && (own || i >= 2)) bias_mask_near(s0, s1, BTL, t, 256 * j + 64 * i, hi, 0x7fffffffu);
                exp_step(s0, s1, l); pv<2>(o, s0, s1, (lcptr)(VB + i * VT64), VS64, lane); }
            l += __shfl_xor(l, 32);
            if (own) {
                const float lt = l + stlc; const float f = lt > 0.f ? OSC / lt : 0.f;
                unsigned char* orow = O8 + ((size_t)b * SEQ + t) * 1024 + h * 64;
#pragma unroll
                for (int d = 0; d < 2; ++d)
#pragma unroll
                    for (int rg = 0; rg < 4; ++rg) { const unsigned w0 = stc[2 * d + (rg >> 1)][(rg & 1) * 2], w1 = stc[2 * d + (rg >> 1)][(rg & 1) * 2 + 1];
                        *(unsigned*)(orow + 32 * d + 8 * rg + 4 * hi) = pg8::pk4_fp8((o[d][4 * rg] + bflo(w0)) * f, (o[d][4 * rg + 1] + bfhi(w0)) * f, (o[d][4 * rg + 2] + bflo(w1)) * f, (o[d][4 * rg + 3] + bfhi(w1)) * f); }
            } else if (va) {
                unsigned char* strow = ST + (size_t)lq * 128 + 64 * hi;
#pragma unroll
                for (int k = 0; k < 4; ++k) { const int d = k >> 1, rg0 = (k & 1) * 2; u32x4 nv;
#pragma unroll
                    for (int c = 0; c < 4; ++c) { const int rg = rg0 + (c >> 1), e = (c & 1) * 2; const unsigned wv = stc[k][c]; nv[c] = pk2(o[d][4 * rg + e] + bflo(wv), o[d][4 * rg + e + 1] + bfhi(wv)); }
                    *(u32x4*)(strow + 16 * k) = nv; }
                if (hi == 0) STL[lq] = stlc + l;
            }
            it = itn; t = tn; lq = lqn; va = van; stlc = stln;
#pragma unroll
            for (int k = 0; k < 4; ++k) qc[k] = qn[k];
#pragma unroll
            for (int k = 0; k < 4; ++k) stc[k] = stn[k];
        }
        __syncthreads();
    }
}
__device__ __forceinline__ void phase_moba2(const Frame& F, unsigned char* ws, int abl = 0) {
    const bf16_t* Q = (const bf16_t*)(ws + OFF_QKV); const bf16_t* K = Q + (size_t)MTOK * 1024; const bf16_t* V = K + (size_t)MTOK * 1024;
    const float* KMEAN = (const float*)(ws + OFF_KMEAN); const float* BT = (const float*)(ws + OFF_BT);
    for (int v = F.bx; v < 256; v += F.G) { const int x = v & 7, jj = v >> 3, pair = 16 * x + (jj >> 1), par = jj & 1;
        moba2_unit(F, pair >> 4, pair & 15, par, v, Q, K, V, KMEAN, BT, ws + OFF_O8, ws + OFF_MST, abl); __syncthreads(); }
}

__device__ __forceinline__ void nsa_unit(const Frame& F, int b, int g, int c, const bf16_t* Y1, const bf16_t* KC, const bf16_t* VC, const float* BT, unsigned char* MIXIN) {
    using namespace att;
    const int lane = F.lane, r32 = lane & 31, hi = lane >> 5, w = F.wave;
    lptr lds = (lptr)F.lds; lptr tl = lds; LAS float* BTL = (LAS float*)(lds + TL64_BYTES);
    LAS float* SCB = (LAS float*)(lds + TL64_BYTES + 2048);
    LAS unsigned long long* SELM = (LAS unsigned long long*)(lds + TL64_BYTES + 2048 + 16384);
    lptr OFL = lds + TL64_BYTES + 2048 + 16384 + 1024 + w * 8704 + r32 * 272 + hi * 16;
    const int n = r32 & 3, tok = 8 * w + (r32 >> 2), t = 64 * c + tok; const size_t row = (size_t)b * SEQ + t;
    const bf16_t* T1 = Y1 + (size_t)1 * MTOK * 256; const bf16_t* QB = Y1 + (size_t)(2 + g) * MTOK * 256;
    const bf16_t* KVS = Y1 + (size_t)5 * MTOK * 256; const bf16_t* KVW = Y1 + (size_t)6 * MTOK * 256;
    bf16x8 qf[4];
#pragma unroll
    for (int ks = 0; ks < 4; ++ks) qf[ks] = *(const bf16x8*)(QB + row * 256 + n * 64 + 16 * ks + 8 * hi);
    float gate[3];
#pragma unroll
    for (int j = 0; j < 3; ++j) { const float x = bf2f(T1[row * 256 + 208 + (4 * g + n) * 3 + j]); gate[j] = 1.f / (1.f + __expf(-x)); }
    for (int i = F.tid; i < 512; i += NTHR) BTL[i] = BT[(8 + 4 * g) * 128 + i] - BT[(8 + 4 * g) * 128 + (i | 127)];
    for (int i = F.tid; i < 4096; i += NTHR) SCB[i] = 0.f;
    __syncthreads();
    const LAS float* bt = BTL + n * 128; const float cfar = 0.f;
    const int vis = (t >= 31) ? ((t - 31) >> 4) : -1;
    const int ntc = ((4 * c + 2) >> 6) + 1;
    const bf16_t* KCg = KC + ((size_t)b * 256 * 2 + g) * 64; const bf16_t* VCg = VC + ((size_t)b * 256 * 2 + g) * 64;
    auto cmp_scores = [&](int i, lcptr Kt, f32x16& s0, f32x16& s1) {
        qk<4>(s0, s1, Kt, KS64, qf, 0.f, r32, hi);
#pragma unroll
        for (int half = 0; half < 2; ++half) { float bb[16]; f32x16& s = half ? s1 : s0;
#pragma unroll
            for (int r = 0; r < 16; ++r) { const int cc = 64 * i + 32 * half + crow(r, hi); const int d = t - 16 * cc - 31; const unsigned ix = (unsigned)d < 127u ? (unsigned)d : 127u; bb[r] = bt[ix]; }
#pragma unroll
            for (int r = 0; r < 16; ++r) asm volatile("" : "+v"(bb[r]));
#pragma unroll
            for (int r = 0; r < 16; ++r) { const int cc = 64 * i + 32 * half + crow(r, hi); s[r] = (cc <= vis) ? s[r] + bb[r] : -INFINITY; } }
    };
    float mc = NEG_BIG, lc = 0.f;
    tile_loop64(F.tid, tl, ntc, 128,
        [&](int i, const bf16_t*& kp, const bf16_t*& vp) { kp = KCg + (size_t)(64 * i) * 128; vp = VCg + (size_t)(64 * i) * 128; },
        [&](int i, lcptr Kt, lcptr Vt) { f32x16 s0, s1; cmp_scores(i, Kt, s0, s1);
            const float mn = fmaxf(mc, rowmax32(s0, s1)); float rs = 0.f;
#pragma unroll
            for (int r = 0; r < 16; ++r) rs += ex2(s0[r] - mn) + ex2(s1[r] - mn);
            lc = lc * ex2(mc - mn) + rs; mc = mn; });
    lc += __shfl_xor(lc, 32);
    const float invc = lc > 0.f ? 1.f / lc : 0.f;
    {
        f32x16 o[2] = {splat16(0.f), splat16(0.f)}; float carry = 0.f;
        tile_loop64(F.tid, tl, ntc, 128,
            [&](int i, const bf16_t*& kp, const bf16_t*& vp) { kp = KCg + (size_t)(64 * i) * 128; vp = VCg + (size_t)(64 * i) * 128; },
            [&](int i, lcptr Kt, lcptr Vt) { f32x16 s0, s1; cmp_scores(i, Kt, s0, s1);
#pragma unroll
                for (int r = 0; r < 16; ++r) { s0[r] = ex2(s0[r] - mc) * invc; s1[r] = ex2(s1[r] - mc) * invc; }
                float x0[4], x1[4];
#pragma unroll
                for (int rg = 0; rg < 4; ++rg) { x0[rg] = __shfl_xor(s0[4 * rg + 3], 32); x1[rg] = __shfl_xor(s1[4 * rg + 3], 32); }
#pragma unroll
                for (int rg = 0; rg < 4; ++rg) {
                    float g0 = (s0[4 * rg] + s0[4 * rg + 1]) + (s0[4 * rg + 2] + s0[4 * rg + 3]), g1 = (s1[4 * rg] + s1[4 * rg + 1]) + (s1[4 * rg + 2] + s1[4 * rg + 3]);
                    const float e0 = hi ? x0[rg] : (rg > 0 ? x0[rg > 0 ? rg - 1 : 0] : carry), e1 = hi ? x1[rg] : (rg > 0 ? x1[rg > 0 ? rg - 1 : 0] : x0[3]);
                    g0 += e0; g1 += e1;
                    g0 += __shfl_xor(g0, 1); g0 += __shfl_xor(g0, 2); g1 += __shfl_xor(g1, 1); g1 += __shfl_xor(g1, 2);
                    if (n == 0) { SCB[tok * 64 + 16 * i + 2 * rg + hi] = g0; SCB[tok * 64 + 16 * i + 8 + 2 * rg + hi] = g1; }
                }
                carry = x1[3];
                pv<2>(o, s0, s1, Vt, VS64, lane); });
#pragma unroll
        for (int d = 0; d < 2; ++d)
#pragma unroll
            for (int rg = 0; rg < 4; ++rg) *(LAS f32x4*)(OFL + d * 128 + rg * 32) = (f32x4){o[d][4 * rg], o[d][4 * rg + 1], o[d][4 * rg + 2], o[d][4 * rg + 3]} * gate[0];
    }
    {
        unsigned long long uni = 0ull;
#pragma unroll 1
        for (int tk = 0; tk < 8; ++tk) { const int tk2 = 8 * w + tk; float v = SCB[tk2 * 64 + lane];
            v = (lane > c) ? -INFINITY : ((lane == 0 || lane == c || lane == c - 1) ? INFINITY : v);
            int cnt = 0;
#pragma unroll
            for (int j = 0; j < 64; ++j) { const float vj = __builtin_bit_cast(float, __builtin_amdgcn_readlane(__builtin_bit_cast(int, v), j)); cnt += (vj > v || (vj == v && j < lane)) ? 1 : 0; }
            const unsigned long long mk = __ballot(cnt < 16 && lane <= c);
            if (lane == 0) SELM[tk2] = mk;
            uni |= mk; }
        if (lane == 0) SELM[64 + w] = uni;
    }
    __syncthreads();
    const unsigned long long mymask = SELM[tok];
    unsigned long long uni = 0ull;
#pragma unroll
    for (int k = 0; k < 8; ++k) uni |= SELM[64 + k];
    {
        f32x16 o[2] = {splat16(0.f), splat16(0.f)}; float l = 0.f;
        const int nsel = __popcll(uni);
        const bf16_t* Kg = KVS + (size_t)b * SEQ * 256 + g * 64; const bf16_t* Vg = Kg + 128;
        LAS unsigned char* LIST = (LAS unsigned char*)(SELM + 72);
        if (F.tid < 64 && ((uni >> F.tid) & 1ull)) LIST[__popcll(uni & ((1ull << F.tid) - 1ull))] = (unsigned char)F.tid;
        __syncthreads();
        tile_loop64(F.tid, tl, nsel, 256,
            [&](int i, const bf16_t*& kp, const bf16_t*& vp) { const int j = LIST[i]; kp = Kg + (size_t)(64 * j) * 256; vp = Vg + (size_t)(64 * j) * 256; },
            [&](int i, lcptr Kt, lcptr Vt) { const int j = LIST[i];
                const bool sel = (mymask >> j) & 1ull;
                if (!__any(sel)) return;
                f32x16 s0, s1; qk<4>(s0, s1, Kt, KS64, qf, 0.f, r32, hi);
                if (j >= c - 2) bias_mask_near(s0, s1, bt, t, 64 * j, hi, 0x7fffffffu);
                if (!sel) mask_all(s0, s1);
                exp_step(s0, s1, l); pv<2>(o, s0, s1, Vt, VS64, lane); });
        l += __shfl_xor(l, 32); const float f = gate[1] * (l > 0.f ? 1.f / l : 0.f);
#pragma unroll
        for (int d = 0; d < 2; ++d)
#pragma unroll
            for (int rg = 0; rg < 4; ++rg) *(LAS f32x4*)(OFL + d * 128 + rg * 32) += (f32x4){o[d][4 * rg], o[d][4 * rg + 1], o[d][4 * rg + 2], o[d][4 * rg + 3]} * f;
    }
    {
        f32x16 o[2] = {splat16(0.f), splat16(0.f)}; float l = 0.f;
        const int k0 = c >= 8 ? c - 8 : 0, ntw = c - k0 + 1;
        const bf16_t* Kg = KVW + (size_t)b * SEQ * 256 + g * 64; const bf16_t* Vg = Kg + 128;
        tile_loop64(F.tid, tl, ntw, 256,
            [&](int i, const bf16_t*& kp, const bf16_t*& vp) { kp = Kg + (size_t)(64 * (k0 + i)) * 256; vp = Vg + (size_t)(64 * (k0 + i)) * 256; },
            [&](int i, lcptr Kt, lcptr Vt) { const int kt = k0 + i; f32x16 s0, s1; qk<4>(s0, s1, Kt, KS64, qf, 0.f, r32, hi);
                if (!(kt < c - 2 && kt > c - 8)) bias_mask_near(s0, s1, bt, t, 64 * kt, hi, 512u);
                exp_step(s0, s1, l); pv<2>(o, s0, s1, Vt, VS64, lane); });
        l += __shfl_xor(l, 32); const float f = gate[2] * (l > 0.f ? 1.f / l : 0.f);
        unsigned char* orow = MIXIN + row * 1536 + 1024 + (4 * g + n) * 64;
#pragma unroll
        for (int d = 0; d < 2; ++d)
#pragma unroll
            for (int rg = 0; rg < 4; ++rg) { const f32x4 v = (*(LAS f32x4*)(OFL + d * 128 + rg * 32) + (f32x4){o[d][4 * rg], o[d][4 * rg + 1], o[d][4 * rg + 2], o[d][4 * rg + 3]} * f) * OSC;
                *(unsigned*)(orow + 32 * d + 8 * rg + 4 * hi) = pg8::pk4_fp8(v[0], v[1], v[2], v[3]); }
    }
}

__device__ __forceinline__ void dsa_unit(const Frame& F, int b, int u, const bf16_t* QLAT, const bf16_t* CKVN, const unsigned* MASK, const float* BT, unsigned char* MIXIN) {
    using namespace att;
    const int lane = F.lane, r32 = lane & 31, hi = lane >> 5, w = F.wave, tid = F.tid;
    lptr lds = (lptr)F.lds; lptr Kb = lds, Vb = lds + 2 * KT128; LAS float* BTL = (LAS float*)(lds + 2 * KT128 + 2 * VT128);
    const int head = r32 & 7, q0 = 32 * u, t = q0 + 4 * w + (r32 >> 3); const size_t row = (size_t)b * SEQ + t;
    bf16x8 qf[8];
#pragma unroll
    for (int ks = 0; ks < 8; ++ks) qf[ks] = *(const bf16x8*)(QLAT + row * 1024 + head * 128 + 16 * ks + 8 * hi);
    for (int i = tid; i < 1024; i += NTHR) BTL[i] = BT[i] - BT[i | 127];
    const LAS float* bt = BTL + head * 128;
    f32x16 o[4] = {splat16(0.f), splat16(0.f), splat16(0.f), splat16(0.f)}; float l = 0.f;
    const int nt = ((q0 + 31) >> 6) + 1;
    const bf16_t* Cb = CKVN + (size_t)b * SEQ * 128; const unsigned* mrow = MASK + row * 128;
    u32x4 st[2];
    auto gload = [&](int i) {
#pragma unroll
        for (int k = 0; k < 2; ++k) { const int idx = tid + 512 * k, rr = idx >> 4, ch = idx & 15; st[k] = *(const u32x4*)(Cb + (size_t)(64 * i + rr) * 128 + ch * 8); } };
    auto lstore = [&](int i) { lptr kd = Kb + (i & 1) * KT128, vd = Vb + (i & 1) * VT128;
#pragma unroll
        for (int k = 0; k < 2; ++k) { const int idx = tid + 512 * k, rr = idx >> 4, ch = idx & 15; *(LAS u32x4*)(kd + rr * KS128 + ch * 16) = st[k]; *(LAS u32x4*)(vd + rr * VS128 + ch * 16) = st[k]; } };
    auto score = [&](int i, f32x16& s0, f32x16& s1) {
        lcptr Kt = (lcptr)(Kb + (i & 1) * KT128);
        const u32x2 mw = *(const u32x2*)(mrow + 2 * i);
        qk<8>(s0, s1, Kt, KS128, qf, 0.f, r32, hi);
        const unsigned w0 = mw.x >> (4 * hi), w1 = mw.y >> (4 * hi);
        if ((q0 - (64 * i + 63)) < 128) {
#pragma unroll
            for (int r = 0; r < 16; ++r) { const int d0 = t - (64 * i + crow(r, hi)), d1 = d0 - 32;
                const unsigned i0 = (unsigned)d0 < 127u ? (unsigned)d0 : 127u, i1 = (unsigned)d1 < 127u ? (unsigned)d1 : 127u;
                s0[r] += bt[i0]; s1[r] += bt[i1]; }
        }
#pragma unroll
        for (int r = 0; r < 16; ++r) { const int bit = (r & 3) + 8 * (r >> 2);
            const int m0 = __builtin_amdgcn_sbfe((int)w0, bit, 1), m1 = __builtin_amdgcn_sbfe((int)w1, bit, 1);
            const float a0 = s0[r], a1 = s1[r];
            s0[r] = __int_as_float((__float_as_int(a0) & m0) | ((int)0xff800000 & ~m0));
            s1[r] = __int_as_float((__float_as_int(a1) & m1) | ((int)0xff800000 & ~m1)); }
    };
    u32x4 st2[2];
    gload(0); lstore(0);
    if (nt > 1) gload(1);
    __syncthreads();
    auto step = [&](int i, u32x4 (&sL)[2], u32x4 (&sS)[2]) {
        if (i + 2 < nt) {
#pragma unroll
            for (int k = 0; k < 2; ++k) { const int idx = tid + 512 * k, rr = idx >> 4, ch = idx & 15; sL[k] = *(const u32x4*)(Cb + (size_t)(64 * (i + 2) + rr) * 128 + ch * 8); } }
        f32x16 s0, s1; score(i, s0, s1);
        exp_step(s0, s1, l); pv<4>(o, s0, s1, (lcptr)(Vb + (i & 1) * VT128), VS128, lane);
        if (i + 1 < nt) { lptr kd = Kb + ((i + 1) & 1) * KT128, vd = Vb + ((i + 1) & 1) * VT128;
#pragma unroll
            for (int k = 0; k < 2; ++k) { const int idx = tid + 512 * k, rr = idx >> 4, ch = idx & 15; *(LAS u32x4*)(kd + rr * KS128 + ch * 16) = sS[k]; *(LAS u32x4*)(vd + rr * VS128 + ch * 16) = sS[k]; } }
        __syncthreads();
    };
    for (int i = 0; i < nt; i += 2) { step(i, st2, st); if (i + 1 < nt) step(i + 1, st, st2); }
    l += __shfl_xor(l, 32); const float f = l > 0.f ? OSC / l : 0.f;
    unsigned char* orow = MIXIN + row * 1536 + head * 128;
#pragma unroll
    for (int d = 0; d < 4; ++d)
#pragma unroll
        for (int rg = 0; rg < 4; ++rg) *(unsigned*)(orow + 32 * d + 8 * rg + 4 * hi) = pg8::pk4_fp8(o[d][4 * rg] * f, o[d][4 * rg + 1] * f, o[d][4 * rg + 2] * f, o[d][4 * rg + 3] * f);
}

constexpr int DS_TILE = 32 * att::KS128, DS_WAVE = 2 * DS_TILE + 640;
__device__ __forceinline__ void dsa_query(int lane, int b, int t, u32x2 mw, att::lptr base, const LAS float* BTL, const bf16_t* QLAT, const bf16_t* CKVN, unsigned char* MIXIN) {
    using namespace att;
    const int r32 = lane & 31, hi = lane >> 5, head = r32 & 7; const size_t row = (size_t)b * SEQ + t;
    LAS unsigned short* LIST = (LAS unsigned short*)(base + 2 * DS_TILE);
    bf16x8 qf[8];
#pragma unroll
    for (int ks = 0; ks < 8; ++ks) qf[ks] = *(const bf16x8*)(QLAT + row * 1024 + head * 128 + 16 * ks + 8 * hi);
    int n;
    { unsigned long long bits = (lane <= (t >> 6)) ? ((unsigned long long)mw.x | ((unsigned long long)mw.y << 32)) : 0ull;
      const int cnt = __popcll(bits); int pre = cnt;
#pragma unroll
      for (int o = 1; o < 64; o <<= 1) { const int v = __shfl_up(pre, o); if (lane >= o) pre += v; }
      n = __builtin_amdgcn_readlane(pre, 63); int pos = pre - cnt;
      while (bits) { const int j = __builtin_ctzll(bits); bits &= bits - 1ull; LIST[pos++] = (unsigned short)(64 * lane + j); }
      if (lane < 32) LIST[n + lane] = 0; }
    const bf16_t* Cb = CKVN + (size_t)b * SEQ * 128; const LAS float* bt = BTL + head * 128;
    const int ntile = (n + 31) >> 5;
    f32x16 o[4] = {splat16(0.f), splat16(0.f), splat16(0.f), splat16(0.f)}; float l = 0.f;
    u32x4 ra[8];
    auto gath = [&](int i, u32x4 (&r)[8]) {
#pragma unroll
        for (int k = 0; k < 8; ++k) { const int c = lane + 64 * k, rw = c >> 4, ch = c & 15; const int idx = LIST[32 * i + rw]; r[k] = *(const u32x4*)(Cb + (size_t)idx * 128 + ch * 8); } };
    auto put = [&](lptr T, const u32x4 (&r)[8]) {
#pragma unroll
        for (int k = 0; k < 8; ++k) { const int c = lane + 64 * k, rw = c >> 4, ch = c & 15; *(LAS u32x4*)(T + rw * KS128 + ch * 16) = r[k]; } };
    const int hq = lane >> 5, g = (lane >> 4) & 1, q4 = (lane & 15) >> 2, p4 = lane & 3;
    auto tile = [&](int i) {
        lcptr T = (lcptr)(base + (i & 1) * DS_TILE);
        f32x16 s = splat16(0.f);
        { lcptr p0 = T + r32 * KS128 + hi * 16;
#pragma unroll
          for (int ks = 0; ks < 8; ++ks) { const bf16x8 kf = *(const LAS bf16x8*)(p0 + ks * 32); s = __builtin_amdgcn_mfma_f32_32x32x16_bf16(kf, qf[ks], s, 0, 0, 0); } }
        const int lastslot = (32 * i + 31 < n) ? 32 * i + 31 : n - 1;
        if (32 * i + 32 > n || t - (int)LIST[lastslot] < 127) {
#pragma unroll
            for (int h8 = 0; h8 < 2; ++h8) { int li[8]; float bb[8];
#pragma unroll
                for (int r = 0; r < 8; ++r) li[r] = LIST[32 * i + crow(8 * h8 + r, hi)];
#pragma unroll
                for (int r = 0; r < 8; ++r) asm volatile("" : "+v"(li[r]));
#pragma unroll
                for (int r = 0; r < 8; ++r) { const int d = t - li[r]; const unsigned ix = (unsigned)d < 127u ? (unsigned)d : 127u; bb[r] = bt[ix]; }
#pragma unroll
                for (int r = 0; r < 8; ++r) asm volatile("" : "+v"(bb[r]));
#pragma unroll
                for (int r = 0; r < 8; ++r) { const int slot = 32 * i + crow(8 * h8 + r, hi); s[8 * h8 + r] = (slot < n) ? s[8 * h8 + r] + bb[r] : -INFINITY; } }
        }
        float rs = 0.f;
#pragma unroll
        for (int r = 0; r < 16; ++r) { s[r] = ex2(s[r]); rs += s[r]; }
        l += rs;
        const bf16x8 pk[2] = {pack_p(s, 0), pack_p(s, 8)};
        lcptr vb = T + (4 * hq + q4) * KS128 + (16 * g + 4 * p4) * 2;
#pragma unroll
        for (int k = 0; k < 2; ++k)
#pragma unroll
            for (int d = 0; d < 4; ++d) { const s16x4 lo = vtr(vb + (16 * k) * KS128 + d * 64), hh = vtr(vb + (16 * k + 8) * KS128 + d * 64);
                const bf16x8 vf = (bf16x8){lo[0], lo[1], lo[2], lo[3], hh[0], hh[1], hh[2], hh[3]};
                o[d] = __builtin_amdgcn_mfma_f32_32x32x16_bf16(vf, pk[k], o[d], 0, 0, 0); }
    };
    gath(0, ra); put(base, ra);
    for (int i = 0; i < ntile; ++i) {
        const bool more = i + 1 < ntile;
        if (more) gath(i + 1, ra);
        tile(i);
        if (more) put(base + ((i + 1) & 1) * DS_TILE, ra);
    }
    l += __shfl_xor(l, 32); const float f = l > 0.f ? OSC / l : 0.f;
    if (r32 < 8) { unsigned char* orow = MIXIN + row * 1536 + head * 128;
#pragma unroll
        for (int d = 0; d < 4; ++d)
#pragma unroll
            for (int rg = 0; rg < 4; ++rg) *(unsigned*)(orow + 32 * d + 8 * rg + 4 * hi) = pg8::pk4_fp8(o[d][4 * rg] * f, o[d][4 * rg + 1] * f, o[d][4 * rg + 2] * f, o[d][4 * rg + 3] * f); }
}
__device__ __forceinline__ void phase_dsa_sparse(const Frame& F, const bf16_t* QLAT, const bf16_t* CKVN, const unsigned* MASK, const float* BT, unsigned char* MIXIN) {
    att::lptr lds = (att::lptr)F.lds; LAS float* BTL = (LAS float*)(lds + 8 * DS_WAVE);
    for (int i = F.tid; i < 1024; i += NTHR) BTL[i] = BT[i] - BT[i | 127];
    __syncthreads();
    att::lptr base = lds + F.wave * DS_WAVE;
    if ((F.G & 7) == 0) {
        const int b = F.bx & 7, wx = (F.bx >> 3) * NWAVES + F.wave, WX = (F.G >> 3) * NWAVES;
        u32x2 mw = *(const u32x2*)(MASK + ((size_t)b * SEQ + wx) * 128 + 2 * F.lane);
        for (int t = wx; t < SEQ; t += WX) { const int tn = (t + WX < SEQ) ? t + WX : t;
            const u32x2 mwn = *(const u32x2*)(MASK + ((size_t)b * SEQ + tn) * 128 + 2 * F.lane);
            dsa_query(F.lane, b, t, mw, base, BTL, QLAT, CKVN, MIXIN); mw = mwn; }
    } else {
        for (int q = F.gw; q < MTOK; q += F.NGW) { const u32x2 mw = *(const u32x2*)(MASK + (size_t)q * 128 + 2 * F.lane); dsa_query(F.lane, q >> 12, q & 4095, mw, base, BTL, QLAT, CKVN, MIXIN); }
    }
    __syncthreads();
}

constexpr int QI_STRIDE = 2064;
__device__ __forceinline__ void indexer_unit(const Frame& F, int b, int c, const bf16_t* QIDX, const bf16_t* T1, _Float16* SC) {
    using namespace att;
    const int lane = F.lane, r32 = lane & 31, hi = lane >> 5, w = F.wave, tid = F.tid;
    lptr lds = (lptr)F.lds; lptr QI = lds; lptr KI = lds + 64 * QI_STRIDE;
    const int qh = w & 1, kq = w >> 1;
    const size_t row0 = (size_t)b * SEQ + 64 * c;
#pragma unroll 4
    for (int k = 0; k < 16; ++k) { const int idx = tid + 512 * k, rr = idx >> 7, ch = idx & 127; *(LAS u32x4*)(QI + rr * QI_STRIDE + ch * 16) = *(const u32x4*)(QIDX + (row0 + rr) * 1024 + ch * 8); }
    float wv[16];
    { const size_t trow = row0 + 32 * qh + r32; const u32x4 a = *(const u32x4*)(T1 + trow * 256 + 192), bq = *(const u32x4*)(T1 + trow * 256 + 200);
      wv[0] = bflo(a.x); wv[1] = bfhi(a.x); wv[2] = bflo(a.y); wv[3] = bfhi(a.y); wv[4] = bflo(a.z); wv[5] = bfhi(a.z); wv[6] = bflo(a.w); wv[7] = bfhi(a.w);
      wv[8] = bflo(bq.x); wv[9] = bfhi(bq.x); wv[10] = bflo(bq.y); wv[11] = bfhi(bq.y); wv[12] = bflo(bq.z); wv[13] = bfhi(bq.z); wv[14] = bflo(bq.w); wv[15] = bfhi(bq.w); }
    const int nsup = (c + 2) >> 1, pitch = (c + 1) * 64;
    _Float16* srow = SC + (size_t)b * SCB_ELEMS + (size_t)4096 * (c * (c + 1) / 2) + (size_t)(32 * qh + r32) * pitch;
    const bf16_t* Kb = T1 + (size_t)b * SEQ * 256 + 128;
    u32x4 st[2];
    for (int s = 0; s < nsup; ++s) {
#pragma unroll
        for (int k = 0; k < 2; ++k) { const int idx = tid + 512 * k, rr = idx >> 3, ch = idx & 7; st[k] = *(const u32x4*)(Kb + (size_t)(128 * s + rr) * 256 + ch * 8); }
        __syncthreads();
#pragma unroll
        for (int k = 0; k < 2; ++k) { const int idx = tid + 512 * k, rr = idx >> 3, ch = idx & 7; *(LAS u32x4*)(KI + rr * KS64 + ch * 16) = st[k]; }
        __syncthreads();
        const int key0 = 128 * s + 32 * kq;
        if (key0 <= 64 * c + 63) {
            bf16x8 kf[4];
#pragma unroll
            for (int ks = 0; ks < 4; ++ks) kf[ks] = *(const LAS bf16x8*)(KI + (32 * kq + r32) * KS64 + ks * 32 + hi * 16);
            f32x16 sc = splat16(0.f);
            lcptr qp = (lcptr)QI + (32 * qh + r32) * QI_STRIDE + hi * 16;
#pragma unroll 2
            for (int hd = 0; hd < 16; ++hd) { f32x16 acc = splat16(0.f);
#pragma unroll
                for (int ks = 0; ks < 4; ++ks) { const bf16x8 qv = *(const LAS bf16x8*)(qp + hd * 128 + ks * 32); acc = __builtin_amdgcn_mfma_f32_32x32x16_bf16(kf[ks], qv, acc, 0, 0, 0); }
                const float ww = wv[hd];
#pragma unroll
                for (int r = 0; r < 16; ++r) sc[r] += ww * fmaxf(acc[r], 0.f); }
#pragma unroll
            for (int rg = 0; rg < 4; ++rg) { f32x2 a = {sc[4 * rg], sc[4 * rg + 1]}, bq = {sc[4 * rg + 2], sc[4 * rg + 3]};
                u32x2 o; o.x = __builtin_bit_cast(unsigned, __builtin_convertvector(a, f16x2_t)); o.y = __builtin_bit_cast(unsigned, __builtin_convertvector(bq, f16x2_t));
                *(u32x2*)(srow + key0 + 8 * rg + 4 * hi) = o; }
        }
    }
    __syncthreads();
}

struct SelRow { const unsigned short* src; unsigned* mrow; int t, c; };
__device__ __forceinline__ SelRow sel_row(int row, const _Float16* SC, unsigned* MASK) {
    SelRow r; const int b = row >> 12; r.t = row & 4095; r.c = r.t >> 6; const int nk = (r.c + 1) * 64;
    r.src = (const unsigned short*)SC + (size_t)b * SCB_ELEMS + (size_t)4096 * (r.c * (r.c + 1) / 2) + (size_t)(r.t & 63) * nk; r.mrow = MASK + (size_t)row * 128; return r;
}
__device__ __forceinline__ void sel_load(const SelRow& r, int lane, unsigned (&key)[64]) {
#pragma unroll
    for (int g = 0; g < 4; ++g) {
        if (r.c >= 16 * g) {
#pragma unroll
            for (int jj = 0; jj < 16; ++jj) { const int j = 16 * g + jj, jc = j <= r.c ? j : r.c;
                const unsigned uu = r.src[64 * jc + lane]; const unsigned k = (uu & 0x8000u) ? (~uu & 0xffffu) : (uu | 0x8000u);
                key[j] = (64 * j + lane > r.t) ? 0u : k; }
        } else {
#pragma unroll
            for (int jj = 0; jj < 16; ++jj) key[16 * g + jj] = 0u;
        }
    }
}
template <bool GT> __device__ __forceinline__ int sel_count(const unsigned (&key)[64], unsigned cand, int c) {
    int cnt = 0;
#pragma unroll
    for (int g = 0; g < 4; ++g) if (c >= 16 * g) {
#pragma unroll
        for (int jj = 0; jj < 16; ++jj) cnt += __popcll(__ballot(GT ? (key[16 * g + jj] > cand) : (key[16 * g + jj] >= cand)));
    }
    return cnt;
}
__device__ __forceinline__ void sel_emit(const SelRow& r, int lane, const unsigned (&key)[64], unsigned prefix, bool exact) {
    if (exact) {
#pragma unroll
        for (int j = 0; j < 64; ++j) if (j <= r.c) { const unsigned long long mk = __ballot(key[j] >= prefix); if (lane == 0) *(u32x2*)(r.mrow + 2 * j) = (u32x2){(unsigned)mk, (unsigned)(mk >> 32)}; }
        return;
    }
    int rem = 256 - sel_count<true>(key, prefix, r.c);
#pragma unroll
    for (int j = 0; j < 64; ++j) {
        if (j <= r.c) {
            const bool eq = key[j] == prefix; const unsigned long long eqm = __ballot(eq);
            const int before = __builtin_amdgcn_mbcnt_hi((unsigned)(eqm >> 32), __builtin_amdgcn_mbcnt_lo((unsigned)eqm, 0u));
            const unsigned long long mk = __ballot(key[j] > prefix || (eq && before < rem));
            rem -= __popcll(eqm); rem = rem < 0 ? 0 : rem;
            if (lane == 0) *(u32x2*)(r.mrow + 2 * j) = (u32x2){(unsigned)mk, (unsigned)(mk >> 32)};
        }
    }
}
__device__ __forceinline__ void sel_small(const SelRow& r, int lane) {
    for (int j = 0; j <= r.c; ++j) { const unsigned long long mk = __ballot(64 * j + lane <= r.t); if (lane == 0) *(u32x2*)(r.mrow + 2 * j) = (u32x2){(unsigned)mk, (unsigned)(mk >> 32)}; }
}
__device__ __forceinline__ void phase_select(const Frame& F, const _Float16* SC, unsigned* MASK) {
    const int lane = F.lane;
    for (int p = F.gw; p < MTOK / 2; p += F.NGW) {
        const int pb_ = p >> 11, q = p & 2047;
        const SelRow ra = sel_row(pb_ * 4096 + q, SC, MASK), rb = sel_row(pb_ * 4096 + 4095 - q, SC, MASK);
        const bool sa = ra.t < 256, sb = rb.t < 256;
        if (sa) sel_small(ra, lane);
        if (sb) sel_small(rb, lane);
        if (sa && sb) continue;
        unsigned ka[64], kb[64];
        sel_load(ra, lane, ka); sel_load(rb, lane, kb);
        unsigned pa = 0u, pb = 0u; bool da = sa, db = sb;
#pragma unroll 1
        for (int bit = 15; bit >= 0 && !(da && db); --bit) {
            if (!da) { const unsigned ca = pa | (1u << bit); const int na = sel_count<false>(ka, ca, ra.c); if (na >= 256) pa = ca; if (na == 256) da = true; }
            if (!db) { const unsigned cb = pb | (1u << bit); const int nb = sel_count<false>(kb, cb, rb.c); if (nb >= 256) pb = cb; if (nb == 256) db = true; }
        }
        if (!sa) sel_emit(ra, lane, ka, pa, da);
        if (!sb) sel_emit(rb, lane, kb, pb, db);
    }
}

__device__ __forceinline__ float gelu_tanh(float x) { const float u = 0.7978845608028654f * (x + 0.044715f * x * x * x); const float e = __expf(2.f * u); return 0.5f * x * (1.f + (1.f - 2.f / (e + 1.f))); }
__device__ __forceinline__ void compress_unit(const Frame& F, int b, int g, int kv, int rt, const bf16_t* KVC, const bf16_t* W1T, const float* w2, const float* cb, bf16_t* OUT) {
    const int lane = F.lane, r32 = lane & 31, hi = lane >> 5, w = F.wave, tid = F.tid;
    LAS float* PART = (LAS float*)F.lds;
    LAS float* HID = PART + 8 * 2048;
    const int n0 = 32 * rt, nn = n0 + r32, nc = nn < 255 ? nn : 254;
    const bf16_t* arow = KVC + ((size_t)b * SEQ + 16 * nc) * 256 + kv * 128 + g * 64;
    f32x16 a0 = att::splat16(0.f), a1 = att::splat16(0.f);
#pragma unroll 4
    for (int ks = 0; ks < 16; ++ks) { const int l = 4 * w + (ks >> 2), d = 16 * (ks & 3) + 8 * hi;
        const bf16x8 af = *(const bf16x8*)(arow + (size_t)l * 256 + d);
        const bf16x8 b0 = *(const bf16x8*)(W1T + (size_t)r32 * 2048 + l * 64 + d), b1 = *(const bf16x8*)(W1T + (size_t)(32 + r32) * 2048 + l * 64 + d);
        a0 = __builtin_amdgcn_mfma_f32_32x32x16_bf16(af, b0, a0, 0, 0, 0); a1 = __builtin_amdgcn_mfma_f32_32x32x16_bf16(af, b1, a1, 0, 0, 0); }
#pragma unroll
    for (int r = 0; r < 16; ++r) { const int mrow = att::crow(r, hi); PART[w * 2048 + mrow * 64 + r32] = a0[r]; PART[w * 2048 + mrow * 64 + 32 + r32] = a1[r]; }
    __syncthreads();
#pragma unroll
    for (int k = 0; k < 4; ++k) { const int idx = tid + 512 * k; float s = cb[idx & 63];
#pragma unroll
        for (int ww = 0; ww < 8; ++ww) s += PART[ww * 2048 + idx];
        HID[idx] = gelu_tanh(s); }
    __syncthreads();
#pragma unroll
    for (int k = 0; k < 4; ++k) { const int idx = tid + 512 * k, nr = idx >> 6, f = idx & 63; float s = 0.f;
#pragma unroll 8
        for (int e = 0; e < 64; ++e) s += HID[nr * 64 + e] * w2[e * 64 + f];
        const int blk = n0 + nr;
        OUT[(((size_t)b * 256 + blk) * 2 + g) * 64 + f] = (blk < 255) ? (bf16_t)f2bf(s) : (bf16_t)0; }
    __syncthreads();
}

#ifdef DBG_MODE
namespace dbg {
constexpr int NSLOT = 40;
__device__ __forceinline__ float bfr(float x) { return bf2f((unsigned short)f2bf(x)); }
__device__ __forceinline__ int srow(int i, int n) { return (int)(((unsigned)i * 2654435761u) % (unsigned)MTOK) ; }
__device__ void commit(unsigned* D, int slot, const float* ref, const float* fast, int n, float tf) {
    __shared__ float red[256];
    const int tid = threadIdx.x; float s = 0.f;
    for (int i = tid; i < n; i += 256) s += ref[i] * ref[i];
    red[tid] = s; __syncthreads();
    for (int o = 128; o > 0; o >>= 1) { if (tid < o) red[tid] += red[tid + o]; __syncthreads(); }
    const float rms = sqrtf(red[0] / (float)n); __syncthreads();
    int bad = 0, tot = 0; float mr = 0.f;
    for (int i = tid; i < n; i += 256) { const float e = fabsf(fast[i] - ref[i]); const float tol = tf * (rms + fabsf(ref[i])) + 1e-7f; if (!(e <= tol)) ++bad; ++tot; const float r = e / (rms + 1e-20f); if (r > mr || !(r == r)) mr = (r == r) ? r : 1e30f; }
    atomicAdd(&D[4 * slot], (unsigned)bad); atomicAdd(&D[4 * slot + 1], (unsigned)tot); atomicMax(&D[4 * slot + 2], __float_as_uint(mr));
    __syncthreads();
}
__device__ __forceinline__ float bias_l2(const float* relb, int head, int dist) { return relb[t5_bucket(dist) * 16 + head] * LOG2E; }

__global__ void chk_in_e(Args a, unsigned* D) {
    __shared__ float ref[1792], fast[1792];
    const int r = srow(blockIdx.x, 64), tid = threadIdx.x; const float* x = a.in[I_X] + (size_t)r * 1024; const float* w = a.in[I_EWIN];
    const bf16_t* Y1 = (const bf16_t*)(a.ws + OFF_Y1);
    for (int n = tid; n < EVEN_IN; n += 256) { float s = 0.f; for (int k = 0; k < 1024; ++k) s += bfr(x[k]) * bfr(w[(size_t)k * EVEN_IN + n]);
        const int dc = RowInE{}(n), tile = dc >> 8, col = dc & 255; const float sc = (tile == 2 || tile == 3) ? QSCALE : 1.f;
        ref[n] = s * sc; fast[n] = bf2f(Y1[((size_t)tile * MTOK + r) * 256 + col]); }
    __syncthreads();
    commit(D, 1, ref, fast, EVEN_IN, 0.02f);
    if (tid == 0) { float sq = 0.f, skv = 0.f; for (int n = 0; n < 256; ++n) sq += ref[n] * ref[n]; for (int n = 256; n < 384; ++n) skv += ref[n] * ref[n];
        const float* pq = (const float*)(a.ws + OFF_SSQ_Q) + (size_t)r * 4; const float* pk = (const float*)(a.ws + OFF_SSQ_KV) + (size_t)r * 4;
        const float fq = pq[0] + pq[1] + pq[2] + pq[3], fk = pk[0] + pk[1] + pk[2] + pk[3];
        int bad = 0; if (!(fabsf(fq - sq) <= 0.02f * sq)) ++bad; if (!(fabsf(fk - skv) <= 0.02f * skv)) ++bad;
        atomicAdd(&D[4 * 2], (unsigned)bad); atomicAdd(&D[4 * 2 + 1], 2u); }
}
__global__ void chk_q2(Args a, unsigned* D) {
    __shared__ float ref[1024], fast[1024], cqn[256], qh[512];
    const int r = srow(blockIdx.x, 64), tid = threadIdx.x; const bf16_t* Y1 = (const bf16_t*)(a.ws + OFF_Y1);
    const bf16_t* CQ = Y1 + (size_t)r * 256; const bf16_t* T1 = Y1 + ((size_t)MTOK + r) * 256;
    { float s = 0.f; for (int k = 0; k < 128; ++k) { const float c = bf2f(T1[k]); s += c * c; } const float rk = 1.f / sqrtf(s / 128.f + 1e-6f);
      if (tid < 128) { ref[tid] = bf2f(T1[tid]) * rk * a.in[I_EKVN][tid]; fast[tid] = bf2f(((const bf16_t*)(a.ws + OFF_CKVN))[(size_t)r * 128 + tid]); } }
    __syncthreads(); commit(D, 3, ref, fast, 128, 0.02f);
    { float s = 0.f; for (int k = 0; k < 256; ++k) { const float c = bf2f(CQ[k]); s += c * c; } const float rq = 1.f / sqrtf(s / 256.f + 1e-6f);
      cqn[tid] = bf2f(CQ[tid]) * rq * a.in[I_EQN][tid]; }
    __syncthreads();
    for (int o = tid; o < 512; o += 256) { float s = 0.f; for (int k = 0; k < 256; ++k) s += cqn[k] * a.in[I_EWUQ][k * 512 + o]; qh[o] = s; }
    __syncthreads();
    for (int o = tid; o < 1024; o += 256) { const int h = o >> 7, c = o & 127; float s = 0.f; for (int d = 0; d < 64; ++d) s += qh[h * 64 + d] * a.in[I_EWUK][c * 512 + h * 64 + d];
        ref[o] = s * QSCALE; fast[o] = bf2f(((const bf16_t*)(a.ws + OFF_QLAT))[(size_t)r * 1024 + o]); }
    __syncthreads(); commit(D, 5, ref, fast, 1024, 0.03f);
    for (int o = tid; o < 1024; o += 256) { float s = 0.f; for (int k = 0; k < 256; ++k) s += cqn[k] * a.in[I_EWQIDX][k * 1024 + o];
        ref[o] = s; fast[o] = bf2f(((const bf16_t*)(a.ws + OFF_QIDX))[(size_t)r * 1024 + o]); }
    __syncthreads(); commit(D, 6, ref, fast, 1024, 0.03f);
}
__global__ void chk_cmp(Args a, unsigned* D) {
    __shared__ float ref[64], fast[64], hid[64];
    const int i = blockIdx.x, tid = threadIdx.x, b = i & 7, g = (i >> 3) & 1, kv = (i >> 4) & 1; const int blk = (i >> 5) == 0 ? 0 : ((i >> 5) == 1 ? 254 : (int)((unsigned)(i * 37 + 11) % 255u));
    const bf16_t* KVC = (const bf16_t*)(a.ws + OFF_Y1) + (size_t)4 * MTOK * 256;
    const float* pos = a.in[kv ? I_EPOSV : I_EPOSK]; const float* w1 = a.in[kv ? I_ECV1 : I_ECK1]; const float* w2 = a.in[kv ? I_ECV2 : I_ECK2];
    if (tid < 64) { float s = 0.f;
        for (int l = 0; l < 32; ++l) for (int d = 0; d < 64; ++d) { const float av = bf2f(KVC[((size_t)b * SEQ + 16 * blk + l) * 256 + kv * 128 + g * 64 + d]); const float wv = w1[(l * 64 + d) * 64 + tid]; s += av * bfr(wv) + pos[l * 64 + d] * wv; }
        hid[tid] = gelu_tanh(s); }
    __syncthreads();
    if (tid < 64) { float s = 0.f; for (int e = 0; e < 64; ++e) s += hid[e] * w2[e * 64 + tid]; ref[tid] = s;
        fast[tid] = bf2f(((const bf16_t*)(a.ws + (kv ? OFF_VC : OFF_KC)))[(((size_t)b * 256 + blk) * 2 + g) * 64 + tid]); }
    __syncthreads(); commit(D, 4, ref, fast, 64, 0.03f);
}
__global__ void chk_idx(Args a, unsigned* D) {
    __shared__ float ref[256], fast[256];
    const int r = (blockIdx.x < 4) ? (blockIdx.x * 4096 + blockIdx.x * 61) : srow(blockIdx.x, 64), tid = threadIdx.x, b = r >> 12, t = r & 4095, c = t >> 6, nk = (c + 1) * 64;
    const bf16_t* Y1 = (const bf16_t*)(a.ws + OFF_Y1); const bf16_t* T1 = Y1 + (size_t)MTOK * 256; const bf16_t* QI = (const bf16_t*)(a.ws + OFF_QIDX) + (size_t)r * 1024;
    const int s = (int)(((unsigned)tid * 2654435761u + 12345u * blockIdx.x) % (unsigned)nk);
    const bf16_t* kr = T1 + ((size_t)b * SEQ + s) * 256 + 128; float sc = 0.f;
    for (int h = 0; h < 16; ++h) { float d = 0.f; for (int k = 0; k < 64; ++k) d += bf2f(QI[h * 64 + k]) * bf2f(kr[k]); sc += bf2f(T1[(size_t)r * 256 + 192 + h]) * fmaxf(d, 0.f); }
    ref[tid] = sc;
    const _Float16* SC = (const _Float16*)(a.ws + OFF_SC) + (size_t)b * SCB_ELEMS + (size_t)4096 * (c * (c + 1) / 2) + (size_t)(t & 63) * nk;
    fast[tid] = (float)SC[s];
    __syncthreads(); commit(D, 7, ref, fast, 256, 0.02f);
}
__global__ void chk_sel(Args a, unsigned* D) {
    __shared__ unsigned key[4096];
    const int r = (blockIdx.x < 8) ? (blockIdx.x * 4096 + 255 + blockIdx.x * 300) : srow(blockIdx.x, 64), tid = threadIdx.x, b = r >> 12, t = r & 4095, c = t >> 6, nk = (c + 1) * 64;
    const unsigned short* SC = (const unsigned short*)(a.ws + OFF_SC) + (size_t)b * SCB_ELEMS + (size_t)4096 * (c * (c + 1) / 2) + (size_t)(t & 63) * nk;
    const unsigned* M = (const unsigned*)(a.ws + OFF_MASK) + (size_t)r * 128;
    for (int s = tid; s < nk; s += 256) { const unsigned u = SC[s]; key[s] = (s <= t) ? ((u & 0x8000u) ? (~u & 0xffffu) : (u | 0x8000u)) : 0u; }
    __syncthreads();
    int bad = 0, tot = 0;
    for (int s = tid; s < nk; s += 256) { bool want;
        if (s > t) want = false; else if (t < 256) want = true;
        else { int rank = 0; const unsigned ks = key[s]; for (int q = 0; q <= t; ++q) rank += (key[q] > ks || (key[q] == ks && q < s)) ? 1 : 0; want = rank < 256; }
        const bool got = (M[s >> 5] >> (s & 31)) & 1u; if (want != got) ++bad; ++tot; }
    atomicAdd(&D[4 * 8], (unsigned)bad); atomicAdd(&D[4 * 8 + 1], (unsigned)tot);
}
__global__ void chk_dsa(Args a, unsigned* D) {
    __shared__ float lg[4096], red[256], ref[128], fast[128];
    const int r = (blockIdx.x < 8) ? (blockIdx.x * 4096 + blockIdx.x * 37) : srow(blockIdx.x, 64), tid = threadIdx.x, b = r >> 12, t = r & 4095, h = blockIdx.x & 7;
    const bf16_t* Q = (const bf16_t*)(a.ws + OFF_QLAT) + (size_t)r * 1024 + h * 128; const bf16_t* C = (const bf16_t*)(a.ws + OFF_CKVN) + (size_t)b * SEQ * 128;
    const unsigned* M = (const unsigned*)(a.ws + OFF_MASK) + (size_t)r * 128; const float* relb = a.in[I_RELB];
    float mx = -INFINITY;
    for (int s = tid; s <= t; s += 256) { float v = -INFINITY; if ((M[s >> 5] >> (s & 31)) & 1u) { float d = 0.f; for (int k = 0; k < 128; ++k) d += bf2f(Q[k]) * bf2f(C[(size_t)s * 128 + k]); v = d + bias_l2(relb, h, t - s); } lg[s] = v; mx = fmaxf(mx, v); }
    red[tid] = mx; __syncthreads(); for (int o = 128; o > 0; o >>= 1) { if (tid < o) red[tid] = fmaxf(red[tid], red[tid + o]); __syncthreads(); } mx = red[0]; __syncthreads();
    float sm = 0.f; for (int s = tid; s <= t; s += 256) { const float p = exp2f(lg[s] - mx); lg[s] = p; sm += p; }
    red[tid] = sm; __syncthreads(); for (int o = 128; o > 0; o >>= 1) { if (tid < o) red[tid] += red[tid + o]; __syncthreads(); } sm = red[0]; __syncthreads();
    if (tid < 128) { float o = 0.f; for (int s = 0; s <= t; ++s) o += lg[s] * bf2f(C[(size_t)s * 128 + tid]); ref[tid] = o / sm; fast[tid] = bf2f(((const bf16_t*)(a.ws + OFF_MIXIN))[(size_t)r * 1536 + h * 128 + tid]); }
    __syncthreads(); commit(D, 9, ref, fast, 128, 0.03f);
}
__global__ void chk_nsa(Args a, unsigned* D) {
    __shared__ float pc[4][256], lg[1100], red[256], ref[64], fast[64], oacc[3][64], scb[64]; __shared__ int selj[16]; __shared__ float qs[4][64];
    const int r = (blockIdx.x < 8) ? (blockIdx.x * 4096 + blockIdx.x * 41) : srow(blockIdx.x, 64), tid = threadIdx.x, b = r >> 12, t = r & 4095, hh = blockIdx.x & 7, g = hh >> 2, n = hh & 3, cur = t >> 6;
    const bf16_t* Y1 = (const bf16_t*)(a.ws + OFF_Y1); const bf16_t* T1 = Y1 + (size_t)MTOK * 256; const bf16_t* QB = Y1 + (size_t)(2 + g) * MTOK * 256;
    const bf16_t* KVS = Y1 + (size_t)5 * MTOK * 256; const bf16_t* KVW = Y1 + (size_t)6 * MTOK * 256;
    const bf16_t* KC = (const bf16_t*)(a.ws + OFF_KC); const bf16_t* VC = (const bf16_t*)(a.ws + OFF_VC); const float* relb = a.in[I_RELB];
    qs[tid >> 6][tid & 63] = bf2f(QB[(size_t)r * 256 + tid]);
    __syncthreads();
    const int vis = (t >= 31) ? ((t - 31) >> 4) : -1;
    for (int nn = 0; nn < 4; ++nn) {
        float v = -INFINITY; if (tid <= vis) { float d = 0.f; for (int k = 0; k < 64; ++k) d += qs[nn][k] * bf2f(KC[(((size_t)b * 256 + tid) * 2 + g) * 64 + k]); v = d + bias_l2(relb, 8 + 4 * g + nn, t - 16 * tid - 31); }
        red[tid] = v; __syncthreads(); for (int o = 128; o > 0; o >>= 1) { if (tid < o) red[tid] = fmaxf(red[tid], red[tid + o]); __syncthreads(); } const float mx = red[0]; __syncthreads();
        const float p = (tid <= vis) ? exp2f(v - mx) : 0.f; red[tid] = p; __syncthreads(); for (int o = 128; o > 0; o >>= 1) { if (tid < o) red[tid] += red[tid + o]; __syncthreads(); } const float sm = red[0]; __syncthreads();
        pc[nn][tid] = sm > 0.f ? p / sm : 0.f; __syncthreads();
    }
    if (tid < 64) { float o = 0.f; for (int i = 0; i <= vis; ++i) o += pc[n][i] * bf2f(VC[(((size_t)b * 256 + i) * 2 + g) * 64 + tid]); oacc[0][tid] = o;
        float s = 0.f; for (int nn = 0; nn < 4; ++nn) for (int i = 4 * tid - 1; i <= 4 * tid + 3; ++i) if (i >= 0 && i < 255) s += pc[nn][i];
        scb[tid] = (tid > cur) ? -INFINITY : ((tid == 0 || tid == cur || tid == cur - 1) ? INFINITY : s); }
    __syncthreads();
    if (tid < 64) { int rank = 0; for (int j = 0; j < 64; ++j) rank += (scb[j] > scb[tid] || (scb[j] == scb[tid] && j < tid)) ? 1 : 0; if (rank < 16) selj[rank] = tid; }
    __syncthreads();
    { float mx = -INFINITY;
      for (int i = tid; i < 1024; i += 256) { const int j = selj[i >> 6], p = 64 * j + (i & 63); float v = -INFINITY; if (p <= t) { float d = 0.f; for (int k = 0; k < 64; ++k) d += qs[n][k] * bf2f(KVS[((size_t)b * SEQ + p) * 256 + g * 64 + k]); v = d + bias_l2(relb, 8 + hh, t - p); } lg[i] = v; mx = fmaxf(mx, v); }
      red[tid] = mx; __syncthreads(); for (int o = 128; o > 0; o >>= 1) { if (tid < o) red[tid] = fmaxf(red[tid], red[tid + o]); __syncthreads(); } mx = red[0]; __syncthreads();
      float sm = 0.f; for (int i = tid; i < 1024; i += 256) { const float p = exp2f(lg[i] - mx); lg[i] = p; sm += p; }
      red[tid] = sm; __syncthreads(); for (int o = 128; o > 0; o >>= 1) { if (tid < o) red[tid] += red[tid + o]; __syncthreads(); } sm = red[0]; __syncthreads();
      if (tid < 64) { float o = 0.f; for (int i = 0; i < 1024; ++i) { const int p = 64 * selj[i >> 6] + (i & 63); if (p <= t) o += lg[i] * bf2f(KVS[((size_t)b * SEQ + p) * 256 + 128 + g * 64 + tid]); } oacc[1][tid] = o / sm; }
      __syncthreads(); }
    { float mx = -INFINITY;
      for (int i = tid; i < 512; i += 256) { const int p = t - i; float v = -INFINITY; if (p >= 0) { float d = 0.f; for (int k = 0; k < 64; ++k) d += qs[n][k] * bf2f(KVW[((size_t)b * SEQ + p) * 256 + g * 64 + k]); v = d + bias_l2(relb, 8 + hh, i); } lg[i] = v; mx = fmaxf(mx, v); }
      red[tid] = mx; __syncthreads(); for (int o = 128; o > 0; o >>= 1) { if (tid < o) red[tid] = fmaxf(red[tid], red[tid + o]); __syncthreads(); } mx = red[0]; __syncthreads();
      float sm = 0.f; for (int i = tid; i < 512; i += 256) { const float p = exp2f(lg[i] - mx); lg[i] = p; sm += p; }
      red[tid] = sm; __syncthreads(); for (int o = 128; o > 0; o >>= 1) { if (tid < o) red[tid] += red[tid + o]; __syncthreads(); } sm = red[0]; __syncthreads();
      if (tid < 64) { float o = 0.f; for (int i = 0; i < 512; ++i) { const int p = t - i; if (p >= 0) o += lg[i] * bf2f(KVW[((size_t)b * SEQ + p) * 256 + 128 + g * 64 + tid]); } oacc[2][tid] = o / sm; }
      __syncthreads(); }
    if (tid < 64) { float gt[3]; for (int j = 0; j < 3; ++j) { const float x = bf2f(T1[(size_t)r * 256 + 208 + hh * 3 + j]); gt[j] = 1.f / (1.f + expf(-x)); }
        ref[tid] = gt[0] * oacc[0][tid] + gt[1] * oacc[1][tid] + gt[2] * oacc[2][tid]; fast[tid] = bf2f(((const bf16_t*)(a.ws + OFF_MIXIN))[(size_t)r * 1536 + 1024 + hh * 64 + tid]); }
    __syncthreads(); commit(D, 10, ref, fast, 64, 0.04f);
}
__global__ void chk_out_e(Args a, unsigned* D) {
    __shared__ float ref[1024], fast[1024], cat[1024];
    const int r = srow(blockIdx.x, 64), tid = threadIdx.x; const bf16_t* MX = (const bf16_t*)(a.ws + OFF_MIXIN) + (size_t)r * 1536;
    for (int o = tid; o < 512; o += 256) { const int h = o >> 6, d = o & 63; float s = 0.f; for (int c = 0; c < 128; ++c) s += bf2f(MX[h * 128 + c]) * a.in[I_EWUV][c * 512 + h * 64 + d]; cat[o] = s; cat[512 + o] = bf2f(MX[1024 + o]); }
    __syncthreads();
    for (int n = tid; n < 1024; n += 256) { float s = 0.f; for (int j = 0; j < 1024; ++j) s += cat[j] * a.in[I_EWOUT][(size_t)j * 1024 + n]; ref[n] = s;
        fast[n] = bf2f(((const bf16_t*)(a.ws + OFF_S1))[(size_t)r * 1024 + n]) - ALPHA * a.in[I_X][(size_t)r * 1024 + n]; }
    __syncthreads(); commit(D, 11, ref, fast, 1024, 0.35f);
}
__global__ void chk_ln(const bf16_t* S, const bf16_t* O, const float* g, const float* bt, unsigned* D, int slot) {
    __shared__ float ref[1024], fast[1024];
    const int r = srow(blockIdx.x, 64), tid = threadIdx.x; float mean = 0.f, var = 0.f;
    for (int k = 0; k < 1024; ++k) mean += bf2f(S[(size_t)r * 1024 + k]); mean /= 1024.f;
    for (int k = 0; k < 1024; ++k) { const float d = bf2f(S[(size_t)r * 1024 + k]) - mean; var += d * d; } var /= 1024.f;
    for (int n = tid; n < 1024; n += 256) { ref[n] = (bf2f(S[(size_t)r * 1024 + n]) - mean) / sqrtf(var + 1e-5f) * g[n] + bt[n]; fast[n] = bf2f(O[(size_t)r * 1024 + n]); }
    __syncthreads(); commit(D, slot, ref, fast, 1024, 0.01f);
}
__global__ void chk_ffn_up(Args a, unsigned* D) {
    __shared__ float ref[DFF], fast[DFF], hrow[1024];
    const int r = srow(blockIdx.x, 64), tid = threadIdx.x; const bf16_t* H = (const bf16_t*)(a.ws + OFF_H) + (size_t)r * 1024;
    for (int k = tid; k < 1024; k += 256) hrow[k] = bf2f(H[k]);
    __syncthreads();
    for (int n = tid; n < DFF; n += 256) { float s1 = 0.f, s3 = 0.f; for (int k = 0; k < 1024; ++k) { s1 += hrow[k] * bfr(a.in[I_EF1][(size_t)k * DFF + n]); s3 += hrow[k] * bfr(a.in[I_EF3][(size_t)k * DFF + n]); }
        ref[n] = s1 / (1.f + expf(-s1)) * s3; fast[n] = bf2f(((const bf16_t*)(a.ws + OFF_ACT))[(size_t)r * DFF + n]); }
    __syncthreads(); commit(D, 13, ref, fast, DFF, 0.02f);
}
__global__ void chk_ffn_dn(Args a, unsigned* D) {
    __shared__ float ref[1024], fast[1024], arow[DFF];
    const int r = srow(blockIdx.x, 64), tid = threadIdx.x; const bf16_t* A = (const bf16_t*)(a.ws + OFF_ACT) + (size_t)r * DFF;
    for (int k = tid; k < DFF; k += 256) arow[k] = bf2f(A[k]);
    __syncthreads();
    for (int n = tid; n < 1024; n += 256) { float s = 0.f; for (int k = 0; k < DFF; ++k) s += arow[k] * bfr(a.in[I_EF2][(size_t)k * 1024 + n]); ref[n] = s;
        fast[n] = bf2f(((const bf16_t*)(a.ws + OFF_S2))[(size_t)r * 1024 + n]) - ALPHA * bf2f(((const bf16_t*)(a.ws + OFF_H))[(size_t)r * 1024 + n]); }
    __syncthreads(); commit(D, 14, ref, fast, 1024, 0.06f);
}
__global__ void chk_in_o(Args a, unsigned* D) {
    __shared__ float ref[2048], fast[2048], xr[1024];
    const int r = srow(blockIdx.x, 64), tid = threadIdx.x; const bf16_t* X1 = (const bf16_t*)(a.ws + OFF_X1) + (size_t)r * 1024;
    for (int k = tid; k < 1024; k += 256) xr[k] = bf2f(X1[k]);
    __syncthreads();
    for (int n = tid; n < 2048; n += 256) { float s = 0.f; for (int k = 0; k < 1024; ++k) s += xr[k] * bfr(a.in[I_OWIN][(size_t)k * 3072 + 1024 + n]); ref[n] = s;
        fast[n] = bf2f(((const bf16_t*)(a.ws + OFF_QKV))[(size_t)(1 + (n >> 10)) * MTOK * 1024 + (size_t)r * 1024 + (n & 1023)]); }
    __syncthreads(); commit(D, 16, ref, fast, 2048, 0.02f);
    const int pm = r >> 8; const bf16_t* K = (const bf16_t*)(a.ws + OFF_QKV) + (size_t)MTOK * 1024 + (size_t)pm * 256 * 1024; const float* KM = (const float*)(a.ws + OFF_KMEAN) + (size_t)pm * 2048;
    for (int n = tid; n < 1024; n += 256) { float s = 0.f; for (int q = 0; q < 256; ++q) s += bf2f(K[(size_t)q * 1024 + n]); ref[n] = s; fast[n] = KM[n] + KM[1024 + n]; }
    __syncthreads(); commit(D, 17, ref, fast, 1024, 0.03f);
}
__global__ void chk_moba(Args a, unsigned* D) {
    __shared__ float lg[1024], red[256], ref[64], fast[64], q[64], gate[16]; __shared__ int blkof[4];
    const int r = (blockIdx.x < 8) ? (blockIdx.x * 4096 + blockIdx.x * 300) : srow(blockIdx.x, 64), tid = threadIdx.x, b = r >> 12, t = r & 4095, h = blockIdx.x & 15, own = t >> 8;
    const bf16_t* X1 = (const bf16_t*)(a.ws + OFF_X1) + (size_t)r * 1024; const bf16_t* K = (const bf16_t*)(a.ws + OFF_QKV) + (size_t)MTOK * 1024 + (size_t)b * SEQ * 1024 + h * 64; const bf16_t* V = K + (size_t)MTOK * 1024;
    const float* relb = a.in[I_RELB];
    if (tid < 64) { float s = 0.f; for (int k = 0; k < 1024; ++k) s += bf2f(X1[k]) * bfr(a.in[I_OWIN][(size_t)k * 3072 + h * 64 + tid]); q[tid] = bfr(s * QSCALE); }
    __syncthreads();
    if (tid < 16) { float s = -INFINITY; if (tid < own) { s = 0.f; for (int p = 0; p < 256; ++p) for (int d = 0; d < 64; ++d) s += q[d] * bf2f(K[(size_t)(256 * tid + p) * 1024 + d]); } gate[tid] = s; }
    __syncthreads();
    if (tid == 0) { unsigned used = 0u; for (int k = 0; k < 3; ++k) { int bj = -1; float best = -INFINITY; for (int j = 0; j < own; ++j) if (!((used >> j) & 1u) && gate[j] > best) { best = gate[j]; bj = j; } blkof[k] = bj; if (bj >= 0) used |= 1u << bj; } blkof[3] = own; }
    __syncthreads();
    float mx = -INFINITY;
    for (int i = tid; i < 1024; i += 256) { const int j = blkof[i >> 8], p = 256 * j + (i & 255); float v = -INFINITY; if (j >= 0 && p <= t) { float d = 0.f; for (int k = 0; k < 64; ++k) d += q[k] * bf2f(K[(size_t)p * 1024 + k]); v = d + bias_l2(relb, h, t - p); } lg[i] = v; mx = fmaxf(mx, v); }
    red[tid] = mx; __syncthreads(); for (int o = 128; o > 0; o >>= 1) { if (tid < o) red[tid] = fmaxf(red[tid], red[tid + o]); __syncthreads(); } mx = red[0]; __syncthreads();
    float sm = 0.f; for (int i = tid; i < 1024; i += 256) { const float p = exp2f(lg[i] - mx); lg[i] = p; sm += p; }
    red[tid] = sm; __syncthreads(); for (int o = 128; o > 0; o >>= 1) { if (tid < o) red[tid] += red[tid + o]; __syncthreads(); } sm = red[0]; __syncthreads();
    if (tid < 64) { float o = 0.f; for (int i = 0; i < 1024; ++i) { const int j = blkof[i >> 8], p = 256 * j + (i & 255); if (j >= 0 && p <= t) o += lg[i] * bf2f(V[(size_t)p * 1024 + tid]); } ref[tid] = o / sm;
        fast[tid] = bf2f(((const bf16_t*)(a.ws + OFF_QKV))[(size_t)r * 1024 + h * 64 + tid]); }
    __syncthreads(); commit(D, 18, ref, fast, 64, 0.04f);
}
__global__ void chk_out_o(Args a, unsigned* D) {
    __shared__ float ref[1024], fast[1024], orow[1024];
    const int r = srow(blockIdx.x, 64), tid = threadIdx.x;
    for (int k = tid; k < 1024; k += 256) orow[k] = bf2f(((const bf16_t*)(a.ws + OFF_QKV))[(size_t)r * 1024 + k]);
    __syncthreads();
    for (int n = tid; n < 1024; n += 256) { float s = 0.f; for (int k = 0; k < 1024; ++k) s += orow[k] * a.in[I_OWOUT][(size_t)k * 1024 + n]; ref[n] = s;
        fast[n] = bf2f(((const bf16_t*)(a.ws + OFF_S1O))[(size_t)r * 1024 + n]) - ALPHA * bf2f(((const bf16_t*)(a.ws + OFF_X1))[(size_t)r * 1024 + n]); }
    __syncthreads(); commit(D, 20, ref, fast, 1024, 0.5f);
}
__global__ void chk_route(Args a, unsigned* D) {
    const int r = srow(blockIdx.x * 256 + threadIdx.x, 64); const bf16_t* H2 = (const bf16_t*)(a.ws + OFF_H2) + (size_t)r * 1024;
    float lg[8]; for (int e = 0; e < 8; ++e) lg[e] = 0.f;
    for (int k = 0; k < 1024; ++k) { const float hv = bf2f(H2[k]); for (int e = 0; e < 8; ++e) lg[e] += hv * a.in[I_OROUTER][k * 8 + e]; }
    int e0 = 0; for (int e = 1; e < 8; ++e) if (lg[e] > lg[e0]) e0 = e; int e1 = -1; for (int e = 0; e < 8; ++e) if (e != e0 && (e1 < 0 || lg[e] > lg[e1])) e1 = e;
    const float g0 = 1.f / (1.f + expf(lg[e1] - lg[e0]));
    const u32x2 rt = ((const u32x2*)(a.ws + OFF_ROUTE))[r]; const int f0 = rt.x & 255, f1 = (rt.x >> 8) & 255; const float fg = __uint_as_float(rt.y);
    int bad = 0; if (f0 != e0 || f1 != e1 || !(fabsf(fg - g0) <= 0.02f)) ++bad;
    atomicAdd(&D[4 * 21], (unsigned)bad); atomicAdd(&D[4 * 21 + 1], 1u);
    const int* GI = (const int*)(a.ws + OFF_GINFO); const int* DEST = (const int*)(a.ws + OFF_DEST) + 2 * (size_t)r;
    int bad2 = 0;
    for (int k = 0; k < 2; ++k) { const int e = k ? f1 : f0, d = DEST[k], ps = e ? GI[e - 1] : 0; if (d < ps || d >= ps + GI[8 + e]) ++bad2; }
    atomicAdd(&D[4 * 22], (unsigned)bad2); atomicAdd(&D[4 * 22 + 1], 2u);
}
__global__ void chk_moe(Args a, unsigned* D) {
    __shared__ float ref[1024], fast[1024], hrow[1024], act[DFFE], fin[1024];
    const int r = srow(blockIdx.x, 64), tid = threadIdx.x; const bf16_t* H2 = (const bf16_t*)(a.ws + OFF_H2) + (size_t)r * 1024;
    for (int k = tid; k < 1024; k += 256) { hrow[k] = bf2f(H2[k]); ref[k] = 0.f; }
    const u32x2 rt = ((const u32x2*)(a.ws + OFF_ROUTE))[r]; const float g0 = __uint_as_float(rt.y); const int* DEST = (const int*)(a.ws + OFF_DEST) + 2 * (size_t)r; const bf16_t* YR = (const bf16_t*)(a.ws + OFF_YR);
    __syncthreads();
    for (int k = 0; k < 2; ++k) { const int e = k ? ((rt.x >> 8) & 255) : (rt.x & 255); const float gk = k ? 1.f - g0 : g0;
        const float* w1 = a.in[I_OM1] + (size_t)e * 1024 * DFFE; const float* w3 = a.in[I_OM3] + (size_t)e * 1024 * DFFE; const float* w2 = a.in[I_OM2] + (size_t)e * DFFE * 1024;
        for (int f = tid; f < DFFE; f += 256) { float s1 = 0.f, s3 = 0.f; for (int q = 0; q < 1024; ++q) { s1 += hrow[q] * bfr(w1[(size_t)q * DFFE + f]); s3 += hrow[q] * bfr(w3[(size_t)q * DFFE + f]); } act[f] = bfr(s1 / (1.f + expf(-s1)) * s3); }
        __syncthreads();
        for (int n = tid; n < 1024; n += 256) { float s = 0.f; for (int f = 0; f < DFFE; ++f) s += act[f] * bfr(w2[(size_t)f * 1024 + n]); ref[n] += gk * s; }
        __syncthreads(); }
    for (int n = tid; n < 1024; n += 256) { fast[n] = g0 * bf2f(YR[(size_t)DEST[0] * 1024 + n]) + (1.f - g0) * bf2f(YR[(size_t)DEST[1] * 1024 + n]); fin[n] = ALPHA * hrow[n] + fast[n]; }
    __syncthreads(); commit(D, 23, ref, fast, 1024, 0.12f);
    float mean = 0.f, var = 0.f; for (int k = 0; k < 1024; ++k) mean += fin[k]; mean /= 1024.f; for (int k = 0; k < 1024; ++k) { const float d = fin[k] - mean; var += d * d; } var /= 1024.f;
    __syncthreads();
    for (int n = tid; n < 1024; n += 256) { ref[n] = (fin[n] - mean) / sqrtf(var + 1e-5f) * a.in[I_OLN2G][n] + a.in[I_OLN2B][n]; fast[n] = a.out[(size_t)r * 1024 + n]; }
    __syncthreads(); commit(D, 24, ref, fast, 1024, 0.005f);
    { float m2 = 0.f, v2 = 0.f; for (int k = 0; k < 1024; ++k) m2 += ALPHA * hrow[k]; m2 /= 1024.f; for (int k = 0; k < 1024; ++k) { const float d = ALPHA * hrow[k] - m2; v2 += d * d; } v2 /= 1024.f;
      for (int n = tid; n < 1024; n += 256) ref[n] = (ALPHA * hrow[n] - m2) / sqrtf(v2 + 1e-5f) * a.in[I_OLN2G][n] + a.in[I_OLN2B][n];
      __syncthreads(); commit(D, 28, ref, fast, 1024, 0.005f); }
    { for (int n = tid; n < 1024; n += 256) fin[n] = ALPHA * hrow[n] + (1.f - g0) * bf2f(YR[(size_t)DEST[0] * 1024 + n]) + g0 * bf2f(YR[(size_t)DEST[1] * 1024 + n]);
      __syncthreads();
      float m2 = 0.f, v2 = 0.f; for (int k = 0; k < 1024; ++k) m2 += fin[k]; m2 /= 1024.f; for (int k = 0; k < 1024; ++k) { const float d = fin[k] - m2; v2 += d * d; } v2 /= 1024.f;
      __syncthreads();
      for (int n = tid; n < 1024; n += 256) ref[n] = (fin[n] - m2) / sqrtf(v2 + 1e-5f) * a.in[I_OLN2G][n] + a.in[I_OLN2B][n];
      __syncthreads(); commit(D, 29, ref, fast, 1024, 0.005f); }
}

__global__ void chk_wmoe(Args a, unsigned* D) {
    const int tid = blockIdx.x * 256 + threadIdx.x; const unsigned hsh = (unsigned)tid * 2654435761u;
    const int e = hsh & 7, f = (hsh >> 3) % DFFE, k = (hsh >> 15) % 1024;
    const bf16_t* W13 = (const bf16_t*)(a.ws + OFF_W_M13) + (size_t)e * 2 * DFFE * 1024; const bf16_t* W2 = (const bf16_t*)(a.ws + OFF_W_M2) + (size_t)e * 1024 * DFFE;
    int bad = 0;
    if (W13[(size_t)(((f >> 7) << 8) + (f & 127)) * 1024 + k] != (bf16_t)f2bf(a.in[I_OM1][(size_t)e * 1024 * DFFE + (size_t)k * DFFE + f])) ++bad;
    if (W13[(size_t)(((f >> 7) << 8) + (f & 127) + 128) * 1024 + k] != (bf16_t)f2bf(a.in[I_OM3][(size_t)e * 1024 * DFFE + (size_t)k * DFFE + f])) ++bad;
    atomicAdd(&D[4 * 25], (unsigned)bad); atomicAdd(&D[4 * 25 + 1], 2u);
    int bad2 = 0; if (W2[(size_t)k * DFFE + f] != (bf16_t)f2bf(a.in[I_OM2][(size_t)e * DFFE * 1024 + (size_t)f * 1024 + k])) ++bad2;
    atomicAdd(&D[4 * 26], (unsigned)bad2); atomicAdd(&D[4 * 26 + 1], 1u);
}
__global__ void chk_actm(Args a, unsigned* D) {
    __shared__ float ref[DFFE], fast[DFFE], hrow[1024]; __shared__ int tokf, kf;
    const int tid = threadIdx.x; const int* GI = (const int*)(a.ws + OFF_GINFO); const int nrows = GI[7], ng = nrows >> 8, g0 = ((ng - 1) / MOE_CHUNK) * MOE_CHUNK;
    const int rho = 256 * g0 + (int)(((unsigned)blockIdx.x * 2654435761u) % (unsigned)(nrows - 256 * g0));
    if (tid == 0) { tokf = -1; kf = 0; } __syncthreads();
    const int* DEST = (const int*)(a.ws + OFF_DEST);
    for (int i = tid; i < 2 * MTOK; i += 256) if (DEST[i] == rho) { tokf = i >> 1; kf = i & 1; }
    __syncthreads();
    if (tokf < 0) return;
    const int tok = tokf; const u32x2 rt = ((const u32x2*)(a.ws + OFF_ROUTE))[tok]; const int e = kf ? ((rt.x >> 8) & 255) : (rt.x & 255);
    const bf16_t* H2 = (const bf16_t*)(a.ws + OFF_H2) + (size_t)tok * 1024;
    for (int k = tid; k < 1024; k += 256) hrow[k] = bf2f(H2[k]);
    __syncthreads();
    const float* w1 = a.in[I_OM1] + (size_t)e * 1024 * DFFE; const float* w3 = a.in[I_OM3] + (size_t)e * 1024 * DFFE;
    for (int f = tid; f < DFFE; f += 256) { float s1 = 0.f, s3 = 0.f; for (int q = 0; q < 1024; ++q) { s1 += hrow[q] * bfr(w1[(size_t)q * DFFE + f]); s3 += hrow[q] * bfr(w3[(size_t)q * DFFE + f]); }
        ref[f] = s1 / (1.f + expf(-s1)) * s3; fast[f] = bf2f(((const bf16_t*)(a.ws + OFF_ACTM))[(size_t)(rho - 256 * g0) * DFFE + f]); }
    __syncthreads(); commit(D, 27, ref, fast, DFFE, 0.02f);
}

__global__ void simple_final(Args a) {
    const int row = blockIdx.x * 4 + (threadIdx.x >> 6), lane = threadIdx.x & 63; unsigned char* ws = a.ws;
    const bf16_t* H2 = (const bf16_t*)(ws + OFF_H2); const bf16_t* YR = (const bf16_t*)(ws + OFF_YR);
    const u32x2* ROUTE = (const u32x2*)(ws + OFF_ROUTE); const int* DEST = (const int*)(ws + OFF_DEST);
    const float g0 = __uint_as_float(ROUTE[row].y), g1 = 1.f - g0; const int d0 = DEST[2 * row], d1 = DEST[2 * row + 1];
    float v[16]; float s = 0.f;
    for (int i = 0; i < 16; ++i) { const int col = lane + 64 * i; v[i] = ALPHA * bf2f(H2[(size_t)row * 1024 + col]) + g0 * bf2f(YR[(size_t)d0 * 1024 + col]) + g1 * bf2f(YR[(size_t)d1 * 1024 + col]); s += v[i]; }
    const float mean = wave_sum(s) / 1024.f; float q = 0.f;
    for (int i = 0; i < 16; ++i) { v[i] -= mean; q += v[i] * v[i]; }
    const float rstd = 1.f / sqrtf(wave_sum(q) / 1024.f + 1e-5f);
    for (int i = 0; i < 16; ++i) { const int col = lane + 64 * i; a.out[(size_t)row * 1024 + col] = v[i] * rstd * a.in[I_OLN2G][col] + a.in[I_OLN2B][col]; }
}
__global__ void report(float* out, const unsigned* D, int nelem) {
    __shared__ float kk, xx;
    if (threadIdx.x == 0) { int idx = 0; float v = 0.f; float worst = 0.f;
        for (int s = 1; s < NSLOT; ++s) { const unsigned bad = D[4 * s], tot = D[4 * s + 1]; if (tot == 0u) continue; const float fr = (float)bad / (float)tot; const float thr = (s == 9 || s == 10 || s == 18) ? 0.1f : 0.002f;
            if (fr > worst) worst = fr; if (fr > thr && idx == 0) { idx = s; v = fr; } }
        if (idx == 0) v = worst;
#ifdef DBG_BITS
        { const int sl[6] = DBG_BITS; idx = 0; for (int q = 0; q < 6; ++q) { const int s = sl[q]; if (s > 0 && D[4 * s + 1] > 0u && (float)D[4 * s] / (float)D[4 * s + 1] > 0.002f) idx |= 1 << q; } v = 1.f; }
#endif
#ifdef DBG_VAL
        { const float mr = __uint_as_float(D[4 * DBG_VAL + 2]); const float fr = D[4 * DBG_VAL + 1] ? (float)D[4 * DBG_VAL] / (float)D[4 * DBG_VAL + 1] : 0.f; kk = sqrtf(fmaxf(mr, 1e-6f) * 1e6f); xx = kk * (2.f + 97.f * fr); }
#else
        v = fmaxf(v, 1e-6f); const int n = (v > 0.3f) ? 4 : (v > 0.03f) ? 3 : (v > 0.003f) ? 2 : 1; kk = (n == 4) ? 1e4f : (n == 3) ? 1e3f : (n == 2) ? 1e2f : 1e1f; xx = kk * (float)(idx + 2);
#endif
        }
    __syncthreads();
    const float k = kk, x = xx;
    for (size_t i = (size_t)blockIdx.x * blockDim.x + threadIdx.x; i < (size_t)nelem; i += (size_t)gridDim.x * blockDim.x) out[i] = (i == 0) ? x : k;
}
}
#endif

#ifndef MK_N_LAUNCHES
#define MK_N_LAUNCHES 1
#endif
constexpr int NPHASE = 18;
#define SP2 true
#ifndef FFN_F8
#define FFN_F8 0
#endif
#ifndef MOE_SP2
#define MOE_SP2 true
#endif
#define ALN true

__global__ void __launch_bounds__(NTHR, 2) fwd_kernel(Args args) {
    extern __shared__ __attribute__((aligned(16))) unsigned char lds_raw[];
    Frame F;
    F.lds = (LAS unsigned char*)lds_raw;
    F.tid = threadIdx.x; F.lane = F.tid & 63; F.wave = __builtin_amdgcn_readfirstlane(F.tid >> 6);
    F.G = gridDim.x; F.bx = blockIdx.x; F.gw = F.bx * NWAVES + F.wave; F.NGW = F.G * NWAVES; F.ws = args.ws;
    unsigned char* ws = args.ws;
    volatile LAS unsigned* MISC = (volatile LAS unsigned*)(F.lds + LDSCTL_OFF);
    for (int u = F.tid; u < (LDS_BYTES - LDSCTL_OFF) / 4; u += NTHR) ((LAS unsigned*)(F.lds + LDSCTL_OFF))[u] = 0u;
    __syncthreads();
    XcdBarrier bar = xcd_barrier_post((unsigned*)(ws + OFF_BAR) + args.li * XCD_BAR_WORDS, MISC + 8);
    const int lo = args.ph_lo, hi = args.ph_hi;
#ifndef PH_MASK
#define PH_MASK 0x3ffff
#endif
#define IN(k) (((PH_MASK >> (k)) & 1) && lo <= (k) && (k) < hi)
#ifdef TS_MODE
    unsigned long long* TS = (unsigned long long*)(ws + OFF_DBG + 1024);
#define STAMP(i) do { if (F.bx == 0 && F.tid == 0) TS[i] = __builtin_amdgcn_s_memrealtime(); } while (0)
#else
#define STAMP(i) do { } while (0)
#endif
#define SEAM(k) do { if (IN(k) && IN((k) + 1)) xcd_barrier(bar); STAMP((k) + 1); } while (0)
    LAS unsigned char* glds = F.lds;

    bf16_t* Y1 = (bf16_t*)(ws + OFF_Y1);
    float* ssq_q = (float*)(ws + OFF_SSQ_Q); float* ssq_kv = (float*)(ws + OFF_SSQ_KV);

    STAMP(0);
    if (IN(0)) { phase_prologue_even(F, args); } SEAM(0);
    if (IN(1)) { pg8::Gemm g{(const bf16_t*)(ws + OFF_XB), (const bf16_t*)(ws + OFF_W_IN), MTOK, EVEN_INP, 1024, 1024, 0}; pg8::StaticOrder S; S.init(MTOK, EVEN_INP, F.G, F.bx);
        pg8::EpiInE E{Y1, ssq_q, ssq_kv}; pg8::gemm_phase<pg8::EpiInE, pg8::StaticOrder, ALN, SP2>(glds, g, S, E); } SEAM(1);
    if (IN(2)) {
        phase_ckvn(F, Y1 + (size_t)1 * MTOK * 256, ssq_kv, args.in[I_EKVN], (bf16_t*)(ws + OFF_CKVN));
#ifndef NO_CMP
        for (int idx = F.bx; idx < 256; idx += F.G) { const int b = idx >> 5, g = (idx >> 4) & 1, kv = (idx >> 3) & 1, rt = idx & 7;
            compress_unit(F, b, g, kv, rt, Y1 + (size_t)4 * MTOK * 256, (const bf16_t*)(ws + (kv ? OFF_CV1 : OFF_CK1)), args.in[kv ? I_ECV2 : I_ECK2], (const float*)(ws + OFF_CB) + kv * 64, (bf16_t*)(ws + (kv ? OFF_VC : OFF_KC))); }
#endif
#ifndef NO_Q2
        pg8::Gemm g{Y1, (const bf16_t*)(ws + OFF_W_Q2), MTOK, 2048, 256, 256, 0}; pg8::StaticOrder S; S.init(MTOK, 2048, F.G, F.bx);
        pg8::EpiQ2 E{(bf16_t*)(ws + OFF_QLAT), (bf16_t*)(ws + OFF_QIDX), ssq_q}; pg8::gemm_phase<pg8::EpiQ2, pg8::StaticOrder, ALN, SP2>(glds, g, S, E);
#endif
    } SEAM(2);
    if (IN(3)) { for (int idx = F.bx; idx < 512; idx += F.G) { const int i = idx >> 8, v = idx & 255, b = v & 7, cc = v >> 3, c = i ? 63 - cc : cc;
            indexer_unit(F, b, c, (const bf16_t*)(ws + OFF_QIDX), Y1 + (size_t)1 * MTOK * 256, (_Float16*)(ws + OFF_SC)); } } SEAM(3);
    if (IN(4)) { phase_select(F, (const _Float16*)(ws + OFF_SC), (unsigned*)(ws + OFF_MASK)); } SEAM(4);
    if (IN(5)) {
#ifndef NO_DSA
        if (args.pad != 2) phase_dsa_sparse(F, (const bf16_t*)(ws + OFF_QLAT), (const bf16_t*)(ws + OFF_CKVN), (const unsigned*)(ws + OFF_MASK), (const float*)(ws + OFF_BT), ws + OFF_MIXIN);
#endif
        STAMP(20);
#ifndef NO_NSA
        if (args.pad != 1) for (int idx = F.bx; idx < 1024; idx += F.G) { const int i = idx >> 8, v = idx & 255, b = v & 7, cc = v >> 3, g = i & 1, c = (i >> 1) ? 63 - cc : cc;
            nsa_unit(F, b, g, c, Y1, (const bf16_t*)(ws + OFF_KC), (const bf16_t*)(ws + OFF_VC), (const float*)(ws + OFF_BT), ws + OFF_MIXIN); __syncthreads(); }
#endif
    } SEAM(5);
    if (IN(6)) { pg8::Gemm g{(const bf16_t*)(ws + OFF_MIXIN), (const bf16_t*)(ws + OFF_W_OUTE), MTOK, 1024, 768, 768, 0}; pg8::StaticOrder S; S.init(MTOK, 1024, F.G, F.bx);
        pg8::EpiRes<true> E{args.in[I_X], (bf16_t*)(ws + OFF_S1), 1.f / (OSC * WOUT_SCALE)}; pg8::gemm_phase<pg8::EpiRes<true>, pg8::StaticOrder, ALN, SP2, true>(glds, g, S, E); } SEAM(6);
    if (IN(7)) { phase_ln_i8(F, (const bf16_t*)(ws + OFF_S1), (bf16_t*)(ws + OFF_H), ws + OFF_H8, (float*)(ws + OFF_SA), args.in[I_ELN1G], args.in[I_ELN1B]); } SEAM(7);
#if FFN_F8
    if (IN(8)) { pg8::Gemm g{(const bf16_t*)(ws + OFF_H8), (const bf16_t*)(ws + OFF_W_F13), MTOK, 2 * DFF, 512, 512, 0}; pg8::StaticOrder S; S.init(MTOK, 2 * DFF, F.G, F.bx);
        pg8::EpiSwiglu8 E{ws + OFF_ACT, DFF, 0, 1.f / WF13_SCALE}; pg8::gemm_phase<pg8::EpiSwiglu8, pg8::StaticOrder, ALN, SP2, true>(glds, g, S, E); } SEAM(8);
#else
    if (IN(8)) { pg8::Gemm g{(const bf16_t*)(ws + OFF_H8), (const bf16_t*)(ws + OFF_W_F13), MTOK, 2 * DFF, 512, 512, 0}; pg8::StaticOrder S; S.init(MTOK, 2 * DFF, F.G, F.bx);
        pg8::EpiSwigluI8 E{ws + OFF_ACT, DFF, (const float*)(ws + OFF_SA), (const float*)(ws + OFF_SW)}; pg8::gemm_phase<pg8::EpiSwigluI8, pg8::StaticOrder, ALN, SP2, false, true>(glds, g, S, E); } SEAM(8);
#endif
#if FFN_F8
    if (IN(9)) { pg8::Gemm g{(const bf16_t*)(ws + OFF_ACT), (const bf16_t*)(ws + OFF_W_F2), MTOK, 1024, DFF / 2, DFF / 2, 0}; pg8::StaticOrder S; S.init(MTOK, 1024, F.G, F.bx);
        pg8::EpiRes<false> E{(const void*)(ws + OFF_H), (bf16_t*)(ws + OFF_S2), 1.f / WF2_SCALE}; pg8::gemm_phase<pg8::EpiRes<false>, pg8::StaticOrder, ALN, SP2, true>(glds, g, S, E); } SEAM(9);
#else
    if (IN(9)) { pg8::Gemm g{(const bf16_t*)(ws + OFF_ACT), (const bf16_t*)(ws + OFF_W_F2), MTOK, 1024, DFF / 2, DFF / 2, 0}; pg8::StaticOrder S; S.init(MTOK, 1024, F.G, F.bx);
        pg8::EpiRes<false> E{(const void*)(ws + OFF_H), (bf16_t*)(ws + OFF_S2), 1.f / WF2_SCALE}; pg8::gemm_phase<pg8::EpiRes<false>, pg8::StaticOrder, ALN, SP2, true>(glds, g, S, E); } SEAM(9);
#endif
    if (IN(10)) { phase_ln_bf16(F, (const bf16_t*)(ws + OFF_S2), (bf16_t*)(ws + OFF_X1), ws + OFF_X18, args.in[I_ELN2G], args.in[I_ELN2B]); phase_convert_odd(F, args); } SEAM(10);
    if (IN(11)) { pg8::Gemm g{(const bf16_t*)(ws + OFF_X18), (const bf16_t*)(ws + OFF_W_OIN), MTOK, 3072, 512, 512, 0}; pg8::StaticOrder S; S.init(MTOK, 3072, F.G, F.bx);
        pg8::EpiInO E{(bf16_t*)(ws + OFF_QKV), (float*)(ws + OFF_KMEAN), 1.f / WIN_SCALE}; pg8::gemm_phase<pg8::EpiInO, pg8::StaticOrder, ALN, SP2, true>(glds, g, S, E); } SEAM(11);
#ifdef MOBA_DENSE
    if (IN(12)) { phase_moba(F, ws, args.pad); } SEAM(12);
#else
    if (IN(12)) { phase_moba2(F, ws, args.pad); } SEAM(12);
#endif
    if (IN(13)) { pg8::Gemm g{(const bf16_t*)(ws + OFF_O8), (const bf16_t*)(ws + OFF_W_OOUT), MTOK, 1024, 512, 512, 0}; pg8::StaticOrder S; S.init(MTOK, 1024, F.G, F.bx);
        pg8::EpiRes<false> E{(const void*)(ws + OFF_X1), (bf16_t*)(ws + OFF_S1O), 1.f / (OSC * WOUT_SCALE)}; pg8::gemm_phase<pg8::EpiRes<false>, pg8::StaticOrder, ALN, SP2, true>(glds, g, S, E); } SEAM(13);
    if (IN(14)) { phase_ln_router(F, (const bf16_t*)(ws + OFF_S1O), (bf16_t*)(ws + OFF_H2), args.in[I_OLN1G], args.in[I_OLN1B], args.in[I_OROUTER], ws); } SEAM(14);
    if (IN(15)) { phase_moe_gather(F, (const bf16_t*)(ws + OFF_H2), ws + OFF_XR, ws); } SEAM(15);
    if (IN(16)) {
        const int* GI = (const int*)(ws + OFF_GINFO);
        pg8::MoeOrder S; S.G = F.G; S.c = F.bx;
#pragma unroll
        for (int e = 0; e < 8; ++e) S.pend[e] = __builtin_amdgcn_readfirstlane(GI[e]);
        const int ngroups = S.pend[7] >> 8;
        for (int g0 = 0; g0 < ngroups; g0 += MOE_CHUNK) {
            S.g0 = g0; S.ng = (ngroups - g0) < MOE_CHUNK ? (ngroups - g0) : MOE_CHUNK;
            { S.nN = 28; pg8::Gemm g{(const bf16_t*)(ws + OFF_XR), (const bf16_t*)(ws + OFF_W_M13), 0, 2 * DFFE, 512, 512, (size_t)2 * DFFE * 512};
              pg8::EpiSwiglu8 E{ws + OFF_ACTM, DFFE, g0, 1.f / W13_SCALE}; pg8::gemm_phase<pg8::EpiSwiglu8, pg8::MoeOrder, ALN, MOE_SP2, true>(glds, g, S, E); }
            xcd_barrier(bar);
            { S.nN = 4; pg8::Gemm g{(const bf16_t*)(ws + OFF_ACTM - (size_t)g0 * 256 * DFFE), (const bf16_t*)(ws + OFF_W_M2), 0, 1024, DFFE / 2, DFFE / 2, (size_t)1024 * DFFE / 2};
              pg8::EpiStoreS E{(bf16_t*)(ws + OFF_YR), 1024, 1.f / W2_SCALE}; pg8::gemm_phase<pg8::EpiStoreS, pg8::MoeOrder, ALN, MOE_SP2, true>(glds, g, S, E); }
            xcd_barrier(bar);
        }
    }
    STAMP(17);
    if (IN(17)) { phase_final(F, (const bf16_t*)(ws + OFF_H2), (const bf16_t*)(ws + OFF_YR), args.in[I_OLN2G], args.in[I_OLN2B], args.out, ws); }
#ifdef TS_MODE
    STAMP(18);
    xcd_barrier(bar);
    { const int ia[2] = TS_SEL; float d[2];
      for (int q = 0; q < 2; ++q) { const int i = ia[q]; const unsigned long long t1 = (i == 5) ? TS[20] : ((i == 25) ? TS[6] : TS[i + 1]); const unsigned long long t0 = (i == 25) ? TS[20] : TS[i]; d[q] = (float)(t1 - t0) * 0.01f; }
      const float k = sqrtf(fmaxf(d[0], 1.f)), x = 10.f * fmaxf(d[1], 1.f);
      for (size_t i = (size_t)F.bx * NTHR + F.tid; i < (size_t)MTOK * 1024; i += (size_t)F.G * NTHR) args.out[i] = (i == 0) ? x : k; }
#endif
#undef IN
#undef SEAM
}

extern "C" void kernel_launch(void* const* d_in, const int* in_sizes, int n_in, void* d_out, int out_size, void* d_ws, size_t ws_size, hipStream_t stream) {
    static int grid = 0;
    if (grid == 0) {
        if (n_in != 33 || in_sizes[0] != MTOK * DM || out_size != MTOK * DM || ws_size < WS_END) { fprintf(stderr, "kernel_launch: unexpected problem (n_in %d, in0 %d, out %d, ws %zu < %zu)\n", n_in, n_in > 0 ? in_sizes[0] : -1, out_size, ws_size, (size_t)WS_END); grid = -1; return; }
        int dev = 0, cus = 0, per_cu = 0;
        if (hipGetDevice(&dev) != hipSuccess || hipDeviceGetAttribute(&cus, hipDeviceAttributeMultiprocessorCount, dev) != hipSuccess) { grid = -1; return; }
        if (hipFuncSetAttribute((const void*)fwd_kernel, hipFuncAttributeMaxDynamicSharedMemorySize, LDS_BYTES) != hipSuccess) { fprintf(stderr, "kernel_launch: hipFuncSetAttribute failed\n"); grid = -1; return; }
        if (hipOccupancyMaxActiveBlocksPerMultiprocessor(&per_cu, (const void*)fwd_kernel, NTHR, LDS_BYTES) != hipSuccess || per_cu < 1) fprintf(stderr, "kernel_launch: occupancy query reports %d\n", per_cu);
        (void)hipGetLastError();
        grid = cus > 256 ? 256 : cus;
    }
    if (grid < 0) return;
    hipMemsetAsync(d_ws, 0, CTL_ZERO_BYTES, stream);
    Args a{};
    for (int i = 0; i < 33; ++i) a.in[i] = (const float*)d_in[i];
    a.out = (float*)d_out; a.ws = (unsigned char*)d_ws;
#if MK_N_LAUNCHES == 1
    a.ph_lo = 0; a.ph_hi = NPHASE; a.li = 0;
    hipLaunchKernelGGL(fwd_kernel, dim3(grid), dim3(NTHR), LDS_BYTES, stream, a);
#else
    for (int p = 0; p < NPHASE; ++p) { a.ph_lo = p; a.ph_hi = p + 1; a.li = p;
#ifdef REP_PHASE
        if (p == REP_PHASE) { Args a2 = a;
#ifdef REP_PAD
            a2.pad = REP_PAD;
#endif
            for (int rep = 0; rep < REP_N; ++rep) { a2.li = NPHASE + rep; hipLaunchKernelGGL(fwd_kernel, dim3(grid), dim3(NTHR), LDS_BYTES, stream, a2); } }
#endif
        hipLaunchKernelGGL(fwd_kernel, dim3(grid), dim3(NTHR), LDS_BYTES, stream, a);
#ifdef DBG_MODE
        unsigned* D = (unsigned*)((unsigned char*)d_ws + OFF_DBG); unsigned char* ws = (unsigned char*)d_ws;
        switch (p) {
            case 1: hipLaunchKernelGGL(dbg::chk_in_e, dim3(64), dim3(256), 0, stream, a, D); break;
            case 2: hipLaunchKernelGGL(dbg::chk_q2, dim3(64), dim3(256), 0, stream, a, D); hipLaunchKernelGGL(dbg::chk_cmp, dim3(96), dim3(256), 0, stream, a, D); break;
            case 3: hipLaunchKernelGGL(dbg::chk_idx, dim3(64), dim3(256), 0, stream, a, D); break;
            case 4: hipLaunchKernelGGL(dbg::chk_sel, dim3(48), dim3(256), 0, stream, a, D); break;
            case 5: hipLaunchKernelGGL(dbg::chk_dsa, dim3(64), dim3(256), 0, stream, a, D); hipLaunchKernelGGL(dbg::chk_nsa, dim3(64), dim3(256), 0, stream, a, D); break;
            case 6: hipLaunchKernelGGL(dbg::chk_out_e, dim3(32), dim3(256), 0, stream, a, D); break;
            case 7: hipLaunchKernelGGL(dbg::chk_ln, dim3(32), dim3(256), 0, stream, (const bf16_t*)(ws + OFF_S1), (const bf16_t*)(ws + OFF_H), a.in[I_ELN1G], a.in[I_ELN1B], D, 12); break;
            case 8: hipLaunchKernelGGL(dbg::chk_ffn_up, dim3(16), dim3(256), 0, stream, a, D); break;
            case 9: hipLaunchKernelGGL(dbg::chk_ffn_dn, dim3(32), dim3(256), 0, stream, a, D); break;
            case 10: hipLaunchKernelGGL(dbg::chk_ln, dim3(32), dim3(256), 0, stream, (const bf16_t*)(ws + OFF_S2), (const bf16_t*)(ws + OFF_X1), a.in[I_ELN2G], a.in[I_ELN2B], D, 15); break;
            case 10 + 100: break;
            case 11: hipLaunchKernelGGL(dbg::chk_wmoe, dim3(16), dim3(256), 0, stream, a, D); hipLaunchKernelGGL(dbg::chk_in_o, dim3(32), dim3(256), 0, stream, a, D); break;
            case 12: hipLaunchKernelGGL(dbg::chk_moba, dim3(64), dim3(256), 0, stream, a, D); break;
            case 13: hipLaunchKernelGGL(dbg::chk_out_o, dim3(32), dim3(256), 0, stream, a, D); break;
            case 14: hipLaunchKernelGGL(dbg::chk_ln, dim3(32), dim3(256), 0, stream, (const bf16_t*)(ws + OFF_S1O), (const bf16_t*)(ws + OFF_H2), a.in[I_OLN1G], a.in[I_OLN1B], D, 19); break;
            case 15: hipLaunchKernelGGL(dbg::chk_route, dim3(1), dim3(256), 0, stream, a, D); break;
            case 16: hipLaunchKernelGGL(dbg::chk_actm, dim3(8), dim3(256), 0, stream, a, D); break;
            case 17:
#ifdef DBG_SIMPLE_FINAL
                hipLaunchKernelGGL(dbg::simple_final, dim3(MTOK / 4), dim3(256), 0, stream, a);
#endif
                hipLaunchKernelGGL(dbg::chk_moe, dim3(16), dim3(256), 0, stream, a, D); hipLaunchKernelGGL(dbg::report, dim3(1024), dim3(256), 0, stream, (float*)d_out, (const unsigned*)D, out_size); break;
            default: break;
        }
#endif
    }
#endif
}
```

```cpp
#include <hip/hip_runtime.h>
#include <cstdio>
#include <cstdint>

#define LAS __attribute__((address_space(3)))
#define GAS __attribute__((address_space(1)))
typedef unsigned short bf16_t;
typedef short bf16x8 __attribute__((ext_vector_type(8)));
typedef short s16x4 __attribute__((ext_vector_type(4)));
typedef float f32x2 __attribute__((ext_vector_type(2)));
typedef float f32x4 __attribute__((ext_vector_type(4)));
typedef float f32x16 __attribute__((ext_vector_type(16)));
typedef unsigned u32x2 __attribute__((ext_vector_type(2)));
typedef unsigned u32x4 __attribute__((ext_vector_type(4)));
typedef __bf16 bf16x2_t __attribute__((ext_vector_type(2)));
typedef _Float16 f16x2_t __attribute__((ext_vector_type(2)));

constexpr int DM = 1024, NB = 8, SEQ = 4096, MTOK = NB * SEQ;
constexpr int EVEN_IN = 1768, EVEN_INP = 1792, DFF = 2816, DFFE = 3584, NEXP = 8;
constexpr float ALPHA = 1.4142135623730951f;
constexpr float LOG2E = 1.4426950408889634f;
constexpr float QSCALE = 0.125f * LOG2E;
constexpr int NWAVES = 8, NTHR = 512;

__device__ __forceinline__ unsigned f2bf(float f) { unsigned u = __builtin_bit_cast(unsigned, f); return (u + 0x7fffu + ((u >> 16) & 1u)) >> 16; }
__device__ __forceinline__ unsigned pk2(float lo, float hi) { f32x2 v = {lo, hi}; bf16x2_t b = __builtin_convertvector(v, bf16x2_t); return __builtin_bit_cast(unsigned, b); }
__device__ __forceinline__ float bf2f(unsigned short h) { return __builtin_bit_cast(float, (unsigned)h << 16); }
__device__ __forceinline__ float bflo(unsigned w) { return __builtin_bit_cast(float, w << 16); }
__device__ __forceinline__ float bfhi(unsigned w) { return __builtin_bit_cast(float, w & 0xffff0000u); }
__device__ __forceinline__ float wave_sum(float v) {
#pragma unroll
    for (int o = 1; o < 64; o <<= 1) v += __shfl_xor(v, o);
    return v;
}
#define LDS_WAIT() asm volatile("s_waitcnt lgkmcnt(0)" ::: "memory")
#define VM_WAIT() asm volatile("s_waitcnt vmcnt(0)" ::: "memory")
namespace pg8 {
#define PG8_LAS __attribute__((address_space(3)))
typedef unsigned short bf16_t;
typedef short bf16x8 __attribute__((ext_vector_type(8)));
typedef float f32x4 __attribute__((ext_vector_type(4)));
typedef unsigned u32x4 __attribute__((ext_vector_type(4)));
constexpr int BM = 256, BK = 64, HALF = 128, HTB = HALF * BK * 2  , STAGE_BYTES = 8 * HTB, NXCD = 8, WGM = 8;

__host__ __device__ __forceinline__ int lds_byte(int r, int c) { const int st = (r >> 4) * 2 + (c >> 5), rr = r & 15, cc = c & 31, ob = rr * 64 + cc * 2; return st * 1024 + (ob ^ (((ob >> 9) & 1) << 5)); }
__host__ __device__ __forceinline__ void stage_rc(int b, int& R, int& C) { const int st = b / 1024, sb = b % 1024, swz = sb ^ (((sb >> 9) & 1) << 5); R = (st >> 1) * 16 + swz / 64; C = (st & 1) * 32 + (swz % 64) / 2; }
__host__ __device__ __forceinline__ int perm32(int rho) { const int n = rho >> 4, i = rho & 15; return 8 * (i >> 2) + 4 * n + (i & 3); }

struct Unit { int pm, pn, e; };
struct Gemm { const bf16_t* A; const bf16_t* Bt; int M, N, K; int lda; size_t bstride; };

struct StaticOrder {
    int nM, nN, nwg, G, c;
    __host__ __device__ void init(int M, int N, int G_, int c_) { nM = M / BM; nN = N / BM; nwg = nM * nN; G = G_; c = c_; }
    __host__ __device__ bool next(int i, Unit& u) const {
        const long L = (long)i * G + c; if (L >= nwg) return false;
        int wgid = (int)L; { const int q = nwg / NXCD, r = nwg % NXCD, xcd = wgid % NXCD, off = wgid / NXCD; wgid = (xcd < r ? xcd * (q + 1) : r * (q + 1) + (xcd - r) * q) + off; }
        const int nig = WGM * nN, gid = wgid / nig, fm = gid * WGM, gsz = (nM - fm) < WGM ? (nM - fm) : WGM;
        u.pm = fm + ((wgid % nig) % gsz); u.pn = (wgid % nig) / gsz; u.e = 0; return true;
    }
    __device__ __forceinline__ void a_ready(const Unit&) const {}
    __device__ __forceinline__ void done(const Unit&) const {}
};


typedef int v8i32_t __attribute__((ext_vector_type(8)));
typedef int v4i32_t __attribute__((ext_vector_type(4)));
__device__ __forceinline__ v8i32_t cat8(bf16x8 lo, bf16x8 hi) { const v4i32_t a = __builtin_bit_cast(v4i32_t, lo), b = __builtin_bit_cast(v4i32_t, hi); return (v8i32_t){a[0], a[1], a[2], a[3], b[0], b[1], b[2], b[3]}; }
template <class Epi, class Sched, bool ALIGN_EPI = false, bool SP2 = false, bool F8 = false, bool I8 = false>
__device__ __forceinline__ void gemm_phase(PG8_LAS unsigned char* lds, const Gemm g, const Sched& S, const Epi& E) {
    const int tid = threadIdx.x, wid = __builtin_amdgcn_readfirstlane(tid >> 6), lane = tid & 63, wr = wid >> 2, wc = wid & 3, fr = lane & 15, fq = lane >> 4;
    const int K = g.K, nt = K / BK;
    unsigned voffA[2], voffB[2];
#pragma unroll
    for (int i = 0; i < 2; ++i) { int R, C; stage_rc(tid * 16 + i * 8192, R, C); const int Rb = Epi::PERM ? ((R & ~31) + perm32(R & 31)) : R;
        voffA[i] = (unsigned)(R * g.lda + C) * 2u; voffB[i] = (unsigned)(Rb * K + C) * 2u; }
    const size_t kstep = (size_t)(BK * 2);
    const size_t hstep = (size_t)HALF * K * 2;
    const size_t tstep = 2 * hstep;
    const size_t hstepA = (size_t)HALF * g.lda * 2, tstepA = 2 * hstepA;
    const size_t estep = g.bstride * 2;
    const unsigned ldsw = (unsigned)wid * 1024u;
    const int aoff = lds_byte(wr * 64 + fr, fq * 8), boff = lds_byte(wc * 32 + fr, fq * 8);
#define PG8_SA(b, h) (((b) * 2 + (h)) * HTB)
#define PG8_SB(b, h) ((4 + (b) * 2 + (h)) * HTB)
#define PG8_STAGE(bufoff, gbase, voff) do { _Pragma("unroll") for (int _i = 0; _i < 2; ++_i) \
        __builtin_amdgcn_global_load_lds((const unsigned*)((const char*)(gbase) + (voff)[_i]), (PG8_LAS unsigned*)(lds + (bufoff) + ldsw + _i * 8192), 16, 0, 0); } while (0)
#define PG8_LDA(dst, b, h) do { _Pragma("unroll") for (int m = 0; m < 4; ++m) _Pragma("unroll") for (int k = 0; k < 2; ++k) dst[m][k] = *(const PG8_LAS bf16x8*)(lds + PG8_SA(b, h) + aoff + m * 2048 + k * 1024); } while (0)
#define PG8_LDB(dst, b, h) do { _Pragma("unroll") for (int n = 0; n < 2; ++n) _Pragma("unroll") for (int k = 0; k < 2; ++k) dst[n][k] = *(const PG8_LAS bf16x8*)(lds + PG8_SB(b, h) + boff + n * 2048 + k * 1024); } while (0)
#define PG8_MMA(ai, bj, At, Bt) do { __builtin_amdgcn_s_setprio(1); if constexpr (I8) { _Pragma("unroll") for (int m = 0; m < 4; ++m) _Pragma("unroll") for (int n = 0; n < 2; ++n) _Pragma("unroll") for (int k = 0; k < 2; ++k) \
        asm volatile("v_mfma_i32_16x16x64_i8 %0, %1, %2, %0" : "+v"(acc[ai][bj][m][n]) : "v"(Bt[n][k]), "v"(At[m][k])); } else if constexpr (F8) { _Pragma("unroll") for (int m = 0; m < 4; ++m) _Pragma("unroll") for (int n = 0; n < 2; ++n) \
        asm volatile("v_mfma_scale_f32_16x16x128_f8f6f4 %0, %1, %2, %0, %3, %3 op_sel_hi:[0,0,0]" : "+v"(acc[ai][bj][m][n]) : "v"(cat8(Bt[n][0], Bt[n][1])), "v"(cat8(At[m][0], At[m][1])), "v"(sc8)); } else { \
        _Pragma("unroll") for (int m = 0; m < 4; ++m) _Pragma("unroll") for (int n = 0; n < 2; ++n) _Pragma("unroll") for (int k = 0; k < 2; ++k) \
        acc[ai][bj][m][n] = __builtin_amdgcn_mfma_f32_16x16x32_bf16(Bt[n][k], At[m][k], acc[ai][bj][m][n], 0, 0, 0); } __builtin_amdgcn_s_setprio(0); } while (0)
#define PG8_WAIT_V(n) asm volatile("s_waitcnt vmcnt(" #n ")" ::: "memory")
#define PG8_WAIT_L(n) asm volatile("s_waitcnt lgkmcnt(" #n ")" ::: "memory")
#define PG8_BAR __builtin_amdgcn_s_barrier()
#define PG8_SCHED __builtin_amdgcn_sched_barrier(0)
    Unit cur, nxt; int ui = 0;
    if (!S.next(0, cur)) return;
    int sc8 = 0x7f7f7f7f; asm volatile("" : "+v"(sc8));
    f32x4 acc[2][2][4][2];
#pragma unroll
    for (int a = 0; a < 2; ++a)
#pragma unroll
        for (int b = 0; b < 2; ++b)
#pragma unroll
            for (int m = 0; m < 4; ++m)
#pragma unroll
                for (int n = 0; n < 2; ++n) acc[a][b][m][n] = (f32x4){0.f, 0.f, 0.f, 0.f};
    bf16x8 At[4][2], B0[2][2], B1[2][2];
    const char* cA = (const char*)g.A + (size_t)cur.pm * tstepA; const char* cB = (const char*)g.Bt + (size_t)cur.pn * tstep + (size_t)cur.e * estep;
    S.a_ready(cur);
    if constexpr (SP2) {
        PG8_STAGE(PG8_SB(0, 0), cB, voffB); PG8_STAGE(PG8_SB(0, 1), cB + hstep, voffB); PG8_STAGE(PG8_SA(0, 0), cA, voffA); PG8_STAGE(PG8_SA(0, 1), cA + hstepA, voffA);
        if (wr == 1) PG8_BAR;
        PG8_WAIT_V(2); PG8_BAR;
        PG8_STAGE(PG8_SB(1, 0), cB + kstep, voffB); PG8_STAGE(PG8_SA(1, 0), cA + kstep, voffA); PG8_STAGE(PG8_SB(1, 1), cB + hstep + kstep, voffB);
        PG8_WAIT_V(6); PG8_BAR;
    } else {
        PG8_STAGE(PG8_SB(0, 0), cB, voffB); PG8_STAGE(PG8_SA(0, 0), cA, voffA); PG8_STAGE(PG8_SB(0, 1), cB + hstep, voffB); PG8_STAGE(PG8_SA(0, 1), cA + hstepA, voffA);
        if (wr == 1) PG8_BAR;
        PG8_WAIT_V(4); PG8_BAR;
        PG8_STAGE(PG8_SB(1, 0), cB + kstep, voffB); PG8_STAGE(PG8_SA(1, 0), cA + kstep, voffA); PG8_STAGE(PG8_SB(1, 1), cB + hstep + kstep, voffB);
        PG8_WAIT_V(6); PG8_BAR;
    }
    for (;;) {
        const bool has_next = S.next(ui + 1, nxt);
        const char* nA = has_next ? (const char*)g.A + (size_t)nxt.pm * tstepA : cA; const char* nB = has_next ? (const char*)g.Bt + (size_t)nxt.pn * tstep + (size_t)nxt.e * estep : cB;
#pragma unroll 1
        for (int t = 0; t < nt; t += 2) {
            const bool last = (t == nt - 2);
            const char* a1 = cA + (size_t)(t + 1) * kstep;
            const char* a2 = last ? nA : cA + (size_t)(t + 2) * kstep; const char* b2 = last ? nB : cB + (size_t)(t + 2) * kstep;
            const char* a3 = a2 + kstep; const char* b3 = b2 + kstep;
            if (last && has_next) S.a_ready(nxt);
            if constexpr (SP2) {
            PG8_LDB(B0, 0, 0); PG8_LDB(B1, 0, 1); PG8_SCHED; PG8_LDA(At, 0, 0); PG8_STAGE(PG8_SA(1, 1), a1 + hstepA, voffA);
            PG8_WAIT_V(8); PG8_WAIT_L(0); PG8_BAR; PG8_MMA(0, 0, At, B0); PG8_MMA(0, 1, At, B1); PG8_BAR; PG8_SCHED;
            PG8_LDA(At, 0, 1); PG8_STAGE(PG8_SB(0, 0), b2, voffB); PG8_STAGE(PG8_SB(0, 1), b2 + hstep, voffB); PG8_STAGE(PG8_SA(0, 0), a2, voffA);
            PG8_WAIT_V(8); PG8_WAIT_L(0); PG8_BAR; PG8_MMA(1, 0, At, B0); PG8_MMA(1, 1, At, B1); PG8_BAR; PG8_SCHED;
            PG8_LDB(B0, 1, 0); PG8_LDB(B1, 1, 1); PG8_SCHED; PG8_LDA(At, 1, 0); PG8_STAGE(PG8_SA(0, 1), a2 + hstepA, voffA);
            PG8_WAIT_V(8); PG8_WAIT_L(0); PG8_BAR; PG8_MMA(0, 0, At, B0); PG8_MMA(0, 1, At, B1); PG8_BAR; PG8_SCHED;
            PG8_LDA(At, 1, 1); PG8_STAGE(PG8_SB(1, 0), b3, voffB); PG8_STAGE(PG8_SB(1, 1), b3 + hstep, voffB); PG8_STAGE(PG8_SA(1, 0), a3, voffA);
            PG8_WAIT_V(8); PG8_WAIT_L(0); PG8_BAR; PG8_MMA(1, 0, At, B0); PG8_MMA(1, 1, At, B1); PG8_BAR; PG8_SCHED;
            } else {
            PG8_LDB(B0, 0, 0); PG8_SCHED; PG8_LDA(At, 0, 0); PG8_STAGE(PG8_SA(1, 1), a1 + hstepA, voffA);
            PG8_WAIT_L(8); PG8_BAR; PG8_WAIT_L(0); PG8_MMA(0, 0, At, B0); PG8_BAR; PG8_SCHED;
            PG8_LDB(B1, 0, 1); PG8_STAGE(PG8_SB(0, 0), b2, voffB);
            PG8_BAR; PG8_WAIT_L(0); PG8_MMA(0, 1, At, B1); PG8_BAR;
            PG8_LDA(At, 0, 1); PG8_STAGE(PG8_SA(0, 0), a2, voffA);
            PG8_BAR; PG8_WAIT_L(0); PG8_MMA(1, 0, At, B0); PG8_BAR; PG8_SCHED;
            PG8_STAGE(PG8_SB(0, 1), b2 + hstep, voffB);
            PG8_WAIT_V(6); PG8_BAR; PG8_MMA(1, 1, At, B1); PG8_BAR;
            PG8_LDB(B0, 1, 0); PG8_SCHED; PG8_LDA(At, 1, 0); PG8_STAGE(PG8_SA(0, 1), a2 + hstepA, voffA);
            PG8_WAIT_L(8); PG8_BAR; PG8_WAIT_L(0); PG8_MMA(0, 0, At, B0); PG8_BAR; PG8_SCHED;
            PG8_LDB(B1, 1, 1); PG8_STAGE(PG8_SB(1, 0), b3, voffB);
            PG8_BAR; PG8_WAIT_L(0); PG8_MMA(0, 1, At, B1); PG8_BAR;
            PG8_LDA(At, 1, 1); PG8_STAGE(PG8_SA(1, 0), a3, voffA);
            PG8_BAR; PG8_WAIT_L(0); PG8_MMA(1, 0, At, B0); PG8_BAR; PG8_SCHED;
            PG8_STAGE(PG8_SB(1, 1), b3 + hstep, voffB);
            PG8_WAIT_V(6); PG8_BAR; PG8_MMA(1, 1, At, B1); PG8_BAR;
            }
        }
        if constexpr (ALIGN_EPI) { if (wr == 0) PG8_BAR; }
        if constexpr (F8 || I8) asm volatile("s_nop 15\n\ts_nop 15" ::: "memory");
        if constexpr (!Epi::AFTER_DRAIN) { E(acc, cur, wr, wc, fr, fq); S.done(cur); }
        if (!has_next) break;
#pragma unroll
        for (int a = 0; a < 2; ++a)
#pragma unroll
            for (int b = 0; b < 2; ++b)
#pragma unroll
                for (int m = 0; m < 4; ++m)
#pragma unroll
                    for (int n = 0; n < 2; ++n) acc[a][b][m][n] = (f32x4){0.f, 0.f, 0.f, 0.f};
        cur = nxt; cA = nA; cB = nB; ++ui;
        if constexpr (ALIGN_EPI) { if (wr == 1) PG8_BAR; }
    }
    PG8_WAIT_V(0);
    if constexpr (!ALIGN_EPI) { if (wr == 0) PG8_BAR; }
    PG8_BAR;
    if constexpr (Epi::AFTER_DRAIN) { E.fused(acc, cur, wr, wc, fr, fq, lds, wid, lane); S.done(cur); }
#undef PG8_SA
#undef PG8_SB
#undef PG8_STAGE
#undef PG8_LDA
#undef PG8_LDB
#undef PG8_MMA
#undef PG8_WAIT_V
#undef PG8_WAIT_L
#undef PG8_BAR
#undef PG8_SCHED
}
}

namespace pg8 {
typedef f32x4 Acc[2][2][4][2];
__device__ __forceinline__ u32x4 pack8(const f32x4 v0, const f32x4 v1) { u32x4 w; w.x = pk2(v0[0], v0[1]); w.y = pk2(v0[2], v0[3]); w.z = pk2(v1[0], v1[1]); w.w = pk2(v1[2], v1[3]); return w; }
__device__ __forceinline__ void unpack8(const u32x4 w, f32x4& a, f32x4& b) { a = (f32x4){bflo(w.x), bfhi(w.x), bflo(w.y), bfhi(w.y)}; b = (f32x4){bflo(w.z), bfhi(w.z), bflo(w.w), bfhi(w.w)}; }

struct EpiInE {
    static constexpr bool PERM = true, AFTER_DRAIN = false;
    bf16_t* Y1; float* ssq_q; float* ssq_kv;
    __device__ __forceinline__ void operator()(const Acc& acc, const Unit& u, int wr, int wc, int fr, int fq) const {
        bf16_t* base = Y1 + (size_t)u.pn * MTOK * 256;
        const float sc = (u.pn == 2 || u.pn == 3) ? QSCALE : 1.f;
        const int col0 = wc * 32 + 8 * fq;
#pragma unroll
        for (int ai = 0; ai < 2; ++ai)
#pragma unroll
            for (int m = 0; m < 4; ++m) {
                const int row = u.pm * BM + ai * HALF + wr * 64 + m * 16 + fr; bf16_t* rowp = base + (size_t)row * 256 + col0;
                float s0 = 0.f, s1 = 0.f;
#pragma unroll
                for (int bj = 0; bj < 2; ++bj) { const f32x4 v0 = acc[ai][bj][m][0], v1 = acc[ai][bj][m][1];
                    const float q = (v0[0] * v0[0] + v0[1] * v0[1]) + (v0[2] * v0[2] + v0[3] * v0[3]) + (v1[0] * v1[0] + v1[1] * v1[1]) + (v1[2] * v1[2] + v1[3] * v1[3]);
                    if (bj == 0) s0 = q; else s1 = q;
                    *(u32x4*)(rowp + bj * HALF) = pack8(v0 * sc, v1 * sc); }
                if (u.pn <= 1) {
                    float s = (u.pn == 0) ? (s0 + s1) : s0;
                    s += __shfl_xor(s, 16); s += __shfl_xor(s, 32);
                    if (fq == 0) (u.pn == 0 ? ssq_q : ssq_kv)[(size_t)row * 4 + wc] = s;
                }
            }
    }
};
struct EpiQ2 {
    static constexpr bool PERM = true, AFTER_DRAIN = false;
    bf16_t* QLAT; bf16_t* QIDX; const float* ssq_q;
    __device__ __forceinline__ void operator()(const Acc& acc, const Unit& u, int wr, int wc, int fr, int fq) const {
        bf16_t* base = (u.pn < 4) ? QLAT : QIDX; const float sc0 = (u.pn < 4) ? QSCALE : 1.f;
        const int col0 = (u.pn & 3) * 256 + wc * 32 + 8 * fq;
#pragma unroll
        for (int ai = 0; ai < 2; ++ai)
#pragma unroll
            for (int m = 0; m < 4; ++m) {
                const int row = u.pm * BM + ai * HALF + wr * 64 + m * 16 + fr; bf16_t* rowp = base + (size_t)row * 1024 + col0;
                const f32x4 sq = *(const f32x4*)(ssq_q + (size_t)row * 4); const float sc = sc0 * __builtin_amdgcn_rsqf(((sq[0] + sq[1]) + (sq[2] + sq[3])) * (1.f / 256.f) + 1e-6f);
#pragma unroll
                for (int bj = 0; bj < 2; ++bj) *(u32x4*)(rowp + bj * HALF) = pack8(acc[ai][bj][m][0] * sc, acc[ai][bj][m][1] * sc);
            }
    }
};
template <bool RES_F32> struct EpiRes {
    static constexpr bool PERM = true, AFTER_DRAIN = false;
    const void* res; bf16_t* S; float sc;
    __device__ __forceinline__ void operator()(const Acc& acc, const Unit& u, int wr, int wc, int fr, int fq) const {
        const int col0 = u.pn * BM + wc * 32 + 8 * fq;
#pragma unroll
        for (int ai = 0; ai < 2; ++ai)
#pragma unroll
            for (int m = 0; m < 4; ++m) {
                const size_t off = (size_t)(u.pm * BM + ai * HALF + wr * 64 + m * 16 + fr) * 1024 + col0;
#pragma unroll
                for (int bj = 0; bj < 2; ++bj) { f32x4 r0, r1;
                    if (RES_F32) { r0 = *(const f32x4*)((const float*)res + off + bj * HALF); r1 = *(const f32x4*)((const float*)res + off + bj * HALF + 4); }
                    else unpack8(*(const u32x4*)((const bf16_t*)res + off + bj * HALF), r0, r1);
                    *(u32x4*)(S + off + bj * HALF) = pack8(r0 * ALPHA + acc[ai][bj][m][0] * sc, r1 * ALPHA + acc[ai][bj][m][1] * sc); }
            }
    }
};
struct EpiSwiglu {
    static constexpr bool PERM = true, AFTER_DRAIN = false;
    bf16_t* O; int ldo; int pm0;
    __device__ __forceinline__ void operator()(const Acc& acc, const Unit& u, int wr, int wc, int fr, int fq) const {
        const int col0 = u.pn * HALF + wc * 32 + 8 * fq;
#pragma unroll
        for (int ai = 0; ai < 2; ++ai)
#pragma unroll
            for (int m = 0; m < 4; ++m) {
                bf16_t* rowp = O + (size_t)((u.pm - pm0) * BM + ai * HALF + wr * 64 + m * 16 + fr) * ldo + col0;
                f32x4 o[2];
#pragma unroll
                for (int n = 0; n < 2; ++n) { const f32x4 a = acc[ai][0][m][n], b = acc[ai][1][m][n];
#pragma unroll
                    for (int e = 0; e < 4; ++e) o[n][e] = a[e] * __builtin_amdgcn_rcpf(1.f + __expf(-a[e])) * b[e]; }
                *(u32x4*)rowp = pack8(o[0], o[1]);
            }
    }
};
struct EpiStore {
    static constexpr bool PERM = true, AFTER_DRAIN = false;
    bf16_t* O; int ldo;
    __device__ __forceinline__ void operator()(const Acc& acc, const Unit& u, int wr, int wc, int fr, int fq) const {
        const int col0 = u.pn * BM + wc * 32 + 8 * fq;
#pragma unroll
        for (int ai = 0; ai < 2; ++ai)
#pragma unroll
            for (int m = 0; m < 4; ++m) {
                bf16_t* rowp = O + (size_t)(u.pm * BM + ai * HALF + wr * 64 + m * 16 + fr) * ldo + col0;
#pragma unroll
                for (int bj = 0; bj < 2; ++bj) *(u32x4*)(rowp + bj * HALF) = pack8(acc[ai][bj][m][0], acc[ai][bj][m][1]);
            }
    }
};
struct EpiInO {
    static constexpr bool PERM = true, AFTER_DRAIN = false;
    bf16_t* QKV; float* kmean; float isc;
    __device__ __forceinline__ void operator()(const Acc& acc, const Unit& u, int wr, int wc, int fr, int fq) const {
        const int which = u.pn >> 2; bf16_t* base = QKV + (size_t)which * MTOK * 1024; const float sc = (which == 0) ? QSCALE * isc : isc;
        const int col0 = (u.pn & 3) * BM + wc * 32 + 8 * fq;
#pragma unroll
        for (int ai = 0; ai < 2; ++ai)
#pragma unroll
            for (int m = 0; m < 4; ++m) {
                bf16_t* rowp = base + (size_t)(u.pm * BM + ai * HALF + wr * 64 + m * 16 + fr) * 1024 + col0;
#pragma unroll
                for (int bj = 0; bj < 2; ++bj) *(u32x4*)(rowp + bj * HALF) = pack8(acc[ai][bj][m][0] * sc, acc[ai][bj][m][1] * sc);
            }
        if (which == 1) {
#pragma unroll
            for (int bj = 0; bj < 2; ++bj)
#pragma unroll
                for (int n = 0; n < 2; ++n) { f32x4 s = (f32x4){0.f, 0.f, 0.f, 0.f};
#pragma unroll
                    for (int ai = 0; ai < 2; ++ai)
#pragma unroll
                        for (int m = 0; m < 4; ++m) s += acc[ai][bj][m][n];
#pragma unroll
                    for (int e = 0; e < 4; ++e) { float v = s[e]; v += __shfl_xor(v, 1); v += __shfl_xor(v, 2); v += __shfl_xor(v, 4); v += __shfl_xor(v, 8);
                        if (fr == 0) kmean[((size_t)u.pm * 2 + wr) * 1024 + col0 + bj * HALF + 4 * n + e] = v; }
                }
        }
    }
};

__device__ __forceinline__ unsigned pk4_fp8(float a, float b, float c, float d) { int w = 0; w = __builtin_amdgcn_cvt_pk_fp8_f32(a, b, w, false); w = __builtin_amdgcn_cvt_pk_fp8_f32(c, d, w, true); return (unsigned)w; }
struct EpiSwiglu8 {
    static constexpr bool PERM = true, AFTER_DRAIN = false;
    unsigned char* O; int ldo; int pm0; float isc;
    __device__ __forceinline__ void operator()(const Acc& acc, const Unit& u, int wr, int wc, int fr, int fq) const {
        const int col0 = u.pn * HALF + wc * 32 + 8 * fq;
#pragma unroll
        for (int ai = 0; ai < 2; ++ai)
#pragma unroll
            for (int m = 0; m < 4; ++m) {
                unsigned char* rowp = O + (size_t)((u.pm - pm0) * BM + ai * HALF + wr * 64 + m * 16 + fr) * ldo + col0;
                f32x4 o[2];
#pragma unroll
                for (int n = 0; n < 2; ++n) { const f32x4 a = acc[ai][0][m][n] * isc, b = acc[ai][1][m][n] * isc;
#pragma unroll
                    for (int e = 0; e < 4; ++e) o[n][e] = a[e] * __builtin_amdgcn_rcpf(1.f + __expf(-a[e])) * b[e]; }
                u32x2 w; w.x = pk4_fp8(o[0][0], o[0][1], o[0][2], o[0][3]); w.y = pk4_fp8(o[1][0], o[1][1], o[1][2], o[1][3]);
                *(u32x2*)rowp = w;
            }
    }
};

struct EpiSwigluI8 {
    static constexpr bool PERM = true, AFTER_DRAIN = false;
    unsigned char* O; int ldo; const float* sa; const float* sw;
    __device__ __forceinline__ void operator()(const Acc& acc, const Unit& u, int wr, int wc, int fr, int fq) const {
        const int col0 = u.pn * HALF + wc * 32 + 8 * fq, bcol = u.pn * BM + wc * 32 + 8 * fq;
        f32x4 w1s[2], w3s[2];
#pragma unroll
        for (int n = 0; n < 2; ++n) { w1s[n] = *(const f32x4*)(sw + bcol + 4 * n); w3s[n] = *(const f32x4*)(sw + bcol + HALF + 4 * n); }
#pragma unroll
        for (int ai = 0; ai < 2; ++ai)
#pragma unroll
            for (int m = 0; m < 4; ++m) {
                const int row = u.pm * BM + ai * HALF + wr * 64 + m * 16 + fr; const float ra = sa[row];
                unsigned char* rowp = O + (size_t)row * ldo + col0;
                f32x4 o[2];
#pragma unroll
                for (int n = 0; n < 2; ++n) {
#pragma unroll
                    for (int e = 0; e < 4; ++e) { const float xa = acc[ai][0][m][n][e], xb = acc[ai][1][m][n][e];
                        const float a = (float)__float_as_int(xa) * ra * w1s[n][e], b = (float)__float_as_int(xb) * ra * w3s[n][e];
                        o[n][e] = a * __builtin_amdgcn_rcpf(1.f + __expf(-a)) * b; } }
                u32x2 w; w.x = pk4_fp8(o[0][0], o[0][1], o[0][2], o[0][3]); w.y = pk4_fp8(o[1][0], o[1][1], o[1][2], o[1][3]);
                *(u32x2*)rowp = w;
            }
    }
};
struct EpiStoreS {
    static constexpr bool PERM = true, AFTER_DRAIN = false;
    bf16_t* O; int ldo; float sc;
    __device__ __forceinline__ void operator()(const Acc& acc, const Unit& u, int wr, int wc, int fr, int fq) const {
        const int col0 = u.pn * BM + wc * 32 + 8 * fq;
#pragma unroll
        for (int ai = 0; ai < 2; ++ai)
#pragma unroll
            for (int m = 0; m < 4; ++m) {
                bf16_t* rowp = O + (size_t)(u.pm * BM + ai * HALF + wr * 64 + m * 16 + fr) * ldo + col0;
#pragma unroll
                for (int bj = 0; bj < 2; ++bj) *(u32x4*)(rowp + bj * HALF) = pack8(acc[ai][bj][m][0] * sc, acc[ai][bj][m][1] * sc);
            }
    }
};
struct MoeOrder {
    int g0, ng, nN, G, c; int pend[8];
    __device__ __forceinline__ bool next(int i, Unit& u) const {
        const int L = i * G + c; if (L >= ng * nN) return false;
        u.pm = g0 + L % ng; u.pn = L / ng; const int r = u.pm * 256; int e = 0;
#pragma unroll
        for (int k = 0; k < 7; ++k) e += (pend[k] <= r) ? 1 : 0;
        u.e = e; return true;
    }
    __device__ __forceinline__ void a_ready(const Unit&) const {}
    __device__ __forceinline__ void done(const Unit&) const {}
};
}

#ifndef FFN_F8
#define FFN_F8 0
#endif
constexpr size_t MiB = 1u << 20, KiB = 1u << 10;
constexpr size_t CTL_ZERO_BYTES = 2 * MiB;
constexpr int    MAX_LAUNCHES = 18;
constexpr size_t OFF_BAR = 16 * KiB;
constexpr size_t OFF_WGCNT = 1 * MiB + 512 * KiB;
constexpr size_t OFF_GINFO = OFF_WGCNT + 16 * KiB;
constexpr size_t OFF_DBG = OFF_GINFO + 1 * KiB;
constexpr size_t OFF_BT = 2 * MiB;
constexpr size_t OFF_CB = 2 * MiB + 16 * KiB;
constexpr size_t OFF_ROUTE = 2 * MiB + 64 * KiB;
constexpr size_t OFF_DEST = 2 * MiB + 512 * KiB;
constexpr size_t OFF_KC = 3 * MiB, OFF_VC = 3 * MiB + 512 * KiB;
constexpr size_t OFF_W_IN = 4 * MiB, OFF_W_Q2 = OFF_W_IN + (size_t)EVEN_INP * 1024 * 2, OFF_W_OUTE = OFF_W_Q2 + 2048 * 256 * 2, OFF_W_F13 = OFF_W_OUTE + 1024 * 1536 * 2,
                 OFF_W_F2 = OFF_W_F13 + (size_t)2 * DFF * 1024 * 2, OFF_CK1 = OFF_W_F2 + (size_t)1024 * DFF * 2, OFF_CV1 = OFF_CK1 + 64 * 2048 * 2, OFF_WE_END = OFF_CV1 + 64 * 2048 * 2;
static_assert(OFF_WE_END <= 30 * MiB, "even weights");
constexpr size_t OFF_W_OIN = 30 * MiB, OFF_W_OOUT = 36 * MiB, OFF_W_M13 = 38 * MiB, OFF_W_M2 = 94 * MiB;
constexpr size_t OFF_Y1 = 30 * MiB;
constexpr size_t OFF_CKVN = 142 * MiB;
constexpr size_t OFF_XB = 206 * MiB, OFF_QLAT = 206 * MiB, OFF_QIDX = 270 * MiB;
constexpr size_t OFF_SC = 334 * MiB, OFF_MASK = 464 * MiB, OFF_MIXIN = 334 * MiB;
constexpr size_t OFF_S1 = 206 * MiB, OFF_H = 270 * MiB, OFF_ACT = 30 * MiB, OFF_S2 = 334 * MiB, OFF_X1 = 398 * MiB, OFF_H8 = 464 * MiB;
constexpr size_t OFF_SA = 497 * MiB, OFF_SW = 497 * MiB + 256 * KiB, OFF_SAX = 497 * MiB + 512 * KiB, OFF_SWIN = 497 * MiB + 768 * KiB;
constexpr size_t OFF_X18 = 464 * MiB, OFF_O8 = 464 * MiB;
constexpr float OSC = 16.f, WOUT_SCALE = 64.f, WIN_SCALE = 32.f, WF13_SCALE = 32.f, WF2_SCALE = 128.f;
constexpr size_t OFF_QKV = 206 * MiB, OFF_S1O = 270 * MiB, OFF_H2 = 122 * MiB, OFF_ACTM = 186 * MiB, OFF_YR = 298 * MiB, OFF_XR = 430 * MiB;
constexpr float W13_SCALE = 32.f, W2_SCALE = 128.f;
constexpr size_t OFF_MST = 122 * MiB;
constexpr size_t OFF_SSQ_Q = 514 * MiB, OFF_SSQ_KV = 514 * MiB + 512 * KiB;
constexpr size_t OFF_KMEAN = 515 * MiB;
constexpr size_t WS_END = 516 * MiB;
constexpr int    MOE_CHUNK = 128;
constexpr size_t SCB_ELEMS = (size_t)64 * 64 * (64 * 65 / 2);

constexpr int LDS_BYTES = 160 * 1024;
constexpr int LDSCTL_OFF = LDS_BYTES - 512;

#define RLX_AGENT __ATOMIC_RELAXED, __HIP_MEMORY_SCOPE_AGENT
typedef GAS unsigned gu32;
#define XB_TMO      128
#define XB_XCNT(j)  (256  + 64 * (j))
#define XB_XSUB(j)  (1280 + 64 * (j))
#define XB_XGEN(j)  (2304 + 64 * (j))
#define XB_TOP      3328
#define XB_TOPGEN   3392
#define XCD_BAR_WORDS 3456
#define XB_SPIN_CAP (1u << 18)

__device__ __forceinline__ unsigned xb_ld(unsigned* p)              { return __hip_atomic_load(p, __ATOMIC_RELAXED, __HIP_MEMORY_SCOPE_AGENT); }
__device__ __forceinline__ unsigned xb_add(unsigned* p, unsigned v) { return __hip_atomic_fetch_add(p, v, __ATOMIC_RELAXED, __HIP_MEMORY_SCOPE_AGENT); }
__device__ __forceinline__ unsigned xb_xcc_id() { return (unsigned)__builtin_amdgcn_s_getreg((3 << 11) | 20) & 0xFu; }
#define XB_SPIN(cond, bar) do { unsigned _sp = 0; while (cond) { __builtin_amdgcn_s_sleep(1); \
    if ((++_sp & 255u) == 0u) { if (xb_ld(&(bar)[XB_TMO])) break; if (_sp > XB_SPIN_CAP) { atomicAdd(&(bar)[XB_TMO], 1u); break; } } } } while (0)

struct XcdBarrier {
    unsigned* bar; unsigned x;
    volatile LAS unsigned* st;
};

__device__ __forceinline__ XcdBarrier xcd_barrier_post(unsigned* bar, volatile LAS unsigned* st) {
    XcdBarrier b; b.bar = bar; b.x = xb_xcc_id(); b.st = st;
    if (threadIdx.x == 0) (void)xb_add(&bar[XB_XCNT(b.x)], 1u);
    return b;
}
__device__ __forceinline__ void xcd_barrier_complete(unsigned* bar, unsigned x, unsigned& nloc, unsigned& nx) {
    const unsigned G = gridDim.x * gridDim.y * gridDim.z;
    unsigned sum, cnt, mine, sp = 0u;
    for (;;) {
        sum = 0u; cnt = 0u; mine = 0u;
#pragma unroll
        for (unsigned j = 0; j < 16; ++j) { const unsigned c = xb_ld(&bar[XB_XCNT(j)]); sum += c; cnt += (c > 0u) ? 1u : 0u; mine = (j == x) ? c : mine; }
        if (sum == G) break;
        __builtin_amdgcn_s_sleep(1);
        if ((++sp & 255u) == 0u) { if (xb_ld(&bar[XB_TMO])) break; if (sp > XB_SPIN_CAP) { atomicAdd(&bar[XB_TMO], 1u); break; } }
    }
    nloc = mine > 0u ? mine : 1u; nx = cnt > 0u ? cnt : 1u;
}

__device__ __forceinline__ void xcd_barrier(const XcdBarrier& b) {
    asm volatile("s_waitcnt vmcnt(0)" ::: "memory");
    __syncthreads();
    if (threadIdx.x == 0) {
        unsigned* bar = b.bar;
        __builtin_amdgcn_s_waitcnt(0);
        unsigned nloc = b.st[0], nx = b.st[1];
        if (nloc == 0u) { xcd_barrier_complete(bar, b.x, nloc, nx); b.st[0] = nloc; b.st[1] = nx; }
        const unsigned old = xb_add(&bar[XB_XSUB(b.x)], 1u);
        const unsigned gen = old / nloc;
        if (old + 1u == (gen + 1u) * nloc) {
            __builtin_amdgcn_fence(__ATOMIC_RELEASE, "agent");
            asm volatile("s_waitcnt vmcnt(0)" ::: "memory");
            const unsigned og = xb_add(&bar[XB_TOP], 1u);
            const unsigned tg = og / nx;
            if (og + 1u == (tg + 1u) * nx) xb_add(&bar[XB_TOPGEN], 1u);
            else XB_SPIN(xb_ld(&bar[XB_TOPGEN]) == tg, bar);
            __builtin_amdgcn_fence(__ATOMIC_ACQUIRE, "agent");
            xb_add(&bar[XB_XGEN(b.x)], 1u);
            asm volatile("s_waitcnt vmcnt(0)" ::: "memory");
        } else {
            XB_SPIN(xb_ld(&bar[XB_XGEN(b.x)]) == gen, bar);
            __builtin_amdgcn_fence(__ATOMIC_ACQUIRE, "agent");
            asm volatile("s_waitcnt vmcnt(0)" ::: "memory");
        }
    }
    __syncthreads();
}

struct Frame {
    LAS unsigned char* lds;
    int tid, lane, wave, G, bx;
    int gw, NGW;
    unsigned char* ws;
    const float* const* in;
};
struct Args { const float* in[33]; float* out; unsigned char* ws; int ph_lo, ph_hi, li, pad; };
enum InIdx { I_X = 0, I_RELB, I_EWIN, I_EQN, I_EKVN, I_EWUQ, I_EWUK, I_EWUV, I_EWQIDX, I_EPOSK, I_EPOSV, I_ECK1, I_ECK2, I_ECV1, I_ECV2, I_EWOUT, I_ELN1G, I_ELN1B,
             I_EF1, I_EF3, I_EF2, I_ELN2G, I_ELN2B, I_OWIN, I_OWOUT, I_OLN1G, I_OLN1B, I_OROUTER, I_OM1, I_OM3, I_OM2, I_OLN2G, I_OLN2B };

template <class RowMap, class KScale>
__device__ __forceinline__ void transpose_item(const float* W, int K, int N, bf16_t* WT, int ldt, LAS float* scr, int item, int lane, RowMap rm, KScale ks) {
    const int nblk = (N + 63) >> 6, kb = item / nblk, nb = item - kb * nblk, k0 = 128 * kb, n = 64 * nb + lane;
    if (n >= N) return;
    const float* src = W + (size_t)k0 * N + n; bf16_t* dst = WT + (size_t)rm(n) * ldt + k0;
#pragma unroll 2
    for (int kk = 0; kk < 128; kk += 8) { float v[8];
#pragma unroll
        for (int i = 0; i < 8; ++i) v[i] = src[(size_t)(kk + i) * N] * ks(k0 + kk + i);
        u32x4 o; o.x = pk2(v[0], v[1]); o.y = pk2(v[2], v[3]); o.z = pk2(v[4], v[5]); o.w = pk2(v[6], v[7]);
        *(u32x4*)(dst + kk) = o; }
}
template <class RowMap, int KB = 128>
__device__ __forceinline__ void transpose_item8(const float* W, int K, int N, unsigned char* WT, int ldt, int item, int lane, RowMap rm, float scale) {
    const int nblk = N >> 8, kb = item / nblk, nb = item - kb * nblk, k0 = KB * kb, n = 256 * nb + 4 * lane;
    const float* src = W + (size_t)k0 * N + n;
    unsigned char* d0 = WT + (size_t)rm(n) * ldt + k0; unsigned char* d1 = WT + (size_t)rm(n + 1) * ldt + k0; unsigned char* d2 = WT + (size_t)rm(n + 2) * ldt + k0; unsigned char* d3 = WT + (size_t)rm(n + 3) * ldt + k0;
#pragma unroll 1
    for (int kk = 0; kk < KB; kk += 16) { f32x4 v[16];
#pragma unroll
        for (int i = 0; i < 16; ++i) v[i] = *(const f32x4*)(src + (size_t)(kk + i) * N) * scale;
#pragma unroll
        for (int c = 0; c < 4; ++c) { u32x4 o; o.x = pg8::pk4_fp8(v[0][c], v[1][c], v[2][c], v[3][c]); o.y = pg8::pk4_fp8(v[4][c], v[5][c], v[6][c], v[7][c]);
            o.z = pg8::pk4_fp8(v[8][c], v[9][c], v[10][c], v[11][c]); o.w = pg8::pk4_fp8(v[12][c], v[13][c], v[14][c], v[15][c]);
            *(u32x4*)((c == 0 ? d0 : c == 1 ? d1 : c == 2 ? d2 : d3) + kk) = o; } }
}
template <class RowMap>
__device__ __forceinline__ void transpose_item_i8(const float* W, int K, int N, unsigned char* WT, int ldt, float* sw, int item, int lane, RowMap rm) {
    const int c = lane & 7, kg = lane >> 3, n = 8 * item + c, ks = K >> 3, kbase = kg * ks;
    const float* src = W + (size_t)kbase * N + n; float mx = 0.f;
#pragma unroll 16
    for (int k = 0; k < ks; ++k) mx = fmaxf(mx, fabsf(src[(size_t)k * N]));
    mx = fmaxf(mx, __shfl_xor(mx, 8)); mx = fmaxf(mx, __shfl_xor(mx, 16)); mx = fmaxf(mx, __shfl_xor(mx, 32));
    mx = fmaxf(mx, 1e-20f); const float inv = 127.f / mx; const int dr = rm(n); if (kg == 0) sw[dr] = mx * (1.f / 127.f);
    unsigned char* dst = WT + (size_t)dr * ldt + kbase;
#pragma unroll 2
    for (int kk = 0; kk < ks; kk += 16) { unsigned w[4];
#pragma unroll
        for (int q = 0; q < 4; ++q) { const int q0 = (int)rintf(src[(size_t)(kk + 4 * q) * N] * inv), q1 = (int)rintf(src[(size_t)(kk + 4 * q + 1) * N] * inv), q2 = (int)rintf(src[(size_t)(kk + 4 * q + 2) * N] * inv), q3 = (int)rintf(src[(size_t)(kk + 4 * q + 3) * N] * inv);
            w[q] = (unsigned)(q0 & 255) | ((unsigned)(q1 & 255) << 8) | ((unsigned)(q2 & 255) << 16) | ((unsigned)(q3 & 255) << 24); }
        *(u32x4*)(dst + kk) = (u32x4){w[0], w[1], w[2], w[3]}; }
}
struct RowId { __device__ __forceinline__ int operator()(int n) const { return n; } };
struct KOne { __device__ __forceinline__ float operator()(int) const { return 1.f; } };
struct RowInE {
    __device__ __forceinline__ int operator()(int n) const { return n < 464 ? n : (n < 1744 ? n + 48 : n - 1744 + 464); }
};
struct RowIlv {
    int add; __device__ __forceinline__ int operator()(int n) const { return ((n >> 7) << 8) + (n & 127) + add; }
};
struct KGain { const float* g; __device__ __forceinline__ float operator()(int k) const { return g[k]; } };

__device__ __forceinline__ void store_row_i8(unsigned char* row, float* sa, int lane, const f32x4 (&v)[4]) {
    float mx = 0.f;
#pragma unroll
    for (int j = 0; j < 4; ++j) mx = fmaxf(fmaxf(mx, fmaxf(fabsf(v[j][0]), fabsf(v[j][1]))), fmaxf(fabsf(v[j][2]), fabsf(v[j][3])));
#pragma unroll
    for (int o = 1; o < 64; o <<= 1) mx = fmaxf(mx, __shfl_xor(mx, o));
    mx = fmaxf(mx, 1e-20f); const float inv = 127.f / mx;
#pragma unroll
    for (int j = 0; j < 4; ++j) { const int q0 = (int)rintf(v[j][0] * inv), q1 = (int)rintf(v[j][1] * inv), q2 = (int)rintf(v[j][2] * inv), q3 = (int)rintf(v[j][3] * inv);
        *(unsigned*)(row + 4 * lane + 256 * j) = (unsigned)(q0 & 255) | ((unsigned)(q1 & 255) << 8) | ((unsigned)(q2 & 255) << 16) | ((unsigned)(q3 & 255) << 24); }
    if (lane == 0) *sa = mx * (1.f / 127.f);
}
__device__ __forceinline__ int t5_bucket(int n) {
    if (n < 16) return n;
    int l = 16 + (int)(__logf((float)n / 16.f) / 2.0794415f * 16.f);
    return l < 31 ? l : 31;
}

__device__ __forceinline__ void phase_prologue_even(const Frame& F, const Args& a) {
    LAS float* scr = (LAS float*)(F.lds + F.wave * 8704);
    unsigned char* ws = F.ws;
    bf16_t* W_IN = (bf16_t*)(ws + OFF_W_IN); bf16_t* W_Q2 = (bf16_t*)(ws + OFF_W_Q2); unsigned char* W_OUTE = ws + OFF_W_OUTE;
    unsigned char* W_F13 = ws + OFF_W_F13; unsigned char* W_F2 = ws + OFF_W_F2; bf16_t* CK1 = (bf16_t*)(ws + OFF_CK1); bf16_t* CV1 = (bf16_t*)(ws + OFF_CV1);
    constexpr int I_IN = 8 * ((EVEN_IN + 63) / 64);
    constexpr int I_QI = 2 * 16;
    constexpr int I_OB = 4 * 4;
    constexpr int I_F1 = DFF / 8, I_F2 = (DFF / 128) * 4;
    constexpr int I_CK = 16 * 1;
    constexpr int NIT = I_IN + I_QI + I_OB + 2 * I_F1 + I_F2 + 2 * I_CK;
    for (int it = F.gw; it < NIT; it += F.NGW) {
        int r = it;
        if (r < I_IN) { transpose_item(a.in[I_EWIN], 1024, EVEN_IN, W_IN, 1024, scr, r, F.lane, RowInE{}, KOne{}); continue; } r -= I_IN;
        if (r < I_QI) { transpose_item(a.in[I_EWQIDX], 256, 1024, W_Q2 + 1024 * 256, 256, scr, r, F.lane, RowId{}, KGain{a.in[I_EQN]}); continue; } r -= I_QI;
        if (r < I_OB) { transpose_item8(a.in[I_EWOUT] + 512 * 1024, 512, 1024, W_OUTE + 1024, 1536, r, F.lane, RowId{}, WOUT_SCALE); continue; } r -= I_OB;
#if FFN_F8
        if (r < I_F1) { transpose_item8(a.in[I_EF1], 1024, DFF, W_F13, 1024, r, F.lane, RowIlv{0}, WF13_SCALE); continue; } r -= I_F1;
        if (r < I_F1) { transpose_item8(a.in[I_EF3], 1024, DFF, W_F13, 1024, r, F.lane, RowIlv{128}, WF13_SCALE); continue; } r -= I_F1;
        if (r < I_F2) { transpose_item8(a.in[I_EF2], DFF, 1024, W_F2, DFF, r, F.lane, RowId{}, WF2_SCALE); continue; } r -= I_F2;
#else
        if (r < I_F1) { transpose_item_i8(a.in[I_EF1], 1024, DFF, W_F13, 1024, (float*)(ws + OFF_SW), r, F.lane, RowIlv{0}); continue; } r -= I_F1;
        if (r < I_F1) { transpose_item_i8(a.in[I_EF3], 1024, DFF, W_F13, 1024, (float*)(ws + OFF_SW), r, F.lane, RowIlv{128}); continue; } r -= I_F1;
        if (r < I_F2) { transpose_item8(a.in[I_EF2], DFF, 1024, W_F2, DFF, r, F.lane, RowId{}, WF2_SCALE); continue; } r -= I_F2;
#endif
        if (r < I_CK) { transpose_item(a.in[I_ECK1], 2048, 64, CK1, 2048, scr, r, F.lane, RowId{}, KOne{}); continue; } r -= I_CK;
        transpose_item(a.in[I_ECV1], 2048, 64, CV1, 2048, scr, r, F.lane, RowId{}, KOne{});
    }
    const int gt = F.bx * NTHR + F.tid, NGT = F.G * NTHR;
    for (int i = gt; i < 24 * 1024 / 8; i += NGT) ((u32x4*)(W_IN + 488 * 1024))[i] = (u32x4){0u, 0u, 0u, 0u};
    { const float* uq = a.in[I_EWUQ]; const float* uk = a.in[I_EWUK]; const float* qg = a.in[I_EQN];
      for (int o = gt; o < 1024 * 256; o += NGT) { const int r = o & 255, hc = o >> 8, h = hc >> 7, c = hc & 127; const float* p = uq + r * 512 + h * 64; const float* q = uk + c * 512 + h * 64; float s = 0.f;
#pragma unroll 8
          for (int d = 0; d < 64; ++d) s += p[d] * q[d];
          W_Q2[o] = (bf16_t)f2bf(s * qg[r]); } }
    { const float* uv = a.in[I_EWUV]; const float* wo = a.in[I_EWOUT];
      for (int o = gt; o < 1024 * 1024 / 16; o += NGT) { const int nb = o & 255, hc4 = o >> 8, h = hc4 >> 5, c0 = (hc4 & 31) * 4, n0 = nb * 4;
          const float* p = uv + (size_t)c0 * 512 + h * 64; const float* q = wo + (size_t)(h * 64) * 1024 + n0;
          f32x4 acc4[4] = {(f32x4){0.f, 0.f, 0.f, 0.f}, (f32x4){0.f, 0.f, 0.f, 0.f}, (f32x4){0.f, 0.f, 0.f, 0.f}, (f32x4){0.f, 0.f, 0.f, 0.f}};
#pragma unroll 4
          for (int d = 0; d < 64; ++d) { const f32x4 qv = *(const f32x4*)(q + (size_t)d * 1024);
#pragma unroll
              for (int cc = 0; cc < 4; ++cc) acc4[cc] += qv * p[cc * 512 + d]; }
#pragma unroll
          for (int cc = 0; cc < 4; ++cc)
#pragma unroll
              for (int e = 0; e < 4; ++e) W_OUTE[(size_t)(n0 + e) * 1536 + h * 128 + c0 + cc] = (unsigned char)(__builtin_amdgcn_cvt_pk_fp8_f32(acc4[cc][e] * WOUT_SCALE, 0.f, 0, false) & 0xff); } }
    if (F.bx == 0) { float* BT = (float*)(ws + OFF_BT); const float* rb = a.in[I_RELB];
        for (int i = F.tid; i < 16 * 128; i += NTHR) { const int h = i >> 7, d = i & 127; BT[i] = rb[t5_bucket(d) * 16 + h] * LOG2E; } }
    if (F.bx == 1 && F.tid < 128) { const int kv = F.tid >> 6, e = F.tid & 63; const float* pos = a.in[kv ? I_EPOSV : I_EPOSK]; const float* w1 = a.in[kv ? I_ECV1 : I_ECK1]; float s = 0.f;
        for (int k = 0; k < 2048; ++k) s += pos[k] * w1[k * 64 + e];
        ((float*)(ws + OFF_CB))[F.tid] = s; }
    { const f32x4* x4 = (const f32x4*)a.in[I_X]; u32x4* xb = (u32x4*)(ws + OFF_XB);
      for (int i = gt; i < MTOK * 1024 / 8; i += NGT) { const f32x4 v0 = x4[2 * i], v1 = x4[2 * i + 1]; xb[i] = pg8::pack8(v0, v1); } }
}

__device__ __forceinline__ void phase_convert_odd(const Frame& F, const Args& a) {
    LAS float* scr = (LAS float*)(F.lds + F.wave * 8704);
    unsigned char* ws = F.ws;
    unsigned char* W_OIN = ws + OFF_W_OIN; unsigned char* W_OOUT = ws + OFF_W_OOUT; unsigned char* W_M13 = ws + OFF_W_M13; unsigned char* W_M2 = ws + OFF_W_M2;
    constexpr int I_IN = 16 * 12, I_OUT = 16 * 4, I_M1 = 16 * (DFFE / 256), I_M2 = (DFFE / 64) * 4;
    constexpr int NIT = I_IN + I_OUT + NEXP * (2 * I_M1 + I_M2);
    for (int it = F.gw; it < NIT; it += F.NGW) {
        int r = it;
        if (r < I_IN) { transpose_item8<RowId, 64>(a.in[I_OWIN], 1024, 3072, W_OIN, 1024, r, F.lane, RowId{}, WIN_SCALE); continue; } r -= I_IN;
        if (r < I_OUT) { transpose_item8<RowId, 64>(a.in[I_OWOUT], 1024, 1024, W_OOUT, 1024, r, F.lane, RowId{}, WOUT_SCALE); continue; } r -= I_OUT;
        const int e = r / (2 * I_M1 + I_M2); r -= e * (2 * I_M1 + I_M2);
        if (r < I_M1) { transpose_item8<RowIlv, 64>(a.in[I_OM1] + (size_t)e * 1024 * DFFE, 1024, DFFE, W_M13 + (size_t)e * 2 * DFFE * 1024, 1024, r, F.lane, RowIlv{0}, W13_SCALE); continue; } r -= I_M1;
        if (r < I_M1) { transpose_item8<RowIlv, 64>(a.in[I_OM3] + (size_t)e * 1024 * DFFE, 1024, DFFE, W_M13 + (size_t)e * 2 * DFFE * 1024, 1024, r, F.lane, RowIlv{128}, W13_SCALE); continue; } r -= I_M1;
        transpose_item8<RowId, 64>(a.in[I_OM2] + (size_t)e * DFFE * 1024, DFFE, 1024, W_M2 + (size_t)e * 1024 * DFFE, DFFE, r, F.lane, RowId{}, W2_SCALE);
    }
}

__device__ __forceinline__ void load_row_bf16(const bf16_t* row, int lane, f32x4 (&v)[4]) {
#pragma unroll
    for (int j = 0; j < 4; ++j) { const u32x2 w = *(const u32x2*)(row + 4 * lane + 256 * j); v[j] = (f32x4){bflo(w.x), bfhi(w.x), bflo(w.y), bfhi(w.y)}; }
}
__device__ __forceinline__ void store_row_bf16(bf16_t* row, int lane, const f32x4 (&v)[4]) {
#pragma unroll
    for (int j = 0; j < 4; ++j) { u32x2 w; w.x = pk2(v[j][0], v[j][1]); w.y = pk2(v[j][2], v[j][3]); *(u32x2*)(row + 4 * lane + 256 * j) = w; }
}
__device__ __forceinline__ void ln_inplace(f32x4 (&v)[4], const f32x4 (&g)[4], const f32x4 (&b)[4]) {
    float s = 0.f;
#pragma unroll
    for (int j = 0; j < 4; ++j) s += (v[j][0] + v[j][1]) + (v[j][2] + v[j][3]);
    const float mean = wave_sum(s) * (1.f / 1024.f); float q = 0.f;
#pragma unroll
    for (int j = 0; j < 4; ++j) { v[j] = v[j] - mean; q += (v[j][0] * v[j][0] + v[j][1] * v[j][1]) + (v[j][2] * v[j][2] + v[j][3] * v[j][3]); }
    const float rstd = 1.f / sqrtf(wave_sum(q) * (1.f / 1024.f) + 1e-5f);
#pragma unroll
    for (int j = 0; j < 4; ++j) v[j] = v[j] * rstd * g[j] + b[j];
}
__device__ __forceinline__ void load_gb(const float* g, const float* b, int lane, f32x4 (&gv)[4], f32x4 (&bv)[4]) {
#pragma unroll
    for (int j = 0; j < 4; ++j) { gv[j] = *(const f32x4*)(g + 4 * lane + 256 * j); bv[j] = *(const f32x4*)(b + 4 * lane + 256 * j); }
}
__device__ __forceinline__ void store_row_fp8(unsigned char* row, int lane, const f32x4 (&v)[4]) {
#pragma unroll
    for (int j = 0; j < 4; ++j) *(unsigned*)(row + 4 * lane + 256 * j) = pg8::pk4_fp8(v[j][0], v[j][1], v[j][2], v[j][3]);
}
__device__ __forceinline__ void phase_ln_bf16(const Frame& F, const bf16_t* S, bf16_t* O, unsigned char* O8, const float* g, const float* b) {
    f32x4 gv[4], bv[4]; load_gb(g, b, F.lane, gv, bv);
    for (int row = F.gw; row < MTOK; row += F.NGW) { f32x4 v[4]; load_row_bf16(S + (size_t)row * 1024, F.lane, v); ln_inplace(v, gv, bv); store_row_bf16(O + (size_t)row * 1024, F.lane, v); store_row_fp8(O8 + (size_t)row * 1024, F.lane, v); }
}
__device__ __forceinline__ void phase_ln_i8(const Frame& F, const bf16_t* S, bf16_t* O, unsigned char* O8, float* sa, const float* g, const float* b) {
    f32x4 gv[4], bv[4]; load_gb(g, b, F.lane, gv, bv);
    for (int row = F.gw; row < MTOK; row += F.NGW) { f32x4 v[4]; load_row_bf16(S + (size_t)row * 1024, F.lane, v); ln_inplace(v, gv, bv); store_row_bf16(O + (size_t)row * 1024, F.lane, v); store_row_i8(O8 + (size_t)row * 1024, sa + row, F.lane, v); }
}
__device__ __forceinline__ void phase_ckvn(const Frame& F, const bf16_t* T1, const float* ssq_kv, const float* gain, bf16_t* CKVN) {
    const float g0 = gain[2 * F.lane], g1 = gain[2 * F.lane + 1];
    for (int row = F.gw; row < MTOK; row += F.NGW) {
        const unsigned w = *(const unsigned*)(T1 + (size_t)row * 256 + 2 * F.lane);
        const f32x4 sq = *(const f32x4*)(ssq_kv + (size_t)row * 4); const float r = __builtin_amdgcn_rsqf(((sq[0] + sq[1]) + (sq[2] + sq[3])) * (1.f / 128.f) + 1e-6f);
        *(unsigned*)(CKVN + (size_t)row * 128 + 2 * F.lane) = pk2(bflo(w) * r * g0, bfhi(w) * r * g1);
    }
}
__device__ __forceinline__ void phase_ln_router(const Frame& F, const bf16_t* S, bf16_t* H2, const float* g, const float* b, const float* router, unsigned char* ws) {
    LAS int* cnt = (LAS int*)(F.lds);
    if (F.tid < 8) cnt[F.tid] = 0;
    __syncthreads();
    f32x4 gv[4], bv[4]; load_gb(g, b, F.lane, gv, bv);
    u32x2* ROUTE = (u32x2*)(ws + OFF_ROUTE);
    f32x4 rw[16][2];
#pragma unroll
    for (int j = 0; j < 4; ++j)
#pragma unroll
        for (int e = 0; e < 4; ++e) { const float* rp = router + (size_t)(4 * F.lane + 256 * j + e) * 8; rw[4 * j + e][0] = *(const f32x4*)rp; rw[4 * j + e][1] = *(const f32x4*)(rp + 4); }
    const bool b0 = F.lane & 1, b1 = F.lane & 2, b2 = F.lane & 4;
    for (int row = F.gw; row < MTOK; row += F.NGW) {
        f32x4 v[4]; load_row_bf16(S + (size_t)row * 1024, F.lane, v); ln_inplace(v, gv, bv); store_row_bf16(H2 + (size_t)row * 1024, F.lane, v);
        float pl[8];
#pragma unroll
        for (int x = 0; x < 8; ++x) pl[x] = 0.f;
#pragma unroll
        for (int j = 0; j < 4; ++j)
#pragma unroll
            for (int e = 0; e < 4; ++e) { const f32x4 r0 = rw[4 * j + e][0], r1 = rw[4 * j + e][1]; const float hv = v[j][e];
                pl[0] += hv * r0[0]; pl[1] += hv * r0[1]; pl[2] += hv * r0[2]; pl[3] += hv * r0[3]; pl[4] += hv * r1[0]; pl[5] += hv * r1[1]; pl[6] += hv * r1[2]; pl[7] += hv * r1[3]; }
        float k4[4], k2[2], k1;
#pragma unroll
        for (int i = 0; i < 4; ++i) { const float send = b0 ? pl[i] : pl[i + 4]; k4[i] = (b0 ? pl[i + 4] : pl[i]) + __shfl_xor(send, 1); }
#pragma unroll
        for (int i = 0; i < 2; ++i) { const float send = b1 ? k4[i] : k4[i + 2]; k2[i] = (b1 ? k4[i + 2] : k4[i]) + __shfl_xor(send, 2); }
        { const float send = b2 ? k2[0] : k2[1]; k1 = (b2 ? k2[1] : k2[0]) + __shfl_xor(send, 4); }
        k1 += __shfl_xor(k1, 8); k1 += __shfl_xor(k1, 16); k1 += __shfl_xor(k1, 32);
        float lg[8];
#pragma unroll
        for (int x = 0; x < 8; ++x) lg[x] = __int_as_float(__builtin_amdgcn_readlane(__float_as_int(k1), (x >> 2) | (((x >> 1) & 1) << 1) | ((x & 1) << 2)));
        int e0 = 0; float l0 = lg[0];
#pragma unroll
        for (int x = 1; x < 8; ++x) if (lg[x] > l0) { l0 = lg[x]; e0 = x; }
        int e1 = -1; float l1 = -INFINITY;
#pragma unroll
        for (int x = 0; x < 8; ++x) if (x != e0 && lg[x] > l1) { l1 = lg[x]; e1 = x; }
        const float g0 = 1.f / (1.f + __expf(l1 - l0));
        if (F.lane == 0) { u32x2 r; r.x = (unsigned)e0 | ((unsigned)e1 << 8); r.y = __builtin_bit_cast(unsigned, g0); ROUTE[row] = r;
            __hip_atomic_fetch_add(cnt + e0, 1, __ATOMIC_RELAXED, __HIP_MEMORY_SCOPE_WORKGROUP); __hip_atomic_fetch_add(cnt + e1, 1, __ATOMIC_RELAXED, __HIP_MEMORY_SCOPE_WORKGROUP); }
    }
    __syncthreads();
    if (F.tid < 8) ((int*)(ws + OFF_WGCNT))[F.bx * 8 + F.tid] = cnt[F.tid];
    __syncthreads();
}
__device__ __forceinline__ void phase_moe_gather(const Frame& F, const bf16_t* H2, unsigned char* XR, unsigned char* ws) {
    LAS int* L = (LAS int*)(F.lds);
    const int* WGCNT = (const int*)(ws + OFF_WGCNT);
    { const int e = F.wave; int t = 0, p = 0;
#pragma unroll
      for (int k = 0; k < 4; ++k) { const int wg = F.lane + 64 * k; const int c = (wg < F.G) ? WGCNT[wg * 8 + e] : 0; t += c; p += (wg < F.bx) ? c : 0; }
      t = (int)wave_sum((float)t); p = (int)wave_sum((float)p);
      if (F.lane == 0) { L[e] = t; L[8 + e] = p; L[24 + e] = 0; } }
    __syncthreads();
    if (F.tid == 0) { int acc = 0;
        for (int e = 0; e < 8; ++e) { const int pad = (L[e] + 255) / 256 * 256; L[32 + e] = acc; L[16 + e] = acc + L[8 + e]; acc += pad; L[40 + e] = acc; }
        if (F.bx == 0) { int* GI = (int*)(ws + OFF_GINFO); for (int e = 0; e < 8; ++e) { GI[e] = L[40 + e]; GI[8 + e] = L[e]; } } }
    __syncthreads();
    const u32x2* ROUTE = (const u32x2*)(ws + OFF_ROUTE); int* DEST = (int*)(ws + OFF_DEST);
    for (int row = F.gw; row < MTOK; row += F.NGW) {
        const u32x2 r = ROUTE[row]; const int e0 = r.x & 255, e1 = (r.x >> 8) & 255; int s0 = 0, s1 = 0;
        if (F.lane == 0) { s0 = L[16 + e0] + __hip_atomic_fetch_add(L + 24 + e0, 1, __ATOMIC_RELAXED, __HIP_MEMORY_SCOPE_WORKGROUP); s1 = L[16 + e1] + __hip_atomic_fetch_add(L + 24 + e1, 1, __ATOMIC_RELAXED, __HIP_MEMORY_SCOPE_WORKGROUP);
            DEST[2 * row] = s0; DEST[2 * row + 1] = s1; }
        s0 = __builtin_amdgcn_readfirstlane(s0); s1 = __builtin_amdgcn_readfirstlane(s1);
        const u32x4* src = (const u32x4*)(H2 + (size_t)row * 1024) + 2 * F.lane; const u32x4 a = src[0], b = src[1];
        u32x4 o; o.x = pg8::pk4_fp8(bflo(a.x), bfhi(a.x), bflo(a.y), bfhi(a.y)); o.y = pg8::pk4_fp8(bflo(a.z), bfhi(a.z), bflo(a.w), bfhi(a.w));
        o.z = pg8::pk4_fp8(bflo(b.x), bfhi(b.x), bflo(b.y), bfhi(b.y)); o.w = pg8::pk4_fp8(bflo(b.z), bfhi(b.z), bflo(b.w), bfhi(b.w));
        ((u32x4*)(XR + (size_t)s0 * 1024))[F.lane] = o; ((u32x4*)(XR + (size_t)s1 * 1024))[F.lane] = o;
    }
    for (int e = 0; e < 8; ++e) { const int r0 = L[32 + e] + L[e], npad = L[40 + e] - r0;
        for (int i = F.gw; i < npad; i += F.NGW) { u32x4* d = (u32x4*)(XR + (size_t)(r0 + i) * 1024); d[F.lane] = (u32x4){0u, 0u, 0u, 0u}; } }
    __syncthreads();
}
__device__ __forceinline__ void phase_final(const Frame& F, const bf16_t* H2, const bf16_t* YR, const float* g, const float* b, float* out, unsigned char* ws) {
    f32x4 gv[4], bv[4]; load_gb(g, b, F.lane, gv, bv);
    const u32x2* ROUTE = (const u32x2*)(ws + OFF_ROUTE); const int* DEST = (const int*)(ws + OFF_DEST);
    for (int row = F.gw; row < MTOK; row += F.NGW) {
        const u32x2 rte = ROUTE[row]; const float g0 = __uint_as_float(rte.y), g1 = 1.f - g0;   const int d0 = DEST[2 * row], d1 = DEST[2 * row + 1];
        f32x4 v[4], y0[4], y1[4]; load_row_bf16(H2 + (size_t)row * 1024, F.lane, v); load_row_bf16(YR + (size_t)d0 * 1024, F.lane, y0); load_row_bf16(YR + (size_t)d1 * 1024, F.lane, y1);
#pragma unroll
        for (int j = 0; j < 4; ++j) v[j] = v[j] * ALPHA + y0[j] * g0 + y1[j] * g1;
        ln_inplace(v, gv, bv);
#pragma unroll
        for (int j = 0; j < 4; ++j) *(f32x4*)(out + (size_t)row * 1024 + 4 * F.lane + 256 * j) = v[j];
    }
}

namespace att {
constexpr float NEG_BIG = -1e30f;
constexpr int KS64 = 144, VS64 = 192, KT64 = 64 * KS64, VT64 = 64 * VS64;
constexpr int KS128 = 272, VS128 = 320, KT128 = 64 * KS128, VT128 = 64 * VS128;
typedef LAS char* lptr; typedef const LAS char* lcptr;
typedef short v4i16_t __attribute__((ext_vector_type(4)));
__device__ __forceinline__ s16x4 vtr(lcptr p) { return __builtin_bit_cast(s16x4, __builtin_amdgcn_ds_read_tr16_b64_v4i16((LAS v4i16_t*)p)); }
__device__ __forceinline__ f32x16 splat16(float c) { f32x16 v;
#pragma unroll
    for (int r = 0; r < 16; ++r) v[r] = c; return v; }
__device__ __forceinline__ int crow(int r, int hi) { return (r & 3) + 8 * (r >> 2) + 4 * hi; }
__device__ __forceinline__ float ex2(float x) { return __builtin_amdgcn_exp2f(x); }

template <int NKS> __device__ __forceinline__ void qk(f32x16& s0, f32x16& s1, lcptr Kt, int kstride, const bf16x8 (&qf)[NKS], float c0, int r32, int hi) {
    s0 = splat16(c0); s1 = splat16(c0);
    lcptr p0 = Kt + r32 * kstride + hi * 16; lcptr p1 = p0 + 32 * kstride;
#pragma unroll
    for (int ks = 0; ks < NKS; ++ks) { const bf16x8 k0 = *(const LAS bf16x8*)(p0 + ks * 32), k1 = *(const LAS bf16x8*)(p1 + ks * 32);
        s0 = __builtin_amdgcn_mfma_f32_32x32x16_bf16(k0, qf[ks], s0, 0, 0, 0); s1 = __builtin_amdgcn_mfma_f32_32x32x16_bf16(k1, qf[ks], s1, 0, 0, 0); }
}
__device__ __forceinline__ float rowmax32(const f32x16& s0, const f32x16& s1) {
    float a = fmaxf(s0[0], s1[0]);
#pragma unroll
    for (int r = 1; r < 16; ++r) a = fmaxf(a, fmaxf(s0[r], s1[r]));
    return fmaxf(a, __shfl_xor(a, 32));
}
template <int NDT> __device__ __forceinline__ void softmax_step(f32x16& s0, f32x16& s1, float& m, float& l, f32x16 (&o)[NDT]) {
    const float mn = fmaxf(m, rowmax32(s0, s1)); float rs = 0.f;
    if (__any(mn > m)) {
        const float al = ex2(m - mn); l *= al;
#pragma unroll
        for (int d = 0; d < NDT; ++d)
#pragma unroll
            for (int r = 0; r < 16; ++r) o[d][r] *= al;
    }
    m = mn;
#pragma unroll
    for (int r = 0; r < 16; ++r) { s0[r] = ex2(s0[r] - mn); s1[r] = ex2(s1[r] - mn); rs += s0[r] + s1[r]; }
    l += rs;
}
__device__ __forceinline__ bf16x8 pack_p(const f32x16& s, int base) { u32x4 w; w.x = pk2(s[base], s[base + 1]); w.y = pk2(s[base + 2], s[base + 3]); w.z = pk2(s[base + 4], s[base + 5]); w.w = pk2(s[base + 6], s[base + 7]); return __builtin_bit_cast(bf16x8, w); }
template <int NDT> __device__ __forceinline__ void pv(f32x16 (&o)[NDT], const f32x16& s0, const f32x16& s1, lcptr Vt, int vstride, int lane) {
    const bf16x8 pk[4] = {pack_p(s0, 0), pack_p(s0, 8), pack_p(s1, 0), pack_p(s1, 8)};
    const int h = lane >> 5, g = (lane >> 4) & 1, q = (lane & 15) >> 2, p = lane & 3;
    lcptr vb = Vt + (4 * h + q) * vstride + (16 * g + 4 * p) * 2;
#pragma unroll
    for (int k = 0; k < 4; ++k)
#pragma unroll
        for (int d = 0; d < NDT; ++d) { const s16x4 lo = vtr(vb + (16 * k) * vstride + d * 64), hh = vtr(vb + (16 * k + 8) * vstride + d * 64);
            const bf16x8 vf = (bf16x8){lo[0], lo[1], lo[2], lo[3], hh[0], hh[1], hh[2], hh[3]};
            o[d] = __builtin_amdgcn_mfma_f32_32x32x16_bf16(vf, pk[k], o[d], 0, 0, 0); }
}

__device__ __forceinline__ void exp_step(f32x16& s0, f32x16& s1, float& l) {
    float rs = 0.f;
#pragma unroll
    for (int r = 0; r < 16; ++r) { s0[r] = ex2(s0[r]); s1[r] = ex2(s1[r]); rs += s0[r] + s1[r]; }
    l += rs;
}

__device__ __forceinline__ void qk2(f32x16& a0, f32x16& a1, f32x16& b0, f32x16& b1, lcptr Kt, const bf16x8 (&qa)[4], const bf16x8 (&qb)[4], int r32, int hi) {
    a0 = splat16(0.f); a1 = splat16(0.f); b0 = splat16(0.f); b1 = splat16(0.f);
    lcptr p0 = Kt + r32 * KS64 + hi * 16; lcptr p1 = p0 + 32 * KS64;
#pragma unroll
    for (int ks = 0; ks < 4; ++ks) { const bf16x8 k0 = *(const LAS bf16x8*)(p0 + ks * 32), k1 = *(const LAS bf16x8*)(p1 + ks * 32);
        a0 = __builtin_amdgcn_mfma_f32_32x32x16_bf16(k0, qa[ks], a0, 0, 0, 0); b0 = __builtin_amdgcn_mfma_f32_32x32x16_bf16(k0, qb[ks], b0, 0, 0, 0);
        a1 = __builtin_amdgcn_mfma_f32_32x32x16_bf16(k1, qa[ks], a1, 0, 0, 0); b1 = __builtin_amdgcn_mfma_f32_32x32x16_bf16(k1, qb[ks], b1, 0, 0, 0); }
}
__device__ __forceinline__ void pv2(f32x16 (&oa)[2], f32x16 (&ob)[2], const bf16x8 (&pa)[4], const bf16x8 (&pb)[4], lcptr Vt, int lane) {
    const int h = lane >> 5, g = (lane >> 4) & 1, q = (lane & 15) >> 2, p = lane & 3;
    lcptr vb = Vt + (4 * h + q) * VS64 + (16 * g + 4 * p) * 2;
#pragma unroll
    for (int k = 0; k < 4; ++k)
#pragma unroll
        for (int d = 0; d < 2; ++d) { const s16x4 lo = vtr(vb + (16 * k) * VS64 + d * 64), hh = vtr(vb + (16 * k + 8) * VS64 + d * 64);
            const bf16x8 vf = (bf16x8){lo[0], lo[1], lo[2], lo[3], hh[0], hh[1], hh[2], hh[3]};
            oa[d] = __builtin_amdgcn_mfma_f32_32x32x16_bf16(vf, pa[k], oa[d], 0, 0, 0); ob[d] = __builtin_amdgcn_mfma_f32_32x32x16_bf16(vf, pb[k], ob[d], 0, 0, 0); }
}
__device__ __forceinline__ void bias_mask_near(f32x16& s0, f32x16& s1, const LAS float* bt, int t, int kp0, int hi, unsigned maxdist) {
#pragma unroll
    for (int q4 = 0; q4 < 4; ++q4) {
        float bb[8]; f32x16& s = (q4 & 2) ? s1 : s0; const int r0 = 8 * (q4 & 1), kq = kp0 + 32 * (q4 >> 1);
#pragma unroll
        for (int r = 0; r < 8; ++r) { const int d = t - (kq + crow(r0 + r, hi)); const unsigned ix = (unsigned)d < 127u ? (unsigned)d : 127u; bb[r] = bt[ix]; }
#pragma unroll
        for (int r = 0; r < 8; ++r) asm volatile("" : "+v"(bb[r]));
#pragma unroll
        for (int r = 0; r < 8; ++r) { const int d = t - (kq + crow(r0 + r, hi)); s[r0 + r] = ((unsigned)d < maxdist) ? s[r0 + r] + bb[r] : -INFINITY; }
    }
}
__device__ __forceinline__ void mask_all(f32x16& s0, f32x16& s1) {
#pragma unroll
    for (int r = 0; r < 16; ++r) { s0[r] = -INFINITY; s1[r] = -INFINITY; }
}
__device__ __forceinline__ void store_o64(bf16_t* orow, const f32x16 (&o)[2], float sc, int hi) {
#pragma unroll
    for (int d = 0; d < 2; ++d)
#pragma unroll
        for (int rg = 0; rg < 4; ++rg) { u32x2 w; w.x = pk2(o[d][4 * rg] * sc, o[d][4 * rg + 1] * sc); w.y = pk2(o[d][4 * rg + 2] * sc, o[d][4 * rg + 3] * sc);
            *(u32x2*)(orow + 32 * d + 8 * rg + 4 * hi) = w; }
}
__device__ __forceinline__ void store_o64_fp8(unsigned char* orow, const f32x16 (&o)[2], float sc, int hi) {
#pragma unroll
    for (int d = 0; d < 2; ++d)
#pragma unroll
        for (int rg = 0; rg < 4; ++rg) *(unsigned*)(orow + 32 * d + 8 * rg + 4 * hi) = pg8::pk4_fp8(o[d][4 * rg] * sc, o[d][4 * rg + 1] * sc, o[d][4 * rg + 2] * sc, o[d][4 * rg + 3] * sc);
}
template <class Src, class Proc> __device__ __forceinline__ void tile_loop64(int tid, lptr base, int nt, int pitch, Src src, Proc proc) {
    if (nt <= 0) return;
    const int row = tid >> 3, ch = tid & 7; u32x4 kr, vr;
    lptr Kb = base, Vb = base + 2 * KT64;
    { const bf16_t *kp, *vp; src(0, kp, vp); kr = *(const u32x4*)(kp + (size_t)row * pitch + ch * 8); vr = *(const u32x4*)(vp + (size_t)row * pitch + ch * 8); }
    *(LAS u32x4*)(Kb + row * KS64 + ch * 16) = kr; *(LAS u32x4*)(Vb + row * VS64 + ch * 16) = vr;
    __syncthreads();
    for (int i = 0; i < nt; ++i) {
        const bool more = i + 1 < nt;
        if (more) { const bf16_t *kp, *vp; src(i + 1, kp, vp); kr = *(const u32x4*)(kp + (size_t)row * pitch + ch * 8); vr = *(const u32x4*)(vp + (size_t)row * pitch + ch * 8); }
        proc(i, (lcptr)(Kb + (i & 1) * KT64), (lcptr)(Vb + (i & 1) * VT64));
        if (more) { *(LAS u32x4*)(Kb + ((i + 1) & 1) * KT64 + row * KS64 + ch * 16) = kr; *(LAS u32x4*)(Vb + ((i + 1) & 1) * VT64 + row * VS64 + ch * 16) = vr; }
        __syncthreads();
    }
}

template <int ROWB, int KSTR, int VSTR, int VAR = 0, class SrcK, class SrcV, class Score, class Accum>
__device__ __forceinline__ void tile_loop_p(int tid, lptr base, int nt, int pitch, SrcK srck, SrcV srcv, Score score, Accum accum) {
    if (nt <= 0) return;
    constexpr int CPR = ROWB / 16, NCH = (64 * CPR) / 512, KT = 64 * KSTR, VT = 64 * VSTR;
    lptr Kb = base, Vb = base + 2 * KT;
    u32x4 kr0[NCH], vr0[NCH], kr1[NCH], vr1[NCH];
    auto gld = [&](const bf16_t* p, u32x4 (&r)[NCH]) {
#pragma unroll
        for (int c = 0; c < NCH; ++c) { const int idx = tid + 512 * c, rr = idx / CPR, ch = idx % CPR; r[c] = *(const u32x4*)(p + (size_t)rr * pitch + ch * 8); } };
    auto lst = [&](lptr dst, int stride, const u32x4 (&r)[NCH]) {
#pragma unroll
        for (int c = 0; c < NCH; ++c) { const int idx = tid + 512 * c, rr = idx / CPR, ch = idx % CPR; *(LAS u32x4*)(dst + rr * stride + ch * 16) = r[c]; } };
    gld(srck(0), kr0); gld(srcv(0), vr0); lst(Kb, KSTR, kr0); lst(Vb, VSTR, vr0);
    if (nt > 1) { gld(srck(1), kr0); lst(Kb + KT, KSTR, kr0); }
    if (nt > 2) gld(srck(2), kr1);
    if (nt > 1) gld(srcv(1), vr1);
    __syncthreads();
    f32x16 a0, a1, b0, b1; bool aact = score(0, (lcptr)Kb, a0, a1), bact = false;
    auto step = [&](int i, f32x16& c0, f32x16& c1, bool& cact, f32x16& n0, f32x16& n1, bool& nact, u32x4 (&kL)[NCH], u32x4 (&vL)[NCH], u32x4 (&kS)[NCH], u32x4 (&vS)[NCH]) {
        const bool m1 = i + 1 < nt, m2 = i + 2 < nt, m3 = i + 3 < nt;
        if (VAR != 7) { if (m3) gld(srck(i + 3), kL);
        if (m2) gld(srcv(i + 2), vL); }
        nact = false;
        if (m1) nact = score(i + 1, (lcptr)(Kb + ((i + 1) & 1) * KT), n0, n1);
        if (cact) accum(i, (lcptr)(Vb + (i & 1) * VT), c0, c1);
        if (VAR != 7) { if (m2) lst(Kb + (i & 1) * KT, KSTR, kS);
        if (m1) lst(Vb + ((i + 1) & 1) * VT, VSTR, vS); }
        __syncthreads();
    };
    for (int i = 0; i < nt; i += 2) { step(i, a0, a1, aact, b0, b1, bact, kr0, vr0, kr1, vr1); if (i + 1 < nt) step(i + 1, b0, b1, bact, a0, a1, aact, kr1, vr1, kr0, vr0); }
}

template <int ROWB, int KSTR, int VSTR, class SrcK, class SrcV, class Score, class Accum>
__device__ __forceinline__ void tile_loop_pp(int tid, int grp, lptr base, int nt, int pitch, SrcK srck, SrcV srcv, Score score, Accum accum) {
    if (nt <= 0) return;
    constexpr int CPR = ROWB / 16, NCH = (64 * CPR) / 512, KT = 64 * KSTR, VT = 64 * VSTR;
    lptr Kb = base, Vb = base + 2 * KT;
    u32x4 kr0[NCH], vr0[NCH], kr1[NCH], vr1[NCH];
    auto gld = [&](const bf16_t* p, u32x4 (&r)[NCH]) {
#pragma unroll
        for (int c = 0; c < NCH; ++c) { const int idx = tid + 512 * c, rr = idx / CPR, ch = idx % CPR; r[c] = *(const u32x4*)(p + (size_t)rr * pitch + ch * 8); } };
    auto lst = [&](lptr dst, int stride, const u32x4 (&r)[NCH]) {
#pragma unroll
        for (int c = 0; c < NCH; ++c) { const int idx = tid + 512 * c, rr = idx / CPR, ch = idx % CPR; *(LAS u32x4*)(dst + rr * stride + ch * 16) = r[c]; } };
    gld(srck(0), kr0); gld(srcv(0), vr0); lst(Kb, KSTR, kr0); lst(Vb, VSTR, vr0);
    if (nt > 1) { gld(srck(1), kr0); gld(srcv(1), vr0); }
    if (nt > 2) { gld(srck(2), kr1); gld(srcv(2), vr1); }
    __syncthreads();
    f32x16 s0, s1; bool act = false;
    const int nslot = 2 * nt + 1;
    auto slot_fn = [&](int slot, u32x4 (&kS)[NCH], u32x4 (&vS)[NCH]) {
        const int my = slot - grp;
        if (my >= 0 && my < 2 * nt) { const int i = my >> 1;
            if (!(my & 1)) act = score(i, (lcptr)(Kb + (i & 1) * KT), s0, s1);
            else if (act) accum(i, (lcptr)(Vb + (i & 1) * VT), s0, s1); }
        if (slot & 1) { const int j = (slot >> 1) + 1;
            if (j < nt) { lst(Kb + (j & 1) * KT, KSTR, kS); lst(Vb + (j & 1) * VT, VSTR, vS); }
            if (j + 2 < nt) { gld(srck(j + 2), kS); gld(srcv(j + 2), vS); } }
        __syncthreads();
    };
    for (int slot = 0; slot < nslot; slot += 4) {
        slot_fn(slot, kr0, vr0);
        if (slot + 1 < nslot) slot_fn(slot + 1, kr0, vr0);
        if (slot + 2 < nslot) slot_fn(slot + 2, kr1, vr1);
        if (slot + 3 < nslot) slot_fn(slot + 3, kr1, vr1);
    }
}

template <int VAR = 0, class SrcK, class SrcV, class Post>
__device__ __forceinline__ void tile_loop_f(int tid, int lane, lptr base, int nt, int pitch, const bf16x8 (&qf)[4], f32x16 (&o)[2], float& l, SrcK srck, SrcV srcv, Post post) {
    if (nt <= 0) return;
    const int r32 = lane & 31, hi = lane >> 5;
    lptr Kb = base, Vb = base + 2 * KT64;
    const int rr = tid >> 3, ch = tid & 7;
    u32x4 kr0, vr0, kr1, vr1;
    auto gld = [&](const bf16_t* p) { return *(const u32x4*)(p + (size_t)rr * pitch + ch * 8); };
    kr0 = gld(srck(0)); vr0 = gld(srcv(0)); *(LAS u32x4*)(Kb + rr * KS64 + ch * 16) = kr0; *(LAS u32x4*)(Vb + rr * VS64 + ch * 16) = vr0;
    if (nt > 1) { kr0 = gld(srck(1)); *(LAS u32x4*)(Kb + KT64 + rr * KS64 + ch * 16) = kr0; }
    if (nt > 2) kr1 = gld(srck(2));
    if (nt > 1) vr1 = gld(srcv(1));
    __syncthreads();
    f32x16 a0, a1, b0, b1; bool aact, bact = false;
    qk<4>(a0, a1, (lcptr)Kb, KS64, qf, 0.f, r32, hi); aact = post(0, a0, a1);
    auto step = [&](int i, f32x16& c0, f32x16& c1, bool& cact, f32x16& n0, f32x16& n1, bool& nact, u32x4& kL, u32x4& vL, u32x4& kS, u32x4& vS) {
        const bool m1 = i + 1 < nt, m2 = i + 2 < nt, m3 = i + 3 < nt;
        if (m3) kL = gld(srck(i + 3));
        if (m2) vL = gld(srcv(i + 2));
        lcptr Kt = (lcptr)(Kb + ((i + 1) & 1) * KT64), Vt = (lcptr)(Vb + (i & 1) * VT64);
        if (m1 && cact) {
            lcptr p0 = Kt + r32 * KS64 + hi * 16; lcptr p1 = p0 + 32 * KS64;
            bf16x8 ka[4], kb[4];
#pragma unroll
            for (int ks = 0; ks < 4; ++ks) { if (VAR == 8 || VAR == 9) { ka[ks] = qf[ks]; kb[ks] = qf[3 - ks]; } else { ka[ks] = *(const LAS bf16x8*)(p0 + ks * 32); kb[ks] = *(const LAS bf16x8*)(p1 + ks * 32); } }
            n0 = splat16(0.f); n1 = splat16(0.f); float rs = 0.f;
            __builtin_amdgcn_sched_barrier(0);
#pragma unroll
            for (int ks = 0; ks < 4; ++ks) {
                n0 = __builtin_amdgcn_mfma_f32_32x32x16_bf16(ka[ks], qf[ks], n0, 0, 0, 0); n1 = __builtin_amdgcn_mfma_f32_32x32x16_bf16(kb[ks], qf[ks], n1, 0, 0, 0);
#pragma unroll
                for (int e = 0; e < 4; ++e) { c0[4 * ks + e] = ex2(c0[4 * ks + e]); c1[4 * ks + e] = ex2(c1[4 * ks + e]); rs += c0[4 * ks + e] + c1[4 * ks + e]; }
                __builtin_amdgcn_sched_barrier(0);
            }
            l += rs;
            if (VAR == 8 || VAR == 10) { const bf16x8 pk0 = pack_p(c0, 0), pk1 = pack_p(c0, 8), pk2_ = pack_p(c1, 0), pk3 = pack_p(c1, 8);
#pragma unroll
                for (int d = 0; d < 2; ++d) { o[d] = __builtin_amdgcn_mfma_f32_32x32x16_bf16(qf[0], pk0, o[d], 0, 0, 0); o[d] = __builtin_amdgcn_mfma_f32_32x32x16_bf16(qf[1], pk1, o[d], 0, 0, 0);
                    o[d] = __builtin_amdgcn_mfma_f32_32x32x16_bf16(qf[2], pk2_, o[d], 0, 0, 0); o[d] = __builtin_amdgcn_mfma_f32_32x32x16_bf16(qf[3], pk3, o[d], 0, 0, 0); } }
            else pv<2>(o, c0, c1, Vt, VS64, lane);
            nact = post(i + 1, n0, n1);
        } else {
            if (cact) { exp_step(c0, c1, l); pv<2>(o, c0, c1, Vt, VS64, lane); }
            nact = false;
            if (m1) { qk<4>(n0, n1, Kt, KS64, qf, 0.f, r32, hi); nact = post(i + 1, n0, n1); }
        }
        if (m2) *(LAS u32x4*)(Kb + (i & 1) * KT64 + rr * KS64 + ch * 16) = kS;
        if (m1) *(LAS u32x4*)(Vb + ((i + 1) & 1) * VT64 + rr * VS64 + ch * 16) = vS;
        __syncthreads();
    };
    for (int i = 0; i < nt; i += 2) { step(i, a0, a1, aact, b0, b1, bact, kr0, vr0, kr1, vr1); if (i + 1 < nt) step(i + 1, b0, b1, bact, a0, a1, aact, kr1, vr1, kr0, vr0); }
}
constexpr int TL64_BYTES = 2 * KT64 + 2 * VT64;
}

#ifndef PP_GRP
#define PP_GRP (w & 1)
#endif
template <int var> __device__ __forceinline__ void moba_unit(const Frame& F, int b, int h, int qb, const bf16_t* Q, const bf16_t* K, const bf16_t* V, const float* KMEAN, const float* BT, unsigned char* O8) {
    using namespace att;
    const int lane = F.lane, r32 = lane & 31, hi = lane >> 5, w = F.wave;
    lptr lds = (lptr)F.lds; lptr tl = lds; LAS float* BTL = (LAS float*)(lds + TL64_BYTES); lptr KM = lds + TL64_BYTES + 512;
    const int t = 256 * qb + 32 * w + r32; const size_t row = (size_t)b * SEQ + t;
    bf16x8 qf[4];
#pragma unroll
    for (int ks = 0; ks < 4; ++ks) qf[ks] = *(const bf16x8*)(Q + row * 1024 + h * 64 + 16 * ks + 8 * hi);
    if (F.tid < 128) BTL[F.tid] = BT[h * 128 + F.tid] - BT[h * 128 + 127];
    { const int idx = F.tid * 2, j = idx >> 6, d = idx & 63; const float* kmp = KMEAN + (size_t)(b * 16 + j) * 2048 + h * 64 + d;
      *(LAS unsigned*)(KM + j * KS64 + d * 2) = (j < qb) ? pk2(kmp[0] + kmp[1024], kmp[1] + kmp[1025]) : 0u;
      *(LAS unsigned*)(KM + (16 + j) * KS64 + d * 2) = 0u; }
    __syncthreads();
    unsigned selmask = 0u;
    if (qb > 0) {
        f32x16 gs = splat16(0.f);
        { lcptr p0 = (lcptr)KM + r32 * KS64 + hi * 16;
#pragma unroll
          for (int ks = 0; ks < 4; ++ks) { const bf16x8 k0 = *(const LAS bf16x8*)(p0 + ks * 32); gs = __builtin_amdgcn_mfma_f32_32x32x16_bf16(k0, qf[ks], gs, 0, 0, 0); } }
        float glo[8], ghi[8];
#pragma unroll
        for (int r = 0; r < 8; ++r) { const float mine = gs[r], oth = __shfl_xor(mine, 32); glo[r] = hi ? oth : mine; ghi[r] = hi ? mine : oth; }
#pragma unroll
        for (int rep = 0; rep < 3; ++rep) { float best = -INFINITY; int bj = -1;
#pragma unroll
            for (int j = 0; j < 16; ++j) { const int r = (j & 3) + 4 * (j >> 3); const float gv = ((j >> 2) & 1) ? ghi[r] : glo[r];
                if (j < qb && !((selmask >> j) & 1u) && gv > best) { best = gv; bj = j; } }
            if (bj >= 0) selmask |= 1u << bj; }
    }
    f32x16 o[2] = {splat16(0.f), splat16(0.f)}; float l = 0.f;
    const int nt = 4 * (qb + 1); const int twmax = 256 * qb + 32 * w + 31;
    const bf16_t* Kh = K + (size_t)b * SEQ * 1024 + h * 64; const bf16_t* Vh = V + (size_t)b * SEQ * 1024 + h * 64;
    tile_loop_f<var>(F.tid, lane, tl, nt, 1024, qf, o, l,
        [&](int i) { return Kh + (size_t)(64 * i) * 1024; }, [&](int i) { return Vh + (size_t)(64 * i) * 1024; },
        [&](int i, f32x16& s0, f32x16& s1) -> bool {
            const int blk = i >> 2, kp0 = 64 * i;
            if (blk < qb) {
                const bool sel = (selmask >> blk) & 1u;
                if (!__any(sel)) return false;
                if (!(blk < qb - 1 || (i & 3) < 2)) bias_mask_near(s0, s1, BTL, t, kp0, hi, 0x7fffffffu);
                if (!sel) mask_all(s0, s1);
            } else {
                if (kp0 > twmax) return false;
                bias_mask_near(s0, s1, BTL, t, kp0, hi, 0x7fffffffu);
            }
            return true; });
    l += __shfl_xor(l, 32);
    store_o64_fp8(O8 + row * 1024 + h * 64, o, l > 0.f ? OSC / l : 0.f, hi);
}
__device__ __forceinline__ void phase_moba(const Frame& F, unsigned char* ws, int var) {
    const bf16_t* Q = (const bf16_t*)(ws + OFF_QKV); const bf16_t* K = Q + (size_t)MTOK * 1024; const bf16_t* V = K + (size_t)MTOK * 1024;
    const float* KMEAN = (const float*)(ws + OFF_KMEAN); const float* BT = (const float*)(ws + OFF_BT);
    for (int idx = F.bx; idx < 2048; idx += F.G) { const int i = idx >> 8, v = idx & 255, x = v & 7, j = v >> 3, bh = 16 * x + 2 * i + (j >> 4), b = bh >> 4, h = bh & 15, p = ((j & 15) + 4 * (i >> 1)) & 15, qb = (i & 1) ? 15 - p : p;

#ifdef MOBA_VAR
        if (var == MOBA_VAR) moba_unit<MOBA_VAR>(F, b, h, qb, Q, K, V, KMEAN, BT, ws + OFF_O8); else
#endif
        moba_unit<0>(F, b, h, qb, Q, K, V, KMEAN, BT, ws + OFF_O8);
        __syncthreads(); }
}

constexpr int MB_KB = 0, MB_VB = 256 * att::KS64, MB_SELM = MB_VB + 256 * att::VS64, MB_LIST = MB_SELM + 4096, MB_CNT = MB_LIST + 12800, MB_FILL = MB_CNT + 64, MB_LOFF = MB_FILL + 64,
              MB_BTL = MB_LOFF + 128, MB_KM = MB_BTL + 512, MB_QC = MB_KM + 32 * att::KS64, MB_END = MB_QC + 64;
constexpr int MST_ROW = 136;
__device__ __forceinline__ void moba2_unit(const Frame& F, int b, int h, int par, int unit, const bf16_t* Q, const bf16_t* K, const bf16_t* V, const float* KMEAN, const float* BT, unsigned char* O8, unsigned char* MST, int abl = 0) {
    using namespace att;
    int tid = F.tid; asm volatile("" : "+v"(tid));
    const int lane = tid & 63, lane_ = lane, r32 = lane & 31, hi = lane >> 5, w = F.wave;
    lptr lds = (lptr)F.lds; lptr KB = lds + MB_KB, VB = lds + MB_VB; LAS unsigned short* SELM = (LAS unsigned short*)(lds + MB_SELM); LAS unsigned short* LIST = (LAS unsigned short*)(lds + MB_LIST);
    LAS int* CNT = (LAS int*)(lds + MB_CNT); LAS int* FILL = (LAS int*)(lds + MB_FILL); LAS int* LOFF = (LAS int*)(lds + MB_LOFF); LAS float* BTL = (LAS float*)(lds + MB_BTL); lptr KM = lds + MB_KM;
    unsigned char* ST = MST + (size_t)unit * 2048 * MST_ROW; float* STL = (float*)(ST + 2048 * 128);
    const bf16_t* Qh = Q + (size_t)b * SEQ * 1024 + h * 64; const bf16_t* Kh = K + (size_t)b * SEQ * 1024 + h * 64; const bf16_t* Vh = V + (size_t)b * SEQ * 1024 + h * 64;
    if (tid < 128) BTL[tid] = BT[h * 128 + tid] - BT[h * 128 + 127];
    { const int idx = tid * 2, j = idx >> 6, d = idx & 63; const float* kmp = KMEAN + (size_t)(b * 16 + j) * 2048 + h * 64 + d;
      *(LAS unsigned*)(KM + j * KS64 + d * 2) = pk2(kmp[0] + kmp[1024], kmp[1] + kmp[1025]); *(LAS unsigned*)(KM + (16 + j) * KS64 + d * 2) = 0u; }
    LAS int* QC = (LAS int*)(lds + MB_QC);
    if (tid < 16) { CNT[tid] = 0; FILL[tid] = 0; QC[tid] = 0; }
    for (int i = tid; i < 2048 * MST_ROW / 16; i += NTHR) ((u32x4*)ST)[i] = (u32x4){0u, 0u, 0u, 0u};
    __syncthreads();
#pragma unroll 1
    for (int m8 = 0; m8 < 8; ++m8) { const int gi = w + 8 * m8, k = gi >> 3, sub = gi & 7, qb = 2 * k + par, q = 32 * sub + r32; const size_t trow = (size_t)(256 * qb + q);
        unsigned selmask = 0u;
        if (qb > 0) {
            bf16x8 qf[4];
#pragma unroll
            for (int ks = 0; ks < 4; ++ks) qf[ks] = *(const bf16x8*)(Qh + trow * 1024 + 16 * ks + 8 * hi);
            f32x16 gs = splat16(0.f);
            { lcptr p0 = (lcptr)KM + r32 * KS64 + hi * 16;
#pragma unroll
              for (int ks = 0; ks < 4; ++ks) { const bf16x8 k0 = *(const LAS bf16x8*)(p0 + ks * 32); gs = __builtin_amdgcn_mfma_f32_32x32x16_bf16(k0, qf[ks], gs, 0, 0, 0); } }
            float glo[8], ghi[8];
#pragma unroll
            for (int r = 0; r < 8; ++r) { const float mine = gs[r], oth = __shfl_xor(mine, 32); glo[r] = hi ? oth : mine; ghi[r] = hi ? mine : oth; }
#pragma unroll
            for (int rep = 0; rep < 3; ++rep) { float best = -INFINITY; int bj = -1;
#pragma unroll
                for (int j = 0; j < 16; ++j) { const int r = (j & 3) + 4 * (j >> 3); const float gv = ((j >> 2) & 1) ? ghi[r] : glo[r];
                    if (j < qb && !((selmask >> j) & 1u) && gv > best) { best = gv; bj = j; } }
                if (bj >= 0) selmask |= 1u << bj; }
        }
        if (hi == 0) { SELM[k * 256 + q] = (unsigned short)selmask; unsigned mm = selmask; while (mm) { const int j = __builtin_ctz(mm); mm &= mm - 1u; __hip_atomic_fetch_add(CNT + j, 1, __ATOMIC_RELAXED, __HIP_MEMORY_SCOPE_WORKGROUP); } }
    }
    __syncthreads();
    if (tid == 0) { int acc = 0; for (int j = 0; j < 16; ++j) { LOFF[j] = acc; acc += CNT[j]; } LOFF[16] = acc; }
    __syncthreads();
    for (int lq = tid; lq < 2048; lq += NTHR) { unsigned mm = SELM[lq]; while (mm) { const int j = __builtin_ctz(mm); mm &= mm - 1u; const int pos = __hip_atomic_fetch_add(FILL + j, 1, __ATOMIC_RELAXED, __HIP_MEMORY_SCOPE_WORKGROUP); LIST[LOFF[j] + pos] = (unsigned short)lq; } }
#ifdef REP_PHASE
    if (abl == 2) return;
#endif
    u32x4 kreg[4], vreg[4];
    auto gblk = [&](int j) { int td = tid; asm volatile("" : "+v"(td));
#pragma unroll
        for (int i = 0; i < 4; ++i) { const int c = td + 512 * i, rr = c >> 3, ch = c & 7; kreg[i] = *(const u32x4*)(Kh + (size_t)(256 * j + rr) * 1024 + ch * 8); vreg[i] = *(const u32x4*)(Vh + (size_t)(256 * j + rr) * 1024 + ch * 8); } };
    gblk(0);
    __syncthreads();
    for (int j = 0; j < 16; ++j) {
        { int td = tid; asm volatile("" : "+v"(td));
#pragma unroll
        for (int i = 0; i < 4; ++i) { const int c = td + 512 * i, rr = c >> 3, ch = c & 7; *(LAS u32x4*)(KB + rr * KS64 + ch * 16) = kreg[i]; *(LAS u32x4*)(VB + rr * VS64 + ch * 16) = vreg[i]; } }
        __syncthreads();
        gblk(j + 1 < 16 ? j + 1 : 15);
        const int nj = CNT[j], ngp = (nj + 31) >> 5, ngo = ((j & 1) == par) ? 8 : 0;
        const int nit = ngo + ngp;
        auto grab = [&]() { int it = 0; if (lane == 0) it = __hip_atomic_fetch_add(QC + j, 1, __ATOMIC_RELAXED, __HIP_MEMORY_SCOPE_WORKGROUP); return __builtin_amdgcn_readfirstlane(it); };
        auto decode = [&](int it, int& t, int& lq, bool& va) {
            if (it < ngo) { const int gidx = ngo - 1 - it; lq = (j >> 1) * 256 + 32 * gidx + r32; t = 256 * j + 32 * gidx + r32; va = true; }
            else { const int gidx = it - ngo, sa = 32 * gidx + r32; va = sa < nj; lq = LIST[LOFF[j] + (va ? sa : 32 * gidx)]; t = 256 * (2 * (lq >> 8) + par) + (lq & 255); } };
        auto issue = [&](int t, int lq, bf16x8 (&q)[4], u32x4 (&st)[4], float& stl) {
#pragma unroll
            for (int ks = 0; ks < 4; ++ks) q[ks] = *(const bf16x8*)(Qh + (size_t)t * 1024 + 16 * ks + 8 * hi);
            const unsigned char* strow = ST + (size_t)lq * 128 + 64 * hi;
#pragma unroll
            for (int k = 0; k < 4; ++k) st[k] = *(const u32x4*)(strow + 16 * k);
            stl = STL[lq]; };
        int it = grab(), t = 0, lq = 0; bool va = false; bf16x8 qc[4] = {}; u32x4 stc[4] = {}; float stlc = 0.f;
        if (it < nit) { decode(it, t, lq, va); issue(t, lq, qc, stc, stlc); }
        while (it < nit) {
            const int itn = grab(); int tn = 0, lqn = 0; bool van = false; bf16x8 qn[4] = {}; u32x4 stn[4] = {}; float stln = 0.f;
            if (itn < nit) { decode(itn, tn, lqn, van); issue(tn, lqn, qn, stn, stln); }
            const bool own = it < ngo; int ntile = own ? ((32 * (ngo - 1 - it) + 31) >> 6) + 1 : 4;
#ifdef REP_PHASE
            if (abl == 1) ntile = 0;
#endif
            const bool nearany = own || __any((t >> 8) == j + 1);
            f32x16 o[2] = {splat16(0.f), splat16(0.f)}; float l = 0.f;
            for (int i = 0; i < ntile; ++i) { f32x16 s0, s1;
                qk<4>(s0, s1, (lcptr)(KB + i * KT64), KS64, qc, 0.f, r32, hi);
                if (nearany && (own || i >= 2)) bias_mask_near(s0, s1, BTL, t, 256 * j + 64 * i, hi, 0x7fffffffu);
                exp_step(s0, s1, l); pv<2>(o, s0, s1, (lcptr)(VB + i * VT64), VS64, lane); }
            l += __shfl_xor(l, 32);
            if (own) {
                const float lt = l + stlc; const float f = lt > 0.f ? OSC / lt : 0.f;
                unsigned char* orow = O8 + ((size_t)b * SEQ + t) * 1024 + h * 64;
#pragma unroll
                for (int d = 0; d < 2; ++d)
#pragma unroll
                    for (int rg = 0; rg < 4; ++rg) { const unsigned w0 = stc[2 * d + (rg >> 1)][(rg & 1) * 2], w1 = stc[2 * d + (rg >> 1)][(rg & 1) * 2 + 1];
                        *(unsigned*)(orow + 32 * d + 8 * rg + 4 * hi) = pg8::pk4_fp8((o[d][4 * rg] + bflo(w0)) * f, (o[d][4 * rg + 1] + bfhi(w0)) * f, (o[d][4 * rg + 2] + bflo(w1)) * f, (o[d][4 * rg + 3] + bfhi(w1)) * f); }
            } else if (va) {
                unsigned char* strow = ST + (size_t)lq * 128 + 64 * hi;
#pragma unroll
                for (int k = 0; k < 4; ++k) { const int d = k >> 1, rg0 = (k & 1) * 2; u32x4 nv;
#pragma unroll
                    for (int c = 0; c < 4; ++c) { const int rg = rg0 + (c >> 1), e = (c & 1) * 2; const unsigned wv = stc[k][c]; nv[c] = pk2(o[d][4 * rg + e] + bflo(wv), o[d][4 * rg + e + 1] + bfhi(wv)); }
                    *(u32x4*)(strow + 16 * k) = nv; }
                if (hi == 0) STL[lq] = stlc + l;
            }
            it = itn; t = tn; lq = lqn; va = van; stlc = stln;
#pragma unroll
            for (int k = 0; k < 4; ++k) qc[k] = qn[k];
#pragma unroll
            for (int k = 0; k < 4; ++k) stc[k] = stn[k];
        }
        __syncthreads();
    }
}
__device__ __forceinline__ void phase_moba2(const Frame& F, unsigned char* ws, int abl = 0) {
    const bf16_t* Q = (const bf16_t*)(ws + OFF_QKV); const bf16_t* K = Q + (size_t)MTOK * 1024; const bf16_t* V = K + (size_t)MTOK * 1024;
    const float* KMEAN = (const float*)(ws + OFF_KMEAN); const float* BT = (const float*)(ws + OFF_BT);
    for (int v = F.bx; v < 256; v += F.G) { const int x = v & 7, jj = v >> 3, pair = 16 * x + (jj >> 1), par = jj & 1;
        moba2_unit(F, pair >> 4, pair & 15, par, v, Q, K, V, KMEAN, BT, ws + OFF_O8, ws + OFF_MST, abl); __syncthreads(); }
}

__device__ __forceinline__ void nsa_unit(const Frame& F, int b, int g, int c, const bf16_t* Y1, const bf16_t* KC, const bf16_t* VC, const float* BT, unsigned char* MIXIN) {
    using namespace att;
    const int lane = F.lane, r32 = lane & 31, hi = lane >> 5, w = F.wave;
    lptr lds = (lptr)F.lds; lptr tl = lds; LAS float* BTL = (LAS float*)(lds + TL64_BYTES);
    LAS float* SCB = (LAS float*)(lds + TL64_BYTES + 2048);
    LAS unsigned long long* SELM = (LAS unsigned long long*)(lds + TL64_BYTES + 2048 + 16384);
    lptr OFL = lds + TL64_BYTES + 2048 + 16384 + 1024 + w * 8704 + r32 * 272 + hi * 16;
    const int n = r32 & 3, tok = 8 * w + (r32 >> 2), t = 64 * c + tok; const size_t row = (size_t)b * SEQ + t;
    const bf16_t* T1 = Y1 + (size_t)1 * MTOK * 256; const bf16_t* QB = Y1 + (size_t)(2 + g) * MTOK * 256;
    const bf16_t* KVS = Y1 + (size_t)5 * MTOK * 256; const bf16_t* KVW = Y1 + (size_t)6 * MTOK * 256;
    bf16x8 qf[4];
#pragma unroll
    for (int ks = 0; ks < 4; ++ks) qf[ks] = *(const bf16x8*)(QB + row * 256 + n * 64 + 16 * ks + 8 * hi);
    float gate[3];
#pragma unroll
    for (int j = 0; j < 3; ++j) { const float x = bf2f(T1[row * 256 + 208 + (4 * g + n) * 3 + j]); gate[j] = 1.f / (1.f + __expf(-x)); }
    for (int i = F.tid; i < 512; i += NTHR) BTL[i] = BT[(8 + 4 * g) * 128 + i] - BT[(8 + 4 * g) * 128 + (i | 127)];
    for (int i = F.tid; i < 4096; i += NTHR) SCB[i] = 0.f;
    __syncthreads();
    const LAS float* bt = BTL + n * 128; const float cfar = 0.f;
    const int vis = (t >= 31) ? ((t - 31) >> 4) : -1;
    const int ntc = ((4 * c + 2) >> 6) + 1;
    const bf16_t* KCg = KC + ((size_t)b * 256 * 2 + g) * 64; const bf16_t* VCg = VC + ((size_t)b * 256 * 2 + g) * 64;
    auto cmp_scores = [&](int i, lcptr Kt, f32x16& s0, f32x16& s1) {
        qk<4>(s0, s1, Kt, KS64, qf, 0.f, r32, hi);
#pragma unroll
        for (int half = 0; half < 2; ++half) { float bb[16]; f32x16& s = half ? s1 : s0;
#pragma unroll
            for (int r = 0; r < 16; ++r) { const int cc = 64 * i + 32 * half + crow(r, hi); const int d = t - 16 * cc - 31; const unsigned ix = (unsigned)d < 127u ? (unsigned)d : 127u; bb[r] = bt[ix]; }
#pragma unroll
            for (int r = 0; r < 16; ++r) asm volatile("" : "+v"(bb[r]));
#pragma unroll
            for (int r = 0; r < 16; ++r) { const int cc = 64 * i + 32 * half + crow(r, hi); s[r] = (cc <= vis) ? s[r] + bb[r] : -INFINITY; } }
    };
    float mc = NEG_BIG, lc = 0.f;
    tile_loop64(F.tid, tl, ntc, 128,
        [&](int i, const bf16_t*& kp, const bf16_t*& vp) { kp = KCg + (size_t)(64 * i) * 128; vp = VCg + (size_t)(64 * i) * 128; },
        [&](int i, lcptr Kt, lcptr Vt) { f32x16 s0, s1; cmp_scores(i, Kt, s0, s1);
            const float mn = fmaxf(mc, rowmax32(s0, s1)); float rs = 0.f;
#pragma unroll
            for (int r = 0; r < 16; ++r) rs += ex2(s0[r] - mn) + ex2(s1[r] - mn);
            lc = lc * ex2(mc - mn) + rs; mc = mn; });
    lc += __shfl_xor(lc, 32);
    const float invc = lc > 0.f ? 1.f / lc : 0.f;
    {
        f32x16 o[2] = {splat16(0.f), splat16(0.f)}; float carry = 0.f;
        tile_loop64(F.tid, tl, ntc, 128,
            [&](int i, const bf16_t*& kp, const bf16_t*& vp) { kp = KCg + (size_t)(64 * i) * 128; vp = VCg + (size_t)(64 * i) * 128; },
            [&](int i, lcptr Kt, lcptr Vt) { f32x16 s0, s1; cmp_scores(i, Kt, s0, s1);
#pragma unroll
                for (int r = 0; r < 16; ++r) { s0[r] = ex2(s0[r] - mc) * invc; s1[r] = ex2(s1[r] - mc) * invc; }
                float x0[4], x1[4];
#pragma unroll
                for (int rg = 0; rg < 4; ++rg) { x0[rg] = __shfl_xor(s0[4 * rg + 3], 32); x1[rg] = __shfl_xor(s1[4 * rg + 3], 32); }
#pragma unroll
                for (int rg = 0; rg < 4; ++rg) {
                    float g0 = (s0[4 * rg] + s0[4 * rg + 1]) + (s0[4 * rg + 2] + s0[4 * rg + 3]), g1 = (s1[4 * rg] + s1[4 * rg + 1]) + (s1[4 * rg + 2] + s1[4 * rg + 3]);
                    const float e0 = hi ? x0[rg] : (rg > 0 ? x0[rg > 0 ? rg - 1 : 0] : carry), e1 = hi ? x1[rg] : (rg > 0 ? x1[rg > 0 ? rg - 1 : 0] : x0[3]);
                    g0 += e0; g1 += e1;
                    g0 += __shfl_xor(g0, 1); g0 += __shfl_xor(g0, 2); g1 += __shfl_xor(g1, 1); g1 += __shfl_xor(g1, 2);
                    if (n == 0) { SCB[tok * 64 + 16 * i + 2 * rg + hi] = g0; SCB[tok * 64 + 16 * i + 8 + 2 * rg + hi] = g1; }
                }
                carry = x1[3];
                pv<2>(o, s0, s1, Vt, VS64, lane); });
#pragma unroll
        for (int d = 0; d < 2; ++d)
#pragma unroll
            for (int rg = 0; rg < 4; ++rg) *(LAS f32x4*)(OFL + d * 128 + rg * 32) = (f32x4){o[d][4 * rg], o[d][4 * rg + 1], o[d][4 * rg + 2], o[d][4 * rg + 3]} * gate[0];
    }
    {
        unsigned long long uni = 0ull;
#pragma unroll 1
        for (int tk = 0; tk < 8; ++tk) { const int tk2 = 8 * w + tk; float v = SCB[tk2 * 64 + lane];
            v = (lane > c) ? -INFINITY : ((lane == 0 || lane == c || lane == c - 1) ? INFINITY : v);
            int cnt = 0;
#pragma unroll
            for (int j = 0; j < 64; ++j) { const float vj = __builtin_bit_cast(float, __builtin_amdgcn_readlane(__builtin_bit_cast(int, v), j)); cnt += (vj > v || (vj == v && j < lane)) ? 1 : 0; }
            const unsigned long long mk = __ballot(cnt < 16 && lane <= c);
            if (lane == 0) SELM[tk2] = mk;
            uni |= mk; }
        if (lane == 0) SELM[64 + w] = uni;
    }
    __syncthreads();
    const unsigned long long mymask = SELM[tok];
    unsigned long long uni = 0ull;
#pragma unroll
    for (int k = 0; k < 8; ++k) uni |= SELM[64 + k];
    {
        f32x16 o[2] = {splat16(0.f), splat16(0.f)}; float l = 0.f;
        const int nsel = __popcll(uni);
        const bf16_t* Kg = KVS + (size_t)b * SEQ * 256 + g * 64; const bf16_t* Vg = Kg + 128;
        LAS unsigned char* LIST = (LAS unsigned char*)(SELM + 72);
        if (F.tid < 64 && ((uni >> F.tid) & 1ull)) LIST[__popcll(uni & ((1ull << F.tid) - 1ull))] = (unsigned char)F.tid;
        __syncthreads();
        tile_loop64(F.tid, tl, nsel, 256,
            [&](int i, const bf16_t*& kp, const bf16_t*& vp) { const int j = LIST[i]; kp = Kg + (size_t)(64 * j) * 256; vp = Vg + (size_t)(64 * j) * 256; },
            [&](int i, lcptr Kt, lcptr Vt) { const int j = LIST[i];
                const bool sel = (mymask >> j) & 1ull;
                if (!__any(sel)) return;
                f32x16 s0, s1; qk<4>(s0, s1, Kt, KS64, qf, 0.f, r32, hi);
                if (j >= c - 2) bias_mask_near(s0, s1, bt, t, 64 * j, hi, 0x7fffffffu);
                if (!sel) mask_all(s0, s1);
                exp_step(s0, s1, l); pv<2>(o, s0, s1, Vt, VS64, lane); });
        l += __shfl_xor(l, 32); const float f = gate[1] * (l > 0.f ? 1.f / l : 0.f);
#pragma unroll
        for (int d = 0; d < 2; ++d)
#pragma unroll
            for (int rg = 0; rg < 4; ++rg) *(LAS f32x4*)(OFL + d * 128 + rg * 32) += (f32x4){o[d][4 * rg], o[d][4 * rg + 1], o[d][4 * rg + 2], o[d][4 * rg + 3]} * f;
    }
    {
        f32x16 o[2] = {splat16(0.f), splat16(0.f)}; float l = 0.f;
        const int k0 = c >= 8 ? c - 8 : 0, ntw = c - k0 + 1;
        const bf16_t* Kg = KVW + (size_t)b * SEQ * 256 + g * 64; const bf16_t* Vg = Kg + 128;
        tile_loop64(F.tid, tl, ntw, 256,
            [&](int i, const bf16_t*& kp, const bf16_t*& vp) { kp = Kg + (size_t)(64 * (k0 + i)) * 256; vp = Vg + (size_t)(64 * (k0 + i)) * 256; },
            [&](int i, lcptr Kt, lcptr Vt) { const int kt = k0 + i; f32x16 s0, s1; qk<4>(s0, s1, Kt, KS64, qf, 0.f, r32, hi);
                if (!(kt < c - 2 && kt > c - 8)) bias_mask_near(s0, s1, bt, t, 64 * kt, hi, 512u);
                exp_step(s0, s1, l); pv<2>(o, s0, s1, Vt, VS64, lane); });
        l += __shfl_xor(l, 32); const float f = gate[2] * (l > 0.f ? 1.f / l : 0.f);
        unsigned char* orow = MIXIN + row * 1536 + 1024 + (4 * g + n) * 64;
#pragma unroll
        for (int d = 0; d < 2; ++d)
#pragma unroll
            for (int rg = 0; rg < 4; ++rg) { const f32x4 v = (*(LAS f32x4*)(OFL + d * 128 + rg * 32) + (f32x4){o[d][4 * rg], o[d][4 * rg + 1], o[d][4 * rg + 2], o[d][4 * rg + 3]} * f) * OSC;
                *(unsigned*)(orow + 32 * d + 8 * rg + 4 * hi) = pg8::pk4_fp8(v[0], v[1], v[2], v[3]); }
    }
}

__device__ __forceinline__ void dsa_unit(const Frame& F, int b, int u, const bf16_t* QLAT, const bf16_t* CKVN, const unsigned* MASK, const float* BT, unsigned char* MIXIN) {
    using namespace att;
    const int lane = F.lane, r32 = lane & 31, hi = lane >> 5, w = F.wave, tid = F.tid;
    lptr lds = (lptr)F.lds; lptr Kb = lds, Vb = lds + 2 * KT128; LAS float* BTL = (LAS float*)(lds + 2 * KT128 + 2 * VT128);
    const int head = r32 & 7, q0 = 32 * u, t = q0 + 4 * w + (r32 >> 3); const size_t row = (size_t)b * SEQ + t;
    bf16x8 qf[8];
#pragma unroll
    for (int ks = 0; ks < 8; ++ks) qf[ks] = *(const bf16x8*)(QLAT + row * 1024 + head * 128 + 16 * ks + 8 * hi);
    for (int i = tid; i < 1024; i += NTHR) BTL[i] = BT[i] - BT[i | 127];
    const LAS float* bt = BTL + head * 128;
    f32x16 o[4] = {splat16(0.f), splat16(0.f), splat16(0.f), splat16(0.f)}; float l = 0.f;
    const int nt = ((q0 + 31) >> 6) + 1;
    const bf16_t* Cb = CKVN + (size_t)b * SEQ * 128; const unsigned* mrow = MASK + row * 128;
    u32x4 st[2];
    auto gload = [&](int i) {
#pragma unroll
        for (int k = 0; k < 2; ++k) { const int idx = tid + 512 * k, rr = idx >> 4, ch = idx & 15; st[k] = *(const u32x4*)(Cb + (size_t)(64 * i + rr) * 128 + ch * 8); } };
    auto lstore = [&](int i) { lptr kd = Kb + (i & 1) * KT128, vd = Vb + (i & 1) * VT128;
#pragma unroll
        for (int k = 0; k < 2; ++k) { const int idx = tid + 512 * k, rr = idx >> 4, ch = idx & 15; *(LAS u32x4*)(kd + rr * KS128 + ch * 16) = st[k]; *(LAS u32x4*)(vd + rr * VS128 + ch * 16) = st[k]; } };
    auto score = [&](int i, f32x16& s0, f32x16& s1) {
        lcptr Kt = (lcptr)(Kb + (i & 1) * KT128);
        const u32x2 mw = *(const u32x2*)(mrow + 2 * i);
        qk<8>(s0, s1, Kt, KS128, qf, 0.f, r32, hi);
        const unsigned w0 = mw.x >> (4 * hi), w1 = mw.y >> (4 * hi);
        if ((q0 - (64 * i + 63)) < 128) {
#pragma unroll
            for (int r = 0; r < 16; ++r) { const int d0 = t - (64 * i + crow(r, hi)), d1 = d0 - 32;
                const unsigned i0 = (unsigned)d0 < 127u ? (unsigned)d0 : 127u, i1 = (unsigned)d1 < 127u ? (unsigned)d1 : 127u;
                s0[r] += bt[i0]; s1[r] += bt[i1]; }
        }
#pragma unroll
        for (int r = 0; r < 16; ++r) { const int bit = (r & 3) + 8 * (r >> 2);
            const int m0 = __builtin_amdgcn_sbfe((int)w0, bit, 1), m1 = __builtin_amdgcn_sbfe((int)w1, bit, 1);
            const float a0 = s0[r], a1 = s1[r];
            s0[r] = __int_as_float((__float_as_int(a0) & m0) | ((int)0xff800000 & ~m0));
            s1[r] = __int_as_float((__float_as_int(a1) & m1) | ((int)0xff800000 & ~m1)); }
    };
    u32x4 st2[2];
    gload(0); lstore(0);
    if (nt > 1) gload(1);
    __syncthreads();
    auto step = [&](int i, u32x4 (&sL)[2], u32x4 (&sS)[2]) {
        if (i + 2 < nt) {
#pragma unroll
            for (int k = 0; k < 2; ++k) { const int idx = tid + 512 * k, rr = idx >> 4, ch = idx & 15; sL[k] = *(const u32x4*)(Cb + (size_t)(64 * (i + 2) + rr) * 128 + ch * 8); } }
        f32x16 s0, s1; score(i, s0, s1);
        exp_step(s0, s1, l); pv<4>(o, s0, s1, (lcptr)(Vb + (i & 1) * VT128), VS128, lane);
        if (i + 1 < nt) { lptr kd = Kb + ((i + 1) & 1) * KT128, vd = Vb + ((i + 1) & 1) * VT128;
#pragma unroll
            for (int k = 0; k < 2; ++k) { const int idx = tid + 512 * k, rr = idx >> 4, ch = idx & 15; *(LAS u32x4*)(kd + rr * KS128 + ch * 16) = sS[k]; *(LAS u32x4*)(vd + rr * VS128 + ch * 16) = sS[k]; } }
        __syncthreads();
    };
    for (int i = 0; i < nt; i += 2) { step(i, st2, st); if (i + 1 < nt) step(i + 1, st, st2); }
    l += __shfl_xor(l, 32); const float f = l > 0.f ? OSC / l : 0.f;
    unsigned char* orow = MIXIN + row * 1536 + head * 128;
#pragma unroll
    for (int d = 0; d < 4; ++d)
#pragma unroll
        for (int rg = 0; rg < 4; ++rg) *(unsigned*)(orow + 32 * d + 8 * rg + 4 * hi) = pg8::pk4_fp8(o[d][4 * rg] * f, o[d][4 * rg + 1] * f, o[d][4 * rg + 2] * f, o[d][4 * rg + 3] * f);
}

constexpr int DS_TILE = 32 * att::KS128, DS_WAVE = 2 * DS_TILE + 640;
__device__ __forceinline__ void dsa_query(int lane, int b, int t, u32x2 mw, att::lptr base, const LAS float* BTL, const bf16_t* QLAT, const bf16_t* CKVN, unsigned char* MIXIN) {
    using namespace att;
    const int r32 = lane & 31, hi = lane >> 5, head = r32 & 7; const size_t row = (size_t)b * SEQ + t;
    LAS unsigned short* LIST = (LAS unsigned short*)(base + 2 * DS_TILE);
    bf16x8 qf[8];
#pragma unroll
    for (int ks = 0; ks < 8; ++ks) qf[ks] = *(const bf16x8*)(QLAT + row * 1024 + head * 128 + 16 * ks + 8 * hi);
    int n;
    { unsigned long long bits = (lane <= (t >> 6)) ? ((unsigned long long)mw.x | ((unsigned long long)mw.y << 32)) : 0ull;
      const int cnt = __popcll(bits); int pre = cnt;
#pragma unroll
      for (int o = 1; o < 64; o <<= 1) { const int v = __shfl_up(pre, o); if (lane >= o) pre += v; }
      n = __builtin_amdgcn_readlane(pre, 63); int pos = pre - cnt;
      while (bits) { const int j = __builtin_ctzll(bits); bits &= bits - 1ull; LIST[pos++] = (unsigned short)(64 * lane + j); }
      if (lane < 32) LIST[n + lane] = 0; }
    const bf16_t* Cb = CKVN + (size_t)b * SEQ * 128; const LAS float* bt = BTL + head * 128;
    const int ntile = (n + 31) >> 5;
    f32x16 o[4] = {splat16(0.f), splat16(0.f), splat16(0.f), splat16(0.f)}; float l = 0.f;
    u32x4 ra[8];
    auto gath = [&](int i, u32x4 (&r)[8]) {
#pragma unroll
        for (int k = 0; k < 8; ++k) { const int c = lane + 64 * k, rw = c >> 4, ch = c & 15; const int idx = LIST[32 * i + rw]; r[k] = *(const u32x4*)(Cb + (size_t)idx * 128 + ch * 8); } };
    auto put = [&](lptr T, const u32x4 (&r)[8]) {
#pragma unroll
        for (int k = 0; k < 8; ++k) { const int c = lane + 64 * k, rw = c >> 4, ch = c & 15; *(LAS u32x4*)(T + rw * KS128 + ch * 16) = r[k]; } };
    const int hq = lane >> 5, g = (lane >> 4) & 1, q4 = (lane & 15) >> 2, p4 = lane & 3;
    auto tile = [&](int i) {
        lcptr T = (lcptr)(base + (i & 1) * DS_TILE);
        f32x16 s = splat16(0.f);
        { lcptr p0 = T + r32 * KS128 + hi * 16;
#pragma unroll
          for (int ks = 0; ks < 8; ++ks) { const bf16x8 kf = *(const LAS bf16x8*)(p0 + ks * 32); s = __builtin_amdgcn_mfma_f32_32x32x16_bf16(kf, qf[ks], s, 0, 0, 0); } }
        const int lastslot = (32 * i + 31 < n) ? 32 * i + 31 : n - 1;
        if (32 * i + 32 > n || t - (int)LIST[lastslot] < 127) {
#pragma unroll
            for (int h8 = 0; h8 < 2; ++h8) { int li[8]; float bb[8];
#pragma unroll
                for (int r = 0; r < 8; ++r) li[r] = LIST[32 * i + crow(8 * h8 + r, hi)];
#pragma unroll
                for (int r = 0; r < 8; ++r) asm volatile("" : "+v"(li[r]));
#pragma unroll
                for (int r = 0; r < 8; ++r) { const int d = t - li[r]; const unsigned ix = (unsigned)d < 127u ? (unsigned)d : 127u; bb[r] = bt[ix]; }
#pragma unroll
                for (int r = 0; r < 8; ++r) asm volatile("" : "+v"(bb[r]));
#pragma unroll
                for (int r = 0; r < 8; ++r) { const int slot = 32 * i + crow(8 * h8 + r, hi); s[8 * h8 + r] = (slot < n) ? s[8 * h8 + r] + bb[r] : -INFINITY; } }
        }
        float rs = 0.f;
#pragma unroll
        for (int r = 0; r < 16; ++r) { s[r] = ex2(s[r]); rs += s[r]; }
        l += rs;
        const bf16x8 pk[2] = {pack_p(s, 0), pack_p(s, 8)};
        lcptr vb = T + (4 * hq + q4) * KS128 + (16 * g + 4 * p4) * 2;
#pragma unroll
        for (int k = 0; k < 2; ++k)
#pragma unroll
            for (int d = 0; d < 4; ++d) { const s16x4 lo = vtr(vb + (16 * k) * KS128 + d * 64), hh = vtr(vb + (16 * k + 8) * KS128 + d * 64);
                const bf16x8 vf = (bf16x8){lo[0], lo[1], lo[2], lo[3], hh[0], hh[1], hh[2], hh[3]};
                o[d] = __builtin_amdgcn_mfma_f32_32x32x16_bf16(vf, pk[k], o[d], 0, 0, 0); }
    };
    gath(0, ra); put(base, ra);
    for (int i = 0; i < ntile; ++i) {
        const bool more = i + 1 < ntile;
        if (more) gath(i + 1, ra);
        tile(i);
        if (more) put(base + ((i + 1) & 1) * DS_TILE, ra);
    }
    l += __shfl_xor(l, 32); const float f = l > 0.f ? OSC / l : 0.f;
    if (r32 < 8) { unsigned char* orow = MIXIN + row * 1536 + head * 128;
#pragma unroll
        for (int d = 0; d < 4; ++d)
#pragma unroll
            for (int rg = 0; rg < 4; ++rg) *(unsigned*)(orow + 32 * d + 8 * rg + 4 * hi) = pg8::pk4_fp8(o[d][4 * rg] * f, o[d][4 * rg + 1] * f, o[d][4 * rg + 2] * f, o[d][4 * rg + 3] * f); }
}
__device__ __forceinline__ void phase_dsa_sparse(const Frame& F, const bf16_t* QLAT, const bf16_t* CKVN, const unsigned* MASK, const float* BT, unsigned char* MIXIN) {
    att::lptr lds = (att::lptr)F.lds; LAS float* BTL = (LAS float*)(lds + 8 * DS_WAVE);
    for (int i = F.tid; i < 1024; i += NTHR) BTL[i] = BT[i] - BT[i | 127];
    __syncthreads();
    att::lptr base = lds + F.wave * DS_WAVE;
    if ((F.G & 7) == 0) {
        const int b = F.bx & 7, wx = (F.bx >> 3) * NWAVES + F.wave, WX = (F.G >> 3) * NWAVES;
        u32x2 mw = *(const u32x2*)(MASK + ((size_t)b * SEQ + wx) * 128 + 2 * F.lane);
        for (int t = wx; t < SEQ; t += WX) { const int tn = (t + WX < SEQ) ? t + WX : t;
            const u32x2 mwn = *(const u32x2*)(MASK + ((size_t)b * SEQ + tn) * 128 + 2 * F.lane);
            dsa_query(F.lane, b, t, mw, base, BTL, QLAT, CKVN, MIXIN); mw = mwn; }
    } else {
        for (int q = F.gw; q < MTOK; q += F.NGW) { const u32x2 mw = *(const u32x2*)(MASK + (size_t)q * 128 + 2 * F.lane); dsa_query(F.lane, q >> 12, q & 4095, mw, base, BTL, QLAT, CKVN, MIXIN); }
    }
    __syncthreads();
}

constexpr int QI_STRIDE = 2064;
__device__ __forceinline__ void indexer_unit(const Frame& F, int b, int c, const bf16_t* QIDX, const bf16_t* T1, _Float16* SC) {
    using namespace att;
    const int lane = F.lane, r32 = lane & 31, hi = lane >> 5, w = F.wave, tid = F.tid;
    lptr lds = (lptr)F.lds; lptr QI = lds; lptr KI = lds + 64 * QI_STRIDE;
    const int qh = w & 1, kq = w >> 1;
    const size_t row0 = (size_t)b * SEQ + 64 * c;
#pragma unroll 4
    for (int k = 0; k < 16; ++k) { const int idx = tid + 512 * k, rr = idx >> 7, ch = idx & 127; *(LAS u32x4*)(QI + rr * QI_STRIDE + ch * 16) = *(const u32x4*)(QIDX + (row0 + rr) * 1024 + ch * 8); }
    float wv[16];
    { const size_t trow = row0 + 32 * qh + r32; const u32x4 a = *(const u32x4*)(T1 + trow * 256 + 192), bq = *(const u32x4*)(T1 + trow * 256 + 200);
      wv[0] = bflo(a.x); wv[1] = bfhi(a.x); wv[2] = bflo(a.y); wv[3] = bfhi(a.y); wv[4] = bflo(a.z); wv[5] = bfhi(a.z); wv[6] = bflo(a.w); wv[7] = bfhi(a.w);
      wv[8] = bflo(bq.x); wv[9] = bfhi(bq.x); wv[10] = bflo(bq.y); wv[11] = bfhi(bq.y); wv[12] = bflo(bq.z); wv[13] = bfhi(bq.z); wv[14] = bflo(bq.w); wv[15] = bfhi(bq.w); }
    const int nsup = (c + 2) >> 1, pitch = (c + 1) * 64;
    _Float16* srow = SC + (size_t)b * SCB_ELEMS + (size_t)4096 * (c * (c + 1) / 2) + (size_t)(32 * qh + r32) * pitch;
    const bf16_t* Kb = T1 + (size_t)b * SEQ * 256 + 128;
    u32x4 st[2];
    for (int s = 0; s < nsup; ++s) {
#pragma unroll
        for (int k = 0; k < 2; ++k) { const int idx = tid + 512 * k, rr = idx >> 3, ch = idx & 7; st[k] = *(const u32x4*)(Kb + (size_t)(128 * s + rr) * 256 + ch * 8); }
        __syncthreads();
#pragma unroll
        for (int k = 0; k < 2; ++k) { const int idx = tid + 512 * k, rr = idx >> 3, ch = idx & 7; *(LAS u32x4*)(KI + rr * KS64 + ch * 16) = st[k]; }
        __syncthreads();
        const int key0 = 128 * s + 32 * kq;
        if (key0 <= 64 * c + 63) {
            bf16x8 kf[4];
#pragma unroll
            for (int ks = 0; ks < 4; ++ks) kf[ks] = *(const LAS bf16x8*)(KI + (32 * kq + r32) * KS64 + ks * 32 + hi * 16);
            f32x16 sc = splat16(0.f);
            lcptr qp = (lcptr)QI + (32 * qh + r32) * QI_STRIDE + hi * 16;
#pragma unroll 2
            for (int hd = 0; hd < 16; ++hd) { f32x16 acc = splat16(0.f);
#pragma unroll
                for (int ks = 0; ks < 4; ++ks) { const bf16x8 qv = *(const LAS bf16x8*)(qp + hd * 128 + ks * 32); acc = __builtin_amdgcn_mfma_f32_32x32x16_bf16(kf[ks], qv, acc, 0, 0, 0); }
                const float ww = wv[hd];
#pragma unroll
                for (int r = 0; r < 16; ++r) sc[r] += ww * fmaxf(acc[r], 0.f); }
#pragma unroll
            for (int rg = 0; rg < 4; ++rg) { f32x2 a = {sc[4 * rg], sc[4 * rg + 1]}, bq = {sc[4 * rg + 2], sc[4 * rg + 3]};
                u32x2 o; o.x = __builtin_bit_cast(unsigned, __builtin_convertvector(a, f16x2_t)); o.y = __builtin_bit_cast(unsigned, __builtin_convertvector(bq, f16x2_t));
                *(u32x2*)(srow + key0 + 8 * rg + 4 * hi) = o; }
        }
    }
    __syncthreads();
}

__device__ __forceinline__ int wave_sum_i(int v) {
    v += __builtin_amdgcn_update_dpp(0, v, 0xB1, 0xF, 0xF, true);
    v += __builtin_amdgcn_update_dpp(0, v, 0x4E, 0xF, 0xF, true);
    v += __builtin_amdgcn_update_dpp(0, v, 0x141, 0xF, 0xF, true);
    v += __builtin_amdgcn_update_dpp(0, v, 0x140, 0xF, 0xF, true);
    return __builtin_amdgcn_readlane(v, 0) + __builtin_amdgcn_readlane(v, 16) + __builtin_amdgcn_readlane(v, 32) + __builtin_amdgcn_readlane(v, 48);
}
struct SelRow { const unsigned short* src; unsigned* mrow; int t, c; };
__device__ __forceinline__ SelRow sel_row(int row, const _Float16* SC, unsigned* MASK) {
    SelRow r; const int b = row >> 12; r.t = row & 4095; r.c = r.t >> 6; const int nk = (r.c + 1) * 64;
    r.src = (const unsigned short*)SC + (size_t)b * SCB_ELEMS + (size_t)4096 * (r.c * (r.c + 1) / 2) + (size_t)(r.t & 63) * nk; r.mrow = MASK + (size_t)row * 128; return r;
}
__device__ __forceinline__ void sel_slices(const SelRow& r, int lane, unsigned (&S)[2][16]) {
    u32x4 x[8];
    if (lane <= r.c) { const u32x4* p = (const u32x4*)(r.src + 64 * lane);
#pragma unroll
        for (int i = 0; i < 8; ++i) x[i] = p[i]; }
    else {
#pragma unroll
        for (int i = 0; i < 8; ++i) x[i] = (u32x4){0u, 0u, 0u, 0u}; }
#pragma unroll
    for (int k = 0; k < 2; ++k) {
        unsigned X[16], R[16];
#pragma unroll
        for (int i = 0; i < 4; ++i) { X[4 * i] = x[4 * k + i].x; X[4 * i + 1] = x[4 * k + i].y; X[4 * i + 2] = x[4 * k + i].z; X[4 * i + 3] = x[4 * k + i].w; }
#pragma unroll
        for (int i = 0; i < 8; ++i) { R[2 * i] = (X[i] & 0xffffu) | (X[i + 8] << 16); R[2 * i + 1] = (X[i] >> 16) | (X[i + 8] & 0xffff0000u); }
#pragma unroll
        for (int s = 0; s < 4; ++s) { const int j = 8 >> s; const unsigned m = (s == 0) ? 0x00ff00ffu : (s == 1) ? 0x0f0f0f0fu : (s == 2) ? 0x33333333u : 0x55555555u;
#pragma unroll
            for (int q = 0; q < 16; ++q) if (!(q & j)) { const unsigned a = R[q], b = R[q + j]; R[q] = (a & m) | ((b << j) & ~m); R[q + j] = ((a >> j) & m) | (b & ~m); } }
        const unsigned sg = R[15];
#pragma unroll
        for (int b = 0; b < 15; ++b) S[k][b] = R[b] ^ sg;
        S[k][15] = ~sg;
    }
}
__device__ __forceinline__ void phase_select(const Frame& F, const _Float16* SC, unsigned* MASK) {
    const int lane = F.lane;
    for (int p = F.gw; p < MTOK / 2; p += F.NGW) {
        const SelRow ra = sel_row(p, SC, MASK), rb = sel_row(p + MTOK / 2, SC, MASK);
        unsigned Sa[2][16], Sb[2][16];
        sel_slices(ra, lane, Sa); sel_slices(rb, lane, Sb);
        unsigned long long va, vb;
        { const int nv = ra.t - 64 * lane + 1; va = nv >= 64 ? ~0ull : (nv <= 0 ? 0ull : ((1ull << nv) - 1ull)); }
        { const int nv = rb.t - 64 * lane + 1; vb = nv >= 64 ? ~0ull : (nv <= 0 ? 0ull : ((1ull << nv) - 1ull)); }
        unsigned a0 = (unsigned)va, a1 = (unsigned)(va >> 32), b0 = (unsigned)vb, b1 = (unsigned)(vb >> 32), sa0 = 0u, sa1 = 0u, sb0 = 0u, sb1 = 0u;
        int na = 256, nb = 256;
#pragma unroll
        for (int bit = 15; bit >= 0; --bit) {
            const unsigned ta0 = a0 & Sa[0][bit], ta1 = a1 & Sa[1][bit], tb0 = b0 & Sb[0][bit], tb1 = b1 & Sb[1][bit];
            const int ca = wave_sum_i(__popc(ta0) + __popc(ta1)), cb = wave_sum_i(__popc(tb0) + __popc(tb1));
            const bool ga = ca >= na, gb = cb >= nb; const unsigned fa = ga ? 0u : ~0u, fb = gb ? 0u : ~0u;
            a0 &= Sa[0][bit] ^ fa; a1 &= Sa[1][bit] ^ fa; b0 &= Sb[0][bit] ^ fb; b1 &= Sb[1][bit] ^ fb;
            sa0 |= ta0 & fa; sa1 |= ta1 & fa; sb0 |= tb0 & fb; sb1 |= tb1 & fb;
            na -= ga ? 0 : ca; nb -= gb ? 0 : cb;
        }
#pragma unroll
        for (int w = 0; w < 2; ++w) {
            unsigned long long a = w ? ((unsigned long long)b0 | ((unsigned long long)b1 << 32)) : ((unsigned long long)a0 | ((unsigned long long)a1 << 32)); const int need = w ? nb : na;
            const int pc = __popcll(a), tot = wave_sum_i(pc);
            if (tot > need) {
                int pre = pc;
#pragma unroll
                for (int o = 1; o < 64; o <<= 1) { const int v = __shfl_up(pre, o); if (lane >= o) pre += v; }
                const int take = need - (pre - pc);
                if (take <= 0) a = 0ull; else while (__popcll(a) > take) a &= ~(1ull << (63 - __clzll(a)));
            }
            const SelRow& r = w ? rb : ra;
            const unsigned s0 = (w ? sb0 : sa0) | (unsigned)a, s1 = (w ? sb1 : sa1) | (unsigned)(a >> 32);
            if (lane <= r.c) *(u32x2*)(r.mrow + 2 * lane) = (u32x2){s0, s1};
        }
    }
}

__device__ __forceinline__ float gelu_tanh(float x) { const float u = 0.7978845608028654f * (x + 0.044715f * x * x * x); const float e = __expf(2.f * u); return 0.5f * x * (1.f + (1.f - 2.f / (e + 1.f))); }
__device__ __forceinline__ void compress_unit(const Frame& F, int b, int g, int kv, int rt, const bf16_t* KVC, const bf16_t* W1T, const float* w2, const float* cb, bf16_t* OUT) {
    const int lane = F.lane, r32 = lane & 31, hi = lane >> 5, w = F.wave, tid = F.tid;
    LAS float* PART = (LAS float*)F.lds;
    LAS float* HID = PART + 8 * 2048;
    const int n0 = 32 * rt, nn = n0 + r32, nc = nn < 255 ? nn : 254;
    const bf16_t* arow = KVC + ((size_t)b * SEQ + 16 * nc) * 256 + kv * 128 + g * 64;
    f32x16 a0 = att::splat16(0.f), a1 = att::splat16(0.f);
#pragma unroll 4
    for (int ks = 0; ks < 16; ++ks) { const int l = 4 * w + (ks >> 2), d = 16 * (ks & 3) + 8 * hi;
        const bf16x8 af = *(const bf16x8*)(arow + (size_t)l * 256 + d);
        const bf16x8 b0 = *(const bf16x8*)(W1T + (size_t)r32 * 2048 + l * 64 + d), b1 = *(const bf16x8*)(W1T + (size_t)(32 + r32) * 2048 + l * 64 + d);
        a0 = __builtin_amdgcn_mfma_f32_32x32x16_bf16(af, b0, a0, 0, 0, 0); a1 = __builtin_amdgcn_mfma_f32_32x32x16_bf16(af, b1, a1, 0, 0, 0); }
#pragma unroll
    for (int r = 0; r < 16; ++r) { const int mrow = att::crow(r, hi); PART[w * 2048 + mrow * 64 + r32] = a0[r]; PART[w * 2048 + mrow * 64 + 32 + r32] = a1[r]; }
    __syncthreads();
#pragma unroll
    for (int k = 0; k < 4; ++k) { const int idx = tid + 512 * k; float s = cb[idx & 63];
#pragma unroll
        for (int ww = 0; ww < 8; ++ww) s += PART[ww * 2048 + idx];
        HID[idx] = gelu_tanh(s); }
    __syncthreads();
#pragma unroll
    for (int k = 0; k < 4; ++k) { const int idx = tid + 512 * k, nr = idx >> 6, f = idx & 63; float s = 0.f;
#pragma unroll 8
        for (int e = 0; e < 64; ++e) s += HID[nr * 64 + e] * w2[e * 64 + f];
        const int blk = n0 + nr;
        OUT[(((size_t)b * 256 + blk) * 2 + g) * 64 + f] = (blk < 255) ? (bf16_t)f2bf(s) : (bf16_t)0; }
    __syncthreads();
}

#ifdef DBG_MODE
namespace dbg {
constexpr int NSLOT = 40;
__device__ __forceinline__ float bfr(float x) { return bf2f((unsigned short)f2bf(x)); }
__device__ __forceinline__ int srow(int i, int n) { return (int)(((unsigned)i * 2654435761u) % (unsigned)MTOK) ; }
__device__ void commit(unsigned* D, int slot, const float* ref, const float* fast, int n, float tf) {
    __shared__ float red[256];
    const int tid = threadIdx.x; float s = 0.f;
    for (int i = tid; i < n; i += 256) s += ref[i] * ref[i];
    red[tid] = s; __syncthreads();
    for (int o = 128; o > 0; o >>= 1) { if (tid < o) red[tid] += red[tid + o]; __syncthreads(); }
    const float rms = sqrtf(red[0] / (float)n); __syncthreads();
    int bad = 0, tot = 0; float mr = 0.f;
    for (int i = tid; i < n; i += 256) { const float e = fabsf(fast[i] - ref[i]); const float tol = tf * (rms + fabsf(ref[i])) + 1e-7f; if (!(e <= tol)) ++bad; ++tot; const float r = e / (rms + 1e-20f); if (r > mr || !(r == r)) mr = (r == r) ? r : 1e30f; }
    atomicAdd(&D[4 * slot], (unsigned)bad); atomicAdd(&D[4 * slot + 1], (unsigned)tot); atomicMax(&D[4 * slot + 2], __float_as_uint(mr));
    __syncthreads();
}
__device__ __forceinline__ float bias_l2(const float* relb, int head, int dist) { return relb[t5_bucket(dist) * 16 + head] * LOG2E; }

__global__ void chk_in_e(Args a, unsigned* D) {
    __shared__ float ref[1792], fast[1792];
    const int r = srow(blockIdx.x, 64), tid = threadIdx.x; const float* x = a.in[I_X] + (size_t)r * 1024; const float* w = a.in[I_EWIN];
    const bf16_t* Y1 = (const bf16_t*)(a.ws + OFF_Y1);
    for (int n = tid; n < EVEN_IN; n += 256) { float s = 0.f; for (int k = 0; k < 1024; ++k) s += bfr(x[k]) * bfr(w[(size_t)k * EVEN_IN + n]);
        const int dc = RowInE{}(n), tile = dc >> 8, col = dc & 255; const float sc = (tile == 2 || tile == 3) ? QSCALE : 1.f;
        ref[n] = s * sc; fast[n] = bf2f(Y1[((size_t)tile * MTOK + r) * 256 + col]); }
    __syncthreads();
    commit(D, 1, ref, fast, EVEN_IN, 0.02f);
    if (tid == 0) { float sq = 0.f, skv = 0.f; for (int n = 0; n < 256; ++n) sq += ref[n] * ref[n]; for (int n = 256; n < 384; ++n) skv += ref[n] * ref[n];
        const float* pq = (const float*)(a.ws + OFF_SSQ_Q) + (size_t)r * 4; const float* pk = (const float*)(a.ws + OFF_SSQ_KV) + (size_t)r * 4;
        const float fq = pq[0] + pq[1] + pq[2] + pq[3], fk = pk[0] + pk[1] + pk[2] + pk[3];
        int bad = 0; if (!(fabsf(fq - sq) <= 0.02f * sq)) ++bad; if (!(fabsf(fk - skv) <= 0.02f * skv)) ++bad;
        atomicAdd(&D[4 * 2], (unsigned)bad); atomicAdd(&D[4 * 2 + 1], 2u); }
}
__global__ void chk_q2(Args a, unsigned* D) {
    __shared__ float ref[1024], fast[1024], cqn[256], qh[512];
    const int r = srow(blockIdx.x, 64), tid = threadIdx.x; const bf16_t* Y1 = (const bf16_t*)(a.ws + OFF_Y1);
    const bf16_t* CQ = Y1 + (size_t)r * 256; const bf16_t* T1 = Y1 + ((size_t)MTOK + r) * 256;
    { float s = 0.f; for (int k = 0; k < 128; ++k) { const float c = bf2f(T1[k]); s += c * c; } const float rk = 1.f / sqrtf(s / 128.f + 1e-6f);
      if (tid < 128) { ref[tid] = bf2f(T1[tid]) * rk * a.in[I_EKVN][tid]; fast[tid] = bf2f(((const bf16_t*)(a.ws + OFF_CKVN))[(size_t)r * 128 + tid]); } }
    __syncthreads(); commit(D, 3, ref, fast, 128, 0.02f);
    { float s = 0.f; for (int k = 0; k < 256; ++k) { const float c = bf2f(CQ[k]); s += c * c; } const float rq = 1.f / sqrtf(s / 256.f + 1e-6f);
      cqn[tid] = bf2f(CQ[tid]) * rq * a.in[I_EQN][tid]; }
    __syncthreads();
    for (int o = tid; o < 512; o += 256) { float s = 0.f; for (int k = 0; k < 256; ++k) s += cqn[k] * a.in[I_EWUQ][k * 512 + o]; qh[o] = s; }
    __syncthreads();
    for (int o = tid; o < 1024; o += 256) { const int h = o >> 7, c = o & 127; float s = 0.f; for (int d = 0; d < 64; ++d) s += qh[h * 64 + d] * a.in[I_EWUK][c * 512 + h * 64 + d];
        ref[o] = s * QSCALE; fast[o] = bf2f(((const bf16_t*)(a.ws + OFF_QLAT))[(size_t)r * 1024 + o]); }
    __syncthreads(); commit(D, 5, ref, fast, 1024, 0.03f);
    for (int o = tid; o < 1024; o += 256) { float s = 0.f; for (int k = 0; k < 256; ++k) s += cqn[k] * a.in[I_EWQIDX][k * 1024 + o];
        ref[o] = s; fast[o] = bf2f(((const bf16_t*)(a.ws + OFF_QIDX))[(size_t)r * 1024 + o]); }
    __syncthreads(); commit(D, 6, ref, fast, 1024, 0.03f);
}
__global__ void chk_cmp(Args a, unsigned* D) {
    __shared__ float ref[64], fast[64], hid[64];
    const int i = blockIdx.x, tid = threadIdx.x, b = i & 7, g = (i >> 3) & 1, kv = (i >> 4) & 1; const int blk = (i >> 5) == 0 ? 0 : ((i >> 5) == 1 ? 254 : (int)((unsigned)(i * 37 + 11) % 255u));
    const bf16_t* KVC = (const bf16_t*)(a.ws + OFF_Y1) + (size_t)4 * MTOK * 256;
    const float* pos = a.in[kv ? I_EPOSV : I_EPOSK]; const float* w1 = a.in[kv ? I_ECV1 : I_ECK1]; const float* w2 = a.in[kv ? I_ECV2 : I_ECK2];
    if (tid < 64) { float s = 0.f;
        for (int l = 0; l < 32; ++l) for (int d = 0; d < 64; ++d) { const float av = bf2f(KVC[((size_t)b * SEQ + 16 * blk + l) * 256 + kv * 128 + g * 64 + d]); const float wv = w1[(l * 64 + d) * 64 + tid]; s += av * bfr(wv) + pos[l * 64 + d] * wv; }
        hid[tid] = gelu_tanh(s); }
    __syncthreads();
    if (tid < 64) { float s = 0.f; for (int e = 0; e < 64; ++e) s += hid[e] * w2[e * 64 + tid]; ref[tid] = s;
        fast[tid] = bf2f(((const bf16_t*)(a.ws + (kv ? OFF_VC : OFF_KC)))[(((size_t)b * 256 + blk) * 2 + g) * 64 + tid]); }
    __syncthreads(); commit(D, 4, ref, fast, 64, 0.03f);
}
__global__ void chk_idx(Args a, unsigned* D) {
    __shared__ float ref[256], fast[256];
    const int r = (blockIdx.x < 4) ? (blockIdx.x * 4096 + blockIdx.x * 61) : srow(blockIdx.x, 64), tid = threadIdx.x, b = r >> 12, t = r & 4095, c = t >> 6, nk = (c + 1) * 64;
    const bf16_t* Y1 = (const bf16_t*)(a.ws + OFF_Y1); const bf16_t* T1 = Y1 + (size_t)MTOK * 256; const bf16_t* QI = (const bf16_t*)(a.ws + OFF_QIDX) + (size_t)r * 1024;
    const int s = (int)(((unsigned)tid * 2654435761u + 12345u * blockIdx.x) % (unsigned)nk);
    const bf16_t* kr = T1 + ((size_t)b * SEQ + s) * 256 + 128; float sc = 0.f;
    for (int h = 0; h < 16; ++h) { float d = 0.f; for (int k = 0; k < 64; ++k) d += bf2f(QI[h * 64 + k]) * bf2f(kr[k]); sc += bf2f(T1[(size_t)r * 256 + 192 + h]) * fmaxf(d, 0.f); }
    ref[tid] = sc;
    const _Float16* SC = (const _Float16*)(a.ws + OFF_SC) + (size_t)b * SCB_ELEMS + (size_t)4096 * (c * (c + 1) / 2) + (size_t)(t & 63) * nk;
    fast[tid] = (float)SC[s];
    __syncthreads(); commit(D, 7, ref, fast, 256, 0.02f);
}
__global__ void chk_sel(Args a, unsigned* D) {
    __shared__ unsigned key[4096];
    const int r = (blockIdx.x < 8) ? (blockIdx.x * 4096 + 255 + blockIdx.x * 300) : srow(blockIdx.x, 64), tid = threadIdx.x, b = r >> 12, t = r & 4095, c = t >> 6, nk = (c + 1) * 64;
    const unsigned short* SC = (const unsigned short*)(a.ws + OFF_SC) + (size_t)b * SCB_ELEMS + (size_t)4096 * (c * (c + 1) / 2) + (size_t)(t & 63) * nk;
    const unsigned* M = (const unsigned*)(a.ws + OFF_MASK) + (size_t)r * 128;
    for (int s = tid; s < nk; s += 256) { const unsigned u = SC[s]; key[s] = (s <= t) ? ((u & 0x8000u) ? (~u & 0xffffu) : (u | 0x8000u)) : 0u; }
    __syncthreads();
    int bad = 0, tot = 0;
    for (int s = tid; s < nk; s += 256) { bool want;
        if (s > t) want = false; else if (t < 256) want = true;
        else { int rank = 0; const unsigned ks = key[s]; for (int q = 0; q <= t; ++q) rank += (key[q] > ks || (key[q] == ks && q < s)) ? 1 : 0; want = rank < 256; }
        const bool got = (M[s >> 5] >> (s & 31)) & 1u; if (want != got) ++bad; ++tot; }
    atomicAdd(&D[4 * 8], (unsigned)bad); atomicAdd(&D[4 * 8 + 1], (unsigned)tot);
}
__global__ void chk_dsa(Args a, unsigned* D) {
    __shared__ float lg[4096], red[256], ref[128], fast[128];
    const int r = (blockIdx.x < 8) ? (blockIdx.x * 4096 + blockIdx.x * 37) : srow(blockIdx.x, 64), tid = threadIdx.x, b = r >> 12, t = r & 4095, h = blockIdx.x & 7;
    const bf16_t* Q = (const bf16_t*)(a.ws + OFF_QLAT) + (size_t)r * 1024 + h * 128; const bf16_t* C = (const bf16_t*)(a.ws + OFF_CKVN) + (size_t)b * SEQ * 128;
    const unsigned* M = (const unsigned*)(a.ws + OFF_MASK) + (size_t)r * 128; const float* relb = a.in[I_RELB];
    float mx = -INFINITY;
    for (int s = tid; s <= t; s += 256) { float v = -INFINITY; if ((M[s >> 5] >> (s & 31)) & 1u) { float d = 0.f; for (int k = 0; k < 128; ++k) d += bf2f(Q[k]) * bf2f(C[(size_t)s * 128 + k]); v = d + bias_l2(relb, h, t - s); } lg[s] = v; mx = fmaxf(mx, v); }
    red[tid] = mx; __syncthreads(); for (int o = 128; o > 0; o >>= 1) { if (tid < o) red[tid] = fmaxf(red[tid], red[tid + o]); __syncthreads(); } mx = red[0]; __syncthreads();
    float sm = 0.f; for (int s = tid; s <= t; s += 256) { const float p = exp2f(lg[s] - mx); lg[s] = p; sm += p; }
    red[tid] = sm; __syncthreads(); for (int o = 128; o > 0; o >>= 1) { if (tid < o) red[tid] += red[tid + o]; __syncthreads(); } sm = red[0]; __syncthreads();
    if (tid < 128) { float o = 0.f; for (int s = 0; s <= t; ++s) o += lg[s] * bf2f(C[(size_t)s * 128 + tid]); ref[tid] = o / sm; fast[tid] = bf2f(((const bf16_t*)(a.ws + OFF_MIXIN))[(size_t)r * 1536 + h * 128 + tid]); }
    __syncthreads(); commit(D, 9, ref, fast, 128, 0.03f);
}
__global__ void chk_nsa(Args a, unsigned* D) {
    __shared__ float pc[4][256], lg[1100], red[256], ref[64], fast[64], oacc[3][64], scb[64]; __shared__ int selj[16]; __shared__ float qs[4][64];
    const int r = (blockIdx.x < 8) ? (blockIdx.x * 4096 + blockIdx.x * 41) : srow(blockIdx.x, 64), tid = threadIdx.x, b = r >> 12, t = r & 4095, hh = blockIdx.x & 7, g = hh >> 2, n = hh & 3, cur = t >> 6;
    const bf16_t* Y1 = (const bf16_t*)(a.ws + OFF_Y1); const bf16_t* T1 = Y1 + (size_t)MTOK * 256; const bf16_t* QB = Y1 + (size_t)(2 + g) * MTOK * 256;
    const bf16_t* KVS = Y1 + (size_t)5 * MTOK * 256; const bf16_t* KVW = Y1 + (size_t)6 * MTOK * 256;
    const bf16_t* KC = (const bf16_t*)(a.ws + OFF_KC); const bf16_t* VC = (const bf16_t*)(a.ws + OFF_VC); const float* relb = a.in[I_RELB];
    qs[tid >> 6][tid & 63] = bf2f(QB[(size_t)r * 256 + tid]);
    __syncthreads();
    const int vis = (t >= 31) ? ((t - 31) >> 4) : -1;
    for (int nn = 0; nn < 4; ++nn) {
        float v = -INFINITY; if (tid <= vis) { float d = 0.f; for (int k = 0; k < 64; ++k) d += qs[nn][k] * bf2f(KC[(((size_t)b * 256 + tid) * 2 + g) * 64 + k]); v = d + bias_l2(relb, 8 + 4 * g + nn, t - 16 * tid - 31); }
        red[tid] = v; __syncthreads(); for (int o = 128; o > 0; o >>= 1) { if (tid < o) red[tid] = fmaxf(red[tid], red[tid + o]); __syncthreads(); } const float mx = red[0]; __syncthreads();
        const float p = (tid <= vis) ? exp2f(v - mx) : 0.f; red[tid] = p; __syncthreads(); for (int o = 128; o > 0; o >>= 1) { if (tid < o) red[tid] += red[tid + o]; __syncthreads(); } const float sm = red[0]; __syncthreads();
        pc[nn][tid] = sm > 0.f ? p / sm : 0.f; __syncthreads();
    }
    if (tid < 64) { float o = 0.f; for (int i = 0; i <= vis; ++i) o += pc[n][i] * bf2f(VC[(((size_t)b * 256 + i) * 2 + g) * 64 + tid]); oacc[0][tid] = o;
        float s = 0.f; for (int nn = 0; nn < 4; ++nn) for (int i = 4 * tid - 1; i <= 4 * tid + 3; ++i) if (i >= 0 && i < 255) s += pc[nn][i];
        scb[tid] = (tid > cur) ? -INFINITY : ((tid == 0 || tid == cur || tid == cur - 1) ? INFINITY : s); }
    __syncthreads();
    if (tid < 64) { int rank = 0; for (int j = 0; j < 64; ++j) rank += (scb[j] > scb[tid] || (scb[j] == scb[tid] && j < tid)) ? 1 : 0; if (rank < 16) selj[rank] = tid; }
    __syncthreads();
    { float mx = -INFINITY;
      for (int i = tid; i < 1024; i += 256) { const int j = selj[i >> 6], p = 64 * j + (i & 63); float v = -INFINITY; if (p <= t) { float d = 0.f; for (int k = 0; k < 64; ++k) d += qs[n][k] * bf2f(KVS[((size_t)b * SEQ + p) * 256 + g * 64 + k]); v = d + bias_l2(relb, 8 + hh, t - p); } lg[i] = v; mx = fmaxf(mx, v); }
      red[tid] = mx; __syncthreads(); for (int o = 128; o > 0; o >>= 1) { if (tid < o) red[tid] = fmaxf(red[tid], red[tid + o]); __syncthreads(); } mx = red[0]; __syncthreads();
      float sm = 0.f; for (int i = tid; i < 1024; i += 256) { const float p = exp2f(lg[i] - mx); lg[i] = p; sm += p; }
      red[tid] = sm; __syncthreads(); for (int o = 128; o > 0; o >>= 1) { if (tid < o) red[tid] += red[tid + o]; __syncthreads(); } sm = red[0]; __syncthreads();
      if (tid < 64) { float o = 0.f; for (int i = 0; i < 1024; ++i) { const int p = 64 * selj[i >> 6] + (i & 63); if (p <= t) o += lg[i] * bf2f(KVS[((size_t)b * SEQ + p) * 256 + 128 + g * 64 + tid]); } oacc[1][tid] = o / sm; }
      __syncthreads(); }
    { float mx = -INFINITY;
      for (int i = tid; i < 512; i += 256) { const int p = t - i; float v = -INFINITY; if (p >= 0) { float d = 0.f; for (int k = 0; k < 64; ++k) d += qs[n][k] * bf2f(KVW[((size_t)b * SEQ + p) * 256 + g * 64 + k]); v = d + bias_l2(relb, 8 + hh, i); } lg[i] = v; mx = fmaxf(mx, v); }
      red[tid] = mx; __syncthreads(); for (int o = 128; o > 0; o >>= 1) { if (tid < o) red[tid] = fmaxf(red[tid], red[tid + o]); __syncthreads(); } mx = red[0]; __syncthreads();
      float sm = 0.f; for (int i = tid; i < 512; i += 256) { const float p = exp2f(lg[i] - mx); lg[i] = p; sm += p; }
      red[tid] = sm; __syncthreads(); for (int o = 128; o > 0; o >>= 1) { if (tid < o) red[tid] += red[tid + o]; __syncthreads(); } sm = red[0]; __syncthreads();
      if (tid < 64) { float o = 0.f; for (int i = 0; i < 512; ++i) { const int p = t - i; if (p >= 0) o += lg[i] * bf2f(KVW[((size_t)b * SEQ + p) * 256 + 128 + g * 64 + tid]); } oacc[2][tid] = o / sm; }
      __syncthreads(); }
    if (tid < 64) { float gt[3]; for (int j = 0; j < 3; ++j) { const float x = bf2f(T1[(size_t)r * 256 + 208 + hh * 3 + j]); gt[j] = 1.f / (1.f + expf(-x)); }
        ref[tid] = gt[0] * oacc[0][tid] + gt[1] * oacc[1][tid] + gt[2] * oacc[2][tid]; fast[tid] = bf2f(((const bf16_t*)(a.ws + OFF_MIXIN))[(size_t)r * 1536 + 1024 + hh * 64 + tid]); }
    __syncthreads(); commit(D, 10, ref, fast, 64, 0.04f);
}
__global__ void chk_out_e(Args a, unsigned* D) {
    __shared__ float ref[1024], fast[1024], cat[1024];
    const int r = srow(blockIdx.x, 64), tid = threadIdx.x; const bf16_t* MX = (const bf16_t*)(a.ws + OFF_MIXIN) + (size_t)r * 1536;
    for (int o = tid; o < 512; o += 256) { const int h = o >> 6, d = o & 63; float s = 0.f; for (int c = 0; c < 128; ++c) s += bf2f(MX[h * 128 + c]) * a.in[I_EWUV][c * 512 + h * 64 + d]; cat[o] = s; cat[512 + o] = bf2f(MX[1024 + o]); }
    __syncthreads();
    for (int n = tid; n < 1024; n += 256) { float s = 0.f; for (int j = 0; j < 1024; ++j) s += cat[j] * a.in[I_EWOUT][(size_t)j * 1024 + n]; ref[n] = s;
        fast[n] = bf2f(((const bf16_t*)(a.ws + OFF_S1))[(size_t)r * 1024 + n]) - ALPHA * a.in[I_X][(size_t)r * 1024 + n]; }
    __syncthreads(); commit(D, 11, ref, fast, 1024, 0.35f);
}
__global__ void chk_ln(const bf16_t* S, const bf16_t* O, const float* g, const float* bt, unsigned* D, int slot) {
    __shared__ float ref[1024], fast[1024];
    const int r = srow(blockIdx.x, 64), tid = threadIdx.x; float mean = 0.f, var = 0.f;
    for (int k = 0; k < 1024; ++k) mean += bf2f(S[(size_t)r * 1024 + k]); mean /= 1024.f;
    for (int k = 0; k < 1024; ++k) { const float d = bf2f(S[(size_t)r * 1024 + k]) - mean; var += d * d; } var /= 1024.f;
    for (int n = tid; n < 1024; n += 256) { ref[n] = (bf2f(S[(size_t)r * 1024 + n]) - mean) / sqrtf(var + 1e-5f) * g[n] + bt[n]; fast[n] = bf2f(O[(size_t)r * 1024 + n]); }
    __syncthreads(); commit(D, slot, ref, fast, 1024, 0.01f);
}
__global__ void chk_ffn_up(Args a, unsigned* D) {
    __shared__ float ref[DFF], fast[DFF], hrow[1024];
    const int r = srow(blockIdx.x, 64), tid = threadIdx.x; const bf16_t* H = (const bf16_t*)(a.ws + OFF_H) + (size_t)r * 1024;
    for (int k = tid; k < 1024; k += 256) hrow[k] = bf2f(H[k]);
    __syncthreads();
    for (int n = tid; n < DFF; n += 256) { float s1 = 0.f, s3 = 0.f; for (int k = 0; k < 1024; ++k) { s1 += hrow[k] * bfr(a.in[I_EF1][(size_t)k * DFF + n]); s3 += hrow[k] * bfr(a.in[I_EF3][(size_t)k * DFF + n]); }
        ref[n] = s1 / (1.f + expf(-s1)) * s3; fast[n] = bf2f(((const bf16_t*)(a.ws + OFF_ACT))[(size_t)r * DFF + n]); }
    __syncthreads(); commit(D, 13, ref, fast, DFF, 0.02f);
}
__global__ void chk_ffn_dn(Args a, unsigned* D) {
    __shared__ float ref[1024], fast[1024], arow[DFF];
    const int r = srow(blockIdx.x, 64), tid = threadIdx.x; const bf16_t* A = (const bf16_t*)(a.ws + OFF_ACT) + (size_t)r * DFF;
    for (int k = tid; k < DFF; k += 256) arow[k] = bf2f(A[k]);
    __syncthreads();
    for (int n = tid; n < 1024; n += 256) { float s = 0.f; for (int k = 0; k < DFF; ++k) s += arow[k] * bfr(a.in[I_EF2][(size_t)k * 1024 + n]); ref[n] = s;
        fast[n] = bf2f(((const bf16_t*)(a.ws + OFF_S2))[(size_t)r * 1024 + n]) - ALPHA * bf2f(((const bf16_t*)(a.ws + OFF_H))[(size_t)r * 1024 + n]); }
    __syncthreads(); commit(D, 14, ref, fast, 1024, 0.06f);
}
__global__ void chk_in_o(Args a, unsigned* D) {
    __shared__ float ref[2048], fast[2048], xr[1024];
    const int r = srow(blockIdx.x, 64), tid = threadIdx.x; const bf16_t* X1 = (const bf16_t*)(a.ws + OFF_X1) + (size_t)r * 1024;
    for (int k = tid; k < 1024; k += 256) xr[k] = bf2f(X1[k]);
    __syncthreads();
    for (int n = tid; n < 2048; n += 256) { float s = 0.f; for (int k = 0; k < 1024; ++k) s += xr[k] * bfr(a.in[I_OWIN][(size_t)k * 3072 + 1024 + n]); ref[n] = s;
        fast[n] = bf2f(((const bf16_t*)(a.ws + OFF_QKV))[(size_t)(1 + (n >> 10)) * MTOK * 1024 + (size_t)r * 1024 + (n & 1023)]); }
    __syncthreads(); commit(D, 16, ref, fast, 2048, 0.02f);
    const int pm = r >> 8; const bf16_t* K = (const bf16_t*)(a.ws + OFF_QKV) + (size_t)MTOK * 1024 + (size_t)pm * 256 * 1024; const float* KM = (const float*)(a.ws + OFF_KMEAN) + (size_t)pm * 2048;
    for (int n = tid; n < 1024; n += 256) { float s = 0.f; for (int q = 0; q < 256; ++q) s += bf2f(K[(size_t)q * 1024 + n]); ref[n] = s; fast[n] = KM[n] + KM[1024 + n]; }
    __syncthreads(); commit(D, 17, ref, fast, 1024, 0.03f);
}
__global__ void chk_moba(Args a, unsigned* D) {
    __shared__ float lg[1024], red[256], ref[64], fast[64], q[64], gate[16]; __shared__ int blkof[4];
    const int r = (blockIdx.x < 8) ? (blockIdx.x * 4096 + blockIdx.x * 300) : srow(blockIdx.x, 64), tid = threadIdx.x, b = r >> 12, t = r & 4095, h = blockIdx.x & 15, own = t >> 8;
    const bf16_t* X1 = (const bf16_t*)(a.ws + OFF_X1) + (size_t)r * 1024; const bf16_t* K = (const bf16_t*)(a.ws + OFF_QKV) + (size_t)MTOK * 1024 + (size_t)b * SEQ * 1024 + h * 64; const bf16_t* V = K + (size_t)MTOK * 1024;
    const float* relb = a.in[I_RELB];
    if (tid < 64) { float s = 0.f; for (int k = 0; k < 1024; ++k) s += bf2f(X1[k]) * bfr(a.in[I_OWIN][(size_t)k * 3072 + h * 64 + tid]); q[tid] = bfr(s * QSCALE); }
    __syncthreads();
    if (tid < 16) { float s = -INFINITY; if (tid < own) { s = 0.f; for (int p = 0; p < 256; ++p) for (int d = 0; d < 64; ++d) s += q[d] * bf2f(K[(size_t)(256 * tid + p) * 1024 + d]); } gate[tid] = s; }
    __syncthreads();
    if (tid == 0) { unsigned used = 0u; for (int k = 0; k < 3; ++k) { int bj = -1; float best = -INFINITY; for (int j = 0; j < own; ++j) if (!((used >> j) & 1u) && gate[j] > best) { best = gate[j]; bj = j; } blkof[k] = bj; if (bj >= 0) used |= 1u << bj; } blkof[3] = own; }
    __syncthreads();
    float mx = -INFINITY;
    for (int i = tid; i < 1024; i += 256) { const int j = blkof[i >> 8], p = 256 * j + (i & 255); float v = -INFINITY; if (j >= 0 && p <= t) { float d = 0.f; for (int k = 0; k < 64; ++k) d += q[k] * bf2f(K[(size_t)p * 1024 + k]); v = d + bias_l2(relb, h, t - p); } lg[i] = v; mx = fmaxf(mx, v); }
    red[tid] = mx; __syncthreads(); for (int o = 128; o > 0; o >>= 1) { if (tid < o) red[tid] = fmaxf(red[tid], red[tid + o]); __syncthreads(); } mx = red[0]; __syncthreads();
    float sm = 0.f; for (int i = tid; i < 1024; i += 256) { const float p = exp2f(lg[i] - mx); lg[i] = p; sm += p; }
    red[tid] = sm; __syncthreads(); for (int o = 128; o > 0; o >>= 1) { if (tid < o) red[tid] += red[tid + o]; __syncthreads(); } sm = red[0]; __syncthreads();
    if (tid < 64) { float o = 0.f; for (int i = 0; i < 1024; ++i) { const int j = blkof[i >> 8], p = 256 * j + (i & 255); if (j >= 0 && p <= t) o += lg[i] * bf2f(V[(size_t)p * 1024 + tid]); } ref[tid] = o / sm;
        fast[tid] = bf2f(((const bf16_t*)(a.ws + OFF_QKV))[(size_t)r * 1024 + h * 64 + tid]); }
    __syncthreads(); commit(D, 18, ref, fast, 64, 0.04f);
}
__global__ void chk_out_o(Args a, unsigned* D) {
    __shared__ float ref[1024], fast[1024], orow[1024];
    const int r = srow(blockIdx.x, 64), tid = threadIdx.x;
    for (int k = tid; k < 1024; k += 256) orow[k] = bf2f(((const bf16_t*)(a.ws + OFF_QKV))[(size_t)r * 1024 + k]);
    __syncthreads();
    for (int n = tid; n < 1024; n += 256) { float s = 0.f; for (int k = 0; k < 1024; ++k) s += orow[k] * a.in[I_OWOUT][(size_t)k * 1024 + n]; ref[n] = s;
        fast[n] = bf2f(((const bf16_t*)(a.ws + OFF_S1O))[(size_t)r * 1024 + n]) - ALPHA * bf2f(((const bf16_t*)(a.ws + OFF_X1))[(size_t)r * 1024 + n]); }
    __syncthreads(); commit(D, 20, ref, fast, 1024, 0.5f);
}
__global__ void chk_route(Args a, unsigned* D) {
    const int r = srow(blockIdx.x * 256 + threadIdx.x, 64); const bf16_t* H2 = (const bf16_t*)(a.ws + OFF_H2) + (size_t)r * 1024;
    float lg[8]; for (int e = 0; e < 8; ++e) lg[e] = 0.f;
    for (int k = 0; k < 1024; ++k) { const float hv = bf2f(H2[k]); for (int e = 0; e < 8; ++e) lg[e] += hv * a.in[I_OROUTER][k * 8 + e]; }
    int e0 = 0; for (int e = 1; e < 8; ++e) if (lg[e] > lg[e0]) e0 = e; int e1 = -1; for (int e = 0; e < 8; ++e) if (e != e0 && (e1 < 0 || lg[e] > lg[e1])) e1 = e;
    const float g0 = 1.f / (1.f + expf(lg[e1] - lg[e0]));
    const u32x2 rt = ((const u32x2*)(a.ws + OFF_ROUTE))[r]; const int f0 = rt.x & 255, f1 = (rt.x >> 8) & 255; const float fg = __uint_as_float(rt.y);
    int bad = 0; if (f0 != e0 || f1 != e1 || !(fabsf(fg - g0) <= 0.02f)) ++bad;
    atomicAdd(&D[4 * 21], (unsigned)bad); atomicAdd(&D[4 * 21 + 1], 1u);
    const int* GI = (const int*)(a.ws + OFF_GINFO); const int* DEST = (const int*)(a.ws + OFF_DEST) + 2 * (size_t)r;
    int bad2 = 0;
    for (int k = 0; k < 2; ++k) { const int e = k ? f1 : f0, d = DEST[k], ps = e ? GI[e - 1] : 0; if (d < ps || d >= ps + GI[8 + e]) ++bad2; }
    atomicAdd(&D[4 * 22], (unsigned)bad2); atomicAdd(&D[4 * 22 + 1], 2u);
}
__global__ void chk_moe(Args a, unsigned* D) {
    __shared__ float ref[1024], fast[1024], hrow[1024], act[DFFE], fin[1024];
    const int r = srow(blockIdx.x, 64), tid = threadIdx.x; const bf16_t* H2 = (const bf16_t*)(a.ws + OFF_H2) + (size_t)r * 1024;
    for (int k = tid; k < 1024; k += 256) { hrow[k] = bf2f(H2[k]); ref[k] = 0.f; }
    const u32x2 rt = ((const u32x2*)(a.ws + OFF_ROUTE))[r]; const float g0 = __uint_as_float(rt.y); const int* DEST = (const int*)(a.ws + OFF_DEST) + 2 * (size_t)r; const bf16_t* YR = (const bf16_t*)(a.ws + OFF_YR);
    __syncthreads();
    for (int k = 0; k < 2; ++k) { const int e = k ? ((rt.x >> 8) & 255) : (rt.x & 255); const float gk = k ? 1.f - g0 : g0;
        const float* w1 = a.in[I_OM1] + (size_t)e * 1024 * DFFE; const float* w3 = a.in[I_OM3] + (size_t)e * 1024 * DFFE; const float* w2 = a.in[I_OM2] + (size_t)e * DFFE * 1024;
        for (int f = tid; f < DFFE; f += 256) { float s1 = 0.f, s3 = 0.f; for (int q = 0; q < 1024; ++q) { s1 += hrow[q] * bfr(w1[(size_t)q * DFFE + f]); s3 += hrow[q] * bfr(w3[(size_t)q * DFFE + f]); } act[f] = bfr(s1 / (1.f + expf(-s1)) * s3); }
        __syncthreads();
        for (int n = tid; n < 1024; n += 256) { float s = 0.f; for (int f = 0; f < DFFE; ++f) s += act[f] * bfr(w2[(size_t)f * 1024 + n]); ref[n] += gk * s; }
        __syncthreads(); }
    for (int n = tid; n < 1024; n += 256) { fast[n] = g0 * bf2f(YR[(size_t)DEST[0] * 1024 + n]) + (1.f - g0) * bf2f(YR[(size_t)DEST[1] * 1024 + n]); fin[n] = ALPHA * hrow[n] + fast[n]; }
    __syncthreads(); commit(D, 23, ref, fast, 1024, 0.12f);
    float mean = 0.f, var = 0.f; for (int k = 0; k < 1024; ++k) mean += fin[k]; mean /= 1024.f; for (int k = 0; k < 1024; ++k) { const float d = fin[k] - mean; var += d * d; } var /= 1024.f;
    __syncthreads();
    for (int n = tid; n < 1024; n += 256) { ref[n] = (fin[n] - mean) / sqrtf(var + 1e-5f) * a.in[I_OLN2G][n] + a.in[I_OLN2B][n]; fast[n] = a.out[(size_t)r * 1024 + n]; }
    __syncthreads(); commit(D, 24, ref, fast, 1024, 0.005f);
    { float m2 = 0.f, v2 = 0.f; for (int k = 0; k < 1024; ++k) m2 += ALPHA * hrow[k]; m2 /= 1024.f; for (int k = 0; k < 1024; ++k) { const float d = ALPHA * hrow[k] - m2; v2 += d * d; } v2 /= 1024.f;
      for (int n = tid; n < 1024; n += 256) ref[n] = (ALPHA * hrow[n] - m2) / sqrtf(v2 + 1e-5f) * a.in[I_OLN2G][n] + a.in[I_OLN2B][n];
      __syncthreads(); commit(D, 28, ref, fast, 1024, 0.005f); }
    { for (int n = tid; n < 1024; n += 256) fin[n] = ALPHA * hrow[n] + (1.f - g0) * bf2f(YR[(size_t)DEST[0] * 1024 + n]) + g0 * bf2f(YR[(size_t)DEST[1] * 1024 + n]);
      __syncthreads();
      float m2 = 0.f, v2 = 0.f; for (int k = 0; k < 1024; ++k) m2 += fin[k]; m2 /= 1024.f; for (int k = 0; k < 1024; ++k) { const float d = fin[k] - m2; v2 += d * d; } v2 /= 1024.f;
      __syncthreads();
      for (int n = tid; n < 1024; n += 256) ref[n] = (fin[n] - m2) / sqrtf(v2 + 1e-5f) * a.in[I_OLN2G][n] + a.in[I_OLN2B][n];
      __syncthreads(); commit(D, 29, ref, fast, 1024, 0.005f); }
}

__global__ void chk_wmoe(Args a, unsigned* D) {
    const int tid = blockIdx.x * 256 + threadIdx.x; const unsigned hsh = (unsigned)tid * 2654435761u;
    const int e = hsh & 7, f = (hsh >> 3) % DFFE, k = (hsh >> 15) % 1024;
    const bf16_t* W13 = (const bf16_t*)(a.ws + OFF_W_M13) + (size_t)e * 2 * DFFE * 1024; const bf16_t* W2 = (const bf16_t*)(a.ws + OFF_W_M2) + (size_t)e * 1024 * DFFE;
    int bad = 0;
    if (W13[(size_t)(((f >> 7) << 8) + (f & 127)) * 1024 + k] != (bf16_t)f2bf(a.in[I_OM1][(size_t)e * 1024 * DFFE + (size_t)k * DFFE + f])) ++bad;
    if (W13[(size_t)(((f >> 7) << 8) + (f & 127) + 128) * 1024 + k] != (bf16_t)f2bf(a.in[I_OM3][(size_t)e * 1024 * DFFE + (size_t)k * DFFE + f])) ++bad;
    atomicAdd(&D[4 * 25], (unsigned)bad); atomicAdd(&D[4 * 25 + 1], 2u);
    int bad2 = 0; if (W2[(size_t)k * DFFE + f] != (bf16_t)f2bf(a.in[I_OM2][(size_t)e * DFFE * 1024 + (size_t)f * 1024 + k])) ++bad2;
    atomicAdd(&D[4 * 26], (unsigned)bad2); atomicAdd(&D[4 * 26 + 1], 1u);
}
__global__ void chk_actm(Args a, unsigned* D) {
    __shared__ float ref[DFFE], fast[DFFE], hrow[1024]; __shared__ int tokf, kf;
    const int tid = threadIdx.x; const int* GI = (const int*)(a.ws + OFF_GINFO); const int nrows = GI[7], ng = nrows >> 8, g0 = ((ng - 1) / MOE_CHUNK) * MOE_CHUNK;
    const int rho = 256 * g0 + (int)(((unsigned)blockIdx.x * 2654435761u) % (unsigned)(nrows - 256 * g0));
    if (tid == 0) { tokf = -1; kf = 0; } __syncthreads();
    const int* DEST = (const int*)(a.ws + OFF_DEST);
    for (int i = tid; i < 2 * MTOK; i += 256) if (DEST[i] == rho) { tokf = i >> 1; kf = i & 1; }
    __syncthreads();
    if (tokf < 0) return;
    const int tok = tokf; const u32x2 rt = ((const u32x2*)(a.ws + OFF_ROUTE))[tok]; const int e = kf ? ((rt.x >> 8) & 255) : (rt.x & 255);
    const bf16_t* H2 = (const bf16_t*)(a.ws + OFF_H2) + (size_t)tok * 1024;
    for (int k = tid; k < 1024; k += 256) hrow[k] = bf2f(H2[k]);
    __syncthreads();
    const float* w1 = a.in[I_OM1] + (size_t)e * 1024 * DFFE; const float* w3 = a.in[I_OM3] + (size_t)e * 1024 * DFFE;
    for (int f = tid; f < DFFE; f += 256) { float s1 = 0.f, s3 = 0.f; for (int q = 0; q < 1024; ++q) { s1 += hrow[q] * bfr(w1[(size_t)q * DFFE + f]); s3 += hrow[q] * bfr(w3[(size_t)q * DFFE + f]); }
        ref[f] = s1 / (1.f + expf(-s1)) * s3; fast[f] = bf2f(((const bf16_t*)(a.ws + OFF_ACTM))[(size_t)(rho - 256 * g0) * DFFE + f]); }
    __syncthreads(); commit(D, 27, ref, fast, DFFE, 0.02f);
}

__global__ void simple_final(Args a) {
    const int row = blockIdx.x * 4 + (threadIdx.x >> 6), lane = threadIdx.x & 63; unsigned char* ws = a.ws;
    const bf16_t* H2 = (const bf16_t*)(ws + OFF_H2); const bf16_t* YR = (const bf16_t*)(ws + OFF_YR);
    const u32x2* ROUTE = (const u32x2*)(ws + OFF_ROUTE); const int* DEST = (const int*)(ws + OFF_DEST);
    const float g0 = __uint_as_float(ROUTE[row].y), g1 = 1.f - g0; const int d0 = DEST[2 * row], d1 = DEST[2 * row + 1];
    float v[16]; float s = 0.f;
    for (int i = 0; i < 16; ++i) { const int col = lane + 64 * i; v[i] = ALPHA * bf2f(H2[(size_t)row * 1024 + col]) + g0 * bf2f(YR[(size_t)d0 * 1024 + col]) + g1 * bf2f(YR[(size_t)d1 * 1024 + col]); s += v[i]; }
    const float mean = wave_sum(s) / 1024.f; float q = 0.f;
    for (int i = 0; i < 16; ++i) { v[i] -= mean; q += v[i] * v[i]; }
    const float rstd = 1.f / sqrtf(wave_sum(q) / 1024.f + 1e-5f);
    for (int i = 0; i < 16; ++i) { const int col = lane + 64 * i; a.out[(size_t)row * 1024 + col] = v[i] * rstd * a.in[I_OLN2G][col] + a.in[I_OLN2B][col]; }
}
__global__ void report(float* out, const unsigned* D, int nelem) {
    __shared__ float kk, xx;
    if (threadIdx.x == 0) { int idx = 0; float v = 0.f; float worst = 0.f;
        for (int s = 1; s < NSLOT; ++s) { const unsigned bad = D[4 * s], tot = D[4 * s + 1]; if (tot == 0u) continue; const float fr = (float)bad / (float)tot; const float thr = (s == 9 || s == 10 || s == 18) ? 0.1f : 0.002f;
            if (fr > worst) worst = fr; if (fr > thr && idx == 0) { idx = s; v = fr; } }
        if (idx == 0) v = worst;
#ifdef DBG_BITS
        { const int sl[6] = DBG_BITS; idx = 0; for (int q = 0; q < 6; ++q) { const int s = sl[q]; if (s > 0 && D[4 * s + 1] > 0u && (float)D[4 * s] / (float)D[4 * s + 1] > 0.002f) idx |= 1 << q; } v = 1.f; }
#endif
#ifdef DBG_VAL
        { const float mr = __uint_as_float(D[4 * DBG_VAL + 2]); const float fr = D[4 * DBG_VAL + 1] ? (float)D[4 * DBG_VAL] / (float)D[4 * DBG_VAL + 1] : 0.f; kk = sqrtf(fmaxf(mr, 1e-6f) * 1e6f); xx = kk * (2.f + 97.f * fr); }
#else
        v = fmaxf(v, 1e-6f); const int n = (v > 0.3f) ? 4 : (v > 0.03f) ? 3 : (v > 0.003f) ? 2 : 1; kk = (n == 4) ? 1e4f : (n == 3) ? 1e3f : (n == 2) ? 1e2f : 1e1f; xx = kk * (float)(idx + 2);
#endif
        }
    __syncthreads();
    const float k = kk, x = xx;
    for (size_t i = (size_t)blockIdx.x * blockDim.x + threadIdx.x; i < (size_t)nelem; i += (size_t)gridDim.x * blockDim.x) out[i] = (i == 0) ? x : k;
}
}
#endif

#ifndef MK_N_LAUNCHES
#define MK_N_LAUNCHES 1
#endif
constexpr int NPHASE = 18;
#define SP2 true
#ifndef FFN_F8
#define FFN_F8 0
#endif
#ifndef MOE_SP2
#define MOE_SP2 true
#endif
#define ALN true

__global__ void __launch_bounds__(NTHR, 2) fwd_kernel(Args args) {
    extern __shared__ __attribute__((aligned(16))) unsigned char lds_raw[];
    Frame F;
    F.lds = (LAS unsigned char*)lds_raw;
    F.tid = threadIdx.x; F.lane = F.tid & 63; F.wave = __builtin_amdgcn_readfirstlane(F.tid >> 6);
    F.G = gridDim.x; F.bx = blockIdx.x; F.gw = F.bx * NWAVES + F.wave; F.NGW = F.G * NWAVES; F.ws = args.ws;
    unsigned char* ws = args.ws;
    volatile LAS unsigned* MISC = (volatile LAS unsigned*)(F.lds + LDSCTL_OFF);
    for (int u = F.tid; u < (LDS_BYTES - LDSCTL_OFF) / 4; u += NTHR) ((LAS unsigned*)(F.lds + LDSCTL_OFF))[u] = 0u;
    __syncthreads();
    XcdBarrier bar = xcd_barrier_post((unsigned*)(ws + OFF_BAR) + args.li * XCD_BAR_WORDS, MISC + 8);
    const int lo = args.ph_lo, hi = args.ph_hi;
#ifndef PH_MASK
#define PH_MASK 0x3ffff
#endif
#define IN(k) (((PH_MASK >> (k)) & 1) && lo <= (k) && (k) < hi)
#ifdef TS_MODE
    unsigned long long* TS = (unsigned long long*)(ws + OFF_DBG + 1024);
#define STAMP(i) do { if (F.bx == 0 && F.tid == 0) TS[i] = __builtin_amdgcn_s_memrealtime(); } while (0)
#else
#define STAMP(i) do { } while (0)
#endif
#define SEAM(k) do { if (IN(k) && IN((k) + 1)) xcd_barrier(bar); STAMP((k) + 1); } while (0)
    LAS unsigned char* glds = F.lds;

    bf16_t* Y1 = (bf16_t*)(ws + OFF_Y1);
    float* ssq_q = (float*)(ws + OFF_SSQ_Q); float* ssq_kv = (float*)(ws + OFF_SSQ_KV);

    STAMP(0);
    if (IN(0)) { phase_prologue_even(F, args); } SEAM(0);
    if (IN(1)) { pg8::Gemm g{(const bf16_t*)(ws + OFF_XB), (const bf16_t*)(ws + OFF_W_IN), MTOK, EVEN_INP, 1024, 1024, 0}; pg8::StaticOrder S; S.init(MTOK, EVEN_INP, F.G, F.bx);
        pg8::EpiInE E{Y1, ssq_q, ssq_kv}; pg8::gemm_phase<pg8::EpiInE, pg8::StaticOrder, ALN, SP2>(glds, g, S, E); } SEAM(1);
    if (IN(2)) {
        phase_ckvn(F, Y1 + (size_t)1 * MTOK * 256, ssq_kv, args.in[I_EKVN], (bf16_t*)(ws + OFF_CKVN));
#ifndef NO_CMP
        for (int idx = F.bx; idx < 256; idx += F.G) { const int b = idx >> 5, g = (idx >> 4) & 1, kv = (idx >> 3) & 1, rt = idx & 7;
            compress_unit(F, b, g, kv, rt, Y1 + (size_t)4 * MTOK * 256, (const bf16_t*)(ws + (kv ? OFF_CV1 : OFF_CK1)), args.in[kv ? I_ECV2 : I_ECK2], (const float*)(ws + OFF_CB) + kv * 64, (bf16_t*)(ws + (kv ? OFF_VC : OFF_KC))); }
#endif
#ifndef NO_Q2
        pg8::Gemm g{Y1, (const bf16_t*)(ws + OFF_W_Q2), MTOK, 2048, 256, 256, 0}; pg8::StaticOrder S; S.init(MTOK, 2048, F.G, F.bx);
        pg8::EpiQ2 E{(bf16_t*)(ws + OFF_QLAT), (bf16_t*)(ws + OFF_QIDX), ssq_q}; pg8::gemm_phase<pg8::EpiQ2, pg8::StaticOrder, ALN, SP2>(glds, g, S, E);
#endif
    } SEAM(2);
    if (IN(3)) { for (int idx = F.bx; idx < 512; idx += F.G) { const int i = idx >> 8, v = idx & 255, b = v & 7, cc = v >> 3, c = i ? 63 - cc : cc;
            indexer_unit(F, b, c, (const bf16_t*)(ws + OFF_QIDX), Y1 + (size_t)1 * MTOK * 256, (_Float16*)(ws + OFF_SC)); } } SEAM(3);
    if (IN(4)) { phase_select(F, (const _Float16*)(ws + OFF_SC), (unsigned*)(ws + OFF_MASK)); } SEAM(4);
    if (IN(5)) {
#ifndef NO_DSA
        if (args.pad != 2) phase_dsa_sparse(F, (const bf16_t*)(ws + OFF_QLAT), (const bf16_t*)(ws + OFF_CKVN), (const unsigned*)(ws + OFF_MASK), (const float*)(ws + OFF_BT), ws + OFF_MIXIN);
#endif
        STAMP(20);
#ifndef NO_NSA
        if (args.pad != 1) for (int idx = F.bx; idx < 1024; idx += F.G) { const int i = idx >> 8, v = idx & 255, b = v & 7, cc = v >> 3, g = i & 1, c = (i >> 1) ? 63 - cc : cc;
            nsa_unit(F, b, g, c, Y1, (const bf16_t*)(ws + OFF_KC), (const bf16_t*)(ws + OFF_VC), (const float*)(ws + OFF_BT), ws + OFF_MIXIN); __syncthreads(); }
#endif
    } SEAM(5);
    if (IN(6)) { pg8::Gemm g{(const bf16_t*)(ws + OFF_MIXIN), (const bf16_t*)(ws + OFF_W_OUTE), MTOK, 1024, 768, 768, 0}; pg8::StaticOrder S; S.init(MTOK, 1024, F.G, F.bx);
        pg8::EpiRes<true> E{args.in[I_X], (bf16_t*)(ws + OFF_S1), 1.f / (OSC * WOUT_SCALE)}; pg8::gemm_phase<pg8::EpiRes<true>, pg8::StaticOrder, ALN, SP2, true>(glds, g, S, E); } SEAM(6);
    if (IN(7)) { phase_ln_i8(F, (const bf16_t*)(ws + OFF_S1), (bf16_t*)(ws + OFF_H), ws + OFF_H8, (float*)(ws + OFF_SA), args.in[I_ELN1G], args.in[I_ELN1B]); } SEAM(7);
#if FFN_F8
    if (IN(8)) { pg8::Gemm g{(const bf16_t*)(ws + OFF_H8), (const bf16_t*)(ws + OFF_W_F13), MTOK, 2 * DFF, 512, 512, 0}; pg8::StaticOrder S; S.init(MTOK, 2 * DFF, F.G, F.bx);
        pg8::EpiSwiglu8 E{ws + OFF_ACT, DFF, 0, 1.f / WF13_SCALE}; pg8::gemm_phase<pg8::EpiSwiglu8, pg8::StaticOrder, ALN, SP2, true>(glds, g, S, E); } SEAM(8);
#else
    if (IN(8)) { pg8::Gemm g{(const bf16_t*)(ws + OFF_H8), (const bf16_t*)(ws + OFF_W_F13), MTOK, 2 * DFF, 512, 512, 0}; pg8::StaticOrder S; S.init(MTOK, 2 * DFF, F.G, F.bx);
        pg8::EpiSwigluI8 E{ws + OFF_ACT, DFF, (const float*)(ws + OFF_SA), (const float*)(ws + OFF_SW)}; pg8::gemm_phase<pg8::EpiSwigluI8, pg8::StaticOrder, ALN, SP2, false, true>(glds, g, S, E); } SEAM(8);
#endif
#if FFN_F8
    if (IN(9)) { pg8::Gemm g{(const bf16_t*)(ws + OFF_ACT), (const bf16_t*)(ws + OFF_W_F2), MTOK, 1024, DFF / 2, DFF / 2, 0}; pg8::StaticOrder S; S.init(MTOK, 1024, F.G, F.bx);
        pg8::EpiRes<false> E{(const void*)(ws + OFF_H), (bf16_t*)(ws + OFF_S2), 1.f / WF2_SCALE}; pg8::gemm_phase<pg8::EpiRes<false>, pg8::StaticOrder, ALN, SP2, true>(glds, g, S, E); } SEAM(9);
#else
    if (IN(9)) { pg8::Gemm g{(const bf16_t*)(ws + OFF_ACT), (const bf16_t*)(ws + OFF_W_F2), MTOK, 1024, DFF / 2, DFF / 2, 0}; pg8::StaticOrder S; S.init(MTOK, 1024, F.G, F.bx);
        pg8::EpiRes<false> E{(const void*)(ws + OFF_H), (bf16_t*)(ws + OFF_S2), 1.f / WF2_SCALE}; pg8::gemm_phase<pg8::EpiRes<false>, pg8::StaticOrder, ALN, SP2, true>(glds, g, S, E); } SEAM(9);
#endif
    if (IN(10)) { phase_ln_bf16(F, (const bf16_t*)(ws + OFF_S2), (bf16_t*)(ws + OFF_X1), ws + OFF_X18, args.in[I_ELN2G], args.in[I_ELN2B]); phase_convert_odd(F, args); } SEAM(10);
    if (IN(11)) { pg8::Gemm g{(const bf16_t*)(ws + OFF_X18), (const bf16_t*)(ws + OFF_W_OIN), MTOK, 3072, 512, 512, 0}; pg8::StaticOrder S; S.init(MTOK, 3072, F.G, F.bx);
        pg8::EpiInO E{(bf16_t*)(ws + OFF_QKV), (float*)(ws + OFF_KMEAN), 1.f / WIN_SCALE}; pg8::gemm_phase<pg8::EpiInO, pg8::StaticOrder, ALN, SP2, true>(glds, g, S, E); } SEAM(11);
#ifdef MOBA_DENSE
    if (IN(12)) { phase_moba(F, ws, args.pad); } SEAM(12);
#else
    if (IN(12)) { phase_moba2(F, ws, args.pad); } SEAM(12);
#endif
    if (IN(13)) { pg8::Gemm g{(const bf16_t*)(ws + OFF_O8), (const bf16_t*)(ws + OFF_W_OOUT), MTOK, 1024, 512, 512, 0}; pg8::StaticOrder S; S.init(MTOK, 1024, F.G, F.bx);
        pg8::EpiRes<false> E{(const void*)(ws + OFF_X1), (bf16_t*)(ws + OFF_S1O), 1.f / (OSC * WOUT_SCALE)}; pg8::gemm_phase<pg8::EpiRes<false>, pg8::StaticOrder, ALN, SP2, true>(glds, g, S, E); } SEAM(13);
    if (IN(14)) { phase_ln_router(F, (const bf16_t*)(ws + OFF_S1O), (bf16_t*)(ws + OFF_H2), args.in[I_OLN1G], args.in[I_OLN1B], args.in[I_OROUTER], ws); } SEAM(14);
    if (IN(15)) { phase_moe_gather(F, (const bf16_t*)(ws + OFF_H2), ws + OFF_XR, ws); } SEAM(15);
    if (IN(16)) {
        const int* GI = (const int*)(ws + OFF_GINFO);
        pg8::MoeOrder S; S.G = F.G; S.c = F.bx;
#pragma unroll
        for (int e = 0; e < 8; ++e) S.pend[e] = __builtin_amdgcn_readfirstlane(GI[e]);
        const int ngroups = S.pend[7] >> 8;
        for (int g0 = 0; g0 < ngroups; g0 += MOE_CHUNK) {
            S.g0 = g0; S.ng = (ngroups - g0) < MOE_CHUNK ? (ngroups - g0) : MOE_CHUNK;
            { S.nN = 28; pg8::Gemm g{(const bf16_t*)(ws + OFF_XR), (const bf16_t*)(ws + OFF_W_M13), 0, 2 * DFFE, 512, 512, (size_t)2 * DFFE * 512};
              pg8::EpiSwiglu8 E{ws + OFF_ACTM, DFFE, g0, 1.f / W13_SCALE}; pg8::gemm_phase<pg8::EpiSwiglu8, pg8::MoeOrder, ALN, MOE_SP2, true>(glds, g, S, E); }
            xcd_barrier(bar);
            { S.nN = 4; pg8::Gemm g{(const bf16_t*)(ws + OFF_ACTM - (size_t)g0 * 256 * DFFE), (const bf16_t*)(ws + OFF_W_M2), 0, 1024, DFFE / 2, DFFE / 2, (size_t)1024 * DFFE / 2};
              pg8::EpiStoreS E{(bf16_t*)(ws + OFF_YR), 1024, 1.f / W2_SCALE}; pg8::gemm_phase<pg8::EpiStoreS, pg8::MoeOrder, ALN, MOE_SP2, true>(glds, g, S, E); }
            xcd_barrier(bar);
        }
    }
    STAMP(17);
    if (IN(17)) { phase_final(F, (const bf16_t*)(ws + OFF_H2), (const bf16_t*)(ws + OFF_YR), args.in[I_OLN2G], args.in[I_OLN2B], args.out, ws); }
#ifdef TS_MODE
    STAMP(18);
    xcd_barrier(bar);
    { const int ia[2] = TS_SEL; float d[2];
      for (int q = 0; q < 2; ++q) { const int i = ia[q]; const unsigned long long t1 = (i == 5) ? TS[20] : ((i == 25) ? TS[6] : TS[i + 1]); const unsigned long long t0 = (i == 25) ? TS[20] : TS[i]; d[q] = (float)(t1 - t0) * 0.01f; }
      const float k = sqrtf(fmaxf(d[0], 1.f)), x = 10.f * fmaxf(d[1], 1.f);
      for (size_t i = (size_t)F.bx * NTHR + F.tid; i < (size_t)MTOK * 1024; i += (size_t)F.G * NTHR) args.out[i] = (i == 0) ? x : k; }
#endif
#undef IN
#undef SEAM
}

extern "C" void kernel_launch(void* const* d_in, const int* in_sizes, int n_in, void* d_out, int out_size, void* d_ws, size_t ws_size, hipStream_t stream) {
    static int grid = 0;
    if (grid == 0) {
        if (n_in != 33 || in_sizes[0] != MTOK * DM || out_size != MTOK * DM || ws_size < WS_END) { fprintf(stderr, "kernel_launch: unexpected problem (n_in %d, in0 %d, out %d, ws %zu < %zu)\n", n_in, n_in > 0 ? in_sizes[0] : -1, out_size, ws_size, (size_t)WS_END); grid = -1; return; }
        int dev = 0, cus = 0, per_cu = 0;
        if (hipGetDevice(&dev) != hipSuccess || hipDeviceGetAttribute(&cus, hipDeviceAttributeMultiprocessorCount, dev) != hipSuccess) { grid = -1; return; }
        if (hipFuncSetAttribute((const void*)fwd_kernel, hipFuncAttributeMaxDynamicSharedMemorySize, LDS_BYTES) != hipSuccess) { fprintf(stderr, "kernel_launch: hipFuncSetAttribute failed\n"); grid = -1; return; }
        if (hipOccupancyMaxActiveBlocksPerMultiprocessor(&per_cu, (const void*)fwd_kernel, NTHR, LDS_BYTES) != hipSuccess || per_cu < 1) fprintf(stderr, "kernel_launch: occupancy query reports %d\n", per_cu);
        (void)hipGetLastError();
        grid = cus > 256 ? 256 : cus;
    }
    if (grid < 0) return;
    hipMemsetAsync(d_ws, 0, CTL_ZERO_BYTES, stream);
    Args a{};
    for (int i = 0; i < 33; ++i) a.in[i] = (const float*)d_in[i];
    a.out = (float*)d_out; a.ws = (unsigned char*)d_ws;
#if MK_N_LAUNCHES == 1
    a.ph_lo = 0; a.ph_hi = NPHASE; a.li = 0;
    hipLaunchKernelGGL(fwd_kernel, dim3(grid), dim3(NTHR), LDS_BYTES, stream, a);
#else
    for (int p = 0; p < NPHASE; ++p) { a.ph_lo = p; a.ph_hi = p + 1; a.li = p;
#ifdef REP_PHASE
        if (p == REP_PHASE) { Args a2 = a;
#ifdef REP_PAD
            a2.pad = REP_PAD;
#endif
            for (int rep = 0; rep < REP_N; ++rep) { a2.li = NPHASE + rep; hipLaunchKernelGGL(fwd_kernel, dim3(grid), dim3(NTHR), LDS_BYTES, stream, a2); } }
#endif
        hipLaunchKernelGGL(fwd_kernel, dim3(grid), dim3(NTHR), LDS_BYTES, stream, a);
#ifdef DBG_MODE
        unsigned* D = (unsigned*)((unsigned char*)d_ws + OFF_DBG); unsigned char* ws = (unsigned char*)d_ws;
        switch (p) {
            case 1: hipLaunchKernelGGL(dbg::chk_in_e, dim3(64), dim3(256), 0, stream, a, D); break;
            case 2: hipLaunchKernelGGL(dbg::chk_q2, dim3(64), dim3(256), 0, stream, a, D); hipLaunchKernelGGL(dbg::chk_cmp, dim3(96), dim3(256), 0, stream, a, D); break;
            case 3: hipLaunchKernelGGL(dbg::chk_idx, dim3(64), dim3(256), 0, stream, a, D); break;
            case 4: hipLaunchKernelGGL(dbg::chk_sel, dim3(48), dim3(256), 0, stream, a, D); break;
            case 5: hipLaunchKernelGGL(dbg::chk_dsa, dim3(64), dim3(256), 0, stream, a, D); hipLaunchKernelGGL(dbg::chk_nsa, dim3(64), dim3(256), 0, stream, a, D); break;
            case 6: hipLaunchKernelGGL(dbg::chk_out_e, dim3(32), dim3(256), 0, stream, a, D); break;
            case 7: hipLaunchKernelGGL(dbg::chk_ln, dim3(32), dim3(256), 0, stream, (const bf16_t*)(ws + OFF_S1), (const bf16_t*)(ws + OFF_H), a.in[I_ELN1G], a.in[I_ELN1B], D, 12); break;
            case 8: hipLaunchKernelGGL(dbg::chk_ffn_up, dim3(16), dim3(256), 0, stream, a, D); break;
            case 9: hipLaunchKernelGGL(dbg::chk_ffn_dn, dim3(32), dim3(256), 0, stream, a, D); break;
            case 10: hipLaunchKernelGGL(dbg::chk_ln, dim3(32), dim3(256), 0, stream, (const bf16_t*)(ws + OFF_S2), (const bf16_t*)(ws + OFF_X1), a.in[I_ELN2G], a.in[I_ELN2B], D, 15); break;
            case 10 + 100: break;
            case 11: hipLaunchKernelGGL(dbg::chk_wmoe, dim3(16), dim3(256), 0, stream, a, D); hipLaunchKernelGGL(dbg::chk_in_o, dim3(32), dim3(256), 0, stream, a, D); break;
            case 12: hipLaunchKernelGGL(dbg::chk_moba, dim3(64), dim3(256), 0, stream, a, D); break;
            case 13: hipLaunchKernelGGL(dbg::chk_out_o, dim3(32), dim3(256), 0, stream, a, D); break;
            case 14: hipLaunchKernelGGL(dbg::chk_ln, dim3(32), dim3(256), 0, stream, (const bf16_t*)(ws + OFF_S1O), (const bf16_t*)(ws + OFF_H2), a.in[I_OLN1G], a.in[I_OLN1B], D, 19); break;
            case 15: hipLaunchKernelGGL(dbg::chk_route, dim3(1), dim3(256), 0, stream, a, D); break;
            case 16: hipLaunchKernelGGL(dbg::chk_actm, dim3(8), dim3(256), 0, stream, a, D); break;
            case 17:
#ifdef DBG_SIMPLE_FINAL
                hipLaunchKernelGGL(dbg::simple_final, dim3(MTOK / 4), dim3(256), 0, stream, a);
#endif
                hipLaunchKernelGGL(dbg::chk_moe, dim3(16), dim3(256), 0, stream, a, D); hipLaunchKernelGGL(dbg::report, dim3(1024), dim3(256), 0, stream, (float*)d_out, (const unsigned*)D, out_size); break;
            default: break;
        }
#endif
    }
#endif
}
```

```cpp
#include <hip/hip_runtime.h>
#include <cstdio>
#include <cstdint>

#define LAS __attribute__((address_space(3)))
#define GAS __attribute__((address_space(1)))
typedef unsigned short bf16_t;
typedef short bf16x8 __attribute__((ext_vector_type(8)));
typedef short s16x4 __attribute__((ext_vector_type(4)));
typedef float f32x2 __attribute__((ext_vector_type(2)));
typedef float f32x4 __attribute__((ext_vector_type(4)));
typedef float f32x16 __attribute__((ext_vector_type(16)));
typedef unsigned u32x2 __attribute__((ext_vector_type(2)));
typedef unsigned u32x4 __attribute__((ext_vector_type(4)));
typedef __bf16 bf16x2_t __attribute__((ext_vector_type(2)));
typedef _Float16 f16x2_t __attribute__((ext_vector_type(2)));

constexpr int DM = 1024, NB = 8, SEQ = 4096, MTOK = NB * SEQ;
constexpr int EVEN_IN = 1768, EVEN_INP = 1792, DFF = 2816, DFFE = 3584, NEXP = 8;
constexpr float ALPHA = 1.4142135623730951f;
constexpr float LOG2E = 1.4426950408889634f;
constexpr float QSCALE = 0.125f * LOG2E;
constexpr int NWAVES = 8, NTHR = 512;

__device__ __forceinline__ unsigned f2bf(float f) { unsigned u = __builtin_bit_cast(unsigned, f); return (u + 0x7fffu + ((u >> 16) & 1u)) >> 16; }
__device__ __forceinline__ unsigned pk2(float lo, float hi) { f32x2 v = {lo, hi}; bf16x2_t b = __builtin_convertvector(v, bf16x2_t); return __builtin_bit_cast(unsigned, b); }
__device__ __forceinline__ float bf2f(unsigned short h) { return __builtin_bit_cast(float, (unsigned)h << 16); }
__device__ __forceinline__ float bflo(unsigned w) { return __builtin_bit_cast(float, w << 16); }
__device__ __forceinline__ float bfhi(unsigned w) { return __builtin_bit_cast(float, w & 0xffff0000u); }
__device__ __forceinline__ float wave_sum(float v) {
#pragma unroll
    for (int o = 1; o < 64; o <<= 1) v += __shfl_xor(v, o);
    return v;
}
#define LDS_WAIT() asm volatile("s_waitcnt lgkmcnt(0)" ::: "memory")
#define VM_WAIT() asm volatile("s_waitcnt vmcnt(0)" ::: "memory")
namespace pg8 {
#define PG8_LAS __attribute__((address_space(3)))
typedef unsigned short bf16_t;
typedef short bf16x8 __attribute__((ext_vector_type(8)));
typedef float f32x4 __attribute__((ext_vector_type(4)));
typedef unsigned u32x4 __attribute__((ext_vector_type(4)));
constexpr int BM = 256, BK = 64, HALF = 128, HTB = HALF * BK * 2  , STAGE_BYTES = 8 * HTB, NXCD = 8, WGM = 8;

__host__ __device__ __forceinline__ int lds_byte(int r, int c) { const int st = (r >> 4) * 2 + (c >> 5), rr = r & 15, cc = c & 31, ob = rr * 64 + cc * 2; return st * 1024 + (ob ^ (((ob >> 9) & 1) << 5)); }
__host__ __device__ __forceinline__ void stage_rc(int b, int& R, int& C) { const int st = b / 1024, sb = b % 1024, swz = sb ^ (((sb >> 9) & 1) << 5); R = (st >> 1) * 16 + swz / 64; C = (st & 1) * 32 + (swz % 64) / 2; }
__host__ __device__ __forceinline__ int perm32(int rho) { const int n = rho >> 4, i = rho & 15; return 8 * (i >> 2) + 4 * n + (i & 3); }

struct Unit { int pm, pn, e; };
struct Gemm { const bf16_t* A; const bf16_t* Bt; int M, N, K; int lda; size_t bstride; };

struct StaticOrder {
    int nM, nN, nwg, G, c;
    __host__ __device__ void init(int M, int N, int G_, int c_) { nM = M / BM; nN = N / BM; nwg = nM * nN; G = G_; c = c_; }
    __host__ __device__ bool next(int i, Unit& u) const {
        const long L = (long)i * G + c; if (L >= nwg) return false;
        int wgid = (int)L; { const int q = nwg / NXCD, r = nwg % NXCD, xcd = wgid % NXCD, off = wgid / NXCD; wgid = (xcd < r ? xcd * (q + 1) : r * (q + 1) + (xcd - r) * q) + off; }
        const int nig = WGM * nN, gid = wgid / nig, fm = gid * WGM, gsz = (nM - fm) < WGM ? (nM - fm) : WGM;
        u.pm = fm + ((wgid % nig) % gsz); u.pn = (wgid % nig) / gsz; u.e = 0; return true;
    }
    __device__ __forceinline__ void a_ready(const Unit&) const {}
    __device__ __forceinline__ void done(const Unit&) const {}
};


typedef int v8i32_t __attribute__((ext_vector_type(8)));
typedef int v4i32_t __attribute__((ext_vector_type(4)));
__device__ __forceinline__ v8i32_t cat8(bf16x8 lo, bf16x8 hi) { const v4i32_t a = __builtin_bit_cast(v4i32_t, lo), b = __builtin_bit_cast(v4i32_t, hi); return (v8i32_t){a[0], a[1], a[2], a[3], b[0], b[1], b[2], b[3]}; }
template <class Epi, class Sched, bool ALIGN_EPI = false, bool SP2 = false, bool F8 = false, bool I8 = false>
__device__ __forceinline__ void gemm_phase(PG8_LAS unsigned char* lds, const Gemm g, const Sched& S, const Epi& E) {
    const int tid = threadIdx.x, wid = __builtin_amdgcn_readfirstlane(tid >> 6), lane = tid & 63, wr = wid >> 2, wc = wid & 3, fr = lane & 15, fq = lane >> 4;
    const int K = g.K, nt = K / BK;
    unsigned voffA[2], voffB[2];
#pragma unroll
    for (int i = 0; i < 2; ++i) { int R, C; stage_rc(tid * 16 + i * 8192, R, C); const int Rb = Epi::PERM ? ((R & ~31) + perm32(R & 31)) : R;
        voffA[i] = (unsigned)(R * g.lda + C) * 2u; voffB[i] = (unsigned)(Rb * K + C) * 2u; }
    const size_t kstep = (size_t)(BK * 2);
    const size_t hstep = (size_t)HALF * K * 2;
    const size_t tstep = 2 * hstep;
    const size_t hstepA = (size_t)HALF * g.lda * 2, tstepA = 2 * hstepA;
    const size_t estep = g.bstride * 2;
    const unsigned ldsw = (unsigned)wid * 1024u;
    const int aoff = lds_byte(wr * 64 + fr, fq * 8), boff = lds_byte(wc * 32 + fr, fq * 8);
#define PG8_SA(b, h) (((b) * 2 + (h)) * HTB)
#define PG8_SB(b, h) ((4 + (b) * 2 + (h)) * HTB)
#define PG8_STAGE(bufoff, gbase, voff) do { _Pragma("unroll") for (int _i = 0; _i < 2; ++_i) \
        __builtin_amdgcn_global_load_lds((const unsigned*)((const char*)(gbase) + (voff)[_i]), (PG8_LAS unsigned*)(lds + (bufoff) + ldsw + _i * 8192), 16, 0, 0); } while (0)
#define PG8_LDA(dst, b, h) do { _Pragma("unroll") for (int m = 0; m < 4; ++m) _Pragma("unroll") for (int k = 0; k < 2; ++k) dst[m][k] = *(const PG8_LAS bf16x8*)(lds + PG8_SA(b, h) + aoff + m * 2048 + k * 1024); } while (0)
#define PG8_LDB(dst, b, h) do { _Pragma("unroll") for (int n = 0; n < 2; ++n) _Pragma("unroll") for (int k = 0; k < 2; ++k) dst[n][k] = *(const PG8_LAS bf16x8*)(lds + PG8_SB(b, h) + boff + n * 2048 + k * 1024); } while (0)
#define PG8_MMA(ai, bj, At, Bt) do { __builtin_amdgcn_s_setprio(1); if constexpr (I8) { _Pragma("unroll") for (int m = 0; m < 4; ++m) _Pragma("unroll") for (int n = 0; n < 2; ++n) _Pragma("unroll") for (int k = 0; k < 2; ++k) \
        asm volatile("v_mfma_i32_16x16x64_i8 %0, %1, %2, %0" : "+v"(acc[ai][bj][m][n]) : "v"(Bt[n][k]), "v"(At[m][k])); } else if constexpr (F8) { _Pragma("unroll") for (int m = 0; m < 4; ++m) _Pragma("unroll") for (int n = 0; n < 2; ++n) \
        asm volatile("v_mfma_scale_f32_16x16x128_f8f6f4 %0, %1, %2, %0, %3, %3 op_sel_hi:[0,0,0]" : "+v"(acc[ai][bj][m][n]) : "v"(cat8(Bt[n][0], Bt[n][1])), "v"(cat8(At[m][0], At[m][1])), "v"(sc8)); } else { \
        _Pragma("unroll") for (int m = 0; m < 4; ++m) _Pragma("unroll") for (int n = 0; n < 2; ++n) _Pragma("unroll") for (int k = 0; k < 2; ++k) \
        acc[ai][bj][m][n] = __builtin_amdgcn_mfma_f32_16x16x32_bf16(Bt[n][k], At[m][k], acc[ai][bj][m][n], 0, 0, 0); } __builtin_amdgcn_s_setprio(0); } while (0)
#define PG8_WAIT_V(n) asm volatile("s_waitcnt vmcnt(" #n ")" ::: "memory")
#define PG8_WAIT_L(n) asm volatile("s_waitcnt lgkmcnt(" #n ")" ::: "memory")
#define PG8_BAR __builtin_amdgcn_s_barrier()
#define PG8_SCHED __builtin_amdgcn_sched_barrier(0)
    Unit cur, nxt; int ui = 0;
    if (!S.next(0, cur)) return;
    int sc8 = 0x7f7f7f7f; asm volatile("" : "+v"(sc8));
    f32x4 acc[2][2][4][2];
#pragma unroll
    for (int a = 0; a < 2; ++a)
#pragma unroll
        for (int b = 0; b < 2; ++b)
#pragma unroll
            for (int m = 0; m < 4; ++m)
#pragma unroll
                for (int n = 0; n < 2; ++n) acc[a][b][m][n] = (f32x4){0.f, 0.f, 0.f, 0.f};
    bf16x8 At[4][2], B0[2][2], B1[2][2];
    const char* cA = (const char*)g.A + (size_t)cur.pm * tstepA; const char* cB = (const char*)g.Bt + (size_t)cur.pn * tstep + (size_t)cur.e * estep;
    S.a_ready(cur);
    if constexpr (SP2) {
        PG8_STAGE(PG8_SB(0, 0), cB, voffB); PG8_STAGE(PG8_SB(0, 1), cB + hstep, voffB); PG8_STAGE(PG8_SA(0, 0), cA, voffA); PG8_STAGE(PG8_SA(0, 1), cA + hstepA, voffA);
        if (wr == 1) PG8_BAR;
        PG8_WAIT_V(2); PG8_BAR;
        PG8_STAGE(PG8_SB(1, 0), cB + kstep, voffB); PG8_STAGE(PG8_SA(1, 0), cA + kstep, voffA); PG8_STAGE(PG8_SB(1, 1), cB + hstep + kstep, voffB);
        PG8_WAIT_V(6); PG8_BAR;
    } else {
        PG8_STAGE(PG8_SB(0, 0), cB, voffB); PG8_STAGE(PG8_SA(0, 0), cA, voffA); PG8_STAGE(PG8_SB(0, 1), cB + hstep, voffB); PG8_STAGE(PG8_SA(0, 1), cA + hstepA, voffA);
        if (wr == 1) PG8_BAR;
        PG8_WAIT_V(4); PG8_BAR;
        PG8_STAGE(PG8_SB(1, 0), cB + kstep, voffB); PG8_STAGE(PG8_SA(1, 0), cA + kstep, voffA); PG8_STAGE(PG8_SB(1, 1), cB + hstep + kstep, voffB);
        PG8_WAIT_V(6); PG8_BAR;
    }
    for (;;) {
        const bool has_next = S.next(ui + 1, nxt);
        const char* nA = has_next ? (const char*)g.A + (size_t)nxt.pm * tstepA : cA; const char* nB = has_next ? (const char*)g.Bt + (size_t)nxt.pn * tstep + (size_t)nxt.e * estep : cB;
#pragma unroll 1
        for (int t = 0; t < nt; t += 2) {
            const bool last = (t == nt - 2);
            const char* a1 = cA + (size_t)(t + 1) * kstep;
            const char* a2 = last ? nA : cA + (size_t)(t + 2) * kstep; const char* b2 = last ? nB : cB + (size_t)(t + 2) * kstep;
            const char* a3 = a2 + kstep; const char* b3 = b2 + kstep;
            if (last && has_next) S.a_ready(nxt);
            if constexpr (SP2) {
            PG8_LDB(B0, 0, 0); PG8_LDB(B1, 0, 1); PG8_SCHED; PG8_LDA(At, 0, 0); PG8_STAGE(PG8_SA(1, 1), a1 + hstepA, voffA);
            PG8_WAIT_V(8); PG8_WAIT_L(0); PG8_BAR; PG8_MMA(0, 0, At, B0); PG8_MMA(0, 1, At, B1); PG8_BAR; PG8_SCHED;
            PG8_LDA(At, 0, 1); PG8_STAGE(PG8_SB(0, 0), b2, voffB); PG8_STAGE(PG8_SB(0, 1), b2 + hstep, voffB); PG8_STAGE(PG8_SA(0, 0), a2, voffA);
            PG8_WAIT_V(8); PG8_WAIT_L(0); PG8_BAR; PG8_MMA(1, 0, At, B0); PG8_MMA(1, 1, At, B1); PG8_BAR; PG8_SCHED;
            PG8_LDB(B0, 1, 0); PG8_LDB(B1, 1, 1); PG8_SCHED; PG8_LDA(At, 1, 0); PG8_STAGE(PG8_SA(0, 1), a2 + hstepA, voffA);
            PG8_WAIT_V(8); PG8_WAIT_L(0); PG8_BAR; PG8_MMA(0, 0, At, B0); PG8_MMA(0, 1, At, B1); PG8_BAR; PG8_SCHED;
            PG8_LDA(At, 1, 1); PG8_STAGE(PG8_SB(1, 0), b3, voffB); PG8_STAGE(PG8_SB(1, 1), b3 + hstep, voffB); PG8_STAGE(PG8_SA(1, 0), a3, voffA);
            PG8_WAIT_V(8); PG8_WAIT_L(0); PG8_BAR; PG8_MMA(1, 0, At, B0); PG8_MMA(1, 1, At, B1); PG8_BAR; PG8_SCHED;
            } else {
            PG8_LDB(B0, 0, 0); PG8_SCHED; PG8_LDA(At, 0, 0); PG8_STAGE(PG8_SA(1, 1), a1 + hstepA, voffA);
            PG8_WAIT_L(8); PG8_BAR; PG8_WAIT_L(0); PG8_MMA(0, 0, At, B0); PG8_BAR; PG8_SCHED;
            PG8_LDB(B1, 0, 1); PG8_STAGE(PG8_SB(0, 0), b2, voffB);
            PG8_BAR; PG8_WAIT_L(0); PG8_MMA(0, 1, At, B1); PG8_BAR;
            PG8_LDA(At, 0, 1); PG8_STAGE(PG8_SA(0, 0), a2, voffA);
            PG8_BAR; PG8_WAIT_L(0); PG8_MMA(1, 0, At, B0); PG8_BAR; PG8_SCHED;
            PG8_STAGE(PG8_SB(0, 1), b2 + hstep, voffB);
            PG8_WAIT_V(6); PG8_BAR; PG8_MMA(1, 1, At, B1); PG8_BAR;
            PG8_LDB(B0, 1, 0); PG8_SCHED; PG8_LDA(At, 1, 0); PG8_STAGE(PG8_SA(0, 1), a2 + hstepA, voffA);
            PG8_WAIT_L(8); PG8_BAR; PG8_WAIT_L(0); PG8_MMA(0, 0, At, B0); PG8_BAR; PG8_SCHED;
            PG8_LDB(B1, 1, 1); PG8_STAGE(PG8_SB(1, 0), b3, voffB);
            PG8_BAR; PG8_WAIT_L(0); PG8_MMA(0, 1, At, B1); PG8_BAR;
            PG8_LDA(At, 1, 1); PG8_STAGE(PG8_SA(1, 0), a3, voffA);
            PG8_BAR; PG8_WAIT_L(0); PG8_MMA(1, 0, At, B0); PG8_BAR; PG8_SCHED;
            PG8_STAGE(PG8_SB(1, 1), b3 + hstep, voffB);
            PG8_WAIT_V(6); PG8_BAR; PG8_MMA(1, 1, At, B1); PG8_BAR;
            }
        }
        if constexpr (ALIGN_EPI) { if (wr == 0) PG8_BAR; }
        if constexpr (F8 || I8) asm volatile("s_nop 15\n\ts_nop 15" ::: "memory");
        if constexpr (!Epi::AFTER_DRAIN) { E(acc, cur, wr, wc, fr, fq); S.done(cur); }
        if (!has_next) break;
#pragma unroll
        for (int a = 0; a < 2; ++a)
#pragma unroll
            for (int b = 0; b < 2; ++b)
#pragma unroll
                for (int m = 0; m < 4; ++m)
#pragma unroll
                    for (int n = 0; n < 2; ++n) acc[a][b][m][n] = (f32x4){0.f, 0.f, 0.f, 0.f};
        cur = nxt; cA = nA; cB = nB; ++ui;
        if constexpr (ALIGN_EPI) { if (wr == 1) PG8_BAR; }
    }
    PG8_WAIT_V(0);
    if constexpr (!ALIGN_EPI) { if (wr == 0) PG8_BAR; }
    PG8_BAR;
    if constexpr (Epi::AFTER_DRAIN) { E.fused(acc, cur, wr, wc, fr, fq, lds, wid, lane); S.done(cur); }
#undef PG8_SA
#undef PG8_SB
#undef PG8_STAGE
#undef PG8_LDA
#undef PG8_LDB
#undef PG8_MMA
#undef PG8_WAIT_V
#undef PG8_WAIT_L
#undef PG8_BAR
#undef PG8_SCHED
}
}

namespace pg8 {
typedef f32x4 Acc[2][2][4][2];
__device__ __forceinline__ u32x4 pack8(const f32x4 v0, const f32x4 v1) { u32x4 w; w.x = pk2(v0[0], v0[1]); w.y = pk2(v0[2], v0[3]); w.z = pk2(v1[0], v1[1]); w.w = pk2(v1[2], v1[3]); return w; }
__device__ __forceinline__ void unpack8(const u32x4 w, f32x4& a, f32x4& b) { a = (f32x4){bflo(w.x), bfhi(w.x), bflo(w.y), bfhi(w.y)}; b = (f32x4){bflo(w.z), bfhi(w.z), bflo(w.w), bfhi(w.w)}; }

struct EpiInE {
    static constexpr bool PERM = true, AFTER_DRAIN = false;
    bf16_t* Y1; float* ssq_q; float* ssq_kv;
    __device__ __forceinline__ void operator()(const Acc& acc, const Unit& u, int wr, int wc, int fr, int fq) const {
        bf16_t* base = Y1 + (size_t)u.pn * MTOK * 256;
        const float sc = (u.pn == 2 || u.pn == 3) ? QSCALE : 1.f;
        const int col0 = wc * 32 + 8 * fq;
#pragma unroll
        for (int ai = 0; ai < 2; ++ai)
#pragma unroll
            for (int m = 0; m < 4; ++m) {
                const int row = u.pm * BM + ai * HALF + wr * 64 + m * 16 + fr; bf16_t* rowp = base + (size_t)row * 256 + col0;
                float s0 = 0.f, s1 = 0.f;
#pragma unroll
                for (int bj = 0; bj < 2; ++bj) { const f32x4 v0 = acc[ai][bj][m][0], v1 = acc[ai][bj][m][1];
                    const float q = (v0[0] * v0[0] + v0[1] * v0[1]) + (v0[2] * v0[2] + v0[3] * v0[3]) + (v1[0] * v1[0] + v1[1] * v1[1]) + (v1[2] * v1[2] + v1[3] * v1[3]);
                    if (bj == 0) s0 = q; else s1 = q;
                    *(u32x4*)(rowp + bj * HALF) = pack8(v0 * sc, v1 * sc); }
                if (u.pn <= 1) {
                    float s = (u.pn == 0) ? (s0 + s1) : s0;
                    s += __shfl_xor(s, 16); s += __shfl_xor(s, 32);
                    if (fq == 0) (u.pn == 0 ? ssq_q : ssq_kv)[(size_t)row * 4 + wc] = s;
                }
            }
    }
};
struct EpiQ2 {
    static constexpr bool PERM = true, AFTER_DRAIN = false;
    bf16_t* QLAT; bf16_t* QIDX; const float* ssq_q;
    __device__ __forceinline__ void operator()(const Acc& acc, const Unit& u, int wr, int wc, int fr, int fq) const {
        bf16_t* base = (u.pn < 4) ? QLAT : QIDX; const float sc0 = (u.pn < 4) ? QSCALE : 1.f;
        const int col0 = (u.pn & 3) * 256 + wc * 32 + 8 * fq;
#pragma unroll
        for (int ai = 0; ai < 2; ++ai)
#pragma unroll
            for (int m = 0; m < 4; ++m) {
                const int row = u.pm * BM + ai * HALF + wr * 64 + m * 16 + fr; bf16_t* rowp = base + (size_t)row * 1024 + col0;
                const f32x4 sq = *(const f32x4*)(ssq_q + (size_t)row * 4); const float sc = sc0 * __builtin_amdgcn_rsqf(((sq[0] + sq[1]) + (sq[2] + sq[3])) * (1.f / 256.f) + 1e-6f);
#pragma unroll
                for (int bj = 0; bj < 2; ++bj) *(u32x4*)(rowp + bj * HALF) = pack8(acc[ai][bj][m][0] * sc, acc[ai][bj][m][1] * sc);
            }
    }
};
template <bool RES_F32> struct EpiRes {
    static constexpr bool PERM = true, AFTER_DRAIN = false;
    const void* res; bf16_t* S; float sc;
    __device__ __forceinline__ void operator()(const Acc& acc, const Unit& u, int wr, int wc, int fr, int fq) const {
        const int col0 = u.pn * BM + wc * 32 + 8 * fq;
#pragma unroll
        for (int ai = 0; ai < 2; ++ai)
#pragma unroll
            for (int m = 0; m < 4; ++m) {
                const size_t off = (size_t)(u.pm * BM + ai * HALF + wr * 64 + m * 16 + fr) * 1024 + col0;
#pragma unroll
                for (int bj = 0; bj < 2; ++bj) { f32x4 r0, r1;
                    if (RES_F32) { r0 = *(const f32x4*)((const float*)res + off + bj * HALF); r1 = *(const f32x4*)((const float*)res + off + bj * HALF + 4); }
                    else unpack8(*(const u32x4*)((const bf16_t*)res + off + bj * HALF), r0, r1);
                    *(u32x4*)(S + off + bj * HALF) = pack8(r0 * ALPHA + acc[ai][bj][m][0] * sc, r1 * ALPHA + acc[ai][bj][m][1] * sc); }
            }
    }
};
struct EpiSwiglu {
    static constexpr bool PERM = true, AFTER_DRAIN = false;
    bf16_t* O; int ldo; int pm0;
    __device__ __forceinline__ void operator()(const Acc& acc, const Unit& u, int wr, int wc, int fr, int fq) const {
        const int col0 = u.pn * HALF + wc * 32 + 8 * fq;
#pragma unroll
        for (int ai = 0; ai < 2; ++ai)
#pragma unroll
            for (int m = 0; m < 4; ++m) {
                bf16_t* rowp = O + (size_t)((u.pm - pm0) * BM + ai * HALF + wr * 64 + m * 16 + fr) * ldo + col0;
                f32x4 o[2];
#pragma unroll
                for (int n = 0; n < 2; ++n) { const f32x4 a = acc[ai][0][m][n], b = acc[ai][1][m][n];
#pragma unroll
                    for (int e = 0; e < 4; ++e) o[n][e] = a[e] * __builtin_amdgcn_rcpf(1.f + __expf(-a[e])) * b[e]; }
                *(u32x4*)rowp = pack8(o[0], o[1]);
            }
    }
};
struct EpiStore {
    static constexpr bool PERM = true, AFTER_DRAIN = false;
    bf16_t* O; int ldo;
    __device__ __forceinline__ void operator()(const Acc& acc, const Unit& u, int wr, int wc, int fr, int fq) const {
        const int col0 = u.pn * BM + wc * 32 + 8 * fq;
#pragma unroll
        for (int ai = 0; ai < 2; ++ai)
#pragma unroll
            for (int m = 0; m < 4; ++m) {
                bf16_t* rowp = O + (size_t)(u.pm * BM + ai * HALF + wr * 64 + m * 16 + fr) * ldo + col0;
#pragma unroll
                for (int bj = 0; bj < 2; ++bj) *(u32x4*)(rowp + bj * HALF) = pack8(acc[ai][bj][m][0], acc[ai][bj][m][1]);
            }
    }
};
struct EpiInO {
    static constexpr bool PERM = true, AFTER_DRAIN = false;
    bf16_t* QKV; float* kmean; float isc;
    __device__ __forceinline__ void operator()(const Acc& acc, const Unit& u, int wr, int wc, int fr, int fq) const {
        const int which = u.pn >> 2; bf16_t* base = QKV + (size_t)which * MTOK * 1024; const float sc = (which == 0) ? QSCALE * isc : isc;
        const int col0 = (u.pn & 3) * BM + wc * 32 + 8 * fq;
#pragma unroll
        for (int ai = 0; ai < 2; ++ai)
#pragma unroll
            for (int m = 0; m < 4; ++m) {
                bf16_t* rowp = base + (size_t)(u.pm * BM + ai * HALF + wr * 64 + m * 16 + fr) * 1024 + col0;
#pragma unroll
                for (int bj = 0; bj < 2; ++bj) *(u32x4*)(rowp + bj * HALF) = pack8(acc[ai][bj][m][0] * sc, acc[ai][bj][m][1] * sc);
            }
        if (which == 1) {
#pragma unroll
            for (int bj = 0; bj < 2; ++bj)
#pragma unroll
                for (int n = 0; n < 2; ++n) { f32x4 s = (f32x4){0.f, 0.f, 0.f, 0.f};
#pragma unroll
                    for (int ai = 0; ai < 2; ++ai)
#pragma unroll
                        for (int m = 0; m < 4; ++m) s += acc[ai][bj][m][n];
#pragma unroll
                    for (int e = 0; e < 4; ++e) { float v = s[e]; v += __shfl_xor(v, 1); v += __shfl_xor(v, 2); v += __shfl_xor(v, 4); v += __shfl_xor(v, 8);
                        if (fr == 0) kmean[((size_t)u.pm * 2 + wr) * 1024 + col0 + bj * HALF + 4 * n + e] = v; }
                }
        }
    }
};

__device__ __forceinline__ unsigned pk4_fp8(float a, float b, float c, float d) { int w = 0; w = __builtin_amdgcn_cvt_pk_fp8_f32(a, b, w, false); w = __builtin_amdgcn_cvt_pk_fp8_f32(c, d, w, true); return (unsigned)w; }
struct EpiSwiglu8 {
    static constexpr bool PERM = true, AFTER_DRAIN = false;
    unsigned char* O; int ldo; int pm0; float isc;
    __device__ __forceinline__ void operator()(const Acc& acc, const Unit& u, int wr, int wc, int fr, int fq) const {
        const int col0 = u.pn * HALF + wc * 32 + 8 * fq;
#pragma unroll
        for (int ai = 0; ai < 2; ++ai)
#pragma unroll
            for (int m = 0; m < 4; ++m) {
                unsigned char* rowp = O + (size_t)((u.pm - pm0) * BM + ai * HALF + wr * 64 + m * 16 + fr) * ldo + col0;
                f32x4 o[2];
#pragma unroll
                for (int n = 0; n < 2; ++n) { const f32x4 a = acc[ai][0][m][n] * isc, b = acc[ai][1][m][n] * isc;
#pragma unroll
                    for (int e = 0; e < 4; ++e) o[n][e] = a[e] * __builtin_amdgcn_rcpf(1.f + __expf(-a[e])) * b[e]; }
                u32x2 w; w.x = pk4_fp8(o[0][0], o[0][1], o[0][2], o[0][3]); w.y = pk4_fp8(o[1][0], o[1][1], o[1][2], o[1][3]);
                *(u32x2*)rowp = w;
            }
    }
};

struct EpiSwigluI8 {
    static constexpr bool PERM = true, AFTER_DRAIN = false;
    unsigned char* O; int ldo; const float* sa; const float* sw;
    __device__ __forceinline__ void operator()(const Acc& acc, const Unit& u, int wr, int wc, int fr, int fq) const {
        const int col0 = u.pn * HALF + wc * 32 + 8 * fq, bcol = u.pn * BM + wc * 32 + 8 * fq;
        f32x4 w1s[2], w3s[2];
#pragma unroll
        for (int n = 0; n < 2; ++n) { w1s[n] = *(const f32x4*)(sw + bcol + 4 * n); w3s[n] = *(const f32x4*)(sw + bcol + HALF + 4 * n); }
#pragma unroll
        for (int ai = 0; ai < 2; ++ai)
#pragma unroll
            for (int m = 0; m < 4; ++m) {
                const int row = u.pm * BM + ai * HALF + wr * 64 + m * 16 + fr; const float ra = sa[row];
                unsigned char* rowp = O + (size_t)row * ldo + col0;
                f32x4 o[2];
#pragma unroll
                for (int n = 0; n < 2; ++n) {
#pragma unroll
                    for (int e = 0; e < 4; ++e) { const float xa = acc[ai][0][m][n][e], xb = acc[ai][1][m][n][e];
                        const float a = (float)__float_as_int(xa) * ra * w1s[n][e], b = (float)__float_as_int(xb) * ra * w3s[n][e];
                        o[n][e] = a * __builtin_amdgcn_rcpf(1.f + __expf(-a)) * b; } }
                u32x2 w; w.x = pk4_fp8(o[0][0], o[0][1], o[0][2], o[0][3]); w.y = pk4_fp8(o[1][0], o[1][1], o[1][2], o[1][3]);
                *(u32x2*)rowp = w;
            }
    }
};
struct EpiStoreS {
    static constexpr bool PERM = true, AFTER_DRAIN = false;
    bf16_t* O; int ldo; float sc;
    __device__ __forceinline__ void operator()(const Acc& acc, const Unit& u, int wr, int wc, int fr, int fq) const {
        const int col0 = u.pn * BM + wc * 32 + 8 * fq;
#pragma unroll
        for (int ai = 0; ai < 2; ++ai)
#pragma unroll
            for (int m = 0; m < 4; ++m) {
                bf16_t* rowp = O + (size_t)(u.pm * BM + ai * HALF + wr * 64 + m * 16 + fr) * ldo + col0;
#pragma unroll
                for (int bj = 0; bj < 2; ++bj) *(u32x4*)(rowp + bj * HALF) = pack8(acc[ai][bj][m][0] * sc, acc[ai][bj][m][1] * sc);
            }
    }
};
struct MoeOrder {
    int g0, ng, nN, G, c; int pend[8];
    __device__ __forceinline__ bool next(int i, Unit& u) const {
        const int L = i * G + c; if (L >= ng * nN) return false;
        u.pm = g0 + L % ng; u.pn = L / ng; const int r = u.pm * 256; int e = 0;
#pragma unroll
        for (int k = 0; k < 7; ++k) e += (pend[k] <= r) ? 1 : 0;
        u.e = e; return true;
    }
    __device__ __forceinline__ void a_ready(const Unit&) const {}
    __device__ __forceinline__ void done(const Unit&) const {}
};
}

#ifndef FFN_F8
#define FFN_F8 0
#endif
constexpr size_t MiB = 1u << 20, KiB = 1u << 10;
constexpr size_t CTL_ZERO_BYTES = 2 * MiB;
constexpr int    MAX_LAUNCHES = 18;
constexpr size_t OFF_BAR = 16 * KiB;
constexpr size_t OFF_WGCNT = 1 * MiB + 512 * KiB;
constexpr size_t OFF_GINFO = OFF_WGCNT + 16 * KiB;
constexpr size_t OFF_DBG = OFF_GINFO + 1 * KiB;
constexpr size_t OFF_BT = 2 * MiB;
constexpr size_t OFF_CB = 2 * MiB + 16 * KiB;
constexpr size_t OFF_ROUTE = 2 * MiB + 64 * KiB;
constexpr size_t OFF_DEST = 2 * MiB + 512 * KiB;
constexpr size_t OFF_KC = 3 * MiB, OFF_VC = 3 * MiB + 512 * KiB;
constexpr size_t OFF_W_IN = 4 * MiB, OFF_W_Q2 = OFF_W_IN + (size_t)EVEN_INP * 1024 * 2, OFF_W_OUTE = OFF_W_Q2 + 2048 * 256 * 2, OFF_W_F13 = OFF_W_OUTE + 1024 * 1536 * 2,
                 OFF_W_F2 = OFF_W_F13 + (size_t)2 * DFF * 1024 * 2, OFF_CK1 = OFF_W_F2 + (size_t)1024 * DFF * 2, OFF_CV1 = OFF_CK1 + 64 * 2048 * 2, OFF_WE_END = OFF_CV1 + 64 * 2048 * 2;
static_assert(OFF_WE_END <= 30 * MiB, "even weights");
constexpr size_t OFF_W_OIN = 30 * MiB, OFF_W_OOUT = 36 * MiB, OFF_W_M13 = 38 * MiB, OFF_W_M2 = 94 * MiB;
constexpr size_t OFF_Y1 = 30 * MiB;
constexpr size_t OFF_CKVN = 142 * MiB;
constexpr size_t OFF_XB = 206 * MiB, OFF_QLAT = 206 * MiB, OFF_QIDX = 270 * MiB;
constexpr size_t OFF_SC = 334 * MiB, OFF_MASK = 464 * MiB, OFF_MIXIN = 334 * MiB;
constexpr size_t OFF_S1 = 206 * MiB, OFF_H = 270 * MiB, OFF_ACT = 30 * MiB, OFF_S2 = 334 * MiB, OFF_X1 = 398 * MiB, OFF_H8 = 464 * MiB;
constexpr size_t OFF_SA = 497 * MiB, OFF_SW = 497 * MiB + 256 * KiB, OFF_SAX = 497 * MiB + 512 * KiB, OFF_SWIN = 497 * MiB + 768 * KiB;
constexpr size_t OFF_X18 = 464 * MiB, OFF_O8 = 464 * MiB;
constexpr float OSC = 16.f, WOUT_SCALE = 64.f, WIN_SCALE = 32.f, WF13_SCALE = 32.f, WF2_SCALE = 128.f;
constexpr size_t OFF_QKV = 206 * MiB, OFF_S1O = 270 * MiB, OFF_H2 = 122 * MiB, OFF_ACTM = 186 * MiB, OFF_YR = 298 * MiB, OFF_XR = 430 * MiB;
constexpr float W13_SCALE = 32.f, W2_SCALE = 128.f;
constexpr size_t OFF_MST = 122 * MiB;
constexpr size_t OFF_SSQ_Q = 514 * MiB, OFF_SSQ_KV = 514 * MiB + 512 * KiB;
constexpr size_t OFF_KMEAN = 515 * MiB;
constexpr size_t WS_END = 516 * MiB;
constexpr int    MOE_CHUNK = 128;
constexpr size_t SCB_ELEMS = (size_t)64 * 64 * (64 * 65 / 2);

constexpr int LDS_BYTES = 160 * 1024;
constexpr int LDSCTL_OFF = LDS_BYTES - 512;

#define RLX_AGENT __ATOMIC_RELAXED, __HIP_MEMORY_SCOPE_AGENT
typedef GAS unsigned gu32;
#define XB_TMO      128
#define XB_XCNT(j)  (256  + 64 * (j))
#define XB_XSUB(j)  (1280 + 64 * (j))
#define XB_XGEN(j)  (2304 + 64 * (j))
#define XB_TOP      3328
#define XB_TOPGEN   3392
#define XCD_BAR_WORDS 3456
#define XB_SPIN_CAP (1u << 18)

__device__ __forceinline__ unsigned xb_ld(unsigned* p)              { return __hip_atomic_load(p, __ATOMIC_RELAXED, __HIP_MEMORY_SCOPE_AGENT); }
__device__ __forceinline__ unsigned xb_add(unsigned* p, unsigned v) { return __hip_atomic_fetch_add(p, v, __ATOMIC_RELAXED, __HIP_MEMORY_SCOPE_AGENT); }
__device__ __forceinline__ unsigned xb_xcc_id() { return (unsigned)__builtin_amdgcn_s_getreg((3 << 11) | 20) & 0xFu; }
#define XB_SPIN(cond, bar) do { unsigned _sp = 0; while (cond) { __builtin_amdgcn_s_sleep(1); \
    if ((++_sp & 255u) == 0u) { if (xb_ld(&(bar)[XB_TMO])) break; if (_sp > XB_SPIN_CAP) { atomicAdd(&(bar)[XB_TMO], 1u); break; } } } } while (0)

struct XcdBarrier {
    unsigned* bar; unsigned x;
    volatile LAS unsigned* st;
};

__device__ __forceinline__ XcdBarrier xcd_barrier_post(unsigned* bar, volatile LAS unsigned* st) {
    XcdBarrier b; b.bar = bar; b.x = xb_xcc_id(); b.st = st;
    if (threadIdx.x == 0) (void)xb_add(&bar[XB_XCNT(b.x)], 1u);
    return b;
}
__device__ __forceinline__ void xcd_barrier_complete(unsigned* bar, unsigned x, unsigned& nloc, unsigned& nx) {
    const unsigned G = gridDim.x * gridDim.y * gridDim.z;
    unsigned sum, cnt, mine, sp = 0u;
    for (;;) {
        sum = 0u; cnt = 0u; mine = 0u;
#pragma unroll
        for (unsigned j = 0; j < 16; ++j) { const unsigned c = xb_ld(&bar[XB_XCNT(j)]); sum += c; cnt += (c > 0u) ? 1u : 0u; mine = (j == x) ? c : mine; }
        if (sum == G) break;
        __builtin_amdgcn_s_sleep(1);
        if ((++sp & 255u) == 0u) { if (xb_ld(&bar[XB_TMO])) break; if (sp > XB_SPIN_CAP) { atomicAdd(&bar[XB_TMO], 1u); break; } }
    }
    nloc = mine > 0u ? mine : 1u; nx = cnt > 0u ? cnt : 1u;
}

__device__ __forceinline__ void xcd_barrier(const XcdBarrier& b) {
    asm volatile("s_waitcnt vmcnt(0)" ::: "memory");
    __syncthreads();
    if (threadIdx.x == 0) {
        unsigned* bar = b.bar;
        __builtin_amdgcn_s_waitcnt(0);
        unsigned nloc = b.st[0], nx = b.st[1];
        if (nloc == 0u) { xcd_barrier_complete(bar, b.x, nloc, nx); b.st[0] = nloc; b.st[1] = nx; }
        const unsigned old = xb_add(&bar[XB_XSUB(b.x)], 1u);
        const unsigned gen = old / nloc;
        if (old + 1u == (gen + 1u) * nloc) {
            __builtin_amdgcn_fence(__ATOMIC_RELEASE, "agent");
            asm volatile("s_waitcnt vmcnt(0)" ::: "memory");
            const unsigned og = xb_add(&bar[XB_TOP], 1u);
            const unsigned tg = og / nx;
            if (og + 1u == (tg + 1u) * nx) xb_add(&bar[XB_TOPGEN], 1u);
            else XB_SPIN(xb_ld(&bar[XB_TOPGEN]) == tg, bar);
            __builtin_amdgcn_fence(__ATOMIC_ACQUIRE, "agent");
            xb_add(&bar[XB_XGEN(b.x)], 1u);
            asm volatile("s_waitcnt vmcnt(0)" ::: "memory");
        } else {
            XB_SPIN(xb_ld(&bar[XB_XGEN(b.x)]) == gen, bar);
            __builtin_amdgcn_fence(__ATOMIC_ACQUIRE, "agent");
            asm volatile("s_waitcnt vmcnt(0)" ::: "memory");
        }
    }
    __syncthreads();
}

struct Frame {
    LAS unsigned char* lds;
    int tid, lane, wave, G, bx;
    int gw, NGW;
    unsigned char* ws;
    const float* const* in;
};
struct Args { const float* in[33]; float* out; unsigned char* ws; int ph_lo, ph_hi, li, pad; };
enum InIdx { I_X = 0, I_RELB, I_EWIN, I_EQN, I_EKVN, I_EWUQ, I_EWUK, I_EWUV, I_EWQIDX, I_EPOSK, I_EPOSV, I_ECK1, I_ECK2, I_ECV1, I_ECV2, I_EWOUT, I_ELN1G, I_ELN1B,
             I_EF1, I_EF3, I_EF2, I_ELN2G, I_ELN2B, I_OWIN, I_OWOUT, I_OLN1G, I_OLN1B, I_OROUTER, I_OM1, I_OM3, I_OM2, I_OLN2G, I_OLN2B };

template <class RowMap, class KScale>
__device__ __forceinline__ void transpose_item(const float* W, int K, int N, bf16_t* WT, int ldt, LAS float* scr, int item, int lane, RowMap rm, KScale ks) {
    const int nblk = (N + 63) >> 6, kb = item / nblk, nb = item - kb * nblk, k0 = 128 * kb, n = 64 * nb + lane;
    if (n >= N) return;
    const float* src = W + (size_t)k0 * N + n; bf16_t* dst = WT + (size_t)rm(n) * ldt + k0;
#pragma unroll 2
    for (int kk = 0; kk < 128; kk += 8) { float v[8];
#pragma unroll
        for (int i = 0; i < 8; ++i) v[i] = src[(size_t)(kk + i) * N] * ks(k0 + kk + i);
        u32x4 o; o.x = pk2(v[0], v[1]); o.y = pk2(v[2], v[3]); o.z = pk2(v[4], v[5]); o.w = pk2(v[6], v[7]);
        *(u32x4*)(dst + kk) = o; }
}
template <class RowMap, int KB = 128>
__device__ __forceinline__ void transpose_item8(const float* W, int K, int N, unsigned char* WT, int ldt, int item, int lane, RowMap rm, float scale) {
    const int nblk = N >> 8, kb = item / nblk, nb = item - kb * nblk, k0 = KB * kb, n = 256 * nb + 4 * lane;
    const float* src = W + (size_t)k0 * N + n;
    unsigned char* d0 = WT + (size_t)rm(n) * ldt + k0; unsigned char* d1 = WT + (size_t)rm(n + 1) * ldt + k0; unsigned char* d2 = WT + (size_t)rm(n + 2) * ldt + k0; unsigned char* d3 = WT + (size_t)rm(n + 3) * ldt + k0;
#pragma unroll 1
    for (int kk = 0; kk < KB; kk += 16) { f32x4 v[16];
#pragma unroll
        for (int i = 0; i < 16; ++i) v[i] = *(const f32x4*)(src + (size_t)(kk + i) * N) * scale;
#pragma unroll
        for (int c = 0; c < 4; ++c) { u32x4 o; o.x = pg8::pk4_fp8(v[0][c], v[1][c], v[2][c], v[3][c]); o.y = pg8::pk4_fp8(v[4][c], v[5][c], v[6][c], v[7][c]);
            o.z = pg8::pk4_fp8(v[8][c], v[9][c], v[10][c], v[11][c]); o.w = pg8::pk4_fp8(v[12][c], v[13][c], v[14][c], v[15][c]);
            *(u32x4*)((c == 0 ? d0 : c == 1 ? d1 : c == 2 ? d2 : d3) + kk) = o; } }
}
template <class RowMap>
__device__ __forceinline__ void transpose_item_i8(const float* W, int K, int N, unsigned char* WT, int ldt, float* sw, int item, int lane, RowMap rm) {
    const int c = lane & 7, kg = lane >> 3, n = 8 * item + c, ks = K >> 3, kbase = kg * ks;
    const float* src = W + (size_t)kbase * N + n; float mx = 0.f;
#pragma unroll 16
    for (int k = 0; k < ks; ++k) mx = fmaxf(mx, fabsf(src[(size_t)k * N]));
    mx = fmaxf(mx, __shfl_xor(mx, 8)); mx = fmaxf(mx, __shfl_xor(mx, 16)); mx = fmaxf(mx, __shfl_xor(mx, 32));
    mx = fmaxf(mx, 1e-20f); const float inv = 127.f / mx; const int dr = rm(n); if (kg == 0) sw[dr] = mx * (1.f / 127.f);
    unsigned char* dst = WT + (size_t)dr * ldt + kbase;
#pragma unroll 2
    for (int kk = 0; kk < ks; kk += 16) { unsigned w[4];
#pragma unroll
        for (int q = 0; q < 4; ++q) { const int q0 = (int)rintf(src[(size_t)(kk + 4 * q) * N] * inv), q1 = (int)rintf(src[(size_t)(kk + 4 * q + 1) * N] * inv), q2 = (int)rintf(src[(size_t)(kk + 4 * q + 2) * N] * inv), q3 = (int)rintf(src[(size_t)(kk + 4 * q + 3) * N] * inv);
            w[q] = (unsigned)(q0 & 255) | ((unsigned)(q1 & 255) << 8) | ((unsigned)(q2 & 255) << 16) | ((unsigned)(q3 & 255) << 24); }
        *(u32x4*)(dst + kk) = (u32x4){w[0], w[1], w[2], w[3]}; }
}
struct RowId { __device__ __forceinline__ int operator()(int n) const { return n; } };
struct KOne { __device__ __forceinline__ float operator()(int) const { return 1.f; } };
struct RowInE {
    __device__ __forceinline__ int operator()(int n) const { return n < 464 ? n : (n < 1744 ? n + 48 : n - 1744 + 464); }
};
struct RowIlv {
    int add; __device__ __forceinline__ int operator()(int n) const { return ((n >> 7) << 8) + (n & 127) + add; }
};
struct KGain { const float* g; __device__ __forceinline__ float operator()(int k) const { return g[k]; } };

__device__ __forceinline__ void store_row_i8(unsigned char* row, float* sa, int lane, const f32x4 (&v)[4]) {
    float mx = 0.f;
#pragma unroll
    for (int j = 0; j < 4; ++j) mx = fmaxf(fmaxf(mx, fmaxf(fabsf(v[j][0]), fabsf(v[j][1]))), fmaxf(fabsf(v[j][2]), fabsf(v[j][3])));
#pragma unroll
    for (int o = 1; o < 64; o <<= 1) mx = fmaxf(mx, __shfl_xor(mx, o));
    mx = fmaxf(mx, 1e-20f); const float inv = 127.f / mx;
#pragma unroll
    for (int j = 0; j < 4; ++j) { const int q0 = (int)rintf(v[j][0] * inv), q1 = (int)rintf(v[j][1] * inv), q2 = (int)rintf(v[j][2] * inv), q3 = (int)rintf(v[j][3] * inv);
        *(unsigned*)(row + 4 * lane + 256 * j) = (unsigned)(q0 & 255) | ((unsigned)(q1 & 255) << 8) | ((unsigned)(q2 & 255) << 16) | ((unsigned)(q3 & 255) << 24); }
    if (lane == 0) *sa = mx * (1.f / 127.f);
}
__device__ __forceinline__ int t5_bucket(int n) {
    if (n < 16) return n;
    int l = 16 + (int)(__logf((float)n / 16.f) / 2.0794415f * 16.f);
    return l < 31 ? l : 31;
}

__device__ __forceinline__ void phase_prologue_even(const Frame& F, const Args& a) {
    LAS float* scr = (LAS float*)(F.lds + F.wave * 8704);
    unsigned char* ws = F.ws;
    bf16_t* W_IN = (bf16_t*)(ws + OFF_W_IN); bf16_t* W_Q2 = (bf16_t*)(ws + OFF_W_Q2); unsigned char* W_OUTE = ws + OFF_W_OUTE;
    unsigned char* W_F13 = ws + OFF_W_F13; unsigned char* W_F2 = ws + OFF_W_F2; bf16_t* CK1 = (bf16_t*)(ws + OFF_CK1); bf16_t* CV1 = (bf16_t*)(ws + OFF_CV1);
    constexpr int I_IN = 8 * ((EVEN_IN + 63) / 64);
    constexpr int I_QI = 2 * 16;
    constexpr int I_OB = 4 * 4;
    constexpr int I_F1 = DFF / 8, I_F2 = (DFF / 128) * 4;
    constexpr int I_CK = 16 * 1;
    constexpr int NIT = I_IN + I_QI + I_OB + 2 * I_F1 + I_F2 + 2 * I_CK;
    for (int it = F.gw; it < NIT; it += F.NGW) {
        int r = it;
        if (r < I_IN) { transpose_item(a.in[I_EWIN], 1024, EVEN_IN, W_IN, 1024, scr, r, F.lane, RowInE{}, KOne{}); continue; } r -= I_IN;
        if (r < I_QI) { transpose_item(a.in[I_EWQIDX], 256, 1024, W_Q2 + 1024 * 256, 256, scr, r, F.lane, RowId{}, KGain{a.in[I_EQN]}); continue; } r -= I_QI;
        if (r < I_OB) { transpose_item8(a.in[I_EWOUT] + 512 * 1024, 512, 1024, W_OUTE + 1024, 1536, r, F.lane, RowId{}, WOUT_SCALE); continue; } r -= I_OB;
#if FFN_F8
        if (r < I_F1) { transpose_item8(a.in[I_EF1], 1024, DFF, W_F13, 1024, r, F.lane, RowIlv{0}, WF13_SCALE); continue; } r -= I_F1;
        if (r < I_F1) { transpose_item8(a.in[I_EF3], 1024, DFF, W_F13, 1024, r, F.lane, RowIlv{128}, WF13_SCALE); continue; } r -= I_F1;
        if (r < I_F2) { transpose_item8(a.in[I_EF2], DFF, 1024, W_F2, DFF, r, F.lane, RowId{}, WF2_SCALE); continue; } r -= I_F2;
#else
        if (r < I_F1) { transpose_item_i8(a.in[I_EF1], 1024, DFF, W_F13, 1024, (float*)(ws + OFF_SW), r, F.lane, RowIlv{0}); continue; } r -= I_F1;
        if (r < I_F1) { transpose_item_i8(a.in[I_EF3], 1024, DFF, W_F13, 1024, (float*)(ws + OFF_SW), r, F.lane, RowIlv{128}); continue; } r -= I_F1;
        if (r < I_F2) { transpose_item8(a.in[I_EF2], DFF, 1024, W_F2, DFF, r, F.lane, RowId{}, WF2_SCALE); continue; } r -= I_F2;
#endif
        if (r < I_CK) { transpose_item(a.in[I_ECK1], 2048, 64, CK1, 2048, scr, r, F.lane, RowId{}, KOne{}); continue; } r -= I_CK;
        transpose_item(a.in[I_ECV1], 2048, 64, CV1, 2048, scr, r, F.lane, RowId{}, KOne{});
    }
    const int gt = F.bx * NTHR + F.tid, NGT = F.G * NTHR;
    for (int i = gt; i < 24 * 1024 / 8; i += NGT) ((u32x4*)(W_IN + 488 * 1024))[i] = (u32x4){0u, 0u, 0u, 0u};
    { const float* uq = a.in[I_EWUQ]; const float* uk = a.in[I_EWUK]; const float* qg = a.in[I_EQN];
      for (int o = gt; o < 1024 * 256; o += NGT) { const int r = o & 255, hc = o >> 8, h = hc >> 7, c = hc & 127; const float* p = uq + r * 512 + h * 64; const float* q = uk + c * 512 + h * 64; float s = 0.f;
#pragma unroll 8
          for (int d = 0; d < 64; ++d) s += p[d] * q[d];
          W_Q2[o] = (bf16_t)f2bf(s * qg[r]); } }
    { const float* uv = a.in[I_EWUV]; const float* wo = a.in[I_EWOUT];
      for (int o = gt; o < 1024 * 1024 / 16; o += NGT) { const int nb = o & 255, hc4 = o >> 8, h = hc4 >> 5, c0 = (hc4 & 31) * 4, n0 = nb * 4;
          const float* p = uv + (size_t)c0 * 512 + h * 64; const float* q = wo + (size_t)(h * 64) * 1024 + n0;
          f32x4 acc4[4] = {(f32x4){0.f, 0.f, 0.f, 0.f}, (f32x4){0.f, 0.f, 0.f, 0.f}, (f32x4){0.f, 0.f, 0.f, 0.f}, (f32x4){0.f, 0.f, 0.f, 0.f}};
#pragma unroll 4
          for (int d = 0; d < 64; ++d) { const f32x4 qv = *(const f32x4*)(q + (size_t)d * 1024);
#pragma unroll
              for (int cc = 0; cc < 4; ++cc) acc4[cc] += qv * p[cc * 512 + d]; }
#pragma unroll
          for (int cc = 0; cc < 4; ++cc)
#pragma unroll
              for (int e = 0; e < 4; ++e) W_OUTE[(size_t)(n0 + e) * 1536 + h * 128 + c0 + cc] = (unsigned char)(__builtin_amdgcn_cvt_pk_fp8_f32(acc4[cc][e] * WOUT_SCALE, 0.f, 0, false) & 0xff); } }
    if (F.bx == 0) { float* BT = (float*)(ws + OFF_BT); const float* rb = a.in[I_RELB];
        for (int i = F.tid; i < 16 * 128; i += NTHR) { const int h = i >> 7, d = i & 127; BT[i] = rb[t5_bucket(d) * 16 + h] * LOG2E; } }
    if (F.bx == 1 && F.tid < 128) { const int kv = F.tid >> 6, e = F.tid & 63; const float* pos = a.in[kv ? I_EPOSV : I_EPOSK]; const float* w1 = a.in[kv ? I_ECV1 : I_ECK1]; float s = 0.f;
        for (int k = 0; k < 2048; ++k) s += pos[k] * w1[k * 64 + e];
        ((float*)(ws + OFF_CB))[F.tid] = s; }
    { const f32x4* x4 = (const f32x4*)a.in[I_X]; u32x4* xb = (u32x4*)(ws + OFF_XB);
      for (int i = gt; i < MTOK * 1024 / 8; i += NGT) { const f32x4 v0 = x4[2 * i], v1 = x4[2 * i + 1]; xb[i] = pg8::pack8(v0, v1); } }
}

__device__ __forceinline__ void phase_convert_odd(const Frame& F, const Args& a) {
    LAS float* scr = (LAS float*)(F.lds + F.wave * 8704);
    unsigned char* ws = F.ws;
    unsigned char* W_OIN = ws + OFF_W_OIN; unsigned char* W_OOUT = ws + OFF_W_OOUT; unsigned char* W_M13 = ws + OFF_W_M13; unsigned char* W_M2 = ws + OFF_W_M2;
    constexpr int I_IN = 16 * 12, I_OUT = 16 * 4, I_M1 = 16 * (DFFE / 256), I_M2 = (DFFE / 64) * 4;
    constexpr int NIT = I_IN + I_OUT + NEXP * (2 * I_M1 + I_M2);
    for (int it = F.gw; it < NIT; it += F.NGW) {
        int r = it;
        if (r < I_IN) { transpose_item8<RowId, 64>(a.in[I_OWIN], 1024, 3072, W_OIN, 1024, r, F.lane, RowId{}, WIN_SCALE); continue; } r -= I_IN;
        if (r < I_OUT) { transpose_item8<RowId, 64>(a.in[I_OWOUT], 1024, 1024, W_OOUT, 1024, r, F.lane, RowId{}, WOUT_SCALE); continue; } r -= I_OUT;
        const int e = r / (2 * I_M1 + I_M2); r -= e * (2 * I_M1 + I_M2);
        if (r < I_M1) { transpose_item8<RowIlv, 64>(a.in[I_OM1] + (size_t)e * 1024 * DFFE, 1024, DFFE, W_M13 + (size_t)e * 2 * DFFE * 1024, 1024, r, F.lane, RowIlv{0}, W13_SCALE); continue; } r -= I_M1;
        if (r < I_M1) { transpose_item8<RowIlv, 64>(a.in[I_OM3] + (size_t)e * 1024 * DFFE, 1024, DFFE, W_M13 + (size_t)e * 2 * DFFE * 1024, 1024, r, F.lane, RowIlv{128}, W13_SCALE); continue; } r -= I_M1;
        transpose_item8<RowId, 64>(a.in[I_OM2] + (size_t)e * DFFE * 1024, DFFE, 1024, W_M2 + (size_t)e * 1024 * DFFE, DFFE, r, F.lane, RowId{}, W2_SCALE);
    }
}

__device__ __forceinline__ void load_row_bf16(const bf16_t* row, int lane, f32x4 (&v)[4]) {
#pragma unroll
    for (int j = 0; j < 4; ++j) { const u32x2 w = *(const u32x2*)(row + 4 * lane + 256 * j); v[j] = (f32x4){bflo(w.x), bfhi(w.x), bflo(w.y), bfhi(w.y)}; }
}
__device__ __forceinline__ void store_row_bf16(bf16_t* row, int lane, const f32x4 (&v)[4]) {
#pragma unroll
    for (int j = 0; j < 4; ++j) { u32x2 w; w.x = pk2(v[j][0], v[j][1]); w.y = pk2(v[j][2], v[j][3]); *(u32x2*)(row + 4 * lane + 256 * j) = w; }
}
__device__ __forceinline__ void ln_inplace(f32x4 (&v)[4], const f32x4 (&g)[4], const f32x4 (&b)[4]) {
    float s = 0.f;
#pragma unroll
    for (int j = 0; j < 4; ++j) s += (v[j][0] + v[j][1]) + (v[j][2] + v[j][3]);
    const float mean = wave_sum(s) * (1.f / 1024.f); float q = 0.f;
#pragma unroll
    for (int j = 0; j < 4; ++j) { v[j] = v[j] - mean; q += (v[j][0] * v[j][0] + v[j][1] * v[j][1]) + (v[j][2] * v[j][2] + v[j][3] * v[j][3]); }
    const float rstd = 1.f / sqrtf(wave_sum(q) * (1.f / 1024.f) + 1e-5f);
#pragma unroll
    for (int j = 0; j < 4; ++j) v[j] = v[j] * rstd * g[j] + b[j];
}
__device__ __forceinline__ void load_gb(const float* g, const float* b, int lane, f32x4 (&gv)[4], f32x4 (&bv)[4]) {
#pragma unroll
    for (int j = 0; j < 4; ++j) { gv[j] = *(const f32x4*)(g + 4 * lane + 256 * j); bv[j] = *(const f32x4*)(b + 4 * lane + 256 * j); }
}
__device__ __forceinline__ void store_row_fp8(unsigned char* row, int lane, const f32x4 (&v)[4]) {
#pragma unroll
    for (int j = 0; j < 4; ++j) *(unsigned*)(row + 4 * lane + 256 * j) = pg8::pk4_fp8(v[j][0], v[j][1], v[j][2], v[j][3]);
}
__device__ __forceinline__ void phase_ln_bf16(const Frame& F, const bf16_t* S, bf16_t* O, unsigned char* O8, const float* g, const float* b) {
    f32x4 gv[4], bv[4]; load_gb(g, b, F.lane, gv, bv);
    for (int row = F.gw; row < MTOK; row += F.NGW) { f32x4 v[4]; load_row_bf16(S + (size_t)row * 1024, F.lane, v); ln_inplace(v, gv, bv); store_row_bf16(O + (size_t)row * 1024, F.lane, v); store_row_fp8(O8 + (size_t)row * 1024, F.lane, v); }
}
__device__ __forceinline__ void phase_ln_i8(const Frame& F, const bf16_t* S, bf16_t* O, unsigned char* O8, float* sa, const float* g, const float* b) {
    f32x4 gv[4], bv[4]; load_gb(g, b, F.lane, gv, bv);
    for (int row = F.gw; row < MTOK; row += F.NGW) { f32x4 v[4]; load_row_bf16(S + (size_t)row * 1024, F.lane, v); ln_inplace(v, gv, bv); store_row_bf16(O + (size_t)row * 1024, F.lane, v); store_row_i8(O8 + (size_t)row * 1024, sa + row, F.lane, v); }
}
__device__ __forceinline__ void phase_ckvn(const Frame& F, const bf16_t* T1, const float* ssq_kv, const float* gain, bf16_t* CKVN) {
    const float g0 = gain[2 * F.lane], g1 = gain[2 * F.lane + 1];
    for (int row = F.gw; row < MTOK; row += F.NGW) {
        const unsigned w = *(const unsigned*)(T1 + (size_t)row * 256 + 2 * F.lane);
        const f32x4 sq = *(const f32x4*)(ssq_kv + (size_t)row * 4); const float r = __builtin_amdgcn_rsqf(((sq[0] + sq[1]) + (sq[2] + sq[3])) * (1.f / 128.f) + 1e-6f);
        *(unsigned*)(CKVN + (size_t)row * 128 + 2 * F.lane) = pk2(bflo(w) * r * g0, bfhi(w) * r * g1);
    }
}
__device__ __forceinline__ void phase_ln_router(const Frame& F, const bf16_t* S, bf16_t* H2, const float* g, const float* b, const float* router, unsigned char* ws) {
    LAS int* cnt = (LAS int*)(F.lds);
    if (F.tid < 8) cnt[F.tid] = 0;
    __syncthreads();
    f32x4 gv[4], bv[4]; load_gb(g, b, F.lane, gv, bv);
    u32x2* ROUTE = (u32x2*)(ws + OFF_ROUTE);
    f32x4 rw[16][2];
#pragma unroll
    for (int j = 0; j < 4; ++j)
#pragma unroll
        for (int e = 0; e < 4; ++e) { const float* rp = router + (size_t)(4 * F.lane + 256 * j + e) * 8; rw[4 * j + e][0] = *(const f32x4*)rp; rw[4 * j + e][1] = *(const f32x4*)(rp + 4); }
    const bool b0 = F.lane & 1, b1 = F.lane & 2, b2 = F.lane & 4;
    for (int row = F.gw; row < MTOK; row += F.NGW) {
        f32x4 v[4]; load_row_bf16(S + (size_t)row * 1024, F.lane, v); ln_inplace(v, gv, bv); store_row_bf16(H2 + (size_t)row * 1024, F.lane, v);
        float pl[8];
#pragma unroll
        for (int x = 0; x < 8; ++x) pl[x] = 0.f;
#pragma unroll
        for (int j = 0; j < 4; ++j)
#pragma unroll
            for (int e = 0; e < 4; ++e) { const f32x4 r0 = rw[4 * j + e][0], r1 = rw[4 * j + e][1]; const float hv = v[j][e];
                pl[0] += hv * r0[0]; pl[1] += hv * r0[1]; pl[2] += hv * r0[2]; pl[3] += hv * r0[3]; pl[4] += hv * r1[0]; pl[5] += hv * r1[1]; pl[6] += hv * r1[2]; pl[7] += hv * r1[3]; }
        float k4[4], k2[2], k1;
#pragma unroll
        for (int i = 0; i < 4; ++i) { const float send = b0 ? pl[i] : pl[i + 4]; k4[i] = (b0 ? pl[i + 4] : pl[i]) + __shfl_xor(send, 1); }
#pragma unroll
        for (int i = 0; i < 2; ++i) { const float send = b1 ? k4[i] : k4[i + 2]; k2[i] = (b1 ? k4[i + 2] : k4[i]) + __shfl_xor(send, 2); }
        { const float send = b2 ? k2[0] : k2[1]; k1 = (b2 ? k2[1] : k2[0]) + __shfl_xor(send, 4); }
        k1 += __shfl_xor(k1, 8); k1 += __shfl_xor(k1, 16); k1 += __shfl_xor(k1, 32);
        float lg[8];
#pragma unroll
        for (int x = 0; x < 8; ++x) lg[x] = __int_as_float(__builtin_amdgcn_readlane(__float_as_int(k1), (x >> 2) | (((x >> 1) & 1) << 1) | ((x & 1) << 2)));
        int e0 = 0; float l0 = lg[0];
#pragma unroll
        for (int x = 1; x < 8; ++x) if (lg[x] > l0) { l0 = lg[x]; e0 = x; }
        int e1 = -1; float l1 = -INFINITY;
#pragma unroll
        for (int x = 0; x < 8; ++x) if (x != e0 && lg[x] > l1) { l1 = lg[x]; e1 = x; }
        const float g0 = 1.f / (1.f + __expf(l1 - l0));
        if (F.lane == 0) { u32x2 r; r.x = (unsigned)e0 | ((unsigned)e1 << 8); r.y = __builtin_bit_cast(unsigned, g0); ROUTE[row] = r;
            __hip_atomic_fetch_add(cnt + e0, 1, __ATOMIC_RELAXED, __HIP_MEMORY_SCOPE_WORKGROUP); __hip_atomic_fetch_add(cnt + e1, 1, __ATOMIC_RELAXED, __HIP_MEMORY_SCOPE_WORKGROUP); }
    }
    __syncthreads();
    if (F.tid < 8) ((int*)(ws + OFF_WGCNT))[F.bx * 8 + F.tid] = cnt[F.tid];
    __syncthreads();
}
__device__ __forceinline__ void phase_moe_gather(const Frame& F, const bf16_t* H2, unsigned char* XR, unsigned char* ws) {
    LAS int* L = (LAS int*)(F.lds);
    const int* WGCNT = (const int*)(ws + OFF_WGCNT);
    { const int e = F.wave; int t = 0, p = 0;
#pragma unroll
      for (int k = 0; k < 4; ++k) { const int wg = F.lane + 64 * k; const int c = (wg < F.G) ? WGCNT[wg * 8 + e] : 0; t += c; p += (wg < F.bx) ? c : 0; }
      t = (int)wave_sum((float)t); p = (int)wave_sum((float)p);
      if (F.lane == 0) { L[e] = t; L[8 + e] = p; L[24 + e] = 0; } }
    __syncthreads();
    if (F.tid == 0) { int acc = 0;
        for (int e = 0; e < 8; ++e) { const int pad = (L[e] + 255) / 256 * 256; L[32 + e] = acc; L[16 + e] = acc + L[8 + e]; acc += pad; L[40 + e] = acc; }
        if (F.bx == 0) { int* GI = (int*)(ws + OFF_GINFO); for (int e = 0; e < 8; ++e) { GI[e] = L[40 + e]; GI[8 + e] = L[e]; } } }
    __syncthreads();
    const u32x2* ROUTE = (const u32x2*)(ws + OFF_ROUTE); int* DEST = (int*)(ws + OFF_DEST);
    for (int row = F.gw; row < MTOK; row += F.NGW) {
        const u32x2 r = ROUTE[row]; const int e0 = r.x & 255, e1 = (r.x >> 8) & 255; int s0 = 0, s1 = 0;
        if (F.lane == 0) { s0 = L[16 + e0] + __hip_atomic_fetch_add(L + 24 + e0, 1, __ATOMIC_RELAXED, __HIP_MEMORY_SCOPE_WORKGROUP); s1 = L[16 + e1] + __hip_atomic_fetch_add(L + 24 + e1, 1, __ATOMIC_RELAXED, __HIP_MEMORY_SCOPE_WORKGROUP);
            DEST[2 * row] = s0; DEST[2 * row + 1] = s1; }
        s0 = __builtin_amdgcn_readfirstlane(s0); s1 = __builtin_amdgcn_readfirstlane(s1);
        const u32x4* src = (const u32x4*)(H2 + (size_t)row * 1024) + 2 * F.lane; const u32x4 a = src[0], b = src[1];
        u32x4 o; o.x = pg8::pk4_fp8(bflo(a.x), bfhi(a.x), bflo(a.y), bfhi(a.y)); o.y = pg8::pk4_fp8(bflo(a.z), bfhi(a.z), bflo(a.w), bfhi(a.w));
        o.z = pg8::pk4_fp8(bflo(b.x), bfhi(b.x), bflo(b.y), bfhi(b.y)); o.w = pg8::pk4_fp8(bflo(b.z), bfhi(b.z), bflo(b.w), bfhi(b.w));
        ((u32x4*)(XR + (size_t)s0 * 1024))[F.lane] = o; ((u32x4*)(XR + (size_t)s1 * 1024))[F.lane] = o;
    }
    for (int e = 0; e < 8; ++e) { const int r0 = L[32 + e] + L[e], npad = L[40 + e] - r0;
        for (int i = F.gw; i < npad; i += F.NGW) { u32x4* d = (u32x4*)(XR + (size_t)(r0 + i) * 1024); d[F.lane] = (u32x4){0u, 0u, 0u, 0u}; } }
    __syncthreads();
}
__device__ __forceinline__ void phase_final(const Frame& F, const bf16_t* H2, const bf16_t* YR, const float* g, const float* b, float* out, unsigned char* ws) {
    f32x4 gv[4], bv[4]; load_gb(g, b, F.lane, gv, bv);
    const u32x2* ROUTE = (const u32x2*)(ws + OFF_ROUTE); const int* DEST = (const int*)(ws + OFF_DEST);
    for (int row = F.gw; row < MTOK; row += F.NGW) {
        const u32x2 rte = ROUTE[row]; const float g0 = __uint_as_float(rte.y), g1 = 1.f - g0;   const int d0 = DEST[2 * row], d1 = DEST[2 * row + 1];
        f32x4 v[4], y0[4], y1[4]; load_row_bf16(H2 + (size_t)row * 1024, F.lane, v); load_row_bf16(YR + (size_t)d0 * 1024, F.lane, y0); load_row_bf16(YR + (size_t)d1 * 1024, F.lane, y1);
#pragma unroll
        for (int j = 0; j < 4; ++j) v[j] = v[j] * ALPHA + y0[j] * g0 + y1[j] * g1;
        ln_inplace(v, gv, bv);
#pragma unroll
        for (int j = 0; j < 4; ++j) *(f32x4*)(out + (size_t)row * 1024 + 4 * F.lane + 256 * j) = v[j];
    }
}

namespace att {
constexpr float NEG_BIG = -1e30f;
constexpr int KS64 = 144, VS64 = 192, KT64 = 64 * KS64, VT64 = 64 * VS64;
constexpr int KS128 = 272, VS128 = 320, KT128 = 64 * KS128, VT128 = 64 * VS128;
typedef LAS char* lptr; typedef const LAS char* lcptr;
typedef short v4i16_t __attribute__((ext_vector_type(4)));
__device__ __forceinline__ s16x4 vtr(lcptr p) { return __builtin_bit_cast(s16x4, __builtin_amdgcn_ds_read_tr16_b64_v4i16((LAS v4i16_t*)p)); }
__device__ __forceinline__ f32x16 splat16(float c) { f32x16 v;
#pragma unroll
    for (int r = 0; r < 16; ++r) v[r] = c; return v; }
__device__ __forceinline__ int crow(int r, int hi) { return (r & 3) + 8 * (r >> 2) + 4 * hi; }
__device__ __forceinline__ float ex2(float x) { return __builtin_amdgcn_exp2f(x); }

template <int NKS> __device__ __forceinline__ void qk(f32x16& s0, f32x16& s1, lcptr Kt, int kstride, const bf16x8 (&qf)[NKS], float c0, int r32, int hi) {
    s0 = splat16(c0); s1 = splat16(c0);
    lcptr p0 = Kt + r32 * kstride + hi * 16; lcptr p1 = p0 + 32 * kstride;
#pragma unroll
    for (int ks = 0; ks < NKS; ++ks) { const bf16x8 k0 = *(const LAS bf16x8*)(p0 + ks * 32), k1 = *(const LAS bf16x8*)(p1 + ks * 32);
        s0 = __builtin_amdgcn_mfma_f32_32x32x16_bf16(k0, qf[ks], s0, 0, 0, 0); s1 = __builtin_amdgcn_mfma_f32_32x32x16_bf16(k1, qf[ks], s1, 0, 0, 0); }
}
__device__ __forceinline__ float rowmax32(const f32x16& s0, const f32x16& s1) {
    float a = fmaxf(s0[0], s1[0]);
#pragma unroll
    for (int r = 1; r < 16; ++r) a = fmaxf(a, fmaxf(s0[r], s1[r]));
    return fmaxf(a, __shfl_xor(a, 32));
}
template <int NDT> __device__ __forceinline__ void softmax_step(f32x16& s0, f32x16& s1, float& m, float& l, f32x16 (&o)[NDT]) {
    const float mn = fmaxf(m, rowmax32(s0, s1)); float rs = 0.f;
    if (__any(mn > m)) {
        const float al = ex2(m - mn); l *= al;
#pragma unroll
        for (int d = 0; d < NDT; ++d)
#pragma unroll
            for (int r = 0; r < 16; ++r) o[d][r] *= al;
    }
    m = mn;
#pragma unroll
    for (int r = 0; r < 16; ++r) { s0[r] = ex2(s0[r] - mn); s1[r] = ex2(s1[r] - mn); rs += s0[r] + s1[r]; }
    l += rs;
}
__device__ __forceinline__ bf16x8 pack_p(const f32x16& s, int base) { u32x4 w; w.x = pk2(s[base], s[base + 1]); w.y = pk2(s[base + 2], s[base + 3]); w.z = pk2(s[base + 4], s[base + 5]); w.w = pk2(s[base + 6], s[base + 7]); return __builtin_bit_cast(bf16x8, w); }
template <int NDT> __device__ __forceinline__ void pv(f32x16 (&o)[NDT], const f32x16& s0, const f32x16& s1, lcptr Vt, int vstride, int lane) {
    const bf16x8 pk[4] = {pack_p(s0, 0), pack_p(s0, 8), pack_p(s1, 0), pack_p(s1, 8)};
    const int h = lane >> 5, g = (lane >> 4) & 1, q = (lane & 15) >> 2, p = lane & 3;
    lcptr vb = Vt + (4 * h + q) * vstride + (16 * g + 4 * p) * 2;
#pragma unroll
    for (int k = 0; k < 4; ++k)
#pragma unroll
        for (int d = 0; d < NDT; ++d) { const s16x4 lo = vtr(vb + (16 * k) * vstride + d * 64), hh = vtr(vb + (16 * k + 8) * vstride + d * 64);
            const bf16x8 vf = (bf16x8){lo[0], lo[1], lo[2], lo[3], hh[0], hh[1], hh[2], hh[3]};
            o[d] = __builtin_amdgcn_mfma_f32_32x32x16_bf16(vf, pk[k], o[d], 0, 0, 0); }
}

__device__ __forceinline__ void exp_step(f32x16& s0, f32x16& s1, float& l) {
    float rs = 0.f;
#pragma unroll
    for (int r = 0; r < 16; ++r) { s0[r] = ex2(s0[r]); s1[r] = ex2(s1[r]); rs += s0[r] + s1[r]; }
    l += rs;
}

__device__ __forceinline__ void qk2(f32x16& a0, f32x16& a1, f32x16& b0, f32x16& b1, lcptr Kt, const bf16x8 (&qa)[4], const bf16x8 (&qb)[4], int r32, int hi) {
    a0 = splat16(0.f); a1 = splat16(0.f); b0 = splat16(0.f); b1 = splat16(0.f);
    lcptr p0 = Kt + r32 * KS64 + hi * 16; lcptr p1 = p0 + 32 * KS64;
#pragma unroll
    for (int ks = 0; ks < 4; ++ks) { const bf16x8 k0 = *(const LAS bf16x8*)(p0 + ks * 32), k1 = *(const LAS bf16x8*)(p1 + ks * 32);
        a0 = __builtin_amdgcn_mfma_f32_32x32x16_bf16(k0, qa[ks], a0, 0, 0, 0); b0 = __builtin_amdgcn_mfma_f32_32x32x16_bf16(k0, qb[ks], b0, 0, 0, 0);
        a1 = __builtin_amdgcn_mfma_f32_32x32x16_bf16(k1, qa[ks], a1, 0, 0, 0); b1 = __builtin_amdgcn_mfma_f32_32x32x16_bf16(k1, qb[ks], b1, 0, 0, 0); }
}
__device__ __forceinline__ void pv2(f32x16 (&oa)[2], f32x16 (&ob)[2], const bf16x8 (&pa)[4], const bf16x8 (&pb)[4], lcptr Vt, int lane) {
    const int h = lane >> 5, g = (lane >> 4) & 1, q = (lane & 15) >> 2, p = lane & 3;
    lcptr vb = Vt + (4 * h + q) * VS64 + (16 * g + 4 * p) * 2;
#pragma unroll
    for (int k = 0; k < 4; ++k)
#pragma unroll
        for (int d = 0; d < 2; ++d) { const s16x4 lo = vtr(vb + (16 * k) * VS64 + d * 64), hh = vtr(vb + (16 * k + 8) * VS64 + d * 64);
            const bf16x8 vf = (bf16x8){lo[0], lo[1], lo[2], lo[3], hh[0], hh[1], hh[2], hh[3]};
            oa[d] = __builtin_amdgcn_mfma_f32_32x32x16_bf16(vf, pa[k], oa[d], 0, 0, 0); ob[d] = __builtin_amdgcn_mfma_f32_32x32x16_bf16(vf, pb[k], ob[d], 0, 0, 0); }
}
__device__ __forceinline__ void bias_mask_near(f32x16& s0, f32x16& s1, const LAS float* bt, int t, int kp0, int hi, unsigned maxdist) {
#pragma unroll
    for (int q4 = 0; q4 < 4; ++q4) {
        float bb[8]; f32x16& s = (q4 & 2) ? s1 : s0; const int r0 = 8 * (q4 & 1), kq = kp0 + 32 * (q4 >> 1);
#pragma unroll
        for (int r = 0; r < 8; ++r) { const int d = t - (kq + crow(r0 + r, hi)); const unsigned ix = (unsigned)d < 127u ? (unsigned)d : 127u; bb[r] = bt[ix]; }
#pragma unroll
        for (int r = 0; r < 8; ++r) asm volatile("" : "+v"(bb[r]));
#pragma unroll
        for (int r = 0; r < 8; ++r) { const int d = t - (kq + crow(r0 + r, hi)); s[r0 + r] = ((unsigned)d < maxdist) ? s[r0 + r] + bb[r] : -INFINITY; }
    }
}
__device__ __forceinline__ void mask_all(f32x16& s0, f32x16& s1) {
#pragma unroll
    for (int r = 0; r < 16; ++r) { s0[r] = -INFINITY; s1[r] = -INFINITY; }
}
__device__ __forceinline__ void store_o64(bf16_t* orow, const f32x16 (&o)[2], float sc, int hi) {
#pragma unroll
    for (int d = 0; d < 2; ++d)
#pragma unroll
        for (int rg = 0; rg < 4; ++rg) { u32x2 w; w.x = pk2(o[d][4 * rg] * sc, o[d][4 * rg + 1] * sc); w.y = pk2(o[d][4 * rg + 2] * sc, o[d][4 * rg + 3] * sc);
            *(u32x2*)(orow + 32 * d + 8 * rg + 4 * hi) = w; }
}
__device__ __forceinline__ void store_o64_fp8(unsigned char* orow, const f32x16 (&o)[2], float sc, int hi) {
#pragma unroll
    for (int d = 0; d < 2; ++d)
#pragma unroll
        for (int rg = 0; rg < 4; ++rg) *(unsigned*)(orow + 32 * d + 8 * rg + 4 * hi) = pg8::pk4_fp8(o[d][4 * rg] * sc, o[d][4 * rg + 1] * sc, o[d][4 * rg + 2] * sc, o[d][4 * rg + 3] * sc);
}
template <class Src, class Proc> __device__ __forceinline__ void tile_loop64(int tid, lptr base, int nt, int pitch, Src src, Proc proc) {
    if (nt <= 0) return;
    const int row = tid >> 3, ch = tid & 7; u32x4 kr, vr;
    lptr Kb = base, Vb = base + 2 * KT64;
    { const bf16_t *kp, *vp; src(0, kp, vp); kr = *(const u32x4*)(kp + (size_t)row * pitch + ch * 8); vr = *(const u32x4*)(vp + (size_t)row * pitch + ch * 8); }
    *(LAS u32x4*)(Kb + row * KS64 + ch * 16) = kr; *(LAS u32x4*)(Vb + row * VS64 + ch * 16) = vr;
    __syncthreads();
    for (int i = 0; i < nt; ++i) {
        const bool more = i + 1 < nt;
        if (more) { const bf16_t *kp, *vp; src(i + 1, kp, vp); kr = *(const u32x4*)(kp + (size_t)row * pitch + ch * 8); vr = *(const u32x4*)(vp + (size_t)row * pitch + ch * 8); }
        proc(i, (lcptr)(Kb + (i & 1) * KT64), (lcptr)(Vb + (i & 1) * VT64));
        if (more) { *(LAS u32x4*)(Kb + ((i + 1) & 1) * KT64 + row * KS64 + ch * 16) = kr; *(LAS u32x4*)(Vb + ((i + 1) & 1) * VT64 + row * VS64 + ch * 16) = vr; }
        __syncthreads();
    }
}

template <int ROWB, int KSTR, int VSTR, int VAR = 0, class SrcK, class SrcV, class Score, class Accum>
__device__ __forceinline__ void tile_loop_p(int tid, lptr base, int nt, int pitch, SrcK srck, SrcV srcv, Score score, Accum accum) {
    if (nt <= 0) return;
    constexpr int CPR = ROWB / 16, NCH = (64 * CPR) / 512, KT = 64 * KSTR, VT = 64 * VSTR;
    lptr Kb = base, Vb = base + 2 * KT;
    u32x4 kr0[NCH], vr0[NCH], kr1[NCH], vr1[NCH];
    auto gld = [&](const bf16_t* p, u32x4 (&r)[NCH]) {
#pragma unroll
        for (int c = 0; c < NCH; ++c) { const int idx = tid + 512 * c, rr = idx / CPR, ch = idx % CPR; r[c] = *(const u32x4*)(p + (size_t)rr * pitch + ch * 8); } };
    auto lst = [&](lptr dst, int stride, const u32x4 (&r)[NCH]) {
#pragma unroll
        for (int c = 0; c < NCH; ++c) { const int idx = tid + 512 * c, rr = idx / CPR, ch = idx % CPR; *(LAS u32x4*)(dst + rr * stride + ch * 16) = r[c]; } };
    gld(srck(0), kr0); gld(srcv(0), vr0); lst(Kb, KSTR, kr0); lst(Vb, VSTR, vr0);
    if (nt > 1) { gld(srck(1), kr0); lst(Kb + KT, KSTR, kr0); }
    if (nt > 2) gld(srck(2), kr1);
    if (nt > 1) gld(srcv(1), vr1);
    __syncthreads();
    f32x16 a0, a1, b0, b1; bool aact = score(0, (lcptr)Kb, a0, a1), bact = false;
    auto step = [&](int i, f32x16& c0, f32x16& c1, bool& cact, f32x16& n0, f32x16& n1, bool& nact, u32x4 (&kL)[NCH], u32x4 (&vL)[NCH], u32x4 (&kS)[NCH], u32x4 (&vS)[NCH]) {
        const bool m1 = i + 1 < nt, m2 = i + 2 < nt, m3 = i + 3 < nt;
        if (VAR != 7) { if (m3) gld(srck(i + 3), kL);
        if (m2) gld(srcv(i + 2), vL); }
        nact = false;
        if (m1) nact = score(i + 1, (lcptr)(Kb + ((i + 1) & 1) * KT), n0, n1);
        if (cact) accum(i, (lcptr)(Vb + (i & 1) * VT), c0, c1);
        if (VAR != 7) { if (m2) lst(Kb + (i & 1) * KT, KSTR, kS);
        if (m1) lst(Vb + ((i + 1) & 1) * VT, VSTR, vS); }
        __syncthreads();
    };
    for (int i = 0; i < nt; i += 2) { step(i, a0, a1, aact, b0, b1, bact, kr0, vr0, kr1, vr1); if (i + 1 < nt) step(i + 1, b0, b1, bact, a0, a1, aact, kr1, vr1, kr0, vr0); }
}

template <int ROWB, int KSTR, int VSTR, class SrcK, class SrcV, class Score, class Accum>
__device__ __forceinline__ void tile_loop_pp(int tid, int grp, lptr base, int nt, int pitch, SrcK srck, SrcV srcv, Score score, Accum accum) {
    if (nt <= 0) return;
    constexpr int CPR = ROWB / 16, NCH = (64 * CPR) / 512, KT = 64 * KSTR, VT = 64 * VSTR;
    lptr Kb = base, Vb = base + 2 * KT;
    u32x4 kr0[NCH], vr0[NCH], kr1[NCH], vr1[NCH];
    auto gld = [&](const bf16_t* p, u32x4 (&r)[NCH]) {
#pragma unroll
        for (int c = 0; c < NCH; ++c) { const int idx = tid + 512 * c, rr = idx / CPR, ch = idx % CPR; r[c] = *(const u32x4*)(p + (size_t)rr * pitch + ch * 8); } };
    auto lst = [&](lptr dst, int stride, const u32x4 (&r)[NCH]) {
#pragma unroll
        for (int c = 0; c < NCH; ++c) { const int idx = tid + 512 * c, rr = idx / CPR, ch = idx % CPR; *(LAS u32x4*)(dst + rr * stride + ch * 16) = r[c]; } };
    gld(srck(0), kr0); gld(srcv(0), vr0); lst(Kb, KSTR, kr0); lst(Vb, VSTR, vr0);
    if (nt > 1) { gld(srck(1), kr0); gld(srcv(1), vr0); }
    if (nt > 2) { gld(srck(2), kr1); gld(srcv(2), vr1); }
    __syncthreads();
    f32x16 s0, s1; bool act = false;
    const int nslot = 2 * nt + 1;
    auto slot_fn = [&](int slot, u32x4 (&kS)[NCH], u32x4 (&vS)[NCH]) {
        const int my = slot - grp;
        if (my >= 0 && my < 2 * nt) { const int i = my >> 1;
            if (!(my & 1)) act = score(i, (lcptr)(Kb + (i & 1) * KT), s0, s1);
            else if (act) accum(i, (lcptr)(Vb + (i & 1) * VT), s0, s1); }
        if (slot & 1) { const int j = (slot >> 1) + 1;
            if (j < nt) { lst(Kb + (j & 1) * KT, KSTR, kS); lst(Vb + (j & 1) * VT, VSTR, vS); }
            if (j + 2 < nt) { gld(srck(j + 2), kS); gld(srcv(j + 2), vS); } }
        __syncthreads();
    };
    for (int slot = 0; slot < nslot; slot += 4) {
        slot_fn(slot, kr0, vr0);
        if (slot + 1 < nslot) slot_fn(slot + 1, kr0, vr0);
        if (slot + 2 < nslot) slot_fn(slot + 2, kr1, vr1);
        if (slot + 3 < nslot) slot_fn(slot + 3, kr1, vr1);
    }
}

template <int VAR = 0, class SrcK, class SrcV, class Post>
__device__ __forceinline__ void tile_loop_f(int tid, int lane, lptr base, int nt, int pitch, const bf16x8 (&qf)[4], f32x16 (&o)[2], float& l, SrcK srck, SrcV srcv, Post post) {
    if (nt <= 0) return;
    const int r32 = lane & 31, hi = lane >> 5;
    lptr Kb = base, Vb = base + 2 * KT64;
    const int rr = tid >> 3, ch = tid & 7;
    u32x4 kr0, vr0, kr1, vr1;
    auto gld = [&](const bf16_t* p) { return *(const u32x4*)(p + (size_t)rr * pitch + ch * 8); };
    kr0 = gld(srck(0)); vr0 = gld(srcv(0)); *(LAS u32x4*)(Kb + rr * KS64 + ch * 16) = kr0; *(LAS u32x4*)(Vb + rr * VS64 + ch * 16) = vr0;
    if (nt > 1) { kr0 = gld(srck(1)); *(LAS u32x4*)(Kb + KT64 + rr * KS64 + ch * 16) = kr0; }
    if (nt > 2) kr1 = gld(srck(2));
    if (nt > 1) vr1 = gld(srcv(1));
    __syncthreads();
    f32x16 a0, a1, b0, b1; bool aact, bact = false;
    qk<4>(a0, a1, (lcptr)Kb, KS64, qf, 0.f, r32, hi); aact = post(0, a0, a1);
    auto step = [&](int i, f32x16& c0, f32x16& c1, bool& cact, f32x16& n0, f32x16& n1, bool& nact, u32x4& kL, u32x4& vL, u32x4& kS, u32x4& vS) {
        const bool m1 = i + 1 < nt, m2 = i + 2 < nt, m3 = i + 3 < nt;
        if (m3) kL = gld(srck(i + 3));
        if (m2) vL = gld(srcv(i + 2));
        lcptr Kt = (lcptr)(Kb + ((i + 1) & 1) * KT64), Vt = (lcptr)(Vb + (i & 1) * VT64);
        if (m1 && cact) {
            lcptr p0 = Kt + r32 * KS64 + hi * 16; lcptr p1 = p0 + 32 * KS64;
            bf16x8 ka[4], kb[4];
#pragma unroll
            for (int ks = 0; ks < 4; ++ks) { if (VAR == 8 || VAR == 9) { ka[ks] = qf[ks]; kb[ks] = qf[3 - ks]; } else { ka[ks] = *(const LAS bf16x8*)(p0 + ks * 32); kb[ks] = *(const LAS bf16x8*)(p1 + ks * 32); } }
            n0 = splat16(0.f); n1 = splat16(0.f); float rs = 0.f;
            __builtin_amdgcn_sched_barrier(0);
#pragma unroll
            for (int ks = 0; ks < 4; ++ks) {
                n0 = __builtin_amdgcn_mfma_f32_32x32x16_bf16(ka[ks], qf[ks], n0, 0, 0, 0); n1 = __builtin_amdgcn_mfma_f32_32x32x16_bf16(kb[ks], qf[ks], n1, 0, 0, 0);
#pragma unroll
                for (int e = 0; e < 4; ++e) { c0[4 * ks + e] = ex2(c0[4 * ks + e]); c1[4 * ks + e] = ex2(c1[4 * ks + e]); rs += c0[4 * ks + e] + c1[4 * ks + e]; }
                __builtin_amdgcn_sched_barrier(0);
            }
            l += rs;
            if (VAR == 8 || VAR == 10) { const bf16x8 pk0 = pack_p(c0, 0), pk1 = pack_p(c0, 8), pk2_ = pack_p(c1, 0), pk3 = pack_p(c1, 8);
#pragma unroll
                for (int d = 0; d < 2; ++d) { o[d] = __builtin_amdgcn_mfma_f32_32x32x16_bf16(qf[0], pk0, o[d], 0, 0, 0); o[d] = __builtin_amdgcn_mfma_f32_32x32x16_bf16(qf[1], pk1, o[d], 0, 0, 0);
                    o[d] = __builtin_amdgcn_mfma_f32_32x32x16_bf16(qf[2], pk2_, o[d], 0, 0, 0); o[d] = __builtin_amdgcn_mfma_f32_32x32x16_bf16(qf[3], pk3, o[d], 0, 0, 0); } }
            else pv<2>(o, c0, c1, Vt, VS64, lane);
            nact = post(i + 1, n0, n1);
        } else {
            if (cact) { exp_step(c0, c1, l); pv<2>(o, c0, c1, Vt, VS64, lane); }
            nact = false;
            if (m1) { qk<4>(n0, n1, Kt, KS64, qf, 0.f, r32, hi); nact = post(i + 1, n0, n1); }
        }
        if (m2) *(LAS u32x4*)(Kb + (i & 1) * KT64 + rr * KS64 + ch * 16) = kS;
        if (m1) *(LAS u32x4*)(Vb + ((i + 1) & 1) * VT64 + rr * VS64 + ch * 16) = vS;
        __syncthreads();
    };
    for (int i = 0; i < nt; i += 2) { step(i, a0, a1, aact, b0, b1, bact, kr0, vr0, kr1, vr1); if (i + 1 < nt) step(i + 1, b0, b1, bact, a0, a1, aact, kr1, vr1, kr0, vr0); }
}
constexpr int TL64_BYTES = 2 * KT64 + 2 * VT64;
}

#ifndef PP_GRP
#define PP_GRP (w & 1)
#endif
template <int var> __device__ __forceinline__ void moba_unit(const Frame& F, int b, int h, int qb, const bf16_t* Q, const bf16_t* K, const bf16_t* V, const float* KMEAN, const float* BT, unsigned char* O8) {
    using namespace att;
    const int lane = F.lane, r32 = lane & 31, hi = lane >> 5, w = F.wave;
    lptr lds = (lptr)F.lds; lptr tl = lds; LAS float* BTL = (LAS float*)(lds + TL64_BYTES); lptr KM = lds + TL64_BYTES + 512;
    const int t = 256 * qb + 32 * w + r32; const size_t row = (size_t)b * SEQ + t;
    bf16x8 qf[4];
#pragma unroll
    for (int ks = 0; ks < 4; ++ks) qf[ks] = *(const bf16x8*)(Q + row * 1024 + h * 64 + 16 * ks + 8 * hi);
    if (F.tid < 128) BTL[F.tid] = BT[h * 128 + F.tid] - BT[h * 128 + 127];
    { const int idx = F.tid * 2, j = idx >> 6, d = idx & 63; const float* kmp = KMEAN + (size_t)(b * 16 + j) * 2048 + h * 64 + d;
      *(LAS unsigned*)(KM + j * KS64 + d * 2) = (j < qb) ? pk2(kmp[0] + kmp[1024], kmp[1] + kmp[1025]) : 0u;
      *(LAS unsigned*)(KM + (16 + j) * KS64 + d * 2) = 0u; }
    __syncthreads();
    unsigned selmask = 0u;
    if (qb > 0) {
        f32x16 gs = splat16(0.f);
        { lcptr p0 = (lcptr)KM + r32 * KS64 + hi * 16;
#pragma unroll
          for (int ks = 0; ks < 4; ++ks) { const bf16x8 k0 = *(const LAS bf16x8*)(p0 + ks * 32); gs = __builtin_amdgcn_mfma_f32_32x32x16_bf16(k0, qf[ks], gs, 0, 0, 0); } }
        float glo[8], ghi[8];
#pragma unroll
        for (int r = 0; r < 8; ++r) { const float mine = gs[r], oth = __shfl_xor(mine, 32); glo[r] = hi ? oth : mine; ghi[r] = hi ? mine : oth; }
#pragma unroll
        for (int rep = 0; rep < 3; ++rep) { float best = -INFINITY; int bj = -1;
#pragma unroll
            for (int j = 0; j < 16; ++j) { const int r = (j & 3) + 4 * (j >> 3); const float gv = ((j >> 2) & 1) ? ghi[r] : glo[r];
                if (j < qb && !((selmask >> j) & 1u) && gv > best) { best = gv; bj = j; } }
            if (bj >= 0) selmask |= 1u << bj; }
    }
    f32x16 o[2] = {splat16(0.f), splat16(0.f)}; float l = 0.f;
    const int nt = 4 * (qb + 1); const int twmax = 256 * qb + 32 * w + 31;
    const bf16_t* Kh = K + (size_t)b * SEQ * 1024 + h * 64; const bf16_t* Vh = V + (size_t)b * SEQ * 1024 + h * 64;
    tile_loop_f<var>(F.tid, lane, tl, nt, 1024, qf, o, l,
        [&](int i) { return Kh + (size_t)(64 * i) * 1024; }, [&](int i) { return Vh + (size_t)(64 * i) * 1024; },
        [&](int i, f32x16& s0, f32x16& s1) -> bool {
            const int blk = i >> 2, kp0 = 64 * i;
            if (blk < qb) {
                const bool sel = (selmask >> blk) & 1u;
                if (!__any(sel)) return false;
                if (!(blk < qb - 1 || (i & 3) < 2)) bias_mask_near(s0, s1, BTL, t, kp0, hi, 0x7fffffffu);
                if (!sel) mask_all(s0, s1);
            } else {
                if (kp0 > twmax) return false;
                bias_mask_near(s0, s1, BTL, t, kp0, hi, 0x7fffffffu);
            }
            return true; });
    l += __shfl_xor(l, 32);
    store_o64_fp8(O8 + row * 1024 + h * 64, o, l > 0.f ? OSC / l : 0.f, hi);
}
__device__ __forceinline__ void phase_moba(const Frame& F, unsigned char* ws, int var) {
    const bf16_t* Q = (const bf16_t*)(ws + OFF_QKV); const bf16_t* K = Q + (size_t)MTOK * 1024; const bf16_t* V = K + (size_t)MTOK * 1024;
    const float* KMEAN = (const float*)(ws + OFF_KMEAN); const float* BT = (const float*)(ws + OFF_BT);
    for (int idx = F.bx; idx < 2048; idx += F.G) { const int i = idx >> 8, v = idx & 255, x = v & 7, j = v >> 3, bh = 16 * x + 2 * i + (j >> 4), b = bh >> 4, h = bh & 15, p = ((j & 15) + 4 * (i >> 1)) & 15, qb = (i & 1) ? 15 - p : p;

#ifdef MOBA_VAR
        if (var == MOBA_VAR) moba_unit<MOBA_VAR>(F, b, h, qb, Q, K, V, KMEAN, BT, ws + OFF_O8); else
#endif
        moba_unit<0>(F, b, h, qb, Q, K, V, KMEAN, BT, ws + OFF_O8);
        __syncthreads(); }
}

constexpr int MB_KB = 0, MB_VB = 256 * att::KS64, MB_SELM = MB_VB + 256 * att::VS64, MB_LIST = MB_SELM + 4096, MB_CNT = MB_LIST + 12800, MB_FILL = MB_CNT + 64, MB_LOFF = MB_FILL + 64,
              MB_BTL = MB_LOFF + 128, MB_KM = MB_BTL + 512, MB_QC = MB_KM + 32 * att::KS64, MB_END = MB_QC + 64;
constexpr int MST_ROW = 136;
__device__ __forceinline__ void moba2_unit(const Frame& F, int b, int h, int par, int unit, const bf16_t* Q, const bf16_t* K, const bf16_t* V, const float* KMEAN, const float* BT, unsigned char* O8, unsigned char* MST, int abl = 0) {
    using namespace att;
    int tid = F.tid; asm volatile("" : "+v"(tid));
    const int lane = tid & 63, lane_ = lane, r32 = lane & 31, hi = lane >> 5, w = F.wave;
    lptr lds = (lptr)F.lds; lptr KB = lds + MB_KB, VB = lds + MB_VB; LAS unsigned short* SELM = (LAS unsigned short*)(lds + MB_SELM); LAS unsigned short* LIST = (LAS unsigned short*)(lds + MB_LIST);
    LAS int* CNT = (LAS int*)(lds + MB_CNT); LAS int* FILL = (LAS int*)(lds + MB_FILL); LAS int* LOFF = (LAS int*)(lds + MB_LOFF); LAS float* BTL = (LAS float*)(lds + MB_BTL); lptr KM = lds + MB_KM;
    unsigned char* ST = MST + (size_t)unit * 2048 * MST_ROW; float* STL = (float*)(ST + 2048 * 128);
    const bf16_t* Qh = Q + (size_t)b * SEQ * 1024 + h * 64; const bf16_t* Kh = K + (size_t)b * SEQ * 1024 + h * 64; const bf16_t* Vh = V + (size_t)b * SEQ * 1024 + h * 64;
    if (tid < 128) BTL[tid] = BT[h * 128 + tid] - BT[h * 128 + 127];
    { const int idx = tid * 2, j = idx >> 6, d = idx & 63; const float* kmp = KMEAN + (size_t)(b * 16 + j) * 2048 + h * 64 + d;
      *(LAS unsigned*)(KM + j * KS64 + d * 2) = pk2(kmp[0] + kmp[1024], kmp[1] + kmp[1025]); *(LAS unsigned*)(KM + (16 + j) * KS64 + d * 2) = 0u; }
    LAS int* QC = (LAS int*)(lds + MB_QC);
    if (tid < 16) { CNT[tid] = 0; FILL[tid] = 0; QC[tid] = 0; }
    for (int i = tid; i < 2048 * MST_ROW / 16; i += NTHR) ((u32x4*)ST)[i] = (u32x4){0u, 0u, 0u, 0u};
    __syncthreads();
#pragma unroll 1
    for (int m8 = 0; m8 < 8; ++m8) { const int gi = w + 8 * m8, k = gi >> 3, sub = gi & 7, qb = 2 * k + par, q = 32 * sub + r32; const size_t trow = (size_t)(256 * qb + q);
        unsigned selmask = 0u;
        if (qb > 0) {
            bf16x8 qf[4];
#pragma unroll
            for (int ks = 0; ks < 4; ++ks) qf[ks] = *(const bf16x8*)(Qh + trow * 1024 + 16 * ks + 8 * hi);
            f32x16 gs = splat16(0.f);
            { lcptr p0 = (lcptr)KM + r32 * KS64 + hi * 16;
#pragma unroll
              for (int ks = 0; ks < 4; ++ks) { const bf16x8 k0 = *(const LAS bf16x8*)(p0 + ks * 32); gs = __builtin_amdgcn_mfma_f32_32x32x16_bf16(k0, qf[ks], gs, 0, 0, 0); } }
            float glo[8], ghi[8];
#pragma unroll
            for (int r = 0; r < 8; ++r) { const float mine = gs[r], oth = __shfl_xor(mine, 32); glo[r] = hi ? oth : mine; ghi[r] = hi ? mine : oth; }
#pragma unroll
            for (int rep = 0; rep < 3; ++rep) { float best = -INFINITY; int bj = -1;
#pragma unroll
                for (int j = 0; j < 16; ++j) { const int r = (j & 3) + 4 * (j >> 3); const float gv = ((j >> 2) & 1) ? ghi[r] : glo[r];
                    if (j < qb && !((selmask >> j) & 1u) && gv > best) { best = gv; bj = j; } }
                if (bj >= 0) selmask |= 1u << bj; }
        }
        if (hi == 0) { SELM[k * 256 + q] = (unsigned short)selmask; unsigned mm = selmask; while (mm) { const int j = __builtin_ctz(mm); mm &= mm - 1u; __hip_atomic_fetch_add(CNT + j, 1, __ATOMIC_RELAXED, __HIP_MEMORY_SCOPE_WORKGROUP); } }
    }
    __syncthreads();
    if (tid == 0) { int acc = 0; for (int j = 0; j < 16; ++j) { LOFF[j] = acc; acc += CNT[j]; } LOFF[16] = acc; }
    __syncthreads();
    for (int lq = tid; lq < 2048; lq += NTHR) { unsigned mm = SELM[lq]; while (mm) { const int j = __builtin_ctz(mm); mm &= mm - 1u; const int pos = __hip_atomic_fetch_add(FILL + j, 1, __ATOMIC_RELAXED, __HIP_MEMORY_SCOPE_WORKGROUP); LIST[LOFF[j] + pos] = (unsigned short)lq; } }
#ifdef REP_PHASE
    if (abl == 2) return;
#endif
    u32x4 kreg[4], vreg[4];
    auto gblk = [&](int j) { int td = tid; asm volatile("" : "+v"(td));
#pragma unroll
        for (int i = 0; i < 4; ++i) { const int c = td + 512 * i, rr = c >> 3, ch = c & 7; kreg[i] = *(const u32x4*)(Kh + (size_t)(256 * j + rr) * 1024 + ch * 8); vreg[i] = *(const u32x4*)(Vh + (size_t)(256 * j + rr) * 1024 + ch * 8); } };
    gblk(0);
    __syncthreads();
    for (int j = 0; j < 16; ++j) {
        { int td = tid; asm volatile("" : "+v"(td));
#pragma unroll
        for (int i = 0; i < 4; ++i) { const int c = td + 512 * i, rr = c >> 3, ch = c & 7; *(LAS u32x4*)(KB + rr * KS64 + ch * 16) = kreg[i]; *(LAS u32x4*)(VB + rr * VS64 + ch * 16) = vreg[i]; } }
        __syncthreads();
        gblk(j + 1 < 16 ? j + 1 : 15);
        const int nj = CNT[j], ngp = (nj + 31) >> 5, ngo = ((j & 1) == par) ? 8 : 0;
        const int nit = ngo + ngp;
        auto grab = [&]() { int it = 0; if (lane == 0) it = __hip_atomic_fetch_add(QC + j, 1, __ATOMIC_RELAXED, __HIP_MEMORY_SCOPE_WORKGROUP); return __builtin_amdgcn_readfirstlane(it); };
        auto decode = [&](int it, int& t, int& lq, bool& va) {
            if (it < ngo) { const int gidx = ngo - 1 - it; lq = (j >> 1) * 256 + 32 * gidx + r32; t = 256 * j + 32 * gidx + r32; va = true; }
            else { const int gidx = it - ngo, sa = 32 * gidx + r32; va = sa < nj; lq = LIST[LOFF[j] + (va ? sa : 32 * gidx)]; t = 256 * (2 * (lq >> 8) + par) + (lq & 255); } };
        auto issue = [&](int t, int lq, bf16x8 (&q)[4], u32x4 (&st)[4], float& stl) {
#pragma unroll
            for (int ks = 0; ks < 4; ++ks) q[ks] = *(const bf16x8*)(Qh + (size_t)t * 1024 + 16 * ks + 8 * hi);
            const unsigned char* strow = ST + (size_t)lq * 128 + 64 * hi;
#pragma unroll
            for (int k = 0; k < 4; ++k) st[k] = *(const u32x4*)(strow + 16 * k);
            stl = STL[lq]; };
        int it = grab(), t = 0, lq = 0; bool va = false; bf16x8 qc[4] = {}; u32x4 stc[4] = {}; float stlc = 0.f;
        if (it < nit) { decode(it, t, lq, va); issue(t, lq, qc, stc, stlc); }
        while (it < nit) {
#pragma unroll
            for (int k = 0; k < 4; ++k) asm volatile("" : "+v"(qc[k]), "+v"(stc[k]));
            asm volatile("" : "+v"(stlc));
            const int itn = grab(); int tn = 0, lqn = 0; bool van = false; bf16x8 qn[4] = {}; u32x4 stn[4] = {}; float stln = 0.f;
            if (itn < nit) { decode(itn, tn, lqn, van); issue(tn, lqn, qn, stn, stln); }
            const bool own = it < ngo; int ntile = own ? ((32 * (ngo - 1 - it) + 31) >> 6) + 1 : 4;
#ifdef REP_PHASE
            if (abl == 1) ntile = 0;
#endif
            const bool nearany = own || __any((t >> 8) == j + 1);
            f32x16 o[2] = {splat16(0.f), splat16(0.f)}; float l = 0.f;
            for (int i = 0; i < ntile; ++i) { f32x16 s0, s1;
                qk<4>(s0, s1, (lcptr)(KB + i * KT64), KS64, qc, 0.f, r32, hi);
                if (nearany && (own || i >= 2)) bias_mask_near(s0, s1, BTL, t, 256 * j + 64 * i, hi, 0x7fffffffu);
                exp_step(s0, s1, l); pv<2>(o, s0, s1, (lcptr)(VB + i * VT64), VS64, lane); }
            l += __shfl_xor(l, 32);
            if (own) {
                const float lt = l + stlc; const float f = lt > 0.f ? OSC / lt : 0.f;
                unsigned char* orow = O8 + ((size_t)b * SEQ + t) * 1024 + h * 64;
#pragma unroll
                for (int d = 0; d < 2; ++d)
#pragma unroll
                    for (int rg = 0; rg < 4; ++rg) { const unsigned w0 = stc[2 * d + (rg >> 1)][(rg & 1) * 2], w1 = stc[2 * d + (rg >> 1)][(rg & 1) * 2 + 1];
                        *(unsigned*)(orow + 32 * d + 8 * rg + 4 * hi) = pg8::pk4_fp8((o[d][4 * rg] + bflo(w0)) * f, (o[d][4 * rg + 1] + bfhi(w0)) * f, (o[d][4 * rg + 2] + bflo(w1)) * f, (o[d][4 * rg + 3] + bfhi(w1)) * f); }
            } else if (va) {
                unsigned char* strow = ST + (size_t)lq * 128 + 64 * hi;
#pragma unroll
                for (int k = 0; k < 4; ++k) { const int d = k >> 1, rg0 = (k & 1) * 2; u32x4 nv;
#pragma unroll
                    for (int c = 0; c < 4; ++c) { const int rg = rg0 + (c >> 1), e = (c & 1) * 2; const unsigned wv = stc[k][c]; nv[c] = pk2(o[d][4 * rg + e] + bflo(wv), o[d][4 * rg + e + 1] + bfhi(wv)); }
                    *(u32x4*)(strow + 16 * k) = nv; }
                if (hi == 0) STL[lq] = stlc + l;
            }
            it = itn; t = tn; lq = lqn; va = van; stlc = stln;
#pragma unroll
            for (int k = 0; k < 4; ++k) qc[k] = qn[k];
#pragma unroll
            for (int k = 0; k < 4; ++k) stc[k] = stn[k];
        }
        __syncthreads();
    }
}
__device__ __forceinline__ void phase_moba2(const Frame& F, unsigned char* ws, int abl = 0) {
    const bf16_t* Q = (const bf16_t*)(ws + OFF_QKV); const bf16_t* K = Q + (size_t)MTOK * 1024; const bf16_t* V = K + (size_t)MTOK * 1024;
    const float* KMEAN = (const float*)(ws + OFF_KMEAN); const float* BT = (const float*)(ws + OFF_BT);
    for (int v = F.bx; v < 256; v += F.G) { const int x = v & 7, jj = v >> 3, pair = 16 * x + (jj >> 1), par = jj & 1;
        moba2_unit(F, pair >> 4, pair & 15, par, v, Q, K, V, KMEAN, BT, ws + OFF_O8, ws + OFF_MST, abl); __syncthreads(); }
}

__device__ __forceinline__ void nsa_unit(const Frame& F, int b, int g, int c, const bf16_t* Y1, const bf16_t* KC, const bf16_t* VC, const float* BT, unsigned char* MIXIN) {
    using namespace att;
    const int lane = F.lane, r32 = lane & 31, hi = lane >> 5, w = F.wave;
    lptr lds = (lptr)F.lds; lptr tl = lds; LAS float* BTL = (LAS float*)(lds + TL64_BYTES);
    LAS float* SCB = (LAS float*)(lds + TL64_BYTES + 2048);
    LAS unsigned long long* SELM = (LAS unsigned long long*)(lds + TL64_BYTES + 2048 + 16384);
    lptr OFL = lds + TL64_BYTES + 2048 + 16384 + 1024 + w * 8704 + r32 * 272 + hi * 16;
    const int n = r32 & 3, tok = 8 * w + (r32 >> 2), t = 64 * c + tok; const size_t row = (size_t)b * SEQ + t;
    const bf16_t* T1 = Y1 + (size_t)1 * MTOK * 256; const bf16_t* QB = Y1 + (size_t)(2 + g) * MTOK * 256;
    const bf16_t* KVS = Y1 + (size_t)5 * MTOK * 256; const bf16_t* KVW = Y1 + (size_t)6 * MTOK * 256;
    bf16x8 qf[4];
#pragma unroll
    for (int ks = 0; ks < 4; ++ks) qf[ks] = *(const bf16x8*)(QB + row * 256 + n * 64 + 16 * ks + 8 * hi);
    float gate[3];
#pragma unroll
    for (int j = 0; j < 3; ++j) { const float x = bf2f(T1[row * 256 + 208 + (4 * g + n) * 3 + j]); gate[j] = 1.f / (1.f + __expf(-x)); }
    for (int i = F.tid; i < 512; i += NTHR) BTL[i] = BT[(8 + 4 * g) * 128 + i] - BT[(8 + 4 * g) * 128 + (i | 127)];
    for (int i = F.tid; i < 4096; i += NTHR) SCB[i] = 0.f;
    __syncthreads();
    const LAS float* bt = BTL + n * 128; const float cfar = 0.f;
    const int vis = (t >= 31) ? ((t - 31) >> 4) : -1;
    const int ntc = ((4 * c + 2) >> 6) + 1;
    const bf16_t* KCg = KC + ((size_t)b * 256 * 2 + g) * 64; const bf16_t* VCg = VC + ((size_t)b * 256 * 2 + g) * 64;
    auto cmp_scores = [&](int i, lcptr Kt, f32x16& s0, f32x16& s1) {
        qk<4>(s0, s1, Kt, KS64, qf, 0.f, r32, hi);
#pragma unroll
        for (int half = 0; half < 2; ++half) { float bb[16]; f32x16& s = half ? s1 : s0;
#pragma unroll
            for (int r = 0; r < 16; ++r) { const int cc = 64 * i + 32 * half + crow(r, hi); const int d = t - 16 * cc - 31; const unsigned ix = (unsigned)d < 127u ? (unsigned)d : 127u; bb[r] = bt[ix]; }
#pragma unroll
            for (int r = 0; r < 16; ++r) asm volatile("" : "+v"(bb[r]));
#pragma unroll
            for (int r = 0; r < 16; ++r) { const int cc = 64 * i + 32 * half + crow(r, hi); s[r] = (cc <= vis) ? s[r] + bb[r] : -INFINITY; } }
    };
    float mc = NEG_BIG, lc = 0.f;
    tile_loop64(F.tid, tl, ntc, 128,
        [&](int i, const bf16_t*& kp, const bf16_t*& vp) { kp = KCg + (size_t)(64 * i) * 128; vp = VCg + (size_t)(64 * i) * 128; },
        [&](int i, lcptr Kt, lcptr Vt) { f32x16 s0, s1; cmp_scores(i, Kt, s0, s1);
            const float mn = fmaxf(mc, rowmax32(s0, s1)); float rs = 0.f;
#pragma unroll
            for (int r = 0; r < 16; ++r) rs += ex2(s0[r] - mn) + ex2(s1[r] - mn);
            lc = lc * ex2(mc - mn) + rs; mc = mn; });
    lc += __shfl_xor(lc, 32);
    const float invc = lc > 0.f ? 1.f / lc : 0.f;
    {
        f32x16 o[2] = {splat16(0.f), splat16(0.f)}; float carry = 0.f;
        tile_loop64(F.tid, tl, ntc, 128,
            [&](int i, const bf16_t*& kp, const bf16_t*& vp) { kp = KCg + (size_t)(64 * i) * 128; vp = VCg + (size_t)(64 * i) * 128; },
            [&](int i, lcptr Kt, lcptr Vt) { f32x16 s0, s1; cmp_scores(i, Kt, s0, s1);
#pragma unroll
                for (int r = 0; r < 16; ++r) { s0[r] = ex2(s0[r] - mc) * invc; s1[r] = ex2(s1[r] - mc) * invc; }
                float x0[4], x1[4];
#pragma unroll
                for (int rg = 0; rg < 4; ++rg) { x0[rg] = __shfl_xor(s0[4 * rg + 3], 32); x1[rg] = __shfl_xor(s1[4 * rg + 3], 32); }
#pragma unroll
                for (int rg = 0; rg < 4; ++rg) {
                    float g0 = (s0[4 * rg] + s0[4 * rg + 1]) + (s0[4 * rg + 2] + s0[4 * rg + 3]), g1 = (s1[4 * rg] + s1[4 * rg + 1]) + (s1[4 * rg + 2] + s1[4 * rg + 3]);
                    const float e0 = hi ? x0[rg] : (rg > 0 ? x0[rg > 0 ? rg - 1 : 0] : carry), e1 = hi ? x1[rg] : (rg > 0 ? x1[rg > 0 ? rg - 1 : 0] : x0[3]);
                    g0 += e0; g1 += e1;
                    g0 += __shfl_xor(g0, 1); g0 += __shfl_xor(g0, 2); g1 += __shfl_xor(g1, 1); g1 += __shfl_xor(g1, 2);
                    if (n == 0) { SCB[tok * 64 + 16 * i + 2 * rg + hi] = g0; SCB[tok * 64 + 16 * i + 8 + 2 * rg + hi] = g1; }
                }
                carry = x1[3];
                pv<2>(o, s0, s1, Vt, VS64, lane); });
#pragma unroll
        for (int d = 0; d < 2; ++d)
#pragma unroll
            for (int rg = 0; rg < 4; ++rg) *(LAS f32x4*)(OFL + d * 128 + rg * 32) = (f32x4){o[d][4 * rg], o[d][4 * rg + 1], o[d][4 * rg + 2], o[d][4 * rg + 3]} * gate[0];
    }
    {
        unsigned long long uni = 0ull;
#pragma unroll 1
        for (int tk = 0; tk < 8; ++tk) { const int tk2 = 8 * w + tk; float v = SCB[tk2 * 64 + lane];
            v = (lane > c) ? -INFINITY : ((lane == 0 || lane == c || lane == c - 1) ? INFINITY : v);
            int cnt = 0;
#pragma unroll
            for (int j = 0; j < 64; ++j) { const float vj = __builtin_bit_cast(float, __builtin_amdgcn_readlane(__builtin_bit_cast(int, v), j)); cnt += (vj > v || (vj == v && j < lane)) ? 1 : 0; }
            const unsigned long long mk = __ballot(cnt < 16 && lane <= c);
            if (lane == 0) SELM[tk2] = mk;
            uni |= mk; }
        if (lane == 0) SELM[64 + w] = uni;
    }
    __syncthreads();
    const unsigned long long mymask = SELM[tok];
    unsigned long long uni = 0ull;
#pragma unroll
    for (int k = 0; k < 8; ++k) uni |= SELM[64 + k];
    {
        f32x16 o[2] = {splat16(0.f), splat16(0.f)}; float l = 0.f;
        const int nsel = __popcll(uni);
        const bf16_t* Kg = KVS + (size_t)b * SEQ * 256 + g * 64; const bf16_t* Vg = Kg + 128;
        LAS unsigned char* LIST = (LAS unsigned char*)(SELM + 72);
        if (F.tid < 64 && ((uni >> F.tid) & 1ull)) LIST[__popcll(uni & ((1ull << F.tid) - 1ull))] = (unsigned char)F.tid;
        __syncthreads();
        tile_loop64(F.tid, tl, nsel, 256,
            [&](int i, const bf16_t*& kp, const bf16_t*& vp) { const int j = LIST[i]; kp = Kg + (size_t)(64 * j) * 256; vp = Vg + (size_t)(64 * j) * 256; },
            [&](int i, lcptr Kt, lcptr Vt) { const int j = LIST[i];
                const bool sel = (mymask >> j) & 1ull;
                if (!__any(sel)) return;
                f32x16 s0, s1; qk<4>(s0, s1, Kt, KS64, qf, 0.f, r32, hi);
                if (j >= c - 2) bias_mask_near(s0, s1, bt, t, 64 * j, hi, 0x7fffffffu);
                if (!sel) mask_all(s0, s1);
                exp_step(s0, s1, l); pv<2>(o, s0, s1, Vt, VS64, lane); });
        l += __shfl_xor(l, 32); const float f = gate[1] * (l > 0.f ? 1.f / l : 0.f);
#pragma unroll
        for (int d = 0; d < 2; ++d)
#pragma unroll
            for (int rg = 0; rg < 4; ++rg) *(LAS f32x4*)(OFL + d * 128 + rg * 32) += (f32x4){o[d][4 * rg], o[d][4 * rg + 1], o[d][4 * rg + 2], o[d][4 * rg + 3]} * f;
    }
    {
        f32x16 o[2] = {splat16(0.f), splat16(0.f)}; float l = 0.f;
        const int k0 = c >= 8 ? c - 8 : 0, ntw = c - k0 + 1;
        const bf16_t* Kg = KVW + (size_t)b * SEQ * 256 + g * 64; const bf16_t* Vg = Kg + 128;
        tile_loop64(F.tid, tl, ntw, 256,
            [&](int i, const bf16_t*& kp, const bf16_t*& vp) { kp = Kg + (size_t)(64 * (k0 + i)) * 256; vp = Vg + (size_t)(64 * (k0 + i)) * 256; },
            [&](int i, lcptr Kt, lcptr Vt) { const int kt = k0 + i; f32x16 s0, s1; qk<4>(s0, s1, Kt, KS64, qf, 0.f, r32, hi);
                if (!(kt < c - 2 && kt > c - 8)) bias_mask_near(s0, s1, bt, t, 64 * kt, hi, 512u);
                exp_step(s0, s1, l); pv<2>(o, s0, s1, Vt, VS64, lane); });
        l += __shfl_xor(l, 32); const float f = gate[2] * (l > 0.f ? 1.f / l : 0.f);
        unsigned char* orow = MIXIN + row * 1536 + 1024 + (4 * g + n) * 64;
#pragma unroll
        for (int d = 0; d < 2; ++d)
#pragma unroll
            for (int rg = 0; rg < 4; ++rg) { const f32x4 v = (*(LAS f32x4*)(OFL + d * 128 + rg * 32) + (f32x4){o[d][4 * rg], o[d][4 * rg + 1], o[d][4 * rg + 2], o[d][4 * rg + 3]} * f) * OSC;
                *(unsigned*)(orow + 32 * d + 8 * rg + 4 * hi) = pg8::pk4_fp8(v[0], v[1], v[2], v[3]); }
    }
}

__device__ __forceinline__ void dsa_unit(const Frame& F, int b, int u, const bf16_t* QLAT, const bf16_t* CKVN, const unsigned* MASK, const float* BT, unsigned char* MIXIN) {
    using namespace att;
    const int lane = F.lane, r32 = lane & 31, hi = lane >> 5, w = F.wave, tid = F.tid;
    lptr lds = (lptr)F.lds; lptr Kb = lds, Vb = lds + 2 * KT128; LAS float* BTL = (LAS float*)(lds + 2 * KT128 + 2 * VT128);
    const int head = r32 & 7, q0 = 32 * u, t = q0 + 4 * w + (r32 >> 3); const size_t row = (size_t)b * SEQ + t;
    bf16x8 qf[8];
#pragma unroll
    for (int ks = 0; ks < 8; ++ks) qf[ks] = *(const bf16x8*)(QLAT + row * 1024 + head * 128 + 16 * ks + 8 * hi);
    for (int i = tid; i < 1024; i += NTHR) BTL[i] = BT[i] - BT[i | 127];
    const LAS float* bt = BTL + head * 128;
    f32x16 o[4] = {splat16(0.f), splat16(0.f), splat16(0.f), splat16(0.f)}; float l = 0.f;
    const int nt = ((q0 + 31) >> 6) + 1;
    const bf16_t* Cb = CKVN + (size_t)b * SEQ * 128; const unsigned* mrow = MASK + row * 128;
    u32x4 st[2];
    auto gload = [&](int i) {
#pragma unroll
        for (int k = 0; k < 2; ++k) { const int idx = tid + 512 * k, rr = idx >> 4, ch = idx & 15; st[k] = *(const u32x4*)(Cb + (size_t)(64 * i + rr) * 128 + ch * 8); } };
    auto lstore = [&](int i) { lptr kd = Kb + (i & 1) * KT128, vd = Vb + (i & 1) * VT128;
#pragma unroll
        for (int k = 0; k < 2; ++k) { const int idx = tid + 512 * k, rr = idx >> 4, ch = idx & 15; *(LAS u32x4*)(kd + rr * KS128 + ch * 16) = st[k]; *(LAS u32x4*)(vd + rr * VS128 + ch * 16) = st[k]; } };
    auto score = [&](int i, f32x16& s0, f32x16& s1) {
        lcptr Kt = (lcptr)(Kb + (i & 1) * KT128);
        const u32x2 mw = *(const u32x2*)(mrow + 2 * i);
        qk<8>(s0, s1, Kt, KS128, qf, 0.f, r32, hi);
        const unsigned w0 = mw.x >> (4 * hi), w1 = mw.y >> (4 * hi);
        if ((q0 - (64 * i + 63)) < 128) {
#pragma unroll
            for (int r = 0; r < 16; ++r) { const int d0 = t - (64 * i + crow(r, hi)), d1 = d0 - 32;
                const unsigned i0 = (unsigned)d0 < 127u ? (unsigned)d0 : 127u, i1 = (unsigned)d1 < 127u ? (unsigned)d1 : 127u;
                s0[r] += bt[i0]; s1[r] += bt[i1]; }
        }
#pragma unroll
        for (int r = 0; r < 16; ++r) { const int bit = (r & 3) + 8 * (r >> 2);
            const int m0 = __builtin_amdgcn_sbfe((int)w0, bit, 1), m1 = __builtin_amdgcn_sbfe((int)w1, bit, 1);
            const float a0 = s0[r], a1 = s1[r];
            s0[r] = __int_as_float((__float_as_int(a0) & m0) | ((int)0xff800000 & ~m0));
            s1[r] = __int_as_float((__float_as_int(a1) & m1) | ((int)0xff800000 & ~m1)); }
    };
    u32x4 st2[2];
    gload(0); lstore(0);
    if (nt > 1) gload(1);
    __syncthreads();
    auto step = [&](int i, u32x4 (&sL)[2], u32x4 (&sS)[2]) {
        if (i + 2 < nt) {
#pragma unroll
            for (int k = 0; k < 2; ++k) { const int idx = tid + 512 * k, rr = idx >> 4, ch = idx & 15; sL[k] = *(const u32x4*)(Cb + (size_t)(64 * (i + 2) + rr) * 128 + ch * 8); } }
        f32x16 s0, s1; score(i, s0, s1);
        exp_step(s0, s1, l); pv<4>(o, s0, s1, (lcptr)(Vb + (i & 1) * VT128), VS128, lane);
        if (i + 1 < nt) { lptr kd = Kb + ((i + 1) & 1) * KT128, vd = Vb + ((i + 1) & 1) * VT128;
#pragma unroll
            for (int k = 0; k < 2; ++k) { const int idx = tid + 512 * k, rr = idx >> 4, ch = idx & 15; *(LAS u32x4*)(kd + rr * KS128 + ch * 16) = sS[k]; *(LAS u32x4*)(vd + rr * VS128 + ch * 16) = sS[k]; } }
        __syncthreads();
    };
    for (int i = 0; i < nt; i += 2) { step(i, st2, st); if (i + 1 < nt) step(i + 1, st, st2); }
    l += __shfl_xor(l, 32); const float f = l > 0.f ? OSC / l : 0.f;
    unsigned char* orow = MIXIN + row * 1536 + head * 128;
#pragma unroll
    for (int d = 0; d < 4; ++d)
#pragma unroll
        for (int rg = 0; rg < 4; ++rg) *(unsigned*)(orow + 32 * d + 8 * rg + 4 * hi) = pg8::pk4_fp8(o[d][4 * rg] * f, o[d][4 * rg + 1] * f, o[d][4 * rg + 2] * f, o[d][4 * rg + 3] * f);
}

constexpr int DS_TILE = 32 * att::KS128, DS_WAVE = 2 * DS_TILE + 640;
__device__ __forceinline__ void dsa_query(int lane, int b, int t, u32x2 mw, att::lptr base, const LAS float* BTL, const bf16_t* QLAT, const bf16_t* CKVN, unsigned char* MIXIN) {
    using namespace att;
    const int r32 = lane & 31, hi = lane >> 5, head = r32 & 7; const size_t row = (size_t)b * SEQ + t;
    LAS unsigned short* LIST = (LAS unsigned short*)(base + 2 * DS_TILE);
    bf16x8 qf[8];
#pragma unroll
    for (int ks = 0; ks < 8; ++ks) qf[ks] = *(const bf16x8*)(QLAT + row * 1024 + head * 128 + 16 * ks + 8 * hi);
    int n;
    { unsigned long long bits = (lane <= (t >> 6)) ? ((unsigned long long)mw.x | ((unsigned long long)mw.y << 32)) : 0ull;
      const int cnt = __popcll(bits); int pre = cnt;
#pragma unroll
      for (int o = 1; o < 64; o <<= 1) { const int v = __shfl_up(pre, o); if (lane >= o) pre += v; }
      n = __builtin_amdgcn_readlane(pre, 63); int pos = pre - cnt;
      while (bits) { const int j = __builtin_ctzll(bits); bits &= bits - 1ull; LIST[pos++] = (unsigned short)(64 * lane + j); }
      if (lane < 32) LIST[n + lane] = 0; }
    const bf16_t* Cb = CKVN + (size_t)b * SEQ * 128; const LAS float* bt = BTL + head * 128;
    const int ntile = (n + 31) >> 5;
    f32x16 o[4] = {splat16(0.f), splat16(0.f), splat16(0.f), splat16(0.f)}; float l = 0.f;
    u32x4 ra[8];
    auto gath = [&](int i, u32x4 (&r)[8]) {
#pragma unroll
        for (int k = 0; k < 8; ++k) { const int c = lane + 64 * k, rw = c >> 4, ch = c & 15; const int idx = LIST[32 * i + rw]; r[k] = *(const u32x4*)(Cb + (size_t)idx * 128 + ch * 8); } };
    auto put = [&](lptr T, const u32x4 (&r)[8]) {
#pragma unroll
        for (int k = 0; k < 8; ++k) { const int c = lane + 64 * k, rw = c >> 4, ch = c & 15; *(LAS u32x4*)(T + rw * KS128 + ch * 16) = r[k]; } };
    const int hq = lane >> 5, g = (lane >> 4) & 1, q4 = (lane & 15) >> 2, p4 = lane & 3;
    auto tile = [&](int i) {
        lcptr T = (lcptr)(base + (i & 1) * DS_TILE);
        f32x16 s = splat16(0.f);
        { lcptr p0 = T + r32 * KS128 + hi * 16;
#pragma unroll
          for (int ks = 0; ks < 8; ++ks) { const bf16x8 kf = *(const LAS bf16x8*)(p0 + ks * 32); s = __builtin_amdgcn_mfma_f32_32x32x16_bf16(kf, qf[ks], s, 0, 0, 0); } }
        const int lastslot = (32 * i + 31 < n) ? 32 * i + 31 : n - 1;
        if (32 * i + 32 > n || t - (int)LIST[lastslot] < 127) {
#pragma unroll
            for (int h8 = 0; h8 < 2; ++h8) { int li[8]; float bb[8];
#pragma unroll
                for (int r = 0; r < 8; ++r) li[r] = LIST[32 * i + crow(8 * h8 + r, hi)];
#pragma unroll
                for (int r = 0; r < 8; ++r) asm volatile("" : "+v"(li[r]));
#pragma unroll
                for (int r = 0; r < 8; ++r) { const int d = t - li[r]; const unsigned ix = (unsigned)d < 127u ? (unsigned)d : 127u; bb[r] = bt[ix]; }
#pragma unroll
                for (int r = 0; r < 8; ++r) asm volatile("" : "+v"(bb[r]));
#pragma unroll
                for (int r = 0; r < 8; ++r) { const int slot = 32 * i + crow(8 * h8 + r, hi); s[8 * h8 + r] = (slot < n) ? s[8 * h8 + r] + bb[r] : -INFINITY; } }
        }
        float rs = 0.f;
#pragma unroll
        for (int r = 0; r < 16; ++r) { s[r] = ex2(s[r]); rs += s[r]; }
        l += rs;
        const bf16x8 pk[2] = {pack_p(s, 0), pack_p(s, 8)};
        lcptr vb = T + (4 * hq + q4) * KS128 + (16 * g + 4 * p4) * 2;
#pragma unroll
        for (int k = 0; k < 2; ++k)
#pragma unroll
            for (int d = 0; d < 4; ++d) { const s16x4 lo = vtr(vb + (16 * k) * KS128 + d * 64), hh = vtr(vb + (16 * k + 8) * KS128 + d * 64);
                const bf16x8 vf = (bf16x8){lo[0], lo[1], lo[2], lo[3], hh[0], hh[1], hh[2], hh[3]};
                o[d] = __builtin_amdgcn_mfma_f32_32x32x16_bf16(vf, pk[k], o[d], 0, 0, 0); }
    };
    gath(0, ra); put(base, ra);
    for (int i = 0; i < ntile; ++i) {
        const bool more = i + 1 < ntile;
        if (more) gath(i + 1, ra);
        tile(i);
        if (more) put(base + ((i + 1) & 1) * DS_TILE, ra);
    }
    l += __shfl_xor(l, 32); const float f = l > 0.f ? OSC / l : 0.f;
    if (r32 < 8) { unsigned char* orow = MIXIN + row * 1536 + head * 128;
#pragma unroll
        for (int d = 0; d < 4; ++d)
#pragma unroll
            for (int rg = 0; rg < 4; ++rg) *(unsigned*)(orow + 32 * d + 8 * rg + 4 * hi) = pg8::pk4_fp8(o[d][4 * rg] * f, o[d][4 * rg + 1] * f, o[d][4 * rg + 2] * f, o[d][4 * rg + 3] * f); }
}
__device__ __forceinline__ void phase_dsa_sparse(const Frame& F, const bf16_t* QLAT, const bf16_t* CKVN, const unsigned* MASK, const float* BT, unsigned char* MIXIN) {
    att::lptr lds = (att::lptr)F.lds; LAS float* BTL = (LAS float*)(lds + 8 * DS_WAVE);
    for (int i = F.tid; i < 1024; i += NTHR) BTL[i] = BT[i] - BT[i | 127];
    __syncthreads();
    att::lptr base = lds + F.wave * DS_WAVE;
    if ((F.G & 7) == 0) {
        const int b = F.bx & 7, wx = (F.bx >> 3) * NWAVES + F.wave, WX = (F.G >> 3) * NWAVES;
        u32x2 mw = *(const u32x2*)(MASK + ((size_t)b * SEQ + wx) * 128 + 2 * F.lane);
        for (int t = wx; t < SEQ; t += WX) { const int tn = (t + WX < SEQ) ? t + WX : t;
            const u32x2 mwn = *(const u32x2*)(MASK + ((size_t)b * SEQ + tn) * 128 + 2 * F.lane);
            const unsigned qwarm = *(const volatile unsigned*)(QLAT + ((size_t)b * SEQ + tn) * 1024 + 16 * F.lane);
            dsa_query(F.lane, b, t, mw, base, BTL, QLAT, CKVN, MIXIN); mw = mwn; asm volatile("" :: "v"(qwarm)); }
    } else {
        for (int q = F.gw; q < MTOK; q += F.NGW) { const u32x2 mw = *(const u32x2*)(MASK + (size_t)q * 128 + 2 * F.lane); dsa_query(F.lane, q >> 12, q & 4095, mw, base, BTL, QLAT, CKVN, MIXIN); }
    }
    __syncthreads();
}

constexpr int QI_STRIDE = 2064;
__device__ __forceinline__ void indexer_unit(const Frame& F, int b, int c, const bf16_t* QIDX, const bf16_t* T1, _Float16* SC) {
    using namespace att;
    int tid = F.tid; asm volatile("" : "+v"(tid));
    const int lane = tid & 63, r32 = lane & 31, hi = lane >> 5, w = F.wave;
    lptr lds = (lptr)F.lds; lptr QI = lds; lptr KI = lds + 64 * QI_STRIDE;
    const int qh = w & 1, kq = w >> 1;
    const size_t row0 = (size_t)b * SEQ + 64 * c;
#pragma unroll 4
    for (int k = 0; k < 16; ++k) { const int idx = tid + 512 * k, rr = idx >> 7, ch = idx & 127; *(LAS u32x4*)(QI + rr * QI_STRIDE + ch * 16) = *(const u32x4*)(QIDX + (row0 + rr) * 1024 + ch * 8); }
    unsigned wp[8];
    { const size_t trow = row0 + 32 * qh + r32; const u32x4 a = *(const u32x4*)(T1 + trow * 256 + 192), bq = *(const u32x4*)(T1 + trow * 256 + 200);
      wp[0] = a.x; wp[1] = a.y; wp[2] = a.z; wp[3] = a.w; wp[4] = bq.x; wp[5] = bq.y; wp[6] = bq.z; wp[7] = bq.w; }
    const int nsup = (c + 2) >> 1, pitch = (c + 1) * 64;
    _Float16* srow = SC + (size_t)b * SCB_ELEMS + (size_t)4096 * (c * (c + 1) / 2) + (size_t)(32 * qh + r32) * pitch;
    const bf16_t* Kb = T1 + (size_t)b * SEQ * 256 + 128;
    u32x4 st[2]; u32x2 pend[4] = {}; int pkey = -1;
#pragma unroll
    for (int k = 0; k < 2; ++k) { const int idx = tid + 512 * k, rr = idx >> 3, ch = idx & 7; st[k] = *(const u32x4*)(Kb + (size_t)rr * 256 + ch * 8); }
    for (int s = 0; s < nsup; ++s) {
        __syncthreads();
#pragma unroll
        for (int k = 0; k < 2; ++k) { const int idx = tid + 512 * k, rr = idx >> 3, ch = idx & 7; *(LAS u32x4*)(KI + rr * KS64 + ch * 16) = st[k]; }
        __syncthreads();
        if (pkey >= 0) {
#pragma unroll
            for (int rg = 0; rg < 4; ++rg) *(u32x2*)(srow + pkey + 8 * rg + 4 * hi) = pend[rg]; }
        { const int sn = (s + 1 < nsup) ? s + 1 : s;
#pragma unroll
          for (int k = 0; k < 2; ++k) { const int idx = tid + 512 * k, rr = idx >> 3, ch = idx & 7; st[k] = *(const u32x4*)(Kb + (size_t)(128 * sn + rr) * 256 + ch * 8); } }
        const int key0 = 128 * s + 32 * kq; pkey = -1;
        if (key0 <= 64 * c + 63) {
            bf16x8 kf[4];
#pragma unroll
            for (int ks = 0; ks < 4; ++ks) kf[ks] = *(const LAS bf16x8*)(KI + (32 * kq + r32) * KS64 + ks * 32 + hi * 16);
            float sc[16];
#pragma unroll
            for (int r = 0; r < 16; ++r) sc[r] = 0.f;
            lcptr qp = (lcptr)QI + (32 * qh + r32) * QI_STRIDE + hi * 16;
            f32x16 ac[2]; bf16x8 qv[2][4];
#pragma unroll
            for (int i = 0; i < 8; ++i) asm volatile("" : "+v"(wp[i]));
#pragma unroll
            for (int ks = 0; ks < 4; ++ks) qv[0][ks] = *(const LAS bf16x8*)(qp + ks * 32);
#pragma unroll
            for (int hd = 0; hd <= 16; ++hd) {
                if (hd + 1 < 16) {
#pragma unroll
                    for (int ks = 0; ks < 4; ++ks) qv[(hd + 1) & 1][ks] = *(const LAS bf16x8*)(qp + (hd + 1) * 128 + ks * 32); }
                if (hd < 16) ac[hd & 1] = splat16(0.f);
#pragma unroll
                for (int ks = 0; ks < 4; ++ks) {
                    if (hd < 16) ac[hd & 1] = __builtin_amdgcn_mfma_f32_32x32x16_bf16(kf[ks], qv[hd & 1][ks], ac[hd & 1], 0, 0, 0);
                    if (hd > 0) { const float ww = ((hd - 1) & 1) ? bfhi(wp[(hd - 1) >> 1]) : bflo(wp[(hd - 1) >> 1]);
#pragma unroll
                        for (int r = 4 * ks; r < 4 * ks + 4; ++r) { const float av = ac[(hd - 1) & 1][r]; const int ai = __float_as_int(av); sc[r] += ww * __int_as_float(ai > 0 ? ai : 0); } }
                    if (hd < 16 && ks < 3) asm volatile("" : "+v"(sc[4 * ks]), "+v"(sc[4 * ks + 1]), "+v"(sc[4 * ks + 2]), "+v"(sc[4 * ks + 3]), "+v"(qv[hd & 1][ks + 1]));
                    else if (hd + 1 < 16) asm volatile("" : "+v"(sc[4 * ks]), "+v"(sc[4 * ks + 1]), "+v"(sc[4 * ks + 2]), "+v"(sc[4 * ks + 3]), "+v"(qv[(hd + 1) & 1][0]));
                    else asm volatile("" : "+v"(sc[4 * ks]), "+v"(sc[4 * ks + 1]), "+v"(sc[4 * ks + 2]), "+v"(sc[4 * ks + 3]));
                }
            }
#pragma unroll
            for (int rg = 0; rg < 4; ++rg) { f32x2 a = {sc[4 * rg], sc[4 * rg + 1]}, bq = {sc[4 * rg + 2], sc[4 * rg + 3]};
                u32x2 o; o.x = __builtin_bit_cast(unsigned, __builtin_convertvector(a, f16x2_t)); o.y = __builtin_bit_cast(unsigned, __builtin_convertvector(bq, f16x2_t));
                pend[rg] = o; }
            pkey = key0;
        }
    }
    if (pkey >= 0) {
#pragma unroll
        for (int rg = 0; rg < 4; ++rg) *(u32x2*)(srow + pkey + 8 * rg + 4 * hi) = pend[rg]; }
    __syncthreads();
}

__device__ __forceinline__ int wave_sum_i(int v) {
    v += __builtin_amdgcn_update_dpp(0, v, 0xB1, 0xF, 0xF, true);
    v += __builtin_amdgcn_update_dpp(0, v, 0x4E, 0xF, 0xF, true);
    v += __builtin_amdgcn_update_dpp(0, v, 0x141, 0xF, 0xF, true);
    v += __builtin_amdgcn_update_dpp(0, v, 0x140, 0xF, 0xF, true);
    return __builtin_amdgcn_readlane(v, 0) + __builtin_amdgcn_readlane(v, 16) + __builtin_amdgcn_readlane(v, 32) + __builtin_amdgcn_readlane(v, 48);
}
struct SelRow { const unsigned short* src; unsigned* mrow; int t, c; };
__device__ __forceinline__ SelRow sel_row(int row, const _Float16* SC, unsigned* MASK) {
    SelRow r; const int b = row >> 12; r.t = row & 4095; r.c = r.t >> 6; const int nk = (r.c + 1) * 64;
    r.src = (const unsigned short*)SC + (size_t)b * SCB_ELEMS + (size_t)4096 * (r.c * (r.c + 1) / 2) + (size_t)(r.t & 63) * nk; r.mrow = MASK + (size_t)row * 128; return r;
}
__device__ __forceinline__ void sel_fetch(const SelRow& r, int lane, u32x4 (&x)[8]) {
    if (lane <= r.c) { const u32x4* p = (const u32x4*)(r.src + 64 * lane);
#pragma unroll
        for (int i = 0; i < 8; ++i) x[i] = p[i]; }
    else {
#pragma unroll
        for (int i = 0; i < 8; ++i) x[i] = (u32x4){0u, 0u, 0u, 0u}; }
}
__device__ __forceinline__ void sel_slices(const u32x4 (&x)[8], unsigned (&S)[2][16]) {
#pragma unroll
    for (int k = 0; k < 2; ++k) {
        unsigned X[16], R[16];
#pragma unroll
        for (int i = 0; i < 4; ++i) { X[4 * i] = x[4 * k + i].x; X[4 * i + 1] = x[4 * k + i].y; X[4 * i + 2] = x[4 * k + i].z; X[4 * i + 3] = x[4 * k + i].w; }
#pragma unroll
        for (int i = 0; i < 8; ++i) { R[2 * i] = (X[i] & 0xffffu) | (X[i + 8] << 16); R[2 * i + 1] = (X[i] >> 16) | (X[i + 8] & 0xffff0000u); }
#pragma unroll
        for (int s = 0; s < 4; ++s) { const int j = 8 >> s; const unsigned m = (s == 0) ? 0x00ff00ffu : (s == 1) ? 0x0f0f0f0fu : (s == 2) ? 0x33333333u : 0x55555555u;
#pragma unroll
            for (int q = 0; q < 16; ++q) if (!(q & j)) { const unsigned a = R[q], b = R[q + j]; R[q] = (a & m) | ((b << j) & ~m); R[q + j] = ((a >> j) & m) | (b & ~m); } }
        const unsigned sg = R[15];
#pragma unroll
        for (int b = 0; b < 15; ++b) S[k][b] = R[b] ^ sg;
        S[k][15] = ~sg;
    }
}
__device__ __forceinline__ void phase_select(const Frame& F, const _Float16* SC, unsigned* MASK) {
    const int lane = F.lane;
    u32x4 xa[8], xb[8];
    if (F.gw < MTOK / 2) { sel_fetch(sel_row(F.gw, SC, MASK), lane, xa); sel_fetch(sel_row(F.gw + MTOK / 2, SC, MASK), lane, xb); }
    for (int p = F.gw; p < MTOK / 2; p += F.NGW) {
        const SelRow ra = sel_row(p, SC, MASK), rb = sel_row(p + MTOK / 2, SC, MASK);
        unsigned Sa[2][16], Sb[2][16];
        sel_slices(xa, Sa); sel_slices(xb, Sb);
        { const int pn = (p + F.NGW < MTOK / 2) ? p + F.NGW : p;
          sel_fetch(sel_row(pn, SC, MASK), lane, xa); sel_fetch(sel_row(pn + MTOK / 2, SC, MASK), lane, xb); }
        unsigned long long va, vb;
        { const int nv = ra.t - 64 * lane + 1; va = nv >= 64 ? ~0ull : (nv <= 0 ? 0ull : ((1ull << nv) - 1ull)); }
        { const int nv = rb.t - 64 * lane + 1; vb = nv >= 64 ? ~0ull : (nv <= 0 ? 0ull : ((1ull << nv) - 1ull)); }
        unsigned a0 = (unsigned)va, a1 = (unsigned)(va >> 32), b0 = (unsigned)vb, b1 = (unsigned)(vb >> 32), sa0 = 0u, sa1 = 0u, sb0 = 0u, sb1 = 0u;
        int na = 256, nb = 256;
#pragma unroll
        for (int bit = 15; bit >= 0; --bit) {
            const unsigned ta0 = a0 & Sa[0][bit], ta1 = a1 & Sa[1][bit], tb0 = b0 & Sb[0][bit], tb1 = b1 & Sb[1][bit];
            const int ca = wave_sum_i(__popc(ta0) + __popc(ta1)), cb = wave_sum_i(__popc(tb0) + __popc(tb1));
            const bool ga = ca >= na, gb = cb >= nb; const unsigned fa = ga ? 0u : ~0u, fb = gb ? 0u : ~0u;
            a0 &= Sa[0][bit] ^ fa; a1 &= Sa[1][bit] ^ fa; b0 &= Sb[0][bit] ^ fb; b1 &= Sb[1][bit] ^ fb;
            sa0 |= ta0 & fa; sa1 |= ta1 & fa; sb0 |= tb0 & fb; sb1 |= tb1 & fb;
            na -= ga ? 0 : ca; nb -= gb ? 0 : cb;
        }
#pragma unroll
        for (int w = 0; w < 2; ++w) {
            unsigned long long a = w ? ((unsigned long long)b0 | ((unsigned long long)b1 << 32)) : ((unsigned long long)a0 | ((unsigned long long)a1 << 32)); const int need = w ? nb : na;
            const int pc = __popcll(a), tot = wave_sum_i(pc);
            if (tot > need) {
                int pre = pc;
#pragma unroll
                for (int o = 1; o < 64; o <<= 1) { const int v = __shfl_up(pre, o); if (lane >= o) pre += v; }
                const int take = need - (pre - pc);
                if (take <= 0) a = 0ull; else while (__popcll(a) > take) a &= ~(1ull << (63 - __clzll(a)));
            }
            const SelRow& r = w ? rb : ra;
            const unsigned s0 = (w ? sb0 : sa0) | (unsigned)a, s1 = (w ? sb1 : sa1) | (unsigned)(a >> 32);
            if (lane <= r.c) *(u32x2*)(r.mrow + 2 * lane) = (u32x2){s0, s1};
        }
    }
}

__device__ __forceinline__ float gelu_tanh(float x) { const float u = 0.7978845608028654f * (x + 0.044715f * x * x * x); const float e = __expf(2.f * u); return 0.5f * x * (1.f + (1.f - 2.f / (e + 1.f))); }
__device__ __forceinline__ void compress_unit(const Frame& F, int b, int g, int kv, int rt, const bf16_t* KVC, const bf16_t* W1T, const float* w2, const float* cb, bf16_t* OUT) {
    const int lane = F.lane, r32 = lane & 31, hi = lane >> 5, w = F.wave, tid = F.tid;
    LAS float* PART = (LAS float*)F.lds;
    LAS float* HID = PART + 8 * 2048;
    const int n0 = 32 * rt, nn = n0 + r32, nc = nn < 255 ? nn : 254;
    const bf16_t* arow = KVC + ((size_t)b * SEQ + 16 * nc) * 256 + kv * 128 + g * 64;
    f32x16 a0 = att::splat16(0.f), a1 = att::splat16(0.f);
#pragma unroll 4
    for (int ks = 0; ks < 16; ++ks) { const int l = 4 * w + (ks >> 2), d = 16 * (ks & 3) + 8 * hi;
        const bf16x8 af = *(const bf16x8*)(arow + (size_t)l * 256 + d);
        const bf16x8 b0 = *(const bf16x8*)(W1T + (size_t)r32 * 2048 + l * 64 + d), b1 = *(const bf16x8*)(W1T + (size_t)(32 + r32) * 2048 + l * 64 + d);
        a0 = __builtin_amdgcn_mfma_f32_32x32x16_bf16(af, b0, a0, 0, 0, 0); a1 = __builtin_amdgcn_mfma_f32_32x32x16_bf16(af, b1, a1, 0, 0, 0); }
#pragma unroll
    for (int r = 0; r < 16; ++r) { const int mrow = att::crow(r, hi); PART[w * 2048 + mrow * 64 + r32] = a0[r]; PART[w * 2048 + mrow * 64 + 32 + r32] = a1[r]; }
    __syncthreads();
#pragma unroll
    for (int k = 0; k < 4; ++k) { const int idx = tid + 512 * k; float s = cb[idx & 63];
#pragma unroll
        for (int ww = 0; ww < 8; ++ww) s += PART[ww * 2048 + idx];
        HID[idx] = gelu_tanh(s); }
    __syncthreads();
#pragma unroll
    for (int k = 0; k < 4; ++k) { const int idx = tid + 512 * k, nr = idx >> 6, f = idx & 63; float s = 0.f;
#pragma unroll 8
        for (int e = 0; e < 64; ++e) s += HID[nr * 64 + e] * w2[e * 64 + f];
        const int blk = n0 + nr;
        OUT[(((size_t)b * 256 + blk) * 2 + g) * 64 + f] = (blk < 255) ? (bf16_t)f2bf(s) : (bf16_t)0; }
    __syncthreads();
}

#ifdef DBG_MODE
namespace dbg {
constexpr int NSLOT = 40;
__device__ __forceinline__ float bfr(float x) { return bf2f((unsigned short)f2bf(x)); }
__device__ __forceinline__ int srow(int i, int n) { return (int)(((unsigned)i * 2654435761u) % (unsigned)MTOK) ; }
__device__ void commit(unsigned* D, int slot, const float* ref, const float* fast, int n, float tf) {
    __shared__ float red[256];
    const int tid = threadIdx.x; float s = 0.f;
    for (int i = tid; i < n; i += 256) s += ref[i] * ref[i];
    red[tid] = s; __syncthreads();
    for (int o = 128; o > 0; o >>= 1) { if (tid < o) red[tid] += red[tid + o]; __syncthreads(); }
    const float rms = sqrtf(red[0] / (float)n); __syncthreads();
    int bad = 0, tot = 0; float mr = 0.f;
    for (int i = tid; i < n; i += 256) { const float e = fabsf(fast[i] - ref[i]); const float tol = tf * (rms + fabsf(ref[i])) + 1e-7f; if (!(e <= tol)) ++bad; ++tot; const float r = e / (rms + 1e-20f); if (r > mr || !(r == r)) mr = (r == r) ? r : 1e30f; }
    atomicAdd(&D[4 * slot], (unsigned)bad); atomicAdd(&D[4 * slot + 1], (unsigned)tot); atomicMax(&D[4 * slot + 2], __float_as_uint(mr));
    __syncthreads();
}
__device__ __forceinline__ float bias_l2(const float* relb, int head, int dist) { return relb[t5_bucket(dist) * 16 + head] * LOG2E; }

__global__ void chk_in_e(Args a, unsigned* D) {
    __shared__ float ref[1792], fast[1792];
    const int r = srow(blockIdx.x, 64), tid = threadIdx.x; const float* x = a.in[I_X] + (size_t)r * 1024; const float* w = a.in[I_EWIN];
    const bf16_t* Y1 = (const bf16_t*)(a.ws + OFF_Y1);
    for (int n = tid; n < EVEN_IN; n += 256) { float s = 0.f; for (int k = 0; k < 1024; ++k) s += bfr(x[k]) * bfr(w[(size_t)k * EVEN_IN + n]);
        const int dc = RowInE{}(n), tile = dc >> 8, col = dc & 255; const float sc = (tile == 2 || tile == 3) ? QSCALE : 1.f;
        ref[n] = s * sc; fast[n] = bf2f(Y1[((size_t)tile * MTOK + r) * 256 + col]); }
    __syncthreads();
    commit(D, 1, ref, fast, EVEN_IN, 0.02f);
    if (tid == 0) { float sq = 0.f, skv = 0.f; for (int n = 0; n < 256; ++n) sq += ref[n] * ref[n]; for (int n = 256; n < 384; ++n) skv += ref[n] * ref[n];
        const float* pq = (const float*)(a.ws + OFF_SSQ_Q) + (size_t)r * 4; const float* pk = (const float*)(a.ws + OFF_SSQ_KV) + (size_t)r * 4;
        const float fq = pq[0] + pq[1] + pq[2] + pq[3], fk = pk[0] + pk[1] + pk[2] + pk[3];
        int bad = 0; if (!(fabsf(fq - sq) <= 0.02f * sq)) ++bad; if (!(fabsf(fk - skv) <= 0.02f * skv)) ++bad;
        atomicAdd(&D[4 * 2], (unsigned)bad); atomicAdd(&D[4 * 2 + 1], 2u); }
}
__global__ void chk_q2(Args a, unsigned* D) {
    __shared__ float ref[1024], fast[1024], cqn[256], qh[512];
    const int r = srow(blockIdx.x, 64), tid = threadIdx.x; const bf16_t* Y1 = (const bf16_t*)(a.ws + OFF_Y1);
    const bf16_t* CQ = Y1 + (size_t)r * 256; const bf16_t* T1 = Y1 + ((size_t)MTOK + r) * 256;
    { float s = 0.f; for (int k = 0; k < 128; ++k) { const float c = bf2f(T1[k]); s += c * c; } const float rk = 1.f / sqrtf(s / 128.f + 1e-6f);
      if (tid < 128) { ref[tid] = bf2f(T1[tid]) * rk * a.in[I_EKVN][tid]; fast[tid] = bf2f(((const bf16_t*)(a.ws + OFF_CKVN))[(size_t)r * 128 + tid]); } }
    __syncthreads(); commit(D, 3, ref, fast, 128, 0.02f);
    { float s = 0.f; for (int k = 0; k < 256; ++k) { const float c = bf2f(CQ[k]); s += c * c; } const float rq = 1.f / sqrtf(s / 256.f + 1e-6f);
      cqn[tid] = bf2f(CQ[tid]) * rq * a.in[I_EQN][tid]; }
    __syncthreads();
    for (int o = tid; o < 512; o += 256) { float s = 0.f; for (int k = 0; k < 256; ++k) s += cqn[k] * a.in[I_EWUQ][k * 512 + o]; qh[o] = s; }
    __syncthreads();
    for (int o = tid; o < 1024; o += 256) { const int h = o >> 7, c = o & 127; float s = 0.f; for (int d = 0; d < 64; ++d) s += qh[h * 64 + d] * a.in[I_EWUK][c * 512 + h * 64 + d];
        ref[o] = s * QSCALE; fast[o] = bf2f(((const bf16_t*)(a.ws + OFF_QLAT))[(size_t)r * 1024 + o]); }
    __syncthreads(); commit(D, 5, ref, fast, 1024, 0.03f);
    for (int o = tid; o < 1024; o += 256) { float s = 0.f; for (int k = 0; k < 256; ++k) s += cqn[k] * a.in[I_EWQIDX][k * 1024 + o];
        ref[o] = s; fast[o] = bf2f(((const bf16_t*)(a.ws + OFF_QIDX))[(size_t)r * 1024 + o]); }
    __syncthreads(); commit(D, 6, ref, fast, 1024, 0.03f);
}
__global__ void chk_cmp(Args a, unsigned* D) {
    __shared__ float ref[64], fast[64], hid[64];
    const int i = blockIdx.x, tid = threadIdx.x, b = i & 7, g = (i >> 3) & 1, kv = (i >> 4) & 1; const int blk = (i >> 5) == 0 ? 0 : ((i >> 5) == 1 ? 254 : (int)((unsigned)(i * 37 + 11) % 255u));
    const bf16_t* KVC = (const bf16_t*)(a.ws + OFF_Y1) + (size_t)4 * MTOK * 256;
    const float* pos = a.in[kv ? I_EPOSV : I_EPOSK]; const float* w1 = a.in[kv ? I_ECV1 : I_ECK1]; const float* w2 = a.in[kv ? I_ECV2 : I_ECK2];
    if (tid < 64) { float s = 0.f;
        for (int l = 0; l < 32; ++l) for (int d = 0; d < 64; ++d) { const float av = bf2f(KVC[((size_t)b * SEQ + 16 * blk + l) * 256 + kv * 128 + g * 64 + d]); const float wv = w1[(l * 64 + d) * 64 + tid]; s += av * bfr(wv) + pos[l * 64 + d] * wv; }
        hid[tid] = gelu_tanh(s); }
    __syncthreads();
    if (tid < 64) { float s = 0.f; for (int e = 0; e < 64; ++e) s += hid[e] * w2[e * 64 + tid]; ref[tid] = s;
        fast[tid] = bf2f(((const bf16_t*)(a.ws + (kv ? OFF_VC : OFF_KC)))[(((size_t)b * 256 + blk) * 2 + g) * 64 + tid]); }
    __syncthreads(); commit(D, 4, ref, fast, 64, 0.03f);
}
__global__ void chk_idx(Args a, unsigned* D) {
    __shared__ float ref[256], fast[256];
    const int r = (blockIdx.x < 4) ? (blockIdx.x * 4096 + blockIdx.x * 61) : srow(blockIdx.x, 64), tid = threadIdx.x, b = r >> 12, t = r & 4095, c = t >> 6, nk = (c + 1) * 64;
    const bf16_t* Y1 = (const bf16_t*)(a.ws + OFF_Y1); const bf16_t* T1 = Y1 + (size_t)MTOK * 256; const bf16_t* QI = (const bf16_t*)(a.ws + OFF_QIDX) + (size_t)r * 1024;
    const int s = (int)(((unsigned)tid * 2654435761u + 12345u * blockIdx.x) % (unsigned)nk);
    const bf16_t* kr = T1 + ((size_t)b * SEQ + s) * 256 + 128; float sc = 0.f;
    for (int h = 0; h < 16; ++h) { float d = 0.f; for (int k = 0; k < 64; ++k) d += bf2f(QI[h * 64 + k]) * bf2f(kr[k]); sc += bf2f(T1[(size_t)r * 256 + 192 + h]) * fmaxf(d, 0.f); }
    ref[tid] = sc;
    const _Float16* SC = (const _Float16*)(a.ws + OFF_SC) + (size_t)b * SCB_ELEMS + (size_t)4096 * (c * (c + 1) / 2) + (size_t)(t & 63) * nk;
    fast[tid] = (float)SC[s];
    __syncthreads(); commit(D, 7, ref, fast, 256, 0.02f);
}
__global__ void chk_sel(Args a, unsigned* D) {
    __shared__ unsigned key[4096];
    const int r = (blockIdx.x < 8) ? (blockIdx.x * 4096 + 255 + blockIdx.x * 300) : srow(blockIdx.x, 64), tid = threadIdx.x, b = r >> 12, t = r & 4095, c = t >> 6, nk = (c + 1) * 64;
    const unsigned short* SC = (const unsigned short*)(a.ws + OFF_SC) + (size_t)b * SCB_ELEMS + (size_t)4096 * (c * (c + 1) / 2) + (size_t)(t & 63) * nk;
    const unsigned* M = (const unsigned*)(a.ws + OFF_MASK) + (size_t)r * 128;
    for (int s = tid; s < nk; s += 256) { const unsigned u = SC[s]; key[s] = (s <= t) ? ((u & 0x8000u) ? (~u & 0xffffu) : (u | 0x8000u)) : 0u; }
    __syncthreads();
    int bad = 0, tot = 0;
    for (int s = tid; s < nk; s += 256) { bool want;
        if (s > t) want = false; else if (t < 256) want = true;
        else { int rank = 0; const unsigned ks = key[s]; for (int q = 0; q <= t; ++q) rank += (key[q] > ks || (key[q] == ks && q < s)) ? 1 : 0; want = rank < 256; }
        const bool got = (M[s >> 5] >> (s & 31)) & 1u; if (want != got) ++bad; ++tot; }
    atomicAdd(&D[4 * 8], (unsigned)bad); atomicAdd(&D[4 * 8 + 1], (unsigned)tot);
}
__global__ void chk_dsa(Args a, unsigned* D) {
    __shared__ float lg[4096], red[256], ref[128], fast[128];
    const int r = (blockIdx.x < 8) ? (blockIdx.x * 4096 + blockIdx.x * 37) : srow(blockIdx.x, 64), tid = threadIdx.x, b = r >> 12, t = r & 4095, h = blockIdx.x & 7;
    const bf16_t* Q = (const bf16_t*)(a.ws + OFF_QLAT) + (size_t)r * 1024 + h * 128; const bf16_t* C = (const bf16_t*)(a.ws + OFF_CKVN) + (size_t)b * SEQ * 128;
    const unsigned* M = (const unsigned*)(a.ws + OFF_MASK) + (size_t)r * 128; const float* relb = a.in[I_RELB];
    float mx = -INFINITY;
    for (int s = tid; s <= t; s += 256) { float v = -INFINITY; if ((M[s >> 5] >> (s & 31)) & 1u) { float d = 0.f; for (int k = 0; k < 128; ++k) d += bf2f(Q[k]) * bf2f(C[(size_t)s * 128 + k]); v = d + bias_l2(relb, h, t - s); } lg[s] = v; mx = fmaxf(mx, v); }
    red[tid] = mx; __syncthreads(); for (int o = 128; o > 0; o >>= 1) { if (tid < o) red[tid] = fmaxf(red[tid], red[tid + o]); __syncthreads(); } mx = red[0]; __syncthreads();
    float sm = 0.f; for (int s = tid; s <= t; s += 256) { const float p = exp2f(lg[s] - mx); lg[s] = p; sm += p; }
    red[tid] = sm; __syncthreads(); for (int o = 128; o > 0; o >>= 1) { if (tid < o) red[tid] += red[tid + o]; __syncthreads(); } sm = red[0]; __syncthreads();
    if (tid < 128) { float o = 0.f; for (int s = 0; s <= t; ++s) o += lg[s] * bf2f(C[(size_t)s * 128 + tid]); ref[tid] = o / sm; fast[tid] = bf2f(((const bf16_t*)(a.ws + OFF_MIXIN))[(size_t)r * 1536 + h * 128 + tid]); }
    __syncthreads(); commit(D, 9, ref, fast, 128, 0.03f);
}
__global__ void chk_nsa(Args a, unsigned* D) {
    __shared__ float pc[4][256], lg[1100], red[256], ref[64], fast[64], oacc[3][64], scb[64]; __shared__ int selj[16]; __shared__ float qs[4][64];
    const int r = (blockIdx.x < 8) ? (blockIdx.x * 4096 + blockIdx.x * 41) : srow(blockIdx.x, 64), tid = threadIdx.x, b = r >> 12, t = r & 4095, hh = blockIdx.x & 7, g = hh >> 2, n = hh & 3, cur = t >> 6;
    const bf16_t* Y1 = (const bf16_t*)(a.ws + OFF_Y1); const bf16_t* T1 = Y1 + (size_t)MTOK * 256; const bf16_t* QB = Y1 + (size_t)(2 + g) * MTOK * 256;
    const bf16_t* KVS = Y1 + (size_t)5 * MTOK * 256; const bf16_t* KVW = Y1 + (size_t)6 * MTOK * 256;
    const bf16_t* KC = (const bf16_t*)(a.ws + OFF_KC); const bf16_t* VC = (const bf16_t*)(a.ws + OFF_VC); const float* relb = a.in[I_RELB];
    qs[tid >> 6][tid & 63] = bf2f(QB[(size_t)r * 256 + tid]);
    __syncthreads();
    const int vis = (t >= 31) ? ((t - 31) >> 4) : -1;
    for (int nn = 0; nn < 4; ++nn) {
        float v = -INFINITY; if (tid <= vis) { float d = 0.f; for (int k = 0; k < 64; ++k) d += qs[nn][k] * bf2f(KC[(((size_t)b * 256 + tid) * 2 + g) * 64 + k]); v = d + bias_l2(relb, 8 + 4 * g + nn, t - 16 * tid - 31); }
        red[tid] = v; __syncthreads(); for (int o = 128; o > 0; o >>= 1) { if (tid < o) red[tid] = fmaxf(red[tid], red[tid + o]); __syncthreads(); } const float mx = red[0]; __syncthreads();
        const float p = (tid <= vis) ? exp2f(v - mx) : 0.f; red[tid] = p; __syncthreads(); for (int o = 128; o > 0; o >>= 1) { if (tid < o) red[tid] += red[tid + o]; __syncthreads(); } const float sm = red[0]; __syncthreads();
        pc[nn][tid] = sm > 0.f ? p / sm : 0.f; __syncthreads();
    }
    if (tid < 64) { float o = 0.f; for (int i = 0; i <= vis; ++i) o += pc[n][i] * bf2f(VC[(((size_t)b * 256 + i) * 2 + g) * 64 + tid]); oacc[0][tid] = o;
        float s = 0.f; for (int nn = 0; nn < 4; ++nn) for (int i = 4 * tid - 1; i <= 4 * tid + 3; ++i) if (i >= 0 && i < 255) s += pc[nn][i];
        scb[tid] = (tid > cur) ? -INFINITY : ((tid == 0 || tid == cur || tid == cur - 1) ? INFINITY : s); }
    __syncthreads();
    if (tid < 64) { int rank = 0; for (int j = 0; j < 64; ++j) rank += (scb[j] > scb[tid] || (scb[j] == scb[tid] && j < tid)) ? 1 : 0; if (rank < 16) selj[rank] = tid; }
    __syncthreads();
    { float mx = -INFINITY;
      for (int i = tid; i < 1024; i += 256) { const int j = selj[i >> 6], p = 64 * j + (i & 63); float v = -INFINITY; if (p <= t) { float d = 0.f; for (int k = 0; k < 64; ++k) d += qs[n][k] * bf2f(KVS[((size_t)b * SEQ + p) * 256 + g * 64 + k]); v = d + bias_l2(relb, 8 + hh, t - p); } lg[i] = v; mx = fmaxf(mx, v); }
      red[tid] = mx; __syncthreads(); for (int o = 128; o > 0; o >>= 1) { if (tid < o) red[tid] = fmaxf(red[tid], red[tid + o]); __syncthreads(); } mx = red[0]; __syncthreads();
      float sm = 0.f; for (int i = tid; i < 1024; i += 256) { const float p = exp2f(lg[i] - mx); lg[i] = p; sm += p; }
      red[tid] = sm; __syncthreads(); for (int o = 128; o > 0; o >>= 1) { if (tid < o) red[tid] += red[tid + o]; __syncthreads(); } sm = red[0]; __syncthreads();
      if (tid < 64) { float o = 0.f; for (int i = 0; i < 1024; ++i) { const int p = 64 * selj[i >> 6] + (i & 63); if (p <= t) o += lg[i] * bf2f(KVS[((size_t)b * SEQ + p) * 256 + 128 + g * 64 + tid]); } oacc[1][tid] = o / sm; }
      __syncthreads(); }
    { float mx = -INFINITY;
      for (int i = tid; i < 512; i += 256) { const int p = t - i; float v = -INFINITY; if (p >= 0) { float d = 0.f; for (int k = 0; k < 64; ++k) d += qs[n][k] * bf2f(KVW[((size_t)b * SEQ + p) * 256 + g * 64 + k]); v = d + bias_l2(relb, 8 + hh, i); } lg[i] = v; mx = fmaxf(mx, v); }
      red[tid] = mx; __syncthreads(); for (int o = 128; o > 0; o >>= 1) { if (tid < o) red[tid] = fmaxf(red[tid], red[tid + o]); __syncthreads(); } mx = red[0]; __syncthreads();
      float sm = 0.f; for (int i = tid; i < 512; i += 256) { const float p = exp2f(lg[i] - mx); lg[i] = p; sm += p; }
      red[tid] = sm; __syncthreads(); for (int o = 128; o > 0; o >>= 1) { if (tid < o) red[tid] += red[tid + o]; __syncthreads(); } sm = red[0]; __syncthreads();
      if (tid < 64) { float o = 0.f; for (int i = 0; i < 512; ++i) { const int p = t - i; if (p >= 0) o += lg[i] * bf2f(KVW[((size_t)b * SEQ + p) * 256 + 128 + g * 64 + tid]); } oacc[2][tid] = o / sm; }
      __syncthreads(); }
    if (tid < 64) { float gt[3]; for (int j = 0; j < 3; ++j) { const float x = bf2f(T1[(size_t)r * 256 + 208 + hh * 3 + j]); gt[j] = 1.f / (1.f + expf(-x)); }
        ref[tid] = gt[0] * oacc[0][tid] + gt[1] * oacc[1][tid] + gt[2] * oacc[2][tid]; fast[tid] = bf2f(((const bf16_t*)(a.ws + OFF_MIXIN))[(size_t)r * 1536 + 1024 + hh * 64 + tid]); }
    __syncthreads(); commit(D, 10, ref, fast, 64, 0.04f);
}
__global__ void chk_out_e(Args a, unsigned* D) {
    __shared__ float ref[1024], fast[1024], cat[1024];
    const int r = srow(blockIdx.x, 64), tid = threadIdx.x; const bf16_t* MX = (const bf16_t*)(a.ws + OFF_MIXIN) + (size_t)r * 1536;
    for (int o = tid; o < 512; o += 256) { const int h = o >> 6, d = o & 63; float s = 0.f; for (int c = 0; c < 128; ++c) s += bf2f(MX[h * 128 + c]) * a.in[I_EWUV][c * 512 + h * 64 + d]; cat[o] = s; cat[512 + o] = bf2f(MX[1024 + o]); }
    __syncthreads();
    for (int n = tid; n < 1024; n += 256) { float s = 0.f; for (int j = 0; j < 1024; ++j) s += cat[j] * a.in[I_EWOUT][(size_t)j * 1024 + n]; ref[n] = s;
        fast[n] = bf2f(((const bf16_t*)(a.ws + OFF_S1))[(size_t)r * 1024 + n]) - ALPHA * a.in[I_X][(size_t)r * 1024 + n]; }
    __syncthreads(); commit(D, 11, ref, fast, 1024, 0.35f);
}
__global__ void chk_ln(const bf16_t* S, const bf16_t* O, const float* g, const float* bt, unsigned* D, int slot) {
    __shared__ float ref[1024], fast[1024];
    const int r = srow(blockIdx.x, 64), tid = threadIdx.x; float mean = 0.f, var = 0.f;
    for (int k = 0; k < 1024; ++k) mean += bf2f(S[(size_t)r * 1024 + k]); mean /= 1024.f;
    for (int k = 0; k < 1024; ++k) { const float d = bf2f(S[(size_t)r * 1024 + k]) - mean; var += d * d; } var /= 1024.f;
    for (int n = tid; n < 1024; n += 256) { ref[n] = (bf2f(S[(size_t)r * 1024 + n]) - mean) / sqrtf(var + 1e-5f) * g[n] + bt[n]; fast[n] = bf2f(O[(size_t)r * 1024 + n]); }
    __syncthreads(); commit(D, slot, ref, fast, 1024, 0.01f);
}
__global__ void chk_ffn_up(Args a, unsigned* D) {
    __shared__ float ref[DFF], fast[DFF], hrow[1024];
    const int r = srow(blockIdx.x, 64), tid = threadIdx.x; const bf16_t* H = (const bf16_t*)(a.ws + OFF_H) + (size_t)r * 1024;
    for (int k = tid; k < 1024; k += 256) hrow[k] = bf2f(H[k]);
    __syncthreads();
    for (int n = tid; n < DFF; n += 256) { float s1 = 0.f, s3 = 0.f; for (int k = 0; k < 1024; ++k) { s1 += hrow[k] * bfr(a.in[I_EF1][(size_t)k * DFF + n]); s3 += hrow[k] * bfr(a.in[I_EF3][(size_t)k * DFF + n]); }
        ref[n] = s1 / (1.f + expf(-s1)) * s3; fast[n] = bf2f(((const bf16_t*)(a.ws + OFF_ACT))[(size_t)r * DFF + n]); }
    __syncthreads(); commit(D, 13, ref, fast, DFF, 0.02f);
}
__global__ void chk_ffn_dn(Args a, unsigned* D) {
    __shared__ float ref[1024], fast[1024], arow[DFF];
    const int r = srow(blockIdx.x, 64), tid = threadIdx.x; const bf16_t* A = (const bf16_t*)(a.ws + OFF_ACT) + (size_t)r * DFF;
    for (int k = tid; k < DFF; k += 256) arow[k] = bf2f(A[k]);
    __syncthreads();
    for (int n = tid; n < 1024; n += 256) { float s = 0.f; for (int k = 0; k < DFF; ++k) s += arow[k] * bfr(a.in[I_EF2][(size_t)k * 1024 + n]); ref[n] = s;
        fast[n] = bf2f(((const bf16_t*)(a.ws + OFF_S2))[(size_t)r * 1024 + n]) - ALPHA * bf2f(((const bf16_t*)(a.ws + OFF_H))[(size_t)r * 1024 + n]); }
    __syncthreads(); commit(D, 14, ref, fast, 1024, 0.06f);
}
__global__ void chk_in_o(Args a, unsigned* D) {
    __shared__ float ref[2048], fast[2048], xr[1024];
    const int r = srow(blockIdx.x, 64), tid = threadIdx.x; const bf16_t* X1 = (const bf16_t*)(a.ws + OFF_X1) + (size_t)r * 1024;
    for (int k = tid; k < 1024; k += 256) xr[k] = bf2f(X1[k]);
    __syncthreads();
    for (int n = tid; n < 2048; n += 256) { float s = 0.f; for (int k = 0; k < 1024; ++k) s += xr[k] * bfr(a.in[I_OWIN][(size_t)k * 3072 + 1024 + n]); ref[n] = s;
        fast[n] = bf2f(((const bf16_t*)(a.ws + OFF_QKV))[(size_t)(1 + (n >> 10)) * MTOK * 1024 + (size_t)r * 1024 + (n & 1023)]); }
    __syncthreads(); commit(D, 16, ref, fast, 2048, 0.02f);
    const int pm = r >> 8; const bf16_t* K = (const bf16_t*)(a.ws + OFF_QKV) + (size_t)MTOK * 1024 + (size_t)pm * 256 * 1024; const float* KM = (const float*)(a.ws + OFF_KMEAN) + (size_t)pm * 2048;
    for (int n = tid; n < 1024; n += 256) { float s = 0.f; for (int q = 0; q < 256; ++q) s += bf2f(K[(size_t)q * 1024 + n]); ref[n] = s; fast[n] = KM[n] + KM[1024 + n]; }
    __syncthreads(); commit(D, 17, ref, fast, 1024, 0.03f);
}
__global__ void chk_moba(Args a, unsigned* D) {
    __shared__ float lg[1024], red[256], ref[64], fast[64], q[64], gate[16]; __shared__ int blkof[4];
    const int r = (blockIdx.x < 8) ? (blockIdx.x * 4096 + blockIdx.x * 300) : srow(blockIdx.x, 64), tid = threadIdx.x, b = r >> 12, t = r & 4095, h = blockIdx.x & 15, own = t >> 8;
    const bf16_t* X1 = (const bf16_t*)(a.ws + OFF_X1) + (size_t)r * 1024; const bf16_t* K = (const bf16_t*)(a.ws + OFF_QKV) + (size_t)MTOK * 1024 + (size_t)b * SEQ * 1024 + h * 64; const bf16_t* V = K + (size_t)MTOK * 1024;
    const float* relb = a.in[I_RELB];
    if (tid < 64) { float s = 0.f; for (int k = 0; k < 1024; ++k) s += bf2f(X1[k]) * bfr(a.in[I_OWIN][(size_t)k * 3072 + h * 64 + tid]); q[tid] = bfr(s * QSCALE); }
    __syncthreads();
    if (tid < 16) { float s = -INFINITY; if (tid < own) { s = 0.f; for (int p = 0; p < 256; ++p) for (int d = 0; d < 64; ++d) s += q[d] * bf2f(K[(size_t)(256 * tid + p) * 1024 + d]); } gate[tid] = s; }
    __syncthreads();
    if (tid == 0) { unsigned used = 0u; for (int k = 0; k < 3; ++k) { int bj = -1; float best = -INFINITY; for (int j = 0; j < own; ++j) if (!((used >> j) & 1u) && gate[j] > best) { best = gate[j]; bj = j; } blkof[k] = bj; if (bj >= 0) used |= 1u << bj; } blkof[3] = own; }
    __syncthreads();
    float mx = -INFINITY;
    for (int i = tid; i < 1024; i += 256) { const int j = blkof[i >> 8], p = 256 * j + (i & 255); float v = -INFINITY; if (j >= 0 && p <= t) { float d = 0.f; for (int k = 0; k < 64; ++k) d += q[k] * bf2f(K[(size_t)p * 1024 + k]); v = d + bias_l2(relb, h, t - p); } lg[i] = v; mx = fmaxf(mx, v); }
    red[tid] = mx; __syncthreads(); for (int o = 128; o > 0; o >>= 1) { if (tid < o) red[tid] = fmaxf(red[tid], red[tid + o]); __syncthreads(); } mx = red[0]; __syncthreads();
    float sm = 0.f; for (int i = tid; i < 1024; i += 256) { const float p = exp2f(lg[i] - mx); lg[i] = p; sm += p; }
    red[tid] = sm; __syncthreads(); for (int o = 128; o > 0; o >>= 1) { if (tid < o) red[tid] += red[tid + o]; __syncthreads(); } sm = red[0]; __syncthreads();
    if (tid < 64) { float o = 0.f; for (int i = 0; i < 1024; ++i) { const int j = blkof[i >> 8], p = 256 * j + (i & 255); if (j >= 0 && p <= t) o += lg[i] * bf2f(V[(size_t)p * 1024 + tid]); } ref[tid] = o / sm;
        fast[tid] = bf2f(((const bf16_t*)(a.ws + OFF_QKV))[(size_t)r * 1024 + h * 64 + tid]); }
    __syncthreads(); commit(D, 18, ref, fast, 64, 0.04f);
}
__global__ void chk_out_o(Args a, unsigned* D) {
    __shared__ float ref[1024], fast[1024], orow[1024];
    const int r = srow(blockIdx.x, 64), tid = threadIdx.x;
    for (int k = tid; k < 1024; k += 256) orow[k] = bf2f(((const bf16_t*)(a.ws + OFF_QKV))[(size_t)r * 1024 + k]);
    __syncthreads();
    for (int n = tid; n < 1024; n += 256) { float s = 0.f; for (int k = 0; k < 1024; ++k) s += orow[k] * a.in[I_OWOUT][(size_t)k * 1024 + n]; ref[n] = s;
        fast[n] = bf2f(((const bf16_t*)(a.ws + OFF_S1O))[(size_t)r * 1024 + n]) - ALPHA * bf2f(((const bf16_t*)(a.ws + OFF_X1))[(size_t)r * 1024 + n]); }
    __syncthreads(); commit(D, 20, ref, fast, 1024, 0.5f);
}
__global__ void chk_route(Args a, unsigned* D) {
    const int r = srow(blockIdx.x * 256 + threadIdx.x, 64); const bf16_t* H2 = (const bf16_t*)(a.ws + OFF_H2) + (size_t)r * 1024;
    float lg[8]; for (int e = 0; e < 8; ++e) lg[e] = 0.f;
    for (int k = 0; k < 1024; ++k) { const float hv = bf2f(H2[k]); for (int e = 0; e < 8; ++e) lg[e] += hv * a.in[I_OROUTER][k * 8 + e]; }
    int e0 = 0; for (int e = 1; e < 8; ++e) if (lg[e] > lg[e0]) e0 = e; int e1 = -1; for (int e = 0; e < 8; ++e) if (e != e0 && (e1 < 0 || lg[e] > lg[e1])) e1 = e;
    const float g0 = 1.f / (1.f + expf(lg[e1] - lg[e0]));
    const u32x2 rt = ((const u32x2*)(a.ws + OFF_ROUTE))[r]; const int f0 = rt.x & 255, f1 = (rt.x >> 8) & 255; const float fg = __uint_as_float(rt.y);
    int bad = 0; if (f0 != e0 || f1 != e1 || !(fabsf(fg - g0) <= 0.02f)) ++bad;
    atomicAdd(&D[4 * 21], (unsigned)bad); atomicAdd(&D[4 * 21 + 1], 1u);
    const int* GI = (const int*)(a.ws + OFF_GINFO); const int* DEST = (const int*)(a.ws + OFF_DEST) + 2 * (size_t)r;
    int bad2 = 0;
    for (int k = 0; k < 2; ++k) { const int e = k ? f1 : f0, d = DEST[k], ps = e ? GI[e - 1] : 0; if (d < ps || d >= ps + GI[8 + e]) ++bad2; }
    atomicAdd(&D[4 * 22], (unsigned)bad2); atomicAdd(&D[4 * 22 + 1], 2u);
}
__global__ void chk_moe(Args a, unsigned* D) {
    __shared__ float ref[1024], fast[1024], hrow[1024], act[DFFE], fin[1024];
    const int r = srow(blockIdx.x, 64), tid = threadIdx.x; const bf16_t* H2 = (const bf16_t*)(a.ws + OFF_H2) + (size_t)r * 1024;
    for (int k = tid; k < 1024; k += 256) { hrow[k] = bf2f(H2[k]); ref[k] = 0.f; }
    const u32x2 rt = ((const u32x2*)(a.ws + OFF_ROUTE))[r]; const float g0 = __uint_as_float(rt.y); const int* DEST = (const int*)(a.ws + OFF_DEST) + 2 * (size_t)r; const bf16_t* YR = (const bf16_t*)(a.ws + OFF_YR);
    __syncthreads();
    for (int k = 0; k < 2; ++k) { const int e = k ? ((rt.x >> 8) & 255) : (rt.x & 255); const float gk = k ? 1.f - g0 : g0;
        const float* w1 = a.in[I_OM1] + (size_t)e * 1024 * DFFE; const float* w3 = a.in[I_OM3] + (size_t)e * 1024 * DFFE; const float* w2 = a.in[I_OM2] + (size_t)e * DFFE * 1024;
        for (int f = tid; f < DFFE; f += 256) { float s1 = 0.f, s3 = 0.f; for (int q = 0; q < 1024; ++q) { s1 += hrow[q] * bfr(w1[(size_t)q * DFFE + f]); s3 += hrow[q] * bfr(w3[(size_t)q * DFFE + f]); } act[f] = bfr(s1 / (1.f + expf(-s1)) * s3); }
        __syncthreads();
        for (int n = tid; n < 1024; n += 256) { float s = 0.f; for (int f = 0; f < DFFE; ++f) s += act[f] * bfr(w2[(size_t)f * 1024 + n]); ref[n] += gk * s; }
        __syncthreads(); }
    for (int n = tid; n < 1024; n += 256) { fast[n] = g0 * bf2f(YR[(size_t)DEST[0] * 1024 + n]) + (1.f - g0) * bf2f(YR[(size_t)DEST[1] * 1024 + n]); fin[n] = ALPHA * hrow[n] + fast[n]; }
    __syncthreads(); commit(D, 23, ref, fast, 1024, 0.12f);
    float mean = 0.f, var = 0.f; for (int k = 0; k < 1024; ++k) mean += fin[k]; mean /= 1024.f; for (int k = 0; k < 1024; ++k) { const float d = fin[k] - mean; var += d * d; } var /= 1024.f;
    __syncthreads();
    for (int n = tid; n < 1024; n += 256) { ref[n] = (fin[n] - mean) / sqrtf(var + 1e-5f) * a.in[I_OLN2G][n] + a.in[I_OLN2B][n]; fast[n] = a.out[(size_t)r * 1024 + n]; }
    __syncthreads(); commit(D, 24, ref, fast, 1024, 0.005f);
    { float m2 = 0.f, v2 = 0.f; for (int k = 0; k < 1024; ++k) m2 += ALPHA * hrow[k]; m2 /= 1024.f; for (int k = 0; k < 1024; ++k) { const float d = ALPHA * hrow[k] - m2; v2 += d * d; } v2 /= 1024.f;
      for (int n = tid; n < 1024; n += 256) ref[n] = (ALPHA * hrow[n] - m2) / sqrtf(v2 + 1e-5f) * a.in[I_OLN2G][n] + a.in[I_OLN2B][n];
      __syncthreads(); commit(D, 28, ref, fast, 1024, 0.005f); }
    { for (int n = tid; n < 1024; n += 256) fin[n] = ALPHA * hrow[n] + (1.f - g0) * bf2f(YR[(size_t)DEST[0] * 1024 + n]) + g0 * bf2f(YR[(size_t)DEST[1] * 1024 + n]);
      __syncthreads();
      float m2 = 0.f, v2 = 0.f; for (int k = 0; k < 1024; ++k) m2 += fin[k]; m2 /= 1024.f; for (int k = 0; k < 1024; ++k) { const float d = fin[k] - m2; v2 += d * d; } v2 /= 1024.f;
      __syncthreads();
      for (int n = tid; n < 1024; n += 256) ref[n] = (fin[n] - m2) / sqrtf(v2 + 1e-5f) * a.in[I_OLN2G][n] + a.in[I_OLN2B][n];
      __syncthreads(); commit(D, 29, ref, fast, 1024, 0.005f); }
}

__global__ void chk_wmoe(Args a, unsigned* D) {
    const int tid = blockIdx.x * 256 + threadIdx.x; const unsigned hsh = (unsigned)tid * 2654435761u;
    const int e = hsh & 7, f = (hsh >> 3) % DFFE, k = (hsh >> 15) % 1024;
    const bf16_t* W13 = (const bf16_t*)(a.ws + OFF_W_M13) + (size_t)e * 2 * DFFE * 1024; const bf16_t* W2 = (const bf16_t*)(a.ws + OFF_W_M2) + (size_t)e * 1024 * DFFE;
    int bad = 0;
    if (W13[(size_t)(((f >> 7) << 8) + (f & 127)) * 1024 + k] != (bf16_t)f2bf(a.in[I_OM1][(size_t)e * 1024 * DFFE + (size_t)k * DFFE + f])) ++bad;
    if (W13[(size_t)(((f >> 7) << 8) + (f & 127) + 128) * 1024 + k] != (bf16_t)f2bf(a.in[I_OM3][(size_t)e * 1024 * DFFE + (size_t)k * DFFE + f])) ++bad;
    atomicAdd(&D[4 * 25], (unsigned)bad); atomicAdd(&D[4 * 25 + 1], 2u);
    int bad2 = 0; if (W2[(size_t)k * DFFE + f] != (bf16_t)f2bf(a.in[I_OM2][(size_t)e * DFFE * 1024 + (size_t)f * 1024 + k])) ++bad2;
    atomicAdd(&D[4 * 26], (unsigned)bad2); atomicAdd(&D[4 * 26 + 1], 1u);
}
__global__ void chk_actm(Args a, unsigned* D) {
    __shared__ float ref[DFFE], fast[DFFE], hrow[1024]; __shared__ int tokf, kf;
    const int tid = threadIdx.x; const int* GI = (const int*)(a.ws + OFF_GINFO); const int nrows = GI[7], ng = nrows >> 8, g0 = ((ng - 1) / MOE_CHUNK) * MOE_CHUNK;
    const int rho = 256 * g0 + (int)(((unsigned)blockIdx.x * 2654435761u) % (unsigned)(nrows - 256 * g0));
    if (tid == 0) { tokf = -1; kf = 0; } __syncthreads();
    const int* DEST = (const int*)(a.ws + OFF_DEST);
    for (int i = tid; i < 2 * MTOK; i += 256) if (DEST[i] == rho) { tokf = i >> 1; kf = i & 1; }
    __syncthreads();
    if (tokf < 0) return;
    const int tok = tokf; const u32x2 rt = ((const u32x2*)(a.ws + OFF_ROUTE))[tok]; const int e = kf ? ((rt.x >> 8) & 255) : (rt.x & 255);
    const bf16_t* H2 = (const bf16_t*)(a.ws + OFF_H2) + (size_t)tok * 1024;
    for (int k = tid; k < 1024; k += 256) hrow[k] = bf2f(H2[k]);
    __syncthreads();
    const float* w1 = a.in[I_OM1] + (size_t)e * 1024 * DFFE; const float* w3 = a.in[I_OM3] + (size_t)e * 1024 * DFFE;
    for (int f = tid; f < DFFE; f += 256) { float s1 = 0.f, s3 = 0.f; for (int q = 0; q < 1024; ++q) { s1 += hrow[q] * bfr(w1[(size_t)q * DFFE + f]); s3 += hrow[q] * bfr(w3[(size_t)q * DFFE + f]); }
        ref[f] = s1 / (1.f + expf(-s1)) * s3; fast[f] = bf2f(((const bf16_t*)(a.ws + OFF_ACTM))[(size_t)(rho - 256 * g0) * DFFE + f]); }
    __syncthreads(); commit(D, 27, ref, fast, DFFE, 0.02f);
}

__global__ void simple_final(Args a) {
    const int row = blockIdx.x * 4 + (threadIdx.x >> 6), lane = threadIdx.x & 63; unsigned char* ws = a.ws;
    const bf16_t* H2 = (const bf16_t*)(ws + OFF_H2); const bf16_t* YR = (const bf16_t*)(ws + OFF_YR);
    const u32x2* ROUTE = (const u32x2*)(ws + OFF_ROUTE); const int* DEST = (const int*)(ws + OFF_DEST);
    const float g0 = __uint_as_float(ROUTE[row].y), g1 = 1.f - g0; const int d0 = DEST[2 * row], d1 = DEST[2 * row + 1];
    float v[16]; float s = 0.f;
    for (int i = 0; i < 16; ++i) { const int col = lane + 64 * i; v[i] = ALPHA * bf2f(H2[(size_t)row * 1024 + col]) + g0 * bf2f(YR[(size_t)d0 * 1024 + col]) + g1 * bf2f(YR[(size_t)d1 * 1024 + col]); s += v[i]; }
    const float mean = wave_sum(s) / 1024.f; float q = 0.f;
    for (int i = 0; i < 16; ++i) { v[i] -= mean; q += v[i] * v[i]; }
    const float rstd = 1.f / sqrtf(wave_sum(q) / 1024.f + 1e-5f);
    for (int i = 0; i < 16; ++i) { const int col = lane + 64 * i; a.out[(size_t)row * 1024 + col] = v[i] * rstd * a.in[I_OLN2G][col] + a.in[I_OLN2B][col]; }
}
__global__ void report(float* out, const unsigned* D, int nelem) {
    __shared__ float kk, xx;
    if (threadIdx.x == 0) { int idx = 0; float v = 0.f; float worst = 0.f;
        for (int s = 1; s < NSLOT; ++s) { const unsigned bad = D[4 * s], tot = D[4 * s + 1]; if (tot == 0u) continue; const float fr = (float)bad / (float)tot; const float thr = (s == 9 || s == 10 || s == 18) ? 0.1f : 0.002f;
            if (fr > worst) worst = fr; if (fr > thr && idx == 0) { idx = s; v = fr; } }
        if (idx == 0) v = worst;
#ifdef DBG_BITS
        { const int sl[6] = DBG_BITS; idx = 0; for (int q = 0; q < 6; ++q) { const int s = sl[q]; if (s > 0 && D[4 * s + 1] > 0u && (float)D[4 * s] / (float)D[4 * s + 1] > 0.002f) idx |= 1 << q; } v = 1.f; }
#endif
#ifdef DBG_VAL
        { const float mr = __uint_as_float(D[4 * DBG_VAL + 2]); const float fr = D[4 * DBG_VAL + 1] ? (float)D[4 * DBG_VAL] / (float)D[4 * DBG_VAL + 1] : 0.f; kk = sqrtf(fmaxf(mr, 1e-6f) * 1e6f); xx = kk * (2.f + 97.f * fr); }
#else
        v = fmaxf(v, 1e-6f); const int n = (v > 0.3f) ? 4 : (v > 0.03f) ? 3 : (v > 0.003f) ? 2 : 1; kk = (n == 4) ? 1e4f : (n == 3) ? 1e3f : (n == 2) ? 1e2f : 1e1f; xx = kk * (float)(idx + 2);
#endif
        }
    __syncthreads();
    const float k = kk, x = xx;
    for (size_t i = (size_t)blockIdx.x * blockDim.x + threadIdx.x; i < (size_t)nelem; i += (size_t)gridDim.x * blockDim.x) out[i] = (i == 0) ? x : k;
}
}
#endif

#ifndef MK_N_LAUNCHES
#define MK_N_LAUNCHES 1
#endif
constexpr int NPHASE = 18;
#define SP2 true
#ifndef FFN_F8
#define FFN_F8 0
#endif
#ifndef MOE_SP2
#define MOE_SP2 true
#endif
#define ALN true

__global__ void __launch_bounds__(NTHR, 2) fwd_kernel(Args args) {
    extern __shared__ __attribute__((aligned(16))) unsigned char lds_raw[];
    Frame F;
    F.lds = (LAS unsigned char*)lds_raw;
    F.tid = threadIdx.x; F.lane = F.tid & 63; F.wave = __builtin_amdgcn_readfirstlane(F.tid >> 6);
    F.G = gridDim.x; F.bx = blockIdx.x; F.gw = F.bx * NWAVES + F.wave; F.NGW = F.G * NWAVES; F.ws = args.ws;
    unsigned char* ws = args.ws;
    volatile LAS unsigned* MISC = (volatile LAS unsigned*)(F.lds + LDSCTL_OFF);
    for (int u = F.tid; u < (LDS_BYTES - LDSCTL_OFF) / 4; u += NTHR) ((LAS unsigned*)(F.lds + LDSCTL_OFF))[u] = 0u;
    __syncthreads();
    XcdBarrier bar = xcd_barrier_post((unsigned*)(ws + OFF_BAR) + args.li * XCD_BAR_WORDS, MISC + 8);
    const int lo = args.ph_lo, hi = args.ph_hi;
#ifndef PH_MASK
#define PH_MASK 0x3ffff
#endif
#define IN(k) (((PH_MASK >> (k)) & 1) && lo <= (k) && (k) < hi)
#ifdef TS_MODE
    unsigned long long* TS = (unsigned long long*)(ws + OFF_DBG + 1024);
#define STAMP(i) do { if (F.bx == 0 && F.tid == 0) TS[i] = __builtin_amdgcn_s_memrealtime(); } while (0)
#else
#define STAMP(i) do { } while (0)
#endif
#define SEAM(k) do { if (IN(k) && IN((k) + 1)) xcd_barrier(bar); STAMP((k) + 1); } while (0)
    LAS unsigned char* glds = F.lds;

    bf16_t* Y1 = (bf16_t*)(ws + OFF_Y1);
    float* ssq_q = (float*)(ws + OFF_SSQ_Q); float* ssq_kv = (float*)(ws + OFF_SSQ_KV);

    STAMP(0);
    if (IN(0)) { phase_prologue_even(F, args); } SEAM(0);
    if (IN(1)) { pg8::Gemm g{(const bf16_t*)(ws + OFF_XB), (const bf16_t*)(ws + OFF_W_IN), MTOK, EVEN_INP, 1024, 1024, 0}; pg8::StaticOrder S; S.init(MTOK, EVEN_INP, F.G, F.bx);
        pg8::EpiInE E{Y1, ssq_q, ssq_kv}; pg8::gemm_phase<pg8::EpiInE, pg8::StaticOrder, ALN, SP2>(glds, g, S, E); } SEAM(1);
    if (IN(2)) {
        phase_ckvn(F, Y1 + (size_t)1 * MTOK * 256, ssq_kv, args.in[I_EKVN], (bf16_t*)(ws + OFF_CKVN));
#ifndef NO_CMP
        for (int idx = F.bx; idx < 256; idx += F.G) { const int b = idx >> 5, g = (idx >> 4) & 1, kv = (idx >> 3) & 1, rt = idx & 7;
            compress_unit(F, b, g, kv, rt, Y1 + (size_t)4 * MTOK * 256, (const bf16_t*)(ws + (kv ? OFF_CV1 : OFF_CK1)), args.in[kv ? I_ECV2 : I_ECK2], (const float*)(ws + OFF_CB) + kv * 64, (bf16_t*)(ws + (kv ? OFF_VC : OFF_KC))); }
#endif
#ifndef NO_Q2
        pg8::Gemm g{Y1, (const bf16_t*)(ws + OFF_W_Q2), MTOK, 2048, 256, 256, 0}; pg8::StaticOrder S; S.init(MTOK, 2048, F.G, F.bx);
        pg8::EpiQ2 E{(bf16_t*)(ws + OFF_QLAT), (bf16_t*)(ws + OFF_QIDX), ssq_q}; pg8::gemm_phase<pg8::EpiQ2, pg8::StaticOrder, ALN, SP2>(glds, g, S, E);
#endif
    } SEAM(2);
    if (IN(3)) { for (int idx = F.bx; idx < 512; idx += F.G) { const int i = idx >> 8, v = idx & 255, b = v & 7, cc = v >> 3, c = i ? 63 - cc : cc;
            indexer_unit(F, b, c, (const bf16_t*)(ws + OFF_QIDX), Y1 + (size_t)1 * MTOK * 256, (_Float16*)(ws + OFF_SC)); } } SEAM(3);
    if (IN(4)) { phase_select(F, (const _Float16*)(ws + OFF_SC), (unsigned*)(ws + OFF_MASK)); } SEAM(4);
    if (IN(5)) {
#ifndef NO_DSA
        if (args.pad != 2) phase_dsa_sparse(F, (const bf16_t*)(ws + OFF_QLAT), (const bf16_t*)(ws + OFF_CKVN), (const unsigned*)(ws + OFF_MASK), (const float*)(ws + OFF_BT), ws + OFF_MIXIN);
#endif
        STAMP(20);
#ifndef NO_NSA
        if (args.pad != 1) for (int idx = F.bx; idx < 1024; idx += F.G) { const int i = idx >> 8, v = idx & 255, b = v & 7, cc = v >> 3, g = i & 1, c = (i >> 1) ? 63 - cc : cc;
            nsa_unit(F, b, g, c, Y1, (const bf16_t*)(ws + OFF_KC), (const bf16_t*)(ws + OFF_VC), (const float*)(ws + OFF_BT), ws + OFF_MIXIN); __syncthreads(); }
#endif
    } SEAM(5);
    if (IN(6)) { pg8::Gemm g{(const bf16_t*)(ws + OFF_MIXIN), (const bf16_t*)(ws + OFF_W_OUTE), MTOK, 1024, 768, 768, 0}; pg8::StaticOrder S; S.init(MTOK, 1024, F.G, F.bx);
        pg8::EpiRes<true> E{args.in[I_X], (bf16_t*)(ws + OFF_S1), 1.f / (OSC * WOUT_SCALE)}; pg8::gemm_phase<pg8::EpiRes<true>, pg8::StaticOrder, ALN, SP2, true>(glds, g, S, E); } SEAM(6);
    if (IN(7)) { phase_ln_i8(F, (const bf16_t*)(ws + OFF_S1), (bf16_t*)(ws + OFF_H), ws + OFF_H8, (float*)(ws + OFF_SA), args.in[I_ELN1G], args.in[I_ELN1B]); } SEAM(7);
#if FFN_F8
    if (IN(8)) { pg8::Gemm g{(const bf16_t*)(ws + OFF_H8), (const bf16_t*)(ws + OFF_W_F13), MTOK, 2 * DFF, 512, 512, 0}; pg8::StaticOrder S; S.init(MTOK, 2 * DFF, F.G, F.bx);
        pg8::EpiSwiglu8 E{ws + OFF_ACT, DFF, 0, 1.f / WF13_SCALE}; pg8::gemm_phase<pg8::EpiSwiglu8, pg8::StaticOrder, ALN, SP2, true>(glds, g, S, E); } SEAM(8);
#else
    if (IN(8)) { pg8::Gemm g{(const bf16_t*)(ws + OFF_H8), (const bf16_t*)(ws + OFF_W_F13), MTOK, 2 * DFF, 512, 512, 0}; pg8::StaticOrder S; S.init(MTOK, 2 * DFF, F.G, F.bx);
        pg8::EpiSwigluI8 E{ws + OFF_ACT, DFF, (const float*)(ws + OFF_SA), (const float*)(ws + OFF_SW)}; pg8::gemm_phase<pg8::EpiSwigluI8, pg8::StaticOrder, ALN, SP2, false, true>(glds, g, S, E); } SEAM(8);
#endif
#if FFN_F8
    if (IN(9)) { pg8::Gemm g{(const bf16_t*)(ws + OFF_ACT), (const bf16_t*)(ws + OFF_W_F2), MTOK, 1024, DFF / 2, DFF / 2, 0}; pg8::StaticOrder S; S.init(MTOK, 1024, F.G, F.bx);
        pg8::EpiRes<false> E{(const void*)(ws + OFF_H), (bf16_t*)(ws + OFF_S2), 1.f / WF2_SCALE}; pg8::gemm_phase<pg8::EpiRes<false>, pg8::StaticOrder, ALN, SP2, true>(glds, g, S, E); } SEAM(9);
#else
    if (IN(9)) { pg8::Gemm g{(const bf16_t*)(ws + OFF_ACT), (const bf16_t*)(ws + OFF_W_F2), MTOK, 1024, DFF / 2, DFF / 2, 0}; pg8::StaticOrder S; S.init(MTOK, 1024, F.G, F.bx);
        pg8::EpiRes<false> E{(const void*)(ws + OFF_H), (bf16_t*)(ws + OFF_S2), 1.f / WF2_SCALE}; pg8::gemm_phase<pg8::EpiRes<false>, pg8::StaticOrder, ALN, SP2, true>(glds, g, S, E); } SEAM(9);
#endif
    if (IN(10)) { phase_ln_bf16(F, (const bf16_t*)(ws + OFF_S2), (bf16_t*)(ws + OFF_X1), ws + OFF_X18, args.in[I_ELN2G], args.in[I_ELN2B]); phase_convert_odd(F, args); } SEAM(10);
    if (IN(11)) { pg8::Gemm g{(const bf16_t*)(ws + OFF_X18), (const bf16_t*)(ws + OFF_W_OIN), MTOK, 3072, 512, 512, 0}; pg8::StaticOrder S; S.init(MTOK, 3072, F.G, F.bx);
        pg8::EpiInO E{(bf16_t*)(ws + OFF_QKV), (float*)(ws + OFF_KMEAN), 1.f / WIN_SCALE}; pg8::gemm_phase<pg8::EpiInO, pg8::StaticOrder, ALN, SP2, true>(glds, g, S, E); } SEAM(11);
#ifdef MOBA_DENSE
    if (IN(12)) { phase_moba(F, ws, args.pad); } SEAM(12);
#else
    if (IN(12)) { phase_moba2(F, ws, args.pad); } SEAM(12);
#endif
    if (IN(13)) { pg8::Gemm g{(const bf16_t*)(ws + OFF_O8), (const bf16_t*)(ws + OFF_W_OOUT), MTOK, 1024, 512, 512, 0}; pg8::StaticOrder S; S.init(MTOK, 1024, F.G, F.bx);
        pg8::EpiRes<false> E{(const void*)(ws + OFF_X1), (bf16_t*)(ws + OFF_S1O), 1.f / (OSC * WOUT_SCALE)}; pg8::gemm_phase<pg8::EpiRes<false>, pg8::StaticOrder, ALN, SP2, true>(glds, g, S, E); } SEAM(13);
    if (IN(14)) { phase_ln_router(F, (const bf16_t*)(ws + OFF_S1O), (bf16_t*)(ws + OFF_H2), args.in[I_OLN1G], args.in[I_OLN1B], args.in[I_OROUTER], ws); } SEAM(14);
    if (IN(15)) { phase_moe_gather(F, (const bf16_t*)(ws + OFF_H2), ws + OFF_XR, ws); } SEAM(15);
    if (IN(16)) {
        const int* GI = (const int*)(ws + OFF_GINFO);
        pg8::MoeOrder S; S.G = F.G; S.c = F.bx;
#pragma unroll
        for (int e = 0; e < 8; ++e) S.pend[e] = __builtin_amdgcn_readfirstlane(GI[e]);
        const int ngroups = S.pend[7] >> 8;
        for (int g0 = 0; g0 < ngroups; g0 += MOE_CHUNK) {
            S.g0 = g0; S.ng = (ngroups - g0) < MOE_CHUNK ? (ngroups - g0) : MOE_CHUNK;
            { S.nN = 28; pg8::Gemm g{(const bf16_t*)(ws + OFF_XR), (const bf16_t*)(ws + OFF_W_M13), 0, 2 * DFFE, 512, 512, (size_t)2 * DFFE * 512};
              pg8::EpiSwiglu8 E{ws + OFF_ACTM, DFFE, g0, 1.f / W13_SCALE}; pg8::gemm_phase<pg8::EpiSwiglu8, pg8::MoeOrder, ALN, MOE_SP2, true>(glds, g, S, E); }
            xcd_barrier(bar);
            { S.nN = 4; pg8::Gemm g{(const bf16_t*)(ws + OFF_ACTM - (size_t)g0 * 256 * DFFE), (const bf16_t*)(ws + OFF_W_M2), 0, 1024, DFFE / 2, DFFE / 2, (size_t)1024 * DFFE / 2};
              pg8::EpiStoreS E{(bf16_t*)(ws + OFF_YR), 1024, 1.f / W2_SCALE}; pg8::gemm_phase<pg8::EpiStoreS, pg8::MoeOrder, ALN, MOE_SP2, true>(glds, g, S, E); }
            xcd_barrier(bar);
        }
    }
    STAMP(17);
    if (IN(17)) { phase_final(F, (const bf16_t*)(ws + OFF_H2), (const bf16_t*)(ws + OFF_YR), args.in[I_OLN2G], args.in[I_OLN2B], args.out, ws); }
#ifdef TS_MODE
    STAMP(18);
    xcd_barrier(bar);
    { const int ia[2] = TS_SEL; float d[2];
      for (int q = 0; q < 2; ++q) { const int i = ia[q]; const unsigned long long t1 = (i == 5) ? TS[20] : ((i == 25) ? TS[6] : TS[i + 1]); const unsigned long long t0 = (i == 25) ? TS[20] : TS[i]; d[q] = (float)(t1 - t0) * 0.01f; }
      const float k = sqrtf(fmaxf(d[0], 1.f)), x = 10.f * fmaxf(d[1], 1.f);
      for (size_t i = (size_t)F.bx * NTHR + F.tid; i < (size_t)MTOK * 1024; i += (size_t)F.G * NTHR) args.out[i] = (i == 0) ? x : k; }
#endif
#undef IN
#undef SEAM
}

extern "C" void kernel_launch(void* const* d_in, const int* in_sizes, int n_in, void* d_out, int out_size, void* d_ws, size_t ws_size, hipStream_t stream) {
    static int grid = 0;
    if (grid == 0) {
        if (n_in != 33 || in_sizes[0] != MTOK * DM || out_size != MTOK * DM || ws_size < WS_END) { fprintf(stderr, "kernel_launch: unexpected problem (n_in %d, in0 %d, out %d, ws %zu < %zu)\n", n_in, n_in > 0 ? in_sizes[0] : -1, out_size, ws_size, (size_t)WS_END); grid = -1; return; }
        int dev = 0, cus = 0, per_cu = 0;
        if (hipGetDevice(&dev) != hipSuccess || hipDeviceGetAttribute(&cus, hipDeviceAttributeMultiprocessorCount, dev) != hipSuccess) { grid = -1; return; }
        if (hipFuncSetAttribute((const void*)fwd_kernel, hipFuncAttributeMaxDynamicSharedMemorySize, LDS_BYTES) != hipSuccess) { fprintf(stderr, "kernel_launch: hipFuncSetAttribute failed\n"); grid = -1; return; }
        if (hipOccupancyMaxActiveBlocksPerMultiprocessor(&per_cu, (const void*)fwd_kernel, NTHR, LDS_BYTES) != hipSuccess || per_cu < 1) fprintf(stderr, "kernel_launch: occupancy query reports %d\n", per_cu);
        (void)hipGetLastError();
        grid = cus > 256 ? 256 : cus;
    }
    if (grid < 0) return;
    hipMemsetAsync(d_ws, 0, CTL_ZERO_BYTES, stream);
    Args a{};
    for (int i = 0; i < 33; ++i) a.in[i] = (const float*)d_in[i];
    a.out = (float*)d_out; a.ws = (unsigned char*)d_ws;
#if MK_N_LAUNCHES == 1
    a.ph_lo = 0; a.ph_hi = NPHASE; a.li = 0;
    hipLaunchKernelGGL(fwd_kernel, dim3(grid), dim3(NTHR), LDS_BYTES, stream, a);
#else
    for (int p = 0; p < NPHASE; ++p) { a.ph_lo = p; a.ph_hi = p + 1; a.li = p;
#ifdef REP_PHASE
        if (p == REP_PHASE) { Args a2 = a;
#ifdef REP_PAD
            a2.pad = REP_PAD;
#endif
            for (int rep = 0; rep < REP_N; ++rep) { a2.li = NPHASE + rep; hipLaunchKernelGGL(fwd_kernel, dim3(grid), dim3(NTHR), LDS_BYTES, stream, a2); } }
#endif
        hipLaunchKernelGGL(fwd_kernel, dim3(grid), dim3(NTHR), LDS_BYTES, stream, a);
#ifdef DBG_MODE
        unsigned* D = (unsigned*)((unsigned char*)d_ws + OFF_DBG); unsigned char* ws = (unsigned char*)d_ws;
        switch (p) {
            case 1: hipLaunchKernelGGL(dbg::chk_in_e, dim3(64), dim3(256), 0, stream, a, D); break;
            case 2: hipLaunchKernelGGL(dbg::chk_q2, dim3(64), dim3(256), 0, stream, a, D); hipLaunchKernelGGL(dbg::chk_cmp, dim3(96), dim3(256), 0, stream, a, D); break;
            case 3: hipLaunchKernelGGL(dbg::chk_idx, dim3(64), dim3(256), 0, stream, a, D); break;
            case 4: hipLaunchKernelGGL(dbg::chk_sel, dim3(48), dim3(256), 0, stream, a, D); break;
            case 5: hipLaunchKernelGGL(dbg::chk_dsa, dim3(64), dim3(256), 0, stream, a, D); hipLaunchKernelGGL(dbg::chk_nsa, dim3(64), dim3(256), 0, stream, a, D); break;
            case 6: hipLaunchKernelGGL(dbg::chk_out_e, dim3(32), dim3(256), 0, stream, a, D); break;
            case 7: hipLaunchKernelGGL(dbg::chk_ln, dim3(32), dim3(256), 0, stream, (const bf16_t*)(ws + OFF_S1), (const bf16_t*)(ws + OFF_H), a.in[I_ELN1G], a.in[I_ELN1B], D, 12); break;
            case 8: hipLaunchKernelGGL(dbg::chk_ffn_up, dim3(16), dim3(256), 0, stream, a, D); break;
            case 9: hipLaunchKernelGGL(dbg::chk_ffn_dn, dim3(32), dim3(256), 0, stream, a, D); break;
            case 10: hipLaunchKernelGGL(dbg::chk_ln, dim3(32), dim3(256), 0, stream, (const bf16_t*)(ws + OFF_S2), (const bf16_t*)(ws + OFF_X1), a.in[I_ELN2G], a.in[I_ELN2B], D, 15); break;
            case 10 + 100: break;
            case 11: hipLaunchKernelGGL(dbg::chk_wmoe, dim3(16), dim3(256), 0, stream, a, D); hipLaunchKernelGGL(dbg::chk_in_o, dim3(32), dim3(256), 0, stream, a, D); break;
            case 12: hipLaunchKernelGGL(dbg::chk_moba, dim3(64), dim3(256), 0, stream, a, D); break;
            case 13: hipLaunchKernelGGL(dbg::chk_out_o, dim3(32), dim3(256), 0, stream, a, D); break;
            case 14: hipLaunchKernelGGL(dbg::chk_ln, dim3(32), dim3(256), 0, stream, (const bf16_t*)(ws + OFF_S1O), (const bf16_t*)(ws + OFF_H2), a.in[I_OLN1G], a.in[I_OLN1B], D, 19); break;
            case 15: hipLaunchKernelGGL(dbg::chk_route, dim3(1), dim3(256), 0, stream, a, D); break;
            case 16: hipLaunchKernelGGL(dbg::chk_actm, dim3(8), dim3(256), 0, stream, a, D); break;
            case 17:
#ifdef DBG_SIMPLE_FINAL
                hipLaunchKernelGGL(dbg::simple_final, dim3(MTOK / 4), dim3(256), 0, stream, a);
#endif
                hipLaunchKernelGGL(dbg::chk_moe, dim3(16), dim3(256), 0, stream, a, D); hipLaunchKernelGGL(dbg::report, dim3(1024), dim3(256), 0, stream, (float*)d_out, (const unsigned*)D, out_size); break;
            default: break;
        }
#endif
    }
#endif
}
```

```cpp
#include <hip/hip_runtime.h>
#include <cstdio>
#include <cstdint>

#define LAS __attribute__((address_space(3)))
#define GAS __attribute__((address_space(1)))
typedef unsigned short bf16_t;
typedef short bf16x8 __attribute__((ext_vector_type(8)));
typedef short s16x4 __attribute__((ext_vector_type(4)));
typedef float f32x2 __attribute__((ext_vector_type(2)));
typedef float f32x4 __attribute__((ext_vector_type(4)));
typedef float f32x16 __attribute__((ext_vector_type(16)));
typedef unsigned u32x2 __attribute__((ext_vector_type(2)));
typedef unsigned u32x4 __attribute__((ext_vector_type(4)));
typedef __bf16 bf16x2_t __attribute__((ext_vector_type(2)));
typedef _Float16 f16x2_t __attribute__((ext_vector_type(2)));

constexpr int DM = 1024, NB = 8, SEQ = 4096, MTOK = NB * SEQ;
constexpr int EVEN_IN = 1768, EVEN_INP = 1792, DFF = 2816, DFFE = 3584, NEXP = 8;
constexpr float ALPHA = 1.4142135623730951f;
constexpr float LOG2E = 1.4426950408889634f;
constexpr float QSCALE = 0.125f * LOG2E;
constexpr int NWAVES = 8, NTHR = 512;

__device__ __forceinline__ unsigned f2bf(float f) { unsigned u = __builtin_bit_cast(unsigned, f); return (u + 0x7fffu + ((u >> 16) & 1u)) >> 16; }
__device__ __forceinline__ unsigned pk2(float lo, float hi) { f32x2 v = {lo, hi}; bf16x2_t b = __builtin_convertvector(v, bf16x2_t); return __builtin_bit_cast(unsigned, b); }
__device__ __forceinline__ float bf2f(unsigned short h) { return __builtin_bit_cast(float, (unsigned)h << 16); }
__device__ __forceinline__ float bflo(unsigned w) { return __builtin_bit_cast(float, w << 16); }
__device__ __forceinline__ float bfhi(unsigned w) { return __builtin_bit_cast(float, w & 0xffff0000u); }
__device__ __forceinline__ float row16_sum(float v) {
    v += __builtin_bit_cast(float, __builtin_amdgcn_update_dpp(0, __builtin_bit_cast(int, v), 0xB1, 0xF, 0xF, true));
    v += __builtin_bit_cast(float, __builtin_amdgcn_update_dpp(0, __builtin_bit_cast(int, v), 0x4E, 0xF, 0xF, true));
    v += __builtin_bit_cast(float, __builtin_amdgcn_update_dpp(0, __builtin_bit_cast(int, v), 0x141, 0xF, 0xF, true));
    v += __builtin_bit_cast(float, __builtin_amdgcn_update_dpp(0, __builtin_bit_cast(int, v), 0x140, 0xF, 0xF, true));
    return v;
}
__device__ __forceinline__ float quad_sum(float v) {
    v += __builtin_bit_cast(float, __builtin_amdgcn_update_dpp(0, __builtin_bit_cast(int, v), 0xB1, 0xF, 0xF, true));
    v += __builtin_bit_cast(float, __builtin_amdgcn_update_dpp(0, __builtin_bit_cast(int, v), 0x4E, 0xF, 0xF, true));
    return v;
}
__device__ __forceinline__ float wave_sum(float v) {
    v += __builtin_bit_cast(float, __builtin_amdgcn_update_dpp(0, __builtin_bit_cast(int, v), 0xB1, 0xF, 0xF, true));
    v += __builtin_bit_cast(float, __builtin_amdgcn_update_dpp(0, __builtin_bit_cast(int, v), 0x4E, 0xF, 0xF, true));
    v += __builtin_bit_cast(float, __builtin_amdgcn_update_dpp(0, __builtin_bit_cast(int, v), 0x141, 0xF, 0xF, true));
    v += __builtin_bit_cast(float, __builtin_amdgcn_update_dpp(0, __builtin_bit_cast(int, v), 0x140, 0xF, 0xF, true));
    const int b = __builtin_bit_cast(int, v);
    const float r0 = __builtin_bit_cast(float, __builtin_amdgcn_readlane(b, 0)), r1 = __builtin_bit_cast(float, __builtin_amdgcn_readlane(b, 16));
    const float r2 = __builtin_bit_cast(float, __builtin_amdgcn_readlane(b, 32)), r3 = __builtin_bit_cast(float, __builtin_amdgcn_readlane(b, 48));
    return (r0 + r1) + (r2 + r3);
}
#define LDS_WAIT() asm volatile("s_waitcnt lgkmcnt(0)" ::: "memory")
#define VM_WAIT() asm volatile("s_waitcnt vmcnt(0)" ::: "memory")
namespace pg8 {
#define PG8_LAS __attribute__((address_space(3)))
typedef unsigned short bf16_t;
typedef short bf16x8 __attribute__((ext_vector_type(8)));
typedef float f32x4 __attribute__((ext_vector_type(4)));
typedef unsigned u32x4 __attribute__((ext_vector_type(4)));
constexpr int BM = 256, BK = 64, HALF = 128, HTB = HALF * BK * 2  , STAGE_BYTES = 8 * HTB, NXCD = 8, WGM = 8;

__host__ __device__ __forceinline__ int lds_byte(int r, int c) { const int st = (r >> 4) * 2 + (c >> 5), rr = r & 15, cc = c & 31, ob = rr * 64 + cc * 2; return st * 1024 + (ob ^ (((ob >> 9) & 1) << 5)); }
__host__ __device__ __forceinline__ void stage_rc(int b, int& R, int& C) { const int st = b / 1024, sb = b % 1024, swz = sb ^ (((sb >> 9) & 1) << 5); R = (st >> 1) * 16 + swz / 64; C = (st & 1) * 32 + (swz % 64) / 2; }
__host__ __device__ __forceinline__ int perm32(int rho) { const int n = rho >> 4, i = rho & 15; return 8 * (i >> 2) + 4 * n + (i & 3); }

struct Unit { int pm, pn, e; };
struct Gemm { const bf16_t* A; const bf16_t* Bt; int M, N, K; int lda; size_t bstride; };

struct StaticOrder {
    int nM, nN, nwg, G, c;
    __host__ __device__ void init(int M, int N, int G_, int c_) { nM = M / BM; nN = N / BM; nwg = nM * nN; G = G_; c = c_; }
    __host__ __device__ bool next(int i, Unit& u) const {
        const long L = (long)i * G + c; if (L >= nwg) return false;
        int wgid = (int)L; { const int q = nwg / NXCD, r = nwg % NXCD, xcd = wgid % NXCD, off = wgid / NXCD; wgid = (xcd < r ? xcd * (q + 1) : r * (q + 1) + (xcd - r) * q) + off; }
        const int nig = WGM * nN, gid = wgid / nig, fm = gid * WGM, gsz = (nM - fm) < WGM ? (nM - fm) : WGM;
        u.pm = fm + ((wgid % nig) % gsz); u.pn = (wgid % nig) / gsz; u.e = 0; return true;
    }
    __device__ __forceinline__ void a_ready(const Unit&) const {}
    __device__ __forceinline__ void done(const Unit&) const {}
};


typedef int v8i32_t __attribute__((ext_vector_type(8)));
typedef int v4i32_t __attribute__((ext_vector_type(4)));
__device__ __forceinline__ v8i32_t cat8(bf16x8 lo, bf16x8 hi) { const v4i32_t a = __builtin_bit_cast(v4i32_t, lo), b = __builtin_bit_cast(v4i32_t, hi); return (v8i32_t){a[0], a[1], a[2], a[3], b[0], b[1], b[2], b[3]}; }
template <class Epi, class Sched, bool ALIGN_EPI = false, bool SP2 = false, bool F8 = false, bool I8 = false>
__device__ __forceinline__ void gemm_phase(PG8_LAS unsigned char* lds, const Gemm g, const Sched& S, const Epi& E) {
    const int tid = threadIdx.x, wid = __builtin_amdgcn_readfirstlane(tid >> 6), lane = tid & 63, wr = wid >> 2, wc = wid & 3, fr = lane & 15, fq = lane >> 4;
    const int K = g.K, nt = K / BK;
    unsigned voffA[2], voffB[2];
#pragma unroll
    for (int i = 0; i < 2; ++i) { int R, C; stage_rc(tid * 16 + i * 8192, R, C); const int Rb = Epi::PERM ? ((R & ~31) + perm32(R & 31)) : R;
        voffA[i] = (unsigned)(R * g.lda + C) * 2u; voffB[i] = (unsigned)(Rb * K + C) * 2u; }
    const size_t kstep = (size_t)(BK * 2);
    const size_t hstep = (size_t)HALF * K * 2;
    const size_t tstep = 2 * hstep;
    const size_t hstepA = (size_t)HALF * g.lda * 2, tstepA = 2 * hstepA;
    const size_t estep = g.bstride * 2;
    const unsigned ldsw = (unsigned)wid * 1024u;
    const int aoff = lds_byte(wr * 64 + fr, fq * 8), boff = lds_byte(wc * 32 + fr, fq * 8);
#define PG8_SA(b, h) (((b) * 2 + (h)) * HTB)
#define PG8_SB(b, h) ((4 + (b) * 2 + (h)) * HTB)
#define PG8_STAGE(bufoff, gbase, voff) do { _Pragma("unroll") for (int _i = 0; _i < 2; ++_i) \
        __builtin_amdgcn_global_load_lds((const unsigned*)((const char*)(gbase) + (voff)[_i]), (PG8_LAS unsigned*)(lds + (bufoff) + ldsw + _i * 8192), 16, 0, 0); } while (0)
#define PG8_LDA(dst, b, h) do { _Pragma("unroll") for (int m = 0; m < 4; ++m) _Pragma("unroll") for (int k = 0; k < 2; ++k) dst[m][k] = *(const PG8_LAS bf16x8*)(lds + PG8_SA(b, h) + aoff + m * 2048 + k * 1024); } while (0)
#define PG8_LDB(dst, b, h) do { _Pragma("unroll") for (int n = 0; n < 2; ++n) _Pragma("unroll") for (int k = 0; k < 2; ++k) dst[n][k] = *(const PG8_LAS bf16x8*)(lds + PG8_SB(b, h) + boff + n * 2048 + k * 1024); } while (0)
#define PG8_MMA(ai, bj, At, Bt) do { __builtin_amdgcn_s_setprio(1); if constexpr (I8) { _Pragma("unroll") for (int m = 0; m < 4; ++m) _Pragma("unroll") for (int n = 0; n < 2; ++n) _Pragma("unroll") for (int k = 0; k < 2; ++k) \
        asm volatile("v_mfma_i32_16x16x64_i8 %0, %1, %2, %0" : "+v"(acc[ai][bj][m][n]) : "v"(Bt[n][k]), "v"(At[m][k])); } else if constexpr (F8) { _Pragma("unroll") for (int m = 0; m < 4; ++m) _Pragma("unroll") for (int n = 0; n < 2; ++n) \
        asm volatile("v_mfma_scale_f32_16x16x128_f8f6f4 %0, %1, %2, %0, %3, %3 op_sel_hi:[0,0,0]" : "+v"(acc[ai][bj][m][n]) : "v"(cat8(Bt[n][0], Bt[n][1])), "v"(cat8(At[m][0], At[m][1])), "v"(sc8)); } else { \
        _Pragma("unroll") for (int m = 0; m < 4; ++m) _Pragma("unroll") for (int n = 0; n < 2; ++n) _Pragma("unroll") for (int k = 0; k < 2; ++k) \
        acc[ai][bj][m][n] = __builtin_amdgcn_mfma_f32_16x16x32_bf16(Bt[n][k], At[m][k], acc[ai][bj][m][n], 0, 0, 0); } __builtin_amdgcn_s_setprio(0); } while (0)
#define PG8_WAIT_V(n) asm volatile("s_waitcnt vmcnt(" #n ")" ::: "memory")
#define PG8_WAIT_L(n) asm volatile("s_waitcnt lgkmcnt(" #n ")" ::: "memory")
#define PG8_BAR __builtin_amdgcn_s_barrier()
#define PG8_SCHED __builtin_amdgcn_sched_barrier(0)
    Unit cur, nxt; int ui = 0;
    if (!S.next(0, cur)) return;
    int sc8 = 0x7f7f7f7f; asm volatile("" : "+v"(sc8));
    f32x4 acc[2][2][4][2];
#pragma unroll
    for (int a = 0; a < 2; ++a)
#pragma unroll
        for (int b = 0; b < 2; ++b)
#pragma unroll
            for (int m = 0; m < 4; ++m)
#pragma unroll
                for (int n = 0; n < 2; ++n) acc[a][b][m][n] = (f32x4){0.f, 0.f, 0.f, 0.f};
    bf16x8 At[4][2], B0[2][2], B1[2][2];
    const char* cA = (const char*)g.A + (size_t)cur.pm * tstepA; const char* cB = (const char*)g.Bt + (size_t)cur.pn * tstep + (size_t)cur.e * estep;
    S.a_ready(cur);
    if constexpr (SP2) {
        PG8_STAGE(PG8_SB(0, 0), cB, voffB); PG8_STAGE(PG8_SB(0, 1), cB + hstep, voffB); PG8_STAGE(PG8_SA(0, 0), cA, voffA); PG8_STAGE(PG8_SA(0, 1), cA + hstepA, voffA);
        if (wr == 1) PG8_BAR;
        PG8_WAIT_V(2); PG8_BAR;
        PG8_STAGE(PG8_SB(1, 0), cB + kstep, voffB); PG8_STAGE(PG8_SA(1, 0), cA + kstep, voffA); PG8_STAGE(PG8_SB(1, 1), cB + hstep + kstep, voffB);
        PG8_WAIT_V(6); PG8_BAR;
    } else {
        PG8_STAGE(PG8_SB(0, 0), cB, voffB); PG8_STAGE(PG8_SA(0, 0), cA, voffA); PG8_STAGE(PG8_SB(0, 1), cB + hstep, voffB); PG8_STAGE(PG8_SA(0, 1), cA + hstepA, voffA);
        if (wr == 1) PG8_BAR;
        PG8_WAIT_V(4); PG8_BAR;
        PG8_STAGE(PG8_SB(1, 0), cB + kstep, voffB); PG8_STAGE(PG8_SA(1, 0), cA + kstep, voffA); PG8_STAGE(PG8_SB(1, 1), cB + hstep + kstep, voffB);
        PG8_WAIT_V(6); PG8_BAR;
    }
    for (;;) {
        const bool has_next = S.next(ui + 1, nxt);
        const char* nA = has_next ? (const char*)g.A + (size_t)nxt.pm * tstepA : cA; const char* nB = has_next ? (const char*)g.Bt + (size_t)nxt.pn * tstep + (size_t)nxt.e * estep : cB;
#pragma unroll 1
        for (int t = 0; t < nt; t += 2) {
            const bool last = (t == nt - 2);
            const char* a1 = cA + (size_t)(t + 1) * kstep;
            const char* a2 = last ? nA : cA + (size_t)(t + 2) * kstep; const char* b2 = last ? nB : cB + (size_t)(t + 2) * kstep;
            const char* a3 = a2 + kstep; const char* b3 = b2 + kstep;
            if (last && has_next) S.a_ready(nxt);
            if constexpr (SP2) {
            PG8_LDB(B0, 0, 0); PG8_LDB(B1, 0, 1); PG8_SCHED; PG8_LDA(At, 0, 0); PG8_STAGE(PG8_SA(1, 1), a1 + hstepA, voffA);
            PG8_WAIT_V(8); PG8_WAIT_L(0); PG8_BAR; PG8_MMA(0, 0, At, B0); PG8_MMA(0, 1, At, B1); PG8_BAR; PG8_SCHED;
            PG8_LDA(At, 0, 1); PG8_STAGE(PG8_SB(0, 0), b2, voffB); PG8_STAGE(PG8_SB(0, 1), b2 + hstep, voffB); PG8_STAGE(PG8_SA(0, 0), a2, voffA);
            PG8_WAIT_V(8); PG8_WAIT_L(0); PG8_BAR; PG8_MMA(1, 0, At, B0); PG8_MMA(1, 1, At, B1); PG8_BAR; PG8_SCHED;
            PG8_LDB(B0, 1, 0); PG8_LDB(B1, 1, 1); PG8_SCHED; PG8_LDA(At, 1, 0); PG8_STAGE(PG8_SA(0, 1), a2 + hstepA, voffA);
            PG8_WAIT_V(8); PG8_WAIT_L(0); PG8_BAR; PG8_MMA(0, 0, At, B0); PG8_MMA(0, 1, At, B1); PG8_BAR; PG8_SCHED;
            PG8_LDA(At, 1, 1); PG8_STAGE(PG8_SB(1, 0), b3, voffB); PG8_STAGE(PG8_SB(1, 1), b3 + hstep, voffB); PG8_STAGE(PG8_SA(1, 0), a3, voffA);
            PG8_WAIT_V(8); PG8_WAIT_L(0); PG8_BAR; PG8_MMA(1, 0, At, B0); PG8_MMA(1, 1, At, B1); PG8_BAR; PG8_SCHED;
            } else {
            PG8_LDB(B0, 0, 0); PG8_SCHED; PG8_LDA(At, 0, 0); PG8_STAGE(PG8_SA(1, 1), a1 + hstepA, voffA);
            PG8_WAIT_L(8); PG8_BAR; PG8_WAIT_L(0); PG8_MMA(0, 0, At, B0); PG8_BAR; PG8_SCHED;
            PG8_LDB(B1, 0, 1); PG8_STAGE(PG8_SB(0, 0), b2, voffB);
            PG8_BAR; PG8_WAIT_L(0); PG8_MMA(0, 1, At, B1); PG8_BAR;
            PG8_LDA(At, 0, 1); PG8_STAGE(PG8_SA(0, 0), a2, voffA);
            PG8_BAR; PG8_WAIT_L(0); PG8_MMA(1, 0, At, B0); PG8_BAR; PG8_SCHED;
            PG8_STAGE(PG8_SB(0, 1), b2 + hstep, voffB);
            PG8_WAIT_V(6); PG8_BAR; PG8_MMA(1, 1, At, B1); PG8_BAR;
            PG8_LDB(B0, 1, 0); PG8_SCHED; PG8_LDA(At, 1, 0); PG8_STAGE(PG8_SA(0, 1), a2 + hstepA, voffA);
            PG8_WAIT_L(8); PG8_BAR; PG8_WAIT_L(0); PG8_MMA(0, 0, At, B0); PG8_BAR; PG8_SCHED;
            PG8_LDB(B1, 1, 1); PG8_STAGE(PG8_SB(1, 0), b3, voffB);
            PG8_BAR; PG8_WAIT_L(0); PG8_MMA(0, 1, At, B1); PG8_BAR;
            PG8_LDA(At, 1, 1); PG8_STAGE(PG8_SA(1, 0), a3, voffA);
            PG8_BAR; PG8_WAIT_L(0); PG8_MMA(1, 0, At, B0); PG8_BAR; PG8_SCHED;
            PG8_STAGE(PG8_SB(1, 1), b3 + hstep, voffB);
            PG8_WAIT_V(6); PG8_BAR; PG8_MMA(1, 1, At, B1); PG8_BAR;
            }
        }
        if constexpr (ALIGN_EPI) { if (wr == 0) PG8_BAR; }
        if constexpr (F8 || I8) asm volatile("s_nop 15\n\ts_nop 15" ::: "memory");
        if constexpr (!Epi::AFTER_DRAIN) { E(acc, cur, wr, wc, fr, fq); S.done(cur); }
        if (!has_next) break;
#pragma unroll
        for (int a = 0; a < 2; ++a)
#pragma unroll
            for (int b = 0; b < 2; ++b)
#pragma unroll
                for (int m = 0; m < 4; ++m)
#pragma unroll
                    for (int n = 0; n < 2; ++n) acc[a][b][m][n] = (f32x4){0.f, 0.f, 0.f, 0.f};
        cur = nxt; cA = nA; cB = nB; ++ui;
        if constexpr (ALIGN_EPI) { if (wr == 1) PG8_BAR; }
    }
    PG8_WAIT_V(0);
    if constexpr (!ALIGN_EPI) { if (wr == 0) PG8_BAR; }
    PG8_BAR;
    if constexpr (Epi::AFTER_DRAIN) { E.fused(acc, cur, wr, wc, fr, fq, lds, wid, lane); S.done(cur); }
#undef PG8_SA
#undef PG8_SB
#undef PG8_STAGE
#undef PG8_LDA
#undef PG8_LDB
#undef PG8_MMA
#undef PG8_WAIT_V
#undef PG8_WAIT_L
#undef PG8_BAR
#undef PG8_SCHED
}
}

namespace pg8 {
typedef f32x4 Acc[2][2][4][2];
__device__ __forceinline__ u32x4 pack8(const f32x4 v0, const f32x4 v1) { u32x4 w; w.x = pk2(v0[0], v0[1]); w.y = pk2(v0[2], v0[3]); w.z = pk2(v1[0], v1[1]); w.w = pk2(v1[2], v1[3]); return w; }
__device__ __forceinline__ void unpack8(const u32x4 w, f32x4& a, f32x4& b) { a = (f32x4){bflo(w.x), bfhi(w.x), bflo(w.y), bfhi(w.y)}; b = (f32x4){bflo(w.z), bfhi(w.z), bflo(w.w), bfhi(w.w)}; }

__device__ __forceinline__ unsigned pk4_fp8(float a, float b, float c, float d) { int w = 0; w = __builtin_amdgcn_cvt_pk_fp8_f32(a, b, w, false); w = __builtin_amdgcn_cvt_pk_fp8_f32(c, d, w, true); return (unsigned)w; }
struct EpiInE {
    static constexpr bool PERM = true, AFTER_DRAIN = false;
    bf16_t* Y1; float* ssq_q; float* ssq_kv; float isc;
    __device__ __forceinline__ void operator()(const Acc& acc, const Unit& u, int wr, int wc, int fr, int fq) const {
        bf16_t* base = Y1 + (size_t)u.pn * MTOK * 256;
        const float sc = (u.pn == 2 || u.pn == 3) ? QSCALE : 1.f;
        const int col0 = wc * 32 + 8 * fq;
#pragma unroll
        for (int ai = 0; ai < 2; ++ai)
#pragma unroll
            for (int m = 0; m < 4; ++m) {
                const int row = u.pm * BM + ai * HALF + wr * 64 + m * 16 + fr; bf16_t* rowp = base + (size_t)row * 256 + col0;
                float s0 = 0.f, s1 = 0.f;
#pragma unroll
                for (int bj = 0; bj < 2; ++bj) { const f32x4 v0 = acc[ai][bj][m][0] * isc, v1 = acc[ai][bj][m][1] * isc;
                    const float q = (v0[0] * v0[0] + v0[1] * v0[1]) + (v0[2] * v0[2] + v0[3] * v0[3]) + (v1[0] * v1[0] + v1[1] * v1[1]) + (v1[2] * v1[2] + v1[3] * v1[3]);
                    if (bj == 0) s0 = q; else s1 = q;
                    *(u32x4*)(rowp + bj * HALF) = pack8(v0 * sc, v1 * sc); }
                if (u.pn <= 1) {
                    float s = (u.pn == 0) ? (s0 + s1) : s0;
                    s += __shfl_xor(s, 16); s += __shfl_xor(s, 32);
                    if (fq == 0) (u.pn == 0 ? ssq_q : ssq_kv)[(size_t)row * 4 + wc] = s;
                }
            }
    }
};
struct EpiQ2 {
    static constexpr bool PERM = true, AFTER_DRAIN = false;
    bf16_t* QLAT; unsigned char* QIDX8; const float* ssq_q;
    __device__ __forceinline__ void operator()(const Acc& acc, const Unit& u, int wr, int wc, int fr, int fq) const {
        const float sc0 = (u.pn < 4) ? QSCALE : 1.f;
        const int col0 = (u.pn & 3) * 256 + wc * 32 + 8 * fq;
#pragma unroll
        for (int ai = 0; ai < 2; ++ai)
#pragma unroll
            for (int m = 0; m < 4; ++m) {
                const int row = u.pm * BM + ai * HALF + wr * 64 + m * 16 + fr;
                const f32x4 sq = *(const f32x4*)(ssq_q + (size_t)row * 4); const float sc = sc0 * __builtin_amdgcn_rsqf(((sq[0] + sq[1]) + (sq[2] + sq[3])) * (1.f / 256.f) + 1e-6f);
                if (u.pn < 4) { bf16_t* rowp = QLAT + (size_t)row * 1024 + col0;
#pragma unroll
                    for (int bj = 0; bj < 2; ++bj) *(u32x4*)(rowp + bj * HALF) = pack8(acc[ai][bj][m][0] * sc, acc[ai][bj][m][1] * sc);
                } else { unsigned char* rowp = QIDX8 + (size_t)row * 1024 + col0;
#pragma unroll
                    for (int bj = 0; bj < 2; ++bj) { const f32x4 v0 = acc[ai][bj][m][0] * sc, v1 = acc[ai][bj][m][1] * sc; u32x2 w; w.x = pk4_fp8(v0[0], v0[1], v0[2], v0[3]); w.y = pk4_fp8(v1[0], v1[1], v1[2], v1[3]); *(u32x2*)(rowp + bj * HALF) = w; } }
            }
    }
};
template <bool RES_F32> struct EpiRes {
    static constexpr bool PERM = true, AFTER_DRAIN = false;
    const void* res; bf16_t* S; float sc;
    __device__ __forceinline__ void operator()(const Acc& acc, const Unit& u, int wr, int wc, int fr, int fq) const {
        const int col0 = u.pn * BM + wc * 32 + 8 * fq;
#pragma unroll
        for (int ai = 0; ai < 2; ++ai)
#pragma unroll
            for (int m = 0; m < 4; ++m) {
                const size_t off = (size_t)(u.pm * BM + ai * HALF + wr * 64 + m * 16 + fr) * 1024 + col0;
#pragma unroll
                for (int bj = 0; bj < 2; ++bj) { f32x4 r0, r1;
                    if (RES_F32) { r0 = *(const f32x4*)((const float*)res + off + bj * HALF); r1 = *(const f32x4*)((const float*)res + off + bj * HALF + 4); }
                    else unpack8(*(const u32x4*)((const bf16_t*)res + off + bj * HALF), r0, r1);
                    *(u32x4*)(S + off + bj * HALF) = pack8(r0 * ALPHA + acc[ai][bj][m][0] * sc, r1 * ALPHA + acc[ai][bj][m][1] * sc); }
            }
    }
};
struct EpiSwiglu {
    static constexpr bool PERM = true, AFTER_DRAIN = false;
    bf16_t* O; int ldo; int pm0;
    __device__ __forceinline__ void operator()(const Acc& acc, const Unit& u, int wr, int wc, int fr, int fq) const {
        const int col0 = u.pn * HALF + wc * 32 + 8 * fq;
#pragma unroll
        for (int ai = 0; ai < 2; ++ai)
#pragma unroll
            for (int m = 0; m < 4; ++m) {
                bf16_t* rowp = O + (size_t)((u.pm - pm0) * BM + ai * HALF + wr * 64 + m * 16 + fr) * ldo + col0;
                f32x4 o[2];
#pragma unroll
                for (int n = 0; n < 2; ++n) { const f32x4 a = acc[ai][0][m][n], b = acc[ai][1][m][n];
#pragma unroll
                    for (int e = 0; e < 4; ++e) o[n][e] = a[e] * __builtin_amdgcn_rcpf(1.f + __expf(-a[e])) * b[e]; }
                *(u32x4*)rowp = pack8(o[0], o[1]);
            }
    }
};
struct EpiStore {
    static constexpr bool PERM = true, AFTER_DRAIN = false;
    bf16_t* O; int ldo;
    __device__ __forceinline__ void operator()(const Acc& acc, const Unit& u, int wr, int wc, int fr, int fq) const {
        const int col0 = u.pn * BM + wc * 32 + 8 * fq;
#pragma unroll
        for (int ai = 0; ai < 2; ++ai)
#pragma unroll
            for (int m = 0; m < 4; ++m) {
                bf16_t* rowp = O + (size_t)(u.pm * BM + ai * HALF + wr * 64 + m * 16 + fr) * ldo + col0;
#pragma unroll
                for (int bj = 0; bj < 2; ++bj) *(u32x4*)(rowp + bj * HALF) = pack8(acc[ai][bj][m][0], acc[ai][bj][m][1]);
            }
    }
};
struct EpiInO {
    static constexpr bool PERM = true, AFTER_DRAIN = false;
    bf16_t* QKV; float* kmean; float isc;
    __device__ __forceinline__ void operator()(const Acc& acc, const Unit& u, int wr, int wc, int fr, int fq) const {
        const int which = u.pn >> 2; bf16_t* base = QKV + (size_t)which * MTOK * 1024; const float sc = (which == 0) ? QSCALE * isc : isc;
        const int col0 = (u.pn & 3) * BM + wc * 32 + 8 * fq;
#pragma unroll
        for (int ai = 0; ai < 2; ++ai)
#pragma unroll
            for (int m = 0; m < 4; ++m) {
                const size_t ro = (size_t)(u.pm * BM + ai * HALF + wr * 64 + m * 16 + fr) * 1024 + col0;
                {
                    unsigned char* rowp = (unsigned char*)base + ro;
#pragma unroll
                    for (int bj = 0; bj < 2; ++bj) { const f32x4 v0 = acc[ai][bj][m][0] * sc, v1 = acc[ai][bj][m][1] * sc; u32x2 w; w.x = pk4_fp8(v0[0], v0[1], v0[2], v0[3]); w.y = pk4_fp8(v1[0], v1[1], v1[2], v1[3]); *(u32x2*)(rowp + bj * HALF) = w; } }
            }
        if (which == 1) {
#pragma unroll
            for (int bj = 0; bj < 2; ++bj)
#pragma unroll
                for (int n = 0; n < 2; ++n) { f32x4 s = (f32x4){0.f, 0.f, 0.f, 0.f};
#pragma unroll
                    for (int ai = 0; ai < 2; ++ai)
#pragma unroll
                        for (int m = 0; m < 4; ++m) s += acc[ai][bj][m][n];
#pragma unroll
                    for (int e = 0; e < 4; ++e) { const float v = row16_sum(s[e]);
                        if (fr == 0) kmean[((size_t)u.pm * 2 + wr) * 1024 + col0 + bj * HALF + 4 * n + e] = v; }
                }
        }
    }
};

struct EpiSwiglu8 {
    static constexpr bool PERM = true, AFTER_DRAIN = false;
    unsigned char* O; int ldo; int pm0; float isc;
    __device__ __forceinline__ void operator()(const Acc& acc, const Unit& u, int wr, int wc, int fr, int fq) const {
        const int col0 = u.pn * HALF + wc * 32 + 8 * fq;
        typedef float ep2 __attribute__((ext_vector_type(2)));
        const float c1 = -isc * 1.44269504088896341f, k2 = 1.f / (isc * isc);
#pragma unroll
        for (int ai = 0; ai < 2; ++ai)
#pragma unroll
            for (int m = 0; m < 4; ++m) {
                unsigned char* rowp = O + (size_t)((u.pm - pm0) * BM + ai * HALF + wr * 64 + m * 16 + fr) * ldo + col0;
                f32x4 o[2];
#pragma unroll
                for (int n = 0; n < 2; ++n) { const f32x4 a = acc[ai][0][m][n], b = acc[ai][1][m][n];
#pragma unroll
                    for (int h = 0; h < 2; ++h) { const ep2 a2 = {a[2 * h], a[2 * h + 1]}, b2 = {b[2 * h], b[2 * h + 1]};
                        const ep2 t = a2 * c1; const ep2 ex = {__builtin_amdgcn_exp2f(t.x), __builtin_amdgcn_exp2f(t.y)}; const ep2 d = ex * k2 + k2;
                        const ep2 r = {__builtin_amdgcn_rcpf(d.x), __builtin_amdgcn_rcpf(d.y)}; const ep2 p = (a2 * b2) * r; o[n][2 * h] = p.x; o[n][2 * h + 1] = p.y; } }
                u32x2 w; w.x = pk4_fp8(o[0][0], o[0][1], o[0][2], o[0][3]); w.y = pk4_fp8(o[1][0], o[1][1], o[1][2], o[1][3]);
                *(u32x2*)rowp = w;
            }
    }
};

struct EpiSwigluI8 {
    static constexpr bool PERM = true, AFTER_DRAIN = false;
    unsigned char* O; int ldo; const float* sa; const float* sw;
    __device__ __forceinline__ void operator()(const Acc& acc, const Unit& u, int wr, int wc, int fr, int fq) const {
        const int col0 = u.pn * HALF + wc * 32 + 8 * fq, bcol = u.pn * BM + wc * 32 + 8 * fq;
        f32x4 w1s[2], w3s[2];
#pragma unroll
        for (int n = 0; n < 2; ++n) { w1s[n] = *(const f32x4*)(sw + bcol + 4 * n); w3s[n] = *(const f32x4*)(sw + bcol + HALF + 4 * n); }
        typedef float ep2 __attribute__((ext_vector_type(2)));
        f32x4 cw1[2], w13[2];
#pragma unroll
        for (int n = 0; n < 2; ++n) { cw1[n] = w1s[n] * -1.44269504088896341f; w13[n] = w1s[n] * w3s[n]; }
#pragma unroll
        for (int ai = 0; ai < 2; ++ai)
#pragma unroll
            for (int m = 0; m < 4; ++m) {
                const int row = u.pm * BM + ai * HALF + wr * 64 + m * 16 + fr; const float ra = sa[row];
                unsigned char* rowp = O + (size_t)row * ldo + col0;
                f32x4 o[2]; const float ra2 = ra * ra;
#pragma unroll
                for (int n = 0; n < 2; ++n) {
#pragma unroll
                    for (int h = 0; h < 2; ++h) { const float xa0 = acc[ai][0][m][n][2 * h], xa1 = acc[ai][0][m][n][2 * h + 1], xb0 = acc[ai][1][m][n][2 * h], xb1 = acc[ai][1][m][n][2 * h + 1];
                        const ep2 fa = {(float)__float_as_int(xa0), (float)__float_as_int(xa1)}, fb = {(float)__float_as_int(xb0), (float)__float_as_int(xb1)};
                        const ep2 cw = {cw1[n][2 * h], cw1[n][2 * h + 1]}, ww = {w13[n][2 * h], w13[n][2 * h + 1]};
                        const ep2 t = (fa * ra) * cw; const ep2 ex = {__builtin_amdgcn_exp2f(t.x), __builtin_amdgcn_exp2f(t.y)}; const ep2 d = ex + 1.f;
                        const ep2 r = {__builtin_amdgcn_rcpf(d.x), __builtin_amdgcn_rcpf(d.y)}; const ep2 p = (((fa * fb) * ra2) * ww) * r; o[n][2 * h] = p.x; o[n][2 * h + 1] = p.y; } }
                u32x2 w; w.x = pk4_fp8(o[0][0], o[0][1], o[0][2], o[0][3]); w.y = pk4_fp8(o[1][0], o[1][1], o[1][2], o[1][3]);
                *(u32x2*)rowp = w;
            }
    }
};
struct EpiStoreS {
    static constexpr bool PERM = true, AFTER_DRAIN = false;
    bf16_t* O; int ldo; float sc;
    __device__ __forceinline__ void operator()(const Acc& acc, const Unit& u, int wr, int wc, int fr, int fq) const {
        const int col0 = u.pn * BM + wc * 32 + 8 * fq;
#pragma unroll
        for (int ai = 0; ai < 2; ++ai)
#pragma unroll
            for (int m = 0; m < 4; ++m) {
                bf16_t* rowp = O + (size_t)(u.pm * BM + ai * HALF + wr * 64 + m * 16 + fr) * ldo + col0;
#pragma unroll
                for (int bj = 0; bj < 2; ++bj) *(u32x4*)(rowp + bj * HALF) = pack8(acc[ai][bj][m][0] * sc, acc[ai][bj][m][1] * sc);
            }
    }
};
struct MoeOrder {
    int g0, ng, nN, G, c; int pend[8]; int nd = 0;
    __device__ __forceinline__ bool next(int j, Unit& u) const {
        const int i = (c < nd) ? j + 4 : j;
        const int L = (i < 4) ? i * (G - nd) + (c - nd) : 4 * (G - nd) + (i - 4) * G + c; if (L >= ng * nN) return false;
        u.pm = g0 + L % ng; u.pn = L / ng; const int r = u.pm * 256; int e = 0;
#pragma unroll
        for (int k = 0; k < 7; ++k) e += (pend[k] <= r) ? 1 : 0;
        u.e = e; return true;
    }
    __device__ __forceinline__ void a_ready(const Unit&) const {}
    __device__ __forceinline__ void done(const Unit&) const {}
};
}

#ifndef FFN_F8
#define FFN_F8 0
#endif
constexpr size_t MiB = 1u << 20, KiB = 1u << 10;
constexpr size_t CTL_ZERO_BYTES = 2 * MiB;
constexpr int    MAX_LAUNCHES = 18;
constexpr size_t OFF_BAR = 16 * KiB;
constexpr size_t OFF_WGCNT = 1 * MiB + 512 * KiB;
constexpr size_t OFF_GINFO = OFF_WGCNT + 16 * KiB;
constexpr size_t OFF_DBG = OFF_GINFO + 1 * KiB;
constexpr size_t OFF_BT = 2 * MiB;
constexpr size_t OFF_CB = 2 * MiB + 16 * KiB;
constexpr size_t OFF_ROUTE = 2 * MiB + 64 * KiB;
constexpr size_t OFF_DEST = 2 * MiB + 512 * KiB;
constexpr size_t OFF_KC = 3 * MiB, OFF_VC = 3 * MiB + 512 * KiB;
constexpr size_t OFF_W_IN = 4 * MiB, OFF_W_Q2 = OFF_W_IN + (size_t)EVEN_INP * 1024 * 2, OFF_W_OUTE = OFF_W_Q2 + 2048 * 256 * 2, OFF_W_F13 = OFF_W_OUTE + 1024 * 1536 * 2,
                 OFF_W_F2 = OFF_W_F13 + (size_t)2 * DFF * 1024 * 2, OFF_CK1 = OFF_W_F2 + (size_t)1024 * DFF * 2, OFF_CV1 = OFF_CK1 + 64 * 2048 * 2, OFF_WE_END = OFF_CV1 + 64 * 2048 * 2;
static_assert(OFF_WE_END <= 30 * MiB, "even weights");
constexpr size_t OFF_W_OIN = 30 * MiB, OFF_W_OOUT = 36 * MiB, OFF_W_M13 = 38 * MiB, OFF_W_M2 = 94 * MiB;
constexpr size_t OFF_Y1 = 30 * MiB;
constexpr size_t OFF_CKVN = 142 * MiB;
constexpr size_t OFF_XB = 206 * MiB, OFF_QLAT = 206 * MiB, OFF_QIDX = 270 * MiB;
constexpr size_t OFF_SC = 334 * MiB, OFF_MASK = 464 * MiB, OFF_MIXIN = 334 * MiB;
constexpr size_t OFF_S1 = 206 * MiB, OFF_H = 270 * MiB, OFF_ACT = 30 * MiB, OFF_S2 = 334 * MiB, OFF_X1 = 398 * MiB, OFF_H8 = 464 * MiB;
constexpr size_t OFF_SA = 497 * MiB, OFF_SW = 497 * MiB + 256 * KiB, OFF_SAX = 497 * MiB + 512 * KiB, OFF_SWIN = 497 * MiB + 768 * KiB;
constexpr size_t OFF_X18 = 464 * MiB, OFF_O8 = 464 * MiB;
constexpr float OSC = 16.f, WOUT_SCALE = 64.f, WIN_SCALE = 32.f, WF13_SCALE = 32.f, WF2_SCALE = 128.f;
constexpr size_t OFF_QKV = 206 * MiB, OFF_S1O = 270 * MiB, OFF_H2 = 122 * MiB, OFF_ACTM = 186 * MiB, OFF_YR = 298 * MiB, OFF_XR = 430 * MiB;
constexpr float W13_SCALE = 32.f, W2_SCALE = 128.f;
constexpr size_t OFF_ACTT = 4 * MiB;
constexpr size_t OFF_MST = 122 * MiB;
constexpr size_t OFF_SSQ_Q = 514 * MiB, OFF_SSQ_KV = 514 * MiB + 512 * KiB;
constexpr size_t OFF_KMEAN = 515 * MiB;
constexpr size_t WS_END = 516 * MiB;
constexpr int    MOE_CHUNK = 128;
constexpr size_t SCB_ELEMS = (size_t)64 * 64 * (64 * 65 / 2);

constexpr int LDS_BYTES = 160 * 1024;
constexpr int LDSCTL_OFF = LDS_BYTES - 512;

#define RLX_AGENT __ATOMIC_RELAXED, __HIP_MEMORY_SCOPE_AGENT
typedef GAS unsigned gu32;
#define XB_TMO      128
#define XB_XCNT(j)  (256  + 64 * (j))
#define XB_XSUB(j)  (1280 + 64 * (j))
#define XB_XGEN(j)  (2304 + 64 * (j))
#define XB_TOP      3328
#define XB_TOPGEN   3392
#define XCD_BAR_WORDS 3456
#define XB_SPIN_CAP (1u << 18)

__device__ __forceinline__ unsigned xb_ld(unsigned* p)              { return __hip_atomic_load(p, __ATOMIC_RELAXED, __HIP_MEMORY_SCOPE_AGENT); }
__device__ __forceinline__ unsigned xb_add(unsigned* p, unsigned v) { return __hip_atomic_fetch_add(p, v, __ATOMIC_RELAXED, __HIP_MEMORY_SCOPE_AGENT); }
__device__ __forceinline__ unsigned xb_xcc_id() { return (unsigned)__builtin_amdgcn_s_getreg((3 << 11) | 20) & 0xFu; }
#define XB_SPIN(cond, bar) do { unsigned _sp = 0; while (cond) { __builtin_amdgcn_s_sleep(1); \
    if ((++_sp & 255u) == 0u) { if (xb_ld(&(bar)[XB_TMO])) break; if (_sp > XB_SPIN_CAP) { atomicAdd(&(bar)[XB_TMO], 1u); break; } } } } while (0)

struct XcdBarrier {
    unsigned* bar; unsigned x;
    volatile LAS unsigned* st;
};

__device__ __forceinline__ XcdBarrier xcd_barrier_post(unsigned* bar, volatile LAS unsigned* st) {
    XcdBarrier b; b.bar = bar; b.x = xb_xcc_id(); b.st = st;
    if (threadIdx.x == 0) (void)xb_add(&bar[XB_XCNT(b.x)], 1u);
    return b;
}
__device__ __forceinline__ void xcd_barrier_complete(unsigned* bar, unsigned x, unsigned& nloc, unsigned& nx) {
    const unsigned G = gridDim.x * gridDim.y * gridDim.z;
    unsigned sum, cnt, mine, sp = 0u;
    for (;;) {
        sum = 0u; cnt = 0u; mine = 0u;
#pragma unroll
        for (unsigned j = 0; j < 16; ++j) { const unsigned c = xb_ld(&bar[XB_XCNT(j)]); sum += c; cnt += (c > 0u) ? 1u : 0u; mine = (j == x) ? c : mine; }
        if (sum == G) break;
        __builtin_amdgcn_s_sleep(1);
        if ((++sp & 255u) == 0u) { if (xb_ld(&bar[XB_TMO])) break; if (sp > XB_SPIN_CAP) { atomicAdd(&bar[XB_TMO], 1u); break; } }
    }
    nloc = mine > 0u ? mine : 1u; nx = cnt > 0u ? cnt : 1u;
}

__device__ __forceinline__ void xcd_barrier(const XcdBarrier& b) {
    asm volatile("s_waitcnt vmcnt(0)" ::: "memory");
    __syncthreads();
    if (threadIdx.x == 0) {
        unsigned* bar = b.bar;
        __builtin_amdgcn_s_waitcnt(0);
        unsigned nloc = b.st[0], nx = b.st[1];
        if (nloc == 0u) { xcd_barrier_complete(bar, b.x, nloc, nx); b.st[0] = nloc; b.st[1] = nx; }
        const unsigned old = xb_add(&bar[XB_XSUB(b.x)], 1u);
        const unsigned gen = old / nloc;
        if (old + 1u == (gen + 1u) * nloc) {
            __builtin_amdgcn_fence(__ATOMIC_RELEASE, "agent");
            asm volatile("s_waitcnt vmcnt(0)" ::: "memory");
            const unsigned og = xb_add(&bar[XB_TOP], 1u);
            const unsigned tg = og / nx;
            if (og + 1u == (tg + 1u) * nx) xb_add(&bar[XB_TOPGEN], 1u);
            else XB_SPIN(xb_ld(&bar[XB_TOPGEN]) == tg, bar);
            __builtin_amdgcn_fence(__ATOMIC_ACQUIRE, "agent");
            xb_add(&bar[XB_XGEN(b.x)], 1u);
            asm volatile("s_waitcnt vmcnt(0)" ::: "memory");
        } else {
            XB_SPIN(xb_ld(&bar[XB_XGEN(b.x)]) == gen, bar);
            __builtin_amdgcn_fence(__ATOMIC_ACQUIRE, "agent");
            asm volatile("s_waitcnt vmcnt(0)" ::: "memory");
        }
    }
    __syncthreads();
}

struct Frame {
    LAS unsigned char* lds;
    int tid, lane, wave, G, bx;
    int gw, NGW;
    unsigned char* ws;
    const float* const* in;
};
struct Args { const float* in[33]; float* out; unsigned char* ws; int ph_lo, ph_hi, li, pad; };
enum InIdx { I_X = 0, I_RELB, I_EWIN, I_EQN, I_EKVN, I_EWUQ, I_EWUK, I_EWUV, I_EWQIDX, I_EPOSK, I_EPOSV, I_ECK1, I_ECK2, I_ECV1, I_ECV2, I_EWOUT, I_ELN1G, I_ELN1B,
             I_EF1, I_EF3, I_EF2, I_ELN2G, I_ELN2B, I_OWIN, I_OWOUT, I_OLN1G, I_OLN1B, I_OROUTER, I_OM1, I_OM3, I_OM2, I_OLN2G, I_OLN2B };

template <class RowMap, class KScale>
__device__ __forceinline__ void transpose_item(const float* W, int K, int N, bf16_t* WT, int ldt, LAS float* scr, int item, int lane, RowMap rm, KScale ks) {
    const int nblk = (N + 63) >> 6, kb = item / nblk, nb = item - kb * nblk, k0 = 128 * kb, n = 64 * nb + lane;
    if (n >= N) return;
    const float* src = W + (size_t)k0 * N + n; bf16_t* dst = WT + (size_t)rm(n) * ldt + k0;
#pragma unroll 2
    for (int kk = 0; kk < 128; kk += 8) { float v[8];
#pragma unroll
        for (int i = 0; i < 8; ++i) v[i] = src[(size_t)(kk + i) * N] * ks(k0 + kk + i);
        u32x4 o; o.x = pk2(v[0], v[1]); o.y = pk2(v[2], v[3]); o.z = pk2(v[4], v[5]); o.w = pk2(v[6], v[7]);
        *(u32x4*)(dst + kk) = o; }
}
template <class RowMap, int KB = 128>
__device__ __forceinline__ void transpose_item8(const float* W, int K, int N, unsigned char* WT, int ldt, int item, int lane, RowMap rm, float scale) {
    const int nblk = N >> 8, kb = item / nblk, nb = item - kb * nblk, k0 = KB * kb, n = 256 * nb + 4 * lane;
    const float* src = W + (size_t)k0 * N + n;
    unsigned char* d0 = WT + (size_t)rm(n) * ldt + k0; unsigned char* d1 = WT + (size_t)rm(n + 1) * ldt + k0; unsigned char* d2 = WT + (size_t)rm(n + 2) * ldt + k0; unsigned char* d3 = WT + (size_t)rm(n + 3) * ldt + k0;
#pragma unroll 1
    for (int kk = 0; kk < KB; kk += 16) { f32x4 v[16];
#pragma unroll
        for (int i = 0; i < 16; ++i) v[i] = *(const f32x4*)(src + (size_t)(kk + i) * N) * scale;
#pragma unroll
        for (int c = 0; c < 4; ++c) { u32x4 o; o.x = pg8::pk4_fp8(v[0][c], v[1][c], v[2][c], v[3][c]); o.y = pg8::pk4_fp8(v[4][c], v[5][c], v[6][c], v[7][c]);
            o.z = pg8::pk4_fp8(v[8][c], v[9][c], v[10][c], v[11][c]); o.w = pg8::pk4_fp8(v[12][c], v[13][c], v[14][c], v[15][c]);
            *(u32x4*)((c == 0 ? d0 : c == 1 ? d1 : c == 2 ? d2 : d3) + kk) = o; } }
}
template <class RowMap>
__device__ __forceinline__ void transpose_item8c(const float* W, int K, int N, unsigned char* WT, int ldt, int item, int lane, RowMap rm, float scale) {
    const int nblk = (N + 63) >> 6, kb = item / nblk, nb = item - kb * nblk, k0 = 128 * kb, n = 64 * nb + lane;
    if (n >= N) return;
    const float* src = W + (size_t)k0 * N + n; unsigned char* dst = WT + (size_t)rm(n) * ldt + k0;
#pragma unroll 1
    for (int kk = 0; kk < 128; kk += 32) { float v[32];
#pragma unroll
        for (int i = 0; i < 32; ++i) v[i] = src[(size_t)(kk + i) * N] * scale;
#pragma unroll
        for (int h = 0; h < 2; ++h) { u32x4 o; o.x = pg8::pk4_fp8(v[16 * h], v[16 * h + 1], v[16 * h + 2], v[16 * h + 3]); o.y = pg8::pk4_fp8(v[16 * h + 4], v[16 * h + 5], v[16 * h + 6], v[16 * h + 7]);
            o.z = pg8::pk4_fp8(v[16 * h + 8], v[16 * h + 9], v[16 * h + 10], v[16 * h + 11]); o.w = pg8::pk4_fp8(v[16 * h + 12], v[16 * h + 13], v[16 * h + 14], v[16 * h + 15]);
            *(u32x4*)(dst + kk + 16 * h) = o; } }
}
template <class RowMap>
__device__ __forceinline__ void transpose_item8s(const float* W, int K, int N, unsigned char* WT, int ldt, int item, int lane, RowMap rm, float scale, LAS unsigned char* stg) {
    const int nblk = N >> 6, kb = item / nblk, nb = item - kb * nblk, k0 = 128 * kb, n = 64 * nb + lane;
    const float* src = W + (size_t)k0 * N + n;
#pragma unroll 1
    for (int kk = 0; kk < 128; kk += 32) { float v[32];
#pragma unroll
        for (int i = 0; i < 32; ++i) v[i] = src[(size_t)(kk + i) * N] * scale;
#pragma unroll
        for (int h = 0; h < 2; ++h) { u32x4 o; o.x = pg8::pk4_fp8(v[16 * h], v[16 * h + 1], v[16 * h + 2], v[16 * h + 3]); o.y = pg8::pk4_fp8(v[16 * h + 4], v[16 * h + 5], v[16 * h + 6], v[16 * h + 7]);
            o.z = pg8::pk4_fp8(v[16 * h + 8], v[16 * h + 9], v[16 * h + 10], v[16 * h + 11]); o.w = pg8::pk4_fp8(v[16 * h + 12], v[16 * h + 13], v[16 * h + 14], v[16 * h + 15]);
            *(LAS u32x4*)(stg + lane * 144 + kk + 16 * h) = o; } }
    const int rr = lane >> 3, ch = lane & 7;
#pragma unroll
    for (int j = 0; j < 8; ++j) { const int r = 8 * j + rr; const u32x4 v = *(const LAS u32x4*)(stg + r * 144 + ch * 16);
        *(u32x4*)(WT + (size_t)rm(64 * nb + r) * ldt + k0 + ch * 16) = v; }
}
template <class RowMap>
__device__ __forceinline__ void transpose_item_i8(const float* W, int K, int N, unsigned char* WT, int ldt, float* sw, int item, int lane, RowMap rm) {
    const int c = lane & 7, kg = lane >> 3, n = 8 * item + c, ks = K >> 3, kbase = kg * ks;
    const float* src = W + (size_t)kbase * N + n; float mx = 0.f;
#pragma unroll 16
    for (int k = 0; k < ks; ++k) mx = fmaxf(mx, fabsf(src[(size_t)k * N]));
    mx = fmaxf(mx, __shfl_xor(mx, 8)); mx = fmaxf(mx, __shfl_xor(mx, 16)); mx = fmaxf(mx, __shfl_xor(mx, 32));
    mx = fmaxf(mx, 1e-20f); const float inv = 127.f / mx; const int dr = rm(n); if (kg == 0) sw[dr] = mx * (1.f / 127.f);
    unsigned char* dst = WT + (size_t)dr * ldt + kbase;
#pragma unroll 2
    for (int kk = 0; kk < ks; kk += 16) { unsigned w[4];
#pragma unroll
        for (int q = 0; q < 4; ++q) { const int q0 = (int)rintf(src[(size_t)(kk + 4 * q) * N] * inv), q1 = (int)rintf(src[(size_t)(kk + 4 * q + 1) * N] * inv), q2 = (int)rintf(src[(size_t)(kk + 4 * q + 2) * N] * inv), q3 = (int)rintf(src[(size_t)(kk + 4 * q + 3) * N] * inv);
            w[q] = (unsigned)(q0 & 255) | ((unsigned)(q1 & 255) << 8) | ((unsigned)(q2 & 255) << 16) | ((unsigned)(q3 & 255) << 24); }
        *(u32x4*)(dst + kk) = (u32x4){w[0], w[1], w[2], w[3]}; }
}
struct RowId { __device__ __forceinline__ int operator()(int n) const { return n; } };
struct KOne { __device__ __forceinline__ float operator()(int) const { return 1.f; } };
struct RowInE {
    __device__ __forceinline__ int operator()(int n) const { return n < 464 ? n : (n < 1744 ? n + 48 : n - 1744 + 464); }
};
struct RowIlv {
    int add; __device__ __forceinline__ int operator()(int n) const { return ((n >> 7) << 8) + (n & 127) + add; }
};
struct KGain { const float* g; __device__ __forceinline__ float operator()(int k) const { return g[k]; } };

__device__ __forceinline__ void store_row_i8(unsigned char* row, float* sa, int lane, const f32x4 (&v)[4]) {
    float mx = 0.f;
#pragma unroll
    for (int j = 0; j < 4; ++j) mx = fmaxf(fmaxf(mx, fmaxf(fabsf(v[j][0]), fabsf(v[j][1]))), fmaxf(fabsf(v[j][2]), fabsf(v[j][3])));
#pragma unroll
    for (int o = 1; o < 64; o <<= 1) mx = fmaxf(mx, __shfl_xor(mx, o));
    mx = fmaxf(mx, 1e-20f); const float inv = 127.f / mx;
#pragma unroll
    for (int j = 0; j < 4; ++j) { const int q0 = (int)rintf(v[j][0] * inv), q1 = (int)rintf(v[j][1] * inv), q2 = (int)rintf(v[j][2] * inv), q3 = (int)rintf(v[j][3] * inv);
        *(unsigned*)(row + 4 * lane + 256 * j) = (unsigned)(q0 & 255) | ((unsigned)(q1 & 255) << 8) | ((unsigned)(q2 & 255) << 16) | ((unsigned)(q3 & 255) << 24); }
    if (lane == 0) *sa = mx * (1.f / 127.f);
}
__device__ __forceinline__ int t5_bucket(int n) {
    if (n < 16) return n;
    int l = 16 + (int)(__logf((float)n / 16.f) / 2.0794415f * 16.f);
    return l < 31 ? l : 31;
}

__device__ __forceinline__ void phase_prologue_even(const Frame& F, const Args& a) {
    LAS float* scr = (LAS float*)(F.lds + F.wave * 8704);
    unsigned char* ws = F.ws;
    bf16_t* W_IN = (bf16_t*)(ws + OFF_W_IN); bf16_t* W_Q2 = (bf16_t*)(ws + OFF_W_Q2); unsigned char* W_OUTE = ws + OFF_W_OUTE;
    unsigned char* W_F13 = ws + OFF_W_F13; unsigned char* W_F2 = ws + OFF_W_F2; bf16_t* CK1 = (bf16_t*)(ws + OFF_CK1); bf16_t* CV1 = (bf16_t*)(ws + OFF_CV1);
    constexpr int I_IN = 8 * ((EVEN_IN + 63) / 64);
    constexpr int I_QI = 2 * 16;
    constexpr int I_OB = 4 * 16;
    constexpr int I_F1 = DFF / 8, I_F2 = (DFF / 128) * 16;
    constexpr int I_CK = 16 * 1;
    constexpr int NIT = I_IN + I_QI + I_OB + 2 * I_F1 + I_F2 + 2 * I_CK;
    for (int it = F.gw; it < NIT; it += F.NGW) {
        int r = it;
        if (r < I_IN) { transpose_item8c(a.in[I_EWIN], 1024, EVEN_IN, (unsigned char*)W_IN, 1024, r, F.lane, RowInE{}, WIN_SCALE); continue; } r -= I_IN;
        if (r < I_QI) { transpose_item(a.in[I_EWQIDX], 256, 1024, W_Q2 + 1024 * 256, 256, scr, r, F.lane, RowId{}, KGain{a.in[I_EQN]}); continue; } r -= I_QI;
        if (r < I_OB) { transpose_item8c(a.in[I_EWOUT] + 512 * 1024, 512, 1024, W_OUTE + 1024, 1536, r, F.lane, RowId{}, WOUT_SCALE); continue; } r -= I_OB;
#if FFN_F8
        if (r < I_F1) { transpose_item8(a.in[I_EF1], 1024, DFF, W_F13, 1024, r, F.lane, RowIlv{0}, WF13_SCALE); continue; } r -= I_F1;
        if (r < I_F1) { transpose_item8(a.in[I_EF3], 1024, DFF, W_F13, 1024, r, F.lane, RowIlv{128}, WF13_SCALE); continue; } r -= I_F1;
        if (r < I_F2) { transpose_item8(a.in[I_EF2], DFF, 1024, W_F2, DFF, r, F.lane, RowId{}, WF2_SCALE); continue; } r -= I_F2;
#else
        if (r < I_F1) { transpose_item_i8(a.in[I_EF1], 1024, DFF, W_F13, 1024, (float*)(ws + OFF_SW), r, F.lane, RowIlv{0}); continue; } r -= I_F1;
        if (r < I_F1) { transpose_item_i8(a.in[I_EF3], 1024, DFF, W_F13, 1024, (float*)(ws + OFF_SW), r, F.lane, RowIlv{128}); continue; } r -= I_F1;
        if (r < I_F2) { transpose_item8c(a.in[I_EF2], DFF, 1024, W_F2, DFF, r, F.lane, RowId{}, WF2_SCALE); continue; } r -= I_F2;
#endif
        if (r < I_CK) { transpose_item(a.in[I_ECK1], 2048, 64, CK1, 2048, scr, r, F.lane, RowId{}, KOne{}); continue; } r -= I_CK;
        transpose_item(a.in[I_ECV1], 2048, 64, CV1, 2048, scr, r, F.lane, RowId{}, KOne{});
    }
    const int gt = F.bx * NTHR + F.tid, NGT = F.G * NTHR;
    for (int i = gt; i < 24 * 1024 / 16; i += NGT) ((u32x4*)((unsigned char*)W_IN + 488 * 1024))[i] = (u32x4){0u, 0u, 0u, 0u};
    { const float* uq = a.in[I_EWUQ]; const float* uk = a.in[I_EWUK]; const float* qg = a.in[I_EQN];
      for (int o = gt; o < 1024 * 256; o += NGT) { const int r = o & 255, hc = o >> 8, h = hc >> 7, c = hc & 127; const float* p = uq + r * 512 + h * 64; const float* q = uk + c * 512 + h * 64; float s = 0.f;
#pragma unroll 8
          for (int d = 0; d < 64; ++d) s += p[d] * q[d];
          W_Q2[o] = (bf16_t)f2bf(s * qg[r]); } }
    { const float* uv = a.in[I_EWUV]; const float* wo = a.in[I_EWOUT];
      for (int o = gt; o < 1024 * 1024 / 16; o += NGT) { const int nb = o & 255, hc4 = o >> 8, h = hc4 >> 5, c0 = (hc4 & 31) * 4, n0 = nb * 4;
          const float* p = uv + (size_t)c0 * 512 + h * 64; const float* q = wo + (size_t)(h * 64) * 1024 + n0;
          f32x4 acc4[4] = {(f32x4){0.f, 0.f, 0.f, 0.f}, (f32x4){0.f, 0.f, 0.f, 0.f}, (f32x4){0.f, 0.f, 0.f, 0.f}, (f32x4){0.f, 0.f, 0.f, 0.f}};
#pragma unroll 4
          for (int d = 0; d < 64; ++d) { const f32x4 qv = *(const f32x4*)(q + (size_t)d * 1024);
#pragma unroll
              for (int cc = 0; cc < 4; ++cc) acc4[cc] += qv * p[cc * 512 + d]; }
#pragma unroll
          for (int cc = 0; cc < 4; ++cc)
#pragma unroll
              for (int e = 0; e < 4; ++e) W_OUTE[(size_t)(n0 + e) * 1536 + h * 128 + c0 + cc] = (unsigned char)(__builtin_amdgcn_cvt_pk_fp8_f32(acc4[cc][e] * WOUT_SCALE, 0.f, 0, false) & 0xff); } }
    if (F.bx == 0) { float* BT = (float*)(ws + OFF_BT); const float* rb = a.in[I_RELB];
        for (int i = F.tid; i < 16 * 128; i += NTHR) { const int h = i >> 7, d = i & 127; BT[i] = rb[t5_bucket(d) * 16 + h] * LOG2E; } }
    if (F.bx == 1 && F.tid < 128) { const int kv = F.tid >> 6, e = F.tid & 63; const float* pos = a.in[kv ? I_EPOSV : I_EPOSK]; const float* w1 = a.in[kv ? I_ECV1 : I_ECK1]; float s = 0.f;
        for (int k = 0; k < 2048; ++k) s += pos[k] * w1[k * 64 + e];
        ((float*)(ws + OFF_CB))[F.tid] = s; }
    { const f32x4* x4 = (const f32x4*)a.in[I_X]; u32x4* xb = (u32x4*)(ws + OFF_XB);
      for (int i = gt; i < MTOK * 1024 / 16; i += NGT) { const f32x4 v0 = x4[4 * i], v1 = x4[4 * i + 1], v2 = x4[4 * i + 2], v3 = x4[4 * i + 3];
          u32x4 o; o.x = pg8::pk4_fp8(v0[0], v0[1], v0[2], v0[3]); o.y = pg8::pk4_fp8(v1[0], v1[1], v1[2], v1[3]); o.z = pg8::pk4_fp8(v2[0], v2[1], v2[2], v2[3]); o.w = pg8::pk4_fp8(v3[0], v3[1], v3[2], v3[3]); xb[i] = o; } }
}

__device__ __forceinline__ void phase_convert_odd(const Frame& F, const Args& a) {
    LAS unsigned char* stg = F.lds + F.wave * 9216;
    unsigned char* ws = F.ws;
    unsigned char* W_OIN = ws + OFF_W_OIN; unsigned char* W_OOUT = ws + OFF_W_OOUT; unsigned char* W_M13 = ws + OFF_W_M13; unsigned char* W_M2 = ws + OFF_W_M2;
    constexpr int I_IN = 8 * 48, I_OUT = 8 * 16, I_M1 = 8 * (DFFE / 64), I_M2 = (DFFE / 128) * 16;
    constexpr int NIT = I_IN + I_OUT + NEXP * (2 * I_M1 + I_M2);
    for (int it = F.gw; it < NIT; it += F.NGW) {
        int r = it;
        if (r < I_IN) { transpose_item8s(a.in[I_OWIN], 1024, 3072, W_OIN, 1024, r, F.lane, RowId{}, WIN_SCALE, stg); continue; } r -= I_IN;
        if (r < I_OUT) { transpose_item8s(a.in[I_OWOUT], 1024, 1024, W_OOUT, 1024, r, F.lane, RowId{}, WOUT_SCALE, stg); continue; } r -= I_OUT;
        const int e = r / (2 * I_M1 + I_M2); r -= e * (2 * I_M1 + I_M2);
        if (r < I_M1) { transpose_item8s(a.in[I_OM1] + (size_t)e * 1024 * DFFE, 1024, DFFE, W_M13 + (size_t)e * 2 * DFFE * 1024, 1024, r, F.lane, RowIlv{0}, W13_SCALE, stg); continue; } r -= I_M1;
        if (r < I_M1) { transpose_item8s(a.in[I_OM3] + (size_t)e * 1024 * DFFE, 1024, DFFE, W_M13 + (size_t)e * 2 * DFFE * 1024, 1024, r, F.lane, RowIlv{128}, W13_SCALE, stg); continue; } r -= I_M1;
        transpose_item8s(a.in[I_OM2] + (size_t)e * DFFE * 1024, DFFE, 1024, W_M2 + (size_t)e * 1024 * DFFE, DFFE, r, F.lane, RowId{}, W2_SCALE, stg);
    }
}

__device__ __forceinline__ void load_row_bf16(const bf16_t* row, int lane, f32x4 (&v)[4]) {
#pragma unroll
    for (int j = 0; j < 4; ++j) { const u32x2 w = *(const u32x2*)(row + 4 * lane + 256 * j); v[j] = (f32x4){bflo(w.x), bfhi(w.x), bflo(w.y), bfhi(w.y)}; }
}
__device__ __forceinline__ void fetch_row_bf16(const bf16_t* row, int lane, u32x2 (&w)[4]) {
#pragma unroll
    for (int j = 0; j < 4; ++j) w[j] = *(const u32x2*)(row + 4 * lane + 256 * j);
}
__device__ __forceinline__ void unpack_row_bf16(const u32x2 (&w)[4], f32x4 (&v)[4]) {
#pragma unroll
    for (int j = 0; j < 4; ++j) v[j] = (f32x4){bflo(w[j].x), bfhi(w[j].x), bflo(w[j].y), bfhi(w[j].y)};
}
constexpr int RB = 2;
__device__ __forceinline__ void store_row_bf16(bf16_t* row, int lane, const f32x4 (&v)[4]) {
#pragma unroll
    for (int j = 0; j < 4; ++j) { u32x2 w; w.x = pk2(v[j][0], v[j][1]); w.y = pk2(v[j][2], v[j][3]); *(u32x2*)(row + 4 * lane + 256 * j) = w; }
}
__device__ __forceinline__ void ln_inplace(f32x4 (&v)[4], const f32x4 (&g)[4], const f32x4 (&b)[4]) {
    float s = 0.f;
#pragma unroll
    for (int j = 0; j < 4; ++j) s += (v[j][0] + v[j][1]) + (v[j][2] + v[j][3]);
    const float mean = wave_sum(s) * (1.f / 1024.f); float q = 0.f;
#pragma unroll
    for (int j = 0; j < 4; ++j) { v[j] = v[j] - mean; q += (v[j][0] * v[j][0] + v[j][1] * v[j][1]) + (v[j][2] * v[j][2] + v[j][3] * v[j][3]); }
    const float rstd = 1.f / sqrtf(wave_sum(q) * (1.f / 1024.f) + 1e-5f);
#pragma unroll
    for (int j = 0; j < 4; ++j) v[j] = v[j] * rstd * g[j] + b[j];
}
__device__ __forceinline__ void load_gb(const float* g, const float* b, int lane, f32x4 (&gv)[4], f32x4 (&bv)[4]) {
#pragma unroll
    for (int j = 0; j < 4; ++j) { gv[j] = *(const f32x4*)(g + 4 * lane + 256 * j); bv[j] = *(const f32x4*)(b + 4 * lane + 256 * j); }
}
__device__ __forceinline__ void pin_row(u32x2 (&w)[4]) {
    asm volatile("" : "+v"(w[0].x), "+v"(w[0].y), "+v"(w[1].x), "+v"(w[1].y), "+v"(w[2].x), "+v"(w[2].y), "+v"(w[3].x), "+v"(w[3].y) :: "memory");
}
template <class P> __device__ __forceinline__ void row_pipeline(const Frame& F, const bf16_t* S, P proc) {
    if (F.gw >= MTOK) return;
    u32x2 c0[4], c1[4]; fetch_row_bf16(S + (size_t)F.gw * 1024, F.lane, c0);
    int row = F.gw;
    for (; row + F.NGW < MTOK; row += 2 * F.NGW) {
        fetch_row_bf16(S + (size_t)(row + F.NGW) * 1024, F.lane, c1); pin_row(c0); proc(row, c0);
        const int rn = (row + 2 * F.NGW < MTOK) ? row + 2 * F.NGW : F.gw; fetch_row_bf16(S + (size_t)rn * 1024, F.lane, c0); pin_row(c1); proc(row + F.NGW, c1);
    }
    if (row < MTOK) proc(row, c0);
}
__device__ __forceinline__ void store_row_fp8(unsigned char* row, int lane, const f32x4 (&v)[4]) {
#pragma unroll
    for (int j = 0; j < 4; ++j) *(unsigned*)(row + 4 * lane + 256 * j) = pg8::pk4_fp8(v[j][0], v[j][1], v[j][2], v[j][3]);
}
__device__ __forceinline__ void phase_ln_bf16(const Frame& F, const bf16_t* S, bf16_t* O, unsigned char* O8, const float* g, const float* b) {
    f32x4 gv[4], bv[4]; load_gb(g, b, F.lane, gv, bv);
    row_pipeline(F, S, [&](int row, const u32x2 (&raw)[4]) { f32x4 v[4]; unpack_row_bf16(raw, v); ln_inplace(v, gv, bv); store_row_bf16(O + (size_t)row * 1024, F.lane, v); store_row_fp8(O8 + (size_t)row * 1024, F.lane, v); });
}
__device__ __forceinline__ void phase_ln_i8(const Frame& F, const bf16_t* S, bf16_t* O, unsigned char* O8, float* sa, const float* g, const float* b) {
    f32x4 gv[4], bv[4]; load_gb(g, b, F.lane, gv, bv);
    row_pipeline(F, S, [&](int row, const u32x2 (&raw)[4]) { f32x4 v[4]; unpack_row_bf16(raw, v); ln_inplace(v, gv, bv); store_row_bf16(O + (size_t)row * 1024, F.lane, v); store_row_i8(O8 + (size_t)row * 1024, sa + row, F.lane, v); });
}
__device__ __forceinline__ void phase_ckvn(const Frame& F, const bf16_t* T1, const float* ssq_kv, const float* gain, bf16_t* CKVN) {
    const float g0 = gain[2 * F.lane], g1 = gain[2 * F.lane + 1];
    for (int row = F.gw; row < MTOK; row += F.NGW) {
        const unsigned w = *(const unsigned*)(T1 + (size_t)row * 256 + 2 * F.lane);
        const f32x4 sq = *(const f32x4*)(ssq_kv + (size_t)row * 4); const float r = __builtin_amdgcn_rsqf(((sq[0] + sq[1]) + (sq[2] + sq[3])) * (1.f / 128.f) + 1e-6f);
        *(unsigned*)(CKVN + (size_t)row * 128 + 2 * F.lane) = pk2(bflo(w) * r * g0, bfhi(w) * r * g1);
    }
}
__device__ __forceinline__ void phase_ln_router(const Frame& F, const bf16_t* S, bf16_t* H2, const float* g, const float* b, const float* router, unsigned char* ws) {
    LAS int* cnt = (LAS int*)(F.lds);
    if (F.tid < 8) cnt[F.tid] = 0;
    __syncthreads();
    f32x4 gv[4], bv[4]; load_gb(g, b, F.lane, gv, bv);
    u32x2* ROUTE = (u32x2*)(ws + OFF_ROUTE);
    f32x4 rw[16][2];
#pragma unroll
    for (int j = 0; j < 4; ++j)
#pragma unroll
        for (int e = 0; e < 4; ++e) { const float* rp = router + (size_t)(4 * F.lane + 256 * j + e) * 8; rw[4 * j + e][0] = *(const f32x4*)rp; rw[4 * j + e][1] = *(const f32x4*)(rp + 4); }
    const bool b0 = F.lane & 1, b1 = F.lane & 2, b2 = F.lane & 4;
    for (int row0 = F.gw; row0 < MTOK; row0 += RB * F.NGW) { u32x2 raw[RB][4];
#pragma unroll
      for (int j = 0; j < RB; ++j) { const int row = row0 + j * F.NGW; if (row < MTOK) fetch_row_bf16(S + (size_t)row * 1024, F.lane, raw[j]); }
#pragma unroll
      for (int j = 0; j < RB; ++j) { const int row = row0 + j * F.NGW; if (row >= MTOK) continue;
        f32x4 v[4]; unpack_row_bf16(raw[j], v); ln_inplace(v, gv, bv); store_row_bf16(H2 + (size_t)row * 1024, F.lane, v);
        float pl[8];
#pragma unroll
        for (int x = 0; x < 8; ++x) pl[x] = 0.f;
#pragma unroll
        for (int j = 0; j < 4; ++j)
#pragma unroll
            for (int e = 0; e < 4; ++e) { const f32x4 r0 = rw[4 * j + e][0], r1 = rw[4 * j + e][1]; const float hv = v[j][e];
                pl[0] += hv * r0[0]; pl[1] += hv * r0[1]; pl[2] += hv * r0[2]; pl[3] += hv * r0[3]; pl[4] += hv * r1[0]; pl[5] += hv * r1[1]; pl[6] += hv * r1[2]; pl[7] += hv * r1[3]; }
        float k4[4], k2[2], k1;
#pragma unroll
        for (int i = 0; i < 4; ++i) { const float send = b0 ? pl[i] : pl[i + 4]; k4[i] = (b0 ? pl[i + 4] : pl[i]) + __shfl_xor(send, 1); }
#pragma unroll
        for (int i = 0; i < 2; ++i) { const float send = b1 ? k4[i] : k4[i + 2]; k2[i] = (b1 ? k4[i + 2] : k4[i]) + __shfl_xor(send, 2); }
        { const float send = b2 ? k2[0] : k2[1]; k1 = (b2 ? k2[1] : k2[0]) + __shfl_xor(send, 4); }
        k1 += __shfl_xor(k1, 8); k1 += __shfl_xor(k1, 16); k1 += __shfl_xor(k1, 32);
        float lg[8];
#pragma unroll
        for (int x = 0; x < 8; ++x) lg[x] = __int_as_float(__builtin_amdgcn_readlane(__float_as_int(k1), (x >> 2) | (((x >> 1) & 1) << 1) | ((x & 1) << 2)));
        int e0 = 0; float l0 = lg[0];
#pragma unroll
        for (int x = 1; x < 8; ++x) if (lg[x] > l0) { l0 = lg[x]; e0 = x; }
        int e1 = -1; float l1 = -INFINITY;
#pragma unroll
        for (int x = 0; x < 8; ++x) if (x != e0 && lg[x] > l1) { l1 = lg[x]; e1 = x; }
        const float g0 = 1.f / (1.f + __expf(l1 - l0));
        if (F.lane == 0) { u32x2 r; r.x = (unsigned)e0 | ((unsigned)e1 << 8); r.y = __builtin_bit_cast(unsigned, g0); ROUTE[row] = r;
            __hip_atomic_fetch_add(cnt + e0, 1, __ATOMIC_RELAXED, __HIP_MEMORY_SCOPE_WORKGROUP); __hip_atomic_fetch_add(cnt + e1, 1, __ATOMIC_RELAXED, __HIP_MEMORY_SCOPE_WORKGROUP); }
      }
    }
    __syncthreads();
    if (F.tid < 8) ((int*)(ws + OFF_WGCNT))[F.bx * 8 + F.tid] = cnt[F.tid];
    __syncthreads();
}
__device__ __forceinline__ void phase_moe_gather(const Frame& F, const bf16_t* H2, unsigned char* XR, unsigned char* ws) {
    LAS int* L = (LAS int*)(F.lds);
    const int* WGCNT = (const int*)(ws + OFF_WGCNT);
    { const int e = F.wave; int t = 0, p = 0;
#pragma unroll
      for (int k = 0; k < 4; ++k) { const int wg = F.lane + 64 * k; const int c = (wg < F.G) ? WGCNT[wg * 8 + e] : 0; t += c; p += (wg < F.bx) ? c : 0; }
      t = (int)wave_sum((float)t); p = (int)wave_sum((float)p);
      if (F.lane == 0) { L[e] = t; L[8 + e] = p; L[24 + e] = 0; } }
    __syncthreads();
    if (F.tid == 0) { int acc = 0;
        for (int e = 0; e < 8; ++e) { const int pad = (L[e] + 255) / 256 * 256; L[32 + e] = acc; L[16 + e] = acc + L[8 + e]; acc += pad; L[40 + e] = acc; }
        if (F.bx == 0) { int* GI = (int*)(ws + OFF_GINFO); for (int e = 0; e < 8; ++e) { GI[e] = L[40 + e]; GI[8 + e] = L[e]; } } }
    __syncthreads();
    const u32x2* ROUTE = (const u32x2*)(ws + OFF_ROUTE); int* DEST = (int*)(ws + OFF_DEST);
    for (int row = F.gw; row < MTOK; row += F.NGW) {
        const u32x2 r = ROUTE[row]; const int e0 = r.x & 255, e1 = (r.x >> 8) & 255; int s0 = 0, s1 = 0;
        if (F.lane == 0) { s0 = L[16 + e0] + __hip_atomic_fetch_add(L + 24 + e0, 1, __ATOMIC_RELAXED, __HIP_MEMORY_SCOPE_WORKGROUP); s1 = L[16 + e1] + __hip_atomic_fetch_add(L + 24 + e1, 1, __ATOMIC_RELAXED, __HIP_MEMORY_SCOPE_WORKGROUP);
            DEST[2 * row] = s0; DEST[2 * row + 1] = s1; }
        s0 = __builtin_amdgcn_readfirstlane(s0); s1 = __builtin_amdgcn_readfirstlane(s1);
        const u32x4* src = (const u32x4*)(H2 + (size_t)row * 1024) + 2 * F.lane; const u32x4 a = src[0], b = src[1];
        u32x4 o; o.x = pg8::pk4_fp8(bflo(a.x), bfhi(a.x), bflo(a.y), bfhi(a.y)); o.y = pg8::pk4_fp8(bflo(a.z), bfhi(a.z), bflo(a.w), bfhi(a.w));
        o.z = pg8::pk4_fp8(bflo(b.x), bfhi(b.x), bflo(b.y), bfhi(b.y)); o.w = pg8::pk4_fp8(bflo(b.z), bfhi(b.z), bflo(b.w), bfhi(b.w));
        ((u32x4*)(XR + (size_t)s0 * 1024))[F.lane] = o; ((u32x4*)(XR + (size_t)s1 * 1024))[F.lane] = o;
    }
    for (int e = 0; e < 8; ++e) { const int r0 = L[32 + e] + L[e], npad = L[40 + e] - r0;
        for (int i = F.gw; i < npad; i += F.NGW) { u32x4* d = (u32x4*)(XR + (size_t)(r0 + i) * 1024); d[F.lane] = (u32x4){0u, 0u, 0u, 0u}; } }
    __syncthreads();
}
__device__ __forceinline__ void phase_final(const Frame& F, const bf16_t* H2, const bf16_t* YR, const float* g, const float* b, float* out, unsigned char* ws) {
    f32x4 gv[4], bv[4]; load_gb(g, b, F.lane, gv, bv);
    const u32x2* ROUTE = (const u32x2*)(ws + OFF_ROUTE); const int* DEST = (const int*)(ws + OFF_DEST);
    if (F.gw >= MTOK) return;
    const u32x2* DEST2 = (const u32x2*)DEST;
    auto cl = [&](int r) { return r < MTOK ? r : F.gw; };
    auto finish = [&](int row, float g0, const u32x2 (&hw)[4], const u32x2 (&aw)[4], const u32x2 (&bw)[4]) {
        const float g1 = 1.f - g0; f32x4 v[4], y0[4], y1[4]; unpack_row_bf16(hw, v); unpack_row_bf16(aw, y0); unpack_row_bf16(bw, y1);
#pragma unroll
        for (int j = 0; j < 4; ++j) v[j] = v[j] * ALPHA + y0[j] * g0 + y1[j] * g1;
        ln_inplace(v, gv, bv);
#pragma unroll
        for (int j = 0; j < 4; ++j) *(f32x4*)(out + (size_t)row * 1024 + 4 * F.lane + 256 * j) = v[j]; };
    int r1 = cl(F.gw + F.NGW); u32x2 rB = ROUTE[r1], dB = DEST2[r1]; asm volatile("" ::: "memory");
    u32x2 rA = ROUTE[F.gw], dA = DEST2[F.gw];
    u32x2 h0[4], a0[4], b0[4], h1[4], a1[4], b1[4];
    fetch_row_bf16(H2 + (size_t)F.gw * 1024, F.lane, h0); fetch_row_bf16(YR + (size_t)dA.x * 1024, F.lane, a0); fetch_row_bf16(YR + (size_t)dA.y * 1024, F.lane, b0);
    int row = F.gw;
    for (; row + F.NGW < MTOK; row += 2 * F.NGW) {
        const int r2 = cl(row + 2 * F.NGW), r3 = cl(row + 3 * F.NGW);
        { const float g0 = __uint_as_float(rA.y); rA = ROUTE[r2]; dA = DEST2[r2]; asm volatile("" ::: "memory");
          fetch_row_bf16(H2 + (size_t)r1 * 1024, F.lane, h1); fetch_row_bf16(YR + (size_t)dB.x * 1024, F.lane, a1); fetch_row_bf16(YR + (size_t)dB.y * 1024, F.lane, b1);
          pin_row(h0); pin_row(a0); pin_row(b0); finish(row, g0, h0, a0, b0); }
        { const float g0 = __uint_as_float(rB.y); rB = ROUTE[r3]; dB = DEST2[r3]; asm volatile("" ::: "memory");
          fetch_row_bf16(H2 + (size_t)r2 * 1024, F.lane, h0); fetch_row_bf16(YR + (size_t)dA.x * 1024, F.lane, a0); fetch_row_bf16(YR + (size_t)dA.y * 1024, F.lane, b0);
          pin_row(h1); pin_row(a1); pin_row(b1); finish(row + F.NGW, g0, h1, a1, b1); }
        r1 = r3;
    }
    if (row < MTOK) finish(row, __uint_as_float(rA.y), h0, a0, b0);
}

namespace att {
constexpr float NEG_BIG = -1e30f;
constexpr int KS64 = 144, VS64 = 192, KT64 = 64 * KS64, VT64 = 64 * VS64;
constexpr int KS128 = 272, VS128 = 320, KT128 = 64 * KS128, VT128 = 64 * VS128;
typedef LAS char* lptr; typedef const LAS char* lcptr;
typedef short v4i16_t __attribute__((ext_vector_type(4)));
__device__ __forceinline__ s16x4 vtr(lcptr p) { return __builtin_bit_cast(s16x4, __builtin_amdgcn_ds_read_tr16_b64_v4i16((LAS v4i16_t*)p)); }
__device__ __forceinline__ f32x16 splat16(float c) { f32x16 v;
#pragma unroll
    for (int r = 0; r < 16; ++r) v[r] = c; return v; }
__device__ __forceinline__ int crow(int r, int hi) { return (r & 3) + 8 * (r >> 2) + 4 * hi; }
__device__ __forceinline__ float ex2(float x) { return __builtin_amdgcn_exp2f(x); }

template <int NKS> __device__ __forceinline__ void qk(f32x16& s0, f32x16& s1, lcptr Kt, int kstride, const bf16x8 (&qf)[NKS], float c0, int r32, int hi) {
    s0 = splat16(c0); s1 = splat16(c0);
    lcptr p0 = Kt + r32 * kstride + hi * 16; lcptr p1 = p0 + 32 * kstride;
#pragma unroll
    for (int ks = 0; ks < NKS; ++ks) { const bf16x8 k0 = *(const LAS bf16x8*)(p0 + ks * 32), k1 = *(const LAS bf16x8*)(p1 + ks * 32);
        s0 = __builtin_amdgcn_mfma_f32_32x32x16_bf16(k0, qf[ks], s0, 0, 0, 0); s1 = __builtin_amdgcn_mfma_f32_32x32x16_bf16(k1, qf[ks], s1, 0, 0, 0); }
}
__device__ __forceinline__ float rowmax32(const f32x16& s0, const f32x16& s1) {
    float a = fmaxf(s0[0], s1[0]);
#pragma unroll
    for (int r = 1; r < 16; ++r) a = fmaxf(a, fmaxf(s0[r], s1[r]));
    return fmaxf(a, __shfl_xor(a, 32));
}
template <int NDT> __device__ __forceinline__ void softmax_step(f32x16& s0, f32x16& s1, float& m, float& l, f32x16 (&o)[NDT]) {
    const float mn = fmaxf(m, rowmax32(s0, s1)); float rs = 0.f;
    if (__any(mn > m)) {
        const float al = ex2(m - mn); l *= al;
#pragma unroll
        for (int d = 0; d < NDT; ++d)
#pragma unroll
            for (int r = 0; r < 16; ++r) o[d][r] *= al;
    }
    m = mn;
#pragma unroll
    for (int r = 0; r < 16; ++r) { s0[r] = ex2(s0[r] - mn); s1[r] = ex2(s1[r] - mn); rs += s0[r] + s1[r]; }
    l += rs;
}
__device__ __forceinline__ bf16x8 pack_p(const f32x16& s, int base) { u32x4 w; w.x = pk2(s[base], s[base + 1]); w.y = pk2(s[base + 2], s[base + 3]); w.z = pk2(s[base + 4], s[base + 5]); w.w = pk2(s[base + 6], s[base + 7]); return __builtin_bit_cast(bf16x8, w); }
__device__ __forceinline__ bf16x8 fp8x8_bf16(const u32x2 w) {
    const f32x2 a = __builtin_amdgcn_cvt_pk_f32_fp8((int)w.x, false), b = __builtin_amdgcn_cvt_pk_f32_fp8((int)w.x, true), c = __builtin_amdgcn_cvt_pk_f32_fp8((int)w.y, false), d = __builtin_amdgcn_cvt_pk_f32_fp8((int)w.y, true);
    u32x4 o; o.x = pk2(a[0], a[1]); o.y = pk2(b[0], b[1]); o.z = pk2(c[0], c[1]); o.w = pk2(d[0], d[1]); return __builtin_bit_cast(bf16x8, o);
}
template <int NDT> __device__ __forceinline__ void pv(f32x16 (&o)[NDT], const f32x16& s0, const f32x16& s1, lcptr Vt, int vstride, int lane) {
    const bf16x8 pk[4] = {pack_p(s0, 0), pack_p(s0, 8), pack_p(s1, 0), pack_p(s1, 8)};
    const int h = lane >> 5, g = (lane >> 4) & 1, q = (lane & 15) >> 2, p = lane & 3;
    lcptr vb = Vt + (4 * h + q) * vstride + (16 * g + 4 * p) * 2;
#pragma unroll
    for (int k = 0; k < 4; ++k)
#pragma unroll
        for (int d = 0; d < NDT; ++d) { const s16x4 lo = vtr(vb + (16 * k) * vstride + d * 64), hh = vtr(vb + (16 * k + 8) * vstride + d * 64);
            const bf16x8 vf = (bf16x8){lo[0], lo[1], lo[2], lo[3], hh[0], hh[1], hh[2], hh[3]};
            o[d] = __builtin_amdgcn_mfma_f32_32x32x16_bf16(vf, pk[k], o[d], 0, 0, 0); }
}

__device__ __forceinline__ void exp_step(f32x16& s0, f32x16& s1, float& l) {
    f32x2 rs2 = {0.f, 0.f};
#pragma unroll
    for (int r = 0; r < 8; ++r) { s0[2 * r] = ex2(s0[2 * r]); s0[2 * r + 1] = ex2(s0[2 * r + 1]); s1[2 * r] = ex2(s1[2 * r]); s1[2 * r + 1] = ex2(s1[2 * r + 1]);
        rs2 += (f32x2){s0[2 * r], s0[2 * r + 1]}; rs2 += (f32x2){s1[2 * r], s1[2 * r + 1]}; }
    l += rs2.x + rs2.y;
}

__device__ __forceinline__ void qk2(f32x16& a0, f32x16& a1, f32x16& b0, f32x16& b1, lcptr Kt, const bf16x8 (&qa)[4], const bf16x8 (&qb)[4], int r32, int hi) {
    a0 = splat16(0.f); a1 = splat16(0.f); b0 = splat16(0.f); b1 = splat16(0.f);
    lcptr p0 = Kt + r32 * KS64 + hi * 16; lcptr p1 = p0 + 32 * KS64;
#pragma unroll
    for (int ks = 0; ks < 4; ++ks) { const bf16x8 k0 = *(const LAS bf16x8*)(p0 + ks * 32), k1 = *(const LAS bf16x8*)(p1 + ks * 32);
        a0 = __builtin_amdgcn_mfma_f32_32x32x16_bf16(k0, qa[ks], a0, 0, 0, 0); b0 = __builtin_amdgcn_mfma_f32_32x32x16_bf16(k0, qb[ks], b0, 0, 0, 0);
        a1 = __builtin_amdgcn_mfma_f32_32x32x16_bf16(k1, qa[ks], a1, 0, 0, 0); b1 = __builtin_amdgcn_mfma_f32_32x32x16_bf16(k1, qb[ks], b1, 0, 0, 0); }
}
__device__ __forceinline__ void pv2(f32x16 (&oa)[2], f32x16 (&ob)[2], const bf16x8 (&pa)[4], const bf16x8 (&pb)[4], lcptr Vt, int lane) {
    const int h = lane >> 5, g = (lane >> 4) & 1, q = (lane & 15) >> 2, p = lane & 3;
    lcptr vb = Vt + (4 * h + q) * VS64 + (16 * g + 4 * p) * 2;
#pragma unroll
    for (int k = 0; k < 4; ++k)
#pragma unroll
        for (int d = 0; d < 2; ++d) { const s16x4 lo = vtr(vb + (16 * k) * VS64 + d * 64), hh = vtr(vb + (16 * k + 8) * VS64 + d * 64);
            const bf16x8 vf = (bf16x8){lo[0], lo[1], lo[2], lo[3], hh[0], hh[1], hh[2], hh[3]};
            oa[d] = __builtin_amdgcn_mfma_f32_32x32x16_bf16(vf, pa[k], oa[d], 0, 0, 0); ob[d] = __builtin_amdgcn_mfma_f32_32x32x16_bf16(vf, pb[k], ob[d], 0, 0, 0); }
}
__device__ __forceinline__ void bias_mask_near(f32x16& s0, f32x16& s1, const LAS float* bt, int t, int kp0, int hi, unsigned maxdist) {
#pragma unroll
    for (int q4 = 0; q4 < 4; ++q4) {
        float bb[8]; f32x16& s = (q4 & 2) ? s1 : s0; const int r0 = 8 * (q4 & 1), kq = kp0 + 32 * (q4 >> 1);
#pragma unroll
        for (int r = 0; r < 8; ++r) { const int d = t - (kq + crow(r0 + r, hi)); const unsigned ix = (unsigned)d < 127u ? (unsigned)d : 127u; bb[r] = bt[ix]; }
#pragma unroll
        for (int r = 0; r < 8; ++r) asm volatile("" : "+v"(bb[r]));
#pragma unroll
        for (int r = 0; r < 8; ++r) { const int d = t - (kq + crow(r0 + r, hi)); s[r0 + r] = ((unsigned)d < maxdist) ? s[r0 + r] + bb[r] : -INFINITY; }
    }
}
__device__ __forceinline__ void mask_all(f32x16& s0, f32x16& s1) {
#pragma unroll
    for (int r = 0; r < 16; ++r) { s0[r] = -INFINITY; s1[r] = -INFINITY; }
}
__device__ __forceinline__ void store_o64(bf16_t* orow, const f32x16 (&o)[2], float sc, int hi) {
#pragma unroll
    for (int d = 0; d < 2; ++d)
#pragma unroll
        for (int rg = 0; rg < 4; ++rg) { u32x2 w; w.x = pk2(o[d][4 * rg] * sc, o[d][4 * rg + 1] * sc); w.y = pk2(o[d][4 * rg + 2] * sc, o[d][4 * rg + 3] * sc);
            *(u32x2*)(orow + 32 * d + 8 * rg + 4 * hi) = w; }
}
__device__ __forceinline__ void store_o64_fp8(unsigned char* orow, const f32x16 (&o)[2], float sc, int hi) {
#pragma unroll
    for (int d = 0; d < 2; ++d)
#pragma unroll
        for (int rg = 0; rg < 4; ++rg) *(unsigned*)(orow + 32 * d + 8 * rg + 4 * hi) = pg8::pk4_fp8(o[d][4 * rg] * sc, o[d][4 * rg + 1] * sc, o[d][4 * rg + 2] * sc, o[d][4 * rg + 3] * sc);
}
template <class Src, class Proc> __device__ __forceinline__ void tile_loop64(int tid, lptr base, int nt, int pitch, Src src, Proc proc) {
    if (nt <= 0) return;
    const int row = tid >> 3, ch = tid & 7; u32x4 kr, vr;
    lptr Kb = base, Vb = base + 2 * KT64;
    { const bf16_t *kp, *vp; src(0, kp, vp); kr = *(const u32x4*)(kp + (size_t)row * pitch + ch * 8); vr = *(const u32x4*)(vp + (size_t)row * pitch + ch * 8); }
    *(LAS u32x4*)(Kb + row * KS64 + ch * 16) = kr; *(LAS u32x4*)(Vb + row * VS64 + ch * 16) = vr;
    __syncthreads();
    for (int i = 0; i < nt; ++i) {
        const bool more = i + 1 < nt;
        if (more) { const bf16_t *kp, *vp; src(i + 1, kp, vp); kr = *(const u32x4*)(kp + (size_t)row * pitch + ch * 8); vr = *(const u32x4*)(vp + (size_t)row * pitch + ch * 8); }
        proc(i, (lcptr)(Kb + (i & 1) * KT64), (lcptr)(Vb + (i & 1) * VT64));
        if (more) { *(LAS u32x4*)(Kb + ((i + 1) & 1) * KT64 + row * KS64 + ch * 16) = kr; *(LAS u32x4*)(Vb + ((i + 1) & 1) * VT64 + row * VS64 + ch * 16) = vr; }
        __syncthreads();
    }
}

constexpr int TL128_BYTES = 4 * KT64 + 4 * VT64;
template <class Src, class Proc> __device__ __forceinline__ void tile_loop128(int tid, lptr base, int nt, int pitch, Src src, Proc proc) {
    if (nt <= 0) return;
    const int row = tid >> 3, ch = tid & 7; u32x4 kr0, vr0;
    lptr Kb = base, Vb = base + 4 * KT64;
    auto ld = [&](int i, u32x4& kr, u32x4& vr) { const bf16_t *kp, *vp; src(i < nt ? i : nt - 1, kp, vp); kr = *(const u32x4*)(kp + (size_t)row * pitch + ch * 8); vr = *(const u32x4*)(vp + (size_t)row * pitch + ch * 8); };
    auto st = [&](int stage, int half, const u32x4& kr, const u32x4& vr) { *(LAS u32x4*)(Kb + stage * 2 * KT64 + half * KT64 + row * KS64 + ch * 16) = kr; *(LAS u32x4*)(Vb + stage * 2 * VT64 + half * VT64 + row * VS64 + ch * 16) = vr; };
    ld(0, kr0, vr0); st(0, 0, kr0, vr0); ld(1, kr0, vr0); st(0, 1, kr0, vr0);
    __syncthreads();
    const int nit = (nt + 1) >> 1;
    for (int it = 0; it < nit; ++it) {
        const bool more = it + 1 < nit; const int sg = it & 1;
        if (more) ld(2 * it + 2, kr0, vr0);
        proc(2 * it, (lcptr)(Kb + sg * 2 * KT64), (lcptr)(Vb + sg * 2 * VT64));
        if (more) { st(sg ^ 1, 0, kr0, vr0); ld(2 * it + 3, kr0, vr0); }
        if (2 * it + 1 < nt) proc(2 * it + 1, (lcptr)(Kb + sg * 2 * KT64 + KT64), (lcptr)(Vb + sg * 2 * VT64 + VT64));
        if (more) st(sg ^ 1, 1, kr0, vr0);
        __syncthreads();
    }
}

template <int ROWB, int KSTR, int VSTR, int VAR = 0, class SrcK, class SrcV, class Score, class Accum>
__device__ __forceinline__ void tile_loop_p(int tid, lptr base, int nt, int pitch, SrcK srck, SrcV srcv, Score score, Accum accum) {
    if (nt <= 0) return;
    constexpr int CPR = ROWB / 16, NCH = (64 * CPR) / 512, KT = 64 * KSTR, VT = 64 * VSTR;
    lptr Kb = base, Vb = base + 2 * KT;
    u32x4 kr0[NCH], vr0[NCH], kr1[NCH], vr1[NCH];
    auto gld = [&](const bf16_t* p, u32x4 (&r)[NCH]) {
#pragma unroll
        for (int c = 0; c < NCH; ++c) { const int idx = tid + 512 * c, rr = idx / CPR, ch = idx % CPR; r[c] = *(const u32x4*)(p + (size_t)rr * pitch + ch * 8); } };
    auto lst = [&](lptr dst, int stride, const u32x4 (&r)[NCH]) {
#pragma unroll
        for (int c = 0; c < NCH; ++c) { const int idx = tid + 512 * c, rr = idx / CPR, ch = idx % CPR; *(LAS u32x4*)(dst + rr * stride + ch * 16) = r[c]; } };
    gld(srck(0), kr0); gld(srcv(0), vr0); lst(Kb, KSTR, kr0); lst(Vb, VSTR, vr0);
    if (nt > 1) { gld(srck(1), kr0); lst(Kb + KT, KSTR, kr0); }
    if (nt > 2) gld(srck(2), kr1);
    if (nt > 1) gld(srcv(1), vr1);
    __syncthreads();
    f32x16 a0, a1, b0, b1; bool aact = score(0, (lcptr)Kb, a0, a1), bact = false;
    auto step = [&](int i, f32x16& c0, f32x16& c1, bool& cact, f32x16& n0, f32x16& n1, bool& nact, u32x4 (&kL)[NCH], u32x4 (&vL)[NCH], u32x4 (&kS)[NCH], u32x4 (&vS)[NCH]) {
        const bool m1 = i + 1 < nt, m2 = i + 2 < nt, m3 = i + 3 < nt;
        if (VAR != 7) { if (m3) gld(srck(i + 3), kL);
        if (m2) gld(srcv(i + 2), vL); }
        nact = false;
        if (m1) nact = score(i + 1, (lcptr)(Kb + ((i + 1) & 1) * KT), n0, n1);
        if (cact) accum(i, (lcptr)(Vb + (i & 1) * VT), c0, c1);
        if (VAR != 7) { if (m2) lst(Kb + (i & 1) * KT, KSTR, kS);
        if (m1) lst(Vb + ((i + 1) & 1) * VT, VSTR, vS); }
        __syncthreads();
    };
    for (int i = 0; i < nt; i += 2) { step(i, a0, a1, aact, b0, b1, bact, kr0, vr0, kr1, vr1); if (i + 1 < nt) step(i + 1, b0, b1, bact, a0, a1, aact, kr1, vr1, kr0, vr0); }
}

template <int ROWB, int KSTR, int VSTR, class SrcK, class SrcV, class Score, class Accum>
__device__ __forceinline__ void tile_loop_pp(int tid, int grp, lptr base, int nt, int pitch, SrcK srck, SrcV srcv, Score score, Accum accum) {
    if (nt <= 0) return;
    constexpr int CPR = ROWB / 16, NCH = (64 * CPR) / 512, KT = 64 * KSTR, VT = 64 * VSTR;
    lptr Kb = base, Vb = base + 2 * KT;
    u32x4 kr0[NCH], vr0[NCH], kr1[NCH], vr1[NCH];
    auto gld = [&](const bf16_t* p, u32x4 (&r)[NCH]) {
#pragma unroll
        for (int c = 0; c < NCH; ++c) { const int idx = tid + 512 * c, rr = idx / CPR, ch = idx % CPR; r[c] = *(const u32x4*)(p + (size_t)rr * pitch + ch * 8); } };
    auto lst = [&](lptr dst, int stride, const u32x4 (&r)[NCH]) {
#pragma unroll
        for (int c = 0; c < NCH; ++c) { const int idx = tid + 512 * c, rr = idx / CPR, ch = idx % CPR; *(LAS u32x4*)(dst + rr * stride + ch * 16) = r[c]; } };
    gld(srck(0), kr0); gld(srcv(0), vr0); lst(Kb, KSTR, kr0); lst(Vb, VSTR, vr0);
    if (nt > 1) { gld(srck(1), kr0); gld(srcv(1), vr0); }
    if (nt > 2) { gld(srck(2), kr1); gld(srcv(2), vr1); }
    __syncthreads();
    f32x16 s0, s1; bool act = false;
    const int nslot = 2 * nt + 1;
    auto slot_fn = [&](int slot, u32x4 (&kS)[NCH], u32x4 (&vS)[NCH]) {
        const int my = slot - grp;
        if (my >= 0 && my < 2 * nt) { const int i = my >> 1;
            if (!(my & 1)) act = score(i, (lcptr)(Kb + (i & 1) * KT), s0, s1);
            else if (act) accum(i, (lcptr)(Vb + (i & 1) * VT), s0, s1); }
        if (slot & 1) { const int j = (slot >> 1) + 1;
            if (j < nt) { lst(Kb + (j & 1) * KT, KSTR, kS); lst(Vb + (j & 1) * VT, VSTR, vS); }
            if (j + 2 < nt) { gld(srck(j + 2), kS); gld(srcv(j + 2), vS); } }
        __syncthreads();
    };
    for (int slot = 0; slot < nslot; slot += 4) {
        slot_fn(slot, kr0, vr0);
        if (slot + 1 < nslot) slot_fn(slot + 1, kr0, vr0);
        if (slot + 2 < nslot) slot_fn(slot + 2, kr1, vr1);
        if (slot + 3 < nslot) slot_fn(slot + 3, kr1, vr1);
    }
}

template <int VAR = 0, class SrcK, class SrcV, class Post>
__device__ __forceinline__ void tile_loop_f(int tid, int lane, lptr base, int nt, int pitch, const bf16x8 (&qf)[4], f32x16 (&o)[2], float& l, SrcK srck, SrcV srcv, Post post) {
    if (nt <= 0) return;
    const int r32 = lane & 31, hi = lane >> 5;
    lptr Kb = base, Vb = base + 2 * KT64;
    const int rr = tid >> 3, ch = tid & 7;
    u32x4 kr0, vr0, kr1, vr1;
    auto gld = [&](const bf16_t* p) { return *(const u32x4*)(p + (size_t)rr * pitch + ch * 8); };
    kr0 = gld(srck(0)); vr0 = gld(srcv(0)); *(LAS u32x4*)(Kb + rr * KS64 + ch * 16) = kr0; *(LAS u32x4*)(Vb + rr * VS64 + ch * 16) = vr0;
    if (nt > 1) { kr0 = gld(srck(1)); *(LAS u32x4*)(Kb + KT64 + rr * KS64 + ch * 16) = kr0; }
    if (nt > 2) kr1 = gld(srck(2));
    if (nt > 1) vr1 = gld(srcv(1));
    __syncthreads();
    f32x16 a0, a1, b0, b1; bool aact, bact = false;
    qk<4>(a0, a1, (lcptr)Kb, KS64, qf, 0.f, r32, hi); aact = post(0, a0, a1);
    auto step = [&](int i, f32x16& c0, f32x16& c1, bool& cact, f32x16& n0, f32x16& n1, bool& nact, u32x4& kL, u32x4& vL, u32x4& kS, u32x4& vS) {
        const bool m1 = i + 1 < nt, m2 = i + 2 < nt, m3 = i + 3 < nt;
        if (m3) kL = gld(srck(i + 3));
        if (m2) vL = gld(srcv(i + 2));
        lcptr Kt = (lcptr)(Kb + ((i + 1) & 1) * KT64), Vt = (lcptr)(Vb + (i & 1) * VT64);
        if (m1 && cact) {
            lcptr p0 = Kt + r32 * KS64 + hi * 16; lcptr p1 = p0 + 32 * KS64;
            bf16x8 ka[4], kb[4];
#pragma unroll
            for (int ks = 0; ks < 4; ++ks) { if (VAR == 8 || VAR == 9) { ka[ks] = qf[ks]; kb[ks] = qf[3 - ks]; } else { ka[ks] = *(const LAS bf16x8*)(p0 + ks * 32); kb[ks] = *(const LAS bf16x8*)(p1 + ks * 32); } }
            n0 = splat16(0.f); n1 = splat16(0.f); f32x2 rs2 = {0.f, 0.f};
            __builtin_amdgcn_sched_barrier(0);
#pragma unroll
            for (int ks = 0; ks < 4; ++ks) {
                n0 = __builtin_amdgcn_mfma_f32_32x32x16_bf16(ka[ks], qf[ks], n0, 0, 0, 0); n1 = __builtin_amdgcn_mfma_f32_32x32x16_bf16(kb[ks], qf[ks], n1, 0, 0, 0);
#pragma unroll
                for (int e = 0; e < 4; e += 2) { const int x = 4 * ks + e; c0[x] = ex2(c0[x]); c0[x + 1] = ex2(c0[x + 1]); c1[x] = ex2(c1[x]); c1[x + 1] = ex2(c1[x + 1]);
                    rs2 += (f32x2){c0[x], c0[x + 1]}; rs2 += (f32x2){c1[x], c1[x + 1]}; }
                __builtin_amdgcn_sched_barrier(0);
            }
            l += rs2.x + rs2.y;
            if (VAR == 8 || VAR == 10) { const bf16x8 pk0 = pack_p(c0, 0), pk1 = pack_p(c0, 8), pk2_ = pack_p(c1, 0), pk3 = pack_p(c1, 8);
#pragma unroll
                for (int d = 0; d < 2; ++d) { o[d] = __builtin_amdgcn_mfma_f32_32x32x16_bf16(qf[0], pk0, o[d], 0, 0, 0); o[d] = __builtin_amdgcn_mfma_f32_32x32x16_bf16(qf[1], pk1, o[d], 0, 0, 0);
                    o[d] = __builtin_amdgcn_mfma_f32_32x32x16_bf16(qf[2], pk2_, o[d], 0, 0, 0); o[d] = __builtin_amdgcn_mfma_f32_32x32x16_bf16(qf[3], pk3, o[d], 0, 0, 0); } }
            else pv<2>(o, c0, c1, Vt, VS64, lane);
            nact = post(i + 1, n0, n1);
        } else {
            if (cact) { exp_step(c0, c1, l); pv<2>(o, c0, c1, Vt, VS64, lane); }
            nact = false;
            if (m1) { qk<4>(n0, n1, Kt, KS64, qf, 0.f, r32, hi); nact = post(i + 1, n0, n1); }
        }
        if (m2) *(LAS u32x4*)(Kb + (i & 1) * KT64 + rr * KS64 + ch * 16) = kS;
        if (m1) *(LAS u32x4*)(Vb + ((i + 1) & 1) * VT64 + rr * VS64 + ch * 16) = vS;
        __syncthreads();
    };
    for (int i = 0; i < nt; i += 2) { step(i, a0, a1, aact, b0, b1, bact, kr0, vr0, kr1, vr1); if (i + 1 < nt) step(i + 1, b0, b1, bact, a0, a1, aact, kr1, vr1, kr0, vr0); }
}
constexpr int TL64_BYTES = 2 * KT64 + 2 * VT64;
}

#ifndef PP_GRP
#define PP_GRP (w & 1)
#endif
template <int var> __device__ __forceinline__ void moba_unit(const Frame& F, int b, int h, int qb, const bf16_t* Q, const bf16_t* K, const bf16_t* V, const float* KMEAN, const float* BT, unsigned char* O8) {
    using namespace att;
    const int lane = F.lane, r32 = lane & 31, hi = lane >> 5, w = F.wave;
    lptr lds = (lptr)F.lds; lptr tl = lds; LAS float* BTL = (LAS float*)(lds + TL64_BYTES); lptr KM = lds + TL64_BYTES + 512;
    const int t = 256 * qb + 32 * w + r32; const size_t row = (size_t)b * SEQ + t;
    bf16x8 qf[4];
#pragma unroll
    for (int ks = 0; ks < 4; ++ks) qf[ks] = *(const bf16x8*)(Q + row * 1024 + h * 64 + 16 * ks + 8 * hi);
    if (F.tid < 128) BTL[F.tid] = BT[h * 128 + F.tid] - BT[h * 128 + 127];
    { const int idx = F.tid * 2, j = idx >> 6, d = idx & 63; const float* kmp = KMEAN + (size_t)(b * 16 + j) * 2048 + h * 64 + d;
      *(LAS unsigned*)(KM + j * KS64 + d * 2) = (j < qb) ? pk2(kmp[0] + kmp[1024], kmp[1] + kmp[1025]) : 0u;
      *(LAS unsigned*)(KM + (16 + j) * KS64 + d * 2) = 0u; }
    __syncthreads();
    unsigned selmask = 0u;
    if (qb > 0) {
        f32x16 gs = splat16(0.f);
        { lcptr p0 = (lcptr)KM + r32 * KS64 + hi * 16;
#pragma unroll
          for (int ks = 0; ks < 4; ++ks) { const bf16x8 k0 = *(const LAS bf16x8*)(p0 + ks * 32); gs = __builtin_amdgcn_mfma_f32_32x32x16_bf16(k0, qf[ks], gs, 0, 0, 0); } }
        float glo[8], ghi[8];
#pragma unroll
        for (int r = 0; r < 8; ++r) { const float mine = gs[r], oth = __shfl_xor(mine, 32); glo[r] = hi ? oth : mine; ghi[r] = hi ? mine : oth; }
#pragma unroll
        for (int rep = 0; rep < 3; ++rep) { float best = -INFINITY; int bj = -1;
#pragma unroll
            for (int j = 0; j < 16; ++j) { const int r = (j & 3) + 4 * (j >> 3); const float gv = ((j >> 2) & 1) ? ghi[r] : glo[r];
                if (j < qb && !((selmask >> j) & 1u) && gv > best) { best = gv; bj = j; } }
            if (bj >= 0) selmask |= 1u << bj; }
    }
    f32x16 o[2] = {splat16(0.f), splat16(0.f)}; float l = 0.f;
    const int nt = 4 * (qb + 1); const int twmax = 256 * qb + 32 * w + 31;
    const bf16_t* Kh = K + (size_t)b * SEQ * 1024 + h * 64; const bf16_t* Vh = V + (size_t)b * SEQ * 1024 + h * 64;
    tile_loop_f<var>(F.tid, lane, tl, nt, 1024, qf, o, l,
        [&](int i) { return Kh + (size_t)(64 * i) * 1024; }, [&](int i) { return Vh + (size_t)(64 * i) * 1024; },
        [&](int i, f32x16& s0, f32x16& s1) -> bool {
            const int blk = i >> 2, kp0 = 64 * i;
            if (blk < qb) {
                const bool sel = (selmask >> blk) & 1u;
                if (!__any(sel)) return false;
                if (!(blk < qb - 1 || (i & 3) < 2)) bias_mask_near(s0, s1, BTL, t, kp0, hi, 0x7fffffffu);
                if (!sel) mask_all(s0, s1);
            } else {
                if (kp0 > twmax) return false;
                bias_mask_near(s0, s1, BTL, t, kp0, hi, 0x7fffffffu);
            }
            return true; });
    l += __shfl_xor(l, 32);
    store_o64_fp8(O8 + row * 1024 + h * 64, o, l > 0.f ? OSC / l : 0.f, hi);
}
__device__ __forceinline__ void phase_moba(const Frame& F, unsigned char* ws, int var) {
    const bf16_t* Q = (const bf16_t*)(ws + OFF_QKV); const bf16_t* K = Q + (size_t)MTOK * 1024; const bf16_t* V = K + (size_t)MTOK * 1024;
    const float* KMEAN = (const float*)(ws + OFF_KMEAN); const float* BT = (const float*)(ws + OFF_BT);
    for (int idx = F.bx; idx < 2048; idx += F.G) { const int i = idx >> 8, v = idx & 255, x = v & 7, j = v >> 3, bh = 16 * x + 2 * i + (j >> 4), b = bh >> 4, h = bh & 15, p = ((j & 15) + 4 * (i >> 1)) & 15, qb = (i & 1) ? 15 - p : p;

#ifdef MOBA_VAR
        if (var == MOBA_VAR) moba_unit<MOBA_VAR>(F, b, h, qb, Q, K, V, KMEAN, BT, ws + OFF_O8); else
#endif
        moba_unit<0>(F, b, h, qb, Q, K, V, KMEAN, BT, ws + OFF_O8);
        __syncthreads(); }
}

constexpr int MB_KB = 0, MB_VB = 256 * att::KS64, MB_SELM = MB_VB + 256 * att::VS64, MB_LIST = MB_SELM + 4096, MB_CNT = MB_LIST + 12800, MB_FILL = MB_CNT + 64, MB_LOFF = MB_FILL + 64,
              MB_BTL = MB_LOFF + 128, MB_KM = MB_BTL + 512, MB_QC = MB_KM + 32 * att::KS64, MB_END = MB_QC + 64;
constexpr int MST_ROW = 136;
__device__ __forceinline__ void moba2_unit(const Frame& F, int b, int h, int par, int unit, const bf16_t* Q, const bf16_t* K, const bf16_t* V, const float* KMEAN, const float* BT, unsigned char* O8, unsigned char* MST, int abl = 0) {
    using namespace att;
    int tid = F.tid; asm volatile("" : "+v"(tid));
    const int lane = tid & 63, lane_ = lane, r32 = lane & 31, hi = lane >> 5, w = F.wave;
    lptr lds = (lptr)F.lds; lptr KB = lds + MB_KB, VB = lds + MB_VB; LAS unsigned short* SELM = (LAS unsigned short*)(lds + MB_SELM); LAS unsigned short* LIST = (LAS unsigned short*)(lds + MB_LIST);
    LAS int* CNT = (LAS int*)(lds + MB_CNT); LAS int* FILL = (LAS int*)(lds + MB_FILL); LAS int* LOFF = (LAS int*)(lds + MB_LOFF); LAS float* BTL = (LAS float*)(lds + MB_BTL); lptr KM = lds + MB_KM;
    unsigned char* ST = MST + (size_t)unit * 2048 * MST_ROW; float* STL = (float*)(ST + 2048 * 128);
    const unsigned char* Qh = (const unsigned char*)Q + (size_t)b * SEQ * 1024 + h * 64;
    const unsigned char* Kh = (const unsigned char*)K + (size_t)b * SEQ * 1024 + h * 64; const unsigned char* Vh = (const unsigned char*)V + (size_t)b * SEQ * 1024 + h * 64;
    if (tid < 128) BTL[tid] = BT[h * 128 + tid] - BT[h * 128 + 127];
    { const int idx = tid * 2, j = idx >> 6, d = idx & 63; const float* kmp = KMEAN + (size_t)(b * 16 + j) * 2048 + h * 64 + d;
      *(LAS unsigned*)(KM + j * KS64 + d * 2) = pk2(kmp[0] + kmp[1024], kmp[1] + kmp[1025]); *(LAS unsigned*)(KM + (16 + j) * KS64 + d * 2) = 0u; }
    LAS int* QC = (LAS int*)(lds + MB_QC);
    if (tid < 16) { CNT[tid] = 0; FILL[tid] = 0; QC[tid] = 0; }
    __syncthreads();
#pragma unroll 1
    for (int m8 = 0; m8 < 8; ++m8) { const int gi = w + 8 * m8, k = gi >> 3, sub = gi & 7, qb = 2 * k + par, q = 32 * sub + r32; const size_t trow = (size_t)(256 * qb + q);
        unsigned selmask = 0u;
        if (qb > 0) {
            bf16x8 qf[4];
#pragma unroll
            for (int ks = 0; ks < 4; ++ks) qf[ks] = fp8x8_bf16(*(const u32x2*)(Qh + trow * 1024 + 16 * ks + 8 * hi));
            f32x16 gs = splat16(0.f);
            { lcptr p0 = (lcptr)KM + r32 * KS64 + hi * 16;
#pragma unroll
              for (int ks = 0; ks < 4; ++ks) { const bf16x8 k0 = *(const LAS bf16x8*)(p0 + ks * 32); gs = __builtin_amdgcn_mfma_f32_32x32x16_bf16(k0, qf[ks], gs, 0, 0, 0); } }
            float glo[8], ghi[8];
#pragma unroll
            for (int r = 0; r < 8; ++r) { const float mine = gs[r], oth = __shfl_xor(mine, 32); glo[r] = hi ? oth : mine; ghi[r] = hi ? mine : oth; }
#pragma unroll
            for (int rep = 0; rep < 3; ++rep) { float best = -INFINITY; int bj = -1;
#pragma unroll
                for (int j = 0; j < 16; ++j) { const int r = (j & 3) + 4 * (j >> 3); const float gv = ((j >> 2) & 1) ? ghi[r] : glo[r];
                    if (j < qb && !((selmask >> j) & 1u) && gv > best) { best = gv; bj = j; } }
                if (bj >= 0) selmask |= 1u << bj; }
        }
        if (hi == 0) { SELM[k * 256 + q] = (unsigned short)selmask; unsigned mm = selmask; while (mm) { const int j = __builtin_ctz(mm); mm &= mm - 1u; __hip_atomic_fetch_add(CNT + j, 1, __ATOMIC_RELAXED, __HIP_MEMORY_SCOPE_WORKGROUP); } }
    }
    __syncthreads();
    if (tid == 0) { int acc = 0; for (int j = 0; j < 16; ++j) { LOFF[j] = acc; acc += CNT[j]; } LOFF[16] = acc; }
    __syncthreads();
    for (int lq = tid; lq < 2048; lq += NTHR) { unsigned mm = SELM[lq]; while (mm) { const int j = __builtin_ctz(mm); mm &= mm - 1u; const int pos = __hip_atomic_fetch_add(FILL + j, 1, __ATOMIC_RELAXED, __HIP_MEMORY_SCOPE_WORKGROUP); LIST[LOFF[j] + pos] = (unsigned short)lq; } }
#ifdef REP_PHASE
    if (abl == 2) return;
#endif
    u32x4 kreg[2], vreg[2];
    auto gblk = [&](int j) { int td = tid; asm volatile("" : "+v"(td));
#pragma unroll
        for (int i = 0; i < 2; ++i) { const int c = td + 512 * i, rr = c >> 2, ch = c & 3; kreg[i] = *(const u32x4*)(Kh + (size_t)(256 * j + rr) * 1024 + ch * 16); vreg[i] = *(const u32x4*)(Vh + (size_t)(256 * j + rr) * 1024 + ch * 16); } };
    gblk(0);
    __syncthreads();
    for (int j = 0; j < 16; ++j) {
        { int td = tid; asm volatile("" : "+v"(td));
#pragma unroll
        for (int i = 0; i < 2; ++i) { const int c = td + 512 * i, rr = c >> 2, ch = c & 3;
            *(LAS bf16x8*)(KB + rr * KS64 + ch * 32) = fp8x8_bf16((u32x2){kreg[i].x, kreg[i].y}); *(LAS bf16x8*)(KB + rr * KS64 + ch * 32 + 16) = fp8x8_bf16((u32x2){kreg[i].z, kreg[i].w});
            *(LAS bf16x8*)(VB + rr * VS64 + ch * 32) = fp8x8_bf16((u32x2){vreg[i].x, vreg[i].y}); *(LAS bf16x8*)(VB + rr * VS64 + ch * 32 + 16) = fp8x8_bf16((u32x2){vreg[i].z, vreg[i].w}); } }
        __syncthreads();
        gblk(j + 1 < 16 ? j + 1 : 15);
        const int nj = CNT[j], ngp = (nj + 31) >> 5, ngo = ((j & 1) == par) ? 8 : 0;
        const int nit = ngo + ngp;
        auto grab = [&]() { int it = 0; if (lane == 0) it = __hip_atomic_fetch_add(QC + j, 1, __ATOMIC_RELAXED, __HIP_MEMORY_SCOPE_WORKGROUP); return __builtin_amdgcn_readfirstlane(it); };
        auto decode = [&](int it, int& t, int& lq, bool& va) {
            if (it < ngo) { const int gidx = ngo - 1 - it; lq = (j >> 1) * 256 + 32 * gidx + r32; t = 256 * j + 32 * gidx + r32; va = true; }
            else { const int gidx = it - ngo, sa = 32 * gidx + r32; va = sa < nj; lq = LIST[LOFF[j] + (va ? sa : 32 * gidx)]; t = 256 * (2 * (lq >> 8) + par) + (lq & 255); } };
        auto issue = [&](int t, int lq, bool ownit, u32x2 (&q)[4], u32x4 (&st)[4], float& stl) {
#pragma unroll
            for (int ks = 0; ks < 4; ++ks) q[ks] = *(const u32x2*)(Qh + (size_t)t * 1024 + 16 * ks + 8 * hi);
            const unsigned sm = SELM[lq]; const bool fresh = ownit ? (sm == 0u) : ((sm & ((1u << j) - 1u)) == 0u);
            if (!fresh) { const unsigned char* strow = ST + (size_t)lq * 128 + 64 * hi;
#pragma unroll
                for (int k = 0; k < 4; ++k) st[k] = *(const u32x4*)(strow + 16 * k);
                stl = STL[lq]; }
            else {
#pragma unroll
                for (int k = 0; k < 4; ++k) st[k] = (u32x4){0u, 0u, 0u, 0u};
                stl = 0.f; } };
        int it = grab(), t = 0, lq = 0; bool va = false; u32x2 qc[4] = {}; u32x4 stc[4] = {}; float stlc = 0.f;
        if (it < nit) { decode(it, t, lq, va); issue(t, lq, it < ngo, qc, stc, stlc); }
        u32x4 sv[4] = {}; float svl = 0.f; int smode = 0; bool sva = false; unsigned char* sp0 = nullptr; float* spl = nullptr;
        auto flush = [&]() {
            if (smode == 1) {
#pragma unroll
                for (int d = 0; d < 2; ++d)
#pragma unroll
                    for (int rg = 0; rg < 4; ++rg) *(unsigned*)(sp0 + 32 * d + 8 * rg) = sv[d][rg];
            } else if (smode == 2 && sva) {
#pragma unroll
                for (int k = 0; k < 4; ++k) *(u32x4*)(sp0 + 16 * k) = sv[k];
                if (hi == 0) *spl = svl;
            }
            smode = 0; };
        while (it < nit) {
#pragma unroll
            for (int k = 0; k < 4; ++k) asm volatile("" : "+v"(qc[k]), "+v"(stc[k]));
            asm volatile("" : "+v"(stlc));
            flush();
            const int itn = grab(); int tn = 0, lqn = 0; bool van = false; u32x2 qn[4] = {}; u32x4 stn[4] = {}; float stln = 0.f;
            bf16x8 qcv[4];
#pragma unroll
            for (int k = 0; k < 4; ++k) qcv[k] = fp8x8_bf16(qc[k]);
            if (itn < nit) { decode(itn, tn, lqn, van); issue(tn, lqn, itn < ngo, qn, stn, stln); }
            const bool own = it < ngo; int ntile = own ? ((32 * (ngo - 1 - it) + 31) >> 6) + 1 : 4;
#ifdef REP_PHASE
            if (abl == 1) ntile = 0;
#endif
            const bool nearany = own || __any((t >> 8) == j + 1);
            f32x16 o[2] = {splat16(0.f), splat16(0.f)}; float l = 0.f;
            for (int i = 0; i < ntile; ++i) { f32x16 s0, s1;
                qk<4>(s0, s1, (lcptr)(KB + i * KT64), KS64, qcv, 0.f, r32, hi);
                if (nearany && (own || i >= 2)) bias_mask_near(s0, s1, BTL, t, 256 * j + 64 * i, hi, 0x7fffffffu);
                exp_step(s0, s1, l); pv<2>(o, s0, s1, (lcptr)(VB + i * VT64), VS64, lane); }
            l += __shfl_xor(l, 32);
            if (own) {
                const float lt = l + stlc; const float f = lt > 0.f ? OSC / lt : 0.f;
                sp0 = O8 + ((size_t)b * SEQ + t) * 1024 + h * 64 + 4 * hi; smode = 1;
#pragma unroll
                for (int d = 0; d < 2; ++d)
#pragma unroll
                    for (int rg = 0; rg < 4; ++rg) { const unsigned w0 = stc[2 * d + (rg >> 1)][(rg & 1) * 2], w1 = stc[2 * d + (rg >> 1)][(rg & 1) * 2 + 1];
                        sv[d][rg] = pg8::pk4_fp8((o[d][4 * rg] + bflo(w0)) * f, (o[d][4 * rg + 1] + bfhi(w0)) * f, (o[d][4 * rg + 2] + bflo(w1)) * f, (o[d][4 * rg + 3] + bfhi(w1)) * f); }
            } else {
                sp0 = ST + (size_t)lq * 128 + 64 * hi; spl = STL + lq; svl = stlc + l; sva = va; smode = 2;
#pragma unroll
                for (int k = 0; k < 4; ++k) { const int d = k >> 1, rg0 = (k & 1) * 2; u32x4 nv;
#pragma unroll
                    for (int c = 0; c < 4; ++c) { const int rg = rg0 + (c >> 1), e = (c & 1) * 2; const unsigned wv = stc[k][c]; nv[c] = pk2(o[d][4 * rg + e] + bflo(wv), o[d][4 * rg + e + 1] + bfhi(wv)); }
                    sv[k] = nv; }
            }
            it = itn; t = tn; lq = lqn; va = van; stlc = stln;
#pragma unroll
            for (int k = 0; k < 4; ++k) qc[k] = qn[k];
#pragma unroll
            for (int k = 0; k < 4; ++k) stc[k] = stn[k];
        }
        flush();
        __syncthreads();
    }
}
__device__ __forceinline__ void phase_moba2(const Frame& F, unsigned char* ws, int abl = 0) {
    const bf16_t* Q = (const bf16_t*)(ws + OFF_QKV); const bf16_t* K = Q + (size_t)MTOK * 1024; const bf16_t* V = K + (size_t)MTOK * 1024;
    const float* KMEAN = (const float*)(ws + OFF_KMEAN); const float* BT = (const float*)(ws + OFF_BT);
    for (int v = F.bx; v < 256; v += F.G) { const int x = v & 7, jj = v >> 3, pair = 16 * x + (jj >> 1), par = jj & 1;
        moba2_unit(F, pair >> 4, pair & 15, par, v, Q, K, V, KMEAN, BT, ws + OFF_O8, ws + OFF_MST, abl); __syncthreads(); }
}

__device__ __forceinline__ void nsa_unit(const Frame& F, int b, int g, int c, const bf16_t* Y1, const bf16_t* KC, const bf16_t* VC, const float* BT, unsigned char* MIXIN) {
    using namespace att;
    const int lane = F.lane, r32 = lane & 31, hi = lane >> 5, w = F.wave;
    lptr lds = (lptr)F.lds; lptr tl = lds; LAS float* BTL = (LAS float*)(lds + TL128_BYTES);
    LAS float* SCB = (LAS float*)(lds + TL128_BYTES + 2048);
    LAS unsigned long long* SELM = (LAS unsigned long long*)(lds + TL128_BYTES + 2048 + 16384);
    lptr OFL = lds + TL128_BYTES + 2048 + 16384 + 1024 + w * 4352 + r32 * 136 + hi * 8;
    auto gput = [&](int d, int rg, const f32x4 v) { u32x2 p; p.x = pk2(v[0], v[1]); p.y = pk2(v[2], v[3]); *(LAS u32x2*)(OFL + d * 64 + rg * 16) = p; };
    auto gget = [&](int d, int rg) { const u32x2 p = *(const LAS u32x2*)(OFL + d * 64 + rg * 16); return (f32x4){bflo(p.x), bfhi(p.x), bflo(p.y), bfhi(p.y)}; };
    const int n = r32 & 3, tok = 8 * w + (r32 >> 2), t = 64 * c + tok; const size_t row = (size_t)b * SEQ + t;
    const bf16_t* T1 = Y1 + (size_t)1 * MTOK * 256; const bf16_t* QB = Y1 + (size_t)(2 + g) * MTOK * 256;
    const bf16_t* KVS = Y1 + (size_t)5 * MTOK * 256; const bf16_t* KVW = Y1 + (size_t)6 * MTOK * 256;
    bf16x8 qf[4];
#pragma unroll
    for (int ks = 0; ks < 4; ++ks) qf[ks] = *(const bf16x8*)(QB + row * 256 + n * 64 + 16 * ks + 8 * hi);
    float gate[3];
#pragma unroll
    for (int j = 0; j < 3; ++j) { const float x = bf2f(T1[row * 256 + 208 + (4 * g + n) * 3 + j]); gate[j] = 1.f / (1.f + __expf(-x)); }
    for (int i = F.tid; i < 512; i += NTHR) BTL[i] = BT[(8 + 4 * g) * 128 + i] - BT[(8 + 4 * g) * 128 + (i | 127)];
    for (int i = F.tid; i < 4096; i += NTHR) SCB[i] = 0.f;
    __syncthreads();
    const LAS float* bt = BTL + n * 128; const float cfar = 0.f;
    const int vis = (t >= 31) ? ((t - 31) >> 4) : -1;
    const int ntc = ((4 * c + 2) >> 6) + 1;
    const bf16_t* KCg = KC + ((size_t)b * 256 * 2 + g) * 64; const bf16_t* VCg = VC + ((size_t)b * 256 * 2 + g) * 64;
    auto cmp_scores = [&](int i, lcptr Kt, f32x16& s0, f32x16& s1) {
        qk<4>(s0, s1, Kt, KS64, qf, 0.f, r32, hi);
#pragma unroll
        for (int half = 0; half < 2; ++half) { float bb[16]; f32x16& s = half ? s1 : s0;
#pragma unroll
            for (int r = 0; r < 16; ++r) { const int cc = 64 * i + 32 * half + crow(r, hi); const int d = t - 16 * cc - 31; const unsigned ix = (unsigned)d < 127u ? (unsigned)d : 127u; bb[r] = bt[ix]; }
#pragma unroll
            for (int r = 0; r < 16; ++r) asm volatile("" : "+v"(bb[r]));
#pragma unroll
            for (int r = 0; r < 16; ++r) { const int cc = 64 * i + 32 * half + crow(r, hi); s[r] = (cc <= vis) ? s[r] + bb[r] : -INFINITY; } }
    };
    float mc = NEG_BIG, lc = 0.f;
    tile_loop128(F.tid, tl, ntc, 128,
        [&](int i, const bf16_t*& kp, const bf16_t*& vp) { kp = KCg + (size_t)(64 * i) * 128; vp = VCg + (size_t)(64 * i) * 128; },
        [&](int i, lcptr Kt, lcptr Vt) { f32x16 s0, s1; cmp_scores(i, Kt, s0, s1);
            const float mn = fmaxf(mc, rowmax32(s0, s1)); float rs = 0.f;
#pragma unroll
            for (int r = 0; r < 16; ++r) rs += ex2(s0[r] - mn) + ex2(s1[r] - mn);
            lc = lc * ex2(mc - mn) + rs; mc = mn; });
    lc += __shfl_xor(lc, 32);
    const float invc = lc > 0.f ? 1.f / lc : 0.f;
    {
        f32x16 o[2] = {splat16(0.f), splat16(0.f)}; float carry = 0.f;
        tile_loop128(F.tid, tl, ntc, 128,
            [&](int i, const bf16_t*& kp, const bf16_t*& vp) { kp = KCg + (size_t)(64 * i) * 128; vp = VCg + (size_t)(64 * i) * 128; },
            [&](int i, lcptr Kt, lcptr Vt) { f32x16 s0, s1; cmp_scores(i, Kt, s0, s1);
#pragma unroll
                for (int r = 0; r < 16; ++r) { s0[r] = ex2(s0[r] - mc) * invc; s1[r] = ex2(s1[r] - mc) * invc; }
                float x0[4], x1[4];
#pragma unroll
                for (int rg = 0; rg < 4; ++rg) { x0[rg] = __shfl_xor(s0[4 * rg + 3], 32); x1[rg] = __shfl_xor(s1[4 * rg + 3], 32); }
#pragma unroll
                for (int rg = 0; rg < 4; ++rg) {
                    float g0 = (s0[4 * rg] + s0[4 * rg + 1]) + (s0[4 * rg + 2] + s0[4 * rg + 3]), g1 = (s1[4 * rg] + s1[4 * rg + 1]) + (s1[4 * rg + 2] + s1[4 * rg + 3]);
                    const float e0 = hi ? x0[rg] : (rg > 0 ? x0[rg > 0 ? rg - 1 : 0] : carry), e1 = hi ? x1[rg] : (rg > 0 ? x1[rg > 0 ? rg - 1 : 0] : x0[3]);
                    g0 += e0; g1 += e1;
                    g0 = quad_sum(g0); g1 = quad_sum(g1);
                    if (n == 0) { SCB[tok * 64 + 16 * i + 2 * rg + hi] = g0; SCB[tok * 64 + 16 * i + 8 + 2 * rg + hi] = g1; }
                }
                carry = x1[3];
                pv<2>(o, s0, s1, Vt, VS64, lane); });
#pragma unroll
        for (int d = 0; d < 2; ++d)
#pragma unroll
            for (int rg = 0; rg < 4; ++rg) gput(d, rg, (f32x4){o[d][4 * rg], o[d][4 * rg + 1], o[d][4 * rg + 2], o[d][4 * rg + 3]} * gate[0]);
    }
    {
        unsigned long long uni = 0ull;
#pragma unroll 1
        for (int tk = 0; tk < 8; ++tk) { const int tk2 = 8 * w + tk; float v = SCB[tk2 * 64 + lane];
            v = (lane > c) ? -INFINITY : ((lane == 0 || lane == c || lane == c - 1) ? INFINITY : v);
            int cnt = 0;
#pragma unroll
            for (int j = 0; j < 64; ++j) { const float vj = __builtin_bit_cast(float, __builtin_amdgcn_readlane(__builtin_bit_cast(int, v), j)); cnt += (vj > v || (vj == v && j < lane)) ? 1 : 0; }
            const unsigned long long mk = __ballot(cnt < 16 && lane <= c);
            if (lane == 0) SELM[tk2] = mk;
            uni |= mk; }
        if (lane == 0) SELM[64 + w] = uni;
    }
    __syncthreads();
    const unsigned long long mymask = SELM[tok];
    unsigned long long uni = 0ull;
#pragma unroll
    for (int k = 0; k < 8; ++k) uni |= SELM[64 + k];
    {
        f32x16 o[2] = {splat16(0.f), splat16(0.f)}; float l = 0.f;
        const int nsel = __popcll(uni);
        const bf16_t* Kg = KVS + (size_t)b * SEQ * 256 + g * 64; const bf16_t* Vg = Kg + 128;
        LAS unsigned char* LIST = (LAS unsigned char*)(SELM + 72);
        if (F.tid < 64 && ((uni >> F.tid) & 1ull)) LIST[__popcll(uni & ((1ull << F.tid) - 1ull))] = (unsigned char)F.tid;
        __syncthreads();
        tile_loop128(F.tid, tl, nsel, 256,
            [&](int i, const bf16_t*& kp, const bf16_t*& vp) { const int j = LIST[i]; kp = Kg + (size_t)(64 * j) * 256; vp = Vg + (size_t)(64 * j) * 256; },
            [&](int i, lcptr Kt, lcptr Vt) { const int j = LIST[i];
                const bool sel = (mymask >> j) & 1ull;
                if (!__any(sel)) return;
                f32x16 s0, s1; qk<4>(s0, s1, Kt, KS64, qf, 0.f, r32, hi);
                if (j >= c - 2) bias_mask_near(s0, s1, bt, t, 64 * j, hi, 0x7fffffffu);
                if (!sel) mask_all(s0, s1);
                exp_step(s0, s1, l); pv<2>(o, s0, s1, Vt, VS64, lane); });
        l += __shfl_xor(l, 32); const float f = gate[1] * (l > 0.f ? 1.f / l : 0.f);
#pragma unroll
        for (int d = 0; d < 2; ++d)
#pragma unroll
            for (int rg = 0; rg < 4; ++rg) gput(d, rg, gget(d, rg) + (f32x4){o[d][4 * rg], o[d][4 * rg + 1], o[d][4 * rg + 2], o[d][4 * rg + 3]} * f);
    }
    {
        f32x16 o[2] = {splat16(0.f), splat16(0.f)}; float l = 0.f;
        const int k0 = c >= 8 ? c - 8 : 0, ntw = c - k0 + 1;
        const bf16_t* Kg = KVW + (size_t)b * SEQ * 256 + g * 64; const bf16_t* Vg = Kg + 128;
        tile_loop128(F.tid, tl, ntw, 256,
            [&](int i, const bf16_t*& kp, const bf16_t*& vp) { kp = Kg + (size_t)(64 * (k0 + i)) * 256; vp = Vg + (size_t)(64 * (k0 + i)) * 256; },
            [&](int i, lcptr Kt, lcptr Vt) { const int kt = k0 + i; f32x16 s0, s1; qk<4>(s0, s1, Kt, KS64, qf, 0.f, r32, hi);
                if (!(kt < c - 2 && kt > c - 8)) bias_mask_near(s0, s1, bt, t, 64 * kt, hi, 512u);
                exp_step(s0, s1, l); pv<2>(o, s0, s1, Vt, VS64, lane); });
        l += __shfl_xor(l, 32); const float f = gate[2] * (l > 0.f ? 1.f / l : 0.f);
        unsigned char* orow = MIXIN + row * 1536 + 1024 + (4 * g + n) * 64;
#pragma unroll
        for (int d = 0; d < 2; ++d)
#pragma unroll
            for (int rg = 0; rg < 4; ++rg) { const f32x4 v = (gget(d, rg) + (f32x4){o[d][4 * rg], o[d][4 * rg + 1], o[d][4 * rg + 2], o[d][4 * rg + 3]} * f) * OSC;
                *(unsigned*)(orow + 32 * d + 8 * rg + 4 * hi) = pg8::pk4_fp8(v[0], v[1], v[2], v[3]); }
    }
}

__device__ __forceinline__ void dsa_unit(const Frame& F, int b, int u, const bf16_t* QLAT, const bf16_t* CKVN, const unsigned* MASK, const float* BT, unsigned char* MIXIN) {
    using namespace att;
    const int lane = F.lane, r32 = lane & 31, hi = lane >> 5, w = F.wave, tid = F.tid;
    lptr lds = (lptr)F.lds; lptr Kb = lds, Vb = lds + 2 * KT128; LAS float* BTL = (LAS float*)(lds + 2 * KT128 + 2 * VT128);
    const int head = r32 & 7, q0 = 32 * u, t = q0 + 4 * w + (r32 >> 3); const size_t row = (size_t)b * SEQ + t;
    bf16x8 qf[8];
#pragma unroll
    for (int ks = 0; ks < 8; ++ks) qf[ks] = *(const bf16x8*)(QLAT + row * 1024 + head * 128 + 16 * ks + 8 * hi);
    for (int i = tid; i < 1024; i += NTHR) BTL[i] = BT[i] - BT[i | 127];
    const LAS float* bt = BTL + head * 128;
    f32x16 o[4] = {splat16(0.f), splat16(0.f), splat16(0.f), splat16(0.f)}; float l = 0.f;
    const int nt = ((q0 + 31) >> 6) + 1;
    const bf16_t* Cb = CKVN + (size_t)b * SEQ * 128; const unsigned* mrow = MASK + row * 128;
    u32x4 st[2];
    auto gload = [&](int i) {
#pragma unroll
        for (int k = 0; k < 2; ++k) { const int idx = tid + 512 * k, rr = idx >> 4, ch = idx & 15; st[k] = *(const u32x4*)(Cb + (size_t)(64 * i + rr) * 128 + ch * 8); } };
    auto lstore = [&](int i) { lptr kd = Kb + (i & 1) * KT128, vd = Vb + (i & 1) * VT128;
#pragma unroll
        for (int k = 0; k < 2; ++k) { const int idx = tid + 512 * k, rr = idx >> 4, ch = idx & 15; *(LAS u32x4*)(kd + rr * KS128 + ch * 16) = st[k]; *(LAS u32x4*)(vd + rr * VS128 + ch * 16) = st[k]; } };
    auto score = [&](int i, f32x16& s0, f32x16& s1) {
        lcptr Kt = (lcptr)(Kb + (i & 1) * KT128);
        const u32x2 mw = *(const u32x2*)(mrow + 2 * i);
        qk<8>(s0, s1, Kt, KS128, qf, 0.f, r32, hi);
        const unsigned w0 = mw.x >> (4 * hi), w1 = mw.y >> (4 * hi);
        if ((q0 - (64 * i + 63)) < 128) {
#pragma unroll
            for (int r = 0; r < 16; ++r) { const int d0 = t - (64 * i + crow(r, hi)), d1 = d0 - 32;
                const unsigned i0 = (unsigned)d0 < 127u ? (unsigned)d0 : 127u, i1 = (unsigned)d1 < 127u ? (unsigned)d1 : 127u;
                s0[r] += bt[i0]; s1[r] += bt[i1]; }
        }
#pragma unroll
        for (int r = 0; r < 16; ++r) { const int bit = (r & 3) + 8 * (r >> 2);
            const int m0 = __builtin_amdgcn_sbfe((int)w0, bit, 1), m1 = __builtin_amdgcn_sbfe((int)w1, bit, 1);
            const float a0 = s0[r], a1 = s1[r];
            s0[r] = __int_as_float((__float_as_int(a0) & m0) | ((int)0xff800000 & ~m0));
            s1[r] = __int_as_float((__float_as_int(a1) & m1) | ((int)0xff800000 & ~m1)); }
    };
    u32x4 st2[2];
    gload(0); lstore(0);
    if (nt > 1) gload(1);
    __syncthreads();
    auto step = [&](int i, u32x4 (&sL)[2], u32x4 (&sS)[2]) {
        if (i + 2 < nt) {
#pragma unroll
            for (int k = 0; k < 2; ++k) { const int idx = tid + 512 * k, rr = idx >> 4, ch = idx & 15; sL[k] = *(const u32x4*)(Cb + (size_t)(64 * (i + 2) + rr) * 128 + ch * 8); } }
        f32x16 s0, s1; score(i, s0, s1);
        exp_step(s0, s1, l); pv<4>(o, s0, s1, (lcptr)(Vb + (i & 1) * VT128), VS128, lane);
        if (i + 1 < nt) { lptr kd = Kb + ((i + 1) & 1) * KT128, vd = Vb + ((i + 1) & 1) * VT128;
#pragma unroll
            for (int k = 0; k < 2; ++k) { const int idx = tid + 512 * k, rr = idx >> 4, ch = idx & 15; *(LAS u32x4*)(kd + rr * KS128 + ch * 16) = sS[k]; *(LAS u32x4*)(vd + rr * VS128 + ch * 16) = sS[k]; } }
        __syncthreads();
    };
    for (int i = 0; i < nt; i += 2) { step(i, st2, st); if (i + 1 < nt) step(i + 1, st, st2); }
    l += __shfl_xor(l, 32); const float f = l > 0.f ? OSC / l : 0.f;
    unsigned char* orow = MIXIN + row * 1536 + head * 128;
#pragma unroll
    for (int d = 0; d < 4; ++d)
#pragma unroll
        for (int rg = 0; rg < 4; ++rg) *(unsigned*)(orow + 32 * d + 8 * rg + 4 * hi) = pg8::pk4_fp8(o[d][4 * rg] * f, o[d][4 * rg + 1] * f, o[d][4 * rg + 2] * f, o[d][4 * rg + 3] * f);
}

constexpr int DS_TILE = 32 * att::KS128, DS_WAVE = 2 * DS_TILE + 640;
__device__ __forceinline__ void dsa_query(int lane, int b, int t, u32x2 mw, att::lptr base, const LAS float* BTL, const bf16_t* QLAT, const bf16_t* CKVN, unsigned char* MIXIN) {
    using namespace att;
    const int c16 = lane & 15, g = lane >> 4, head = c16 & 7; const size_t row = (size_t)b * SEQ + t;
    LAS unsigned short* LIST = (LAS unsigned short*)(base + 2 * DS_TILE);
    bf16x8 qf[4];
#pragma unroll
    for (int ks = 0; ks < 4; ++ks) qf[ks] = *(const bf16x8*)(QLAT + row * 1024 + head * 128 + 32 * ks + 8 * g);
    int n;
    { unsigned long long bits = (lane <= (t >> 6)) ? ((unsigned long long)mw.x | ((unsigned long long)mw.y << 32)) : 0ull;
      const int cnt = __popcll(bits); int pre = cnt;
#pragma unroll
      for (int o = 1; o < 64; o <<= 1) { const int v = __shfl_up(pre, o); if (lane >= o) pre += v; }
      n = __builtin_amdgcn_readlane(pre, 63); int pos = pre - cnt;
      while (bits) { const int j = __builtin_ctzll(bits); bits &= bits - 1ull; LIST[pos++] = (unsigned short)(64 * lane + j); }
      if (lane < 32) LIST[n + lane] = 0; }
    const bf16_t* Cb = CKVN + (size_t)b * SEQ * 128; const LAS float* bt = BTL + head * 128;
    const int ntile = (n + 31) >> 5;
    f32x4 o[8]; float l = 0.f;
#pragma unroll
    for (int d = 0; d < 8; ++d) o[d] = (f32x4){0.f, 0.f, 0.f, 0.f};
    u32x4 ra[8], rb[8];
    auto gath = [&](int i, u32x4 (&r)[8]) {
#pragma unroll
        for (int k = 0; k < 8; ++k) { const int c = lane + 64 * k, rw = c >> 4, ch = c & 15; const int idx = LIST[32 * i + rw]; r[k] = *(const u32x4*)(Cb + (size_t)idx * 128 + ch * 8); } };
    auto put = [&](lptr T, const u32x4 (&r)[8]) {
#pragma unroll
        for (int k = 0; k < 8; ++k) { const int c = lane + 64 * k, rw = c >> 4, ch = c & 15; *(LAS u32x4*)(T + rw * KS128 + ch * 16) = r[k]; } };
    const int q4 = c16 >> 2, p4 = c16 & 3;
    auto tile = [&](int i) {
        lcptr T = (lcptr)(base + (i & 1) * DS_TILE);
        f32x4 slo = (f32x4){0.f, 0.f, 0.f, 0.f}, shi = (f32x4){0.f, 0.f, 0.f, 0.f};
        { lcptr p0 = T + c16 * KS128 + g * 16; lcptr p1 = p0 + 16 * KS128;
#pragma unroll
          for (int ks = 0; ks < 4; ++ks) { const bf16x8 k0 = *(const LAS bf16x8*)(p0 + ks * 64), k1 = *(const LAS bf16x8*)(p1 + ks * 64);
              slo = __builtin_amdgcn_mfma_f32_16x16x32_bf16(k0, qf[ks], slo, 0, 0, 0); shi = __builtin_amdgcn_mfma_f32_16x16x32_bf16(k1, qf[ks], shi, 0, 0, 0); } }
        float sv[8] = {slo[0], slo[1], slo[2], slo[3], shi[0], shi[1], shi[2], shi[3]};
        const int lastslot = (32 * i + 31 < n) ? 32 * i + 31 : n - 1;
        if (32 * i + 32 > n || t - (int)LIST[lastslot] < 127) {
            int li[8]; float bb[8];
#pragma unroll
            for (int r = 0; r < 8; ++r) li[r] = LIST[32 * i + 16 * (r >> 2) + 4 * g + (r & 3)];
#pragma unroll
            for (int r = 0; r < 8; ++r) asm volatile("" : "+v"(li[r]));
#pragma unroll
            for (int r = 0; r < 8; ++r) { const int d = t - li[r]; const unsigned ix = (unsigned)d < 127u ? (unsigned)d : 127u; bb[r] = bt[ix]; }
#pragma unroll
            for (int r = 0; r < 8; ++r) asm volatile("" : "+v"(bb[r]));
#pragma unroll
            for (int r = 0; r < 8; ++r) { const int slot = 32 * i + 16 * (r >> 2) + 4 * g + (r & 3); sv[r] = (slot < n) ? sv[r] + bb[r] : -INFINITY; }
        }
        float rs = 0.f;
#pragma unroll
        for (int r = 0; r < 8; ++r) { sv[r] = ex2(sv[r]); rs += sv[r]; }
        l += rs;
        u32x4 pw; pw.x = pk2(sv[0], sv[1]); pw.y = pk2(sv[2], sv[3]); pw.z = pk2(sv[4], sv[5]); pw.w = pk2(sv[6], sv[7]);
        const bf16x8 pk = __builtin_bit_cast(bf16x8, pw);
        lcptr vb = T + (4 * g + q4) * KS128 + (4 * p4) * 2;
#pragma unroll
        for (int d = 0; d < 8; ++d) { const s16x4 lo = vtr(vb + d * 32), hh = vtr(vb + 16 * KS128 + d * 32);
            const bf16x8 vf = (bf16x8){lo[0], lo[1], lo[2], lo[3], hh[0], hh[1], hh[2], hh[3]};
            o[d] = __builtin_amdgcn_mfma_f32_16x16x32_bf16(vf, pk, o[d], 0, 0, 0); }
    };
    gath(0, ra); put(base, ra);
    if (ntile > 1) gath(1, ra);
    for (int i = 0; i < ntile; i += 2) {
        if (i + 2 < ntile) gath(i + 2, rb);
        tile(i);
        if (i + 1 < ntile) {
            put(base + DS_TILE, ra);
            if (i + 3 < ntile) gath(i + 3, ra);
            tile(i + 1);
            if (i + 2 < ntile) put(base, rb);
        }
    }
    l += __shfl_xor(l, 16); l += __shfl_xor(l, 32); const float f = l > 0.f ? OSC / l : 0.f;
    if (c16 < 8) { unsigned char* orow = MIXIN + row * 1536 + head * 128 + 4 * g;
#pragma unroll
        for (int d = 0; d < 8; ++d) *(unsigned*)(orow + 16 * d) = pg8::pk4_fp8(o[d][0] * f, o[d][1] * f, o[d][2] * f, o[d][3] * f); }
}
__device__ __forceinline__ void phase_dsa_sparse(const Frame& F, const bf16_t* QLAT, const bf16_t* CKVN, const unsigned* MASK, const float* BT, unsigned char* MIXIN) {
    att::lptr lds = (att::lptr)F.lds; LAS float* BTL = (LAS float*)(lds + 8 * DS_WAVE);
    for (int i = F.tid; i < 1024; i += NTHR) BTL[i] = BT[i] - BT[i | 127];
    __syncthreads();
    att::lptr base = lds + F.wave * DS_WAVE;
    if ((F.G & 7) == 0) {
        const int b = F.bx & 7, wx = (F.bx >> 3) * NWAVES + F.wave, WX = (F.G >> 3) * NWAVES;
        u32x2 mw = *(const u32x2*)(MASK + ((size_t)b * SEQ + wx) * 128 + 2 * F.lane);
        for (int t = wx; t < SEQ; t += WX) { const int tn = (t + WX < SEQ) ? t + WX : t;
            const u32x2 mwn = *(const u32x2*)(MASK + ((size_t)b * SEQ + tn) * 128 + 2 * F.lane);
            const unsigned qwarm = *(const volatile unsigned*)(QLAT + ((size_t)b * SEQ + tn) * 1024 + 16 * F.lane);
            dsa_query(F.lane, b, t, mw, base, BTL, QLAT, CKVN, MIXIN); mw = mwn; asm volatile("" :: "v"(qwarm)); }
    } else {
        for (int q = F.gw; q < MTOK; q += F.NGW) { const u32x2 mw = *(const u32x2*)(MASK + (size_t)q * 128 + 2 * F.lane); dsa_query(F.lane, q >> 12, q & 4095, mw, base, BTL, QLAT, CKVN, MIXIN); }
    }
    __syncthreads();
}

__device__ __forceinline__ void slice_block32(const unsigned (&X)[16], unsigned (&S)[16]) {
    unsigned R[16];
#pragma unroll
    for (int i = 0; i < 8; ++i) { R[2 * i] = (X[i] & 0xffffu) | (X[i + 8] << 16); R[2 * i + 1] = (X[i] >> 16) | (X[i + 8] & 0xffff0000u); }
#pragma unroll
    for (int st = 0; st < 4; ++st) { const int j = 8 >> st; const unsigned m = (st == 0) ? 0x00ff00ffu : (st == 1) ? 0x0f0f0f0fu : (st == 2) ? 0x33333333u : 0x55555555u;
#pragma unroll
        for (int q = 0; q < 16; ++q) if (!(q & j)) { const unsigned a = R[q], b = R[q + j]; R[q] = (a & m) | ((b << j) & ~m); R[q + j] = ((a >> j) & m) | (b & ~m); } }
    const unsigned sg = R[15];
#pragma unroll
    for (int b = 0; b < 15; ++b) S[b] = R[b] ^ sg;
    S[15] = ~sg;
}

constexpr int Q8_STRIDE = 1104, K8_STRIDE = 80, NH8 = 17, SS8 = 272;
typedef int idx_v8 __attribute__((ext_vector_type(8)));
__device__ __forceinline__ void indexer_unit(const Frame& F, int b, int c, const unsigned char* QIDX8, const bf16_t* T1, _Float16* SC) {
    using namespace att;
    int tid = F.tid; asm volatile("" : "+v"(tid));
    const int lane = tid & 63, r32 = lane & 31, hi = lane >> 5, w = F.wave;
    lptr lds = (lptr)F.lds; lptr QI = lds; lptr KI = lds + 64 * Q8_STRIDE; lptr STG = KI + 128 * K8_STRIDE;
    const int qh = w & 1, kq = w >> 1;
    const size_t row0 = (size_t)b * SEQ + 64 * c;
#pragma unroll
    for (int k = 0; k < 8; ++k) { const int idx = tid + 512 * k, rr = idx >> 6, ch = idx & 63; *(LAS u32x4*)(QI + rr * Q8_STRIDE + ch * 16) = *(const u32x4*)(QIDX8 + (row0 + rr) * 1024 + ch * 16); }
    __syncthreads();
    { const int q = tid >> 3, dg = tid & 7; const size_t trow = row0 + q; const u32x4 wa = *(const u32x4*)(T1 + trow * 256 + 192), wb = *(const u32x4*)(T1 + trow * 256 + 200);
      const unsigned wq[8] = {wa.x, wa.y, wa.z, wa.w, wb.x, wb.y, wb.z, wb.w}; float a8[8];
#pragma unroll
      for (int i = 0; i < 8; ++i) a8[i] = 0.f;
#pragma unroll
      for (int h = 0; h < 16; ++h) { const float wh = 0.5f * ((h & 1) ? bfhi(wq[h >> 1]) : bflo(wq[h >> 1])); const u32x2 x = *(const LAS u32x2*)(QI + q * Q8_STRIDE + h * 64 + dg * 8);
          const f32x2 p0 = __builtin_amdgcn_cvt_pk_f32_fp8((int)x.x, false), p1 = __builtin_amdgcn_cvt_pk_f32_fp8((int)x.x, true), p2 = __builtin_amdgcn_cvt_pk_f32_fp8((int)x.y, false), p3 = __builtin_amdgcn_cvt_pk_f32_fp8((int)x.y, true);
          a8[0] += wh * p0[0]; a8[1] += wh * p0[1]; a8[2] += wh * p1[0]; a8[3] += wh * p1[1]; a8[4] += wh * p2[0]; a8[5] += wh * p2[1]; a8[6] += wh * p3[0]; a8[7] += wh * p3[1]; }
      u32x2 o; o.x = pg8::pk4_fp8(a8[0], a8[1], a8[2], a8[3]); o.y = pg8::pk4_fp8(a8[4], a8[5], a8[6], a8[7]);
      *(LAS u32x2*)(QI + q * Q8_STRIDE + 1024 + dg * 8) = o; }
    unsigned wp[8];
    { const size_t trow = row0 + 32 * qh + r32; const u32x4 a = *(const u32x4*)(T1 + trow * 256 + 192), bq = *(const u32x4*)(T1 + trow * 256 + 200);
      wp[0] = a.x; wp[1] = a.y; wp[2] = a.z; wp[3] = a.w; wp[4] = bq.x; wp[5] = bq.y; wp[6] = bq.z; wp[7] = bq.w; }
    const int nsup = (c + 2) >> 1, pitch = (c + 1) * 64;
    const int ft = tid & 255;
    _Float16* sdst = SC + (size_t)b * SCB_ELEMS + (size_t)4096 * (c * (c + 1) / 2) + (size_t)(ft >> 2) * pitch + 32 * (ft & 3);
    auto flush = [&](int sp) { if ((tid < 256) == !(sp & 1) && 128 * sp + 32 * (ft & 3) < pitch) { lcptr p = (lcptr)STG + (sp & 1) * (64 * SS8) + (ft >> 2) * SS8 + (ft & 3) * 64;
            unsigned X[16], S[16];
#pragma unroll
            for (int i = 0; i < 4; ++i) { const u32x4 v = *(const LAS u32x4*)(p + 16 * i); X[4 * i] = v.x; X[4 * i + 1] = v.y; X[4 * i + 2] = v.z; X[4 * i + 3] = v.w; }
            slice_block32(X, S);
            u32x4* d = (u32x4*)(sdst + 128 * sp);
#pragma unroll
            for (int i = 0; i < 4; ++i) d[i] = (u32x4){S[4 * i], S[4 * i + 1], S[4 * i + 2], S[4 * i + 3]}; } };
    const bf16_t* Kb = T1 + (size_t)b * SEQ * 256 + 128;
    const int krow = tid >> 2, kch = tid & 3;
    u32x4 st[2];
    { const bf16_t* p = Kb + (size_t)krow * 256 + kch * 16; st[0] = *(const u32x4*)p; st[1] = *(const u32x4*)(p + 8); }
    int sc8 = 0x7f7f7f7f; asm volatile("" : "+v"(sc8));
    for (int s = 0; s < nsup; ++s) {
        __syncthreads();
        { u32x4 o; o.x = pg8::pk4_fp8(bflo(st[0].x), bfhi(st[0].x), bflo(st[0].y), bfhi(st[0].y)); o.y = pg8::pk4_fp8(bflo(st[0].z), bfhi(st[0].z), bflo(st[0].w), bfhi(st[0].w));
          o.z = pg8::pk4_fp8(bflo(st[1].x), bfhi(st[1].x), bflo(st[1].y), bfhi(st[1].y)); o.w = pg8::pk4_fp8(bflo(st[1].z), bfhi(st[1].z), bflo(st[1].w), bfhi(st[1].w));
          *(LAS u32x4*)(KI + krow * K8_STRIDE + kch * 16) = o; }
        __syncthreads();
        if (s > 0) flush(s - 1);
        { const int sn = (s + 1 < nsup) ? s + 1 : s;
          const bf16_t* p = Kb + (size_t)(128 * sn + krow) * 256 + kch * 16; st[0] = *(const u32x4*)p; st[1] = *(const u32x4*)(p + 8); }
        const int key0 = 128 * s + 32 * kq;
        if (key0 <= 64 * c + 63) {
            idx_v8 kf; { lcptr kp = (lcptr)KI + (32 * kq + r32) * K8_STRIDE + hi * 32; const u32x4 k0 = *(const LAS u32x4*)kp, k1 = *(const LAS u32x4*)(kp + 16);
                kf = (idx_v8){(int)k0.x, (int)k0.y, (int)k0.z, (int)k0.w, (int)k1.x, (int)k1.y, (int)k1.z, (int)k1.w}; }
            float sc[16];
#pragma unroll
            for (int r = 0; r < 16; ++r) sc[r] = 0.f;
            lcptr qp = (lcptr)QI + (32 * qh + r32) * Q8_STRIDE + hi * 32;
            f32x16 ac[2]; idx_v8 qv[2];
#pragma unroll
            for (int i = 0; i < 8; ++i) asm volatile("" : "+v"(wp[i]));
            { const u32x4 q0 = *(const LAS u32x4*)qp, q1 = *(const LAS u32x4*)(qp + 16); qv[0] = (idx_v8){(int)q0.x, (int)q0.y, (int)q0.z, (int)q0.w, (int)q1.x, (int)q1.y, (int)q1.z, (int)q1.w}; }
#pragma unroll
            for (int hd = 0; hd <= NH8; ++hd) {
                if (hd + 1 < NH8) { const u32x4 q0 = *(const LAS u32x4*)(qp + (hd + 1) * 64), q1 = *(const LAS u32x4*)(qp + (hd + 1) * 64 + 16);
                    qv[(hd + 1) & 1] = (idx_v8){(int)q0.x, (int)q0.y, (int)q0.z, (int)q0.w, (int)q1.x, (int)q1.y, (int)q1.z, (int)q1.w}; }
                if (hd == 0) asm volatile("s_nop 1\n\tv_mfma_scale_f32_32x32x64_f8f6f4 %0, %1, %2, 0, %3, %3 op_sel_hi:[0,0,0]\n\ts_nop 15\n\ts_nop 7" : "=&v"(ac[0]) : "v"(kf), "v"(qv[0]), "v"(sc8));
                else if (hd < NH8) asm volatile("s_nop 1\n\tv_mfma_scale_f32_32x32x64_f8f6f4 %0, %2, %3, 0, %4, %4 op_sel_hi:[0,0,0]\n\ts_nop 7" : "=&v"(ac[hd & 1]), "+v"(ac[(hd - 1) & 1]) : "v"(kf), "v"(qv[hd & 1]), "v"(sc8));
                else asm volatile("s_nop 7" : "+v"(ac[(hd - 1) & 1]));
                if (hd > 0 && hd <= 16) { const float ww = 0.5f * (((hd - 1) & 1) ? bfhi(wp[(hd - 1) >> 1]) : bflo(wp[(hd - 1) >> 1]));
#pragma unroll
                    for (int r = 0; r < 16; ++r) { const float av = ac[(hd - 1) & 1][r]; sc[r] = __builtin_fmaf(__builtin_fabsf(av), ww, sc[r]); } }
                if (hd == NH8) {
#pragma unroll
                    for (int r = 0; r < 16; ++r) { const float av = ac[(hd - 1) & 1][r]; sc[r] += av; } }
                if (hd + 1 < NH8) asm volatile("" : "+v"(sc[0]), "+v"(sc[1]), "+v"(sc[2]), "+v"(sc[3]), "+v"(sc[4]), "+v"(sc[5]), "+v"(sc[6]), "+v"(sc[7]), "+v"(sc[8]), "+v"(sc[9]), "+v"(sc[10]), "+v"(sc[11]), "+v"(sc[12]), "+v"(sc[13]), "+v"(sc[14]), "+v"(sc[15]), "+v"(qv[(hd + 1) & 1]));
                else asm volatile("" : "+v"(sc[0]), "+v"(sc[1]), "+v"(sc[2]), "+v"(sc[3]), "+v"(sc[4]), "+v"(sc[5]), "+v"(sc[6]), "+v"(sc[7]), "+v"(sc[8]), "+v"(sc[9]), "+v"(sc[10]), "+v"(sc[11]), "+v"(sc[12]), "+v"(sc[13]), "+v"(sc[14]), "+v"(sc[15]));
            }
            lptr sp = STG + (s & 1) * (64 * SS8) + (32 * qh + r32) * SS8 + (32 * kq + 4 * hi) * 2;
#pragma unroll
            for (int rg = 0; rg < 4; ++rg) { f32x2 a = {sc[4 * rg], sc[4 * rg + 1]}, bq = {sc[4 * rg + 2], sc[4 * rg + 3]};
                u32x2 o; o.x = __builtin_bit_cast(unsigned, __builtin_convertvector(a, f16x2_t)); o.y = __builtin_bit_cast(unsigned, __builtin_convertvector(bq, f16x2_t));
                *(LAS u32x2*)(sp + 16 * rg) = o; }
        }
    }
    __syncthreads();
    flush(nsup - 1);
}

__device__ __forceinline__ int wave_sum_i(int v) {
    v += __builtin_amdgcn_update_dpp(0, v, 0xB1, 0xF, 0xF, true);
    v += __builtin_amdgcn_update_dpp(0, v, 0x4E, 0xF, 0xF, true);
    v += __builtin_amdgcn_update_dpp(0, v, 0x141, 0xF, 0xF, true);
    v += __builtin_amdgcn_update_dpp(0, v, 0x140, 0xF, 0xF, true);
    return __builtin_amdgcn_readlane(v, 0) + __builtin_amdgcn_readlane(v, 16) + __builtin_amdgcn_readlane(v, 32) + __builtin_amdgcn_readlane(v, 48);
}
struct SelRow { const unsigned short* src; unsigned* mrow; int t, c; };
__device__ __forceinline__ SelRow sel_row(int row, const _Float16* SC, unsigned* MASK) {
    SelRow r; const int b = row >> 12; r.t = row & 4095; r.c = r.t >> 6; const int nk = (r.c + 1) * 64;
    r.src = (const unsigned short*)SC + (size_t)b * SCB_ELEMS + (size_t)4096 * (r.c * (r.c + 1) / 2) + (size_t)(r.t & 63) * nk; r.mrow = MASK + (size_t)row * 128; return r;
}
__device__ __forceinline__ void sel_fetch(const SelRow& r, int lane, u32x4 (&x)[8]) {
    if (lane <= r.c) { const u32x4* p = (const u32x4*)(r.src + 64 * lane);
#pragma unroll
        for (int i = 0; i < 8; ++i) x[i] = p[i]; }
    else {
#pragma unroll
        for (int i = 0; i < 8; ++i) x[i] = (u32x4){0u, 0u, 0u, 0u}; }
}
__device__ __forceinline__ void sel_slices(const u32x4 (&x)[8], unsigned (&S)[2][16]) {
#pragma unroll
    for (int k = 0; k < 2; ++k)
#pragma unroll
        for (int i = 0; i < 4; ++i) { S[k][4 * i] = x[4 * k + i].x; S[k][4 * i + 1] = x[4 * k + i].y; S[k][4 * i + 2] = x[4 * k + i].z; S[k][4 * i + 3] = x[4 * k + i].w; }
}
__device__ __forceinline__ void phase_select(const Frame& F, const _Float16* SC, unsigned* MASK) {
    const int lane = F.lane;
    u32x4 xa[8], xb[8];
    if (F.gw < MTOK / 2) { sel_fetch(sel_row(F.gw, SC, MASK), lane, xa); sel_fetch(sel_row(F.gw + MTOK / 2, SC, MASK), lane, xb); }
    for (int p = F.gw; p < MTOK / 2; p += F.NGW) {
        const SelRow ra = sel_row(p, SC, MASK), rb = sel_row(p + MTOK / 2, SC, MASK);
        unsigned Sa[2][16], Sb[2][16];
        sel_slices(xa, Sa); sel_slices(xb, Sb);
        { const int pn = (p + F.NGW < MTOK / 2) ? p + F.NGW : p;
          sel_fetch(sel_row(pn, SC, MASK), lane, xa); sel_fetch(sel_row(pn + MTOK / 2, SC, MASK), lane, xb); }
        unsigned long long va, vb;
        { const int nv = ra.t - 64 * lane + 1; va = nv >= 64 ? ~0ull : (nv <= 0 ? 0ull : ((1ull << nv) - 1ull)); }
        { const int nv = rb.t - 64 * lane + 1; vb = nv >= 64 ? ~0ull : (nv <= 0 ? 0ull : ((1ull << nv) - 1ull)); }
        unsigned a0 = (unsigned)va, a1 = (unsigned)(va >> 32), b0 = (unsigned)vb, b1 = (unsigned)(vb >> 32), sa0 = 0u, sa1 = 0u, sb0 = 0u, sb1 = 0u;
        int na = 256, nb = 256;
#pragma unroll
        for (int bit = 15; bit >= 0; --bit) {
            const unsigned ta0 = a0 & Sa[0][bit], ta1 = a1 & Sa[1][bit], tb0 = b0 & Sb[0][bit], tb1 = b1 & Sb[1][bit];
            const int ca = wave_sum_i(__popc(ta0) + __popc(ta1)), cb = wave_sum_i(__popc(tb0) + __popc(tb1));
            const bool ga = ca >= na, gb = cb >= nb; const unsigned fa = ga ? 0u : ~0u, fb = gb ? 0u : ~0u;
            a0 &= Sa[0][bit] ^ fa; a1 &= Sa[1][bit] ^ fa; b0 &= Sb[0][bit] ^ fb; b1 &= Sb[1][bit] ^ fb;
            sa0 |= ta0 & fa; sa1 |= ta1 & fa; sb0 |= tb0 & fb; sb1 |= tb1 & fb;
            na -= ga ? 0 : ca; nb -= gb ? 0 : cb;
        }
#pragma unroll
        for (int w = 0; w < 2; ++w) {
            unsigned long long a = w ? ((unsigned long long)b0 | ((unsigned long long)b1 << 32)) : ((unsigned long long)a0 | ((unsigned long long)a1 << 32)); const int need = w ? nb : na;
            const int pc = __popcll(a), tot = wave_sum_i(pc);
            if (tot > need) {
                int pre = pc;
#pragma unroll
                for (int o = 1; o < 64; o <<= 1) { const int v = __shfl_up(pre, o); if (lane >= o) pre += v; }
                const int take = need - (pre - pc);
                if (take <= 0) a = 0ull; else while (__popcll(a) > take) a &= ~(1ull << (63 - __clzll(a)));
            }
            const SelRow& r = w ? rb : ra;
            const unsigned s0 = (w ? sb0 : sa0) | (unsigned)a, s1 = (w ? sb1 : sa1) | (unsigned)(a >> 32);
            if (lane <= r.c) *(u32x2*)(r.mrow + 2 * lane) = (u32x2){s0, s1};
        }
    }
}

__device__ __forceinline__ float gelu_tanh(float x) { const float u = 0.7978845608028654f * (x + 0.044715f * x * x * x); const float e = __expf(2.f * u); return 0.5f * x * (1.f + (1.f - 2.f / (e + 1.f))); }
__device__ __forceinline__ void compress_unit(const Frame& F, int b, int g, int kv, int rt, const bf16_t* KVC, const bf16_t* W1T, const float* w2, const float* cb, bf16_t* OUT) {
    const int lane = F.lane, r32 = lane & 31, hi = lane >> 5, w = F.wave, tid = F.tid;
    LAS float* PART = (LAS float*)F.lds;
    LAS float* HID = PART + 8 * 2048;
    const int n0 = 32 * rt, nn = n0 + r32, nc = nn < 255 ? nn : 254;
    const bf16_t* arow = KVC + ((size_t)b * SEQ + 16 * nc) * 256 + kv * 128 + g * 64;
    f32x16 a0 = att::splat16(0.f), a1 = att::splat16(0.f);
#pragma unroll 4
    for (int ks = 0; ks < 16; ++ks) { const int l = 4 * w + (ks >> 2), d = 16 * (ks & 3) + 8 * hi;
        const bf16x8 af = *(const bf16x8*)(arow + (size_t)l * 256 + d);
        const bf16x8 b0 = *(const bf16x8*)(W1T + (size_t)r32 * 2048 + l * 64 + d), b1 = *(const bf16x8*)(W1T + (size_t)(32 + r32) * 2048 + l * 64 + d);
        a0 = __builtin_amdgcn_mfma_f32_32x32x16_bf16(af, b0, a0, 0, 0, 0); a1 = __builtin_amdgcn_mfma_f32_32x32x16_bf16(af, b1, a1, 0, 0, 0); }
#pragma unroll
    for (int r = 0; r < 16; ++r) { const int mrow = att::crow(r, hi); PART[w * 2048 + mrow * 64 + r32] = a0[r]; PART[w * 2048 + mrow * 64 + 32 + r32] = a1[r]; }
    __syncthreads();
#pragma unroll
    for (int k = 0; k < 4; ++k) { const int idx = tid + 512 * k; float s = cb[idx & 63];
#pragma unroll
        for (int ww = 0; ww < 8; ++ww) s += PART[ww * 2048 + idx];
        HID[idx] = gelu_tanh(s); }
    __syncthreads();
#pragma unroll
    for (int k = 0; k < 4; ++k) { const int idx = tid + 512 * k, nr = idx >> 6, f = idx & 63; float s = 0.f;
#pragma unroll 8
        for (int e = 0; e < 64; ++e) s += HID[nr * 64 + e] * w2[e * 64 + f];
        const int blk = n0 + nr;
        OUT[(((size_t)b * 256 + blk) * 2 + g) * 64 + f] = (blk < 255) ? (bf16_t)f2bf(s) : (bf16_t)0; }
    __syncthreads();
}

#ifdef DBG_MODE
namespace dbg {
constexpr int NSLOT = 40;
__device__ __forceinline__ float bfr(float x) { return bf2f((unsigned short)f2bf(x)); }
__device__ __forceinline__ int srow(int i, int n) { return (int)(((unsigned)i * 2654435761u) % (unsigned)MTOK) ; }
__device__ void commit(unsigned* D, int slot, const float* ref, const float* fast, int n, float tf) {
    __shared__ float red[256];
    const int tid = threadIdx.x; float s = 0.f;
    for (int i = tid; i < n; i += 256) s += ref[i] * ref[i];
    red[tid] = s; __syncthreads();
    for (int o = 128; o > 0; o >>= 1) { if (tid < o) red[tid] += red[tid + o]; __syncthreads(); }
    const float rms = sqrtf(red[0] / (float)n); __syncthreads();
    int bad = 0, tot = 0; float mr = 0.f;
    for (int i = tid; i < n; i += 256) { const float e = fabsf(fast[i] - ref[i]); const float tol = tf * (rms + fabsf(ref[i])) + 1e-7f; if (!(e <= tol)) ++bad; ++tot; const float r = e / (rms + 1e-20f); if (r > mr || !(r == r)) mr = (r == r) ? r : 1e30f; }
    atomicAdd(&D[4 * slot], (unsigned)bad); atomicAdd(&D[4 * slot + 1], (unsigned)tot); atomicMax(&D[4 * slot + 2], __float_as_uint(mr));
    __syncthreads();
}
__device__ __forceinline__ float bias_l2(const float* relb, int head, int dist) { return relb[t5_bucket(dist) * 16 + head] * LOG2E; }

__global__ void chk_in_e(Args a, unsigned* D) {
    __shared__ float ref[1792], fast[1792];
    const int r = srow(blockIdx.x, 64), tid = threadIdx.x; const float* x = a.in[I_X] + (size_t)r * 1024; const float* w = a.in[I_EWIN];
    const bf16_t* Y1 = (const bf16_t*)(a.ws + OFF_Y1);
    for (int n = tid; n < EVEN_IN; n += 256) { float s = 0.f; for (int k = 0; k < 1024; ++k) s += bfr(x[k]) * bfr(w[(size_t)k * EVEN_IN + n]);
        const int dc = RowInE{}(n), tile = dc >> 8, col = dc & 255; const float sc = (tile == 2 || tile == 3) ? QSCALE : 1.f;
        ref[n] = s * sc; fast[n] = bf2f(Y1[((size_t)tile * MTOK + r) * 256 + col]); }
    __syncthreads();
    commit(D, 1, ref, fast, EVEN_IN, 0.02f);
    if (tid == 0) { float sq = 0.f, skv = 0.f; for (int n = 0; n < 256; ++n) sq += ref[n] * ref[n]; for (int n = 256; n < 384; ++n) skv += ref[n] * ref[n];
        const float* pq = (const float*)(a.ws + OFF_SSQ_Q) + (size_t)r * 4; const float* pk = (const float*)(a.ws + OFF_SSQ_KV) + (size_t)r * 4;
        const float fq = pq[0] + pq[1] + pq[2] + pq[3], fk = pk[0] + pk[1] + pk[2] + pk[3];
        int bad = 0; if (!(fabsf(fq - sq) <= 0.02f * sq)) ++bad; if (!(fabsf(fk - skv) <= 0.02f * skv)) ++bad;
        atomicAdd(&D[4 * 2], (unsigned)bad); atomicAdd(&D[4 * 2 + 1], 2u); }
}
__global__ void chk_q2(Args a, unsigned* D) {
    __shared__ float ref[1024], fast[1024], cqn[256], qh[512];
    const int r = srow(blockIdx.x, 64), tid = threadIdx.x; const bf16_t* Y1 = (const bf16_t*)(a.ws + OFF_Y1);
    const bf16_t* CQ = Y1 + (size_t)r * 256; const bf16_t* T1 = Y1 + ((size_t)MTOK + r) * 256;
    { float s = 0.f; for (int k = 0; k < 128; ++k) { const float c = bf2f(T1[k]); s += c * c; } const float rk = 1.f / sqrtf(s / 128.f + 1e-6f);
      if (tid < 128) { ref[tid] = bf2f(T1[tid]) * rk * a.in[I_EKVN][tid]; fast[tid] = bf2f(((const bf16_t*)(a.ws + OFF_CKVN))[(size_t)r * 128 + tid]); } }
    __syncthreads(); commit(D, 3, ref, fast, 128, 0.02f);
    { float s = 0.f; for (int k = 0; k < 256; ++k) { const float c = bf2f(CQ[k]); s += c * c; } const float rq = 1.f / sqrtf(s / 256.f + 1e-6f);
      cqn[tid] = bf2f(CQ[tid]) * rq * a.in[I_EQN][tid]; }
    __syncthreads();
    for (int o = tid; o < 512; o += 256) { float s = 0.f; for (int k = 0; k < 256; ++k) s += cqn[k] * a.in[I_EWUQ][k * 512 + o]; qh[o] = s; }
    __syncthreads();
    for (int o = tid; o < 1024; o += 256) { const int h = o >> 7, c = o & 127; float s = 0.f; for (int d = 0; d < 64; ++d) s += qh[h * 64 + d] * a.in[I_EWUK][c * 512 + h * 64 + d];
        ref[o] = s * QSCALE; fast[o] = bf2f(((const bf16_t*)(a.ws + OFF_QLAT))[(size_t)r * 1024 + o]); }
    __syncthreads(); commit(D, 5, ref, fast, 1024, 0.03f);
    for (int o = tid; o < 1024; o += 256) { float s = 0.f; for (int k = 0; k < 256; ++k) s += cqn[k] * a.in[I_EWQIDX][k * 1024 + o];
        ref[o] = s; fast[o] = bf2f(((const bf16_t*)(a.ws + OFF_QIDX))[(size_t)r * 1024 + o]); }
    __syncthreads(); commit(D, 6, ref, fast, 1024, 0.03f);
}
__global__ void chk_cmp(Args a, unsigned* D) {
    __shared__ float ref[64], fast[64], hid[64];
    const int i = blockIdx.x, tid = threadIdx.x, b = i & 7, g = (i >> 3) & 1, kv = (i >> 4) & 1; const int blk = (i >> 5) == 0 ? 0 : ((i >> 5) == 1 ? 254 : (int)((unsigned)(i * 37 + 11) % 255u));
    const bf16_t* KVC = (const bf16_t*)(a.ws + OFF_Y1) + (size_t)4 * MTOK * 256;
    const float* pos = a.in[kv ? I_EPOSV : I_EPOSK]; const float* w1 = a.in[kv ? I_ECV1 : I_ECK1]; const float* w2 = a.in[kv ? I_ECV2 : I_ECK2];
    if (tid < 64) { float s = 0.f;
        for (int l = 0; l < 32; ++l) for (int d = 0; d < 64; ++d) { const float av = bf2f(KVC[((size_t)b * SEQ + 16 * blk + l) * 256 + kv * 128 + g * 64 + d]); const float wv = w1[(l * 64 + d) * 64 + tid]; s += av * bfr(wv) + pos[l * 64 + d] * wv; }
        hid[tid] = gelu_tanh(s); }
    __syncthreads();
    if (tid < 64) { float s = 0.f; for (int e = 0; e < 64; ++e) s += hid[e] * w2[e * 64 + tid]; ref[tid] = s;
        fast[tid] = bf2f(((const bf16_t*)(a.ws + (kv ? OFF_VC : OFF_KC)))[(((size_t)b * 256 + blk) * 2 + g) * 64 + tid]); }
    __syncthreads(); commit(D, 4, ref, fast, 64, 0.03f);
}
__global__ void chk_idx(Args a, unsigned* D) {
    __shared__ float ref[256], fast[256];
    const int r = (blockIdx.x < 4) ? (blockIdx.x * 4096 + blockIdx.x * 61) : srow(blockIdx.x, 64), tid = threadIdx.x, b = r >> 12, t = r & 4095, c = t >> 6, nk = (c + 1) * 64;
    const bf16_t* Y1 = (const bf16_t*)(a.ws + OFF_Y1); const bf16_t* T1 = Y1 + (size_t)MTOK * 256; const bf16_t* QI = (const bf16_t*)(a.ws + OFF_QIDX) + (size_t)r * 1024;
    const int s = (int)(((unsigned)tid * 2654435761u + 12345u * blockIdx.x) % (unsigned)nk);
    const bf16_t* kr = T1 + ((size_t)b * SEQ + s) * 256 + 128; float sc = 0.f;
    for (int h = 0; h < 16; ++h) { float d = 0.f; for (int k = 0; k < 64; ++k) d += bf2f(QI[h * 64 + k]) * bf2f(kr[k]); sc += bf2f(T1[(size_t)r * 256 + 192 + h]) * fmaxf(d, 0.f); }
    ref[tid] = sc;
    const _Float16* SC = (const _Float16*)(a.ws + OFF_SC) + (size_t)b * SCB_ELEMS + (size_t)4096 * (c * (c + 1) / 2) + (size_t)(t & 63) * nk;
    fast[tid] = (float)SC[s];
    __syncthreads(); commit(D, 7, ref, fast, 256, 0.02f);
}
__global__ void chk_sel(Args a, unsigned* D) {
    __shared__ unsigned key[4096];
    const int r = (blockIdx.x < 8) ? (blockIdx.x * 4096 + 255 + blockIdx.x * 300) : srow(blockIdx.x, 64), tid = threadIdx.x, b = r >> 12, t = r & 4095, c = t >> 6, nk = (c + 1) * 64;
    const unsigned short* SC = (const unsigned short*)(a.ws + OFF_SC) + (size_t)b * SCB_ELEMS + (size_t)4096 * (c * (c + 1) / 2) + (size_t)(t & 63) * nk;
    const unsigned* M = (const unsigned*)(a.ws + OFF_MASK) + (size_t)r * 128;
    for (int s = tid; s < nk; s += 256) { const unsigned u = SC[s]; key[s] = (s <= t) ? ((u & 0x8000u) ? (~u & 0xffffu) : (u | 0x8000u)) : 0u; }
    __syncthreads();
    int bad = 0, tot = 0;
    for (int s = tid; s < nk; s += 256) { bool want;
        if (s > t) want = false; else if (t < 256) want = true;
        else { int rank = 0; const unsigned ks = key[s]; for (int q = 0; q <= t; ++q) rank += (key[q] > ks || (key[q] == ks && q < s)) ? 1 : 0; want = rank < 256; }
        const bool got = (M[s >> 5] >> (s & 31)) & 1u; if (want != got) ++bad; ++tot; }
    atomicAdd(&D[4 * 8], (unsigned)bad); atomicAdd(&D[4 * 8 + 1], (unsigned)tot);
}
__global__ void chk_dsa(Args a, unsigned* D) {
    __shared__ float lg[4096], red[256], ref[128], fast[128];
    const int r = (blockIdx.x < 8) ? (blockIdx.x * 4096 + blockIdx.x * 37) : srow(blockIdx.x, 64), tid = threadIdx.x, b = r >> 12, t = r & 4095, h = blockIdx.x & 7;
    const bf16_t* Q = (const bf16_t*)(a.ws + OFF_QLAT) + (size_t)r * 1024 + h * 128; const bf16_t* C = (const bf16_t*)(a.ws + OFF_CKVN) + (size_t)b * SEQ * 128;
    const unsigned* M = (const unsigned*)(a.ws + OFF_MASK) + (size_t)r * 128; const float* relb = a.in[I_RELB];
    float mx = -INFINITY;
    for (int s = tid; s <= t; s += 256) { float v = -INFINITY; if ((M[s >> 5] >> (s & 31)) & 1u) { float d = 0.f; for (int k = 0; k < 128; ++k) d += bf2f(Q[k]) * bf2f(C[(size_t)s * 128 + k]); v = d + bias_l2(relb, h, t - s); } lg[s] = v; mx = fmaxf(mx, v); }
    red[tid] = mx; __syncthreads(); for (int o = 128; o > 0; o >>= 1) { if (tid < o) red[tid] = fmaxf(red[tid], red[tid + o]); __syncthreads(); } mx = red[0]; __syncthreads();
    float sm = 0.f; for (int s = tid; s <= t; s += 256) { const float p = exp2f(lg[s] - mx); lg[s] = p; sm += p; }
    red[tid] = sm; __syncthreads(); for (int o = 128; o > 0; o >>= 1) { if (tid < o) red[tid] += red[tid + o]; __syncthreads(); } sm = red[0]; __syncthreads();
    if (tid < 128) { float o = 0.f; for (int s = 0; s <= t; ++s) o += lg[s] * bf2f(C[(size_t)s * 128 + tid]); ref[tid] = o / sm; fast[tid] = bf2f(((const bf16_t*)(a.ws + OFF_MIXIN))[(size_t)r * 1536 + h * 128 + tid]); }
    __syncthreads(); commit(D, 9, ref, fast, 128, 0.03f);
}
__global__ void chk_nsa(Args a, unsigned* D) {
    __shared__ float pc[4][256], lg[1100], red[256], ref[64], fast[64], oacc[3][64], scb[64]; __shared__ int selj[16]; __shared__ float qs[4][64];
    const int r = (blockIdx.x < 8) ? (blockIdx.x * 4096 + blockIdx.x * 41) : srow(blockIdx.x, 64), tid = threadIdx.x, b = r >> 12, t = r & 4095, hh = blockIdx.x & 7, g = hh >> 2, n = hh & 3, cur = t >> 6;
    const bf16_t* Y1 = (const bf16_t*)(a.ws + OFF_Y1); const bf16_t* T1 = Y1 + (size_t)MTOK * 256; const bf16_t* QB = Y1 + (size_t)(2 + g) * MTOK * 256;
    const bf16_t* KVS = Y1 + (size_t)5 * MTOK * 256; const bf16_t* KVW = Y1 + (size_t)6 * MTOK * 256;
    const bf16_t* KC = (const bf16_t*)(a.ws + OFF_KC); const bf16_t* VC = (const bf16_t*)(a.ws + OFF_VC); const float* relb = a.in[I_RELB];
    qs[tid >> 6][tid & 63] = bf2f(QB[(size_t)r * 256 + tid]);
    __syncthreads();
    const int vis = (t >= 31) ? ((t - 31) >> 4) : -1;
    for (int nn = 0; nn < 4; ++nn) {
        float v = -INFINITY; if (tid <= vis) { float d = 0.f; for (int k = 0; k < 64; ++k) d += qs[nn][k] * bf2f(KC[(((size_t)b * 256 + tid) * 2 + g) * 64 + k]); v = d + bias_l2(relb, 8 + 4 * g + nn, t - 16 * tid - 31); }
        red[tid] = v; __syncthreads(); for (int o = 128; o > 0; o >>= 1) { if (tid < o) red[tid] = fmaxf(red[tid], red[tid + o]); __syncthreads(); } const float mx = red[0]; __syncthreads();
        const float p = (tid <= vis) ? exp2f(v - mx) : 0.f; red[tid] = p; __syncthreads(); for (int o = 128; o > 0; o >>= 1) { if (tid < o) red[tid] += red[tid + o]; __syncthreads(); } const float sm = red[0]; __syncthreads();
        pc[nn][tid] = sm > 0.f ? p / sm : 0.f; __syncthreads();
    }
    if (tid < 64) { float o = 0.f; for (int i = 0; i <= vis; ++i) o += pc[n][i] * bf2f(VC[(((size_t)b * 256 + i) * 2 + g) * 64 + tid]); oacc[0][tid] = o;
        float s = 0.f; for (int nn = 0; nn < 4; ++nn) for (int i = 4 * tid - 1; i <= 4 * tid + 3; ++i) if (i >= 0 && i < 255) s += pc[nn][i];
        scb[tid] = (tid > cur) ? -INFINITY : ((tid == 0 || tid == cur || tid == cur - 1) ? INFINITY : s); }
    __syncthreads();
    if (tid < 64) { int rank = 0; for (int j = 0; j < 64; ++j) rank += (scb[j] > scb[tid] || (scb[j] == scb[tid] && j < tid)) ? 1 : 0; if (rank < 16) selj[rank] = tid; }
    __syncthreads();
    { float mx = -INFINITY;
      for (int i = tid; i < 1024; i += 256) { const int j = selj[i >> 6], p = 64 * j + (i & 63); float v = -INFINITY; if (p <= t) { float d = 0.f; for (int k = 0; k < 64; ++k) d += qs[n][k] * bf2f(KVS[((size_t)b * SEQ + p) * 256 + g * 64 + k]); v = d + bias_l2(relb, 8 + hh, t - p); } lg[i] = v; mx = fmaxf(mx, v); }
      red[tid] = mx; __syncthreads(); for (int o = 128; o > 0; o >>= 1) { if (tid < o) red[tid] = fmaxf(red[tid], red[tid + o]); __syncthreads(); } mx = red[0]; __syncthreads();
      float sm = 0.f; for (int i = tid; i < 1024; i += 256) { const float p = exp2f(lg[i] - mx); lg[i] = p; sm += p; }
      red[tid] = sm; __syncthreads(); for (int o = 128; o > 0; o >>= 1) { if (tid < o) red[tid] += red[tid + o]; __syncthreads(); } sm = red[0]; __syncthreads();
      if (tid < 64) { float o = 0.f; for (int i = 0; i < 1024; ++i) { const int p = 64 * selj[i >> 6] + (i & 63); if (p <= t) o += lg[i] * bf2f(KVS[((size_t)b * SEQ + p) * 256 + 128 + g * 64 + tid]); } oacc[1][tid] = o / sm; }
      __syncthreads(); }
    { float mx = -INFINITY;
      for (int i = tid; i < 512; i += 256) { const int p = t - i; float v = -INFINITY; if (p >= 0) { float d = 0.f; for (int k = 0; k < 64; ++k) d += qs[n][k] * bf2f(KVW[((size_t)b * SEQ + p) * 256 + g * 64 + k]); v = d + bias_l2(relb, 8 + hh, i); } lg[i] = v; mx = fmaxf(mx, v); }
      red[tid] = mx; __syncthreads(); for (int o = 128; o > 0; o >>= 1) { if (tid < o) red[tid] = fmaxf(red[tid], red[tid + o]); __syncthreads(); } mx = red[0]; __syncthreads();
      float sm = 0.f; for (int i = tid; i < 512; i += 256) { const float p = exp2f(lg[i] - mx); lg[i] = p; sm += p; }
      red[tid] = sm; __syncthreads(); for (int o = 128; o > 0; o >>= 1) { if (tid < o) red[tid] += red[tid + o]; __syncthreads(); } sm = red[0]; __syncthreads();
      if (tid < 64) { float o = 0.f; for (int i = 0; i < 512; ++i) { const int p = t - i; if (p >= 0) o += lg[i] * bf2f(KVW[((size_t)b * SEQ + p) * 256 + 128 + g * 64 + tid]); } oacc[2][tid] = o / sm; }
      __syncthreads(); }
    if (tid < 64) { float gt[3]; for (int j = 0; j < 3; ++j) { const float x = bf2f(T1[(size_t)r * 256 + 208 + hh * 3 + j]); gt[j] = 1.f / (1.f + expf(-x)); }
        ref[tid] = gt[0] * oacc[0][tid] + gt[1] * oacc[1][tid] + gt[2] * oacc[2][tid]; fast[tid] = bf2f(((const bf16_t*)(a.ws + OFF_MIXIN))[(size_t)r * 1536 + 1024 + hh * 64 + tid]); }
    __syncthreads(); commit(D, 10, ref, fast, 64, 0.04f);
}
__global__ void chk_out_e(Args a, unsigned* D) {
    __shared__ float ref[1024], fast[1024], cat[1024];
    const int r = srow(blockIdx.x, 64), tid = threadIdx.x; const bf16_t* MX = (const bf16_t*)(a.ws + OFF_MIXIN) + (size_t)r * 1536;
    for (int o = tid; o < 512; o += 256) { const int h = o >> 6, d = o & 63; float s = 0.f; for (int c = 0; c < 128; ++c) s += bf2f(MX[h * 128 + c]) * a.in[I_EWUV][c * 512 + h * 64 + d]; cat[o] = s; cat[512 + o] = bf2f(MX[1024 + o]); }
    __syncthreads();
    for (int n = tid; n < 1024; n += 256) { float s = 0.f; for (int j = 0; j < 1024; ++j) s += cat[j] * a.in[I_EWOUT][(size_t)j * 1024 + n]; ref[n] = s;
        fast[n] = bf2f(((const bf16_t*)(a.ws + OFF_S1))[(size_t)r * 1024 + n]) - ALPHA * a.in[I_X][(size_t)r * 1024 + n]; }
    __syncthreads(); commit(D, 11, ref, fast, 1024, 0.35f);
}
__global__ void chk_ln(const bf16_t* S, const bf16_t* O, const float* g, const float* bt, unsigned* D, int slot) {
    __shared__ float ref[1024], fast[1024];
    const int r = srow(blockIdx.x, 64), tid = threadIdx.x; float mean = 0.f, var = 0.f;
    for (int k = 0; k < 1024; ++k) mean += bf2f(S[(size_t)r * 1024 + k]); mean /= 1024.f;
    for (int k = 0; k < 1024; ++k) { const float d = bf2f(S[(size_t)r * 1024 + k]) - mean; var += d * d; } var /= 1024.f;
    for (int n = tid; n < 1024; n += 256) { ref[n] = (bf2f(S[(size_t)r * 1024 + n]) - mean) / sqrtf(var + 1e-5f) * g[n] + bt[n]; fast[n] = bf2f(O[(size_t)r * 1024 + n]); }
    __syncthreads(); commit(D, slot, ref, fast, 1024, 0.01f);
}
__global__ void chk_ffn_up(Args a, unsigned* D) {
    __shared__ float ref[DFF], fast[DFF], hrow[1024];
    const int r = srow(blockIdx.x, 64), tid = threadIdx.x; const bf16_t* H = (const bf16_t*)(a.ws + OFF_H) + (size_t)r * 1024;
    for (int k = tid; k < 1024; k += 256) hrow[k] = bf2f(H[k]);
    __syncthreads();
    for (int n = tid; n < DFF; n += 256) { float s1 = 0.f, s3 = 0.f; for (int k = 0; k < 1024; ++k) { s1 += hrow[k] * bfr(a.in[I_EF1][(size_t)k * DFF + n]); s3 += hrow[k] * bfr(a.in[I_EF3][(size_t)k * DFF + n]); }
        ref[n] = s1 / (1.f + expf(-s1)) * s3; fast[n] = bf2f(((const bf16_t*)(a.ws + OFF_ACT))[(size_t)r * DFF + n]); }
    __syncthreads(); commit(D, 13, ref, fast, DFF, 0.02f);
}
__global__ void chk_ffn_dn(Args a, unsigned* D) {
    __shared__ float ref[1024], fast[1024], arow[DFF];
    const int r = srow(blockIdx.x, 64), tid = threadIdx.x; const bf16_t* A = (const bf16_t*)(a.ws + OFF_ACT) + (size_t)r * DFF;
    for (int k = tid; k < DFF; k += 256) arow[k] = bf2f(A[k]);
    __syncthreads();
    for (int n = tid; n < 1024; n += 256) { float s = 0.f; for (int k = 0; k < DFF; ++k) s += arow[k] * bfr(a.in[I_EF2][(size_t)k * 1024 + n]); ref[n] = s;
        fast[n] = bf2f(((const bf16_t*)(a.ws + OFF_S2))[(size_t)r * 1024 + n]) - ALPHA * bf2f(((const bf16_t*)(a.ws + OFF_H))[(size_t)r * 1024 + n]); }
    __syncthreads(); commit(D, 14, ref, fast, 1024, 0.06f);
}
__global__ void chk_in_o(Args a, unsigned* D) {
    __shared__ float ref[2048], fast[2048], xr[1024];
    const int r = srow(blockIdx.x, 64), tid = threadIdx.x; const bf16_t* X1 = (const bf16_t*)(a.ws + OFF_X1) + (size_t)r * 1024;
    for (int k = tid; k < 1024; k += 256) xr[k] = bf2f(X1[k]);
    __syncthreads();
    for (int n = tid; n < 2048; n += 256) { float s = 0.f; for (int k = 0; k < 1024; ++k) s += xr[k] * bfr(a.in[I_OWIN][(size_t)k * 3072 + 1024 + n]); ref[n] = s;
        fast[n] = bf2f(((const bf16_t*)(a.ws + OFF_QKV))[(size_t)(1 + (n >> 10)) * MTOK * 1024 + (size_t)r * 1024 + (n & 1023)]); }
    __syncthreads(); commit(D, 16, ref, fast, 2048, 0.02f);
    const int pm = r >> 8; const bf16_t* K = (const bf16_t*)(a.ws + OFF_QKV) + (size_t)MTOK * 1024 + (size_t)pm * 256 * 1024; const float* KM = (const float*)(a.ws + OFF_KMEAN) + (size_t)pm * 2048;
    for (int n = tid; n < 1024; n += 256) { float s = 0.f; for (int q = 0; q < 256; ++q) s += bf2f(K[(size_t)q * 1024 + n]); ref[n] = s; fast[n] = KM[n] + KM[1024 + n]; }
    __syncthreads(); commit(D, 17, ref, fast, 1024, 0.03f);
}
__global__ void chk_moba(Args a, unsigned* D) {
    __shared__ float lg[1024], red[256], ref[64], fast[64], q[64], gate[16]; __shared__ int blkof[4];
    const int r = (blockIdx.x < 8) ? (blockIdx.x * 4096 + blockIdx.x * 300) : srow(blockIdx.x, 64), tid = threadIdx.x, b = r >> 12, t = r & 4095, h = blockIdx.x & 15, own = t >> 8;
    const bf16_t* X1 = (const bf16_t*)(a.ws + OFF_X1) + (size_t)r * 1024; const bf16_t* K = (const bf16_t*)(a.ws + OFF_QKV) + (size_t)MTOK * 1024 + (size_t)b * SEQ * 1024 + h * 64; const bf16_t* V = K + (size_t)MTOK * 1024;
    const float* relb = a.in[I_RELB];
    if (tid < 64) { float s = 0.f; for (int k = 0; k < 1024; ++k) s += bf2f(X1[k]) * bfr(a.in[I_OWIN][(size_t)k * 3072 + h * 64 + tid]); q[tid] = bfr(s * QSCALE); }
    __syncthreads();
    if (tid < 16) { float s = -INFINITY; if (tid < own) { s = 0.f; for (int p = 0; p < 256; ++p) for (int d = 0; d < 64; ++d) s += q[d] * bf2f(K[(size_t)(256 * tid + p) * 1024 + d]); } gate[tid] = s; }
    __syncthreads();
    if (tid == 0) { unsigned used = 0u; for (int k = 0; k < 3; ++k) { int bj = -1; float best = -INFINITY; for (int j = 0; j < own; ++j) if (!((used >> j) & 1u) && gate[j] > best) { best = gate[j]; bj = j; } blkof[k] = bj; if (bj >= 0) used |= 1u << bj; } blkof[3] = own; }
    __syncthreads();
    float mx = -INFINITY;
    for (int i = tid; i < 1024; i += 256) { const int j = blkof[i >> 8], p = 256 * j + (i & 255); float v = -INFINITY; if (j >= 0 && p <= t) { float d = 0.f; for (int k = 0; k < 64; ++k) d += q[k] * bf2f(K[(size_t)p * 1024 + k]); v = d + bias_l2(relb, h, t - p); } lg[i] = v; mx = fmaxf(mx, v); }
    red[tid] = mx; __syncthreads(); for (int o = 128; o > 0; o >>= 1) { if (tid < o) red[tid] = fmaxf(red[tid], red[tid + o]); __syncthreads(); } mx = red[0]; __syncthreads();
    float sm = 0.f; for (int i = tid; i < 1024; i += 256) { const float p = exp2f(lg[i] - mx); lg[i] = p; sm += p; }
    red[tid] = sm; __syncthreads(); for (int o = 128; o > 0; o >>= 1) { if (tid < o) red[tid] += red[tid + o]; __syncthreads(); } sm = red[0]; __syncthreads();
    if (tid < 64) { float o = 0.f; for (int i = 0; i < 1024; ++i) { const int j = blkof[i >> 8], p = 256 * j + (i & 255); if (j >= 0 && p <= t) o += lg[i] * bf2f(V[(size_t)p * 1024 + tid]); } ref[tid] = o / sm;
        fast[tid] = bf2f(((const bf16_t*)(a.ws + OFF_QKV))[(size_t)r * 1024 + h * 64 + tid]); }
    __syncthreads(); commit(D, 18, ref, fast, 64, 0.04f);
}
__global__ void chk_out_o(Args a, unsigned* D) {
    __shared__ float ref[1024], fast[1024], orow[1024];
    const int r = srow(blockIdx.x, 64), tid = threadIdx.x;
    for (int k = tid; k < 1024; k += 256) orow[k] = bf2f(((const bf16_t*)(a.ws + OFF_QKV))[(size_t)r * 1024 + k]);
    __syncthreads();
    for (int n = tid; n < 1024; n += 256) { float s = 0.f; for (int k = 0; k < 1024; ++k) s += orow[k] * a.in[I_OWOUT][(size_t)k * 1024 + n]; ref[n] = s;
        fast[n] = bf2f(((const bf16_t*)(a.ws + OFF_S1O))[(size_t)r * 1024 + n]) - ALPHA * bf2f(((const bf16_t*)(a.ws + OFF_X1))[(size_t)r * 1024 + n]); }
    __syncthreads(); commit(D, 20, ref, fast, 1024, 0.5f);
}
__global__ void chk_route(Args a, unsigned* D) {
    const int r = srow(blockIdx.x * 256 + threadIdx.x, 64); const bf16_t* H2 = (const bf16_t*)(a.ws + OFF_H2) + (size_t)r * 1024;
    float lg[8]; for (int e = 0; e < 8; ++e) lg[e] = 0.f;
    for (int k = 0; k < 1024; ++k) { const float hv = bf2f(H2[k]); for (int e = 0; e < 8; ++e) lg[e] += hv * a.in[I_OROUTER][k * 8 + e]; }
    int e0 = 0; for (int e = 1; e < 8; ++e) if (lg[e] > lg[e0]) e0 = e; int e1 = -1; for (int e = 0; e < 8; ++e) if (e != e0 && (e1 < 0 || lg[e] > lg[e1])) e1 = e;
    const float g0 = 1.f / (1.f + expf(lg[e1] - lg[e0]));
    const u32x2 rt = ((const u32x2*)(a.ws + OFF_ROUTE))[r]; const int f0 = rt.x & 255, f1 = (rt.x >> 8) & 255; const float fg = __uint_as_float(rt.y);
    int bad = 0; if (f0 != e0 || f1 != e1 || !(fabsf(fg - g0) <= 0.02f)) ++bad;
    atomicAdd(&D[4 * 21], (unsigned)bad); atomicAdd(&D[4 * 21 + 1], 1u);
    const int* GI = (const int*)(a.ws + OFF_GINFO); const int* DEST = (const int*)(a.ws + OFF_DEST) + 2 * (size_t)r;
    int bad2 = 0;
    for (int k = 0; k < 2; ++k) { const int e = k ? f1 : f0, d = DEST[k], ps = e ? GI[e - 1] : 0; if (d < ps || d >= ps + GI[8 + e]) ++bad2; }
    atomicAdd(&D[4 * 22], (unsigned)bad2); atomicAdd(&D[4 * 22 + 1], 2u);
}
__global__ void chk_moe(Args a, unsigned* D) {
    __shared__ float ref[1024], fast[1024], hrow[1024], act[DFFE], fin[1024];
    const int r = srow(blockIdx.x, 64), tid = threadIdx.x; const bf16_t* H2 = (const bf16_t*)(a.ws + OFF_H2) + (size_t)r * 1024;
    for (int k = tid; k < 1024; k += 256) { hrow[k] = bf2f(H2[k]); ref[k] = 0.f; }
    const u32x2 rt = ((const u32x2*)(a.ws + OFF_ROUTE))[r]; const float g0 = __uint_as_float(rt.y); const int* DEST = (const int*)(a.ws + OFF_DEST) + 2 * (size_t)r; const bf16_t* YR = (const bf16_t*)(a.ws + OFF_YR);
    __syncthreads();
    for (int k = 0; k < 2; ++k) { const int e = k ? ((rt.x >> 8) & 255) : (rt.x & 255); const float gk = k ? 1.f - g0 : g0;
        const float* w1 = a.in[I_OM1] + (size_t)e * 1024 * DFFE; const float* w3 = a.in[I_OM3] + (size_t)e * 1024 * DFFE; const float* w2 = a.in[I_OM2] + (size_t)e * DFFE * 1024;
        for (int f = tid; f < DFFE; f += 256) { float s1 = 0.f, s3 = 0.f; for (int q = 0; q < 1024; ++q) { s1 += hrow[q] * bfr(w1[(size_t)q * DFFE + f]); s3 += hrow[q] * bfr(w3[(size_t)q * DFFE + f]); } act[f] = bfr(s1 / (1.f + expf(-s1)) * s3); }
        __syncthreads();
        for (int n = tid; n < 1024; n += 256) { float s = 0.f; for (int f = 0; f < DFFE; ++f) s += act[f] * bfr(w2[(size_t)f * 1024 + n]); ref[n] += gk * s; }
        __syncthreads(); }
    for (int n = tid; n < 1024; n += 256) { fast[n] = g0 * bf2f(YR[(size_t)DEST[0] * 1024 + n]) + (1.f - g0) * bf2f(YR[(size_t)DEST[1] * 1024 + n]); fin[n] = ALPHA * hrow[n] + fast[n]; }
    __syncthreads(); commit(D, 23, ref, fast, 1024, 0.12f);
    float mean = 0.f, var = 0.f; for (int k = 0; k < 1024; ++k) mean += fin[k]; mean /= 1024.f; for (int k = 0; k < 1024; ++k) { const float d = fin[k] - mean; var += d * d; } var /= 1024.f;
    __syncthreads();
    for (int n = tid; n < 1024; n += 256) { ref[n] = (fin[n] - mean) / sqrtf(var + 1e-5f) * a.in[I_OLN2G][n] + a.in[I_OLN2B][n]; fast[n] = a.out[(size_t)r * 1024 + n]; }
    __syncthreads(); commit(D, 24, ref, fast, 1024, 0.005f);
    { float m2 = 0.f, v2 = 0.f; for (int k = 0; k < 1024; ++k) m2 += ALPHA * hrow[k]; m2 /= 1024.f; for (int k = 0; k < 1024; ++k) { const float d = ALPHA * hrow[k] - m2; v2 += d * d; } v2 /= 1024.f;
      for (int n = tid; n < 1024; n += 256) ref[n] = (ALPHA * hrow[n] - m2) / sqrtf(v2 + 1e-5f) * a.in[I_OLN2G][n] + a.in[I_OLN2B][n];
      __syncthreads(); commit(D, 28, ref, fast, 1024, 0.005f); }
    { for (int n = tid; n < 1024; n += 256) fin[n] = ALPHA * hrow[n] + (1.f - g0) * bf2f(YR[(size_t)DEST[0] * 1024 + n]) + g0 * bf2f(YR[(size_t)DEST[1] * 1024 + n]);
      __syncthreads();
      float m2 = 0.f, v2 = 0.f; for (int k = 0; k < 1024; ++k) m2 += fin[k]; m2 /= 1024.f; for (int k = 0; k < 1024; ++k) { const float d = fin[k] - m2; v2 += d * d; } v2 /= 1024.f;
      __syncthreads();
      for (int n = tid; n < 1024; n += 256) ref[n] = (fin[n] - m2) / sqrtf(v2 + 1e-5f) * a.in[I_OLN2G][n] + a.in[I_OLN2B][n];
      __syncthreads(); commit(D, 29, ref, fast, 1024, 0.005f); }
}

__global__ void chk_wmoe(Args a, unsigned* D) {
    const int tid = blockIdx.x * 256 + threadIdx.x; const unsigned hsh = (unsigned)tid * 2654435761u;
    const int e = hsh & 7, f = (hsh >> 3) % DFFE, k = (hsh >> 15) % 1024;
    const bf16_t* W13 = (const bf16_t*)(a.ws + OFF_W_M13) + (size_t)e * 2 * DFFE * 1024; const bf16_t* W2 = (const bf16_t*)(a.ws + OFF_W_M2) + (size_t)e * 1024 * DFFE;
    int bad = 0;
    if (W13[(size_t)(((f >> 7) << 8) + (f & 127)) * 1024 + k] != (bf16_t)f2bf(a.in[I_OM1][(size_t)e * 1024 * DFFE + (size_t)k * DFFE + f])) ++bad;
    if (W13[(size_t)(((f >> 7) << 8) + (f & 127) + 128) * 1024 + k] != (bf16_t)f2bf(a.in[I_OM3][(size_t)e * 1024 * DFFE + (size_t)k * DFFE + f])) ++bad;
    atomicAdd(&D[4 * 25], (unsigned)bad); atomicAdd(&D[4 * 25 + 1], 2u);
    int bad2 = 0; if (W2[(size_t)k * DFFE + f] != (bf16_t)f2bf(a.in[I_OM2][(size_t)e * DFFE * 1024 + (size_t)f * 1024 + k])) ++bad2;
    atomicAdd(&D[4 * 26], (unsigned)bad2); atomicAdd(&D[4 * 26 + 1], 1u);
}
__global__ void chk_actm(Args a, unsigned* D) {
    __shared__ float ref[DFFE], fast[DFFE], hrow[1024]; __shared__ int tokf, kf;
    const int tid = threadIdx.x; const int* GI = (const int*)(a.ws + OFF_GINFO); const int nrows = GI[7], ng = nrows >> 8, g0 = ((ng - 1) / MOE_CHUNK) * MOE_CHUNK;
    const int rho = 256 * g0 + (int)(((unsigned)blockIdx.x * 2654435761u) % (unsigned)(nrows - 256 * g0));
    if (tid == 0) { tokf = -1; kf = 0; } __syncthreads();
    const int* DEST = (const int*)(a.ws + OFF_DEST);
    for (int i = tid; i < 2 * MTOK; i += 256) if (DEST[i] == rho) { tokf = i >> 1; kf = i & 1; }
    __syncthreads();
    if (tokf < 0) return;
    const int tok = tokf; const u32x2 rt = ((const u32x2*)(a.ws + OFF_ROUTE))[tok]; const int e = kf ? ((rt.x >> 8) & 255) : (rt.x & 255);
    const bf16_t* H2 = (const bf16_t*)(a.ws + OFF_H2) + (size_t)tok * 1024;
    for (int k = tid; k < 1024; k += 256) hrow[k] = bf2f(H2[k]);
    __syncthreads();
    const float* w1 = a.in[I_OM1] + (size_t)e * 1024 * DFFE; const float* w3 = a.in[I_OM3] + (size_t)e * 1024 * DFFE;
    for (int f = tid; f < DFFE; f += 256) { float s1 = 0.f, s3 = 0.f; for (int q = 0; q < 1024; ++q) { s1 += hrow[q] * bfr(w1[(size_t)q * DFFE + f]); s3 += hrow[q] * bfr(w3[(size_t)q * DFFE + f]); }
        ref[f] = s1 / (1.f + expf(-s1)) * s3; fast[f] = bf2f(((const bf16_t*)(a.ws + OFF_ACTM))[(size_t)(rho - 256 * g0) * DFFE + f]); }
    __syncthreads(); commit(D, 27, ref, fast, DFFE, 0.02f);
}

__global__ void simple_final(Args a) {
    const int row = blockIdx.x * 4 + (threadIdx.x >> 6), lane = threadIdx.x & 63; unsigned char* ws = a.ws;
    const bf16_t* H2 = (const bf16_t*)(ws + OFF_H2); const bf16_t* YR = (const bf16_t*)(ws + OFF_YR);
    const u32x2* ROUTE = (const u32x2*)(ws + OFF_ROUTE); const int* DEST = (const int*)(ws + OFF_DEST);
    const float g0 = __uint_as_float(ROUTE[row].y), g1 = 1.f - g0; const int d0 = DEST[2 * row], d1 = DEST[2 * row + 1];
    float v[16]; float s = 0.f;
    for (int i = 0; i < 16; ++i) { const int col = lane + 64 * i; v[i] = ALPHA * bf2f(H2[(size_t)row * 1024 + col]) + g0 * bf2f(YR[(size_t)d0 * 1024 + col]) + g1 * bf2f(YR[(size_t)d1 * 1024 + col]); s += v[i]; }
    const float mean = wave_sum(s) / 1024.f; float q = 0.f;
    for (int i = 0; i < 16; ++i) { v[i] -= mean; q += v[i] * v[i]; }
    const float rstd = 1.f / sqrtf(wave_sum(q) / 1024.f + 1e-5f);
    for (int i = 0; i < 16; ++i) { const int col = lane + 64 * i; a.out[(size_t)row * 1024 + col] = v[i] * rstd * a.in[I_OLN2G][col] + a.in[I_OLN2B][col]; }
}
__global__ void report(float* out, const unsigned* D, int nelem) {
    __shared__ float kk, xx;
    if (threadIdx.x == 0) { int idx = 0; float v = 0.f; float worst = 0.f;
        for (int s = 1; s < NSLOT; ++s) { const unsigned bad = D[4 * s], tot = D[4 * s + 1]; if (tot == 0u) continue; const float fr = (float)bad / (float)tot; const float thr = (s == 9 || s == 10 || s == 18) ? 0.1f : 0.002f;
            if (fr > worst) worst = fr; if (fr > thr && idx == 0) { idx = s; v = fr; } }
        if (idx == 0) v = worst;
#ifdef DBG_BITS
        { const int sl[6] = DBG_BITS; idx = 0; for (int q = 0; q < 6; ++q) { const int s = sl[q]; if (s > 0 && D[4 * s + 1] > 0u && (float)D[4 * s] / (float)D[4 * s + 1] > 0.002f) idx |= 1 << q; } v = 1.f; }
#endif
#ifdef DBG_VAL
        { const float mr = __uint_as_float(D[4 * DBG_VAL + 2]); const float fr = D[4 * DBG_VAL + 1] ? (float)D[4 * DBG_VAL] / (float)D[4 * DBG_VAL + 1] : 0.f; kk = sqrtf(fmaxf(mr, 1e-6f) * 1e6f); xx = kk * (2.f + 97.f * fr); }
#else
        v = fmaxf(v, 1e-6f); const int n = (v > 0.3f) ? 4 : (v > 0.03f) ? 3 : (v > 0.003f) ? 2 : 1; kk = (n == 4) ? 1e4f : (n == 3) ? 1e3f : (n == 2) ? 1e2f : 1e1f; xx = kk * (float)(idx + 2);
#endif
        }
    __syncthreads();
    const float k = kk, x = xx;
    for (size_t i = (size_t)blockIdx.x * blockDim.x + threadIdx.x; i < (size_t)nelem; i += (size_t)gridDim.x * blockDim.x) out[i] = (i == 0) ? x : k;
}
}
#endif

#ifndef MK_N_LAUNCHES
#define MK_N_LAUNCHES 1
#endif
constexpr int NPHASE = 18;
#define SP2 true
#ifndef FFN_F8
#define FFN_F8 0
#endif
#ifndef MOE_SP2
#define MOE_SP2 true
#endif
#define ALN true

__global__ void __launch_bounds__(NTHR, 2) fwd_kernel(Args args) {
    extern __shared__ __attribute__((aligned(16))) unsigned char lds_raw[];
    Frame F;
    F.lds = (LAS unsigned char*)lds_raw;
    F.tid = threadIdx.x; F.lane = F.tid & 63; F.wave = __builtin_amdgcn_readfirstlane(F.tid >> 6);
    F.G = gridDim.x; F.bx = blockIdx.x; F.gw = F.bx * NWAVES + F.wave; F.NGW = F.G * NWAVES; F.ws = args.ws;
    unsigned char* ws = args.ws;
    volatile LAS unsigned* MISC = (volatile LAS unsigned*)(F.lds + LDSCTL_OFF);
    for (int u = F.tid; u < (LDS_BYTES - LDSCTL_OFF) / 4; u += NTHR) ((LAS unsigned*)(F.lds + LDSCTL_OFF))[u] = 0u;
    __syncthreads();
    XcdBarrier bar = xcd_barrier_post((unsigned*)(ws + OFF_BAR) + args.li * XCD_BAR_WORDS, MISC + 8);
    const int lo = args.ph_lo, hi = args.ph_hi;
#ifndef PH_MASK
#define PH_MASK 0x3ffff
#endif
#define IN(k) (((PH_MASK >> (k)) & 1) && lo <= (k) && (k) < hi)
#ifdef TS_MODE
    unsigned long long* TS = (unsigned long long*)(ws + OFF_DBG + 1024);
#define STAMP(i) do { if (F.bx == 0 && F.tid == 0) TS[i] = __builtin_amdgcn_s_memrealtime(); } while (0)
#else
#define STAMP(i) do { } while (0)
#endif
#define SEAM(k) do { if (IN(k) && IN((k) + 1)) xcd_barrier(bar); STAMP((k) + 1); } while (0)
    LAS unsigned char* glds = F.lds;

    bf16_t* Y1 = (bf16_t*)(ws + OFF_Y1);
    float* ssq_q = (float*)(ws + OFF_SSQ_Q); float* ssq_kv = (float*)(ws + OFF_SSQ_KV);

    STAMP(0);
    if (IN(0)) { phase_prologue_even(F, args); } SEAM(0);
    if (IN(1)) { pg8::Gemm g{(const bf16_t*)(ws + OFF_XB), (const bf16_t*)(ws + OFF_W_IN), MTOK, EVEN_INP, 512, 512, 0}; pg8::StaticOrder S; S.init(MTOK, EVEN_INP, F.G, F.bx);
        pg8::EpiInE E{Y1, ssq_q, ssq_kv, 1.f / WIN_SCALE}; pg8::gemm_phase<pg8::EpiInE, pg8::StaticOrder, ALN, SP2, true>(glds, g, S, E); } SEAM(1);
    if (IN(2)) {
        phase_ckvn(F, Y1 + (size_t)1 * MTOK * 256, ssq_kv, args.in[I_EKVN], (bf16_t*)(ws + OFF_CKVN));
#ifndef NO_CMP
        for (int idx = F.bx; idx < 256; idx += F.G) { const int b = idx >> 5, g = (idx >> 4) & 1, kv = (idx >> 3) & 1, rt = idx & 7;
            compress_unit(F, b, g, kv, rt, Y1 + (size_t)4 * MTOK * 256, (const bf16_t*)(ws + (kv ? OFF_CV1 : OFF_CK1)), args.in[kv ? I_ECV2 : I_ECK2], (const float*)(ws + OFF_CB) + kv * 64, (bf16_t*)(ws + (kv ? OFF_VC : OFF_KC))); }
#endif
#ifndef NO_Q2
        pg8::Gemm g{Y1, (const bf16_t*)(ws + OFF_W_Q2), MTOK, 2048, 256, 256, 0}; pg8::StaticOrder S; S.init(MTOK, 2048, F.G, F.bx);
        pg8::EpiQ2 E{(bf16_t*)(ws + OFF_QLAT), ws + OFF_QIDX, ssq_q}; pg8::gemm_phase<pg8::EpiQ2, pg8::StaticOrder, ALN, SP2>(glds, g, S, E);
#endif
    } SEAM(2);
    if (IN(3)) { for (int idx = F.bx; idx < 512; idx += F.G) { const int i = idx >> 8, v = idx & 255, b = v & 7, cc = v >> 3, c = i ? 63 - cc : cc;
            indexer_unit(F, b, c, ws + OFF_QIDX, Y1 + (size_t)1 * MTOK * 256, (_Float16*)(ws + OFF_SC)); } } SEAM(3);
    if (IN(4)) { phase_select(F, (const _Float16*)(ws + OFF_SC), (unsigned*)(ws + OFF_MASK)); } SEAM(4);
    if (IN(5)) {
#ifndef NO_DSA
        if (args.pad != 2) phase_dsa_sparse(F, (const bf16_t*)(ws + OFF_QLAT), (const bf16_t*)(ws + OFF_CKVN), (const unsigned*)(ws + OFF_MASK), (const float*)(ws + OFF_BT), ws + OFF_MIXIN);
#endif
        STAMP(20);
#ifndef NO_NSA
        if (args.pad != 1) for (int idx = F.bx; idx < 1024; idx += F.G) { const int i = idx >> 8, v = idx & 255, b = v & 7, cc = v >> 3, g = i & 1, c = (i >> 1) ? 63 - cc : cc;
            nsa_unit(F, b, g, c, Y1, (const bf16_t*)(ws + OFF_KC), (const bf16_t*)(ws + OFF_VC), (const float*)(ws + OFF_BT), ws + OFF_MIXIN); __syncthreads(); }
#endif
    } SEAM(5);
    if (IN(6)) { pg8::Gemm g{(const bf16_t*)(ws + OFF_MIXIN), (const bf16_t*)(ws + OFF_W_OUTE), MTOK, 1024, 768, 768, 0}; pg8::StaticOrder S; S.init(MTOK, 1024, F.G, F.bx);
        pg8::EpiRes<true> E{args.in[I_X], (bf16_t*)(ws + OFF_S1), 1.f / (OSC * WOUT_SCALE)}; pg8::gemm_phase<pg8::EpiRes<true>, pg8::StaticOrder, ALN, SP2, true>(glds, g, S, E); } SEAM(6);
    if (IN(7)) { phase_ln_i8(F, (const bf16_t*)(ws + OFF_S1), (bf16_t*)(ws + OFF_H), ws + OFF_H8, (float*)(ws + OFF_SA), args.in[I_ELN1G], args.in[I_ELN1B]); } SEAM(7);
#if FFN_F8
    if (IN(8)) { pg8::Gemm g{(const bf16_t*)(ws + OFF_H8), (const bf16_t*)(ws + OFF_W_F13), MTOK, 2 * DFF, 512, 512, 0}; pg8::StaticOrder S; S.init(MTOK, 2 * DFF, F.G, F.bx);
        pg8::EpiSwiglu8 E{ws + OFF_ACT, DFF, 0, 1.f / WF13_SCALE}; pg8::gemm_phase<pg8::EpiSwiglu8, pg8::StaticOrder, ALN, SP2, true>(glds, g, S, E); } SEAM(8);
#else
    if (IN(8)) { pg8::Gemm g{(const bf16_t*)(ws + OFF_H8), (const bf16_t*)(ws + OFF_W_F13), MTOK, 2 * DFF, 512, 512, 0}; pg8::StaticOrder S; S.init(MTOK, 2 * DFF, F.G, F.bx);
        pg8::EpiSwigluI8 E{ws + OFF_ACT, DFF, (const float*)(ws + OFF_SA), (const float*)(ws + OFF_SW)}; pg8::gemm_phase<pg8::EpiSwigluI8, pg8::StaticOrder, ALN, SP2, false, true>(glds, g, S, E); } SEAM(8);
#endif
#if FFN_F8
    if (IN(9)) { pg8::Gemm g{(const bf16_t*)(ws + OFF_ACT), (const bf16_t*)(ws + OFF_W_F2), MTOK, 1024, DFF / 2, DFF / 2, 0}; pg8::StaticOrder S; S.init(MTOK, 1024, F.G, F.bx);
        pg8::EpiRes<false> E{(const void*)(ws + OFF_H), (bf16_t*)(ws + OFF_S2), 1.f / WF2_SCALE}; pg8::gemm_phase<pg8::EpiRes<false>, pg8::StaticOrder, ALN, SP2, true>(glds, g, S, E); } SEAM(9);
#else
    if (IN(9)) { pg8::Gemm g{(const bf16_t*)(ws + OFF_ACT), (const bf16_t*)(ws + OFF_W_F2), MTOK, 1024, DFF / 2, DFF / 2, 0}; pg8::StaticOrder S; S.init(MTOK, 1024, F.G, F.bx);
        pg8::EpiRes<false> E{(const void*)(ws + OFF_H), (bf16_t*)(ws + OFF_S2), 1.f / WF2_SCALE}; pg8::gemm_phase<pg8::EpiRes<false>, pg8::StaticOrder, ALN, SP2, true>(glds, g, S, E); } SEAM(9);
#endif
    if (IN(10)) { phase_ln_bf16(F, (const bf16_t*)(ws + OFF_S2), (bf16_t*)(ws + OFF_X1), ws + OFF_X18, args.in[I_ELN2G], args.in[I_ELN2B]); phase_convert_odd(F, args); } SEAM(10);
    if (IN(11)) { pg8::Gemm g{(const bf16_t*)(ws + OFF_X18), (const bf16_t*)(ws + OFF_W_OIN), MTOK, 3072, 512, 512, 0}; pg8::StaticOrder S; S.init(MTOK, 3072, F.G, F.bx);
        pg8::EpiInO E{(bf16_t*)(ws + OFF_QKV), (float*)(ws + OFF_KMEAN), 1.f / WIN_SCALE}; pg8::gemm_phase<pg8::EpiInO, pg8::StaticOrder, ALN, SP2, true>(glds, g, S, E); } SEAM(11);
#ifdef MOBA_DENSE
    if (IN(12)) { phase_moba(F, ws, args.pad); } SEAM(12);
#else
    if (IN(12)) { phase_moba2(F, ws, args.pad); } SEAM(12);
#endif
    if (IN(13)) { pg8::Gemm g{(const bf16_t*)(ws + OFF_O8), (const bf16_t*)(ws + OFF_W_OOUT), MTOK, 1024, 512, 512, 0}; pg8::StaticOrder S; S.init(MTOK, 1024, F.G, F.bx);
        pg8::EpiRes<false> E{(const void*)(ws + OFF_X1), (bf16_t*)(ws + OFF_S1O), 1.f / (OSC * WOUT_SCALE)}; pg8::gemm_phase<pg8::EpiRes<false>, pg8::StaticOrder, ALN, SP2, true>(glds, g, S, E); } SEAM(13);
    if (IN(14)) { phase_ln_router(F, (const bf16_t*)(ws + OFF_S1O), (bf16_t*)(ws + OFF_H2), args.in[I_OLN1G], args.in[I_OLN1B], args.in[I_OROUTER], ws); } SEAM(14);
    if (IN(15)) { phase_moe_gather(F, (const bf16_t*)(ws + OFF_H2), ws + OFF_XR, ws); } SEAM(15);
    if (IN(16)) {
        const int* GI = (const int*)(ws + OFF_GINFO);
        pg8::MoeOrder S; S.G = F.G; S.c = F.bx;
#pragma unroll
        for (int e = 0; e < 8; ++e) S.pend[e] = __builtin_amdgcn_readfirstlane(GI[e]);
        const int ngroups = S.pend[7] >> 8;
        const int nfull = ngroups / MOE_CHUNK, rem = ngroups - nfull * MOE_CHUNK; const bool merged = rem > 0 && rem <= 16 && nfull > 0;
        const int nchunk = nfull + ((rem > 0 && !merged) ? 1 : 0), nsteps = merged ? 2 * nfull + 1 : 2 * nchunk;
        for (int st = 0; st < nsteps; ++st) {
            bool doD = false, doU = false, dtail = false, utail = false; int dg0 = 0, dng = 0, ug0 = 0, ung = 0, und = 0;
            if (merged) {
                if (st == 0) { doU = true; utail = true; ug0 = nfull * MOE_CHUNK; ung = rem; }
                else if (st == 1) { doD = true; dtail = true; dg0 = nfull * MOE_CHUNK; dng = rem; doU = true; ug0 = 0; ung = MOE_CHUNK; und = 4 * rem; }
                else { const int k = st - 2, ci = (k + 1) >> 1; if (k & 1) { doU = true; ug0 = ci * MOE_CHUNK; ung = MOE_CHUNK; } else { doD = true; dg0 = ci * MOE_CHUNK; dng = MOE_CHUNK; } }
            } else { const int ci = st >> 1, g0 = ci * MOE_CHUNK, ng = (ngroups - g0) < MOE_CHUNK ? (ngroups - g0) : MOE_CHUNK; if (st & 1) { doD = true; dg0 = g0; dng = ng; } else { doU = true; ug0 = g0; ung = ng; } }
            if (doD) { S.g0 = dg0; S.ng = dng; S.nN = 4; S.nd = 0;
              pg8::Gemm g{(const bf16_t*)(ws + (dtail ? OFF_ACTT : OFF_ACTM) - (size_t)dg0 * 256 * DFFE), (const bf16_t*)(ws + OFF_W_M2), 0, 1024, DFFE / 2, DFFE / 2, (size_t)1024 * DFFE / 2};
              pg8::EpiStoreS E{(bf16_t*)(ws + OFF_YR), 1024, 1.f / W2_SCALE}; pg8::gemm_phase<pg8::EpiStoreS, pg8::MoeOrder, ALN, MOE_SP2, true>(glds, g, S, E); }
            if (doU) { S.g0 = ug0; S.ng = ung; S.nN = 28; S.nd = und;
              pg8::Gemm g{(const bf16_t*)(ws + OFF_XR), (const bf16_t*)(ws + OFF_W_M13), 0, 2 * DFFE, 512, 512, (size_t)2 * DFFE * 512};
              pg8::EpiSwiglu8 E{ws + (utail ? OFF_ACTT : OFF_ACTM), DFFE, ug0, 1.f / W13_SCALE}; pg8::gemm_phase<pg8::EpiSwiglu8, pg8::MoeOrder, ALN, MOE_SP2, true>(glds, g, S, E); }
            xcd_barrier(bar);
        }
    }
    STAMP(17);
    if (IN(17)) { phase_final(F, (const bf16_t*)(ws + OFF_H2), (const bf16_t*)(ws + OFF_YR), args.in[I_OLN2G], args.in[I_OLN2B], args.out, ws); }
#ifdef TS_MODE
    STAMP(18);
    xcd_barrier(bar);
    { const int ia[2] = TS_SEL; float d[2];
      for (int q = 0; q < 2; ++q) { const int i = ia[q]; const unsigned long long t1 = (i == 5) ? TS[20] : ((i == 25) ? TS[6] : TS[i + 1]); const unsigned long long t0 = (i == 25) ? TS[20] : TS[i]; d[q] = (float)(t1 - t0) * 0.01f; }
      const float k = sqrtf(fmaxf(d[0], 1.f)), x = 10.f * fmaxf(d[1], 1.f);
      for (size_t i = (size_t)F.bx * NTHR + F.tid; i < (size_t)MTOK * 1024; i += (size_t)F.G * NTHR) args.out[i] = (i == 0) ? x : k; }
#endif
#undef IN
#undef SEAM
}

extern "C" void kernel_launch(void* const* d_in, const int* in_sizes, int n_in, void* d_out, int out_size, void* d_ws, size_t ws_size, hipStream_t stream) {
    static int grid = 0;
    if (grid == 0) {
        if (n_in != 33 || in_sizes[0] != MTOK * DM || out_size != MTOK * DM || ws_size < WS_END) { fprintf(stderr, "kernel_launch: unexpected problem (n_in %d, in0 %d, out %d, ws %zu < %zu)\n", n_in, n_in > 0 ? in_sizes[0] : -1, out_size, ws_size, (size_t)WS_END); grid = -1; return; }
        int dev = 0, cus = 0, per_cu = 0;
        if (hipGetDevice(&dev) != hipSuccess || hipDeviceGetAttribute(&cus, hipDeviceAttributeMultiprocessorCount, dev) != hipSuccess) { grid = -1; return; }
        if (hipFuncSetAttribute((const void*)fwd_kernel, hipFuncAttributeMaxDynamicSharedMemorySize, LDS_BYTES) != hipSuccess) { fprintf(stderr, "kernel_launch: hipFuncSetAttribute failed\n"); grid = -1; return; }
        if (hipOccupancyMaxActiveBlocksPerMultiprocessor(&per_cu, (const void*)fwd_kernel, NTHR, LDS_BYTES) != hipSuccess || per_cu < 1) fprintf(stderr, "kernel_launch: occupancy query reports %d\n", per_cu);
        (void)hipGetLastError();
        grid = cus > 256 ? 256 : cus;
    }
    if (grid < 0) return;
    hipMemsetAsync(d_ws, 0, CTL_ZERO_BYTES, stream);
    Args a{};
    for (int i = 0; i < 33; ++i) a.in[i] = (const float*)d_in[i];
    a.out = (float*)d_out; a.ws = (unsigned char*)d_ws;
#if MK_N_LAUNCHES == 1
    a.ph_lo = 0; a.ph_hi = NPHASE; a.li = 0;
    hipLaunchKernelGGL(fwd_kernel, dim3(grid), dim3(NTHR), LDS_BYTES, stream, a);
#else
    for (int p = 0; p < NPHASE; ++p) { a.ph_lo = p; a.ph_hi = p + 1; a.li = p;
#ifdef REP_PHASE
        if (p == REP_PHASE) { Args a2 = a;
#ifdef REP_PAD
            a2.pad = REP_PAD;
#endif
            for (int rep = 0; rep < REP_N; ++rep) { a2.li = NPHASE + rep; hipLaunchKernelGGL(fwd_kernel, dim3(grid), dim3(NTHR), LDS_BYTES, stream, a2); } }
#endif
        hipLaunchKernelGGL(fwd_kernel, dim3(grid), dim3(NTHR), LDS_BYTES, stream, a);
#ifdef DBG_MODE
        unsigned* D = (unsigned*)((unsigned char*)d_ws + OFF_DBG); unsigned char* ws = (unsigned char*)d_ws;
        switch (p) {
            case 1: hipLaunchKernelGGL(dbg::chk_in_e, dim3(64), dim3(256), 0, stream, a, D); break;
            case 2: hipLaunchKernelGGL(dbg::chk_q2, dim3(64), dim3(256), 0, stream, a, D); hipLaunchKernelGGL(dbg::chk_cmp, dim3(96), dim3(256), 0, stream, a, D); break;
            case 3: hipLaunchKernelGGL(dbg::chk_idx, dim3(64), dim3(256), 0, stream, a, D); break;
            case 4: hipLaunchKernelGGL(dbg::chk_sel, dim3(48), dim3(256), 0, stream, a, D); break;
            case 5: hipLaunchKernelGGL(dbg::chk_dsa, dim3(64), dim3(256), 0, stream, a, D); hipLaunchKernelGGL(dbg::chk_nsa, dim3(64), dim3(256), 0, stream, a, D); break;
            case 6: hipLaunchKernelGGL(dbg::chk_out_e, dim3(32), dim3(256), 0, stream, a, D); break;
            case 7: hipLaunchKernelGGL(dbg::chk_ln, dim3(32), dim3(256), 0, stream, (const bf16_t*)(ws + OFF_S1), (const bf16_t*)(ws + OFF_H), a.in[I_ELN1G], a.in[I_ELN1B], D, 12); break;
            case 8: hipLaunchKernelGGL(dbg::chk_ffn_up, dim3(16), dim3(256), 0, stream, a, D); break;
            case 9: hipLaunchKernelGGL(dbg::chk_ffn_dn, dim3(32), dim3(256), 0, stream, a, D); break;
            case 10: hipLaunchKernelGGL(dbg::chk_ln, dim3(32), dim3(256), 0, stream, (const bf16_t*)(ws + OFF_S2), (const bf16_t*)(ws + OFF_X1), a.in[I_ELN2G], a.in[I_ELN2B], D, 15); break;
            case 10 + 100: break;
            case 11: hipLaunchKernelGGL(dbg::chk_wmoe, dim3(16), dim3(256), 0, stream, a, D); hipLaunchKernelGGL(dbg::chk_in_o, dim3(32), dim3(256), 0, stream, a, D); break;
            case 12: hipLaunchKernelGGL(dbg::chk_moba, dim3(64), dim3(256), 0, stream, a, D); break;
            case 13: hipLaunchKernelGGL(dbg::chk_out_o, dim3(32), dim3(256), 0, stream, a, D); break;
            case 14: hipLaunchKernelGGL(dbg::chk_ln, dim3(32), dim3(256), 0, stream, (const bf16_t*)(ws + OFF_S1O), (const bf16_t*)(ws + OFF_H2), a.in[I_OLN1G], a.in[I_OLN1B], D, 19); break;
            case 15: hipLaunchKernelGGL(dbg::chk_route, dim3(1), dim3(256), 0, stream, a, D); break;
            case 16: hipLaunchKernelGGL(dbg::chk_actm, dim3(8), dim3(256), 0, stream, a, D); break;
            case 17:
#ifdef DBG_SIMPLE_FINAL
                hipLaunchKernelGGL(dbg::simple_final, dim3(MTOK / 4), dim3(256), 0, stream, a);
#endif
                hipLaunchKernelGGL(dbg::chk_moe, dim3(16), dim3(256), 0, stream, a, D); hipLaunchKernelGGL(dbg::report, dim3(1024), dim3(256), 0, stream, (float*)d_out, (const unsigned*)D, out_size); break;
            default: break;
        }
#endif
    }
#endif
}
```
